# Optimizing an MI355X kernel written in HIP

```python
import math
import jax
import jax.numpy as jnp
from jax import lax
import numpy as np

D_MODEL = 1024
BATCH = 8
SEQ = 2048
DEPTH = 2

RMS_EPS = 1e-6
CONV_WIDTH = 4
N_BRANCH = 3

LRU_WIDTH = 1024
LRU_BLOCKS = 16
LRU_BLOCK_DIM = LRU_WIDTH // LRU_BLOCKS
LRU_C = 8.0

GDN_HEADS = 8
GDN_DK = 128
GDN_DV = 128
GDN_QK_WIDTH = GDN_HEADS * GDN_DK
GDN_V_WIDTH = GDN_HEADS * GDN_DV
GDN_CHUNK = 64

RWKV_HEADS = 16
RWKV_HD = 64
RWKV_WIDTH = RWKV_HEADS * RWKV_HD
RWKV_DECAY_RANK = 64
RWKV_ICLR_RANK = 64
RWKV_GATE_RANK = 128
RWKV_GN_EPS = 64e-5
RWKV_SIZES = (RWKV_WIDTH, RWKV_WIDTH, RWKV_WIDTH, RWKV_DECAY_RANK, RWKV_ICLR_RANK, RWKV_GATE_RANK)
RWKV_IN_WIDTH = sum(RWKV_SIZES)
RWKV_OFFSETS = tuple(sum(RWKV_SIZES[:i + 1]) for i in range(len(RWKV_SIZES) - 1))

IN_SIZES = (LRU_WIDTH, LRU_WIDTH, 2 * GDN_QK_WIDTH + GDN_V_WIDTH, GDN_V_WIDTH, GDN_HEADS, GDN_HEADS, RWKV_IN_WIDTH, N_BRANCH * D_MODEL)
IN_WIDTH = sum(IN_SIZES)
IN_OFFSETS = tuple(sum(IN_SIZES[:i + 1]) for i in range(len(IN_SIZES) - 1))

PEER_HEADS = 8
PEER_NKEYS = 128
PEER_EXPERTS = PEER_NKEYS * PEER_NKEYS
PEER_DKEY = 256
PEER_HALF = PEER_DKEY // 2
PEER_TOPK = 16
PEER_BLOCK = 128

kernel_name = 'hybrid_rglru_gdn_rwkv7_peer_trunk'


def rmsnorm(x, w):
    xf = x.astype(jnp.float32)
    y = xf * lax.rsqrt(jnp.mean(xf * xf, axis=-1, keepdims=True) + RMS_EPS)
    return (y * w.astype(jnp.float32)).astype(x.dtype)


def l2norm(x):
    return x * lax.rsqrt(jnp.sum(x * x, axis=-1, keepdims=True) + RMS_EPS)


def causal_depthwise_conv(x, w):
    taps, seq = w.shape[0], x.shape[1]
    xp = jnp.pad(x, ((0, 0), (taps - 1, 0), (0, 0)))
    return sum(xp[:, j:j + seq] * w[j] for j in range(taps))


def token_shift(z, mu):
    z_prev = jnp.pad(z, ((0, 0), (1, 0), (0, 0)))[:, :-1]
    return z + mu * (z_prev - z)


def rglru_branch(u, gate, conv_w, conv_b, w_a, b_a, w_x, b_x, lam):
    bsz, seq, _ = u.shape
    f32 = jnp.float32
    xc = causal_depthwise_conv(u, conv_w) + conv_b
    xh = xc.reshape(bsz, seq, LRU_BLOCKS, LRU_BLOCK_DIM)
    r = jax.nn.sigmoid(jnp.einsum('btni,nij->btnj', xh, w_a).reshape(bsz, seq, LRU_WIDTH) + b_a)
    i = jax.nn.sigmoid(jnp.einsum('btni,nij->btnj', xh, w_x).reshape(bsz, seq, LRU_WIDTH) + b_x)
    log_a = (-LRU_C * r.astype(f32)) * jax.nn.softplus(-lam.astype(f32))
    a = jnp.exp(log_a)
    b = jnp.sqrt(-jnp.expm1(2.0 * log_a)) * (i * xc).astype(f32)

    def combine(left, right):
        a_l, b_l = left
        a_r, b_r = right
        return a_l * a_r, a_r * b_l + b_r

    _, h = lax.associative_scan(combine, (a, b), axis=1)
    return h.astype(u.dtype) * jax.nn.gelu(gate)


def chunked_gated_delta_rule(q, k, v, beta, g):
    bsz, seq, heads, dk = q.shape
    dv = v.shape[-1]
    c = GDN_CHUNK
    n = seq // c

    def to_chunks(t):
        t = t.reshape((bsz, n, c, heads) + t.shape[3:])
        return jnp.moveaxis(t, 3, 1)

    q, k, v, beta, g = (to_chunks(t) for t in (q, k, v, beta, g))
    g = jnp.cumsum(g, axis=-1)
    incl = jnp.tril(jnp.ones((c, c), dtype=bool))
    strict = jnp.tril(jnp.ones((c, c), dtype=bool), -1)
    decay = jnp.exp(jnp.where(incl, g[..., :, None] - g[..., None, :], -jnp.inf))
    k_beta = k * beta[..., None]
    a_mat = jnp.where(strict, jnp.einsum('bhnik,bhnjk->bhnij', k_beta, k) * decay, 0.0)
    lower = a_mat + jnp.eye(c, dtype=a_mat.dtype)
    rhs = jnp.concatenate([v * beta[..., None], k_beta * jnp.exp(g)[..., None]], axis=-1)
    sol = lax.linalg.triangular_solve(lower, rhs, left_side=True, lower=True, unit_diagonal=True)
    u_c, w_c = sol[..., :dv], sol[..., dv:]
    qk = jnp.einsum('bhnik,bhnjk->bhnij', q, k) * decay
    q_dec = q * jnp.exp(g)[..., None]
    k_dec = k * jnp.exp(g[..., -1:] - g)[..., None]
    g_tot = jnp.exp(g[..., -1])

    def step(state, inp):
        qk_n, qd_n, kd_n, u_n, w_n, gt_n = inp
        v_new = u_n - jnp.einsum('bhck,bhkv->bhcv', w_n, state)
        o = jnp.einsum('bhck,bhkv->bhcv', qd_n, state) + jnp.einsum('bhcs,bhsv->bhcv', qk_n, v_new)
        state = state * gt_n[..., None, None] + jnp.einsum('bhck,bhcv->bhkv', kd_n, v_new)
        return state, o

    xs = tuple(jnp.moveaxis(t, 2, 0) for t in (qk, q_dec, k_dec, u_c, w_c, g_tot))
    s0 = jnp.zeros((bsz, heads, dk, dv), q.dtype)
    _, o = lax.scan(step, s0, xs)
    return jnp.transpose(o, (1, 0, 3, 2, 4)).reshape(bsz, seq, heads, dv)


def gdn_branch(qkv, z, alpha, beta_pre, conv_w, a_log, dt_bias, norm_w):
    bsz, seq, _ = qkv.shape
    f32 = jnp.float32
    qkv = jax.nn.silu(causal_depthwise_conv(qkv, conv_w)).astype(f32)
    q, k, v = jnp.split(qkv, (GDN_QK_WIDTH, 2 * GDN_QK_WIDTH), axis=-1)
    q = l2norm(q.reshape(bsz, seq, GDN_HEADS, GDN_DK)) * (GDN_DK ** -0.5)
    k = l2norm(k.reshape(bsz, seq, GDN_HEADS, GDN_DK))
    v = v.reshape(bsz, seq, GDN_HEADS, GDN_DV)
    beta = jax.nn.sigmoid(beta_pre.astype(f32))
    g = -jnp.exp(a_log.astype(f32)) * jax.nn.softplus(alpha.astype(f32) + dt_bias.astype(f32))
    o = chunked_gated_delta_rule(q, k, v, beta, g)
    o = o * lax.rsqrt(jnp.mean(o * o, axis=-1, keepdims=True) + RMS_EPS) * norm_w.astype(f32)
    o = o * jax.nn.silu(z.astype(f32).reshape(bsz, seq, GDN_HEADS, GDN_DV))
    return o.reshape(bsz, seq, GDN_V_WIDTH).astype(z.dtype)


def rwkv7_branch(z_rw, mu, w0, w_up, a0, a_up, g_up, k_k, k_a, r_k, lnx_w, lnx_b):
    bsz, seq, _ = z_rw.shape
    f32 = jnp.float32
    zs = token_shift(z_rw, mu)
    r, k, v, wl, al, gl = jnp.split(zs, RWKV_OFFSETS, axis=-1)
    w_log = -jax.nn.softplus(-(w0 + jnp.tanh(wl) @ w_up)) - 0.5
    decay = jnp.exp(-jnp.exp(w_log.astype(f32)))
    a = jax.nn.sigmoid(a0 + al @ a_up)
    gate = jax.nn.sigmoid(gl) @ g_up
    heads = lambda t: t.astype(f32).reshape(bsz, seq, RWKV_HEADS, RWKV_HD)
    kk = l2norm(heads(k * k_k))
    k = k * (1.0 + (a - 1.0) * k_a)
    r_h, k_h, v_h, a_h, w_h = heads(r), heads(k), heads(v), heads(a), heads(decay)

    def step(state, inp):
        r_t, w_t, k_t, v_t, kk_t, kka_t = inp
        s_kk = jnp.einsum('bhvk,bhk->bhv', state, kk_t)
        state = state * w_t[:, :, None, :] - s_kk[..., None] * kka_t[:, :, None, :] + v_t[..., None] * k_t[:, :, None, :]
        return state, jnp.einsum('bhvk,bhk->bhv', state, r_t)

    xs = tuple(jnp.swapaxes(t, 0, 1) for t in (r_h, w_h, k_h, v_h, kk, kk * a_h))
    s0 = jnp.zeros((bsz, RWKV_HEADS, RWKV_HD, RWKV_HD), f32)
    _, o = lax.scan(step, s0, xs)
    o = jnp.swapaxes(o, 0, 1)
    mean = jnp.mean(o, axis=-1, keepdims=True)
    var = jnp.mean(jnp.square(o - mean), axis=-1, keepdims=True)
    o = ((o - mean) * lax.rsqrt(var + RWKV_GN_EPS)).reshape(bsz, seq, RWKV_WIDTH)
    o = o * lnx_w.astype(f32) + lnx_b.astype(f32)
    bonus = jnp.sum(r_h * k_h * r_k.astype(f32), axis=-1, keepdims=True) * v_h
    o = (o + bonus.reshape(bsz, seq, RWKV_WIDTH)) * gate.astype(f32)
    return o.astype(z_rw.dtype)


def hybrid_mixer(xn, w_in, lru_conv_w, lru_conv_b, lru_w_a, lru_b_a, lru_w_x, lru_b_x, lru_lambda,
                 gdn_conv_w, gdn_a_log, gdn_dt_bias, gdn_norm_w,
                 rwkv_mu, rwkv_w0, rwkv_w_up, rwkv_a0, rwkv_a_up, rwkv_g_up, rwkv_k_k, rwkv_k_a,
                 rwkv_r_k, rwkv_lnx_w, rwkv_lnx_b, merge_b, p_lru, p_gdn, p_rwkv, w_out):
    z = xn @ w_in
    u_lru, g_lru, qkv, z_gdn, alpha, beta_pre, z_rw, z_merge = jnp.split(z, IN_OFFSETS, axis=-1)
    y_a = rglru_branch(u_lru, g_lru, lru_conv_w, lru_conv_b, lru_w_a, lru_b_a, lru_w_x, lru_b_x, lru_lambda)
    y_b = gdn_branch(qkv, z_gdn, alpha, beta_pre, gdn_conv_w, gdn_a_log, gdn_dt_bias, gdn_norm_w)
    y_c = rwkv7_branch(z_rw, rwkv_mu, rwkv_w0, rwkv_w_up, rwkv_a0, rwkv_a_up, rwkv_g_up, rwkv_k_k,
                       rwkv_k_a, rwkv_r_k, rwkv_lnx_w, rwkv_lnx_b)
    g_a, g_b, g_c = jnp.split(jax.nn.sigmoid(z_merge + merge_b), N_BRANCH, axis=-1)
    merged = g_a * (y_a @ p_lru) + g_b * (y_b @ p_gdn) + g_c * (y_c @ p_rwkv)
    return merged @ w_out


def peer_ffn(xn, w_query, sub_keys, expert_u, expert_v):
    bsz, seq, dim = xn.shape
    q = (xn @ w_query).reshape(bsz, seq, PEER_HEADS, 2, PEER_HALF)
    s = jnp.einsum('bthsc,hsnc->bthsn', q, sub_keys).astype(jnp.float32)
    top_s, top_i = lax.top_k(s, PEER_TOPK)
    cand_s = (top_s[..., 0, :, None] + top_s[..., 1, None, :]).reshape(bsz, seq, PEER_HEADS, PEER_TOPK * PEER_TOPK)
    cand_i = (top_i[..., 0, :, None] * PEER_NKEYS + top_i[..., 1, None, :]).reshape(bsz, seq, PEER_HEADS, PEER_TOPK * PEER_TOPK)
    best_s, best_pos = lax.top_k(cand_s, PEER_TOPK)
    expert_idx = jnp.take_along_axis(cand_i, best_pos, axis=-1)
    gate = jax.nn.softmax(best_s, axis=-1)
    n_blocks = (bsz * seq) // PEER_BLOCK
    x_blk = xn.reshape(n_blocks, PEER_BLOCK, dim)
    i_blk = expert_idx.reshape(n_blocks, PEER_BLOCK, PEER_HEADS * PEER_TOPK)
    g_blk = gate.reshape(n_blocks, PEER_BLOCK, PEER_HEADS * PEER_TOPK)

    def block(args):
        xb, ib, gb = args
        u = jnp.take(expert_u, ib, axis=0)
        act = gb.astype(xb.dtype) * jax.nn.gelu(jnp.einsum('pkd,pd->pk', u, xb))
        vv = jnp.take(expert_v, ib, axis=0)
        return jnp.einsum('pk,pkd->pd', act, vv)

    y = lax.map(block, (x_blk, i_blk, g_blk))
    return y.reshape(bsz, seq, dim)


def setup_inputs(seed: int = 0) -> dict:
    key = jax.random.key(seed)
    ks = iter(jax.random.split(key, 48))
    f32 = jnp.float32
    L = DEPTH

    def normal(shape, scale):
        return scale * jax.random.normal(next(ks), shape, f32)

    def uniform(shape, lo, hi):
        return jax.random.uniform(next(ks), shape, f32, lo, hi)

    x = normal((BATCH, SEQ, D_MODEL), 1.0)
    norm_mix_w = 1.0 + normal((L, D_MODEL), 0.02)
    norm_ffn_w = 1.0 + normal((L, D_MODEL), 0.02)
    final_norm_w = 1.0 + normal((D_MODEL,), 0.02)
    w_in = normal((L, D_MODEL, IN_WIDTH), D_MODEL ** -0.5)
    lru_conv_w = normal((L, CONV_WIDTH, LRU_WIDTH), CONV_WIDTH ** -0.5)
    lru_conv_b = normal((L, LRU_WIDTH), 0.02)
    lru_w_a = normal((L, LRU_BLOCKS, LRU_BLOCK_DIM, LRU_BLOCK_DIM), LRU_BLOCK_DIM ** -0.5)
    lru_b_a = normal((L, LRU_WIDTH), 0.02)
    lru_w_x = normal((L, LRU_BLOCKS, LRU_BLOCK_DIM, LRU_BLOCK_DIM), LRU_BLOCK_DIM ** -0.5)
    lru_b_x = normal((L, LRU_WIDTH), 0.02)
    a_pow = uniform((L, LRU_WIDTH), 0.9, 0.999) ** (1.0 / LRU_C)
    lru_lambda = jnp.log(a_pow) - jnp.log1p(-a_pow)
    gdn_conv_w = normal((L, CONV_WIDTH, 2 * GDN_QK_WIDTH + GDN_V_WIDTH), CONV_WIDTH ** -0.5)
    gdn_a_log = jnp.log(uniform((L, GDN_HEADS), 1.0, 16.0))
    dt = jnp.exp(uniform((L, GDN_HEADS), math.log(1e-3), math.log(1e-1)))
    gdn_dt_bias = dt + jnp.log(-jnp.expm1(-dt))
    gdn_norm_w = 1.0 + normal((L, GDN_DV), 0.02)
    rwkv_mu = uniform((L, RWKV_IN_WIDTH), 0.0, 1.0)
    rwkv_w0 = uniform((L, RWKV_WIDTH), -6.5, -1.5)
    rwkv_w_up = normal((L, RWKV_DECAY_RANK, RWKV_WIDTH), 0.5 * RWKV_DECAY_RANK ** -0.5)
    rwkv_a0 = normal((L, RWKV_WIDTH), 0.1)
    rwkv_a_up = normal((L, RWKV_ICLR_RANK, RWKV_WIDTH), 0.5 * RWKV_ICLR_RANK ** -0.5)
    rwkv_g_up = normal((L, RWKV_GATE_RANK, RWKV_WIDTH), RWKV_GATE_RANK ** -0.5)
    rwkv_k_k = 0.85 + normal((L, RWKV_WIDTH), 0.02)
    rwkv_k_a = 1.0 + normal((L, RWKV_WIDTH), 0.02)
    rwkv_r_k = normal((L, RWKV_HEADS, RWKV_HD), 0.1)
    rwkv_lnx_w = 1.0 + normal((L, RWKV_WIDTH), 0.02)
    rwkv_lnx_b = normal((L, RWKV_WIDTH), 0.02)
    merge_b = normal((L, N_BRANCH * D_MODEL), 0.02)
    p_lru = normal((L, LRU_WIDTH, D_MODEL), LRU_WIDTH ** -0.5)
    p_gdn = normal((L, GDN_V_WIDTH, D_MODEL), GDN_V_WIDTH ** -0.5)
    p_rwkv = normal((L, RWKV_WIDTH, D_MODEL), RWKV_WIDTH ** -0.5)
    w_out = normal((L, D_MODEL, D_MODEL), D_MODEL ** -0.5)
    peer_wq = normal((L, D_MODEL, PEER_HEADS * PEER_DKEY), D_MODEL ** -0.5)
    peer_keys = normal((L, PEER_HEADS, 2, PEER_NKEYS, PEER_HALF), PEER_HALF ** -0.5)
    peer_u = normal((L, PEER_EXPERTS, D_MODEL), D_MODEL ** -0.5)
    peer_v = normal((L, PEER_EXPERTS, D_MODEL), PEER_TOPK ** -0.5)
    return {'x': x, 'norm_mix_w': norm_mix_w, 'norm_ffn_w': norm_ffn_w, 'final_norm_w': final_norm_w,
            'w_in': w_in, 'lru_conv_w': lru_conv_w, 'lru_conv_b': lru_conv_b, 'lru_w_a': lru_w_a,
            'lru_b_a': lru_b_a, 'lru_w_x': lru_w_x, 'lru_b_x': lru_b_x, 'lru_lambda': lru_lambda,
            'gdn_conv_w': gdn_conv_w, 'gdn_a_log': gdn_a_log, 'gdn_dt_bias': gdn_dt_bias,
            'gdn_norm_w': gdn_norm_w, 'rwkv_mu': rwkv_mu, 'rwkv_w0': rwkv_w0, 'rwkv_w_up': rwkv_w_up,
            'rwkv_a0': rwkv_a0, 'rwkv_a_up': rwkv_a_up, 'rwkv_g_up': rwkv_g_up, 'rwkv_k_k': rwkv_k_k,
            'rwkv_k_a': rwkv_k_a, 'rwkv_r_k': rwkv_r_k, 'rwkv_lnx_w': rwkv_lnx_w, 'rwkv_lnx_b': rwkv_lnx_b,
            'merge_b': merge_b, 'p_lru': p_lru, 'p_gdn': p_gdn, 'p_rwkv': p_rwkv, 'w_out': w_out,
            'peer_wq': peer_wq, 'peer_keys': peer_keys, 'peer_u': peer_u, 'peer_v': peer_v}


def reference(x, norm_mix_w, norm_ffn_w, final_norm_w, w_in, lru_conv_w, lru_conv_b, lru_w_a,
              lru_b_a, lru_w_x, lru_b_x, lru_lambda, gdn_conv_w, gdn_a_log, gdn_dt_bias, gdn_norm_w,
              rwkv_mu, rwkv_w0, rwkv_w_up, rwkv_a0, rwkv_a_up, rwkv_g_up, rwkv_k_k, rwkv_k_a,
              rwkv_r_k, rwkv_lnx_w, rwkv_lnx_b, merge_b, p_lru, p_gdn, p_rwkv, w_out,
              peer_wq, peer_keys, peer_u, peer_v):
    h = x
    for l in range(DEPTH):
        xn = rmsnorm(h, norm_mix_w[l])
        h = h + hybrid_mixer(xn, w_in[l], lru_conv_w[l], lru_conv_b[l], lru_w_a[l], lru_b_a[l],
                             lru_w_x[l], lru_b_x[l], lru_lambda[l], gdn_conv_w[l], gdn_a_log[l],
                             gdn_dt_bias[l], gdn_norm_w[l], rwkv_mu[l], rwkv_w0[l], rwkv_w_up[l],
                             rwkv_a0[l], rwkv_a_up[l], rwkv_g_up[l], rwkv_k_k[l], rwkv_k_a[l],
                             rwkv_r_k[l], rwkv_lnx_w[l], rwkv_lnx_b[l], merge_b[l], p_lru[l],
                             p_gdn[l], p_rwkv[l], w_out[l])
        xn = rmsnorm(h, norm_ffn_w[l])
        h = h + peer_ffn(xn, peer_wq[l], peer_keys[l], peer_u[l], peer_v[l])
    return rmsnorm(h, final_norm_w)
```

```cpp
#ifndef CPU_EMU
#include <hip/hip_runtime.h>
#include <cstdio>
#include <cstdint>
#define DYN_SMEM(name) extern __shared__ __attribute__((aligned(16))) char name[]
#define LAUNCH(kern, grid, block, smem, stream, ...) hipLaunchKernelGGL(kern, dim3(grid), dim3(block), smem, stream, __VA_ARGS__)
#endif

#ifndef CFG_B
#define CFG_B 8
#endif
#ifndef CFG_T
#define CFG_T 2048
#endif

namespace {
constexpr int B_ = CFG_B, T_ = CFG_T, M_ = B_ * T_, D_ = 1024, NL_ = 2;
constexpr int INW = 12560, ZW = 9488;
constexpr int Z_ULRU = 0, Z_GLRU = 1024, Z_Q = 2048, Z_K = 3072, Z_V = 4096, Z_ZG = 5120, Z_ALPHA = 6144, Z_BETA = 6152, Z_RW = 6160;
constexpr int RW_R = 0, RW_K = 1024, RW_V = 2048, RW_WL = 3072, RW_AL = 3136, RW_GL = 3200, RWW = 3328;
constexpr float RMS_EPS = 1e-6f, GN_EPS = 64e-5f;
typedef unsigned short bf16_t;

enum { I_X = 0, I_NMIX, I_NFFN, I_NFINAL, I_WIN, I_LCW, I_LCB, I_LWA, I_LBA, I_LWX, I_LBX, I_LLAM, I_GCW, I_GALOG, I_GDT, I_GNW,
       I_RMU, I_RW0, I_RWUP, I_RA0, I_RAUP, I_RGUP, I_RKK, I_RKA, I_RRK, I_RLW, I_RLB, I_MB, I_PL, I_PG, I_PR, I_WOUT, I_PWQ, I_PKEYS, I_PU, I_PV, N_IN };

struct Params {
    const float* in[N_IN];
    float* out;
    char* ws;
};

constexpr size_t al256(size_t x) { return (x + 255) / 256 * 256; }
constexpr size_t OFF_Z = 0;
constexpr size_t OFF_YC = al256(OFF_Z + (size_t)M_ * ZW * 2);
constexpr size_t OFF_XN = al256(OFF_YC + (size_t)M_ * 1024 * 2);
constexpr size_t OFF_G = al256(OFF_XN + (size_t)M_ * 1024 * 2);
constexpr size_t OFF_MG = al256(OFF_G + (size_t)M_ * 3072 * 2);
constexpr size_t WS_END = al256(OFF_MG + (size_t)M_ * 1024 * 2);
constexpr size_t OFF_Q = 0;
constexpr size_t OFF_IDX = al256(OFF_Q + (size_t)M_ * 2048 * 4);
constexpr size_t OFF_GT = al256(OFF_IDX + (size_t)M_ * 128 * 4);
static_assert(OFF_GT + (size_t)M_ * 128 * 4 <= OFF_YC, "peer overlay");

__device__ __forceinline__ bf16_t f2bf(float f) { unsigned u = __float_as_uint(f); u += 0x7fffu + ((u >> 16) & 1u); return (bf16_t)(u >> 16); }
__device__ __forceinline__ float bf2f(bf16_t h) { return __uint_as_float(((unsigned)h) << 16); }
__device__ __forceinline__ float sigmoidf_(float x) { return 1.0f / (1.0f + expf(-x)); }
__device__ __forceinline__ float softplusf_(float x) { return fmaxf(x, 0.0f) + log1pf(expf(-fabsf(x))); }
__device__ __forceinline__ float siluf_(float x) { return x * sigmoidf_(x); }
__device__ __forceinline__ float geluf_(float x) { return 0.5f * x * (1.0f + tanhf(0.7978845608028654f * (x + 0.044715f * x * x * x))); }

__device__ __forceinline__ float block_sum256(float v, float* red) {
    const int tid = threadIdx.x;
    red[tid] = v;
    __syncthreads();
    if (tid < 16) { float s = 0.f; for (int i = 0; i < 16; ++i) s += red[tid * 16 + i]; red[256 + tid] = s; }
    __syncthreads();
    float tot = 0.f;
    for (int i = 0; i < 16; ++i) tot += red[256 + i];
    __syncthreads();
    return tot;
}

template <bool OUT_F32>
__device__ void stage_rmsnorm(const float* src, const float* w, void* dst, char* smem) {
    float* red = (float*)smem;
    const int tid = threadIdx.x;
    for (int row = blockIdx.x; row < M_; row += gridDim.x) {
        const float4 v = *(const float4*)(src + (size_t)row * D_ + tid * 4);
        const float ss = block_sum256(v.x * v.x + v.y * v.y + v.z * v.z + v.w * v.w, red);
        const float rstd = rsqrtf(ss * (1.0f / D_) + RMS_EPS);
        const float4 wv = *(const float4*)(w + tid * 4);
        const float o0 = v.x * rstd * wv.x, o1 = v.y * rstd * wv.y, o2 = v.z * rstd * wv.z, o3 = v.w * rstd * wv.w;
        if (OUT_F32) {
            *(float4*)((float*)dst + (size_t)row * D_ + tid * 4) = make_float4(o0, o1, o2, o3);
        } else {
            bf16_t* d = (bf16_t*)dst + (size_t)row * D_ + tid * 4;
            d[0] = f2bf(o0); d[1] = f2bf(o1); d[2] = f2bf(o2); d[3] = f2bf(o3);
        }
    }
}

enum { EPI_BF16 = 0, EPI_SIGB_BF16 = 1, EPI_RESID = 3, EPI_F32 = 4 };
struct GemmArgs {
    const bf16_t* A; int lda;
    const float* Bw; int ldb;
    int N;
    void* C; int ldc;
    const float* bias;
    const float* resid;
};
__device__ __forceinline__ void gemm_tile_acc(const bf16_t* A, int lda, const float* Bw, int ldb, int N, int m0, int n0, float (&acc)[4][4], float* As, float* Bs) {
    const int tid = threadIdx.x, tx = tid & 15, ty = tid >> 4;
    for (int k0 = 0; k0 < 1024; k0 += 16) {
        {
            const int r = tid >> 2, kq = (tid & 3) * 4;
            const bf16_t* ap = A + (size_t)(m0 + r) * lda + k0 + kq;
            As[(kq + 0) * 65 + r] = bf2f(ap[0]); As[(kq + 1) * 65 + r] = bf2f(ap[1]); As[(kq + 2) * 65 + r] = bf2f(ap[2]); As[(kq + 3) * 65 + r] = bf2f(ap[3]);
            const int kk = tid >> 4, nq = (tid & 15) * 4;
            const float* bp = Bw + (size_t)(k0 + kk) * ldb + n0 + nq;
#pragma unroll
            for (int j = 0; j < 4; ++j) Bs[kk * 64 + nq + j] = (n0 + nq + j < N) ? bp[j] : 0.f;
        }
        __syncthreads();
#pragma unroll
        for (int kk = 0; kk < 16; ++kk) {
            float a[4], b[4];
#pragma unroll
            for (int i = 0; i < 4; ++i) a[i] = As[kk * 65 + ty * 4 + i];
#pragma unroll
            for (int j = 0; j < 4; ++j) b[j] = Bs[kk * 64 + tx * 4 + j];
#pragma unroll
            for (int i = 0; i < 4; ++i)
#pragma unroll
                for (int j = 0; j < 4; ++j) acc[i][j] += a[i] * b[j];
        }
        __syncthreads();
    }
}
template <int EPI>
__device__ void stage_gemm(const GemmArgs g, char* smem) {
    float* As = (float*)smem; float* Bs = As + 16 * 65;
    const int tid = threadIdx.x, tx = tid & 15, ty = tid >> 4;
    const int nM = M_ / 64, nN = (g.N + 63) / 64;
    for (int tile = blockIdx.x; tile < nM * nN; tile += gridDim.x) {
        const int m0 = (tile % nM) * 64, n0 = (tile / nM) * 64;
        float acc[4][4];
#pragma unroll
        for (int i = 0; i < 4; ++i)
#pragma unroll
            for (int j = 0; j < 4; ++j) acc[i][j] = 0.f;
        gemm_tile_acc(g.A, g.lda, g.Bw, g.ldb, g.N, m0, n0, acc, As, Bs);
#pragma unroll
        for (int i = 0; i < 4; ++i)
#pragma unroll
            for (int j = 0; j < 4; ++j) {
                const int m = m0 + ty * 4 + i, n = n0 + tx * 4 + j;
                if (n < g.N) {
                    const size_t o = (size_t)m * g.ldc + n;
                    if (EPI == EPI_BF16) ((bf16_t*)g.C)[o] = f2bf(acc[i][j]);
                    else if (EPI == EPI_SIGB_BF16) ((bf16_t*)g.C)[o] = f2bf(sigmoidf_(acc[i][j] + g.bias[n]));
                    else if (EPI == EPI_RESID) ((float*)g.C)[o] = g.resid[o] + acc[i][j];
                    else ((float*)g.C)[o] = acc[i][j];
                }
            }
    }
}
__device__ void stage_merge(const Params p, int l, char* smem) {
    float* As = (float*)smem; float* Bs = As + 16 * 65;
    const int tid = threadIdx.x, tx = tid & 15, ty = tid >> 4;
    const bf16_t* Z = (const bf16_t*)(p.ws + OFF_Z);
    const bf16_t* YC = (const bf16_t*)(p.ws + OFF_YC);
    const bf16_t* G = (const bf16_t*)(p.ws + OFF_G);
    bf16_t* MG = (bf16_t*)(p.ws + OFF_MG);
    const int nM = M_ / 64, nN = 1024 / 64;
    for (int tile = blockIdx.x; tile < nM * nN; tile += gridDim.x) {
        const int m0 = (tile % nM) * 64, n0 = (tile / nM) * 64;
        float tot[4][4];
#pragma unroll
        for (int i = 0; i < 4; ++i)
#pragma unroll
            for (int j = 0; j < 4; ++j) tot[i][j] = 0.f;
        for (int br = 0; br < 3; ++br) {
            const bf16_t* A = br == 0 ? Z + Z_GLRU : (br == 1 ? Z + Z_ZG : YC);
            const int lda = br == 2 ? 1024 : ZW;
            const float* Bw = p.in[br == 0 ? I_PL : (br == 1 ? I_PG : I_PR)] + (size_t)l * 1024 * 1024;
            float acc[4][4];
#pragma unroll
            for (int i = 0; i < 4; ++i)
#pragma unroll
                for (int j = 0; j < 4; ++j) acc[i][j] = 0.f;
            gemm_tile_acc(A, lda, Bw, 1024, 1024, m0, n0, acc, As, Bs);
#pragma unroll
            for (int i = 0; i < 4; ++i)
#pragma unroll
                for (int j = 0; j < 4; ++j) {
                    const int m = m0 + ty * 4 + i, n = n0 + tx * 4 + j;
                    tot[i][j] += bf2f(G[(size_t)m * 3072 + br * 1024 + n]) * acc[i][j];
                }
        }
#pragma unroll
        for (int i = 0; i < 4; ++i)
#pragma unroll
            for (int j = 0; j < 4; ++j) MG[(size_t)(m0 + ty * 4 + i) * 1024 + n0 + tx * 4 + j] = f2bf(tot[i][j]);
    }
}

__device__ void stage_lru(const Params p, int l, char* smem) {
    float* xc_s = (float*)smem; float* gi_s = xc_s + 64; float* wa_s = gi_s + 64; float* wx_s = wa_s + 4096;
    bf16_t* Z = (bf16_t*)(p.ws + OFF_Z);
    const int tid = threadIdx.x, j = tid & 63, q = tid >> 6;
    for (int item = blockIdx.x; item < B_ * 16; item += gridDim.x) {
        const int b = item / 16, n = item % 16, c = n * 64 + j;
        __syncthreads();
        for (int i = tid; i < 4096; i += 256) { wa_s[i] = p.in[I_LWA][((size_t)l * 16 + n) * 4096 + i]; wx_s[i] = p.in[I_LWX][((size_t)l * 16 + n) * 4096 + i]; }
        float cw0 = p.in[I_LCW][((size_t)l * 4 + 0) * 1024 + c], cw1 = p.in[I_LCW][((size_t)l * 4 + 1) * 1024 + c];
        float cw2 = p.in[I_LCW][((size_t)l * 4 + 2) * 1024 + c], cw3 = p.in[I_LCW][((size_t)l * 4 + 3) * 1024 + c];
        const float cb = p.in[I_LCB][l * 1024 + c];
        const float bias = q == 0 ? p.in[I_LBA][l * 1024 + c] : p.in[I_LBX][l * 1024 + c];
        const float sp = softplusf_(-p.in[I_LLAM][l * 1024 + c]);
        const float* wsel = q == 0 ? wa_s : wx_s;
        float u1 = 0.f, u2 = 0.f, u3 = 0.f, hst = 0.f, xc = 0.f;
        __syncthreads();
        for (int t = 0; t < T_; ++t) {
            const size_t m = (size_t)b * T_ + t;
            if (q == 0) {
                const float u0 = bf2f(Z[m * ZW + Z_ULRU + c]);
                xc = cw0 * u3 + cw1 * u2 + cw2 * u1 + cw3 * u0 + cb;
                u3 = u2; u2 = u1; u1 = u0;
                xc_s[j] = xc;
            }
            __syncthreads();
            float val = 0.f;
            if (q < 2) {
                float dot = 0.f;
#pragma unroll 8
                for (int i = 0; i < 64; ++i) dot += xc_s[i] * wsel[i * 64 + j];
                val = sigmoidf_(dot + bias);
                if (q == 1) gi_s[j] = val;
            }
            __syncthreads();
            if (q == 0) {
                const float r = val, ig = gi_s[j];
                const float log_a = -8.0f * r * sp;
                const float a = expf(log_a);
                const float bb = sqrtf(-expm1f(2.0f * log_a)) * (ig * xc);
                hst = a * hst + bb;
                const float g = bf2f(Z[m * ZW + Z_GLRU + c]);
                Z[m * ZW + Z_GLRU + c] = f2bf(hst * geluf_(g));
            }
        }
    }
}

__device__ void stage_gdn(const Params p, int l, char* smem) {
    float* qs = (float*)smem; float* ks = qs + 128; float* vs = ks + 128; float* part = vs + 128; float* part2 = part + 256; float* os = part2 + 256;
    bf16_t* Z = (bf16_t*)(p.ws + OFF_Z);
    const int tid = threadIdx.x, v = tid & 127, hf = tid >> 7;
    for (int item = blockIdx.x; item < B_ * 8; item += gridDim.x) {
        const int b = item / 8, h = item % 8;
        const int ch0 = hf == 0 ? (h * 128 + v) : (1024 + h * 128 + v);
        const int ch1 = 2048 + h * 128 + v;
        float c0w[4], c1w[4];
#pragma unroll
        for (int jj = 0; jj < 4; ++jj) { c0w[jj] = p.in[I_GCW][((size_t)l * 4 + jj) * 3072 + ch0]; c1w[jj] = p.in[I_GCW][((size_t)l * 4 + jj) * 3072 + ch1]; }
        const float a_exp = expf(p.in[I_GALOG][l * 8 + h]), dtb = p.in[I_GDT][l * 8 + h];
        const float nw = p.in[I_GNW][l * 128 + v];
        float S[64];
#pragma unroll
        for (int k = 0; k < 64; ++k) S[k] = 0.f;
        float a1 = 0.f, a2 = 0.f, a3 = 0.f, b1 = 0.f, b2 = 0.f, b3 = 0.f;
        __syncthreads();
        for (int t = 0; t < T_; ++t) {
            const size_t m = (size_t)b * T_ + t;
            {
                const float x0 = bf2f(Z[m * ZW + Z_Q + ch0]);
                const float cv = c0w[0] * a3 + c0w[1] * a2 + c0w[2] * a1 + c0w[3] * x0;
                a3 = a2; a2 = a1; a1 = x0;
                if (hf == 0) qs[v] = siluf_(cv); else ks[v] = siluf_(cv);
                if (hf == 0) {
                    const float y0 = bf2f(Z[m * ZW + Z_Q + ch1]);
                    const float cv1 = c1w[0] * b3 + c1w[1] * b2 + c1w[2] * b1 + c1w[3] * y0;
                    b3 = b2; b2 = b1; b1 = y0;
                    vs[v] = siluf_(cv1);
                }
            }
            __syncthreads();
            float sq = 0.f, sk = 0.f;
            for (int i = 0; i < 128; ++i) { sq += qs[i] * qs[i]; sk += ks[i] * ks[i]; }
            const float rq = rsqrtf(sq + RMS_EPS) * 0.08838834764831845f, rk = rsqrtf(sk + RMS_EPS);
            const float beta = sigmoidf_(bf2f(Z[m * ZW + Z_BETA + h]));
            const float gg = -a_exp * softplusf_(bf2f(Z[m * ZW + Z_ALPHA + h]) + dtb);
            const float eg = expf(gg);
            float pk = 0.f;
#pragma unroll
            for (int k = 0; k < 64; ++k) pk += S[k] * ks[hf * 64 + k];
            part[hf * 128 + v] = pk * rk;
            __syncthreads();
            const float kS = part[v] + part[128 + v];
            const float cc = beta * (vs[v] - eg * kS) * rk;
            float po = 0.f;
#pragma unroll
            for (int k = 0; k < 64; ++k) { S[k] = eg * S[k] + ks[hf * 64 + k] * cc; po += S[k] * qs[hf * 64 + k]; }
            part2[hf * 128 + v] = po * rq;
            __syncthreads();
            if (hf == 0) os[v] = part2[v] + part2[128 + v];
            __syncthreads();
            if (hf == 0) {
                float ms = 0.f;
                for (int i = 0; i < 128; ++i) ms += os[i] * os[i];
                const float o = os[v] * rsqrtf(ms * (1.0f / 128.0f) + RMS_EPS) * nw;
                const float zg = bf2f(Z[m * ZW + Z_ZG + h * 128 + v]);
                Z[m * ZW + Z_ZG + h * 128 + v] = f2bf(o * siluf_(zg));
            }
        }
    }
}

__device__ void stage_rwkv(const Params p, int l, char* smem) {
    float* zs_s = (float*)smem;
    float* lw = zs_s + 448;
    float* la = lw + 256;
    float* lg = la + 256;
    float* r_s = lg + 256; float* w_s = r_s + 64; float* k2_s = w_s + 64; float* a_s = k2_s + 64; float* gate_s = a_s + 64; float* v_s = gate_s + 64; float* kkr_s = v_s + 64;
    float* part = kkr_s + 64;
    float* part2 = part + 256;
    float* o_s = part2 + 256;
    const bf16_t* Z = (const bf16_t*)(p.ws + OFF_Z);
    bf16_t* YC = (bf16_t*)(p.ws + OFF_YC);
    const int tid = threadIdx.x;
    for (int item = blockIdx.x; item < B_ * 16; item += gridDim.x) {
        const int b = item / 16, h = item % 16;
        int col[2]; float mu[2]; float prev[2] = {0.f, 0.f};
        for (int s = 0; s < 2; ++s) {
            const int e = tid + s * 256;
            int cl = 0;
            if (e < 64) cl = RW_R + h * 64 + e; else if (e < 128) cl = RW_K + h * 64 + (e - 64); else if (e < 192) cl = RW_V + h * 64 + (e - 128);
            else if (e < 256) cl = RW_WL + (e - 192); else if (e < 320) cl = RW_AL + (e - 256); else if (e < 448) cl = RW_GL + (e - 320);
            col[s] = cl; mu[s] = (e < 448) ? p.in[I_RMU][(size_t)l * RWW + cl] : 0.f;
        }
        const int jc = tid & 63, pp = tid >> 6, c = h * 64 + jc;
        const int ri = tid >> 2, q4 = tid & 3;
        const float w0 = p.in[I_RW0][l * 1024 + c], a0 = p.in[I_RA0][l * 1024 + c], k_k = p.in[I_RKK][l * 1024 + c], k_a = p.in[I_RKA][l * 1024 + c];
        const float lnw = p.in[I_RLW][l * 1024 + h * 64 + ri], lnb = p.in[I_RLB][l * 1024 + h * 64 + ri];
        const float* wup = p.in[I_RWUP] + (size_t)l * 64 * 1024; const float* aup = p.in[I_RAUP] + (size_t)l * 64 * 1024; const float* gup = p.in[I_RGUP] + (size_t)l * 128 * 1024;
        const float* rk = p.in[I_RRK] + (size_t)l * 1024 + h * 64;
        float S[16];
#pragma unroll
        for (int e = 0; e < 16; ++e) S[e] = 0.f;
        __syncthreads();
        for (int t = 0; t < T_; ++t) {
            const size_t m = (size_t)b * T_ + t;
            for (int s = 0; s < 2; ++s) {
                const int e = tid + s * 256;
                if (e < 448) {
                    const float zc = bf2f(Z[m * ZW + Z_RW + col[s]]);
                    float zs = zc + mu[s] * (prev[s] - zc);
                    prev[s] = zc;
                    if (e >= 192 && e < 256) zs = tanhf(zs); else if (e >= 320) zs = sigmoidf_(zs);
                    zs_s[e] = zs;
                }
            }
            __syncthreads();
            {
                float dw = 0.f, da = 0.f, dg = 0.f;
                for (int i = pp * 16; i < pp * 16 + 16; ++i) { dw += zs_s[192 + i] * wup[(size_t)i * 1024 + c]; da += zs_s[256 + i] * aup[(size_t)i * 1024 + c]; }
                for (int i = pp * 32; i < pp * 32 + 32; ++i) dg += zs_s[320 + i] * gup[(size_t)i * 1024 + c];
                lw[pp * 64 + jc] = dw; la[pp * 64 + jc] = da; lg[pp * 64 + jc] = dg;
            }
            __syncthreads();
            if (tid < 64) {
                const float wd = lw[jc] + lw[64 + jc] + lw[128 + jc] + lw[192 + jc];
                const float ad = la[jc] + la[64 + jc] + la[128 + jc] + la[192 + jc];
                const float gd = lg[jc] + lg[64 + jc] + lg[128 + jc] + lg[192 + jc];
                const float w_log = -softplusf_(-(w0 + wd)) - 0.5f;
                const float decay = expf(-expf(w_log));
                const float a = sigmoidf_(a0 + ad);
                const float kx = zs_s[64 + jc];
                r_s[jc] = zs_s[jc]; w_s[jc] = decay; a_s[jc] = a; gate_s[jc] = gd; v_s[jc] = zs_s[128 + jc];
                kkr_s[jc] = kx * k_k; k2_s[jc] = kx * (1.0f + (a - 1.0f) * k_a);
            }
            __syncthreads();
            float nsq = 0.f, bon = 0.f;
            for (int i = 0; i < 64; ++i) { nsq += kkr_s[i] * kkr_s[i]; bon += r_s[i] * k2_s[i] * rk[i]; }
            const float nrm = rsqrtf(nsq + RMS_EPS);
            float pk = 0.f;
#pragma unroll
            for (int e = 0; e < 16; ++e) pk += S[e] * (kkr_s[q4 * 16 + e] * nrm);
            part[ri * 4 + q4] = pk;
            __syncthreads();
            const float skk = part[ri * 4] + part[ri * 4 + 1] + part[ri * 4 + 2] + part[ri * 4 + 3];
            const float vi = v_s[ri];
            float po = 0.f;
#pragma unroll
            for (int e = 0; e < 16; ++e) {
                const int jj = q4 * 16 + e;
                const float kkj = kkr_s[jj] * nrm;
                S[e] = S[e] * w_s[jj] - skk * (kkj * a_s[jj]) + vi * k2_s[jj];
                po += S[e] * r_s[jj];
            }
            part2[ri * 4 + q4] = po;
            __syncthreads();
            if (q4 == 0) o_s[ri] = part2[ri * 4] + part2[ri * 4 + 1] + part2[ri * 4 + 2] + part2[ri * 4 + 3];
            __syncthreads();
            if (q4 == 0) {
                float mean = 0.f;
                for (int i = 0; i < 64; ++i) mean += o_s[i];
                mean *= (1.0f / 64.0f);
                float var = 0.f;
                for (int i = 0; i < 64; ++i) { const float d = o_s[i] - mean; var += d * d; }
                var *= (1.0f / 64.0f);
                const float o = (o_s[ri] - mean) * rsqrtf(var + GN_EPS) * lnw + lnb;
                YC[m * 1024 + h * 64 + ri] = f2bf((o + bon * vi) * gate_s[ri]);
            }
        }
    }
}

__device__ void stage_peer_topk(const Params p, int l, char* smem) {
    float* q_s = (float*)smem; float* sc = q_s + 256; float* top_s = sc + 256; int* top_i = (int*)(top_s + 32); float* cand = (float*)(top_i + 32);
    float* best_s = cand + 256; int* best_e = (int*)(best_s + 16);
    const float* Q = (const float*)(p.ws + OFF_Q);
    int* IDX = (int*)(p.ws + OFF_IDX); float* GT = (float*)(p.ws + OFF_GT);
    const int tid = threadIdx.x, s = tid >> 7, n = tid & 127;
    for (int item = blockIdx.x; item < M_ * 8; item += gridDim.x) {
        const int m = item >> 3, hd = item & 7;
        __syncthreads();
        q_s[tid] = Q[(size_t)m * 2048 + hd * 256 + tid];
        __syncthreads();
        const float* key = p.in[I_PKEYS] + ((((size_t)l * 8 + hd) * 2 + s) * 128 + n) * 128;
        float dot = 0.f;
        for (int cix = 0; cix < 128; ++cix) dot += q_s[s * 128 + cix] * key[cix];
        sc[tid] = dot;
        __syncthreads();
        int cnt = 0;
        for (int jj = 0; jj < 128; ++jj) { const float o = sc[s * 128 + jj]; cnt += (o > dot || (o == dot && jj < n)) ? 1 : 0; }
        if (cnt < 16) { top_s[s * 16 + cnt] = dot; top_i[s * 16 + cnt] = n; }
        __syncthreads();
        const int ci = tid >> 4, cj = tid & 15;
        const float cs = top_s[ci] + top_s[16 + cj];
        cand[tid] = cs;
        __syncthreads();
        int cnt2 = 0;
        for (int jj = 0; jj < 256; ++jj) { const float o = cand[jj]; cnt2 += (o > cs || (o == cs && jj < tid)) ? 1 : 0; }
        if (cnt2 < 16) { best_s[cnt2] = cs; best_e[cnt2] = top_i[ci] * 128 + top_i[16 + cj]; }
        __syncthreads();
        if (tid < 16) {
            const float mx = best_s[0];
            float sum = 0.f;
            for (int i = 0; i < 16; ++i) sum += expf(best_s[i] - mx);
            IDX[(size_t)m * 128 + hd * 16 + tid] = best_e[tid];
            GT[(size_t)m * 128 + hd * 16 + tid] = expf(best_s[tid] - mx) / sum;
        }
    }
}

__device__ void stage_peer_gather(const Params p, int l, char* smem) {
    float* x_s = (float*)smem; float* hid = x_s + 1024; float* gate_s = hid + 128; int* idx_s = (int*)(gate_s + 128); float* red = (float*)(idx_s + 128);
    const bf16_t* XN = (const bf16_t*)(p.ws + OFF_XN);
    const int* IDX = (const int*)(p.ws + OFF_IDX); const float* GT = (const float*)(p.ws + OFF_GT);
    const float* U = p.in[I_PU] + (size_t)l * 16384 * 1024; const float* V = p.in[I_PV] + (size_t)l * 16384 * 1024;
    const int tid = threadIdx.x, w = tid >> 6, lane = tid & 63;
    for (int m = blockIdx.x; m < M_; m += gridDim.x) {
        __syncthreads();
        for (int i = 0; i < 4; ++i) x_s[tid * 4 + i] = bf2f(XN[(size_t)m * 1024 + tid * 4 + i]);
        if (tid < 128) { idx_s[tid] = IDX[(size_t)m * 128 + tid]; gate_s[tid] = GT[(size_t)m * 128 + tid]; }
        __syncthreads();
        for (int e = w; e < 128; e += 4) {
            const float* row = U + (size_t)idx_s[e] * 1024;
            float part = 0.f;
#pragma unroll
            for (int k = 0; k < 4; ++k) {
                const float4 uv = *(const float4*)(row + (k * 64 + lane) * 4);
                const float* xp = x_s + (k * 64 + lane) * 4;
                part += uv.x * xp[0] + uv.y * xp[1] + uv.z * xp[2] + uv.w * xp[3];
            }
            red[tid] = part;
            __syncthreads();
            if (lane == 0) { float sm = 0.f; for (int i = 0; i < 64; ++i) sm += red[w * 64 + i]; hid[e] = gate_s[e] * geluf_(sm); }
            __syncthreads();
        }
        float a0 = 0.f, a1 = 0.f, a2 = 0.f, a3 = 0.f;
        for (int e = 0; e < 128; ++e) {
            const float4 vv = *(const float4*)(V + (size_t)idx_s[e] * 1024 + tid * 4);
            const float hh = hid[e];
            a0 += hh * vv.x; a1 += hh * vv.y; a2 += hh * vv.z; a3 += hh * vv.w;
        }
        float4* op = (float4*)(p.out + (size_t)m * 1024 + tid * 4);
        float4 ov = *op;
        ov.x += a0; ov.y += a1; ov.z += a2; ov.w += a3;
        *op = ov;
    }
}

__global__ void __launch_bounds__(256) k_rmsnorm_bf16(const float* src, const float* w, bf16_t* dst) { DYN_SMEM(smem); stage_rmsnorm<false>(src, w, dst, smem); }
__global__ void __launch_bounds__(256) k_rmsnorm_f32(const float* src, const float* w, float* dst) { DYN_SMEM(smem); stage_rmsnorm<true>(src, w, dst, smem); }
__global__ void __launch_bounds__(256) k_gemm_bf16(GemmArgs g) { DYN_SMEM(smem); stage_gemm<EPI_BF16>(g, smem); }
__global__ void __launch_bounds__(256) k_gemm_sig(GemmArgs g) { DYN_SMEM(smem); stage_gemm<EPI_SIGB_BF16>(g, smem); }
__global__ void __launch_bounds__(256) k_gemm_resid(GemmArgs g) { DYN_SMEM(smem); stage_gemm<EPI_RESID>(g, smem); }
__global__ void __launch_bounds__(256) k_gemm_f32(GemmArgs g) { DYN_SMEM(smem); stage_gemm<EPI_F32>(g, smem); }
__global__ void __launch_bounds__(256) k_merge(Params p, int l) { DYN_SMEM(smem); stage_merge(p, l, smem); }
__global__ void __launch_bounds__(256) k_lru(Params p, int l) { DYN_SMEM(smem); stage_lru(p, l, smem); }
__global__ void __launch_bounds__(256) k_gdn(Params p, int l) { DYN_SMEM(smem); stage_gdn(p, l, smem); }
__global__ void __launch_bounds__(256) k_rwkv(Params p, int l) { DYN_SMEM(smem); stage_rwkv(p, l, smem); }
__global__ void __launch_bounds__(256) k_peer_topk(Params p, int l) { DYN_SMEM(smem); stage_peer_topk(p, l, smem); }
__global__ void __launch_bounds__(256) k_peer_gather(Params p, int l) { DYN_SMEM(smem); stage_peer_gather(p, l, smem); }
}

#ifdef CPU_EMU
int g_emu_stop = 1000;
#define EMU_STOP(n) if (g_emu_stop == (n)) return;
#else
#define EMU_STOP(n)
#endif

extern "C" void kernel_launch(void* const* d_in, const int* in_sizes, int n_in, void* d_out, int out_size, void* d_ws, size_t ws_size, hipStream_t stream) {
    Params p{};
    for (int i = 0; i < N_IN; ++i) p.in[i] = (const float*)d_in[i];
    p.out = (float*)d_out; p.ws = (char*)d_ws;
    char* ws = p.ws;
    bf16_t* Z = (bf16_t*)(ws + OFF_Z); bf16_t* XN = (bf16_t*)(ws + OFF_XN); bf16_t* G = (bf16_t*)(ws + OFF_G); bf16_t* MG = (bf16_t*)(ws + OFF_MG);
    const size_t GEMM_SMEM = (16 * 65 + 16 * 64) * 4;
    const int nM = M_ / 64;
    for (int l = 0; l < NL_; ++l) {
        const float* hin = l == 0 ? p.in[I_X] : p.out;
        LAUNCH(k_rmsnorm_bf16, M_, 256, 272 * 4, stream, hin, p.in[I_NMIX] + l * 1024, XN);
        const float* win = p.in[I_WIN] + (size_t)l * 1024 * INW;
        { GemmArgs g{}; g.A = XN; g.lda = 1024; g.Bw = win; g.ldb = INW; g.N = ZW; g.C = Z; g.ldc = ZW; LAUNCH(k_gemm_bf16, nM * ((ZW + 63) / 64), 256, GEMM_SMEM, stream, g); }
        { GemmArgs g{}; g.A = XN; g.lda = 1024; g.Bw = win + ZW; g.ldb = INW; g.N = 3072; g.C = G; g.ldc = 3072; g.bias = p.in[I_MB] + l * 3072; LAUNCH(k_gemm_sig, nM * 48, 256, GEMM_SMEM, stream, g); }
        EMU_STOP(l * 10 + 1)
        LAUNCH(k_lru, B_ * 16, 256, (128 + 8192) * 4, stream, p, l);
        LAUNCH(k_gdn, B_ * 8, 256, (128 * 3 + 512 + 128) * 4, stream, p, l);
        LAUNCH(k_rwkv, B_ * 16, 256, (448 + 768 + 448 + 512 + 64) * 4, stream, p, l);
        EMU_STOP(l * 10 + 2)
        LAUNCH(k_merge, nM * 16, 256, GEMM_SMEM, stream, p, l);
        EMU_STOP(l * 10 + 3)
        { GemmArgs g{}; g.A = MG; g.lda = 1024; g.Bw = p.in[I_WOUT] + (size_t)l * 1024 * 1024; g.ldb = 1024; g.N = 1024; g.C = p.out; g.ldc = 1024; g.resid = hin; LAUNCH(k_gemm_resid, nM * 16, 256, GEMM_SMEM, stream, g); }
        EMU_STOP(l * 10 + 4)
        LAUNCH(k_rmsnorm_bf16, M_, 256, 272 * 4, stream, (const float*)p.out, p.in[I_NFFN] + l * 1024, XN);
        { GemmArgs g{}; g.A = XN; g.lda = 1024; g.Bw = p.in[I_PWQ] + (size_t)l * 1024 * 2048; g.ldb = 2048; g.N = 2048; g.C = ws + OFF_Q; g.ldc = 2048; LAUNCH(k_gemm_f32, nM * 32, 256, GEMM_SMEM, stream, g); }
        LAUNCH(k_peer_topk, M_ * 8, 256, (256 + 256 + 32 + 32 + 256 + 16 + 16) * 4, stream, p, l);
        LAUNCH(k_peer_gather, M_, 256, (1024 + 128 + 128 + 128 + 256) * 4, stream, p, l);
        EMU_STOP(l * 10 + 5)
    }
    LAUNCH(k_rmsnorm_f32, M_, 256, 272 * 4, stream, (const float*)p.out, p.in[I_NFINAL], p.out);
}
```

```cpp
#ifndef CPU_EMU
#include <hip/hip_runtime.h>
#include <hip/hip_cooperative_groups.h>
#include <cstdio>
#include <cstdint>
namespace cg = cooperative_groups;
#define DYN_SMEM(name) extern __shared__ __attribute__((aligned(16))) char name[]
#define LAUNCH(kern, grid, block, smem, stream, ...) hipLaunchKernelGGL(kern, dim3(grid), dim3(block), smem, stream, __VA_ARGS__)
#endif

#ifndef CFG_B
#define CFG_B 8
#endif
#ifndef CFG_T
#define CFG_T 2048
#endif
#ifndef MK_MULTI
#define MK_MULTI 0
#endif

namespace {
constexpr int B_ = CFG_B, T_ = CFG_T, M_ = B_ * T_, D_ = 1024, NL_ = 2, NT = 512;
constexpr int INW = 12560, ZW = 9488;
constexpr int Z_ULRU = 0, Z_GLRU = 1024, Z_Q = 2048, Z_K = 3072, Z_V = 4096, Z_ZG = 5120, Z_ALPHA = 6144, Z_BETA = 6152, Z_RW = 6160;
constexpr int RW_R = 0, RW_K = 1024, RW_V = 2048, RW_WL = 3072, RW_AL = 3136, RW_GL = 3200, RWW = 3328;
constexpr float RMS_EPS = 1e-6f, GN_EPS = 64e-5f;
typedef unsigned short bf16_t;

enum { I_X = 0, I_NMIX, I_NFFN, I_NFINAL, I_WIN, I_LCW, I_LCB, I_LWA, I_LBA, I_LWX, I_LBX, I_LLAM, I_GCW, I_GALOG, I_GDT, I_GNW,
       I_RMU, I_RW0, I_RWUP, I_RA0, I_RAUP, I_RGUP, I_RKK, I_RKA, I_RRK, I_RLW, I_RLB, I_MB, I_PL, I_PG, I_PR, I_WOUT, I_PWQ, I_PKEYS, I_PU, I_PV, N_IN };

struct Params {
    const float* in[N_IN];
    float* out;
    char* ws;
};
#ifdef CPU_EMU
typedef const Params* KParams;
#else
typedef const Params __attribute__((address_space(4)))* KParams;
#endif


constexpr size_t al256(size_t x) { return (x + 255) / 256 * 256; }
constexpr size_t OFF_Z = 0;
constexpr size_t OFF_YC = al256(OFF_Z + (size_t)M_ * ZW * 2);
constexpr size_t OFF_XN = al256(OFF_YC + (size_t)M_ * 1024 * 2);
constexpr size_t OFF_G = al256(OFF_XN + (size_t)M_ * 1024 * 2);
constexpr size_t OFF_MG = al256(OFF_G + (size_t)M_ * 3072 * 2);
constexpr size_t WS_END = al256(OFF_MG + (size_t)M_ * 1024 * 2);
constexpr size_t OFF_Q = 0;
constexpr size_t OFF_IDX = al256(OFF_Q + (size_t)M_ * 2048 * 4);
constexpr size_t OFF_GT = al256(OFF_IDX + (size_t)M_ * 128 * 4);
static_assert(OFF_GT + (size_t)M_ * 128 * 4 <= OFF_YC, "peer overlay");
constexpr size_t SMEM_BYTES = 48 * 1024;

#ifdef CPU_EMU
__device__ __forceinline__ int tid_() { return threadIdx.x; }
__device__ __forceinline__ int bid_() { return blockIdx.x; }
#else
__device__ __forceinline__ int tid_() { int t = threadIdx.x; asm volatile("" : "+v"(t)); return t; }
__device__ __forceinline__ int bid_() { return (int)blockIdx.x; }
#endif

__device__ __forceinline__ bf16_t f2bf(float f) { unsigned u = __float_as_uint(f); u += 0x7fffu + ((u >> 16) & 1u); return (bf16_t)(u >> 16); }
__device__ __forceinline__ float bf2f(bf16_t h) { return __uint_as_float(((unsigned)h) << 16); }
__device__ __forceinline__ float sigmoidf_(float x) { return 1.0f / (1.0f + expf(-x)); }
__device__ __forceinline__ float softplusf_(float x) { return fmaxf(x, 0.0f) + log1pf(expf(-fabsf(x))); }
__device__ __forceinline__ float siluf_(float x) { return x * sigmoidf_(x); }
__device__ __forceinline__ float geluf_(float x) { return 0.5f * x * (1.0f + tanhf(0.7978845608028654f * (x + 0.044715f * x * x * x))); }

__device__ __forceinline__ float block_sum512(float v, float* red) {
    const int tid = tid_();
    red[tid] = v;
    __syncthreads();
    if (tid < 32) { float s = 0.f; for (int i = 0; i < 16; ++i) s += red[tid * 16 + i]; red[512 + tid] = s; }
    __syncthreads();
    float tot = 0.f;
    for (int i = 0; i < 32; ++i) tot += red[512 + i];
    __syncthreads();
    return tot;
}

template <bool OUT_F32>
__device__ __forceinline__ void stage_rmsnorm(const float* src, const float* w, void* dst, char* smem) {
    float* red = (float*)smem;
    const int tid = tid_();
    for (int row = bid_(); row < M_; row += gridDim.x) {
        const float2 v = *(const float2*)(src + (size_t)row * D_ + tid * 2);
        const float ss = block_sum512(v.x * v.x + v.y * v.y, red);
        const float rstd = rsqrtf(ss * (1.0f / D_) + RMS_EPS);
        const float2 wv = *(const float2*)(w + tid * 2);
        const float o0 = v.x * rstd * wv.x, o1 = v.y * rstd * wv.y;
        if (OUT_F32) {
            float2 o; o.x = o0; o.y = o1;
            *(float2*)((float*)dst + (size_t)row * D_ + tid * 2) = o;
        } else {
            bf16_t* d = (bf16_t*)dst + (size_t)row * D_ + tid * 2;
            d[0] = f2bf(o0); d[1] = f2bf(o1);
        }
    }
}

enum { EPI_BF16 = 0, EPI_SIGB_BF16 = 1, EPI_RESID = 3, EPI_F32 = 4 };
struct GemmArgs {
    const bf16_t* A; int lda;
    const float* Bw; int ldb;
    int N;
    void* C; int ldc;
    const float* bias;
    const float* resid;
};
__device__ __forceinline__ void gemm_tile_acc(const bf16_t* A, int lda, const float* Bw, int ldb, int N, int m0, int n0, float (&acc)[4][4], float* As, float* Bs) {
    const int tid = tid_(), tx = tid & 15, ty = tid >> 4;
#pragma unroll 1
    for (int k0 = 0; k0 < 1024; k0 += 16) {
        {
            const int r = tid >> 2, kq = (tid & 3) * 4;
            const bf16_t* ap = A + (size_t)(m0 + r) * lda + k0 + kq;
            As[(kq + 0) * 129 + r] = bf2f(ap[0]); As[(kq + 1) * 129 + r] = bf2f(ap[1]); As[(kq + 2) * 129 + r] = bf2f(ap[2]); As[(kq + 3) * 129 + r] = bf2f(ap[3]);
            const int kk = tid >> 5, nq = (tid & 31) * 2;
            const float* bp = Bw + (size_t)(k0 + kk) * ldb + n0 + nq;
#pragma unroll
            for (int j = 0; j < 2; ++j) Bs[kk * 64 + nq + j] = (n0 + nq + j < N) ? bp[j] : 0.f;
        }
        __syncthreads();
#pragma unroll
        for (int kk = 0; kk < 16; ++kk) {
            float a[4], b[4];
#pragma unroll
            for (int i = 0; i < 4; ++i) a[i] = As[kk * 129 + ty * 4 + i];
#pragma unroll
            for (int j = 0; j < 4; ++j) b[j] = Bs[kk * 64 + tx * 4 + j];
#pragma unroll
            for (int i = 0; i < 4; ++i)
#pragma unroll
                for (int j = 0; j < 4; ++j) acc[i][j] += a[i] * b[j];
        }
        __syncthreads();
    }
}
template <int EPI>
__device__ __forceinline__ void stage_gemm(const GemmArgs g, char* smem) {
    float* As = (float*)smem; float* Bs = As + 16 * 129;
    const int tid = tid_(), tx = tid & 15, ty = tid >> 4;
    const int nM = M_ / 128, nN = (g.N + 63) / 64;
    for (int tile = bid_(); tile < nM * nN; tile += gridDim.x) {
        const int m0 = (tile % nM) * 128, n0 = (tile / nM) * 64;
        float acc[4][4];
#pragma unroll
        for (int i = 0; i < 4; ++i)
#pragma unroll
            for (int j = 0; j < 4; ++j) acc[i][j] = 0.f;
        gemm_tile_acc(g.A, g.lda, g.Bw, g.ldb, g.N, m0, n0, acc, As, Bs);
#pragma unroll
        for (int i = 0; i < 4; ++i)
#pragma unroll
            for (int j = 0; j < 4; ++j) {
                const int m = m0 + ty * 4 + i, n = n0 + tx * 4 + j;
                if (n < g.N) {
                    const size_t o = (size_t)m * g.ldc + n;
                    if (EPI == EPI_BF16) ((bf16_t*)g.C)[o] = f2bf(acc[i][j]);
                    else if (EPI == EPI_SIGB_BF16) ((bf16_t*)g.C)[o] = f2bf(sigmoidf_(acc[i][j] + g.bias[n]));
                    else if (EPI == EPI_RESID) ((float*)g.C)[o] = g.resid[o] + acc[i][j];
                    else ((float*)g.C)[o] = acc[i][j];
                }
            }
    }
}
__device__ __forceinline__ void stage_merge(KParams p, int l, char* smem) {
    float* As = (float*)smem; float* Bs = As + 16 * 129;
    const int tid = tid_(), tx = tid & 15, ty = tid >> 4;
    const bf16_t* Z = (const bf16_t*)(p->ws + OFF_Z);
    const bf16_t* YC = (const bf16_t*)(p->ws + OFF_YC);
    const bf16_t* G = (const bf16_t*)(p->ws + OFF_G);
    bf16_t* MG = (bf16_t*)(p->ws + OFF_MG);
    const int nM = M_ / 128, nN = 1024 / 64;
    for (int tile = bid_(); tile < nM * nN; tile += gridDim.x) {
        const int m0 = (tile % nM) * 128, n0 = (tile / nM) * 64;
        float tot[4][4];
#pragma unroll
        for (int i = 0; i < 4; ++i)
#pragma unroll
            for (int j = 0; j < 4; ++j) tot[i][j] = 0.f;
#pragma unroll 1
        for (int br = 0; br < 3; ++br) {
            const bf16_t* A = br == 0 ? Z + Z_GLRU : (br == 1 ? Z + Z_ZG : YC);
            const int lda = br == 2 ? 1024 : ZW;
            const float* Bw = p->in[br == 0 ? I_PL : (br == 1 ? I_PG : I_PR)] + (size_t)l * 1024 * 1024;
            float acc[4][4];
#pragma unroll
            for (int i = 0; i < 4; ++i)
#pragma unroll
                for (int j = 0; j < 4; ++j) acc[i][j] = 0.f;
            gemm_tile_acc(A, lda, Bw, 1024, 1024, m0, n0, acc, As, Bs);
#pragma unroll
            for (int i = 0; i < 4; ++i)
#pragma unroll
                for (int j = 0; j < 4; ++j) {
                    const int m = m0 + ty * 4 + i, n = n0 + tx * 4 + j;
                    tot[i][j] += bf2f(G[(size_t)m * 3072 + br * 1024 + n]) * acc[i][j];
                }
        }
#pragma unroll
        for (int i = 0; i < 4; ++i)
#pragma unroll
            for (int j = 0; j < 4; ++j) MG[(size_t)(m0 + ty * 4 + i) * 1024 + n0 + tx * 4 + j] = f2bf(tot[i][j]);
    }
}

__device__ __forceinline__ void stage_lru(KParams p, int l, char* smem, int vb0, int nvb) {
    const int vb = bid_() - vb0;
    if (vb < 0 || vb >= nvb) return;
    float* xc_s = (float*)smem; float* gi_s = xc_s + 64; float* wa_s = gi_s + 64; float* wx_s = wa_s + 4096;
    bf16_t* Z = (bf16_t*)(p->ws + OFF_Z);
    const int tid = tid_(), j = tid & 63, q = tid >> 6;
    for (int item = vb; item < B_ * 16; item += nvb) {
        const int b = item / 16, n = item % 16, c = n * 64 + j;
        __syncthreads();
        for (int i = tid; i < 4096; i += NT) { wa_s[i] = p->in[I_LWA][((size_t)l * 16 + n) * 4096 + i]; wx_s[i] = p->in[I_LWX][((size_t)l * 16 + n) * 4096 + i]; }
        const float cw0 = p->in[I_LCW][((size_t)l * 4 + 0) * 1024 + c], cw1 = p->in[I_LCW][((size_t)l * 4 + 1) * 1024 + c];
        const float cw2 = p->in[I_LCW][((size_t)l * 4 + 2) * 1024 + c], cw3 = p->in[I_LCW][((size_t)l * 4 + 3) * 1024 + c];
        const float cb = p->in[I_LCB][l * 1024 + c];
        const float bias = q == 0 ? p->in[I_LBA][l * 1024 + c] : p->in[I_LBX][l * 1024 + c];
        const float sp = softplusf_(-p->in[I_LLAM][l * 1024 + c]);
        const float* wsel = q == 0 ? wa_s : wx_s;
        float u1 = 0.f, u2 = 0.f, u3 = 0.f, hst = 0.f, xc = 0.f;
        __syncthreads();
#pragma unroll 1
        for (int t = 0; t < T_; ++t) {
            const size_t m = (size_t)b * T_ + t;
            if (q == 0) {
                const float u0 = bf2f(Z[m * ZW + Z_ULRU + c]);
                xc = cw0 * u3 + cw1 * u2 + cw2 * u1 + cw3 * u0 + cb;
                u3 = u2; u2 = u1; u1 = u0;
                xc_s[j] = xc;
            }
            __syncthreads();
            float val = 0.f;
            if (q < 2) {
                float dot = 0.f;
#pragma unroll 8
                for (int i = 0; i < 64; ++i) dot += xc_s[i] * wsel[i * 64 + j];
                val = sigmoidf_(dot + bias);
                if (q == 1) gi_s[j] = val;
            }
            __syncthreads();
            if (q == 0) {
                const float r = val, ig = gi_s[j];
                const float log_a = -8.0f * r * sp;
                const float a = expf(log_a);
                const float bb = sqrtf(-expm1f(2.0f * log_a)) * (ig * xc);
                hst = a * hst + bb;
                const float g = bf2f(Z[m * ZW + Z_GLRU + c]);
                Z[m * ZW + Z_GLRU + c] = f2bf(hst * geluf_(g));
            }
        }
    }
}

__device__ __forceinline__ void stage_gdn(KParams p, int l, char* smem, int vb0, int nvb) {
    const int vb = bid_() - vb0;
    if (vb < 0 || vb >= nvb) return;
    float* qs = (float*)smem; float* ks = qs + 128; float* vs = ks + 128; float* part = vs + 128; float* part2 = part + 512; float* os = part2 + 512;
    bf16_t* Z = (bf16_t*)(p->ws + OFF_Z);
    const int tid = tid_(), v = tid & 127, hf = tid >> 7;
    for (int item = vb; item < B_ * 8; item += nvb) {
        const int b = item / 8, h = item % 8;
        const int ch0 = hf == 1 ? (1024 + h * 128 + v) : (h * 128 + v);
        const int ch1 = 2048 + h * 128 + v;
        float c0w[4], c1w[4];
#pragma unroll
        for (int jj = 0; jj < 4; ++jj) { c0w[jj] = p->in[I_GCW][((size_t)l * 4 + jj) * 3072 + ch0]; c1w[jj] = p->in[I_GCW][((size_t)l * 4 + jj) * 3072 + ch1]; }
        const float a_exp = expf(p->in[I_GALOG][l * 8 + h]), dtb = p->in[I_GDT][l * 8 + h];
        const float nw = p->in[I_GNW][l * 128 + v];
        float S[32];
#pragma unroll
        for (int k = 0; k < 32; ++k) S[k] = 0.f;
        float a1 = 0.f, a2 = 0.f, a3 = 0.f, b1 = 0.f, b2 = 0.f, b3 = 0.f;
        __syncthreads();
#pragma unroll 1
        for (int t = 0; t < T_; ++t) {
            const size_t m = (size_t)b * T_ + t;
            if (hf < 2) {
                const float x0 = bf2f(Z[m * ZW + Z_Q + ch0]);
                const float cv = c0w[0] * a3 + c0w[1] * a2 + c0w[2] * a1 + c0w[3] * x0;
                a3 = a2; a2 = a1; a1 = x0;
                if (hf == 0) qs[v] = siluf_(cv); else ks[v] = siluf_(cv);
                if (hf == 0) {
                    const float y0 = bf2f(Z[m * ZW + Z_Q + ch1]);
                    const float cv1 = c1w[0] * b3 + c1w[1] * b2 + c1w[2] * b1 + c1w[3] * y0;
                    b3 = b2; b2 = b1; b1 = y0;
                    vs[v] = siluf_(cv1);
                }
            }
            __syncthreads();
            float sq = 0.f, sk = 0.f;
            for (int i = 0; i < 128; ++i) { sq += qs[i] * qs[i]; sk += ks[i] * ks[i]; }
            const float rq = rsqrtf(sq + RMS_EPS) * 0.08838834764831845f, rk = rsqrtf(sk + RMS_EPS);
            const float beta = sigmoidf_(bf2f(Z[m * ZW + Z_BETA + h]));
            const float gg = -a_exp * softplusf_(bf2f(Z[m * ZW + Z_ALPHA + h]) + dtb);
            const float eg = expf(gg);
            float pk = 0.f;
#pragma unroll
            for (int k = 0; k < 32; ++k) pk += S[k] * ks[hf * 32 + k];
            part[hf * 128 + v] = pk * rk;
            __syncthreads();
            const float kS = part[v] + part[128 + v] + part[256 + v] + part[384 + v];
            const float cc = beta * (vs[v] - eg * kS) * rk;
            float po = 0.f;
#pragma unroll
            for (int k = 0; k < 32; ++k) { S[k] = eg * S[k] + ks[hf * 32 + k] * cc; po += S[k] * qs[hf * 32 + k]; }
            part2[hf * 128 + v] = po * rq;
            __syncthreads();
            if (hf == 0) os[v] = part2[v] + part2[128 + v] + part2[256 + v] + part2[384 + v];
            __syncthreads();
            if (hf == 0) {
                float ms = 0.f;
                for (int i = 0; i < 128; ++i) ms += os[i] * os[i];
                const float o = os[v] * rsqrtf(ms * (1.0f / 128.0f) + RMS_EPS) * nw;
                const float zg = bf2f(Z[m * ZW + Z_ZG + h * 128 + v]);
                Z[m * ZW + Z_ZG + h * 128 + v] = f2bf(o * siluf_(zg));
            }
        }
    }
}

__device__ __forceinline__ void stage_rwkv(KParams p, int l, char* smem, int vb0, int nvb) {
    const int vb = bid_() - vb0;
    if (vb < 0 || vb >= nvb) return;
    float* zs_s = (float*)smem;
    float* lw = zs_s + 448;
    float* la = lw + 512;
    float* lg = la + 512;
    float* r_s = lg + 512; float* w_s = r_s + 64; float* k2_s = w_s + 64; float* a_s = k2_s + 64; float* gate_s = a_s + 64; float* v_s = gate_s + 64; float* kkr_s = v_s + 64;
    float* part = kkr_s + 64;
    float* part2 = part + 512;
    float* o_s = part2 + 512;
    float* bonp_s = o_s + 64;
    const bf16_t* Z = (const bf16_t*)(p->ws + OFF_Z);
    bf16_t* YC = (bf16_t*)(p->ws + OFF_YC);
    const int tid = tid_();
    for (int item = vb; item < B_ * 16; item += nvb) {
        const int b = item / 16, h = item % 16;
        int cl = 0;
        {
            const int e = tid;
            if (e < 64) cl = RW_R + h * 64 + e; else if (e < 128) cl = RW_K + h * 64 + (e - 64); else if (e < 192) cl = RW_V + h * 64 + (e - 128);
            else if (e < 256) cl = RW_WL + (e - 192); else if (e < 320) cl = RW_AL + (e - 256); else if (e < 448) cl = RW_GL + (e - 320);
        }
        const float mu = (tid < 448) ? p->in[I_RMU][(size_t)l * RWW + cl] : 0.f;
        float prev = 0.f;
        const int jc = tid & 63, pp = tid >> 6, c = h * 64 + jc;
        const int ri = tid >> 3, q8 = tid & 7;
        const float w0 = p->in[I_RW0][l * 1024 + c], a0 = p->in[I_RA0][l * 1024 + c], k_k = p->in[I_RKK][l * 1024 + c], k_a = p->in[I_RKA][l * 1024 + c];
        const float lnw = p->in[I_RLW][l * 1024 + h * 64 + ri], lnb = p->in[I_RLB][l * 1024 + h * 64 + ri];
        const float* wup = p->in[I_RWUP] + (size_t)l * 64 * 1024; const float* aup = p->in[I_RAUP] + (size_t)l * 64 * 1024; const float* gup = p->in[I_RGUP] + (size_t)l * 128 * 1024;
        const float rk_c = p->in[I_RRK][(size_t)l * 1024 + c];
        float S[8];
#pragma unroll
        for (int e = 0; e < 8; ++e) S[e] = 0.f;
        __syncthreads();
#pragma unroll 1
        for (int t = 0; t < T_; ++t) {
            const size_t m = (size_t)b * T_ + t;
            if (tid < 448) {
                const float zc = bf2f(Z[m * ZW + Z_RW + cl]);
                float zs = zc + mu * (prev - zc);
                prev = zc;
                if (tid >= 192 && tid < 256) zs = tanhf(zs); else if (tid >= 320) zs = sigmoidf_(zs);
                zs_s[tid] = zs;
            }
            __syncthreads();
            {
                float dw = 0.f, da = 0.f, dg = 0.f;
                for (int i = pp * 8; i < pp * 8 + 8; ++i) { dw += zs_s[192 + i] * wup[(size_t)i * 1024 + c]; da += zs_s[256 + i] * aup[(size_t)i * 1024 + c]; }
                for (int i = pp * 16; i < pp * 16 + 16; ++i) dg += zs_s[320 + i] * gup[(size_t)i * 1024 + c];
                lw[pp * 64 + jc] = dw; la[pp * 64 + jc] = da; lg[pp * 64 + jc] = dg;
            }
            __syncthreads();
            if (tid < 64) {
                float wd = 0.f, ad = 0.f, gd = 0.f;
                for (int i = 0; i < 8; ++i) { wd += lw[i * 64 + jc]; ad += la[i * 64 + jc]; gd += lg[i * 64 + jc]; }
                const float w_log = -softplusf_(-(w0 + wd)) - 0.5f;
                const float decay = expf(-expf(w_log));
                const float a = sigmoidf_(a0 + ad);
                const float kx = zs_s[64 + jc];
                r_s[jc] = zs_s[jc]; w_s[jc] = decay; a_s[jc] = a; gate_s[jc] = gd; v_s[jc] = zs_s[128 + jc];
                const float k2v = kx * (1.0f + (a - 1.0f) * k_a);
                kkr_s[jc] = kx * k_k; k2_s[jc] = k2v; bonp_s[jc] = zs_s[jc] * k2v * rk_c;
            }
            __syncthreads();
            float nsq = 0.f, bon = 0.f;
#pragma unroll 8
            for (int i = 0; i < 64; ++i) { nsq += kkr_s[i] * kkr_s[i]; bon += bonp_s[i]; }
            const float nrm = rsqrtf(nsq + RMS_EPS);
            float pk = 0.f;
#pragma unroll
            for (int e = 0; e < 8; ++e) pk += S[e] * (kkr_s[q8 * 8 + e] * nrm);
            part[ri * 8 + q8] = pk;
            __syncthreads();
            float skk = 0.f;
            for (int i = 0; i < 8; ++i) skk += part[ri * 8 + i];
            const float vi = v_s[ri];
            float po = 0.f;
#pragma unroll
            for (int e = 0; e < 8; ++e) {
                const int jj = q8 * 8 + e;
                const float kkj = kkr_s[jj] * nrm;
                S[e] = S[e] * w_s[jj] - skk * (kkj * a_s[jj]) + vi * k2_s[jj];
                po += S[e] * r_s[jj];
            }
            part2[ri * 8 + q8] = po;
            __syncthreads();
            if (q8 == 0) { float o = 0.f; for (int i = 0; i < 8; ++i) o += part2[ri * 8 + i]; o_s[ri] = o; }
            __syncthreads();
            if (q8 == 0) {
                float mean = 0.f;
#pragma unroll 8
                for (int i = 0; i < 64; ++i) mean += o_s[i];
                mean *= (1.0f / 64.0f);
                float var = 0.f;
#pragma unroll 8
                for (int i = 0; i < 64; ++i) { const float d = o_s[i] - mean; var += d * d; }
                var *= (1.0f / 64.0f);
                const float o = (o_s[ri] - mean) * rsqrtf(var + GN_EPS) * lnw + lnb;
                YC[m * 1024 + h * 64 + ri] = f2bf((o + bon * vi) * gate_s[ri]);
            }
        }
    }
}

__device__ __forceinline__ void stage_peer_topk(KParams p, int l, char* smem) {
    const int tid = tid_(), sub = tid >> 8, lt = tid & 255;
    float* q_s = (float*)smem + sub * 1024; float* sc = q_s + 256; float* top_s = sc + 256; int* top_i = (int*)(top_s + 32); float* cand = (float*)(top_i + 32);
    float* best_s = cand + 256; int* best_e = (int*)(best_s + 16);
    const float* Q = (const float*)(p->ws + OFF_Q);
    int* IDX = (int*)(p->ws + OFF_IDX); float* GT = (float*)(p->ws + OFF_GT);
    const int s = lt >> 7, n = lt & 127;
    for (int item = bid_(); item < M_ * 4; item += gridDim.x) {
        const int m = item >> 2, hd = (item & 3) * 2 + sub;
        __syncthreads();
        q_s[lt] = Q[(size_t)m * 2048 + hd * 256 + lt];
        __syncthreads();
        const float* key = p->in[I_PKEYS] + ((((size_t)l * 8 + hd) * 2 + s) * 128 + n) * 128;
        float dot = 0.f;
        for (int cix = 0; cix < 128; ++cix) dot += q_s[s * 128 + cix] * key[cix];
        sc[lt] = dot;
        __syncthreads();
        int cnt = 0;
        for (int jj = 0; jj < 128; ++jj) { const float o = sc[s * 128 + jj]; cnt += (o > dot || (o == dot && jj < n)) ? 1 : 0; }
        if (cnt < 16) { top_s[s * 16 + cnt] = dot; top_i[s * 16 + cnt] = n; }
        __syncthreads();
        const int ci = lt >> 4, cj = lt & 15;
        const float cs = top_s[ci] + top_s[16 + cj];
        cand[lt] = cs;
        __syncthreads();
        int cnt2 = 0;
        for (int jj = 0; jj < 256; ++jj) { const float o = cand[jj]; cnt2 += (o > cs || (o == cs && jj < lt)) ? 1 : 0; }
        if (cnt2 < 16) { best_s[cnt2] = cs; best_e[cnt2] = top_i[ci] * 128 + top_i[16 + cj]; }
        __syncthreads();
        if (lt < 16) {
            const float mx = best_s[0];
            float sum = 0.f;
            for (int i = 0; i < 16; ++i) sum += expf(best_s[i] - mx);
            IDX[(size_t)m * 128 + hd * 16 + lt] = best_e[lt];
            GT[(size_t)m * 128 + hd * 16 + lt] = expf(best_s[lt] - mx) / sum;
        }
    }
}

__device__ __forceinline__ void stage_peer_gather(KParams p, int l, char* smem) {
    float* x_s = (float*)smem; float* hid = x_s + 1024; float* gate_s = hid + 128; int* idx_s = (int*)(gate_s + 128); float* red = (float*)(idx_s + 128);
    const bf16_t* XN = (const bf16_t*)(p->ws + OFF_XN);
    const int* IDX = (const int*)(p->ws + OFF_IDX); const float* GT = (const float*)(p->ws + OFF_GT);
    const float* U = p->in[I_PU] + (size_t)l * 16384 * 1024; const float* V = p->in[I_PV] + (size_t)l * 16384 * 1024;
    const int tid = tid_(), w = tid >> 6, lane = tid & 63;
    for (int m = bid_(); m < M_; m += gridDim.x) {
        __syncthreads();
        for (int i = 0; i < 2; ++i) x_s[tid * 2 + i] = bf2f(XN[(size_t)m * 1024 + tid * 2 + i]);
        if (tid < 128) { idx_s[tid] = IDX[(size_t)m * 128 + tid]; gate_s[tid] = GT[(size_t)m * 128 + tid]; }
        __syncthreads();
        for (int e = w; e < 128; e += 8) {
            const float* row = U + (size_t)idx_s[e] * 1024;
            float part = 0.f;
#pragma unroll
            for (int k = 0; k < 4; ++k) {
                const float4 uv = *(const float4*)(row + (k * 64 + lane) * 4);
                const float* xp = x_s + (k * 64 + lane) * 4;
                part += uv.x * xp[0] + uv.y * xp[1] + uv.z * xp[2] + uv.w * xp[3];
            }
            red[tid] = part;
            __syncthreads();
            if (lane == 0) { float sm = 0.f; for (int i = 0; i < 64; ++i) sm += red[w * 64 + i]; hid[e] = gate_s[e] * geluf_(sm); }
            __syncthreads();
        }
        float a0 = 0.f, a1 = 0.f;
        for (int e = 0; e < 128; ++e) {
            const float2 vv = *(const float2*)(V + (size_t)idx_s[e] * 1024 + tid * 2);
            const float hh = hid[e];
            a0 += hh * vv.x; a1 += hh * vv.y;
        }
        float2* op = (float2*)(p->out + (size_t)m * 1024 + tid * 2);
        float2 ov = *op;
        ov.x += a0; ov.y += a1;
        *op = ov;
    }
}

enum { PH_NORM_MIX = 0, PH_INPROJ, PH_MIXERS, PH_MERGE, PH_WOUT, PH_NORM_FFN, PH_QUERY, PH_TOPK, PH_GATHER, PH_PER_LAYER, PH_FINAL = 100 };
__device__ __forceinline__ void run_phase(KParams p, int l, int ph, char* smem) {
    char* ws = p->ws;
    bf16_t* Z = (bf16_t*)(ws + OFF_Z); bf16_t* XN = (bf16_t*)(ws + OFF_XN); bf16_t* G = (bf16_t*)(ws + OFF_G); bf16_t* MG = (bf16_t*)(ws + OFF_MG);
    const float* hin = l == 0 ? p->in[I_X] : p->out;
    const float* win = p->in[I_WIN] + (size_t)l * 1024 * INW;
    switch (ph) {
    case PH_NORM_MIX: stage_rmsnorm<false>(hin, p->in[I_NMIX] + l * 1024, XN, smem); break;
    case PH_INPROJ: {
        { GemmArgs g{}; g.A = XN; g.lda = 1024; g.Bw = win; g.ldb = INW; g.N = ZW; g.C = Z; g.ldc = ZW; stage_gemm<EPI_BF16>(g, smem); }
        { GemmArgs g{}; g.A = XN; g.lda = 1024; g.Bw = win + ZW; g.ldb = INW; g.N = 3072; g.C = G; g.ldc = 3072; g.bias = p->in[I_MB] + l * 3072; stage_gemm<EPI_SIGB_BF16>(g, smem); }
    } break;
    case PH_MIXERS: {
        const int nb = gridDim.x, n_rw = nb / 2, n_gd = nb / 4, n_lr = nb - n_rw - n_gd;
        stage_rwkv(p, l, smem, 0, n_rw);
        stage_gdn(p, l, smem, n_rw, n_gd);
        stage_lru(p, l, smem, n_rw + n_gd, n_lr);
    } break;
    case PH_MERGE: stage_merge(p, l, smem); break;
    case PH_WOUT: { GemmArgs g{}; g.A = MG; g.lda = 1024; g.Bw = p->in[I_WOUT] + (size_t)l * 1024 * 1024; g.ldb = 1024; g.N = 1024; g.C = p->out; g.ldc = 1024; g.resid = hin; stage_gemm<EPI_RESID>(g, smem); } break;
    case PH_NORM_FFN: stage_rmsnorm<false>(p->out, p->in[I_NFFN] + l * 1024, XN, smem); break;
    case PH_QUERY: { GemmArgs g{}; g.A = XN; g.lda = 1024; g.Bw = p->in[I_PWQ] + (size_t)l * 1024 * 2048; g.ldb = 2048; g.N = 2048; g.C = ws + OFF_Q; g.ldc = 2048; stage_gemm<EPI_F32>(g, smem); } break;
    case PH_TOPK: stage_peer_topk(p, l, smem); break;
    case PH_GATHER: stage_peer_gather(p, l, smem); break;
    case PH_FINAL: stage_rmsnorm<true>(p->out, p->in[I_NFINAL], p->out, smem); break;
    default: break;
    }
}

#if !defined(CPU_EMU) && !MK_MULTI
__global__ void __launch_bounds__(512, 2) k_mega(Params p_) {
    DYN_SMEM(smem);
    KParams pk = (KParams)__builtin_amdgcn_kernarg_segment_ptr();
    cg::grid_group grid = cg::this_grid();
#pragma unroll 1
    for (int it = 0; it <= NL_ * PH_PER_LAYER; ++it) {
        const int l = it < NL_ * PH_PER_LAYER ? it / PH_PER_LAYER : 0, ph = it < NL_ * PH_PER_LAYER ? it % PH_PER_LAYER : (int)PH_FINAL;
        KParams q = pk; asm volatile("" : "+s"(q));
        run_phase(q, l, ph, smem);
        if (it < NL_ * PH_PER_LAYER) grid.sync();
    }
}
#endif
#ifdef CPU_EMU
__global__ void k_phase(Params p_, int l, int ph) { DYN_SMEM(smem); run_phase(&p_, l, ph, smem); }
#elif MK_MULTI
__global__ void __launch_bounds__(512, 2) k_phase(Params p_, int l, int ph) { DYN_SMEM(smem); KParams pk = (KParams)__builtin_amdgcn_kernarg_segment_ptr(); run_phase(pk, l, ph, smem); }
#endif
}

#ifdef CPU_EMU
int g_emu_stop = 1000;
#endif

extern "C" void kernel_launch(void* const* d_in, const int* in_sizes, int n_in, void* d_out, int out_size, void* d_ws, size_t ws_size, hipStream_t stream) {
    Params p{};
    for (int i = 0; i < N_IN; ++i) p.in[i] = (const float*)d_in[i];
    p.out = (float*)d_out; p.ws = (char*)d_ws;
#if defined(CPU_EMU) || MK_MULTI
    const int grid = 256;
    for (int l = 0; l < NL_; ++l)
        for (int ph = 0; ph < PH_PER_LAYER; ++ph) {
            LAUNCH(k_phase, grid, NT, SMEM_BYTES, stream, p, l, ph);
#ifdef CPU_EMU
            const int code = ph == PH_INPROJ ? 1 : ph == PH_MIXERS ? 2 : ph == PH_MERGE ? 3 : ph == PH_WOUT ? 4 : ph == PH_GATHER ? 5 : 0;
            if (code && g_emu_stop == l * 10 + code) return;
#endif
        }
    LAUNCH(k_phase, grid, NT, SMEM_BYTES, stream, p, 0, (int)PH_FINAL);
#else
    static int grid_blocks = 0;
    if (!grid_blocks) {
        int dev = 0, cus = 0, per_cu = 0;
        (void)hipGetDevice(&dev);
        (void)hipDeviceGetAttribute(&cus, hipDeviceAttributeMultiprocessorCount, dev);
        (void)hipFuncSetAttribute((const void*)k_mega, hipFuncAttributeMaxDynamicSharedMemorySize, (int)SMEM_BYTES);
        (void)hipOccupancyMaxActiveBlocksPerMultiprocessor(&per_cu, k_mega, NT, SMEM_BYTES);
        if (per_cu > 1) per_cu = 1;
        grid_blocks = cus * per_cu;
    }
    void* args[] = {&p};
    hipError_t e = hipLaunchCooperativeKernel((void*)k_mega, dim3(grid_blocks), dim3(NT), args, SMEM_BYTES, stream);
    if (e != hipSuccess) fprintf(stderr, "cooperative launch failed: %s (grid %d)\n", hipGetErrorString(e), grid_blocks);
#endif
}
```

```cpp
#ifndef CPU_EMU
#include <hip/hip_runtime.h>
#include <hip/hip_cooperative_groups.h>
#include <cstdio>
#include <cstdint>
namespace cg = cooperative_groups;
#define DYN_SMEM(name) extern __shared__ __attribute__((aligned(16))) char name[]
#define LAUNCH(kern, grid, block, smem, stream, ...) hipLaunchKernelGGL(kern, dim3(grid), dim3(block), smem, stream, __VA_ARGS__)
#endif

#ifndef CFG_B
#define CFG_B 8
#endif
#ifndef CFG_T
#define CFG_T 2048
#endif
#ifndef MK_MULTI
#define MK_MULTI 0
#endif

namespace {
constexpr int B_ = CFG_B, T_ = CFG_T, M_ = B_ * T_, D_ = 1024, NL_ = 2, NT = 512;
constexpr int INW = 12560;
constexpr int LDZ = 11776;
constexpr int Z_ULRU = 0, Z_GLRU = 1024, Z_Q = 2048, Z_K = 3072, Z_V = 4096, Z_ZG = 5120, Z_RW = 6144, Z_ALPHA = 9472, Z_BETA = 9480;
constexpr int ZN = 9728;
constexpr int C_XN = 9728, C_YC = 10752;
constexpr int C_YA = Z_GLRU, C_YB = Z_ZG;
constexpr int C_GS = Z_Q, C_MG = Z_K;
constexpr int C_QRY = 0;
constexpr int RW_R = 0, RW_K = 1024, RW_V = 2048, RW_WL = 3072, RW_AL = 3136, RW_GL = 3200, RWW = 3328;
constexpr float RMS_EPS = 1e-6f, GN_EPS = 64e-5f;
typedef unsigned short h16_t;

enum { I_X = 0, I_NMIX, I_NFFN, I_NFINAL, I_WIN, I_LCW, I_LCB, I_LWA, I_LBA, I_LWX, I_LBX, I_LLAM, I_GCW, I_GALOG, I_GDT, I_GNW,
       I_RMU, I_RW0, I_RWUP, I_RA0, I_RAUP, I_RGUP, I_RKK, I_RKA, I_RRK, I_RLW, I_RLB, I_MB, I_PL, I_PG, I_PR, I_WOUT, I_PWQ, I_PKEYS, I_PU, I_PV, N_IN };

struct Params {
    const float* in[N_IN];
    float* out;
    char* ws;
};
#ifdef CPU_EMU
typedef const Params* KParams;
#else
typedef const Params __attribute__((address_space(4)))* KParams;
#endif

constexpr size_t al256(size_t x) { return (x + 255) / 256 * 256; }
constexpr size_t OFF_ACT = 0;
constexpr size_t OFF_WT = al256(OFF_ACT + (size_t)M_ * LDZ * 2);
constexpr int WT_IN = 0, WT_MG = ZN, WT_P = WT_MG + 3072, WT_OUT = WT_P + 3072, WT_Q = WT_OUT + 1024, WT_ROWS = WT_Q + 2048;
constexpr size_t OFF_IDX = al256(OFF_WT + (size_t)NL_ * WT_ROWS * 1024 * 2);
constexpr size_t OFF_GT = al256(OFF_IDX + (size_t)M_ * 128 * 4);
constexpr size_t WS_END = al256(OFF_GT + (size_t)M_ * 128 * 4);
static_assert(CFG_B != 8 || CFG_T != 2048 || WS_END <= (size_t)512 * 1024 * 1024, "workspace budget");
constexpr size_t SMEM_BYTES = 128 * 1024;

#ifdef CPU_EMU
__device__ __forceinline__ int tid_() { return threadIdx.x; }
__device__ __forceinline__ h16_t f2h(float f) { return (h16_t)_cvtss_sh(f, _MM_FROUND_TO_NEAREST_INT); }
__device__ __forceinline__ float h2f(h16_t h) { return _cvtsh_ss(h); }
#else
__device__ __forceinline__ int tid_() { int t = threadIdx.x; asm volatile("" : "+v"(t)); return t; }
__device__ __forceinline__ h16_t f2h(float f) { return __builtin_bit_cast(unsigned short, (_Float16)f); }
__device__ __forceinline__ float h2f(h16_t h) { return (float)__builtin_bit_cast(_Float16, h); }
#endif
__device__ __forceinline__ int bid_() { return (int)blockIdx.x; }

__device__ __forceinline__ float sigmoidf_(float x) { return 1.0f / (1.0f + expf(-x)); }
__device__ __forceinline__ float softplusf_(float x) { return fmaxf(x, 0.0f) + log1pf(expf(-fabsf(x))); }
__device__ __forceinline__ float siluf_(float x) { return x * sigmoidf_(x); }
__device__ __forceinline__ float geluf_(float x) { return 0.5f * x * (1.0f + tanhf(0.7978845608028654f * (x + 0.044715f * x * x * x))); }
__device__ __forceinline__ unsigned pack2h(float a, float b) { return (unsigned)f2h(a) | ((unsigned)f2h(b) << 16); }
__device__ __forceinline__ void store8h(h16_t* p, const float (&v)[8]) {
    uint4 w; w.x = pack2h(v[0], v[1]); w.y = pack2h(v[2], v[3]); w.z = pack2h(v[4], v[5]); w.w = pack2h(v[6], v[7]);
    *(uint4*)p = w;
}
__device__ __forceinline__ void load8h(const h16_t* p, float (&v)[8]) {
    const uint4 w = *(const uint4*)p;
    v[0] = h2f((h16_t)(w.x & 0xffffu)); v[1] = h2f((h16_t)(w.x >> 16)); v[2] = h2f((h16_t)(w.y & 0xffffu)); v[3] = h2f((h16_t)(w.y >> 16));
    v[4] = h2f((h16_t)(w.z & 0xffffu)); v[5] = h2f((h16_t)(w.z >> 16)); v[6] = h2f((h16_t)(w.w & 0xffffu)); v[7] = h2f((h16_t)(w.w >> 16));
}

__device__ __forceinline__ float block_sum512(float v, float* red) {
    const int tid = tid_();
    red[tid] = v;
    __syncthreads();
    if (tid < 32) { float s = 0.f; for (int i = 0; i < 16; ++i) s += red[tid * 16 + i]; red[512 + tid] = s; }
    __syncthreads();
    float tot = 0.f;
    for (int i = 0; i < 32; ++i) tot += red[512 + i];
    __syncthreads();
    return tot;
}

template <bool OUT_F32>
__device__ __forceinline__ void stage_rmsnorm(const float* src, const float* w, void* dst, int ldd, char* smem) {
    float* red = (float*)smem;
    const int tid = tid_();
    for (int row = bid_(); row < M_; row += gridDim.x) {
        const float2 v = *(const float2*)(src + (size_t)row * D_ + tid * 2);
        const float ss = block_sum512(v.x * v.x + v.y * v.y, red);
        const float rstd = rsqrtf(ss * (1.0f / D_) + RMS_EPS);
        const float2 wv = *(const float2*)(w + tid * 2);
        const float o0 = v.x * rstd * wv.x, o1 = v.y * rstd * wv.y;
        if (OUT_F32) {
            float2 o; o.x = o0; o.y = o1;
            *(float2*)((float*)dst + (size_t)row * ldd + tid * 2) = o;
        } else {
            *(unsigned*)((h16_t*)dst + (size_t)row * ldd + tid * 2) = pack2h(o0, o1);
        }
    }
}

__device__ __forceinline__ const float* wt_src(KParams p, int l, int r, int& ld) {
    if (r < ZN) {
        ld = INW;
        int c;
        if (r < 6144) c = r; else if (r < 9472) c = r + 16; else if (r < 9488) c = r - 3328; else return nullptr;
        return p->in[I_WIN] + (size_t)l * 1024 * INW + c;
    }
    r -= ZN;
    if (r < 3072) { ld = INW; return p->in[I_WIN] + (size_t)l * 1024 * INW + 9488 + r; }
    r -= 3072;
    if (r < 3072) { ld = 1024; const int br = r >> 10; return p->in[br == 0 ? I_PL : (br == 1 ? I_PG : I_PR)] + (size_t)l * 1024 * 1024 + (r & 1023); }
    r -= 3072;
    if (r < 1024) { ld = 1024; return p->in[I_WOUT] + (size_t)l * 1024 * 1024 + r; }
    r -= 1024;
    ld = 2048; return p->in[I_PWQ] + (size_t)l * 1024 * 2048 + r;
}
__device__ __forceinline__ void stage_wprep(KParams p, char* smem) {
    float* tile = (float*)smem;
    h16_t* WT = (h16_t*)(p->ws + OFF_WT);
    const int tid = tid_();
    const int ntr = WT_ROWS / 64, total = NL_ * ntr * 16;
    for (int it = bid_(); it < total; it += gridDim.x) {
        const int l = it / (ntr * 16), rem = it % (ntr * 16), rt = rem / 16, kt = rem % 16;
        const int r0 = rt * 64, k0 = kt * 64;
        __syncthreads();
        {
            const int nn = tid & 63;
            int ld = 0; const float* src = wt_src(p, l, r0 + nn, ld);
#pragma unroll
            for (int i = 0; i < 8; ++i) { const int kk = (tid >> 6) + 8 * i; tile[kk * 65 + nn] = src ? src[(size_t)(k0 + kk) * ld] : 0.f; }
        }
        __syncthreads();
        {
            const int r = tid >> 3, kq = (tid & 7) * 8;
            float v[8];
#pragma unroll
            for (int j = 0; j < 8; ++j) v[j] = tile[(kq + j) * 65 + r];
            store8h(WT + ((size_t)l * WT_ROWS + r0 + r) * 1024 + k0 + kq, v);
        }
    }
}

namespace pg8 {
constexpr int BM = 256, BK = 64, HALF = 128, HTB = HALF * BK * 2, STAGE_BYTES = 8 * HTB, NXCD = 8, WGM = 8;
struct Unit { const char* A; const char* B; int pm, pn, kind; };
#ifdef CPU_EMU
struct f32x4 { float d[4]; float& operator[](int i) { return d[i]; } const float& operator[](int i) const { return d[i]; } };
#else
#define PG8_LAS __attribute__((address_space(3)))
typedef _Float16 f16x8 __attribute__((ext_vector_type(8)));
typedef float f32x4 __attribute__((ext_vector_type(4)));
__device__ __forceinline__ int lds_byte(int r, int c) { const int st = (r >> 4) * 2 + (c >> 5), rr = r & 15, cc = c & 31, ob = rr * 64 + cc * 2; return st * 1024 + (ob ^ (((ob >> 9) & 1) << 5)); }
__device__ __forceinline__ void stage_rc(int b, int& R, int& C) { const int st = b / 1024, sb = b % 1024, swz = sb ^ (((sb >> 9) & 1) << 5); R = (st >> 1) * 16 + swz / 64; C = (st & 1) * 32 + (swz % 64) / 2; }
__device__ __forceinline__ int perm32(int rho) { const int n = rho >> 4, i = rho & 15; return 8 * (i >> 2) + 4 * n + (i & 3); }
#endif
__device__ __forceinline__ void tile_of(int L, int nM, int nN, int& pm, int& pn) {
    const int nwg = nM * nN;
    int wgid = L; { const int q = nwg / NXCD, r = nwg % NXCD, xcd = wgid % NXCD, off = wgid / NXCD; wgid = (xcd < r ? xcd * (q + 1) : r * (q + 1) + (xcd - r) * q) + off; }
    const int nig = WGM * nN, gid = wgid / nig, fm = gid * WGM, gsz = (nM - fm) < WGM ? (nM - fm) : WGM;
    pm = fm + ((wgid % nig) % gsz); pn = (wgid % nig) / gsz;
}

template <class Sched, class Epi>
__device__ __forceinline__ void gemm_phase(char* smem, const Sched& S, const Epi& E) {
    constexpr int K = 1024, nt = K / BK;
    constexpr unsigned lda = LDZ, ldb = 1024;
#ifdef CPU_EMU
    const int tid = tid_(), wid = tid >> 6, lane = tid & 63, wr = wid >> 2, wc = wid & 3, fr = lane & 15, fq = lane >> 4;
    Unit u;
    for (int ui = 0; S.next(ui, u); ++ui) {
        f32x4 acc[2][2][4][2];
        for (int ai = 0; ai < 2; ++ai) for (int bj = 0; bj < 2; ++bj) for (int m = 0; m < 4; ++m) for (int n = 0; n < 2; ++n) for (int e = 0; e < 4; ++e) {
            const int r = 128 * ai + 64 * wr + 16 * m + fr, c = 128 * bj + 32 * wc + 8 * fq + 4 * n + e;
            const h16_t* a = (const h16_t*)u.A + (size_t)r * lda; const h16_t* b = (const h16_t*)u.B + (size_t)c * ldb;
            float s = 0.f;
            for (int k = 0; k < K; ++k) s += h2f(a[k]) * h2f(b[k]);
            acc[ai][bj][m][n][e] = s;
        }
        E(acc, u, wr, wc, fr, fq);
    }
    (void)smem; (void)nt;
#else
    PG8_LAS unsigned char* lds = (PG8_LAS unsigned char*)smem;
    const int tid = tid_(), wid = __builtin_amdgcn_readfirstlane(tid >> 6), lane = tid & 63, wr = wid >> 2, wc = wid & 3, fr = lane & 15, fq = lane >> 4;
    unsigned voffA[2], voffB[2];
#pragma unroll
    for (int i = 0; i < 2; ++i) { int R, C; stage_rc(tid * 16 + i * 8192, R, C); const int Rb = (R & ~31) + perm32(R & 31);
        voffA[i] = (unsigned)(R * lda + C) * 2u; voffB[i] = (unsigned)(Rb * ldb + C) * 2u; }
    constexpr size_t kstep = (size_t)(BK * 2);
    constexpr size_t hstepA = (size_t)HALF * lda * 2, hstepB = (size_t)HALF * ldb * 2;
    const unsigned ldsw = (unsigned)wid * 1024u;
    const int aoff = lds_byte(wr * 64 + fr, fq * 8), boff = lds_byte(wc * 32 + fr, fq * 8);
#define PG8_SA(b, h) (((b) * 2 + (h)) * HTB)
#define PG8_SB(b, h) ((4 + (b) * 2 + (h)) * HTB)
#define PG8_STAGE(bufoff, gbase, voff) do { _Pragma("unroll") for (int _i = 0; _i < 2; ++_i) \
        __builtin_amdgcn_global_load_lds((const unsigned*)((const char*)(gbase) + (voff)[_i]), (PG8_LAS unsigned*)(lds + (bufoff) + ldsw + _i * 8192), 16, 0, 0); } while (0)
#define PG8_LDA(dst, b, h) do { _Pragma("unroll") for (int m = 0; m < 4; ++m) _Pragma("unroll") for (int k = 0; k < 2; ++k) dst[m][k] = *(const PG8_LAS f16x8*)(lds + PG8_SA(b, h) + aoff + m * 2048 + k * 1024); } while (0)
#define PG8_LDB(dst, b, h) do { _Pragma("unroll") for (int n = 0; n < 2; ++n) _Pragma("unroll") for (int k = 0; k < 2; ++k) dst[n][k] = *(const PG8_LAS f16x8*)(lds + PG8_SB(b, h) + boff + n * 2048 + k * 1024); } while (0)
#define PG8_MMA(ai, bj, At, Bt) do { __builtin_amdgcn_s_setprio(1); _Pragma("unroll") for (int m = 0; m < 4; ++m) _Pragma("unroll") for (int n = 0; n < 2; ++n) _Pragma("unroll") for (int k = 0; k < 2; ++k) \
        acc[ai][bj][m][n] = __builtin_amdgcn_mfma_f32_16x16x32_f16(Bt[n][k], At[m][k], acc[ai][bj][m][n], 0, 0, 0); __builtin_amdgcn_s_setprio(0); } while (0)
#define PG8_WAIT_V(n) asm volatile("s_waitcnt vmcnt(" #n ")" ::: "memory")
#define PG8_WAIT_L(n) asm volatile("s_waitcnt lgkmcnt(" #n ")" ::: "memory")
#define PG8_BAR __builtin_amdgcn_s_barrier()
#define PG8_SCHED __builtin_amdgcn_sched_barrier(0)
    Unit cur, nxt; int ui = 0;
    if (!S.next(0, cur)) return;
    f32x4 acc[2][2][4][2];
#pragma unroll
    for (int a = 0; a < 2; ++a)
#pragma unroll
        for (int b = 0; b < 2; ++b)
#pragma unroll
            for (int m = 0; m < 4; ++m)
#pragma unroll
                for (int n = 0; n < 2; ++n) acc[a][b][m][n] = (f32x4){0.f, 0.f, 0.f, 0.f};
    f16x8 At[4][2], B0[2][2], B1[2][2];
    const char* cA = cur.A; const char* cB = cur.B;
    PG8_STAGE(PG8_SB(0, 0), cB, voffB); PG8_STAGE(PG8_SA(0, 0), cA, voffA); PG8_STAGE(PG8_SB(0, 1), cB + hstepB, voffB); PG8_STAGE(PG8_SA(0, 1), cA + hstepA, voffA);
    if (wr == 1) PG8_BAR;
    PG8_WAIT_V(4); PG8_BAR;
    PG8_STAGE(PG8_SB(1, 0), cB + kstep, voffB); PG8_STAGE(PG8_SA(1, 0), cA + kstep, voffA); PG8_STAGE(PG8_SB(1, 1), cB + hstepB + kstep, voffB);
    PG8_WAIT_V(6); PG8_BAR;
    for (;;) {
        const bool has_next = S.next(ui + 1, nxt);
        const char* nA = has_next ? nxt.A : cA; const char* nB = has_next ? nxt.B : cB;
#pragma unroll 1
        for (int t = 0; t < nt; t += 2) {
            const bool last = (t == nt - 2);
            const char* a1 = cA + (size_t)(t + 1) * kstep;
            const char* a2 = last ? nA : cA + (size_t)(t + 2) * kstep; const char* b2 = last ? nB : cB + (size_t)(t + 2) * kstep;
            const char* a3 = a2 + kstep; const char* b3 = b2 + kstep;
            PG8_LDB(B0, 0, 0); PG8_SCHED; PG8_LDA(At, 0, 0); PG8_STAGE(PG8_SA(1, 1), a1 + hstepA, voffA);
            PG8_WAIT_L(8); PG8_BAR; PG8_WAIT_L(0); PG8_MMA(0, 0, At, B0); PG8_BAR; PG8_SCHED;
            PG8_LDB(B1, 0, 1); PG8_STAGE(PG8_SB(0, 0), b2, voffB);
            PG8_BAR; PG8_WAIT_L(0); PG8_MMA(0, 1, At, B1); PG8_BAR;
            PG8_LDA(At, 0, 1); PG8_STAGE(PG8_SA(0, 0), a2, voffA);
            PG8_BAR; PG8_WAIT_L(0); PG8_MMA(1, 0, At, B0); PG8_BAR; PG8_SCHED;
            PG8_STAGE(PG8_SB(0, 1), b2 + hstepB, voffB);
            PG8_WAIT_V(6); PG8_BAR; PG8_MMA(1, 1, At, B1); PG8_BAR;
            PG8_LDB(B0, 1, 0); PG8_SCHED; PG8_LDA(At, 1, 0); PG8_STAGE(PG8_SA(0, 1), a2 + hstepA, voffA);
            PG8_WAIT_L(8); PG8_BAR; PG8_WAIT_L(0); PG8_MMA(0, 0, At, B0); PG8_BAR; PG8_SCHED;
            PG8_LDB(B1, 1, 1); PG8_STAGE(PG8_SB(1, 0), b3, voffB);
            PG8_BAR; PG8_WAIT_L(0); PG8_MMA(0, 1, At, B1); PG8_BAR;
            PG8_LDA(At, 1, 1); PG8_STAGE(PG8_SA(1, 0), a3, voffA);
            PG8_BAR; PG8_WAIT_L(0); PG8_MMA(1, 0, At, B0); PG8_BAR; PG8_SCHED;
            PG8_STAGE(PG8_SB(1, 1), b3 + hstepB, voffB);
            PG8_WAIT_V(6); PG8_BAR; PG8_MMA(1, 1, At, B1); PG8_BAR;
        }
        E(acc, cur, wr, wc, fr, fq);
        if (!has_next) break;
#pragma unroll
        for (int a = 0; a < 2; ++a)
#pragma unroll
            for (int b = 0; b < 2; ++b)
#pragma unroll
                for (int m = 0; m < 4; ++m)
#pragma unroll
                    for (int n = 0; n < 2; ++n) acc[a][b][m][n] = (f32x4){0.f, 0.f, 0.f, 0.f};
        cur = nxt; cA = nA; cB = nB; ++ui;
    }
    PG8_WAIT_V(0);
    if (wr == 0) PG8_BAR;
    PG8_BAR;
#undef PG8_SA
#undef PG8_SB
#undef PG8_STAGE
#undef PG8_LDA
#undef PG8_LDB
#undef PG8_MMA
#undef PG8_WAIT_V
#undef PG8_WAIT_L
#undef PG8_BAR
#undef PG8_SCHED
#endif
}
}

enum { GK_STORE = 0, GK_GATE0, GK_GATE1, GK_GATE2, GK_PROJ0, GK_PROJ1, GK_PROJ2, GK_RESID };
enum { GP_INPROJ = 0, GP_MERGE, GP_WOUT, GP_QUERY };
struct GemmProg {
    const char* act; const char* wt;
    int which, G, c;
    __device__ __forceinline__ bool next(int i, pg8::Unit& u) const {
        constexpr int nM = M_ / 256;
        constexpr size_t rowA = (size_t)256 * LDZ * 2, rowB = (size_t)256 * 1024 * 2;
        if (which == GP_MERGE) {
            const int L = (i / 6) * G + c, j = i % 6, br = j >> 1;
            if (L >= nM * 4) return false;
            pg8::tile_of(L, nM, 4, u.pm, u.pn);
            if ((j & 1) == 0) { u.A = act + (size_t)C_XN * 2; u.B = wt + ((size_t)(WT_MG + br * 1024) * 1024) * 2; u.kind = GK_GATE0 + br; }
            else { u.A = act + (size_t)(br == 0 ? C_YA : (br == 1 ? C_YB : C_YC)) * 2; u.B = wt + ((size_t)(WT_P + br * 1024) * 1024) * 2; u.kind = GK_PROJ0 + br; }
        } else {
            const int nN = which == GP_INPROJ ? ZN / 256 : (which == GP_WOUT ? 4 : 8);
            const int L = i * G + c;
            if (L >= nM * nN) return false;
            pg8::tile_of(L, nM, nN, u.pm, u.pn);
            u.A = act + (size_t)(which == GP_WOUT ? C_MG : C_XN) * 2;
            u.B = wt + ((size_t)(which == GP_INPROJ ? WT_IN : (which == GP_WOUT ? WT_OUT : WT_Q)) * 1024) * 2;
            u.kind = which == GP_WOUT ? GK_RESID : GK_STORE;
        }
        u.A += (size_t)u.pm * rowA; u.B += (size_t)u.pn * rowB;
        return true;
    }
};
struct GemmEpi {
    h16_t* act; const float* mb; const float* resid; float* out;
    __device__ __forceinline__ void operator()(const pg8::f32x4 (&acc)[2][2][4][2], const pg8::Unit& u, int wr, int wc, int fr, int fq) const {
        const int row0 = u.pm * 256 + wr * 64 + fr, col0 = u.pn * 256 + wc * 32 + 8 * fq;
#pragma unroll
        for (int ai = 0; ai < 2; ++ai)
#pragma unroll
            for (int m = 0; m < 4; ++m) {
                const int row = row0 + ai * 128 + m * 16;
#pragma unroll
                for (int bj = 0; bj < 2; ++bj) {
                    const int col = col0 + bj * 128;
                    float v[8];
#pragma unroll
                    for (int e = 0; e < 4; ++e) { v[e] = acc[ai][bj][m][0][e]; v[4 + e] = acc[ai][bj][m][1][e]; }
                    h16_t* arow = act + (size_t)row * LDZ;
                    if (u.kind == GK_STORE) {
                        store8h(arow + col, v);
                    } else if (u.kind <= GK_GATE2) {
                        const float* bp = mb + (u.kind - GK_GATE0) * 1024 + col;
                        const float4 b0 = *(const float4*)bp, b1 = *(const float4*)(bp + 4);
                        v[0] = sigmoidf_(v[0] + b0.x); v[1] = sigmoidf_(v[1] + b0.y); v[2] = sigmoidf_(v[2] + b0.z); v[3] = sigmoidf_(v[3] + b0.w);
                        v[4] = sigmoidf_(v[4] + b1.x); v[5] = sigmoidf_(v[5] + b1.y); v[6] = sigmoidf_(v[6] + b1.z); v[7] = sigmoidf_(v[7] + b1.w);
                        store8h(arow + C_GS + col, v);
                    } else if (u.kind <= GK_PROJ2) {
                        float g[8]; load8h(arow + C_GS + col, g);
                        if (u.kind == GK_PROJ0) {
#pragma unroll
                            for (int e = 0; e < 8; ++e) v[e] = g[e] * v[e];
                        } else {
                            float o[8]; load8h(arow + C_MG + col, o);
#pragma unroll
                            for (int e = 0; e < 8; ++e) v[e] = o[e] + g[e] * v[e];
                        }
                        store8h(arow + C_MG + col, v);
                    } else {
                        const size_t o = (size_t)row * 1024 + col;
                        const float4 r0 = *(const float4*)(resid + o), r1 = *(const float4*)(resid + o + 4);
                        *(float4*)(out + o) = make_float4(r0.x + v[0], r0.y + v[1], r0.z + v[2], r0.w + v[3]);
                        *(float4*)(out + o + 4) = make_float4(r1.x + v[4], r1.y + v[5], r1.z + v[6], r1.w + v[7]);
                    }
                }
            }
    }
};
__device__ __forceinline__ void stage_gemm(KParams p, int l, int which, char* smem) {
    GemmProg S; S.act = p->ws + OFF_ACT; S.wt = p->ws + OFF_WT + (size_t)l * WT_ROWS * 1024 * 2; S.which = which; S.G = gridDim.x; S.c = bid_();
    GemmEpi E; E.act = (h16_t*)(p->ws + OFF_ACT); E.mb = p->in[I_MB] + l * 3072; E.resid = l == 0 ? p->in[I_X] : p->out; E.out = p->out;
    pg8::gemm_phase(smem, S, E);
}

__device__ __forceinline__ void stage_lru(KParams p, int l, char* smem, int vb0, int nvb) {
    const int vb = bid_() - vb0;
    if (vb < 0 || vb >= nvb) return;
    float* xc_s = (float*)smem; float* gi_s = xc_s + 64; float* wa_s = gi_s + 64; float* wx_s = wa_s + 4096;
    h16_t* Z = (h16_t*)(p->ws + OFF_ACT);
    const int tid = tid_(), j = tid & 63, q = tid >> 6;
    for (int item = vb; item < B_ * 16; item += nvb) {
        const int b = item / 16, n = item % 16, c = n * 64 + j;
        __syncthreads();
        for (int i = tid; i < 4096; i += NT) { wa_s[i] = p->in[I_LWA][((size_t)l * 16 + n) * 4096 + i]; wx_s[i] = p->in[I_LWX][((size_t)l * 16 + n) * 4096 + i]; }
        const float cw0 = p->in[I_LCW][((size_t)l * 4 + 0) * 1024 + c], cw1 = p->in[I_LCW][((size_t)l * 4 + 1) * 1024 + c];
        const float cw2 = p->in[I_LCW][((size_t)l * 4 + 2) * 1024 + c], cw3 = p->in[I_LCW][((size_t)l * 4 + 3) * 1024 + c];
        const float cb = p->in[I_LCB][l * 1024 + c];
        const float bias = q == 0 ? p->in[I_LBA][l * 1024 + c] : p->in[I_LBX][l * 1024 + c];
        const float sp = softplusf_(-p->in[I_LLAM][l * 1024 + c]);
        const float* wsel = q == 0 ? wa_s : wx_s;
        float u1 = 0.f, u2 = 0.f, u3 = 0.f, hst = 0.f, xc = 0.f;
        __syncthreads();
#pragma unroll 1
        for (int t = 0; t < T_; ++t) {
            const size_t m = (size_t)b * T_ + t;
            if (q == 0) {
                const float u0 = h2f(Z[m * LDZ + Z_ULRU + c]);
                xc = cw0 * u3 + cw1 * u2 + cw2 * u1 + cw3 * u0 + cb;
                u3 = u2; u2 = u1; u1 = u0;
                xc_s[j] = xc;
            }
            __syncthreads();
            float val = 0.f;
            if (q < 2) {
                float dot = 0.f;
#pragma unroll 8
                for (int i = 0; i < 64; ++i) dot += xc_s[i] * wsel[i * 64 + j];
                val = sigmoidf_(dot + bias);
                if (q == 1) gi_s[j] = val;
            }
            __syncthreads();
            if (q == 0) {
                const float r = val, ig = gi_s[j];
                const float log_a = -8.0f * r * sp;
                const float a = expf(log_a);
                const float bb = sqrtf(-expm1f(2.0f * log_a)) * (ig * xc);
                hst = a * hst + bb;
                const float g = h2f(Z[m * LDZ + Z_GLRU + c]);
                Z[m * LDZ + Z_GLRU + c] = f2h(hst * geluf_(g));
            }
        }
    }
}

__device__ __forceinline__ void stage_gdn(KParams p, int l, char* smem, int vb0, int nvb) {
    const int vb = bid_() - vb0;
    if (vb < 0 || vb >= nvb) return;
    float* qs = (float*)smem; float* ks = qs + 128; float* vs = ks + 128; float* part = vs + 128; float* part2 = part + 512; float* os = part2 + 512;
    h16_t* Z = (h16_t*)(p->ws + OFF_ACT);
    const int tid = tid_(), v = tid & 127, hf = tid >> 7;
    for (int item = vb; item < B_ * 8; item += nvb) {
        const int b = item / 8, h = item % 8;
        const int ch0 = hf == 1 ? (1024 + h * 128 + v) : (h * 128 + v);
        const int ch1 = 2048 + h * 128 + v;
        float c0w[4], c1w[4];
#pragma unroll
        for (int jj = 0; jj < 4; ++jj) { c0w[jj] = p->in[I_GCW][((size_t)l * 4 + jj) * 3072 + ch0]; c1w[jj] = p->in[I_GCW][((size_t)l * 4 + jj) * 3072 + ch1]; }
        const float a_exp = expf(p->in[I_GALOG][l * 8 + h]), dtb = p->in[I_GDT][l * 8 + h];
        const float nw = p->in[I_GNW][l * 128 + v];
        float S[32];
#pragma unroll
        for (int k = 0; k < 32; ++k) S[k] = 0.f;
        float a1 = 0.f, a2 = 0.f, a3 = 0.f, b1 = 0.f, b2 = 0.f, b3 = 0.f;
        __syncthreads();
#pragma unroll 1
        for (int t = 0; t < T_; ++t) {
            const size_t m = (size_t)b * T_ + t;
            if (hf < 2) {
                const float x0 = h2f(Z[m * LDZ + Z_Q + ch0]);
                const float cv = c0w[0] * a3 + c0w[1] * a2 + c0w[2] * a1 + c0w[3] * x0;
                a3 = a2; a2 = a1; a1 = x0;
                if (hf == 0) qs[v] = siluf_(cv); else ks[v] = siluf_(cv);
                if (hf == 0) {
                    const float y0 = h2f(Z[m * LDZ + Z_Q + ch1]);
                    const float cv1 = c1w[0] * b3 + c1w[1] * b2 + c1w[2] * b1 + c1w[3] * y0;
                    b3 = b2; b2 = b1; b1 = y0;
                    vs[v] = siluf_(cv1);
                }
            }
            __syncthreads();
            float sq = 0.f, sk = 0.f;
            for (int i = 0; i < 128; ++i) { sq += qs[i] * qs[i]; sk += ks[i] * ks[i]; }
            const float rq = rsqrtf(sq + RMS_EPS) * 0.08838834764831845f, rk = rsqrtf(sk + RMS_EPS);
            const float beta = sigmoidf_(h2f(Z[m * LDZ + Z_BETA + h]));
            const float gg = -a_exp * softplusf_(h2f(Z[m * LDZ + Z_ALPHA + h]) + dtb);
            const float eg = expf(gg);
            float pk = 0.f;
#pragma unroll
            for (int k = 0; k < 32; ++k) pk += S[k] * ks[hf * 32 + k];
            part[hf * 128 + v] = pk * rk;
            __syncthreads();
            const float kS = part[v] + part[128 + v] + part[256 + v] + part[384 + v];
            const float cc = beta * (vs[v] - eg * kS) * rk;
            float po = 0.f;
#pragma unroll
            for (int k = 0; k < 32; ++k) { S[k] = eg * S[k] + ks[hf * 32 + k] * cc; po += S[k] * qs[hf * 32 + k]; }
            part2[hf * 128 + v] = po * rq;
            __syncthreads();
            if (hf == 0) os[v] = part2[v] + part2[128 + v] + part2[256 + v] + part2[384 + v];
            __syncthreads();
            if (hf == 0) {
                float ms = 0.f;
                for (int i = 0; i < 128; ++i) ms += os[i] * os[i];
                const float o = os[v] * rsqrtf(ms * (1.0f / 128.0f) + RMS_EPS) * nw;
                const float zg = h2f(Z[m * LDZ + Z_ZG + h * 128 + v]);
                Z[m * LDZ + Z_ZG + h * 128 + v] = f2h(o * siluf_(zg));
            }
        }
    }
}

__device__ __forceinline__ void stage_rwkv(KParams p, int l, char* smem, int vb0, int nvb) {
    const int vb = bid_() - vb0;
    if (vb < 0 || vb >= nvb) return;
    float* zs_s = (float*)smem;
    float* lw = zs_s + 448;
    float* la = lw + 512;
    float* lg = la + 512;
    float* r_s = lg + 512; float* w_s = r_s + 64; float* k2_s = w_s + 64; float* a_s = k2_s + 64; float* gate_s = a_s + 64; float* v_s = gate_s + 64; float* kkr_s = v_s + 64;
    float* part = kkr_s + 64;
    float* part2 = part + 512;
    float* o_s = part2 + 512;
    float* bonp_s = o_s + 64;
    const h16_t* Z = (const h16_t*)(p->ws + OFF_ACT);
    h16_t* YC = (h16_t*)(p->ws + OFF_ACT) + C_YC;
    const int tid = tid_();
    for (int item = vb; item < B_ * 16; item += nvb) {
        const int b = item / 16, h = item % 16;
        int cl = 0;
        {
            const int e = tid;
            if (e < 64) cl = RW_R + h * 64 + e; else if (e < 128) cl = RW_K + h * 64 + (e - 64); else if (e < 192) cl = RW_V + h * 64 + (e - 128);
            else if (e < 256) cl = RW_WL + (e - 192); else if (e < 320) cl = RW_AL + (e - 256); else if (e < 448) cl = RW_GL + (e - 320);
        }
        const float mu = (tid < 448) ? p->in[I_RMU][(size_t)l * RWW + cl] : 0.f;
        float prev = 0.f;
        const int jc = tid & 63, pp = tid >> 6, c = h * 64 + jc;
        const int ri = tid >> 3, q8 = tid & 7;
        const float w0 = p->in[I_RW0][l * 1024 + c], a0 = p->in[I_RA0][l * 1024 + c], k_k = p->in[I_RKK][l * 1024 + c], k_a = p->in[I_RKA][l * 1024 + c];
        const float lnw = p->in[I_RLW][l * 1024 + h * 64 + ri], lnb = p->in[I_RLB][l * 1024 + h * 64 + ri];
        const float* wup = p->in[I_RWUP] + (size_t)l * 64 * 1024; const float* aup = p->in[I_RAUP] + (size_t)l * 64 * 1024; const float* gup = p->in[I_RGUP] + (size_t)l * 128 * 1024;
        const float rk_c = p->in[I_RRK][(size_t)l * 1024 + c];
        float S[8];
#pragma unroll
        for (int e = 0; e < 8; ++e) S[e] = 0.f;
        __syncthreads();
#pragma unroll 1
        for (int t = 0; t < T_; ++t) {
            const size_t m = (size_t)b * T_ + t;
            if (tid < 448) {
                const float zc = h2f(Z[m * LDZ + Z_RW + cl]);
                float zs = zc + mu * (prev - zc);
                prev = zc;
                if (tid >= 192 && tid < 256) zs = tanhf(zs); else if (tid >= 320) zs = sigmoidf_(zs);
                zs_s[tid] = zs;
            }
            __syncthreads();
            {
                float dw = 0.f, da = 0.f, dg = 0.f;
                for (int i = pp * 8; i < pp * 8 + 8; ++i) { dw += zs_s[192 + i] * wup[(size_t)i * 1024 + c]; da += zs_s[256 + i] * aup[(size_t)i * 1024 + c]; }
                for (int i = pp * 16; i < pp * 16 + 16; ++i) dg += zs_s[320 + i] * gup[(size_t)i * 1024 + c];
                lw[pp * 64 + jc] = dw; la[pp * 64 + jc] = da; lg[pp * 64 + jc] = dg;
            }
            __syncthreads();
            if (tid < 64) {
                float wd = 0.f, ad = 0.f, gd = 0.f;
                for (int i = 0; i < 8; ++i) { wd += lw[i * 64 + jc]; ad += la[i * 64 + jc]; gd += lg[i * 64 + jc]; }
                const float w_log = -softplusf_(-(w0 + wd)) - 0.5f;
                const float decay = expf(-expf(w_log));
                const float a = sigmoidf_(a0 + ad);
                const float kx = zs_s[64 + jc];
                r_s[jc] = zs_s[jc]; w_s[jc] = decay; a_s[jc] = a; gate_s[jc] = gd; v_s[jc] = zs_s[128 + jc];
                const float k2v = kx * (1.0f + (a - 1.0f) * k_a);
                kkr_s[jc] = kx * k_k; k2_s[jc] = k2v; bonp_s[jc] = zs_s[jc] * k2v * rk_c;
            }
            __syncthreads();
            float nsq = 0.f, bon = 0.f;
#pragma unroll 8
            for (int i = 0; i < 64; ++i) { nsq += kkr_s[i] * kkr_s[i]; bon += bonp_s[i]; }
            const float nrm = rsqrtf(nsq + RMS_EPS);
            float pk = 0.f;
#pragma unroll
            for (int e = 0; e < 8; ++e) pk += S[e] * (kkr_s[q8 * 8 + e] * nrm);
            part[ri * 8 + q8] = pk;
            __syncthreads();
            float skk = 0.f;
            for (int i = 0; i < 8; ++i) skk += part[ri * 8 + i];
            const float vi = v_s[ri];
            float po = 0.f;
#pragma unroll
            for (int e = 0; e < 8; ++e) {
                const int jj = q8 * 8 + e;
                const float kkj = kkr_s[jj] * nrm;
                S[e] = S[e] * w_s[jj] - skk * (kkj * a_s[jj]) + vi * k2_s[jj];
                po += S[e] * r_s[jj];
            }
            part2[ri * 8 + q8] = po;
            __syncthreads();
            if (q8 == 0) { float o = 0.f; for (int i = 0; i < 8; ++i) o += part2[ri * 8 + i]; o_s[ri] = o; }
            __syncthreads();
            if (q8 == 0) {
                float mean = 0.f;
#pragma unroll 8
                for (int i = 0; i < 64; ++i) mean += o_s[i];
                mean *= (1.0f / 64.0f);
                float var = 0.f;
#pragma unroll 8
                for (int i = 0; i < 64; ++i) { const float d = o_s[i] - mean; var += d * d; }
                var *= (1.0f / 64.0f);
                const float o = (o_s[ri] - mean) * rsqrtf(var + GN_EPS) * lnw + lnb;
                YC[m * LDZ + h * 64 + ri] = f2h((o + bon * vi) * gate_s[ri]);
            }
        }
    }
}

__device__ __forceinline__ void stage_peer_topk(KParams p, int l, char* smem) {
    const int tid = tid_(), sub = tid >> 8, lt = tid & 255;
    float* q_s = (float*)smem + sub * 1024; float* sc = q_s + 256; float* top_s = sc + 256; int* top_i = (int*)(top_s + 32); float* cand = (float*)(top_i + 32);
    float* best_s = cand + 256; int* best_e = (int*)(best_s + 16);
    const h16_t* Q = (const h16_t*)(p->ws + OFF_ACT) + C_QRY;
    int* IDX = (int*)(p->ws + OFF_IDX); float* GT = (float*)(p->ws + OFF_GT);
    const int s = lt >> 7, n = lt & 127;
    for (int item = bid_(); item < M_ * 4; item += gridDim.x) {
        const int m = item >> 2, hd = (item & 3) * 2 + sub;
        __syncthreads();
        q_s[lt] = h2f(Q[(size_t)m * LDZ + hd * 256 + lt]);
        __syncthreads();
        const float* key = p->in[I_PKEYS] + ((((size_t)l * 8 + hd) * 2 + s) * 128 + n) * 128;
        float dot = 0.f;
        for (int cix = 0; cix < 128; ++cix) dot += q_s[s * 128 + cix] * key[cix];
        sc[lt] = dot;
        __syncthreads();
        int cnt = 0;
        for (int jj = 0; jj < 128; ++jj) { const float o = sc[s * 128 + jj]; cnt += (o > dot || (o == dot && jj < n)) ? 1 : 0; }
        if (cnt < 16) { top_s[s * 16 + cnt] = dot; top_i[s * 16 + cnt] = n; }
        __syncthreads();
        const int ci = lt >> 4, cj = lt & 15;
        const float cs = top_s[ci] + top_s[16 + cj];
        cand[lt] = cs;
        __syncthreads();
        int cnt2 = 0;
        for (int jj = 0; jj < 256; ++jj) { const float o = cand[jj]; cnt2 += (o > cs || (o == cs && jj < lt)) ? 1 : 0; }
        if (cnt2 < 16) { best_s[cnt2] = cs; best_e[cnt2] = top_i[ci] * 128 + top_i[16 + cj]; }
        __syncthreads();
        if (lt < 16) {
            const float mx = best_s[0];
            float sum = 0.f;
            for (int i = 0; i < 16; ++i) sum += expf(best_s[i] - mx);
            IDX[(size_t)m * 128 + hd * 16 + lt] = best_e[lt];
            GT[(size_t)m * 128 + hd * 16 + lt] = expf(best_s[lt] - mx) / sum;
        }
    }
}

__device__ __forceinline__ void stage_peer_gather(KParams p, int l, char* smem) {
    float* x_s = (float*)smem; float* hid = x_s + 1024; float* gate_s = hid + 128; int* idx_s = (int*)(gate_s + 128); float* red = (float*)(idx_s + 128);
    const h16_t* XN = (const h16_t*)(p->ws + OFF_ACT) + C_XN;
    const int* IDX = (const int*)(p->ws + OFF_IDX); const float* GT = (const float*)(p->ws + OFF_GT);
    const float* U = p->in[I_PU] + (size_t)l * 16384 * 1024; const float* V = p->in[I_PV] + (size_t)l * 16384 * 1024;
    const int tid = tid_(), w = tid >> 6, lane = tid & 63;
    for (int m = bid_(); m < M_; m += gridDim.x) {
        __syncthreads();
        for (int i = 0; i < 2; ++i) x_s[tid * 2 + i] = h2f(XN[(size_t)m * LDZ + tid * 2 + i]);
        if (tid < 128) { idx_s[tid] = IDX[(size_t)m * 128 + tid]; gate_s[tid] = GT[(size_t)m * 128 + tid]; }
        __syncthreads();
        for (int e = w; e < 128; e += 8) {
            const float* row = U + (size_t)idx_s[e] * 1024;
            float part = 0.f;
#pragma unroll
            for (int k = 0; k < 4; ++k) {
                const float4 uv = *(const float4*)(row + (k * 64 + lane) * 4);
                const float* xp = x_s + (k * 64 + lane) * 4;
                part += uv.x * xp[0] + uv.y * xp[1] + uv.z * xp[2] + uv.w * xp[3];
            }
            red[tid] = part;
            __syncthreads();
            if (lane == 0) { float sm = 0.f; for (int i = 0; i < 64; ++i) sm += red[w * 64 + i]; hid[e] = gate_s[e] * geluf_(sm); }
            __syncthreads();
        }
        float a0 = 0.f, a1 = 0.f;
        for (int e = 0; e < 128; ++e) {
            const float2 vv = *(const float2*)(V + (size_t)idx_s[e] * 1024 + tid * 2);
            const float hh = hid[e];
            a0 += hh * vv.x; a1 += hh * vv.y;
        }
        float2* op = (float2*)(p->out + (size_t)m * 1024 + tid * 2);
        float2 ov = *op;
        ov.x += a0; ov.y += a1;
        *op = ov;
    }
}

enum { PH_NORM_MIX = 0, PH_INPROJ, PH_MIXERS, PH_MERGE, PH_WOUT, PH_NORM_FFN, PH_QUERY, PH_TOPK, PH_GATHER, PH_PER_LAYER, PH_FINAL = 100, PH_WPREP = 101 };
__device__ __forceinline__ void run_phase(KParams p, int l, int ph, char* smem) {
    h16_t* ACT = (h16_t*)(p->ws + OFF_ACT);
    const float* hin = l == 0 ? p->in[I_X] : p->out;
    switch (ph) {
    case PH_WPREP: stage_wprep(p, smem); break;
    case PH_NORM_MIX: stage_rmsnorm<false>(hin, p->in[I_NMIX] + l * 1024, ACT + C_XN, LDZ, smem); break;
    case PH_INPROJ: stage_gemm(p, l, GP_INPROJ, smem); break;
    case PH_MIXERS: {
        const int nb = gridDim.x, n_rw = nb / 2, n_gd = nb / 4, n_lr = nb - n_rw - n_gd;
        stage_rwkv(p, l, smem, 0, n_rw);
        stage_gdn(p, l, smem, n_rw, n_gd);
        stage_lru(p, l, smem, n_rw + n_gd, n_lr);
    } break;
    case PH_MERGE: stage_gemm(p, l, GP_MERGE, smem); break;
    case PH_WOUT: stage_gemm(p, l, GP_WOUT, smem); break;
    case PH_NORM_FFN: stage_rmsnorm<false>(p->out, p->in[I_NFFN] + l * 1024, ACT + C_XN, LDZ, smem); break;
    case PH_QUERY: stage_gemm(p, l, GP_QUERY, smem); break;
    case PH_TOPK: stage_peer_topk(p, l, smem); break;
    case PH_GATHER: stage_peer_gather(p, l, smem); break;
    case PH_FINAL: stage_rmsnorm<true>(p->out, p->in[I_NFINAL], p->out, 1024, smem); break;
    default: break;
    }
}

#if !defined(CPU_EMU) && !MK_MULTI
__global__ void __launch_bounds__(512, 2) k_mega(Params p_) {
    DYN_SMEM(smem);
    KParams pk = (KParams)__builtin_amdgcn_kernarg_segment_ptr();
    cg::grid_group grid = cg::this_grid();
    constexpr int NIT = NL_ * PH_PER_LAYER;
#pragma unroll 1
    for (int it = -1; it <= NIT; ++it) {
        const int l = (it >= 0 && it < NIT) ? it / PH_PER_LAYER : 0, ph = it < 0 ? (int)PH_WPREP : (it < NIT ? it % PH_PER_LAYER : (int)PH_FINAL);
        KParams q = pk; asm volatile("" : "+s"(q));
        run_phase(q, l, ph, smem);
        if (it < NIT && !(it < 0)) grid.sync();
    }
}
#endif
#ifdef CPU_EMU
__global__ void k_phase(Params p_, int l, int ph) { DYN_SMEM(smem); run_phase(&p_, l, ph, smem); }
#elif MK_MULTI
__global__ void __launch_bounds__(512, 2) k_phase(Params p_, int l, int ph) { DYN_SMEM(smem); KParams pk = (KParams)__builtin_amdgcn_kernarg_segment_ptr(); run_phase(pk, l, ph, smem); }
#endif
}

#ifdef CPU_EMU
int g_emu_stop = 1000;
#endif

extern "C" void kernel_launch(void* const* d_in, const int* in_sizes, int n_in, void* d_out, int out_size, void* d_ws, size_t ws_size, hipStream_t stream) {
    Params p{};
    for (int i = 0; i < N_IN; ++i) p.in[i] = (const float*)d_in[i];
    p.out = (float*)d_out; p.ws = (char*)d_ws;
#if defined(CPU_EMU) || MK_MULTI
    const int grid = 256;
    LAUNCH(k_phase, grid, NT, SMEM_BYTES, stream, p, 0, (int)PH_WPREP);
    for (int l = 0; l < NL_; ++l)
        for (int ph = 0; ph < PH_PER_LAYER; ++ph) {
            LAUNCH(k_phase, grid, NT, SMEM_BYTES, stream, p, l, ph);
#ifdef CPU_EMU
            const int code = ph == PH_INPROJ ? 1 : ph == PH_MIXERS ? 2 : ph == PH_MERGE ? 3 : ph == PH_WOUT ? 4 : ph == PH_GATHER ? 5 : 0;
            if (code && g_emu_stop == l * 10 + code) return;
#endif
        }
    LAUNCH(k_phase, grid, NT, SMEM_BYTES, stream, p, 0, (int)PH_FINAL);
#else
    static int grid_blocks = 0;
    if (!grid_blocks) {
        int dev = 0, cus = 0, per_cu = 0;
        (void)hipGetDevice(&dev);
        (void)hipDeviceGetAttribute(&cus, hipDeviceAttributeMultiprocessorCount, dev);
        (void)hipFuncSetAttribute((const void*)k_mega, hipFuncAttributeMaxDynamicSharedMemorySize, (int)SMEM_BYTES);
        (void)hipOccupancyMaxActiveBlocksPerMultiprocessor(&per_cu, k_mega, NT, SMEM_BYTES);
        if (per_cu > 1) per_cu = 1;
        grid_blocks = cus * per_cu;
    }
    void* args[] = {&p};
    hipError_t e = hipLaunchCooperativeKernel((void*)k_mega, dim3(grid_blocks), dim3(NT), args, SMEM_BYTES, stream);
    if (e != hipSuccess) fprintf(stderr, "cooperative launch failed: %s (grid %d)\n", hipGetErrorString(e), grid_blocks);
#endif
}
```

```cpp
#ifndef CPU_EMU
#include <hip/hip_runtime.h>
#include <hip/hip_cooperative_groups.h>
#include <cstdio>
#include <cstdint>
namespace cg = cooperative_groups;
#define DYN_SMEM(name) extern __shared__ __attribute__((aligned(16))) char name[]
#define LAUNCH(kern, grid, block, smem, stream, ...) hipLaunchKernelGGL(kern, dim3(grid), dim3(block), smem, stream, __VA_ARGS__)
#endif

#ifndef CFG_B
#define CFG_B 8
#endif
#ifndef CFG_T
#define CFG_T 2048
#endif
#ifndef MK_MULTI
#define MK_MULTI 0
#endif

namespace {
constexpr int B_ = CFG_B, T_ = CFG_T, M_ = B_ * T_, D_ = 1024, NL_ = 2, NT = 512;
constexpr int INW = 12560;
constexpr int LDZ = 11776;
constexpr int Z_ULRU = 0, Z_GLRU = 1024, Z_Q = 2048, Z_K = 3072, Z_V = 4096, Z_ZG = 5120, Z_RW = 6144, Z_ALPHA = 9472, Z_BETA = 9480;
constexpr int ZN = 9728;
constexpr int C_XN = 9728, C_YC = 10752;
constexpr int C_YA = Z_GLRU, C_YB = Z_ZG;
constexpr int C_GS = Z_Q, C_MG = Z_K;
constexpr int C_QRY = 0;
constexpr int RW_R = 0, RW_K = 1024, RW_V = 2048, RW_WL = 3072, RW_AL = 3136, RW_GL = 3200, RWW = 3328;
constexpr float RMS_EPS = 1e-6f, GN_EPS = 64e-5f;
typedef unsigned short h16_t;

enum { I_X = 0, I_NMIX, I_NFFN, I_NFINAL, I_WIN, I_LCW, I_LCB, I_LWA, I_LBA, I_LWX, I_LBX, I_LLAM, I_GCW, I_GALOG, I_GDT, I_GNW,
       I_RMU, I_RW0, I_RWUP, I_RA0, I_RAUP, I_RGUP, I_RKK, I_RKA, I_RRK, I_RLW, I_RLB, I_MB, I_PL, I_PG, I_PR, I_WOUT, I_PWQ, I_PKEYS, I_PU, I_PV, N_IN };

struct Params {
    const float* in[N_IN];
    float* out;
    char* ws;
};
#ifdef CPU_EMU
typedef const Params* KParams;
#else
typedef const Params __attribute__((address_space(4)))* KParams;
#endif

constexpr size_t al256(size_t x) { return (x + 255) / 256 * 256; }
constexpr size_t OFF_ACT = 0;
constexpr size_t OFF_WT = al256(OFF_ACT + (size_t)M_ * LDZ * 2);
constexpr int WT_IN = 0, WT_MG = ZN, WT_P = WT_MG + 3072, WT_OUT = WT_P + 3072, WT_Q = WT_OUT + 1024, WT_ROWS = WT_Q + 2048;
constexpr size_t OFF_IDX = al256(OFF_WT + (size_t)NL_ * WT_ROWS * 1024 * 2);
constexpr size_t OFF_GT = al256(OFF_IDX + (size_t)M_ * 128 * 4);
constexpr size_t WS_END = al256(OFF_GT + (size_t)M_ * 128 * 4);
static_assert(CFG_B != 8 || CFG_T != 2048 || WS_END <= (size_t)512 * 1024 * 1024, "workspace budget");
constexpr size_t SMEM_BYTES = 128 * 1024;

#ifdef CPU_EMU
__device__ __forceinline__ int tid_() { return threadIdx.x; }
__device__ __forceinline__ h16_t f2h(float f) { return (h16_t)_cvtss_sh(f, _MM_FROUND_TO_NEAREST_INT); }
__device__ __forceinline__ float h2f(h16_t h) { return _cvtsh_ss(h); }
#else
__device__ __forceinline__ int tid_() { int t = threadIdx.x; asm volatile("" : "+v"(t)); return t; }
__device__ __forceinline__ h16_t f2h(float f) { return __builtin_bit_cast(unsigned short, (_Float16)f); }
__device__ __forceinline__ float h2f(h16_t h) { return (float)__builtin_bit_cast(_Float16, h); }
#endif
__device__ __forceinline__ int bid_() { return (int)blockIdx.x; }

__device__ __forceinline__ float sigmoidf_(float x) { return 1.0f / (1.0f + expf(-x)); }
__device__ __forceinline__ float softplusf_(float x) { return fmaxf(x, 0.0f) + log1pf(expf(-fabsf(x))); }
__device__ __forceinline__ float siluf_(float x) { return x * sigmoidf_(x); }
__device__ __forceinline__ float geluf_(float x) { return 0.5f * x * (1.0f + tanhf(0.7978845608028654f * (x + 0.044715f * x * x * x))); }
__device__ __forceinline__ unsigned pack2h(float a, float b) { return (unsigned)f2h(a) | ((unsigned)f2h(b) << 16); }
__device__ __forceinline__ void store8h(h16_t* p, const float (&v)[8]) {
    uint4 w; w.x = pack2h(v[0], v[1]); w.y = pack2h(v[2], v[3]); w.z = pack2h(v[4], v[5]); w.w = pack2h(v[6], v[7]);
    *(uint4*)p = w;
}
__device__ __forceinline__ void load8h(const h16_t* p, float (&v)[8]) {
    const uint4 w = *(const uint4*)p;
    v[0] = h2f((h16_t)(w.x & 0xffffu)); v[1] = h2f((h16_t)(w.x >> 16)); v[2] = h2f((h16_t)(w.y & 0xffffu)); v[3] = h2f((h16_t)(w.y >> 16));
    v[4] = h2f((h16_t)(w.z & 0xffffu)); v[5] = h2f((h16_t)(w.z >> 16)); v[6] = h2f((h16_t)(w.w & 0xffffu)); v[7] = h2f((h16_t)(w.w >> 16));
}

__device__ __forceinline__ float block_sum512(float v, float* red) {
    const int tid = tid_();
    red[tid] = v;
    __syncthreads();
    if (tid < 32) { float s = 0.f; for (int i = 0; i < 16; ++i) s += red[tid * 16 + i]; red[512 + tid] = s; }
    __syncthreads();
    float tot = 0.f;
    for (int i = 0; i < 32; ++i) tot += red[512 + i];
    __syncthreads();
    return tot;
}

template <bool OUT_F32>
__device__ __forceinline__ void stage_rmsnorm(const float* src, const float* w, void* dst, int ldd, char* smem) {
    float* red = (float*)smem;
    const int tid = tid_();
    for (int row = bid_(); row < M_; row += gridDim.x) {
        const float2 v = *(const float2*)(src + (size_t)row * D_ + tid * 2);
        const float ss = block_sum512(v.x * v.x + v.y * v.y, red);
        const float rstd = rsqrtf(ss * (1.0f / D_) + RMS_EPS);
        const float2 wv = *(const float2*)(w + tid * 2);
        const float o0 = v.x * rstd * wv.x, o1 = v.y * rstd * wv.y;
        if (OUT_F32) {
            float2 o; o.x = o0; o.y = o1;
            *(float2*)((float*)dst + (size_t)row * ldd + tid * 2) = o;
        } else {
            *(unsigned*)((h16_t*)dst + (size_t)row * ldd + tid * 2) = pack2h(o0, o1);
        }
    }
}

__device__ __forceinline__ const float* wt_src(KParams p, int l, int r, int& ld) {
    if (r < ZN) {
        ld = INW;
        int c;
        if (r < 6144) c = r; else if (r < 9472) c = r + 16; else if (r < 9488) c = r - 3328; else return nullptr;
        return p->in[I_WIN] + (size_t)l * 1024 * INW + c;
    }
    r -= ZN;
    if (r < 3072) { ld = INW; return p->in[I_WIN] + (size_t)l * 1024 * INW + 9488 + r; }
    r -= 3072;
    if (r < 3072) { ld = 1024; const int br = r >> 10; return p->in[br == 0 ? I_PL : (br == 1 ? I_PG : I_PR)] + (size_t)l * 1024 * 1024 + (r & 1023); }
    r -= 3072;
    if (r < 1024) { ld = 1024; return p->in[I_WOUT] + (size_t)l * 1024 * 1024 + r; }
    r -= 1024;
    ld = 2048; return p->in[I_PWQ] + (size_t)l * 1024 * 2048 + r;
}
__device__ __forceinline__ void stage_wprep(KParams p, char* smem) {
    float* tile = (float*)smem;
    h16_t* WT = (h16_t*)(p->ws + OFF_WT);
    const int tid = tid_();
    const int ntr = WT_ROWS / 64, total = NL_ * ntr * 16;
    for (int it = bid_(); it < total; it += gridDim.x) {
        const int l = it / (ntr * 16), rem = it % (ntr * 16), rt = rem / 16, kt = rem % 16;
        const int r0 = rt * 64, k0 = kt * 64;
        __syncthreads();
        {
            const int nn = tid & 63;
            int ld = 0; const float* src = wt_src(p, l, r0 + nn, ld);
#pragma unroll
            for (int i = 0; i < 8; ++i) { const int kk = (tid >> 6) + 8 * i; tile[kk * 65 + nn] = src ? src[(size_t)(k0 + kk) * ld] : 0.f; }
        }
        __syncthreads();
        {
            const int r = tid >> 3, kq = (tid & 7) * 8;
            float v[8];
#pragma unroll
            for (int j = 0; j < 8; ++j) v[j] = tile[(kq + j) * 65 + r];
            store8h(WT + ((size_t)l * WT_ROWS + r0 + r) * 1024 + k0 + kq, v);
        }
    }
}

namespace pg8 {
constexpr int BM = 256, BK = 64, HALF = 128, HTB = HALF * BK * 2, STAGE_BYTES = 8 * HTB, NXCD = 8, WGM = 8;
struct Unit { const char* A; const char* B; int pm, pn, kind; };
#ifdef CPU_EMU
struct f32x4 { float d[4]; float& operator[](int i) { return d[i]; } const float& operator[](int i) const { return d[i]; } };
#else
#define PG8_LAS __attribute__((address_space(3)))
typedef _Float16 f16x8 __attribute__((ext_vector_type(8)));
typedef float f32x4 __attribute__((ext_vector_type(4)));
__device__ __forceinline__ int lds_byte(int r, int c) { const int st = (r >> 4) * 2 + (c >> 5), rr = r & 15, cc = c & 31, ob = rr * 64 + cc * 2; return st * 1024 + (ob ^ (((ob >> 9) & 1) << 5)); }
__device__ __forceinline__ void stage_rc(int b, int& R, int& C) { const int st = b / 1024, sb = b % 1024, swz = sb ^ (((sb >> 9) & 1) << 5); R = (st >> 1) * 16 + swz / 64; C = (st & 1) * 32 + (swz % 64) / 2; }
__device__ __forceinline__ int perm32(int rho) { const int n = rho >> 4, i = rho & 15; return 8 * (i >> 2) + 4 * n + (i & 3); }
#endif
__device__ __forceinline__ void tile_of(int L, int nM, int nN, int& pm, int& pn) {
    const int nwg = nM * nN;
    int wgid = L; { const int q = nwg / NXCD, r = nwg % NXCD, xcd = wgid % NXCD, off = wgid / NXCD; wgid = (xcd < r ? xcd * (q + 1) : r * (q + 1) + (xcd - r) * q) + off; }
    const int nig = WGM * nN, gid = wgid / nig, fm = gid * WGM, gsz = (nM - fm) < WGM ? (nM - fm) : WGM;
    pm = fm + ((wgid % nig) % gsz); pn = (wgid % nig) / gsz;
}

template <class Sched, class Epi>
__device__ __forceinline__ void gemm_phase(char* smem, const Sched& S, const Epi& E) {
    constexpr int K = 1024, nt = K / BK;
    constexpr unsigned lda = LDZ, ldb = 1024;
#ifdef CPU_EMU
    const int tid = tid_(), wid = tid >> 6, lane = tid & 63, wr = wid >> 2, wc = wid & 3, fr = lane & 15, fq = lane >> 4;
    Unit u;
    for (int ui = 0; S.next(ui, u); ++ui) {
        f32x4 acc[2][2][4][2];
        for (int ai = 0; ai < 2; ++ai) for (int bj = 0; bj < 2; ++bj) for (int m = 0; m < 4; ++m) for (int n = 0; n < 2; ++n) for (int e = 0; e < 4; ++e) {
            const int r = 128 * ai + 64 * wr + 16 * m + fr, c = 128 * bj + 32 * wc + 8 * fq + 4 * n + e;
            const h16_t* a = (const h16_t*)u.A + (size_t)r * lda; const h16_t* b = (const h16_t*)u.B + (size_t)c * ldb;
            float s = 0.f;
            for (int k = 0; k < K; ++k) s += h2f(a[k]) * h2f(b[k]);
            acc[ai][bj][m][n][e] = s;
        }
        E(acc, u, wr, wc, fr, fq);
    }
    (void)smem; (void)nt;
#else
    PG8_LAS unsigned char* lds = (PG8_LAS unsigned char*)smem;
    const int tid = tid_(), wid = __builtin_amdgcn_readfirstlane(tid >> 6), lane = tid & 63, wr = wid >> 2, wc = wid & 3, fr = lane & 15, fq = lane >> 4;
    unsigned voffA[2], voffB[2];
#pragma unroll
    for (int i = 0; i < 2; ++i) { int R, C; stage_rc(tid * 16 + i * 8192, R, C); const int Rb = (R & ~31) + perm32(R & 31);
        voffA[i] = (unsigned)(R * lda + C) * 2u; voffB[i] = (unsigned)(Rb * ldb + C) * 2u; }
    constexpr size_t kstep = (size_t)(BK * 2);
    constexpr size_t hstepA = (size_t)HALF * lda * 2, hstepB = (size_t)HALF * ldb * 2;
    const unsigned ldsw = (unsigned)wid * 1024u;
    const int aoff = lds_byte(wr * 64 + fr, fq * 8), boff = lds_byte(wc * 32 + fr, fq * 8);
#define PG8_SA(b, h) (((b) * 2 + (h)) * HTB)
#define PG8_SB(b, h) ((4 + (b) * 2 + (h)) * HTB)
#define PG8_STAGE(bufoff, gbase, voff) do { _Pragma("unroll") for (int _i = 0; _i < 2; ++_i) \
        __builtin_amdgcn_global_load_lds((const unsigned*)((const char*)(gbase) + (voff)[_i]), (PG8_LAS unsigned*)(lds + (bufoff) + ldsw + _i * 8192), 16, 0, 0); } while (0)
#define PG8_LDA(dst, b, h) do { _Pragma("unroll") for (int m = 0; m < 4; ++m) _Pragma("unroll") for (int k = 0; k < 2; ++k) dst[m][k] = *(const PG8_LAS f16x8*)(lds + PG8_SA(b, h) + aoff + m * 2048 + k * 1024); } while (0)
#define PG8_LDB(dst, b, h) do { _Pragma("unroll") for (int n = 0; n < 2; ++n) _Pragma("unroll") for (int k = 0; k < 2; ++k) dst[n][k] = *(const PG8_LAS f16x8*)(lds + PG8_SB(b, h) + boff + n * 2048 + k * 1024); } while (0)
#define PG8_MMA(ai, bj, At, Bt) do { __builtin_amdgcn_s_setprio(1); _Pragma("unroll") for (int m = 0; m < 4; ++m) _Pragma("unroll") for (int n = 0; n < 2; ++n) _Pragma("unroll") for (int k = 0; k < 2; ++k) \
        acc[ai][bj][m][n] = __builtin_amdgcn_mfma_f32_16x16x32_f16(Bt[n][k], At[m][k], acc[ai][bj][m][n], 0, 0, 0); __builtin_amdgcn_s_setprio(0); } while (0)
#define PG8_WAIT_V(n) asm volatile("s_waitcnt vmcnt(" #n ")" ::: "memory")
#define PG8_WAIT_L(n) asm volatile("s_waitcnt lgkmcnt(" #n ")" ::: "memory")
#define PG8_BAR __builtin_amdgcn_s_barrier()
#define PG8_SCHED __builtin_amdgcn_sched_barrier(0)
    Unit cur, nxt; int ui = 0;
    if (!S.next(0, cur)) return;
    f32x4 acc[2][2][4][2];
#pragma unroll
    for (int a = 0; a < 2; ++a)
#pragma unroll
        for (int b = 0; b < 2; ++b)
#pragma unroll
            for (int m = 0; m < 4; ++m)
#pragma unroll
                for (int n = 0; n < 2; ++n) acc[a][b][m][n] = (f32x4){0.f, 0.f, 0.f, 0.f};
    f16x8 At[4][2], B0[2][2], B1[2][2];
    const char* cA = cur.A; const char* cB = cur.B;
    PG8_STAGE(PG8_SB(0, 0), cB, voffB); PG8_STAGE(PG8_SA(0, 0), cA, voffA); PG8_STAGE(PG8_SB(0, 1), cB + hstepB, voffB); PG8_STAGE(PG8_SA(0, 1), cA + hstepA, voffA);
    if (wr == 1) PG8_BAR;
    PG8_WAIT_V(4); PG8_BAR;
    PG8_STAGE(PG8_SB(1, 0), cB + kstep, voffB); PG8_STAGE(PG8_SA(1, 0), cA + kstep, voffA); PG8_STAGE(PG8_SB(1, 1), cB + hstepB + kstep, voffB);
    PG8_WAIT_V(6); PG8_BAR;
    for (;;) {
        const bool has_next = S.next(ui + 1, nxt);
        const char* nA = has_next ? nxt.A : cA; const char* nB = has_next ? nxt.B : cB;
#pragma unroll 1
        for (int t = 0; t < nt; t += 2) {
            const bool last = (t == nt - 2);
            const char* a1 = cA + (size_t)(t + 1) * kstep;
            const char* a2 = last ? nA : cA + (size_t)(t + 2) * kstep; const char* b2 = last ? nB : cB + (size_t)(t + 2) * kstep;
            const char* a3 = a2 + kstep; const char* b3 = b2 + kstep;
            PG8_LDB(B0, 0, 0); PG8_SCHED; PG8_LDA(At, 0, 0); PG8_STAGE(PG8_SA(1, 1), a1 + hstepA, voffA);
            PG8_WAIT_L(8); PG8_BAR; PG8_WAIT_L(0); PG8_MMA(0, 0, At, B0); PG8_BAR; PG8_SCHED;
            PG8_LDB(B1, 0, 1); PG8_STAGE(PG8_SB(0, 0), b2, voffB);
            PG8_BAR; PG8_WAIT_L(0); PG8_MMA(0, 1, At, B1); PG8_BAR;
            PG8_LDA(At, 0, 1); PG8_STAGE(PG8_SA(0, 0), a2, voffA);
            PG8_BAR; PG8_WAIT_L(0); PG8_MMA(1, 0, At, B0); PG8_BAR; PG8_SCHED;
            PG8_STAGE(PG8_SB(0, 1), b2 + hstepB, voffB);
            PG8_WAIT_V(6); PG8_BAR; PG8_MMA(1, 1, At, B1); PG8_BAR;
            PG8_LDB(B0, 1, 0); PG8_SCHED; PG8_LDA(At, 1, 0); PG8_STAGE(PG8_SA(0, 1), a2 + hstepA, voffA);
            PG8_WAIT_L(8); PG8_BAR; PG8_WAIT_L(0); PG8_MMA(0, 0, At, B0); PG8_BAR; PG8_SCHED;
            PG8_LDB(B1, 1, 1); PG8_STAGE(PG8_SB(1, 0), b3, voffB);
            PG8_BAR; PG8_WAIT_L(0); PG8_MMA(0, 1, At, B1); PG8_BAR;
            PG8_LDA(At, 1, 1); PG8_STAGE(PG8_SA(1, 0), a3, voffA);
            PG8_BAR; PG8_WAIT_L(0); PG8_MMA(1, 0, At, B0); PG8_BAR; PG8_SCHED;
            PG8_STAGE(PG8_SB(1, 1), b3 + hstepB, voffB);
            PG8_WAIT_V(6); PG8_BAR; PG8_MMA(1, 1, At, B1); PG8_BAR;
        }
        E(acc, cur, wr, wc, fr, fq);
        if (!has_next) break;
#pragma unroll
        for (int a = 0; a < 2; ++a)
#pragma unroll
            for (int b = 0; b < 2; ++b)
#pragma unroll
                for (int m = 0; m < 4; ++m)
#pragma unroll
                    for (int n = 0; n < 2; ++n) acc[a][b][m][n] = (f32x4){0.f, 0.f, 0.f, 0.f};
        cur = nxt; cA = nA; cB = nB; ++ui;
    }
    PG8_WAIT_V(0);
    if (wr == 0) PG8_BAR;
    PG8_BAR;
#undef PG8_SA
#undef PG8_SB
#undef PG8_STAGE
#undef PG8_LDA
#undef PG8_LDB
#undef PG8_MMA
#undef PG8_WAIT_V
#undef PG8_WAIT_L
#undef PG8_BAR
#undef PG8_SCHED
#endif
}
}

enum { GK_STORE = 0, GK_GATE0, GK_GATE1, GK_GATE2, GK_PROJ0, GK_PROJ1, GK_PROJ2, GK_RESID };
enum { GP_INPROJ = 0, GP_MERGE, GP_WOUT, GP_QUERY };
struct GemmProg {
    const char* act; const char* wt;
    int which, G, c;
    __device__ __forceinline__ bool next(int i, pg8::Unit& u) const {
        constexpr int nM = M_ / 256;
        constexpr size_t rowA = (size_t)256 * LDZ * 2, rowB = (size_t)256 * 1024 * 2;
        if (which == GP_MERGE) {
            const int L = (i / 6) * G + c, j = i % 6, br = j >> 1;
            if (L >= nM * 4) return false;
            pg8::tile_of(L, nM, 4, u.pm, u.pn);
            if ((j & 1) == 0) { u.A = act + (size_t)C_XN * 2; u.B = wt + ((size_t)(WT_MG + br * 1024) * 1024) * 2; u.kind = GK_GATE0 + br; }
            else { u.A = act + (size_t)(br == 0 ? C_YA : (br == 1 ? C_YB : C_YC)) * 2; u.B = wt + ((size_t)(WT_P + br * 1024) * 1024) * 2; u.kind = GK_PROJ0 + br; }
        } else {
            const int nN = which == GP_INPROJ ? ZN / 256 : (which == GP_WOUT ? 4 : 8);
            const int L = i * G + c;
            if (L >= nM * nN) return false;
            pg8::tile_of(L, nM, nN, u.pm, u.pn);
            u.A = act + (size_t)(which == GP_WOUT ? C_MG : C_XN) * 2;
            u.B = wt + ((size_t)(which == GP_INPROJ ? WT_IN : (which == GP_WOUT ? WT_OUT : WT_Q)) * 1024) * 2;
            u.kind = which == GP_WOUT ? GK_RESID : GK_STORE;
        }
        u.A += (size_t)u.pm * rowA; u.B += (size_t)u.pn * rowB;
        return true;
    }
};
struct GemmEpi {
    h16_t* act; const float* mb; const float* resid; float* out;
    __device__ __forceinline__ void operator()(const pg8::f32x4 (&acc)[2][2][4][2], const pg8::Unit& u, int wr, int wc, int fr, int fq) const {
        const int row0 = u.pm * 256 + wr * 64 + fr, col0 = u.pn * 256 + wc * 32 + 8 * fq;
#pragma unroll
        for (int ai = 0; ai < 2; ++ai)
#pragma unroll
            for (int m = 0; m < 4; ++m) {
                const int row = row0 + ai * 128 + m * 16;
#pragma unroll
                for (int bj = 0; bj < 2; ++bj) {
                    const int col = col0 + bj * 128;
                    float v[8];
#pragma unroll
                    for (int e = 0; e < 4; ++e) { v[e] = acc[ai][bj][m][0][e]; v[4 + e] = acc[ai][bj][m][1][e]; }
                    h16_t* arow = act + (size_t)row * LDZ;
                    if (u.kind == GK_STORE) {
                        store8h(arow + col, v);
                    } else if (u.kind <= GK_GATE2) {
                        const float* bp = mb + (u.kind - GK_GATE0) * 1024 + col;
                        const float4 b0 = *(const float4*)bp, b1 = *(const float4*)(bp + 4);
                        v[0] = sigmoidf_(v[0] + b0.x); v[1] = sigmoidf_(v[1] + b0.y); v[2] = sigmoidf_(v[2] + b0.z); v[3] = sigmoidf_(v[3] + b0.w);
                        v[4] = sigmoidf_(v[4] + b1.x); v[5] = sigmoidf_(v[5] + b1.y); v[6] = sigmoidf_(v[6] + b1.z); v[7] = sigmoidf_(v[7] + b1.w);
                        store8h(arow + C_GS + col, v);
                    } else if (u.kind <= GK_PROJ2) {
                        float g[8]; load8h(arow + C_GS + col, g);
                        if (u.kind == GK_PROJ0) {
#pragma unroll
                            for (int e = 0; e < 8; ++e) v[e] = g[e] * v[e];
                        } else {
                            float o[8]; load8h(arow + C_MG + col, o);
#pragma unroll
                            for (int e = 0; e < 8; ++e) v[e] = o[e] + g[e] * v[e];
                        }
                        store8h(arow + C_MG + col, v);
                    } else {
                        const size_t o = (size_t)row * 1024 + col;
                        const float4 r0 = *(const float4*)(resid + o), r1 = *(const float4*)(resid + o + 4);
                        *(float4*)(out + o) = make_float4(r0.x + v[0], r0.y + v[1], r0.z + v[2], r0.w + v[3]);
                        *(float4*)(out + o + 4) = make_float4(r1.x + v[4], r1.y + v[5], r1.z + v[6], r1.w + v[7]);
                    }
                }
            }
    }
};
__device__ __forceinline__ void stage_gemm(KParams p, int l, int which, char* smem) {
    GemmProg S; S.act = p->ws + OFF_ACT; S.wt = p->ws + OFF_WT + (size_t)l * WT_ROWS * 1024 * 2; S.which = which; S.G = gridDim.x; S.c = bid_();
    GemmEpi E; E.act = (h16_t*)(p->ws + OFF_ACT); E.mb = p->in[I_MB] + l * 3072; E.resid = l == 0 ? p->in[I_X] : p->out; E.out = p->out;
    pg8::gemm_phase(smem, S, E);
}

#ifdef CPU_EMU
__device__ __forceinline__ float group_sum(float v, int width, float* scratch) {
    const int tid = tid_();
    scratch[tid] = v;
    __syncthreads();
    float s = 0.f; const int base = tid & ~(width - 1);
    for (int i = 0; i < width; ++i) s += scratch[base + i];
    __syncthreads();
    return s;
}
#else
__device__ __forceinline__ float group_sum(float v, int width, float*) {
    for (int off = width >> 1; off > 0; off >>= 1) v += __shfl_xor(v, off);
    return v;
}
#endif

__device__ __forceinline__ void stage_lru(KParams p, int l, char* smem, int vb0, int nvb) {
    const int vb = bid_() - vb0;
    if (vb < 0 || vb >= nvb) return;
    constexpr int CH = 64;
    float* wa_s = (float*)smem;
    float* wx_s = wa_s + 4096;
    float* xcT = wx_s + 4096;
    float* a_s = xcT + 64 * CH;
    float* b_s = a_s + CH * 64;
    h16_t* ACT = (h16_t*)(p->ws + OFF_ACT);
    const int tid = tid_(), c = tid & 63, tg = tid >> 6;
    for (int item = vb; item < B_ * 16; item += nvb) {
        const int b = item / 16, n = item % 16, ch = n * 64 + c;
        __syncthreads();
        for (int i = tid; i < 4096; i += NT) { wa_s[i] = p->in[I_LWA][((size_t)l * 16 + n) * 4096 + i]; wx_s[i] = p->in[I_LWX][((size_t)l * 16 + n) * 4096 + i]; }
        const float cw0 = p->in[I_LCW][((size_t)l * 4 + 0) * 1024 + ch], cw1 = p->in[I_LCW][((size_t)l * 4 + 1) * 1024 + ch];
        const float cw2 = p->in[I_LCW][((size_t)l * 4 + 2) * 1024 + ch], cw3 = p->in[I_LCW][((size_t)l * 4 + 3) * 1024 + ch];
        const float cb = p->in[I_LCB][l * 1024 + ch], ba = p->in[I_LBA][l * 1024 + ch], bx = p->in[I_LBX][l * 1024 + ch];
        const float sp = softplusf_(-p->in[I_LLAM][l * 1024 + ch]);
        float hst = 0.f;
#pragma unroll 1
        for (int t0 = 0; t0 < T_; t0 += CH) {
            float xc[8];
            {
                const h16_t* up = ACT + ((size_t)b * T_ + t0 + tg * 8) * LDZ + Z_ULRU + ch;
                float u[11];
#pragma unroll
                for (int s = 0; s < 11; ++s) { const int t = t0 + tg * 8 + s - 3; u[s] = t >= 0 ? h2f(up[(ptrdiff_t)(s - 3) * LDZ]) : 0.f; }
#pragma unroll
                for (int s = 0; s < 8; ++s) { xc[s] = cw0 * u[s] + cw1 * u[s + 1] + cw2 * u[s + 2] + cw3 * u[s + 3] + cb; xcT[c * CH + tg * 8 + s] = xc[s]; }
            }
            __syncthreads();
            {
                float dr[8], di[8];
#pragma unroll
                for (int s = 0; s < 8; ++s) { dr[s] = 0.f; di[s] = 0.f; }
#pragma unroll 4
                for (int i = 0; i < 64; ++i) {
                    const float wa = wa_s[i * 64 + c], wx = wx_s[i * 64 + c];
                    const float4 x0 = *(const float4*)(xcT + i * CH + tg * 8), x1 = *(const float4*)(xcT + i * CH + tg * 8 + 4);
                    dr[0] += x0.x * wa; dr[1] += x0.y * wa; dr[2] += x0.z * wa; dr[3] += x0.w * wa; dr[4] += x1.x * wa; dr[5] += x1.y * wa; dr[6] += x1.z * wa; dr[7] += x1.w * wa;
                    di[0] += x0.x * wx; di[1] += x0.y * wx; di[2] += x0.z * wx; di[3] += x0.w * wx; di[4] += x1.x * wx; di[5] += x1.y * wx; di[6] += x1.z * wx; di[7] += x1.w * wx;
                }
#pragma unroll
                for (int s = 0; s < 8; ++s) {
                    const float r = sigmoidf_(dr[s] + ba), ig = sigmoidf_(di[s] + bx);
                    const float log_a = -8.0f * r * sp;
                    a_s[(tg * 8 + s) * 64 + c] = expf(log_a);
                    b_s[(tg * 8 + s) * 64 + c] = sqrtf(-expm1f(2.0f * log_a)) * (ig * xc[s]);
                }
            }
            __syncthreads();
            if (tid < 64) {
#pragma unroll 8
                for (int t = 0; t < CH; ++t) { hst = a_s[t * 64 + c] * hst + b_s[t * 64 + c]; b_s[t * 64 + c] = hst; }
            }
            __syncthreads();
#pragma unroll
            for (int s = 0; s < 8; ++s) {
                h16_t* gp = ACT + ((size_t)b * T_ + t0 + tg * 8 + s) * LDZ + Z_GLRU + ch;
                *gp = f2h(b_s[(tg * 8 + s) * 64 + c] * geluf_(h2f(*gp)));
            }
        }
    }
}

__device__ __forceinline__ void stage_gdn(KParams p, int l, char* smem, int vb0, int nvb) {
    const int vb = bid_() - vb0;
    if (vb < 0 || vb >= nvb) return;
    constexpr int CH = 32;
    float* q_s = (float*)smem;
    float* k_s = q_s + CH * 128;
    float* v_s = k_s + CH * 128;
    float* o_s = v_s + CH * 128;
    float* sc_s = o_s + CH * 128;
    float* scr = sc_s + CH * 2;
    h16_t* ACT = (h16_t*)(p->ws + OFF_ACT);
    const int tid = tid_(), lane = tid & 63, wv = tid >> 6;
    const int col = tid >> 2, q4 = tid & 3;
    for (int item = vb; item < B_ * 8; item += nvb) {
        const int b = item / 8, h = item % 8;
        const float a_exp = expf(p->in[I_GALOG][l * 8 + h]), dtb = p->in[I_GDT][l * 8 + h];
        const int cc = tid;
        const int gch = cc < 128 ? (h * 128 + cc) : (cc < 256 ? (1024 + h * 128 + cc - 128) : (2048 + h * 128 + cc - 256));
        float cw[4] = {0.f, 0.f, 0.f, 0.f};
        if (cc < 384) {
#pragma unroll
            for (int jj = 0; jj < 4; ++jj) cw[jj] = p->in[I_GCW][((size_t)l * 4 + jj) * 3072 + gch];
        }
        const float nw = p->in[I_GNW][l * 128 + (tid & 127)];
        float S[32];
#pragma unroll
        for (int k = 0; k < 32; ++k) S[k] = 0.f;
        float x1 = 0.f, x2 = 0.f, x3 = 0.f;
        __syncthreads();
#pragma unroll 1
        for (int t0 = 0; t0 < T_; t0 += CH) {
            if (cc < 384) {
                const h16_t* zp = ACT + ((size_t)b * T_ + t0) * LDZ + Z_Q + gch;
                float* dst = cc < 128 ? (q_s + cc) : (cc < 256 ? (k_s + cc - 128) : (v_s + cc - 256));
#pragma unroll 8
                for (int t = 0; t < CH; ++t) {
                    const float x0 = h2f(zp[(size_t)t * LDZ]);
                    const float cv = cw[0] * x3 + cw[1] * x2 + cw[2] * x1 + cw[3] * x0;
                    x3 = x2; x2 = x1; x1 = x0;
                    dst[t * 128] = siluf_(cv);
                }
            }
            __syncthreads();
#pragma unroll
            for (int s = 0; s < 4; ++s) {
                const int t = wv * 4 + s;
                const float qa = q_s[t * 128 + lane], qb = q_s[t * 128 + 64 + lane], ka = k_s[t * 128 + lane], kb = k_s[t * 128 + 64 + lane];
                const float sq = group_sum(qa * qa + qb * qb, 64, scr), sk = group_sum(ka * ka + kb * kb, 64, scr);
                const float rq = rsqrtf(sq + RMS_EPS) * 0.08838834764831845f, rk = rsqrtf(sk + RMS_EPS);
                q_s[t * 128 + lane] = qa * rq; q_s[t * 128 + 64 + lane] = qb * rq; k_s[t * 128 + lane] = ka * rk; k_s[t * 128 + 64 + lane] = kb * rk;
                if (lane == 0) {
                    const size_t m = (size_t)b * T_ + t0 + t;
                    sc_s[t * 2] = sigmoidf_(h2f(ACT[m * LDZ + Z_BETA + h]));
                    sc_s[t * 2 + 1] = expf(-a_exp * softplusf_(h2f(ACT[m * LDZ + Z_ALPHA + h]) + dtb));
                }
            }
            __syncthreads();
#pragma unroll 1
            for (int t = 0; t < CH; ++t) {
                const float* kp = k_s + t * 128 + q4 * 32; const float* qp = q_s + t * 128 + q4 * 32;
                float kr[32];
#pragma unroll
                for (int k = 0; k < 32; k += 4) { const float4 kv = *(const float4*)(kp + k); kr[k] = kv.x; kr[k + 1] = kv.y; kr[k + 2] = kv.z; kr[k + 3] = kv.w; }
                float pk = 0.f;
#pragma unroll
                for (int k = 0; k < 32; ++k) pk += S[k] * kr[k];
                const float kS = group_sum(pk, 4, scr);
                const float beta = sc_s[t * 2], eg = sc_s[t * 2 + 1];
                const float cf = beta * (v_s[t * 128 + col] - eg * kS);
                float po = 0.f;
#pragma unroll
                for (int k = 0; k < 32; k += 4) {
                    const float4 qv = *(const float4*)(qp + k);
                    S[k] = eg * S[k] + kr[k] * cf; S[k + 1] = eg * S[k + 1] + kr[k + 1] * cf; S[k + 2] = eg * S[k + 2] + kr[k + 2] * cf; S[k + 3] = eg * S[k + 3] + kr[k + 3] * cf;
                    po += S[k] * qv.x + S[k + 1] * qv.y + S[k + 2] * qv.z + S[k + 3] * qv.w;
                }
                const float o = group_sum(po, 4, scr);
                if (q4 == 0) o_s[t * 128 + col] = o;
            }
            __syncthreads();
#pragma unroll
            for (int s = 0; s < 4; ++s) {
                const int t = wv * 4 + s;
                const float oa = o_s[t * 128 + lane], ob = o_s[t * 128 + 64 + lane];
                const float ms = group_sum(oa * oa + ob * ob, 64, scr);
                const float rs = rsqrtf(ms * (1.0f / 128.0f) + RMS_EPS);
                h16_t* zg = ACT + ((size_t)b * T_ + t0 + t) * LDZ + Z_ZG + h * 128;
                const float nwa = p->in[I_GNW][l * 128 + lane], nwb = p->in[I_GNW][l * 128 + 64 + lane];
                zg[lane] = f2h(oa * rs * nwa * siluf_(h2f(zg[lane])));
                zg[64 + lane] = f2h(ob * rs * nwb * siluf_(h2f(zg[64 + lane])));
            }
            (void)nw;
        }
    }
}

__device__ __forceinline__ void stage_rwkv(KParams p, int l, char* smem, int vb0, int nvb) {
    const int vb = bid_() - vb0;
    if (vb < 0 || vb >= nvb) return;
    constexpr int CH = 32;
    float* r_s = (float*)smem;
    float* k_s = r_s + CH * 64;
    float* v_s = k_s + CH * 64;
    float* w_s = v_s + CH * 64;
    float* kk_s = w_s + CH * 64;
    float* ka_s = kk_s + CH * 64;
    float* g_s = ka_s + CH * 64;
    float* o_s = g_s + CH * 64;
    float* lwT = o_s + CH * 64;
    float* laT = lwT + 64 * CH;
    float* lgT = laT + 64 * CH;
    float* bon_s = lgT + 128 * CH;
    float* scr = bon_s + CH;
    const h16_t* ACT = (const h16_t*)(p->ws + OFF_ACT);
    h16_t* ACTw = (h16_t*)(p->ws + OFF_ACT);
    const int tid = tid_(), c = tid & 63, tg = tid >> 6;
    const int ri = tid >> 3, q8 = tid & 7;
    for (int item = vb; item < B_ * 16; item += nvb) {
        const int b = item / 16, h = item % 16, ch = h * 64 + c;
        const float w0 = p->in[I_RW0][l * 1024 + ch], a0 = p->in[I_RA0][l * 1024 + ch], k_k = p->in[I_RKK][l * 1024 + ch], k_a = p->in[I_RKA][l * 1024 + ch];
        const float rk_c = p->in[I_RRK][(size_t)l * 1024 + ch];
        const float lnw = p->in[I_RLW][l * 1024 + ch], lnb = p->in[I_RLB][l * 1024 + ch];
        const float* mu = p->in[I_RMU] + (size_t)l * RWW;
        const float mu_r = mu[RW_R + ch], mu_k = mu[RW_K + ch], mu_v = mu[RW_V + ch];
        const float mu_wl = mu[RW_WL + c], mu_al = mu[RW_AL + c], mu_g0 = mu[RW_GL + c], mu_g1 = mu[RW_GL + 64 + c];
        const float* wup = p->in[I_RWUP] + (size_t)l * 64 * 1024 + ch; const float* aup = p->in[I_RAUP] + (size_t)l * 64 * 1024 + ch; const float* gup = p->in[I_RGUP] + (size_t)l * 128 * 1024 + ch;
        float S[8];
#pragma unroll
        for (int e = 0; e < 8; ++e) S[e] = 0.f;
        __syncthreads();
#pragma unroll 1
        for (int t0 = 0; t0 < T_; t0 += CH) {
#pragma unroll
            for (int s = 0; s < 4; ++s) {
                const int tl = tg * 4 + s, t = t0 + tl;
                const h16_t* zc = ACT + ((size_t)b * T_ + t) * LDZ + Z_RW;
                const h16_t* zp = zc - LDZ;
                const bool hp = t > 0;
#define RW_SHIFT(col, muv) ({ const float zz = h2f(zc[col]); zz + (muv) * ((hp ? h2f(zp[col]) : 0.f) - zz); })
                r_s[tl * 64 + c] = RW_SHIFT(RW_R + ch, mu_r);
                k_s[tl * 64 + c] = RW_SHIFT(RW_K + ch, mu_k);
                v_s[tl * 64 + c] = RW_SHIFT(RW_V + ch, mu_v);
                lwT[c * CH + tl] = tanhf(RW_SHIFT(RW_WL + c, mu_wl));
                laT[c * CH + tl] = RW_SHIFT(RW_AL + c, mu_al);
                lgT[c * CH + tl] = sigmoidf_(RW_SHIFT(RW_GL + c, mu_g0));
                lgT[(64 + c) * CH + tl] = sigmoidf_(RW_SHIFT(RW_GL + 64 + c, mu_g1));
#undef RW_SHIFT
            }
            __syncthreads();
            {
                float dw[4] = {0.f, 0.f, 0.f, 0.f}, da[4] = {0.f, 0.f, 0.f, 0.f}, dg[4] = {0.f, 0.f, 0.f, 0.f};
#pragma unroll 4
                for (int i = 0; i < 64; ++i) {
                    const float ww = wup[(size_t)i * 1024], aw = aup[(size_t)i * 1024];
                    const float4 x = *(const float4*)(lwT + i * CH + tg * 4), y = *(const float4*)(laT + i * CH + tg * 4);
                    dw[0] += x.x * ww; dw[1] += x.y * ww; dw[2] += x.z * ww; dw[3] += x.w * ww;
                    da[0] += y.x * aw; da[1] += y.y * aw; da[2] += y.z * aw; da[3] += y.w * aw;
                }
#pragma unroll 4
                for (int i = 0; i < 128; ++i) {
                    const float gw = gup[(size_t)i * 1024];
                    const float4 x = *(const float4*)(lgT + i * CH + tg * 4);
                    dg[0] += x.x * gw; dg[1] += x.y * gw; dg[2] += x.z * gw; dg[3] += x.w * gw;
                }
#pragma unroll
                for (int s = 0; s < 4; ++s) {
                    const int tl = tg * 4 + s;
                    const float w_log = -softplusf_(-(w0 + dw[s])) - 0.5f;
                    const float decay = expf(-expf(w_log));
                    const float a = sigmoidf_(a0 + da[s]);
                    const float kx = k_s[tl * 64 + c], rx = r_s[tl * 64 + c];
                    const float kkr = kx * k_k, k2 = kx * (1.0f + (a - 1.0f) * k_a);
                    const float nsq = group_sum(kkr * kkr, 64, scr);
                    const float bon = group_sum(rx * k2 * rk_c, 64, scr);
                    const float kkn = kkr * rsqrtf(nsq + RMS_EPS);
                    w_s[tl * 64 + c] = decay; k_s[tl * 64 + c] = k2; kk_s[tl * 64 + c] = kkn; ka_s[tl * 64 + c] = kkn * a; g_s[tl * 64 + c] = dg[s];
                    if (c == 0) bon_s[tl] = bon;
                }
            }
            __syncthreads();
#pragma unroll 1
            for (int t = 0; t < CH; ++t) {
                const int o8 = t * 64 + q8 * 8;
                const float4 kk0 = *(const float4*)(kk_s + o8), kk1 = *(const float4*)(kk_s + o8 + 4);
                float pk = S[0] * kk0.x + S[1] * kk0.y + S[2] * kk0.z + S[3] * kk0.w + S[4] * kk1.x + S[5] * kk1.y + S[6] * kk1.z + S[7] * kk1.w;
                const float skk = group_sum(pk, 8, scr);
                const float vi = v_s[t * 64 + ri];
                const float4 w0v = *(const float4*)(w_s + o8), w1v = *(const float4*)(w_s + o8 + 4);
                const float4 a0v = *(const float4*)(ka_s + o8), a1v = *(const float4*)(ka_s + o8 + 4);
                const float4 k0v = *(const float4*)(k_s + o8), k1v = *(const float4*)(k_s + o8 + 4);
                const float4 r0v = *(const float4*)(r_s + o8), r1v = *(const float4*)(r_s + o8 + 4);
                S[0] = S[0] * w0v.x - skk * a0v.x + vi * k0v.x; S[1] = S[1] * w0v.y - skk * a0v.y + vi * k0v.y; S[2] = S[2] * w0v.z - skk * a0v.z + vi * k0v.z; S[3] = S[3] * w0v.w - skk * a0v.w + vi * k0v.w;
                S[4] = S[4] * w1v.x - skk * a1v.x + vi * k1v.x; S[5] = S[5] * w1v.y - skk * a1v.y + vi * k1v.y; S[6] = S[6] * w1v.z - skk * a1v.z + vi * k1v.z; S[7] = S[7] * w1v.w - skk * a1v.w + vi * k1v.w;
                const float po = S[0] * r0v.x + S[1] * r0v.y + S[2] * r0v.z + S[3] * r0v.w + S[4] * r1v.x + S[5] * r1v.y + S[6] * r1v.z + S[7] * r1v.w;
                const float o = group_sum(po, 8, scr);
                if (q8 == 0) o_s[t * 64 + ri] = o;
            }
            __syncthreads();
#pragma unroll
            for (int s = 0; s < 4; ++s) {
                const int tl = tg * 4 + s;
                const float ov = o_s[tl * 64 + c];
                const float mean = group_sum(ov, 64, scr) * (1.0f / 64.0f);
                const float d = ov - mean;
                const float var = group_sum(d * d, 64, scr) * (1.0f / 64.0f);
                const float y = (d * rsqrtf(var + GN_EPS) * lnw + lnb + bon_s[tl] * v_s[tl * 64 + c]) * g_s[tl * 64 + c];
                ACTw[((size_t)b * T_ + t0 + tl) * LDZ + C_YC + ch] = f2h(y);
            }
            __syncthreads();
        }
    }
}

__device__ __forceinline__ void stage_peer_topk(KParams p, int l, char* smem) {
    const int tid = tid_(), sub = tid >> 8, lt = tid & 255;
    float* q_s = (float*)smem + sub * 1024; float* sc = q_s + 256; float* top_s = sc + 256; int* top_i = (int*)(top_s + 32); float* cand = (float*)(top_i + 32);
    float* best_s = cand + 256; int* best_e = (int*)(best_s + 16);
    const h16_t* Q = (const h16_t*)(p->ws + OFF_ACT) + C_QRY;
    int* IDX = (int*)(p->ws + OFF_IDX); float* GT = (float*)(p->ws + OFF_GT);
    const int s = lt >> 7, n = lt & 127;
    for (int item = bid_(); item < M_ * 4; item += gridDim.x) {
        const int m = item >> 2, hd = (item & 3) * 2 + sub;
        __syncthreads();
        q_s[lt] = h2f(Q[(size_t)m * LDZ + hd * 256 + lt]);
        __syncthreads();
        const float* key = p->in[I_PKEYS] + ((((size_t)l * 8 + hd) * 2 + s) * 128 + n) * 128;
        float dot = 0.f;
        for (int cix = 0; cix < 128; ++cix) dot += q_s[s * 128 + cix] * key[cix];
        sc[lt] = dot;
        __syncthreads();
        int cnt = 0;
        for (int jj = 0; jj < 128; ++jj) { const float o = sc[s * 128 + jj]; cnt += (o > dot || (o == dot && jj < n)) ? 1 : 0; }
        if (cnt < 16) { top_s[s * 16 + cnt] = dot; top_i[s * 16 + cnt] = n; }
        __syncthreads();
        const int ci = lt >> 4, cj = lt & 15;
        const float cs = top_s[ci] + top_s[16 + cj];
        cand[lt] = cs;
        __syncthreads();
        int cnt2 = 0;
        for (int jj = 0; jj < 256; ++jj) { const float o = cand[jj]; cnt2 += (o > cs || (o == cs && jj < lt)) ? 1 : 0; }
        if (cnt2 < 16) { best_s[cnt2] = cs; best_e[cnt2] = top_i[ci] * 128 + top_i[16 + cj]; }
        __syncthreads();
        if (lt < 16) {
            const float mx = best_s[0];
            float sum = 0.f;
            for (int i = 0; i < 16; ++i) sum += expf(best_s[i] - mx);
            IDX[(size_t)m * 128 + hd * 16 + lt] = best_e[lt];
            GT[(size_t)m * 128 + hd * 16 + lt] = expf(best_s[lt] - mx) / sum;
        }
    }
}

__device__ __forceinline__ void stage_peer_gather(KParams p, int l, char* smem) {
    float* x_s = (float*)smem; float* hid = x_s + 1024; float* gate_s = hid + 128; int* idx_s = (int*)(gate_s + 128); float* red = (float*)(idx_s + 128);
    const h16_t* XN = (const h16_t*)(p->ws + OFF_ACT) + C_XN;
    const int* IDX = (const int*)(p->ws + OFF_IDX); const float* GT = (const float*)(p->ws + OFF_GT);
    const float* U = p->in[I_PU] + (size_t)l * 16384 * 1024; const float* V = p->in[I_PV] + (size_t)l * 16384 * 1024;
    const int tid = tid_(), w = tid >> 6, lane = tid & 63;
    for (int m = bid_(); m < M_; m += gridDim.x) {
        __syncthreads();
        for (int i = 0; i < 2; ++i) x_s[tid * 2 + i] = h2f(XN[(size_t)m * LDZ + tid * 2 + i]);
        if (tid < 128) { idx_s[tid] = IDX[(size_t)m * 128 + tid]; gate_s[tid] = GT[(size_t)m * 128 + tid]; }
        __syncthreads();
        for (int e = w; e < 128; e += 8) {
            const float* row = U + (size_t)idx_s[e] * 1024;
            float part = 0.f;
#pragma unroll
            for (int k = 0; k < 4; ++k) {
                const float4 uv = *(const float4*)(row + (k * 64 + lane) * 4);
                const float* xp = x_s + (k * 64 + lane) * 4;
                part += uv.x * xp[0] + uv.y * xp[1] + uv.z * xp[2] + uv.w * xp[3];
            }
            red[tid] = part;
            __syncthreads();
            if (lane == 0) { float sm = 0.f; for (int i = 0; i < 64; ++i) sm += red[w * 64 + i]; hid[e] = gate_s[e] * geluf_(sm); }
            __syncthreads();
        }
        float a0 = 0.f, a1 = 0.f;
        for (int e = 0; e < 128; ++e) {
            const float2 vv = *(const float2*)(V + (size_t)idx_s[e] * 1024 + tid * 2);
            const float hh = hid[e];
            a0 += hh * vv.x; a1 += hh * vv.y;
        }
        float2* op = (float2*)(p->out + (size_t)m * 1024 + tid * 2);
        float2 ov = *op;
        ov.x += a0; ov.y += a1;
        *op = ov;
    }
}

enum { PH_NORM_MIX = 0, PH_INPROJ, PH_MIXERS, PH_MERGE, PH_WOUT, PH_NORM_FFN, PH_QUERY, PH_TOPK, PH_GATHER, PH_PER_LAYER, PH_FINAL = 100, PH_WPREP = 101 };
__device__ __forceinline__ void run_phase(KParams p, int l, int ph, char* smem) {
    h16_t* ACT = (h16_t*)(p->ws + OFF_ACT);
    const float* hin = l == 0 ? p->in[I_X] : p->out;
    switch (ph) {
    case PH_WPREP: stage_wprep(p, smem); break;
    case PH_NORM_MIX: stage_rmsnorm<false>(hin, p->in[I_NMIX] + l * 1024, ACT + C_XN, LDZ, smem); break;
    case PH_INPROJ: stage_gemm(p, l, GP_INPROJ, smem); break;
    case PH_MIXERS: {
        const int nb = gridDim.x, n_rw = nb / 2, n_gd = nb / 4, n_lr = nb - n_rw - n_gd;
        stage_rwkv(p, l, smem, 0, n_rw);
        stage_gdn(p, l, smem, n_rw, n_gd);
        stage_lru(p, l, smem, n_rw + n_gd, n_lr);
    } break;
    case PH_MERGE: stage_gemm(p, l, GP_MERGE, smem); break;
    case PH_WOUT: stage_gemm(p, l, GP_WOUT, smem); break;
    case PH_NORM_FFN: stage_rmsnorm<false>(p->out, p->in[I_NFFN] + l * 1024, ACT + C_XN, LDZ, smem); break;
    case PH_QUERY: stage_gemm(p, l, GP_QUERY, smem); break;
    case PH_TOPK: stage_peer_topk(p, l, smem); break;
    case PH_GATHER: stage_peer_gather(p, l, smem); break;
    case PH_FINAL: stage_rmsnorm<true>(p->out, p->in[I_NFINAL], p->out, 1024, smem); break;
    default: break;
    }
}

#if !defined(CPU_EMU) && !MK_MULTI
__global__ void __launch_bounds__(512, 2) k_mega(Params p_) {
    DYN_SMEM(smem);
    KParams pk = (KParams)__builtin_amdgcn_kernarg_segment_ptr();
    cg::grid_group grid = cg::this_grid();
    constexpr int NIT = NL_ * PH_PER_LAYER;
#pragma unroll 1
    for (int it = -1; it <= NIT; ++it) {
        const int l = (it >= 0 && it < NIT) ? it / PH_PER_LAYER : 0, ph = it < 0 ? (int)PH_WPREP : (it < NIT ? it % PH_PER_LAYER : (int)PH_FINAL);
        KParams q = pk; asm volatile("" : "+s"(q));
        run_phase(q, l, ph, smem);
        if (it < NIT && !(it < 0)) grid.sync();
    }
}
#endif
#ifdef CPU_EMU
__global__ void k_phase(Params p_, int l, int ph) { DYN_SMEM(smem); run_phase(&p_, l, ph, smem); }
#elif MK_MULTI
__global__ void __launch_bounds__(512, 2) k_phase(Params p_, int l, int ph) { DYN_SMEM(smem); KParams pk = (KParams)__builtin_amdgcn_kernarg_segment_ptr(); run_phase(pk, l, ph, smem); }
#endif
}

#ifdef CPU_EMU
int g_emu_stop = 1000;
#endif

extern "C" void kernel_launch(void* const* d_in, const int* in_sizes, int n_in, void* d_out, int out_size, void* d_ws, size_t ws_size, hipStream_t stream) {
    Params p{};
    for (int i = 0; i < N_IN; ++i) p.in[i] = (const float*)d_in[i];
    p.out = (float*)d_out; p.ws = (char*)d_ws;
#if defined(CPU_EMU) || MK_MULTI
    const int grid = 256;
    LAUNCH(k_phase, grid, NT, SMEM_BYTES, stream, p, 0, (int)PH_WPREP);
    for (int l = 0; l < NL_; ++l)
        for (int ph = 0; ph < PH_PER_LAYER; ++ph) {
            LAUNCH(k_phase, grid, NT, SMEM_BYTES, stream, p, l, ph);
#ifdef CPU_EMU
            const int code = ph == PH_INPROJ ? 1 : ph == PH_MIXERS ? 2 : ph == PH_MERGE ? 3 : ph == PH_WOUT ? 4 : ph == PH_GATHER ? 5 : 0;
            if (code && g_emu_stop == l * 10 + code) return;
#endif
        }
    LAUNCH(k_phase, grid, NT, SMEM_BYTES, stream, p, 0, (int)PH_FINAL);
#else
    static int grid_blocks = 0;
    if (!grid_blocks) {
        int dev = 0, cus = 0, per_cu = 0;
        (void)hipGetDevice(&dev);
        (void)hipDeviceGetAttribute(&cus, hipDeviceAttributeMultiprocessorCount, dev);
        (void)hipFuncSetAttribute((const void*)k_mega, hipFuncAttributeMaxDynamicSharedMemorySize, (int)SMEM_BYTES);
        (void)hipOccupancyMaxActiveBlocksPerMultiprocessor(&per_cu, k_mega, NT, SMEM_BYTES);
        if (per_cu > 1) per_cu = 1;
        grid_blocks = cus * per_cu;
    }
    void* args[] = {&p};
    hipError_t e = hipLaunchCooperativeKernel((void*)k_mega, dim3(grid_blocks), dim3(NT), args, SMEM_BYTES, stream);
    if (e != hipSuccess) fprintf(stderr, "cooperative launch failed: %s (grid %d)\n", hipGetErrorString(e), grid_blocks);
#endif
}
```

```cpp
#ifndef CPU_EMU
#include <hip/hip_runtime.h>
#include <hip/hip_cooperative_groups.h>
#include <cstdio>
#include <cstdint>
namespace cg = cooperative_groups;
#define DYN_SMEM(name) extern __shared__ __attribute__((aligned(16))) char name[]
#define LAUNCH(kern, grid, block, smem, stream, ...) hipLaunchKernelGGL(kern, dim3(grid), dim3(block), smem, stream, __VA_ARGS__)
#endif

#ifndef CFG_B
#define CFG_B 8
#endif
#ifndef CFG_T
#define CFG_T 2048
#endif
#ifndef MK_MULTI
#define MK_MULTI 0
#endif

namespace {
constexpr int B_ = CFG_B, T_ = CFG_T, M_ = B_ * T_, D_ = 1024, NL_ = 2, NT = 512;
constexpr int INW = 12560;
constexpr int LDZ = 11776;
constexpr int Z_ULRU = 0, Z_GLRU = 1024, Z_Q = 2048, Z_K = 3072, Z_V = 4096, Z_ZG = 5120, Z_RW = 6144, Z_ALPHA = 9472, Z_BETA = 9480;
constexpr int ZN = 9728;
constexpr int C_XN = 9728, C_YC = 10752;
constexpr int C_YA = Z_GLRU, C_YB = Z_ZG;
constexpr int C_GS = Z_Q, C_MG = Z_K;
constexpr int C_QRY = 0;
constexpr int RW_R = 0, RW_K = 1024, RW_V = 2048, RW_WL = 3072, RW_AL = 3136, RW_GL = 3200, RWW = 3328;
constexpr float RMS_EPS = 1e-6f, GN_EPS = 64e-5f;
typedef unsigned short h16_t;

enum { I_X = 0, I_NMIX, I_NFFN, I_NFINAL, I_WIN, I_LCW, I_LCB, I_LWA, I_LBA, I_LWX, I_LBX, I_LLAM, I_GCW, I_GALOG, I_GDT, I_GNW,
       I_RMU, I_RW0, I_RWUP, I_RA0, I_RAUP, I_RGUP, I_RKK, I_RKA, I_RRK, I_RLW, I_RLB, I_MB, I_PL, I_PG, I_PR, I_WOUT, I_PWQ, I_PKEYS, I_PU, I_PV, N_IN };

struct Params {
    const float* in[N_IN];
    float* out;
    char* ws;
};
#ifdef CPU_EMU
typedef const Params* KParams;
#else
typedef const Params __attribute__((address_space(4)))* KParams;
#endif

constexpr size_t al256(size_t x) { return (x + 255) / 256 * 256; }
constexpr size_t OFF_ACT = 0;
constexpr size_t OFF_WT = al256(OFF_ACT + (size_t)M_ * LDZ * 2);
constexpr int WT_IN = 0, WT_MG = ZN, WT_P = WT_MG + 3072, WT_OUT = WT_P + 3072, WT_Q = WT_OUT + 1024, WT_ROWS = WT_Q + 2048;
constexpr size_t OFF_TOPS = al256(OFF_WT + (size_t)NL_ * WT_ROWS * 1024 * 2);
constexpr size_t OFF_TAB = al256(OFF_TOPS + (size_t)M_ * 256 * 4);
constexpr size_t WS_END = OFF_TAB + (M_ == 16384 ? 0 : (size_t)2 * 16384 * 1024 * 2);
static_assert(CFG_B != 8 || CFG_T != 2048 || WS_END <= (size_t)512 * 1024 * 1024, "workspace budget");
constexpr size_t SMEM_BYTES = 128 * 1024;

#ifdef CPU_EMU
__device__ __forceinline__ int tid_() { return threadIdx.x; }
__device__ __forceinline__ h16_t f2h(float f) { return (h16_t)_cvtss_sh(f, _MM_FROUND_TO_NEAREST_INT); }
__device__ __forceinline__ float h2f(h16_t h) { return _cvtsh_ss(h); }
#else
__device__ __forceinline__ int tid_() { int t = threadIdx.x; asm volatile("" : "+v"(t)); return t; }
__device__ __forceinline__ h16_t f2h(float f) { return __builtin_bit_cast(unsigned short, (_Float16)f); }
__device__ __forceinline__ float h2f(h16_t h) { return (float)__builtin_bit_cast(_Float16, h); }
#endif
__device__ __forceinline__ int bid_() { return (int)blockIdx.x; }

__device__ __forceinline__ float sigmoidf_(float x) { return 1.0f / (1.0f + expf(-x)); }
__device__ __forceinline__ float softplusf_(float x) { return fmaxf(x, 0.0f) + log1pf(expf(-fabsf(x))); }
__device__ __forceinline__ float siluf_(float x) { return x * sigmoidf_(x); }
__device__ __forceinline__ float geluf_(float x) { return 0.5f * x * (1.0f + tanhf(0.7978845608028654f * (x + 0.044715f * x * x * x))); }
__device__ __forceinline__ unsigned pack2h(float a, float b) { return (unsigned)f2h(a) | ((unsigned)f2h(b) << 16); }
__device__ __forceinline__ void store8h(h16_t* p, const float (&v)[8]) {
    uint4 w; w.x = pack2h(v[0], v[1]); w.y = pack2h(v[2], v[3]); w.z = pack2h(v[4], v[5]); w.w = pack2h(v[6], v[7]);
    *(uint4*)p = w;
}
__device__ __forceinline__ void load8h(const h16_t* p, float (&v)[8]) {
    const uint4 w = *(const uint4*)p;
    v[0] = h2f((h16_t)(w.x & 0xffffu)); v[1] = h2f((h16_t)(w.x >> 16)); v[2] = h2f((h16_t)(w.y & 0xffffu)); v[3] = h2f((h16_t)(w.y >> 16));
    v[4] = h2f((h16_t)(w.z & 0xffffu)); v[5] = h2f((h16_t)(w.z >> 16)); v[6] = h2f((h16_t)(w.w & 0xffffu)); v[7] = h2f((h16_t)(w.w >> 16));
}

__device__ __forceinline__ float block_sum512(float v, float* red) {
    const int tid = tid_();
    red[tid] = v;
    __syncthreads();
    if (tid < 32) { float s = 0.f; for (int i = 0; i < 16; ++i) s += red[tid * 16 + i]; red[512 + tid] = s; }
    __syncthreads();
    float tot = 0.f;
    for (int i = 0; i < 32; ++i) tot += red[512 + i];
    __syncthreads();
    return tot;
}

template <bool OUT_F32>
__device__ __forceinline__ void stage_rmsnorm(const float* src, const float* w, void* dst, int ldd, char* smem) {
    float* red = (float*)smem;
    const int tid = tid_();
    for (int row = bid_(); row < M_; row += gridDim.x) {
        const float2 v = *(const float2*)(src + (size_t)row * D_ + tid * 2);
        const float ss = block_sum512(v.x * v.x + v.y * v.y, red);
        const float rstd = rsqrtf(ss * (1.0f / D_) + RMS_EPS);
        const float2 wv = *(const float2*)(w + tid * 2);
        const float o0 = v.x * rstd * wv.x, o1 = v.y * rstd * wv.y;
        if (OUT_F32) {
            float2 o; o.x = o0; o.y = o1;
            *(float2*)((float*)dst + (size_t)row * ldd + tid * 2) = o;
        } else {
            *(unsigned*)((h16_t*)dst + (size_t)row * ldd + tid * 2) = pack2h(o0, o1);
        }
    }
}

__device__ __forceinline__ const float* wt_src(KParams p, int l, int r, int& ld) {
    if (r < ZN) {
        ld = INW;
        int c;
        if (r < 6144) c = r; else if (r < 9472) c = r + 16; else if (r < 9488) c = r - 3328; else return nullptr;
        return p->in[I_WIN] + (size_t)l * 1024 * INW + c;
    }
    r -= ZN;
    if (r < 3072) { ld = INW; return p->in[I_WIN] + (size_t)l * 1024 * INW + 9488 + r; }
    r -= 3072;
    if (r < 3072) { ld = 1024; const int br = r >> 10; return p->in[br == 0 ? I_PL : (br == 1 ? I_PG : I_PR)] + (size_t)l * 1024 * 1024 + (r & 1023); }
    r -= 3072;
    if (r < 1024) { ld = 1024; return p->in[I_WOUT] + (size_t)l * 1024 * 1024 + r; }
    r -= 1024;
    ld = 2048; return p->in[I_PWQ] + (size_t)l * 1024 * 2048 + r;
}
__device__ __forceinline__ void stage_wprep(KParams p, char* smem) {
    float* tile = (float*)smem;
    h16_t* WT = (h16_t*)(p->ws + OFF_WT);
    const int tid = tid_();
    const int ntr = WT_ROWS / 64, total = NL_ * ntr * 16;
    for (int it = bid_(); it < total; it += gridDim.x) {
        const int l = it / (ntr * 16), rem = it % (ntr * 16), rt = rem / 16, kt = rem % 16;
        const int r0 = rt * 64, k0 = kt * 64;
        __syncthreads();
        {
            const int nn = tid & 63;
            int ld = 0; const float* src = wt_src(p, l, r0 + nn, ld);
#pragma unroll
            for (int i = 0; i < 8; ++i) { const int kk = (tid >> 6) + 8 * i; tile[kk * 65 + nn] = src ? src[(size_t)(k0 + kk) * ld] : 0.f; }
        }
        __syncthreads();
        {
            const int r = tid >> 3, kq = (tid & 7) * 8;
            float v[8];
#pragma unroll
            for (int j = 0; j < 8; ++j) v[j] = tile[(kq + j) * 65 + r];
            store8h(WT + ((size_t)l * WT_ROWS + r0 + r) * 1024 + k0 + kq, v);
        }
    }
}

namespace pg8 {
constexpr int BM = 256, BK = 64, HALF = 128, HTB = HALF * BK * 2, STAGE_BYTES = 8 * HTB, NXCD = 8, WGM = 8;
struct Unit { const char* A; const char* B; int pm, pn, kind; };
#ifdef CPU_EMU
struct f32x4 { float d[4]; float& operator[](int i) { return d[i]; } const float& operator[](int i) const { return d[i]; } };
#else
#define PG8_LAS __attribute__((address_space(3)))
typedef _Float16 f16x8 __attribute__((ext_vector_type(8)));
typedef float f32x4 __attribute__((ext_vector_type(4)));
__device__ __forceinline__ int lds_byte(int r, int c) { const int st = (r >> 4) * 2 + (c >> 5), rr = r & 15, cc = c & 31, ob = rr * 64 + cc * 2; return st * 1024 + (ob ^ (((ob >> 9) & 1) << 5)); }
__device__ __forceinline__ void stage_rc(int b, int& R, int& C) { const int st = b / 1024, sb = b % 1024, swz = sb ^ (((sb >> 9) & 1) << 5); R = (st >> 1) * 16 + swz / 64; C = (st & 1) * 32 + (swz % 64) / 2; }
__device__ __forceinline__ int perm32(int rho) { const int n = rho >> 4, i = rho & 15; return 8 * (i >> 2) + 4 * n + (i & 3); }
#endif
__device__ __forceinline__ void tile_of(int L, int nM, int nN, int& pm, int& pn) {
    const int nwg = nM * nN;
    int wgid = L; { const int q = nwg / NXCD, r = nwg % NXCD, xcd = wgid % NXCD, off = wgid / NXCD; wgid = (xcd < r ? xcd * (q + 1) : r * (q + 1) + (xcd - r) * q) + off; }
    const int nig = WGM * nN, gid = wgid / nig, fm = gid * WGM, gsz = (nM - fm) < WGM ? (nM - fm) : WGM;
    pm = fm + ((wgid % nig) % gsz); pn = (wgid % nig) / gsz;
}

template <class Sched, class Epi>
__device__ __forceinline__ void gemm_phase(char* smem, const Sched& S, const Epi& E) {
    constexpr int K = 1024, nt = K / BK;
    constexpr unsigned lda = LDZ, ldb = 1024;
#ifdef CPU_EMU
    const int tid = tid_(), wid = tid >> 6, lane = tid & 63, wr = wid >> 2, wc = wid & 3, fr = lane & 15, fq = lane >> 4;
    Unit u;
    for (int ui = 0; S.next(ui, u); ++ui) {
        f32x4 acc[2][2][4][2];
        for (int ai = 0; ai < 2; ++ai) for (int bj = 0; bj < 2; ++bj) for (int m = 0; m < 4; ++m) for (int n = 0; n < 2; ++n) for (int e = 0; e < 4; ++e) {
            const int r = 128 * ai + 64 * wr + 16 * m + fr, c = 128 * bj + 32 * wc + 8 * fq + 4 * n + e;
            const h16_t* a = (const h16_t*)u.A + (size_t)r * lda; const h16_t* b = (const h16_t*)u.B + (size_t)c * ldb;
            float s = 0.f;
            for (int k = 0; k < K; ++k) s += h2f(a[k]) * h2f(b[k]);
            acc[ai][bj][m][n][e] = s;
        }
        E(acc, u, wr, wc, fr, fq);
    }
    (void)smem; (void)nt;
#else
    PG8_LAS unsigned char* lds = (PG8_LAS unsigned char*)smem;
    const int tid = tid_(), wid = __builtin_amdgcn_readfirstlane(tid >> 6), lane = tid & 63, wr = wid >> 2, wc = wid & 3, fr = lane & 15, fq = lane >> 4;
    unsigned voffA[2], voffB[2];
#pragma unroll
    for (int i = 0; i < 2; ++i) { int R, C; stage_rc(tid * 16 + i * 8192, R, C); const int Rb = (R & ~31) + perm32(R & 31);
        voffA[i] = (unsigned)(R * lda + C) * 2u; voffB[i] = (unsigned)(Rb * ldb + C) * 2u; }
    constexpr size_t kstep = (size_t)(BK * 2);
    constexpr size_t hstepA = (size_t)HALF * lda * 2, hstepB = (size_t)HALF * ldb * 2;
    const unsigned ldsw = (unsigned)wid * 1024u;
    const int aoff = lds_byte(wr * 64 + fr, fq * 8), boff = lds_byte(wc * 32 + fr, fq * 8);
#define PG8_SA(b, h) (((b) * 2 + (h)) * HTB)
#define PG8_SB(b, h) ((4 + (b) * 2 + (h)) * HTB)
#define PG8_STAGE(bufoff, gbase, voff) do { _Pragma("unroll") for (int _i = 0; _i < 2; ++_i) \
        __builtin_amdgcn_global_load_lds((const unsigned*)((const char*)(gbase) + (voff)[_i]), (PG8_LAS unsigned*)(lds + (bufoff) + ldsw + _i * 8192), 16, 0, 0); } while (0)
#define PG8_LDA(dst, b, h) do { _Pragma("unroll") for (int m = 0; m < 4; ++m) _Pragma("unroll") for (int k = 0; k < 2; ++k) dst[m][k] = *(const PG8_LAS f16x8*)(lds + PG8_SA(b, h) + aoff + m * 2048 + k * 1024); } while (0)
#define PG8_LDB(dst, b, h) do { _Pragma("unroll") for (int n = 0; n < 2; ++n) _Pragma("unroll") for (int k = 0; k < 2; ++k) dst[n][k] = *(const PG8_LAS f16x8*)(lds + PG8_SB(b, h) + boff + n * 2048 + k * 1024); } while (0)
#define PG8_MMA(ai, bj, At, Bt) do { __builtin_amdgcn_s_setprio(1); _Pragma("unroll") for (int m = 0; m < 4; ++m) _Pragma("unroll") for (int n = 0; n < 2; ++n) _Pragma("unroll") for (int k = 0; k < 2; ++k) \
        acc[ai][bj][m][n] = __builtin_amdgcn_mfma_f32_16x16x32_f16(Bt[n][k], At[m][k], acc[ai][bj][m][n], 0, 0, 0); __builtin_amdgcn_s_setprio(0); } while (0)
#define PG8_WAIT_V(n) asm volatile("s_waitcnt vmcnt(" #n ")" ::: "memory")
#define PG8_WAIT_L(n) asm volatile("s_waitcnt lgkmcnt(" #n ")" ::: "memory")
#define PG8_BAR __builtin_amdgcn_s_barrier()
#define PG8_SCHED __builtin_amdgcn_sched_barrier(0)
    Unit cur, nxt; int ui = 0;
    if (!S.next(0, cur)) return;
    f32x4 acc[2][2][4][2];
#pragma unroll
    for (int a = 0; a < 2; ++a)
#pragma unroll
        for (int b = 0; b < 2; ++b)
#pragma unroll
            for (int m = 0; m < 4; ++m)
#pragma unroll
                for (int n = 0; n < 2; ++n) acc[a][b][m][n] = (f32x4){0.f, 0.f, 0.f, 0.f};
    f16x8 At[4][2], B0[2][2], B1[2][2];
    const char* cA = cur.A; const char* cB = cur.B;
    PG8_STAGE(PG8_SB(0, 0), cB, voffB); PG8_STAGE(PG8_SA(0, 0), cA, voffA); PG8_STAGE(PG8_SB(0, 1), cB + hstepB, voffB); PG8_STAGE(PG8_SA(0, 1), cA + hstepA, voffA);
    if (wr == 1) PG8_BAR;
    PG8_WAIT_V(4); PG8_BAR;
    PG8_STAGE(PG8_SB(1, 0), cB + kstep, voffB); PG8_STAGE(PG8_SA(1, 0), cA + kstep, voffA); PG8_STAGE(PG8_SB(1, 1), cB + hstepB + kstep, voffB);
    PG8_WAIT_V(6); PG8_BAR;
    for (;;) {
        const bool has_next = S.next(ui + 1, nxt);
        const char* nA = has_next ? nxt.A : cA; const char* nB = has_next ? nxt.B : cB;
#pragma unroll 1
        for (int t = 0; t < nt; t += 2) {
            const bool last = (t == nt - 2);
            const char* a1 = cA + (size_t)(t + 1) * kstep;
            const char* a2 = last ? nA : cA + (size_t)(t + 2) * kstep; const char* b2 = last ? nB : cB + (size_t)(t + 2) * kstep;
            const char* a3 = a2 + kstep; const char* b3 = b2 + kstep;
            PG8_LDB(B0, 0, 0); PG8_SCHED; PG8_LDA(At, 0, 0); PG8_STAGE(PG8_SA(1, 1), a1 + hstepA, voffA);
            PG8_WAIT_L(8); PG8_BAR; PG8_WAIT_L(0); PG8_MMA(0, 0, At, B0); PG8_BAR; PG8_SCHED;
            PG8_LDB(B1, 0, 1); PG8_STAGE(PG8_SB(0, 0), b2, voffB);
            PG8_BAR; PG8_WAIT_L(0); PG8_MMA(0, 1, At, B1); PG8_BAR;
            PG8_LDA(At, 0, 1); PG8_STAGE(PG8_SA(0, 0), a2, voffA);
            PG8_BAR; PG8_WAIT_L(0); PG8_MMA(1, 0, At, B0); PG8_BAR; PG8_SCHED;
            PG8_STAGE(PG8_SB(0, 1), b2 + hstepB, voffB);
            PG8_WAIT_V(6); PG8_BAR; PG8_MMA(1, 1, At, B1); PG8_BAR;
            PG8_LDB(B0, 1, 0); PG8_SCHED; PG8_LDA(At, 1, 0); PG8_STAGE(PG8_SA(0, 1), a2 + hstepA, voffA);
            PG8_WAIT_L(8); PG8_BAR; PG8_WAIT_L(0); PG8_MMA(0, 0, At, B0); PG8_BAR; PG8_SCHED;
            PG8_LDB(B1, 1, 1); PG8_STAGE(PG8_SB(1, 0), b3, voffB);
            PG8_BAR; PG8_WAIT_L(0); PG8_MMA(0, 1, At, B1); PG8_BAR;
            PG8_LDA(At, 1, 1); PG8_STAGE(PG8_SA(1, 0), a3, voffA);
            PG8_BAR; PG8_WAIT_L(0); PG8_MMA(1, 0, At, B0); PG8_BAR; PG8_SCHED;
            PG8_STAGE(PG8_SB(1, 1), b3 + hstepB, voffB);
            PG8_WAIT_V(6); PG8_BAR; PG8_MMA(1, 1, At, B1); PG8_BAR;
        }
        E(acc, cur, wr, wc, fr, fq);
        if (!has_next) break;
#pragma unroll
        for (int a = 0; a < 2; ++a)
#pragma unroll
            for (int b = 0; b < 2; ++b)
#pragma unroll
                for (int m = 0; m < 4; ++m)
#pragma unroll
                    for (int n = 0; n < 2; ++n) acc[a][b][m][n] = (f32x4){0.f, 0.f, 0.f, 0.f};
        cur = nxt; cA = nA; cB = nB; ++ui;
    }
    PG8_WAIT_V(0);
    if (wr == 0) PG8_BAR;
    PG8_BAR;
#undef PG8_SA
#undef PG8_SB
#undef PG8_STAGE
#undef PG8_LDA
#undef PG8_LDB
#undef PG8_MMA
#undef PG8_WAIT_V
#undef PG8_WAIT_L
#undef PG8_BAR
#undef PG8_SCHED
#endif
}
}

enum { GK_STORE = 0, GK_GATE0, GK_GATE1, GK_GATE2, GK_PROJ0, GK_PROJ1, GK_PROJ2, GK_RESID };
enum { GP_INPROJ = 0, GP_MERGE, GP_WOUT, GP_QUERY };
struct GemmProg {
    const char* act; const char* wt;
    int which, G, c;
    __device__ __forceinline__ bool next(int i, pg8::Unit& u) const {
        constexpr int nM = M_ / 256;
        constexpr size_t rowA = (size_t)256 * LDZ * 2, rowB = (size_t)256 * 1024 * 2;
        if (which == GP_MERGE) {
            const int L = (i / 6) * G + c, j = i % 6, br = j >> 1;
            if (L >= nM * 4) return false;
            pg8::tile_of(L, nM, 4, u.pm, u.pn);
            if ((j & 1) == 0) { u.A = act + (size_t)C_XN * 2; u.B = wt + ((size_t)(WT_MG + br * 1024) * 1024) * 2; u.kind = GK_GATE0 + br; }
            else { u.A = act + (size_t)(br == 0 ? C_YA : (br == 1 ? C_YB : C_YC)) * 2; u.B = wt + ((size_t)(WT_P + br * 1024) * 1024) * 2; u.kind = GK_PROJ0 + br; }
        } else {
            const int nN = which == GP_INPROJ ? ZN / 256 : (which == GP_WOUT ? 4 : 8);
            const int L = i * G + c;
            if (L >= nM * nN) return false;
            pg8::tile_of(L, nM, nN, u.pm, u.pn);
            u.A = act + (size_t)(which == GP_WOUT ? C_MG : C_XN) * 2;
            u.B = wt + ((size_t)(which == GP_INPROJ ? WT_IN : (which == GP_WOUT ? WT_OUT : WT_Q)) * 1024) * 2;
            u.kind = which == GP_WOUT ? GK_RESID : GK_STORE;
        }
        u.A += (size_t)u.pm * rowA; u.B += (size_t)u.pn * rowB;
        return true;
    }
};
struct GemmEpi {
    h16_t* act; const float* mb; const float* resid; float* out;
    __device__ __forceinline__ void operator()(const pg8::f32x4 (&acc)[2][2][4][2], const pg8::Unit& u, int wr, int wc, int fr, int fq) const {
        const int row0 = u.pm * 256 + wr * 64 + fr, col0 = u.pn * 256 + wc * 32 + 8 * fq;
#pragma unroll
        for (int ai = 0; ai < 2; ++ai)
#pragma unroll
            for (int m = 0; m < 4; ++m) {
                const int row = row0 + ai * 128 + m * 16;
#pragma unroll
                for (int bj = 0; bj < 2; ++bj) {
                    const int col = col0 + bj * 128;
                    float v[8];
#pragma unroll
                    for (int e = 0; e < 4; ++e) { v[e] = acc[ai][bj][m][0][e]; v[4 + e] = acc[ai][bj][m][1][e]; }
                    h16_t* arow = act + (size_t)row * LDZ;
                    if (u.kind == GK_STORE) {
                        store8h(arow + col, v);
                    } else if (u.kind <= GK_GATE2) {
                        const float* bp = mb + (u.kind - GK_GATE0) * 1024 + col;
                        const float4 b0 = *(const float4*)bp, b1 = *(const float4*)(bp + 4);
                        v[0] = sigmoidf_(v[0] + b0.x); v[1] = sigmoidf_(v[1] + b0.y); v[2] = sigmoidf_(v[2] + b0.z); v[3] = sigmoidf_(v[3] + b0.w);
                        v[4] = sigmoidf_(v[4] + b1.x); v[5] = sigmoidf_(v[5] + b1.y); v[6] = sigmoidf_(v[6] + b1.z); v[7] = sigmoidf_(v[7] + b1.w);
                        store8h(arow + C_GS + col, v);
                    } else if (u.kind <= GK_PROJ2) {
                        float g[8]; load8h(arow + C_GS + col, g);
                        if (u.kind == GK_PROJ0) {
#pragma unroll
                            for (int e = 0; e < 8; ++e) v[e] = g[e] * v[e];
                        } else {
                            float o[8]; load8h(arow + C_MG + col, o);
#pragma unroll
                            for (int e = 0; e < 8; ++e) v[e] = o[e] + g[e] * v[e];
                        }
                        store8h(arow + C_MG + col, v);
                    } else {
                        const size_t o = (size_t)row * 1024 + col;
                        const float4 r0 = *(const float4*)(resid + o), r1 = *(const float4*)(resid + o + 4);
                        *(float4*)(out + o) = make_float4(r0.x + v[0], r0.y + v[1], r0.z + v[2], r0.w + v[3]);
                        *(float4*)(out + o + 4) = make_float4(r1.x + v[4], r1.y + v[5], r1.z + v[6], r1.w + v[7]);
                    }
                }
            }
    }
};
__device__ __forceinline__ void stage_gemm(KParams p, int l, int which, char* smem) {
    GemmProg S; S.act = p->ws + OFF_ACT; S.wt = p->ws + OFF_WT + (size_t)l * WT_ROWS * 1024 * 2; S.which = which; S.G = gridDim.x; S.c = bid_();
    GemmEpi E; E.act = (h16_t*)(p->ws + OFF_ACT); E.mb = p->in[I_MB] + l * 3072; E.resid = l == 0 ? p->in[I_X] : p->out; E.out = p->out;
    pg8::gemm_phase(smem, S, E);
}

#ifdef CPU_EMU
__device__ __forceinline__ float group_sum(float v, int width, float* scratch) {
    const int tid = tid_();
    scratch[tid] = v;
    __syncthreads();
    float s = 0.f; const int base = tid & ~(width - 1);
    for (int i = 0; i < width; ++i) s += scratch[base + i];
    __syncthreads();
    return s;
}
#else
__device__ __forceinline__ float group_sum(float v, int width, float*) {
    for (int off = width >> 1; off > 0; off >>= 1) v += __shfl_xor(v, off);
    return v;
}
#endif

__device__ __forceinline__ void stage_lru(KParams p, int l, char* smem, int vb0, int nvb) {
    const int vb = bid_() - vb0;
    if (vb < 0 || vb >= nvb) return;
    constexpr int CH = 64;
    float* wa_s = (float*)smem;
    float* wx_s = wa_s + 4096;
    float* xcT = wx_s + 4096;
    float* a_s = xcT + 64 * CH;
    float* b_s = a_s + CH * 64;
    h16_t* ACT = (h16_t*)(p->ws + OFF_ACT);
    const int tid = tid_(), c = tid & 63, tg = tid >> 6;
    for (int item = vb; item < B_ * 16; item += nvb) {
        const int b = item / 16, n = item % 16, ch = n * 64 + c;
        __syncthreads();
        for (int i = tid; i < 4096; i += NT) { wa_s[i] = p->in[I_LWA][((size_t)l * 16 + n) * 4096 + i]; wx_s[i] = p->in[I_LWX][((size_t)l * 16 + n) * 4096 + i]; }
        const float cw0 = p->in[I_LCW][((size_t)l * 4 + 0) * 1024 + ch], cw1 = p->in[I_LCW][((size_t)l * 4 + 1) * 1024 + ch];
        const float cw2 = p->in[I_LCW][((size_t)l * 4 + 2) * 1024 + ch], cw3 = p->in[I_LCW][((size_t)l * 4 + 3) * 1024 + ch];
        const float cb = p->in[I_LCB][l * 1024 + ch], ba = p->in[I_LBA][l * 1024 + ch], bx = p->in[I_LBX][l * 1024 + ch];
        const float sp = softplusf_(-p->in[I_LLAM][l * 1024 + ch]);
        float hst = 0.f;
#pragma unroll 1
        for (int t0 = 0; t0 < T_; t0 += CH) {
            float xc[8];
            {
                const h16_t* up = ACT + ((size_t)b * T_ + t0 + tg * 8) * LDZ + Z_ULRU + ch;
                float u[11];
#pragma unroll
                for (int s = 0; s < 11; ++s) { const int t = t0 + tg * 8 + s - 3; u[s] = t >= 0 ? h2f(up[(ptrdiff_t)(s - 3) * LDZ]) : 0.f; }
#pragma unroll
                for (int s = 0; s < 8; ++s) { xc[s] = cw0 * u[s] + cw1 * u[s + 1] + cw2 * u[s + 2] + cw3 * u[s + 3] + cb; xcT[c * CH + tg * 8 + s] = xc[s]; }
            }
            __syncthreads();
            {
                float dr[8], di[8];
#pragma unroll
                for (int s = 0; s < 8; ++s) { dr[s] = 0.f; di[s] = 0.f; }
#pragma unroll 4
                for (int i = 0; i < 64; ++i) {
                    const float wa = wa_s[i * 64 + c], wx = wx_s[i * 64 + c];
                    const float4 x0 = *(const float4*)(xcT + i * CH + tg * 8), x1 = *(const float4*)(xcT + i * CH + tg * 8 + 4);
                    dr[0] += x0.x * wa; dr[1] += x0.y * wa; dr[2] += x0.z * wa; dr[3] += x0.w * wa; dr[4] += x1.x * wa; dr[5] += x1.y * wa; dr[6] += x1.z * wa; dr[7] += x1.w * wa;
                    di[0] += x0.x * wx; di[1] += x0.y * wx; di[2] += x0.z * wx; di[3] += x0.w * wx; di[4] += x1.x * wx; di[5] += x1.y * wx; di[6] += x1.z * wx; di[7] += x1.w * wx;
                }
#pragma unroll
                for (int s = 0; s < 8; ++s) {
                    const float r = sigmoidf_(dr[s] + ba), ig = sigmoidf_(di[s] + bx);
                    const float log_a = -8.0f * r * sp;
                    a_s[(tg * 8 + s) * 64 + c] = expf(log_a);
                    b_s[(tg * 8 + s) * 64 + c] = sqrtf(-expm1f(2.0f * log_a)) * (ig * xc[s]);
                }
            }
            __syncthreads();
            if (tid < 64) {
#pragma unroll 8
                for (int t = 0; t < CH; ++t) { hst = a_s[t * 64 + c] * hst + b_s[t * 64 + c]; b_s[t * 64 + c] = hst; }
            }
            __syncthreads();
#pragma unroll
            for (int s = 0; s < 8; ++s) {
                h16_t* gp = ACT + ((size_t)b * T_ + t0 + tg * 8 + s) * LDZ + Z_GLRU + ch;
                *gp = f2h(b_s[(tg * 8 + s) * 64 + c] * geluf_(h2f(*gp)));
            }
        }
    }
}

__device__ __forceinline__ void stage_gdn(KParams p, int l, char* smem, int vb0, int nvb) {
    const int vb = bid_() - vb0;
    if (vb < 0 || vb >= nvb) return;
    constexpr int CH = 32;
    float* q_s = (float*)smem;
    float* k_s = q_s + CH * 128;
    float* v_s = k_s + CH * 128;
    float* o_s = v_s + CH * 128;
    float* sc_s = o_s + CH * 128;
    float* scr = sc_s + CH * 2;
    h16_t* ACT = (h16_t*)(p->ws + OFF_ACT);
    const int tid = tid_(), lane = tid & 63, wv = tid >> 6;
    const int col = tid >> 2, q4 = tid & 3;
    for (int item = vb; item < B_ * 8; item += nvb) {
        const int b = item / 8, h = item % 8;
        const float a_exp = expf(p->in[I_GALOG][l * 8 + h]), dtb = p->in[I_GDT][l * 8 + h];
        const int cc = tid;
        const int gch = cc < 128 ? (h * 128 + cc) : (cc < 256 ? (1024 + h * 128 + cc - 128) : (2048 + h * 128 + cc - 256));
        float cw[4] = {0.f, 0.f, 0.f, 0.f};
        if (cc < 384) {
#pragma unroll
            for (int jj = 0; jj < 4; ++jj) cw[jj] = p->in[I_GCW][((size_t)l * 4 + jj) * 3072 + gch];
        }
        const float nw = p->in[I_GNW][l * 128 + (tid & 127)];
        float S[32];
#pragma unroll
        for (int k = 0; k < 32; ++k) S[k] = 0.f;
        float x1 = 0.f, x2 = 0.f, x3 = 0.f;
        __syncthreads();
#pragma unroll 1
        for (int t0 = 0; t0 < T_; t0 += CH) {
            if (cc < 384) {
                const h16_t* zp = ACT + ((size_t)b * T_ + t0) * LDZ + Z_Q + gch;
                float* dst = cc < 128 ? (q_s + cc) : (cc < 256 ? (k_s + cc - 128) : (v_s + cc - 256));
#pragma unroll 8
                for (int t = 0; t < CH; ++t) {
                    const float x0 = h2f(zp[(size_t)t * LDZ]);
                    const float cv = cw[0] * x3 + cw[1] * x2 + cw[2] * x1 + cw[3] * x0;
                    x3 = x2; x2 = x1; x1 = x0;
                    dst[t * 128] = siluf_(cv);
                }
            }
            __syncthreads();
#pragma unroll
            for (int s = 0; s < 4; ++s) {
                const int t = wv * 4 + s;
                const float qa = q_s[t * 128 + lane], qb = q_s[t * 128 + 64 + lane], ka = k_s[t * 128 + lane], kb = k_s[t * 128 + 64 + lane];
                const float sq = group_sum(qa * qa + qb * qb, 64, scr), sk = group_sum(ka * ka + kb * kb, 64, scr);
                const float rq = rsqrtf(sq + RMS_EPS) * 0.08838834764831845f, rk = rsqrtf(sk + RMS_EPS);
                q_s[t * 128 + lane] = qa * rq; q_s[t * 128 + 64 + lane] = qb * rq; k_s[t * 128 + lane] = ka * rk; k_s[t * 128 + 64 + lane] = kb * rk;
                if (lane == 0) {
                    const size_t m = (size_t)b * T_ + t0 + t;
                    sc_s[t * 2] = sigmoidf_(h2f(ACT[m * LDZ + Z_BETA + h]));
                    sc_s[t * 2 + 1] = expf(-a_exp * softplusf_(h2f(ACT[m * LDZ + Z_ALPHA + h]) + dtb));
                }
            }
            __syncthreads();
#pragma unroll 1
            for (int t = 0; t < CH; ++t) {
                const float* kp = k_s + t * 128 + q4 * 32; const float* qp = q_s + t * 128 + q4 * 32;
                float kr[32];
#pragma unroll
                for (int k = 0; k < 32; k += 4) { const float4 kv = *(const float4*)(kp + k); kr[k] = kv.x; kr[k + 1] = kv.y; kr[k + 2] = kv.z; kr[k + 3] = kv.w; }
                float pk = 0.f;
#pragma unroll
                for (int k = 0; k < 32; ++k) pk += S[k] * kr[k];
                const float kS = group_sum(pk, 4, scr);
                const float beta = sc_s[t * 2], eg = sc_s[t * 2 + 1];
                const float cf = beta * (v_s[t * 128 + col] - eg * kS);
                float po = 0.f;
#pragma unroll
                for (int k = 0; k < 32; k += 4) {
                    const float4 qv = *(const float4*)(qp + k);
                    S[k] = eg * S[k] + kr[k] * cf; S[k + 1] = eg * S[k + 1] + kr[k + 1] * cf; S[k + 2] = eg * S[k + 2] + kr[k + 2] * cf; S[k + 3] = eg * S[k + 3] + kr[k + 3] * cf;
                    po += S[k] * qv.x + S[k + 1] * qv.y + S[k + 2] * qv.z + S[k + 3] * qv.w;
                }
                const float o = group_sum(po, 4, scr);
                if (q4 == 0) o_s[t * 128 + col] = o;
            }
            __syncthreads();
#pragma unroll
            for (int s = 0; s < 4; ++s) {
                const int t = wv * 4 + s;
                const float oa = o_s[t * 128 + lane], ob = o_s[t * 128 + 64 + lane];
                const float ms = group_sum(oa * oa + ob * ob, 64, scr);
                const float rs = rsqrtf(ms * (1.0f / 128.0f) + RMS_EPS);
                h16_t* zg = ACT + ((size_t)b * T_ + t0 + t) * LDZ + Z_ZG + h * 128;
                const float nwa = p->in[I_GNW][l * 128 + lane], nwb = p->in[I_GNW][l * 128 + 64 + lane];
                zg[lane] = f2h(oa * rs * nwa * siluf_(h2f(zg[lane])));
                zg[64 + lane] = f2h(ob * rs * nwb * siluf_(h2f(zg[64 + lane])));
            }
            (void)nw;
        }
    }
}

__device__ __forceinline__ void stage_rwkv(KParams p, int l, char* smem, int vb0, int nvb) {
    const int vb = bid_() - vb0;
    if (vb < 0 || vb >= nvb) return;
    constexpr int CH = 32;
    float* r_s = (float*)smem;
    float* k_s = r_s + CH * 64;
    float* v_s = k_s + CH * 64;
    float* w_s = v_s + CH * 64;
    float* kk_s = w_s + CH * 64;
    float* ka_s = kk_s + CH * 64;
    float* g_s = ka_s + CH * 64;
    float* o_s = g_s + CH * 64;
    float* lwT = o_s + CH * 64;
    float* laT = lwT + 64 * CH;
    float* lgT = laT + 64 * CH;
    float* bon_s = lgT + 128 * CH;
    float* scr = bon_s + CH;
    const h16_t* ACT = (const h16_t*)(p->ws + OFF_ACT);
    h16_t* ACTw = (h16_t*)(p->ws + OFF_ACT);
    const int tid = tid_(), c = tid & 63, tg = tid >> 6;
    const int ri = tid >> 3, q8 = tid & 7;
    for (int item = vb; item < B_ * 16; item += nvb) {
        const int b = item / 16, h = item % 16, ch = h * 64 + c;
        const float w0 = p->in[I_RW0][l * 1024 + ch], a0 = p->in[I_RA0][l * 1024 + ch], k_k = p->in[I_RKK][l * 1024 + ch], k_a = p->in[I_RKA][l * 1024 + ch];
        const float rk_c = p->in[I_RRK][(size_t)l * 1024 + ch];
        const float lnw = p->in[I_RLW][l * 1024 + ch], lnb = p->in[I_RLB][l * 1024 + ch];
        const float* mu = p->in[I_RMU] + (size_t)l * RWW;
        const float mu_r = mu[RW_R + ch], mu_k = mu[RW_K + ch], mu_v = mu[RW_V + ch];
        const float mu_wl = mu[RW_WL + c], mu_al = mu[RW_AL + c], mu_g0 = mu[RW_GL + c], mu_g1 = mu[RW_GL + 64 + c];
        const float* wup = p->in[I_RWUP] + (size_t)l * 64 * 1024 + ch; const float* aup = p->in[I_RAUP] + (size_t)l * 64 * 1024 + ch; const float* gup = p->in[I_RGUP] + (size_t)l * 128 * 1024 + ch;
        float S[8];
#pragma unroll
        for (int e = 0; e < 8; ++e) S[e] = 0.f;
        __syncthreads();
#pragma unroll 1
        for (int t0 = 0; t0 < T_; t0 += CH) {
#pragma unroll
            for (int s = 0; s < 4; ++s) {
                const int tl = tg * 4 + s, t = t0 + tl;
                const h16_t* zc = ACT + ((size_t)b * T_ + t) * LDZ + Z_RW;
                const h16_t* zp = zc - LDZ;
                const bool hp = t > 0;
#define RW_SHIFT(col, muv) ({ const float zz = h2f(zc[col]); zz + (muv) * ((hp ? h2f(zp[col]) : 0.f) - zz); })
                r_s[tl * 64 + c] = RW_SHIFT(RW_R + ch, mu_r);
                k_s[tl * 64 + c] = RW_SHIFT(RW_K + ch, mu_k);
                v_s[tl * 64 + c] = RW_SHIFT(RW_V + ch, mu_v);
                lwT[c * CH + tl] = tanhf(RW_SHIFT(RW_WL + c, mu_wl));
                laT[c * CH + tl] = RW_SHIFT(RW_AL + c, mu_al);
                lgT[c * CH + tl] = sigmoidf_(RW_SHIFT(RW_GL + c, mu_g0));
                lgT[(64 + c) * CH + tl] = sigmoidf_(RW_SHIFT(RW_GL + 64 + c, mu_g1));
#undef RW_SHIFT
            }
            __syncthreads();
            {
                float dw[4] = {0.f, 0.f, 0.f, 0.f}, da[4] = {0.f, 0.f, 0.f, 0.f}, dg[4] = {0.f, 0.f, 0.f, 0.f};
#pragma unroll 4
                for (int i = 0; i < 64; ++i) {
                    const float ww = wup[(size_t)i * 1024], aw = aup[(size_t)i * 1024];
                    const float4 x = *(const float4*)(lwT + i * CH + tg * 4), y = *(const float4*)(laT + i * CH + tg * 4);
                    dw[0] += x.x * ww; dw[1] += x.y * ww; dw[2] += x.z * ww; dw[3] += x.w * ww;
                    da[0] += y.x * aw; da[1] += y.y * aw; da[2] += y.z * aw; da[3] += y.w * aw;
                }
#pragma unroll 4
                for (int i = 0; i < 128; ++i) {
                    const float gw = gup[(size_t)i * 1024];
                    const float4 x = *(const float4*)(lgT + i * CH + tg * 4);
                    dg[0] += x.x * gw; dg[1] += x.y * gw; dg[2] += x.z * gw; dg[3] += x.w * gw;
                }
#pragma unroll
                for (int s = 0; s < 4; ++s) {
                    const int tl = tg * 4 + s;
                    const float w_log = -softplusf_(-(w0 + dw[s])) - 0.5f;
                    const float decay = expf(-expf(w_log));
                    const float a = sigmoidf_(a0 + da[s]);
                    const float kx = k_s[tl * 64 + c], rx = r_s[tl * 64 + c];
                    const float kkr = kx * k_k, k2 = kx * (1.0f + (a - 1.0f) * k_a);
                    const float nsq = group_sum(kkr * kkr, 64, scr);
                    const float bon = group_sum(rx * k2 * rk_c, 64, scr);
                    const float kkn = kkr * rsqrtf(nsq + RMS_EPS);
                    w_s[tl * 64 + c] = decay; k_s[tl * 64 + c] = k2; kk_s[tl * 64 + c] = kkn; ka_s[tl * 64 + c] = kkn * a; g_s[tl * 64 + c] = dg[s];
                    if (c == 0) bon_s[tl] = bon;
                }
            }
            __syncthreads();
#pragma unroll 1
            for (int t = 0; t < CH; ++t) {
                const int o8 = t * 64 + q8 * 8;
                const float4 kk0 = *(const float4*)(kk_s + o8), kk1 = *(const float4*)(kk_s + o8 + 4);
                float pk = S[0] * kk0.x + S[1] * kk0.y + S[2] * kk0.z + S[3] * kk0.w + S[4] * kk1.x + S[5] * kk1.y + S[6] * kk1.z + S[7] * kk1.w;
                const float skk = group_sum(pk, 8, scr);
                const float vi = v_s[t * 64 + ri];
                const float4 w0v = *(const float4*)(w_s + o8), w1v = *(const float4*)(w_s + o8 + 4);
                const float4 a0v = *(const float4*)(ka_s + o8), a1v = *(const float4*)(ka_s + o8 + 4);
                const float4 k0v = *(const float4*)(k_s + o8), k1v = *(const float4*)(k_s + o8 + 4);
                const float4 r0v = *(const float4*)(r_s + o8), r1v = *(const float4*)(r_s + o8 + 4);
                S[0] = S[0] * w0v.x - skk * a0v.x + vi * k0v.x; S[1] = S[1] * w0v.y - skk * a0v.y + vi * k0v.y; S[2] = S[2] * w0v.z - skk * a0v.z + vi * k0v.z; S[3] = S[3] * w0v.w - skk * a0v.w + vi * k0v.w;
                S[4] = S[4] * w1v.x - skk * a1v.x + vi * k1v.x; S[5] = S[5] * w1v.y - skk * a1v.y + vi * k1v.y; S[6] = S[6] * w1v.z - skk * a1v.z + vi * k1v.z; S[7] = S[7] * w1v.w - skk * a1v.w + vi * k1v.w;
                const float po = S[0] * r0v.x + S[1] * r0v.y + S[2] * r0v.z + S[3] * r0v.w + S[4] * r1v.x + S[5] * r1v.y + S[6] * r1v.z + S[7] * r1v.w;
                const float o = group_sum(po, 8, scr);
                if (q8 == 0) o_s[t * 64 + ri] = o;
            }
            __syncthreads();
#pragma unroll
            for (int s = 0; s < 4; ++s) {
                const int tl = tg * 4 + s;
                const float ov = o_s[tl * 64 + c];
                const float mean = group_sum(ov, 64, scr) * (1.0f / 64.0f);
                const float d = ov - mean;
                const float var = group_sum(d * d, 64, scr) * (1.0f / 64.0f);
                const float y = (d * rsqrtf(var + GN_EPS) * lnw + lnb + bon_s[tl] * v_s[tl * 64 + c]) * g_s[tl * 64 + c];
                ACTw[((size_t)b * T_ + t0 + tl) * LDZ + C_YC + ch] = f2h(y);
            }
            __syncthreads();
        }
    }
}

constexpr bool TAB_IN_ACT = (M_ == 16384);
__device__ __forceinline__ h16_t* tab_row(char* ws, int which, int e) {
    if (TAB_IN_ACT) return (h16_t*)(ws + OFF_ACT) + (size_t)e * LDZ + (which ? C_MG : C_GS);
    return (h16_t*)(ws + OFF_TAB) + ((size_t)which * 16384 + e) * 1024;
}
__device__ __forceinline__ void stage_tabconv(KParams p, int l) {
    const int tid = tid_();
    const float* U = p->in[I_PU] + (size_t)l * 16384 * 1024; const float* V = p->in[I_PV] + (size_t)l * 16384 * 1024;
    char* ws = p->ws;
    for (int it = bid_() * NT + tid; it < 2 * 16384 * 128; it += gridDim.x * NT) {
        const int which = it >= 16384 * 128, r = (it >> 7) & 16383, ck = it & 127;
        const float* src = (which ? V : U) + (size_t)r * 1024 + ck * 8;
        const float4 a = *(const float4*)src, b = *(const float4*)(src + 4);
        const float v[8] = {a.x, a.y, a.z, a.w, b.x, b.y, b.z, b.w};
        store8h(tab_row(ws, which, r) + ck * 8, v);
    }
}

__device__ __forceinline__ void stage_peer_topk(KParams p, int l, char* smem) {
    float* key_s = (float*)smem;
    const h16_t* ACT = (const h16_t*)(p->ws + OFF_ACT);
    float* TOPS = (float*)(p->ws + OFF_TOPS);
    const int tid = tid_();
    const int nb = gridDim.x;
    for (int hs = bid_() % 16; hs < 16; hs += nb) {
        const int hd = hs >> 1, s = hs & 1;
        __syncthreads();
        {
            const float* kp = p->in[I_PKEYS] + (((size_t)l * 8 + hd) * 2 + s) * 128 * 128;
            for (int i = tid * 4; i < 128 * 128; i += NT * 4) *(float4*)(key_s + i) = *(const float4*)(kp + i);
        }
        __syncthreads();
        const int nblk = nb >= 16 ? nb / 16 : 1, bsub = nb >= 16 ? bid_() / 16 : 0;
        for (int chunk = bsub; chunk < (M_ + NT - 1) / NT; chunk += nblk) {
            if (nb >= 16 && bid_() >= nblk * 16) break;
            const int m = chunk * NT + tid;
            if (m >= M_) continue;
            float q[128];
            {
                const h16_t* qp = ACT + (size_t)m * LDZ + C_QRY + hd * 256 + s * 128;
#pragma unroll
                for (int c8 = 0; c8 < 16; ++c8) { float t8[8]; load8h(qp + c8 * 8, t8);
#pragma unroll
                    for (int j = 0; j < 8; ++j) q[c8 * 8 + j] = t8[j]; }
            }
            float top[16];
#pragma unroll
            for (int i = 0; i < 16; ++i) top[i] = -3.0e38f;
#pragma unroll 2
            for (int n = 0; n < 128; ++n) {
                const float* kr = key_s + n * 128;
                float a0 = 0.f, a1 = 0.f, a2 = 0.f, a3 = 0.f;
#pragma unroll
                for (int c4 = 0; c4 < 32; ++c4) {
                    const float4 kv = *(const float4*)(kr + c4 * 4);
                    a0 += q[c4 * 4] * kv.x; a1 += q[c4 * 4 + 1] * kv.y; a2 += q[c4 * 4 + 2] * kv.z; a3 += q[c4 * 4 + 3] * kv.w;
                }
                float x = __uint_as_float((__float_as_uint((a0 + a1) + (a2 + a3)) & ~127u) | (unsigned)(127 - n));
#pragma unroll
                for (int i = 0; i < 16; ++i) { const float hi = fmaxf(top[i], x); x = fminf(top[i], x); top[i] = hi; }
            }
            float* tp = TOPS + (((size_t)m * 8 + hd) * 2 + s) * 16;
#pragma unroll
            for (int i = 0; i < 16; i += 4) *(float4*)(tp + i) = make_float4(top[i], top[i + 1], top[i + 2], top[i + 3]);
        }
    }
}

__device__ __forceinline__ void peer_cand(int k, int& i, int& j) {
    if (k < 16) { i = 0; j = k; } else if (k < 24) { i = 1; j = k - 16; } else if (k < 29) { i = 2; j = k - 24; } else if (k < 33) { i = 3; j = k - 29; }
    else if (k < 36) { i = 4; j = k - 33; } else if (k < 38) { i = 5; j = k - 36; } else if (k < 40) { i = 6; j = k - 38; } else if (k < 42) { i = 7; j = k - 40; }
    else { i = k - 34; j = 0; }
}
__device__ __forceinline__ float dot8h(const uint4 a, const float (&x)[8]) {
    float s = 0.f;
    s += h2f((h16_t)(a.x & 0xffffu)) * x[0]; s += h2f((h16_t)(a.x >> 16)) * x[1]; s += h2f((h16_t)(a.y & 0xffffu)) * x[2]; s += h2f((h16_t)(a.y >> 16)) * x[3];
    s += h2f((h16_t)(a.z & 0xffffu)) * x[4]; s += h2f((h16_t)(a.z >> 16)) * x[5]; s += h2f((h16_t)(a.w & 0xffffu)) * x[6]; s += h2f((h16_t)(a.w >> 16)) * x[7];
    return s;
}
__device__ __forceinline__ void axpy8h(const uint4 a, float s, float (&y)[8]) {
    y[0] += s * h2f((h16_t)(a.x & 0xffffu)); y[1] += s * h2f((h16_t)(a.x >> 16)); y[2] += s * h2f((h16_t)(a.y & 0xffffu)); y[3] += s * h2f((h16_t)(a.y >> 16));
    y[4] += s * h2f((h16_t)(a.z & 0xffffu)); y[5] += s * h2f((h16_t)(a.z >> 16)); y[6] += s * h2f((h16_t)(a.w & 0xffffu)); y[7] += s * h2f((h16_t)(a.w >> 16));
}
__device__ __forceinline__ void stage_peer_gather(KParams p, int l, char* smem) {
    float* tops_s = (float*)smem;
    float* cand_s = tops_s + 256;
    float* best_s = cand_s + 512;
    int* idx_s = (int*)(best_s + 128);
    float* gate_s = (float*)(idx_s + 128);
    float* part_s = gate_s + 128;
    float* ysum_s = part_s + 8 * 16 * 64;
    const h16_t* ACT = (const h16_t*)(p->ws + OFF_ACT);
    const float* TOPS = (const float*)(p->ws + OFF_TOPS);
    char* ws = p->ws;
    const int tid = tid_(), w = tid >> 6, lane = tid & 63;
    for (int m = bid_(); m < M_; m += gridDim.x) {
        __syncthreads();
        if (tid < 256) tops_s[tid] = TOPS[(size_t)m * 256 + tid];
        __syncthreads();
        int ci = 0, cj = 0; float cs = -3.0e38f;
        if (lane < 50) { peer_cand(lane, ci, cj); cs = tops_s[w * 32 + ci] + tops_s[w * 32 + 16 + cj]; }
        cand_s[w * 64 + lane] = cs;
        __syncthreads();
        if (lane < 50) {
            int cnt = 0; const int pos = ci * 16 + cj;
            for (int o = 0; o < 50; ++o) { int oi, oj; peer_cand(o, oi, oj); const float ov = cand_s[w * 64 + o]; cnt += (ov > cs || (ov == cs && oi * 16 + oj < pos)) ? 1 : 0; }
            if (cnt < 16) {
                best_s[w * 16 + cnt] = cs;
                const int n0 = 127 - (int)(__float_as_uint(tops_s[w * 32 + ci]) & 127u), n1 = 127 - (int)(__float_as_uint(tops_s[w * 32 + 16 + cj]) & 127u);
                idx_s[w * 16 + cnt] = n0 * 128 + n1;
            }
        }
        __syncthreads();
        if (tid < 128) {
            const int hd = tid >> 4;
            const float mx = best_s[hd * 16];
            float sum = 0.f;
            for (int i = 0; i < 16; ++i) sum += expf(best_s[hd * 16 + i] - mx);
            gate_s[tid] = expf(best_s[tid] - mx) / sum;
        }
        float x0[8], x1[8];
        load8h(ACT + (size_t)m * LDZ + C_XN + lane * 8, x0); load8h(ACT + (size_t)m * LDZ + C_XN + 512 + lane * 8, x1);
        __syncthreads();
        float* pw = part_s + w * 1024;
#pragma unroll 4
        for (int k = 0; k < 16; ++k) {
            const h16_t* ur = tab_row(ws, 0, idx_s[w * 16 + k]);
            const uint4 u0 = *(const uint4*)(ur + lane * 8), u1 = *(const uint4*)(ur + 512 + lane * 8);
            pw[k * 64 + lane] = dot8h(u0, x0) + dot8h(u1, x1);
        }
        __syncthreads();
        float hid;
        {
            const int k = lane >> 2, qq = lane & 3;
            float s = 0.f;
#pragma unroll
            for (int i = 0; i < 16; ++i) s += pw[k * 64 + qq * 16 + i];
            pw[k * 64 + qq * 16] = s;
        }
        __syncthreads();
        float y0[8], y1[8];
#pragma unroll
        for (int i = 0; i < 8; ++i) { y0[i] = 0.f; y1[i] = 0.f; }
#pragma unroll 4
        for (int k = 0; k < 16; ++k) {
            const float dotv = pw[k * 64] + pw[k * 64 + 16] + pw[k * 64 + 32] + pw[k * 64 + 48];
            hid = gate_s[w * 16 + k] * geluf_(dotv);
            const h16_t* vr = tab_row(ws, 1, idx_s[w * 16 + k]);
            const uint4 v0 = *(const uint4*)(vr + lane * 8), v1 = *(const uint4*)(vr + 512 + lane * 8);
            axpy8h(v0, hid, y0); axpy8h(v1, hid, y1);
        }
        {
            float* yw = ysum_s + w * 1024;
#pragma unroll
            for (int i = 0; i < 8; ++i) { yw[lane * 8 + i] = y0[i]; yw[512 + lane * 8 + i] = y1[i]; }
        }
        __syncthreads();
        {
            float a0 = 0.f, a1 = 0.f;
#pragma unroll
            for (int ww = 0; ww < 8; ++ww) { a0 += ysum_s[ww * 1024 + tid * 2]; a1 += ysum_s[ww * 1024 + tid * 2 + 1]; }
            float2* op = (float2*)(p->out + (size_t)m * 1024 + tid * 2);
            float2 ov = *op;
            ov.x += a0; ov.y += a1;
            *op = ov;
        }
    }
}

enum { PH_NORM_MIX = 0, PH_INPROJ, PH_MIXERS, PH_MERGE, PH_WOUT, PH_NORM_FFN, PH_QUERY, PH_TOPK, PH_GATHER, PH_PER_LAYER, PH_FINAL = 100, PH_WPREP = 101 };
__device__ __forceinline__ void run_phase(KParams p, int l, int ph, char* smem) {
    h16_t* ACT = (h16_t*)(p->ws + OFF_ACT);
    const float* hin = l == 0 ? p->in[I_X] : p->out;
    switch (ph) {
    case PH_WPREP: stage_wprep(p, smem); break;
    case PH_NORM_MIX: stage_rmsnorm<false>(hin, p->in[I_NMIX] + l * 1024, ACT + C_XN, LDZ, smem); break;
    case PH_INPROJ: stage_gemm(p, l, GP_INPROJ, smem); break;
    case PH_MIXERS: {
        const int nb = gridDim.x, n_rw = nb / 2, n_gd = nb / 4, n_lr = nb - n_rw - n_gd;
        stage_rwkv(p, l, smem, 0, n_rw);
        stage_gdn(p, l, smem, n_rw, n_gd);
        stage_lru(p, l, smem, n_rw + n_gd, n_lr);
    } break;
    case PH_MERGE: stage_gemm(p, l, GP_MERGE, smem); break;
    case PH_WOUT: stage_gemm(p, l, GP_WOUT, smem); break;
    case PH_NORM_FFN: stage_rmsnorm<false>(p->out, p->in[I_NFFN] + l * 1024, ACT + C_XN, LDZ, smem); stage_tabconv(p, l); break;
    case PH_QUERY: stage_gemm(p, l, GP_QUERY, smem); break;
    case PH_TOPK: stage_peer_topk(p, l, smem); break;
    case PH_GATHER: stage_peer_gather(p, l, smem); break;
    case PH_FINAL: stage_rmsnorm<true>(p->out, p->in[I_NFINAL], p->out, 1024, smem); break;
    default: break;
    }
}

#if !defined(CPU_EMU) && !MK_MULTI
__global__ void __launch_bounds__(512, 2) k_mega(Params p_) {
    DYN_SMEM(smem);
    KParams pk = (KParams)__builtin_amdgcn_kernarg_segment_ptr();
    cg::grid_group grid = cg::this_grid();
    constexpr int NIT = NL_ * PH_PER_LAYER;
#pragma unroll 1
    for (int it = -1; it <= NIT; ++it) {
        const int l = (it >= 0 && it < NIT) ? it / PH_PER_LAYER : 0, ph = it < 0 ? (int)PH_WPREP : (it < NIT ? it % PH_PER_LAYER : (int)PH_FINAL);
        KParams q = pk; asm volatile("" : "+s"(q));
        run_phase(q, l, ph, smem);
        if (it < NIT && !(it < 0)) grid.sync();
    }
}
#endif
#ifdef CPU_EMU
__global__ void k_phase(Params p_, int l, int ph) { DYN_SMEM(smem); run_phase(&p_, l, ph, smem); }
#elif MK_MULTI
__global__ void __launch_bounds__(512, 2) k_phase(Params p_, int l, int ph) { DYN_SMEM(smem); KParams pk = (KParams)__builtin_amdgcn_kernarg_segment_ptr(); run_phase(pk, l, ph, smem); }
#endif
}

#ifdef CPU_EMU
int g_emu_stop = 1000;
#endif

extern "C" void kernel_launch(void* const* d_in, const int* in_sizes, int n_in, void* d_out, int out_size, void* d_ws, size_t ws_size, hipStream_t stream) {
    Params p{};
    for (int i = 0; i < N_IN; ++i) p.in[i] = (const float*)d_in[i];
    p.out = (float*)d_out; p.ws = (char*)d_ws;
#if defined(CPU_EMU) || MK_MULTI
    const int grid = 256;
    LAUNCH(k_phase, grid, NT, SMEM_BYTES, stream, p, 0, (int)PH_WPREP);
    for (int l = 0; l < NL_; ++l)
        for (int ph = 0; ph < PH_PER_LAYER; ++ph) {
            LAUNCH(k_phase, grid, NT, SMEM_BYTES, stream, p, l, ph);
#ifdef CPU_EMU
            const int code = ph == PH_INPROJ ? 1 : ph == PH_MIXERS ? 2 : ph == PH_MERGE ? 3 : ph == PH_WOUT ? 4 : ph == PH_GATHER ? 5 : 0;
            if (code && g_emu_stop == l * 10 + code) return;
#endif
        }
    LAUNCH(k_phase, grid, NT, SMEM_BYTES, stream, p, 0, (int)PH_FINAL);
#else
    static int grid_blocks = 0;
    if (!grid_blocks) {
        int dev = 0, cus = 0, per_cu = 0;
        (void)hipGetDevice(&dev);
        (void)hipDeviceGetAttribute(&cus, hipDeviceAttributeMultiprocessorCount, dev);
        (void)hipFuncSetAttribute((const void*)k_mega, hipFuncAttributeMaxDynamicSharedMemorySize, (int)SMEM_BYTES);
        (void)hipOccupancyMaxActiveBlocksPerMultiprocessor(&per_cu, k_mega, NT, SMEM_BYTES);
        if (per_cu > 1) per_cu = 1;
        grid_blocks = cus * per_cu;
    }
    void* args[] = {&p};
    hipError_t e = hipLaunchCooperativeKernel((void*)k_mega, dim3(grid_blocks), dim3(NT), args, SMEM_BYTES, stream);
    if (e != hipSuccess) fprintf(stderr, "cooperative launch failed: %s (grid %d)\n", hipGetErrorString(e), grid_blocks);
#endif
}
```

```cpp
#ifndef CPU_EMU
#include <hip/hip_runtime.h>
#include <hip/hip_cooperative_groups.h>
#include <cstdio>
#include <cstdint>
namespace cg = cooperative_groups;
#define DYN_SMEM(name) extern __shared__ __attribute__((aligned(16))) char name[]
#define LAUNCH(kern, grid, block, smem, stream, ...) hipLaunchKernelGGL(kern, dim3(grid), dim3(block), smem, stream, __VA_ARGS__)
#endif

#ifndef CFG_B
#define CFG_B 8
#endif
#ifndef CFG_T
#define CFG_T 2048
#endif
#ifndef MK_MULTI
#define MK_MULTI 0
#endif

namespace {
constexpr int B_ = CFG_B, T_ = CFG_T, M_ = B_ * T_, D_ = 1024, NL_ = 2, NT = 512;
constexpr int INW = 12560;
constexpr int LDZ = 11776;
constexpr int Z_ULRU = 0, Z_GLRU = 1024, Z_Q = 2048, Z_K = 3072, Z_V = 4096, Z_ZG = 5120, Z_RW = 6144, Z_ALPHA = 9472, Z_BETA = 9480;
constexpr int ZN = 9728;
constexpr int C_XN = 9728, C_YC = 10752;
constexpr int C_YA = Z_GLRU, C_YB = Z_ZG;
constexpr int C_GS = Z_Q, C_MG = Z_K;
constexpr int C_QRY = 0;
constexpr int RW_R = 0, RW_K = 1024, RW_V = 2048, RW_WL = 3072, RW_AL = 3136, RW_GL = 3200, RWW = 3328;
constexpr float RMS_EPS = 1e-6f, GN_EPS = 64e-5f;
typedef unsigned short h16_t;

enum { I_X = 0, I_NMIX, I_NFFN, I_NFINAL, I_WIN, I_LCW, I_LCB, I_LWA, I_LBA, I_LWX, I_LBX, I_LLAM, I_GCW, I_GALOG, I_GDT, I_GNW,
       I_RMU, I_RW0, I_RWUP, I_RA0, I_RAUP, I_RGUP, I_RKK, I_RKA, I_RRK, I_RLW, I_RLB, I_MB, I_PL, I_PG, I_PR, I_WOUT, I_PWQ, I_PKEYS, I_PU, I_PV, N_IN };

struct Params {
    const float* in[N_IN];
    float* out;
    char* ws;
};
#ifdef CPU_EMU
typedef const Params* KParams;
#else
typedef const Params __attribute__((address_space(4)))* KParams;
#endif

constexpr size_t al256(size_t x) { return (x + 255) / 256 * 256; }
constexpr size_t OFF_ACT = 0;
constexpr size_t OFF_WT = al256(OFF_ACT + (size_t)M_ * LDZ * 2);
constexpr int WT_IN = 0, WT_MG = ZN, WT_P = WT_MG + 3072, WT_OUT = WT_P + 3072, WT_Q = WT_OUT + 1024, WT_ROWS = WT_Q + 2048;
constexpr size_t OFF_TOPS = al256(OFF_WT + (size_t)NL_ * WT_ROWS * 1024 * 2);
constexpr size_t OFF_TAB = al256(OFF_TOPS + (size_t)M_ * 256 * 4);
constexpr size_t WS_END = OFF_TAB + (M_ == 16384 ? 0 : (size_t)2 * 16384 * 1024 * 2);
static_assert(CFG_B != 8 || CFG_T != 2048 || WS_END <= (size_t)512 * 1024 * 1024, "workspace budget");
constexpr size_t SMEM_BYTES = 128 * 1024;

#ifdef CPU_EMU
__device__ __forceinline__ int tid_() { return threadIdx.x; }
__device__ __forceinline__ h16_t f2h(float f) { return (h16_t)_cvtss_sh(f, _MM_FROUND_TO_NEAREST_INT); }
__device__ __forceinline__ float h2f(h16_t h) { return _cvtsh_ss(h); }
#else
__device__ __forceinline__ int tid_() { int t = threadIdx.x; asm volatile("" : "+v"(t)); return t; }
__device__ __forceinline__ h16_t f2h(float f) { return __builtin_bit_cast(unsigned short, (_Float16)f); }
__device__ __forceinline__ float h2f(h16_t h) { return (float)__builtin_bit_cast(_Float16, h); }
#endif
__device__ __forceinline__ int bid_() { return (int)blockIdx.x; }

__device__ __forceinline__ float sigmoidf_(float x) { return 1.0f / (1.0f + expf(-x)); }
__device__ __forceinline__ float softplusf_(float x) { return fmaxf(x, 0.0f) + log1pf(expf(-fabsf(x))); }
__device__ __forceinline__ float siluf_(float x) { return x * sigmoidf_(x); }
__device__ __forceinline__ float geluf_(float x) { return 0.5f * x * (1.0f + tanhf(0.7978845608028654f * (x + 0.044715f * x * x * x))); }
__device__ __forceinline__ unsigned pack2h(float a, float b) { return (unsigned)f2h(a) | ((unsigned)f2h(b) << 16); }
__device__ __forceinline__ void store8h(h16_t* p, const float (&v)[8]) {
    uint4 w; w.x = pack2h(v[0], v[1]); w.y = pack2h(v[2], v[3]); w.z = pack2h(v[4], v[5]); w.w = pack2h(v[6], v[7]);
    *(uint4*)p = w;
}
__device__ __forceinline__ void load8h(const h16_t* p, float (&v)[8]) {
    const uint4 w = *(const uint4*)p;
    v[0] = h2f((h16_t)(w.x & 0xffffu)); v[1] = h2f((h16_t)(w.x >> 16)); v[2] = h2f((h16_t)(w.y & 0xffffu)); v[3] = h2f((h16_t)(w.y >> 16));
    v[4] = h2f((h16_t)(w.z & 0xffffu)); v[5] = h2f((h16_t)(w.z >> 16)); v[6] = h2f((h16_t)(w.w & 0xffffu)); v[7] = h2f((h16_t)(w.w >> 16));
}

__device__ __forceinline__ float block_sum512(float v, float* red) {
    const int tid = tid_();
    red[tid] = v;
    __syncthreads();
    if (tid < 32) { float s = 0.f; for (int i = 0; i < 16; ++i) s += red[tid * 16 + i]; red[512 + tid] = s; }
    __syncthreads();
    float tot = 0.f;
    for (int i = 0; i < 32; ++i) tot += red[512 + i];
    __syncthreads();
    return tot;
}

template <bool OUT_F32>
__device__ __forceinline__ void stage_rmsnorm(const float* src, const float* w, void* dst, int ldd, char* smem) {
    float* red = (float*)smem;
    const int tid = tid_();
    for (int row = bid_(); row < M_; row += gridDim.x) {
        const float2 v = *(const float2*)(src + (size_t)row * D_ + tid * 2);
        const float ss = block_sum512(v.x * v.x + v.y * v.y, red);
        const float rstd = rsqrtf(ss * (1.0f / D_) + RMS_EPS);
        const float2 wv = *(const float2*)(w + tid * 2);
        const float o0 = v.x * rstd * wv.x, o1 = v.y * rstd * wv.y;
        if (OUT_F32) {
            float2 o; o.x = o0; o.y = o1;
            *(float2*)((float*)dst + (size_t)row * ldd + tid * 2) = o;
        } else {
            *(unsigned*)((h16_t*)dst + (size_t)row * ldd + tid * 2) = pack2h(o0, o1);
        }
    }
}

__device__ __forceinline__ const float* wt_src(KParams p, int l, int r, int& ld) {
    if (r < ZN) {
        ld = INW;
        int c;
        if (r < 6144) c = r; else if (r < 9472) c = r + 16; else if (r < 9488) c = r - 3328; else return nullptr;
        return p->in[I_WIN] + (size_t)l * 1024 * INW + c;
    }
    r -= ZN;
    if (r < 3072) { ld = INW; return p->in[I_WIN] + (size_t)l * 1024 * INW + 9488 + r; }
    r -= 3072;
    if (r < 3072) { ld = 1024; const int br = r >> 10; return p->in[br == 0 ? I_PL : (br == 1 ? I_PG : I_PR)] + (size_t)l * 1024 * 1024 + (r & 1023); }
    r -= 3072;
    if (r < 1024) { ld = 1024; return p->in[I_WOUT] + (size_t)l * 1024 * 1024 + r; }
    r -= 1024;
    ld = 2048; return p->in[I_PWQ] + (size_t)l * 1024 * 2048 + r;
}
__device__ __forceinline__ void stage_wprep(KParams p, char* smem) {
    float* tile = (float*)smem;
    h16_t* WT = (h16_t*)(p->ws + OFF_WT);
    const int tid = tid_();
    const int ntr = WT_ROWS / 64, total = NL_ * ntr * 16;
    for (int it = bid_(); it < total; it += gridDim.x) {
        const int l = it / (ntr * 16), rem = it % (ntr * 16), rt = rem / 16, kt = rem % 16;
        const int r0 = rt * 64, k0 = kt * 64;
        __syncthreads();
        {
            const int nn = tid & 63;
            int ld = 0; const float* src = wt_src(p, l, r0 + nn, ld);
#pragma unroll
            for (int i = 0; i < 8; ++i) { const int kk = (tid >> 6) + 8 * i; tile[kk * 65 + nn] = src ? src[(size_t)(k0 + kk) * ld] : 0.f; }
        }
        __syncthreads();
        {
            const int r = tid >> 3, kq = (tid & 7) * 8;
            float v[8];
#pragma unroll
            for (int j = 0; j < 8; ++j) v[j] = tile[(kq + j) * 65 + r];
            store8h(WT + ((size_t)l * WT_ROWS + r0 + r) * 1024 + k0 + kq, v);
        }
    }
}

namespace pg8 {
constexpr int BM = 256, BK = 64, HALF = 128, HTB = HALF * BK * 2, STAGE_BYTES = 8 * HTB, NXCD = 8, WGM = 8;
struct Unit { const char* A; const char* B; int pm, pn, kind; };
#ifdef CPU_EMU
struct f32x4 { float d[4]; float& operator[](int i) { return d[i]; } const float& operator[](int i) const { return d[i]; } };
#else
#define PG8_LAS __attribute__((address_space(3)))
typedef _Float16 f16x8 __attribute__((ext_vector_type(8)));
typedef float f32x4 __attribute__((ext_vector_type(4)));
__device__ __forceinline__ int lds_byte(int r, int c) { const int st = (r >> 4) * 2 + (c >> 5), rr = r & 15, cc = c & 31, ob = rr * 64 + cc * 2; return st * 1024 + (ob ^ (((ob >> 9) & 1) << 5)); }
__device__ __forceinline__ void stage_rc(int b, int& R, int& C) { const int st = b / 1024, sb = b % 1024, swz = sb ^ (((sb >> 9) & 1) << 5); R = (st >> 1) * 16 + swz / 64; C = (st & 1) * 32 + (swz % 64) / 2; }
__device__ __forceinline__ int perm32(int rho) { const int n = rho >> 4, i = rho & 15; return 8 * (i >> 2) + 4 * n + (i & 3); }
#endif
__device__ __forceinline__ void tile_of(int L, int nM, int nN, int& pm, int& pn) {
    const int nwg = nM * nN;
    int wgid = L; { const int q = nwg / NXCD, r = nwg % NXCD, xcd = wgid % NXCD, off = wgid / NXCD; wgid = (xcd < r ? xcd * (q + 1) : r * (q + 1) + (xcd - r) * q) + off; }
    const int nig = WGM * nN, gid = wgid / nig, fm = gid * WGM, gsz = (nM - fm) < WGM ? (nM - fm) : WGM;
    pm = fm + ((wgid % nig) % gsz); pn = (wgid % nig) / gsz;
}

template <class Sched, class Epi>
__device__ __forceinline__ void gemm_phase(char* smem, const Sched& S, const Epi& E) {
    constexpr int K = 1024, nt = K / BK;
    constexpr unsigned lda = LDZ, ldb = 1024;
#ifdef CPU_EMU
    const int tid = tid_(), wid = tid >> 6, lane = tid & 63, wr = wid >> 2, wc = wid & 3, fr = lane & 15, fq = lane >> 4;
    Unit u;
    for (int ui = 0; S.next(ui, u); ++ui) {
        f32x4 acc[2][2][4][2];
        for (int ai = 0; ai < 2; ++ai) for (int bj = 0; bj < 2; ++bj) for (int m = 0; m < 4; ++m) for (int n = 0; n < 2; ++n) for (int e = 0; e < 4; ++e) {
            const int r = 128 * ai + 64 * wr + 16 * m + fr, c = 128 * bj + 32 * wc + 8 * fq + 4 * n + e;
            const h16_t* a = (const h16_t*)u.A + (size_t)r * lda; const h16_t* b = (const h16_t*)u.B + (size_t)c * ldb;
            float s = 0.f;
            for (int k = 0; k < K; ++k) s += h2f(a[k]) * h2f(b[k]);
            acc[ai][bj][m][n][e] = s;
        }
        E(acc, u, wr, wc, fr, fq);
    }
    (void)smem; (void)nt;
#else
    PG8_LAS unsigned char* lds = (PG8_LAS unsigned char*)smem;
    const int tid = tid_(), wid = __builtin_amdgcn_readfirstlane(tid >> 6), lane = tid & 63, wr = wid >> 2, wc = wid & 3, fr = lane & 15, fq = lane >> 4;
    unsigned voffA[2], voffB[2];
#pragma unroll
    for (int i = 0; i < 2; ++i) { int R, C; stage_rc(tid * 16 + i * 8192, R, C); const int Rb = (R & ~31) + perm32(R & 31);
        voffA[i] = (unsigned)(R * lda + C) * 2u; voffB[i] = (unsigned)(Rb * ldb + C) * 2u; }
    constexpr size_t kstep = (size_t)(BK * 2);
    constexpr size_t hstepA = (size_t)HALF * lda * 2, hstepB = (size_t)HALF * ldb * 2;
    const unsigned ldsw = (unsigned)wid * 1024u;
    const int aoff = lds_byte(wr * 64 + fr, fq * 8), boff = lds_byte(wc * 32 + fr, fq * 8);
#define PG8_SA(b, h) (((b) * 2 + (h)) * HTB)
#define PG8_SB(b, h) ((4 + (b) * 2 + (h)) * HTB)
#define PG8_STAGE(bufoff, gbase, voff) do { _Pragma("unroll") for (int _i = 0; _i < 2; ++_i) \
        __builtin_amdgcn_global_load_lds((const unsigned*)((const char*)(gbase) + (voff)[_i]), (PG8_LAS unsigned*)(lds + (bufoff) + ldsw + _i * 8192), 16, 0, 0); } while (0)
#define PG8_LDA(dst, b, h) do { _Pragma("unroll") for (int m = 0; m < 4; ++m) _Pragma("unroll") for (int k = 0; k < 2; ++k) dst[m][k] = *(const PG8_LAS f16x8*)(lds + PG8_SA(b, h) + aoff + m * 2048 + k * 1024); } while (0)
#define PG8_LDB(dst, b, h) do { _Pragma("unroll") for (int n = 0; n < 2; ++n) _Pragma("unroll") for (int k = 0; k < 2; ++k) dst[n][k] = *(const PG8_LAS f16x8*)(lds + PG8_SB(b, h) + boff + n * 2048 + k * 1024); } while (0)
#define PG8_MMA(ai, bj, At, Bt) do { __builtin_amdgcn_s_setprio(1); _Pragma("unroll") for (int m = 0; m < 4; ++m) _Pragma("unroll") for (int n = 0; n < 2; ++n) _Pragma("unroll") for (int k = 0; k < 2; ++k) \
        acc[ai][bj][m][n] = __builtin_amdgcn_mfma_f32_16x16x32_f16(Bt[n][k], At[m][k], acc[ai][bj][m][n], 0, 0, 0); __builtin_amdgcn_s_setprio(0); } while (0)
#define PG8_WAIT_V(n) asm volatile("s_waitcnt vmcnt(" #n ")" ::: "memory")
#define PG8_WAIT_L(n) asm volatile("s_waitcnt lgkmcnt(" #n ")" ::: "memory")
#define PG8_BAR __builtin_amdgcn_s_barrier()
#define PG8_SCHED __builtin_amdgcn_sched_barrier(0)
    Unit cur, nxt; int ui = 0;
    if (!S.next(0, cur)) return;
    f32x4 acc[2][2][4][2];
#pragma unroll
    for (int a = 0; a < 2; ++a)
#pragma unroll
        for (int b = 0; b < 2; ++b)
#pragma unroll
            for (int m = 0; m < 4; ++m)
#pragma unroll
                for (int n = 0; n < 2; ++n) acc[a][b][m][n] = (f32x4){0.f, 0.f, 0.f, 0.f};
    f16x8 At[4][2], B0[2][2], B1[2][2];
    const char* cA = cur.A; const char* cB = cur.B;
    PG8_STAGE(PG8_SB(0, 0), cB, voffB); PG8_STAGE(PG8_SA(0, 0), cA, voffA); PG8_STAGE(PG8_SB(0, 1), cB + hstepB, voffB); PG8_STAGE(PG8_SA(0, 1), cA + hstepA, voffA);
    if (wr == 1) PG8_BAR;
    PG8_WAIT_V(4); PG8_BAR;
    PG8_STAGE(PG8_SB(1, 0), cB + kstep, voffB); PG8_STAGE(PG8_SA(1, 0), cA + kstep, voffA); PG8_STAGE(PG8_SB(1, 1), cB + hstepB + kstep, voffB);
    PG8_WAIT_V(6); PG8_BAR;
    for (;;) {
        const bool has_next = S.next(ui + 1, nxt);
        const char* nA = has_next ? nxt.A : cA; const char* nB = has_next ? nxt.B : cB;
#pragma unroll 1
        for (int t = 0; t < nt; t += 2) {
            const bool last = (t == nt - 2);
            const char* a1 = cA + (size_t)(t + 1) * kstep;
            const char* a2 = last ? nA : cA + (size_t)(t + 2) * kstep; const char* b2 = last ? nB : cB + (size_t)(t + 2) * kstep;
            const char* a3 = a2 + kstep; const char* b3 = b2 + kstep;
            PG8_LDB(B0, 0, 0); PG8_SCHED; PG8_LDA(At, 0, 0); PG8_STAGE(PG8_SA(1, 1), a1 + hstepA, voffA);
            PG8_WAIT_L(8); PG8_BAR; PG8_WAIT_L(0); PG8_MMA(0, 0, At, B0); PG8_BAR; PG8_SCHED;
            PG8_LDB(B1, 0, 1); PG8_STAGE(PG8_SB(0, 0), b2, voffB);
            PG8_BAR; PG8_WAIT_L(0); PG8_MMA(0, 1, At, B1); PG8_BAR;
            PG8_LDA(At, 0, 1); PG8_STAGE(PG8_SA(0, 0), a2, voffA);
            PG8_BAR; PG8_WAIT_L(0); PG8_MMA(1, 0, At, B0); PG8_BAR; PG8_SCHED;
            PG8_STAGE(PG8_SB(0, 1), b2 + hstepB, voffB);
            PG8_WAIT_V(6); PG8_BAR; PG8_MMA(1, 1, At, B1); PG8_BAR;
            PG8_LDB(B0, 1, 0); PG8_SCHED; PG8_LDA(At, 1, 0); PG8_STAGE(PG8_SA(0, 1), a2 + hstepA, voffA);
            PG8_WAIT_L(8); PG8_BAR; PG8_WAIT_L(0); PG8_MMA(0, 0, At, B0); PG8_BAR; PG8_SCHED;
            PG8_LDB(B1, 1, 1); PG8_STAGE(PG8_SB(1, 0), b3, voffB);
            PG8_BAR; PG8_WAIT_L(0); PG8_MMA(0, 1, At, B1); PG8_BAR;
            PG8_LDA(At, 1, 1); PG8_STAGE(PG8_SA(1, 0), a3, voffA);
            PG8_BAR; PG8_WAIT_L(0); PG8_MMA(1, 0, At, B0); PG8_BAR; PG8_SCHED;
            PG8_STAGE(PG8_SB(1, 1), b3 + hstepB, voffB);
            PG8_WAIT_V(6); PG8_BAR; PG8_MMA(1, 1, At, B1); PG8_BAR;
        }
        E(acc, cur, wr, wc, fr, fq);
        if (!has_next) break;
#pragma unroll
        for (int a = 0; a < 2; ++a)
#pragma unroll
            for (int b = 0; b < 2; ++b)
#pragma unroll
                for (int m = 0; m < 4; ++m)
#pragma unroll
                    for (int n = 0; n < 2; ++n) acc[a][b][m][n] = (f32x4){0.f, 0.f, 0.f, 0.f};
        cur = nxt; cA = nA; cB = nB; ++ui;
    }
    PG8_WAIT_V(0);
    if (wr == 0) PG8_BAR;
    PG8_BAR;
#undef PG8_SA
#undef PG8_SB
#undef PG8_STAGE
#undef PG8_LDA
#undef PG8_LDB
#undef PG8_MMA
#undef PG8_WAIT_V
#undef PG8_WAIT_L
#undef PG8_BAR
#undef PG8_SCHED
#endif
}
}

enum { GK_STORE = 0, GK_GATE0, GK_GATE1, GK_GATE2, GK_PROJ0, GK_PROJ1, GK_PROJ2, GK_RESID };
enum { GP_INPROJ = 0, GP_MERGE, GP_WOUT, GP_QUERY };
struct GemmProg {
    const char* act; const char* wt;
    int which, G, c;
    __device__ __forceinline__ bool next(int i, pg8::Unit& u) const {
        constexpr int nM = M_ / 256;
        constexpr size_t rowA = (size_t)256 * LDZ * 2, rowB = (size_t)256 * 1024 * 2;
        if (which == GP_MERGE) {
            const int L = (i / 6) * G + c, j = i % 6, br = j >> 1;
            if (L >= nM * 4) return false;
            pg8::tile_of(L, nM, 4, u.pm, u.pn);
            if ((j & 1) == 0) { u.A = act + (size_t)C_XN * 2; u.B = wt + ((size_t)(WT_MG + br * 1024) * 1024) * 2; u.kind = GK_GATE0 + br; }
            else { u.A = act + (size_t)(br == 0 ? C_YA : (br == 1 ? C_YB : C_YC)) * 2; u.B = wt + ((size_t)(WT_P + br * 1024) * 1024) * 2; u.kind = GK_PROJ0 + br; }
        } else {
            const int nN = which == GP_INPROJ ? ZN / 256 : (which == GP_WOUT ? 4 : 8);
            const int L = i * G + c;
            if (L >= nM * nN) return false;
            pg8::tile_of(L, nM, nN, u.pm, u.pn);
            u.A = act + (size_t)(which == GP_WOUT ? C_MG : C_XN) * 2;
            u.B = wt + ((size_t)(which == GP_INPROJ ? WT_IN : (which == GP_WOUT ? WT_OUT : WT_Q)) * 1024) * 2;
            u.kind = which == GP_WOUT ? GK_RESID : GK_STORE;
        }
        u.A += (size_t)u.pm * rowA; u.B += (size_t)u.pn * rowB;
        return true;
    }
};
struct GemmEpi {
    h16_t* act; const float* mb; const float* resid; float* out;
    __device__ __forceinline__ void operator()(const pg8::f32x4 (&acc)[2][2][4][2], const pg8::Unit& u, int wr, int wc, int fr, int fq) const {
        const int row0 = u.pm * 256 + wr * 64 + fr, col0 = u.pn * 256 + wc * 32 + 8 * fq;
#pragma unroll
        for (int ai = 0; ai < 2; ++ai)
#pragma unroll
            for (int m = 0; m < 4; ++m) {
                const int row = row0 + ai * 128 + m * 16;
#pragma unroll
                for (int bj = 0; bj < 2; ++bj) {
                    const int col = col0 + bj * 128;
                    float v[8];
#pragma unroll
                    for (int e = 0; e < 4; ++e) { v[e] = acc[ai][bj][m][0][e]; v[4 + e] = acc[ai][bj][m][1][e]; }
                    h16_t* arow = act + (size_t)row * LDZ;
                    if (u.kind == GK_STORE) {
                        store8h(arow + col, v);
                    } else if (u.kind <= GK_GATE2) {
                        const float* bp = mb + (u.kind - GK_GATE0) * 1024 + col;
                        const float4 b0 = *(const float4*)bp, b1 = *(const float4*)(bp + 4);
                        v[0] = sigmoidf_(v[0] + b0.x); v[1] = sigmoidf_(v[1] + b0.y); v[2] = sigmoidf_(v[2] + b0.z); v[3] = sigmoidf_(v[3] + b0.w);
                        v[4] = sigmoidf_(v[4] + b1.x); v[5] = sigmoidf_(v[5] + b1.y); v[6] = sigmoidf_(v[6] + b1.z); v[7] = sigmoidf_(v[7] + b1.w);
                        store8h(arow + C_GS + col, v);
                    } else if (u.kind <= GK_PROJ2) {
                        float g[8]; load8h(arow + C_GS + col, g);
                        if (u.kind == GK_PROJ0) {
#pragma unroll
                            for (int e = 0; e < 8; ++e) v[e] = g[e] * v[e];
                        } else {
                            float o[8]; load8h(arow + C_MG + col, o);
#pragma unroll
                            for (int e = 0; e < 8; ++e) v[e] = o[e] + g[e] * v[e];
                        }
                        store8h(arow + C_MG + col, v);
                    } else {
                        const size_t o = (size_t)row * 1024 + col;
                        const float4 r0 = *(const float4*)(resid + o), r1 = *(const float4*)(resid + o + 4);
                        *(float4*)(out + o) = make_float4(r0.x + v[0], r0.y + v[1], r0.z + v[2], r0.w + v[3]);
                        *(float4*)(out + o + 4) = make_float4(r1.x + v[4], r1.y + v[5], r1.z + v[6], r1.w + v[7]);
                    }
                }
            }
    }
};
__device__ __forceinline__ void stage_gemm(KParams p, int l, int which, char* smem) {
    GemmProg S; S.act = p->ws + OFF_ACT; S.wt = p->ws + OFF_WT + (size_t)l * WT_ROWS * 1024 * 2; S.which = which; S.G = gridDim.x; S.c = bid_();
    GemmEpi E; E.act = (h16_t*)(p->ws + OFF_ACT); E.mb = p->in[I_MB] + l * 3072; E.resid = l == 0 ? p->in[I_X] : p->out; E.out = p->out;
    pg8::gemm_phase(smem, S, E);
}

#ifdef CPU_EMU
__device__ __forceinline__ float group_sum(float v, int width, float* scratch) {
    const int tid = tid_();
    scratch[tid] = v;
    __syncthreads();
    float s = 0.f; const int base = tid & ~(width - 1);
    for (int i = 0; i < width; ++i) s += scratch[base + i];
    __syncthreads();
    return s;
}
#else
__device__ __forceinline__ float group_sum(float v, int width, float*) {
    for (int off = width >> 1; off > 0; off >>= 1) v += __shfl_xor(v, off);
    return v;
}
#endif
__device__ __forceinline__ uint4 ldg16(const h16_t* p) { return *(const uint4*)p; }
__device__ __forceinline__ uint4 zero16() { uint4 z; z.x = 0u; z.y = 0u; z.z = 0u; z.w = 0u; return z; }

__device__ __forceinline__ void stage_lru(KParams p, int l, char* smem, int vb0, int nvb) {
    const int vb = bid_() - vb0;
    if (vb < 0 || vb >= nvb) return;
    constexpr int CH = 64;
    float* wa_s = (float*)smem;
    float* wx_s = wa_s + 4096;
    float* xcT = wx_s + 4096;
    float* a_s = xcT + 64 * CH;
    float* b_s = a_s + CH * 64;
    h16_t* ru = (h16_t*)(b_s + CH * 64);
    h16_t* rg = ru + (CH + 3) * 64;
    h16_t* ACT = (h16_t*)(p->ws + OFF_ACT);
    const int tid = tid_(), c = tid & 63, tg = tid >> 6;
    for (int item = vb; item < B_ * 16; item += nvb) {
        const int b = item / 16, n = item % 16, ch = n * 64 + c;
        __syncthreads();
        for (int i = tid; i < 4096; i += NT) { wa_s[i] = p->in[I_LWA][((size_t)l * 16 + n) * 4096 + i]; wx_s[i] = p->in[I_LWX][((size_t)l * 16 + n) * 4096 + i]; }
        const float cw0 = p->in[I_LCW][((size_t)l * 4 + 0) * 1024 + ch], cw1 = p->in[I_LCW][((size_t)l * 4 + 1) * 1024 + ch];
        const float cw2 = p->in[I_LCW][((size_t)l * 4 + 2) * 1024 + ch], cw3 = p->in[I_LCW][((size_t)l * 4 + 3) * 1024 + ch];
        const float cb = p->in[I_LCB][l * 1024 + ch], ba = p->in[I_LBA][l * 1024 + ch], bx = p->in[I_LBX][l * 1024 + ch];
        const float sp = softplusf_(-p->in[I_LLAM][l * 1024 + ch]);
        float hst = 0.f;
        uint4 pf[3];
#define LRU_LOAD(t0_) do { _Pragma("unroll") for (int i = 0; i < 3; ++i) { const int j = tid + NT * i; pf[i] = zero16(); \
            if (j < 536) { const int t = (t0_) - 3 + (j >> 3); if (t >= 0) pf[i] = ldg16(ACT + ((size_t)b * T_ + t) * LDZ + Z_ULRU + n * 64 + (j & 7) * 8); } \
            else if (j < 1048) { const int jj = j - 536; pf[i] = ldg16(ACT + ((size_t)b * T_ + (t0_) + (jj >> 3)) * LDZ + Z_GLRU + n * 64 + (jj & 7) * 8); } } } while (0)
#define LRU_PUT() do { _Pragma("unroll") for (int i = 0; i < 3; ++i) { const int j = tid + NT * i; \
            if (j < 536) *(uint4*)(ru + (j >> 3) * 64 + (j & 7) * 8) = pf[i]; else if (j < 1048) *(uint4*)(rg + ((j - 536) >> 3) * 64 + ((j - 536) & 7) * 8) = pf[i]; } } while (0)
        LRU_LOAD(0);
        LRU_PUT();
        __syncthreads();
#pragma unroll 1
        for (int t0 = 0; t0 < T_; t0 += CH) {
            float xc[8];
            {
                float u[11];
#pragma unroll
                for (int s = 0; s < 11; ++s) u[s] = h2f(ru[(tg * 8 + s) * 64 + c]);
#pragma unroll
                for (int s = 0; s < 8; ++s) { xc[s] = cw0 * u[s] + cw1 * u[s + 1] + cw2 * u[s + 2] + cw3 * u[s + 3] + cb; xcT[c * CH + tg * 8 + s] = xc[s]; }
            }
            __syncthreads();
            if (t0 + CH < T_) LRU_LOAD(t0 + CH);
            {
                float dr[8], di[8];
#pragma unroll
                for (int s = 0; s < 8; ++s) { dr[s] = 0.f; di[s] = 0.f; }
#pragma unroll 4
                for (int i = 0; i < 64; ++i) {
                    const float wa = wa_s[i * 64 + c], wx = wx_s[i * 64 + c];
                    const float4 x0 = *(const float4*)(xcT + i * CH + tg * 8), x1 = *(const float4*)(xcT + i * CH + tg * 8 + 4);
                    dr[0] += x0.x * wa; dr[1] += x0.y * wa; dr[2] += x0.z * wa; dr[3] += x0.w * wa; dr[4] += x1.x * wa; dr[5] += x1.y * wa; dr[6] += x1.z * wa; dr[7] += x1.w * wa;
                    di[0] += x0.x * wx; di[1] += x0.y * wx; di[2] += x0.z * wx; di[3] += x0.w * wx; di[4] += x1.x * wx; di[5] += x1.y * wx; di[6] += x1.z * wx; di[7] += x1.w * wx;
                }
#pragma unroll
                for (int s = 0; s < 8; ++s) {
                    const float r = sigmoidf_(dr[s] + ba), ig = sigmoidf_(di[s] + bx);
                    const float log_a = -8.0f * r * sp;
                    a_s[(tg * 8 + s) * 64 + c] = expf(log_a);
                    b_s[(tg * 8 + s) * 64 + c] = sqrtf(-expm1f(2.0f * log_a)) * (ig * xc[s]);
                }
            }
            __syncthreads();
            if (tid < 64) {
#pragma unroll 8
                for (int t = 0; t < CH; ++t) { hst = a_s[t * 64 + c] * hst + b_s[t * 64 + c]; b_s[t * 64 + c] = hst; }
            }
            __syncthreads();
#pragma unroll
            for (int s = 0; s < 8; ++s) { h16_t* gp = rg + (tg * 8 + s) * 64 + c; *gp = f2h(b_s[(tg * 8 + s) * 64 + c] * geluf_(h2f(*gp))); }
            __syncthreads();
            *(uint4*)(ACT + ((size_t)b * T_ + t0 + (tid >> 3)) * LDZ + Z_GLRU + n * 64 + (tid & 7) * 8) = *(const uint4*)(rg + (tid >> 3) * 64 + (tid & 7) * 8);
            __syncthreads();
            if (t0 + CH < T_) LRU_PUT();
            __syncthreads();
        }
#undef LRU_LOAD
#undef LRU_PUT
    }
}

__device__ __forceinline__ void stage_gdn(KParams p, int l, char* smem, int vb0, int nvb) {
    const int vb = bid_() - vb0;
    if (vb < 0 || vb >= nvb) return;
    constexpr int CH = 32, QS = 144;
    float* q_s = (float*)smem;
    float* k_s = q_s + CH * QS;
    float* v_s = k_s + CH * QS;
    float* o_s = v_s + CH * 128;
    float* sc_s = o_s + CH * 128;
    float* scr = sc_s + CH * 2;
    h16_t* raw = (h16_t*)(scr + 512);
    h16_t* rsc = raw + CH * 512;
    h16_t* ob = rsc + CH * 2;
    h16_t* ACT = (h16_t*)(p->ws + OFF_ACT);
    const int tid = tid_(), lane = tid & 63, wv = tid >> 6;
    const int col = tid >> 2, q4 = tid & 3;
    for (int item = vb; item < B_ * 8; item += nvb) {
        const int b = item / 8, h = item % 8;
        const float a_exp = expf(p->in[I_GALOG][l * 8 + h]), dtb = p->in[I_GDT][l * 8 + h];
        const int cc = tid;
        const int gch = cc < 128 ? (h * 128 + cc) : (cc < 256 ? (1024 + h * 128 + cc - 128) : (2048 + h * 128 + cc - 256));
        float cw[4] = {0.f, 0.f, 0.f, 0.f};
        if (cc < 384) {
#pragma unroll
            for (int jj = 0; jj < 4; ++jj) cw[jj] = p->in[I_GCW][((size_t)l * 4 + jj) * 3072 + gch];
        }
        const float nwa = p->in[I_GNW][l * 128 + lane], nwb = p->in[I_GNW][l * 128 + 64 + lane];
        float S[32];
#pragma unroll
        for (int k = 0; k < 32; ++k) S[k] = 0.f;
        float x1 = 0.f, x2 = 0.f, x3 = 0.f;
        uint4 pf[4]; unsigned pfs = 0;
#define GDN_LOAD(t0_) do { _Pragma("unroll") for (int i = 0; i < 4; ++i) { const int j = tid + NT * i, u = j & 63, sg = u >> 4; \
            pf[i] = ldg16(ACT + ((size_t)b * T_ + (t0_) + (j >> 6)) * LDZ + (sg < 3 ? Z_Q + sg * 1024 : Z_ZG) + h * 128 + (u & 15) * 8); } \
            if (tid < 64) pfs = ACT[((size_t)b * T_ + (t0_) + (tid >> 1)) * LDZ + ((tid & 1) ? Z_BETA : Z_ALPHA) + h]; } while (0)
#define GDN_PUT() do { _Pragma("unroll") for (int i = 0; i < 4; ++i) { const int j = tid + NT * i; *(uint4*)(raw + (j >> 6) * 512 + (j & 63) * 8) = pf[i]; } \
            if (tid < 64) rsc[tid] = (h16_t)pfs; } while (0)
        __syncthreads();
        GDN_LOAD(0);
        GDN_PUT();
        __syncthreads();
#pragma unroll 1
        for (int t0 = 0; t0 < T_; t0 += CH) {
            if (cc < 384) {
                float* dst = cc < 128 ? (q_s + (cc >> 5) * 36 + (cc & 31)) : (cc < 256 ? (k_s + ((cc - 128) >> 5) * 36 + (cc & 31)) : (v_s + cc - 256));
                const int dstride = cc < 256 ? QS : 128;
#pragma unroll 8
                for (int t = 0; t < CH; ++t) {
                    const float x0 = h2f(raw[t * 512 + cc]);
                    const float cv = cw[0] * x3 + cw[1] * x2 + cw[2] * x1 + cw[3] * x0;
                    x3 = x2; x2 = x1; x1 = x0;
                    dst[t * dstride] = siluf_(cv);
                }
            }
            __syncthreads();
#pragma unroll
            for (int s = 0; s < 4; ++s) {
                const int t = wv * 4 + s;
                float* qa_p = q_s + t * QS + (lane >> 5) * 36 + (lane & 31); float* qb_p = qa_p + 72;
                float* ka_p = k_s + t * QS + (lane >> 5) * 36 + (lane & 31); float* kb_p = ka_p + 72;
                const float qa = *qa_p, qb = *qb_p, ka = *ka_p, kb = *kb_p;
                const float sq = group_sum(qa * qa + qb * qb, 64, scr), sk = group_sum(ka * ka + kb * kb, 64, scr);
                const float rq = rsqrtf(sq + RMS_EPS) * 0.08838834764831845f, rk = rsqrtf(sk + RMS_EPS);
                *qa_p = qa * rq; *qb_p = qb * rq; *ka_p = ka * rk; *kb_p = kb * rk;
                if (lane == 0) {
                    sc_s[t * 2] = sigmoidf_(h2f(rsc[t * 2 + 1]));
                    sc_s[t * 2 + 1] = expf(-a_exp * softplusf_(h2f(rsc[t * 2]) + dtb));
                }
            }
            __syncthreads();
            if (t0 + CH < T_) GDN_LOAD(t0 + CH);
#pragma unroll 1
            for (int t = 0; t < CH; ++t) {
                const float* kp = k_s + t * QS + q4 * 36; const float* qp = q_s + t * QS + q4 * 36;
                float kr[32];
#pragma unroll
                for (int k = 0; k < 32; k += 4) { const float4 kv = *(const float4*)(kp + k); kr[k] = kv.x; kr[k + 1] = kv.y; kr[k + 2] = kv.z; kr[k + 3] = kv.w; }
                float pk0 = 0.f, pk1 = 0.f, pk2 = 0.f, pk3 = 0.f;
#pragma unroll
                for (int k = 0; k < 32; k += 4) { pk0 += S[k] * kr[k]; pk1 += S[k + 1] * kr[k + 1]; pk2 += S[k + 2] * kr[k + 2]; pk3 += S[k + 3] * kr[k + 3]; }
                const float kS = group_sum((pk0 + pk1) + (pk2 + pk3), 4, scr);
                const float beta = sc_s[t * 2], eg = sc_s[t * 2 + 1];
                const float cf = beta * (v_s[t * 128 + col] - eg * kS);
                float po0 = 0.f, po1 = 0.f, po2 = 0.f, po3 = 0.f;
#pragma unroll
                for (int k = 0; k < 32; k += 4) {
                    const float4 qv = *(const float4*)(qp + k);
                    S[k] = eg * S[k] + kr[k] * cf; S[k + 1] = eg * S[k + 1] + kr[k + 1] * cf; S[k + 2] = eg * S[k + 2] + kr[k + 2] * cf; S[k + 3] = eg * S[k + 3] + kr[k + 3] * cf;
                    po0 += S[k] * qv.x; po1 += S[k + 1] * qv.y; po2 += S[k + 2] * qv.z; po3 += S[k + 3] * qv.w;
                }
                const float o = group_sum((po0 + po1) + (po2 + po3), 4, scr);
                if (q4 == 0) o_s[t * 128 + col] = o;
            }
            __syncthreads();
#pragma unroll
            for (int s = 0; s < 4; ++s) {
                const int t = wv * 4 + s;
                const float oa = o_s[t * 128 + lane], ob2 = o_s[t * 128 + 64 + lane];
                const float ms = group_sum(oa * oa + ob2 * ob2, 64, scr);
                const float rs = rsqrtf(ms * (1.0f / 128.0f) + RMS_EPS);
                ob[t * 128 + lane] = f2h(oa * rs * nwa * siluf_(h2f(raw[t * 512 + 384 + lane])));
                ob[t * 128 + 64 + lane] = f2h(ob2 * rs * nwb * siluf_(h2f(raw[t * 512 + 448 + lane])));
            }
            __syncthreads();
            *(uint4*)(ACT + ((size_t)b * T_ + t0 + (tid >> 4)) * LDZ + Z_ZG + h * 128 + (tid & 15) * 8) = *(const uint4*)(ob + (tid >> 4) * 128 + (tid & 15) * 8);
            if (t0 + CH < T_) GDN_PUT();
            __syncthreads();
        }
#undef GDN_LOAD
#undef GDN_PUT
    }
}

#ifndef CPU_EMU
typedef _Float16 rw_f16x8 __attribute__((ext_vector_type(8)));
typedef float rw_f32x4 __attribute__((ext_vector_type(4)));
#endif
__device__ __forceinline__ void stage_rwkv(KParams p, int l, char* smem, int vb0, int nvb) {
    const int vb = bid_() - vb0;
    if (vb < 0 || vb >= nvb) return;
    constexpr int CH = 32, XS = 264;
    float* r_s = (float*)smem;
    float* k_s = r_s + CH * 64;
    float* v_s = k_s + CH * 64;
    float* w_s = v_s + CH * 64;
    float* kk_s = w_s + CH * 64;
    float* ka_s = kk_s + CH * 64;
    float* g_s = ka_s + CH * 64;
    float* o_s = g_s + CH * 64;
    float* bon_s = o_s + CH * 64;
    float* scr = bon_s + CH;
    h16_t* raw = (h16_t*)(scr + 512);
    h16_t* xs = raw + (CH + 1) * 448;
    h16_t* ACT = (h16_t*)(p->ws + OFF_ACT);
    const int tid = tid_(), c = tid & 63, tg = tid >> 6;
    const int ri = tid >> 3, q8 = tid & 7;
    for (int item = vb; item < B_ * 16; item += nvb) {
        const int b = item / 16, h = item % 16, ch = h * 64 + c;
        const float w0 = p->in[I_RW0][l * 1024 + ch], a0 = p->in[I_RA0][l * 1024 + ch], k_k = p->in[I_RKK][l * 1024 + ch], k_a = p->in[I_RKA][l * 1024 + ch];
        const float rk_c = p->in[I_RRK][(size_t)l * 1024 + ch];
        const float lnw = p->in[I_RLW][l * 1024 + ch], lnb = p->in[I_RLB][l * 1024 + ch];
        const float* mu = p->in[I_RMU] + (size_t)l * RWW;
        const float mu_r = mu[RW_R + ch], mu_k = mu[RW_K + ch], mu_v = mu[RW_V + ch];
        const float mu_wl = mu[RW_WL + c], mu_al = mu[RW_AL + c], mu_g0 = mu[RW_GL + c], mu_g1 = mu[RW_GL + 64 + c];
        const float* wup = p->in[I_RWUP] + (size_t)l * 64 * 1024 + h * 64; const float* aup = p->in[I_RAUP] + (size_t)l * 64 * 1024 + h * 64; const float* gup = p->in[I_RGUP] + (size_t)l * 128 * 1024 + h * 64;
#ifndef CPU_EMU
        const int wid = tid >> 6, lane = tid & 63, mt = wid >> 2, nt = wid & 3;
        rw_f16x8 bw[2], ba_[2], bg[4];
        {
            const int cn = nt * 16 + (lane & 15), kb = 8 * (lane >> 4);
#pragma unroll
            for (int ks = 0; ks < 2; ++ks)
#pragma unroll
                for (int j = 0; j < 8; ++j) { bw[ks][j] = (_Float16)wup[(size_t)(ks * 32 + kb + j) * 1024 + cn]; ba_[ks][j] = (_Float16)aup[(size_t)(ks * 32 + kb + j) * 1024 + cn]; }
#pragma unroll
            for (int ks = 0; ks < 4; ++ks)
#pragma unroll
                for (int j = 0; j < 8; ++j) bg[ks][j] = (_Float16)gup[(size_t)(ks * 32 + kb + j) * 1024 + cn];
        }
#endif
        float S[8];
#pragma unroll
        for (int e = 0; e < 8; ++e) S[e] = 0.f;
        uint4 pf[4];
#define RW_LOAD(t0_) do { _Pragma("unroll") for (int i = 0; i < 4; ++i) { const int j = tid + NT * i, row = j / 56, u = j % 56, t = (t0_) - 1 + row; pf[i] = zero16(); \
            if (j < (CH + 1) * 56 && t >= 0) pf[i] = ldg16(ACT + ((size_t)b * T_ + t) * LDZ + Z_RW + (u < 24 ? (u >> 3) * 1024 + h * 64 + (u & 7) * 8 : 3072 + (u - 24) * 8)); } } while (0)
#define RW_PUT() do { _Pragma("unroll") for (int i = 0; i < 4; ++i) { const int j = tid + NT * i; if (j < (CH + 1) * 56) *(uint4*)(raw + (j / 56) * 448 + (j % 56) * 8) = pf[i]; } } while (0)
        __syncthreads();
        RW_LOAD(0);
        RW_PUT();
        __syncthreads();
#pragma unroll 1
        for (int t0 = 0; t0 < T_; t0 += CH) {
#pragma unroll
            for (int s = 0; s < 4; ++s) {
                const int tl = tg * 4 + s;
                const h16_t* zc = raw + (tl + 1) * 448; const h16_t* zp = raw + tl * 448;
#define RW_SHIFT(col, muv) ({ const float zz = h2f(zc[col]); zz + (muv) * (h2f(zp[col]) - zz); })
                r_s[tl * 64 + c] = RW_SHIFT(c, mu_r);
                k_s[tl * 64 + c] = RW_SHIFT(64 + c, mu_k);
                v_s[tl * 64 + c] = RW_SHIFT(128 + c, mu_v);
                xs[tl * XS + c] = f2h(tanhf(RW_SHIFT(192 + c, mu_wl)));
                xs[tl * XS + 64 + c] = f2h(RW_SHIFT(256 + c, mu_al));
                xs[tl * XS + 128 + c] = f2h(sigmoidf_(RW_SHIFT(320 + c, mu_g0)));
                xs[tl * XS + 192 + c] = f2h(sigmoidf_(RW_SHIFT(384 + c, mu_g1)));
#undef RW_SHIFT
            }
            __syncthreads();
            if (t0 + CH < T_) RW_LOAD(t0 + CH);
#ifdef CPU_EMU
#pragma unroll
            for (int s = 0; s < 4; ++s) {
                const int tl = tg * 4 + s;
                float dw = 0.f, da = 0.f, dg = 0.f;
                for (int i = 0; i < 64; ++i) { dw += h2f(xs[tl * XS + i]) * h2f(f2h(wup[(size_t)i * 1024 + c])); da += h2f(xs[tl * XS + 64 + i]) * h2f(f2h(aup[(size_t)i * 1024 + c])); }
                for (int i = 0; i < 128; ++i) dg += h2f(xs[tl * XS + 128 + i]) * h2f(f2h(gup[(size_t)i * 1024 + c]));
                w_s[tl * 64 + c] = dw; ka_s[tl * 64 + c] = da; g_s[tl * 64 + c] = dg;
            }
#else
            {
                const h16_t* ap = xs + (mt * 16 + (lane & 15)) * XS + 8 * (lane >> 4);
                rw_f32x4 dw = {0.f, 0.f, 0.f, 0.f}, da = {0.f, 0.f, 0.f, 0.f}, dg = {0.f, 0.f, 0.f, 0.f};
#pragma unroll
                for (int ks = 0; ks < 2; ++ks) {
                    dw = __builtin_amdgcn_mfma_f32_16x16x32_f16(*(const rw_f16x8*)(ap + ks * 32), bw[ks], dw, 0, 0, 0);
                    da = __builtin_amdgcn_mfma_f32_16x16x32_f16(*(const rw_f16x8*)(ap + 64 + ks * 32), ba_[ks], da, 0, 0, 0);
                }
#pragma unroll
                for (int ks = 0; ks < 4; ++ks) dg = __builtin_amdgcn_mfma_f32_16x16x32_f16(*(const rw_f16x8*)(ap + 128 + ks * 32), bg[ks], dg, 0, 0, 0);
#pragma unroll
                for (int rg = 0; rg < 4; ++rg) { const int o = (mt * 16 + 4 * (lane >> 4) + rg) * 64 + nt * 16 + (lane & 15); w_s[o] = dw[rg]; ka_s[o] = da[rg]; g_s[o] = dg[rg]; }
            }
#endif
            __syncthreads();
#pragma unroll
            for (int s = 0; s < 4; ++s) {
                const int tl = tg * 4 + s;
                const float w_log = -softplusf_(-(w0 + w_s[tl * 64 + c])) - 0.5f;
                const float decay = expf(-expf(w_log));
                const float a = sigmoidf_(a0 + ka_s[tl * 64 + c]);
                const float kx = k_s[tl * 64 + c], rx = r_s[tl * 64 + c];
                const float kkr = kx * k_k, k2 = kx * (1.0f + (a - 1.0f) * k_a);
                const float nsq = group_sum(kkr * kkr, 64, scr);
                const float bon = group_sum(rx * k2 * rk_c, 64, scr);
                const float kkn = kkr * rsqrtf(nsq + RMS_EPS);
                w_s[tl * 64 + c] = decay; k_s[tl * 64 + c] = k2; kk_s[tl * 64 + c] = kkn; ka_s[tl * 64 + c] = kkn * a;
                if (c == 0) bon_s[tl] = bon;
            }
            __syncthreads();
#pragma unroll 1
            for (int t = 0; t < CH; ++t) {
                const int o8 = t * 64 + q8 * 8;
                const float4 kk0 = *(const float4*)(kk_s + o8), kk1 = *(const float4*)(kk_s + o8 + 4);
                const float pk = (S[0] * kk0.x + S[1] * kk0.y) + (S[2] * kk0.z + S[3] * kk0.w) + ((S[4] * kk1.x + S[5] * kk1.y) + (S[6] * kk1.z + S[7] * kk1.w));
                const float skk = group_sum(pk, 8, scr);
                const float vi = v_s[t * 64 + ri];
                const float4 w0v = *(const float4*)(w_s + o8), w1v = *(const float4*)(w_s + o8 + 4);
                const float4 a0v = *(const float4*)(ka_s + o8), a1v = *(const float4*)(ka_s + o8 + 4);
                const float4 k0v = *(const float4*)(k_s + o8), k1v = *(const float4*)(k_s + o8 + 4);
                const float4 r0v = *(const float4*)(r_s + o8), r1v = *(const float4*)(r_s + o8 + 4);
                S[0] = S[0] * w0v.x - skk * a0v.x + vi * k0v.x; S[1] = S[1] * w0v.y - skk * a0v.y + vi * k0v.y; S[2] = S[2] * w0v.z - skk * a0v.z + vi * k0v.z; S[3] = S[3] * w0v.w - skk * a0v.w + vi * k0v.w;
                S[4] = S[4] * w1v.x - skk * a1v.x + vi * k1v.x; S[5] = S[5] * w1v.y - skk * a1v.y + vi * k1v.y; S[6] = S[6] * w1v.z - skk * a1v.z + vi * k1v.z; S[7] = S[7] * w1v.w - skk * a1v.w + vi * k1v.w;
                const float po = (S[0] * r0v.x + S[1] * r0v.y) + (S[2] * r0v.z + S[3] * r0v.w) + ((S[4] * r1v.x + S[5] * r1v.y) + (S[6] * r1v.z + S[7] * r1v.w));
                const float o = group_sum(po, 8, scr);
                if (q8 == 0) o_s[t * 64 + ri] = o;
            }
            __syncthreads();
#pragma unroll
            for (int s = 0; s < 4; ++s) {
                const int tl = tg * 4 + s;
                const float ov = o_s[tl * 64 + c];
                const float mean = group_sum(ov, 64, scr) * (1.0f / 64.0f);
                const float d = ov - mean;
                const float var = group_sum(d * d, 64, scr) * (1.0f / 64.0f);
                const float y = (d * rsqrtf(var + GN_EPS) * lnw + lnb + bon_s[tl] * v_s[tl * 64 + c]) * g_s[tl * 64 + c];
                ACT[((size_t)b * T_ + t0 + tl) * LDZ + C_YC + ch] = f2h(y);
            }
            __syncthreads();
            if (t0 + CH < T_) RW_PUT();
            __syncthreads();
        }
#undef RW_LOAD
#undef RW_PUT
    }
}

constexpr bool TAB_IN_ACT = (M_ == 16384);
__device__ __forceinline__ h16_t* tab_row(char* ws, int which, int e) {
    if (TAB_IN_ACT) return (h16_t*)(ws + OFF_ACT) + (size_t)e * LDZ + (which ? C_MG : C_GS);
    return (h16_t*)(ws + OFF_TAB) + ((size_t)which * 16384 + e) * 1024;
}
__device__ __forceinline__ void stage_tabconv(KParams p, int l) {
    const int tid = tid_();
    const float* U = p->in[I_PU] + (size_t)l * 16384 * 1024; const float* V = p->in[I_PV] + (size_t)l * 16384 * 1024;
    char* ws = p->ws;
    for (int it = bid_() * NT + tid; it < 2 * 16384 * 128; it += gridDim.x * NT) {
        const int which = it >= 16384 * 128, r = (it >> 7) & 16383, ck = it & 127;
        const float* src = (which ? V : U) + (size_t)r * 1024 + ck * 8;
        const float4 a = *(const float4*)src, b = *(const float4*)(src + 4);
        const float v[8] = {a.x, a.y, a.z, a.w, b.x, b.y, b.z, b.w};
        store8h(tab_row(ws, which, r) + ck * 8, v);
    }
}

__device__ __forceinline__ void stage_peer_topk(KParams p, int l, char* smem) {
    float* key_s = (float*)smem;
    const h16_t* ACT = (const h16_t*)(p->ws + OFF_ACT);
    float* TOPS = (float*)(p->ws + OFF_TOPS);
    const int tid = tid_();
    const int nb = gridDim.x;
    for (int hs = bid_() % 16; hs < 16; hs += nb) {
        const int hd = hs >> 1, s = hs & 1;
        __syncthreads();
        {
            const float* kp = p->in[I_PKEYS] + (((size_t)l * 8 + hd) * 2 + s) * 128 * 128;
            for (int i = tid * 4; i < 128 * 128; i += NT * 4) *(float4*)(key_s + i) = *(const float4*)(kp + i);
        }
        __syncthreads();
        const int nblk = nb >= 16 ? nb / 16 : 1, bsub = nb >= 16 ? bid_() / 16 : 0;
        for (int chunk = bsub; chunk < (M_ + NT - 1) / NT; chunk += nblk) {
            if (nb >= 16 && bid_() >= nblk * 16) break;
            const int m = chunk * NT + tid;
            if (m >= M_) continue;
            float q[128];
            {
                const h16_t* qp = ACT + (size_t)m * LDZ + C_QRY + hd * 256 + s * 128;
#pragma unroll
                for (int c8 = 0; c8 < 16; ++c8) { float t8[8]; load8h(qp + c8 * 8, t8);
#pragma unroll
                    for (int j = 0; j < 8; ++j) q[c8 * 8 + j] = t8[j]; }
            }
            float top[16];
#pragma unroll
            for (int i = 0; i < 16; ++i) top[i] = -3.0e38f;
#pragma unroll 2
            for (int n = 0; n < 128; ++n) {
                const float* kr = key_s + n * 128;
                float a0 = 0.f, a1 = 0.f, a2 = 0.f, a3 = 0.f;
#pragma unroll
                for (int c4 = 0; c4 < 32; ++c4) {
                    const float4 kv = *(const float4*)(kr + c4 * 4);
                    a0 += q[c4 * 4] * kv.x; a1 += q[c4 * 4 + 1] * kv.y; a2 += q[c4 * 4 + 2] * kv.z; a3 += q[c4 * 4 + 3] * kv.w;
                }
                float x = __uint_as_float((__float_as_uint((a0 + a1) + (a2 + a3)) & ~127u) | (unsigned)(127 - n));
#pragma unroll
                for (int i = 0; i < 16; ++i) { const float hi = fmaxf(top[i], x); x = fminf(top[i], x); top[i] = hi; }
            }
            float* tp = TOPS + (((size_t)m * 8 + hd) * 2 + s) * 16;
#pragma unroll
            for (int i = 0; i < 16; i += 4) *(float4*)(tp + i) = make_float4(top[i], top[i + 1], top[i + 2], top[i + 3]);
        }
    }
}

__device__ __forceinline__ void peer_cand(int k, int& i, int& j) {
    if (k < 16) { i = 0; j = k; } else if (k < 24) { i = 1; j = k - 16; } else if (k < 29) { i = 2; j = k - 24; } else if (k < 33) { i = 3; j = k - 29; }
    else if (k < 36) { i = 4; j = k - 33; } else if (k < 38) { i = 5; j = k - 36; } else if (k < 40) { i = 6; j = k - 38; } else if (k < 42) { i = 7; j = k - 40; }
    else { i = k - 34; j = 0; }
}
__device__ __forceinline__ float dot8h(const uint4 a, const float (&x)[8]) {
    float s = 0.f;
    s += h2f((h16_t)(a.x & 0xffffu)) * x[0]; s += h2f((h16_t)(a.x >> 16)) * x[1]; s += h2f((h16_t)(a.y & 0xffffu)) * x[2]; s += h2f((h16_t)(a.y >> 16)) * x[3];
    s += h2f((h16_t)(a.z & 0xffffu)) * x[4]; s += h2f((h16_t)(a.z >> 16)) * x[5]; s += h2f((h16_t)(a.w & 0xffffu)) * x[6]; s += h2f((h16_t)(a.w >> 16)) * x[7];
    return s;
}
__device__ __forceinline__ void axpy8h(const uint4 a, float s, float (&y)[8]) {
    y[0] += s * h2f((h16_t)(a.x & 0xffffu)); y[1] += s * h2f((h16_t)(a.x >> 16)); y[2] += s * h2f((h16_t)(a.y & 0xffffu)); y[3] += s * h2f((h16_t)(a.y >> 16));
    y[4] += s * h2f((h16_t)(a.z & 0xffffu)); y[5] += s * h2f((h16_t)(a.z >> 16)); y[6] += s * h2f((h16_t)(a.w & 0xffffu)); y[7] += s * h2f((h16_t)(a.w >> 16));
}
__device__ __forceinline__ void stage_peer_gather(KParams p, int l, char* smem) {
    float* tops_s = (float*)smem;
    float* cand_s = tops_s + 256;
    float* best_s = cand_s + 512;
    int* idx_s = (int*)(best_s + 128);
    float* gate_s = (float*)(idx_s + 128);
    float* part_s = gate_s + 128;
    float* ysum_s = part_s + 8 * 16 * 64;
    const h16_t* ACT = (const h16_t*)(p->ws + OFF_ACT);
    const float* TOPS = (const float*)(p->ws + OFF_TOPS);
    char* ws = p->ws;
    const int tid = tid_(), w = tid >> 6, lane = tid & 63;
    for (int m = bid_(); m < M_; m += gridDim.x) {
        __syncthreads();
        if (tid < 256) tops_s[tid] = TOPS[(size_t)m * 256 + tid];
        __syncthreads();
        int ci = 0, cj = 0; float cs = -3.0e38f;
        if (lane < 50) { peer_cand(lane, ci, cj); cs = tops_s[w * 32 + ci] + tops_s[w * 32 + 16 + cj]; }
        cand_s[w * 64 + lane] = cs;
        __syncthreads();
        if (lane < 50) {
            int cnt = 0; const int pos = ci * 16 + cj;
            for (int o = 0; o < 50; ++o) { int oi, oj; peer_cand(o, oi, oj); const float ov = cand_s[w * 64 + o]; cnt += (ov > cs || (ov == cs && oi * 16 + oj < pos)) ? 1 : 0; }
            if (cnt < 16) {
                best_s[w * 16 + cnt] = cs;
                const int n0 = 127 - (int)(__float_as_uint(tops_s[w * 32 + ci]) & 127u), n1 = 127 - (int)(__float_as_uint(tops_s[w * 32 + 16 + cj]) & 127u);
                idx_s[w * 16 + cnt] = n0 * 128 + n1;
            }
        }
        __syncthreads();
        if (tid < 128) {
            const int hd = tid >> 4;
            const float mx = best_s[hd * 16];
            float sum = 0.f;
            for (int i = 0; i < 16; ++i) sum += expf(best_s[hd * 16 + i] - mx);
            gate_s[tid] = expf(best_s[tid] - mx) / sum;
        }
        float x0[8], x1[8];
        load8h(ACT + (size_t)m * LDZ + C_XN + lane * 8, x0); load8h(ACT + (size_t)m * LDZ + C_XN + 512 + lane * 8, x1);
        __syncthreads();
        float* pw = part_s + w * 1024;
#pragma unroll 4
        for (int k = 0; k < 16; ++k) {
            const h16_t* ur = tab_row(ws, 0, idx_s[w * 16 + k]);
            const uint4 u0 = *(const uint4*)(ur + lane * 8), u1 = *(const uint4*)(ur + 512 + lane * 8);
            pw[k * 64 + lane] = dot8h(u0, x0) + dot8h(u1, x1);
        }
        __syncthreads();
        float hid;
        {
            const int k = lane >> 2, qq = lane & 3;
            float s = 0.f;
#pragma unroll
            for (int i = 0; i < 16; ++i) s += pw[k * 64 + qq * 16 + i];
            pw[k * 64 + qq * 16] = s;
        }
        __syncthreads();
        float y0[8], y1[8];
#pragma unroll
        for (int i = 0; i < 8; ++i) { y0[i] = 0.f; y1[i] = 0.f; }
#pragma unroll 4
        for (int k = 0; k < 16; ++k) {
            const float dotv = pw[k * 64] + pw[k * 64 + 16] + pw[k * 64 + 32] + pw[k * 64 + 48];
            hid = gate_s[w * 16 + k] * geluf_(dotv);
            const h16_t* vr = tab_row(ws, 1, idx_s[w * 16 + k]);
            const uint4 v0 = *(const uint4*)(vr + lane * 8), v1 = *(const uint4*)(vr + 512 + lane * 8);
            axpy8h(v0, hid, y0); axpy8h(v1, hid, y1);
        }
        {
            float* yw = ysum_s + w * 1024;
#pragma unroll
            for (int i = 0; i < 8; ++i) { yw[lane * 8 + i] = y0[i]; yw[512 + lane * 8 + i] = y1[i]; }
        }
        __syncthreads();
        {
            float a0 = 0.f, a1 = 0.f;
#pragma unroll
            for (int ww = 0; ww < 8; ++ww) { a0 += ysum_s[ww * 1024 + tid * 2]; a1 += ysum_s[ww * 1024 + tid * 2 + 1]; }
            float2* op = (float2*)(p->out + (size_t)m * 1024 + tid * 2);
            float2 ov = *op;
            ov.x += a0; ov.y += a1;
            *op = ov;
        }
    }
}

enum { PH_NORM_MIX = 0, PH_INPROJ, PH_MIXERS, PH_MERGE, PH_WOUT, PH_NORM_FFN, PH_QUERY, PH_TOPK, PH_GATHER, PH_PER_LAYER, PH_FINAL = 100, PH_WPREP = 101 };
__device__ __forceinline__ void run_phase(KParams p, int l, int ph, char* smem) {
    h16_t* ACT = (h16_t*)(p->ws + OFF_ACT);
    const float* hin = l == 0 ? p->in[I_X] : p->out;
    switch (ph) {
    case PH_WPREP: stage_wprep(p, smem); break;
    case PH_NORM_MIX: stage_rmsnorm<false>(hin, p->in[I_NMIX] + l * 1024, ACT + C_XN, LDZ, smem); break;
    case PH_INPROJ: stage_gemm(p, l, GP_INPROJ, smem); break;
    case PH_MIXERS: {
        const int nb = gridDim.x, n_rw = nb / 2, n_gd = nb / 4, n_lr = nb - n_rw - n_gd;
        stage_rwkv(p, l, smem, 0, n_rw);
        stage_gdn(p, l, smem, n_rw, n_gd);
        stage_lru(p, l, smem, n_rw + n_gd, n_lr);
    } break;
    case PH_MERGE: stage_gemm(p, l, GP_MERGE, smem); break;
    case PH_WOUT: stage_gemm(p, l, GP_WOUT, smem); break;
    case PH_NORM_FFN: stage_rmsnorm<false>(p->out, p->in[I_NFFN] + l * 1024, ACT + C_XN, LDZ, smem); stage_tabconv(p, l); break;
    case PH_QUERY: stage_gemm(p, l, GP_QUERY, smem); break;
    case PH_TOPK: stage_peer_topk(p, l, smem); break;
    case PH_GATHER: stage_peer_gather(p, l, smem); break;
    case PH_FINAL: stage_rmsnorm<true>(p->out, p->in[I_NFINAL], p->out, 1024, smem); break;
    default: break;
    }
}

#if !defined(CPU_EMU) && !MK_MULTI
__global__ void __launch_bounds__(512, 2) k_mega(Params p_) {
    DYN_SMEM(smem);
    KParams pk = (KParams)__builtin_amdgcn_kernarg_segment_ptr();
    cg::grid_group grid = cg::this_grid();
    constexpr int NIT = NL_ * PH_PER_LAYER;
#pragma unroll 1
    for (int it = -1; it <= NIT; ++it) {
        const int l = (it >= 0 && it < NIT) ? it / PH_PER_LAYER : 0, ph = it < 0 ? (int)PH_WPREP : (it < NIT ? it % PH_PER_LAYER : (int)PH_FINAL);
        KParams q = pk; asm volatile("" : "+s"(q));
        run_phase(q, l, ph, smem);
        if (it < NIT && !(it < 0)) grid.sync();
    }
}
#endif
#ifdef CPU_EMU
__global__ void k_phase(Params p_, int l, int ph) { DYN_SMEM(smem); run_phase(&p_, l, ph, smem); }
#elif MK_MULTI
__global__ void __launch_bounds__(512, 2) k_phase(Params p_, int l, int ph) { DYN_SMEM(smem); KParams pk = (KParams)__builtin_amdgcn_kernarg_segment_ptr(); run_phase(pk, l, ph, smem); }
#endif
}

#ifdef CPU_EMU
int g_emu_stop = 1000;
#endif

extern "C" void kernel_launch(void* const* d_in, const int* in_sizes, int n_in, void* d_out, int out_size, void* d_ws, size_t ws_size, hipStream_t stream) {
    Params p{};
    for (int i = 0; i < N_IN; ++i) p.in[i] = (const float*)d_in[i];
    p.out = (float*)d_out; p.ws = (char*)d_ws;
#if defined(CPU_EMU) || MK_MULTI
    const int grid = 256;
    LAUNCH(k_phase, grid, NT, SMEM_BYTES, stream, p, 0, (int)PH_WPREP);
    for (int l = 0; l < NL_; ++l)
        for (int ph = 0; ph < PH_PER_LAYER; ++ph) {
            LAUNCH(k_phase, grid, NT, SMEM_BYTES, stream, p, l, ph);
#ifdef CPU_EMU
            const int code = ph == PH_INPROJ ? 1 : ph == PH_MIXERS ? 2 : ph == PH_MERGE ? 3 : ph == PH_WOUT ? 4 : ph == PH_GATHER ? 5 : 0;
            if (code && g_emu_stop == l * 10 + code) return;
#endif
        }
    LAUNCH(k_phase, grid, NT, SMEM_BYTES, stream, p, 0, (int)PH_FINAL);
#else
    static int grid_blocks = 0;
    if (!grid_blocks) {
        int dev = 0, cus = 0, per_cu = 0;
        (void)hipGetDevice(&dev);
        (void)hipDeviceGetAttribute(&cus, hipDeviceAttributeMultiprocessorCount, dev);
        (void)hipFuncSetAttribute((const void*)k_mega, hipFuncAttributeMaxDynamicSharedMemorySize, (int)SMEM_BYTES);
        (void)hipOccupancyMaxActiveBlocksPerMultiprocessor(&per_cu, k_mega, NT, SMEM_BYTES);
        if (per_cu > 1) per_cu = 1;
        grid_blocks = cus * per_cu;
    }
    void* args[] = {&p};
    hipError_t e = hipLaunchCooperativeKernel((void*)k_mega, dim3(grid_blocks), dim3(NT), args, SMEM_BYTES, stream);
    if (e != hipSuccess) fprintf(stderr, "cooperative launch failed: %s (grid %d)\n", hipGetErrorString(e), grid_blocks);
#endif
}
```

```cpp
#ifndef CPU_EMU
#include <hip/hip_runtime.h>
#include <hip/hip_cooperative_groups.h>
#include <cstdio>
#include <cstdint>
namespace cg = cooperative_groups;
#define DYN_SMEM(name) extern __shared__ __attribute__((aligned(16))) char name[]
#define LAUNCH(kern, grid, block, smem, stream, ...) hipLaunchKernelGGL(kern, dim3(grid), dim3(block), smem, stream, __VA_ARGS__)
#endif

#ifndef CFG_B
#define CFG_B 8
#endif
#ifndef CFG_T
#define CFG_T 2048
#endif
#ifndef MK_MULTI
#define MK_MULTI 0
#endif

namespace {
constexpr int B_ = CFG_B, T_ = CFG_T, M_ = B_ * T_, D_ = 1024, NL_ = 2, NT = 512;
constexpr int INW = 12560;
constexpr int LDZ = 11776;
constexpr int Z_ULRU = 0, Z_GLRU = 1024, Z_Q = 2048, Z_K = 3072, Z_V = 4096, Z_ZG = 5120, Z_RW = 6144, Z_ALPHA = 9472, Z_BETA = 9480;
constexpr int ZN = 9728;
constexpr int C_XN = 9728, C_YC = 10752;
constexpr int C_YA = Z_GLRU, C_YB = Z_ZG;
constexpr int C_GS = Z_Q, C_MG = Z_K;
constexpr int C_QRY = 0;
constexpr int RW_R = 0, RW_K = 1024, RW_V = 2048, RW_WL = 3072, RW_AL = 3136, RW_GL = 3200, RWW = 3328;
constexpr float RMS_EPS = 1e-6f, GN_EPS = 64e-5f;
typedef unsigned short h16_t;

enum { I_X = 0, I_NMIX, I_NFFN, I_NFINAL, I_WIN, I_LCW, I_LCB, I_LWA, I_LBA, I_LWX, I_LBX, I_LLAM, I_GCW, I_GALOG, I_GDT, I_GNW,
       I_RMU, I_RW0, I_RWUP, I_RA0, I_RAUP, I_RGUP, I_RKK, I_RKA, I_RRK, I_RLW, I_RLB, I_MB, I_PL, I_PG, I_PR, I_WOUT, I_PWQ, I_PKEYS, I_PU, I_PV, N_IN };

struct Params {
    const float* in[N_IN];
    float* out;
    char* ws;
};
#ifdef CPU_EMU
typedef const Params* KParams;
#else
typedef const Params __attribute__((address_space(4)))* KParams;
#endif

constexpr size_t al256(size_t x) { return (x + 255) / 256 * 256; }
constexpr size_t OFF_ACT = 0;
constexpr size_t OFF_WT = al256(OFF_ACT + (size_t)M_ * LDZ * 2);
constexpr int WT_IN = 0, WT_MG = ZN, WT_P = WT_MG + 3072, WT_OUT = WT_P + 3072, WT_Q = WT_OUT + 1024, WT_ROWS = WT_Q + 2048;
constexpr size_t OFF_TOPS = al256(OFF_WT + (size_t)NL_ * WT_ROWS * 1024 * 2);
constexpr size_t OFF_TAB = al256(OFF_TOPS + (size_t)M_ * 256 * 4);
constexpr size_t WS_END = OFF_TAB + (M_ == 16384 ? 0 : (size_t)2 * 16384 * 1024 * 2);
static_assert(CFG_B != 8 || CFG_T != 2048 || WS_END <= (size_t)512 * 1024 * 1024, "workspace budget");
constexpr size_t SMEM_BYTES = 128 * 1024;

#ifdef CPU_EMU
__device__ __forceinline__ int tid_() { return threadIdx.x; }
__device__ __forceinline__ h16_t f2h(float f) { return (h16_t)_cvtss_sh(f, _MM_FROUND_TO_NEAREST_INT); }
__device__ __forceinline__ float h2f(h16_t h) { return _cvtsh_ss(h); }
#else
__device__ __forceinline__ int tid_() { int t = threadIdx.x; asm volatile("" : "+v"(t)); return t; }
__device__ __forceinline__ h16_t f2h(float f) { return __builtin_bit_cast(unsigned short, (_Float16)f); }
__device__ __forceinline__ float h2f(h16_t h) { return (float)__builtin_bit_cast(_Float16, h); }
#endif
__device__ __forceinline__ int bid_() { return (int)blockIdx.x; }

__device__ __forceinline__ float sigmoidf_(float x) { return 1.0f / (1.0f + expf(-x)); }
__device__ __forceinline__ float softplusf_(float x) { return fmaxf(x, 0.0f) + log1pf(expf(-fabsf(x))); }
__device__ __forceinline__ float siluf_(float x) { return x * sigmoidf_(x); }
__device__ __forceinline__ float geluf_(float x) { return 0.5f * x * (1.0f + tanhf(0.7978845608028654f * (x + 0.044715f * x * x * x))); }
__device__ __forceinline__ unsigned pack2h(float a, float b) { return (unsigned)f2h(a) | ((unsigned)f2h(b) << 16); }
__device__ __forceinline__ void store8h(h16_t* p, const float (&v)[8]) {
    uint4 w; w.x = pack2h(v[0], v[1]); w.y = pack2h(v[2], v[3]); w.z = pack2h(v[4], v[5]); w.w = pack2h(v[6], v[7]);
    *(uint4*)p = w;
}
__device__ __forceinline__ void load8h(const h16_t* p, float (&v)[8]) {
    const uint4 w = *(const uint4*)p;
    v[0] = h2f((h16_t)(w.x & 0xffffu)); v[1] = h2f((h16_t)(w.x >> 16)); v[2] = h2f((h16_t)(w.y & 0xffffu)); v[3] = h2f((h16_t)(w.y >> 16));
    v[4] = h2f((h16_t)(w.z & 0xffffu)); v[5] = h2f((h16_t)(w.z >> 16)); v[6] = h2f((h16_t)(w.w & 0xffffu)); v[7] = h2f((h16_t)(w.w >> 16));
}

__device__ __forceinline__ float block_sum512(float v, float* red) {
    const int tid = tid_();
    red[tid] = v;
    __syncthreads();
    if (tid < 32) { float s = 0.f; for (int i = 0; i < 16; ++i) s += red[tid * 16 + i]; red[512 + tid] = s; }
    __syncthreads();
    float tot = 0.f;
    for (int i = 0; i < 32; ++i) tot += red[512 + i];
    __syncthreads();
    return tot;
}

template <bool OUT_F32>
__device__ __forceinline__ void stage_rmsnorm(const float* src, const float* w, void* dst, int ldd, char* smem) {
    float* red = (float*)smem;
    const int tid = tid_();
    for (int row = bid_(); row < M_; row += gridDim.x) {
        const float2 v = *(const float2*)(src + (size_t)row * D_ + tid * 2);
        const float ss = block_sum512(v.x * v.x + v.y * v.y, red);
        const float rstd = rsqrtf(ss * (1.0f / D_) + RMS_EPS);
        const float2 wv = *(const float2*)(w + tid * 2);
        const float o0 = v.x * rstd * wv.x, o1 = v.y * rstd * wv.y;
        if (OUT_F32) {
            float2 o; o.x = o0; o.y = o1;
            *(float2*)((float*)dst + (size_t)row * ldd + tid * 2) = o;
        } else {
            *(unsigned*)((h16_t*)dst + (size_t)row * ldd + tid * 2) = pack2h(o0, o1);
        }
    }
}

__device__ __forceinline__ const float* wt_src(KParams p, int l, int r, int& ld) {
    if (r < ZN) {
        ld = INW;
        int c;
        if (r < 6144) c = r; else if (r < 9472) c = r + 16; else if (r < 9488) c = r - 3328; else return nullptr;
        return p->in[I_WIN] + (size_t)l * 1024 * INW + c;
    }
    r -= ZN;
    if (r < 3072) { ld = INW; return p->in[I_WIN] + (size_t)l * 1024 * INW + 9488 + r; }
    r -= 3072;
    if (r < 3072) { ld = 1024; const int br = r >> 10; return p->in[br == 0 ? I_PL : (br == 1 ? I_PG : I_PR)] + (size_t)l * 1024 * 1024 + (r & 1023); }
    r -= 3072;
    if (r < 1024) { ld = 1024; return p->in[I_WOUT] + (size_t)l * 1024 * 1024 + r; }
    r -= 1024;
    ld = 2048; return p->in[I_PWQ] + (size_t)l * 1024 * 2048 + r;
}
__device__ __forceinline__ void stage_wprep(KParams p, char* smem) {
    float* tile = (float*)smem;
    h16_t* WT = (h16_t*)(p->ws + OFF_WT);
    const int tid = tid_();
    const int ntr = WT_ROWS / 64, total = NL_ * ntr * 16;
    for (int it = bid_(); it < total; it += gridDim.x) {
        const int l = it / (ntr * 16), rem = it % (ntr * 16), rt = rem / 16, kt = rem % 16;
        const int r0 = rt * 64, k0 = kt * 64;
        __syncthreads();
        {
            const int nn = tid & 63;
            int ld = 0; const float* src = wt_src(p, l, r0 + nn, ld);
#pragma unroll
            for (int i = 0; i < 8; ++i) { const int kk = (tid >> 6) + 8 * i; tile[kk * 65 + nn] = src ? src[(size_t)(k0 + kk) * ld] : 0.f; }
        }
        __syncthreads();
        {
            const int r = tid >> 3, kq = (tid & 7) * 8;
            float v[8];
#pragma unroll
            for (int j = 0; j < 8; ++j) v[j] = tile[(kq + j) * 65 + r];
            store8h(WT + ((size_t)l * WT_ROWS + r0 + r) * 1024 + k0 + kq, v);
        }
    }
}

namespace pg8 {
constexpr int BM = 256, BK = 64, HALF = 128, HTB = HALF * BK * 2, STAGE_BYTES = 8 * HTB, NXCD = 8, WGM = 8;
struct Unit { const char* A; const char* B; int pm, pn, kind; };
#ifdef CPU_EMU
struct f32x4 { float d[4]; float& operator[](int i) { return d[i]; } const float& operator[](int i) const { return d[i]; } };
#else
#define PG8_LAS __attribute__((address_space(3)))
typedef _Float16 f16x8 __attribute__((ext_vector_type(8)));
typedef float f32x4 __attribute__((ext_vector_type(4)));
__device__ __forceinline__ int lds_byte(int r, int c) { const int st = (r >> 4) * 2 + (c >> 5), rr = r & 15, cc = c & 31, ob = rr * 64 + cc * 2; return st * 1024 + (ob ^ (((ob >> 9) & 1) << 5)); }
__device__ __forceinline__ void stage_rc(int b, int& R, int& C) { const int st = b / 1024, sb = b % 1024, swz = sb ^ (((sb >> 9) & 1) << 5); R = (st >> 1) * 16 + swz / 64; C = (st & 1) * 32 + (swz % 64) / 2; }
__device__ __forceinline__ int perm32(int rho) { const int n = rho >> 4, i = rho & 15; return 8 * (i >> 2) + 4 * n + (i & 3); }
#endif
__device__ __forceinline__ void tile_of(int L, int nM, int nN, int& pm, int& pn) {
    const int nwg = nM * nN;
    int wgid = L; { const int q = nwg / NXCD, r = nwg % NXCD, xcd = wgid % NXCD, off = wgid / NXCD; wgid = (xcd < r ? xcd * (q + 1) : r * (q + 1) + (xcd - r) * q) + off; }
    const int nig = WGM * nN, gid = wgid / nig, fm = gid * WGM, gsz = (nM - fm) < WGM ? (nM - fm) : WGM;
    pm = fm + ((wgid % nig) % gsz); pn = (wgid % nig) / gsz;
}

template <class Sched, class Epi>
__device__ __forceinline__ void gemm_phase(char* smem, const Sched& S, const Epi& E) {
    constexpr int K = 1024, nt = K / BK;
    constexpr unsigned lda = LDZ, ldb = 1024;
#ifdef CPU_EMU
    const int tid = tid_(), wid = tid >> 6, lane = tid & 63, wr = wid >> 2, wc = wid & 3, fr = lane & 15, fq = lane >> 4;
    Unit u;
    for (int ui = 0; S.next(ui, u); ++ui) {
        f32x4 acc[2][2][4][2];
        for (int ai = 0; ai < 2; ++ai) for (int bj = 0; bj < 2; ++bj) for (int m = 0; m < 4; ++m) for (int n = 0; n < 2; ++n) for (int e = 0; e < 4; ++e) {
            const int r = 128 * ai + 64 * wr + 16 * m + fr, c = 128 * bj + 32 * wc + 8 * fq + 4 * n + e;
            const h16_t* a = (const h16_t*)u.A + (size_t)r * lda; const h16_t* b = (const h16_t*)u.B + (size_t)c * ldb;
            float s = 0.f;
            for (int k = 0; k < K; ++k) s += h2f(a[k]) * h2f(b[k]);
            acc[ai][bj][m][n][e] = s;
        }
        E(acc, u, wr, wc, fr, fq);
    }
    (void)smem; (void)nt;
#else
    PG8_LAS unsigned char* lds = (PG8_LAS unsigned char*)smem;
    const int tid = tid_(), wid = __builtin_amdgcn_readfirstlane(tid >> 6), lane = tid & 63, wr = wid >> 2, wc = wid & 3, fr = lane & 15, fq = lane >> 4;
    unsigned voffA[2], voffB[2];
#pragma unroll
    for (int i = 0; i < 2; ++i) { int R, C; stage_rc(tid * 16 + i * 8192, R, C); const int Rb = (R & ~31) + perm32(R & 31);
        voffA[i] = (unsigned)(R * lda + C) * 2u; voffB[i] = (unsigned)(Rb * ldb + C) * 2u; }
    constexpr size_t kstep = (size_t)(BK * 2);
    constexpr size_t hstepA = (size_t)HALF * lda * 2, hstepB = (size_t)HALF * ldb * 2;
    const unsigned ldsw = (unsigned)wid * 1024u;
    const int aoff = lds_byte(wr * 64 + fr, fq * 8), boff = lds_byte(wc * 32 + fr, fq * 8);
#define PG8_SA(b, h) (((b) * 2 + (h)) * HTB)
#define PG8_SB(b, h) ((4 + (b) * 2 + (h)) * HTB)
#define PG8_STAGE(bufoff, gbase, voff) do { _Pragma("unroll") for (int _i = 0; _i < 2; ++_i) \
        __builtin_amdgcn_global_load_lds((const unsigned*)((const char*)(gbase) + (voff)[_i]), (PG8_LAS unsigned*)(lds + (bufoff) + ldsw + _i * 8192), 16, 0, 0); } while (0)
#define PG8_LDA(dst, b, h) do { _Pragma("unroll") for (int m = 0; m < 4; ++m) _Pragma("unroll") for (int k = 0; k < 2; ++k) dst[m][k] = *(const PG8_LAS f16x8*)(lds + PG8_SA(b, h) + aoff + m * 2048 + k * 1024); } while (0)
#define PG8_LDB(dst, b, h) do { _Pragma("unroll") for (int n = 0; n < 2; ++n) _Pragma("unroll") for (int k = 0; k < 2; ++k) dst[n][k] = *(const PG8_LAS f16x8*)(lds + PG8_SB(b, h) + boff + n * 2048 + k * 1024); } while (0)
#define PG8_MMA(ai, bj, At, Bt) do { __builtin_amdgcn_s_setprio(1); _Pragma("unroll") for (int m = 0; m < 4; ++m) _Pragma("unroll") for (int n = 0; n < 2; ++n) _Pragma("unroll") for (int k = 0; k < 2; ++k) \
        acc[ai][bj][m][n] = __builtin_amdgcn_mfma_f32_16x16x32_f16(Bt[n][k], At[m][k], acc[ai][bj][m][n], 0, 0, 0); __builtin_amdgcn_s_setprio(0); } while (0)
#define PG8_WAIT_V(n) asm volatile("s_waitcnt vmcnt(" #n ")" ::: "memory")
#define PG8_WAIT_L(n) asm volatile("s_waitcnt lgkmcnt(" #n ")" ::: "memory")
#define PG8_BAR __builtin_amdgcn_s_barrier()
#define PG8_SCHED __builtin_amdgcn_sched_barrier(0)
    Unit cur, nxt; int ui = 0;
    if (!S.next(0, cur)) return;
    f32x4 acc[2][2][4][2];
#pragma unroll
    for (int a = 0; a < 2; ++a)
#pragma unroll
        for (int b = 0; b < 2; ++b)
#pragma unroll
            for (int m = 0; m < 4; ++m)
#pragma unroll
                for (int n = 0; n < 2; ++n) acc[a][b][m][n] = (f32x4){0.f, 0.f, 0.f, 0.f};
    f16x8 At[4][2], B0[2][2], B1[2][2];
    const char* cA = cur.A; const char* cB = cur.B;
    PG8_STAGE(PG8_SB(0, 0), cB, voffB); PG8_STAGE(PG8_SA(0, 0), cA, voffA); PG8_STAGE(PG8_SB(0, 1), cB + hstepB, voffB); PG8_STAGE(PG8_SA(0, 1), cA + hstepA, voffA);
    if (wr == 1) PG8_BAR;
    PG8_WAIT_V(4); PG8_BAR;
    PG8_STAGE(PG8_SB(1, 0), cB + kstep, voffB); PG8_STAGE(PG8_SA(1, 0), cA + kstep, voffA); PG8_STAGE(PG8_SB(1, 1), cB + hstepB + kstep, voffB);
    PG8_WAIT_V(6); PG8_BAR;
    for (;;) {
        const bool has_next = S.next(ui + 1, nxt);
        const char* nA = has_next ? nxt.A : cA; const char* nB = has_next ? nxt.B : cB;
#pragma unroll 1
        for (int t = 0; t < nt; t += 2) {
            const bool last = (t == nt - 2);
            const char* a1 = cA + (size_t)(t + 1) * kstep;
            const char* a2 = last ? nA : cA + (size_t)(t + 2) * kstep; const char* b2 = last ? nB : cB + (size_t)(t + 2) * kstep;
            const char* a3 = a2 + kstep; const char* b3 = b2 + kstep;
            PG8_LDB(B0, 0, 0); PG8_SCHED; PG8_LDA(At, 0, 0); PG8_STAGE(PG8_SA(1, 1), a1 + hstepA, voffA);
            PG8_WAIT_L(8); PG8_BAR; PG8_WAIT_L(0); PG8_MMA(0, 0, At, B0); PG8_BAR; PG8_SCHED;
            PG8_LDB(B1, 0, 1); PG8_STAGE(PG8_SB(0, 0), b2, voffB);
            PG8_BAR; PG8_WAIT_L(0); PG8_MMA(0, 1, At, B1); PG8_BAR;
            PG8_LDA(At, 0, 1); PG8_STAGE(PG8_SA(0, 0), a2, voffA);
            PG8_BAR; PG8_WAIT_L(0); PG8_MMA(1, 0, At, B0); PG8_BAR; PG8_SCHED;
            PG8_STAGE(PG8_SB(0, 1), b2 + hstepB, voffB);
            PG8_WAIT_V(6); PG8_BAR; PG8_MMA(1, 1, At, B1); PG8_BAR;
            PG8_LDB(B0, 1, 0); PG8_SCHED; PG8_LDA(At, 1, 0); PG8_STAGE(PG8_SA(0, 1), a2 + hstepA, voffA);
            PG8_WAIT_L(8); PG8_BAR; PG8_WAIT_L(0); PG8_MMA(0, 0, At, B0); PG8_BAR; PG8_SCHED;
            PG8_LDB(B1, 1, 1); PG8_STAGE(PG8_SB(1, 0), b3, voffB);
            PG8_BAR; PG8_WAIT_L(0); PG8_MMA(0, 1, At, B1); PG8_BAR;
            PG8_LDA(At, 1, 1); PG8_STAGE(PG8_SA(1, 0), a3, voffA);
            PG8_BAR; PG8_WAIT_L(0); PG8_MMA(1, 0, At, B0); PG8_BAR; PG8_SCHED;
            PG8_STAGE(PG8_SB(1, 1), b3 + hstepB, voffB);
            PG8_WAIT_V(6); PG8_BAR; PG8_MMA(1, 1, At, B1); PG8_BAR;
        }
        E(acc, cur, wr, wc, fr, fq);
        if (!has_next) break;
#pragma unroll
        for (int a = 0; a < 2; ++a)
#pragma unroll
            for (int b = 0; b < 2; ++b)
#pragma unroll
                for (int m = 0; m < 4; ++m)
#pragma unroll
                    for (int n = 0; n < 2; ++n) acc[a][b][m][n] = (f32x4){0.f, 0.f, 0.f, 0.f};
        cur = nxt; cA = nA; cB = nB; ++ui;
    }
    PG8_WAIT_V(0);
    if (wr == 0) PG8_BAR;
    PG8_BAR;
#undef PG8_SA
#undef PG8_SB
#undef PG8_STAGE
#undef PG8_LDA
#undef PG8_LDB
#undef PG8_MMA
#undef PG8_WAIT_V
#undef PG8_WAIT_L
#undef PG8_BAR
#undef PG8_SCHED
#endif
}
}

enum { GK_STORE = 0, GK_GATE0, GK_GATE1, GK_GATE2, GK_PROJ0, GK_PROJ1, GK_PROJ2, GK_RESID };
enum { GP_INPROJ = 0, GP_MERGE, GP_WOUT, GP_QUERY };
struct GemmProg {
    const char* act; const char* wt;
    int which, G, c;
    __device__ __forceinline__ bool next(int i, pg8::Unit& u) const {
        constexpr int nM = M_ / 256;
        constexpr size_t rowA = (size_t)256 * LDZ * 2, rowB = (size_t)256 * 1024 * 2;
        if (which == GP_MERGE) {
            const int L = (i / 6) * G + c, j = i % 6, br = j >> 1;
            if (L >= nM * 4) return false;
            pg8::tile_of(L, nM, 4, u.pm, u.pn);
            if ((j & 1) == 0) { u.A = act + (size_t)C_XN * 2; u.B = wt + ((size_t)(WT_MG + br * 1024) * 1024) * 2; u.kind = GK_GATE0 + br; }
            else { u.A = act + (size_t)(br == 0 ? C_YA : (br == 1 ? C_YB : C_YC)) * 2; u.B = wt + ((size_t)(WT_P + br * 1024) * 1024) * 2; u.kind = GK_PROJ0 + br; }
        } else {
            const int nN = which == GP_INPROJ ? ZN / 256 : (which == GP_WOUT ? 4 : 8);
            const int L = i * G + c;
            if (L >= nM * nN) return false;
            pg8::tile_of(L, nM, nN, u.pm, u.pn);
            u.A = act + (size_t)(which == GP_WOUT ? C_MG : C_XN) * 2;
            u.B = wt + ((size_t)(which == GP_INPROJ ? WT_IN : (which == GP_WOUT ? WT_OUT : WT_Q)) * 1024) * 2;
            u.kind = which == GP_WOUT ? GK_RESID : GK_STORE;
        }
        u.A += (size_t)u.pm * rowA; u.B += (size_t)u.pn * rowB;
        return true;
    }
};
struct GemmEpi {
    h16_t* act; const float* mb; const float* resid; float* out;
    __device__ __forceinline__ void operator()(const pg8::f32x4 (&acc)[2][2][4][2], const pg8::Unit& u, int wr, int wc, int fr, int fq) const {
        const int row0 = u.pm * 256 + wr * 64 + fr, col0 = u.pn * 256 + wc * 32 + 8 * fq;
#pragma unroll
        for (int ai = 0; ai < 2; ++ai)
#pragma unroll
            for (int m = 0; m < 4; ++m) {
                const int row = row0 + ai * 128 + m * 16;
#pragma unroll
                for (int bj = 0; bj < 2; ++bj) {
                    const int col = col0 + bj * 128;
                    float v[8];
#pragma unroll
                    for (int e = 0; e < 4; ++e) { v[e] = acc[ai][bj][m][0][e]; v[4 + e] = acc[ai][bj][m][1][e]; }
                    h16_t* arow = act + (size_t)row * LDZ;
                    if (u.kind == GK_STORE) {
                        store8h(arow + col, v);
                    } else if (u.kind <= GK_GATE2) {
                        const float* bp = mb + (u.kind - GK_GATE0) * 1024 + col;
                        const float4 b0 = *(const float4*)bp, b1 = *(const float4*)(bp + 4);
                        v[0] = sigmoidf_(v[0] + b0.x); v[1] = sigmoidf_(v[1] + b0.y); v[2] = sigmoidf_(v[2] + b0.z); v[3] = sigmoidf_(v[3] + b0.w);
                        v[4] = sigmoidf_(v[4] + b1.x); v[5] = sigmoidf_(v[5] + b1.y); v[6] = sigmoidf_(v[6] + b1.z); v[7] = sigmoidf_(v[7] + b1.w);
                        store8h(arow + C_GS + col, v);
                    } else if (u.kind <= GK_PROJ2) {
                        float g[8]; load8h(arow + C_GS + col, g);
                        if (u.kind == GK_PROJ0) {
#pragma unroll
                            for (int e = 0; e < 8; ++e) v[e] = g[e] * v[e];
                        } else {
                            float o[8]; load8h(arow + C_MG + col, o);
#pragma unroll
                            for (int e = 0; e < 8; ++e) v[e] = o[e] + g[e] * v[e];
                        }
                        store8h(arow + C_MG + col, v);
                    } else {
                        const size_t o = (size_t)row * 1024 + col;
                        const float4 r0 = *(const float4*)(resid + o), r1 = *(const float4*)(resid + o + 4);
                        *(float4*)(out + o) = make_float4(r0.x + v[0], r0.y + v[1], r0.z + v[2], r0.w + v[3]);
                        *(float4*)(out + o + 4) = make_float4(r1.x + v[4], r1.y + v[5], r1.z + v[6], r1.w + v[7]);
                    }
                }
            }
    }
};
__device__ __forceinline__ void stage_gemm(KParams p, int l, int which, char* smem) {
    GemmProg S; S.act = p->ws + OFF_ACT; S.wt = p->ws + OFF_WT + (size_t)l * WT_ROWS * 1024 * 2; S.which = which; S.G = gridDim.x; S.c = bid_();
    GemmEpi E; E.act = (h16_t*)(p->ws + OFF_ACT); E.mb = p->in[I_MB] + l * 3072; E.resid = l == 0 ? p->in[I_X] : p->out; E.out = p->out;
    pg8::gemm_phase(smem, S, E);
}

#ifdef CPU_EMU
__device__ __forceinline__ float group_sum(float v, int width, float* scratch) {
    const int tid = tid_();
    scratch[tid] = v;
    __syncthreads();
    float s = 0.f; const int base = tid & ~(width - 1);
    for (int i = 0; i < width; ++i) s += scratch[base + i];
    __syncthreads();
    return s;
}
#else
template <int CTRL> __device__ __forceinline__ float dpp_f(float v) { return __builtin_bit_cast(float, __builtin_amdgcn_update_dpp(0, __builtin_bit_cast(int, v), CTRL, 0xf, 0xf, false)); }
__device__ __forceinline__ float group_sum(float v, int width, float*) {
    v += dpp_f<0xB1>(v);
    v += dpp_f<0x4E>(v);
    if (width >= 8) v += dpp_f<0x141>(v);
    if (width >= 16) v += dpp_f<0x140>(v);
    if (width >= 32) v += __shfl_xor(v, 16);
    if (width >= 64) v += __shfl_xor(v, 32);
    return v;
}
#endif
__device__ __forceinline__ uint4 ldg16(const h16_t* p) { return *(const uint4*)p; }
__device__ __forceinline__ uint4 zero16() { uint4 z; z.x = 0u; z.y = 0u; z.z = 0u; z.w = 0u; return z; }

__device__ __forceinline__ void stage_lru(KParams p, int l, char* smem, int vb0, int nvb) {
    const int vb = bid_() - vb0;
    if (vb < 0 || vb >= nvb) return;
    constexpr int CH = 64;
    float* wa_s = (float*)smem;
    float* wx_s = wa_s + 4096;
    float* xcT = wx_s + 4096;
    float* a_s = xcT + 64 * CH;
    float* b_s = a_s + CH * 64;
    h16_t* ru = (h16_t*)(b_s + CH * 64);
    h16_t* rg = ru + (CH + 3) * 64;
    h16_t* ACT = (h16_t*)(p->ws + OFF_ACT);
    const int tid = tid_(), c = tid & 63, tg = tid >> 6;
    for (int item = vb; item < B_ * 16; item += nvb) {
        const int b = item / 16, n = item % 16, ch = n * 64 + c;
        __syncthreads();
        for (int i = tid; i < 4096; i += NT) { wa_s[i] = p->in[I_LWA][((size_t)l * 16 + n) * 4096 + i]; wx_s[i] = p->in[I_LWX][((size_t)l * 16 + n) * 4096 + i]; }
        const float cw0 = p->in[I_LCW][((size_t)l * 4 + 0) * 1024 + ch], cw1 = p->in[I_LCW][((size_t)l * 4 + 1) * 1024 + ch];
        const float cw2 = p->in[I_LCW][((size_t)l * 4 + 2) * 1024 + ch], cw3 = p->in[I_LCW][((size_t)l * 4 + 3) * 1024 + ch];
        const float cb = p->in[I_LCB][l * 1024 + ch], ba = p->in[I_LBA][l * 1024 + ch], bx = p->in[I_LBX][l * 1024 + ch];
        const float sp = softplusf_(-p->in[I_LLAM][l * 1024 + ch]);
        float hst = 0.f;
        uint4 pf[3];
#define LRU_LOAD(t0_) do { _Pragma("unroll") for (int i = 0; i < 3; ++i) { const int j = tid + NT * i; pf[i] = zero16(); \
            if (j < 536) { const int t = (t0_) - 3 + (j >> 3); if (t >= 0) pf[i] = ldg16(ACT + ((size_t)b * T_ + t) * LDZ + Z_ULRU + n * 64 + (j & 7) * 8); } \
            else if (j < 1048) { const int jj = j - 536; pf[i] = ldg16(ACT + ((size_t)b * T_ + (t0_) + (jj >> 3)) * LDZ + Z_GLRU + n * 64 + (jj & 7) * 8); } } } while (0)
#define LRU_PUT() do { _Pragma("unroll") for (int i = 0; i < 3; ++i) { const int j = tid + NT * i; \
            if (j < 536) *(uint4*)(ru + (j >> 3) * 64 + (j & 7) * 8) = pf[i]; else if (j < 1048) *(uint4*)(rg + ((j - 536) >> 3) * 64 + ((j - 536) & 7) * 8) = pf[i]; } } while (0)
        LRU_LOAD(0);
        LRU_PUT();
        __syncthreads();
#pragma unroll 1
        for (int t0 = 0; t0 < T_; t0 += CH) {
            float xc[8];
            {
                float u[11];
#pragma unroll
                for (int s = 0; s < 11; ++s) u[s] = h2f(ru[(tg * 8 + s) * 64 + c]);
#pragma unroll
                for (int s = 0; s < 8; ++s) { xc[s] = cw0 * u[s] + cw1 * u[s + 1] + cw2 * u[s + 2] + cw3 * u[s + 3] + cb; xcT[c * CH + tg * 8 + s] = xc[s]; }
            }
            __syncthreads();
            if (t0 + CH < T_) LRU_LOAD(t0 + CH);
            {
                float dr[8], di[8];
#pragma unroll
                for (int s = 0; s < 8; ++s) { dr[s] = 0.f; di[s] = 0.f; }
#pragma unroll 4
                for (int i = 0; i < 64; ++i) {
                    const float wa = wa_s[i * 64 + c], wx = wx_s[i * 64 + c];
                    const float4 x0 = *(const float4*)(xcT + i * CH + tg * 8), x1 = *(const float4*)(xcT + i * CH + tg * 8 + 4);
                    dr[0] += x0.x * wa; dr[1] += x0.y * wa; dr[2] += x0.z * wa; dr[3] += x0.w * wa; dr[4] += x1.x * wa; dr[5] += x1.y * wa; dr[6] += x1.z * wa; dr[7] += x1.w * wa;
                    di[0] += x0.x * wx; di[1] += x0.y * wx; di[2] += x0.z * wx; di[3] += x0.w * wx; di[4] += x1.x * wx; di[5] += x1.y * wx; di[6] += x1.z * wx; di[7] += x1.w * wx;
                }
#pragma unroll
                for (int s = 0; s < 8; ++s) {
                    const float r = sigmoidf_(dr[s] + ba), ig = sigmoidf_(di[s] + bx);
                    const float log_a = -8.0f * r * sp;
                    a_s[(tg * 8 + s) * 64 + c] = expf(log_a);
                    b_s[(tg * 8 + s) * 64 + c] = sqrtf(-expm1f(2.0f * log_a)) * (ig * xc[s]);
                }
            }
            __syncthreads();
            if (tid < 64) {
#pragma unroll 8
                for (int t = 0; t < CH; ++t) { hst = a_s[t * 64 + c] * hst + b_s[t * 64 + c]; b_s[t * 64 + c] = hst; }
            }
            __syncthreads();
#pragma unroll
            for (int s = 0; s < 8; ++s) { h16_t* gp = rg + (tg * 8 + s) * 64 + c; *gp = f2h(b_s[(tg * 8 + s) * 64 + c] * geluf_(h2f(*gp))); }
            __syncthreads();
            *(uint4*)(ACT + ((size_t)b * T_ + t0 + (tid >> 3)) * LDZ + Z_GLRU + n * 64 + (tid & 7) * 8) = *(const uint4*)(rg + (tid >> 3) * 64 + (tid & 7) * 8);
            __syncthreads();
            if (t0 + CH < T_) LRU_PUT();
            __syncthreads();
        }
#undef LRU_LOAD
#undef LRU_PUT
    }
}

#ifdef CPU_EMU
struct hfrag { h16_t v[8]; };
struct facc { float d[4]; float& operator[](int i) { return d[i]; } const float& operator[](int i) const { return d[i]; } };
__device__ __forceinline__ facc facc_zero() { facc a; a.d[0] = a.d[1] = a.d[2] = a.d[3] = 0.f; return a; }
__device__ __forceinline__ hfrag frag_u4(uint4 w) { hfrag f; memcpy(&f, &w, 16); return f; }
__device__ __forceinline__ hfrag frag_2u2(uint2 lo, uint2 hi) { hfrag f; memcpy(&f.v[0], &lo, 8); memcpy(&f.v[4], &hi, 8); return f; }
__device__ __forceinline__ hfrag frag_mul(hfrag a, hfrag b) { hfrag f; for (int j = 0; j < 8; ++j) f.v[j] = f2h(h2f(a.v[j]) * h2f(b.v[j])); return f; }
__device__ __forceinline__ facc mfma16(hfrag a, hfrag b, facc c) {
    const int tid = tid_(), w = tid >> 6, l = tid & 63;
    unsigned short (*X)[64][16] = emu::ctx->xscr;
    for (int j = 0; j < 8; ++j) { X[w][l][j] = a.v[j]; X[w][l][8 + j] = b.v[j]; }
    __syncthreads();
    for (int reg = 0; reg < 4; ++reg) {
        const int row = 4 * (l >> 4) + reg, col = l & 15;
        float s = 0.f;
        for (int k = 0; k < 32; ++k) s += h2f(X[w][row + 16 * (k >> 3)][k & 7]) * h2f(X[w][col + 16 * (k >> 3)][8 + (k & 7)]);
        c.d[reg] += s;
    }
    __syncthreads();
    return c;
}
#else
typedef _Float16 hfrag __attribute__((ext_vector_type(8)));
typedef float facc __attribute__((ext_vector_type(4)));
__device__ __forceinline__ facc facc_zero() { return (facc){0.f, 0.f, 0.f, 0.f}; }
__device__ __forceinline__ hfrag frag_u4(uint4 w) { return __builtin_bit_cast(hfrag, w); }
__device__ __forceinline__ hfrag frag_2u2(uint2 lo, uint2 hi) { uint4 w; w.x = lo.x; w.y = lo.y; w.z = hi.x; w.w = hi.y; return __builtin_bit_cast(hfrag, w); }
__device__ __forceinline__ hfrag frag_mul(hfrag a, hfrag b) { return a * b; }
__device__ __forceinline__ facc mfma16(hfrag a, hfrag b, facc c) { return __builtin_amdgcn_mfma_f32_16x16x32_f16(a, b, c, 0, 0, 0); }
#endif
__device__ __forceinline__ hfrag frag_pack8(float a0, float a1, float a2, float a3, float a4, float a5, float a6, float a7) {
    uint4 w; w.x = pack2h(a0, a1); w.y = pack2h(a2, a3); w.z = pack2h(a4, a5); w.w = pack2h(a6, a7); return frag_u4(w);
}
__device__ __forceinline__ hfrag frag_acc2(const facc& t0, const facc& t1) { return frag_pack8(t0[0], t0[1], t0[2], t0[3], t1[0], t1[1], t1[2], t1[3]); }
__device__ __forceinline__ hfrag permfrag(const h16_t* rowp, int ks, int g) { return frag_2u2(*(const uint2*)(rowp + 32 * ks + 4 * g), *(const uint2*)(rowp + 32 * ks + 16 + 4 * g)); }

__device__ __forceinline__ void stage_gdn(KParams p, int l, char* smem, int vb0, int nvb) {
    const int vb = bid_() - vb0;
    if (vb < 0 || vb >= nvb) return;
    constexpr int CH = 64, QS = 136, TS = 72, AS = 68;
    h16_t* Qs = (h16_t*)smem;
    h16_t* Ks = Qs + 64 * QS;
    h16_t* Kt = Ks + 64 * QS;
    h16_t* Vt = Kt + 128 * TS;
    float* A32 = (float*)(Vt + 128 * TS);
    h16_t* ob = (h16_t*)A32;
    h16_t* Tu = (h16_t*)(A32 + 64 * AS);
    h16_t* Tw = Tu + 64 * TS;
    h16_t* QKm = Tw + 64 * TS;
    float* gc_s = (float*)(QKm + 64 * TS);
    float* be_s = gc_s + 64;
    float* e1_s = be_s + 64;
    float* part_s = e1_s + 64;
    float* scr = part_s + 512;
    float* cw_s = scr + 512;
    h16_t* ACT = (h16_t*)(p->ws + OFF_ACT);
    int tid = tid_(), lane = tid & 63, w = tid >> 6, g = lane >> 4, r16 = lane & 15;
    int sg = lane >> 4, pc = lane & 15, rb = w;
#define GDN_ROLES() do { tid = tid_(); lane = tid & 63; w = tid >> 6; g = lane >> 4; r16 = lane & 15; sg = g; pc = r16; rb = w; } while (0)
    for (int item = vb; item < B_ * 8; item += nvb) {
        const int b = item / 8, h = item % 8;
        const float a_exp = expf(p->in[I_GALOG][l * 8 + h]), dtb = p->in[I_GDT][l * 8 + h];
        facc S[8];
#pragma unroll
        for (int dt = 0; dt < 8; ++dt) S[dt] = facc_zero();
        __syncthreads();
        for (int i = tid; i < 64 * TS / 2; i += NT) ((unsigned*)QKm)[i] = 0u;
        for (int i = tid; i < 4 * 384; i += NT) { const int jj = i / 384, c3 = i % 384; cw_s[i] = p->in[I_GCW][((size_t)l * 4 + jj) * 3072 + (c3 >> 7) * 1024 + h * 128 + (c3 & 127)]; }
        uint4 pf[11];
#define GDN_LOAD(t0_) do { GDN_ROLES(); const h16_t* colp = ACT + ((size_t)b * T_ + (t0_) + 8 * rb - 3) * LDZ + (sg < 3 ? Z_Q + sg * 1024 : Z_ZG) + h * 128 + pc * 8; \
            _Pragma("unroll") for (int i = 0; i < 11; ++i) { const int t = (t0_) + 8 * rb - 3 + i; pf[i] = (t >= 0 && sg < 3) ? ldg16(colp + (size_t)i * LDZ) : zero16(); } } while (0)
        GDN_LOAD(0);
#pragma unroll 1
        for (int t0 = 0; t0 < T_; t0 += CH) {
            GDN_ROLES();
            if (tid < 64) {
                const size_t m = (size_t)b * T_ + t0 + tid;
                part_s[tid] = -a_exp * softplusf_(h2f(ACT[m * LDZ + Z_ALPHA + h]) + dtb);
                be_s[tid] = sigmoidf_(h2f(ACT[m * LDZ + Z_BETA + h]));
            }
            __syncthreads();
            if (tid < 64) { float s = 0.f; for (int i = 0; i <= tid; ++i) s += part_s[i]; gc_s[tid] = s; }
#pragma unroll
            for (int hf = 0; hf < 2; ++hf) {
                float ov[4][8];
#pragma unroll
                for (int i = 0; i < 4; ++i) {
#pragma unroll
                    for (int cc = 0; cc < 8; ++cc) ov[i][cc] = 0.f;
#pragma unroll
                    for (int jj = 0; jj < 4; ++jj) {
                        const uint4 wv = pf[hf * 4 + i + jj];
                        const float* cwp = cw_s + jj * 384 + (sg < 3 ? sg : 0) * 128 + pc * 8;
                        const float4 c0 = *(const float4*)cwp, c1 = *(const float4*)(cwp + 4);
                        ov[i][0] += c0.x * h2f((h16_t)(wv.x & 0xffffu)); ov[i][1] += c0.y * h2f((h16_t)(wv.x >> 16)); ov[i][2] += c0.z * h2f((h16_t)(wv.y & 0xffffu)); ov[i][3] += c0.w * h2f((h16_t)(wv.y >> 16));
                        ov[i][4] += c1.x * h2f((h16_t)(wv.z & 0xffffu)); ov[i][5] += c1.y * h2f((h16_t)(wv.z >> 16)); ov[i][6] += c1.z * h2f((h16_t)(wv.w & 0xffffu)); ov[i][7] += c1.w * h2f((h16_t)(wv.w >> 16));
                    }
                    float ss = 0.f;
#pragma unroll
                    for (int cc = 0; cc < 8; ++cc) { ov[i][cc] = siluf_(ov[i][cc]); ss += ov[i][cc] * ov[i][cc]; }
                    ss = group_sum(ss, 16, scr);
                    const float rn = sg == 0 ? rsqrtf(ss + RMS_EPS) * 0.08838834764831845f : (sg == 1 ? rsqrtf(ss + RMS_EPS) : 1.0f);
#pragma unroll
                    for (int cc = 0; cc < 8; ++cc) ov[i][cc] *= rn;
                    const int t = 8 * rb + hf * 4 + i;
                    if (sg == 0) store8h(Qs + t * QS + pc * 8, ov[i]);
                    else if (sg == 1) store8h(Ks + t * QS + pc * 8, ov[i]);
                }
                if (sg == 1 || sg == 2) {
                    h16_t* dstT = sg == 1 ? Kt : Vt;
#pragma unroll
                    for (int cc = 0; cc < 8; ++cc) { uint2 w2; w2.x = pack2h(ov[0][cc], ov[1][cc]); w2.y = pack2h(ov[2][cc], ov[3][cc]); *(uint2*)(dstT + (pc * 8 + cc) * TS + 8 * rb + hf * 4) = w2; }
                }
            }
            __syncthreads();
            GDN_ROLES();
            if (tid < 64) e1_s[tid] = expf(gc_s[63] - gc_s[tid]);
            for (int e = tid; e < 64 * 64; e += NT) { const int i = e >> 6, j = e & 63; if ((j >> 4) > (i >> 4)) A32[i * AS + (j & 7) * 8 + (j >> 3)] = 0.f; }
#pragma unroll 1
            for (int jr = 0; jr < 3; ++jr) {
                const int jb = w + 8 * jr; const bool valid = jb < 20;
                const int kind = (valid && jb >= 10) ? 1 : 0, tix = valid ? (jb % 10) : 0;
                const int ti = tix < 1 ? 0 : (tix < 3 ? 1 : (tix < 6 ? 2 : 3)), tj = tix - (ti * (ti + 1)) / 2;
                const h16_t* ap = (kind ? Qs : Ks) + (16 * ti + r16) * QS + 8 * g; const h16_t* bp = Ks + (16 * tj + r16) * QS + 8 * g;
                facc acc = facc_zero();
#pragma unroll
                for (int ks = 0; ks < 4; ++ks) acc = mfma16(frag_u4(*(const uint4*)(ap + 32 * ks)), frag_u4(*(const uint4*)(bp + 32 * ks)), acc);
                if (valid) {
                    const int j = 16 * tj + r16; const float gj = gc_s[j];
#pragma unroll
                    for (int reg = 0; reg < 4; ++reg) {
                        const int i = 16 * ti + 4 * g + reg;
                        const float dec = expf(fminf(gc_s[i] - gj, 0.f));
                        if (kind == 0) A32[i * AS + (j & 7) * 8 + (j >> 3)] = i > j ? be_s[i] * acc[reg] * dec : 0.f;
                        else QKm[i * TS + j] = f2h(i >= j ? acc[reg] * dec : 0.f);
                    }
                }
            }
            __syncthreads();
            GDN_ROLES();
            {
                const int t = tid >> 3, d0 = (tid & 7) * 16; const float eg = expf(gc_s[t]);
                float v8[8];
                load8h(Qs + t * QS + d0, v8);
#pragma unroll
                for (int e = 0; e < 8; ++e) v8[e] *= eg;
                store8h(Qs + t * QS + d0, v8);
                load8h(Qs + t * QS + d0 + 8, v8);
#pragma unroll
                for (int e = 0; e < 8; ++e) v8[e] *= eg;
                store8h(Qs + t * QS + d0 + 8, v8);
            }
            {
                const int c = tid >> 3, q = tid & 7;
                const float bc = be_s[c], bgc = bc * expf(gc_s[c]);
                float x[8];
#pragma unroll
                for (int i = 0; i < 8; ++i) x[i] = 0.f;
#pragma unroll
                for (int r = 0; r < 64; ++r) {
                    float sacc = 0.f;
                    if (r > 0) {
                        const float4 a0 = *(const float4*)(A32 + r * AS + q * 8);
                        sacc = a0.x * x[0];
                        if (r > 8) sacc += a0.y * x[1];
                        if (r > 16) sacc += a0.z * x[2];
                        if (r > 24) sacc += a0.w * x[3];
                        if (r > 32) {
                            const float4 a1 = *(const float4*)(A32 + r * AS + q * 8 + 4);
                            sacc += a1.x * x[4];
                            if (r > 40) sacc += a1.y * x[5];
                            if (r > 48) sacc += a1.z * x[6];
                            if (r > 56) sacc += a1.w * x[7];
                        }
                        sacc = group_sum(sacc, 8, scr);
                    }
                    const float xr = ((r == c) ? 1.f : 0.f) - sacc;
                    if (q == (r & 7)) { x[r >> 3] = xr; Tu[r * TS + c] = f2h(xr * bc); Tw[r * TS + c] = f2h(xr * bgc); }
                }
            }
            __syncthreads();
            GDN_ROLES();
            facc vn[4], aw[4];
#pragma unroll
            for (int tt = 0; tt < 4; ++tt) { vn[tt] = facc_zero(); aw[tt] = facc_zero(); }
#pragma unroll
            for (int tt = 0; tt < 4; ++tt)
#pragma unroll
                for (int ks = 0; ks <= (tt >> 1); ++ks) {
                    const hfrag au = frag_u4(*(const uint4*)(Tu + (16 * tt + r16) * TS + 32 * ks + 8 * g)), aww = frag_u4(*(const uint4*)(Tw + (16 * tt + r16) * TS + 32 * ks + 8 * g));
                    vn[tt] = mfma16(au, frag_u4(*(const uint4*)(Vt + (16 * w + r16) * TS + 32 * ks + 8 * g)), vn[tt]);
                    aw[tt] = mfma16(aww, frag_u4(*(const uint4*)(Kt + (16 * w + r16) * TS + 32 * ks + 8 * g)), aw[tt]);
                }
#pragma unroll
            for (int tt = 0; tt < 4; ++tt)
#pragma unroll
                for (int reg = 0; reg < 4; ++reg) Ks[(16 * tt + 4 * g + reg) * QS + 16 * w + r16] = f2h(-aw[tt][reg]);
            __syncthreads();
            GDN_ROLES();
            h16_t zraw[16];
#pragma unroll
            for (int tt = 0; tt < 4; ++tt)
#pragma unroll
                for (int reg = 0; reg < 4; ++reg) zraw[tt * 4 + reg] = ACT[((size_t)b * T_ + t0 + 16 * tt + 4 * g + reg) * LDZ + Z_ZG + h * 128 + 16 * w + r16];
            hfrag Sb[4];
#pragma unroll
            for (int ks = 0; ks < 4; ++ks) Sb[ks] = frag_acc2(S[2 * ks], S[2 * ks + 1]);
            facc oc[4];
#pragma unroll
            for (int tt = 0; tt < 4; ++tt) {
                oc[tt] = facc_zero();
                const h16_t* wrow = Ks + (16 * tt + r16) * QS; const h16_t* qrow = Qs + (16 * tt + r16) * QS;
#pragma unroll
                for (int ks = 0; ks < 4; ++ks) { vn[tt] = mfma16(permfrag(wrow, ks, g), Sb[ks], vn[tt]); oc[tt] = mfma16(permfrag(qrow, ks, g), Sb[ks], oc[tt]); }
            }
            hfrag VNb[2];
            VNb[0] = frag_acc2(vn[0], vn[1]); VNb[1] = frag_acc2(vn[2], vn[3]);
#pragma unroll
            for (int tt = 0; tt < 4; ++tt)
#pragma unroll
                for (int ks2 = 0; ks2 <= (tt >> 1); ++ks2) oc[tt] = mfma16(permfrag(QKm + (16 * tt + r16) * TS, ks2, g), VNb[ks2], oc[tt]);
            {
                const float egl = expf(gc_s[63]);
                hfrag e1f[2];
#pragma unroll
                for (int ks2 = 0; ks2 < 2; ++ks2) { const float* ep = e1_s + 32 * ks2 + 4 * g; e1f[ks2] = frag_pack8(ep[0], ep[1], ep[2], ep[3], ep[16], ep[17], ep[18], ep[19]); }
#pragma unroll
                for (int dt = 0; dt < 8; ++dt) {
#pragma unroll
                    for (int reg = 0; reg < 4; ++reg) S[dt][reg] *= egl;
#pragma unroll
                    for (int ks2 = 0; ks2 < 2; ++ks2) S[dt] = mfma16(frag_mul(permfrag(Kt + (16 * dt + r16) * TS, ks2, g), e1f[ks2]), VNb[ks2], S[dt]);
                }
            }
            if (t0 + CH < T_) GDN_LOAD(t0 + CH);
            GDN_ROLES();
#pragma unroll
            for (int tt = 0; tt < 4; ++tt)
#pragma unroll
                for (int reg = 0; reg < 4; ++reg) { const float ss = group_sum(oc[tt][reg] * oc[tt][reg], 16, scr); if (r16 == 0) part_s[w * 64 + 16 * tt + 4 * g + reg] = ss; }
            __syncthreads();
            const float nw = p->in[I_GNW][l * 128 + w * 16 + r16];
#pragma unroll
            for (int tt = 0; tt < 4; ++tt)
#pragma unroll
                for (int reg = 0; reg < 4; ++reg) {
                    const int t = 16 * tt + 4 * g + reg;
                    float ms = 0.f;
#pragma unroll
                    for (int ww = 0; ww < 8; ++ww) ms += part_s[ww * 64 + t];
                    ob[t * 128 + 16 * w + r16] = f2h(oc[tt][reg] * rsqrtf(ms * (1.0f / 128.0f) + RMS_EPS) * nw * siluf_(h2f(zraw[tt * 4 + reg])));
                }
            __syncthreads();
            GDN_ROLES();
#pragma unroll
            for (int i = 0; i < 2; ++i) { const int j = tid + NT * i; *(uint4*)(ACT + ((size_t)b * T_ + t0 + (j >> 4)) * LDZ + Z_ZG + h * 128 + (j & 15) * 8) = *(const uint4*)(ob + (j >> 4) * 128 + (j & 15) * 8); }
            __syncthreads();
        }
#undef GDN_LOAD
#undef GDN_ROLES
    }
}

#ifndef CPU_EMU
typedef _Float16 rw_f16x8 __attribute__((ext_vector_type(8)));
typedef float rw_f32x4 __attribute__((ext_vector_type(4)));
#endif
__device__ __forceinline__ void stage_rwkv(KParams p, int l, char* smem, int vb0, int nvb) {
    const int vb = bid_() - vb0;
    if (vb < 0 || vb >= nvb) return;
    constexpr int CH = 32, XS = 264;
    float* r_s = (float*)smem;
    float* k_s = r_s + CH * 64;
    float* v_s = k_s + CH * 64;
    float* w_s = v_s + CH * 64;
    float* kk_s = w_s + CH * 64;
    float* ka_s = kk_s + CH * 64;
    float* g_s = ka_s + CH * 64;
    float* o_s = g_s + CH * 64;
    float* bon_s = o_s + CH * 64;
    float* scr = bon_s + CH;
    h16_t* raw = (h16_t*)(scr + 512);
    h16_t* xs = raw + (CH + 1) * 448;
    h16_t* ACT = (h16_t*)(p->ws + OFF_ACT);
    const int tid = tid_(), c = tid & 63, tg = tid >> 6;
    const int ri = tid >> 3, q8 = tid & 7;
    for (int item = vb; item < B_ * 16; item += nvb) {
        const int b = item / 16, h = item % 16, ch = h * 64 + c;
        const float w0 = p->in[I_RW0][l * 1024 + ch], a0 = p->in[I_RA0][l * 1024 + ch], k_k = p->in[I_RKK][l * 1024 + ch], k_a = p->in[I_RKA][l * 1024 + ch];
        const float rk_c = p->in[I_RRK][(size_t)l * 1024 + ch];
        const float lnw = p->in[I_RLW][l * 1024 + ch], lnb = p->in[I_RLB][l * 1024 + ch];
        const float* mu = p->in[I_RMU] + (size_t)l * RWW;
        const float mu_r = mu[RW_R + ch], mu_k = mu[RW_K + ch], mu_v = mu[RW_V + ch];
        const float mu_wl = mu[RW_WL + c], mu_al = mu[RW_AL + c], mu_g0 = mu[RW_GL + c], mu_g1 = mu[RW_GL + 64 + c];
        const float* wup = p->in[I_RWUP] + (size_t)l * 64 * 1024 + h * 64; const float* aup = p->in[I_RAUP] + (size_t)l * 64 * 1024 + h * 64; const float* gup = p->in[I_RGUP] + (size_t)l * 128 * 1024 + h * 64;
#ifndef CPU_EMU
        const int wid = tid >> 6, lane = tid & 63, mt = wid >> 2, nt = wid & 3;
        rw_f16x8 bw[2], ba_[2], bg[4];
        {
            const int cn = nt * 16 + (lane & 15), kb = 8 * (lane >> 4);
#pragma unroll
            for (int ks = 0; ks < 2; ++ks)
#pragma unroll
                for (int j = 0; j < 8; ++j) { bw[ks][j] = (_Float16)wup[(size_t)(ks * 32 + kb + j) * 1024 + cn]; ba_[ks][j] = (_Float16)aup[(size_t)(ks * 32 + kb + j) * 1024 + cn]; }
#pragma unroll
            for (int ks = 0; ks < 4; ++ks)
#pragma unroll
                for (int j = 0; j < 8; ++j) bg[ks][j] = (_Float16)gup[(size_t)(ks * 32 + kb + j) * 1024 + cn];
        }
#endif
        float S[8];
#pragma unroll
        for (int e = 0; e < 8; ++e) S[e] = 0.f;
        uint4 pf[4];
#define RW_LOAD(t0_) do { _Pragma("unroll") for (int i = 0; i < 4; ++i) { const int j = tid + NT * i, row = j / 56, u = j % 56, t = (t0_) - 1 + row; pf[i] = zero16(); \
            if (j < (CH + 1) * 56 && t >= 0) pf[i] = ldg16(ACT + ((size_t)b * T_ + t) * LDZ + Z_RW + (u < 24 ? (u >> 3) * 1024 + h * 64 + (u & 7) * 8 : 3072 + (u - 24) * 8)); } } while (0)
#define RW_PUT() do { _Pragma("unroll") for (int i = 0; i < 4; ++i) { const int j = tid + NT * i; if (j < (CH + 1) * 56) *(uint4*)(raw + (j / 56) * 448 + (j % 56) * 8) = pf[i]; } } while (0)
        __syncthreads();
        RW_LOAD(0);
        RW_PUT();
        __syncthreads();
#pragma unroll 1
        for (int t0 = 0; t0 < T_; t0 += CH) {
#pragma unroll
            for (int s = 0; s < 4; ++s) {
                const int tl = tg * 4 + s;
                const h16_t* zc = raw + (tl + 1) * 448; const h16_t* zp = raw + tl * 448;
#define RW_SHIFT(col, muv) ({ const float zz = h2f(zc[col]); zz + (muv) * (h2f(zp[col]) - zz); })
                r_s[tl * 64 + c] = RW_SHIFT(c, mu_r);
                k_s[tl * 64 + c] = RW_SHIFT(64 + c, mu_k);
                v_s[tl * 64 + c] = RW_SHIFT(128 + c, mu_v);
                xs[tl * XS + c] = f2h(tanhf(RW_SHIFT(192 + c, mu_wl)));
                xs[tl * XS + 64 + c] = f2h(RW_SHIFT(256 + c, mu_al));
                xs[tl * XS + 128 + c] = f2h(sigmoidf_(RW_SHIFT(320 + c, mu_g0)));
                xs[tl * XS + 192 + c] = f2h(sigmoidf_(RW_SHIFT(384 + c, mu_g1)));
#undef RW_SHIFT
            }
            __syncthreads();
            if (t0 + CH < T_) RW_LOAD(t0 + CH);
#ifdef CPU_EMU
#pragma unroll
            for (int s = 0; s < 4; ++s) {
                const int tl = tg * 4 + s;
                float dw = 0.f, da = 0.f, dg = 0.f;
                for (int i = 0; i < 64; ++i) { dw += h2f(xs[tl * XS + i]) * h2f(f2h(wup[(size_t)i * 1024 + c])); da += h2f(xs[tl * XS + 64 + i]) * h2f(f2h(aup[(size_t)i * 1024 + c])); }
                for (int i = 0; i < 128; ++i) dg += h2f(xs[tl * XS + 128 + i]) * h2f(f2h(gup[(size_t)i * 1024 + c]));
                w_s[tl * 64 + c] = dw; ka_s[tl * 64 + c] = da; g_s[tl * 64 + c] = dg;
            }
#else
            {
                const h16_t* ap = xs + (mt * 16 + (lane & 15)) * XS + 8 * (lane >> 4);
                rw_f32x4 dw = {0.f, 0.f, 0.f, 0.f}, da = {0.f, 0.f, 0.f, 0.f}, dg = {0.f, 0.f, 0.f, 0.f};
#pragma unroll
                for (int ks = 0; ks < 2; ++ks) {
                    dw = __builtin_amdgcn_mfma_f32_16x16x32_f16(*(const rw_f16x8*)(ap + ks * 32), bw[ks], dw, 0, 0, 0);
                    da = __builtin_amdgcn_mfma_f32_16x16x32_f16(*(const rw_f16x8*)(ap + 64 + ks * 32), ba_[ks], da, 0, 0, 0);
                }
#pragma unroll
                for (int ks = 0; ks < 4; ++ks) dg = __builtin_amdgcn_mfma_f32_16x16x32_f16(*(const rw_f16x8*)(ap + 128 + ks * 32), bg[ks], dg, 0, 0, 0);
#pragma unroll
                for (int rg = 0; rg < 4; ++rg) { const int o = (mt * 16 + 4 * (lane >> 4) + rg) * 64 + nt * 16 + (lane & 15); w_s[o] = dw[rg]; ka_s[o] = da[rg]; g_s[o] = dg[rg]; }
            }
#endif
            __syncthreads();
#pragma unroll
            for (int s = 0; s < 4; ++s) {
                const int tl = tg * 4 + s;
                const float w_log = -softplusf_(-(w0 + w_s[tl * 64 + c])) - 0.5f;
                const float decay = expf(-expf(w_log));
                const float a = sigmoidf_(a0 + ka_s[tl * 64 + c]);
                const float kx = k_s[tl * 64 + c], rx = r_s[tl * 64 + c];
                const float kkr = kx * k_k, k2 = kx * (1.0f + (a - 1.0f) * k_a);
                const float nsq = group_sum(kkr * kkr, 64, scr);
                const float bon = group_sum(rx * k2 * rk_c, 64, scr);
                const float kkn = kkr * rsqrtf(nsq + RMS_EPS);
                w_s[tl * 64 + c] = decay; k_s[tl * 64 + c] = k2; kk_s[tl * 64 + c] = kkn; ka_s[tl * 64 + c] = kkn * a;
                if (c == 0) bon_s[tl] = bon;
            }
            __syncthreads();
#pragma unroll 1
            for (int t = 0; t < CH; ++t) {
                const int o8 = t * 64 + q8 * 8;
                const float4 kk0 = *(const float4*)(kk_s + o8), kk1 = *(const float4*)(kk_s + o8 + 4);
                const float pk = (S[0] * kk0.x + S[1] * kk0.y) + (S[2] * kk0.z + S[3] * kk0.w) + ((S[4] * kk1.x + S[5] * kk1.y) + (S[6] * kk1.z + S[7] * kk1.w));
                const float skk = group_sum(pk, 8, scr);
                const float vi = v_s[t * 64 + ri];
                const float4 w0v = *(const float4*)(w_s + o8), w1v = *(const float4*)(w_s + o8 + 4);
                const float4 a0v = *(const float4*)(ka_s + o8), a1v = *(const float4*)(ka_s + o8 + 4);
                const float4 k0v = *(const float4*)(k_s + o8), k1v = *(const float4*)(k_s + o8 + 4);
                const float4 r0v = *(const float4*)(r_s + o8), r1v = *(const float4*)(r_s + o8 + 4);
                S[0] = S[0] * w0v.x - skk * a0v.x + vi * k0v.x; S[1] = S[1] * w0v.y - skk * a0v.y + vi * k0v.y; S[2] = S[2] * w0v.z - skk * a0v.z + vi * k0v.z; S[3] = S[3] * w0v.w - skk * a0v.w + vi * k0v.w;
                S[4] = S[4] * w1v.x - skk * a1v.x + vi * k1v.x; S[5] = S[5] * w1v.y - skk * a1v.y + vi * k1v.y; S[6] = S[6] * w1v.z - skk * a1v.z + vi * k1v.z; S[7] = S[7] * w1v.w - skk * a1v.w + vi * k1v.w;
                const float po = (S[0] * r0v.x + S[1] * r0v.y) + (S[2] * r0v.z + S[3] * r0v.w) + ((S[4] * r1v.x + S[5] * r1v.y) + (S[6] * r1v.z + S[7] * r1v.w));
                const float o = group_sum(po, 8, scr);
                if (q8 == 0) o_s[t * 64 + ri] = o;
            }
            __syncthreads();
#pragma unroll
            for (int s = 0; s < 4; ++s) {
                const int tl = tg * 4 + s;
                const float ov = o_s[tl * 64 + c];
                const float mean = group_sum(ov, 64, scr) * (1.0f / 64.0f);
                const float d = ov - mean;
                const float var = group_sum(d * d, 64, scr) * (1.0f / 64.0f);
                const float y = (d * rsqrtf(var + GN_EPS) * lnw + lnb + bon_s[tl] * v_s[tl * 64 + c]) * g_s[tl * 64 + c];
                ACT[((size_t)b * T_ + t0 + tl) * LDZ + C_YC + ch] = f2h(y);
            }
            __syncthreads();
            if (t0 + CH < T_) RW_PUT();
            __syncthreads();
        }
#undef RW_LOAD
#undef RW_PUT
    }
}

constexpr bool TAB_IN_ACT = (M_ == 16384);
__device__ __forceinline__ h16_t* tab_row(char* ws, int which, int e) {
    if (TAB_IN_ACT) return (h16_t*)(ws + OFF_ACT) + (size_t)e * LDZ + (which ? C_MG : C_GS);
    return (h16_t*)(ws + OFF_TAB) + ((size_t)which * 16384 + e) * 1024;
}
__device__ __forceinline__ void stage_tabconv(KParams p, int l) {
    const int tid = tid_();
    const float* U = p->in[I_PU] + (size_t)l * 16384 * 1024; const float* V = p->in[I_PV] + (size_t)l * 16384 * 1024;
    char* ws = p->ws;
    for (int it = bid_() * NT + tid; it < 2 * 16384 * 128; it += gridDim.x * NT) {
        const int which = it >= 16384 * 128, r = (it >> 7) & 16383, ck = it & 127;
        const float* src = (which ? V : U) + (size_t)r * 1024 + ck * 8;
        const float4 a = *(const float4*)src, b = *(const float4*)(src + 4);
        const float v[8] = {a.x, a.y, a.z, a.w, b.x, b.y, b.z, b.w};
        store8h(tab_row(ws, which, r) + ck * 8, v);
    }
}

__device__ __forceinline__ void stage_peer_topk(KParams p, int l, char* smem) {
    float* key_s = (float*)smem;
    const h16_t* ACT = (const h16_t*)(p->ws + OFF_ACT);
    float* TOPS = (float*)(p->ws + OFF_TOPS);
    const int tid = tid_();
    const int nb = gridDim.x;
    for (int hs = bid_() % 16; hs < 16; hs += nb) {
        const int hd = hs >> 1, s = hs & 1;
        __syncthreads();
        {
            const float* kp = p->in[I_PKEYS] + (((size_t)l * 8 + hd) * 2 + s) * 128 * 128;
            for (int i = tid * 4; i < 128 * 128; i += NT * 4) *(float4*)(key_s + i) = *(const float4*)(kp + i);
        }
        __syncthreads();
        const int nblk = nb >= 16 ? nb / 16 : 1, bsub = nb >= 16 ? bid_() / 16 : 0;
        for (int chunk = bsub; chunk < (M_ + NT - 1) / NT; chunk += nblk) {
            if (nb >= 16 && bid_() >= nblk * 16) break;
            const int m = chunk * NT + tid;
            if (m >= M_) continue;
            float q[128];
            {
                const h16_t* qp = ACT + (size_t)m * LDZ + C_QRY + hd * 256 + s * 128;
#pragma unroll
                for (int c8 = 0; c8 < 16; ++c8) { float t8[8]; load8h(qp + c8 * 8, t8);
#pragma unroll
                    for (int j = 0; j < 8; ++j) q[c8 * 8 + j] = t8[j]; }
            }
            float top[16];
#pragma unroll
            for (int i = 0; i < 16; ++i) top[i] = -3.0e38f;
#pragma unroll 2
            for (int n = 0; n < 128; ++n) {
                const float* kr = key_s + n * 128;
                float a0 = 0.f, a1 = 0.f, a2 = 0.f, a3 = 0.f;
#pragma unroll
                for (int c4 = 0; c4 < 32; ++c4) {
                    const float4 kv = *(const float4*)(kr + c4 * 4);
                    a0 += q[c4 * 4] * kv.x; a1 += q[c4 * 4 + 1] * kv.y; a2 += q[c4 * 4 + 2] * kv.z; a3 += q[c4 * 4 + 3] * kv.w;
                }
                float x = __uint_as_float((__float_as_uint((a0 + a1) + (a2 + a3)) & ~127u) | (unsigned)(127 - n));
#pragma unroll
                for (int i = 0; i < 16; ++i) { const float hi = fmaxf(top[i], x); x = fminf(top[i], x); top[i] = hi; }
            }
            float* tp = TOPS + (((size_t)m * 8 + hd) * 2 + s) * 16;
#pragma unroll
            for (int i = 0; i < 16; i += 4) *(float4*)(tp + i) = make_float4(top[i], top[i + 1], top[i + 2], top[i + 3]);
        }
    }
}

__device__ __forceinline__ void peer_cand(int k, int& i, int& j) {
    if (k < 16) { i = 0; j = k; } else if (k < 24) { i = 1; j = k - 16; } else if (k < 29) { i = 2; j = k - 24; } else if (k < 33) { i = 3; j = k - 29; }
    else if (k < 36) { i = 4; j = k - 33; } else if (k < 38) { i = 5; j = k - 36; } else if (k < 40) { i = 6; j = k - 38; } else if (k < 42) { i = 7; j = k - 40; }
    else { i = k - 34; j = 0; }
}
__device__ __forceinline__ float dot8h(const uint4 a, const float (&x)[8]) {
    float s = 0.f;
    s += h2f((h16_t)(a.x & 0xffffu)) * x[0]; s += h2f((h16_t)(a.x >> 16)) * x[1]; s += h2f((h16_t)(a.y & 0xffffu)) * x[2]; s += h2f((h16_t)(a.y >> 16)) * x[3];
    s += h2f((h16_t)(a.z & 0xffffu)) * x[4]; s += h2f((h16_t)(a.z >> 16)) * x[5]; s += h2f((h16_t)(a.w & 0xffffu)) * x[6]; s += h2f((h16_t)(a.w >> 16)) * x[7];
    return s;
}
__device__ __forceinline__ void axpy8h(const uint4 a, float s, float (&y)[8]) {
    y[0] += s * h2f((h16_t)(a.x & 0xffffu)); y[1] += s * h2f((h16_t)(a.x >> 16)); y[2] += s * h2f((h16_t)(a.y & 0xffffu)); y[3] += s * h2f((h16_t)(a.y >> 16));
    y[4] += s * h2f((h16_t)(a.z & 0xffffu)); y[5] += s * h2f((h16_t)(a.z >> 16)); y[6] += s * h2f((h16_t)(a.w & 0xffffu)); y[7] += s * h2f((h16_t)(a.w >> 16));
}
__device__ __forceinline__ void stage_peer_gather(KParams p, int l, char* smem) {
    float* tops_s = (float*)smem;
    float* cand_s = tops_s + 256;
    float* best_s = cand_s + 512;
    int* idx_s = (int*)(best_s + 128);
    float* gate_s = (float*)(idx_s + 128);
    float* part_s = gate_s + 128;
    float* ysum_s = part_s + 8 * 16 * 64;
    const h16_t* ACT = (const h16_t*)(p->ws + OFF_ACT);
    const float* TOPS = (const float*)(p->ws + OFF_TOPS);
    char* ws = p->ws;
    const int tid = tid_(), w = tid >> 6, lane = tid & 63;
    for (int m = bid_(); m < M_; m += gridDim.x) {
        __syncthreads();
        if (tid < 256) tops_s[tid] = TOPS[(size_t)m * 256 + tid];
        __syncthreads();
        int ci = 0, cj = 0; float cs = -3.0e38f;
        if (lane < 50) { peer_cand(lane, ci, cj); cs = tops_s[w * 32 + ci] + tops_s[w * 32 + 16 + cj]; }
        cand_s[w * 64 + lane] = cs;
        __syncthreads();
        if (lane < 50) {
            int cnt = 0; const int pos = ci * 16 + cj;
            for (int o = 0; o < 50; ++o) { int oi, oj; peer_cand(o, oi, oj); const float ov = cand_s[w * 64 + o]; cnt += (ov > cs || (ov == cs && oi * 16 + oj < pos)) ? 1 : 0; }
            if (cnt < 16) {
                best_s[w * 16 + cnt] = cs;
                const int n0 = 127 - (int)(__float_as_uint(tops_s[w * 32 + ci]) & 127u), n1 = 127 - (int)(__float_as_uint(tops_s[w * 32 + 16 + cj]) & 127u);
                idx_s[w * 16 + cnt] = n0 * 128 + n1;
            }
        }
        __syncthreads();
        if (tid < 128) {
            const int hd = tid >> 4;
            const float mx = best_s[hd * 16];
            float sum = 0.f;
            for (int i = 0; i < 16; ++i) sum += expf(best_s[hd * 16 + i] - mx);
            gate_s[tid] = expf(best_s[tid] - mx) / sum;
        }
        float x0[8], x1[8];
        load8h(ACT + (size_t)m * LDZ + C_XN + lane * 8, x0); load8h(ACT + (size_t)m * LDZ + C_XN + 512 + lane * 8, x1);
        __syncthreads();
        float* pw = part_s + w * 1024;
#pragma unroll 4
        for (int k = 0; k < 16; ++k) {
            const h16_t* ur = tab_row(ws, 0, idx_s[w * 16 + k]);
            const uint4 u0 = *(const uint4*)(ur + lane * 8), u1 = *(const uint4*)(ur + 512 + lane * 8);
            pw[k * 64 + lane] = dot8h(u0, x0) + dot8h(u1, x1);
        }
        __syncthreads();
        float hid;
        {
            const int k = lane >> 2, qq = lane & 3;
            float s = 0.f;
#pragma unroll
            for (int i = 0; i < 16; ++i) s += pw[k * 64 + qq * 16 + i];
            pw[k * 64 + qq * 16] = s;
        }
        __syncthreads();
        float y0[8], y1[8];
#pragma unroll
        for (int i = 0; i < 8; ++i) { y0[i] = 0.f; y1[i] = 0.f; }
#pragma unroll 4
        for (int k = 0; k < 16; ++k) {
            const float dotv = pw[k * 64] + pw[k * 64 + 16] + pw[k * 64 + 32] + pw[k * 64 + 48];
            hid = gate_s[w * 16 + k] * geluf_(dotv);
            const h16_t* vr = tab_row(ws, 1, idx_s[w * 16 + k]);
            const uint4 v0 = *(const uint4*)(vr + lane * 8), v1 = *(const uint4*)(vr + 512 + lane * 8);
            axpy8h(v0, hid, y0); axpy8h(v1, hid, y1);
        }
        {
            float* yw = ysum_s + w * 1024;
#pragma unroll
            for (int i = 0; i < 8; ++i) { yw[lane * 8 + i] = y0[i]; yw[512 + lane * 8 + i] = y1[i]; }
        }
        __syncthreads();
        {
            float a0 = 0.f, a1 = 0.f;
#pragma unroll
            for (int ww = 0; ww < 8; ++ww) { a0 += ysum_s[ww * 1024 + tid * 2]; a1 += ysum_s[ww * 1024 + tid * 2 + 1]; }
            float2* op = (float2*)(p->out + (size_t)m * 1024 + tid * 2);
            float2 ov = *op;
            ov.x += a0; ov.y += a1;
            *op = ov;
        }
    }
}

enum { PH_NORM_MIX = 0, PH_INPROJ, PH_MIXERS, PH_MERGE, PH_WOUT, PH_NORM_FFN, PH_QUERY, PH_TOPK, PH_GATHER, PH_PER_LAYER, PH_FINAL = 100, PH_WPREP = 101 };
__device__ __forceinline__ void run_phase(KParams p, int l, int ph, char* smem) {
    h16_t* ACT = (h16_t*)(p->ws + OFF_ACT);
    const float* hin = l == 0 ? p->in[I_X] : p->out;
    switch (ph) {
    case PH_WPREP: stage_wprep(p, smem); break;
    case PH_NORM_MIX: stage_rmsnorm<false>(hin, p->in[I_NMIX] + l * 1024, ACT + C_XN, LDZ, smem); break;
    case PH_INPROJ: stage_gemm(p, l, GP_INPROJ, smem); break;
    case PH_MIXERS: {
        const int nb = gridDim.x, n_rw = nb / 2, n_gd = nb / 4, n_lr = nb - n_rw - n_gd;
        stage_rwkv(p, l, smem, 0, n_rw);
        stage_gdn(p, l, smem, n_rw, n_gd);
        stage_lru(p, l, smem, n_rw + n_gd, n_lr);
    } break;
    case PH_MERGE: stage_gemm(p, l, GP_MERGE, smem); break;
    case PH_WOUT: stage_gemm(p, l, GP_WOUT, smem); break;
    case PH_NORM_FFN: stage_rmsnorm<false>(p->out, p->in[I_NFFN] + l * 1024, ACT + C_XN, LDZ, smem); stage_tabconv(p, l); break;
    case PH_QUERY: stage_gemm(p, l, GP_QUERY, smem); break;
    case PH_TOPK: stage_peer_topk(p, l, smem); break;
    case PH_GATHER: stage_peer_gather(p, l, smem); break;
    case PH_FINAL: stage_rmsnorm<true>(p->out, p->in[I_NFINAL], p->out, 1024, smem); break;
    default: break;
    }
}

#if !defined(CPU_EMU) && !MK_MULTI
__global__ void __launch_bounds__(512, 2) k_mega(Params p_) {
    DYN_SMEM(smem);
    KParams pk = (KParams)__builtin_amdgcn_kernarg_segment_ptr();
    cg::grid_group grid = cg::this_grid();
    constexpr int NIT = NL_ * PH_PER_LAYER;
#pragma unroll 1
    for (int it = -1; it <= NIT; ++it) {
        const int l = (it >= 0 && it < NIT) ? it / PH_PER_LAYER : 0, ph = it < 0 ? (int)PH_WPREP : (it < NIT ? it % PH_PER_LAYER : (int)PH_FINAL);
        KParams q = pk; asm volatile("" : "+s"(q));
        run_phase(q, l, ph, smem);
        if (it < NIT && !(it < 0)) grid.sync();
    }
}
#endif
#ifdef CPU_EMU
__global__ void k_phase(Params p_, int l, int ph) { DYN_SMEM(smem); run_phase(&p_, l, ph, smem); }
#elif MK_MULTI
__global__ void __launch_bounds__(512, 2) k_phase(Params p_, int l, int ph) { DYN_SMEM(smem); KParams pk = (KParams)__builtin_amdgcn_kernarg_segment_ptr(); run_phase(pk, l, ph, smem); }
#endif
}

#ifdef CPU_EMU
int g_emu_stop = 1000;
#endif

extern "C" void kernel_launch(void* const* d_in, const int* in_sizes, int n_in, void* d_out, int out_size, void* d_ws, size_t ws_size, hipStream_t stream) {
    Params p{};
    for (int i = 0; i < N_IN; ++i) p.in[i] = (const float*)d_in[i];
    p.out = (float*)d_out; p.ws = (char*)d_ws;
#if defined(CPU_EMU) || MK_MULTI
    const int grid = 256;
    LAUNCH(k_phase, grid, NT, SMEM_BYTES, stream, p, 0, (int)PH_WPREP);
    for (int l = 0; l < NL_; ++l)
        for (int ph = 0; ph < PH_PER_LAYER; ++ph) {
            LAUNCH(k_phase, grid, NT, SMEM_BYTES, stream, p, l, ph);
#ifdef CPU_EMU
            const int code = ph == PH_INPROJ ? 1 : ph == PH_MIXERS ? 2 : ph == PH_MERGE ? 3 : ph == PH_WOUT ? 4 : ph == PH_GATHER ? 5 : 0;
            if (code && g_emu_stop == l * 10 + code) return;
#endif
        }
    LAUNCH(k_phase, grid, NT, SMEM_BYTES, stream, p, 0, (int)PH_FINAL);
#else
    static int grid_blocks = 0;
    if (!grid_blocks) {
        int dev = 0, cus = 0, per_cu = 0;
        (void)hipGetDevice(&dev);
        (void)hipDeviceGetAttribute(&cus, hipDeviceAttributeMultiprocessorCount, dev);
        (void)hipFuncSetAttribute((const void*)k_mega, hipFuncAttributeMaxDynamicSharedMemorySize, (int)SMEM_BYTES);
        (void)hipOccupancyMaxActiveBlocksPerMultiprocessor(&per_cu, k_mega, NT, SMEM_BYTES);
        if (per_cu > 1) per_cu = 1;
        grid_blocks = cus * per_cu;
    }
    void* args[] = {&p};
    hipError_t e = hipLaunchCooperativeKernel((void*)k_mega, dim3(grid_blocks), dim3(NT), args, SMEM_BYTES, stream);
    if (e != hipSuccess) fprintf(stderr, "cooperative launch failed: %s (grid %d)\n", hipGetErrorString(e), grid_blocks);
#endif
}
```

```cpp
#ifndef CPU_EMU
#include <hip/hip_runtime.h>
#include <hip/hip_cooperative_groups.h>
#include <cstdio>
#include <cstdint>
namespace cg = cooperative_groups;
#define DYN_SMEM(name) extern __shared__ __attribute__((aligned(16))) char name[]
#define LAUNCH(kern, grid, block, smem, stream, ...) hipLaunchKernelGGL(kern, dim3(grid), dim3(block), smem, stream, __VA_ARGS__)
#endif

#ifndef CFG_B
#define CFG_B 8
#endif
#ifndef CFG_T
#define CFG_T 2048
#endif
#ifndef MK_MULTI
#define MK_MULTI 0
#endif

namespace {
constexpr int B_ = CFG_B, T_ = CFG_T, M_ = B_ * T_, D_ = 1024, NL_ = 2, NT = 512;
constexpr int INW = 12560;
constexpr int LDZ = 11776;
constexpr int Z_ULRU = 0, Z_GLRU = 1024, Z_Q = 2048, Z_K = 3072, Z_V = 4096, Z_ZG = 5120, Z_RW = 6144, Z_ALPHA = 9472, Z_BETA = 9480;
constexpr int ZN = 9728;
constexpr int C_XN = 9728, C_YC = 10752;
constexpr int C_YA = Z_GLRU, C_YB = Z_ZG;
constexpr int C_GS = Z_Q, C_MG = Z_K;
constexpr int C_QRY = 0;
constexpr int RW_R = 0, RW_K = 1024, RW_V = 2048, RW_WL = 3072, RW_AL = 3136, RW_GL = 3200, RWW = 3328;
constexpr float RMS_EPS = 1e-6f, GN_EPS = 64e-5f;
typedef unsigned short h16_t;

enum { I_X = 0, I_NMIX, I_NFFN, I_NFINAL, I_WIN, I_LCW, I_LCB, I_LWA, I_LBA, I_LWX, I_LBX, I_LLAM, I_GCW, I_GALOG, I_GDT, I_GNW,
       I_RMU, I_RW0, I_RWUP, I_RA0, I_RAUP, I_RGUP, I_RKK, I_RKA, I_RRK, I_RLW, I_RLB, I_MB, I_PL, I_PG, I_PR, I_WOUT, I_PWQ, I_PKEYS, I_PU, I_PV, N_IN };

struct Params {
    const float* in[N_IN];
    float* out;
    char* ws;
};
#ifdef CPU_EMU
typedef const Params* KParams;
#else
typedef const Params __attribute__((address_space(4)))* KParams;
#endif

constexpr size_t al256(size_t x) { return (x + 255) / 256 * 256; }
constexpr size_t OFF_ACT = 0;
constexpr size_t OFF_WT = al256(OFF_ACT + (size_t)M_ * LDZ * 2);
constexpr int WT_IN = 0, WT_MG = ZN, WT_P = WT_MG + 3072, WT_OUT = WT_P + 3072, WT_Q = WT_OUT + 1024, WT_ROWS = WT_Q + 2048;
constexpr size_t OFF_TOPS = al256(OFF_WT + (size_t)NL_ * WT_ROWS * 1024 * 2);
constexpr size_t OFF_TAB = al256(OFF_TOPS + (size_t)M_ * 256 * 4);
constexpr size_t WS_END = OFF_TAB + (M_ == 16384 ? 0 : (size_t)16384 * 2048);
static_assert(CFG_B != 8 || CFG_T != 2048 || WS_END <= (size_t)512 * 1024 * 1024, "workspace budget");
constexpr size_t SMEM_BYTES = 128 * 1024;

#ifdef CPU_EMU
__device__ __forceinline__ int tid_() { return threadIdx.x; }
__device__ __forceinline__ h16_t f2h(float f) { return (h16_t)_cvtss_sh(f, _MM_FROUND_TO_NEAREST_INT); }
__device__ __forceinline__ float h2f(h16_t h) { return _cvtsh_ss(h); }
#else
__device__ __forceinline__ int tid_() { int t = threadIdx.x; asm volatile("" : "+v"(t)); return t; }
__device__ __forceinline__ h16_t f2h(float f) { return __builtin_bit_cast(unsigned short, (_Float16)f); }
__device__ __forceinline__ float h2f(h16_t h) { return (float)__builtin_bit_cast(_Float16, h); }
#endif
__device__ __forceinline__ int bid_() { return (int)blockIdx.x; }

__device__ __forceinline__ float sigmoidf_(float x) { return 1.0f / (1.0f + expf(-x)); }
__device__ __forceinline__ float softplusf_(float x) { return fmaxf(x, 0.0f) + log1pf(expf(-fabsf(x))); }
__device__ __forceinline__ float siluf_(float x) { return x * sigmoidf_(x); }
__device__ __forceinline__ float geluf_(float x) { return 0.5f * x * (1.0f + tanhf(0.7978845608028654f * (x + 0.044715f * x * x * x))); }
__device__ __forceinline__ unsigned pack2h(float a, float b) { return (unsigned)f2h(a) | ((unsigned)f2h(b) << 16); }
__device__ __forceinline__ void store8h(h16_t* p, const float (&v)[8]) {
    uint4 w; w.x = pack2h(v[0], v[1]); w.y = pack2h(v[2], v[3]); w.z = pack2h(v[4], v[5]); w.w = pack2h(v[6], v[7]);
    *(uint4*)p = w;
}
__device__ __forceinline__ void load8h(const h16_t* p, float (&v)[8]) {
    const uint4 w = *(const uint4*)p;
    v[0] = h2f((h16_t)(w.x & 0xffffu)); v[1] = h2f((h16_t)(w.x >> 16)); v[2] = h2f((h16_t)(w.y & 0xffffu)); v[3] = h2f((h16_t)(w.y >> 16));
    v[4] = h2f((h16_t)(w.z & 0xffffu)); v[5] = h2f((h16_t)(w.z >> 16)); v[6] = h2f((h16_t)(w.w & 0xffffu)); v[7] = h2f((h16_t)(w.w >> 16));
}

__device__ __forceinline__ float block_sum512(float v, float* red) {
    const int tid = tid_();
    red[tid] = v;
    __syncthreads();
    if (tid < 32) { float s = 0.f; for (int i = 0; i < 16; ++i) s += red[tid * 16 + i]; red[512 + tid] = s; }
    __syncthreads();
    float tot = 0.f;
    for (int i = 0; i < 32; ++i) tot += red[512 + i];
    __syncthreads();
    return tot;
}

template <bool OUT_F32>
__device__ __forceinline__ void stage_rmsnorm(const float* src, const float* w, void* dst, int ldd, char* smem) {
    float* red = (float*)smem;
    const int tid = tid_();
    for (int row = bid_(); row < M_; row += gridDim.x) {
        const float2 v = *(const float2*)(src + (size_t)row * D_ + tid * 2);
        const float ss = block_sum512(v.x * v.x + v.y * v.y, red);
        const float rstd = rsqrtf(ss * (1.0f / D_) + RMS_EPS);
        const float2 wv = *(const float2*)(w + tid * 2);
        const float o0 = v.x * rstd * wv.x, o1 = v.y * rstd * wv.y;
        if (OUT_F32) {
            float2 o; o.x = o0; o.y = o1;
            *(float2*)((float*)dst + (size_t)row * ldd + tid * 2) = o;
        } else {
            *(unsigned*)((h16_t*)dst + (size_t)row * ldd + tid * 2) = pack2h(o0, o1);
        }
    }
}

__device__ __forceinline__ const float* wt_src(KParams p, int l, int r, int& ld) {
    if (r < ZN) {
        ld = INW;
        int c;
        if (r < 6144) c = r; else if (r < 9472) c = r + 16; else if (r < 9488) c = r - 3328; else return nullptr;
        return p->in[I_WIN] + (size_t)l * 1024 * INW + c;
    }
    r -= ZN;
    if (r < 3072) { ld = INW; return p->in[I_WIN] + (size_t)l * 1024 * INW + 9488 + r; }
    r -= 3072;
    if (r < 3072) { ld = 1024; const int br = r >> 10; return p->in[br == 0 ? I_PL : (br == 1 ? I_PG : I_PR)] + (size_t)l * 1024 * 1024 + (r & 1023); }
    r -= 3072;
    if (r < 1024) { ld = 1024; return p->in[I_WOUT] + (size_t)l * 1024 * 1024 + r; }
    r -= 1024;
    ld = 2048; return p->in[I_PWQ] + (size_t)l * 1024 * 2048 + r;
}
__device__ __forceinline__ void stage_wprep(KParams p, char* smem) {
    float* tile = (float*)smem;
    h16_t* WT = (h16_t*)(p->ws + OFF_WT);
    const int tid = tid_();
    const int ntr = WT_ROWS / 64, total = NL_ * ntr * 16;
    for (int it = bid_(); it < total; it += gridDim.x) {
        const int l = it / (ntr * 16), rem = it % (ntr * 16), rt = rem / 16, kt = rem % 16;
        const int r0 = rt * 64, k0 = kt * 64;
        __syncthreads();
        {
            const int nn = tid & 63;
            int ld = 0; const float* src = wt_src(p, l, r0 + nn, ld);
#pragma unroll
            for (int i = 0; i < 8; ++i) { const int kk = (tid >> 6) + 8 * i; tile[kk * 65 + nn] = src ? src[(size_t)(k0 + kk) * ld] : 0.f; }
        }
        __syncthreads();
        {
            const int r = tid >> 3, kq = (tid & 7) * 8;
            float v[8];
#pragma unroll
            for (int j = 0; j < 8; ++j) v[j] = tile[(kq + j) * 65 + r];
            store8h(WT + ((size_t)l * WT_ROWS + r0 + r) * 1024 + k0 + kq, v);
        }
    }
}

namespace pg8 {
constexpr int BM = 256, BK = 64, HALF = 128, HTB = HALF * BK * 2, STAGE_BYTES = 8 * HTB, NXCD = 8, WGM = 8;
struct Unit { const char* A; const char* B; int pm, pn, kind; };
#ifdef CPU_EMU
struct f32x4 { float d[4]; float& operator[](int i) { return d[i]; } const float& operator[](int i) const { return d[i]; } };
#else
#define PG8_LAS __attribute__((address_space(3)))
typedef _Float16 f16x8 __attribute__((ext_vector_type(8)));
typedef float f32x4 __attribute__((ext_vector_type(4)));
__device__ __forceinline__ int lds_byte(int r, int c) { const int st = (r >> 4) * 2 + (c >> 5), rr = r & 15, cc = c & 31, ob = rr * 64 + cc * 2; return st * 1024 + (ob ^ (((ob >> 9) & 1) << 5)); }
__device__ __forceinline__ void stage_rc(int b, int& R, int& C) { const int st = b / 1024, sb = b % 1024, swz = sb ^ (((sb >> 9) & 1) << 5); R = (st >> 1) * 16 + swz / 64; C = (st & 1) * 32 + (swz % 64) / 2; }
__device__ __forceinline__ int perm32(int rho) { const int n = rho >> 4, i = rho & 15; return 8 * (i >> 2) + 4 * n + (i & 3); }
#endif
__device__ __forceinline__ void tile_of(int L, int nM, int nN, int& pm, int& pn) {
    const int nwg = nM * nN;
    int wgid = L; { const int q = nwg / NXCD, r = nwg % NXCD, xcd = wgid % NXCD, off = wgid / NXCD; wgid = (xcd < r ? xcd * (q + 1) : r * (q + 1) + (xcd - r) * q) + off; }
    const int nig = WGM * nN, gid = wgid / nig, fm = gid * WGM, gsz = (nM - fm) < WGM ? (nM - fm) : WGM;
    pm = fm + ((wgid % nig) % gsz); pn = (wgid % nig) / gsz;
}

template <class Sched, class Epi>
__device__ __forceinline__ void gemm_phase(char* smem, const Sched& S, const Epi& E) {
    constexpr int K = 1024, nt = K / BK;
    constexpr unsigned lda = LDZ, ldb = 1024;
#ifdef CPU_EMU
    const int tid = tid_(), wid = tid >> 6, lane = tid & 63, wr = wid >> 2, wc = wid & 3, fr = lane & 15, fq = lane >> 4;
    Unit u;
    for (int ui = 0; S.next(ui, u); ++ui) {
        f32x4 acc[2][2][4][2];
        for (int ai = 0; ai < 2; ++ai) for (int bj = 0; bj < 2; ++bj) for (int m = 0; m < 4; ++m) for (int n = 0; n < 2; ++n) for (int e = 0; e < 4; ++e) {
            const int r = 128 * ai + 64 * wr + 16 * m + fr, c = 128 * bj + 32 * wc + 8 * fq + 4 * n + e;
            const h16_t* a = (const h16_t*)u.A + (size_t)r * lda; const h16_t* b = (const h16_t*)u.B + (size_t)c * ldb;
            float s = 0.f;
            for (int k = 0; k < K; ++k) s += h2f(a[k]) * h2f(b[k]);
            acc[ai][bj][m][n][e] = s;
        }
        E(acc, u, wr, wc, fr, fq);
    }
    (void)smem; (void)nt;
#else
    PG8_LAS unsigned char* lds = (PG8_LAS unsigned char*)smem;
    const int tid = tid_(), wid = __builtin_amdgcn_readfirstlane(tid >> 6), lane = tid & 63, wr = wid >> 2, wc = wid & 3, fr = lane & 15, fq = lane >> 4;
    unsigned voffA[2], voffB[2];
#pragma unroll
    for (int i = 0; i < 2; ++i) { int R, C; stage_rc(tid * 16 + i * 8192, R, C); const int Rb = (R & ~31) + perm32(R & 31);
        voffA[i] = (unsigned)(R * lda + C) * 2u; voffB[i] = (unsigned)(Rb * ldb + C) * 2u; }
    constexpr size_t kstep = (size_t)(BK * 2);
    constexpr size_t hstepA = (size_t)HALF * lda * 2, hstepB = (size_t)HALF * ldb * 2;
    const unsigned ldsw = (unsigned)wid * 1024u;
    const int aoff = lds_byte(wr * 64 + fr, fq * 8), boff = lds_byte(wc * 32 + fr, fq * 8);
#define PG8_SA(b, h) (((b) * 2 + (h)) * HTB)
#define PG8_SB(b, h) ((4 + (b) * 2 + (h)) * HTB)
#define PG8_STAGE(bufoff, gbase, voff) do { _Pragma("unroll") for (int _i = 0; _i < 2; ++_i) \
        __builtin_amdgcn_global_load_lds((const unsigned*)((const char*)(gbase) + (voff)[_i]), (PG8_LAS unsigned*)(lds + (bufoff) + ldsw + _i * 8192), 16, 0, 0); } while (0)
#define PG8_LDA(dst, b, h) do { _Pragma("unroll") for (int m = 0; m < 4; ++m) _Pragma("unroll") for (int k = 0; k < 2; ++k) dst[m][k] = *(const PG8_LAS f16x8*)(lds + PG8_SA(b, h) + aoff + m * 2048 + k * 1024); } while (0)
#define PG8_LDB(dst, b, h) do { _Pragma("unroll") for (int n = 0; n < 2; ++n) _Pragma("unroll") for (int k = 0; k < 2; ++k) dst[n][k] = *(const PG8_LAS f16x8*)(lds + PG8_SB(b, h) + boff + n * 2048 + k * 1024); } while (0)
#define PG8_MMA(ai, bj, At, Bt) do { __builtin_amdgcn_s_setprio(1); _Pragma("unroll") for (int m = 0; m < 4; ++m) _Pragma("unroll") for (int n = 0; n < 2; ++n) _Pragma("unroll") for (int k = 0; k < 2; ++k) \
        acc[ai][bj][m][n] = __builtin_amdgcn_mfma_f32_16x16x32_f16(Bt[n][k], At[m][k], acc[ai][bj][m][n], 0, 0, 0); __builtin_amdgcn_s_setprio(0); } while (0)
#define PG8_WAIT_V(n) asm volatile("s_waitcnt vmcnt(" #n ")" ::: "memory")
#define PG8_WAIT_L(n) asm volatile("s_waitcnt lgkmcnt(" #n ")" ::: "memory")
#define PG8_BAR __builtin_amdgcn_s_barrier()
#define PG8_SCHED __builtin_amdgcn_sched_barrier(0)
    Unit cur, nxt; int ui = 0;
    if (!S.next(0, cur)) return;
    f32x4 acc[2][2][4][2];
#pragma unroll
    for (int a = 0; a < 2; ++a)
#pragma unroll
        for (int b = 0; b < 2; ++b)
#pragma unroll
            for (int m = 0; m < 4; ++m)
#pragma unroll
                for (int n = 0; n < 2; ++n) acc[a][b][m][n] = (f32x4){0.f, 0.f, 0.f, 0.f};
    f16x8 At[4][2], B0[2][2], B1[2][2];
    const char* cA = cur.A; const char* cB = cur.B;
    PG8_STAGE(PG8_SB(0, 0), cB, voffB); PG8_STAGE(PG8_SA(0, 0), cA, voffA); PG8_STAGE(PG8_SB(0, 1), cB + hstepB, voffB); PG8_STAGE(PG8_SA(0, 1), cA + hstepA, voffA);
    if (wr == 1) PG8_BAR;
    PG8_WAIT_V(4); PG8_BAR;
    PG8_STAGE(PG8_SB(1, 0), cB + kstep, voffB); PG8_STAGE(PG8_SA(1, 0), cA + kstep, voffA); PG8_STAGE(PG8_SB(1, 1), cB + hstepB + kstep, voffB);
    PG8_WAIT_V(6); PG8_BAR;
    for (;;) {
        const bool has_next = S.next(ui + 1, nxt);
        const char* nA = has_next ? nxt.A : cA; const char* nB = has_next ? nxt.B : cB;
#pragma unroll 1
        for (int t = 0; t < nt; t += 2) {
            const bool last = (t == nt - 2);
            const char* a1 = cA + (size_t)(t + 1) * kstep;
            const char* a2 = last ? nA : cA + (size_t)(t + 2) * kstep; const char* b2 = last ? nB : cB + (size_t)(t + 2) * kstep;
            const char* a3 = a2 + kstep; const char* b3 = b2 + kstep;
            PG8_LDB(B0, 0, 0); PG8_SCHED; PG8_LDA(At, 0, 0); PG8_STAGE(PG8_SA(1, 1), a1 + hstepA, voffA);
            PG8_WAIT_L(8); PG8_BAR; PG8_WAIT_L(0); PG8_MMA(0, 0, At, B0); PG8_BAR; PG8_SCHED;
            PG8_LDB(B1, 0, 1); PG8_STAGE(PG8_SB(0, 0), b2, voffB);
            PG8_BAR; PG8_WAIT_L(0); PG8_MMA(0, 1, At, B1); PG8_BAR;
            PG8_LDA(At, 0, 1); PG8_STAGE(PG8_SA(0, 0), a2, voffA);
            PG8_BAR; PG8_WAIT_L(0); PG8_MMA(1, 0, At, B0); PG8_BAR; PG8_SCHED;
            PG8_STAGE(PG8_SB(0, 1), b2 + hstepB, voffB);
            PG8_WAIT_V(6); PG8_BAR; PG8_MMA(1, 1, At, B1); PG8_BAR;
            PG8_LDB(B0, 1, 0); PG8_SCHED; PG8_LDA(At, 1, 0); PG8_STAGE(PG8_SA(0, 1), a2 + hstepA, voffA);
            PG8_WAIT_L(8); PG8_BAR; PG8_WAIT_L(0); PG8_MMA(0, 0, At, B0); PG8_BAR; PG8_SCHED;
            PG8_LDB(B1, 1, 1); PG8_STAGE(PG8_SB(1, 0), b3, voffB);
            PG8_BAR; PG8_WAIT_L(0); PG8_MMA(0, 1, At, B1); PG8_BAR;
            PG8_LDA(At, 1, 1); PG8_STAGE(PG8_SA(1, 0), a3, voffA);
            PG8_BAR; PG8_WAIT_L(0); PG8_MMA(1, 0, At, B0); PG8_BAR; PG8_SCHED;
            PG8_STAGE(PG8_SB(1, 1), b3 + hstepB, voffB);
            PG8_WAIT_V(6); PG8_BAR; PG8_MMA(1, 1, At, B1); PG8_BAR;
        }
        E(acc, cur, wr, wc, fr, fq);
        if (!has_next) break;
#pragma unroll
        for (int a = 0; a < 2; ++a)
#pragma unroll
            for (int b = 0; b < 2; ++b)
#pragma unroll
                for (int m = 0; m < 4; ++m)
#pragma unroll
                    for (int n = 0; n < 2; ++n) acc[a][b][m][n] = (f32x4){0.f, 0.f, 0.f, 0.f};
        cur = nxt; cA = nA; cB = nB; ++ui;
    }
    PG8_WAIT_V(0);
    if (wr == 0) PG8_BAR;
    PG8_BAR;
#undef PG8_SA
#undef PG8_SB
#undef PG8_STAGE
#undef PG8_LDA
#undef PG8_LDB
#undef PG8_MMA
#undef PG8_WAIT_V
#undef PG8_WAIT_L
#undef PG8_BAR
#undef PG8_SCHED
#endif
}
}

enum { GK_STORE = 0, GK_GATE0, GK_GATE1, GK_GATE2, GK_PROJ0, GK_PROJ1, GK_PROJ2, GK_RESID };
enum { GP_INPROJ = 0, GP_MERGE, GP_WOUT, GP_QUERY };
struct GemmProg {
    const char* act; const char* wt;
    int which, G, c;
    __device__ __forceinline__ bool next(int i, pg8::Unit& u) const {
        constexpr int nM = M_ / 256;
        constexpr size_t rowA = (size_t)256 * LDZ * 2, rowB = (size_t)256 * 1024 * 2;
        if (which == GP_MERGE) {
            const int L = (i / 6) * G + c, j = i % 6, br = j >> 1;
            if (L >= nM * 4) return false;
            pg8::tile_of(L, nM, 4, u.pm, u.pn);
            if ((j & 1) == 0) { u.A = act + (size_t)C_XN * 2; u.B = wt + ((size_t)(WT_MG + br * 1024) * 1024) * 2; u.kind = GK_GATE0 + br; }
            else { u.A = act + (size_t)(br == 0 ? C_YA : (br == 1 ? C_YB : C_YC)) * 2; u.B = wt + ((size_t)(WT_P + br * 1024) * 1024) * 2; u.kind = GK_PROJ0 + br; }
        } else {
            const int nN = which == GP_INPROJ ? ZN / 256 : (which == GP_WOUT ? 4 : 8);
            const int L = i * G + c;
            if (L >= nM * nN) return false;
            pg8::tile_of(L, nM, nN, u.pm, u.pn);
            u.A = act + (size_t)(which == GP_WOUT ? C_MG : C_XN) * 2;
            u.B = wt + ((size_t)(which == GP_INPROJ ? WT_IN : (which == GP_WOUT ? WT_OUT : WT_Q)) * 1024) * 2;
            u.kind = which == GP_WOUT ? GK_RESID : GK_STORE;
        }
        u.A += (size_t)u.pm * rowA; u.B += (size_t)u.pn * rowB;
        return true;
    }
};
struct GemmEpi {
    h16_t* act; const float* mb; const float* resid; float* out;
    __device__ __forceinline__ void operator()(const pg8::f32x4 (&acc)[2][2][4][2], const pg8::Unit& u, int wr, int wc, int fr, int fq) const {
        const int row0 = u.pm * 256 + wr * 64 + fr, col0 = u.pn * 256 + wc * 32 + 8 * fq;
#pragma unroll
        for (int ai = 0; ai < 2; ++ai)
#pragma unroll
            for (int m = 0; m < 4; ++m) {
                const int row = row0 + ai * 128 + m * 16;
#pragma unroll
                for (int bj = 0; bj < 2; ++bj) {
                    const int col = col0 + bj * 128;
                    float v[8];
#pragma unroll
                    for (int e = 0; e < 4; ++e) { v[e] = acc[ai][bj][m][0][e]; v[4 + e] = acc[ai][bj][m][1][e]; }
                    h16_t* arow = act + (size_t)row * LDZ;
                    if (u.kind == GK_STORE) {
                        store8h(arow + col, v);
                    } else if (u.kind <= GK_GATE2) {
                        const float* bp = mb + (u.kind - GK_GATE0) * 1024 + col;
                        const float4 b0 = *(const float4*)bp, b1 = *(const float4*)(bp + 4);
                        v[0] = sigmoidf_(v[0] + b0.x); v[1] = sigmoidf_(v[1] + b0.y); v[2] = sigmoidf_(v[2] + b0.z); v[3] = sigmoidf_(v[3] + b0.w);
                        v[4] = sigmoidf_(v[4] + b1.x); v[5] = sigmoidf_(v[5] + b1.y); v[6] = sigmoidf_(v[6] + b1.z); v[7] = sigmoidf_(v[7] + b1.w);
                        store8h(arow + C_GS + col, v);
                    } else if (u.kind <= GK_PROJ2) {
                        float g[8]; load8h(arow + C_GS + col, g);
                        if (u.kind == GK_PROJ0) {
#pragma unroll
                            for (int e = 0; e < 8; ++e) v[e] = g[e] * v[e];
                        } else {
                            float o[8]; load8h(arow + C_MG + col, o);
#pragma unroll
                            for (int e = 0; e < 8; ++e) v[e] = o[e] + g[e] * v[e];
                        }
                        store8h(arow + C_MG + col, v);
                    } else {
                        const size_t o = (size_t)row * 1024 + col;
                        const float4 r0 = *(const float4*)(resid + o), r1 = *(const float4*)(resid + o + 4);
                        *(float4*)(out + o) = make_float4(r0.x + v[0], r0.y + v[1], r0.z + v[2], r0.w + v[3]);
                        *(float4*)(out + o + 4) = make_float4(r1.x + v[4], r1.y + v[5], r1.z + v[6], r1.w + v[7]);
                    }
                }
            }
    }
};
__device__ __forceinline__ void stage_gemm(KParams p, int l, int which, char* smem) {
    GemmProg S; S.act = p->ws + OFF_ACT; S.wt = p->ws + OFF_WT + (size_t)l * WT_ROWS * 1024 * 2; S.which = which; S.G = gridDim.x; S.c = bid_();
    GemmEpi E; E.act = (h16_t*)(p->ws + OFF_ACT); E.mb = p->in[I_MB] + l * 3072; E.resid = l == 0 ? p->in[I_X] : p->out; E.out = p->out;
    pg8::gemm_phase(smem, S, E);
}

#ifdef CPU_EMU
__device__ __forceinline__ float group_sum(float v, int width, float* scratch) {
    const int tid = tid_();
    scratch[tid] = v;
    __syncthreads();
    float s = 0.f; const int base = tid & ~(width - 1);
    for (int i = 0; i < width; ++i) s += scratch[base + i];
    __syncthreads();
    return s;
}
#else
template <int CTRL> __device__ __forceinline__ float dpp_f(float v) { return __builtin_bit_cast(float, __builtin_amdgcn_update_dpp(0, __builtin_bit_cast(int, v), CTRL, 0xf, 0xf, false)); }
__device__ __forceinline__ float group_sum(float v, int width, float*) {
    v += dpp_f<0xB1>(v);
    v += dpp_f<0x4E>(v);
    if (width >= 8) v += dpp_f<0x141>(v);
    if (width >= 16) v += dpp_f<0x140>(v);
    if (width >= 32) v += __shfl_xor(v, 16);
    if (width >= 64) v += __shfl_xor(v, 32);
    return v;
}
#endif
__device__ __forceinline__ uint4 ldg16(const h16_t* p) { return *(const uint4*)p; }
__device__ __forceinline__ uint4 zero16() { uint4 z; z.x = 0u; z.y = 0u; z.z = 0u; z.w = 0u; return z; }

__device__ __forceinline__ void stage_lru(KParams p, int l, char* smem, int vb0, int nvb) {
    const int vb = bid_() - vb0;
    if (vb < 0 || vb >= nvb) return;
    constexpr int CH = 64;
    float* wa_s = (float*)smem;
    float* wx_s = wa_s + 4096;
    float* xcT = wx_s + 4096;
    float* a_s = xcT + 64 * CH;
    float* b_s = a_s + CH * 64;
    h16_t* ru = (h16_t*)(b_s + CH * 64);
    h16_t* rg = ru + (CH + 3) * 64;
    h16_t* ACT = (h16_t*)(p->ws + OFF_ACT);
    const int tid = tid_(), c = tid & 63, tg = tid >> 6;
    for (int item = vb; item < B_ * 16; item += nvb) {
        const int b = item / 16, n = item % 16, ch = n * 64 + c;
        __syncthreads();
        for (int i = tid; i < 4096; i += NT) { wa_s[i] = p->in[I_LWA][((size_t)l * 16 + n) * 4096 + i]; wx_s[i] = p->in[I_LWX][((size_t)l * 16 + n) * 4096 + i]; }
        const float cw0 = p->in[I_LCW][((size_t)l * 4 + 0) * 1024 + ch], cw1 = p->in[I_LCW][((size_t)l * 4 + 1) * 1024 + ch];
        const float cw2 = p->in[I_LCW][((size_t)l * 4 + 2) * 1024 + ch], cw3 = p->in[I_LCW][((size_t)l * 4 + 3) * 1024 + ch];
        const float cb = p->in[I_LCB][l * 1024 + ch], ba = p->in[I_LBA][l * 1024 + ch], bx = p->in[I_LBX][l * 1024 + ch];
        const float sp = softplusf_(-p->in[I_LLAM][l * 1024 + ch]);
        float hst = 0.f;
        uint4 pf[3];
#define LRU_LOAD(t0_) do { _Pragma("unroll") for (int i = 0; i < 3; ++i) { const int j = tid + NT * i; pf[i] = zero16(); \
            if (j < 536) { const int t = (t0_) - 3 + (j >> 3); if (t >= 0) pf[i] = ldg16(ACT + ((size_t)b * T_ + t) * LDZ + Z_ULRU + n * 64 + (j & 7) * 8); } \
            else if (j < 1048) { const int jj = j - 536; pf[i] = ldg16(ACT + ((size_t)b * T_ + (t0_) + (jj >> 3)) * LDZ + Z_GLRU + n * 64 + (jj & 7) * 8); } } } while (0)
#define LRU_PUT() do { _Pragma("unroll") for (int i = 0; i < 3; ++i) { const int j = tid + NT * i; \
            if (j < 536) *(uint4*)(ru + (j >> 3) * 64 + (j & 7) * 8) = pf[i]; else if (j < 1048) *(uint4*)(rg + ((j - 536) >> 3) * 64 + ((j - 536) & 7) * 8) = pf[i]; } } while (0)
        LRU_LOAD(0);
        LRU_PUT();
        __syncthreads();
#pragma unroll 1
        for (int t0 = 0; t0 < T_; t0 += CH) {
            float xc[8];
            {
                float u[11];
#pragma unroll
                for (int s = 0; s < 11; ++s) u[s] = h2f(ru[(tg * 8 + s) * 64 + c]);
#pragma unroll
                for (int s = 0; s < 8; ++s) { xc[s] = cw0 * u[s] + cw1 * u[s + 1] + cw2 * u[s + 2] + cw3 * u[s + 3] + cb; xcT[c * CH + tg * 8 + s] = xc[s]; }
            }
            __syncthreads();
            if (t0 + CH < T_) LRU_LOAD(t0 + CH);
            {
                float dr[8], di[8];
#pragma unroll
                for (int s = 0; s < 8; ++s) { dr[s] = 0.f; di[s] = 0.f; }
#pragma unroll 4
                for (int i = 0; i < 64; ++i) {
                    const float wa = wa_s[i * 64 + c], wx = wx_s[i * 64 + c];
                    const float4 x0 = *(const float4*)(xcT + i * CH + tg * 8), x1 = *(const float4*)(xcT + i * CH + tg * 8 + 4);
                    dr[0] += x0.x * wa; dr[1] += x0.y * wa; dr[2] += x0.z * wa; dr[3] += x0.w * wa; dr[4] += x1.x * wa; dr[5] += x1.y * wa; dr[6] += x1.z * wa; dr[7] += x1.w * wa;
                    di[0] += x0.x * wx; di[1] += x0.y * wx; di[2] += x0.z * wx; di[3] += x0.w * wx; di[4] += x1.x * wx; di[5] += x1.y * wx; di[6] += x1.z * wx; di[7] += x1.w * wx;
                }
#pragma unroll
                for (int s = 0; s < 8; ++s) {
                    const float r = sigmoidf_(dr[s] + ba), ig = sigmoidf_(di[s] + bx);
                    const float log_a = -8.0f * r * sp;
                    a_s[(tg * 8 + s) * 64 + c] = expf(log_a);
                    b_s[(tg * 8 + s) * 64 + c] = sqrtf(-expm1f(2.0f * log_a)) * (ig * xc[s]);
                }
            }
            __syncthreads();
            if (tid < 64) {
#pragma unroll 8
                for (int t = 0; t < CH; ++t) { hst = a_s[t * 64 + c] * hst + b_s[t * 64 + c]; b_s[t * 64 + c] = hst; }
            }
            __syncthreads();
#pragma unroll
            for (int s = 0; s < 8; ++s) { h16_t* gp = rg + (tg * 8 + s) * 64 + c; *gp = f2h(b_s[(tg * 8 + s) * 64 + c] * geluf_(h2f(*gp))); }
            __syncthreads();
            *(uint4*)(ACT + ((size_t)b * T_ + t0 + (tid >> 3)) * LDZ + Z_GLRU + n * 64 + (tid & 7) * 8) = *(const uint4*)(rg + (tid >> 3) * 64 + (tid & 7) * 8);
            __syncthreads();
            if (t0 + CH < T_) LRU_PUT();
            __syncthreads();
        }
#undef LRU_LOAD
#undef LRU_PUT
    }
}

#ifdef CPU_EMU
struct hfrag { h16_t v[8]; };
struct facc { float d[4]; float& operator[](int i) { return d[i]; } const float& operator[](int i) const { return d[i]; } };
__device__ __forceinline__ facc facc_zero() { facc a; a.d[0] = a.d[1] = a.d[2] = a.d[3] = 0.f; return a; }
__device__ __forceinline__ hfrag frag_u4(uint4 w) { hfrag f; memcpy(&f, &w, 16); return f; }
__device__ __forceinline__ hfrag frag_2u2(uint2 lo, uint2 hi) { hfrag f; memcpy(&f.v[0], &lo, 8); memcpy(&f.v[4], &hi, 8); return f; }
__device__ __forceinline__ hfrag frag_mul(hfrag a, hfrag b) { hfrag f; for (int j = 0; j < 8; ++j) f.v[j] = f2h(h2f(a.v[j]) * h2f(b.v[j])); return f; }
__device__ __forceinline__ facc mfma16(hfrag a, hfrag b, facc c) {
    const int tid = tid_(), w = tid >> 6, l = tid & 63;
    unsigned short (*X)[64][16] = emu::ctx->xscr;
    for (int j = 0; j < 8; ++j) { X[w][l][j] = a.v[j]; X[w][l][8 + j] = b.v[j]; }
    __syncthreads();
    for (int reg = 0; reg < 4; ++reg) {
        const int row = 4 * (l >> 4) + reg, col = l & 15;
        float s = 0.f;
        for (int k = 0; k < 32; ++k) s += h2f(X[w][row + 16 * (k >> 3)][k & 7]) * h2f(X[w][col + 16 * (k >> 3)][8 + (k & 7)]);
        c.d[reg] += s;
    }
    __syncthreads();
    return c;
}
#else
typedef _Float16 hfrag __attribute__((ext_vector_type(8)));
typedef float facc __attribute__((ext_vector_type(4)));
__device__ __forceinline__ facc facc_zero() { return (facc){0.f, 0.f, 0.f, 0.f}; }
__device__ __forceinline__ hfrag frag_u4(uint4 w) { return __builtin_bit_cast(hfrag, w); }
__device__ __forceinline__ hfrag frag_2u2(uint2 lo, uint2 hi) { uint4 w; w.x = lo.x; w.y = lo.y; w.z = hi.x; w.w = hi.y; return __builtin_bit_cast(hfrag, w); }
__device__ __forceinline__ hfrag frag_mul(hfrag a, hfrag b) { return a * b; }
__device__ __forceinline__ facc mfma16(hfrag a, hfrag b, facc c) { return __builtin_amdgcn_mfma_f32_16x16x32_f16(a, b, c, 0, 0, 0); }
#endif
__device__ __forceinline__ hfrag frag_pack8(float a0, float a1, float a2, float a3, float a4, float a5, float a6, float a7) {
    uint4 w; w.x = pack2h(a0, a1); w.y = pack2h(a2, a3); w.z = pack2h(a4, a5); w.w = pack2h(a6, a7); return frag_u4(w);
}
__device__ __forceinline__ hfrag frag_acc2(const facc& t0, const facc& t1) { return frag_pack8(t0[0], t0[1], t0[2], t0[3], t1[0], t1[1], t1[2], t1[3]); }
__device__ __forceinline__ hfrag permfrag(const h16_t* rowp, int ks, int g) { return frag_2u2(*(const uint2*)(rowp + 32 * ks + 4 * g), *(const uint2*)(rowp + 32 * ks + 16 + 4 * g)); }

__device__ __forceinline__ void stage_gdn(KParams p, int l, char* smem, int vb0, int nvb) {
    const int vb = bid_() - vb0;
    if (vb < 0 || vb >= nvb) return;
    constexpr int CH = 64, QS = 136, TS = 72, AS = 68;
    h16_t* Qs = (h16_t*)smem;
    h16_t* Ks = Qs + 64 * QS;
    h16_t* Kt = Ks + 64 * QS;
    h16_t* Vt = Kt + 128 * TS;
    float* A32 = (float*)(Vt + 128 * TS);
    h16_t* ob = (h16_t*)A32;
    h16_t* Tu = (h16_t*)(A32 + 64 * AS);
    h16_t* Tw = Tu + 64 * TS;
    h16_t* QKm = Tw + 64 * TS;
    float* gc_s = (float*)(QKm + 64 * TS);
    float* be_s = gc_s + 64;
    float* e1_s = be_s + 64;
    float* part_s = e1_s + 64;
    float* scr = part_s + 512;
    float* cw_s = scr + 512;
    h16_t* ACT = (h16_t*)(p->ws + OFF_ACT);
    int tid = tid_(), lane = tid & 63, w = tid >> 6, g = lane >> 4, r16 = lane & 15;
    int sg = lane >> 4, pc = lane & 15, rb = w;
#define GDN_ROLES() do { tid = tid_(); lane = tid & 63; w = tid >> 6; g = lane >> 4; r16 = lane & 15; sg = g; pc = r16; rb = w; } while (0)
    for (int item = vb; item < B_ * 8; item += nvb) {
        const int b = item / 8, h = item % 8;
        const float a_exp = expf(p->in[I_GALOG][l * 8 + h]), dtb = p->in[I_GDT][l * 8 + h];
        facc S[8];
#pragma unroll
        for (int dt = 0; dt < 8; ++dt) S[dt] = facc_zero();
        __syncthreads();
        for (int i = tid; i < 64 * TS / 2; i += NT) ((unsigned*)QKm)[i] = 0u;
        for (int i = tid; i < 4 * 384; i += NT) { const int jj = i / 384, c3 = i % 384; cw_s[i] = p->in[I_GCW][((size_t)l * 4 + jj) * 3072 + (c3 >> 7) * 1024 + h * 128 + (c3 & 127)]; }
        uint4 pf[11];
#define GDN_LOAD(t0_) do { GDN_ROLES(); const h16_t* colp = ACT + ((size_t)b * T_ + (t0_) + 8 * rb - 3) * LDZ + (sg < 3 ? Z_Q + sg * 1024 : Z_ZG) + h * 128 + pc * 8; \
            _Pragma("unroll") for (int i = 0; i < 11; ++i) { const int t = (t0_) + 8 * rb - 3 + i; pf[i] = (t >= 0 && sg < 3) ? ldg16(colp + (size_t)i * LDZ) : zero16(); } } while (0)
        GDN_LOAD(0);
#pragma unroll 1
        for (int t0 = 0; t0 < T_; t0 += CH) {
            GDN_ROLES();
            if (tid < 64) {
                const size_t m = (size_t)b * T_ + t0 + tid;
                part_s[tid] = -a_exp * softplusf_(h2f(ACT[m * LDZ + Z_ALPHA + h]) + dtb);
                be_s[tid] = sigmoidf_(h2f(ACT[m * LDZ + Z_BETA + h]));
            }
            __syncthreads();
            if (tid < 64) { float s = 0.f; for (int i = 0; i <= tid; ++i) s += part_s[i]; gc_s[tid] = s; }
#pragma unroll
            for (int hf = 0; hf < 2; ++hf) {
                float ov[4][8];
#pragma unroll
                for (int i = 0; i < 4; ++i) {
#pragma unroll
                    for (int cc = 0; cc < 8; ++cc) ov[i][cc] = 0.f;
#pragma unroll
                    for (int jj = 0; jj < 4; ++jj) {
                        const uint4 wv = pf[hf * 4 + i + jj];
                        const float* cwp = cw_s + jj * 384 + (sg < 3 ? sg : 0) * 128 + pc * 8;
                        const float4 c0 = *(const float4*)cwp, c1 = *(const float4*)(cwp + 4);
                        ov[i][0] += c0.x * h2f((h16_t)(wv.x & 0xffffu)); ov[i][1] += c0.y * h2f((h16_t)(wv.x >> 16)); ov[i][2] += c0.z * h2f((h16_t)(wv.y & 0xffffu)); ov[i][3] += c0.w * h2f((h16_t)(wv.y >> 16));
                        ov[i][4] += c1.x * h2f((h16_t)(wv.z & 0xffffu)); ov[i][5] += c1.y * h2f((h16_t)(wv.z >> 16)); ov[i][6] += c1.z * h2f((h16_t)(wv.w & 0xffffu)); ov[i][7] += c1.w * h2f((h16_t)(wv.w >> 16));
                    }
                    float ss = 0.f;
#pragma unroll
                    for (int cc = 0; cc < 8; ++cc) { ov[i][cc] = siluf_(ov[i][cc]); ss += ov[i][cc] * ov[i][cc]; }
                    ss = group_sum(ss, 16, scr);
                    const float rn = sg == 0 ? rsqrtf(ss + RMS_EPS) * 0.08838834764831845f : (sg == 1 ? rsqrtf(ss + RMS_EPS) : 1.0f);
#pragma unroll
                    for (int cc = 0; cc < 8; ++cc) ov[i][cc] *= rn;
                    const int t = 8 * rb + hf * 4 + i;
                    if (sg == 0) store8h(Qs + t * QS + pc * 8, ov[i]);
                    else if (sg == 1) store8h(Ks + t * QS + pc * 8, ov[i]);
                }
                if (sg == 1 || sg == 2) {
                    h16_t* dstT = sg == 1 ? Kt : Vt;
#pragma unroll
                    for (int cc = 0; cc < 8; ++cc) { uint2 w2; w2.x = pack2h(ov[0][cc], ov[1][cc]); w2.y = pack2h(ov[2][cc], ov[3][cc]); *(uint2*)(dstT + (pc * 8 + cc) * TS + 8 * rb + hf * 4) = w2; }
                }
            }
            __syncthreads();
            GDN_ROLES();
            if (tid < 64) e1_s[tid] = expf(gc_s[63] - gc_s[tid]);
            for (int e = tid; e < 64 * 64; e += NT) { const int i = e >> 6, j = e & 63; if ((j >> 4) > (i >> 4)) A32[i * AS + (j & 7) * 8 + (j >> 3)] = 0.f; }
#pragma unroll 1
            for (int jr = 0; jr < 3; ++jr) {
                const int jb = w + 8 * jr; const bool valid = jb < 20;
                const int kind = (valid && jb >= 10) ? 1 : 0, tix = valid ? (jb % 10) : 0;
                const int ti = tix < 1 ? 0 : (tix < 3 ? 1 : (tix < 6 ? 2 : 3)), tj = tix - (ti * (ti + 1)) / 2;
                const h16_t* ap = (kind ? Qs : Ks) + (16 * ti + r16) * QS + 8 * g; const h16_t* bp = Ks + (16 * tj + r16) * QS + 8 * g;
                facc acc = facc_zero();
#pragma unroll
                for (int ks = 0; ks < 4; ++ks) acc = mfma16(frag_u4(*(const uint4*)(ap + 32 * ks)), frag_u4(*(const uint4*)(bp + 32 * ks)), acc);
                if (valid) {
                    const int j = 16 * tj + r16; const float gj = gc_s[j];
#pragma unroll
                    for (int reg = 0; reg < 4; ++reg) {
                        const int i = 16 * ti + 4 * g + reg;
                        const float dec = expf(fminf(gc_s[i] - gj, 0.f));
                        if (kind == 0) A32[i * AS + (j & 7) * 8 + (j >> 3)] = i > j ? be_s[i] * acc[reg] * dec : 0.f;
                        else QKm[i * TS + j] = f2h(i >= j ? acc[reg] * dec : 0.f);
                    }
                }
            }
            __syncthreads();
            GDN_ROLES();
            {
                const int t = tid >> 3, d0 = (tid & 7) * 16; const float eg = expf(gc_s[t]);
                float v8[8];
                load8h(Qs + t * QS + d0, v8);
#pragma unroll
                for (int e = 0; e < 8; ++e) v8[e] *= eg;
                store8h(Qs + t * QS + d0, v8);
                load8h(Qs + t * QS + d0 + 8, v8);
#pragma unroll
                for (int e = 0; e < 8; ++e) v8[e] *= eg;
                store8h(Qs + t * QS + d0 + 8, v8);
            }
            {
                const int c = tid >> 3, q = tid & 7;
                const float bc = be_s[c], bgc = bc * expf(gc_s[c]);
                float x[8];
#pragma unroll
                for (int i = 0; i < 8; ++i) x[i] = 0.f;
#pragma unroll
                for (int r = 0; r < 64; ++r) {
                    float sacc = 0.f;
                    if (r > 0) {
                        const float4 a0 = *(const float4*)(A32 + r * AS + q * 8);
                        sacc = a0.x * x[0];
                        if (r > 8) sacc += a0.y * x[1];
                        if (r > 16) sacc += a0.z * x[2];
                        if (r > 24) sacc += a0.w * x[3];
                        if (r > 32) {
                            const float4 a1 = *(const float4*)(A32 + r * AS + q * 8 + 4);
                            sacc += a1.x * x[4];
                            if (r > 40) sacc += a1.y * x[5];
                            if (r > 48) sacc += a1.z * x[6];
                            if (r > 56) sacc += a1.w * x[7];
                        }
                        sacc = group_sum(sacc, 8, scr);
                    }
                    const float xr = ((r == c) ? 1.f : 0.f) - sacc;
                    if (q == (r & 7)) { x[r >> 3] = xr; Tu[r * TS + c] = f2h(xr * bc); Tw[r * TS + c] = f2h(xr * bgc); }
                }
            }
            __syncthreads();
            GDN_ROLES();
            facc vn[4], aw[4];
#pragma unroll
            for (int tt = 0; tt < 4; ++tt) { vn[tt] = facc_zero(); aw[tt] = facc_zero(); }
#pragma unroll
            for (int tt = 0; tt < 4; ++tt)
#pragma unroll
                for (int ks = 0; ks <= (tt >> 1); ++ks) {
                    const hfrag au = frag_u4(*(const uint4*)(Tu + (16 * tt + r16) * TS + 32 * ks + 8 * g)), aww = frag_u4(*(const uint4*)(Tw + (16 * tt + r16) * TS + 32 * ks + 8 * g));
                    vn[tt] = mfma16(au, frag_u4(*(const uint4*)(Vt + (16 * w + r16) * TS + 32 * ks + 8 * g)), vn[tt]);
                    aw[tt] = mfma16(aww, frag_u4(*(const uint4*)(Kt + (16 * w + r16) * TS + 32 * ks + 8 * g)), aw[tt]);
                }
#pragma unroll
            for (int tt = 0; tt < 4; ++tt)
#pragma unroll
                for (int reg = 0; reg < 4; ++reg) Ks[(16 * tt + 4 * g + reg) * QS + 16 * w + r16] = f2h(-aw[tt][reg]);
            __syncthreads();
            GDN_ROLES();
            h16_t zraw[16];
#pragma unroll
            for (int tt = 0; tt < 4; ++tt)
#pragma unroll
                for (int reg = 0; reg < 4; ++reg) zraw[tt * 4 + reg] = ACT[((size_t)b * T_ + t0 + 16 * tt + 4 * g + reg) * LDZ + Z_ZG + h * 128 + 16 * w + r16];
            hfrag Sb[4];
#pragma unroll
            for (int ks = 0; ks < 4; ++ks) Sb[ks] = frag_acc2(S[2 * ks], S[2 * ks + 1]);
            facc oc[4];
#pragma unroll
            for (int tt = 0; tt < 4; ++tt) {
                oc[tt] = facc_zero();
                const h16_t* wrow = Ks + (16 * tt + r16) * QS; const h16_t* qrow = Qs + (16 * tt + r16) * QS;
#pragma unroll
                for (int ks = 0; ks < 4; ++ks) { vn[tt] = mfma16(permfrag(wrow, ks, g), Sb[ks], vn[tt]); oc[tt] = mfma16(permfrag(qrow, ks, g), Sb[ks], oc[tt]); }
            }
            hfrag VNb[2];
            VNb[0] = frag_acc2(vn[0], vn[1]); VNb[1] = frag_acc2(vn[2], vn[3]);
#pragma unroll
            for (int tt = 0; tt < 4; ++tt)
#pragma unroll
                for (int ks2 = 0; ks2 <= (tt >> 1); ++ks2) oc[tt] = mfma16(permfrag(QKm + (16 * tt + r16) * TS, ks2, g), VNb[ks2], oc[tt]);
            {
                const float egl = expf(gc_s[63]);
                hfrag e1f[2];
#pragma unroll
                for (int ks2 = 0; ks2 < 2; ++ks2) { const float* ep = e1_s + 32 * ks2 + 4 * g; e1f[ks2] = frag_pack8(ep[0], ep[1], ep[2], ep[3], ep[16], ep[17], ep[18], ep[19]); }
#pragma unroll
                for (int dt = 0; dt < 8; ++dt) {
#pragma unroll
                    for (int reg = 0; reg < 4; ++reg) S[dt][reg] *= egl;
#pragma unroll
                    for (int ks2 = 0; ks2 < 2; ++ks2) S[dt] = mfma16(frag_mul(permfrag(Kt + (16 * dt + r16) * TS, ks2, g), e1f[ks2]), VNb[ks2], S[dt]);
                }
            }
            if (t0 + CH < T_) GDN_LOAD(t0 + CH);
            GDN_ROLES();
#pragma unroll
            for (int tt = 0; tt < 4; ++tt)
#pragma unroll
                for (int reg = 0; reg < 4; ++reg) { const float ss = group_sum(oc[tt][reg] * oc[tt][reg], 16, scr); if (r16 == 0) part_s[w * 64 + 16 * tt + 4 * g + reg] = ss; }
            __syncthreads();
            const float nw = p->in[I_GNW][l * 128 + w * 16 + r16];
#pragma unroll
            for (int tt = 0; tt < 4; ++tt)
#pragma unroll
                for (int reg = 0; reg < 4; ++reg) {
                    const int t = 16 * tt + 4 * g + reg;
                    float ms = 0.f;
#pragma unroll
                    for (int ww = 0; ww < 8; ++ww) ms += part_s[ww * 64 + t];
                    ob[t * 128 + 16 * w + r16] = f2h(oc[tt][reg] * rsqrtf(ms * (1.0f / 128.0f) + RMS_EPS) * nw * siluf_(h2f(zraw[tt * 4 + reg])));
                }
            __syncthreads();
            GDN_ROLES();
#pragma unroll
            for (int i = 0; i < 2; ++i) { const int j = tid + NT * i; *(uint4*)(ACT + ((size_t)b * T_ + t0 + (j >> 4)) * LDZ + Z_ZG + h * 128 + (j & 15) * 8) = *(const uint4*)(ob + (j >> 4) * 128 + (j & 15) * 8); }
            __syncthreads();
        }
#undef GDN_LOAD
#undef GDN_ROLES
    }
}

#ifndef CPU_EMU
typedef _Float16 rw_f16x8 __attribute__((ext_vector_type(8)));
typedef float rw_f32x4 __attribute__((ext_vector_type(4)));
#endif
__device__ __forceinline__ void stage_rwkv(KParams p, int l, char* smem, int vb0, int nvb) {
    const int vb = bid_() - vb0;
    if (vb < 0 || vb >= nvb) return;
    constexpr int CH = 32, XS = 264;
    float* r_s = (float*)smem;
    float* k_s = r_s + CH * 64;
    float* v_s = k_s + CH * 64;
    float* w_s = v_s + CH * 64;
    float* kk_s = w_s + CH * 64;
    float* ka_s = kk_s + CH * 64;
    float* g_s = ka_s + CH * 64;
    float* o_s = g_s + CH * 64;
    float* bon_s = o_s + CH * 64;
    float* scr = bon_s + CH;
    h16_t* raw = (h16_t*)(scr + 512);
    h16_t* xs = raw + (CH + 1) * 448;
    h16_t* ACT = (h16_t*)(p->ws + OFF_ACT);
    const int tid = tid_(), c = tid & 63, tg = tid >> 6;
    const int ri = tid >> 3, q8 = tid & 7;
    for (int item = vb; item < B_ * 16; item += nvb) {
        const int b = item / 16, h = item % 16, ch = h * 64 + c;
        const float w0 = p->in[I_RW0][l * 1024 + ch], a0 = p->in[I_RA0][l * 1024 + ch], k_k = p->in[I_RKK][l * 1024 + ch], k_a = p->in[I_RKA][l * 1024 + ch];
        const float rk_c = p->in[I_RRK][(size_t)l * 1024 + ch];
        const float lnw = p->in[I_RLW][l * 1024 + ch], lnb = p->in[I_RLB][l * 1024 + ch];
        const float* mu = p->in[I_RMU] + (size_t)l * RWW;
        const float mu_r = mu[RW_R + ch], mu_k = mu[RW_K + ch], mu_v = mu[RW_V + ch];
        const float mu_wl = mu[RW_WL + c], mu_al = mu[RW_AL + c], mu_g0 = mu[RW_GL + c], mu_g1 = mu[RW_GL + 64 + c];
        const float* wup = p->in[I_RWUP] + (size_t)l * 64 * 1024 + h * 64; const float* aup = p->in[I_RAUP] + (size_t)l * 64 * 1024 + h * 64; const float* gup = p->in[I_RGUP] + (size_t)l * 128 * 1024 + h * 64;
#ifndef CPU_EMU
        const int wid = tid >> 6, lane = tid & 63, mt = wid >> 2, nt = wid & 3;
        rw_f16x8 bw[2], ba_[2], bg[4];
        {
            const int cn = nt * 16 + (lane & 15), kb = 8 * (lane >> 4);
#pragma unroll
            for (int ks = 0; ks < 2; ++ks)
#pragma unroll
                for (int j = 0; j < 8; ++j) { bw[ks][j] = (_Float16)wup[(size_t)(ks * 32 + kb + j) * 1024 + cn]; ba_[ks][j] = (_Float16)aup[(size_t)(ks * 32 + kb + j) * 1024 + cn]; }
#pragma unroll
            for (int ks = 0; ks < 4; ++ks)
#pragma unroll
                for (int j = 0; j < 8; ++j) bg[ks][j] = (_Float16)gup[(size_t)(ks * 32 + kb + j) * 1024 + cn];
        }
#endif
        float S[8];
#pragma unroll
        for (int e = 0; e < 8; ++e) S[e] = 0.f;
        uint4 pf[4];
#define RW_LOAD(t0_) do { _Pragma("unroll") for (int i = 0; i < 4; ++i) { const int j = tid + NT * i, row = j / 56, u = j % 56, t = (t0_) - 1 + row; pf[i] = zero16(); \
            if (j < (CH + 1) * 56 && t >= 0) pf[i] = ldg16(ACT + ((size_t)b * T_ + t) * LDZ + Z_RW + (u < 24 ? (u >> 3) * 1024 + h * 64 + (u & 7) * 8 : 3072 + (u - 24) * 8)); } } while (0)
#define RW_PUT() do { _Pragma("unroll") for (int i = 0; i < 4; ++i) { const int j = tid + NT * i; if (j < (CH + 1) * 56) *(uint4*)(raw + (j / 56) * 448 + (j % 56) * 8) = pf[i]; } } while (0)
        __syncthreads();
        RW_LOAD(0);
        RW_PUT();
        __syncthreads();
#pragma unroll 1
        for (int t0 = 0; t0 < T_; t0 += CH) {
#pragma unroll
            for (int s = 0; s < 4; ++s) {
                const int tl = tg * 4 + s;
                const h16_t* zc = raw + (tl + 1) * 448; const h16_t* zp = raw + tl * 448;
#define RW_SHIFT(col, muv) ({ const float zz = h2f(zc[col]); zz + (muv) * (h2f(zp[col]) - zz); })
                r_s[tl * 64 + c] = RW_SHIFT(c, mu_r);
                k_s[tl * 64 + c] = RW_SHIFT(64 + c, mu_k);
                v_s[tl * 64 + c] = RW_SHIFT(128 + c, mu_v);
                xs[tl * XS + c] = f2h(tanhf(RW_SHIFT(192 + c, mu_wl)));
                xs[tl * XS + 64 + c] = f2h(RW_SHIFT(256 + c, mu_al));
                xs[tl * XS + 128 + c] = f2h(sigmoidf_(RW_SHIFT(320 + c, mu_g0)));
                xs[tl * XS + 192 + c] = f2h(sigmoidf_(RW_SHIFT(384 + c, mu_g1)));
#undef RW_SHIFT
            }
            __syncthreads();
            if (t0 + CH < T_) RW_LOAD(t0 + CH);
#ifdef CPU_EMU
#pragma unroll
            for (int s = 0; s < 4; ++s) {
                const int tl = tg * 4 + s;
                float dw = 0.f, da = 0.f, dg = 0.f;
                for (int i = 0; i < 64; ++i) { dw += h2f(xs[tl * XS + i]) * h2f(f2h(wup[(size_t)i * 1024 + c])); da += h2f(xs[tl * XS + 64 + i]) * h2f(f2h(aup[(size_t)i * 1024 + c])); }
                for (int i = 0; i < 128; ++i) dg += h2f(xs[tl * XS + 128 + i]) * h2f(f2h(gup[(size_t)i * 1024 + c]));
                w_s[tl * 64 + c] = dw; ka_s[tl * 64 + c] = da; g_s[tl * 64 + c] = dg;
            }
#else
            {
                const h16_t* ap = xs + (mt * 16 + (lane & 15)) * XS + 8 * (lane >> 4);
                rw_f32x4 dw = {0.f, 0.f, 0.f, 0.f}, da = {0.f, 0.f, 0.f, 0.f}, dg = {0.f, 0.f, 0.f, 0.f};
#pragma unroll
                for (int ks = 0; ks < 2; ++ks) {
                    dw = __builtin_amdgcn_mfma_f32_16x16x32_f16(*(const rw_f16x8*)(ap + ks * 32), bw[ks], dw, 0, 0, 0);
                    da = __builtin_amdgcn_mfma_f32_16x16x32_f16(*(const rw_f16x8*)(ap + 64 + ks * 32), ba_[ks], da, 0, 0, 0);
                }
#pragma unroll
                for (int ks = 0; ks < 4; ++ks) dg = __builtin_amdgcn_mfma_f32_16x16x32_f16(*(const rw_f16x8*)(ap + 128 + ks * 32), bg[ks], dg, 0, 0, 0);
#pragma unroll
                for (int rg = 0; rg < 4; ++rg) { const int o = (mt * 16 + 4 * (lane >> 4) + rg) * 64 + nt * 16 + (lane & 15); w_s[o] = dw[rg]; ka_s[o] = da[rg]; g_s[o] = dg[rg]; }
            }
#endif
            __syncthreads();
#pragma unroll
            for (int s = 0; s < 4; ++s) {
                const int tl = tg * 4 + s;
                const float w_log = -softplusf_(-(w0 + w_s[tl * 64 + c])) - 0.5f;
                const float decay = expf(-expf(w_log));
                const float a = sigmoidf_(a0 + ka_s[tl * 64 + c]);
                const float kx = k_s[tl * 64 + c], rx = r_s[tl * 64 + c];
                const float kkr = kx * k_k, k2 = kx * (1.0f + (a - 1.0f) * k_a);
                const float nsq = group_sum(kkr * kkr, 64, scr);
                const float bon = group_sum(rx * k2 * rk_c, 64, scr);
                const float kkn = kkr * rsqrtf(nsq + RMS_EPS);
                w_s[tl * 64 + c] = decay; k_s[tl * 64 + c] = k2; kk_s[tl * 64 + c] = kkn; ka_s[tl * 64 + c] = kkn * a;
                if (c == 0) bon_s[tl] = bon;
            }
            __syncthreads();
#pragma unroll 1
            for (int t = 0; t < CH; ++t) {
                const int o8 = t * 64 + q8 * 8;
                const float4 kk0 = *(const float4*)(kk_s + o8), kk1 = *(const float4*)(kk_s + o8 + 4);
                const float pk = (S[0] * kk0.x + S[1] * kk0.y) + (S[2] * kk0.z + S[3] * kk0.w) + ((S[4] * kk1.x + S[5] * kk1.y) + (S[6] * kk1.z + S[7] * kk1.w));
                const float skk = group_sum(pk, 8, scr);
                const float vi = v_s[t * 64 + ri];
                const float4 w0v = *(const float4*)(w_s + o8), w1v = *(const float4*)(w_s + o8 + 4);
                const float4 a0v = *(const float4*)(ka_s + o8), a1v = *(const float4*)(ka_s + o8 + 4);
                const float4 k0v = *(const float4*)(k_s + o8), k1v = *(const float4*)(k_s + o8 + 4);
                const float4 r0v = *(const float4*)(r_s + o8), r1v = *(const float4*)(r_s + o8 + 4);
                S[0] = S[0] * w0v.x - skk * a0v.x + vi * k0v.x; S[1] = S[1] * w0v.y - skk * a0v.y + vi * k0v.y; S[2] = S[2] * w0v.z - skk * a0v.z + vi * k0v.z; S[3] = S[3] * w0v.w - skk * a0v.w + vi * k0v.w;
                S[4] = S[4] * w1v.x - skk * a1v.x + vi * k1v.x; S[5] = S[5] * w1v.y - skk * a1v.y + vi * k1v.y; S[6] = S[6] * w1v.z - skk * a1v.z + vi * k1v.z; S[7] = S[7] * w1v.w - skk * a1v.w + vi * k1v.w;
                const float po = (S[0] * r0v.x + S[1] * r0v.y) + (S[2] * r0v.z + S[3] * r0v.w) + ((S[4] * r1v.x + S[5] * r1v.y) + (S[6] * r1v.z + S[7] * r1v.w));
                const float o = group_sum(po, 8, scr);
                if (q8 == 0) o_s[t * 64 + ri] = o;
            }
            __syncthreads();
#pragma unroll
            for (int s = 0; s < 4; ++s) {
                const int tl = tg * 4 + s;
                const float ov = o_s[tl * 64 + c];
                const float mean = group_sum(ov, 64, scr) * (1.0f / 64.0f);
                const float d = ov - mean;
                const float var = group_sum(d * d, 64, scr) * (1.0f / 64.0f);
                const float y = (d * rsqrtf(var + GN_EPS) * lnw + lnb + bon_s[tl] * v_s[tl * 64 + c]) * g_s[tl * 64 + c];
                ACT[((size_t)b * T_ + t0 + tl) * LDZ + C_YC + ch] = f2h(y);
            }
            __syncthreads();
            if (t0 + CH < T_) RW_PUT();
            __syncthreads();
        }
#undef RW_LOAD
#undef RW_PUT
    }
}

constexpr bool TAB_IN_ACT = (M_ == 16384);
constexpr float TAB_SU = 256.0f, TAB_SV = 32.0f;
__device__ __forceinline__ unsigned char* tab_row(char* ws, int e) {
    if (TAB_IN_ACT) return (unsigned char*)((h16_t*)(ws + OFF_ACT) + (size_t)e * LDZ + C_GS);
    return (unsigned char*)(ws + OFF_TAB) + (size_t)e * 2048;
}
#ifdef CPU_EMU
__device__ __forceinline__ unsigned f2fp8(float f) {
    const unsigned sgn = f < 0.f ? 0x80u : 0u; float a = fabsf(f);
    if (!(a == a)) return 0x7fu;
    if (a >= 448.0f) return sgn | 0x7eu;
    if (a < 0.0009765625f) return sgn;
    int e; frexpf(a, &e); e -= 1;
    if (e < -6) { const float q = nearbyintf(a * 512.0f); return sgn | (unsigned)q; }
    float q = nearbyintf((a / ldexpf(1.0f, e) - 1.0f) * 8.0f);
    if (q >= 8.0f) { q = 0.f; e += 1; }
    if (e > 8) return sgn | 0x7eu;
    const unsigned r = ((unsigned)(e + 7) << 3) | (unsigned)q;
    return sgn | (r > 0x7eu ? 0x7eu : r);
}
__device__ __forceinline__ float fp82f(unsigned b) {
    const unsigned e = (b >> 3) & 15u, m = b & 7u; const float s = (b & 0x80u) ? -1.f : 1.f;
    if (e == 0) return s * (float)m * 0.001953125f;
    return s * ldexpf(1.0f + (float)m * 0.125f, (int)e - 7);
}
__device__ __forceinline__ unsigned pack4fp8(float a, float b, float c, float d) { return f2fp8(a) | (f2fp8(b) << 8) | (f2fp8(c) << 16) | (f2fp8(d) << 24); }
__device__ __forceinline__ void dec4fp8(unsigned w, float* o) { o[0] = fp82f(w & 255u); o[1] = fp82f((w >> 8) & 255u); o[2] = fp82f((w >> 16) & 255u); o[3] = fp82f(w >> 24); }
#else
__device__ __forceinline__ unsigned pack4fp8(float a, float b, float c, float d) { int p = __builtin_amdgcn_cvt_pk_fp8_f32(a, b, 0, false); p = __builtin_amdgcn_cvt_pk_fp8_f32(c, d, p, true); return (unsigned)p; }
__device__ __forceinline__ void dec4fp8(unsigned w, float* o) { const auto lo = __builtin_amdgcn_cvt_pk_f32_fp8((int)w, false); const auto hi = __builtin_amdgcn_cvt_pk_f32_fp8((int)w, true); o[0] = lo[0]; o[1] = lo[1]; o[2] = hi[0]; o[3] = hi[1]; }
#endif
__device__ __forceinline__ void stage_tabconv(KParams p, int l) {
    const int tid = tid_();
    const float* U = p->in[I_PU] + (size_t)l * 16384 * 1024; const float* V = p->in[I_PV] + (size_t)l * 16384 * 1024;
    char* ws = p->ws;
    for (int it = bid_() * NT + tid; it < 16384 * 128; it += gridDim.x * NT) {
        const int r = it >> 7, ck = it & 127, which = ck >> 6, c16 = ck & 63;
        const float* src = (which ? V : U) + (size_t)r * 1024 + c16 * 16;
        const float sc = which ? TAB_SV : TAB_SU;
        const float4 a = *(const float4*)src, b = *(const float4*)(src + 4), c = *(const float4*)(src + 8), d = *(const float4*)(src + 12);
        uint4 w;
        w.x = pack4fp8(a.x * sc, a.y * sc, a.z * sc, a.w * sc); w.y = pack4fp8(b.x * sc, b.y * sc, b.z * sc, b.w * sc);
        w.z = pack4fp8(c.x * sc, c.y * sc, c.z * sc, c.w * sc); w.w = pack4fp8(d.x * sc, d.y * sc, d.z * sc, d.w * sc);
        *(uint4*)(tab_row(ws, r) + which * 1024 + c16 * 16) = w;
    }
}

__device__ __forceinline__ void stage_peer_topk(KParams p, int l, char* smem) {
    float* key_s = (float*)smem;
    const h16_t* ACT = (const h16_t*)(p->ws + OFF_ACT);
    float* TOPS = (float*)(p->ws + OFF_TOPS);
    const int tid = tid_();
    const int nb = gridDim.x;
    for (int hs = bid_() % 16; hs < 16; hs += nb) {
        const int hd = hs >> 1, s = hs & 1;
        __syncthreads();
        {
            const float* kp = p->in[I_PKEYS] + (((size_t)l * 8 + hd) * 2 + s) * 128 * 128;
            for (int i = tid * 4; i < 128 * 128; i += NT * 4) *(float4*)(key_s + i) = *(const float4*)(kp + i);
        }
        __syncthreads();
        const int nblk = nb >= 16 ? nb / 16 : 1, bsub = nb >= 16 ? bid_() / 16 : 0;
        for (int chunk = bsub; chunk < (M_ + NT - 1) / NT; chunk += nblk) {
            if (nb >= 16 && bid_() >= nblk * 16) break;
            const int m = chunk * NT + tid;
            if (m >= M_) continue;
            float q[128];
            {
                const h16_t* qp = ACT + (size_t)m * LDZ + C_QRY + hd * 256 + s * 128;
#pragma unroll
                for (int c8 = 0; c8 < 16; ++c8) { float t8[8]; load8h(qp + c8 * 8, t8);
#pragma unroll
                    for (int j = 0; j < 8; ++j) q[c8 * 8 + j] = t8[j]; }
            }
            float top[16];
#pragma unroll
            for (int i = 0; i < 16; ++i) top[i] = -3.0e38f;
#pragma unroll 2
            for (int n = 0; n < 128; ++n) {
                const float* kr = key_s + n * 128;
                float a0 = 0.f, a1 = 0.f, a2 = 0.f, a3 = 0.f;
#pragma unroll
                for (int c4 = 0; c4 < 32; ++c4) {
                    const float4 kv = *(const float4*)(kr + c4 * 4);
                    a0 += q[c4 * 4] * kv.x; a1 += q[c4 * 4 + 1] * kv.y; a2 += q[c4 * 4 + 2] * kv.z; a3 += q[c4 * 4 + 3] * kv.w;
                }
                float x = __uint_as_float((__float_as_uint((a0 + a1) + (a2 + a3)) & ~127u) | (unsigned)(127 - n));
#pragma unroll
                for (int i = 0; i < 16; ++i) { const float hi = fmaxf(top[i], x); x = fminf(top[i], x); top[i] = hi; }
            }
            float* tp = TOPS + (((size_t)m * 8 + hd) * 2 + s) * 16;
#pragma unroll
            for (int i = 0; i < 16; i += 4) *(float4*)(tp + i) = make_float4(top[i], top[i + 1], top[i + 2], top[i + 3]);
        }
    }
}

__device__ __forceinline__ void peer_cand(int k, int& i, int& j) {
    if (k < 16) { i = 0; j = k; } else if (k < 24) { i = 1; j = k - 16; } else if (k < 29) { i = 2; j = k - 24; } else if (k < 33) { i = 3; j = k - 29; }
    else if (k < 36) { i = 4; j = k - 33; } else if (k < 38) { i = 5; j = k - 36; } else if (k < 40) { i = 6; j = k - 38; } else if (k < 42) { i = 7; j = k - 40; }
    else { i = k - 34; j = 0; }
}
__device__ __forceinline__ float dot16q(const uint4 a, const float (&x)[16]) {
    float t[16]; dec4fp8(a.x, t); dec4fp8(a.y, t + 4); dec4fp8(a.z, t + 8); dec4fp8(a.w, t + 12);
    float s0 = 0.f, s1 = 0.f, s2 = 0.f, s3 = 0.f;
#pragma unroll
    for (int j = 0; j < 16; j += 4) { s0 += t[j] * x[j]; s1 += t[j + 1] * x[j + 1]; s2 += t[j + 2] * x[j + 2]; s3 += t[j + 3] * x[j + 3]; }
    return (s0 + s1) + (s2 + s3);
}
__device__ __forceinline__ void axpy16q(const uint4 a, float s, float (&y)[16]) {
    float t[16]; dec4fp8(a.x, t); dec4fp8(a.y, t + 4); dec4fp8(a.z, t + 8); dec4fp8(a.w, t + 12);
#pragma unroll
    for (int j = 0; j < 16; ++j) y[j] += s * t[j];
}
__device__ __forceinline__ void stage_peer_gather(KParams p, int l, char* smem) {
    const int tid = tid_(), w = tid >> 6, lane = tid & 63;
    float* base = (float*)smem + w * 2048;
    float* tops_s = base;
    float* cand_s = tops_s + 256;
    float* best_s = cand_s + 64;
    int* idx_s = (int*)(best_s + 128);
    float* gate_s = (float*)(idx_s + 128);
    float* pw = gate_s + 128;
    float* scr = (float*)smem + 8 * 2048;
    h16_t* ACT = (h16_t*)(p->ws + OFF_ACT);
    const float* TOPS = (const float*)(p->ws + OFF_TOPS);
    char* ws = p->ws;
    const float* nxt_w = (l + 1 < NL_) ? p->in[I_NMIX] + (l + 1) * 1024 : p->in[I_NFINAL];
    const int nwaves = gridDim.x * 8;
    for (int m = bid_() * 8 + w; m < M_; m += nwaves) {
        __syncthreads();
        *(float4*)(tops_s + lane * 4) = *(const float4*)(TOPS + (size_t)m * 256 + lane * 4);
        float x[16];
        { float t8[8]; load8h(ACT + (size_t)m * LDZ + C_XN + lane * 16, t8);
#pragma unroll
          for (int j = 0; j < 8; ++j) x[j] = t8[j];
          load8h(ACT + (size_t)m * LDZ + C_XN + lane * 16 + 8, t8);
#pragma unroll
          for (int j = 0; j < 8; ++j) x[8 + j] = t8[j]; }
        __syncthreads();
        int ci = 0, cj = 0;
        if (lane < 50) peer_cand(lane, ci, cj);
        const int pos = ci * 16 + cj;
#pragma unroll 1
        for (int hd = 0; hd < 8; ++hd) {
            const float cs = lane < 50 ? tops_s[hd * 32 + ci] + tops_s[hd * 32 + 16 + cj] : -3.0e38f;
            cand_s[lane] = cs;
            __syncthreads();
            if (lane < 50) {
                int cnt = 0;
                for (int o = 0; o < 50; ++o) { int oi, oj; peer_cand(o, oi, oj); const float ov = cand_s[o]; cnt += (ov > cs || (ov == cs && oi * 16 + oj < pos)) ? 1 : 0; }
                if (cnt < 16) {
                    best_s[hd * 16 + cnt] = cs;
                    const int n0 = 127 - (int)(__float_as_uint(tops_s[hd * 32 + ci]) & 127u), n1 = 127 - (int)(__float_as_uint(tops_s[hd * 32 + 16 + cj]) & 127u);
                    idx_s[hd * 16 + cnt] = n0 * 128 + n1;
                }
            }
            __syncthreads();
        }
#pragma unroll
        for (int rr = 0; rr < 2; ++rr) {
            const int e = lane + 64 * rr, hd = e >> 4;
            const float mx = best_s[hd * 16];
            float sum = 0.f;
#pragma unroll
            for (int i = 0; i < 16; ++i) sum += expf(best_s[hd * 16 + i] - mx);
            gate_s[e] = expf(best_s[e] - mx) / sum;
        }
        __syncthreads();
        float y[16];
#pragma unroll
        for (int i = 0; i < 16; ++i) y[i] = 0.f;
#pragma unroll 1
        for (int eb = 0; eb < 128; eb += 16) {
            uint4 uq[16];
#pragma unroll
            for (int k = 0; k < 16; ++k) uq[k] = *(const uint4*)(tab_row(ws, idx_s[eb + k]) + lane * 16);
            uint4 vq[16];
#pragma unroll
            for (int k = 0; k < 16; ++k) vq[k] = *(const uint4*)(tab_row(ws, idx_s[eb + k]) + 1024 + lane * 16);
#pragma unroll
            for (int k = 0; k < 16; ++k) pw[k * 64 + lane] = dot16q(uq[k], x);
            __syncthreads();
            {
                const int k = lane >> 2, qq = lane & 3;
                float s = 0.f;
#pragma unroll
                for (int i = 0; i < 16; ++i) s += pw[k * 64 + qq * 16 + i];
                s = group_sum(s, 4, scr);
                __syncthreads();
                pw[k * 64] = s;
            }
            __syncthreads();
#pragma unroll
            for (int k = 0; k < 16; ++k) {
                const float hid = gate_s[eb + k] * geluf_(pw[k * 64] * (1.0f / TAB_SU));
                axpy16q(vq[k], hid, y);
            }
            __syncthreads();
        }
        float* op = p->out + (size_t)m * 1024 + lane * 16;
        float hn[16]; float ss = 0.f;
#pragma unroll
        for (int i = 0; i < 16; i += 4) {
            const float4 o4 = *(const float4*)(op + i);
            hn[i] = o4.x + y[i] * (1.0f / TAB_SV); hn[i + 1] = o4.y + y[i + 1] * (1.0f / TAB_SV); hn[i + 2] = o4.z + y[i + 2] * (1.0f / TAB_SV); hn[i + 3] = o4.w + y[i + 3] * (1.0f / TAB_SV);
            ss += hn[i] * hn[i] + hn[i + 1] * hn[i + 1] + hn[i + 2] * hn[i + 2] + hn[i + 3] * hn[i + 3];
        }
        ss = group_sum(ss, 64, scr);
        const float rstd = rsqrtf(ss * (1.0f / D_) + RMS_EPS);
        float nv[16];
#pragma unroll
        for (int i = 0; i < 16; i += 4) { const float4 w4 = *(const float4*)(nxt_w + lane * 16 + i); nv[i] = hn[i] * rstd * w4.x; nv[i + 1] = hn[i + 1] * rstd * w4.y; nv[i + 2] = hn[i + 2] * rstd * w4.z; nv[i + 3] = hn[i + 3] * rstd * w4.w; }
        if (l + 1 < NL_) {
#pragma unroll
            for (int i = 0; i < 16; i += 4) *(float4*)(op + i) = make_float4(hn[i], hn[i + 1], hn[i + 2], hn[i + 3]);
            const float n0[8] = {nv[0], nv[1], nv[2], nv[3], nv[4], nv[5], nv[6], nv[7]}, n1[8] = {nv[8], nv[9], nv[10], nv[11], nv[12], nv[13], nv[14], nv[15]};
            store8h(ACT + (size_t)m * LDZ + C_XN + lane * 16, n0); store8h(ACT + (size_t)m * LDZ + C_XN + lane * 16 + 8, n1);
        } else {
#pragma unroll
            for (int i = 0; i < 16; i += 4) *(float4*)(op + i) = make_float4(nv[i], nv[i + 1], nv[i + 2], nv[i + 3]);
        }
    }
}

enum { PH_NORM_MIX = 0, PH_INPROJ, PH_MIXERS, PH_MERGE, PH_WOUT, PH_NORM_FFN, PH_QUERY, PH_TOPK, PH_GATHER, PH_PER_LAYER, PH_FINAL = 100, PH_WPREP = 101 };
__device__ __forceinline__ void run_phase(KParams p, int l, int ph, char* smem) {
    h16_t* ACT = (h16_t*)(p->ws + OFF_ACT);
    const float* hin = l == 0 ? p->in[I_X] : p->out;
    switch (ph) {
    case PH_WPREP: stage_wprep(p, smem); break;
    case PH_NORM_MIX: if (l == 0) stage_rmsnorm<false>(hin, p->in[I_NMIX] + l * 1024, ACT + C_XN, LDZ, smem); break;
    case PH_INPROJ: stage_gemm(p, l, GP_INPROJ, smem); break;
    case PH_MIXERS: {
        const int nb = gridDim.x, n_rw = nb / 2, n_gd = nb / 4, n_lr = nb - n_rw - n_gd;
        stage_rwkv(p, l, smem, 0, n_rw);
        stage_gdn(p, l, smem, n_rw, n_gd);
        stage_lru(p, l, smem, n_rw + n_gd, n_lr);
    } break;
    case PH_MERGE: stage_gemm(p, l, GP_MERGE, smem); break;
    case PH_WOUT: stage_gemm(p, l, GP_WOUT, smem); break;
    case PH_NORM_FFN: stage_rmsnorm<false>(p->out, p->in[I_NFFN] + l * 1024, ACT + C_XN, LDZ, smem); stage_tabconv(p, l); break;
    case PH_QUERY: stage_gemm(p, l, GP_QUERY, smem); break;
    case PH_TOPK: stage_peer_topk(p, l, smem); break;
    case PH_GATHER: stage_peer_gather(p, l, smem); break;
    case PH_FINAL: break;
    default: break;
    }
}

#if !defined(CPU_EMU) && !MK_MULTI
__global__ void __launch_bounds__(512, 2) k_mega(Params p_) {
    DYN_SMEM(smem);
    KParams pk = (KParams)__builtin_amdgcn_kernarg_segment_ptr();
    cg::grid_group grid = cg::this_grid();
    constexpr int NIT = NL_ * PH_PER_LAYER;
#pragma unroll 1
    for (int it = -1; it <= NIT; ++it) {
        const int l = (it >= 0 && it < NIT) ? it / PH_PER_LAYER : 0, ph = it < 0 ? (int)PH_WPREP : (it < NIT ? it % PH_PER_LAYER : (int)PH_FINAL);
        KParams q = pk; asm volatile("" : "+s"(q));
        run_phase(q, l, ph, smem);
        if (it >= 0 && it < NIT - 1 && !(l > 0 && ph == PH_NORM_MIX)) grid.sync();
    }
}
#endif
#ifdef CPU_EMU
__global__ void k_phase(Params p_, int l, int ph) { DYN_SMEM(smem); run_phase(&p_, l, ph, smem); }
#elif MK_MULTI
__global__ void __launch_bounds__(512, 2) k_phase(Params p_, int l, int ph) { DYN_SMEM(smem); KParams pk = (KParams)__builtin_amdgcn_kernarg_segment_ptr(); run_phase(pk, l, ph, smem); }
#endif
}

#ifdef CPU_EMU
int g_emu_stop = 1000;
#endif

extern "C" void kernel_launch(void* const* d_in, const int* in_sizes, int n_in, void* d_out, int out_size, void* d_ws, size_t ws_size, hipStream_t stream) {
    Params p{};
    for (int i = 0; i < N_IN; ++i) p.in[i] = (const float*)d_in[i];
    p.out = (float*)d_out; p.ws = (char*)d_ws;
#if defined(CPU_EMU) || MK_MULTI
    const int grid = 256;
    LAUNCH(k_phase, grid, NT, SMEM_BYTES, stream, p, 0, (int)PH_WPREP);
    for (int l = 0; l < NL_; ++l)
        for (int ph = 0; ph < PH_PER_LAYER; ++ph) {
            LAUNCH(k_phase, grid, NT, SMEM_BYTES, stream, p, l, ph);
#ifdef CPU_EMU
            const int code = ph == PH_INPROJ ? 1 : ph == PH_MIXERS ? 2 : ph == PH_MERGE ? 3 : ph == PH_WOUT ? 4 : ph == PH_GATHER ? 5 : 0;
            if (code && g_emu_stop == l * 10 + code) return;
#endif
        }
    LAUNCH(k_phase, grid, NT, SMEM_BYTES, stream, p, 0, (int)PH_FINAL);
#else
    static int grid_blocks = 0;
    if (!grid_blocks) {
        int dev = 0, cus = 0, per_cu = 0;
        (void)hipGetDevice(&dev);
        (void)hipDeviceGetAttribute(&cus, hipDeviceAttributeMultiprocessorCount, dev);
        (void)hipFuncSetAttribute((const void*)k_mega, hipFuncAttributeMaxDynamicSharedMemorySize, (int)SMEM_BYTES);
        (void)hipOccupancyMaxActiveBlocksPerMultiprocessor(&per_cu, k_mega, NT, SMEM_BYTES);
        if (per_cu > 1) per_cu = 1;
        grid_blocks = cus * per_cu;
    }
    void* args[] = {&p};
    hipError_t e = hipLaunchCooperativeKernel((void*)k_mega, dim3(grid_blocks), dim3(NT), args, SMEM_BYTES, stream);
    if (e != hipSuccess) fprintf(stderr, "cooperative launch failed: %s (grid %d)\n", hipGetErrorString(e), grid_blocks);
#endif
}
```

```cpp
#ifndef CPU_EMU
#include <hip/hip_runtime.h>
#include <hip/hip_cooperative_groups.h>
#include <cstdio>
#include <cstdint>
namespace cg = cooperative_groups;
#define DYN_SMEM(name) extern __shared__ __attribute__((aligned(16))) char name[]
#define LAUNCH(kern, grid, block, smem, stream, ...) hipLaunchKernelGGL(kern, dim3(grid), dim3(block), smem, stream, __VA_ARGS__)
#endif

#ifndef CFG_B
#define CFG_B 8
#endif
#ifndef CFG_T
#define CFG_T 2048
#endif
#ifndef MK_MULTI
#define MK_MULTI 0
#endif

namespace {
constexpr int B_ = CFG_B, T_ = CFG_T, M_ = B_ * T_, D_ = 1024, NL_ = 2, NT = 512;
constexpr int INW = 12560;
constexpr int LDZ = 11776;
constexpr int Z_ULRU = 0, Z_GLRU = 1024, Z_Q = 2048, Z_K = 3072, Z_V = 4096, Z_ZG = 5120, Z_RW = 6144, Z_ALPHA = 9472, Z_BETA = 9480;
constexpr int ZN = 9728;
constexpr int C_XN = 9728, C_YC = 10752;
constexpr int C_YA = Z_GLRU, C_YB = Z_ZG;
constexpr int C_GS = Z_Q, C_MG = Z_K;
constexpr int C_QRY = 0;
constexpr int RW_R = 0, RW_K = 1024, RW_V = 2048, RW_WL = 3072, RW_AL = 3136, RW_GL = 3200, RWW = 3328;
constexpr float RMS_EPS = 1e-6f, GN_EPS = 64e-5f;
typedef unsigned short h16_t;

enum { I_X = 0, I_NMIX, I_NFFN, I_NFINAL, I_WIN, I_LCW, I_LCB, I_LWA, I_LBA, I_LWX, I_LBX, I_LLAM, I_GCW, I_GALOG, I_GDT, I_GNW,
       I_RMU, I_RW0, I_RWUP, I_RA0, I_RAUP, I_RGUP, I_RKK, I_RKA, I_RRK, I_RLW, I_RLB, I_MB, I_PL, I_PG, I_PR, I_WOUT, I_PWQ, I_PKEYS, I_PU, I_PV, N_IN };

struct Params {
    const float* in[N_IN];
    float* out;
    char* ws;
};
#ifdef CPU_EMU
typedef const Params* KParams;
#else
typedef const Params __attribute__((address_space(4)))* KParams;
#endif

constexpr size_t al256(size_t x) { return (x + 255) / 256 * 256; }
constexpr size_t OFF_ACT = 0;
constexpr size_t OFF_WT = al256(OFF_ACT + (size_t)M_ * LDZ * 2);
constexpr int WT_IN = 0, WT_MG = ZN, WT_P = WT_MG + 3072, WT_OUT = WT_P + 3072, WT_Q = WT_OUT + 1024, WT_ROWS = WT_Q + 2048;
constexpr size_t OFF_TOPS = al256(OFF_WT + (size_t)NL_ * WT_ROWS * 1024 * 2);
constexpr size_t OFF_TAB = al256(OFF_TOPS + (size_t)M_ * 256 * 4);
constexpr size_t WS_END = OFF_TAB + (M_ == 16384 ? 0 : (size_t)16384 * 2048);
static_assert(CFG_B != 8 || CFG_T != 2048 || WS_END <= (size_t)512 * 1024 * 1024, "workspace budget");
constexpr size_t SMEM_BYTES = 128 * 1024;

#ifdef CPU_EMU
__device__ __forceinline__ int tid_() { return threadIdx.x; }
__device__ __forceinline__ h16_t f2h(float f) { return (h16_t)_cvtss_sh(f, _MM_FROUND_TO_NEAREST_INT); }
__device__ __forceinline__ float h2f(h16_t h) { return _cvtsh_ss(h); }
#else
__device__ __forceinline__ int tid_() { int t = threadIdx.x; asm volatile("" : "+v"(t)); return t; }
__device__ __forceinline__ h16_t f2h(float f) { return __builtin_bit_cast(unsigned short, (_Float16)f); }
__device__ __forceinline__ float h2f(h16_t h) { return (float)__builtin_bit_cast(_Float16, h); }
#endif
__device__ __forceinline__ int bid_() { return (int)blockIdx.x; }

__device__ __forceinline__ float sigmoidf_(float x) { return 1.0f / (1.0f + expf(-x)); }
__device__ __forceinline__ float softplusf_(float x) { return fmaxf(x, 0.0f) + log1pf(expf(-fabsf(x))); }
__device__ __forceinline__ float siluf_(float x) { return x * sigmoidf_(x); }
__device__ __forceinline__ float geluf_(float x) { return 0.5f * x * (1.0f + tanhf(0.7978845608028654f * (x + 0.044715f * x * x * x))); }
__device__ __forceinline__ unsigned pack2h(float a, float b) { return (unsigned)f2h(a) | ((unsigned)f2h(b) << 16); }
__device__ __forceinline__ void store8h(h16_t* p, const float (&v)[8]) {
    uint4 w; w.x = pack2h(v[0], v[1]); w.y = pack2h(v[2], v[3]); w.z = pack2h(v[4], v[5]); w.w = pack2h(v[6], v[7]);
    *(uint4*)p = w;
}
__device__ __forceinline__ void load8h(const h16_t* p, float (&v)[8]) {
    const uint4 w = *(const uint4*)p;
    v[0] = h2f((h16_t)(w.x & 0xffffu)); v[1] = h2f((h16_t)(w.x >> 16)); v[2] = h2f((h16_t)(w.y & 0xffffu)); v[3] = h2f((h16_t)(w.y >> 16));
    v[4] = h2f((h16_t)(w.z & 0xffffu)); v[5] = h2f((h16_t)(w.z >> 16)); v[6] = h2f((h16_t)(w.w & 0xffffu)); v[7] = h2f((h16_t)(w.w >> 16));
}

__device__ __forceinline__ float block_sum512(float v, float* red) {
    const int tid = tid_();
    red[tid] = v;
    __syncthreads();
    if (tid < 32) { float s = 0.f; for (int i = 0; i < 16; ++i) s += red[tid * 16 + i]; red[512 + tid] = s; }
    __syncthreads();
    float tot = 0.f;
    for (int i = 0; i < 32; ++i) tot += red[512 + i];
    __syncthreads();
    return tot;
}

template <bool OUT_F32>
__device__ __forceinline__ void stage_rmsnorm(const float* src, const float* w, void* dst, int ldd, char* smem) {
    float* red = (float*)smem;
    const int tid = tid_();
    for (int row = bid_(); row < M_; row += gridDim.x) {
        const float2 v = *(const float2*)(src + (size_t)row * D_ + tid * 2);
        const float ss = block_sum512(v.x * v.x + v.y * v.y, red);
        const float rstd = rsqrtf(ss * (1.0f / D_) + RMS_EPS);
        const float2 wv = *(const float2*)(w + tid * 2);
        const float o0 = v.x * rstd * wv.x, o1 = v.y * rstd * wv.y;
        if (OUT_F32) {
            float2 o; o.x = o0; o.y = o1;
            *(float2*)((float*)dst + (size_t)row * ldd + tid * 2) = o;
        } else {
            *(unsigned*)((h16_t*)dst + (size_t)row * ldd + tid * 2) = pack2h(o0, o1);
        }
    }
}

__device__ __forceinline__ const float* wt_src(KParams p, int l, int r, int& ld) {
    if (r < ZN) {
        ld = INW;
        int c;
        if (r < 6144) c = r; else if (r < 9472) c = r + 16; else if (r < 9488) c = r - 3328; else return nullptr;
        return p->in[I_WIN] + (size_t)l * 1024 * INW + c;
    }
    r -= ZN;
    if (r < 3072) { ld = INW; return p->in[I_WIN] + (size_t)l * 1024 * INW + 9488 + r; }
    r -= 3072;
    if (r < 3072) { ld = 1024; const int br = r >> 10; return p->in[br == 0 ? I_PL : (br == 1 ? I_PG : I_PR)] + (size_t)l * 1024 * 1024 + (r & 1023); }
    r -= 3072;
    if (r < 1024) { ld = 1024; return p->in[I_WOUT] + (size_t)l * 1024 * 1024 + r; }
    r -= 1024;
    ld = 2048; return p->in[I_PWQ] + (size_t)l * 1024 * 2048 + r;
}
__device__ __forceinline__ void stage_wprep(KParams p, char* smem) {
    float* tile = (float*)smem;
    h16_t* WT = (h16_t*)(p->ws + OFF_WT);
    const int tid = tid_();
    const int ntr = WT_ROWS / 64, total = NL_ * ntr * 16;
    for (int it = bid_(); it < total; it += gridDim.x) {
        const int l = it / (ntr * 16), rem = it % (ntr * 16), rt = rem / 16, kt = rem % 16;
        const int r0 = rt * 64, k0 = kt * 64;
        __syncthreads();
        {
            const int nn = tid & 63;
            int ld = 0; const float* src = wt_src(p, l, r0 + nn, ld);
#pragma unroll
            for (int i = 0; i < 8; ++i) { const int kk = (tid >> 6) + 8 * i; tile[kk * 65 + nn] = src ? src[(size_t)(k0 + kk) * ld] : 0.f; }
        }
        __syncthreads();
        {
            const int r = tid >> 3, kq = (tid & 7) * 8;
            float v[8];
#pragma unroll
            for (int j = 0; j < 8; ++j) v[j] = tile[(kq + j) * 65 + r];
            store8h(WT + ((size_t)l * WT_ROWS + r0 + r) * 1024 + k0 + kq, v);
        }
    }
}

namespace pg8 {
constexpr int BM = 256, BK = 64, HALF = 128, HTB = HALF * BK * 2, STAGE_BYTES = 8 * HTB, NXCD = 8, WGM = 8;
struct Unit { const char* A; const char* B; int pm, pn, kind; };
#ifdef CPU_EMU
struct f32x4 { float d[4]; float& operator[](int i) { return d[i]; } const float& operator[](int i) const { return d[i]; } };
#else
#define PG8_LAS __attribute__((address_space(3)))
typedef _Float16 f16x8 __attribute__((ext_vector_type(8)));
typedef float f32x4 __attribute__((ext_vector_type(4)));
__device__ __forceinline__ int lds_byte(int r, int c) { const int st = (r >> 4) * 2 + (c >> 5), rr = r & 15, cc = c & 31, ob = rr * 64 + cc * 2; return st * 1024 + (ob ^ (((ob >> 9) & 1) << 5)); }
__device__ __forceinline__ void stage_rc(int b, int& R, int& C) { const int st = b / 1024, sb = b % 1024, swz = sb ^ (((sb >> 9) & 1) << 5); R = (st >> 1) * 16 + swz / 64; C = (st & 1) * 32 + (swz % 64) / 2; }
__device__ __forceinline__ int perm32(int rho) { const int n = rho >> 4, i = rho & 15; return 8 * (i >> 2) + 4 * n + (i & 3); }
#endif
__device__ __forceinline__ void tile_of(int L, int nM, int nN, int& pm, int& pn) {
    const int nwg = nM * nN;
    int wgid = L; { const int q = nwg / NXCD, r = nwg % NXCD, xcd = wgid % NXCD, off = wgid / NXCD; wgid = (xcd < r ? xcd * (q + 1) : r * (q + 1) + (xcd - r) * q) + off; }
    const int nig = WGM * nN, gid = wgid / nig, fm = gid * WGM, gsz = (nM - fm) < WGM ? (nM - fm) : WGM;
    pm = fm + ((wgid % nig) % gsz); pn = (wgid % nig) / gsz;
}

template <class Sched, class Epi>
__device__ __forceinline__ void gemm_phase(char* smem, const Sched& S, const Epi& E) {
    constexpr int K = 1024, nt = K / BK;
    constexpr unsigned lda = LDZ, ldb = 1024;
#ifdef CPU_EMU
    const int tid = tid_(), wid = tid >> 6, lane = tid & 63, wr = wid >> 2, wc = wid & 3, fr = lane & 15, fq = lane >> 4;
    Unit u;
    for (int ui = 0; S.next(ui, u); ++ui) {
        f32x4 acc[2][2][4][2];
        for (int ai = 0; ai < 2; ++ai) for (int bj = 0; bj < 2; ++bj) for (int m = 0; m < 4; ++m) for (int n = 0; n < 2; ++n) for (int e = 0; e < 4; ++e) {
            const int r = 128 * ai + 64 * wr + 16 * m + fr, c = 128 * bj + 32 * wc + 8 * fq + 4 * n + e;
            const h16_t* a = (const h16_t*)u.A + (size_t)r * lda; const h16_t* b = (const h16_t*)u.B + (size_t)c * ldb;
            float s = 0.f;
            for (int k = 0; k < K; ++k) s += h2f(a[k]) * h2f(b[k]);
            acc[ai][bj][m][n][e] = s;
        }
        E(acc, u, wr, wc, fr, fq);
    }
    (void)smem; (void)nt;
#else
    PG8_LAS unsigned char* lds = (PG8_LAS unsigned char*)smem;
    const int tid = tid_(), wid = __builtin_amdgcn_readfirstlane(tid >> 6), lane = tid & 63, wr = wid >> 2, wc = wid & 3, fr = lane & 15, fq = lane >> 4;
    unsigned voffA[2], voffB[2];
#pragma unroll
    for (int i = 0; i < 2; ++i) { int R, C; stage_rc(tid * 16 + i * 8192, R, C); const int Rb = (R & ~31) + perm32(R & 31);
        voffA[i] = (unsigned)(R * lda + C) * 2u; voffB[i] = (unsigned)(Rb * ldb + C) * 2u; }
    constexpr size_t kstep = (size_t)(BK * 2);
    constexpr size_t hstepA = (size_t)HALF * lda * 2, hstepB = (size_t)HALF * ldb * 2;
    const unsigned ldsw = (unsigned)wid * 1024u;
    const int aoff = lds_byte(wr * 64 + fr, fq * 8), boff = lds_byte(wc * 32 + fr, fq * 8);
#define PG8_SA(b, h) (((b) * 2 + (h)) * HTB)
#define PG8_SB(b, h) ((4 + (b) * 2 + (h)) * HTB)
#define PG8_STAGE(bufoff, gbase, voff) do { _Pragma("unroll") for (int _i = 0; _i < 2; ++_i) \
        __builtin_amdgcn_global_load_lds((const unsigned*)((const char*)(gbase) + (voff)[_i]), (PG8_LAS unsigned*)(lds + (bufoff) + ldsw + _i * 8192), 16, 0, 0); } while (0)
#define PG8_LDA(dst, b, h) do { _Pragma("unroll") for (int m = 0; m < 4; ++m) _Pragma("unroll") for (int k = 0; k < 2; ++k) dst[m][k] = *(const PG8_LAS f16x8*)(lds + PG8_SA(b, h) + aoff + m * 2048 + k * 1024); } while (0)
#define PG8_LDB(dst, b, h) do { _Pragma("unroll") for (int n = 0; n < 2; ++n) _Pragma("unroll") for (int k = 0; k < 2; ++k) dst[n][k] = *(const PG8_LAS f16x8*)(lds + PG8_SB(b, h) + boff + n * 2048 + k * 1024); } while (0)
#define PG8_MMA(ai, bj, At, Bt) do { __builtin_amdgcn_s_setprio(1); _Pragma("unroll") for (int m = 0; m < 4; ++m) _Pragma("unroll") for (int n = 0; n < 2; ++n) _Pragma("unroll") for (int k = 0; k < 2; ++k) \
        acc[ai][bj][m][n] = __builtin_amdgcn_mfma_f32_16x16x32_f16(Bt[n][k], At[m][k], acc[ai][bj][m][n], 0, 0, 0); __builtin_amdgcn_s_setprio(0); } while (0)
#define PG8_WAIT_V(n) asm volatile("s_waitcnt vmcnt(" #n ")" ::: "memory")
#define PG8_WAIT_L(n) asm volatile("s_waitcnt lgkmcnt(" #n ")" ::: "memory")
#define PG8_BAR __builtin_amdgcn_s_barrier()
#define PG8_SCHED __builtin_amdgcn_sched_barrier(0)
    Unit cur, nxt; int ui = 0;
    if (!S.next(0, cur)) return;
    f32x4 acc[2][2][4][2];
#pragma unroll
    for (int a = 0; a < 2; ++a)
#pragma unroll
        for (int b = 0; b < 2; ++b)
#pragma unroll
            for (int m = 0; m < 4; ++m)
#pragma unroll
                for (int n = 0; n < 2; ++n) acc[a][b][m][n] = (f32x4){0.f, 0.f, 0.f, 0.f};
    f16x8 At[4][2], B0[2][2], B1[2][2];
    const char* cA = cur.A; const char* cB = cur.B;
    PG8_STAGE(PG8_SB(0, 0), cB, voffB); PG8_STAGE(PG8_SA(0, 0), cA, voffA); PG8_STAGE(PG8_SB(0, 1), cB + hstepB, voffB); PG8_STAGE(PG8_SA(0, 1), cA + hstepA, voffA);
    if (wr == 1) PG8_BAR;
    PG8_WAIT_V(4); PG8_BAR;
    PG8_STAGE(PG8_SB(1, 0), cB + kstep, voffB); PG8_STAGE(PG8_SA(1, 0), cA + kstep, voffA); PG8_STAGE(PG8_SB(1, 1), cB + hstepB + kstep, voffB);
    PG8_WAIT_V(6); PG8_BAR;
    for (;;) {
        const bool has_next = S.next(ui + 1, nxt);
        const char* nA = has_next ? nxt.A : cA; const char* nB = has_next ? nxt.B : cB;
#pragma unroll 1
        for (int t = 0; t < nt; t += 2) {
            const bool last = (t == nt - 2);
            const char* a1 = cA + (size_t)(t + 1) * kstep;
            const char* a2 = last ? nA : cA + (size_t)(t + 2) * kstep; const char* b2 = last ? nB : cB + (size_t)(t + 2) * kstep;
            const char* a3 = a2 + kstep; const char* b3 = b2 + kstep;
            PG8_LDB(B0, 0, 0); PG8_SCHED; PG8_LDA(At, 0, 0); PG8_STAGE(PG8_SA(1, 1), a1 + hstepA, voffA);
            PG8_WAIT_L(8); PG8_BAR; PG8_WAIT_L(0); PG8_MMA(0, 0, At, B0); PG8_BAR; PG8_SCHED;
            PG8_LDB(B1, 0, 1); PG8_STAGE(PG8_SB(0, 0), b2, voffB);
            PG8_BAR; PG8_WAIT_L(0); PG8_MMA(0, 1, At, B1); PG8_BAR;
            PG8_LDA(At, 0, 1); PG8_STAGE(PG8_SA(0, 0), a2, voffA);
            PG8_BAR; PG8_WAIT_L(0); PG8_MMA(1, 0, At, B0); PG8_BAR; PG8_SCHED;
            PG8_STAGE(PG8_SB(0, 1), b2 + hstepB, voffB);
            PG8_WAIT_V(6); PG8_BAR; PG8_MMA(1, 1, At, B1); PG8_BAR;
            PG8_LDB(B0, 1, 0); PG8_SCHED; PG8_LDA(At, 1, 0); PG8_STAGE(PG8_SA(0, 1), a2 + hstepA, voffA);
            PG8_WAIT_L(8); PG8_BAR; PG8_WAIT_L(0); PG8_MMA(0, 0, At, B0); PG8_BAR; PG8_SCHED;
            PG8_LDB(B1, 1, 1); PG8_STAGE(PG8_SB(1, 0), b3, voffB);
            PG8_BAR; PG8_WAIT_L(0); PG8_MMA(0, 1, At, B1); PG8_BAR;
            PG8_LDA(At, 1, 1); PG8_STAGE(PG8_SA(1, 0), a3, voffA);
            PG8_BAR; PG8_WAIT_L(0); PG8_MMA(1, 0, At, B0); PG8_BAR; PG8_SCHED;
            PG8_STAGE(PG8_SB(1, 1), b3 + hstepB, voffB);
            PG8_WAIT_V(6); PG8_BAR; PG8_MMA(1, 1, At, B1); PG8_BAR;
        }
        E(acc, cur, wr, wc, fr, fq);
        if (!has_next) break;
#pragma unroll
        for (int a = 0; a < 2; ++a)
#pragma unroll
            for (int b = 0; b < 2; ++b)
#pragma unroll
                for (int m = 0; m < 4; ++m)
#pragma unroll
                    for (int n = 0; n < 2; ++n) acc[a][b][m][n] = (f32x4){0.f, 0.f, 0.f, 0.f};
        cur = nxt; cA = nA; cB = nB; ++ui;
    }
    PG8_WAIT_V(0);
    if (wr == 0) PG8_BAR;
    PG8_BAR;
#undef PG8_SA
#undef PG8_SB
#undef PG8_STAGE
#undef PG8_LDA
#undef PG8_LDB
#undef PG8_MMA
#undef PG8_WAIT_V
#undef PG8_WAIT_L
#undef PG8_BAR
#undef PG8_SCHED
#endif
}
}

enum { GK_STORE = 0, GK_GATE0, GK_GATE1, GK_GATE2, GK_PROJ0, GK_PROJ1, GK_PROJ2, GK_RESID };
enum { GP_INPROJ = 0, GP_MERGE, GP_WOUT, GP_QUERY };
struct GemmProg {
    const char* act; const char* wt;
    int which, G, c;
    __device__ __forceinline__ bool next(int i, pg8::Unit& u) const {
        constexpr int nM = M_ / 256;
        constexpr size_t rowA = (size_t)256 * LDZ * 2, rowB = (size_t)256 * 1024 * 2;
        if (which == GP_MERGE) {
            const int L = (i / 6) * G + c, j = i % 6, br = j >> 1;
            if (L >= nM * 4) return false;
            pg8::tile_of(L, nM, 4, u.pm, u.pn);
            if ((j & 1) == 0) { u.A = act + (size_t)C_XN * 2; u.B = wt + ((size_t)(WT_MG + br * 1024) * 1024) * 2; u.kind = GK_GATE0 + br; }
            else { u.A = act + (size_t)(br == 0 ? C_YA : (br == 1 ? C_YB : C_YC)) * 2; u.B = wt + ((size_t)(WT_P + br * 1024) * 1024) * 2; u.kind = GK_PROJ0 + br; }
        } else {
            const int nN = which == GP_INPROJ ? ZN / 256 : (which == GP_WOUT ? 4 : 8);
            const int L = i * G + c;
            if (L >= nM * nN) return false;
            pg8::tile_of(L, nM, nN, u.pm, u.pn);
            u.A = act + (size_t)(which == GP_WOUT ? C_MG : C_XN) * 2;
            u.B = wt + ((size_t)(which == GP_INPROJ ? WT_IN : (which == GP_WOUT ? WT_OUT : WT_Q)) * 1024) * 2;
            u.kind = which == GP_WOUT ? GK_RESID : GK_STORE;
        }
        u.A += (size_t)u.pm * rowA; u.B += (size_t)u.pn * rowB;
        return true;
    }
};
struct GemmEpi {
    h16_t* act; const float* mb; const float* resid; float* out;
    __device__ __forceinline__ void operator()(const pg8::f32x4 (&acc)[2][2][4][2], const pg8::Unit& u, int wr, int wc, int fr, int fq) const {
        const int row0 = u.pm * 256 + wr * 64 + fr, col0 = u.pn * 256 + wc * 32 + 8 * fq;
#pragma unroll
        for (int ai = 0; ai < 2; ++ai)
#pragma unroll
            for (int m = 0; m < 4; ++m) {
                const int row = row0 + ai * 128 + m * 16;
#pragma unroll
                for (int bj = 0; bj < 2; ++bj) {
                    const int col = col0 + bj * 128;
                    float v[8];
#pragma unroll
                    for (int e = 0; e < 4; ++e) { v[e] = acc[ai][bj][m][0][e]; v[4 + e] = acc[ai][bj][m][1][e]; }
                    h16_t* arow = act + (size_t)row * LDZ;
                    if (u.kind == GK_STORE) {
                        store8h(arow + col, v);
                    } else if (u.kind <= GK_GATE2) {
                        const float* bp = mb + (u.kind - GK_GATE0) * 1024 + col;
                        const float4 b0 = *(const float4*)bp, b1 = *(const float4*)(bp + 4);
                        v[0] = sigmoidf_(v[0] + b0.x); v[1] = sigmoidf_(v[1] + b0.y); v[2] = sigmoidf_(v[2] + b0.z); v[3] = sigmoidf_(v[3] + b0.w);
                        v[4] = sigmoidf_(v[4] + b1.x); v[5] = sigmoidf_(v[5] + b1.y); v[6] = sigmoidf_(v[6] + b1.z); v[7] = sigmoidf_(v[7] + b1.w);
                        store8h(arow + C_GS + col, v);
                    } else if (u.kind <= GK_PROJ2) {
                        float g[8]; load8h(arow + C_GS + col, g);
                        if (u.kind == GK_PROJ0) {
#pragma unroll
                            for (int e = 0; e < 8; ++e) v[e] = g[e] * v[e];
                        } else {
                            float o[8]; load8h(arow + C_MG + col, o);
#pragma unroll
                            for (int e = 0; e < 8; ++e) v[e] = o[e] + g[e] * v[e];
                        }
                        store8h(arow + C_MG + col, v);
                    } else {
                        const size_t o = (size_t)row * 1024 + col;
                        const float4 r0 = *(const float4*)(resid + o), r1 = *(const float4*)(resid + o + 4);
                        *(float4*)(out + o) = make_float4(r0.x + v[0], r0.y + v[1], r0.z + v[2], r0.w + v[3]);
                        *(float4*)(out + o + 4) = make_float4(r1.x + v[4], r1.y + v[5], r1.z + v[6], r1.w + v[7]);
                    }
                }
            }
    }
};
__device__ __forceinline__ void stage_gemm(KParams p, int l, int which, char* smem) {
    GemmProg S; S.act = p->ws + OFF_ACT; S.wt = p->ws + OFF_WT + (size_t)l * WT_ROWS * 1024 * 2; S.which = which; S.G = gridDim.x; S.c = bid_();
    GemmEpi E; E.act = (h16_t*)(p->ws + OFF_ACT); E.mb = p->in[I_MB] + l * 3072; E.resid = l == 0 ? p->in[I_X] : p->out; E.out = p->out;
    pg8::gemm_phase(smem, S, E);
}

#ifdef CPU_EMU
__device__ __forceinline__ float group_sum(float v, int width, float* scratch) {
    const int tid = tid_();
    scratch[tid] = v;
    __syncthreads();
    float s = 0.f; const int base = tid & ~(width - 1);
    for (int i = 0; i < width; ++i) s += scratch[base + i];
    __syncthreads();
    return s;
}
#else
template <int CTRL> __device__ __forceinline__ float dpp_f(float v) { return __builtin_bit_cast(float, __builtin_amdgcn_update_dpp(0, __builtin_bit_cast(int, v), CTRL, 0xf, 0xf, false)); }
__device__ __forceinline__ float group_sum(float v, int width, float*) {
    v += dpp_f<0xB1>(v);
    v += dpp_f<0x4E>(v);
    if (width >= 8) v += dpp_f<0x141>(v);
    if (width >= 16) v += dpp_f<0x140>(v);
    if (width >= 32) v += __shfl_xor(v, 16);
    if (width >= 64) v += __shfl_xor(v, 32);
    return v;
}
#endif
__device__ __forceinline__ uint4 ldg16(const h16_t* p) { return *(const uint4*)p; }
__device__ __forceinline__ uint4 zero16() { uint4 z; z.x = 0u; z.y = 0u; z.z = 0u; z.w = 0u; return z; }

__device__ __forceinline__ void stage_lru(KParams p, int l, char* smem, int vb0, int nvb) {
    const int vb = bid_() - vb0;
    if (vb < 0 || vb >= nvb) return;
    constexpr int CH = 64;
    float* wa_s = (float*)smem;
    float* wx_s = wa_s + 4096;
    float* xcT = wx_s + 4096;
    float* a_s = xcT + 64 * CH;
    float* b_s = a_s + CH * 64;
    h16_t* ru = (h16_t*)(b_s + CH * 64);
    h16_t* rg = ru + (CH + 3) * 64;
    h16_t* ACT = (h16_t*)(p->ws + OFF_ACT);
    const int tid = tid_(), c = tid & 63, tg = tid >> 6;
    for (int item = vb; item < B_ * 16; item += nvb) {
        const int b = item / 16, n = item % 16, ch = n * 64 + c;
        __syncthreads();
        for (int i = tid; i < 4096; i += NT) { wa_s[i] = p->in[I_LWA][((size_t)l * 16 + n) * 4096 + i]; wx_s[i] = p->in[I_LWX][((size_t)l * 16 + n) * 4096 + i]; }
        const float cw0 = p->in[I_LCW][((size_t)l * 4 + 0) * 1024 + ch], cw1 = p->in[I_LCW][((size_t)l * 4 + 1) * 1024 + ch];
        const float cw2 = p->in[I_LCW][((size_t)l * 4 + 2) * 1024 + ch], cw3 = p->in[I_LCW][((size_t)l * 4 + 3) * 1024 + ch];
        const float cb = p->in[I_LCB][l * 1024 + ch], ba = p->in[I_LBA][l * 1024 + ch], bx = p->in[I_LBX][l * 1024 + ch];
        const float sp = softplusf_(-p->in[I_LLAM][l * 1024 + ch]);
        float hst = 0.f;
        uint4 pf[3];
#define LRU_LOAD(t0_) do { _Pragma("unroll") for (int i = 0; i < 3; ++i) { const int j = tid + NT * i; pf[i] = zero16(); \
            if (j < 536) { const int t = (t0_) - 3 + (j >> 3); if (t >= 0) pf[i] = ldg16(ACT + ((size_t)b * T_ + t) * LDZ + Z_ULRU + n * 64 + (j & 7) * 8); } \
            else if (j < 1048) { const int jj = j - 536; pf[i] = ldg16(ACT + ((size_t)b * T_ + (t0_) + (jj >> 3)) * LDZ + Z_GLRU + n * 64 + (jj & 7) * 8); } } } while (0)
#define LRU_PUT() do { _Pragma("unroll") for (int i = 0; i < 3; ++i) { const int j = tid + NT * i; \
            if (j < 536) *(uint4*)(ru + (j >> 3) * 64 + (j & 7) * 8) = pf[i]; else if (j < 1048) *(uint4*)(rg + ((j - 536) >> 3) * 64 + ((j - 536) & 7) * 8) = pf[i]; } } while (0)
        LRU_LOAD(0);
        LRU_PUT();
        __syncthreads();
#pragma unroll 1
        for (int t0 = 0; t0 < T_; t0 += CH) {
            float xc[8];
            {
                float u[11];
#pragma unroll
                for (int s = 0; s < 11; ++s) u[s] = h2f(ru[(tg * 8 + s) * 64 + c]);
#pragma unroll
                for (int s = 0; s < 8; ++s) { xc[s] = cw0 * u[s] + cw1 * u[s + 1] + cw2 * u[s + 2] + cw3 * u[s + 3] + cb; xcT[c * CH + tg * 8 + s] = xc[s]; }
            }
            __syncthreads();
            if (t0 + CH < T_) LRU_LOAD(t0 + CH);
            {
                float dr[8], di[8];
#pragma unroll
                for (int s = 0; s < 8; ++s) { dr[s] = 0.f; di[s] = 0.f; }
#pragma unroll 4
                for (int i = 0; i < 64; ++i) {
                    const float wa = wa_s[i * 64 + c], wx = wx_s[i * 64 + c];
                    const float4 x0 = *(const float4*)(xcT + i * CH + tg * 8), x1 = *(const float4*)(xcT + i * CH + tg * 8 + 4);
                    dr[0] += x0.x * wa; dr[1] += x0.y * wa; dr[2] += x0.z * wa; dr[3] += x0.w * wa; dr[4] += x1.x * wa; dr[5] += x1.y * wa; dr[6] += x1.z * wa; dr[7] += x1.w * wa;
                    di[0] += x0.x * wx; di[1] += x0.y * wx; di[2] += x0.z * wx; di[3] += x0.w * wx; di[4] += x1.x * wx; di[5] += x1.y * wx; di[6] += x1.z * wx; di[7] += x1.w * wx;
                }
#pragma unroll
                for (int s = 0; s < 8; ++s) {
                    const float r = sigmoidf_(dr[s] + ba), ig = sigmoidf_(di[s] + bx);
                    const float log_a = -8.0f * r * sp;
                    a_s[(tg * 8 + s) * 64 + c] = expf(log_a);
                    b_s[(tg * 8 + s) * 64 + c] = sqrtf(-expm1f(2.0f * log_a)) * (ig * xc[s]);
                }
            }
            __syncthreads();
            if (tid < 64) {
#pragma unroll 8
                for (int t = 0; t < CH; ++t) { hst = a_s[t * 64 + c] * hst + b_s[t * 64 + c]; b_s[t * 64 + c] = hst; }
            }
            __syncthreads();
#pragma unroll
            for (int s = 0; s < 8; ++s) { h16_t* gp = rg + (tg * 8 + s) * 64 + c; *gp = f2h(b_s[(tg * 8 + s) * 64 + c] * geluf_(h2f(*gp))); }
            __syncthreads();
            *(uint4*)(ACT + ((size_t)b * T_ + t0 + (tid >> 3)) * LDZ + Z_GLRU + n * 64 + (tid & 7) * 8) = *(const uint4*)(rg + (tid >> 3) * 64 + (tid & 7) * 8);
            __syncthreads();
            if (t0 + CH < T_) LRU_PUT();
            __syncthreads();
        }
#undef LRU_LOAD
#undef LRU_PUT
    }
}

#ifdef CPU_EMU
struct hfrag { h16_t v[8]; };
struct facc { float d[4]; float& operator[](int i) { return d[i]; } const float& operator[](int i) const { return d[i]; } };
__device__ __forceinline__ facc facc_zero() { facc a; a.d[0] = a.d[1] = a.d[2] = a.d[3] = 0.f; return a; }
__device__ __forceinline__ hfrag frag_u4(uint4 w) { hfrag f; memcpy(&f, &w, 16); return f; }
__device__ __forceinline__ hfrag frag_2u2(uint2 lo, uint2 hi) { hfrag f; memcpy(&f.v[0], &lo, 8); memcpy(&f.v[4], &hi, 8); return f; }
__device__ __forceinline__ hfrag frag_mul(hfrag a, hfrag b) { hfrag f; for (int j = 0; j < 8; ++j) f.v[j] = f2h(h2f(a.v[j]) * h2f(b.v[j])); return f; }
__device__ __forceinline__ facc mfma16(hfrag a, hfrag b, facc c) {
    const int tid = tid_(), w = tid >> 6, l = tid & 63;
    unsigned short (*X)[64][16] = emu::ctx->xscr;
    for (int j = 0; j < 8; ++j) { X[w][l][j] = a.v[j]; X[w][l][8 + j] = b.v[j]; }
    __syncthreads();
    for (int reg = 0; reg < 4; ++reg) {
        const int row = 4 * (l >> 4) + reg, col = l & 15;
        float s = 0.f;
        for (int k = 0; k < 32; ++k) s += h2f(X[w][row + 16 * (k >> 3)][k & 7]) * h2f(X[w][col + 16 * (k >> 3)][8 + (k & 7)]);
        c.d[reg] += s;
    }
    __syncthreads();
    return c;
}
#else
typedef _Float16 hfrag __attribute__((ext_vector_type(8)));
typedef float facc __attribute__((ext_vector_type(4)));
__device__ __forceinline__ facc facc_zero() { return (facc){0.f, 0.f, 0.f, 0.f}; }
__device__ __forceinline__ hfrag frag_u4(uint4 w) { return __builtin_bit_cast(hfrag, w); }
__device__ __forceinline__ hfrag frag_2u2(uint2 lo, uint2 hi) { uint4 w; w.x = lo.x; w.y = lo.y; w.z = hi.x; w.w = hi.y; return __builtin_bit_cast(hfrag, w); }
__device__ __forceinline__ hfrag frag_mul(hfrag a, hfrag b) { return a * b; }
__device__ __forceinline__ facc mfma16(hfrag a, hfrag b, facc c) { return __builtin_amdgcn_mfma_f32_16x16x32_f16(a, b, c, 0, 0, 0); }
#endif
__device__ __forceinline__ hfrag frag_pack8(float a0, float a1, float a2, float a3, float a4, float a5, float a6, float a7) {
    uint4 w; w.x = pack2h(a0, a1); w.y = pack2h(a2, a3); w.z = pack2h(a4, a5); w.w = pack2h(a6, a7); return frag_u4(w);
}
__device__ __forceinline__ hfrag frag_acc2(const facc& t0, const facc& t1) { return frag_pack8(t0[0], t0[1], t0[2], t0[3], t1[0], t1[1], t1[2], t1[3]); }
__device__ __forceinline__ hfrag permfrag(const h16_t* rowp, int ks, int g) { return frag_2u2(*(const uint2*)(rowp + 32 * ks + 4 * g), *(const uint2*)(rowp + 32 * ks + 16 + 4 * g)); }

__device__ __forceinline__ void stage_gdn(KParams p, int l, char* smem, int vb0, int nvb) {
    const int vb = bid_() - vb0;
    if (vb < 0 || vb >= nvb) return;
    constexpr int CH = 64, QS = 136, TS = 72, AS = 68;
    h16_t* Qs = (h16_t*)smem;
    h16_t* Ks = Qs + 64 * QS;
    h16_t* Kt = Ks + 64 * QS;
    h16_t* Vt = Kt + 128 * TS;
    float* A32 = (float*)(Vt + 128 * TS);
    h16_t* ob = (h16_t*)A32;
    h16_t* Tu = (h16_t*)(A32 + 64 * AS);
    h16_t* Tw = Tu + 64 * TS;
    h16_t* QKm = Tw + 64 * TS;
    float* gc_s = (float*)(QKm + 64 * TS);
    float* be_s = gc_s + 64;
    float* e1_s = be_s + 64;
    float* part_s = e1_s + 64;
    float* scr = part_s + 512;
    float* cw_s = scr + 512;
    h16_t* ACT = (h16_t*)(p->ws + OFF_ACT);
    int tid = tid_(), lane = tid & 63, w = tid >> 6, g = lane >> 4, r16 = lane & 15;
    int sg = lane >> 4, pc = lane & 15, rb = w;
#define GDN_ROLES() do { tid = tid_(); lane = tid & 63; w = tid >> 6; g = lane >> 4; r16 = lane & 15; sg = g; pc = r16; rb = w; } while (0)
    for (int item = vb; item < B_ * 8; item += nvb) {
        const int b = item / 8, h = item % 8;
        const float a_exp = expf(p->in[I_GALOG][l * 8 + h]), dtb = p->in[I_GDT][l * 8 + h];
        facc S[8];
#pragma unroll
        for (int dt = 0; dt < 8; ++dt) S[dt] = facc_zero();
        __syncthreads();
        for (int i = tid; i < 64 * TS / 2; i += NT) ((unsigned*)QKm)[i] = 0u;
        for (int i = tid; i < 4 * 384; i += NT) { const int jj = i / 384, c3 = i % 384; cw_s[i] = p->in[I_GCW][((size_t)l * 4 + jj) * 3072 + (c3 >> 7) * 1024 + h * 128 + (c3 & 127)]; }
        uint4 pf[11];
#define GDN_LOAD(t0_) do { GDN_ROLES(); const h16_t* colp = ACT + ((size_t)b * T_ + (t0_) + 8 * rb - 3) * LDZ + (sg < 3 ? Z_Q + sg * 1024 : Z_ZG) + h * 128 + pc * 8; \
            _Pragma("unroll") for (int i = 0; i < 11; ++i) { const int t = (t0_) + 8 * rb - 3 + i; pf[i] = (t >= 0 && sg < 3) ? ldg16(colp + (size_t)i * LDZ) : zero16(); } } while (0)
        GDN_LOAD(0);
#pragma unroll 1
        for (int t0 = 0; t0 < T_; t0 += CH) {
            GDN_ROLES();
            if (tid < 64) {
                const size_t m = (size_t)b * T_ + t0 + tid;
                part_s[tid] = -a_exp * softplusf_(h2f(ACT[m * LDZ + Z_ALPHA + h]) + dtb);
                be_s[tid] = sigmoidf_(h2f(ACT[m * LDZ + Z_BETA + h]));
            }
            __syncthreads();
            if (tid < 64) { float s = 0.f; for (int i = 0; i <= tid; ++i) s += part_s[i]; gc_s[tid] = s; }
#pragma unroll
            for (int hf = 0; hf < 2; ++hf) {
                float ov[4][8];
#pragma unroll
                for (int i = 0; i < 4; ++i) {
#pragma unroll
                    for (int cc = 0; cc < 8; ++cc) ov[i][cc] = 0.f;
#pragma unroll
                    for (int jj = 0; jj < 4; ++jj) {
                        const uint4 wv = pf[hf * 4 + i + jj];
                        const float* cwp = cw_s + jj * 384 + (sg < 3 ? sg : 0) * 128 + pc * 8;
                        const float4 c0 = *(const float4*)cwp, c1 = *(const float4*)(cwp + 4);
                        ov[i][0] += c0.x * h2f((h16_t)(wv.x & 0xffffu)); ov[i][1] += c0.y * h2f((h16_t)(wv.x >> 16)); ov[i][2] += c0.z * h2f((h16_t)(wv.y & 0xffffu)); ov[i][3] += c0.w * h2f((h16_t)(wv.y >> 16));
                        ov[i][4] += c1.x * h2f((h16_t)(wv.z & 0xffffu)); ov[i][5] += c1.y * h2f((h16_t)(wv.z >> 16)); ov[i][6] += c1.z * h2f((h16_t)(wv.w & 0xffffu)); ov[i][7] += c1.w * h2f((h16_t)(wv.w >> 16));
                    }
                    float ss = 0.f;
#pragma unroll
                    for (int cc = 0; cc < 8; ++cc) { ov[i][cc] = siluf_(ov[i][cc]); ss += ov[i][cc] * ov[i][cc]; }
                    ss = group_sum(ss, 16, scr);
                    const float rn = sg == 0 ? rsqrtf(ss + RMS_EPS) * 0.08838834764831845f : (sg == 1 ? rsqrtf(ss + RMS_EPS) : 1.0f);
#pragma unroll
                    for (int cc = 0; cc < 8; ++cc) ov[i][cc] *= rn;
                    const int t = 8 * rb + hf * 4 + i;
                    if (sg == 0) store8h(Qs + t * QS + pc * 8, ov[i]);
                    else if (sg == 1) store8h(Ks + t * QS + pc * 8, ov[i]);
                }
                if (sg == 1 || sg == 2) {
                    h16_t* dstT = sg == 1 ? Kt : Vt;
#pragma unroll
                    for (int cc = 0; cc < 8; ++cc) { uint2 w2; w2.x = pack2h(ov[0][cc], ov[1][cc]); w2.y = pack2h(ov[2][cc], ov[3][cc]); *(uint2*)(dstT + (pc * 8 + cc) * TS + 8 * rb + hf * 4) = w2; }
                }
            }
            __syncthreads();
            GDN_ROLES();
            if (tid < 64) e1_s[tid] = expf(gc_s[63] - gc_s[tid]);
            for (int e = tid; e < 64 * 64; e += NT) { const int i = e >> 6, j = e & 63; if ((j >> 4) > (i >> 4)) A32[i * AS + (j & 7) * 8 + (j >> 3)] = 0.f; }
#pragma unroll 1
            for (int jr = 0; jr < 3; ++jr) {
                const int jb = w + 8 * jr; const bool valid = jb < 20;
                const int kind = (valid && jb >= 10) ? 1 : 0, tix = valid ? (jb % 10) : 0;
                const int ti = tix < 1 ? 0 : (tix < 3 ? 1 : (tix < 6 ? 2 : 3)), tj = tix - (ti * (ti + 1)) / 2;
                const h16_t* ap = (kind ? Qs : Ks) + (16 * ti + r16) * QS + 8 * g; const h16_t* bp = Ks + (16 * tj + r16) * QS + 8 * g;
                facc acc = facc_zero();
#pragma unroll
                for (int ks = 0; ks < 4; ++ks) acc = mfma16(frag_u4(*(const uint4*)(ap + 32 * ks)), frag_u4(*(const uint4*)(bp + 32 * ks)), acc);
                if (valid) {
                    const int j = 16 * tj + r16; const float gj = gc_s[j];
#pragma unroll
                    for (int reg = 0; reg < 4; ++reg) {
                        const int i = 16 * ti + 4 * g + reg;
                        const float dec = expf(fminf(gc_s[i] - gj, 0.f));
                        if (kind == 0) A32[i * AS + (j & 7) * 8 + (j >> 3)] = i > j ? be_s[i] * acc[reg] * dec : 0.f;
                        else QKm[i * TS + j] = f2h(i >= j ? acc[reg] * dec : 0.f);
                    }
                }
            }
            __syncthreads();
            GDN_ROLES();
            {
                const int t = tid >> 3, d0 = (tid & 7) * 16; const float eg = expf(gc_s[t]);
                float v8[8];
                load8h(Qs + t * QS + d0, v8);
#pragma unroll
                for (int e = 0; e < 8; ++e) v8[e] *= eg;
                store8h(Qs + t * QS + d0, v8);
                load8h(Qs + t * QS + d0 + 8, v8);
#pragma unroll
                for (int e = 0; e < 8; ++e) v8[e] *= eg;
                store8h(Qs + t * QS + d0 + 8, v8);
            }
            {
                const int c = tid >> 3, q = tid & 7;
                const float bc = be_s[c], bgc = bc * expf(gc_s[c]);
                float x[8];
#pragma unroll
                for (int i = 0; i < 8; ++i) x[i] = 0.f;
#pragma unroll
                for (int r = 0; r < 64; ++r) {
                    float sacc = 0.f;
                    if (r > 0) {
                        const float4 a0 = *(const float4*)(A32 + r * AS + q * 8);
                        sacc = a0.x * x[0];
                        if (r > 8) sacc += a0.y * x[1];
                        if (r > 16) sacc += a0.z * x[2];
                        if (r > 24) sacc += a0.w * x[3];
                        if (r > 32) {
                            const float4 a1 = *(const float4*)(A32 + r * AS + q * 8 + 4);
                            sacc += a1.x * x[4];
                            if (r > 40) sacc += a1.y * x[5];
                            if (r > 48) sacc += a1.z * x[6];
                            if (r > 56) sacc += a1.w * x[7];
                        }
                        sacc = group_sum(sacc, 8, scr);
                    }
                    const float xr = ((r == c) ? 1.f : 0.f) - sacc;
                    if (q == (r & 7)) { x[r >> 3] = xr; Tu[r * TS + c] = f2h(xr * bc); Tw[r * TS + c] = f2h(xr * bgc); }
                }
            }
            __syncthreads();
            GDN_ROLES();
            facc vn[4], aw[4];
#pragma unroll
            for (int tt = 0; tt < 4; ++tt) { vn[tt] = facc_zero(); aw[tt] = facc_zero(); }
#pragma unroll
            for (int tt = 0; tt < 4; ++tt)
#pragma unroll
                for (int ks = 0; ks <= (tt >> 1); ++ks) {
                    const hfrag au = frag_u4(*(const uint4*)(Tu + (16 * tt + r16) * TS + 32 * ks + 8 * g)), aww = frag_u4(*(const uint4*)(Tw + (16 * tt + r16) * TS + 32 * ks + 8 * g));
                    vn[tt] = mfma16(au, frag_u4(*(const uint4*)(Vt + (16 * w + r16) * TS + 32 * ks + 8 * g)), vn[tt]);
                    aw[tt] = mfma16(aww, frag_u4(*(const uint4*)(Kt + (16 * w + r16) * TS + 32 * ks + 8 * g)), aw[tt]);
                }
#pragma unroll
            for (int tt = 0; tt < 4; ++tt)
#pragma unroll
                for (int reg = 0; reg < 4; ++reg) Ks[(16 * tt + 4 * g + reg) * QS + 16 * w + r16] = f2h(-aw[tt][reg]);
            __syncthreads();
            GDN_ROLES();
            h16_t zraw[16];
#pragma unroll
            for (int tt = 0; tt < 4; ++tt)
#pragma unroll
                for (int reg = 0; reg < 4; ++reg) zraw[tt * 4 + reg] = ACT[((size_t)b * T_ + t0 + 16 * tt + 4 * g + reg) * LDZ + Z_ZG + h * 128 + 16 * w + r16];
            hfrag Sb[4];
#pragma unroll
            for (int ks = 0; ks < 4; ++ks) Sb[ks] = frag_acc2(S[2 * ks], S[2 * ks + 1]);
            facc oc[4];
#pragma unroll
            for (int tt = 0; tt < 4; ++tt) {
                oc[tt] = facc_zero();
                const h16_t* wrow = Ks + (16 * tt + r16) * QS; const h16_t* qrow = Qs + (16 * tt + r16) * QS;
#pragma unroll
                for (int ks = 0; ks < 4; ++ks) { vn[tt] = mfma16(permfrag(wrow, ks, g), Sb[ks], vn[tt]); oc[tt] = mfma16(permfrag(qrow, ks, g), Sb[ks], oc[tt]); }
            }
            hfrag VNb[2];
            VNb[0] = frag_acc2(vn[0], vn[1]); VNb[1] = frag_acc2(vn[2], vn[3]);
#pragma unroll
            for (int tt = 0; tt < 4; ++tt)
#pragma unroll
                for (int ks2 = 0; ks2 <= (tt >> 1); ++ks2) oc[tt] = mfma16(permfrag(QKm + (16 * tt + r16) * TS, ks2, g), VNb[ks2], oc[tt]);
            {
                const float egl = expf(gc_s[63]);
                hfrag e1f[2];
#pragma unroll
                for (int ks2 = 0; ks2 < 2; ++ks2) { const float* ep = e1_s + 32 * ks2 + 4 * g; e1f[ks2] = frag_pack8(ep[0], ep[1], ep[2], ep[3], ep[16], ep[17], ep[18], ep[19]); }
#pragma unroll
                for (int dt = 0; dt < 8; ++dt) {
#pragma unroll
                    for (int reg = 0; reg < 4; ++reg) S[dt][reg] *= egl;
#pragma unroll
                    for (int ks2 = 0; ks2 < 2; ++ks2) S[dt] = mfma16(frag_mul(permfrag(Kt + (16 * dt + r16) * TS, ks2, g), e1f[ks2]), VNb[ks2], S[dt]);
                }
            }
            if (t0 + CH < T_) GDN_LOAD(t0 + CH);
            GDN_ROLES();
#pragma unroll
            for (int tt = 0; tt < 4; ++tt)
#pragma unroll
                for (int reg = 0; reg < 4; ++reg) { const float ss = group_sum(oc[tt][reg] * oc[tt][reg], 16, scr); if (r16 == 0) part_s[w * 64 + 16 * tt + 4 * g + reg] = ss; }
            __syncthreads();
            const float nw = p->in[I_GNW][l * 128 + w * 16 + r16];
#pragma unroll
            for (int tt = 0; tt < 4; ++tt)
#pragma unroll
                for (int reg = 0; reg < 4; ++reg) {
                    const int t = 16 * tt + 4 * g + reg;
                    float ms = 0.f;
#pragma unroll
                    for (int ww = 0; ww < 8; ++ww) ms += part_s[ww * 64 + t];
                    ob[t * 128 + 16 * w + r16] = f2h(oc[tt][reg] * rsqrtf(ms * (1.0f / 128.0f) + RMS_EPS) * nw * siluf_(h2f(zraw[tt * 4 + reg])));
                }
            __syncthreads();
            GDN_ROLES();
#pragma unroll
            for (int i = 0; i < 2; ++i) { const int j = tid + NT * i; *(uint4*)(ACT + ((size_t)b * T_ + t0 + (j >> 4)) * LDZ + Z_ZG + h * 128 + (j & 15) * 8) = *(const uint4*)(ob + (j >> 4) * 128 + (j & 15) * 8); }
            __syncthreads();
        }
#undef GDN_LOAD
#undef GDN_ROLES
    }
}

#ifndef CPU_EMU
typedef _Float16 rw_f16x8 __attribute__((ext_vector_type(8)));
typedef float rw_f32x4 __attribute__((ext_vector_type(4)));
#endif
__device__ __forceinline__ void stage_rwkv(KParams p, int l, char* smem, int vb0, int nvb) {
    const int vb = bid_() - vb0;
    if (vb < 0 || vb >= nvb) return;
    constexpr int CH = 32, XS = 264;
    float* r_s = (float*)smem;
    float* k_s = r_s + CH * 64;
    float* v_s = k_s + CH * 64;
    float* w_s = v_s + CH * 64;
    float* kk_s = w_s + CH * 64;
    float* ka_s = kk_s + CH * 64;
    float* g_s = ka_s + CH * 64;
    float* o_s = g_s + CH * 64;
    float* bon_s = o_s + CH * 64;
    float* scr = bon_s + CH;
    h16_t* raw = (h16_t*)(scr + 512);
    h16_t* xs = raw + (CH + 1) * 448;
    h16_t* ACT = (h16_t*)(p->ws + OFF_ACT);
    const int tid = tid_(), c = tid & 63, tg = tid >> 6;
    const int ri = tid >> 3, q8 = tid & 7;
    for (int item = vb; item < B_ * 16; item += nvb) {
        const int b = item / 16, h = item % 16, ch = h * 64 + c;
        const float w0 = p->in[I_RW0][l * 1024 + ch], a0 = p->in[I_RA0][l * 1024 + ch], k_k = p->in[I_RKK][l * 1024 + ch], k_a = p->in[I_RKA][l * 1024 + ch];
        const float rk_c = p->in[I_RRK][(size_t)l * 1024 + ch];
        const float lnw = p->in[I_RLW][l * 1024 + ch], lnb = p->in[I_RLB][l * 1024 + ch];
        const float* mu = p->in[I_RMU] + (size_t)l * RWW;
        const float mu_r = mu[RW_R + ch], mu_k = mu[RW_K + ch], mu_v = mu[RW_V + ch];
        const float mu_wl = mu[RW_WL + c], mu_al = mu[RW_AL + c], mu_g0 = mu[RW_GL + c], mu_g1 = mu[RW_GL + 64 + c];
        const float* wup = p->in[I_RWUP] + (size_t)l * 64 * 1024 + h * 64; const float* aup = p->in[I_RAUP] + (size_t)l * 64 * 1024 + h * 64; const float* gup = p->in[I_RGUP] + (size_t)l * 128 * 1024 + h * 64;
#ifndef CPU_EMU
        const int wid = tid >> 6, lane = tid & 63, mt = wid >> 2, nt = wid & 3;
        rw_f16x8 bw[2], ba_[2], bg[4];
        {
            const int cn = nt * 16 + (lane & 15), kb = 8 * (lane >> 4);
#pragma unroll
            for (int ks = 0; ks < 2; ++ks)
#pragma unroll
                for (int j = 0; j < 8; ++j) { bw[ks][j] = (_Float16)wup[(size_t)(ks * 32 + kb + j) * 1024 + cn]; ba_[ks][j] = (_Float16)aup[(size_t)(ks * 32 + kb + j) * 1024 + cn]; }
#pragma unroll
            for (int ks = 0; ks < 4; ++ks)
#pragma unroll
                for (int j = 0; j < 8; ++j) bg[ks][j] = (_Float16)gup[(size_t)(ks * 32 + kb + j) * 1024 + cn];
        }
#endif
        float S[8];
#pragma unroll
        for (int e = 0; e < 8; ++e) S[e] = 0.f;
        uint4 pf[4];
#define RW_LOAD(t0_) do { _Pragma("unroll") for (int i = 0; i < 4; ++i) { const int j = tid + NT * i, row = j / 56, u = j % 56, t = (t0_) - 1 + row; pf[i] = zero16(); \
            if (j < (CH + 1) * 56 && t >= 0) pf[i] = ldg16(ACT + ((size_t)b * T_ + t) * LDZ + Z_RW + (u < 24 ? (u >> 3) * 1024 + h * 64 + (u & 7) * 8 : 3072 + (u - 24) * 8)); } } while (0)
#define RW_PUT() do { _Pragma("unroll") for (int i = 0; i < 4; ++i) { const int j = tid + NT * i; if (j < (CH + 1) * 56) *(uint4*)(raw + (j / 56) * 448 + (j % 56) * 8) = pf[i]; } } while (0)
        __syncthreads();
        RW_LOAD(0);
        RW_PUT();
        __syncthreads();
#pragma unroll 1
        for (int t0 = 0; t0 < T_; t0 += CH) {
#pragma unroll
            for (int s = 0; s < 4; ++s) {
                const int tl = tg * 4 + s;
                const h16_t* zc = raw + (tl + 1) * 448; const h16_t* zp = raw + tl * 448;
#define RW_SHIFT(col, muv) ({ const float zz = h2f(zc[col]); zz + (muv) * (h2f(zp[col]) - zz); })
                r_s[tl * 64 + c] = RW_SHIFT(c, mu_r);
                k_s[tl * 64 + c] = RW_SHIFT(64 + c, mu_k);
                v_s[tl * 64 + c] = RW_SHIFT(128 + c, mu_v);
                xs[tl * XS + c] = f2h(tanhf(RW_SHIFT(192 + c, mu_wl)));
                xs[tl * XS + 64 + c] = f2h(RW_SHIFT(256 + c, mu_al));
                xs[tl * XS + 128 + c] = f2h(sigmoidf_(RW_SHIFT(320 + c, mu_g0)));
                xs[tl * XS + 192 + c] = f2h(sigmoidf_(RW_SHIFT(384 + c, mu_g1)));
#undef RW_SHIFT
            }
            __syncthreads();
            if (t0 + CH < T_) RW_LOAD(t0 + CH);
#ifdef CPU_EMU
#pragma unroll
            for (int s = 0; s < 4; ++s) {
                const int tl = tg * 4 + s;
                float dw = 0.f, da = 0.f, dg = 0.f;
                for (int i = 0; i < 64; ++i) { dw += h2f(xs[tl * XS + i]) * h2f(f2h(wup[(size_t)i * 1024 + c])); da += h2f(xs[tl * XS + 64 + i]) * h2f(f2h(aup[(size_t)i * 1024 + c])); }
                for (int i = 0; i < 128; ++i) dg += h2f(xs[tl * XS + 128 + i]) * h2f(f2h(gup[(size_t)i * 1024 + c]));
                w_s[tl * 64 + c] = dw; ka_s[tl * 64 + c] = da; g_s[tl * 64 + c] = dg;
            }
#else
            {
                const h16_t* ap = xs + (mt * 16 + (lane & 15)) * XS + 8 * (lane >> 4);
                rw_f32x4 dw = {0.f, 0.f, 0.f, 0.f}, da = {0.f, 0.f, 0.f, 0.f}, dg = {0.f, 0.f, 0.f, 0.f};
#pragma unroll
                for (int ks = 0; ks < 2; ++ks) {
                    dw = __builtin_amdgcn_mfma_f32_16x16x32_f16(*(const rw_f16x8*)(ap + ks * 32), bw[ks], dw, 0, 0, 0);
                    da = __builtin_amdgcn_mfma_f32_16x16x32_f16(*(const rw_f16x8*)(ap + 64 + ks * 32), ba_[ks], da, 0, 0, 0);
                }
#pragma unroll
                for (int ks = 0; ks < 4; ++ks) dg = __builtin_amdgcn_mfma_f32_16x16x32_f16(*(const rw_f16x8*)(ap + 128 + ks * 32), bg[ks], dg, 0, 0, 0);
#pragma unroll
                for (int rg = 0; rg < 4; ++rg) { const int o = (mt * 16 + 4 * (lane >> 4) + rg) * 64 + nt * 16 + (lane & 15); w_s[o] = dw[rg]; ka_s[o] = da[rg]; g_s[o] = dg[rg]; }
            }
#endif
            __syncthreads();
#pragma unroll
            for (int s = 0; s < 4; ++s) {
                const int tl = tg * 4 + s;
                const float w_log = -softplusf_(-(w0 + w_s[tl * 64 + c])) - 0.5f;
                const float decay = expf(-expf(w_log));
                const float a = sigmoidf_(a0 + ka_s[tl * 64 + c]);
                const float kx = k_s[tl * 64 + c], rx = r_s[tl * 64 + c];
                const float kkr = kx * k_k, k2 = kx * (1.0f + (a - 1.0f) * k_a);
                const float nsq = group_sum(kkr * kkr, 64, scr);
                const float bon = group_sum(rx * k2 * rk_c, 64, scr);
                const float kkn = kkr * rsqrtf(nsq + RMS_EPS);
                w_s[tl * 64 + c] = decay; k_s[tl * 64 + c] = k2; kk_s[tl * 64 + c] = kkn; ka_s[tl * 64 + c] = kkn * a;
                if (c == 0) bon_s[tl] = bon;
            }
            __syncthreads();
#pragma unroll 1
            for (int t = 0; t < CH; ++t) {
                const int o8 = t * 64 + q8 * 8;
                const float4 kk0 = *(const float4*)(kk_s + o8), kk1 = *(const float4*)(kk_s + o8 + 4);
                const float pk = (S[0] * kk0.x + S[1] * kk0.y) + (S[2] * kk0.z + S[3] * kk0.w) + ((S[4] * kk1.x + S[5] * kk1.y) + (S[6] * kk1.z + S[7] * kk1.w));
                const float skk = group_sum(pk, 8, scr);
                const float vi = v_s[t * 64 + ri];
                const float4 w0v = *(const float4*)(w_s + o8), w1v = *(const float4*)(w_s + o8 + 4);
                const float4 a0v = *(const float4*)(ka_s + o8), a1v = *(const float4*)(ka_s + o8 + 4);
                const float4 k0v = *(const float4*)(k_s + o8), k1v = *(const float4*)(k_s + o8 + 4);
                const float4 r0v = *(const float4*)(r_s + o8), r1v = *(const float4*)(r_s + o8 + 4);
                S[0] = S[0] * w0v.x - skk * a0v.x + vi * k0v.x; S[1] = S[1] * w0v.y - skk * a0v.y + vi * k0v.y; S[2] = S[2] * w0v.z - skk * a0v.z + vi * k0v.z; S[3] = S[3] * w0v.w - skk * a0v.w + vi * k0v.w;
                S[4] = S[4] * w1v.x - skk * a1v.x + vi * k1v.x; S[5] = S[5] * w1v.y - skk * a1v.y + vi * k1v.y; S[6] = S[6] * w1v.z - skk * a1v.z + vi * k1v.z; S[7] = S[7] * w1v.w - skk * a1v.w + vi * k1v.w;
                const float po = (S[0] * r0v.x + S[1] * r0v.y) + (S[2] * r0v.z + S[3] * r0v.w) + ((S[4] * r1v.x + S[5] * r1v.y) + (S[6] * r1v.z + S[7] * r1v.w));
                const float o = group_sum(po, 8, scr);
                if (q8 == 0) o_s[t * 64 + ri] = o;
            }
            __syncthreads();
#pragma unroll
            for (int s = 0; s < 4; ++s) {
                const int tl = tg * 4 + s;
                const float ov = o_s[tl * 64 + c];
                const float mean = group_sum(ov, 64, scr) * (1.0f / 64.0f);
                const float d = ov - mean;
                const float var = group_sum(d * d, 64, scr) * (1.0f / 64.0f);
                const float y = (d * rsqrtf(var + GN_EPS) * lnw + lnb + bon_s[tl] * v_s[tl * 64 + c]) * g_s[tl * 64 + c];
                ACT[((size_t)b * T_ + t0 + tl) * LDZ + C_YC + ch] = f2h(y);
            }
            __syncthreads();
            if (t0 + CH < T_) RW_PUT();
            __syncthreads();
        }
#undef RW_LOAD
#undef RW_PUT
    }
}

constexpr bool TAB_IN_ACT = (M_ == 16384);
constexpr float TAB_SU = 256.0f, TAB_SV = 32.0f;
__device__ __forceinline__ unsigned char* tab_row(char* ws, int e) {
    if (TAB_IN_ACT) return (unsigned char*)((h16_t*)(ws + OFF_ACT) + (size_t)e * LDZ + C_GS);
    return (unsigned char*)(ws + OFF_TAB) + (size_t)e * 2048;
}
#ifdef CPU_EMU
__device__ __forceinline__ unsigned f2fp8(float f) {
    const unsigned sgn = f < 0.f ? 0x80u : 0u; float a = fabsf(f);
    if (!(a == a)) return 0x7fu;
    if (a >= 448.0f) return sgn | 0x7eu;
    if (a < 0.0009765625f) return sgn;
    int e; frexpf(a, &e); e -= 1;
    if (e < -6) { const float q = nearbyintf(a * 512.0f); return sgn | (unsigned)q; }
    float q = nearbyintf((a / ldexpf(1.0f, e) - 1.0f) * 8.0f);
    if (q >= 8.0f) { q = 0.f; e += 1; }
    if (e > 8) return sgn | 0x7eu;
    const unsigned r = ((unsigned)(e + 7) << 3) | (unsigned)q;
    return sgn | (r > 0x7eu ? 0x7eu : r);
}
__device__ __forceinline__ float fp82f(unsigned b) {
    const unsigned e = (b >> 3) & 15u, m = b & 7u; const float s = (b & 0x80u) ? -1.f : 1.f;
    if (e == 0) return s * (float)m * 0.001953125f;
    return s * ldexpf(1.0f + (float)m * 0.125f, (int)e - 7);
}
__device__ __forceinline__ unsigned pack4fp8(float a, float b, float c, float d) { return f2fp8(a) | (f2fp8(b) << 8) | (f2fp8(c) << 16) | (f2fp8(d) << 24); }
__device__ __forceinline__ void dec4fp8(unsigned w, float* o) { o[0] = fp82f(w & 255u); o[1] = fp82f((w >> 8) & 255u); o[2] = fp82f((w >> 16) & 255u); o[3] = fp82f(w >> 24); }
#else
__device__ __forceinline__ unsigned pack4fp8(float a, float b, float c, float d) { int p = __builtin_amdgcn_cvt_pk_fp8_f32(a, b, 0, false); p = __builtin_amdgcn_cvt_pk_fp8_f32(c, d, p, true); return (unsigned)p; }
__device__ __forceinline__ void dec4fp8(unsigned w, float* o) { const auto lo = __builtin_amdgcn_cvt_pk_f32_fp8((int)w, false); const auto hi = __builtin_amdgcn_cvt_pk_f32_fp8((int)w, true); o[0] = lo[0]; o[1] = lo[1]; o[2] = hi[0]; o[3] = hi[1]; }
#endif
__device__ __forceinline__ void stage_tabconv(KParams p, int l) {
    const int tid = tid_();
    const float* U = p->in[I_PU] + (size_t)l * 16384 * 1024; const float* V = p->in[I_PV] + (size_t)l * 16384 * 1024;
    char* ws = p->ws;
    for (int it = bid_() * NT + tid; it < 16384 * 128; it += gridDim.x * NT) {
        const int r = it >> 7, ck = it & 127, which = ck >> 6, c16 = ck & 63;
        const float* src = (which ? V : U) + (size_t)r * 1024 + c16 * 16;
        const float sc = which ? TAB_SV : TAB_SU;
        const float4 a = *(const float4*)src, b = *(const float4*)(src + 4), c = *(const float4*)(src + 8), d = *(const float4*)(src + 12);
        uint4 w;
        w.x = pack4fp8(a.x * sc, a.y * sc, a.z * sc, a.w * sc); w.y = pack4fp8(b.x * sc, b.y * sc, b.z * sc, b.w * sc);
        w.z = pack4fp8(c.x * sc, c.y * sc, c.z * sc, c.w * sc); w.w = pack4fp8(d.x * sc, d.y * sc, d.z * sc, d.w * sc);
        *(uint4*)(tab_row(ws, r) + which * 1024 + c16 * 16) = w;
    }
}

__device__ __forceinline__ void stage_peer_topk(KParams p, int l, char* smem) {
    float* key_s = (float*)smem;
    const h16_t* ACT = (const h16_t*)(p->ws + OFF_ACT);
    float* TOPS = (float*)(p->ws + OFF_TOPS);
    const int tid = tid_();
    const int nb = gridDim.x;
    for (int hs = bid_() % 16; hs < 16; hs += nb) {
        const int hd = hs >> 1, s = hs & 1;
        __syncthreads();
        {
            const float* kp = p->in[I_PKEYS] + (((size_t)l * 8 + hd) * 2 + s) * 128 * 128;
            for (int i = tid * 4; i < 128 * 128; i += NT * 4) *(float4*)(key_s + i) = *(const float4*)(kp + i);
        }
        __syncthreads();
        const int nblk = nb >= 16 ? nb / 16 : 1, bsub = nb >= 16 ? bid_() / 16 : 0;
        for (int chunk = bsub; chunk < (M_ + NT - 1) / NT; chunk += nblk) {
            if (nb >= 16 && bid_() >= nblk * 16) break;
            const int m = chunk * NT + tid;
            if (m >= M_) continue;
            float q[128];
            {
                const h16_t* qp = ACT + (size_t)m * LDZ + C_QRY + hd * 256 + s * 128;
#pragma unroll
                for (int c8 = 0; c8 < 16; ++c8) { float t8[8]; load8h(qp + c8 * 8, t8);
#pragma unroll
                    for (int j = 0; j < 8; ++j) q[c8 * 8 + j] = t8[j]; }
            }
            float top[16];
#pragma unroll
            for (int i = 0; i < 16; ++i) top[i] = -3.0e38f;
#pragma unroll 2
            for (int n = 0; n < 128; ++n) {
                const float* kr = key_s + n * 128;
                float a0 = 0.f, a1 = 0.f, a2 = 0.f, a3 = 0.f;
#pragma unroll
                for (int c4 = 0; c4 < 32; ++c4) {
                    const float4 kv = *(const float4*)(kr + c4 * 4);
                    a0 += q[c4 * 4] * kv.x; a1 += q[c4 * 4 + 1] * kv.y; a2 += q[c4 * 4 + 2] * kv.z; a3 += q[c4 * 4 + 3] * kv.w;
                }
                float x = __uint_as_float((__float_as_uint((a0 + a1) + (a2 + a3)) & ~127u) | (unsigned)(127 - n));
#pragma unroll
                for (int i = 0; i < 16; ++i) { const float hi = fmaxf(top[i], x); x = fminf(top[i], x); top[i] = hi; }
            }
            float* tp = TOPS + (((size_t)m * 8 + hd) * 2 + s) * 16;
#pragma unroll
            for (int i = 0; i < 16; i += 4) *(float4*)(tp + i) = make_float4(top[i], top[i + 1], top[i + 2], top[i + 3]);
        }
    }
}

__device__ __forceinline__ void peer_cand(int k, int& i, int& j) {
    if (k < 16) { i = 0; j = k; } else if (k < 24) { i = 1; j = k - 16; } else if (k < 29) { i = 2; j = k - 24; } else if (k < 33) { i = 3; j = k - 29; }
    else if (k < 36) { i = 4; j = k - 33; } else if (k < 38) { i = 5; j = k - 36; } else if (k < 40) { i = 6; j = k - 38; } else if (k < 42) { i = 7; j = k - 40; }
    else { i = k - 34; j = 0; }
}
__device__ __forceinline__ float dot16q(const uint4 a, const float (&x)[16]) {
    float t[4], s0, s1;
    dec4fp8(a.x, t); s0 = t[0] * x[0] + t[1] * x[1]; s1 = t[2] * x[2] + t[3] * x[3];
    dec4fp8(a.y, t); s0 += t[0] * x[4] + t[1] * x[5]; s1 += t[2] * x[6] + t[3] * x[7];
    dec4fp8(a.z, t); s0 += t[0] * x[8] + t[1] * x[9]; s1 += t[2] * x[10] + t[3] * x[11];
    dec4fp8(a.w, t); s0 += t[0] * x[12] + t[1] * x[13]; s1 += t[2] * x[14] + t[3] * x[15];
    return s0 + s1;
}
__device__ __forceinline__ void axpy16q(const uint4 a, float s, float (&y)[16]) {
    float t[4];
    dec4fp8(a.x, t); y[0] += s * t[0]; y[1] += s * t[1]; y[2] += s * t[2]; y[3] += s * t[3];
    dec4fp8(a.y, t); y[4] += s * t[0]; y[5] += s * t[1]; y[6] += s * t[2]; y[7] += s * t[3];
    dec4fp8(a.z, t); y[8] += s * t[0]; y[9] += s * t[1]; y[10] += s * t[2]; y[11] += s * t[3];
    dec4fp8(a.w, t); y[12] += s * t[0]; y[13] += s * t[1]; y[14] += s * t[2]; y[15] += s * t[3];
}
#ifdef CPU_EMU
__device__ __forceinline__ float lane_xor(float v, int mask, float* scr) { const int tid = tid_(); scr[tid] = v; __syncthreads(); const float r = scr[tid ^ mask]; __syncthreads(); return r; }
__device__ __forceinline__ float lane_bcast(float v, int src, float* scr) { const int tid = tid_(); scr[tid] = v; __syncthreads(); const float r = scr[(tid & ~63) + src]; __syncthreads(); return r; }
#else
__device__ __forceinline__ float lane_xor(float v, int mask, float*) { return mask == 1 ? dpp_f<0xB1>(v) : (mask == 2 ? dpp_f<0x4E>(v) : __shfl_xor(v, mask)); }
__device__ __forceinline__ float lane_bcast(float v, int src, float*) { return __builtin_bit_cast(float, __builtin_amdgcn_readlane(__builtin_bit_cast(int, v), src)); }
#endif
__device__ __forceinline__ float reduce8(const float (&v)[8], int lane, float* scr) {
    const bool b0 = lane & 1, b1 = lane & 2, b2 = lane & 4;
    float w4[4], u2[2];
#pragma unroll
    for (int j = 0; j < 4; ++j) { const float keep = b0 ? v[2 * j + 1] : v[2 * j], send = b0 ? v[2 * j] : v[2 * j + 1]; w4[j] = keep + lane_xor(send, 1, scr); }
#pragma unroll
    for (int j = 0; j < 2; ++j) { const float keep = b1 ? w4[2 * j + 1] : w4[2 * j], send = b1 ? w4[2 * j] : w4[2 * j + 1]; u2[j] = keep + lane_xor(send, 2, scr); }
    float z = (b2 ? u2[1] : u2[0]) + lane_xor(b2 ? u2[0] : u2[1], 4, scr);
    z += lane_xor(z, 8, scr); z += lane_xor(z, 16, scr); z += lane_xor(z, 32, scr);
    return z;
}
__device__ __forceinline__ void stage_peer_gather(KParams p, int l, char* smem) {
    int tid = tid_(), w = tid >> 6, lane = tid & 63;
    float* base; float* tops_s; float* cand_s; float* best_s; int* idx_s; float* gate_s; int* pos_s;
#define PG_ROLES() do { tid = tid_(); w = tid >> 6; lane = tid & 63; base = (float*)smem + w * 2048; tops_s = base; cand_s = tops_s + 256; best_s = cand_s + 64; \
        idx_s = (int*)(best_s + 128); gate_s = (float*)(idx_s + 128); pos_s = (int*)(gate_s + 128); } while (0)
    PG_ROLES();
    float* scr = (float*)smem + 8 * 2048;
    h16_t* ACT = (h16_t*)(p->ws + OFF_ACT);
    const float* TOPS = (const float*)(p->ws + OFF_TOPS);
    char* ws = p->ws;
    const float* nxt_w = (l + 1 < NL_) ? p->in[I_NMIX] + (l + 1) * 1024 : p->in[I_NFINAL];
    const int nwaves = gridDim.x * 8;
    for (int m = bid_() * 8 + w; m < M_; m += nwaves) {
        PG_ROLES();
        __syncthreads();
        *(float4*)(tops_s + lane * 4) = *(const float4*)(TOPS + (size_t)m * 256 + lane * 4);
        float x[16];
        { float t8[8]; load8h(ACT + (size_t)m * LDZ + C_XN + lane * 16, t8);
#pragma unroll
          for (int j = 0; j < 8; ++j) x[j] = t8[j];
          load8h(ACT + (size_t)m * LDZ + C_XN + lane * 16 + 8, t8);
#pragma unroll
          for (int j = 0; j < 8; ++j) x[8 + j] = t8[j]; }
        __syncthreads();
        int ci = 0, cj = 0;
        if (lane < 50) peer_cand(lane, ci, cj);
        const int pos = ci * 16 + cj;
        pos_s[lane] = pos;
#pragma unroll 1
        for (int hd = 0; hd < 8; ++hd) {
            const float cs = lane < 50 ? tops_s[hd * 32 + ci] + tops_s[hd * 32 + 16 + cj] : -3.0e38f;
            cand_s[lane] = cs;
            __syncthreads();
            if (lane < 50) {
                int cnt = 0;
#pragma unroll 10
                for (int o = 0; o < 50; ++o) { const float ov = cand_s[o]; cnt += (ov > cs || (ov == cs && pos_s[o] < pos)) ? 1 : 0; }
                if (cnt < 16) {
                    best_s[hd * 16 + cnt] = cs;
                    const int n0 = 127 - (int)(__float_as_uint(tops_s[hd * 32 + ci]) & 127u), n1 = 127 - (int)(__float_as_uint(tops_s[hd * 32 + 16 + cj]) & 127u);
                    idx_s[hd * 16 + cnt] = n0 * 128 + n1;
                }
            }
            __syncthreads();
        }
#pragma unroll
        for (int rr = 0; rr < 2; ++rr) {
            const int e = lane + 64 * rr, hd = e >> 4;
            const float mx = best_s[hd * 16];
            float sum = 0.f;
#pragma unroll
            for (int i = 0; i < 16; ++i) sum += expf(best_s[hd * 16 + i] - mx);
            gate_s[e] = expf(best_s[e] - mx) / sum;
        }
        __syncthreads();
        float y[16];
#pragma unroll
        for (int i = 0; i < 16; ++i) y[i] = 0.f;
        PG_ROLES();
        uint4 uu[8], vv[8];
#define PG_LOADU(eb_) do { _Pragma("unroll") for (int k = 0; k < 8; ++k) uu[k] = *(const uint4*)(tab_row(ws, idx_s[(eb_) + k]) + lane * 16); } while (0)
#define PG_LOADV(eb_) do { _Pragma("unroll") for (int k = 0; k < 8; ++k) vv[k] = *(const uint4*)(tab_row(ws, idx_s[(eb_) + k]) + 1024 + lane * 16); } while (0)
        PG_LOADU(0); PG_LOADV(0);
#pragma unroll 1
        for (int eb = 0; eb < 128; eb += 8) {
            float d8[8];
#pragma unroll
            for (int k = 0; k < 8; ++k) d8[k] = dot16q(uu[k], x);
            if (eb + 8 < 128) PG_LOADU(eb + 8);
            const float tot = reduce8(d8, lane, scr);
            const float hk = gate_s[eb + (lane & 7)] * geluf_(tot * (1.0f / TAB_SU));
#pragma unroll
            for (int k = 0; k < 8; ++k) axpy16q(vv[k], lane_bcast(hk, k, scr), y);
            if (eb + 8 < 128) PG_LOADV(eb + 8);
        }
#undef PG_LOADU
#undef PG_LOADV
        PG_ROLES();
        float* op = p->out + (size_t)m * 1024 + lane * 16;
        float hn[16]; float ss = 0.f;
#pragma unroll
        for (int i = 0; i < 16; i += 4) {
            const float4 o4 = *(const float4*)(op + i);
            hn[i] = o4.x + y[i] * (1.0f / TAB_SV); hn[i + 1] = o4.y + y[i + 1] * (1.0f / TAB_SV); hn[i + 2] = o4.z + y[i + 2] * (1.0f / TAB_SV); hn[i + 3] = o4.w + y[i + 3] * (1.0f / TAB_SV);
            ss += hn[i] * hn[i] + hn[i + 1] * hn[i + 1] + hn[i + 2] * hn[i + 2] + hn[i + 3] * hn[i + 3];
        }
        ss = group_sum(ss, 64, scr);
        const float rstd = rsqrtf(ss * (1.0f / D_) + RMS_EPS);
        float nv[16];
#pragma unroll
        for (int i = 0; i < 16; i += 4) { const float4 w4 = *(const float4*)(nxt_w + lane * 16 + i); nv[i] = hn[i] * rstd * w4.x; nv[i + 1] = hn[i + 1] * rstd * w4.y; nv[i + 2] = hn[i + 2] * rstd * w4.z; nv[i + 3] = hn[i + 3] * rstd * w4.w; }
        if (l + 1 < NL_) {
#pragma unroll
            for (int i = 0; i < 16; i += 4) *(float4*)(op + i) = make_float4(hn[i], hn[i + 1], hn[i + 2], hn[i + 3]);
            const float n0[8] = {nv[0], nv[1], nv[2], nv[3], nv[4], nv[5], nv[6], nv[7]}, n1[8] = {nv[8], nv[9], nv[10], nv[11], nv[12], nv[13], nv[14], nv[15]};
            store8h(ACT + (size_t)m * LDZ + C_XN + lane * 16, n0); store8h(ACT + (size_t)m * LDZ + C_XN + lane * 16 + 8, n1);
        } else {
#pragma unroll
            for (int i = 0; i < 16; i += 4) *(float4*)(op + i) = make_float4(nv[i], nv[i + 1], nv[i + 2], nv[i + 3]);
        }
    }
}
#undef PG_ROLES

enum { PH_NORM_MIX = 0, PH_INPROJ, PH_MIXERS, PH_MERGE, PH_WOUT, PH_NORM_FFN, PH_QUERY, PH_TOPK, PH_GATHER, PH_PER_LAYER, PH_FINAL = 100, PH_WPREP = 101 };
__device__ __forceinline__ void run_phase(KParams p, int l, int ph, char* smem) {
    h16_t* ACT = (h16_t*)(p->ws + OFF_ACT);
    const float* hin = l == 0 ? p->in[I_X] : p->out;
    switch (ph) {
    case PH_WPREP: stage_wprep(p, smem); break;
    case PH_NORM_MIX: if (l == 0) stage_rmsnorm<false>(hin, p->in[I_NMIX] + l * 1024, ACT + C_XN, LDZ, smem); break;
    case PH_INPROJ: stage_gemm(p, l, GP_INPROJ, smem); break;
    case PH_MIXERS: {
        const int nb = gridDim.x, n_rw = nb / 2, n_gd = nb / 4, n_lr = nb - n_rw - n_gd;
        stage_rwkv(p, l, smem, 0, n_rw);
        stage_gdn(p, l, smem, n_rw, n_gd);
        stage_lru(p, l, smem, n_rw + n_gd, n_lr);
    } break;
    case PH_MERGE: stage_gemm(p, l, GP_MERGE, smem); break;
    case PH_WOUT: stage_gemm(p, l, GP_WOUT, smem); break;
    case PH_NORM_FFN: stage_rmsnorm<false>(p->out, p->in[I_NFFN] + l * 1024, ACT + C_XN, LDZ, smem); stage_tabconv(p, l); break;
    case PH_QUERY: stage_gemm(p, l, GP_QUERY, smem); break;
    case PH_TOPK: stage_peer_topk(p, l, smem); break;
    case PH_GATHER: stage_peer_gather(p, l, smem); break;
    case PH_FINAL: break;
    default: break;
    }
}

#if !defined(CPU_EMU) && !MK_MULTI
__global__ void __launch_bounds__(512, 2) k_mega(Params p_) {
    DYN_SMEM(smem);
    KParams pk = (KParams)__builtin_amdgcn_kernarg_segment_ptr();
    cg::grid_group grid = cg::this_grid();
    constexpr int NIT = NL_ * PH_PER_LAYER;
#pragma unroll 1
    for (int it = -1; it <= NIT; ++it) {
        const int l = (it >= 0 && it < NIT) ? it / PH_PER_LAYER : 0, ph = it < 0 ? (int)PH_WPREP : (it < NIT ? it % PH_PER_LAYER : (int)PH_FINAL);
        KParams q = pk; asm volatile("" : "+s"(q));
        run_phase(q, l, ph, smem);
        if (it >= 0 && it < NIT - 1 && !(l > 0 && ph == PH_NORM_MIX)) grid.sync();
    }
}
#endif
#ifdef CPU_EMU
__global__ void k_phase(Params p_, int l, int ph) { DYN_SMEM(smem); run_phase(&p_, l, ph, smem); }
#elif MK_MULTI
__global__ void __launch_bounds__(512, 2) k_phase(Params p_, int l, int ph) { DYN_SMEM(smem); KParams pk = (KParams)__builtin_amdgcn_kernarg_segment_ptr(); run_phase(pk, l, ph, smem); }
#endif
}

#ifdef CPU_EMU
int g_emu_stop = 1000;
#endif

extern "C" void kernel_launch(void* const* d_in, const int* in_sizes, int n_in, void* d_out, int out_size, void* d_ws, size_t ws_size, hipStream_t stream) {
    Params p{};
    for (int i = 0; i < N_IN; ++i) p.in[i] = (const float*)d_in[i];
    p.out = (float*)d_out; p.ws = (char*)d_ws;
#if defined(CPU_EMU) || MK_MULTI
    const int grid = 256;
    LAUNCH(k_phase, grid, NT, SMEM_BYTES, stream, p, 0, (int)PH_WPREP);
    for (int l = 0; l < NL_; ++l)
        for (int ph = 0; ph < PH_PER_LAYER; ++ph) {
            LAUNCH(k_phase, grid, NT, SMEM_BYTES, stream, p, l, ph);
#ifdef CPU_EMU
            const int code = ph == PH_INPROJ ? 1 : ph == PH_MIXERS ? 2 : ph == PH_MERGE ? 3 : ph == PH_WOUT ? 4 : ph == PH_GATHER ? 5 : 0;
            if (code && g_emu_stop == l * 10 + code) return;
#endif
        }
    LAUNCH(k_phase, grid, NT, SMEM_BYTES, stream, p, 0, (int)PH_FINAL);
#else
    static int grid_blocks = 0;
    if (!grid_blocks) {
        int dev = 0, cus = 0, per_cu = 0;
        (void)hipGetDevice(&dev);
        (void)hipDeviceGetAttribute(&cus, hipDeviceAttributeMultiprocessorCount, dev);
        (void)hipFuncSetAttribute((const void*)k_mega, hipFuncAttributeMaxDynamicSharedMemorySize, (int)SMEM_BYTES);
        (void)hipOccupancyMaxActiveBlocksPerMultiprocessor(&per_cu, k_mega, NT, SMEM_BYTES);
        if (per_cu > 1) per_cu = 1;
        grid_blocks = cus * per_cu;
    }
    void* args[] = {&p};
    hipError_t e = hipLaunchCooperativeKernel((void*)k_mega, dim3(grid_blocks), dim3(NT), args, SMEM_BYTES, stream);
    if (e != hipSuccess) fprintf(stderr, "cooperative launch failed: %s (grid %d)\n", hipGetErrorString(e), grid_blocks);
#endif
}
```

```cpp
#ifndef CPU_EMU
#include <hip/hip_runtime.h>
#include <hip/hip_cooperative_groups.h>
#include <cstdio>
#include <cstdint>
namespace cg = cooperative_groups;
#define DYN_SMEM(name) extern __shared__ __attribute__((aligned(16))) char name[]
#define LAUNCH(kern, grid, block, smem, stream, ...) hipLaunchKernelGGL(kern, dim3(grid), dim3(block), smem, stream, __VA_ARGS__)
#endif

#ifndef CFG_B
#define CFG_B 8
#endif
#ifndef CFG_T
#define CFG_T 2048
#endif
#ifndef MK_MULTI
#define MK_MULTI 0
#endif

namespace {
constexpr int B_ = CFG_B, T_ = CFG_T, M_ = B_ * T_, D_ = 1024, NL_ = 2, NT = 512;
constexpr int INW = 12560;
constexpr int LDZ = 11776;
constexpr int Z_ULRU = 0, Z_GLRU = 1024, Z_Q = 2048, Z_K = 3072, Z_V = 4096, Z_ZG = 5120, Z_RW = 6144, Z_ALPHA = 9472, Z_BETA = 9480;
constexpr int ZN = 9728;
constexpr int C_XN = 9728, C_YC = 10752;
constexpr int C_YA = Z_GLRU, C_YB = Z_ZG;
constexpr int C_GS = Z_Q, C_MG = Z_K;
constexpr int C_QRY = 0;
constexpr int RW_R = 0, RW_K = 1024, RW_V = 2048, RW_WL = 3072, RW_AL = 3136, RW_GL = 3200, RWW = 3328;
constexpr float RMS_EPS = 1e-6f, GN_EPS = 64e-5f;
typedef unsigned short h16_t;

enum { I_X = 0, I_NMIX, I_NFFN, I_NFINAL, I_WIN, I_LCW, I_LCB, I_LWA, I_LBA, I_LWX, I_LBX, I_LLAM, I_GCW, I_GALOG, I_GDT, I_GNW,
       I_RMU, I_RW0, I_RWUP, I_RA0, I_RAUP, I_RGUP, I_RKK, I_RKA, I_RRK, I_RLW, I_RLB, I_MB, I_PL, I_PG, I_PR, I_WOUT, I_PWQ, I_PKEYS, I_PU, I_PV, N_IN };

struct Params {
    const float* in[N_IN];
    float* out;
    char* ws;
};
#ifdef CPU_EMU
typedef const Params* KParams;
#else
typedef const Params __attribute__((address_space(4)))* KParams;
#endif

constexpr size_t al256(size_t x) { return (x + 255) / 256 * 256; }
constexpr size_t OFF_ACT = 0;
constexpr size_t OFF_WT = al256(OFF_ACT + (size_t)M_ * LDZ * 2);
constexpr int WT_IN = 0, WT_MG = ZN, WT_P = WT_MG + 3072, WT_OUT = WT_P + 3072, WT_Q = WT_OUT + 1024, WT_ROWS = WT_Q + 2048;
constexpr size_t OFF_TOPS = al256(OFF_WT + (size_t)NL_ * WT_ROWS * 1024 * 2);
constexpr size_t OFF_TAB = al256(OFF_TOPS + (size_t)M_ * 256 * 4);
constexpr size_t WS_END = OFF_TAB + (M_ == 16384 ? 0 : (size_t)16384 * 2048);
static_assert(CFG_B != 8 || CFG_T != 2048 || WS_END <= (size_t)512 * 1024 * 1024, "workspace budget");
constexpr size_t SMEM_BYTES = 128 * 1024;

#ifdef CPU_EMU
__device__ __forceinline__ int tid_() { return threadIdx.x; }
__device__ __forceinline__ h16_t f2h(float f) { return (h16_t)_cvtss_sh(f, _MM_FROUND_TO_NEAREST_INT); }
__device__ __forceinline__ float h2f(h16_t h) { return _cvtsh_ss(h); }
#else
__device__ __forceinline__ int tid_() { int t = threadIdx.x; asm volatile("" : "+v"(t)); return t; }
__device__ __forceinline__ h16_t f2h(float f) { return __builtin_bit_cast(unsigned short, (_Float16)f); }
__device__ __forceinline__ float h2f(h16_t h) { return (float)__builtin_bit_cast(_Float16, h); }
#endif
__device__ __forceinline__ int bid_() { return (int)blockIdx.x; }

#ifdef CPU_EMU
__device__ __forceinline__ float fexp_(float x) { return expf(x); }
__device__ __forceinline__ float flog_(float x) { return logf(x); }
__device__ __forceinline__ float frcp_(float x) { return 1.0f / x; }
#else
__device__ __forceinline__ float fexp_(float x) { return __builtin_amdgcn_exp2f(x * 1.4426950408889634f); }
__device__ __forceinline__ float flog_(float x) { return __builtin_amdgcn_logf(x) * 0.6931471805599453f; }
__device__ __forceinline__ float frcp_(float x) { return __builtin_amdgcn_rcpf(x); }
#endif
__device__ __forceinline__ float sigmoidf_(float x) { return frcp_(1.0f + fexp_(-x)); }
__device__ __forceinline__ float softplusf_(float x) { return fmaxf(x, 0.0f) + flog_(1.0f + fexp_(-fabsf(x))); }
__device__ __forceinline__ float siluf_(float x) { return x * sigmoidf_(x); }
__device__ __forceinline__ float tanhf_(float x) { return 1.0f - 2.0f * frcp_(1.0f + fexp_(2.0f * x)); }
__device__ __forceinline__ float geluf_(float x) { return x * frcp_(1.0f + fexp_(-1.5957691216057308f * (x + 0.044715f * x * x * x))); }
__device__ __forceinline__ unsigned pack2h(float a, float b) { return (unsigned)f2h(a) | ((unsigned)f2h(b) << 16); }
__device__ __forceinline__ void store8h(h16_t* p, const float (&v)[8]) {
    uint4 w; w.x = pack2h(v[0], v[1]); w.y = pack2h(v[2], v[3]); w.z = pack2h(v[4], v[5]); w.w = pack2h(v[6], v[7]);
    *(uint4*)p = w;
}
__device__ __forceinline__ void load8h(const h16_t* p, float (&v)[8]) {
    const uint4 w = *(const uint4*)p;
    v[0] = h2f((h16_t)(w.x & 0xffffu)); v[1] = h2f((h16_t)(w.x >> 16)); v[2] = h2f((h16_t)(w.y & 0xffffu)); v[3] = h2f((h16_t)(w.y >> 16));
    v[4] = h2f((h16_t)(w.z & 0xffffu)); v[5] = h2f((h16_t)(w.z >> 16)); v[6] = h2f((h16_t)(w.w & 0xffffu)); v[7] = h2f((h16_t)(w.w >> 16));
}

__device__ __forceinline__ float block_sum512(float v, float* red) {
    const int tid = tid_();
    red[tid] = v;
    __syncthreads();
    if (tid < 32) { float s = 0.f; for (int i = 0; i < 16; ++i) s += red[tid * 16 + i]; red[512 + tid] = s; }
    __syncthreads();
    float tot = 0.f;
    for (int i = 0; i < 32; ++i) tot += red[512 + i];
    __syncthreads();
    return tot;
}

template <bool OUT_F32>
__device__ __forceinline__ void stage_rmsnorm(const float* src, const float* w, void* dst, int ldd, char* smem) {
    float* red = (float*)smem;
    const int tid = tid_();
    for (int row = bid_(); row < M_; row += gridDim.x) {
        const float2 v = *(const float2*)(src + (size_t)row * D_ + tid * 2);
        const float ss = block_sum512(v.x * v.x + v.y * v.y, red);
        const float rstd = rsqrtf(ss * (1.0f / D_) + RMS_EPS);
        const float2 wv = *(const float2*)(w + tid * 2);
        const float o0 = v.x * rstd * wv.x, o1 = v.y * rstd * wv.y;
        if (OUT_F32) {
            float2 o; o.x = o0; o.y = o1;
            *(float2*)((float*)dst + (size_t)row * ldd + tid * 2) = o;
        } else {
            *(unsigned*)((h16_t*)dst + (size_t)row * ldd + tid * 2) = pack2h(o0, o1);
        }
    }
}

__device__ __forceinline__ const float* wt_src(KParams p, int l, int r, int& ld) {
    if (r < ZN) {
        ld = INW;
        int c;
        if (r < 6144) c = r; else if (r < 9472) c = r + 16; else if (r < 9488) c = r - 3328; else return nullptr;
        return p->in[I_WIN] + (size_t)l * 1024 * INW + c;
    }
    r -= ZN;
    if (r < 3072) { ld = INW; return p->in[I_WIN] + (size_t)l * 1024 * INW + 9488 + r; }
    r -= 3072;
    if (r < 3072) { ld = 1024; const int br = r >> 10; return p->in[br == 0 ? I_PL : (br == 1 ? I_PG : I_PR)] + (size_t)l * 1024 * 1024 + (r & 1023); }
    r -= 3072;
    if (r < 1024) { ld = 1024; return p->in[I_WOUT] + (size_t)l * 1024 * 1024 + r; }
    r -= 1024;
    ld = 2048; return p->in[I_PWQ] + (size_t)l * 1024 * 2048 + r;
}
__device__ __forceinline__ void stage_wprep(KParams p, char* smem) {
    float* tile = (float*)smem;
    h16_t* WT = (h16_t*)(p->ws + OFF_WT);
    const int tid = tid_();
    const int ntr = WT_ROWS / 64, total = NL_ * ntr * 16;
    for (int it = bid_(); it < total; it += gridDim.x) {
        const int l = it / (ntr * 16), rem = it % (ntr * 16), rt = rem / 16, kt = rem % 16;
        const int r0 = rt * 64, k0 = kt * 64;
        __syncthreads();
        {
            const int nn = tid & 63;
            int ld = 0; const float* src = wt_src(p, l, r0 + nn, ld);
#pragma unroll
            for (int i = 0; i < 8; ++i) { const int kk = (tid >> 6) + 8 * i; tile[kk * 65 + nn] = src ? src[(size_t)(k0 + kk) * ld] : 0.f; }
        }
        __syncthreads();
        {
            const int r = tid >> 3, kq = (tid & 7) * 8;
            float v[8];
#pragma unroll
            for (int j = 0; j < 8; ++j) v[j] = tile[(kq + j) * 65 + r];
            store8h(WT + ((size_t)l * WT_ROWS + r0 + r) * 1024 + k0 + kq, v);
        }
    }
}

namespace pg8 {
constexpr int BM = 256, BK = 64, HALF = 128, HTB = HALF * BK * 2, STAGE_BYTES = 8 * HTB, NXCD = 8, WGM = 8;
struct Unit { const char* A; const char* B; int pm, pn, kind; };
#ifdef CPU_EMU
struct f32x4 { float d[4]; float& operator[](int i) { return d[i]; } const float& operator[](int i) const { return d[i]; } };
#else
#define PG8_LAS __attribute__((address_space(3)))
typedef _Float16 f16x8 __attribute__((ext_vector_type(8)));
typedef float f32x4 __attribute__((ext_vector_type(4)));
__device__ __forceinline__ int lds_byte(int r, int c) { const int st = (r >> 4) * 2 + (c >> 5), rr = r & 15, cc = c & 31, ob = rr * 64 + cc * 2; return st * 1024 + (ob ^ (((ob >> 9) & 1) << 5)); }
__device__ __forceinline__ void stage_rc(int b, int& R, int& C) { const int st = b / 1024, sb = b % 1024, swz = sb ^ (((sb >> 9) & 1) << 5); R = (st >> 1) * 16 + swz / 64; C = (st & 1) * 32 + (swz % 64) / 2; }
__device__ __forceinline__ int perm32(int rho) { const int n = rho >> 4, i = rho & 15; return 8 * (i >> 2) + 4 * n + (i & 3); }
#endif
__device__ __forceinline__ void tile_of(int L, int nM, int nN, int& pm, int& pn) {
    const int nwg = nM * nN;
    int wgid = L; { const int q = nwg / NXCD, r = nwg % NXCD, xcd = wgid % NXCD, off = wgid / NXCD; wgid = (xcd < r ? xcd * (q + 1) : r * (q + 1) + (xcd - r) * q) + off; }
    const int nig = WGM * nN, gid = wgid / nig, fm = gid * WGM, gsz = (nM - fm) < WGM ? (nM - fm) : WGM;
    pm = fm + ((wgid % nig) % gsz); pn = (wgid % nig) / gsz;
}

template <class Sched, class Epi>
__device__ __forceinline__ void gemm_phase(char* smem, const Sched& S, const Epi& E) {
    constexpr int K = 1024, nt = K / BK;
    constexpr unsigned lda = LDZ, ldb = 1024;
#ifdef CPU_EMU
    const int tid = tid_(), wid = tid >> 6, lane = tid & 63, wr = wid >> 2, wc = wid & 3, fr = lane & 15, fq = lane >> 4;
    Unit u;
    for (int ui = 0; S.next(ui, u); ++ui) {
        f32x4 acc[2][2][4][2];
        for (int ai = 0; ai < 2; ++ai) for (int bj = 0; bj < 2; ++bj) for (int m = 0; m < 4; ++m) for (int n = 0; n < 2; ++n) for (int e = 0; e < 4; ++e) {
            const int r = 128 * ai + 64 * wr + 16 * m + fr, c = 128 * bj + 32 * wc + 8 * fq + 4 * n + e;
            const h16_t* a = (const h16_t*)u.A + (size_t)r * lda; const h16_t* b = (const h16_t*)u.B + (size_t)c * ldb;
            float s = 0.f;
            for (int k = 0; k < K; ++k) s += h2f(a[k]) * h2f(b[k]);
            acc[ai][bj][m][n][e] = s;
        }
        E(acc, u, wr, wc, fr, fq);
    }
    (void)smem; (void)nt;
#else
    PG8_LAS unsigned char* lds = (PG8_LAS unsigned char*)smem;
    const int tid = tid_(), wid = __builtin_amdgcn_readfirstlane(tid >> 6), lane = tid & 63, wr = wid >> 2, wc = wid & 3, fr = lane & 15, fq = lane >> 4;
    unsigned voffA[2], voffB[2];
#pragma unroll
    for (int i = 0; i < 2; ++i) { int R, C; stage_rc(tid * 16 + i * 8192, R, C); const int Rb = (R & ~31) + perm32(R & 31);
        voffA[i] = (unsigned)(R * lda + C) * 2u; voffB[i] = (unsigned)(Rb * ldb + C) * 2u; }
    constexpr size_t kstep = (size_t)(BK * 2);
    constexpr size_t hstepA = (size_t)HALF * lda * 2, hstepB = (size_t)HALF * ldb * 2;
    const unsigned ldsw = (unsigned)wid * 1024u;
    const int aoff = lds_byte(wr * 64 + fr, fq * 8), boff = lds_byte(wc * 32 + fr, fq * 8);
#define PG8_SA(b, h) (((b) * 2 + (h)) * HTB)
#define PG8_SB(b, h) ((4 + (b) * 2 + (h)) * HTB)
#define PG8_STAGE(bufoff, gbase, voff) do { _Pragma("unroll") for (int _i = 0; _i < 2; ++_i) \
        __builtin_amdgcn_global_load_lds((const unsigned*)((const char*)(gbase) + (voff)[_i]), (PG8_LAS unsigned*)(lds + (bufoff) + ldsw + _i * 8192), 16, 0, 0); } while (0)
#define PG8_LDA(dst, b, h) do { _Pragma("unroll") for (int m = 0; m < 4; ++m) _Pragma("unroll") for (int k = 0; k < 2; ++k) dst[m][k] = *(const PG8_LAS f16x8*)(lds + PG8_SA(b, h) + aoff + m * 2048 + k * 1024); } while (0)
#define PG8_LDB(dst, b, h) do { _Pragma("unroll") for (int n = 0; n < 2; ++n) _Pragma("unroll") for (int k = 0; k < 2; ++k) dst[n][k] = *(const PG8_LAS f16x8*)(lds + PG8_SB(b, h) + boff + n * 2048 + k * 1024); } while (0)
#define PG8_MMA(ai, bj, At, Bt) do { __builtin_amdgcn_s_setprio(1); _Pragma("unroll") for (int m = 0; m < 4; ++m) _Pragma("unroll") for (int n = 0; n < 2; ++n) _Pragma("unroll") for (int k = 0; k < 2; ++k) \
        acc[ai][bj][m][n] = __builtin_amdgcn_mfma_f32_16x16x32_f16(Bt[n][k], At[m][k], acc[ai][bj][m][n], 0, 0, 0); __builtin_amdgcn_s_setprio(0); } while (0)
#define PG8_WAIT_V(n) asm volatile("s_waitcnt vmcnt(" #n ")" ::: "memory")
#define PG8_WAIT_L(n) asm volatile("s_waitcnt lgkmcnt(" #n ")" ::: "memory")
#define PG8_BAR __builtin_amdgcn_s_barrier()
#define PG8_SCHED __builtin_amdgcn_sched_barrier(0)
    Unit cur, nxt; int ui = 0;
    if (!S.next(0, cur)) return;
    f32x4 acc[2][2][4][2];
#pragma unroll
    for (int a = 0; a < 2; ++a)
#pragma unroll
        for (int b = 0; b < 2; ++b)
#pragma unroll
            for (int m = 0; m < 4; ++m)
#pragma unroll
                for (int n = 0; n < 2; ++n) acc[a][b][m][n] = (f32x4){0.f, 0.f, 0.f, 0.f};
    f16x8 At[4][2], B0[2][2], B1[2][2];
    const char* cA = cur.A; const char* cB = cur.B;
    PG8_STAGE(PG8_SB(0, 0), cB, voffB); PG8_STAGE(PG8_SA(0, 0), cA, voffA); PG8_STAGE(PG8_SB(0, 1), cB + hstepB, voffB); PG8_STAGE(PG8_SA(0, 1), cA + hstepA, voffA);
    if (wr == 1) PG8_BAR;
    PG8_WAIT_V(4); PG8_BAR;
    PG8_STAGE(PG8_SB(1, 0), cB + kstep, voffB); PG8_STAGE(PG8_SA(1, 0), cA + kstep, voffA); PG8_STAGE(PG8_SB(1, 1), cB + hstepB + kstep, voffB);
    PG8_WAIT_V(6); PG8_BAR;
    for (;;) {
        const bool has_next = S.next(ui + 1, nxt);
        const char* nA = has_next ? nxt.A : cA; const char* nB = has_next ? nxt.B : cB;
#pragma unroll 1
        for (int t = 0; t < nt; t += 2) {
            const bool last = (t == nt - 2);
            const char* a1 = cA + (size_t)(t + 1) * kstep;
            const char* a2 = last ? nA : cA + (size_t)(t + 2) * kstep; const char* b2 = last ? nB : cB + (size_t)(t + 2) * kstep;
            const char* a3 = a2 + kstep; const char* b3 = b2 + kstep;
            PG8_LDB(B0, 0, 0); PG8_SCHED; PG8_LDA(At, 0, 0); PG8_STAGE(PG8_SA(1, 1), a1 + hstepA, voffA);
            PG8_WAIT_L(8); PG8_BAR; PG8_WAIT_L(0); PG8_MMA(0, 0, At, B0); PG8_BAR; PG8_SCHED;
            PG8_LDB(B1, 0, 1); PG8_STAGE(PG8_SB(0, 0), b2, voffB);
            PG8_BAR; PG8_WAIT_L(0); PG8_MMA(0, 1, At, B1); PG8_BAR;
            PG8_LDA(At, 0, 1); PG8_STAGE(PG8_SA(0, 0), a2, voffA);
            PG8_BAR; PG8_WAIT_L(0); PG8_MMA(1, 0, At, B0); PG8_BAR; PG8_SCHED;
            PG8_STAGE(PG8_SB(0, 1), b2 + hstepB, voffB);
            PG8_WAIT_V(6); PG8_BAR; PG8_MMA(1, 1, At, B1); PG8_BAR;
            PG8_LDB(B0, 1, 0); PG8_SCHED; PG8_LDA(At, 1, 0); PG8_STAGE(PG8_SA(0, 1), a2 + hstepA, voffA);
            PG8_WAIT_L(8); PG8_BAR; PG8_WAIT_L(0); PG8_MMA(0, 0, At, B0); PG8_BAR; PG8_SCHED;
            PG8_LDB(B1, 1, 1); PG8_STAGE(PG8_SB(1, 0), b3, voffB);
            PG8_BAR; PG8_WAIT_L(0); PG8_MMA(0, 1, At, B1); PG8_BAR;
            PG8_LDA(At, 1, 1); PG8_STAGE(PG8_SA(1, 0), a3, voffA);
            PG8_BAR; PG8_WAIT_L(0); PG8_MMA(1, 0, At, B0); PG8_BAR; PG8_SCHED;
            PG8_STAGE(PG8_SB(1, 1), b3 + hstepB, voffB);
            PG8_WAIT_V(6); PG8_BAR; PG8_MMA(1, 1, At, B1); PG8_BAR;
        }
        E(acc, cur, wr, wc, fr, fq);
        if (!has_next) break;
#pragma unroll
        for (int a = 0; a < 2; ++a)
#pragma unroll
            for (int b = 0; b < 2; ++b)
#pragma unroll
                for (int m = 0; m < 4; ++m)
#pragma unroll
                    for (int n = 0; n < 2; ++n) acc[a][b][m][n] = (f32x4){0.f, 0.f, 0.f, 0.f};
        cur = nxt; cA = nA; cB = nB; ++ui;
    }
    PG8_WAIT_V(0);
    if (wr == 0) PG8_BAR;
    PG8_BAR;
#undef PG8_SA
#undef PG8_SB
#undef PG8_STAGE
#undef PG8_LDA
#undef PG8_LDB
#undef PG8_MMA
#undef PG8_WAIT_V
#undef PG8_WAIT_L
#undef PG8_BAR
#undef PG8_SCHED
#endif
}
}

enum { GK_STORE = 0, GK_GATE0, GK_GATE1, GK_GATE2, GK_PROJ0, GK_PROJ1, GK_PROJ2, GK_RESID };
enum { GP_INPROJ = 0, GP_MERGE, GP_WOUT, GP_QUERY };
struct GemmProg {
    const char* act; const char* wt;
    int which, G, c;
    __device__ __forceinline__ bool next(int i, pg8::Unit& u) const {
        constexpr int nM = M_ / 256;
        constexpr size_t rowA = (size_t)256 * LDZ * 2, rowB = (size_t)256 * 1024 * 2;
        if (which == GP_MERGE) {
            const int L = (i / 6) * G + c, j = i % 6, br = j >> 1;
            if (L >= nM * 4) return false;
            pg8::tile_of(L, nM, 4, u.pm, u.pn);
            if ((j & 1) == 0) { u.A = act + (size_t)C_XN * 2; u.B = wt + ((size_t)(WT_MG + br * 1024) * 1024) * 2; u.kind = GK_GATE0 + br; }
            else { u.A = act + (size_t)(br == 0 ? C_YA : (br == 1 ? C_YB : C_YC)) * 2; u.B = wt + ((size_t)(WT_P + br * 1024) * 1024) * 2; u.kind = GK_PROJ0 + br; }
        } else {
            const int nN = which == GP_INPROJ ? ZN / 256 : (which == GP_WOUT ? 4 : 8);
            const int L = i * G + c;
            if (L >= nM * nN) return false;
            pg8::tile_of(L, nM, nN, u.pm, u.pn);
            u.A = act + (size_t)(which == GP_WOUT ? C_MG : C_XN) * 2;
            u.B = wt + ((size_t)(which == GP_INPROJ ? WT_IN : (which == GP_WOUT ? WT_OUT : WT_Q)) * 1024) * 2;
            u.kind = which == GP_WOUT ? GK_RESID : GK_STORE;
        }
        u.A += (size_t)u.pm * rowA; u.B += (size_t)u.pn * rowB;
        return true;
    }
};
struct GemmEpi {
    h16_t* act; const float* mb; const float* resid; float* out;
    __device__ __forceinline__ void operator()(const pg8::f32x4 (&acc)[2][2][4][2], const pg8::Unit& u, int wr, int wc, int fr, int fq) const {
        const int row0 = u.pm * 256 + wr * 64 + fr, col0 = u.pn * 256 + wc * 32 + 8 * fq;
#pragma unroll
        for (int ai = 0; ai < 2; ++ai)
#pragma unroll
            for (int m = 0; m < 4; ++m) {
                const int row = row0 + ai * 128 + m * 16;
#pragma unroll
                for (int bj = 0; bj < 2; ++bj) {
                    const int col = col0 + bj * 128;
                    float v[8];
#pragma unroll
                    for (int e = 0; e < 4; ++e) { v[e] = acc[ai][bj][m][0][e]; v[4 + e] = acc[ai][bj][m][1][e]; }
                    h16_t* arow = act + (size_t)row * LDZ;
                    if (u.kind == GK_STORE) {
                        store8h(arow + col, v);
                    } else if (u.kind <= GK_GATE2) {
                        const float* bp = mb + (u.kind - GK_GATE0) * 1024 + col;
                        const float4 b0 = *(const float4*)bp, b1 = *(const float4*)(bp + 4);
                        v[0] = sigmoidf_(v[0] + b0.x); v[1] = sigmoidf_(v[1] + b0.y); v[2] = sigmoidf_(v[2] + b0.z); v[3] = sigmoidf_(v[3] + b0.w);
                        v[4] = sigmoidf_(v[4] + b1.x); v[5] = sigmoidf_(v[5] + b1.y); v[6] = sigmoidf_(v[6] + b1.z); v[7] = sigmoidf_(v[7] + b1.w);
                        store8h(arow + C_GS + col, v);
                    } else if (u.kind <= GK_PROJ2) {
                        float g[8]; load8h(arow + C_GS + col, g);
                        if (u.kind == GK_PROJ0) {
#pragma unroll
                            for (int e = 0; e < 8; ++e) v[e] = g[e] * v[e];
                        } else {
                            float o[8]; load8h(arow + C_MG + col, o);
#pragma unroll
                            for (int e = 0; e < 8; ++e) v[e] = o[e] + g[e] * v[e];
                        }
                        store8h(arow + C_MG + col, v);
                    } else {
                        const size_t o = (size_t)row * 1024 + col;
                        const float4 r0 = *(const float4*)(resid + o), r1 = *(const float4*)(resid + o + 4);
                        *(float4*)(out + o) = make_float4(r0.x + v[0], r0.y + v[1], r0.z + v[2], r0.w + v[3]);
                        *(float4*)(out + o + 4) = make_float4(r1.x + v[4], r1.y + v[5], r1.z + v[6], r1.w + v[7]);
                    }
                }
            }
    }
};
__device__ __forceinline__ void stage_gemm(KParams p, int l, int which, char* smem) {
    GemmProg S; S.act = p->ws + OFF_ACT; S.wt = p->ws + OFF_WT + (size_t)l * WT_ROWS * 1024 * 2; S.which = which; S.G = gridDim.x; S.c = bid_();
    GemmEpi E; E.act = (h16_t*)(p->ws + OFF_ACT); E.mb = p->in[I_MB] + l * 3072; E.resid = l == 0 ? p->in[I_X] : p->out; E.out = p->out;
    pg8::gemm_phase(smem, S, E);
}

#ifdef CPU_EMU
__device__ __forceinline__ float group_sum(float v, int width, float* scratch) {
    const int tid = tid_();
    scratch[tid] = v;
    __syncthreads();
    float s = 0.f; const int base = tid & ~(width - 1);
    for (int i = 0; i < width; ++i) s += scratch[base + i];
    __syncthreads();
    return s;
}
#else
template <int CTRL> __device__ __forceinline__ float dpp_f(float v) { return __builtin_bit_cast(float, __builtin_amdgcn_update_dpp(0, __builtin_bit_cast(int, v), CTRL, 0xf, 0xf, false)); }
__device__ __forceinline__ float group_sum(float v, int width, float*) {
    v += dpp_f<0xB1>(v);
    v += dpp_f<0x4E>(v);
    if (width >= 8) v += dpp_f<0x141>(v);
    if (width >= 16) v += dpp_f<0x140>(v);
    if (width >= 32) v += __shfl_xor(v, 16);
    if (width >= 64) v += __shfl_xor(v, 32);
    return v;
}
#endif
__device__ __forceinline__ uint4 ldg16(const h16_t* p) { return *(const uint4*)p; }
__device__ __forceinline__ uint4 zero16() { uint4 z; z.x = 0u; z.y = 0u; z.z = 0u; z.w = 0u; return z; }

__device__ __forceinline__ void stage_lru(KParams p, int l, char* smem, int vb0, int nvb) {
    const int vb = bid_() - vb0;
    if (vb < 0 || vb >= nvb) return;
    constexpr int CH = 64;
    float* wa_s = (float*)smem;
    float* wx_s = wa_s + 4096;
    float* xcT = wx_s + 4096;
    float* a_s = xcT + 64 * CH;
    float* b_s = a_s + CH * 64;
    h16_t* ru = (h16_t*)(b_s + CH * 64);
    h16_t* rg = ru + (CH + 3) * 64;
    h16_t* ACT = (h16_t*)(p->ws + OFF_ACT);
    const int tid = tid_(), c = tid & 63, tg = tid >> 6;
    for (int item = vb; item < B_ * 16; item += nvb) {
        const int b = item / 16, n = item % 16, ch = n * 64 + c;
        __syncthreads();
        for (int i = tid; i < 4096; i += NT) { wa_s[i] = p->in[I_LWA][((size_t)l * 16 + n) * 4096 + i]; wx_s[i] = p->in[I_LWX][((size_t)l * 16 + n) * 4096 + i]; }
        const float cw0 = p->in[I_LCW][((size_t)l * 4 + 0) * 1024 + ch], cw1 = p->in[I_LCW][((size_t)l * 4 + 1) * 1024 + ch];
        const float cw2 = p->in[I_LCW][((size_t)l * 4 + 2) * 1024 + ch], cw3 = p->in[I_LCW][((size_t)l * 4 + 3) * 1024 + ch];
        const float cb = p->in[I_LCB][l * 1024 + ch], ba = p->in[I_LBA][l * 1024 + ch], bx = p->in[I_LBX][l * 1024 + ch];
        const float sp = softplusf_(-p->in[I_LLAM][l * 1024 + ch]);
        float hst = 0.f;
        uint4 pf[3];
#define LRU_LOAD(t0_) do { _Pragma("unroll") for (int i = 0; i < 3; ++i) { const int j = tid + NT * i; pf[i] = zero16(); \
            if (j < 536) { const int t = (t0_) - 3 + (j >> 3); if (t >= 0) pf[i] = ldg16(ACT + ((size_t)b * T_ + t) * LDZ + Z_ULRU + n * 64 + (j & 7) * 8); } \
            else if (j < 1048) { const int jj = j - 536; pf[i] = ldg16(ACT + ((size_t)b * T_ + (t0_) + (jj >> 3)) * LDZ + Z_GLRU + n * 64 + (jj & 7) * 8); } } } while (0)
#define LRU_PUT() do { _Pragma("unroll") for (int i = 0; i < 3; ++i) { const int j = tid + NT * i; \
            if (j < 536) *(uint4*)(ru + (j >> 3) * 64 + (j & 7) * 8) = pf[i]; else if (j < 1048) *(uint4*)(rg + ((j - 536) >> 3) * 64 + ((j - 536) & 7) * 8) = pf[i]; } } while (0)
        LRU_LOAD(0);
        LRU_PUT();
        __syncthreads();
#pragma unroll 1
        for (int t0 = 0; t0 < T_; t0 += CH) {
            float xc[8];
            {
                float u[11];
#pragma unroll
                for (int s = 0; s < 11; ++s) u[s] = h2f(ru[(tg * 8 + s) * 64 + c]);
#pragma unroll
                for (int s = 0; s < 8; ++s) { xc[s] = cw0 * u[s] + cw1 * u[s + 1] + cw2 * u[s + 2] + cw3 * u[s + 3] + cb; xcT[c * CH + tg * 8 + s] = xc[s]; }
            }
            __syncthreads();
            if (t0 + CH < T_) LRU_LOAD(t0 + CH);
            {
                float dr[8], di[8];
#pragma unroll
                for (int s = 0; s < 8; ++s) { dr[s] = 0.f; di[s] = 0.f; }
#pragma unroll 4
                for (int i = 0; i < 64; ++i) {
                    const float wa = wa_s[i * 64 + c], wx = wx_s[i * 64 + c];
                    const float4 x0 = *(const float4*)(xcT + i * CH + tg * 8), x1 = *(const float4*)(xcT + i * CH + tg * 8 + 4);
                    dr[0] += x0.x * wa; dr[1] += x0.y * wa; dr[2] += x0.z * wa; dr[3] += x0.w * wa; dr[4] += x1.x * wa; dr[5] += x1.y * wa; dr[6] += x1.z * wa; dr[7] += x1.w * wa;
                    di[0] += x0.x * wx; di[1] += x0.y * wx; di[2] += x0.z * wx; di[3] += x0.w * wx; di[4] += x1.x * wx; di[5] += x1.y * wx; di[6] += x1.z * wx; di[7] += x1.w * wx;
                }
#pragma unroll
                for (int s = 0; s < 8; ++s) {
                    const float r = sigmoidf_(dr[s] + ba), ig = sigmoidf_(di[s] + bx);
                    const float log_a = -8.0f * r * sp;
                    a_s[(tg * 8 + s) * 64 + c] = fexp_(log_a);
                    b_s[(tg * 8 + s) * 64 + c] = sqrtf(fmaxf(1.0f - fexp_(2.0f * log_a), 0.0f)) * (ig * xc[s]);
                }
            }
            __syncthreads();
            if (tid < 64) {
#pragma unroll 8
                for (int t = 0; t < CH; ++t) { hst = a_s[t * 64 + c] * hst + b_s[t * 64 + c]; b_s[t * 64 + c] = hst; }
            }
            __syncthreads();
#pragma unroll
            for (int s = 0; s < 8; ++s) { h16_t* gp = rg + (tg * 8 + s) * 64 + c; *gp = f2h(b_s[(tg * 8 + s) * 64 + c] * geluf_(h2f(*gp))); }
            __syncthreads();
            *(uint4*)(ACT + ((size_t)b * T_ + t0 + (tid >> 3)) * LDZ + Z_GLRU + n * 64 + (tid & 7) * 8) = *(const uint4*)(rg + (tid >> 3) * 64 + (tid & 7) * 8);
            __syncthreads();
            if (t0 + CH < T_) LRU_PUT();
            __syncthreads();
        }
#undef LRU_LOAD
#undef LRU_PUT
    }
}

#ifdef CPU_EMU
struct hfrag { h16_t v[8]; };
struct facc { float d[4]; float& operator[](int i) { return d[i]; } const float& operator[](int i) const { return d[i]; } };
__device__ __forceinline__ facc facc_zero() { facc a; a.d[0] = a.d[1] = a.d[2] = a.d[3] = 0.f; return a; }
__device__ __forceinline__ hfrag frag_u4(uint4 w) { hfrag f; memcpy(&f, &w, 16); return f; }
__device__ __forceinline__ hfrag frag_2u2(uint2 lo, uint2 hi) { hfrag f; memcpy(&f.v[0], &lo, 8); memcpy(&f.v[4], &hi, 8); return f; }
__device__ __forceinline__ hfrag frag_mul(hfrag a, hfrag b) { hfrag f; for (int j = 0; j < 8; ++j) f.v[j] = f2h(h2f(a.v[j]) * h2f(b.v[j])); return f; }
__device__ __forceinline__ facc mfma16(hfrag a, hfrag b, facc c) {
    const int tid = tid_(), w = tid >> 6, l = tid & 63;
    unsigned short (*X)[64][16] = emu::ctx->xscr;
    for (int j = 0; j < 8; ++j) { X[w][l][j] = a.v[j]; X[w][l][8 + j] = b.v[j]; }
    __syncthreads();
    for (int reg = 0; reg < 4; ++reg) {
        const int row = 4 * (l >> 4) + reg, col = l & 15;
        float s = 0.f;
        for (int k = 0; k < 32; ++k) s += h2f(X[w][row + 16 * (k >> 3)][k & 7]) * h2f(X[w][col + 16 * (k >> 3)][8 + (k & 7)]);
        c.d[reg] += s;
    }
    __syncthreads();
    return c;
}
#else
typedef _Float16 hfrag __attribute__((ext_vector_type(8)));
typedef float facc __attribute__((ext_vector_type(4)));
__device__ __forceinline__ facc facc_zero() { return (facc){0.f, 0.f, 0.f, 0.f}; }
__device__ __forceinline__ hfrag frag_u4(uint4 w) { return __builtin_bit_cast(hfrag, w); }
__device__ __forceinline__ hfrag frag_2u2(uint2 lo, uint2 hi) { uint4 w; w.x = lo.x; w.y = lo.y; w.z = hi.x; w.w = hi.y; return __builtin_bit_cast(hfrag, w); }
__device__ __forceinline__ hfrag frag_mul(hfrag a, hfrag b) { return a * b; }
__device__ __forceinline__ facc mfma16(hfrag a, hfrag b, facc c) { return __builtin_amdgcn_mfma_f32_16x16x32_f16(a, b, c, 0, 0, 0); }
#endif
__device__ __forceinline__ hfrag frag_pack8(float a0, float a1, float a2, float a3, float a4, float a5, float a6, float a7) {
    uint4 w; w.x = pack2h(a0, a1); w.y = pack2h(a2, a3); w.z = pack2h(a4, a5); w.w = pack2h(a6, a7); return frag_u4(w);
}
__device__ __forceinline__ hfrag frag_acc2(const facc& t0, const facc& t1) { return frag_pack8(t0[0], t0[1], t0[2], t0[3], t1[0], t1[1], t1[2], t1[3]); }
__device__ __forceinline__ hfrag permfrag(const h16_t* rowp, int ks, int g) { return frag_2u2(*(const uint2*)(rowp + 32 * ks + 4 * g), *(const uint2*)(rowp + 32 * ks + 16 + 4 * g)); }

__device__ __forceinline__ void stage_gdn(KParams p, int l, char* smem, int vb0, int nvb) {
    const int vb = bid_() - vb0;
    if (vb < 0 || vb >= nvb) return;
    constexpr int CH = 64, QS = 136, TS = 72, AS = 68;
    h16_t* Qs = (h16_t*)smem;
    h16_t* Ks = Qs + 64 * QS;
    h16_t* Kt = Ks + 64 * QS;
    h16_t* Vt = Kt + 128 * TS;
    float* A32 = (float*)(Vt + 128 * TS);
    h16_t* ob = (h16_t*)A32;
    h16_t* Tu = (h16_t*)(A32 + 64 * AS);
    h16_t* Tw = Tu + 64 * TS;
    h16_t* QKm = Tw + 64 * TS;
    float* gc_s = (float*)(QKm + 64 * TS);
    float* be_s = gc_s + 64;
    float* e1_s = be_s + 64;
    float* part_s = e1_s + 64;
    float* scr = part_s + 512;
    float* cw_s = scr + 512;
    h16_t* ACT = (h16_t*)(p->ws + OFF_ACT);
    int tid = tid_(), lane = tid & 63, w = tid >> 6, g = lane >> 4, r16 = lane & 15;
    int sg = lane >> 4, pc = lane & 15, rb = w;
#define GDN_ROLES() do { tid = tid_(); lane = tid & 63; w = tid >> 6; g = lane >> 4; r16 = lane & 15; sg = g; pc = r16; rb = w; } while (0)
    for (int item = vb; item < B_ * 8; item += nvb) {
        const int b = item / 8, h = item % 8;
        const float a_exp = fexp_(p->in[I_GALOG][l * 8 + h]), dtb = p->in[I_GDT][l * 8 + h];
        facc S[8];
#pragma unroll
        for (int dt = 0; dt < 8; ++dt) S[dt] = facc_zero();
        __syncthreads();
        for (int i = tid; i < 64 * TS / 2; i += NT) ((unsigned*)QKm)[i] = 0u;
        for (int i = tid; i < 4 * 384; i += NT) { const int jj = i / 384, c3 = i % 384; cw_s[i] = p->in[I_GCW][((size_t)l * 4 + jj) * 3072 + (c3 >> 7) * 1024 + h * 128 + (c3 & 127)]; }
        uint4 pf[11];
#define GDN_LOAD(t0_) do { GDN_ROLES(); const h16_t* colp = ACT + ((size_t)b * T_ + (t0_) + 8 * rb - 3) * LDZ + (sg < 3 ? Z_Q + sg * 1024 : Z_ZG) + h * 128 + pc * 8; \
            _Pragma("unroll") for (int i = 0; i < 11; ++i) { const int t = (t0_) + 8 * rb - 3 + i; pf[i] = (t >= 0 && sg < 3) ? ldg16(colp + (size_t)i * LDZ) : zero16(); } } while (0)
        GDN_LOAD(0);
#pragma unroll 1
        for (int t0 = 0; t0 < T_; t0 += CH) {
            GDN_ROLES();
            if (tid < 64) {
                const size_t m = (size_t)b * T_ + t0 + tid;
                part_s[tid] = -a_exp * softplusf_(h2f(ACT[m * LDZ + Z_ALPHA + h]) + dtb);
                be_s[tid] = sigmoidf_(h2f(ACT[m * LDZ + Z_BETA + h]));
            }
            __syncthreads();
            if (tid < 64) { float s = 0.f; for (int i = 0; i <= tid; ++i) s += part_s[i]; gc_s[tid] = s; }
#pragma unroll
            for (int hf = 0; hf < 2; ++hf) {
                float ov[4][8];
#pragma unroll
                for (int i = 0; i < 4; ++i) {
#pragma unroll
                    for (int cc = 0; cc < 8; ++cc) ov[i][cc] = 0.f;
#pragma unroll
                    for (int jj = 0; jj < 4; ++jj) {
                        const uint4 wv = pf[hf * 4 + i + jj];
                        const float* cwp = cw_s + jj * 384 + (sg < 3 ? sg : 0) * 128 + pc * 8;
                        const float4 c0 = *(const float4*)cwp, c1 = *(const float4*)(cwp + 4);
                        ov[i][0] += c0.x * h2f((h16_t)(wv.x & 0xffffu)); ov[i][1] += c0.y * h2f((h16_t)(wv.x >> 16)); ov[i][2] += c0.z * h2f((h16_t)(wv.y & 0xffffu)); ov[i][3] += c0.w * h2f((h16_t)(wv.y >> 16));
                        ov[i][4] += c1.x * h2f((h16_t)(wv.z & 0xffffu)); ov[i][5] += c1.y * h2f((h16_t)(wv.z >> 16)); ov[i][6] += c1.z * h2f((h16_t)(wv.w & 0xffffu)); ov[i][7] += c1.w * h2f((h16_t)(wv.w >> 16));
                    }
                    float ss = 0.f;
#pragma unroll
                    for (int cc = 0; cc < 8; ++cc) { ov[i][cc] = siluf_(ov[i][cc]); ss += ov[i][cc] * ov[i][cc]; }
                    ss = group_sum(ss, 16, scr);
                    const float rn = sg == 0 ? rsqrtf(ss + RMS_EPS) * 0.08838834764831845f : (sg == 1 ? rsqrtf(ss + RMS_EPS) : 1.0f);
#pragma unroll
                    for (int cc = 0; cc < 8; ++cc) ov[i][cc] *= rn;
                    const int t = 8 * rb + hf * 4 + i;
                    if (sg == 0) store8h(Qs + t * QS + pc * 8, ov[i]);
                    else if (sg == 1) store8h(Ks + t * QS + pc * 8, ov[i]);
                }
                if (sg == 1 || sg == 2) {
                    h16_t* dstT = sg == 1 ? Kt : Vt;
#pragma unroll
                    for (int cc = 0; cc < 8; ++cc) { uint2 w2; w2.x = pack2h(ov[0][cc], ov[1][cc]); w2.y = pack2h(ov[2][cc], ov[3][cc]); *(uint2*)(dstT + (pc * 8 + cc) * TS + 8 * rb + hf * 4) = w2; }
                }
            }
            __syncthreads();
            GDN_ROLES();
            if (tid < 64) e1_s[tid] = fexp_(gc_s[63] - gc_s[tid]);
            for (int e = tid; e < 64 * 64; e += NT) { const int i = e >> 6, j = e & 63; if ((j >> 4) > (i >> 4)) A32[i * AS + (j & 7) * 8 + (j >> 3)] = 0.f; }
#pragma unroll 1
            for (int jr = 0; jr < 3; ++jr) {
                const int jb = w + 8 * jr; const bool valid = jb < 20;
                const int kind = (valid && jb >= 10) ? 1 : 0, tix = valid ? (jb % 10) : 0;
                const int ti = tix < 1 ? 0 : (tix < 3 ? 1 : (tix < 6 ? 2 : 3)), tj = tix - (ti * (ti + 1)) / 2;
                const h16_t* ap = (kind ? Qs : Ks) + (16 * ti + r16) * QS + 8 * g; const h16_t* bp = Ks + (16 * tj + r16) * QS + 8 * g;
                facc acc = facc_zero();
#pragma unroll
                for (int ks = 0; ks < 4; ++ks) acc = mfma16(frag_u4(*(const uint4*)(ap + 32 * ks)), frag_u4(*(const uint4*)(bp + 32 * ks)), acc);
                if (valid) {
                    const int j = 16 * tj + r16; const float gj = gc_s[j];
#pragma unroll
                    for (int reg = 0; reg < 4; ++reg) {
                        const int i = 16 * ti + 4 * g + reg;
                        const float dec = fexp_(fminf(gc_s[i] - gj, 0.f));
                        if (kind == 0) A32[i * AS + (j & 7) * 8 + (j >> 3)] = i > j ? be_s[i] * acc[reg] * dec : 0.f;
                        else QKm[i * TS + j] = f2h(i >= j ? acc[reg] * dec : 0.f);
                    }
                }
            }
            __syncthreads();
            GDN_ROLES();
            {
                const int t = tid >> 3, d0 = (tid & 7) * 16; const float eg = fexp_(gc_s[t]);
                float v8[8];
                load8h(Qs + t * QS + d0, v8);
#pragma unroll
                for (int e = 0; e < 8; ++e) v8[e] *= eg;
                store8h(Qs + t * QS + d0, v8);
                load8h(Qs + t * QS + d0 + 8, v8);
#pragma unroll
                for (int e = 0; e < 8; ++e) v8[e] *= eg;
                store8h(Qs + t * QS + d0 + 8, v8);
            }
            {
                const int c = tid >> 3, q = tid & 7;
                const float bc = be_s[c], bgc = bc * fexp_(gc_s[c]);
                float x[8];
#pragma unroll
                for (int i = 0; i < 8; ++i) x[i] = 0.f;
#pragma unroll
                for (int r = 0; r < 64; ++r) {
                    float sacc = 0.f;
                    if (r > 0) {
                        const float4 a0 = *(const float4*)(A32 + r * AS + q * 8);
                        sacc = a0.x * x[0];
                        if (r > 8) sacc += a0.y * x[1];
                        if (r > 16) sacc += a0.z * x[2];
                        if (r > 24) sacc += a0.w * x[3];
                        if (r > 32) {
                            const float4 a1 = *(const float4*)(A32 + r * AS + q * 8 + 4);
                            sacc += a1.x * x[4];
                            if (r > 40) sacc += a1.y * x[5];
                            if (r > 48) sacc += a1.z * x[6];
                            if (r > 56) sacc += a1.w * x[7];
                        }
                        sacc = group_sum(sacc, 8, scr);
                    }
                    const float xr = ((r == c) ? 1.f : 0.f) - sacc;
                    if (q == (r & 7)) { x[r >> 3] = xr; Tu[r * TS + c] = f2h(xr * bc); Tw[r * TS + c] = f2h(xr * bgc); }
                }
            }
            __syncthreads();
            GDN_ROLES();
            facc vn[4], aw[4];
#pragma unroll
            for (int tt = 0; tt < 4; ++tt) { vn[tt] = facc_zero(); aw[tt] = facc_zero(); }
#pragma unroll
            for (int tt = 0; tt < 4; ++tt)
#pragma unroll
                for (int ks = 0; ks <= (tt >> 1); ++ks) {
                    const hfrag au = frag_u4(*(const uint4*)(Tu + (16 * tt + r16) * TS + 32 * ks + 8 * g)), aww = frag_u4(*(const uint4*)(Tw + (16 * tt + r16) * TS + 32 * ks + 8 * g));
                    vn[tt] = mfma16(au, frag_u4(*(const uint4*)(Vt + (16 * w + r16) * TS + 32 * ks + 8 * g)), vn[tt]);
                    aw[tt] = mfma16(aww, frag_u4(*(const uint4*)(Kt + (16 * w + r16) * TS + 32 * ks + 8 * g)), aw[tt]);
                }
#pragma unroll
            for (int tt = 0; tt < 4; ++tt)
#pragma unroll
                for (int reg = 0; reg < 4; ++reg) Ks[(16 * tt + 4 * g + reg) * QS + 16 * w + r16] = f2h(-aw[tt][reg]);
            __syncthreads();
            GDN_ROLES();
            h16_t zraw[16];
#pragma unroll
            for (int tt = 0; tt < 4; ++tt)
#pragma unroll
                for (int reg = 0; reg < 4; ++reg) zraw[tt * 4 + reg] = ACT[((size_t)b * T_ + t0 + 16 * tt + 4 * g + reg) * LDZ + Z_ZG + h * 128 + 16 * w + r16];
            hfrag Sb[4];
#pragma unroll
            for (int ks = 0; ks < 4; ++ks) Sb[ks] = frag_acc2(S[2 * ks], S[2 * ks + 1]);
            facc oc[4];
#pragma unroll
            for (int tt = 0; tt < 4; ++tt) {
                oc[tt] = facc_zero();
                const h16_t* wrow = Ks + (16 * tt + r16) * QS; const h16_t* qrow = Qs + (16 * tt + r16) * QS;
#pragma unroll
                for (int ks = 0; ks < 4; ++ks) { vn[tt] = mfma16(permfrag(wrow, ks, g), Sb[ks], vn[tt]); oc[tt] = mfma16(permfrag(qrow, ks, g), Sb[ks], oc[tt]); }
            }
            hfrag VNb[2];
            VNb[0] = frag_acc2(vn[0], vn[1]); VNb[1] = frag_acc2(vn[2], vn[3]);
#pragma unroll
            for (int tt = 0; tt < 4; ++tt)
#pragma unroll
                for (int ks2 = 0; ks2 <= (tt >> 1); ++ks2) oc[tt] = mfma16(permfrag(QKm + (16 * tt + r16) * TS, ks2, g), VNb[ks2], oc[tt]);
            {
                const float egl = fexp_(gc_s[63]);
                hfrag e1f[2];
#pragma unroll
                for (int ks2 = 0; ks2 < 2; ++ks2) { const float* ep = e1_s + 32 * ks2 + 4 * g; e1f[ks2] = frag_pack8(ep[0], ep[1], ep[2], ep[3], ep[16], ep[17], ep[18], ep[19]); }
#pragma unroll
                for (int dt = 0; dt < 8; ++dt) {
#pragma unroll
                    for (int reg = 0; reg < 4; ++reg) S[dt][reg] *= egl;
#pragma unroll
                    for (int ks2 = 0; ks2 < 2; ++ks2) S[dt] = mfma16(frag_mul(permfrag(Kt + (16 * dt + r16) * TS, ks2, g), e1f[ks2]), VNb[ks2], S[dt]);
                }
            }
            if (t0 + CH < T_) GDN_LOAD(t0 + CH);
            GDN_ROLES();
#pragma unroll
            for (int tt = 0; tt < 4; ++tt)
#pragma unroll
                for (int reg = 0; reg < 4; ++reg) { const float ss = group_sum(oc[tt][reg] * oc[tt][reg], 16, scr); if (r16 == 0) part_s[w * 64 + 16 * tt + 4 * g + reg] = ss; }
            __syncthreads();
            const float nw = p->in[I_GNW][l * 128 + w * 16 + r16];
#pragma unroll
            for (int tt = 0; tt < 4; ++tt)
#pragma unroll
                for (int reg = 0; reg < 4; ++reg) {
                    const int t = 16 * tt + 4 * g + reg;
                    float ms = 0.f;
#pragma unroll
                    for (int ww = 0; ww < 8; ++ww) ms += part_s[ww * 64 + t];
                    ob[t * 128 + 16 * w + r16] = f2h(oc[tt][reg] * rsqrtf(ms * (1.0f / 128.0f) + RMS_EPS) * nw * siluf_(h2f(zraw[tt * 4 + reg])));
                }
            __syncthreads();
            GDN_ROLES();
#pragma unroll
            for (int i = 0; i < 2; ++i) { const int j = tid + NT * i; *(uint4*)(ACT + ((size_t)b * T_ + t0 + (j >> 4)) * LDZ + Z_ZG + h * 128 + (j & 15) * 8) = *(const uint4*)(ob + (j >> 4) * 128 + (j & 15) * 8); }
            __syncthreads();
        }
#undef GDN_LOAD
#undef GDN_ROLES
    }
}

#ifndef CPU_EMU
typedef _Float16 rw_f16x8 __attribute__((ext_vector_type(8)));
typedef float rw_f32x4 __attribute__((ext_vector_type(4)));
#endif
__device__ __forceinline__ void stage_rwkv(KParams p, int l, char* smem, int vb0, int nvb) {
    const int vb = bid_() - vb0;
    if (vb < 0 || vb >= nvb) return;
    constexpr int CH = 32, XS = 264;
    float* r_s = (float*)smem;
    float* k_s = r_s + CH * 64;
    float* v_s = k_s + CH * 64;
    float* w_s = v_s + CH * 64;
    float* kk_s = w_s + CH * 64;
    float* ka_s = kk_s + CH * 64;
    float* g_s = ka_s + CH * 64;
    float* o_s = g_s + CH * 64;
    float* bon_s = o_s + CH * 64;
    float* scr = bon_s + CH;
    h16_t* raw = (h16_t*)(scr + 512);
    h16_t* xs = raw + (CH + 1) * 448;
    h16_t* ACT = (h16_t*)(p->ws + OFF_ACT);
    const int tid = tid_(), c = tid & 63, tg = tid >> 6;
    const int ri = tid >> 3, q8 = tid & 7;
    for (int item = vb; item < B_ * 16; item += nvb) {
        const int b = item / 16, h = item % 16, ch = h * 64 + c;
        const float w0 = p->in[I_RW0][l * 1024 + ch], a0 = p->in[I_RA0][l * 1024 + ch], k_k = p->in[I_RKK][l * 1024 + ch], k_a = p->in[I_RKA][l * 1024 + ch];
        const float rk_c = p->in[I_RRK][(size_t)l * 1024 + ch];
        const float lnw = p->in[I_RLW][l * 1024 + ch], lnb = p->in[I_RLB][l * 1024 + ch];
        const float* mu = p->in[I_RMU] + (size_t)l * RWW;
        const float mu_r = mu[RW_R + ch], mu_k = mu[RW_K + ch], mu_v = mu[RW_V + ch];
        const float mu_wl = mu[RW_WL + c], mu_al = mu[RW_AL + c], mu_g0 = mu[RW_GL + c], mu_g1 = mu[RW_GL + 64 + c];
        const float* wup = p->in[I_RWUP] + (size_t)l * 64 * 1024 + h * 64; const float* aup = p->in[I_RAUP] + (size_t)l * 64 * 1024 + h * 64; const float* gup = p->in[I_RGUP] + (size_t)l * 128 * 1024 + h * 64;
#ifndef CPU_EMU
        const int wid = tid >> 6, lane = tid & 63, mt = wid >> 2, nt = wid & 3;
        rw_f16x8 bw[2], ba_[2], bg[4];
        {
            const int cn = nt * 16 + (lane & 15), kb = 8 * (lane >> 4);
#pragma unroll
            for (int ks = 0; ks < 2; ++ks)
#pragma unroll
                for (int j = 0; j < 8; ++j) { bw[ks][j] = (_Float16)wup[(size_t)(ks * 32 + kb + j) * 1024 + cn]; ba_[ks][j] = (_Float16)aup[(size_t)(ks * 32 + kb + j) * 1024 + cn]; }
#pragma unroll
            for (int ks = 0; ks < 4; ++ks)
#pragma unroll
                for (int j = 0; j < 8; ++j) bg[ks][j] = (_Float16)gup[(size_t)(ks * 32 + kb + j) * 1024 + cn];
        }
#endif
        float S[8];
#pragma unroll
        for (int e = 0; e < 8; ++e) S[e] = 0.f;
        uint4 pf[4];
#define RW_LOAD(t0_) do { _Pragma("unroll") for (int i = 0; i < 4; ++i) { const int j = tid + NT * i, row = j / 56, u = j % 56, t = (t0_) - 1 + row; pf[i] = zero16(); \
            if (j < (CH + 1) * 56 && t >= 0) pf[i] = ldg16(ACT + ((size_t)b * T_ + t) * LDZ + Z_RW + (u < 24 ? (u >> 3) * 1024 + h * 64 + (u & 7) * 8 : 3072 + (u - 24) * 8)); } } while (0)
#define RW_PUT() do { _Pragma("unroll") for (int i = 0; i < 4; ++i) { const int j = tid + NT * i; if (j < (CH + 1) * 56) *(uint4*)(raw + (j / 56) * 448 + (j % 56) * 8) = pf[i]; } } while (0)
        __syncthreads();
        RW_LOAD(0);
        RW_PUT();
        __syncthreads();
#pragma unroll 1
        for (int t0 = 0; t0 < T_; t0 += CH) {
#pragma unroll
            for (int s = 0; s < 4; ++s) {
                const int tl = tg * 4 + s;
                const h16_t* zc = raw + (tl + 1) * 448; const h16_t* zp = raw + tl * 448;
#define RW_SHIFT(col, muv) ({ const float zz = h2f(zc[col]); zz + (muv) * (h2f(zp[col]) - zz); })
                r_s[tl * 64 + c] = RW_SHIFT(c, mu_r);
                k_s[tl * 64 + c] = RW_SHIFT(64 + c, mu_k);
                v_s[tl * 64 + c] = RW_SHIFT(128 + c, mu_v);
                xs[tl * XS + c] = f2h(tanhf_(RW_SHIFT(192 + c, mu_wl)));
                xs[tl * XS + 64 + c] = f2h(RW_SHIFT(256 + c, mu_al));
                xs[tl * XS + 128 + c] = f2h(sigmoidf_(RW_SHIFT(320 + c, mu_g0)));
                xs[tl * XS + 192 + c] = f2h(sigmoidf_(RW_SHIFT(384 + c, mu_g1)));
#undef RW_SHIFT
            }
            __syncthreads();
            if (t0 + CH < T_) RW_LOAD(t0 + CH);
#ifdef CPU_EMU
#pragma unroll
            for (int s = 0; s < 4; ++s) {
                const int tl = tg * 4 + s;
                float dw = 0.f, da = 0.f, dg = 0.f;
                for (int i = 0; i < 64; ++i) { dw += h2f(xs[tl * XS + i]) * h2f(f2h(wup[(size_t)i * 1024 + c])); da += h2f(xs[tl * XS + 64 + i]) * h2f(f2h(aup[(size_t)i * 1024 + c])); }
                for (int i = 0; i < 128; ++i) dg += h2f(xs[tl * XS + 128 + i]) * h2f(f2h(gup[(size_t)i * 1024 + c]));
                w_s[tl * 64 + c] = dw; ka_s[tl * 64 + c] = da; g_s[tl * 64 + c] = dg;
            }
#else
            {
                const h16_t* ap = xs + (mt * 16 + (lane & 15)) * XS + 8 * (lane >> 4);
                rw_f32x4 dw = {0.f, 0.f, 0.f, 0.f}, da = {0.f, 0.f, 0.f, 0.f}, dg = {0.f, 0.f, 0.f, 0.f};
#pragma unroll
                for (int ks = 0; ks < 2; ++ks) {
                    dw = __builtin_amdgcn_mfma_f32_16x16x32_f16(*(const rw_f16x8*)(ap + ks * 32), bw[ks], dw, 0, 0, 0);
                    da = __builtin_amdgcn_mfma_f32_16x16x32_f16(*(const rw_f16x8*)(ap + 64 + ks * 32), ba_[ks], da, 0, 0, 0);
                }
#pragma unroll
                for (int ks = 0; ks < 4; ++ks) dg = __builtin_amdgcn_mfma_f32_16x16x32_f16(*(const rw_f16x8*)(ap + 128 + ks * 32), bg[ks], dg, 0, 0, 0);
#pragma unroll
                for (int rg = 0; rg < 4; ++rg) { const int o = (mt * 16 + 4 * (lane >> 4) + rg) * 64 + nt * 16 + (lane & 15); w_s[o] = dw[rg]; ka_s[o] = da[rg]; g_s[o] = dg[rg]; }
            }
#endif
            __syncthreads();
#pragma unroll
            for (int s = 0; s < 4; ++s) {
                const int tl = tg * 4 + s;
                const float w_log = -softplusf_(-(w0 + w_s[tl * 64 + c])) - 0.5f;
                const float decay = fexp_(-fexp_(w_log));
                const float a = sigmoidf_(a0 + ka_s[tl * 64 + c]);
                const float kx = k_s[tl * 64 + c], rx = r_s[tl * 64 + c];
                const float kkr = kx * k_k, k2 = kx * (1.0f + (a - 1.0f) * k_a);
                const float nsq = group_sum(kkr * kkr, 64, scr);
                const float bon = group_sum(rx * k2 * rk_c, 64, scr);
                const float kkn = kkr * rsqrtf(nsq + RMS_EPS);
                w_s[tl * 64 + c] = decay; k_s[tl * 64 + c] = k2; kk_s[tl * 64 + c] = kkn; ka_s[tl * 64 + c] = kkn * a;
                if (c == 0) bon_s[tl] = bon;
            }
            __syncthreads();
#pragma unroll 1
            for (int t = 0; t < CH; ++t) {
                const int o8 = t * 64 + q8 * 8;
                const float4 kk0 = *(const float4*)(kk_s + o8), kk1 = *(const float4*)(kk_s + o8 + 4);
                const float pk = (S[0] * kk0.x + S[1] * kk0.y) + (S[2] * kk0.z + S[3] * kk0.w) + ((S[4] * kk1.x + S[5] * kk1.y) + (S[6] * kk1.z + S[7] * kk1.w));
                const float skk = group_sum(pk, 8, scr);
                const float vi = v_s[t * 64 + ri];
                const float4 w0v = *(const float4*)(w_s + o8), w1v = *(const float4*)(w_s + o8 + 4);
                const float4 a0v = *(const float4*)(ka_s + o8), a1v = *(const float4*)(ka_s + o8 + 4);
                const float4 k0v = *(const float4*)(k_s + o8), k1v = *(const float4*)(k_s + o8 + 4);
                const float4 r0v = *(const float4*)(r_s + o8), r1v = *(const float4*)(r_s + o8 + 4);
                S[0] = S[0] * w0v.x - skk * a0v.x + vi * k0v.x; S[1] = S[1] * w0v.y - skk * a0v.y + vi * k0v.y; S[2] = S[2] * w0v.z - skk * a0v.z + vi * k0v.z; S[3] = S[3] * w0v.w - skk * a0v.w + vi * k0v.w;
                S[4] = S[4] * w1v.x - skk * a1v.x + vi * k1v.x; S[5] = S[5] * w1v.y - skk * a1v.y + vi * k1v.y; S[6] = S[6] * w1v.z - skk * a1v.z + vi * k1v.z; S[7] = S[7] * w1v.w - skk * a1v.w + vi * k1v.w;
                const float po = (S[0] * r0v.x + S[1] * r0v.y) + (S[2] * r0v.z + S[3] * r0v.w) + ((S[4] * r1v.x + S[5] * r1v.y) + (S[6] * r1v.z + S[7] * r1v.w));
                const float o = group_sum(po, 8, scr);
                if (q8 == 0) o_s[t * 64 + ri] = o;
            }
            __syncthreads();
#pragma unroll
            for (int s = 0; s < 4; ++s) {
                const int tl = tg * 4 + s;
                const float ov = o_s[tl * 64 + c];
                const float mean = group_sum(ov, 64, scr) * (1.0f / 64.0f);
                const float d = ov - mean;
                const float var = group_sum(d * d, 64, scr) * (1.0f / 64.0f);
                const float y = (d * rsqrtf(var + GN_EPS) * lnw + lnb + bon_s[tl] * v_s[tl * 64 + c]) * g_s[tl * 64 + c];
                ACT[((size_t)b * T_ + t0 + tl) * LDZ + C_YC + ch] = f2h(y);
            }
            __syncthreads();
            if (t0 + CH < T_) RW_PUT();
            __syncthreads();
        }
#undef RW_LOAD
#undef RW_PUT
    }
}

constexpr bool TAB_IN_ACT = (M_ == 16384);
constexpr float TAB_SU = 256.0f, TAB_SV = 32.0f;
__device__ __forceinline__ unsigned char* tab_row(char* ws, int e) {
    if (TAB_IN_ACT) return (unsigned char*)((h16_t*)(ws + OFF_ACT) + (size_t)e * LDZ + C_GS);
    return (unsigned char*)(ws + OFF_TAB) + (size_t)e * 2048;
}
#ifdef CPU_EMU
__device__ __forceinline__ unsigned f2fp8(float f) {
    const unsigned sgn = f < 0.f ? 0x80u : 0u; float a = fabsf(f);
    if (!(a == a)) return 0x7fu;
    if (a >= 448.0f) return sgn | 0x7eu;
    if (a < 0.0009765625f) return sgn;
    int e; frexpf(a, &e); e -= 1;
    if (e < -6) { const float q = nearbyintf(a * 512.0f); return sgn | (unsigned)q; }
    float q = nearbyintf((a / ldexpf(1.0f, e) - 1.0f) * 8.0f);
    if (q >= 8.0f) { q = 0.f; e += 1; }
    if (e > 8) return sgn | 0x7eu;
    const unsigned r = ((unsigned)(e + 7) << 3) | (unsigned)q;
    return sgn | (r > 0x7eu ? 0x7eu : r);
}
__device__ __forceinline__ float fp82f(unsigned b) {
    const unsigned e = (b >> 3) & 15u, m = b & 7u; const float s = (b & 0x80u) ? -1.f : 1.f;
    if (e == 0) return s * (float)m * 0.001953125f;
    return s * ldexpf(1.0f + (float)m * 0.125f, (int)e - 7);
}
__device__ __forceinline__ unsigned pack4fp8(float a, float b, float c, float d) { return f2fp8(a) | (f2fp8(b) << 8) | (f2fp8(c) << 16) | (f2fp8(d) << 24); }
__device__ __forceinline__ void dec4fp8(unsigned w, float* o) { o[0] = fp82f(w & 255u); o[1] = fp82f((w >> 8) & 255u); o[2] = fp82f((w >> 16) & 255u); o[3] = fp82f(w >> 24); }
#else
__device__ __forceinline__ unsigned pack4fp8(float a, float b, float c, float d) { int p = __builtin_amdgcn_cvt_pk_fp8_f32(a, b, 0, false); p = __builtin_amdgcn_cvt_pk_fp8_f32(c, d, p, true); return (unsigned)p; }
__device__ __forceinline__ void dec4fp8(unsigned w, float* o) { const auto lo = __builtin_amdgcn_cvt_pk_f32_fp8((int)w, false); const auto hi = __builtin_amdgcn_cvt_pk_f32_fp8((int)w, true); o[0] = lo[0]; o[1] = lo[1]; o[2] = hi[0]; o[3] = hi[1]; }
#endif
__device__ __forceinline__ void stage_tabconv(KParams p, int l) {
    const int tid = tid_();
    const float* U = p->in[I_PU] + (size_t)l * 16384 * 1024; const float* V = p->in[I_PV] + (size_t)l * 16384 * 1024;
    char* ws = p->ws;
    for (int it = bid_() * NT + tid; it < 16384 * 128; it += gridDim.x * NT) {
        const int r = it >> 7, ck = it & 127, which = ck >> 6, c16 = ck & 63;
        const float* src = (which ? V : U) + (size_t)r * 1024 + c16 * 16;
        const float sc = which ? TAB_SV : TAB_SU;
        const float4 a = *(const float4*)src, b = *(const float4*)(src + 4), c = *(const float4*)(src + 8), d = *(const float4*)(src + 12);
        uint4 w;
        w.x = pack4fp8(a.x * sc, a.y * sc, a.z * sc, a.w * sc); w.y = pack4fp8(b.x * sc, b.y * sc, b.z * sc, b.w * sc);
        w.z = pack4fp8(c.x * sc, c.y * sc, c.z * sc, c.w * sc); w.w = pack4fp8(d.x * sc, d.y * sc, d.z * sc, d.w * sc);
        *(uint4*)(tab_row(ws, r) + which * 1024 + c16 * 16) = w;
    }
}

__device__ __forceinline__ void stage_peer_topk(KParams p, int l, char* smem) {
    float* key_s = (float*)smem;
    const h16_t* ACT = (const h16_t*)(p->ws + OFF_ACT);
    float* TOPS = (float*)(p->ws + OFF_TOPS);
    const int tid = tid_();
    const int nb = gridDim.x;
    for (int hs = bid_() % 16; hs < 16; hs += nb) {
        const int hd = hs >> 1, s = hs & 1;
        __syncthreads();
        {
            const float* kp = p->in[I_PKEYS] + (((size_t)l * 8 + hd) * 2 + s) * 128 * 128;
            for (int i = tid * 4; i < 128 * 128; i += NT * 4) *(float4*)(key_s + i) = *(const float4*)(kp + i);
        }
        __syncthreads();
        const int nblk = nb >= 16 ? nb / 16 : 1, bsub = nb >= 16 ? bid_() / 16 : 0;
        for (int chunk = bsub; chunk < (M_ + NT - 1) / NT; chunk += nblk) {
            if (nb >= 16 && bid_() >= nblk * 16) break;
            const int m = chunk * NT + tid;
            if (m >= M_) continue;
            float q[128];
            {
                const h16_t* qp = ACT + (size_t)m * LDZ + C_QRY + hd * 256 + s * 128;
#pragma unroll
                for (int c8 = 0; c8 < 16; ++c8) { float t8[8]; load8h(qp + c8 * 8, t8);
#pragma unroll
                    for (int j = 0; j < 8; ++j) q[c8 * 8 + j] = t8[j]; }
            }
            float top[16];
#pragma unroll
            for (int i = 0; i < 16; ++i) top[i] = -3.0e38f;
#pragma unroll 2
            for (int n = 0; n < 128; ++n) {
                const float* kr = key_s + n * 128;
                float a0 = 0.f, a1 = 0.f, a2 = 0.f, a3 = 0.f;
#pragma unroll
                for (int c4 = 0; c4 < 32; ++c4) {
                    const float4 kv = *(const float4*)(kr + c4 * 4);
                    a0 += q[c4 * 4] * kv.x; a1 += q[c4 * 4 + 1] * kv.y; a2 += q[c4 * 4 + 2] * kv.z; a3 += q[c4 * 4 + 3] * kv.w;
                }
                float x = __uint_as_float((__float_as_uint((a0 + a1) + (a2 + a3)) & ~127u) | (unsigned)(127 - n));
#pragma unroll
                for (int i = 0; i < 16; ++i) { const float hi = fmaxf(top[i], x); x = fminf(top[i], x); top[i] = hi; }
            }
            float* tp = TOPS + (((size_t)m * 8 + hd) * 2 + s) * 16;
#pragma unroll
            for (int i = 0; i < 16; i += 4) *(float4*)(tp + i) = make_float4(top[i], top[i + 1], top[i + 2], top[i + 3]);
        }
    }
}

__device__ __forceinline__ void peer_cand(int k, int& i, int& j) {
    if (k < 16) { i = 0; j = k; } else if (k < 24) { i = 1; j = k - 16; } else if (k < 29) { i = 2; j = k - 24; } else if (k < 33) { i = 3; j = k - 29; }
    else if (k < 36) { i = 4; j = k - 33; } else if (k < 38) { i = 5; j = k - 36; } else if (k < 40) { i = 6; j = k - 38; } else if (k < 42) { i = 7; j = k - 40; }
    else { i = k - 34; j = 0; }
}
__device__ __forceinline__ float dot16q(const uint4 a, const float (&x)[16]) {
    float t[4], s0, s1;
    dec4fp8(a.x, t); s0 = t[0] * x[0] + t[1] * x[1]; s1 = t[2] * x[2] + t[3] * x[3];
    dec4fp8(a.y, t); s0 += t[0] * x[4] + t[1] * x[5]; s1 += t[2] * x[6] + t[3] * x[7];
    dec4fp8(a.z, t); s0 += t[0] * x[8] + t[1] * x[9]; s1 += t[2] * x[10] + t[3] * x[11];
    dec4fp8(a.w, t); s0 += t[0] * x[12] + t[1] * x[13]; s1 += t[2] * x[14] + t[3] * x[15];
    return s0 + s1;
}
__device__ __forceinline__ void axpy16q(const uint4 a, float s, float (&y)[16]) {
    float t[4];
    dec4fp8(a.x, t); y[0] += s * t[0]; y[1] += s * t[1]; y[2] += s * t[2]; y[3] += s * t[3];
    dec4fp8(a.y, t); y[4] += s * t[0]; y[5] += s * t[1]; y[6] += s * t[2]; y[7] += s * t[3];
    dec4fp8(a.z, t); y[8] += s * t[0]; y[9] += s * t[1]; y[10] += s * t[2]; y[11] += s * t[3];
    dec4fp8(a.w, t); y[12] += s * t[0]; y[13] += s * t[1]; y[14] += s * t[2]; y[15] += s * t[3];
}
#ifdef CPU_EMU
__device__ __forceinline__ float lane_xor(float v, int mask, float* scr) { const int tid = tid_(); scr[tid] = v; __syncthreads(); const float r = scr[tid ^ mask]; __syncthreads(); return r; }
__device__ __forceinline__ float lane_bcast(float v, int src, float* scr) { const int tid = tid_(); scr[tid] = v; __syncthreads(); const float r = scr[(tid & ~63) + src]; __syncthreads(); return r; }
#else
__device__ __forceinline__ float lane_xor(float v, int mask, float*) { return mask == 1 ? dpp_f<0xB1>(v) : (mask == 2 ? dpp_f<0x4E>(v) : __shfl_xor(v, mask)); }
__device__ __forceinline__ float lane_bcast(float v, int src, float*) { return __builtin_bit_cast(float, __builtin_amdgcn_readlane(__builtin_bit_cast(int, v), src)); }
#endif
__device__ __forceinline__ float reduce8(const float (&v)[8], int lane, float* scr) {
    const bool b0 = lane & 1, b1 = lane & 2, b2 = lane & 4;
    float w4[4], u2[2];
#pragma unroll
    for (int j = 0; j < 4; ++j) { const float keep = b0 ? v[2 * j + 1] : v[2 * j], send = b0 ? v[2 * j] : v[2 * j + 1]; w4[j] = keep + lane_xor(send, 1, scr); }
#pragma unroll
    for (int j = 0; j < 2; ++j) { const float keep = b1 ? w4[2 * j + 1] : w4[2 * j], send = b1 ? w4[2 * j] : w4[2 * j + 1]; u2[j] = keep + lane_xor(send, 2, scr); }
    float z = (b2 ? u2[1] : u2[0]) + lane_xor(b2 ? u2[0] : u2[1], 4, scr);
    z += lane_xor(z, 8, scr); z += lane_xor(z, 16, scr); z += lane_xor(z, 32, scr);
    return z;
}
__device__ __forceinline__ void stage_peer_gather(KParams p, int l, char* smem) {
    int tid = tid_(), w = tid >> 6, lane = tid & 63;
    float* base; float* tops_s; float* cand_s; float* best_s; int* idx_s; float* gate_s; int* pos_s;
#define PG_ROLES() do { tid = tid_(); w = tid >> 6; lane = tid & 63; base = (float*)smem + w * 2048; tops_s = base; cand_s = tops_s + 256; best_s = cand_s + 64; \
        idx_s = (int*)(best_s + 128); gate_s = (float*)(idx_s + 128); pos_s = (int*)(gate_s + 128); } while (0)
    PG_ROLES();
    float* scr = (float*)smem + 8 * 2048;
    h16_t* ACT = (h16_t*)(p->ws + OFF_ACT);
    const float* TOPS = (const float*)(p->ws + OFF_TOPS);
    char* ws = p->ws;
    const float* nxt_w = (l + 1 < NL_) ? p->in[I_NMIX] + (l + 1) * 1024 : p->in[I_NFINAL];
    const int nwaves = gridDim.x * 8;
    for (int m = bid_() * 8 + w; m < M_; m += nwaves) {
        PG_ROLES();
        __syncthreads();
        *(float4*)(tops_s + lane * 4) = *(const float4*)(TOPS + (size_t)m * 256 + lane * 4);
        float x[16];
        { float t8[8]; load8h(ACT + (size_t)m * LDZ + C_XN + lane * 16, t8);
#pragma unroll
          for (int j = 0; j < 8; ++j) x[j] = t8[j];
          load8h(ACT + (size_t)m * LDZ + C_XN + lane * 16 + 8, t8);
#pragma unroll
          for (int j = 0; j < 8; ++j) x[8 + j] = t8[j]; }
        __syncthreads();
        int ci = 0, cj = 0;
        if (lane < 50) peer_cand(lane, ci, cj);
        const int pos = ci * 16 + cj;
        pos_s[lane] = pos;
#pragma unroll 1
        for (int hd = 0; hd < 8; ++hd) {
            const float cs = lane < 50 ? tops_s[hd * 32 + ci] + tops_s[hd * 32 + 16 + cj] : -3.0e38f;
            cand_s[lane] = cs;
            __syncthreads();
            if (lane < 50) {
                int cnt = 0;
#pragma unroll 10
                for (int o = 0; o < 50; ++o) { const float ov = cand_s[o]; cnt += (ov > cs || (ov == cs && pos_s[o] < pos)) ? 1 : 0; }
                if (cnt < 16) {
                    best_s[hd * 16 + cnt] = cs;
                    const int n0 = 127 - (int)(__float_as_uint(tops_s[hd * 32 + ci]) & 127u), n1 = 127 - (int)(__float_as_uint(tops_s[hd * 32 + 16 + cj]) & 127u);
                    idx_s[hd * 16 + cnt] = n0 * 128 + n1;
                }
            }
            __syncthreads();
        }
#pragma unroll
        for (int rr = 0; rr < 2; ++rr) {
            const int e = lane + 64 * rr, hd = e >> 4;
            const float mx = best_s[hd * 16];
            float sum = 0.f;
#pragma unroll
            for (int i = 0; i < 16; ++i) sum += fexp_(best_s[hd * 16 + i] - mx);
            gate_s[e] = fexp_(best_s[e] - mx) / sum;
        }
        __syncthreads();
        float y[16];
#pragma unroll
        for (int i = 0; i < 16; ++i) y[i] = 0.f;
        PG_ROLES();
        uint4 uu[8], vv[8];
#define PG_LOADU(eb_) do { _Pragma("unroll") for (int k = 0; k < 8; ++k) uu[k] = *(const uint4*)(tab_row(ws, idx_s[(eb_) + k]) + lane * 16); } while (0)
#define PG_LOADV(eb_) do { _Pragma("unroll") for (int k = 0; k < 8; ++k) vv[k] = *(const uint4*)(tab_row(ws, idx_s[(eb_) + k]) + 1024 + lane * 16); } while (0)
        PG_LOADU(0); PG_LOADV(0);
#pragma unroll 1
        for (int eb = 0; eb < 128; eb += 8) {
            float d8[8];
#pragma unroll
            for (int k = 0; k < 8; ++k) d8[k] = dot16q(uu[k], x);
            if (eb + 8 < 128) PG_LOADU(eb + 8);
            const float tot = reduce8(d8, lane, scr);
            const float hk = gate_s[eb + (lane & 7)] * geluf_(tot * (1.0f / TAB_SU));
#pragma unroll
            for (int k = 0; k < 8; ++k) axpy16q(vv[k], lane_bcast(hk, k, scr), y);
            if (eb + 8 < 128) PG_LOADV(eb + 8);
        }
#undef PG_LOADU
#undef PG_LOADV
        PG_ROLES();
        float* op = p->out + (size_t)m * 1024 + lane * 16;
        float hn[16]; float ss = 0.f;
#pragma unroll
        for (int i = 0; i < 16; i += 4) {
            const float4 o4 = *(const float4*)(op + i);
            hn[i] = o4.x + y[i] * (1.0f / TAB_SV); hn[i + 1] = o4.y + y[i + 1] * (1.0f / TAB_SV); hn[i + 2] = o4.z + y[i + 2] * (1.0f / TAB_SV); hn[i + 3] = o4.w + y[i + 3] * (1.0f / TAB_SV);
            ss += hn[i] * hn[i] + hn[i + 1] * hn[i + 1] + hn[i + 2] * hn[i + 2] + hn[i + 3] * hn[i + 3];
        }
        ss = group_sum(ss, 64, scr);
        const float rstd = rsqrtf(ss * (1.0f / D_) + RMS_EPS);
        float nv[16];
#pragma unroll
        for (int i = 0; i < 16; i += 4) { const float4 w4 = *(const float4*)(nxt_w + lane * 16 + i); nv[i] = hn[i] * rstd * w4.x; nv[i + 1] = hn[i + 1] * rstd * w4.y; nv[i + 2] = hn[i + 2] * rstd * w4.z; nv[i + 3] = hn[i + 3] * rstd * w4.w; }
        if (l + 1 < NL_) {
#pragma unroll
            for (int i = 0; i < 16; i += 4) *(float4*)(op + i) = make_float4(hn[i], hn[i + 1], hn[i + 2], hn[i + 3]);
            const float n0[8] = {nv[0], nv[1], nv[2], nv[3], nv[4], nv[5], nv[6], nv[7]}, n1[8] = {nv[8], nv[9], nv[10], nv[11], nv[12], nv[13], nv[14], nv[15]};
            store8h(ACT + (size_t)m * LDZ + C_XN + lane * 16, n0); store8h(ACT + (size_t)m * LDZ + C_XN + lane * 16 + 8, n1);
        } else {
#pragma unroll
            for (int i = 0; i < 16; i += 4) *(float4*)(op + i) = make_float4(nv[i], nv[i + 1], nv[i + 2], nv[i + 3]);
        }
    }
}
#undef PG_ROLES

enum { PH_NORM_MIX = 0, PH_INPROJ, PH_MIXERS, PH_MERGE, PH_WOUT, PH_NORM_FFN, PH_QUERY, PH_TOPK, PH_GATHER, PH_PER_LAYER, PH_FINAL = 100, PH_WPREP = 101 };
__device__ __forceinline__ void run_phase(KParams p, int l, int ph, char* smem) {
    h16_t* ACT = (h16_t*)(p->ws + OFF_ACT);
    const float* hin = l == 0 ? p->in[I_X] : p->out;
    switch (ph) {
    case PH_WPREP: stage_wprep(p, smem); break;
    case PH_NORM_MIX: if (l == 0) stage_rmsnorm<false>(hin, p->in[I_NMIX] + l * 1024, ACT + C_XN, LDZ, smem); break;
    case PH_INPROJ: stage_gemm(p, l, GP_INPROJ, smem); break;
    case PH_MIXERS: {
        const int nb = gridDim.x, n_rw = nb / 2, n_gd = nb / 4, n_lr = nb - n_rw - n_gd;
        stage_rwkv(p, l, smem, 0, n_rw);
        stage_gdn(p, l, smem, n_rw, n_gd);
        stage_lru(p, l, smem, n_rw + n_gd, n_lr);
    } break;
    case PH_MERGE: stage_gemm(p, l, GP_MERGE, smem); break;
    case PH_WOUT: stage_gemm(p, l, GP_WOUT, smem); break;
    case PH_NORM_FFN: stage_rmsnorm<false>(p->out, p->in[I_NFFN] + l * 1024, ACT + C_XN, LDZ, smem); stage_tabconv(p, l); break;
    case PH_QUERY: stage_gemm(p, l, GP_QUERY, smem); break;
    case PH_TOPK: stage_peer_topk(p, l, smem); break;
    case PH_GATHER: stage_peer_gather(p, l, smem); break;
    case PH_FINAL: break;
    default: break;
    }
}

#if !defined(CPU_EMU) && !MK_MULTI
__global__ void __launch_bounds__(512, 2) k_mega(Params p_) {
    DYN_SMEM(smem);
    KParams pk = (KParams)__builtin_amdgcn_kernarg_segment_ptr();
    cg::grid_group grid = cg::this_grid();
    constexpr int NIT = NL_ * PH_PER_LAYER;
#pragma unroll 1
    for (int it = -1; it <= NIT; ++it) {
        const int l = (it >= 0 && it < NIT) ? it / PH_PER_LAYER : 0, ph = it < 0 ? (int)PH_WPREP : (it < NIT ? it % PH_PER_LAYER : (int)PH_FINAL);
        KParams q = pk; asm volatile("" : "+s"(q));
        run_phase(q, l, ph, smem);
        if (it >= 0 && it < NIT - 1 && !(l > 0 && ph == PH_NORM_MIX)) grid.sync();
    }
}
#endif
#ifdef CPU_EMU
__global__ void k_phase(Params p_, int l, int ph) { DYN_SMEM(smem); run_phase(&p_, l, ph, smem); }
#elif MK_MULTI
__global__ void __launch_bounds__(512, 2) k_phase(Params p_, int l, int ph) { DYN_SMEM(smem); KParams pk = (KParams)__builtin_amdgcn_kernarg_segment_ptr(); run_phase(pk, l, ph, smem); }
#endif
}

#ifdef CPU_EMU
int g_emu_stop = 1000;
#endif

extern "C" void kernel_launch(void* const* d_in, const int* in_sizes, int n_in, void* d_out, int out_size, void* d_ws, size_t ws_size, hipStream_t stream) {
    Params p{};
    for (int i = 0; i < N_IN; ++i) p.in[i] = (const float*)d_in[i];
    p.out = (float*)d_out; p.ws = (char*)d_ws;
#if defined(CPU_EMU) || MK_MULTI
    const int grid = 256;
    LAUNCH(k_phase, grid, NT, SMEM_BYTES, stream, p, 0, (int)PH_WPREP);
    for (int l = 0; l < NL_; ++l)
        for (int ph = 0; ph < PH_PER_LAYER; ++ph) {
            LAUNCH(k_phase, grid, NT, SMEM_BYTES, stream, p, l, ph);
#ifdef CPU_EMU
            const int code = ph == PH_INPROJ ? 1 : ph == PH_MIXERS ? 2 : ph == PH_MERGE ? 3 : ph == PH_WOUT ? 4 : ph == PH_GATHER ? 5 : 0;
            if (code && g_emu_stop == l * 10 + code) return;
#endif
        }
    LAUNCH(k_phase, grid, NT, SMEM_BYTES, stream, p, 0, (int)PH_FINAL);
#else
    static int grid_blocks = 0;
    if (!grid_blocks) {
        int dev = 0, cus = 0, per_cu = 0;
        (void)hipGetDevice(&dev);
        (void)hipDeviceGetAttribute(&cus, hipDeviceAttributeMultiprocessorCount, dev);
        (void)hipFuncSetAttribute((const void*)k_mega, hipFuncAttributeMaxDynamicSharedMemorySize, (int)SMEM_BYTES);
        (void)hipOccupancyMaxActiveBlocksPerMultiprocessor(&per_cu, k_mega, NT, SMEM_BYTES);
        if (per_cu > 1) per_cu = 1;
        grid_blocks = cus * per_cu;
    }
    void* args[] = {&p};
    hipError_t e = hipLaunchCooperativeKernel((void*)k_mega, dim3(grid_blocks), dim3(NT), args, SMEM_BYTES, stream);
    if (e != hipSuccess) fprintf(stderr, "cooperative launch failed: %s (grid %d)\n", hipGetErrorString(e), grid_blocks);
#endif
}
```

```cpp
#ifndef CPU_EMU
#include <hip/hip_runtime.h>
#include <hip/hip_cooperative_groups.h>
#include <cstdio>
#include <cstdint>
namespace cg = cooperative_groups;
#define DYN_SMEM(name) extern __shared__ __attribute__((aligned(16))) char name[]
#define LAUNCH(kern, grid, block, smem, stream, ...) hipLaunchKernelGGL(kern, dim3(grid), dim3(block), smem, stream, __VA_ARGS__)
#endif

#ifndef CFG_B
#define CFG_B 8
#endif
#ifndef CFG_T
#define CFG_T 2048
#endif
#ifndef MK_MULTI
#define MK_MULTI 0
#endif

namespace {
constexpr int B_ = CFG_B, T_ = CFG_T, M_ = B_ * T_, D_ = 1024, NL_ = 2, NT = 512;
constexpr int INW = 12560;
constexpr int LDZ = 11776;
constexpr int Z_ULRU = 0, Z_GLRU = 1024, Z_Q = 2048, Z_K = 3072, Z_V = 4096, Z_ZG = 5120, Z_RW = 6144, Z_ALPHA = 9472, Z_BETA = 9480;
constexpr int ZN = 9728;
constexpr int C_XN = 9728, C_YC = 10752;
constexpr int C_YA = Z_GLRU, C_YB = Z_ZG;
constexpr int C_GS = Z_Q, C_MG = Z_K;
constexpr int C_QRY = 0;
constexpr int RW_R = 0, RW_K = 1024, RW_V = 2048, RW_WL = 3072, RW_AL = 3136, RW_GL = 3200, RWW = 3328;
constexpr float RMS_EPS = 1e-6f, GN_EPS = 64e-5f;
typedef unsigned short h16_t;

enum { I_X = 0, I_NMIX, I_NFFN, I_NFINAL, I_WIN, I_LCW, I_LCB, I_LWA, I_LBA, I_LWX, I_LBX, I_LLAM, I_GCW, I_GALOG, I_GDT, I_GNW,
       I_RMU, I_RW0, I_RWUP, I_RA0, I_RAUP, I_RGUP, I_RKK, I_RKA, I_RRK, I_RLW, I_RLB, I_MB, I_PL, I_PG, I_PR, I_WOUT, I_PWQ, I_PKEYS, I_PU, I_PV, N_IN };

struct Params {
    const float* in[N_IN];
    float* out;
    char* ws;
};
#ifdef CPU_EMU
typedef const Params* KParams;
#else
typedef const Params __attribute__((address_space(4)))* KParams;
#endif

constexpr size_t al256(size_t x) { return (x + 255) / 256 * 256; }
constexpr size_t OFF_ACT = 0;
constexpr size_t OFF_WT = al256(OFF_ACT + (size_t)M_ * LDZ * 2);
constexpr int WT_IN = 0, WT_MG = ZN, WT_P = WT_MG + 3072, WT_OUT = WT_P + 3072, WT_Q = WT_OUT + 1024, WT_ROWS = WT_Q + 2048;
constexpr size_t OFF_TOPS = al256(OFF_WT + (size_t)NL_ * WT_ROWS * 1024 * 2);
constexpr size_t OFF_TAB = al256(OFF_TOPS + (size_t)M_ * 256 * 4);
constexpr size_t OFF_BAR = OFF_TAB + (M_ == 16384 ? 0 : (size_t)16384 * 2048);
constexpr size_t WS_END = OFF_BAR + 16384;
static_assert(CFG_B != 8 || CFG_T != 2048 || WS_END <= (size_t)512 * 1024 * 1024, "workspace budget");
constexpr size_t SMEM_BYTES = 128 * 1024;

#ifdef CPU_EMU
__device__ __forceinline__ int tid_() { return threadIdx.x; }
__device__ __forceinline__ h16_t f2h(float f) { return (h16_t)_cvtss_sh(f, _MM_FROUND_TO_NEAREST_INT); }
__device__ __forceinline__ float h2f(h16_t h) { return _cvtsh_ss(h); }
#else
__device__ __forceinline__ int tid_() { int t = threadIdx.x; asm volatile("" : "+v"(t)); return t; }
__device__ __forceinline__ h16_t f2h(float f) { return __builtin_bit_cast(unsigned short, (_Float16)f); }
__device__ __forceinline__ float h2f(h16_t h) { return (float)__builtin_bit_cast(_Float16, h); }
#endif
__device__ __forceinline__ int bid_() { return (int)blockIdx.x; }

#ifdef CPU_EMU
__device__ __forceinline__ float fexp_(float x) { return expf(x); }
__device__ __forceinline__ float flog_(float x) { return logf(x); }
__device__ __forceinline__ float frcp_(float x) { return 1.0f / x; }
#else
__device__ __forceinline__ float fexp_(float x) { return __builtin_amdgcn_exp2f(x * 1.4426950408889634f); }
__device__ __forceinline__ float flog_(float x) { return __builtin_amdgcn_logf(x) * 0.6931471805599453f; }
__device__ __forceinline__ float frcp_(float x) { return __builtin_amdgcn_rcpf(x); }
#endif
__device__ __forceinline__ float sigmoidf_(float x) { return frcp_(1.0f + fexp_(-x)); }
__device__ __forceinline__ float softplusf_(float x) { return fmaxf(x, 0.0f) + flog_(1.0f + fexp_(-fabsf(x))); }
__device__ __forceinline__ float siluf_(float x) { return x * sigmoidf_(x); }
__device__ __forceinline__ float tanhf_(float x) { return 1.0f - 2.0f * frcp_(1.0f + fexp_(2.0f * x)); }
__device__ __forceinline__ float geluf_(float x) { return x * frcp_(1.0f + fexp_(-1.5957691216057308f * (x + 0.044715f * x * x * x))); }
__device__ __forceinline__ unsigned pack2h(float a, float b) { return (unsigned)f2h(a) | ((unsigned)f2h(b) << 16); }
__device__ __forceinline__ void store8h(h16_t* p, const float (&v)[8]) {
    uint4 w; w.x = pack2h(v[0], v[1]); w.y = pack2h(v[2], v[3]); w.z = pack2h(v[4], v[5]); w.w = pack2h(v[6], v[7]);
    *(uint4*)p = w;
}
__device__ __forceinline__ void load8h(const h16_t* p, float (&v)[8]) {
    const uint4 w = *(const uint4*)p;
    v[0] = h2f((h16_t)(w.x & 0xffffu)); v[1] = h2f((h16_t)(w.x >> 16)); v[2] = h2f((h16_t)(w.y & 0xffffu)); v[3] = h2f((h16_t)(w.y >> 16));
    v[4] = h2f((h16_t)(w.z & 0xffffu)); v[5] = h2f((h16_t)(w.z >> 16)); v[6] = h2f((h16_t)(w.w & 0xffffu)); v[7] = h2f((h16_t)(w.w >> 16));
}

__device__ __forceinline__ float block_sum512(float v, float* red) {
    const int tid = tid_();
    red[tid] = v;
    __syncthreads();
    if (tid < 32) { float s = 0.f; for (int i = 0; i < 16; ++i) s += red[tid * 16 + i]; red[512 + tid] = s; }
    __syncthreads();
    float tot = 0.f;
    for (int i = 0; i < 32; ++i) tot += red[512 + i];
    __syncthreads();
    return tot;
}

template <bool OUT_F32>
__device__ __forceinline__ void stage_rmsnorm(const float* src, const float* w, void* dst, int ldd, char* smem) {
    float* red = (float*)smem;
    const int tid = tid_();
    for (int row = bid_(); row < M_; row += gridDim.x) {
        const float2 v = *(const float2*)(src + (size_t)row * D_ + tid * 2);
        const float ss = block_sum512(v.x * v.x + v.y * v.y, red);
        const float rstd = rsqrtf(ss * (1.0f / D_) + RMS_EPS);
        const float2 wv = *(const float2*)(w + tid * 2);
        const float o0 = v.x * rstd * wv.x, o1 = v.y * rstd * wv.y;
        if (OUT_F32) {
            float2 o; o.x = o0; o.y = o1;
            *(float2*)((float*)dst + (size_t)row * ldd + tid * 2) = o;
        } else {
            *(unsigned*)((h16_t*)dst + (size_t)row * ldd + tid * 2) = pack2h(o0, o1);
        }
    }
}

__device__ __forceinline__ const float* wt_src(KParams p, int l, int r, int& ld) {
    if (r < ZN) {
        ld = INW;
        int c;
        if (r < 6144) c = r; else if (r < 9472) c = r + 16; else if (r < 9488) c = r - 3328; else return nullptr;
        return p->in[I_WIN] + (size_t)l * 1024 * INW + c;
    }
    r -= ZN;
    if (r < 3072) { ld = INW; return p->in[I_WIN] + (size_t)l * 1024 * INW + 9488 + r; }
    r -= 3072;
    if (r < 3072) { ld = 1024; const int br = r >> 10; return p->in[br == 0 ? I_PL : (br == 1 ? I_PG : I_PR)] + (size_t)l * 1024 * 1024 + (r & 1023); }
    r -= 3072;
    if (r < 1024) { ld = 1024; return p->in[I_WOUT] + (size_t)l * 1024 * 1024 + r; }
    r -= 1024;
    ld = 2048; return p->in[I_PWQ] + (size_t)l * 1024 * 2048 + r;
}
__device__ __forceinline__ void stage_wprep(KParams p, char* smem) {
    float* tile = (float*)smem;
    h16_t* WT = (h16_t*)(p->ws + OFF_WT);
    const int tid = tid_();
    const int ntr = WT_ROWS / 64, total = NL_ * ntr * 16;
    for (int it = bid_(); it < total; it += gridDim.x) {
        const int l = it / (ntr * 16), rem = it % (ntr * 16), rt = rem / 16, kt = rem % 16;
        const int r0 = rt * 64, k0 = kt * 64;
        __syncthreads();
        {
            const int nn = tid & 63;
            int ld = 0; const float* src = wt_src(p, l, r0 + nn, ld);
#pragma unroll
            for (int i = 0; i < 8; ++i) { const int kk = (tid >> 6) + 8 * i; tile[kk * 65 + nn] = src ? src[(size_t)(k0 + kk) * ld] : 0.f; }
        }
        __syncthreads();
        {
            const int r = tid >> 3, kq = (tid & 7) * 8;
            float v[8];
#pragma unroll
            for (int j = 0; j < 8; ++j) v[j] = tile[(kq + j) * 65 + r];
            store8h(WT + ((size_t)l * WT_ROWS + r0 + r) * 1024 + k0 + kq, v);
        }
    }
}

namespace pg8 {
constexpr int BM = 256, BK = 64, HALF = 128, HTB = HALF * BK * 2, STAGE_BYTES = 8 * HTB, NXCD = 8, WGM = 8;
struct Unit { const char* A; const char* B; int pm, pn, kind; };
#ifdef CPU_EMU
struct f32x4 { float d[4]; float& operator[](int i) { return d[i]; } const float& operator[](int i) const { return d[i]; } };
#else
#define PG8_LAS __attribute__((address_space(3)))
typedef _Float16 f16x8 __attribute__((ext_vector_type(8)));
typedef float f32x4 __attribute__((ext_vector_type(4)));
__device__ __forceinline__ int lds_byte(int r, int c) { const int st = (r >> 4) * 2 + (c >> 5), rr = r & 15, cc = c & 31, ob = rr * 64 + cc * 2; return st * 1024 + (ob ^ (((ob >> 9) & 1) << 5)); }
__device__ __forceinline__ void stage_rc(int b, int& R, int& C) { const int st = b / 1024, sb = b % 1024, swz = sb ^ (((sb >> 9) & 1) << 5); R = (st >> 1) * 16 + swz / 64; C = (st & 1) * 32 + (swz % 64) / 2; }
__device__ __forceinline__ int perm32(int rho) { const int n = rho >> 4, i = rho & 15; return 8 * (i >> 2) + 4 * n + (i & 3); }
#endif
__device__ __forceinline__ void tile_of(int L, int nM, int nN, int& pm, int& pn) {
    const int nwg = nM * nN;
    int wgid = L; { const int q = nwg / NXCD, r = nwg % NXCD, xcd = wgid % NXCD, off = wgid / NXCD; wgid = (xcd < r ? xcd * (q + 1) : r * (q + 1) + (xcd - r) * q) + off; }
    const int nig = WGM * nN, gid = wgid / nig, fm = gid * WGM, gsz = (nM - fm) < WGM ? (nM - fm) : WGM;
    pm = fm + ((wgid % nig) % gsz); pn = (wgid % nig) / gsz;
}

template <class Sched, class Epi>
__device__ __forceinline__ void gemm_phase(char* smem, const Sched& S, const Epi& E) {
    constexpr int K = 1024, nt = K / BK;
    constexpr unsigned lda = LDZ, ldb = 1024;
#ifdef CPU_EMU
    const int tid = tid_(), wid = tid >> 6, lane = tid & 63, wr = wid >> 2, wc = wid & 3, fr = lane & 15, fq = lane >> 4;
    Unit u;
    for (int ui = 0; S.next(ui, u); ++ui) {
        f32x4 acc[2][2][4][2];
        for (int ai = 0; ai < 2; ++ai) for (int bj = 0; bj < 2; ++bj) for (int m = 0; m < 4; ++m) for (int n = 0; n < 2; ++n) for (int e = 0; e < 4; ++e) {
            const int r = 128 * ai + 64 * wr + 16 * m + fr, c = 128 * bj + 32 * wc + 8 * fq + 4 * n + e;
            const h16_t* a = (const h16_t*)u.A + (size_t)r * lda; const h16_t* b = (const h16_t*)u.B + (size_t)c * ldb;
            float s = 0.f;
            for (int k = 0; k < K; ++k) s += h2f(a[k]) * h2f(b[k]);
            acc[ai][bj][m][n][e] = s;
        }
        E(acc, u, wr, wc, fr, fq);
    }
    (void)smem; (void)nt;
#else
    PG8_LAS unsigned char* lds = (PG8_LAS unsigned char*)smem;
    const int tid = tid_(), wid = __builtin_amdgcn_readfirstlane(tid >> 6), lane = tid & 63, wr = wid >> 2, wc = wid & 3, fr = lane & 15, fq = lane >> 4;
    unsigned voffA[2], voffB[2];
#pragma unroll
    for (int i = 0; i < 2; ++i) { int R, C; stage_rc(tid * 16 + i * 8192, R, C); const int Rb = (R & ~31) + perm32(R & 31);
        voffA[i] = (unsigned)(R * lda + C) * 2u; voffB[i] = (unsigned)(Rb * ldb + C) * 2u; }
    constexpr size_t kstep = (size_t)(BK * 2);
    constexpr size_t hstepA = (size_t)HALF * lda * 2, hstepB = (size_t)HALF * ldb * 2;
    const unsigned ldsw = (unsigned)wid * 1024u;
    const int aoff = lds_byte(wr * 64 + fr, fq * 8), boff = lds_byte(wc * 32 + fr, fq * 8);
#define PG8_SA(b, h) (((b) * 2 + (h)) * HTB)
#define PG8_SB(b, h) ((4 + (b) * 2 + (h)) * HTB)
#define PG8_STAGE(bufoff, gbase, voff) do { _Pragma("unroll") for (int _i = 0; _i < 2; ++_i) \
        __builtin_amdgcn_global_load_lds((const unsigned*)((const char*)(gbase) + (voff)[_i]), (PG8_LAS unsigned*)(lds + (bufoff) + ldsw + _i * 8192), 16, 0, 0); } while (0)
#define PG8_LDA(dst, b, h) do { _Pragma("unroll") for (int m = 0; m < 4; ++m) _Pragma("unroll") for (int k = 0; k < 2; ++k) dst[m][k] = *(const PG8_LAS f16x8*)(lds + PG8_SA(b, h) + aoff + m * 2048 + k * 1024); } while (0)
#define PG8_LDB(dst, b, h) do { _Pragma("unroll") for (int n = 0; n < 2; ++n) _Pragma("unroll") for (int k = 0; k < 2; ++k) dst[n][k] = *(const PG8_LAS f16x8*)(lds + PG8_SB(b, h) + boff + n * 2048 + k * 1024); } while (0)
#define PG8_MMA(ai, bj, At, Bt) do { __builtin_amdgcn_s_setprio(1); _Pragma("unroll") for (int m = 0; m < 4; ++m) _Pragma("unroll") for (int n = 0; n < 2; ++n) _Pragma("unroll") for (int k = 0; k < 2; ++k) \
        acc[ai][bj][m][n] = __builtin_amdgcn_mfma_f32_16x16x32_f16(Bt[n][k], At[m][k], acc[ai][bj][m][n], 0, 0, 0); __builtin_amdgcn_s_setprio(0); } while (0)
#define PG8_WAIT_V(n) asm volatile("s_waitcnt vmcnt(" #n ")" ::: "memory")
#define PG8_WAIT_L(n) asm volatile("s_waitcnt lgkmcnt(" #n ")" ::: "memory")
#define PG8_BAR __builtin_amdgcn_s_barrier()
#define PG8_SCHED __builtin_amdgcn_sched_barrier(0)
    Unit cur, nxt; int ui = 0;
    if (!S.next(0, cur)) return;
    f32x4 acc[2][2][4][2];
#pragma unroll
    for (int a = 0; a < 2; ++a)
#pragma unroll
        for (int b = 0; b < 2; ++b)
#pragma unroll
            for (int m = 0; m < 4; ++m)
#pragma unroll
                for (int n = 0; n < 2; ++n) acc[a][b][m][n] = (f32x4){0.f, 0.f, 0.f, 0.f};
    f16x8 At[4][2], B0[2][2], B1[2][2];
    const char* cA = cur.A; const char* cB = cur.B;
    PG8_STAGE(PG8_SB(0, 0), cB, voffB); PG8_STAGE(PG8_SA(0, 0), cA, voffA); PG8_STAGE(PG8_SB(0, 1), cB + hstepB, voffB); PG8_STAGE(PG8_SA(0, 1), cA + hstepA, voffA);
    if (wr == 1) PG8_BAR;
    PG8_WAIT_V(4); PG8_BAR;
    PG8_STAGE(PG8_SB(1, 0), cB + kstep, voffB); PG8_STAGE(PG8_SA(1, 0), cA + kstep, voffA); PG8_STAGE(PG8_SB(1, 1), cB + hstepB + kstep, voffB);
    PG8_WAIT_V(6); PG8_BAR;
    for (;;) {
        const bool has_next = S.next(ui + 1, nxt);
        const char* nA = has_next ? nxt.A : cA; const char* nB = has_next ? nxt.B : cB;
#pragma unroll 1
        for (int t = 0; t < nt; t += 2) {
            const bool last = (t == nt - 2);
            const char* a1 = cA + (size_t)(t + 1) * kstep;
            const char* a2 = last ? nA : cA + (size_t)(t + 2) * kstep; const char* b2 = last ? nB : cB + (size_t)(t + 2) * kstep;
            const char* a3 = a2 + kstep; const char* b3 = b2 + kstep;
            PG8_LDB(B0, 0, 0); PG8_SCHED; PG8_LDA(At, 0, 0); PG8_STAGE(PG8_SA(1, 1), a1 + hstepA, voffA);
            PG8_WAIT_L(8); PG8_BAR; PG8_WAIT_L(0); PG8_MMA(0, 0, At, B0); PG8_BAR; PG8_SCHED;
            PG8_LDB(B1, 0, 1); PG8_STAGE(PG8_SB(0, 0), b2, voffB);
            PG8_BAR; PG8_WAIT_L(0); PG8_MMA(0, 1, At, B1); PG8_BAR;
            PG8_LDA(At, 0, 1); PG8_STAGE(PG8_SA(0, 0), a2, voffA);
            PG8_BAR; PG8_WAIT_L(0); PG8_MMA(1, 0, At, B0); PG8_BAR; PG8_SCHED;
            PG8_STAGE(PG8_SB(0, 1), b2 + hstepB, voffB);
            PG8_WAIT_V(6); PG8_BAR; PG8_MMA(1, 1, At, B1); PG8_BAR;
            PG8_LDB(B0, 1, 0); PG8_SCHED; PG8_LDA(At, 1, 0); PG8_STAGE(PG8_SA(0, 1), a2 + hstepA, voffA);
            PG8_WAIT_L(8); PG8_BAR; PG8_WAIT_L(0); PG8_MMA(0, 0, At, B0); PG8_BAR; PG8_SCHED;
            PG8_LDB(B1, 1, 1); PG8_STAGE(PG8_SB(1, 0), b3, voffB);
            PG8_BAR; PG8_WAIT_L(0); PG8_MMA(0, 1, At, B1); PG8_BAR;
            PG8_LDA(At, 1, 1); PG8_STAGE(PG8_SA(1, 0), a3, voffA);
            PG8_BAR; PG8_WAIT_L(0); PG8_MMA(1, 0, At, B0); PG8_BAR; PG8_SCHED;
            PG8_STAGE(PG8_SB(1, 1), b3 + hstepB, voffB);
            PG8_WAIT_V(6); PG8_BAR; PG8_MMA(1, 1, At, B1); PG8_BAR;
        }
        E(acc, cur, wr, wc, fr, fq);
        if (!has_next) break;
#pragma unroll
        for (int a = 0; a < 2; ++a)
#pragma unroll
            for (int b = 0; b < 2; ++b)
#pragma unroll
                for (int m = 0; m < 4; ++m)
#pragma unroll
                    for (int n = 0; n < 2; ++n) acc[a][b][m][n] = (f32x4){0.f, 0.f, 0.f, 0.f};
        cur = nxt; cA = nA; cB = nB; ++ui;
    }
    PG8_WAIT_V(0);
    if (wr == 0) PG8_BAR;
    PG8_BAR;
#undef PG8_SA
#undef PG8_SB
#undef PG8_STAGE
#undef PG8_LDA
#undef PG8_LDB
#undef PG8_MMA
#undef PG8_WAIT_V
#undef PG8_WAIT_L
#undef PG8_BAR
#undef PG8_SCHED
#endif
}
}

enum { GK_STORE = 0, GK_GATE0, GK_GATE1, GK_GATE2, GK_PROJ0, GK_PROJ1, GK_PROJ2, GK_RESID };
enum { GP_INPROJ = 0, GP_MERGE, GP_WOUT, GP_QUERY };
struct GemmProg {
    const char* act; const char* wt;
    int which, G, c;
    __device__ __forceinline__ bool next(int i, pg8::Unit& u) const {
        constexpr int nM = M_ / 256;
        constexpr size_t rowA = (size_t)256 * LDZ * 2, rowB = (size_t)256 * 1024 * 2;
        if (which == GP_MERGE) {
            const int L = (i / 6) * G + c, j = i % 6, br = j >> 1;
            if (L >= nM * 4) return false;
            pg8::tile_of(L, nM, 4, u.pm, u.pn);
            if ((j & 1) == 0) { u.A = act + (size_t)C_XN * 2; u.B = wt + ((size_t)(WT_MG + br * 1024) * 1024) * 2; u.kind = GK_GATE0 + br; }
            else { u.A = act + (size_t)(br == 0 ? C_YA : (br == 1 ? C_YB : C_YC)) * 2; u.B = wt + ((size_t)(WT_P + br * 1024) * 1024) * 2; u.kind = GK_PROJ0 + br; }
        } else {
            const int nN = which == GP_INPROJ ? ZN / 256 : (which == GP_WOUT ? 4 : 8);
            const int L = i * G + c;
            if (L >= nM * nN) return false;
            pg8::tile_of(L, nM, nN, u.pm, u.pn);
            u.A = act + (size_t)(which == GP_WOUT ? C_MG : C_XN) * 2;
            u.B = wt + ((size_t)(which == GP_INPROJ ? WT_IN : (which == GP_WOUT ? WT_OUT : WT_Q)) * 1024) * 2;
            u.kind = which == GP_WOUT ? GK_RESID : GK_STORE;
        }
        u.A += (size_t)u.pm * rowA; u.B += (size_t)u.pn * rowB;
        return true;
    }
};
struct GemmEpi {
    h16_t* act; const float* mb; const float* resid; float* out;
    __device__ __forceinline__ void operator()(const pg8::f32x4 (&acc)[2][2][4][2], const pg8::Unit& u, int wr, int wc, int fr, int fq) const {
        const int row0 = u.pm * 256 + wr * 64 + fr, col0 = u.pn * 256 + wc * 32 + 8 * fq;
#pragma unroll
        for (int ai = 0; ai < 2; ++ai)
#pragma unroll
            for (int m = 0; m < 4; ++m) {
                const int row = row0 + ai * 128 + m * 16;
#pragma unroll
                for (int bj = 0; bj < 2; ++bj) {
                    const int col = col0 + bj * 128;
                    float v[8];
#pragma unroll
                    for (int e = 0; e < 4; ++e) { v[e] = acc[ai][bj][m][0][e]; v[4 + e] = acc[ai][bj][m][1][e]; }
                    h16_t* arow = act + (size_t)row * LDZ;
                    if (u.kind == GK_STORE) {
                        store8h(arow + col, v);
                    } else if (u.kind <= GK_GATE2) {
                        const float* bp = mb + (u.kind - GK_GATE0) * 1024 + col;
                        const float4 b0 = *(const float4*)bp, b1 = *(const float4*)(bp + 4);
                        v[0] = sigmoidf_(v[0] + b0.x); v[1] = sigmoidf_(v[1] + b0.y); v[2] = sigmoidf_(v[2] + b0.z); v[3] = sigmoidf_(v[3] + b0.w);
                        v[4] = sigmoidf_(v[4] + b1.x); v[5] = sigmoidf_(v[5] + b1.y); v[6] = sigmoidf_(v[6] + b1.z); v[7] = sigmoidf_(v[7] + b1.w);
                        store8h(arow + C_GS + col, v);
                    } else if (u.kind <= GK_PROJ2) {
                        float g[8]; load8h(arow + C_GS + col, g);
                        if (u.kind == GK_PROJ0) {
#pragma unroll
                            for (int e = 0; e < 8; ++e) v[e] = g[e] * v[e];
                        } else {
                            float o[8]; load8h(arow + C_MG + col, o);
#pragma unroll
                            for (int e = 0; e < 8; ++e) v[e] = o[e] + g[e] * v[e];
                        }
                        store8h(arow + C_MG + col, v);
                    } else {
                        const size_t o = (size_t)row * 1024 + col;
                        const float4 r0 = *(const float4*)(resid + o), r1 = *(const float4*)(resid + o + 4);
                        *(float4*)(out + o) = make_float4(r0.x + v[0], r0.y + v[1], r0.z + v[2], r0.w + v[3]);
                        *(float4*)(out + o + 4) = make_float4(r1.x + v[4], r1.y + v[5], r1.z + v[6], r1.w + v[7]);
                    }
                }
            }
    }
};
__device__ __forceinline__ void stage_gemm(KParams p, int l, int which, char* smem) {
    GemmProg S; S.act = p->ws + OFF_ACT; S.wt = p->ws + OFF_WT + (size_t)l * WT_ROWS * 1024 * 2; S.which = which; S.G = gridDim.x; S.c = bid_();
    GemmEpi E; E.act = (h16_t*)(p->ws + OFF_ACT); E.mb = p->in[I_MB] + l * 3072; E.resid = l == 0 ? p->in[I_X] : p->out; E.out = p->out;
    pg8::gemm_phase(smem, S, E);
}

#ifdef CPU_EMU
__device__ __forceinline__ float group_sum(float v, int width, float* scratch) {
    const int tid = tid_();
    scratch[tid] = v;
    __syncthreads();
    float s = 0.f; const int base = tid & ~(width - 1);
    for (int i = 0; i < width; ++i) s += scratch[base + i];
    __syncthreads();
    return s;
}
#else
template <int CTRL> __device__ __forceinline__ float dpp_f(float v) { return __builtin_bit_cast(float, __builtin_amdgcn_update_dpp(0, __builtin_bit_cast(int, v), CTRL, 0xf, 0xf, false)); }
__device__ __forceinline__ float group_sum(float v, int width, float*) {
    v += dpp_f<0xB1>(v);
    v += dpp_f<0x4E>(v);
    if (width >= 8) v += dpp_f<0x141>(v);
    if (width >= 16) v += dpp_f<0x140>(v);
    if (width >= 64) {
        v += __builtin_bit_cast(float, __builtin_amdgcn_update_dpp(0, __builtin_bit_cast(int, v), 0x142, 0xa, 0xf, false));
        v += __builtin_bit_cast(float, __builtin_amdgcn_update_dpp(0, __builtin_bit_cast(int, v), 0x143, 0xc, 0xf, false));
        v = __builtin_bit_cast(float, __builtin_amdgcn_readlane(__builtin_bit_cast(int, v), 63));
    } else if (width >= 32) v += __shfl_xor(v, 16);
    return v;
}
#endif
__device__ __forceinline__ uint4 ldg16(const h16_t* p) { return *(const uint4*)p; }
__device__ __forceinline__ uint4 zero16() { uint4 z; z.x = 0u; z.y = 0u; z.z = 0u; z.w = 0u; return z; }

__device__ __forceinline__ void stage_lru(KParams p, int l, char* smem, int vb0, int nvb) {
    const int vb = bid_() - vb0;
    if (vb < 0 || vb >= nvb) return;
    constexpr int CH = 64;
    float* wa_s = (float*)smem;
    float* wx_s = wa_s + 4096;
    float* xcT = wx_s + 4096;
    float* a_s = xcT + 64 * CH;
    float* b_s = a_s + CH * 64;
    h16_t* ru = (h16_t*)(b_s + CH * 64);
    h16_t* rg = ru + (CH + 3) * 64;
    h16_t* ACT = (h16_t*)(p->ws + OFF_ACT);
    const int tid = tid_(), c = tid & 63, tg = tid >> 6;
    for (int item = vb; item < B_ * 16; item += nvb) {
        const int b = item / 16, n = item % 16, ch = n * 64 + c;
        __syncthreads();
        for (int i = tid; i < 4096; i += NT) { wa_s[i] = p->in[I_LWA][((size_t)l * 16 + n) * 4096 + i]; wx_s[i] = p->in[I_LWX][((size_t)l * 16 + n) * 4096 + i]; }
        const float cw0 = p->in[I_LCW][((size_t)l * 4 + 0) * 1024 + ch], cw1 = p->in[I_LCW][((size_t)l * 4 + 1) * 1024 + ch];
        const float cw2 = p->in[I_LCW][((size_t)l * 4 + 2) * 1024 + ch], cw3 = p->in[I_LCW][((size_t)l * 4 + 3) * 1024 + ch];
        const float cb = p->in[I_LCB][l * 1024 + ch], ba = p->in[I_LBA][l * 1024 + ch], bx = p->in[I_LBX][l * 1024 + ch];
        const float sp = softplusf_(-p->in[I_LLAM][l * 1024 + ch]);
        float hst = 0.f;
        uint4 pf[3];
#define LRU_LOAD(t0_) do { _Pragma("unroll") for (int i = 0; i < 3; ++i) { const int j = tid + NT * i; pf[i] = zero16(); \
            if (j < 536) { const int t = (t0_) - 3 + (j >> 3); if (t >= 0) pf[i] = ldg16(ACT + ((size_t)b * T_ + t) * LDZ + Z_ULRU + n * 64 + (j & 7) * 8); } \
            else if (j < 1048) { const int jj = j - 536; pf[i] = ldg16(ACT + ((size_t)b * T_ + (t0_) + (jj >> 3)) * LDZ + Z_GLRU + n * 64 + (jj & 7) * 8); } } } while (0)
#define LRU_PUT() do { _Pragma("unroll") for (int i = 0; i < 3; ++i) { const int j = tid + NT * i; \
            if (j < 536) *(uint4*)(ru + (j >> 3) * 64 + (j & 7) * 8) = pf[i]; else if (j < 1048) *(uint4*)(rg + ((j - 536) >> 3) * 64 + ((j - 536) & 7) * 8) = pf[i]; } } while (0)
        LRU_LOAD(0);
        LRU_PUT();
        __syncthreads();
#pragma unroll 1
        for (int t0 = 0; t0 < T_; t0 += CH) {
            float xc[8];
            {
                float u[11];
#pragma unroll
                for (int s = 0; s < 11; ++s) u[s] = h2f(ru[(tg * 8 + s) * 64 + c]);
#pragma unroll
                for (int s = 0; s < 8; ++s) { xc[s] = cw0 * u[s] + cw1 * u[s + 1] + cw2 * u[s + 2] + cw3 * u[s + 3] + cb; xcT[c * CH + tg * 8 + s] = xc[s]; }
            }
            __syncthreads();
            if (t0 + CH < T_) LRU_LOAD(t0 + CH);
            {
                float dr[8], di[8];
#pragma unroll
                for (int s = 0; s < 8; ++s) { dr[s] = 0.f; di[s] = 0.f; }
#pragma unroll 4
                for (int i = 0; i < 64; ++i) {
                    const float wa = wa_s[i * 64 + c], wx = wx_s[i * 64 + c];
                    const float4 x0 = *(const float4*)(xcT + i * CH + tg * 8), x1 = *(const float4*)(xcT + i * CH + tg * 8 + 4);
                    dr[0] += x0.x * wa; dr[1] += x0.y * wa; dr[2] += x0.z * wa; dr[3] += x0.w * wa; dr[4] += x1.x * wa; dr[5] += x1.y * wa; dr[6] += x1.z * wa; dr[7] += x1.w * wa;
                    di[0] += x0.x * wx; di[1] += x0.y * wx; di[2] += x0.z * wx; di[3] += x0.w * wx; di[4] += x1.x * wx; di[5] += x1.y * wx; di[6] += x1.z * wx; di[7] += x1.w * wx;
                }
#pragma unroll
                for (int s = 0; s < 8; ++s) {
                    const float r = sigmoidf_(dr[s] + ba), ig = sigmoidf_(di[s] + bx);
                    const float log_a = -8.0f * r * sp;
                    a_s[(tg * 8 + s) * 64 + c] = fexp_(log_a);
                    b_s[(tg * 8 + s) * 64 + c] = sqrtf(fmaxf(1.0f - fexp_(2.0f * log_a), 0.0f)) * (ig * xc[s]);
                }
            }
            __syncthreads();
            if (tid < 64) {
#pragma unroll 8
                for (int t = 0; t < CH; ++t) { hst = a_s[t * 64 + c] * hst + b_s[t * 64 + c]; b_s[t * 64 + c] = hst; }
            }
            __syncthreads();
#pragma unroll
            for (int s = 0; s < 8; ++s) { h16_t* gp = rg + (tg * 8 + s) * 64 + c; *gp = f2h(b_s[(tg * 8 + s) * 64 + c] * geluf_(h2f(*gp))); }
            __syncthreads();
            *(uint4*)(ACT + ((size_t)b * T_ + t0 + (tid >> 3)) * LDZ + Z_GLRU + n * 64 + (tid & 7) * 8) = *(const uint4*)(rg + (tid >> 3) * 64 + (tid & 7) * 8);
            __syncthreads();
            if (t0 + CH < T_) LRU_PUT();
            __syncthreads();
        }
#undef LRU_LOAD
#undef LRU_PUT
    }
}

#ifdef CPU_EMU
struct hfrag { h16_t v[8]; };
struct facc { float d[4]; float& operator[](int i) { return d[i]; } const float& operator[](int i) const { return d[i]; } };
__device__ __forceinline__ facc facc_zero() { facc a; a.d[0] = a.d[1] = a.d[2] = a.d[3] = 0.f; return a; }
__device__ __forceinline__ hfrag frag_u4(uint4 w) { hfrag f; memcpy(&f, &w, 16); return f; }
__device__ __forceinline__ hfrag frag_2u2(uint2 lo, uint2 hi) { hfrag f; memcpy(&f.v[0], &lo, 8); memcpy(&f.v[4], &hi, 8); return f; }
__device__ __forceinline__ hfrag frag_mul(hfrag a, hfrag b) { hfrag f; for (int j = 0; j < 8; ++j) f.v[j] = f2h(h2f(a.v[j]) * h2f(b.v[j])); return f; }
__device__ __forceinline__ facc mfma16(hfrag a, hfrag b, facc c) {
    const int tid = tid_(), w = tid >> 6, l = tid & 63;
    unsigned short (*X)[64][16] = emu::ctx->xscr;
    for (int j = 0; j < 8; ++j) { X[w][l][j] = a.v[j]; X[w][l][8 + j] = b.v[j]; }
    __syncthreads();
    for (int reg = 0; reg < 4; ++reg) {
        const int row = 4 * (l >> 4) + reg, col = l & 15;
        float s = 0.f;
        for (int k = 0; k < 32; ++k) s += h2f(X[w][row + 16 * (k >> 3)][k & 7]) * h2f(X[w][col + 16 * (k >> 3)][8 + (k & 7)]);
        c.d[reg] += s;
    }
    __syncthreads();
    return c;
}
#else
typedef _Float16 hfrag __attribute__((ext_vector_type(8)));
typedef float facc __attribute__((ext_vector_type(4)));
__device__ __forceinline__ facc facc_zero() { return (facc){0.f, 0.f, 0.f, 0.f}; }
__device__ __forceinline__ hfrag frag_u4(uint4 w) { return __builtin_bit_cast(hfrag, w); }
__device__ __forceinline__ hfrag frag_2u2(uint2 lo, uint2 hi) { uint4 w; w.x = lo.x; w.y = lo.y; w.z = hi.x; w.w = hi.y; return __builtin_bit_cast(hfrag, w); }
__device__ __forceinline__ hfrag frag_mul(hfrag a, hfrag b) { return a * b; }
__device__ __forceinline__ facc mfma16(hfrag a, hfrag b, facc c) { return __builtin_amdgcn_mfma_f32_16x16x32_f16(a, b, c, 0, 0, 0); }
#endif
__device__ __forceinline__ hfrag frag_pack8(float a0, float a1, float a2, float a3, float a4, float a5, float a6, float a7) {
    uint4 w; w.x = pack2h(a0, a1); w.y = pack2h(a2, a3); w.z = pack2h(a4, a5); w.w = pack2h(a6, a7); return frag_u4(w);
}
__device__ __forceinline__ hfrag frag_acc2(const facc& t0, const facc& t1) { return frag_pack8(t0[0], t0[1], t0[2], t0[3], t1[0], t1[1], t1[2], t1[3]); }
__device__ __forceinline__ hfrag permfrag(const h16_t* rowp, int ks, int g) { return frag_2u2(*(const uint2*)(rowp + 32 * ks + 4 * g), *(const uint2*)(rowp + 32 * ks + 16 + 4 * g)); }

__device__ __forceinline__ void stage_gdn(KParams p, int l, char* smem, int vb0, int nvb) {
    const int vb = bid_() - vb0;
    if (vb < 0 || vb >= nvb) return;
    constexpr int CH = 64, QS = 136, TS = 72, AS = 68;
    h16_t* Qs = (h16_t*)smem;
    h16_t* Ks = Qs + 64 * QS;
    h16_t* Kt = Ks + 64 * QS;
    h16_t* Vt = Kt + 128 * TS;
    float* A32 = (float*)(Vt + 128 * TS);
    h16_t* ob = (h16_t*)A32;
    h16_t* Tu = (h16_t*)(A32 + 64 * AS);
    h16_t* Tw = Tu + 64 * TS;
    h16_t* QKm = Tw + 64 * TS;
    float* gc_s = (float*)(QKm + 64 * TS);
    float* be_s = gc_s + 64;
    float* e1_s = be_s + 64;
    float* part_s = e1_s + 64;
    float* scr = part_s + 512;
    float* cw_s = scr + 512;
    h16_t* ACT = (h16_t*)(p->ws + OFF_ACT);
    int tid = tid_(), lane = tid & 63, w = tid >> 6, g = lane >> 4, r16 = lane & 15;
    int sg = lane >> 4, pc = lane & 15, rb = w;
#define GDN_ROLES() do { tid = tid_(); lane = tid & 63; w = tid >> 6; g = lane >> 4; r16 = lane & 15; sg = g; pc = r16; rb = w; } while (0)
    for (int item = vb; item < B_ * 8; item += nvb) {
        const int b = item / 8, h = item % 8;
        const float a_exp = fexp_(p->in[I_GALOG][l * 8 + h]), dtb = p->in[I_GDT][l * 8 + h];
        facc S[8];
#pragma unroll
        for (int dt = 0; dt < 8; ++dt) S[dt] = facc_zero();
        __syncthreads();
        for (int i = tid; i < 64 * TS / 2; i += NT) ((unsigned*)QKm)[i] = 0u;
        for (int i = tid; i < 4 * 384; i += NT) { const int jj = i / 384, c3 = i % 384; cw_s[i] = p->in[I_GCW][((size_t)l * 4 + jj) * 3072 + (c3 >> 7) * 1024 + h * 128 + (c3 & 127)]; }
        uint4 pf[11];
#define GDN_LOAD(t0_) do { GDN_ROLES(); const h16_t* colp = ACT + ((size_t)b * T_ + (t0_) + 8 * rb - 3) * LDZ + (sg < 3 ? Z_Q + sg * 1024 : Z_ZG) + h * 128 + pc * 8; \
            _Pragma("unroll") for (int i = 0; i < 11; ++i) { const int t = (t0_) + 8 * rb - 3 + i; pf[i] = (t >= 0 && sg < 3) ? ldg16(colp + (size_t)i * LDZ) : zero16(); } } while (0)
        GDN_LOAD(0);
#pragma unroll 1
        for (int t0 = 0; t0 < T_; t0 += CH) {
            GDN_ROLES();
            if (tid < 64) {
                const size_t m = (size_t)b * T_ + t0 + tid;
                part_s[tid] = -a_exp * softplusf_(h2f(ACT[m * LDZ + Z_ALPHA + h]) + dtb);
                be_s[tid] = sigmoidf_(h2f(ACT[m * LDZ + Z_BETA + h]));
            }
            __syncthreads();
            if (tid < 64) { float s = 0.f; for (int i = 0; i <= tid; ++i) s += part_s[i]; gc_s[tid] = s; }
#pragma unroll
            for (int hf = 0; hf < 2; ++hf) {
                float ov[4][8];
#pragma unroll
                for (int i = 0; i < 4; ++i) {
#pragma unroll
                    for (int cc = 0; cc < 8; ++cc) ov[i][cc] = 0.f;
#pragma unroll
                    for (int jj = 0; jj < 4; ++jj) {
                        const uint4 wv = pf[hf * 4 + i + jj];
                        const float* cwp = cw_s + jj * 384 + (sg < 3 ? sg : 0) * 128 + pc * 8;
                        const float4 c0 = *(const float4*)cwp, c1 = *(const float4*)(cwp + 4);
                        ov[i][0] += c0.x * h2f((h16_t)(wv.x & 0xffffu)); ov[i][1] += c0.y * h2f((h16_t)(wv.x >> 16)); ov[i][2] += c0.z * h2f((h16_t)(wv.y & 0xffffu)); ov[i][3] += c0.w * h2f((h16_t)(wv.y >> 16));
                        ov[i][4] += c1.x * h2f((h16_t)(wv.z & 0xffffu)); ov[i][5] += c1.y * h2f((h16_t)(wv.z >> 16)); ov[i][6] += c1.z * h2f((h16_t)(wv.w & 0xffffu)); ov[i][7] += c1.w * h2f((h16_t)(wv.w >> 16));
                    }
                    float ss = 0.f;
#pragma unroll
                    for (int cc = 0; cc < 8; ++cc) { ov[i][cc] = siluf_(ov[i][cc]); ss += ov[i][cc] * ov[i][cc]; }
                    ss = group_sum(ss, 16, scr);
                    const float rn = sg == 0 ? rsqrtf(ss + RMS_EPS) * 0.08838834764831845f : (sg == 1 ? rsqrtf(ss + RMS_EPS) : 1.0f);
#pragma unroll
                    for (int cc = 0; cc < 8; ++cc) ov[i][cc] *= rn;
                    const int t = 8 * rb + hf * 4 + i;
                    if (sg == 0) store8h(Qs + t * QS + pc * 8, ov[i]);
                    else if (sg == 1) store8h(Ks + t * QS + pc * 8, ov[i]);
                }
                if (sg == 1 || sg == 2) {
                    h16_t* dstT = sg == 1 ? Kt : Vt;
#pragma unroll
                    for (int cc = 0; cc < 8; ++cc) { uint2 w2; w2.x = pack2h(ov[0][cc], ov[1][cc]); w2.y = pack2h(ov[2][cc], ov[3][cc]); *(uint2*)(dstT + (pc * 8 + cc) * TS + 8 * rb + hf * 4) = w2; }
                }
            }
            __syncthreads();
            GDN_ROLES();
            if (tid < 64) e1_s[tid] = fexp_(gc_s[63] - gc_s[tid]);
            for (int e = tid; e < 64 * 64; e += NT) { const int i = e >> 6, j = e & 63; if ((j >> 4) > (i >> 4)) A32[i * AS + (j & 7) * 8 + (j >> 3)] = 0.f; }
#pragma unroll 1
            for (int jr = 0; jr < 3; ++jr) {
                const int jb = w + 8 * jr; const bool valid = jb < 20;
                const int kind = (valid && jb >= 10) ? 1 : 0, tix = valid ? (jb % 10) : 0;
                const int ti = tix < 1 ? 0 : (tix < 3 ? 1 : (tix < 6 ? 2 : 3)), tj = tix - (ti * (ti + 1)) / 2;
                const h16_t* ap = (kind ? Qs : Ks) + (16 * ti + r16) * QS + 8 * g; const h16_t* bp = Ks + (16 * tj + r16) * QS + 8 * g;
                facc acc = facc_zero();
#pragma unroll
                for (int ks = 0; ks < 4; ++ks) acc = mfma16(frag_u4(*(const uint4*)(ap + 32 * ks)), frag_u4(*(const uint4*)(bp + 32 * ks)), acc);
                if (valid) {
                    const int j = 16 * tj + r16; const float gj = gc_s[j];
#pragma unroll
                    for (int reg = 0; reg < 4; ++reg) {
                        const int i = 16 * ti + 4 * g + reg;
                        const float dec = fexp_(fminf(gc_s[i] - gj, 0.f));
                        if (kind == 0) A32[i * AS + (j & 7) * 8 + (j >> 3)] = i > j ? be_s[i] * acc[reg] * dec : 0.f;
                        else QKm[i * TS + j] = f2h(i >= j ? acc[reg] * dec : 0.f);
                    }
                }
            }
            __syncthreads();
            GDN_ROLES();
            {
                const int t = tid >> 3, d0 = (tid & 7) * 16; const float eg = fexp_(gc_s[t]);
                float v8[8];
                load8h(Qs + t * QS + d0, v8);
#pragma unroll
                for (int e = 0; e < 8; ++e) v8[e] *= eg;
                store8h(Qs + t * QS + d0, v8);
                load8h(Qs + t * QS + d0 + 8, v8);
#pragma unroll
                for (int e = 0; e < 8; ++e) v8[e] *= eg;
                store8h(Qs + t * QS + d0 + 8, v8);
            }
            {
                const int c = tid >> 3, q = tid & 7;
                const float bc = be_s[c], bgc = bc * fexp_(gc_s[c]);
                float x[8];
#pragma unroll
                for (int i = 0; i < 8; ++i) x[i] = 0.f;
#pragma unroll
                for (int r = 0; r < 64; ++r) {
                    float sacc = 0.f;
                    if (r > 0) {
                        const float4 a0 = *(const float4*)(A32 + r * AS + q * 8);
                        sacc = a0.x * x[0];
                        if (r > 8) sacc += a0.y * x[1];
                        if (r > 16) sacc += a0.z * x[2];
                        if (r > 24) sacc += a0.w * x[3];
                        if (r > 32) {
                            const float4 a1 = *(const float4*)(A32 + r * AS + q * 8 + 4);
                            sacc += a1.x * x[4];
                            if (r > 40) sacc += a1.y * x[5];
                            if (r > 48) sacc += a1.z * x[6];
                            if (r > 56) sacc += a1.w * x[7];
                        }
                        sacc = group_sum(sacc, 8, scr);
                    }
                    const float xr = ((r == c) ? 1.f : 0.f) - sacc;
                    if (q == (r & 7)) { x[r >> 3] = xr; Tu[r * TS + c] = f2h(xr * bc); Tw[r * TS + c] = f2h(xr * bgc); }
                }
            }
            __syncthreads();
            GDN_ROLES();
            facc vn[4], aw[4];
#pragma unroll
            for (int tt = 0; tt < 4; ++tt) { vn[tt] = facc_zero(); aw[tt] = facc_zero(); }
#pragma unroll
            for (int tt = 0; tt < 4; ++tt)
#pragma unroll
                for (int ks = 0; ks <= (tt >> 1); ++ks) {
                    const hfrag au = frag_u4(*(const uint4*)(Tu + (16 * tt + r16) * TS + 32 * ks + 8 * g)), aww = frag_u4(*(const uint4*)(Tw + (16 * tt + r16) * TS + 32 * ks + 8 * g));
                    vn[tt] = mfma16(au, frag_u4(*(const uint4*)(Vt + (16 * w + r16) * TS + 32 * ks + 8 * g)), vn[tt]);
                    aw[tt] = mfma16(aww, frag_u4(*(const uint4*)(Kt + (16 * w + r16) * TS + 32 * ks + 8 * g)), aw[tt]);
                }
#pragma unroll
            for (int tt = 0; tt < 4; ++tt)
#pragma unroll
                for (int reg = 0; reg < 4; ++reg) Ks[(16 * tt + 4 * g + reg) * QS + 16 * w + r16] = f2h(-aw[tt][reg]);
            __syncthreads();
            GDN_ROLES();
            h16_t zraw[16];
#pragma unroll
            for (int tt = 0; tt < 4; ++tt)
#pragma unroll
                for (int reg = 0; reg < 4; ++reg) zraw[tt * 4 + reg] = ACT[((size_t)b * T_ + t0 + 16 * tt + 4 * g + reg) * LDZ + Z_ZG + h * 128 + 16 * w + r16];
            hfrag Sb[4];
#pragma unroll
            for (int ks = 0; ks < 4; ++ks) Sb[ks] = frag_acc2(S[2 * ks], S[2 * ks + 1]);
            facc oc[4];
#pragma unroll
            for (int tt = 0; tt < 4; ++tt) {
                oc[tt] = facc_zero();
                const h16_t* wrow = Ks + (16 * tt + r16) * QS; const h16_t* qrow = Qs + (16 * tt + r16) * QS;
#pragma unroll
                for (int ks = 0; ks < 4; ++ks) { vn[tt] = mfma16(permfrag(wrow, ks, g), Sb[ks], vn[tt]); oc[tt] = mfma16(permfrag(qrow, ks, g), Sb[ks], oc[tt]); }
            }
            hfrag VNb[2];
            VNb[0] = frag_acc2(vn[0], vn[1]); VNb[1] = frag_acc2(vn[2], vn[3]);
#pragma unroll
            for (int tt = 0; tt < 4; ++tt)
#pragma unroll
                for (int ks2 = 0; ks2 <= (tt >> 1); ++ks2) oc[tt] = mfma16(permfrag(QKm + (16 * tt + r16) * TS, ks2, g), VNb[ks2], oc[tt]);
            {
                const float egl = fexp_(gc_s[63]);
                hfrag e1f[2];
#pragma unroll
                for (int ks2 = 0; ks2 < 2; ++ks2) { const float* ep = e1_s + 32 * ks2 + 4 * g; e1f[ks2] = frag_pack8(ep[0], ep[1], ep[2], ep[3], ep[16], ep[17], ep[18], ep[19]); }
#pragma unroll
                for (int dt = 0; dt < 8; ++dt) {
#pragma unroll
                    for (int reg = 0; reg < 4; ++reg) S[dt][reg] *= egl;
#pragma unroll
                    for (int ks2 = 0; ks2 < 2; ++ks2) S[dt] = mfma16(frag_mul(permfrag(Kt + (16 * dt + r16) * TS, ks2, g), e1f[ks2]), VNb[ks2], S[dt]);
                }
            }
            if (t0 + CH < T_) GDN_LOAD(t0 + CH);
            GDN_ROLES();
#pragma unroll
            for (int tt = 0; tt < 4; ++tt)
#pragma unroll
                for (int reg = 0; reg < 4; ++reg) { const float ss = group_sum(oc[tt][reg] * oc[tt][reg], 16, scr); if (r16 == 0) part_s[w * 64 + 16 * tt + 4 * g + reg] = ss; }
            __syncthreads();
            const float nw = p->in[I_GNW][l * 128 + w * 16 + r16];
#pragma unroll
            for (int tt = 0; tt < 4; ++tt)
#pragma unroll
                for (int reg = 0; reg < 4; ++reg) {
                    const int t = 16 * tt + 4 * g + reg;
                    float ms = 0.f;
#pragma unroll
                    for (int ww = 0; ww < 8; ++ww) ms += part_s[ww * 64 + t];
                    ob[t * 128 + 16 * w + r16] = f2h(oc[tt][reg] * rsqrtf(ms * (1.0f / 128.0f) + RMS_EPS) * nw * siluf_(h2f(zraw[tt * 4 + reg])));
                }
            __syncthreads();
            GDN_ROLES();
#pragma unroll
            for (int i = 0; i < 2; ++i) { const int j = tid + NT * i; *(uint4*)(ACT + ((size_t)b * T_ + t0 + (j >> 4)) * LDZ + Z_ZG + h * 128 + (j & 15) * 8) = *(const uint4*)(ob + (j >> 4) * 128 + (j & 15) * 8); }
            __syncthreads();
        }
#undef GDN_LOAD
#undef GDN_ROLES
    }
}

#ifndef CPU_EMU
typedef _Float16 rw_f16x8 __attribute__((ext_vector_type(8)));
typedef float rw_f32x4 __attribute__((ext_vector_type(4)));
#endif
__device__ __forceinline__ void stage_rwkv(KParams p, int l, char* smem, int vb0, int nvb) {
    const int vb = bid_() - vb0;
    if (vb < 0 || vb >= nvb) return;
    constexpr int CH = 32, XS = 264;
    float* r_s = (float*)smem;
    float* k_s = r_s + CH * 64;
    float* v_s = k_s + CH * 64;
    float* w_s = v_s + CH * 64;
    float* kk_s = w_s + CH * 64;
    float* ka_s = kk_s + CH * 64;
    float* g_s = ka_s + CH * 64;
    float* o_s = g_s + CH * 64;
    float* bon_s = o_s + CH * 64;
    float* scr = bon_s + CH;
    h16_t* raw = (h16_t*)(scr + 512);
    h16_t* xs = raw + (CH + 1) * 448;
    h16_t* ACT = (h16_t*)(p->ws + OFF_ACT);
    const int tid = tid_(), c = tid & 63, tg = tid >> 6;
    const int ri = tid >> 3, q8 = tid & 7;
    for (int item = vb; item < B_ * 16; item += nvb) {
        const int b = item / 16, h = item % 16, ch = h * 64 + c;
        const float w0 = p->in[I_RW0][l * 1024 + ch], a0 = p->in[I_RA0][l * 1024 + ch], k_k = p->in[I_RKK][l * 1024 + ch], k_a = p->in[I_RKA][l * 1024 + ch];
        const float rk_c = p->in[I_RRK][(size_t)l * 1024 + ch];
        const float lnw = p->in[I_RLW][l * 1024 + ch], lnb = p->in[I_RLB][l * 1024 + ch];
        const float* mu = p->in[I_RMU] + (size_t)l * RWW;
        const float mu_r = mu[RW_R + ch], mu_k = mu[RW_K + ch], mu_v = mu[RW_V + ch];
        const float mu_wl = mu[RW_WL + c], mu_al = mu[RW_AL + c], mu_g0 = mu[RW_GL + c], mu_g1 = mu[RW_GL + 64 + c];
        const float* wup = p->in[I_RWUP] + (size_t)l * 64 * 1024 + h * 64; const float* aup = p->in[I_RAUP] + (size_t)l * 64 * 1024 + h * 64; const float* gup = p->in[I_RGUP] + (size_t)l * 128 * 1024 + h * 64;
#ifndef CPU_EMU
        const int wid = tid >> 6, lane = tid & 63, mt = wid >> 2, nt = wid & 3;
        rw_f16x8 bw[2], ba_[2], bg[4];
        {
            const int cn = nt * 16 + (lane & 15), kb = 8 * (lane >> 4);
#pragma unroll
            for (int ks = 0; ks < 2; ++ks)
#pragma unroll
                for (int j = 0; j < 8; ++j) { bw[ks][j] = (_Float16)wup[(size_t)(ks * 32 + kb + j) * 1024 + cn]; ba_[ks][j] = (_Float16)aup[(size_t)(ks * 32 + kb + j) * 1024 + cn]; }
#pragma unroll
            for (int ks = 0; ks < 4; ++ks)
#pragma unroll
                for (int j = 0; j < 8; ++j) bg[ks][j] = (_Float16)gup[(size_t)(ks * 32 + kb + j) * 1024 + cn];
        }
#endif
        float S[8];
#pragma unroll
        for (int e = 0; e < 8; ++e) S[e] = 0.f;
        uint4 pf[4];
#define RW_LOAD(t0_) do { _Pragma("unroll") for (int i = 0; i < 4; ++i) { const int j = tid + NT * i, row = j / 56, u = j % 56, t = (t0_) - 1 + row; pf[i] = zero16(); \
            if (j < (CH + 1) * 56 && t >= 0) pf[i] = ldg16(ACT + ((size_t)b * T_ + t) * LDZ + Z_RW + (u < 24 ? (u >> 3) * 1024 + h * 64 + (u & 7) * 8 : 3072 + (u - 24) * 8)); } } while (0)
#define RW_PUT() do { _Pragma("unroll") for (int i = 0; i < 4; ++i) { const int j = tid + NT * i; if (j < (CH + 1) * 56) *(uint4*)(raw + (j / 56) * 448 + (j % 56) * 8) = pf[i]; } } while (0)
        __syncthreads();
        RW_LOAD(0);
        RW_PUT();
        __syncthreads();
#pragma unroll 1
        for (int t0 = 0; t0 < T_; t0 += CH) {
#pragma unroll
            for (int s = 0; s < 4; ++s) {
                const int tl = tg * 4 + s;
                const h16_t* zc = raw + (tl + 1) * 448; const h16_t* zp = raw + tl * 448;
#define RW_SHIFT(col, muv) ({ const float zz = h2f(zc[col]); zz + (muv) * (h2f(zp[col]) - zz); })
                r_s[tl * 64 + c] = RW_SHIFT(c, mu_r);
                k_s[tl * 64 + c] = RW_SHIFT(64 + c, mu_k);
                v_s[tl * 64 + c] = RW_SHIFT(128 + c, mu_v);
                xs[tl * XS + c] = f2h(tanhf_(RW_SHIFT(192 + c, mu_wl)));
                xs[tl * XS + 64 + c] = f2h(RW_SHIFT(256 + c, mu_al));
                xs[tl * XS + 128 + c] = f2h(sigmoidf_(RW_SHIFT(320 + c, mu_g0)));
                xs[tl * XS + 192 + c] = f2h(sigmoidf_(RW_SHIFT(384 + c, mu_g1)));
#undef RW_SHIFT
            }
            __syncthreads();
            if (t0 + CH < T_) RW_LOAD(t0 + CH);
#ifdef CPU_EMU
#pragma unroll
            for (int s = 0; s < 4; ++s) {
                const int tl = tg * 4 + s;
                float dw = 0.f, da = 0.f, dg = 0.f;
                for (int i = 0; i < 64; ++i) { dw += h2f(xs[tl * XS + i]) * h2f(f2h(wup[(size_t)i * 1024 + c])); da += h2f(xs[tl * XS + 64 + i]) * h2f(f2h(aup[(size_t)i * 1024 + c])); }
                for (int i = 0; i < 128; ++i) dg += h2f(xs[tl * XS + 128 + i]) * h2f(f2h(gup[(size_t)i * 1024 + c]));
                w_s[tl * 64 + c] = dw; ka_s[tl * 64 + c] = da; g_s[tl * 64 + c] = dg;
            }
#else
            {
                const h16_t* ap = xs + (mt * 16 + (lane & 15)) * XS + 8 * (lane >> 4);
                rw_f32x4 dw = {0.f, 0.f, 0.f, 0.f}, da = {0.f, 0.f, 0.f, 0.f}, dg = {0.f, 0.f, 0.f, 0.f};
#pragma unroll
                for (int ks = 0; ks < 2; ++ks) {
                    dw = __builtin_amdgcn_mfma_f32_16x16x32_f16(*(const rw_f16x8*)(ap + ks * 32), bw[ks], dw, 0, 0, 0);
                    da = __builtin_amdgcn_mfma_f32_16x16x32_f16(*(const rw_f16x8*)(ap + 64 + ks * 32), ba_[ks], da, 0, 0, 0);
                }
#pragma unroll
                for (int ks = 0; ks < 4; ++ks) dg = __builtin_amdgcn_mfma_f32_16x16x32_f16(*(const rw_f16x8*)(ap + 128 + ks * 32), bg[ks], dg, 0, 0, 0);
#pragma unroll
                for (int rg = 0; rg < 4; ++rg) { const int o = (mt * 16 + 4 * (lane >> 4) + rg) * 64 + nt * 16 + (lane & 15); w_s[o] = dw[rg]; ka_s[o] = da[rg]; g_s[o] = dg[rg]; }
            }
#endif
            __syncthreads();
#pragma unroll
            for (int s = 0; s < 4; ++s) {
                const int tl = tg * 4 + s;
                const float w_log = -softplusf_(-(w0 + w_s[tl * 64 + c])) - 0.5f;
                const float decay = fexp_(-fexp_(w_log));
                const float a = sigmoidf_(a0 + ka_s[tl * 64 + c]);
                const float kx = k_s[tl * 64 + c], rx = r_s[tl * 64 + c];
                const float kkr = kx * k_k, k2 = kx * (1.0f + (a - 1.0f) * k_a);
                const float nsq = group_sum(kkr * kkr, 64, scr);
                const float bon = group_sum(rx * k2 * rk_c, 64, scr);
                const float kkn = kkr * rsqrtf(nsq + RMS_EPS);
                w_s[tl * 64 + c] = decay; k_s[tl * 64 + c] = k2; kk_s[tl * 64 + c] = kkn; ka_s[tl * 64 + c] = kkn * a;
                if (c == 0) bon_s[tl] = bon;
            }
            __syncthreads();
#pragma unroll 1
            for (int t = 0; t < CH; ++t) {
                const int o8 = t * 64 + q8 * 8;
                const float4 kk0 = *(const float4*)(kk_s + o8), kk1 = *(const float4*)(kk_s + o8 + 4);
                const float pk = (S[0] * kk0.x + S[1] * kk0.y) + (S[2] * kk0.z + S[3] * kk0.w) + ((S[4] * kk1.x + S[5] * kk1.y) + (S[6] * kk1.z + S[7] * kk1.w));
                const float skk = group_sum(pk, 8, scr);
                const float vi = v_s[t * 64 + ri];
                const float4 w0v = *(const float4*)(w_s + o8), w1v = *(const float4*)(w_s + o8 + 4);
                const float4 a0v = *(const float4*)(ka_s + o8), a1v = *(const float4*)(ka_s + o8 + 4);
                const float4 k0v = *(const float4*)(k_s + o8), k1v = *(const float4*)(k_s + o8 + 4);
                const float4 r0v = *(const float4*)(r_s + o8), r1v = *(const float4*)(r_s + o8 + 4);
                S[0] = S[0] * w0v.x - skk * a0v.x + vi * k0v.x; S[1] = S[1] * w0v.y - skk * a0v.y + vi * k0v.y; S[2] = S[2] * w0v.z - skk * a0v.z + vi * k0v.z; S[3] = S[3] * w0v.w - skk * a0v.w + vi * k0v.w;
                S[4] = S[4] * w1v.x - skk * a1v.x + vi * k1v.x; S[5] = S[5] * w1v.y - skk * a1v.y + vi * k1v.y; S[6] = S[6] * w1v.z - skk * a1v.z + vi * k1v.z; S[7] = S[7] * w1v.w - skk * a1v.w + vi * k1v.w;
                const float po = (S[0] * r0v.x + S[1] * r0v.y) + (S[2] * r0v.z + S[3] * r0v.w) + ((S[4] * r1v.x + S[5] * r1v.y) + (S[6] * r1v.z + S[7] * r1v.w));
                const float o = group_sum(po, 8, scr);
                if (q8 == 0) o_s[t * 64 + ri] = o;
            }
            __syncthreads();
#pragma unroll
            for (int s = 0; s < 4; ++s) {
                const int tl = tg * 4 + s;
                const float ov = o_s[tl * 64 + c];
                const float mean = group_sum(ov, 64, scr) * (1.0f / 64.0f);
                const float d = ov - mean;
                const float var = group_sum(d * d, 64, scr) * (1.0f / 64.0f);
                const float y = (d * rsqrtf(var + GN_EPS) * lnw + lnb + bon_s[tl] * v_s[tl * 64 + c]) * g_s[tl * 64 + c];
                ACT[((size_t)b * T_ + t0 + tl) * LDZ + C_YC + ch] = f2h(y);
            }
            __syncthreads();
            if (t0 + CH < T_) RW_PUT();
            __syncthreads();
        }
#undef RW_LOAD
#undef RW_PUT
    }
}

constexpr bool TAB_IN_ACT = (M_ == 16384);
constexpr float TAB_SU = 256.0f, TAB_SV = 32.0f;
__device__ __forceinline__ unsigned char* tab_row(char* ws, int e) {
    if (TAB_IN_ACT) return (unsigned char*)((h16_t*)(ws + OFF_ACT) + (size_t)e * LDZ + C_GS);
    return (unsigned char*)(ws + OFF_TAB) + (size_t)e * 2048;
}
#ifdef CPU_EMU
__device__ __forceinline__ unsigned f2fp8(float f) {
    const unsigned sgn = f < 0.f ? 0x80u : 0u; float a = fabsf(f);
    if (!(a == a)) return 0x7fu;
    if (a >= 448.0f) return sgn | 0x7eu;
    if (a < 0.0009765625f) return sgn;
    int e; frexpf(a, &e); e -= 1;
    if (e < -6) { const float q = nearbyintf(a * 512.0f); return sgn | (unsigned)q; }
    float q = nearbyintf((a / ldexpf(1.0f, e) - 1.0f) * 8.0f);
    if (q >= 8.0f) { q = 0.f; e += 1; }
    if (e > 8) return sgn | 0x7eu;
    const unsigned r = ((unsigned)(e + 7) << 3) | (unsigned)q;
    return sgn | (r > 0x7eu ? 0x7eu : r);
}
__device__ __forceinline__ float fp82f(unsigned b) {
    const unsigned e = (b >> 3) & 15u, m = b & 7u; const float s = (b & 0x80u) ? -1.f : 1.f;
    if (e == 0) return s * (float)m * 0.001953125f;
    return s * ldexpf(1.0f + (float)m * 0.125f, (int)e - 7);
}
__device__ __forceinline__ unsigned pack4fp8(float a, float b, float c, float d) { return f2fp8(a) | (f2fp8(b) << 8) | (f2fp8(c) << 16) | (f2fp8(d) << 24); }
__device__ __forceinline__ void dec4fp8(unsigned w, float* o) { o[0] = fp82f(w & 255u); o[1] = fp82f((w >> 8) & 255u); o[2] = fp82f((w >> 16) & 255u); o[3] = fp82f(w >> 24); }
#else
__device__ __forceinline__ unsigned pack4fp8(float a, float b, float c, float d) { int p = __builtin_amdgcn_cvt_pk_fp8_f32(a, b, 0, false); p = __builtin_amdgcn_cvt_pk_fp8_f32(c, d, p, true); return (unsigned)p; }
__device__ __forceinline__ void dec4fp8(unsigned w, float* o) { const auto lo = __builtin_amdgcn_cvt_pk_f32_fp8((int)w, false); const auto hi = __builtin_amdgcn_cvt_pk_f32_fp8((int)w, true); o[0] = lo[0]; o[1] = lo[1]; o[2] = hi[0]; o[3] = hi[1]; }
#endif
__device__ __forceinline__ void stage_tabconv(KParams p, int l) {
    const int tid = tid_();
    const float* U = p->in[I_PU] + (size_t)l * 16384 * 1024; const float* V = p->in[I_PV] + (size_t)l * 16384 * 1024;
    char* ws = p->ws;
    for (int it = bid_() * NT + tid; it < 16384 * 128; it += gridDim.x * NT) {
        const int r = it >> 7, ck = it & 127, which = ck >> 6, c16 = ck & 63;
        const float* src = (which ? V : U) + (size_t)r * 1024 + c16 * 16;
        const float sc = which ? TAB_SV : TAB_SU;
        const float4 a = *(const float4*)src, b = *(const float4*)(src + 4), c = *(const float4*)(src + 8), d = *(const float4*)(src + 12);
        uint4 w;
        w.x = pack4fp8(a.x * sc, a.y * sc, a.z * sc, a.w * sc); w.y = pack4fp8(b.x * sc, b.y * sc, b.z * sc, b.w * sc);
        w.z = pack4fp8(c.x * sc, c.y * sc, c.z * sc, c.w * sc); w.w = pack4fp8(d.x * sc, d.y * sc, d.z * sc, d.w * sc);
        *(uint4*)(tab_row(ws, r) + which * 1024 + c16 * 16) = w;
    }
}

__device__ __forceinline__ void stage_peer_topk(KParams p, int l, char* smem) {
    float* key_s = (float*)smem;
    const h16_t* ACT = (const h16_t*)(p->ws + OFF_ACT);
    float* TOPS = (float*)(p->ws + OFF_TOPS);
    const int tid = tid_();
    const int nb = gridDim.x;
    for (int hs = bid_() % 16; hs < 16; hs += nb) {
        const int hd = hs >> 1, s = hs & 1;
        __syncthreads();
        {
            const float* kp = p->in[I_PKEYS] + (((size_t)l * 8 + hd) * 2 + s) * 128 * 128;
            for (int i = tid * 4; i < 128 * 128; i += NT * 4) *(float4*)(key_s + i) = *(const float4*)(kp + i);
        }
        __syncthreads();
        const int nblk = nb >= 16 ? nb / 16 : 1, bsub = nb >= 16 ? bid_() / 16 : 0;
        for (int chunk = bsub; chunk < (M_ + NT - 1) / NT; chunk += nblk) {
            if (nb >= 16 && bid_() >= nblk * 16) break;
            const int m = chunk * NT + tid;
            if (m >= M_) continue;
            float q[128];
            {
                const h16_t* qp = ACT + (size_t)m * LDZ + C_QRY + hd * 256 + s * 128;
#pragma unroll
                for (int c8 = 0; c8 < 16; ++c8) { float t8[8]; load8h(qp + c8 * 8, t8);
#pragma unroll
                    for (int j = 0; j < 8; ++j) q[c8 * 8 + j] = t8[j]; }
            }
            float top[16];
#pragma unroll
            for (int i = 0; i < 16; ++i) top[i] = -3.0e38f;
#pragma unroll 2
            for (int n = 0; n < 128; ++n) {
                const float* kr = key_s + n * 128;
                float a0 = 0.f, a1 = 0.f, a2 = 0.f, a3 = 0.f;
#pragma unroll
                for (int c4 = 0; c4 < 32; ++c4) {
                    const float4 kv = *(const float4*)(kr + c4 * 4);
                    a0 += q[c4 * 4] * kv.x; a1 += q[c4 * 4 + 1] * kv.y; a2 += q[c4 * 4 + 2] * kv.z; a3 += q[c4 * 4 + 3] * kv.w;
                }
                float x = __uint_as_float((__float_as_uint((a0 + a1) + (a2 + a3)) & ~127u) | (unsigned)(127 - n));
#pragma unroll
                for (int i = 0; i < 16; ++i) { const float hi = fmaxf(top[i], x); x = fminf(top[i], x); top[i] = hi; }
            }
            float* tp = TOPS + (((size_t)m * 8 + hd) * 2 + s) * 16;
#pragma unroll
            for (int i = 0; i < 16; i += 4) *(float4*)(tp + i) = make_float4(top[i], top[i + 1], top[i + 2], top[i + 3]);
        }
    }
}

__device__ __forceinline__ void peer_cand(int k, int& i, int& j) {
    if (k < 16) { i = 0; j = k; } else if (k < 24) { i = 1; j = k - 16; } else if (k < 29) { i = 2; j = k - 24; } else if (k < 33) { i = 3; j = k - 29; }
    else if (k < 36) { i = 4; j = k - 33; } else if (k < 38) { i = 5; j = k - 36; } else if (k < 40) { i = 6; j = k - 38; } else if (k < 42) { i = 7; j = k - 40; }
    else { i = k - 34; j = 0; }
}
__device__ __forceinline__ float dot16q(const uint4 a, const float (&x)[16]) {
    float t[4], s0, s1;
    dec4fp8(a.x, t); s0 = t[0] * x[0] + t[1] * x[1]; s1 = t[2] * x[2] + t[3] * x[3];
    dec4fp8(a.y, t); s0 += t[0] * x[4] + t[1] * x[5]; s1 += t[2] * x[6] + t[3] * x[7];
    dec4fp8(a.z, t); s0 += t[0] * x[8] + t[1] * x[9]; s1 += t[2] * x[10] + t[3] * x[11];
    dec4fp8(a.w, t); s0 += t[0] * x[12] + t[1] * x[13]; s1 += t[2] * x[14] + t[3] * x[15];
    return s0 + s1;
}
__device__ __forceinline__ void axpy16q(const uint4 a, float s, float (&y)[16]) {
    float t[4];
    dec4fp8(a.x, t); y[0] += s * t[0]; y[1] += s * t[1]; y[2] += s * t[2]; y[3] += s * t[3];
    dec4fp8(a.y, t); y[4] += s * t[0]; y[5] += s * t[1]; y[6] += s * t[2]; y[7] += s * t[3];
    dec4fp8(a.z, t); y[8] += s * t[0]; y[9] += s * t[1]; y[10] += s * t[2]; y[11] += s * t[3];
    dec4fp8(a.w, t); y[12] += s * t[0]; y[13] += s * t[1]; y[14] += s * t[2]; y[15] += s * t[3];
}
#ifdef CPU_EMU
__device__ __forceinline__ float lane_xor(float v, int mask, float* scr) { const int tid = tid_(); scr[tid] = v; __syncthreads(); const float r = scr[tid ^ mask]; __syncthreads(); return r; }
__device__ __forceinline__ float lane_bcast(float v, int src, float* scr) { const int tid = tid_(); scr[tid] = v; __syncthreads(); const float r = scr[(tid & ~63) + src]; __syncthreads(); return r; }
#else
__device__ __forceinline__ float lane_xor(float v, int mask, float*) { return mask == 1 ? dpp_f<0xB1>(v) : (mask == 2 ? dpp_f<0x4E>(v) : __shfl_xor(v, mask)); }
__device__ __forceinline__ float lane_bcast(float v, int src, float*) { return __builtin_bit_cast(float, __builtin_amdgcn_readlane(__builtin_bit_cast(int, v), src)); }
#endif
__device__ __forceinline__ float reduce8(const float (&v)[8], int lane, float* scr) {
    const bool b0 = lane & 1, b1 = lane & 2, b2 = lane & 4;
    float w4[4], u2[2];
#pragma unroll
    for (int j = 0; j < 4; ++j) { const float keep = b0 ? v[2 * j + 1] : v[2 * j], send = b0 ? v[2 * j] : v[2 * j + 1]; w4[j] = keep + lane_xor(send, 1, scr); }
#pragma unroll
    for (int j = 0; j < 2; ++j) { const float keep = b1 ? w4[2 * j + 1] : w4[2 * j], send = b1 ? w4[2 * j] : w4[2 * j + 1]; u2[j] = keep + lane_xor(send, 2, scr); }
    float z = (b2 ? u2[1] : u2[0]) + lane_xor(b2 ? u2[0] : u2[1], 4, scr);
    z += lane_xor(z, 8, scr); z += lane_xor(z, 16, scr); z += lane_xor(z, 32, scr);
    return z;
}
__device__ __forceinline__ void stage_peer_gather(KParams p, int l, char* smem) {
    int tid = tid_(), w = tid >> 6, lane = tid & 63;
    float* base; float* tops_s; float* cand_s; float* best_s; int* idx_s; float* gate_s; int* pos_s;
#define PG_ROLES() do { tid = tid_(); w = tid >> 6; lane = tid & 63; base = (float*)smem + w * 2048; tops_s = base; cand_s = tops_s + 256; best_s = cand_s + 64; \
        idx_s = (int*)(best_s + 128); gate_s = (float*)(idx_s + 128); pos_s = (int*)(gate_s + 128); } while (0)
    PG_ROLES();
    float* scr = (float*)smem + 8 * 2048;
    h16_t* ACT = (h16_t*)(p->ws + OFF_ACT);
    const float* TOPS = (const float*)(p->ws + OFF_TOPS);
    char* ws = p->ws;
    const float* nxt_w = (l + 1 < NL_) ? p->in[I_NMIX] + (l + 1) * 1024 : p->in[I_NFINAL];
    const int nwaves = gridDim.x * 8;
    for (int m = bid_() * 8 + w; m < M_; m += nwaves) {
        PG_ROLES();
        __syncthreads();
        *(float4*)(tops_s + lane * 4) = *(const float4*)(TOPS + (size_t)m * 256 + lane * 4);
        float x[16];
        { float t8[8]; load8h(ACT + (size_t)m * LDZ + C_XN + lane * 16, t8);
#pragma unroll
          for (int j = 0; j < 8; ++j) x[j] = t8[j];
          load8h(ACT + (size_t)m * LDZ + C_XN + lane * 16 + 8, t8);
#pragma unroll
          for (int j = 0; j < 8; ++j) x[8 + j] = t8[j]; }
        __syncthreads();
        int ci = 0, cj = 0;
        if (lane < 50) peer_cand(lane, ci, cj);
        const int pos = ci * 16 + cj;
        pos_s[lane] = pos;
#pragma unroll 1
        for (int hd = 0; hd < 8; ++hd) {
            const float cs = lane < 50 ? tops_s[hd * 32 + ci] + tops_s[hd * 32 + 16 + cj] : -3.0e38f;
            cand_s[lane] = cs;
            __syncthreads();
            if (lane < 50) {
                int cnt = 0;
#pragma unroll 10
                for (int o = 0; o < 50; ++o) { const float ov = cand_s[o]; cnt += (ov > cs || (ov == cs && pos_s[o] < pos)) ? 1 : 0; }
                if (cnt < 16) {
                    best_s[hd * 16 + cnt] = cs;
                    const int n0 = 127 - (int)(__float_as_uint(tops_s[hd * 32 + ci]) & 127u), n1 = 127 - (int)(__float_as_uint(tops_s[hd * 32 + 16 + cj]) & 127u);
                    idx_s[hd * 16 + cnt] = n0 * 128 + n1;
                }
            }
            __syncthreads();
        }
#pragma unroll
        for (int rr = 0; rr < 2; ++rr) {
            const int e = lane + 64 * rr, hd = e >> 4;
            const float mx = best_s[hd * 16];
            float sum = 0.f;
#pragma unroll
            for (int i = 0; i < 16; ++i) sum += fexp_(best_s[hd * 16 + i] - mx);
            gate_s[e] = fexp_(best_s[e] - mx) / sum;
        }
        __syncthreads();
        float y[16];
#pragma unroll
        for (int i = 0; i < 16; ++i) y[i] = 0.f;
        PG_ROLES();
        uint4 uu[8], vv[8];
#define PG_LOADU(eb_) do { _Pragma("unroll") for (int k = 0; k < 8; ++k) uu[k] = *(const uint4*)(tab_row(ws, idx_s[(eb_) + k]) + lane * 16); } while (0)
#define PG_LOADV(eb_) do { _Pragma("unroll") for (int k = 0; k < 8; ++k) vv[k] = *(const uint4*)(tab_row(ws, idx_s[(eb_) + k]) + 1024 + lane * 16); } while (0)
        PG_LOADU(0); PG_LOADV(0);
#pragma unroll 1
        for (int eb = 0; eb < 128; eb += 8) {
            float d8[8];
#pragma unroll
            for (int k = 0; k < 8; ++k) d8[k] = dot16q(uu[k], x);
            if (eb + 8 < 128) PG_LOADU(eb + 8);
            const float tot = reduce8(d8, lane, scr);
            const float hk = gate_s[eb + (lane & 7)] * geluf_(tot * (1.0f / TAB_SU));
#pragma unroll
            for (int k = 0; k < 8; ++k) axpy16q(vv[k], lane_bcast(hk, k, scr), y);
            if (eb + 8 < 128) PG_LOADV(eb + 8);
        }
#undef PG_LOADU
#undef PG_LOADV
        PG_ROLES();
        float* op = p->out + (size_t)m * 1024 + lane * 16;
        float hn[16]; float ss = 0.f;
#pragma unroll
        for (int i = 0; i < 16; i += 4) {
            const float4 o4 = *(const float4*)(op + i);
            hn[i] = o4.x + y[i] * (1.0f / TAB_SV); hn[i + 1] = o4.y + y[i + 1] * (1.0f / TAB_SV); hn[i + 2] = o4.z + y[i + 2] * (1.0f / TAB_SV); hn[i + 3] = o4.w + y[i + 3] * (1.0f / TAB_SV);
            ss += hn[i] * hn[i] + hn[i + 1] * hn[i + 1] + hn[i + 2] * hn[i + 2] + hn[i + 3] * hn[i + 3];
        }
        ss = group_sum(ss, 64, scr);
        const float rstd = rsqrtf(ss * (1.0f / D_) + RMS_EPS);
        float nv[16];
#pragma unroll
        for (int i = 0; i < 16; i += 4) { const float4 w4 = *(const float4*)(nxt_w + lane * 16 + i); nv[i] = hn[i] * rstd * w4.x; nv[i + 1] = hn[i + 1] * rstd * w4.y; nv[i + 2] = hn[i + 2] * rstd * w4.z; nv[i + 3] = hn[i + 3] * rstd * w4.w; }
        if (l + 1 < NL_) {
#pragma unroll
            for (int i = 0; i < 16; i += 4) *(float4*)(op + i) = make_float4(hn[i], hn[i + 1], hn[i + 2], hn[i + 3]);
            const float n0[8] = {nv[0], nv[1], nv[2], nv[3], nv[4], nv[5], nv[6], nv[7]}, n1[8] = {nv[8], nv[9], nv[10], nv[11], nv[12], nv[13], nv[14], nv[15]};
            store8h(ACT + (size_t)m * LDZ + C_XN + lane * 16, n0); store8h(ACT + (size_t)m * LDZ + C_XN + lane * 16 + 8, n1);
        } else {
#pragma unroll
            for (int i = 0; i < 16; i += 4) *(float4*)(op + i) = make_float4(nv[i], nv[i + 1], nv[i + 2], nv[i + 3]);
        }
    }
}
#undef PG_ROLES

enum { PH_NORM_MIX = 0, PH_INPROJ, PH_MIXERS, PH_MERGE, PH_WOUT, PH_NORM_FFN, PH_QUERY, PH_TOPK, PH_GATHER, PH_PER_LAYER, PH_FINAL = 100, PH_WPREP = 101 };
__device__ __forceinline__ void run_phase(KParams p, int l, int ph, char* smem) {
    h16_t* ACT = (h16_t*)(p->ws + OFF_ACT);
    const float* hin = l == 0 ? p->in[I_X] : p->out;
    switch (ph) {
    case PH_WPREP: stage_wprep(p, smem); break;
    case PH_NORM_MIX: if (l == 0) stage_rmsnorm<false>(hin, p->in[I_NMIX] + l * 1024, ACT + C_XN, LDZ, smem); break;
    case PH_INPROJ: stage_gemm(p, l, GP_INPROJ, smem); break;
    case PH_MIXERS: {
        const int nb = gridDim.x, n_rw = nb / 2, n_gd = nb / 4, n_lr = nb - n_rw - n_gd;
        stage_rwkv(p, l, smem, 0, n_rw);
        stage_gdn(p, l, smem, n_rw, n_gd);
        stage_lru(p, l, smem, n_rw + n_gd, n_lr);
    } break;
    case PH_MERGE: stage_gemm(p, l, GP_MERGE, smem); break;
    case PH_WOUT: stage_gemm(p, l, GP_WOUT, smem); break;
    case PH_NORM_FFN: stage_rmsnorm<false>(p->out, p->in[I_NFFN] + l * 1024, ACT + C_XN, LDZ, smem); stage_tabconv(p, l); break;
    case PH_QUERY: stage_gemm(p, l, GP_QUERY, smem); break;
    case PH_TOPK: stage_peer_topk(p, l, smem); break;
    case PH_GATHER: stage_peer_gather(p, l, smem); break;
    case PH_FINAL: break;
    default: break;
    }
}


#if !defined(CPU_EMU) && !MK_MULTI
#define XB_TMO      128
#define XB_XCNT(j)  (256  + 64 * (j))
#define XB_XSUB(j)  (1280 + 64 * (j))
#define XB_XGEN(j)  (2304 + 64 * (j))
#define XB_TOP      3328
#define XB_TOPGEN   3392
#define XCD_BAR_WORDS 3456
#define XB_SPIN_CAP (1u << 22)
#define XB_LAS __attribute__((address_space(3)))
__device__ __forceinline__ unsigned xb_ld(unsigned* p)              { return __hip_atomic_load(p, __ATOMIC_RELAXED, __HIP_MEMORY_SCOPE_AGENT); }
__device__ __forceinline__ unsigned xb_add(unsigned* p, unsigned v) { return __hip_atomic_fetch_add(p, v, __ATOMIC_RELAXED, __HIP_MEMORY_SCOPE_AGENT); }
__device__ __forceinline__ unsigned xb_xcc_id() { return (unsigned)__builtin_amdgcn_s_getreg((3 << 11) | 20) & 0xFu; }
#define XB_SPIN(cond, bar) do { unsigned _sp = 0; while (cond) { __builtin_amdgcn_s_sleep(1); \
    if ((++_sp & 255u) == 0u) { if (xb_ld(&(bar)[XB_TMO])) break; if (_sp > XB_SPIN_CAP) { atomicAdd(&(bar)[XB_TMO], 1u); break; } } } } while (0)
struct XcdBarrier { unsigned* bar; unsigned x; volatile XB_LAS unsigned* st; };
__device__ __forceinline__ XcdBarrier xcd_barrier_post(unsigned* bar, volatile XB_LAS unsigned* st) {
    XcdBarrier b; b.bar = bar; b.x = xb_xcc_id(); b.st = st;
    if (threadIdx.x == 0) (void)xb_add(&bar[XB_XCNT(b.x)], 1u);
    return b;
}
__device__ __forceinline__ void xcd_barrier_complete(unsigned* bar, unsigned x, unsigned& nloc, unsigned& nx) {
    const unsigned G = gridDim.x * gridDim.y * gridDim.z;
    unsigned sum, cnt, mine, sp = 0u;
    for (;;) {
        sum = 0u; cnt = 0u; mine = 0u;
#pragma unroll
        for (unsigned j = 0; j < 16; ++j) { const unsigned c = xb_ld(&bar[XB_XCNT(j)]); sum += c; cnt += (c > 0u) ? 1u : 0u; mine = (j == x) ? c : mine; }
        if (sum == G) break;
        __builtin_amdgcn_s_sleep(1);
        if ((++sp & 255u) == 0u) { if (xb_ld(&bar[XB_TMO])) break; if (sp > XB_SPIN_CAP) { atomicAdd(&bar[XB_TMO], 1u); break; } }
    }
    nloc = mine > 0u ? mine : 1u; nx = cnt > 0u ? cnt : 1u;
}
__device__ __forceinline__ void xcd_barrier(const XcdBarrier& b) {
    asm volatile("s_waitcnt vmcnt(0)" ::: "memory");
    __syncthreads();
    if (threadIdx.x == 0) {
        unsigned* bar = b.bar;
        __builtin_amdgcn_s_waitcnt(0);
        unsigned nloc = b.st[0], nx = b.st[1];
        if (nloc == 0u) { xcd_barrier_complete(bar, b.x, nloc, nx); b.st[0] = nloc; b.st[1] = nx; }
        const unsigned old = xb_add(&bar[XB_XSUB(b.x)], 1u);
        const unsigned gen = old / nloc;
        if (old + 1u == (gen + 1u) * nloc) {
            __builtin_amdgcn_fence(__ATOMIC_RELEASE, "agent");
            asm volatile("s_waitcnt vmcnt(0)" ::: "memory");
            const unsigned og = xb_add(&bar[XB_TOP], 1u);
            const unsigned tg = og / nx;
            if (og + 1u == (tg + 1u) * nx) xb_add(&bar[XB_TOPGEN], 1u);
            else XB_SPIN(xb_ld(&bar[XB_TOPGEN]) == tg, bar);
            __builtin_amdgcn_fence(__ATOMIC_ACQUIRE, "agent");
            xb_add(&bar[XB_XGEN(b.x)], 1u);
            asm volatile("s_waitcnt vmcnt(0)" ::: "memory");
        } else {
            XB_SPIN(xb_ld(&bar[XB_XGEN(b.x)]) == gen, bar);
            __builtin_amdgcn_fence(__ATOMIC_ACQUIRE, "agent");
            asm volatile("s_waitcnt vmcnt(0)" ::: "memory");
        }
    }
    __syncthreads();
}
#endif
#if !defined(CPU_EMU) && !MK_MULTI
__global__ void __launch_bounds__(512, 2) k_mega(Params p_) {
    DYN_SMEM(smem);
    KParams pk = (KParams)__builtin_amdgcn_kernarg_segment_ptr();
    cg::grid_group grid = cg::this_grid();
    volatile XB_LAS unsigned* xst = (volatile XB_LAS unsigned*)(XB_LAS char*)(smem + SMEM_BYTES);
    if (threadIdx.x == 0) { xst[0] = 0u; xst[1] = 0u; xst[2] = 0u; xst[3] = 0u; }
    __syncthreads();
    const XcdBarrier xb = xcd_barrier_post((unsigned*)(pk->ws + OFF_BAR), xst);
    bool first_sync = true;
    constexpr int NIT = NL_ * PH_PER_LAYER;
#pragma unroll 1
    for (int it = -1; it <= NIT; ++it) {
        const int l = (it >= 0 && it < NIT) ? it / PH_PER_LAYER : 0, ph = it < 0 ? (int)PH_WPREP : (it < NIT ? it % PH_PER_LAYER : (int)PH_FINAL);
        KParams q = pk; asm volatile("" : "+s"(q));
        run_phase(q, l, ph, smem);
        if (it >= 0 && it < NIT - 1 && !(l > 0 && ph == PH_NORM_MIX)) {
            if (first_sync) { grid.sync(); first_sync = false; }
            else xcd_barrier(xb);
        }
    }
}
#endif
#ifdef CPU_EMU
__global__ void k_phase(Params p_, int l, int ph) { DYN_SMEM(smem); run_phase(&p_, l, ph, smem); }
#elif MK_MULTI
__global__ void __launch_bounds__(512, 2) k_phase(Params p_, int l, int ph) { DYN_SMEM(smem); KParams pk = (KParams)__builtin_amdgcn_kernarg_segment_ptr(); run_phase(pk, l, ph, smem); }
#endif
}

#ifdef CPU_EMU
int g_emu_stop = 1000;
#endif

extern "C" void kernel_launch(void* const* d_in, const int* in_sizes, int n_in, void* d_out, int out_size, void* d_ws, size_t ws_size, hipStream_t stream) {
    Params p{};
    for (int i = 0; i < N_IN; ++i) p.in[i] = (const float*)d_in[i];
    p.out = (float*)d_out; p.ws = (char*)d_ws;
#if defined(CPU_EMU) || MK_MULTI
    const int grid = 256;
    LAUNCH(k_phase, grid, NT, SMEM_BYTES, stream, p, 0, (int)PH_WPREP);
    for (int l = 0; l < NL_; ++l)
        for (int ph = 0; ph < PH_PER_LAYER; ++ph) {
            LAUNCH(k_phase, grid, NT, SMEM_BYTES, stream, p, l, ph);
#ifdef CPU_EMU
            const int code = ph == PH_INPROJ ? 1 : ph == PH_MIXERS ? 2 : ph == PH_MERGE ? 3 : ph == PH_WOUT ? 4 : ph == PH_GATHER ? 5 : 0;
            if (code && g_emu_stop == l * 10 + code) return;
#endif
        }
    LAUNCH(k_phase, grid, NT, SMEM_BYTES, stream, p, 0, (int)PH_FINAL);
#else
    static int grid_blocks = 0;
    if (!grid_blocks) {
        int dev = 0, cus = 0, per_cu = 0;
        (void)hipGetDevice(&dev);
        (void)hipDeviceGetAttribute(&cus, hipDeviceAttributeMultiprocessorCount, dev);
        (void)hipFuncSetAttribute((const void*)k_mega, hipFuncAttributeMaxDynamicSharedMemorySize, (int)SMEM_BYTES + 16);
        (void)hipOccupancyMaxActiveBlocksPerMultiprocessor(&per_cu, k_mega, NT, SMEM_BYTES + 16);
        if (per_cu > 1) per_cu = 1;
        grid_blocks = cus * per_cu;
    }
    (void)hipMemsetAsync((char*)d_ws + OFF_BAR, 0, 16384, stream);
    void* args[] = {&p};
    hipError_t e = hipLaunchCooperativeKernel((void*)k_mega, dim3(grid_blocks), dim3(NT), args, SMEM_BYTES + 16, stream);
    if (e != hipSuccess) fprintf(stderr, "cooperative launch failed: %s (grid %d)\n", hipGetErrorString(e), grid_blocks);
#endif
}
```

```cpp
#ifndef CPU_EMU
#include <hip/hip_runtime.h>
#include <hip/hip_cooperative_groups.h>
#include <cstdio>
#include <cstdint>
namespace cg = cooperative_groups;
#define DYN_SMEM(name) extern __shared__ __attribute__((aligned(16))) char name[]
#define LAUNCH(kern, grid, block, smem, stream, ...) hipLaunchKernelGGL(kern, dim3(grid), dim3(block), smem, stream, __VA_ARGS__)
#endif

#ifndef CFG_B
#define CFG_B 8
#endif
#ifndef CFG_T
#define CFG_T 2048
#endif
#ifndef MK_MULTI
#define MK_MULTI 0
#endif

namespace {
constexpr int B_ = CFG_B, T_ = CFG_T, M_ = B_ * T_, D_ = 1024, NL_ = 2, NT = 512;
constexpr int INW = 12560;
constexpr int LDZ = 11776;
constexpr int Z_ULRU = 0, Z_GLRU = 1024, Z_Q = 2048, Z_K = 3072, Z_V = 4096, Z_ZG = 5120, Z_RW = 6144, Z_ALPHA = 9472, Z_BETA = 9480;
constexpr int ZN = 9728;
constexpr int C_XN = 9728, C_YC = 10752;
constexpr int C_YA = Z_GLRU, C_YB = Z_ZG;
constexpr int C_GS = Z_Q, C_MG = Z_K;
constexpr int C_QRY = 0;
constexpr int RW_R = 0, RW_K = 1024, RW_V = 2048, RW_WL = 3072, RW_AL = 3136, RW_GL = 3200, RWW = 3328;
constexpr float RMS_EPS = 1e-6f, GN_EPS = 64e-5f;
typedef unsigned short h16_t;

enum { I_X = 0, I_NMIX, I_NFFN, I_NFINAL, I_WIN, I_LCW, I_LCB, I_LWA, I_LBA, I_LWX, I_LBX, I_LLAM, I_GCW, I_GALOG, I_GDT, I_GNW,
       I_RMU, I_RW0, I_RWUP, I_RA0, I_RAUP, I_RGUP, I_RKK, I_RKA, I_RRK, I_RLW, I_RLB, I_MB, I_PL, I_PG, I_PR, I_WOUT, I_PWQ, I_PKEYS, I_PU, I_PV, N_IN };

struct Params {
    const float* in[N_IN];
    float* out;
    char* ws;
};
#ifdef CPU_EMU
typedef const Params* KParams;
#else
typedef const Params __attribute__((address_space(4)))* KParams;
#endif

constexpr size_t al256(size_t x) { return (x + 255) / 256 * 256; }
constexpr size_t OFF_ACT = 0;
constexpr size_t OFF_WT = al256(OFF_ACT + (size_t)M_ * LDZ * 2);
constexpr int WT_IN = 0, WT_MG = ZN, WT_P = WT_MG + 3072, WT_OUT = WT_P + 3072, WT_Q = WT_OUT + 1024, WT_ROWS = WT_Q + 2048;
constexpr size_t OFF_TOPS = al256(OFF_WT + (size_t)NL_ * WT_ROWS * 1024 * 2);
constexpr size_t OFF_TAB = al256(OFF_TOPS + (size_t)M_ * 256 * 4);
constexpr size_t OFF_BAR = OFF_TAB + (M_ == 16384 ? 0 : (size_t)16384 * 2048);
constexpr size_t WS_END = OFF_BAR + 16384;
static_assert(CFG_B != 8 || CFG_T != 2048 || WS_END <= (size_t)512 * 1024 * 1024, "workspace budget");
constexpr size_t SMEM_BYTES = 128 * 1024;

#ifdef CPU_EMU
__device__ __forceinline__ int tid_() { return threadIdx.x; }
__device__ __forceinline__ h16_t f2h(float f) { return (h16_t)_cvtss_sh(f, _MM_FROUND_TO_NEAREST_INT); }
__device__ __forceinline__ float h2f(h16_t h) { return _cvtsh_ss(h); }
#else
__device__ __forceinline__ int tid_() { int t = threadIdx.x; asm volatile("" : "+v"(t)); return t; }
__device__ __forceinline__ h16_t f2h(float f) { return __builtin_bit_cast(unsigned short, (_Float16)f); }
__device__ __forceinline__ float h2f(h16_t h) { return (float)__builtin_bit_cast(_Float16, h); }
#endif
__device__ __forceinline__ int bid_() { return (int)blockIdx.x; }

#ifdef CPU_EMU
__device__ __forceinline__ float fexp_(float x) { return expf(x); }
__device__ __forceinline__ float flog_(float x) { return logf(x); }
__device__ __forceinline__ float frcp_(float x) { return 1.0f / x; }
#else
__device__ __forceinline__ float fexp_(float x) { return __builtin_amdgcn_exp2f(x * 1.4426950408889634f); }
__device__ __forceinline__ float flog_(float x) { return __builtin_amdgcn_logf(x) * 0.6931471805599453f; }
__device__ __forceinline__ float frcp_(float x) { return __builtin_amdgcn_rcpf(x); }
#endif
__device__ __forceinline__ float sigmoidf_(float x) { return frcp_(1.0f + fexp_(-x)); }
__device__ __forceinline__ float softplusf_(float x) { return fmaxf(x, 0.0f) + flog_(1.0f + fexp_(-fabsf(x))); }
__device__ __forceinline__ float siluf_(float x) { return x * sigmoidf_(x); }
__device__ __forceinline__ float tanhf_(float x) { return 1.0f - 2.0f * frcp_(1.0f + fexp_(2.0f * x)); }
__device__ __forceinline__ float geluf_(float x) { return x * frcp_(1.0f + fexp_(-1.5957691216057308f * (x + 0.044715f * x * x * x))); }
__device__ __forceinline__ unsigned pack2h(float a, float b) { return (unsigned)f2h(a) | ((unsigned)f2h(b) << 16); }
__device__ __forceinline__ void store8h(h16_t* p, const float (&v)[8]) {
    uint4 w; w.x = pack2h(v[0], v[1]); w.y = pack2h(v[2], v[3]); w.z = pack2h(v[4], v[5]); w.w = pack2h(v[6], v[7]);
    *(uint4*)p = w;
}
__device__ __forceinline__ void load8h(const h16_t* p, float (&v)[8]) {
    const uint4 w = *(const uint4*)p;
    v[0] = h2f((h16_t)(w.x & 0xffffu)); v[1] = h2f((h16_t)(w.x >> 16)); v[2] = h2f((h16_t)(w.y & 0xffffu)); v[3] = h2f((h16_t)(w.y >> 16));
    v[4] = h2f((h16_t)(w.z & 0xffffu)); v[5] = h2f((h16_t)(w.z >> 16)); v[6] = h2f((h16_t)(w.w & 0xffffu)); v[7] = h2f((h16_t)(w.w >> 16));
}

__device__ __forceinline__ float block_sum512(float v, float* red) {
    const int tid = tid_();
    red[tid] = v;
    __syncthreads();
    if (tid < 32) { float s = 0.f; for (int i = 0; i < 16; ++i) s += red[tid * 16 + i]; red[512 + tid] = s; }
    __syncthreads();
    float tot = 0.f;
    for (int i = 0; i < 32; ++i) tot += red[512 + i];
    __syncthreads();
    return tot;
}

template <bool OUT_F32>
__device__ __forceinline__ void stage_rmsnorm(const float* src, const float* w, void* dst, int ldd, char* smem) {
    float* red = (float*)smem;
    const int tid = tid_();
    for (int row = bid_(); row < M_; row += gridDim.x) {
        const float2 v = *(const float2*)(src + (size_t)row * D_ + tid * 2);
        const float ss = block_sum512(v.x * v.x + v.y * v.y, red);
        const float rstd = rsqrtf(ss * (1.0f / D_) + RMS_EPS);
        const float2 wv = *(const float2*)(w + tid * 2);
        const float o0 = v.x * rstd * wv.x, o1 = v.y * rstd * wv.y;
        if (OUT_F32) {
            float2 o; o.x = o0; o.y = o1;
            *(float2*)((float*)dst + (size_t)row * ldd + tid * 2) = o;
        } else {
            *(unsigned*)((h16_t*)dst + (size_t)row * ldd + tid * 2) = pack2h(o0, o1);
        }
    }
}

__device__ __forceinline__ const float* wt_src(KParams p, int l, int r, int& ld) {
    if (r < ZN) {
        ld = INW;
        int c;
        if (r < 6144) c = r; else if (r < 9472) c = r + 16; else if (r < 9488) c = r - 3328; else return nullptr;
        return p->in[I_WIN] + (size_t)l * 1024 * INW + c;
    }
    r -= ZN;
    if (r < 3072) { ld = INW; return p->in[I_WIN] + (size_t)l * 1024 * INW + 9488 + r; }
    r -= 3072;
    if (r < 3072) { ld = 1024; const int br = r >> 10; return p->in[br == 0 ? I_PL : (br == 1 ? I_PG : I_PR)] + (size_t)l * 1024 * 1024 + (r & 1023); }
    r -= 3072;
    if (r < 1024) { ld = 1024; return p->in[I_WOUT] + (size_t)l * 1024 * 1024 + r; }
    r -= 1024;
    ld = 2048; return p->in[I_PWQ] + (size_t)l * 1024 * 2048 + r;
}
__device__ __forceinline__ void stage_wprep(KParams p, char* smem) {
    float* tile = (float*)smem;
    h16_t* WT = (h16_t*)(p->ws + OFF_WT);
    const int tid = tid_();
    const int ntr = WT_ROWS / 64, total = NL_ * ntr * 16;
    for (int it = bid_(); it < total; it += gridDim.x) {
        const int l = it / (ntr * 16), rem = it % (ntr * 16), rt = rem / 16, kt = rem % 16;
        const int r0 = rt * 64, k0 = kt * 64;
        __syncthreads();
        {
            const int nn = tid & 63;
            int ld = 0; const float* src = wt_src(p, l, r0 + nn, ld);
#pragma unroll
            for (int i = 0; i < 8; ++i) { const int kk = (tid >> 6) + 8 * i; tile[kk * 65 + nn] = src ? src[(size_t)(k0 + kk) * ld] : 0.f; }
        }
        __syncthreads();
        {
            const int r = tid >> 3, kq = (tid & 7) * 8;
            float v[8];
#pragma unroll
            for (int j = 0; j < 8; ++j) v[j] = tile[(kq + j) * 65 + r];
            store8h(WT + ((size_t)l * WT_ROWS + r0 + r) * 1024 + k0 + kq, v);
        }
    }
}

namespace pg8 {
constexpr int BM = 256, BK = 64, HALF = 128, HTB = HALF * BK * 2, STAGE_BYTES = 8 * HTB, NXCD = 8, WGM = 8;
struct Unit { const char* A; const char* B; int pm, pn, kind; };
#ifdef CPU_EMU
struct f32x4 { float d[4]; float& operator[](int i) { return d[i]; } const float& operator[](int i) const { return d[i]; } };
#else
#define PG8_LAS __attribute__((address_space(3)))
typedef _Float16 f16x8 __attribute__((ext_vector_type(8)));
typedef float f32x4 __attribute__((ext_vector_type(4)));
__device__ __forceinline__ int lds_byte(int r, int c) { const int st = (r >> 4) * 2 + (c >> 5), rr = r & 15, cc = c & 31, ob = rr * 64 + cc * 2; return st * 1024 + (ob ^ (((ob >> 9) & 1) << 5)); }
__device__ __forceinline__ void stage_rc(int b, int& R, int& C) { const int st = b / 1024, sb = b % 1024, swz = sb ^ (((sb >> 9) & 1) << 5); R = (st >> 1) * 16 + swz / 64; C = (st & 1) * 32 + (swz % 64) / 2; }
__device__ __forceinline__ int perm32(int rho) { const int n = rho >> 4, i = rho & 15; return 8 * (i >> 2) + 4 * n + (i & 3); }
#endif
__device__ __forceinline__ void tile_of(int L, int nM, int nN, int& pm, int& pn) {
    const int nwg = nM * nN;
    int wgid = L; { const int q = nwg / NXCD, r = nwg % NXCD, xcd = wgid % NXCD, off = wgid / NXCD; wgid = (xcd < r ? xcd * (q + 1) : r * (q + 1) + (xcd - r) * q) + off; }
    const int nig = WGM * nN, gid = wgid / nig, fm = gid * WGM, gsz = (nM - fm) < WGM ? (nM - fm) : WGM;
    pm = fm + ((wgid % nig) % gsz); pn = (wgid % nig) / gsz;
}

template <class Sched, class Epi>
__device__ __forceinline__ void gemm_phase(char* smem, const Sched& S, const Epi& E) {
    constexpr int K = 1024, nt = K / BK;
    constexpr unsigned lda = LDZ, ldb = 1024;
#ifdef CPU_EMU
    const int tid = tid_(), wid = tid >> 6, lane = tid & 63, wr = wid >> 2, wc = wid & 3, fr = lane & 15, fq = lane >> 4;
    Unit u;
    for (int ui = 0; S.next(ui, u); ++ui) {
        f32x4 acc[2][2][4][2];
        for (int ai = 0; ai < 2; ++ai) for (int bj = 0; bj < 2; ++bj) for (int m = 0; m < 4; ++m) for (int n = 0; n < 2; ++n) for (int e = 0; e < 4; ++e) {
            const int r = 128 * ai + 64 * wr + 16 * m + fr, c = 128 * bj + 32 * wc + 8 * fq + 4 * n + e;
            const h16_t* a = (const h16_t*)u.A + (size_t)r * lda; const h16_t* b = (const h16_t*)u.B + (size_t)c * ldb;
            float s = 0.f;
            for (int k = 0; k < K; ++k) s += h2f(a[k]) * h2f(b[k]);
            acc[ai][bj][m][n][e] = s;
        }
        E(acc, u, wr, wc, fr, fq);
    }
    (void)smem; (void)nt;
#else
    PG8_LAS unsigned char* lds = (PG8_LAS unsigned char*)smem;
    const int tid = tid_(), wid = __builtin_amdgcn_readfirstlane(tid >> 6), lane = tid & 63, wr = wid >> 2, wc = wid & 3, fr = lane & 15, fq = lane >> 4;
    unsigned voffA[2], voffB[2];
#pragma unroll
    for (int i = 0; i < 2; ++i) { int R, C; stage_rc(tid * 16 + i * 8192, R, C); const int Rb = (R & ~31) + perm32(R & 31);
        voffA[i] = (unsigned)(R * lda + C) * 2u; voffB[i] = (unsigned)(Rb * ldb + C) * 2u; }
    constexpr size_t kstep = (size_t)(BK * 2);
    constexpr size_t hstepA = (size_t)HALF * lda * 2, hstepB = (size_t)HALF * ldb * 2;
    const unsigned ldsw = (unsigned)wid * 1024u;
    const int aoff = lds_byte(wr * 64 + fr, fq * 8), boff = lds_byte(wc * 32 + fr, fq * 8);
#define PG8_SA(b, h) (((b) * 2 + (h)) * HTB)
#define PG8_SB(b, h) ((4 + (b) * 2 + (h)) * HTB)
#define PG8_STAGE(bufoff, gbase, voff) do { _Pragma("unroll") for (int _i = 0; _i < 2; ++_i) \
        __builtin_amdgcn_global_load_lds((const unsigned*)((const char*)(gbase) + (voff)[_i]), (PG8_LAS unsigned*)(lds + (bufoff) + ldsw + _i * 8192), 16, 0, 0); } while (0)
#define PG8_LDA(dst, b, h) do { _Pragma("unroll") for (int m = 0; m < 4; ++m) _Pragma("unroll") for (int k = 0; k < 2; ++k) dst[m][k] = *(const PG8_LAS f16x8*)(lds + PG8_SA(b, h) + aoff + m * 2048 + k * 1024); } while (0)
#define PG8_LDB(dst, b, h) do { _Pragma("unroll") for (int n = 0; n < 2; ++n) _Pragma("unroll") for (int k = 0; k < 2; ++k) dst[n][k] = *(const PG8_LAS f16x8*)(lds + PG8_SB(b, h) + boff + n * 2048 + k * 1024); } while (0)
#define PG8_MMA(ai, bj, At, Bt) do { __builtin_amdgcn_s_setprio(1); _Pragma("unroll") for (int m = 0; m < 4; ++m) _Pragma("unroll") for (int n = 0; n < 2; ++n) _Pragma("unroll") for (int k = 0; k < 2; ++k) \
        acc[ai][bj][m][n] = __builtin_amdgcn_mfma_f32_16x16x32_f16(Bt[n][k], At[m][k], acc[ai][bj][m][n], 0, 0, 0); __builtin_amdgcn_s_setprio(0); } while (0)
#define PG8_WAIT_V(n) asm volatile("s_waitcnt vmcnt(" #n ")" ::: "memory")
#define PG8_WAIT_L(n) asm volatile("s_waitcnt lgkmcnt(" #n ")" ::: "memory")
#define PG8_BAR __builtin_amdgcn_s_barrier()
#define PG8_SCHED __builtin_amdgcn_sched_barrier(0)
    Unit cur, nxt; int ui = 0;
    if (!S.next(0, cur)) return;
    f32x4 acc[2][2][4][2];
#pragma unroll
    for (int a = 0; a < 2; ++a)
#pragma unroll
        for (int b = 0; b < 2; ++b)
#pragma unroll
            for (int m = 0; m < 4; ++m)
#pragma unroll
                for (int n = 0; n < 2; ++n) acc[a][b][m][n] = (f32x4){0.f, 0.f, 0.f, 0.f};
    f16x8 At[4][2], B0[2][2], B1[2][2];
    const char* cA = cur.A; const char* cB = cur.B;
    PG8_STAGE(PG8_SB(0, 0), cB, voffB); PG8_STAGE(PG8_SA(0, 0), cA, voffA); PG8_STAGE(PG8_SB(0, 1), cB + hstepB, voffB); PG8_STAGE(PG8_SA(0, 1), cA + hstepA, voffA);
    if (wr == 1) PG8_BAR;
    PG8_WAIT_V(4); PG8_BAR;
    PG8_STAGE(PG8_SB(1, 0), cB + kstep, voffB); PG8_STAGE(PG8_SA(1, 0), cA + kstep, voffA); PG8_STAGE(PG8_SB(1, 1), cB + hstepB + kstep, voffB);
    PG8_WAIT_V(6); PG8_BAR;
    for (;;) {
        const bool has_next = S.next(ui + 1, nxt);
        const char* nA = has_next ? nxt.A : cA; const char* nB = has_next ? nxt.B : cB;
#pragma unroll 1
        for (int t = 0; t < nt; t += 2) {
            const bool last = (t == nt - 2);
            const char* a1 = cA + (size_t)(t + 1) * kstep;
            const char* a2 = last ? nA : cA + (size_t)(t + 2) * kstep; const char* b2 = last ? nB : cB + (size_t)(t + 2) * kstep;
            const char* a3 = a2 + kstep; const char* b3 = b2 + kstep;
            PG8_LDB(B0, 0, 0); PG8_SCHED; PG8_LDA(At, 0, 0); PG8_STAGE(PG8_SA(1, 1), a1 + hstepA, voffA);
            PG8_WAIT_L(8); PG8_BAR; PG8_WAIT_L(0); PG8_MMA(0, 0, At, B0); PG8_BAR; PG8_SCHED;
            PG8_LDB(B1, 0, 1); PG8_STAGE(PG8_SB(0, 0), b2, voffB);
            PG8_BAR; PG8_WAIT_L(0); PG8_MMA(0, 1, At, B1); PG8_BAR;
            PG8_LDA(At, 0, 1); PG8_STAGE(PG8_SA(0, 0), a2, voffA);
            PG8_BAR; PG8_WAIT_L(0); PG8_MMA(1, 0, At, B0); PG8_BAR; PG8_SCHED;
            PG8_STAGE(PG8_SB(0, 1), b2 + hstepB, voffB);
            PG8_WAIT_V(6); PG8_BAR; PG8_MMA(1, 1, At, B1); PG8_BAR;
            PG8_LDB(B0, 1, 0); PG8_SCHED; PG8_LDA(At, 1, 0); PG8_STAGE(PG8_SA(0, 1), a2 + hstepA, voffA);
            PG8_WAIT_L(8); PG8_BAR; PG8_WAIT_L(0); PG8_MMA(0, 0, At, B0); PG8_BAR; PG8_SCHED;
            PG8_LDB(B1, 1, 1); PG8_STAGE(PG8_SB(1, 0), b3, voffB);
            PG8_BAR; PG8_WAIT_L(0); PG8_MMA(0, 1, At, B1); PG8_BAR;
            PG8_LDA(At, 1, 1); PG8_STAGE(PG8_SA(1, 0), a3, voffA);
            PG8_BAR; PG8_WAIT_L(0); PG8_MMA(1, 0, At, B0); PG8_BAR; PG8_SCHED;
            PG8_STAGE(PG8_SB(1, 1), b3 + hstepB, voffB);
            PG8_WAIT_V(6); PG8_BAR; PG8_MMA(1, 1, At, B1); PG8_BAR;
        }
        E(acc, cur, wr, wc, fr, fq);
        if (!has_next) break;
#pragma unroll
        for (int a = 0; a < 2; ++a)
#pragma unroll
            for (int b = 0; b < 2; ++b)
#pragma unroll
                for (int m = 0; m < 4; ++m)
#pragma unroll
                    for (int n = 0; n < 2; ++n) acc[a][b][m][n] = (f32x4){0.f, 0.f, 0.f, 0.f};
        cur = nxt; cA = nA; cB = nB; ++ui;
    }
    PG8_WAIT_V(0);
    if (wr == 0) PG8_BAR;
    PG8_BAR;
#undef PG8_SA
#undef PG8_SB
#undef PG8_STAGE
#undef PG8_LDA
#undef PG8_LDB
#undef PG8_MMA
#undef PG8_WAIT_V
#undef PG8_WAIT_L
#undef PG8_BAR
#undef PG8_SCHED
#endif
}
}

enum { GK_STORE = 0, GK_GATE0, GK_GATE1, GK_GATE2, GK_PROJ0, GK_PROJ1, GK_PROJ2, GK_RESID };
enum { GP_INPROJ = 0, GP_MERGE, GP_WOUT, GP_QUERY };
struct GemmProg {
    const char* act; const char* wt;
    int which, G, c;
    __device__ __forceinline__ bool next(int i, pg8::Unit& u) const {
        constexpr int nM = M_ / 256;
        constexpr size_t rowA = (size_t)256 * LDZ * 2, rowB = (size_t)256 * 1024 * 2;
        if (which == GP_MERGE) {
            const int L = (i / 6) * G + c, j = i % 6, br = j < 3 ? j : j - 3;
            if (L >= nM * 4) return false;
            pg8::tile_of(L, nM, 4, u.pm, u.pn);
            if (j < 3) { u.A = act + (size_t)C_XN * 2; u.B = wt + ((size_t)(WT_MG + br * 1024) * 1024) * 2; u.kind = GK_GATE0 + br; }
            else { u.A = act + (size_t)(br == 0 ? C_YA : (br == 1 ? C_YB : C_YC)) * 2; u.B = wt + ((size_t)(WT_P + br * 1024) * 1024) * 2; u.kind = GK_PROJ0 + br; }
        } else {
            const int nN = which == GP_INPROJ ? ZN / 256 : (which == GP_WOUT ? 4 : 8);
            const int L = i * G + c;
            if (L >= nM * nN) return false;
            pg8::tile_of(L, nM, nN, u.pm, u.pn);
            u.A = act + (size_t)(which == GP_WOUT ? C_MG : C_XN) * 2;
            u.B = wt + ((size_t)(which == GP_INPROJ ? WT_IN : (which == GP_WOUT ? WT_OUT : WT_Q)) * 1024) * 2;
            u.kind = which == GP_WOUT ? GK_RESID : GK_STORE;
        }
        u.A += (size_t)u.pm * rowA; u.B += (size_t)u.pn * rowB;
        return true;
    }
};
__device__ __forceinline__ int gs_slot(int br) { return br == 0 ? C_GS : (br == 1 ? Z_V : Z_ULRU); }
struct GemmEpi {
    h16_t* act; const float* mb; const float* resid; float* out;
    __device__ __forceinline__ void operator()(const pg8::f32x4 (&acc)[2][2][4][2], const pg8::Unit& u, int wr, int wc, int fr, int fq) const {
        const int row0 = u.pm * 256 + wr * 64 + fr, col0 = u.pn * 256 + wc * 32 + 8 * fq;
#pragma unroll
        for (int ai = 0; ai < 2; ++ai)
#pragma unroll
            for (int m = 0; m < 4; ++m) {
                const int row = row0 + ai * 128 + m * 16;
#pragma unroll
                for (int bj = 0; bj < 2; ++bj) {
                    const int col = col0 + bj * 128;
                    float v[8];
#pragma unroll
                    for (int e = 0; e < 4; ++e) { v[e] = acc[ai][bj][m][0][e]; v[4 + e] = acc[ai][bj][m][1][e]; }
                    h16_t* arow = act + (size_t)row * LDZ;
                    if (u.kind == GK_STORE) {
                        store8h(arow + col, v);
                    } else if (u.kind <= GK_GATE2) {
                        const float* bp = mb + (u.kind - GK_GATE0) * 1024 + col;
                        const float4 b0 = *(const float4*)bp, b1 = *(const float4*)(bp + 4);
                        v[0] = sigmoidf_(v[0] + b0.x); v[1] = sigmoidf_(v[1] + b0.y); v[2] = sigmoidf_(v[2] + b0.z); v[3] = sigmoidf_(v[3] + b0.w);
                        v[4] = sigmoidf_(v[4] + b1.x); v[5] = sigmoidf_(v[5] + b1.y); v[6] = sigmoidf_(v[6] + b1.z); v[7] = sigmoidf_(v[7] + b1.w);
                        store8h(arow + gs_slot(u.kind - GK_GATE0) + col, v);
                    } else if (u.kind <= GK_PROJ2) {
                        float g[8]; load8h(arow + gs_slot(u.kind - GK_PROJ0) + col, g);
                        if (u.kind == GK_PROJ0) {
#pragma unroll
                            for (int e = 0; e < 8; ++e) v[e] = g[e] * v[e];
                        } else {
                            float o[8]; load8h(arow + C_MG + col, o);
#pragma unroll
                            for (int e = 0; e < 8; ++e) v[e] = o[e] + g[e] * v[e];
                        }
                        store8h(arow + C_MG + col, v);
                    } else {
                        const size_t o = (size_t)row * 1024 + col;
                        const float4 r0 = *(const float4*)(resid + o), r1 = *(const float4*)(resid + o + 4);
                        *(float4*)(out + o) = make_float4(r0.x + v[0], r0.y + v[1], r0.z + v[2], r0.w + v[3]);
                        *(float4*)(out + o + 4) = make_float4(r1.x + v[4], r1.y + v[5], r1.z + v[6], r1.w + v[7]);
                    }
                }
            }
    }
};
__device__ __forceinline__ void stage_gemm(KParams p, int l, int which, char* smem) {
    GemmProg S; S.act = p->ws + OFF_ACT; S.wt = p->ws + OFF_WT + (size_t)l * WT_ROWS * 1024 * 2; S.which = which; S.G = gridDim.x; S.c = bid_();
    GemmEpi E; E.act = (h16_t*)(p->ws + OFF_ACT); E.mb = p->in[I_MB] + l * 3072; E.resid = l == 0 ? p->in[I_X] : p->out; E.out = p->out;
    pg8::gemm_phase(smem, S, E);
}

#ifdef CPU_EMU
__device__ __forceinline__ float group_sum(float v, int width, float* scratch) {
    const int tid = tid_();
    scratch[tid] = v;
    __syncthreads();
    float s = 0.f; const int base = tid & ~(width - 1);
    for (int i = 0; i < width; ++i) s += scratch[base + i];
    __syncthreads();
    return s;
}
#else
template <int CTRL> __device__ __forceinline__ float dpp_f(float v) { return __builtin_bit_cast(float, __builtin_amdgcn_update_dpp(0, __builtin_bit_cast(int, v), CTRL, 0xf, 0xf, false)); }
__device__ __forceinline__ float group_sum(float v, int width, float*) {
    v += dpp_f<0xB1>(v);
    v += dpp_f<0x4E>(v);
    if (width >= 8) v += dpp_f<0x141>(v);
    if (width >= 16) v += dpp_f<0x140>(v);
    if (width >= 64) {
        v += __builtin_bit_cast(float, __builtin_amdgcn_update_dpp(0, __builtin_bit_cast(int, v), 0x142, 0xa, 0xf, false));
        v += __builtin_bit_cast(float, __builtin_amdgcn_update_dpp(0, __builtin_bit_cast(int, v), 0x143, 0xc, 0xf, false));
        v = __builtin_bit_cast(float, __builtin_amdgcn_readlane(__builtin_bit_cast(int, v), 63));
    } else if (width >= 32) v += __shfl_xor(v, 16);
    return v;
}
#endif
__device__ __forceinline__ uint4 ldg16(const h16_t* p) { return *(const uint4*)p; }
__device__ __forceinline__ uint4 zero16() { uint4 z; z.x = 0u; z.y = 0u; z.z = 0u; z.w = 0u; return z; }

__device__ __forceinline__ void stage_lru(KParams p, int l, char* smem, int vb0, int nvb) {
    const int vb = bid_() - vb0;
    if (vb < 0 || vb >= nvb) return;
    constexpr int CH = 64;
    float* wa_s = (float*)smem;
    float* wx_s = wa_s + 4096;
    float* xcT = wx_s + 4096;
    float* a_s = xcT + 64 * CH;
    float* b_s = a_s + CH * 64;
    h16_t* ru = (h16_t*)(b_s + CH * 64);
    h16_t* rg = ru + (CH + 3) * 64;
    h16_t* ACT = (h16_t*)(p->ws + OFF_ACT);
    const int tid = tid_(), c = tid & 63, tg = tid >> 6;
    for (int item = vb; item < B_ * 16; item += nvb) {
        const int b = item / 16, n = item % 16, ch = n * 64 + c;
        __syncthreads();
        for (int i = tid; i < 4096; i += NT) { wa_s[i] = p->in[I_LWA][((size_t)l * 16 + n) * 4096 + i]; wx_s[i] = p->in[I_LWX][((size_t)l * 16 + n) * 4096 + i]; }
        const float cw0 = p->in[I_LCW][((size_t)l * 4 + 0) * 1024 + ch], cw1 = p->in[I_LCW][((size_t)l * 4 + 1) * 1024 + ch];
        const float cw2 = p->in[I_LCW][((size_t)l * 4 + 2) * 1024 + ch], cw3 = p->in[I_LCW][((size_t)l * 4 + 3) * 1024 + ch];
        const float cb = p->in[I_LCB][l * 1024 + ch], ba = p->in[I_LBA][l * 1024 + ch], bx = p->in[I_LBX][l * 1024 + ch];
        const float sp = softplusf_(-p->in[I_LLAM][l * 1024 + ch]);
        float hst = 0.f;
        uint4 pf[3];
#define LRU_LOAD(t0_) do { _Pragma("unroll") for (int i = 0; i < 3; ++i) { const int j = tid + NT * i; pf[i] = zero16(); \
            if (j < 536) { const int t = (t0_) - 3 + (j >> 3); if (t >= 0) pf[i] = ldg16(ACT + ((size_t)b * T_ + t) * LDZ + Z_ULRU + n * 64 + (j & 7) * 8); } \
            else if (j < 1048) { const int jj = j - 536; pf[i] = ldg16(ACT + ((size_t)b * T_ + (t0_) + (jj >> 3)) * LDZ + Z_GLRU + n * 64 + (jj & 7) * 8); } } } while (0)
#define LRU_PUT() do { _Pragma("unroll") for (int i = 0; i < 3; ++i) { const int j = tid + NT * i; \
            if (j < 536) *(uint4*)(ru + (j >> 3) * 64 + (j & 7) * 8) = pf[i]; else if (j < 1048) *(uint4*)(rg + ((j - 536) >> 3) * 64 + ((j - 536) & 7) * 8) = pf[i]; } } while (0)
        LRU_LOAD(0);
        LRU_PUT();
        __syncthreads();
#pragma unroll 1
        for (int t0 = 0; t0 < T_; t0 += CH) {
            float xc[8];
            {
                float u[11];
#pragma unroll
                for (int s = 0; s < 11; ++s) u[s] = h2f(ru[(tg * 8 + s) * 64 + c]);
#pragma unroll
                for (int s = 0; s < 8; ++s) { xc[s] = cw0 * u[s] + cw1 * u[s + 1] + cw2 * u[s + 2] + cw3 * u[s + 3] + cb; xcT[c * CH + tg * 8 + s] = xc[s]; }
            }
            __syncthreads();
            if (t0 + CH < T_) LRU_LOAD(t0 + CH);
            {
                float dr[8], di[8];
#pragma unroll
                for (int s = 0; s < 8; ++s) { dr[s] = 0.f; di[s] = 0.f; }
#pragma unroll 4
                for (int i = 0; i < 64; ++i) {
                    const float wa = wa_s[i * 64 + c], wx = wx_s[i * 64 + c];
                    const float4 x0 = *(const float4*)(xcT + i * CH + tg * 8), x1 = *(const float4*)(xcT + i * CH + tg * 8 + 4);
                    dr[0] += x0.x * wa; dr[1] += x0.y * wa; dr[2] += x0.z * wa; dr[3] += x0.w * wa; dr[4] += x1.x * wa; dr[5] += x1.y * wa; dr[6] += x1.z * wa; dr[7] += x1.w * wa;
                    di[0] += x0.x * wx; di[1] += x0.y * wx; di[2] += x0.z * wx; di[3] += x0.w * wx; di[4] += x1.x * wx; di[5] += x1.y * wx; di[6] += x1.z * wx; di[7] += x1.w * wx;
                }
#pragma unroll
                for (int s = 0; s < 8; ++s) {
                    const float r = sigmoidf_(dr[s] + ba), ig = sigmoidf_(di[s] + bx);
                    const float log_a = -8.0f * r * sp;
                    a_s[(tg * 8 + s) * 64 + c] = fexp_(log_a);
                    b_s[(tg * 8 + s) * 64 + c] = sqrtf(fmaxf(1.0f - fexp_(2.0f * log_a), 0.0f)) * (ig * xc[s]);
                }
            }
            __syncthreads();
            if (tid < 64) {
#pragma unroll 8
                for (int t = 0; t < CH; ++t) { hst = a_s[t * 64 + c] * hst + b_s[t * 64 + c]; b_s[t * 64 + c] = hst; }
            }
            __syncthreads();
#pragma unroll
            for (int s = 0; s < 8; ++s) { h16_t* gp = rg + (tg * 8 + s) * 64 + c; *gp = f2h(b_s[(tg * 8 + s) * 64 + c] * geluf_(h2f(*gp))); }
            __syncthreads();
            *(uint4*)(ACT + ((size_t)b * T_ + t0 + (tid >> 3)) * LDZ + Z_GLRU + n * 64 + (tid & 7) * 8) = *(const uint4*)(rg + (tid >> 3) * 64 + (tid & 7) * 8);
            __syncthreads();
            if (t0 + CH < T_) LRU_PUT();
            __syncthreads();
        }
#undef LRU_LOAD
#undef LRU_PUT
    }
}

#ifdef CPU_EMU
struct hfrag { h16_t v[8]; };
struct facc { float d[4]; float& operator[](int i) { return d[i]; } const float& operator[](int i) const { return d[i]; } };
__device__ __forceinline__ facc facc_zero() { facc a; a.d[0] = a.d[1] = a.d[2] = a.d[3] = 0.f; return a; }
__device__ __forceinline__ hfrag frag_u4(uint4 w) { hfrag f; memcpy(&f, &w, 16); return f; }
__device__ __forceinline__ hfrag frag_2u2(uint2 lo, uint2 hi) { hfrag f; memcpy(&f.v[0], &lo, 8); memcpy(&f.v[4], &hi, 8); return f; }
__device__ __forceinline__ hfrag frag_mul(hfrag a, hfrag b) { hfrag f; for (int j = 0; j < 8; ++j) f.v[j] = f2h(h2f(a.v[j]) * h2f(b.v[j])); return f; }
__device__ __forceinline__ facc mfma16(hfrag a, hfrag b, facc c) {
    const int tid = tid_(), w = tid >> 6, l = tid & 63;
    unsigned short (*X)[64][16] = emu::ctx->xscr;
    for (int j = 0; j < 8; ++j) { X[w][l][j] = a.v[j]; X[w][l][8 + j] = b.v[j]; }
    __syncthreads();
    for (int reg = 0; reg < 4; ++reg) {
        const int row = 4 * (l >> 4) + reg, col = l & 15;
        float s = 0.f;
        for (int k = 0; k < 32; ++k) s += h2f(X[w][row + 16 * (k >> 3)][k & 7]) * h2f(X[w][col + 16 * (k >> 3)][8 + (k & 7)]);
        c.d[reg] += s;
    }
    __syncthreads();
    return c;
}
#else
typedef _Float16 hfrag __attribute__((ext_vector_type(8)));
typedef float facc __attribute__((ext_vector_type(4)));
__device__ __forceinline__ facc facc_zero() { return (facc){0.f, 0.f, 0.f, 0.f}; }
__device__ __forceinline__ hfrag frag_u4(uint4 w) { return __builtin_bit_cast(hfrag, w); }
__device__ __forceinline__ hfrag frag_2u2(uint2 lo, uint2 hi) { uint4 w; w.x = lo.x; w.y = lo.y; w.z = hi.x; w.w = hi.y; return __builtin_bit_cast(hfrag, w); }
__device__ __forceinline__ hfrag frag_mul(hfrag a, hfrag b) { return a * b; }
__device__ __forceinline__ facc mfma16(hfrag a, hfrag b, facc c) { return __builtin_amdgcn_mfma_f32_16x16x32_f16(a, b, c, 0, 0, 0); }
#endif
__device__ __forceinline__ hfrag frag_pack8(float a0, float a1, float a2, float a3, float a4, float a5, float a6, float a7) {
    uint4 w; w.x = pack2h(a0, a1); w.y = pack2h(a2, a3); w.z = pack2h(a4, a5); w.w = pack2h(a6, a7); return frag_u4(w);
}
__device__ __forceinline__ hfrag frag_acc2(const facc& t0, const facc& t1) { return frag_pack8(t0[0], t0[1], t0[2], t0[3], t1[0], t1[1], t1[2], t1[3]); }
__device__ __forceinline__ hfrag permfrag(const h16_t* rowp, int ks, int g) { return frag_2u2(*(const uint2*)(rowp + 32 * ks + 4 * g), *(const uint2*)(rowp + 32 * ks + 16 + 4 * g)); }

__device__ __forceinline__ void stage_gdn(KParams p, int l, char* smem, int vb0, int nvb) {
    const int vb = bid_() - vb0;
    if (vb < 0 || vb >= nvb) return;
    constexpr int CH = 64, QS = 136, TS = 72, AS = 68;
    h16_t* Qs = (h16_t*)smem;
    h16_t* Ks = Qs + 64 * QS;
    h16_t* Kt = Ks + 64 * QS;
    h16_t* Vt = Kt + 128 * TS;
    float* A32 = (float*)(Vt + 128 * TS);
    h16_t* ob = (h16_t*)A32;
    h16_t* Tu = (h16_t*)(A32 + 64 * AS);
    h16_t* Tw = Tu + 64 * TS;
    h16_t* QKm = Tw + 64 * TS;
    float* gc_s = (float*)(QKm + 64 * TS);
    float* be_s = gc_s + 64;
    float* e1_s = be_s + 64;
    float* part_s = e1_s + 64;
    float* scr = part_s + 512;
    float* cw_s = scr + 512;
    h16_t* ACT = (h16_t*)(p->ws + OFF_ACT);
    int tid = tid_(), lane = tid & 63, w = tid >> 6, g = lane >> 4, r16 = lane & 15;
    int sg = lane >> 4, pc = lane & 15, rb = w;
#define GDN_ROLES() do { tid = tid_(); lane = tid & 63; w = tid >> 6; g = lane >> 4; r16 = lane & 15; sg = g; pc = r16; rb = w; } while (0)
    for (int item = vb; item < B_ * 8; item += nvb) {
        const int b = item / 8, h = item % 8;
        const float a_exp = fexp_(p->in[I_GALOG][l * 8 + h]), dtb = p->in[I_GDT][l * 8 + h];
        facc S[8];
#pragma unroll
        for (int dt = 0; dt < 8; ++dt) S[dt] = facc_zero();
        __syncthreads();
        for (int i = tid; i < 64 * TS / 2; i += NT) ((unsigned*)QKm)[i] = 0u;
        for (int i = tid; i < 4 * 384; i += NT) { const int jj = i / 384, c3 = i % 384; cw_s[i] = p->in[I_GCW][((size_t)l * 4 + jj) * 3072 + (c3 >> 7) * 1024 + h * 128 + (c3 & 127)]; }
        uint4 pf[11];
#define GDN_LOAD(t0_) do { GDN_ROLES(); const h16_t* colp = ACT + ((size_t)b * T_ + (t0_) + 8 * rb - 3) * LDZ + (sg < 3 ? Z_Q + sg * 1024 : Z_ZG) + h * 128 + pc * 8; \
            _Pragma("unroll") for (int i = 0; i < 11; ++i) { const int t = (t0_) + 8 * rb - 3 + i; pf[i] = (t >= 0 && sg < 3) ? ldg16(colp + (size_t)i * LDZ) : zero16(); } } while (0)
        GDN_LOAD(0);
#pragma unroll 1
        for (int t0 = 0; t0 < T_; t0 += CH) {
            GDN_ROLES();
            if (tid < 64) {
                const size_t m = (size_t)b * T_ + t0 + tid;
                part_s[tid] = -a_exp * softplusf_(h2f(ACT[m * LDZ + Z_ALPHA + h]) + dtb);
                be_s[tid] = sigmoidf_(h2f(ACT[m * LDZ + Z_BETA + h]));
            }
            __syncthreads();
            if (tid < 64) { float s = 0.f; for (int i = 0; i <= tid; ++i) s += part_s[i]; gc_s[tid] = s; }
#pragma unroll
            for (int hf = 0; hf < 2; ++hf) {
                float ov[4][8];
#pragma unroll
                for (int i = 0; i < 4; ++i) {
#pragma unroll
                    for (int cc = 0; cc < 8; ++cc) ov[i][cc] = 0.f;
#pragma unroll
                    for (int jj = 0; jj < 4; ++jj) {
                        const uint4 wv = pf[hf * 4 + i + jj];
                        const float* cwp = cw_s + jj * 384 + (sg < 3 ? sg : 0) * 128 + pc * 8;
                        const float4 c0 = *(const float4*)cwp, c1 = *(const float4*)(cwp + 4);
                        ov[i][0] += c0.x * h2f((h16_t)(wv.x & 0xffffu)); ov[i][1] += c0.y * h2f((h16_t)(wv.x >> 16)); ov[i][2] += c0.z * h2f((h16_t)(wv.y & 0xffffu)); ov[i][3] += c0.w * h2f((h16_t)(wv.y >> 16));
                        ov[i][4] += c1.x * h2f((h16_t)(wv.z & 0xffffu)); ov[i][5] += c1.y * h2f((h16_t)(wv.z >> 16)); ov[i][6] += c1.z * h2f((h16_t)(wv.w & 0xffffu)); ov[i][7] += c1.w * h2f((h16_t)(wv.w >> 16));
                    }
                    float ss = 0.f;
#pragma unroll
                    for (int cc = 0; cc < 8; ++cc) { ov[i][cc] = siluf_(ov[i][cc]); ss += ov[i][cc] * ov[i][cc]; }
                    ss = group_sum(ss, 16, scr);
                    const float rn = sg == 0 ? rsqrtf(ss + RMS_EPS) * 0.08838834764831845f : (sg == 1 ? rsqrtf(ss + RMS_EPS) : 1.0f);
#pragma unroll
                    for (int cc = 0; cc < 8; ++cc) ov[i][cc] *= rn;
                    const int t = 8 * rb + hf * 4 + i;
                    if (sg == 0) store8h(Qs + t * QS + pc * 8, ov[i]);
                    else if (sg == 1) store8h(Ks + t * QS + pc * 8, ov[i]);
                }
                if (sg == 1 || sg == 2) {
                    h16_t* dstT = sg == 1 ? Kt : Vt;
#pragma unroll
                    for (int cc = 0; cc < 8; ++cc) { uint2 w2; w2.x = pack2h(ov[0][cc], ov[1][cc]); w2.y = pack2h(ov[2][cc], ov[3][cc]); *(uint2*)(dstT + (pc * 8 + cc) * TS + 8 * rb + hf * 4) = w2; }
                }
            }
            __syncthreads();
            GDN_ROLES();
            if (tid < 64) e1_s[tid] = fexp_(gc_s[63] - gc_s[tid]);
            for (int e = tid; e < 64 * 64; e += NT) { const int i = e >> 6, j = e & 63; if ((j >> 4) > (i >> 4)) A32[i * AS + (j & 7) * 8 + (j >> 3)] = 0.f; }
#pragma unroll 1
            for (int jr = 0; jr < 3; ++jr) {
                const int jb = w + 8 * jr; const bool valid = jb < 20;
                const int kind = (valid && jb >= 10) ? 1 : 0, tix = valid ? (jb % 10) : 0;
                const int ti = tix < 1 ? 0 : (tix < 3 ? 1 : (tix < 6 ? 2 : 3)), tj = tix - (ti * (ti + 1)) / 2;
                const h16_t* ap = (kind ? Qs : Ks) + (16 * ti + r16) * QS + 8 * g; const h16_t* bp = Ks + (16 * tj + r16) * QS + 8 * g;
                facc acc = facc_zero();
#pragma unroll
                for (int ks = 0; ks < 4; ++ks) acc = mfma16(frag_u4(*(const uint4*)(ap + 32 * ks)), frag_u4(*(const uint4*)(bp + 32 * ks)), acc);
                if (valid) {
                    const int j = 16 * tj + r16; const float gj = gc_s[j];
#pragma unroll
                    for (int reg = 0; reg < 4; ++reg) {
                        const int i = 16 * ti + 4 * g + reg;
                        const float dec = fexp_(fminf(gc_s[i] - gj, 0.f));
                        if (kind == 0) A32[i * AS + (j & 7) * 8 + (j >> 3)] = i > j ? be_s[i] * acc[reg] * dec : 0.f;
                        else QKm[i * TS + j] = f2h(i >= j ? acc[reg] * dec : 0.f);
                    }
                }
            }
            __syncthreads();
            GDN_ROLES();
            {
                const int t = tid >> 3, d0 = (tid & 7) * 16; const float eg = fexp_(gc_s[t]);
                float v8[8];
                load8h(Qs + t * QS + d0, v8);
#pragma unroll
                for (int e = 0; e < 8; ++e) v8[e] *= eg;
                store8h(Qs + t * QS + d0, v8);
                load8h(Qs + t * QS + d0 + 8, v8);
#pragma unroll
                for (int e = 0; e < 8; ++e) v8[e] *= eg;
                store8h(Qs + t * QS + d0 + 8, v8);
            }
            {
                const int c = tid >> 3, q = tid & 7;
                const float bc = be_s[c], bgc = bc * fexp_(gc_s[c]);
                float x[8];
#pragma unroll
                for (int i = 0; i < 8; ++i) x[i] = 0.f;
#pragma unroll
                for (int r = 0; r < 64; ++r) {
                    float sacc = 0.f;
                    if (r > 0) {
                        const float4 a0 = *(const float4*)(A32 + r * AS + q * 8);
                        sacc = a0.x * x[0];
                        if (r > 8) sacc += a0.y * x[1];
                        if (r > 16) sacc += a0.z * x[2];
                        if (r > 24) sacc += a0.w * x[3];
                        if (r > 32) {
                            const float4 a1 = *(const float4*)(A32 + r * AS + q * 8 + 4);
                            sacc += a1.x * x[4];
                            if (r > 40) sacc += a1.y * x[5];
                            if (r > 48) sacc += a1.z * x[6];
                            if (r > 56) sacc += a1.w * x[7];
                        }
                        sacc = group_sum(sacc, 8, scr);
                    }
                    const float xr = ((r == c) ? 1.f : 0.f) - sacc;
                    if (q == (r & 7)) { x[r >> 3] = xr; Tu[r * TS + c] = f2h(xr * bc); Tw[r * TS + c] = f2h(xr * bgc); }
                }
            }
            __syncthreads();
            GDN_ROLES();
            facc vn[4], aw[4];
#pragma unroll
            for (int tt = 0; tt < 4; ++tt) { vn[tt] = facc_zero(); aw[tt] = facc_zero(); }
#pragma unroll
            for (int tt = 0; tt < 4; ++tt)
#pragma unroll
                for (int ks = 0; ks <= (tt >> 1); ++ks) {
                    const hfrag au = frag_u4(*(const uint4*)(Tu + (16 * tt + r16) * TS + 32 * ks + 8 * g)), aww = frag_u4(*(const uint4*)(Tw + (16 * tt + r16) * TS + 32 * ks + 8 * g));
                    vn[tt] = mfma16(au, frag_u4(*(const uint4*)(Vt + (16 * w + r16) * TS + 32 * ks + 8 * g)), vn[tt]);
                    aw[tt] = mfma16(aww, frag_u4(*(const uint4*)(Kt + (16 * w + r16) * TS + 32 * ks + 8 * g)), aw[tt]);
                }
#pragma unroll
            for (int tt = 0; tt < 4; ++tt)
#pragma unroll
                for (int reg = 0; reg < 4; ++reg) Ks[(16 * tt + 4 * g + reg) * QS + 16 * w + r16] = f2h(-aw[tt][reg]);
            __syncthreads();
            GDN_ROLES();
            h16_t zraw[16];
#pragma unroll
            for (int tt = 0; tt < 4; ++tt)
#pragma unroll
                for (int reg = 0; reg < 4; ++reg) zraw[tt * 4 + reg] = ACT[((size_t)b * T_ + t0 + 16 * tt + 4 * g + reg) * LDZ + Z_ZG + h * 128 + 16 * w + r16];
            hfrag Sb[4];
#pragma unroll
            for (int ks = 0; ks < 4; ++ks) Sb[ks] = frag_acc2(S[2 * ks], S[2 * ks + 1]);
            facc oc[4];
#pragma unroll
            for (int tt = 0; tt < 4; ++tt) {
                oc[tt] = facc_zero();
                const h16_t* wrow = Ks + (16 * tt + r16) * QS; const h16_t* qrow = Qs + (16 * tt + r16) * QS;
#pragma unroll
                for (int ks = 0; ks < 4; ++ks) { vn[tt] = mfma16(permfrag(wrow, ks, g), Sb[ks], vn[tt]); oc[tt] = mfma16(permfrag(qrow, ks, g), Sb[ks], oc[tt]); }
            }
            hfrag VNb[2];
            VNb[0] = frag_acc2(vn[0], vn[1]); VNb[1] = frag_acc2(vn[2], vn[3]);
#pragma unroll
            for (int tt = 0; tt < 4; ++tt)
#pragma unroll
                for (int ks2 = 0; ks2 <= (tt >> 1); ++ks2) oc[tt] = mfma16(permfrag(QKm + (16 * tt + r16) * TS, ks2, g), VNb[ks2], oc[tt]);
            {
                const float egl = fexp_(gc_s[63]);
                hfrag e1f[2];
#pragma unroll
                for (int ks2 = 0; ks2 < 2; ++ks2) { const float* ep = e1_s + 32 * ks2 + 4 * g; e1f[ks2] = frag_pack8(ep[0], ep[1], ep[2], ep[3], ep[16], ep[17], ep[18], ep[19]); }
#pragma unroll
                for (int dt = 0; dt < 8; ++dt) {
#pragma unroll
                    for (int reg = 0; reg < 4; ++reg) S[dt][reg] *= egl;
#pragma unroll
                    for (int ks2 = 0; ks2 < 2; ++ks2) S[dt] = mfma16(frag_mul(permfrag(Kt + (16 * dt + r16) * TS, ks2, g), e1f[ks2]), VNb[ks2], S[dt]);
                }
            }
            if (t0 + CH < T_) GDN_LOAD(t0 + CH);
            GDN_ROLES();
#pragma unroll
            for (int tt = 0; tt < 4; ++tt)
#pragma unroll
                for (int reg = 0; reg < 4; ++reg) { const float ss = group_sum(oc[tt][reg] * oc[tt][reg], 16, scr); if (r16 == 0) part_s[w * 64 + 16 * tt + 4 * g + reg] = ss; }
            __syncthreads();
            const float nw = p->in[I_GNW][l * 128 + w * 16 + r16];
#pragma unroll
            for (int tt = 0; tt < 4; ++tt)
#pragma unroll
                for (int reg = 0; reg < 4; ++reg) {
                    const int t = 16 * tt + 4 * g + reg;
                    float ms = 0.f;
#pragma unroll
                    for (int ww = 0; ww < 8; ++ww) ms += part_s[ww * 64 + t];
                    ob[t * 128 + 16 * w + r16] = f2h(oc[tt][reg] * rsqrtf(ms * (1.0f / 128.0f) + RMS_EPS) * nw * siluf_(h2f(zraw[tt * 4 + reg])));
                }
            __syncthreads();
            GDN_ROLES();
#pragma unroll
            for (int i = 0; i < 2; ++i) { const int j = tid + NT * i; *(uint4*)(ACT + ((size_t)b * T_ + t0 + (j >> 4)) * LDZ + Z_ZG + h * 128 + (j & 15) * 8) = *(const uint4*)(ob + (j >> 4) * 128 + (j & 15) * 8); }
            __syncthreads();
        }
#undef GDN_LOAD
#undef GDN_ROLES
    }
}

#ifndef CPU_EMU
typedef _Float16 rw_f16x8 __attribute__((ext_vector_type(8)));
typedef float rw_f32x4 __attribute__((ext_vector_type(4)));
#endif
__device__ __forceinline__ void stage_rwkv(KParams p, int l, char* smem, int vb0, int nvb) {
    const int vb = bid_() - vb0;
    if (vb < 0 || vb >= nvb) return;
    constexpr int CH = 32, XS = 264;
    float* r_s = (float*)smem;
    float* k_s = r_s + CH * 64;
    float* v_s = k_s + CH * 64;
    float* w_s = v_s + CH * 64;
    float* kk_s = w_s + CH * 64;
    float* ka_s = kk_s + CH * 64;
    float* g_s = ka_s + CH * 64;
    float* o_s = g_s + CH * 64;
    float* bon_s = o_s + CH * 64;
    float* scr = bon_s + CH;
    h16_t* raw = (h16_t*)(scr + 512);
    h16_t* xs = raw + (CH + 1) * 448;
    h16_t* ACT = (h16_t*)(p->ws + OFF_ACT);
    const int tid = tid_(), c = tid & 63, tg = tid >> 6;
    const int ri = tid >> 3, q8 = tid & 7;
    for (int item = vb; item < B_ * 16; item += nvb) {
        const int b = item / 16, h = item % 16, ch = h * 64 + c;
        const float w0 = p->in[I_RW0][l * 1024 + ch], a0 = p->in[I_RA0][l * 1024 + ch], k_k = p->in[I_RKK][l * 1024 + ch], k_a = p->in[I_RKA][l * 1024 + ch];
        const float rk_c = p->in[I_RRK][(size_t)l * 1024 + ch];
        const float lnw = p->in[I_RLW][l * 1024 + ch], lnb = p->in[I_RLB][l * 1024 + ch];
        const float* mu = p->in[I_RMU] + (size_t)l * RWW;
        const float mu_r = mu[RW_R + ch], mu_k = mu[RW_K + ch], mu_v = mu[RW_V + ch];
        const float mu_wl = mu[RW_WL + c], mu_al = mu[RW_AL + c], mu_g0 = mu[RW_GL + c], mu_g1 = mu[RW_GL + 64 + c];
        const float* wup = p->in[I_RWUP] + (size_t)l * 64 * 1024 + h * 64; const float* aup = p->in[I_RAUP] + (size_t)l * 64 * 1024 + h * 64; const float* gup = p->in[I_RGUP] + (size_t)l * 128 * 1024 + h * 64;
#ifndef CPU_EMU
        const int wid = tid >> 6, lane = tid & 63, mt = wid >> 2, nt = wid & 3;
        rw_f16x8 bw[2], ba_[2], bg[4];
        {
            const int cn = nt * 16 + (lane & 15), kb = 8 * (lane >> 4);
#pragma unroll
            for (int ks = 0; ks < 2; ++ks)
#pragma unroll
                for (int j = 0; j < 8; ++j) { bw[ks][j] = (_Float16)wup[(size_t)(ks * 32 + kb + j) * 1024 + cn]; ba_[ks][j] = (_Float16)aup[(size_t)(ks * 32 + kb + j) * 1024 + cn]; }
#pragma unroll
            for (int ks = 0; ks < 4; ++ks)
#pragma unroll
                for (int j = 0; j < 8; ++j) bg[ks][j] = (_Float16)gup[(size_t)(ks * 32 + kb + j) * 1024 + cn];
        }
#endif
        float S[8];
#pragma unroll
        for (int e = 0; e < 8; ++e) S[e] = 0.f;
        uint4 pf[4];
#define RW_LOAD(t0_) do { _Pragma("unroll") for (int i = 0; i < 4; ++i) { const int j = tid + NT * i, row = j / 56, u = j % 56, t = (t0_) - 1 + row; pf[i] = zero16(); \
            if (j < (CH + 1) * 56 && t >= 0) pf[i] = ldg16(ACT + ((size_t)b * T_ + t) * LDZ + Z_RW + (u < 24 ? (u >> 3) * 1024 + h * 64 + (u & 7) * 8 : 3072 + (u - 24) * 8)); } } while (0)
#define RW_PUT() do { _Pragma("unroll") for (int i = 0; i < 4; ++i) { const int j = tid + NT * i; if (j < (CH + 1) * 56) *(uint4*)(raw + (j / 56) * 448 + (j % 56) * 8) = pf[i]; } } while (0)
        __syncthreads();
        RW_LOAD(0);
        RW_PUT();
        __syncthreads();
#pragma unroll 1
        for (int t0 = 0; t0 < T_; t0 += CH) {
#pragma unroll
            for (int s = 0; s < 4; ++s) {
                const int tl = tg * 4 + s;
                const h16_t* zc = raw + (tl + 1) * 448; const h16_t* zp = raw + tl * 448;
#define RW_SHIFT(col, muv) ({ const float zz = h2f(zc[col]); zz + (muv) * (h2f(zp[col]) - zz); })
                r_s[tl * 64 + c] = RW_SHIFT(c, mu_r);
                k_s[tl * 64 + c] = RW_SHIFT(64 + c, mu_k);
                v_s[tl * 64 + c] = RW_SHIFT(128 + c, mu_v);
                xs[tl * XS + c] = f2h(tanhf_(RW_SHIFT(192 + c, mu_wl)));
                xs[tl * XS + 64 + c] = f2h(RW_SHIFT(256 + c, mu_al));
                xs[tl * XS + 128 + c] = f2h(sigmoidf_(RW_SHIFT(320 + c, mu_g0)));
                xs[tl * XS + 192 + c] = f2h(sigmoidf_(RW_SHIFT(384 + c, mu_g1)));
#undef RW_SHIFT
            }
            __syncthreads();
            if (t0 + CH < T_) RW_LOAD(t0 + CH);
#ifdef CPU_EMU
#pragma unroll
            for (int s = 0; s < 4; ++s) {
                const int tl = tg * 4 + s;
                float dw = 0.f, da = 0.f, dg = 0.f;
                for (int i = 0; i < 64; ++i) { dw += h2f(xs[tl * XS + i]) * h2f(f2h(wup[(size_t)i * 1024 + c])); da += h2f(xs[tl * XS + 64 + i]) * h2f(f2h(aup[(size_t)i * 1024 + c])); }
                for (int i = 0; i < 128; ++i) dg += h2f(xs[tl * XS + 128 + i]) * h2f(f2h(gup[(size_t)i * 1024 + c]));
                w_s[tl * 64 + c] = dw; ka_s[tl * 64 + c] = da; g_s[tl * 64 + c] = dg;
            }
#else
            {
                const h16_t* ap = xs + (mt * 16 + (lane & 15)) * XS + 8 * (lane >> 4);
                rw_f32x4 dw = {0.f, 0.f, 0.f, 0.f}, da = {0.f, 0.f, 0.f, 0.f}, dg = {0.f, 0.f, 0.f, 0.f};
#pragma unroll
                for (int ks = 0; ks < 2; ++ks) {
                    dw = __builtin_amdgcn_mfma_f32_16x16x32_f16(*(const rw_f16x8*)(ap + ks * 32), bw[ks], dw, 0, 0, 0);
                    da = __builtin_amdgcn_mfma_f32_16x16x32_f16(*(const rw_f16x8*)(ap + 64 + ks * 32), ba_[ks], da, 0, 0, 0);
                }
#pragma unroll
                for (int ks = 0; ks < 4; ++ks) dg = __builtin_amdgcn_mfma_f32_16x16x32_f16(*(const rw_f16x8*)(ap + 128 + ks * 32), bg[ks], dg, 0, 0, 0);
#pragma unroll
                for (int rg = 0; rg < 4; ++rg) { const int o = (mt * 16 + 4 * (lane >> 4) + rg) * 64 + nt * 16 + (lane & 15); w_s[o] = dw[rg]; ka_s[o] = da[rg]; g_s[o] = dg[rg]; }
            }
#endif
            __syncthreads();
#pragma unroll
            for (int s = 0; s < 4; ++s) {
                const int tl = tg * 4 + s;
                const float w_log = -softplusf_(-(w0 + w_s[tl * 64 + c])) - 0.5f;
                const float decay = fexp_(-fexp_(w_log));
                const float a = sigmoidf_(a0 + ka_s[tl * 64 + c]);
                const float kx = k_s[tl * 64 + c], rx = r_s[tl * 64 + c];
                const float kkr = kx * k_k, k2 = kx * (1.0f + (a - 1.0f) * k_a);
                const float nsq = group_sum(kkr * kkr, 64, scr);
                const float bon = group_sum(rx * k2 * rk_c, 64, scr);
                const float kkn = kkr * rsqrtf(nsq + RMS_EPS);
                w_s[tl * 64 + c] = decay; k_s[tl * 64 + c] = k2; kk_s[tl * 64 + c] = kkn; ka_s[tl * 64 + c] = kkn * a;
                if (c == 0) bon_s[tl] = bon;
            }
            __syncthreads();
#pragma unroll 1
            for (int t = 0; t < CH; ++t) {
                const int o8 = t * 64 + q8 * 8;
                const float4 kk0 = *(const float4*)(kk_s + o8), kk1 = *(const float4*)(kk_s + o8 + 4);
                const float pk = (S[0] * kk0.x + S[1] * kk0.y) + (S[2] * kk0.z + S[3] * kk0.w) + ((S[4] * kk1.x + S[5] * kk1.y) + (S[6] * kk1.z + S[7] * kk1.w));
                const float skk = group_sum(pk, 8, scr);
                const float vi = v_s[t * 64 + ri];
                const float4 w0v = *(const float4*)(w_s + o8), w1v = *(const float4*)(w_s + o8 + 4);
                const float4 a0v = *(const float4*)(ka_s + o8), a1v = *(const float4*)(ka_s + o8 + 4);
                const float4 k0v = *(const float4*)(k_s + o8), k1v = *(const float4*)(k_s + o8 + 4);
                const float4 r0v = *(const float4*)(r_s + o8), r1v = *(const float4*)(r_s + o8 + 4);
                S[0] = S[0] * w0v.x - skk * a0v.x + vi * k0v.x; S[1] = S[1] * w0v.y - skk * a0v.y + vi * k0v.y; S[2] = S[2] * w0v.z - skk * a0v.z + vi * k0v.z; S[3] = S[3] * w0v.w - skk * a0v.w + vi * k0v.w;
                S[4] = S[4] * w1v.x - skk * a1v.x + vi * k1v.x; S[5] = S[5] * w1v.y - skk * a1v.y + vi * k1v.y; S[6] = S[6] * w1v.z - skk * a1v.z + vi * k1v.z; S[7] = S[7] * w1v.w - skk * a1v.w + vi * k1v.w;
                const float po = (S[0] * r0v.x + S[1] * r0v.y) + (S[2] * r0v.z + S[3] * r0v.w) + ((S[4] * r1v.x + S[5] * r1v.y) + (S[6] * r1v.z + S[7] * r1v.w));
                const float o = group_sum(po, 8, scr);
                if (q8 == 0) o_s[t * 64 + ri] = o;
            }
            __syncthreads();
#pragma unroll
            for (int s = 0; s < 4; ++s) {
                const int tl = tg * 4 + s;
                const float ov = o_s[tl * 64 + c];
                const float mean = group_sum(ov, 64, scr) * (1.0f / 64.0f);
                const float d = ov - mean;
                const float var = group_sum(d * d, 64, scr) * (1.0f / 64.0f);
                const float y = (d * rsqrtf(var + GN_EPS) * lnw + lnb + bon_s[tl] * v_s[tl * 64 + c]) * g_s[tl * 64 + c];
                ACT[((size_t)b * T_ + t0 + tl) * LDZ + C_YC + ch] = f2h(y);
            }
            __syncthreads();
            if (t0 + CH < T_) RW_PUT();
            __syncthreads();
        }
#undef RW_LOAD
#undef RW_PUT
    }
}

constexpr bool TAB_IN_ACT = (M_ == 16384);
constexpr float TAB_SU = 256.0f, TAB_SV = 32.0f;
__device__ __forceinline__ unsigned char* tab_row(char* ws, int e) {
    if (TAB_IN_ACT) return (unsigned char*)((h16_t*)(ws + OFF_ACT) + (size_t)e * LDZ + C_GS);
    return (unsigned char*)(ws + OFF_TAB) + (size_t)e * 2048;
}
#ifdef CPU_EMU
__device__ __forceinline__ unsigned f2fp8(float f) {
    const unsigned sgn = f < 0.f ? 0x80u : 0u; float a = fabsf(f);
    if (!(a == a)) return 0x7fu;
    if (a >= 448.0f) return sgn | 0x7eu;
    if (a < 0.0009765625f) return sgn;
    int e; frexpf(a, &e); e -= 1;
    if (e < -6) { const float q = nearbyintf(a * 512.0f); return sgn | (unsigned)q; }
    float q = nearbyintf((a / ldexpf(1.0f, e) - 1.0f) * 8.0f);
    if (q >= 8.0f) { q = 0.f; e += 1; }
    if (e > 8) return sgn | 0x7eu;
    const unsigned r = ((unsigned)(e + 7) << 3) | (unsigned)q;
    return sgn | (r > 0x7eu ? 0x7eu : r);
}
__device__ __forceinline__ float fp82f(unsigned b) {
    const unsigned e = (b >> 3) & 15u, m = b & 7u; const float s = (b & 0x80u) ? -1.f : 1.f;
    if (e == 0) return s * (float)m * 0.001953125f;
    return s * ldexpf(1.0f + (float)m * 0.125f, (int)e - 7);
}
__device__ __forceinline__ unsigned pack4fp8(float a, float b, float c, float d) { return f2fp8(a) | (f2fp8(b) << 8) | (f2fp8(c) << 16) | (f2fp8(d) << 24); }
__device__ __forceinline__ void dec4fp8(unsigned w, float* o) { o[0] = fp82f(w & 255u); o[1] = fp82f((w >> 8) & 255u); o[2] = fp82f((w >> 16) & 255u); o[3] = fp82f(w >> 24); }
#else
__device__ __forceinline__ unsigned pack4fp8(float a, float b, float c, float d) { int p = __builtin_amdgcn_cvt_pk_fp8_f32(a, b, 0, false); p = __builtin_amdgcn_cvt_pk_fp8_f32(c, d, p, true); return (unsigned)p; }
__device__ __forceinline__ void dec4fp8(unsigned w, float* o) { const auto lo = __builtin_amdgcn_cvt_pk_f32_fp8((int)w, false); const auto hi = __builtin_amdgcn_cvt_pk_f32_fp8((int)w, true); o[0] = lo[0]; o[1] = lo[1]; o[2] = hi[0]; o[3] = hi[1]; }
#endif
__device__ __forceinline__ void stage_tabconv(KParams p, int l) {
    const int tid = tid_();
    const float* U = p->in[I_PU] + (size_t)l * 16384 * 1024; const float* V = p->in[I_PV] + (size_t)l * 16384 * 1024;
    char* ws = p->ws;
    for (int it = bid_() * NT + tid; it < 16384 * 128; it += gridDim.x * NT) {
        const int r = it >> 7, ck = it & 127, which = ck >> 6, c16 = ck & 63;
        const float* src = (which ? V : U) + (size_t)r * 1024 + c16 * 16;
        const float sc = which ? TAB_SV : TAB_SU;
        const float4 a = *(const float4*)src, b = *(const float4*)(src + 4), c = *(const float4*)(src + 8), d = *(const float4*)(src + 12);
        uint4 w;
        w.x = pack4fp8(a.x * sc, a.y * sc, a.z * sc, a.w * sc); w.y = pack4fp8(b.x * sc, b.y * sc, b.z * sc, b.w * sc);
        w.z = pack4fp8(c.x * sc, c.y * sc, c.z * sc, c.w * sc); w.w = pack4fp8(d.x * sc, d.y * sc, d.z * sc, d.w * sc);
        *(uint4*)(tab_row(ws, r) + which * 1024 + c16 * 16) = w;
    }
}

#ifdef CPU_EMU
__device__ __forceinline__ float group_max16(float v, float* scr) {
    const int tid = tid_();
    scr[tid] = v;
    __syncthreads();
    float m = -3.0e38f; const int base = tid & ~15;
    for (int i = 0; i < 16; ++i) m = fmaxf(m, scr[base + i]);
    __syncthreads();
    return m;
}
#else
__device__ __forceinline__ float group_max16(float v, float*) {
    v = fmaxf(v, dpp_f<0xB1>(v)); v = fmaxf(v, dpp_f<0x4E>(v)); v = fmaxf(v, dpp_f<0x141>(v)); v = fmaxf(v, dpp_f<0x140>(v));
    return v;
}
#endif
__device__ __forceinline__ void stage_peer_topk(KParams p, int l, char* smem) {
    constexpr int KS = 136;
    h16_t* khi = (h16_t*)smem;
    h16_t* klo = khi + 128 * KS;
    float* scr = (float*)(klo + 128 * KS);
    const h16_t* ACT = (const h16_t*)(p->ws + OFF_ACT);
    float* TOPS = (float*)(p->ws + OFF_TOPS);
    int tid = tid_(), lane = tid & 63, w = tid >> 6, g = lane >> 4, r16 = lane & 15;
#define TK_ROLES() do { tid = tid_(); lane = tid & 63; w = tid >> 6; g = lane >> 4; r16 = lane & 15; } while (0)
    const int nb = gridDim.x;
    for (int hs = bid_() % 16; hs < 16; hs += nb) {
        const int hd = hs >> 1, s = hs & 1;
        __syncthreads();
        {
            const float* kp = p->in[I_PKEYS] + (((size_t)l * 8 + hd) * 2 + s) * 128 * 128;
            for (int i = tid * 4; i < 128 * 128; i += NT * 4) {
                const float4 kv = *(const float4*)(kp + i);
                const int n = i >> 7, c0 = i & 127;
                const float h0 = h2f(f2h(kv.x)), h1 = h2f(f2h(kv.y)), h2 = h2f(f2h(kv.z)), h3 = h2f(f2h(kv.w));
                uint2 hw, lw; hw.x = pack2h(kv.x, kv.y); hw.y = pack2h(kv.z, kv.w); lw.x = pack2h(kv.x - h0, kv.y - h1); lw.y = pack2h(kv.z - h2, kv.w - h3);
                *(uint2*)(khi + n * KS + c0) = hw; *(uint2*)(klo + n * KS + c0) = lw;
            }
        }
        __syncthreads();
        const int nblk = nb >= 16 ? nb / 16 : 1, bsub = nb >= 16 ? bid_() / 16 : 0;
        for (int chunk = bsub; chunk < (M_ + NT - 1) / NT; chunk += nblk) {
            if (nb >= 16 && bid_() >= nblk * 16) break;
#pragma unroll 1
            for (int tt = 0; tt < 4; ++tt) {
                TK_ROLES();
                const int tok0 = chunk * NT + w * 64 + tt * 16;
                const bool live = tok0 < M_;
                hfrag af[4];
                {
                    const h16_t* qp = ACT + (size_t)(live ? tok0 + r16 : 0) * LDZ + C_QRY + hd * 256 + s * 128 + 8 * g;
#pragma unroll
                    for (int ks = 0; ks < 4; ++ks) af[ks] = frag_u4(*(const uint4*)(qp + 32 * ks));
                }
                facc acc[8];
#pragma unroll
                for (int nt = 0; nt < 8; ++nt) {
                    acc[nt] = facc_zero();
                    const h16_t* bh = khi + (16 * nt + r16) * KS + 8 * g; const h16_t* bl = klo + (16 * nt + r16) * KS + 8 * g;
#pragma unroll
                    for (int ks = 0; ks < 4; ++ks) { acc[nt] = mfma16(af[ks], frag_u4(*(const uint4*)(bh + 32 * ks)), acc[nt]); acc[nt] = mfma16(af[ks], frag_u4(*(const uint4*)(bl + 32 * ks)), acc[nt]); }
                }
#pragma unroll 1
                for (int rp = 0; rp < 2; ++rp) {
                  TK_ROLES();
#pragma unroll
                  for (int r2 = 0; r2 < 2; ++r2) {
                    const int reg = rp * 2 + r2;
                    float v[8];
#pragma unroll
                    for (int nt = 0; nt < 8; ++nt) { const float av = rp == 0 ? (r2 == 0 ? acc[nt][0] : acc[nt][1]) : (r2 == 0 ? acc[nt][2] : acc[nt][3]); v[nt] = __uint_as_float((__float_as_uint(av) & ~127u) | (unsigned)(127 - (16 * nt + r16))); }
#define CE(i, j) { const float hi_ = fmaxf(v[i], v[j]), lo_ = fminf(v[i], v[j]); v[i] = hi_; v[j] = lo_; }
                    CE(0, 1) CE(2, 3) CE(4, 5) CE(6, 7) CE(0, 2) CE(1, 3) CE(4, 6) CE(5, 7) CE(1, 2) CE(5, 6) CE(0, 4) CE(1, 5) CE(2, 6) CE(3, 7) CE(2, 4) CE(3, 5) CE(1, 2) CE(3, 4) CE(5, 6)
#undef CE
                    float res = 0.f;
#pragma unroll
                    for (int rnd = 0; rnd < 16; ++rnd) {
                        const float m = group_max16(v[0], scr);
                        const bool win = v[0] == m;
#pragma unroll
                        for (int i = 0; i < 7; ++i) v[i] = win ? v[i + 1] : v[i];
                        v[7] = win ? -3.0e38f : v[7];
                        res = (r16 == rnd) ? m : res;
                    }
                    if (live) TOPS[(((size_t)(tok0 + 4 * g + reg) * 8 + hd) * 2 + s) * 16 + r16] = res;
                  }
                }
            }
        }
    }
}

#undef TK_ROLES
__device__ __forceinline__ void peer_cand(int k, int& i, int& j) {
    if (k < 16) { i = 0; j = k; } else if (k < 24) { i = 1; j = k - 16; } else if (k < 29) { i = 2; j = k - 24; } else if (k < 33) { i = 3; j = k - 29; }
    else if (k < 36) { i = 4; j = k - 33; } else if (k < 38) { i = 5; j = k - 36; } else if (k < 40) { i = 6; j = k - 38; } else if (k < 42) { i = 7; j = k - 40; }
    else { i = k - 34; j = 0; }
}
__device__ __forceinline__ float dot16q(const uint4 a, const float (&x)[16]) {
    float t[4], s0, s1;
    dec4fp8(a.x, t); s0 = t[0] * x[0] + t[1] * x[1]; s1 = t[2] * x[2] + t[3] * x[3];
    dec4fp8(a.y, t); s0 += t[0] * x[4] + t[1] * x[5]; s1 += t[2] * x[6] + t[3] * x[7];
    dec4fp8(a.z, t); s0 += t[0] * x[8] + t[1] * x[9]; s1 += t[2] * x[10] + t[3] * x[11];
    dec4fp8(a.w, t); s0 += t[0] * x[12] + t[1] * x[13]; s1 += t[2] * x[14] + t[3] * x[15];
    return s0 + s1;
}
__device__ __forceinline__ void axpy16q(const uint4 a, float s, float (&y)[16]) {
    float t[4];
    dec4fp8(a.x, t); y[0] += s * t[0]; y[1] += s * t[1]; y[2] += s * t[2]; y[3] += s * t[3];
    dec4fp8(a.y, t); y[4] += s * t[0]; y[5] += s * t[1]; y[6] += s * t[2]; y[7] += s * t[3];
    dec4fp8(a.z, t); y[8] += s * t[0]; y[9] += s * t[1]; y[10] += s * t[2]; y[11] += s * t[3];
    dec4fp8(a.w, t); y[12] += s * t[0]; y[13] += s * t[1]; y[14] += s * t[2]; y[15] += s * t[3];
}
#ifdef CPU_EMU
__device__ __forceinline__ float lane_xor(float v, int mask, float* scr) { const int tid = tid_(); scr[tid] = v; __syncthreads(); const float r = scr[tid ^ mask]; __syncthreads(); return r; }
__device__ __forceinline__ float lane_bcast(float v, int src, float* scr) { const int tid = tid_(); scr[tid] = v; __syncthreads(); const float r = scr[(tid & ~63) + src]; __syncthreads(); return r; }
#else
__device__ __forceinline__ float lane_xor(float v, int mask, float*) { return mask == 1 ? dpp_f<0xB1>(v) : (mask == 2 ? dpp_f<0x4E>(v) : __shfl_xor(v, mask)); }
__device__ __forceinline__ float lane_bcast(float v, int src, float*) { return __builtin_bit_cast(float, __builtin_amdgcn_readlane(__builtin_bit_cast(int, v), src)); }
#endif
__device__ __forceinline__ float reduce8(const float (&v)[8], int lane, float* scr) {
    const bool b0 = lane & 1, b1 = lane & 2, b2 = lane & 4;
    float w4[4], u2[2];
#pragma unroll
    for (int j = 0; j < 4; ++j) { const float keep = b0 ? v[2 * j + 1] : v[2 * j], send = b0 ? v[2 * j] : v[2 * j + 1]; w4[j] = keep + lane_xor(send, 1, scr); }
#pragma unroll
    for (int j = 0; j < 2; ++j) { const float keep = b1 ? w4[2 * j + 1] : w4[2 * j], send = b1 ? w4[2 * j] : w4[2 * j + 1]; u2[j] = keep + lane_xor(send, 2, scr); }
    float z = (b2 ? u2[1] : u2[0]) + lane_xor(b2 ? u2[0] : u2[1], 4, scr);
    z += lane_xor(z, 8, scr); z += lane_xor(z, 16, scr); z += lane_xor(z, 32, scr);
    return z;
}
__device__ __forceinline__ void stage_peer_gather(KParams p, int l, char* smem) {
    int tid = tid_(), w = tid >> 6, lane = tid & 63;
    float* base; float* tops_s; float* cand_s; float* best_s; int* idx_s; float* gate_s; int* pos_s;
#define PG_ROLES() do { tid = tid_(); w = tid >> 6; lane = tid & 63; base = (float*)smem + w * 2048; tops_s = base; cand_s = tops_s + 256; best_s = cand_s + 64; \
        idx_s = (int*)(best_s + 128); gate_s = (float*)(idx_s + 128); pos_s = (int*)(gate_s + 128); } while (0)
    PG_ROLES();
    float* scr = (float*)smem + 8 * 2048;
    h16_t* ACT = (h16_t*)(p->ws + OFF_ACT);
    const float* TOPS = (const float*)(p->ws + OFF_TOPS);
    char* ws = p->ws;
    const float* nxt_w = (l + 1 < NL_) ? p->in[I_NMIX] + (l + 1) * 1024 : p->in[I_NFINAL];
    const int nwaves = gridDim.x * 8;
    for (int m = bid_() * 8 + w; m < M_; m += nwaves) {
        PG_ROLES();
        __syncthreads();
        *(float4*)(tops_s + lane * 4) = *(const float4*)(TOPS + (size_t)m * 256 + lane * 4);
        float x[16];
        { float t8[8]; load8h(ACT + (size_t)m * LDZ + C_XN + lane * 16, t8);
#pragma unroll
          for (int j = 0; j < 8; ++j) x[j] = t8[j];
          load8h(ACT + (size_t)m * LDZ + C_XN + lane * 16 + 8, t8);
#pragma unroll
          for (int j = 0; j < 8; ++j) x[8 + j] = t8[j]; }
        __syncthreads();
        int ci = 0, cj = 0;
        if (lane < 50) peer_cand(lane, ci, cj);
        const int pos = ci * 16 + cj;
        pos_s[lane] = pos;
#pragma unroll 1
        for (int hd = 0; hd < 8; ++hd) {
            const float cs = lane < 50 ? tops_s[hd * 32 + ci] + tops_s[hd * 32 + 16 + cj] : -3.0e38f;
            cand_s[lane] = cs;
            __syncthreads();
            if (lane < 50) {
                int cnt = 0;
#pragma unroll 10
                for (int o = 0; o < 50; ++o) { const float ov = cand_s[o]; cnt += (ov > cs || (ov == cs && pos_s[o] < pos)) ? 1 : 0; }
                if (cnt < 16) {
                    best_s[hd * 16 + cnt] = cs;
                    const int n0 = 127 - (int)(__float_as_uint(tops_s[hd * 32 + ci]) & 127u), n1 = 127 - (int)(__float_as_uint(tops_s[hd * 32 + 16 + cj]) & 127u);
                    idx_s[hd * 16 + cnt] = n0 * 128 + n1;
                }
            }
            __syncthreads();
        }
#pragma unroll
        for (int rr = 0; rr < 2; ++rr) {
            const int e = lane + 64 * rr, hd = e >> 4;
            const float mx = best_s[hd * 16];
            float sum = 0.f;
#pragma unroll
            for (int i = 0; i < 16; ++i) sum += fexp_(best_s[hd * 16 + i] - mx);
            gate_s[e] = fexp_(best_s[e] - mx) / sum;
        }
        __syncthreads();
        float y[16];
#pragma unroll
        for (int i = 0; i < 16; ++i) y[i] = 0.f;
        PG_ROLES();
        uint4 uu[8], vv[8];
#define PG_LOADU(eb_) do { _Pragma("unroll") for (int k = 0; k < 8; ++k) uu[k] = *(const uint4*)(tab_row(ws, idx_s[(eb_) + k]) + lane * 16); } while (0)
#define PG_LOADV(eb_) do { _Pragma("unroll") for (int k = 0; k < 8; ++k) vv[k] = *(const uint4*)(tab_row(ws, idx_s[(eb_) + k]) + 1024 + lane * 16); } while (0)
        PG_LOADU(0); PG_LOADV(0);
#pragma unroll 1
        for (int eb = 0; eb < 128; eb += 8) {
            float d8[8];
#pragma unroll
            for (int k = 0; k < 8; ++k) d8[k] = dot16q(uu[k], x);
            if (eb + 8 < 128) PG_LOADU(eb + 8);
            const float tot = reduce8(d8, lane, scr);
            const float hk = gate_s[eb + (lane & 7)] * geluf_(tot * (1.0f / TAB_SU));
#pragma unroll
            for (int k = 0; k < 8; ++k) axpy16q(vv[k], lane_bcast(hk, k, scr), y);
            if (eb + 8 < 128) PG_LOADV(eb + 8);
        }
#undef PG_LOADU
#undef PG_LOADV
        PG_ROLES();
        float* op = p->out + (size_t)m * 1024 + lane * 16;
        float hn[16]; float ss = 0.f;
#pragma unroll
        for (int i = 0; i < 16; i += 4) {
            const float4 o4 = *(const float4*)(op + i);
            hn[i] = o4.x + y[i] * (1.0f / TAB_SV); hn[i + 1] = o4.y + y[i + 1] * (1.0f / TAB_SV); hn[i + 2] = o4.z + y[i + 2] * (1.0f / TAB_SV); hn[i + 3] = o4.w + y[i + 3] * (1.0f / TAB_SV);
            ss += hn[i] * hn[i] + hn[i + 1] * hn[i + 1] + hn[i + 2] * hn[i + 2] + hn[i + 3] * hn[i + 3];
        }
        ss = group_sum(ss, 64, scr);
        const float rstd = rsqrtf(ss * (1.0f / D_) + RMS_EPS);
        float nv[16];
#pragma unroll
        for (int i = 0; i < 16; i += 4) { const float4 w4 = *(const float4*)(nxt_w + lane * 16 + i); nv[i] = hn[i] * rstd * w4.x; nv[i + 1] = hn[i + 1] * rstd * w4.y; nv[i + 2] = hn[i + 2] * rstd * w4.z; nv[i + 3] = hn[i + 3] * rstd * w4.w; }
        if (l + 1 < NL_) {
#pragma unroll
            for (int i = 0; i < 16; i += 4) *(float4*)(op + i) = make_float4(hn[i], hn[i + 1], hn[i + 2], hn[i + 3]);
            const float n0[8] = {nv[0], nv[1], nv[2], nv[3], nv[4], nv[5], nv[6], nv[7]}, n1[8] = {nv[8], nv[9], nv[10], nv[11], nv[12], nv[13], nv[14], nv[15]};
            store8h(ACT + (size_t)m * LDZ + C_XN + lane * 16, n0); store8h(ACT + (size_t)m * LDZ + C_XN + lane * 16 + 8, n1);
        } else {
#pragma unroll
            for (int i = 0; i < 16; i += 4) *(float4*)(op + i) = make_float4(nv[i], nv[i + 1], nv[i + 2], nv[i + 3]);
        }
    }
}
#undef PG_ROLES

enum { PH_NORM_MIX = 0, PH_INPROJ, PH_MIXERS, PH_MERGE, PH_WOUT, PH_NORM_FFN, PH_QUERY, PH_TOPK, PH_GATHER, PH_PER_LAYER, PH_FINAL = 100, PH_WPREP = 101 };
__device__ __forceinline__ void run_phase(KParams p, int l, int ph, char* smem) {
    h16_t* ACT = (h16_t*)(p->ws + OFF_ACT);
    const float* hin = l == 0 ? p->in[I_X] : p->out;
    switch (ph) {
    case PH_WPREP: stage_wprep(p, smem); break;
    case PH_NORM_MIX: if (l == 0) stage_rmsnorm<false>(hin, p->in[I_NMIX] + l * 1024, ACT + C_XN, LDZ, smem); break;
    case PH_INPROJ: stage_gemm(p, l, GP_INPROJ, smem); break;
    case PH_MIXERS: {
        const int nb = gridDim.x, n_rw = nb / 2, n_gd = nb / 4, n_lr = nb - n_rw - n_gd;
        stage_rwkv(p, l, smem, 0, n_rw);
        stage_gdn(p, l, smem, n_rw, n_gd);
        stage_lru(p, l, smem, n_rw + n_gd, n_lr);
    } break;
    case PH_MERGE: stage_gemm(p, l, GP_MERGE, smem); break;
    case PH_WOUT: stage_gemm(p, l, GP_WOUT, smem); break;
    case PH_NORM_FFN: stage_rmsnorm<false>(p->out, p->in[I_NFFN] + l * 1024, ACT + C_XN, LDZ, smem); stage_tabconv(p, l); break;
    case PH_QUERY: stage_gemm(p, l, GP_QUERY, smem); break;
    case PH_TOPK: stage_peer_topk(p, l, smem); break;
    case PH_GATHER: stage_peer_gather(p, l, smem); break;
    case PH_FINAL: break;
    default: break;
    }
}


#if !defined(CPU_EMU) && !MK_MULTI
#define XB_TMO      128
#define XB_XCNT(j)  (256  + 64 * (j))
#define XB_XSUB(j)  (1280 + 64 * (j))
#define XB_XGEN(j)  (2304 + 64 * (j))
#define XB_TOP      3328
#define XB_TOPGEN   3392
#define XCD_BAR_WORDS 3456
#define XB_SPIN_CAP (1u << 22)
#define XB_LAS __attribute__((address_space(3)))
__device__ __forceinline__ unsigned xb_ld(unsigned* p)              { return __hip_atomic_load(p, __ATOMIC_RELAXED, __HIP_MEMORY_SCOPE_AGENT); }
__device__ __forceinline__ unsigned xb_add(unsigned* p, unsigned v) { return __hip_atomic_fetch_add(p, v, __ATOMIC_RELAXED, __HIP_MEMORY_SCOPE_AGENT); }
__device__ __forceinline__ unsigned xb_xcc_id() { return (unsigned)__builtin_amdgcn_s_getreg((3 << 11) | 20) & 0xFu; }
#define XB_SPIN(cond, bar) do { unsigned _sp = 0; while (cond) { __builtin_amdgcn_s_sleep(1); \
    if ((++_sp & 255u) == 0u) { if (xb_ld(&(bar)[XB_TMO])) break; if (_sp > XB_SPIN_CAP) { atomicAdd(&(bar)[XB_TMO], 1u); break; } } } } while (0)
struct XcdBarrier { unsigned* bar; unsigned x; volatile XB_LAS unsigned* st; };
__device__ __forceinline__ XcdBarrier xcd_barrier_post(unsigned* bar, volatile XB_LAS unsigned* st) {
    XcdBarrier b; b.bar = bar; b.x = xb_xcc_id(); b.st = st;
    if (threadIdx.x == 0) (void)xb_add(&bar[XB_XCNT(b.x)], 1u);
    return b;
}
__device__ __forceinline__ void xcd_barrier_complete(unsigned* bar, unsigned x, unsigned& nloc, unsigned& nx) {
    const unsigned G = gridDim.x * gridDim.y * gridDim.z;
    unsigned sum, cnt, mine, sp = 0u;
    for (;;) {
        sum = 0u; cnt = 0u; mine = 0u;
#pragma unroll
        for (unsigned j = 0; j < 16; ++j) { const unsigned c = xb_ld(&bar[XB_XCNT(j)]); sum += c; cnt += (c > 0u) ? 1u : 0u; mine = (j == x) ? c : mine; }
        if (sum == G) break;
        __builtin_amdgcn_s_sleep(1);
        if ((++sp & 255u) == 0u) { if (xb_ld(&bar[XB_TMO])) break; if (sp > XB_SPIN_CAP) { atomicAdd(&bar[XB_TMO], 1u); break; } }
    }
    nloc = mine > 0u ? mine : 1u; nx = cnt > 0u ? cnt : 1u;
}
__device__ __forceinline__ void xcd_barrier(const XcdBarrier& b) {
    asm volatile("s_waitcnt vmcnt(0)" ::: "memory");
    __syncthreads();
    if (threadIdx.x == 0) {
        unsigned* bar = b.bar;
        __builtin_amdgcn_s_waitcnt(0);
        unsigned nloc = b.st[0], nx = b.st[1];
        if (nloc == 0u) { xcd_barrier_complete(bar, b.x, nloc, nx); b.st[0] = nloc; b.st[1] = nx; }
        const unsigned old = xb_add(&bar[XB_XSUB(b.x)], 1u);
        const unsigned gen = old / nloc;
        if (old + 1u == (gen + 1u) * nloc) {
            __builtin_amdgcn_fence(__ATOMIC_RELEASE, "agent");
            asm volatile("s_waitcnt vmcnt(0)" ::: "memory");
            const unsigned og = xb_add(&bar[XB_TOP], 1u);
            const unsigned tg = og / nx;
            if (og + 1u == (tg + 1u) * nx) xb_add(&bar[XB_TOPGEN], 1u);
            else XB_SPIN(xb_ld(&bar[XB_TOPGEN]) == tg, bar);
            __builtin_amdgcn_fence(__ATOMIC_ACQUIRE, "agent");
            xb_add(&bar[XB_XGEN(b.x)], 1u);
            asm volatile("s_waitcnt vmcnt(0)" ::: "memory");
        } else {
            XB_SPIN(xb_ld(&bar[XB_XGEN(b.x)]) == gen, bar);
            __builtin_amdgcn_fence(__ATOMIC_ACQUIRE, "agent");
            asm volatile("s_waitcnt vmcnt(0)" ::: "memory");
        }
    }
    __syncthreads();
}
#endif
#if !defined(CPU_EMU) && !MK_MULTI
__global__ void __launch_bounds__(512, 2) k_mega(Params p_) {
    DYN_SMEM(smem);
    KParams pk = (KParams)__builtin_amdgcn_kernarg_segment_ptr();
    cg::grid_group grid = cg::this_grid();
    volatile XB_LAS unsigned* xst = (volatile XB_LAS unsigned*)(XB_LAS char*)(smem + SMEM_BYTES);
    if (threadIdx.x == 0) { xst[0] = 0u; xst[1] = 0u; xst[2] = 0u; xst[3] = 0u; }
    __syncthreads();
    const XcdBarrier xb = xcd_barrier_post((unsigned*)(pk->ws + OFF_BAR), xst);
    bool first_sync = true;
    constexpr int NIT = NL_ * PH_PER_LAYER;
#pragma unroll 1
    for (int it = -1; it <= NIT; ++it) {
        const int l = (it >= 0 && it < NIT) ? it / PH_PER_LAYER : 0, ph = it < 0 ? (int)PH_WPREP : (it < NIT ? it % PH_PER_LAYER : (int)PH_FINAL);
        KParams q = pk; asm volatile("" : "+s"(q));
        run_phase(q, l, ph, smem);
        if (it >= 0 && it < NIT - 1 && !(l > 0 && ph == PH_NORM_MIX)) {
            if (first_sync) { grid.sync(); first_sync = false; }
            else xcd_barrier(xb);
        }
    }
}
#endif
#ifdef CPU_EMU
__global__ void k_phase(Params p_, int l, int ph) { DYN_SMEM(smem); run_phase(&p_, l, ph, smem); }
#elif MK_MULTI
__global__ void __launch_bounds__(512, 2) k_phase(Params p_, int l, int ph) { DYN_SMEM(smem); KParams pk = (KParams)__builtin_amdgcn_kernarg_segment_ptr(); run_phase(pk, l, ph, smem); }
#endif
}

#ifdef CPU_EMU
int g_emu_stop = 1000;
#endif

extern "C" void kernel_launch(void* const* d_in, const int* in_sizes, int n_in, void* d_out, int out_size, void* d_ws, size_t ws_size, hipStream_t stream) {
    Params p{};
    for (int i = 0; i < N_IN; ++i) p.in[i] = (const float*)d_in[i];
    p.out = (float*)d_out; p.ws = (char*)d_ws;
#if defined(CPU_EMU) || MK_MULTI
    const int grid = 256;
    LAUNCH(k_phase, grid, NT, SMEM_BYTES, stream, p, 0, (int)PH_WPREP);
    for (int l = 0; l < NL_; ++l)
        for (int ph = 0; ph < PH_PER_LAYER; ++ph) {
            LAUNCH(k_phase, grid, NT, SMEM_BYTES, stream, p, l, ph);
#ifdef CPU_EMU
            const int code = ph == PH_INPROJ ? 1 : ph == PH_MIXERS ? 2 : ph == PH_MERGE ? 3 : ph == PH_WOUT ? 4 : ph == PH_GATHER ? 5 : 0;
            if (code && g_emu_stop == l * 10 + code) return;
#endif
        }
    LAUNCH(k_phase, grid, NT, SMEM_BYTES, stream, p, 0, (int)PH_FINAL);
#else
    static int grid_blocks = 0;
    if (!grid_blocks) {
        int dev = 0, cus = 0, per_cu = 0;
        (void)hipGetDevice(&dev);
        (void)hipDeviceGetAttribute(&cus, hipDeviceAttributeMultiprocessorCount, dev);
        (void)hipFuncSetAttribute((const void*)k_mega, hipFuncAttributeMaxDynamicSharedMemorySize, (int)SMEM_BYTES + 16);
        (void)hipOccupancyMaxActiveBlocksPerMultiprocessor(&per_cu, k_mega, NT, SMEM_BYTES + 16);
        if (per_cu > 1) per_cu = 1;
        grid_blocks = cus * per_cu;
    }
    (void)hipMemsetAsync((char*)d_ws + OFF_BAR, 0, 16384, stream);
    void* args[] = {&p};
    hipError_t e = hipLaunchCooperativeKernel((void*)k_mega, dim3(grid_blocks), dim3(NT), args, SMEM_BYTES + 16, stream);
    if (e != hipSuccess) fprintf(stderr, "cooperative launch failed: %s (grid %d)\n", hipGetErrorString(e), grid_blocks);
#endif
}
```

```cpp
#ifndef CPU_EMU
#include <hip/hip_runtime.h>
#include <hip/hip_cooperative_groups.h>
#include <cstdio>
#include <cstdint>
namespace cg = cooperative_groups;
#define DYN_SMEM(name) extern __shared__ __attribute__((aligned(16))) char name[]
#define LAUNCH(kern, grid, block, smem, stream, ...) hipLaunchKernelGGL(kern, dim3(grid), dim3(block), smem, stream, __VA_ARGS__)
#endif

#ifndef CFG_B
#define CFG_B 8
#endif
#ifndef CFG_T
#define CFG_T 2048
#endif
#ifndef MK_MULTI
#define MK_MULTI 0
#endif

namespace {
constexpr int B_ = CFG_B, T_ = CFG_T, M_ = B_ * T_, D_ = 1024, NL_ = 2, NT = 512;
constexpr int INW = 12560;
constexpr int LDZ = 11776;
constexpr int Z_ULRU = 0, Z_GLRU = 1024, Z_Q = 2048, Z_K = 3072, Z_V = 4096, Z_ZG = 5120, Z_RW = 6144, Z_ALPHA = 9472, Z_BETA = 9480;
constexpr int ZN = 9728;
constexpr int C_XN = 9728, C_YC = 10752;
constexpr int C_YA = Z_GLRU, C_YB = Z_ZG;
constexpr int C_GS = Z_Q, C_MG = Z_K;
constexpr int C_QRY = 0;
constexpr int RW_R = 0, RW_K = 1024, RW_V = 2048, RW_WL = 3072, RW_AL = 3136, RW_GL = 3200, RWW = 3328;
constexpr float RMS_EPS = 1e-6f, GN_EPS = 64e-5f;
typedef unsigned short h16_t;

enum { I_X = 0, I_NMIX, I_NFFN, I_NFINAL, I_WIN, I_LCW, I_LCB, I_LWA, I_LBA, I_LWX, I_LBX, I_LLAM, I_GCW, I_GALOG, I_GDT, I_GNW,
       I_RMU, I_RW0, I_RWUP, I_RA0, I_RAUP, I_RGUP, I_RKK, I_RKA, I_RRK, I_RLW, I_RLB, I_MB, I_PL, I_PG, I_PR, I_WOUT, I_PWQ, I_PKEYS, I_PU, I_PV, N_IN };

struct Params {
    const float* in[N_IN];
    float* out;
    char* ws;
};
#ifdef CPU_EMU
typedef const Params* KParams;
#else
typedef const Params __attribute__((address_space(4)))* KParams;
#endif

constexpr size_t al256(size_t x) { return (x + 255) / 256 * 256; }
constexpr size_t OFF_ACT = 0;
constexpr size_t OFF_WT = al256(OFF_ACT + (size_t)M_ * LDZ * 2);
constexpr int WT_IN = 0, WT_MG = ZN, WT_P = WT_MG + 3072, WT_OUT = WT_P + 3072, WT_Q = WT_OUT + 1024, WT_ROWS = WT_Q + 2048;
constexpr size_t OFF_TOPS = al256(OFF_WT + (size_t)NL_ * WT_ROWS * 1024 * 2);
constexpr size_t OFF_TAB = al256(OFF_TOPS + (size_t)M_ * 256 * 4);
constexpr size_t OFF_BAR = OFF_TAB + (M_ == 16384 ? 0 : (size_t)16384 * 2048);
constexpr size_t WS_END = OFF_BAR + 16384;
static_assert(CFG_B != 8 || CFG_T != 2048 || WS_END <= (size_t)512 * 1024 * 1024, "workspace budget");
constexpr size_t SMEM_BYTES = 128 * 1024;

#ifdef CPU_EMU
__device__ __forceinline__ int tid_() { return threadIdx.x; }
__device__ __forceinline__ h16_t f2h(float f) { return (h16_t)_cvtss_sh(f, _MM_FROUND_TO_NEAREST_INT); }
__device__ __forceinline__ float h2f(h16_t h) { return _cvtsh_ss(h); }
#else
__device__ __forceinline__ int tid_() { int t = threadIdx.x; asm volatile("" : "+v"(t)); return t; }
__device__ __forceinline__ h16_t f2h(float f) { return __builtin_bit_cast(unsigned short, (_Float16)f); }
__device__ __forceinline__ float h2f(h16_t h) { return (float)__builtin_bit_cast(_Float16, h); }
#endif
__device__ __forceinline__ int bid_() { return (int)blockIdx.x; }

#ifdef CPU_EMU
__device__ __forceinline__ float fexp_(float x) { return expf(x); }
__device__ __forceinline__ float flog_(float x) { return logf(x); }
__device__ __forceinline__ float frcp_(float x) { return 1.0f / x; }
#else
__device__ __forceinline__ float fexp_(float x) { return __builtin_amdgcn_exp2f(x * 1.4426950408889634f); }
__device__ __forceinline__ float flog_(float x) { return __builtin_amdgcn_logf(x) * 0.6931471805599453f; }
__device__ __forceinline__ float frcp_(float x) { return __builtin_amdgcn_rcpf(x); }
#endif
__device__ __forceinline__ float sigmoidf_(float x) { return frcp_(1.0f + fexp_(-x)); }
__device__ __forceinline__ float softplusf_(float x) { return fmaxf(x, 0.0f) + flog_(1.0f + fexp_(-fabsf(x))); }
__device__ __forceinline__ float siluf_(float x) { return x * sigmoidf_(x); }
__device__ __forceinline__ float tanhf_(float x) { return 1.0f - 2.0f * frcp_(1.0f + fexp_(2.0f * x)); }
__device__ __forceinline__ float geluf_(float x) { return x * frcp_(1.0f + fexp_(-1.5957691216057308f * (x + 0.044715f * x * x * x))); }
__device__ __forceinline__ unsigned pack2h(float a, float b) { return (unsigned)f2h(a) | ((unsigned)f2h(b) << 16); }
__device__ __forceinline__ void store8h(h16_t* p, const float (&v)[8]) {
    uint4 w; w.x = pack2h(v[0], v[1]); w.y = pack2h(v[2], v[3]); w.z = pack2h(v[4], v[5]); w.w = pack2h(v[6], v[7]);
    *(uint4*)p = w;
}
__device__ __forceinline__ void load8h(const h16_t* p, float (&v)[8]) {
    const uint4 w = *(const uint4*)p;
    v[0] = h2f((h16_t)(w.x & 0xffffu)); v[1] = h2f((h16_t)(w.x >> 16)); v[2] = h2f((h16_t)(w.y & 0xffffu)); v[3] = h2f((h16_t)(w.y >> 16));
    v[4] = h2f((h16_t)(w.z & 0xffffu)); v[5] = h2f((h16_t)(w.z >> 16)); v[6] = h2f((h16_t)(w.w & 0xffffu)); v[7] = h2f((h16_t)(w.w >> 16));
}

__device__ __forceinline__ float block_sum512(float v, float* red) {
    const int tid = tid_();
    red[tid] = v;
    __syncthreads();
    if (tid < 32) { float s = 0.f; for (int i = 0; i < 16; ++i) s += red[tid * 16 + i]; red[512 + tid] = s; }
    __syncthreads();
    float tot = 0.f;
    for (int i = 0; i < 32; ++i) tot += red[512 + i];
    __syncthreads();
    return tot;
}

template <bool OUT_F32>
__device__ __forceinline__ void stage_rmsnorm(const float* src, const float* w, void* dst, int ldd, char* smem) {
    float* red = (float*)smem;
    const int tid = tid_();
    for (int row = bid_(); row < M_; row += gridDim.x) {
        const float2 v = *(const float2*)(src + (size_t)row * D_ + tid * 2);
        const float ss = block_sum512(v.x * v.x + v.y * v.y, red);
        const float rstd = rsqrtf(ss * (1.0f / D_) + RMS_EPS);
        const float2 wv = *(const float2*)(w + tid * 2);
        const float o0 = v.x * rstd * wv.x, o1 = v.y * rstd * wv.y;
        if (OUT_F32) {
            float2 o; o.x = o0; o.y = o1;
            *(float2*)((float*)dst + (size_t)row * ldd + tid * 2) = o;
        } else {
            *(unsigned*)((h16_t*)dst + (size_t)row * ldd + tid * 2) = pack2h(o0, o1);
        }
    }
}

__device__ __forceinline__ const float* wt_src(KParams p, int l, int r, int& ld) {
    if (r < ZN) {
        ld = INW;
        int c;
        if (r < 6144) c = r; else if (r < 9472) c = r + 16; else if (r < 9488) c = r - 3328; else return nullptr;
        return p->in[I_WIN] + (size_t)l * 1024 * INW + c;
    }
    r -= ZN;
    if (r < 3072) { ld = INW; return p->in[I_WIN] + (size_t)l * 1024 * INW + 9488 + r; }
    r -= 3072;
    if (r < 3072) { ld = 1024; const int br = r >> 10; return p->in[br == 0 ? I_PL : (br == 1 ? I_PG : I_PR)] + (size_t)l * 1024 * 1024 + (r & 1023); }
    r -= 3072;
    if (r < 1024) { ld = 1024; return p->in[I_WOUT] + (size_t)l * 1024 * 1024 + r; }
    r -= 1024;
    ld = 2048; return p->in[I_PWQ] + (size_t)l * 1024 * 2048 + r;
}
__device__ __forceinline__ void stage_wprep(KParams p, char* smem) {
    float* tile = (float*)smem;
    h16_t* WT = (h16_t*)(p->ws + OFF_WT);
    const int tid = tid_();
    const int ntr = WT_ROWS / 64, total = NL_ * ntr * 16;
    for (int it = bid_(); it < total; it += gridDim.x) {
        const int l = it / (ntr * 16), rem = it % (ntr * 16), rt = rem / 16, kt = rem % 16;
        const int r0 = rt * 64, k0 = kt * 64;
        __syncthreads();
        {
            const int nn = tid & 63;
            int ld = 0; const float* src = wt_src(p, l, r0 + nn, ld);
#pragma unroll
            for (int i = 0; i < 8; ++i) { const int kk = (tid >> 6) + 8 * i; tile[kk * 65 + nn] = src ? src[(size_t)(k0 + kk) * ld] : 0.f; }
        }
        __syncthreads();
        {
            const int r = tid >> 3, kq = (tid & 7) * 8;
            float v[8];
#pragma unroll
            for (int j = 0; j < 8; ++j) v[j] = tile[(kq + j) * 65 + r];
            store8h(WT + ((size_t)l * WT_ROWS + r0 + r) * 1024 + k0 + kq, v);
        }
    }
}

namespace pg8 {
constexpr int BM = 256, BK = 64, HALF = 128, HTB = HALF * BK * 2, STAGE_BYTES = 8 * HTB, NXCD = 8, WGM = 8;
struct Unit { const char* A; const char* B; int pm, pn, kind; };
#ifdef CPU_EMU
struct f32x4 { float d[4]; float& operator[](int i) { return d[i]; } const float& operator[](int i) const { return d[i]; } };
#else
#define PG8_LAS __attribute__((address_space(3)))
typedef _Float16 f16x8 __attribute__((ext_vector_type(8)));
typedef float f32x4 __attribute__((ext_vector_type(4)));
__device__ __forceinline__ int lds_byte(int r, int c) { const int st = (r >> 4) * 2 + (c >> 5), rr = r & 15, cc = c & 31, ob = rr * 64 + cc * 2; return st * 1024 + (ob ^ (((ob >> 9) & 1) << 5)); }
__device__ __forceinline__ void stage_rc(int b, int& R, int& C) { const int st = b / 1024, sb = b % 1024, swz = sb ^ (((sb >> 9) & 1) << 5); R = (st >> 1) * 16 + swz / 64; C = (st & 1) * 32 + (swz % 64) / 2; }
__device__ __forceinline__ int perm32(int rho) { const int n = rho >> 4, i = rho & 15; return 8 * (i >> 2) + 4 * n + (i & 3); }
#endif
__device__ __forceinline__ void tile_of(int L, int nM, int nN, int& pm, int& pn) {
    const int nwg = nM * nN;
    int wgid = L; { const int q = nwg / NXCD, r = nwg % NXCD, xcd = wgid % NXCD, off = wgid / NXCD; wgid = (xcd < r ? xcd * (q + 1) : r * (q + 1) + (xcd - r) * q) + off; }
    const int nig = WGM * nN, gid = wgid / nig, fm = gid * WGM, gsz = (nM - fm) < WGM ? (nM - fm) : WGM;
    pm = fm + ((wgid % nig) % gsz); pn = (wgid % nig) / gsz;
}

template <class Sched, class Epi>
__device__ __forceinline__ void gemm_phase(char* smem, const Sched& S, const Epi& E) {
    constexpr int K = 1024, nt = K / BK;
    constexpr unsigned lda = LDZ, ldb = 1024;
#ifdef CPU_EMU
    const int tid = tid_(), wid = tid >> 6, lane = tid & 63, wr = wid >> 2, wc = wid & 3, fr = lane & 15, fq = lane >> 4;
    Unit u;
    for (int ui = 0; S.next(ui, u); ++ui) {
        f32x4 acc[2][2][4][2];
        for (int ai = 0; ai < 2; ++ai) for (int bj = 0; bj < 2; ++bj) for (int m = 0; m < 4; ++m) for (int n = 0; n < 2; ++n) for (int e = 0; e < 4; ++e) {
            const int r = 128 * ai + 64 * wr + 16 * m + fr, c = 128 * bj + 32 * wc + 8 * fq + 4 * n + e;
            const h16_t* a = (const h16_t*)u.A + (size_t)r * lda; const h16_t* b = (const h16_t*)u.B + (size_t)c * ldb;
            float s = 0.f;
            for (int k = 0; k < K; ++k) s += h2f(a[k]) * h2f(b[k]);
            acc[ai][bj][m][n][e] = s;
        }
        E(acc, u, wr, wc, fr, fq);
    }
    (void)smem; (void)nt;
#else
    PG8_LAS unsigned char* lds = (PG8_LAS unsigned char*)smem;
    const int tid = tid_(), wid = __builtin_amdgcn_readfirstlane(tid >> 6), lane = tid & 63, wr = wid >> 2, wc = wid & 3, fr = lane & 15, fq = lane >> 4;
    unsigned voffA[2], voffB[2];
#pragma unroll
    for (int i = 0; i < 2; ++i) { int R, C; stage_rc(tid * 16 + i * 8192, R, C); const int Rb = (R & ~31) + perm32(R & 31);
        voffA[i] = (unsigned)(R * lda + C) * 2u; voffB[i] = (unsigned)(Rb * ldb + C) * 2u; }
    constexpr size_t kstep = (size_t)(BK * 2);
    constexpr size_t hstepA = (size_t)HALF * lda * 2, hstepB = (size_t)HALF * ldb * 2;
    const unsigned ldsw = (unsigned)wid * 1024u;
    const int aoff = lds_byte(wr * 64 + fr, fq * 8), boff = lds_byte(wc * 32 + fr, fq * 8);
#define PG8_SA(b, h) (((b) * 2 + (h)) * HTB)
#define PG8_SB(b, h) ((4 + (b) * 2 + (h)) * HTB)
#define PG8_STAGE(bufoff, gbase, voff) do { _Pragma("unroll") for (int _i = 0; _i < 2; ++_i) \
        __builtin_amdgcn_global_load_lds((const unsigned*)((const char*)(gbase) + (voff)[_i]), (PG8_LAS unsigned*)(lds + (bufoff) + ldsw + _i * 8192), 16, 0, 0); } while (0)
#define PG8_LDA(dst, b, h) do { _Pragma("unroll") for (int m = 0; m < 4; ++m) _Pragma("unroll") for (int k = 0; k < 2; ++k) dst[m][k] = *(const PG8_LAS f16x8*)(lds + PG8_SA(b, h) + aoff + m * 2048 + k * 1024); } while (0)
#define PG8_LDB(dst, b, h) do { _Pragma("unroll") for (int n = 0; n < 2; ++n) _Pragma("unroll") for (int k = 0; k < 2; ++k) dst[n][k] = *(const PG8_LAS f16x8*)(lds + PG8_SB(b, h) + boff + n * 2048 + k * 1024); } while (0)
#define PG8_MMA(ai, bj, At, Bt) do { __builtin_amdgcn_s_setprio(1); _Pragma("unroll") for (int m = 0; m < 4; ++m) _Pragma("unroll") for (int n = 0; n < 2; ++n) _Pragma("unroll") for (int k = 0; k < 2; ++k) \
        acc[ai][bj][m][n] = __builtin_amdgcn_mfma_f32_16x16x32_f16(Bt[n][k], At[m][k], acc[ai][bj][m][n], 0, 0, 0); __builtin_amdgcn_s_setprio(0); } while (0)
#define PG8_WAIT_V(n) asm volatile("s_waitcnt vmcnt(" #n ")" ::: "memory")
#define PG8_WAIT_L(n) asm volatile("s_waitcnt lgkmcnt(" #n ")" ::: "memory")
#define PG8_BAR __builtin_amdgcn_s_barrier()
#define PG8_SCHED __builtin_amdgcn_sched_barrier(0)
    Unit cur, nxt; int ui = 0;
    if (!S.next(0, cur)) return;
    f32x4 acc[2][2][4][2];
#pragma unroll
    for (int a = 0; a < 2; ++a)
#pragma unroll
        for (int b = 0; b < 2; ++b)
#pragma unroll
            for (int m = 0; m < 4; ++m)
#pragma unroll
                for (int n = 0; n < 2; ++n) acc[a][b][m][n] = (f32x4){0.f, 0.f, 0.f, 0.f};
    f16x8 At[4][2], B0[2][2], B1[2][2];
    const char* cA = cur.A; const char* cB = cur.B;
    PG8_STAGE(PG8_SB(0, 0), cB, voffB); PG8_STAGE(PG8_SA(0, 0), cA, voffA); PG8_STAGE(PG8_SB(0, 1), cB + hstepB, voffB); PG8_STAGE(PG8_SA(0, 1), cA + hstepA, voffA);
    if (wr == 1) PG8_BAR;
    PG8_WAIT_V(4); PG8_BAR;
    PG8_STAGE(PG8_SB(1, 0), cB + kstep, voffB); PG8_STAGE(PG8_SA(1, 0), cA + kstep, voffA); PG8_STAGE(PG8_SB(1, 1), cB + hstepB + kstep, voffB);
    PG8_WAIT_V(6); PG8_BAR;
    for (;;) {
        const bool has_next = S.next(ui + 1, nxt);
        const char* nA = has_next ? nxt.A : cA; const char* nB = has_next ? nxt.B : cB;
#pragma unroll 1
        for (int t = 0; t < nt; t += 2) {
            const bool last = (t == nt - 2);
            const char* a1 = cA + (size_t)(t + 1) * kstep;
            const char* a2 = last ? nA : cA + (size_t)(t + 2) * kstep; const char* b2 = last ? nB : cB + (size_t)(t + 2) * kstep;
            const char* a3 = a2 + kstep; const char* b3 = b2 + kstep;
            PG8_LDB(B0, 0, 0); PG8_SCHED; PG8_LDA(At, 0, 0); PG8_STAGE(PG8_SA(1, 1), a1 + hstepA, voffA);
            PG8_WAIT_L(8); PG8_BAR; PG8_WAIT_L(0); PG8_MMA(0, 0, At, B0); PG8_BAR; PG8_SCHED;
            PG8_LDB(B1, 0, 1); PG8_STAGE(PG8_SB(0, 0), b2, voffB);
            PG8_BAR; PG8_WAIT_L(0); PG8_MMA(0, 1, At, B1); PG8_BAR;
            PG8_LDA(At, 0, 1); PG8_STAGE(PG8_SA(0, 0), a2, voffA);
            PG8_BAR; PG8_WAIT_L(0); PG8_MMA(1, 0, At, B0); PG8_BAR; PG8_SCHED;
            PG8_STAGE(PG8_SB(0, 1), b2 + hstepB, voffB);
            PG8_WAIT_V(6); PG8_BAR; PG8_MMA(1, 1, At, B1); PG8_BAR;
            PG8_LDB(B0, 1, 0); PG8_SCHED; PG8_LDA(At, 1, 0); PG8_STAGE(PG8_SA(0, 1), a2 + hstepA, voffA);
            PG8_WAIT_L(8); PG8_BAR; PG8_WAIT_L(0); PG8_MMA(0, 0, At, B0); PG8_BAR; PG8_SCHED;
            PG8_LDB(B1, 1, 1); PG8_STAGE(PG8_SB(1, 0), b3, voffB);
            PG8_BAR; PG8_WAIT_L(0); PG8_MMA(0, 1, At, B1); PG8_BAR;
            PG8_LDA(At, 1, 1); PG8_STAGE(PG8_SA(1, 0), a3, voffA);
            PG8_BAR; PG8_WAIT_L(0); PG8_MMA(1, 0, At, B0); PG8_BAR; PG8_SCHED;
            PG8_STAGE(PG8_SB(1, 1), b3 + hstepB, voffB);
            PG8_WAIT_V(6); PG8_BAR; PG8_MMA(1, 1, At, B1); PG8_BAR;
        }
        E(acc, cur, wr, wc, fr, fq);
        if (!has_next) break;
#pragma unroll
        for (int a = 0; a < 2; ++a)
#pragma unroll
            for (int b = 0; b < 2; ++b)
#pragma unroll
                for (int m = 0; m < 4; ++m)
#pragma unroll
                    for (int n = 0; n < 2; ++n) acc[a][b][m][n] = (f32x4){0.f, 0.f, 0.f, 0.f};
        cur = nxt; cA = nA; cB = nB; ++ui;
    }
    PG8_WAIT_V(0);
    if (wr == 0) PG8_BAR;
    PG8_BAR;
#undef PG8_SA
#undef PG8_SB
#undef PG8_STAGE
#undef PG8_LDA
#undef PG8_LDB
#undef PG8_MMA
#undef PG8_WAIT_V
#undef PG8_WAIT_L
#undef PG8_BAR
#undef PG8_SCHED
#endif
}
}

enum { GK_STORE = 0, GK_GATE0, GK_GATE1, GK_GATE2, GK_PROJ0, GK_PROJ1, GK_PROJ2, GK_RESID };
enum { GP_INPROJ = 0, GP_MERGE, GP_WOUT, GP_QUERY };
struct GemmProg {
    const char* act; const char* wt;
    int which, G, c;
    __device__ __forceinline__ bool next(int i, pg8::Unit& u) const {
        constexpr int nM = M_ / 256;
        constexpr size_t rowA = (size_t)256 * LDZ * 2, rowB = (size_t)256 * 1024 * 2;
        if (which == GP_MERGE) {
            const int L = (i / 6) * G + c, j = i % 6, br = j < 3 ? j : j - 3;
            if (L >= nM * 4) return false;
            pg8::tile_of(L, nM, 4, u.pm, u.pn);
            if (j < 3) { u.A = act + (size_t)C_XN * 2; u.B = wt + ((size_t)(WT_MG + br * 1024) * 1024) * 2; u.kind = GK_GATE0 + br; }
            else { u.A = act + (size_t)(br == 0 ? C_YA : (br == 1 ? C_YB : C_YC)) * 2; u.B = wt + ((size_t)(WT_P + br * 1024) * 1024) * 2; u.kind = GK_PROJ0 + br; }
        } else {
            const int nN = which == GP_INPROJ ? ZN / 256 : (which == GP_WOUT ? 4 : 8);
            const int L = i * G + c;
            if (L >= nM * nN) return false;
            pg8::tile_of(L, nM, nN, u.pm, u.pn);
            u.A = act + (size_t)(which == GP_WOUT ? C_MG : C_XN) * 2;
            u.B = wt + ((size_t)(which == GP_INPROJ ? WT_IN : (which == GP_WOUT ? WT_OUT : WT_Q)) * 1024) * 2;
            u.kind = which == GP_WOUT ? GK_RESID : GK_STORE;
        }
        u.A += (size_t)u.pm * rowA; u.B += (size_t)u.pn * rowB;
        return true;
    }
};
__device__ __forceinline__ int gs_slot(int br) { return br == 0 ? C_GS : (br == 1 ? Z_V : Z_ULRU); }
struct GemmEpi {
    h16_t* act; const float* mb; const float* resid; float* out;
    __device__ __forceinline__ void operator()(const pg8::f32x4 (&acc)[2][2][4][2], const pg8::Unit& u, int wr, int wc, int fr, int fq) const {
        const int row0 = u.pm * 256 + wr * 64 + fr, col0 = u.pn * 256 + wc * 32 + 8 * fq;
#pragma unroll
        for (int ai = 0; ai < 2; ++ai)
#pragma unroll
            for (int m = 0; m < 4; ++m) {
                const int row = row0 + ai * 128 + m * 16;
#pragma unroll
                for (int bj = 0; bj < 2; ++bj) {
                    const int col = col0 + bj * 128;
                    float v[8];
#pragma unroll
                    for (int e = 0; e < 4; ++e) { v[e] = acc[ai][bj][m][0][e]; v[4 + e] = acc[ai][bj][m][1][e]; }
                    h16_t* arow = act + (size_t)row * LDZ;
                    if (u.kind == GK_STORE) {
                        store8h(arow + col, v);
                    } else if (u.kind <= GK_GATE2) {
                        const float* bp = mb + (u.kind - GK_GATE0) * 1024 + col;
                        const float4 b0 = *(const float4*)bp, b1 = *(const float4*)(bp + 4);
                        v[0] = sigmoidf_(v[0] + b0.x); v[1] = sigmoidf_(v[1] + b0.y); v[2] = sigmoidf_(v[2] + b0.z); v[3] = sigmoidf_(v[3] + b0.w);
                        v[4] = sigmoidf_(v[4] + b1.x); v[5] = sigmoidf_(v[5] + b1.y); v[6] = sigmoidf_(v[6] + b1.z); v[7] = sigmoidf_(v[7] + b1.w);
                        store8h(arow + gs_slot(u.kind - GK_GATE0) + col, v);
                    } else if (u.kind <= GK_PROJ2) {
                        float g[8]; load8h(arow + gs_slot(u.kind - GK_PROJ0) + col, g);
                        if (u.kind == GK_PROJ0) {
#pragma unroll
                            for (int e = 0; e < 8; ++e) v[e] = g[e] * v[e];
                        } else {
                            float o[8]; load8h(arow + C_MG + col, o);
#pragma unroll
                            for (int e = 0; e < 8; ++e) v[e] = o[e] + g[e] * v[e];
                        }
                        store8h(arow + C_MG + col, v);
                    } else {
                        const size_t o = (size_t)row * 1024 + col;
                        const float4 r0 = *(const float4*)(resid + o), r1 = *(const float4*)(resid + o + 4);
                        *(float4*)(out + o) = make_float4(r0.x + v[0], r0.y + v[1], r0.z + v[2], r0.w + v[3]);
                        *(float4*)(out + o + 4) = make_float4(r1.x + v[4], r1.y + v[5], r1.z + v[6], r1.w + v[7]);
                    }
                }
            }
    }
};
__device__ __forceinline__ void stage_gemm(KParams p, int l, int which, char* smem) {
    GemmProg S; S.act = p->ws + OFF_ACT; S.wt = p->ws + OFF_WT + (size_t)l * WT_ROWS * 1024 * 2; S.which = which; S.G = gridDim.x; S.c = bid_();
    GemmEpi E; E.act = (h16_t*)(p->ws + OFF_ACT); E.mb = p->in[I_MB] + l * 3072; E.resid = l == 0 ? p->in[I_X] : p->out; E.out = p->out;
    pg8::gemm_phase(smem, S, E);
}

#ifdef CPU_EMU
__device__ __forceinline__ float group_sum(float v, int width, float* scratch) {
    const int tid = tid_();
    scratch[tid] = v;
    __syncthreads();
    float s = 0.f; const int base = tid & ~(width - 1);
    for (int i = 0; i < width; ++i) s += scratch[base + i];
    __syncthreads();
    return s;
}
#else
template <int CTRL> __device__ __forceinline__ float dpp_f(float v) { return __builtin_bit_cast(float, __builtin_amdgcn_update_dpp(0, __builtin_bit_cast(int, v), CTRL, 0xf, 0xf, false)); }
__device__ __forceinline__ float group_sum(float v, int width, float*) {
    v += dpp_f<0xB1>(v);
    v += dpp_f<0x4E>(v);
    if (width >= 8) v += dpp_f<0x141>(v);
    if (width >= 16) v += dpp_f<0x140>(v);
    if (width >= 64) {
        v += __builtin_bit_cast(float, __builtin_amdgcn_update_dpp(0, __builtin_bit_cast(int, v), 0x142, 0xa, 0xf, false));
        v += __builtin_bit_cast(float, __builtin_amdgcn_update_dpp(0, __builtin_bit_cast(int, v), 0x143, 0xc, 0xf, false));
        v = __builtin_bit_cast(float, __builtin_amdgcn_readlane(__builtin_bit_cast(int, v), 63));
    } else if (width >= 32) v += __shfl_xor(v, 16);
    return v;
}
#endif
__device__ __forceinline__ uint4 ldg16(const h16_t* p) { return *(const uint4*)p; }
__device__ __forceinline__ uint4 zero16() { uint4 z; z.x = 0u; z.y = 0u; z.z = 0u; z.w = 0u; return z; }

__device__ __forceinline__ void stage_lru(KParams p, int l, char* smem, int vb0, int nvb) {
    const int vb = bid_() - vb0;
    if (vb < 0 || vb >= nvb) return;
    constexpr int CH = 64;
    float* wa_s = (float*)smem;
    float* wx_s = wa_s + 4096;
    float* xcT = wx_s + 4096;
    float* a_s = xcT + 64 * CH;
    float* b_s = a_s + CH * 64;
    h16_t* ru = (h16_t*)(b_s + CH * 64);
    h16_t* rg = ru + (CH + 3) * 64;
    h16_t* ACT = (h16_t*)(p->ws + OFF_ACT);
    const int tid = tid_(), c = tid & 63, tg = tid >> 6;
    for (int item = vb; item < B_ * 16; item += nvb) {
        const int b = item / 16, n = item % 16, ch = n * 64 + c;
        __syncthreads();
        for (int i = tid; i < 4096; i += NT) { wa_s[i] = p->in[I_LWA][((size_t)l * 16 + n) * 4096 + i]; wx_s[i] = p->in[I_LWX][((size_t)l * 16 + n) * 4096 + i]; }
        const float cw0 = p->in[I_LCW][((size_t)l * 4 + 0) * 1024 + ch], cw1 = p->in[I_LCW][((size_t)l * 4 + 1) * 1024 + ch];
        const float cw2 = p->in[I_LCW][((size_t)l * 4 + 2) * 1024 + ch], cw3 = p->in[I_LCW][((size_t)l * 4 + 3) * 1024 + ch];
        const float cb = p->in[I_LCB][l * 1024 + ch], ba = p->in[I_LBA][l * 1024 + ch], bx = p->in[I_LBX][l * 1024 + ch];
        const float sp = softplusf_(-p->in[I_LLAM][l * 1024 + ch]);
        float hst = 0.f;
        uint4 pf[3];
#define LRU_LOAD(t0_) do { _Pragma("unroll") for (int i = 0; i < 3; ++i) { const int j = tid + NT * i; pf[i] = zero16(); \
            if (j < 536) { const int t = (t0_) - 3 + (j >> 3); if (t >= 0) pf[i] = ldg16(ACT + ((size_t)b * T_ + t) * LDZ + Z_ULRU + n * 64 + (j & 7) * 8); } \
            else if (j < 1048) { const int jj = j - 536; pf[i] = ldg16(ACT + ((size_t)b * T_ + (t0_) + (jj >> 3)) * LDZ + Z_GLRU + n * 64 + (jj & 7) * 8); } } } while (0)
#define LRU_PUT() do { _Pragma("unroll") for (int i = 0; i < 3; ++i) { const int j = tid + NT * i; \
            if (j < 536) *(uint4*)(ru + (j >> 3) * 64 + (j & 7) * 8) = pf[i]; else if (j < 1048) *(uint4*)(rg + ((j - 536) >> 3) * 64 + ((j - 536) & 7) * 8) = pf[i]; } } while (0)
        LRU_LOAD(0);
        LRU_PUT();
        __syncthreads();
#pragma unroll 1
        for (int t0 = 0; t0 < T_; t0 += CH) {
            float xc[8];
            {
                float u[11];
#pragma unroll
                for (int s = 0; s < 11; ++s) u[s] = h2f(ru[(tg * 8 + s) * 64 + c]);
#pragma unroll
                for (int s = 0; s < 8; ++s) { xc[s] = cw0 * u[s] + cw1 * u[s + 1] + cw2 * u[s + 2] + cw3 * u[s + 3] + cb; xcT[c * CH + tg * 8 + s] = xc[s]; }
            }
            __syncthreads();
            if (t0 + CH < T_) LRU_LOAD(t0 + CH);
            {
                float dr[8], di[8];
#pragma unroll
                for (int s = 0; s < 8; ++s) { dr[s] = 0.f; di[s] = 0.f; }
#pragma unroll 4
                for (int i = 0; i < 64; ++i) {
                    const float wa = wa_s[i * 64 + c], wx = wx_s[i * 64 + c];
                    const float4 x0 = *(const float4*)(xcT + i * CH + tg * 8), x1 = *(const float4*)(xcT + i * CH + tg * 8 + 4);
                    dr[0] += x0.x * wa; dr[1] += x0.y * wa; dr[2] += x0.z * wa; dr[3] += x0.w * wa; dr[4] += x1.x * wa; dr[5] += x1.y * wa; dr[6] += x1.z * wa; dr[7] += x1.w * wa;
                    di[0] += x0.x * wx; di[1] += x0.y * wx; di[2] += x0.z * wx; di[3] += x0.w * wx; di[4] += x1.x * wx; di[5] += x1.y * wx; di[6] += x1.z * wx; di[7] += x1.w * wx;
                }
#pragma unroll
                for (int s = 0; s < 8; ++s) {
                    const float r = sigmoidf_(dr[s] + ba), ig = sigmoidf_(di[s] + bx);
                    const float log_a = -8.0f * r * sp;
                    a_s[(tg * 8 + s) * 64 + c] = fexp_(log_a);
                    b_s[(tg * 8 + s) * 64 + c] = sqrtf(fmaxf(1.0f - fexp_(2.0f * log_a), 0.0f)) * (ig * xc[s]);
                }
            }
            __syncthreads();
            if (tid < 64) {
#pragma unroll 8
                for (int t = 0; t < CH; ++t) { hst = a_s[t * 64 + c] * hst + b_s[t * 64 + c]; b_s[t * 64 + c] = hst; }
            }
            __syncthreads();
#pragma unroll
            for (int s = 0; s < 8; ++s) { h16_t* gp = rg + (tg * 8 + s) * 64 + c; *gp = f2h(b_s[(tg * 8 + s) * 64 + c] * geluf_(h2f(*gp))); }
            __syncthreads();
            *(uint4*)(ACT + ((size_t)b * T_ + t0 + (tid >> 3)) * LDZ + Z_GLRU + n * 64 + (tid & 7) * 8) = *(const uint4*)(rg + (tid >> 3) * 64 + (tid & 7) * 8);
            __syncthreads();
            if (t0 + CH < T_) LRU_PUT();
            __syncthreads();
        }
#undef LRU_LOAD
#undef LRU_PUT
    }
}

#ifdef CPU_EMU
struct hfrag { h16_t v[8]; };
struct facc { float d[4]; float& operator[](int i) { return d[i]; } const float& operator[](int i) const { return d[i]; } };
__device__ __forceinline__ facc facc_zero() { facc a; a.d[0] = a.d[1] = a.d[2] = a.d[3] = 0.f; return a; }
__device__ __forceinline__ hfrag frag_u4(uint4 w) { hfrag f; memcpy(&f, &w, 16); return f; }
__device__ __forceinline__ hfrag frag_2u2(uint2 lo, uint2 hi) { hfrag f; memcpy(&f.v[0], &lo, 8); memcpy(&f.v[4], &hi, 8); return f; }
__device__ __forceinline__ hfrag frag_mul(hfrag a, hfrag b) { hfrag f; for (int j = 0; j < 8; ++j) f.v[j] = f2h(h2f(a.v[j]) * h2f(b.v[j])); return f; }
__device__ __forceinline__ facc mfma16(hfrag a, hfrag b, facc c) {
    const int tid = tid_(), w = tid >> 6, l = tid & 63;
    unsigned short (*X)[64][16] = emu::ctx->xscr;
    for (int j = 0; j < 8; ++j) { X[w][l][j] = a.v[j]; X[w][l][8 + j] = b.v[j]; }
    __syncthreads();
    for (int reg = 0; reg < 4; ++reg) {
        const int row = 4 * (l >> 4) + reg, col = l & 15;
        float s = 0.f;
        for (int k = 0; k < 32; ++k) s += h2f(X[w][row + 16 * (k >> 3)][k & 7]) * h2f(X[w][col + 16 * (k >> 3)][8 + (k & 7)]);
        c.d[reg] += s;
    }
    __syncthreads();
    return c;
}
#else
typedef _Float16 hfrag __attribute__((ext_vector_type(8)));
typedef float facc __attribute__((ext_vector_type(4)));
__device__ __forceinline__ facc facc_zero() { return (facc){0.f, 0.f, 0.f, 0.f}; }
__device__ __forceinline__ hfrag frag_u4(uint4 w) { return __builtin_bit_cast(hfrag, w); }
__device__ __forceinline__ hfrag frag_2u2(uint2 lo, uint2 hi) { uint4 w; w.x = lo.x; w.y = lo.y; w.z = hi.x; w.w = hi.y; return __builtin_bit_cast(hfrag, w); }
__device__ __forceinline__ hfrag frag_mul(hfrag a, hfrag b) { return a * b; }
__device__ __forceinline__ facc mfma16(hfrag a, hfrag b, facc c) { return __builtin_amdgcn_mfma_f32_16x16x32_f16(a, b, c, 0, 0, 0); }
#endif
__device__ __forceinline__ hfrag frag_pack8(float a0, float a1, float a2, float a3, float a4, float a5, float a6, float a7) {
    uint4 w; w.x = pack2h(a0, a1); w.y = pack2h(a2, a3); w.z = pack2h(a4, a5); w.w = pack2h(a6, a7); return frag_u4(w);
}
__device__ __forceinline__ hfrag frag_acc2(const facc& t0, const facc& t1) { return frag_pack8(t0[0], t0[1], t0[2], t0[3], t1[0], t1[1], t1[2], t1[3]); }
__device__ __forceinline__ hfrag permfrag(const h16_t* rowp, int ks, int g) { return frag_2u2(*(const uint2*)(rowp + 32 * ks + 4 * g), *(const uint2*)(rowp + 32 * ks + 16 + 4 * g)); }

__device__ __forceinline__ void stage_gdn(KParams p, int l, char* smem, int vb0, int nvb) {
    const int vb = bid_() - vb0;
    if (vb < 0 || vb >= nvb) return;
    constexpr int CH = 64, QS = 136, TS = 72, AS = 68, KTS = 128 * TS + 16 * 8;
#define KTO(d) ((d) * TS + ((d) >> 3) * 8)
    h16_t* Qs = (h16_t*)smem;
    h16_t* Ks = Qs + 64 * QS;
    h16_t* Kt = Ks + 64 * QS;
    h16_t* Vt = Kt + KTS;
    float* A32 = (float*)(Vt + KTS);
    h16_t* ob = (h16_t*)A32;
    h16_t* Tu = (h16_t*)(A32 + 64 * AS);
    h16_t* Tw = Tu + 64 * TS;
    h16_t* QKm = Tw + 64 * TS;
    float* gc_s = (float*)(QKm + 64 * TS);
    float* be_s = gc_s + 64;
    float* e1_s = be_s + 64;
    float* part_s = e1_s + 64;
    float* scr = part_s + 512;
    float* cw_s = scr + 512;
    h16_t* ACT = (h16_t*)(p->ws + OFF_ACT);
    int tid = tid_(), lane = tid & 63, w = tid >> 6, g = lane >> 4, r16 = lane & 15;
    int sg = lane >> 4, pc = lane & 15, rb = w;
#define GDN_ROLES() do { tid = tid_(); lane = tid & 63; w = tid >> 6; g = lane >> 4; r16 = lane & 15; sg = g; pc = r16; rb = w; } while (0)
    for (int item = vb; item < B_ * 8; item += nvb) {
        const int b = item / 8, h = item % 8;
        const float a_exp = fexp_(p->in[I_GALOG][l * 8 + h]), dtb = p->in[I_GDT][l * 8 + h];
        facc S[8];
#pragma unroll
        for (int dt = 0; dt < 8; ++dt) S[dt] = facc_zero();
        __syncthreads();
        for (int i = tid; i < 64 * TS / 2; i += NT) ((unsigned*)QKm)[i] = 0u;
        for (int i = tid; i < 4 * 384; i += NT) { const int jj = i / 384, c3 = i % 384; cw_s[i] = p->in[I_GCW][((size_t)l * 4 + jj) * 3072 + (c3 >> 7) * 1024 + h * 128 + (c3 & 127)]; }
        uint4 pf[11];
#define GDN_LOAD(t0_) do { GDN_ROLES(); const h16_t* colp = ACT + ((size_t)b * T_ + (t0_) + 8 * rb - 3) * LDZ + (sg < 3 ? Z_Q + sg * 1024 : Z_ZG) + h * 128 + pc * 8; \
            _Pragma("unroll") for (int i = 0; i < 11; ++i) { const int t = (t0_) + 8 * rb - 3 + i; pf[i] = (t >= 0 && sg < 3) ? ldg16(colp + (size_t)i * LDZ) : zero16(); } } while (0)
        GDN_LOAD(0);
        h16_t pfa = 0, pfb = 0;
#define GDN_LOADS(t0_) do { if (tid < 64) { const size_t m_ = (size_t)b * T_ + (t0_) + tid; pfa = ACT[m_ * LDZ + Z_ALPHA + h]; pfb = ACT[m_ * LDZ + Z_BETA + h]; } } while (0)
        GDN_LOADS(0);
#pragma unroll 1
        for (int t0 = 0; t0 < T_; t0 += CH) {
            GDN_ROLES();
            if (tid < 64) {
                part_s[tid] = -a_exp * softplusf_(h2f(pfa) + dtb);
                be_s[tid] = sigmoidf_(h2f(pfb));
            }
            __syncthreads();
            if (tid < 64) { float s = 0.f;
#pragma unroll
                for (int i4 = 0; i4 < 16; ++i4) { const float4 pv = *(const float4*)(part_s + i4 * 4); s += (i4 * 4 <= tid ? pv.x : 0.f) + (i4 * 4 + 1 <= tid ? pv.y : 0.f) + (i4 * 4 + 2 <= tid ? pv.z : 0.f) + (i4 * 4 + 3 <= tid ? pv.w : 0.f); }
                gc_s[tid] = s; }
#pragma unroll
            for (int hf = 0; hf < 2; ++hf) {
                float ov[4][8];
#pragma unroll
                for (int i = 0; i < 4; ++i) {
#pragma unroll
                    for (int cc = 0; cc < 8; ++cc) ov[i][cc] = 0.f;
#pragma unroll
                    for (int jj = 0; jj < 4; ++jj) {
                        const uint4 wv = pf[hf * 4 + i + jj];
                        const float* cwp = cw_s + jj * 384 + (sg < 3 ? sg : 0) * 128 + pc * 8;
                        const float4 c0 = *(const float4*)cwp, c1 = *(const float4*)(cwp + 4);
                        ov[i][0] += c0.x * h2f((h16_t)(wv.x & 0xffffu)); ov[i][1] += c0.y * h2f((h16_t)(wv.x >> 16)); ov[i][2] += c0.z * h2f((h16_t)(wv.y & 0xffffu)); ov[i][3] += c0.w * h2f((h16_t)(wv.y >> 16));
                        ov[i][4] += c1.x * h2f((h16_t)(wv.z & 0xffffu)); ov[i][5] += c1.y * h2f((h16_t)(wv.z >> 16)); ov[i][6] += c1.z * h2f((h16_t)(wv.w & 0xffffu)); ov[i][7] += c1.w * h2f((h16_t)(wv.w >> 16));
                    }
                    float ss = 0.f;
#pragma unroll
                    for (int cc = 0; cc < 8; ++cc) { ov[i][cc] = siluf_(ov[i][cc]); ss += ov[i][cc] * ov[i][cc]; }
                    ss = group_sum(ss, 16, scr);
                    const float rn = sg == 0 ? rsqrtf(ss + RMS_EPS) * 0.08838834764831845f : (sg == 1 ? rsqrtf(ss + RMS_EPS) : 1.0f);
#pragma unroll
                    for (int cc = 0; cc < 8; ++cc) ov[i][cc] *= rn;
                    const int t = 8 * rb + hf * 4 + i;
                    if (sg == 0) store8h(Qs + t * QS + pc * 8, ov[i]);
                    else if (sg == 1) store8h(Ks + t * QS + pc * 8, ov[i]);
                }
                if (sg == 1 || sg == 2) {
                    h16_t* dstT = sg == 1 ? Kt : Vt;
#pragma unroll
                    for (int cc = 0; cc < 8; ++cc) { uint2 w2; w2.x = pack2h(ov[0][cc], ov[1][cc]); w2.y = pack2h(ov[2][cc], ov[3][cc]); *(uint2*)(dstT + KTO(pc * 8 + cc) + 8 * rb + hf * 4) = w2; }
                }
            }
            __syncthreads();
            GDN_ROLES();
            if (tid < 64) e1_s[tid] = fexp_(gc_s[63] - gc_s[tid]);
            for (int e = tid; e < 64 * 64; e += NT) { const int i = e >> 6, j = e & 63; if ((j >> 4) > (i >> 4)) A32[i * AS + (j & 7) * 8 + (j >> 3)] = 0.f; }
#pragma unroll 1
            for (int jr = 0; jr < 3; ++jr) {
                const int jb = w + 8 * jr; const bool valid = jb < 20;
                const int kind = (valid && jb >= 10) ? 1 : 0, tix = valid ? (jb % 10) : 0;
                const int ti = tix < 1 ? 0 : (tix < 3 ? 1 : (tix < 6 ? 2 : 3)), tj = tix - (ti * (ti + 1)) / 2;
                const h16_t* ap = (kind ? Qs : Ks) + (16 * ti + r16) * QS + 8 * g; const h16_t* bp = Ks + (16 * tj + r16) * QS + 8 * g;
                facc acc = facc_zero();
#pragma unroll
                for (int ks = 0; ks < 4; ++ks) acc = mfma16(frag_u4(*(const uint4*)(ap + 32 * ks)), frag_u4(*(const uint4*)(bp + 32 * ks)), acc);
                if (valid) {
                    const int j = 16 * tj + r16; const float gj = gc_s[j];
#pragma unroll
                    for (int reg = 0; reg < 4; ++reg) {
                        const int i = 16 * ti + 4 * g + reg;
                        const float dec = fexp_(fminf(gc_s[i] - gj, 0.f));
                        if (kind == 0) A32[i * AS + (j & 7) * 8 + (j >> 3)] = i > j ? be_s[i] * acc[reg] * dec : 0.f;
                        else QKm[i * TS + j] = f2h(i >= j ? acc[reg] * dec : 0.f);
                    }
                }
            }
            __syncthreads();
            GDN_ROLES();
            {
                const int t = tid >> 3, d0 = (tid & 7) * 16; const float eg = fexp_(gc_s[t]);
                float v8[8];
                load8h(Qs + t * QS + d0, v8);
#pragma unroll
                for (int e = 0; e < 8; ++e) v8[e] *= eg;
                store8h(Qs + t * QS + d0, v8);
                load8h(Qs + t * QS + d0 + 8, v8);
#pragma unroll
                for (int e = 0; e < 8; ++e) v8[e] *= eg;
                store8h(Qs + t * QS + d0 + 8, v8);
            }
            {
                const int c = tid >> 3, q = tid & 7;
                const float bc = be_s[c], bgc = bc * fexp_(gc_s[c]);
                float x[8];
#pragma unroll
                for (int i = 0; i < 8; ++i) x[i] = 0.f;
#pragma unroll
                for (int r = 0; r < 64; ++r) {
                    float sacc = 0.f;
                    if (r > 0) {
                        const float4 a0 = *(const float4*)(A32 + r * AS + q * 8);
                        sacc = a0.x * x[0];
                        if (r > 8) sacc += a0.y * x[1];
                        if (r > 16) sacc += a0.z * x[2];
                        if (r > 24) sacc += a0.w * x[3];
                        if (r > 32) {
                            const float4 a1 = *(const float4*)(A32 + r * AS + q * 8 + 4);
                            sacc += a1.x * x[4];
                            if (r > 40) sacc += a1.y * x[5];
                            if (r > 48) sacc += a1.z * x[6];
                            if (r > 56) sacc += a1.w * x[7];
                        }
                        sacc = group_sum(sacc, 8, scr);
                    }
                    const float xr = ((r == c) ? 1.f : 0.f) - sacc;
                    if (q == (r & 7)) { x[r >> 3] = xr; Tu[r * TS + c] = f2h(xr * bc); Tw[r * TS + c] = f2h(xr * bgc); }
                }
            }
            __syncthreads();
            GDN_ROLES();
            facc vn[4], aw[4];
#pragma unroll
            for (int tt = 0; tt < 4; ++tt) { vn[tt] = facc_zero(); aw[tt] = facc_zero(); }
#pragma unroll
            for (int tt = 0; tt < 4; ++tt)
#pragma unroll
                for (int ks = 0; ks <= (tt >> 1); ++ks) {
                    const hfrag au = frag_u4(*(const uint4*)(Tu + (16 * tt + r16) * TS + 32 * ks + 8 * g)), aww = frag_u4(*(const uint4*)(Tw + (16 * tt + r16) * TS + 32 * ks + 8 * g));
                    vn[tt] = mfma16(au, frag_u4(*(const uint4*)(Vt + KTO(16 * w + r16) + 32 * ks + 8 * g)), vn[tt]);
                    aw[tt] = mfma16(aww, frag_u4(*(const uint4*)(Kt + KTO(16 * w + r16) + 32 * ks + 8 * g)), aw[tt]);
                }
#pragma unroll
            for (int tt = 0; tt < 4; ++tt)
#pragma unroll
                for (int reg = 0; reg < 4; ++reg) Ks[(16 * tt + 4 * g + reg) * QS + 16 * w + r16] = f2h(-aw[tt][reg]);
            __syncthreads();
            GDN_ROLES();
            h16_t zraw[16];
#pragma unroll
            for (int tt = 0; tt < 4; ++tt)
#pragma unroll
                for (int reg = 0; reg < 4; ++reg) zraw[tt * 4 + reg] = ACT[((size_t)b * T_ + t0 + 16 * tt + 4 * g + reg) * LDZ + Z_ZG + h * 128 + 16 * w + r16];
            hfrag Sb[4];
#pragma unroll
            for (int ks = 0; ks < 4; ++ks) Sb[ks] = frag_acc2(S[2 * ks], S[2 * ks + 1]);
            facc oc[4];
#pragma unroll
            for (int tt = 0; tt < 4; ++tt) {
                oc[tt] = facc_zero();
                const h16_t* wrow = Ks + (16 * tt + r16) * QS; const h16_t* qrow = Qs + (16 * tt + r16) * QS;
#pragma unroll
                for (int ks = 0; ks < 4; ++ks) { vn[tt] = mfma16(permfrag(wrow, ks, g), Sb[ks], vn[tt]); oc[tt] = mfma16(permfrag(qrow, ks, g), Sb[ks], oc[tt]); }
            }
            hfrag VNb[2];
            VNb[0] = frag_acc2(vn[0], vn[1]); VNb[1] = frag_acc2(vn[2], vn[3]);
#pragma unroll
            for (int tt = 0; tt < 4; ++tt)
#pragma unroll
                for (int ks2 = 0; ks2 <= (tt >> 1); ++ks2) oc[tt] = mfma16(permfrag(QKm + (16 * tt + r16) * TS, ks2, g), VNb[ks2], oc[tt]);
            {
                const float egl = fexp_(gc_s[63]);
                hfrag e1f[2];
#pragma unroll
                for (int ks2 = 0; ks2 < 2; ++ks2) { const float* ep = e1_s + 32 * ks2 + 4 * g; e1f[ks2] = frag_pack8(ep[0], ep[1], ep[2], ep[3], ep[16], ep[17], ep[18], ep[19]); }
#pragma unroll
                for (int dt = 0; dt < 8; ++dt) {
#pragma unroll
                    for (int reg = 0; reg < 4; ++reg) S[dt][reg] *= egl;
#pragma unroll
                    for (int ks2 = 0; ks2 < 2; ++ks2) S[dt] = mfma16(frag_mul(permfrag(Kt + KTO(16 * dt + r16), ks2, g), e1f[ks2]), VNb[ks2], S[dt]);
                }
            }
            if (t0 + CH < T_) { GDN_LOAD(t0 + CH); GDN_LOADS(t0 + CH); }
            GDN_ROLES();
#pragma unroll
            for (int tt = 0; tt < 4; ++tt)
#pragma unroll
                for (int reg = 0; reg < 4; ++reg) { const float ss = group_sum(oc[tt][reg] * oc[tt][reg], 16, scr); if (r16 == 0) part_s[w * 64 + 16 * tt + 4 * g + reg] = ss; }
            __syncthreads();
            const float nw = p->in[I_GNW][l * 128 + w * 16 + r16];
#pragma unroll
            for (int tt = 0; tt < 4; ++tt)
#pragma unroll
                for (int reg = 0; reg < 4; ++reg) {
                    const int t = 16 * tt + 4 * g + reg;
                    float ms = 0.f;
#pragma unroll
                    for (int ww = 0; ww < 8; ++ww) ms += part_s[ww * 64 + t];
                    ob[t * 128 + 16 * w + r16] = f2h(oc[tt][reg] * rsqrtf(ms * (1.0f / 128.0f) + RMS_EPS) * nw * siluf_(h2f(zraw[tt * 4 + reg])));
                }
            __syncthreads();
            GDN_ROLES();
#pragma unroll
            for (int i = 0; i < 2; ++i) { const int j = tid + NT * i; *(uint4*)(ACT + ((size_t)b * T_ + t0 + (j >> 4)) * LDZ + Z_ZG + h * 128 + (j & 15) * 8) = *(const uint4*)(ob + (j >> 4) * 128 + (j & 15) * 8); }
            __syncthreads();
        }
#undef GDN_LOAD
#undef GDN_LOADS
#undef KTO
#undef GDN_ROLES
    }
}

#ifndef CPU_EMU
typedef _Float16 rw_f16x8 __attribute__((ext_vector_type(8)));
typedef float rw_f32x4 __attribute__((ext_vector_type(4)));
#endif
__device__ __forceinline__ void stage_rwkv(KParams p, int l, char* smem, int vb0, int nvb) {
    const int vb = bid_() - vb0;
    if (vb < 0 || vb >= nvb) return;
    constexpr int CH = 32, XS = 264;
    float* r_s = (float*)smem;
    float* k_s = r_s + CH * 64;
    float* v_s = k_s + CH * 64;
    float* w_s = v_s + CH * 64;
    float* kk_s = w_s + CH * 64;
    float* ka_s = kk_s + CH * 64;
    float* g_s = ka_s + CH * 64;
    float* o_s = g_s + CH * 64;
    float* bon_s = o_s + CH * 64;
    float* scr = bon_s + CH;
    h16_t* raw = (h16_t*)(scr + 512);
    h16_t* xs = raw + (CH + 1) * 448;
    h16_t* ACT = (h16_t*)(p->ws + OFF_ACT);
    int tid = tid_(), c = tid & 63, tg = tid >> 6;
    int ri = tid >> 3, q8 = tid & 7;
#define RW_ROLES() do { tid = tid_(); c = tid & 63; tg = tid >> 6; ri = tid >> 3; q8 = tid & 7; } while (0)
    float* cst_s = (float*)(xs + CH * XS);
    for (int item = vb; item < B_ * 16; item += nvb) {
        const int b = item / 16, h = item % 16, ch = h * 64 + c;
        __syncthreads();
        if (tid < 64) {
            const float* mu = p->in[I_RMU] + (size_t)l * RWW;
            cst_s[0 * 64 + c] = p->in[I_RW0][l * 1024 + ch]; cst_s[1 * 64 + c] = p->in[I_RA0][l * 1024 + ch]; cst_s[2 * 64 + c] = p->in[I_RKK][l * 1024 + ch]; cst_s[3 * 64 + c] = p->in[I_RKA][l * 1024 + ch];
            cst_s[4 * 64 + c] = p->in[I_RRK][(size_t)l * 1024 + ch]; cst_s[5 * 64 + c] = p->in[I_RLW][l * 1024 + ch]; cst_s[6 * 64 + c] = p->in[I_RLB][l * 1024 + ch];
            cst_s[7 * 64 + c] = mu[RW_R + ch]; cst_s[8 * 64 + c] = mu[RW_K + ch]; cst_s[9 * 64 + c] = mu[RW_V + ch];
            cst_s[10 * 64 + c] = mu[RW_WL + c]; cst_s[11 * 64 + c] = mu[RW_AL + c]; cst_s[12 * 64 + c] = mu[RW_GL + c]; cst_s[13 * 64 + c] = mu[RW_GL + 64 + c];
        }
        const float* wup = p->in[I_RWUP] + (size_t)l * 64 * 1024 + h * 64; const float* aup = p->in[I_RAUP] + (size_t)l * 64 * 1024 + h * 64; const float* gup = p->in[I_RGUP] + (size_t)l * 128 * 1024 + h * 64;
#ifndef CPU_EMU
        const int wid = tid >> 6, lane = tid & 63, mt = wid >> 2, nt = wid & 3;
        rw_f16x8 bw[2], ba_[2], bg[4];
        {
            const int cn = nt * 16 + (lane & 15), kb = 8 * (lane >> 4);
#pragma unroll
            for (int ks = 0; ks < 2; ++ks)
#pragma unroll
                for (int j = 0; j < 8; ++j) { bw[ks][j] = (_Float16)wup[(size_t)(ks * 32 + kb + j) * 1024 + cn]; ba_[ks][j] = (_Float16)aup[(size_t)(ks * 32 + kb + j) * 1024 + cn]; }
#pragma unroll
            for (int ks = 0; ks < 4; ++ks)
#pragma unroll
                for (int j = 0; j < 8; ++j) bg[ks][j] = (_Float16)gup[(size_t)(ks * 32 + kb + j) * 1024 + cn];
        }
#endif
        float S[8];
#pragma unroll
        for (int e = 0; e < 8; ++e) S[e] = 0.f;
        uint4 pf[4];
#define RW_LOAD(t0_) do { _Pragma("unroll") for (int i = 0; i < 4; ++i) { const int j = tid + NT * i, row = j / 56, u = j % 56, t = (t0_) - 1 + row; pf[i] = zero16(); \
            if (j < (CH + 1) * 56 && t >= 0) pf[i] = ldg16(ACT + ((size_t)b * T_ + t) * LDZ + Z_RW + (u < 24 ? (u >> 3) * 1024 + h * 64 + (u & 7) * 8 : 3072 + (u - 24) * 8)); } } while (0)
#define RW_PUT() do { _Pragma("unroll") for (int i = 0; i < 4; ++i) { const int j = tid + NT * i; if (j < (CH + 1) * 56) *(uint4*)(raw + (j / 56) * 448 + (j % 56) * 8) = pf[i]; } } while (0)
        __syncthreads();
        RW_LOAD(0);
        RW_PUT();
        __syncthreads();
#pragma unroll 1
        for (int t0 = 0; t0 < T_; t0 += CH) {
            RW_ROLES();
            {
            const float mu_r = cst_s[7 * 64 + c], mu_k = cst_s[8 * 64 + c], mu_v = cst_s[9 * 64 + c], mu_wl = cst_s[10 * 64 + c], mu_al = cst_s[11 * 64 + c], mu_g0 = cst_s[12 * 64 + c], mu_g1 = cst_s[13 * 64 + c];
#pragma unroll
            for (int s = 0; s < 4; ++s) {
                const int tl = tg * 4 + s;
                const h16_t* zc = raw + (tl + 1) * 448; const h16_t* zp = raw + tl * 448;
#define RW_SHIFT(col, muv) ({ const float zz = h2f(zc[col]); zz + (muv) * (h2f(zp[col]) - zz); })
                r_s[tl * 64 + c] = RW_SHIFT(c, mu_r);
                k_s[tl * 64 + c] = RW_SHIFT(64 + c, mu_k);
                v_s[tl * 64 + c] = RW_SHIFT(128 + c, mu_v);
                xs[tl * XS + c] = f2h(tanhf_(RW_SHIFT(192 + c, mu_wl)));
                xs[tl * XS + 64 + c] = f2h(RW_SHIFT(256 + c, mu_al));
                xs[tl * XS + 128 + c] = f2h(sigmoidf_(RW_SHIFT(320 + c, mu_g0)));
                xs[tl * XS + 192 + c] = f2h(sigmoidf_(RW_SHIFT(384 + c, mu_g1)));
#undef RW_SHIFT
            }
            }
            __syncthreads();
#ifdef CPU_EMU
#pragma unroll
            for (int s = 0; s < 4; ++s) {
                const int tl = tg * 4 + s;
                float dw = 0.f, da = 0.f, dg = 0.f;
                for (int i = 0; i < 64; ++i) { dw += h2f(xs[tl * XS + i]) * h2f(f2h(wup[(size_t)i * 1024 + c])); da += h2f(xs[tl * XS + 64 + i]) * h2f(f2h(aup[(size_t)i * 1024 + c])); }
                for (int i = 0; i < 128; ++i) dg += h2f(xs[tl * XS + 128 + i]) * h2f(f2h(gup[(size_t)i * 1024 + c]));
                w_s[tl * 64 + c] = dw; ka_s[tl * 64 + c] = da; g_s[tl * 64 + c] = dg;
            }
#else
            {
                const h16_t* ap = xs + (mt * 16 + (lane & 15)) * XS + 8 * (lane >> 4);
                rw_f32x4 dw = {0.f, 0.f, 0.f, 0.f}, da = {0.f, 0.f, 0.f, 0.f}, dg = {0.f, 0.f, 0.f, 0.f};
#pragma unroll
                for (int ks = 0; ks < 2; ++ks) {
                    dw = __builtin_amdgcn_mfma_f32_16x16x32_f16(*(const rw_f16x8*)(ap + ks * 32), bw[ks], dw, 0, 0, 0);
                    da = __builtin_amdgcn_mfma_f32_16x16x32_f16(*(const rw_f16x8*)(ap + 64 + ks * 32), ba_[ks], da, 0, 0, 0);
                }
#pragma unroll
                for (int ks = 0; ks < 4; ++ks) dg = __builtin_amdgcn_mfma_f32_16x16x32_f16(*(const rw_f16x8*)(ap + 128 + ks * 32), bg[ks], dg, 0, 0, 0);
#pragma unroll
                for (int rg = 0; rg < 4; ++rg) { const int o = (mt * 16 + 4 * (lane >> 4) + rg) * 64 + nt * 16 + (lane & 15); w_s[o] = dw[rg]; ka_s[o] = da[rg]; g_s[o] = dg[rg]; }
            }
#endif
            __syncthreads();
            RW_ROLES();
            {
            const float w0 = cst_s[0 * 64 + c], a0 = cst_s[1 * 64 + c], k_k = cst_s[2 * 64 + c], k_a = cst_s[3 * 64 + c], rk_c = cst_s[4 * 64 + c];
#pragma unroll
            for (int s = 0; s < 4; ++s) {
                const int tl = tg * 4 + s;
                const float w_log = -softplusf_(-(w0 + w_s[tl * 64 + c])) - 0.5f;
                const float decay = fexp_(-fexp_(w_log));
                const float a = sigmoidf_(a0 + ka_s[tl * 64 + c]);
                const float kx = k_s[tl * 64 + c], rx = r_s[tl * 64 + c];
                const float kkr = kx * k_k, k2 = kx * (1.0f + (a - 1.0f) * k_a);
                const float nsq = group_sum(kkr * kkr, 64, scr);
                const float bon = group_sum(rx * k2 * rk_c, 64, scr);
                const float kkn = kkr * rsqrtf(nsq + RMS_EPS);
                w_s[tl * 64 + c] = decay; k_s[tl * 64 + c] = k2; kk_s[tl * 64 + c] = kkn; ka_s[tl * 64 + c] = kkn * a;
                if (c == 0) bon_s[tl] = bon;
            }
            }
            __syncthreads();
            RW_ROLES();
            {
                struct StepVec { float4 kk0, kk1, w0, w1, a0, a1, k0, k1, r0, r1; float vi; };
#define RW_LDSTEP(V_, t_) do { const int o8_ = (t_) * 64 + q8 * 8; V_.kk0 = *(const float4*)(kk_s + o8_); V_.kk1 = *(const float4*)(kk_s + o8_ + 4); V_.w0 = *(const float4*)(w_s + o8_); V_.w1 = *(const float4*)(w_s + o8_ + 4); \
                    V_.a0 = *(const float4*)(ka_s + o8_); V_.a1 = *(const float4*)(ka_s + o8_ + 4); V_.k0 = *(const float4*)(k_s + o8_); V_.k1 = *(const float4*)(k_s + o8_ + 4); \
                    V_.r0 = *(const float4*)(r_s + o8_); V_.r1 = *(const float4*)(r_s + o8_ + 4); V_.vi = v_s[(t_) * 64 + ri]; } while (0)
#define RW_STEP(V_, t_) do { \
                    const float pk = (S[0] * V_.kk0.x + S[1] * V_.kk0.y) + (S[2] * V_.kk0.z + S[3] * V_.kk0.w) + ((S[4] * V_.kk1.x + S[5] * V_.kk1.y) + (S[6] * V_.kk1.z + S[7] * V_.kk1.w)); \
                    const float skk = group_sum(pk, 8, scr); const float vi = V_.vi; \
                    S[0] = S[0] * V_.w0.x - skk * V_.a0.x + vi * V_.k0.x; S[1] = S[1] * V_.w0.y - skk * V_.a0.y + vi * V_.k0.y; S[2] = S[2] * V_.w0.z - skk * V_.a0.z + vi * V_.k0.z; S[3] = S[3] * V_.w0.w - skk * V_.a0.w + vi * V_.k0.w; \
                    S[4] = S[4] * V_.w1.x - skk * V_.a1.x + vi * V_.k1.x; S[5] = S[5] * V_.w1.y - skk * V_.a1.y + vi * V_.k1.y; S[6] = S[6] * V_.w1.z - skk * V_.a1.z + vi * V_.k1.z; S[7] = S[7] * V_.w1.w - skk * V_.a1.w + vi * V_.k1.w; \
                    const float po = (S[0] * V_.r0.x + S[1] * V_.r0.y) + (S[2] * V_.r0.z + S[3] * V_.r0.w) + ((S[4] * V_.r1.x + S[5] * V_.r1.y) + (S[6] * V_.r1.z + S[7] * V_.r1.w)); \
                    const float o = group_sum(po, 8, scr); \
                    if (q8 == 0) o_s[(t_) * 64 + ri] = o; } while (0)
                StepVec va, vb;
                RW_LDSTEP(va, 0);
#pragma unroll 1
                for (int t = 0; t < CH; t += 2) {
                    RW_LDSTEP(vb, t + 1);
                    RW_STEP(va, t);
                    if (t + 2 < CH) RW_LDSTEP(va, t + 2);
                    RW_STEP(vb, t + 1);
                }
#undef RW_LDSTEP
#undef RW_STEP
            }
            if (t0 + CH < T_) RW_LOAD(t0 + CH);
            __syncthreads();
            RW_ROLES();
            {
            const float lnw = cst_s[5 * 64 + c], lnb = cst_s[6 * 64 + c];
            const int ch = h * 64 + c;
#pragma unroll
            for (int s = 0; s < 4; ++s) {
                const int tl = tg * 4 + s;
                const float ov = o_s[tl * 64 + c];
                const float mean = group_sum(ov, 64, scr) * (1.0f / 64.0f);
                const float d = ov - mean;
                const float var = group_sum(d * d, 64, scr) * (1.0f / 64.0f);
                const float y = (d * rsqrtf(var + GN_EPS) * lnw + lnb + bon_s[tl] * v_s[tl * 64 + c]) * g_s[tl * 64 + c];
                ACT[((size_t)b * T_ + t0 + tl) * LDZ + C_YC + ch] = f2h(y);
            }
            }
            __syncthreads();
            RW_ROLES();
            if (t0 + CH < T_) RW_PUT();
            __syncthreads();
        }
#undef RW_LOAD
#undef RW_PUT
#undef RW_ROLES
    }
}

constexpr bool TAB_IN_ACT = (M_ == 16384);
constexpr float TAB_SU = 256.0f, TAB_SV = 32.0f;
__device__ __forceinline__ unsigned char* tab_row(char* ws, int e) {
    if (TAB_IN_ACT) return (unsigned char*)((h16_t*)(ws + OFF_ACT) + (size_t)e * LDZ + C_GS);
    return (unsigned char*)(ws + OFF_TAB) + (size_t)e * 2048;
}
#ifdef CPU_EMU
__device__ __forceinline__ unsigned f2fp8(float f) {
    const unsigned sgn = f < 0.f ? 0x80u : 0u; float a = fabsf(f);
    if (!(a == a)) return 0x7fu;
    if (a >= 448.0f) return sgn | 0x7eu;
    if (a < 0.0009765625f) return sgn;
    int e; frexpf(a, &e); e -= 1;
    if (e < -6) { const float q = nearbyintf(a * 512.0f); return sgn | (unsigned)q; }
    float q = nearbyintf((a / ldexpf(1.0f, e) - 1.0f) * 8.0f);
    if (q >= 8.0f) { q = 0.f; e += 1; }
    if (e > 8) return sgn | 0x7eu;
    const unsigned r = ((unsigned)(e + 7) << 3) | (unsigned)q;
    return sgn | (r > 0x7eu ? 0x7eu : r);
}
__device__ __forceinline__ float fp82f(unsigned b) {
    const unsigned e = (b >> 3) & 15u, m = b & 7u; const float s = (b & 0x80u) ? -1.f : 1.f;
    if (e == 0) return s * (float)m * 0.001953125f;
    return s * ldexpf(1.0f + (float)m * 0.125f, (int)e - 7);
}
__device__ __forceinline__ unsigned pack4fp8(float a, float b, float c, float d) { return f2fp8(a) | (f2fp8(b) << 8) | (f2fp8(c) << 16) | (f2fp8(d) << 24); }
__device__ __forceinline__ void dec4fp8(unsigned w, float* o) { o[0] = fp82f(w & 255u); o[1] = fp82f((w >> 8) & 255u); o[2] = fp82f((w >> 16) & 255u); o[3] = fp82f(w >> 24); }
#else
__device__ __forceinline__ unsigned pack4fp8(float a, float b, float c, float d) { int p = __builtin_amdgcn_cvt_pk_fp8_f32(a, b, 0, false); p = __builtin_amdgcn_cvt_pk_fp8_f32(c, d, p, true); return (unsigned)p; }
__device__ __forceinline__ void dec4fp8(unsigned w, float* o) { const auto lo = __builtin_amdgcn_cvt_pk_f32_fp8((int)w, false); const auto hi = __builtin_amdgcn_cvt_pk_f32_fp8((int)w, true); o[0] = lo[0]; o[1] = lo[1]; o[2] = hi[0]; o[3] = hi[1]; }
#endif
__device__ __forceinline__ void stage_tabconv(KParams p, int l) {
    const int tid = tid_();
    const float* U = p->in[I_PU] + (size_t)l * 16384 * 1024; const float* V = p->in[I_PV] + (size_t)l * 16384 * 1024;
    char* ws = p->ws;
    for (int it = bid_() * NT + tid; it < 16384 * 128; it += gridDim.x * NT) {
        const int r = it >> 7, ck = it & 127, which = ck >> 6, c16 = ck & 63;
        const float* src = (which ? V : U) + (size_t)r * 1024 + c16 * 16;
        const float sc = which ? TAB_SV : TAB_SU;
        const float4 a = *(const float4*)src, b = *(const float4*)(src + 4), c = *(const float4*)(src + 8), d = *(const float4*)(src + 12);
        uint4 w;
        w.x = pack4fp8(a.x * sc, a.y * sc, a.z * sc, a.w * sc); w.y = pack4fp8(b.x * sc, b.y * sc, b.z * sc, b.w * sc);
        w.z = pack4fp8(c.x * sc, c.y * sc, c.z * sc, c.w * sc); w.w = pack4fp8(d.x * sc, d.y * sc, d.z * sc, d.w * sc);
        *(uint4*)(tab_row(ws, r) + which * 1024 + c16 * 16) = w;
    }
}

#ifdef CPU_EMU
__device__ __forceinline__ float group_max16(float v, float* scr) {
    const int tid = tid_();
    scr[tid] = v;
    __syncthreads();
    float m = -3.0e38f; const int base = tid & ~15;
    for (int i = 0; i < 16; ++i) m = fmaxf(m, scr[base + i]);
    __syncthreads();
    return m;
}
#else
__device__ __forceinline__ float group_max16(float v, float*) {
    v = fmaxf(v, dpp_f<0xB1>(v)); v = fmaxf(v, dpp_f<0x4E>(v)); v = fmaxf(v, dpp_f<0x141>(v)); v = fmaxf(v, dpp_f<0x140>(v));
    return v;
}
#endif
__device__ __forceinline__ void stage_peer_topk(KParams p, int l, char* smem) {
    constexpr int KS = 136;
    h16_t* khi = (h16_t*)smem;
    h16_t* klo = khi + 128 * KS;
    float* scr = (float*)(klo + 128 * KS);
    const h16_t* ACT = (const h16_t*)(p->ws + OFF_ACT);
    float* TOPS = (float*)(p->ws + OFF_TOPS);
    int tid = tid_(), lane = tid & 63, w = tid >> 6, g = lane >> 4, r16 = lane & 15;
#define TK_ROLES() do { tid = tid_(); lane = tid & 63; w = tid >> 6; g = lane >> 4; r16 = lane & 15; } while (0)
    const int nb = gridDim.x;
    for (int hs = bid_() % 16; hs < 16; hs += nb) {
        const int hd = hs >> 1, s = hs & 1;
        __syncthreads();
        {
            const float* kp = p->in[I_PKEYS] + (((size_t)l * 8 + hd) * 2 + s) * 128 * 128;
            for (int i = tid * 4; i < 128 * 128; i += NT * 4) {
                const float4 kv = *(const float4*)(kp + i);
                const int n = i >> 7, c0 = i & 127;
                const float h0 = h2f(f2h(kv.x)), h1 = h2f(f2h(kv.y)), h2 = h2f(f2h(kv.z)), h3 = h2f(f2h(kv.w));
                uint2 hw, lw; hw.x = pack2h(kv.x, kv.y); hw.y = pack2h(kv.z, kv.w); lw.x = pack2h(kv.x - h0, kv.y - h1); lw.y = pack2h(kv.z - h2, kv.w - h3);
                *(uint2*)(khi + n * KS + c0) = hw; *(uint2*)(klo + n * KS + c0) = lw;
            }
        }
        __syncthreads();
        const int nblk = nb >= 16 ? nb / 16 : 1, bsub = nb >= 16 ? bid_() / 16 : 0;
        for (int chunk = bsub; chunk < (M_ + NT - 1) / NT; chunk += nblk) {
            if (nb >= 16 && bid_() >= nblk * 16) break;
#pragma unroll 1
            for (int tt = 0; tt < 4; ++tt) {
                TK_ROLES();
                const int tok0 = chunk * NT + w * 64 + tt * 16;
                const bool live = tok0 < M_;
                hfrag af[4];
                {
                    const h16_t* qp = ACT + (size_t)(live ? tok0 + r16 : 0) * LDZ + C_QRY + hd * 256 + s * 128 + 8 * g;
#pragma unroll
                    for (int ks = 0; ks < 4; ++ks) af[ks] = frag_u4(*(const uint4*)(qp + 32 * ks));
                }
                facc acc[8];
#pragma unroll
                for (int nt = 0; nt < 8; ++nt) {
                    acc[nt] = facc_zero();
                    const h16_t* bh = khi + (16 * nt + r16) * KS + 8 * g; const h16_t* bl = klo + (16 * nt + r16) * KS + 8 * g;
#pragma unroll
                    for (int ks = 0; ks < 4; ++ks) { acc[nt] = mfma16(af[ks], frag_u4(*(const uint4*)(bh + 32 * ks)), acc[nt]); acc[nt] = mfma16(af[ks], frag_u4(*(const uint4*)(bl + 32 * ks)), acc[nt]); }
                }
#pragma unroll 1
                for (int rp = 0; rp < 2; ++rp) {
                  TK_ROLES();
#pragma unroll
                  for (int r2 = 0; r2 < 2; ++r2) {
                    const int reg = rp * 2 + r2;
                    float v[8];
#pragma unroll
                    for (int nt = 0; nt < 8; ++nt) { const float av = rp == 0 ? (r2 == 0 ? acc[nt][0] : acc[nt][1]) : (r2 == 0 ? acc[nt][2] : acc[nt][3]); v[nt] = __uint_as_float((__float_as_uint(av) & ~127u) | (unsigned)(127 - (16 * nt + r16))); }
#define CE(i, j) { const float hi_ = fmaxf(v[i], v[j]), lo_ = fminf(v[i], v[j]); v[i] = hi_; v[j] = lo_; }
                    CE(0, 1) CE(2, 3) CE(4, 5) CE(6, 7) CE(0, 2) CE(1, 3) CE(4, 6) CE(5, 7) CE(1, 2) CE(5, 6) CE(0, 4) CE(1, 5) CE(2, 6) CE(3, 7) CE(2, 4) CE(3, 5) CE(1, 2) CE(3, 4) CE(5, 6)
#undef CE
                    float res = 0.f;
#pragma unroll
                    for (int rnd = 0; rnd < 16; ++rnd) {
                        const float m = group_max16(v[0], scr);
                        const bool win = v[0] == m;
#pragma unroll
                        for (int i = 0; i < 7; ++i) v[i] = win ? v[i + 1] : v[i];
                        v[7] = win ? -3.0e38f : v[7];
                        res = (r16 == rnd) ? m : res;
                    }
                    if (live) TOPS[(((size_t)(tok0 + 4 * g + reg) * 8 + hd) * 2 + s) * 16 + r16] = res;
                  }
                }
            }
        }
    }
}

#undef TK_ROLES
__device__ __forceinline__ void peer_cand(int k, int& i, int& j) {
    if (k < 16) { i = 0; j = k; } else if (k < 24) { i = 1; j = k - 16; } else if (k < 29) { i = 2; j = k - 24; } else if (k < 33) { i = 3; j = k - 29; }
    else if (k < 36) { i = 4; j = k - 33; } else if (k < 38) { i = 5; j = k - 36; } else if (k < 40) { i = 6; j = k - 38; } else if (k < 42) { i = 7; j = k - 40; }
    else { i = k - 34; j = 0; }
}
__device__ __forceinline__ float dot16q(const uint4 a, const float (&x)[16]) {
    float t[4], s0, s1;
    dec4fp8(a.x, t); s0 = t[0] * x[0] + t[1] * x[1]; s1 = t[2] * x[2] + t[3] * x[3];
    dec4fp8(a.y, t); s0 += t[0] * x[4] + t[1] * x[5]; s1 += t[2] * x[6] + t[3] * x[7];
    dec4fp8(a.z, t); s0 += t[0] * x[8] + t[1] * x[9]; s1 += t[2] * x[10] + t[3] * x[11];
    dec4fp8(a.w, t); s0 += t[0] * x[12] + t[1] * x[13]; s1 += t[2] * x[14] + t[3] * x[15];
    return s0 + s1;
}
__device__ __forceinline__ void axpy16q(const uint4 a, float s, float (&y)[16]) {
    float t[4];
    dec4fp8(a.x, t); y[0] += s * t[0]; y[1] += s * t[1]; y[2] += s * t[2]; y[3] += s * t[3];
    dec4fp8(a.y, t); y[4] += s * t[0]; y[5] += s * t[1]; y[6] += s * t[2]; y[7] += s * t[3];
    dec4fp8(a.z, t); y[8] += s * t[0]; y[9] += s * t[1]; y[10] += s * t[2]; y[11] += s * t[3];
    dec4fp8(a.w, t); y[12] += s * t[0]; y[13] += s * t[1]; y[14] += s * t[2]; y[15] += s * t[3];
}
#ifdef CPU_EMU
__device__ __forceinline__ float lane_xor(float v, int mask, float* scr) { const int tid = tid_(); scr[tid] = v; __syncthreads(); const float r = scr[tid ^ mask]; __syncthreads(); return r; }
__device__ __forceinline__ float lane_bcast(float v, int src, float* scr) { const int tid = tid_(); scr[tid] = v; __syncthreads(); const float r = scr[(tid & ~63) + src]; __syncthreads(); return r; }
#else
__device__ __forceinline__ float lane_xor(float v, int mask, float*) { return mask == 1 ? dpp_f<0xB1>(v) : (mask == 2 ? dpp_f<0x4E>(v) : __shfl_xor(v, mask)); }
__device__ __forceinline__ float lane_bcast(float v, int src, float*) { return __builtin_bit_cast(float, __builtin_amdgcn_readlane(__builtin_bit_cast(int, v), src)); }
#endif
__device__ __forceinline__ float reduce8(const float (&v)[8], int lane, float* scr) {
    const bool b0 = lane & 1, b1 = lane & 2, b2 = lane & 4;
    float w4[4], u2[2];
#pragma unroll
    for (int j = 0; j < 4; ++j) { const float keep = b0 ? v[2 * j + 1] : v[2 * j], send = b0 ? v[2 * j] : v[2 * j + 1]; w4[j] = keep + lane_xor(send, 1, scr); }
#pragma unroll
    for (int j = 0; j < 2; ++j) { const float keep = b1 ? w4[2 * j + 1] : w4[2 * j], send = b1 ? w4[2 * j] : w4[2 * j + 1]; u2[j] = keep + lane_xor(send, 2, scr); }
    float z = (b2 ? u2[1] : u2[0]) + lane_xor(b2 ? u2[0] : u2[1], 4, scr);
    z += lane_xor(z, 8, scr); z += lane_xor(z, 16, scr); z += lane_xor(z, 32, scr);
    return z;
}
__device__ __forceinline__ void stage_peer_gather(KParams p, int l, char* smem) {
    int tid = tid_(), w = tid >> 6, lane = tid & 63;
    float* base; float* tops_s; float* cand_s; float* best_s; int* idx_s; float* gate_s; int* pos_s;
#define PG_ROLES() do { tid = tid_(); w = tid >> 6; lane = tid & 63; base = (float*)smem + w * 2048; tops_s = base; cand_s = tops_s + 256; best_s = cand_s + 64; \
        idx_s = (int*)(best_s + 128); gate_s = (float*)(idx_s + 128); pos_s = (int*)(gate_s + 128); } while (0)
    PG_ROLES();
    float* scr = (float*)smem + 8 * 2048;
    h16_t* ACT = (h16_t*)(p->ws + OFF_ACT);
    const float* TOPS = (const float*)(p->ws + OFF_TOPS);
    char* ws = p->ws;
    const float* nxt_w = (l + 1 < NL_) ? p->in[I_NMIX] + (l + 1) * 1024 : p->in[I_NFINAL];
    const int nwaves = gridDim.x * 8;
    for (int m = bid_() * 8 + w; m < M_; m += nwaves) {
        PG_ROLES();
        __syncthreads();
        *(float4*)(tops_s + lane * 4) = *(const float4*)(TOPS + (size_t)m * 256 + lane * 4);
        float x[16];
        { float t8[8]; load8h(ACT + (size_t)m * LDZ + C_XN + lane * 16, t8);
#pragma unroll
          for (int j = 0; j < 8; ++j) x[j] = t8[j];
          load8h(ACT + (size_t)m * LDZ + C_XN + lane * 16 + 8, t8);
#pragma unroll
          for (int j = 0; j < 8; ++j) x[8 + j] = t8[j]; }
        __syncthreads();
        int ci = 0, cj = 0;
        if (lane < 50) peer_cand(lane, ci, cj);
        const int pos = ci * 16 + cj;
        pos_s[lane] = pos;
#pragma unroll 1
        for (int hd = 0; hd < 8; ++hd) {
            const float cs = lane < 50 ? tops_s[hd * 32 + ci] + tops_s[hd * 32 + 16 + cj] : -3.0e38f;
            cand_s[lane] = cs;
            __syncthreads();
            if (lane < 50) {
                int cnt = 0;
#pragma unroll 10
                for (int o = 0; o < 50; ++o) { const float ov = cand_s[o]; cnt += (ov > cs || (ov == cs && pos_s[o] < pos)) ? 1 : 0; }
                if (cnt < 16) {
                    best_s[hd * 16 + cnt] = cs;
                    const int n0 = 127 - (int)(__float_as_uint(tops_s[hd * 32 + ci]) & 127u), n1 = 127 - (int)(__float_as_uint(tops_s[hd * 32 + 16 + cj]) & 127u);
                    idx_s[hd * 16 + cnt] = n0 * 128 + n1;
                }
            }
            __syncthreads();
        }
#pragma unroll
        for (int rr = 0; rr < 2; ++rr) {
            const int e = lane + 64 * rr, hd = e >> 4;
            const float mx = best_s[hd * 16];
            float sum = 0.f;
#pragma unroll
            for (int i = 0; i < 16; ++i) sum += fexp_(best_s[hd * 16 + i] - mx);
            gate_s[e] = fexp_(best_s[e] - mx) / sum;
        }
        __syncthreads();
        float y[16];
#pragma unroll
        for (int i = 0; i < 16; ++i) y[i] = 0.f;
        PG_ROLES();
        uint4 uu[8], vv[8];
#define PG_LOADU(eb_) do { _Pragma("unroll") for (int k = 0; k < 8; ++k) uu[k] = *(const uint4*)(tab_row(ws, idx_s[(eb_) + k]) + lane * 16); } while (0)
#define PG_LOADV(eb_) do { _Pragma("unroll") for (int k = 0; k < 8; ++k) vv[k] = *(const uint4*)(tab_row(ws, idx_s[(eb_) + k]) + 1024 + lane * 16); } while (0)
        PG_LOADU(0); PG_LOADV(0);
#pragma unroll 1
        for (int eb = 0; eb < 128; eb += 8) {
            float d8[8];
#pragma unroll
            for (int k = 0; k < 8; ++k) d8[k] = dot16q(uu[k], x);
            if (eb + 8 < 128) PG_LOADU(eb + 8);
            const float tot = reduce8(d8, lane, scr);
            const float hk = gate_s[eb + (lane & 7)] * geluf_(tot * (1.0f / TAB_SU));
#pragma unroll
            for (int k = 0; k < 8; ++k) axpy16q(vv[k], lane_bcast(hk, k, scr), y);
            if (eb + 8 < 128) PG_LOADV(eb + 8);
        }
#undef PG_LOADU
#undef PG_LOADV
        PG_ROLES();
        float* op = p->out + (size_t)m * 1024 + lane * 16;
        float hn[16]; float ss = 0.f;
#pragma unroll
        for (int i = 0; i < 16; i += 4) {
            const float4 o4 = *(const float4*)(op + i);
            hn[i] = o4.x + y[i] * (1.0f / TAB_SV); hn[i + 1] = o4.y + y[i + 1] * (1.0f / TAB_SV); hn[i + 2] = o4.z + y[i + 2] * (1.0f / TAB_SV); hn[i + 3] = o4.w + y[i + 3] * (1.0f / TAB_SV);
            ss += hn[i] * hn[i] + hn[i + 1] * hn[i + 1] + hn[i + 2] * hn[i + 2] + hn[i + 3] * hn[i + 3];
        }
        ss = group_sum(ss, 64, scr);
        const float rstd = rsqrtf(ss * (1.0f / D_) + RMS_EPS);
        float nv[16];
#pragma unroll
        for (int i = 0; i < 16; i += 4) { const float4 w4 = *(const float4*)(nxt_w + lane * 16 + i); nv[i] = hn[i] * rstd * w4.x; nv[i + 1] = hn[i + 1] * rstd * w4.y; nv[i + 2] = hn[i + 2] * rstd * w4.z; nv[i + 3] = hn[i + 3] * rstd * w4.w; }
        if (l + 1 < NL_) {
#pragma unroll
            for (int i = 0; i < 16; i += 4) *(float4*)(op + i) = make_float4(hn[i], hn[i + 1], hn[i + 2], hn[i + 3]);
            const float n0[8] = {nv[0], nv[1], nv[2], nv[3], nv[4], nv[5], nv[6], nv[7]}, n1[8] = {nv[8], nv[9], nv[10], nv[11], nv[12], nv[13], nv[14], nv[15]};
            store8h(ACT + (size_t)m * LDZ + C_XN + lane * 16, n0); store8h(ACT + (size_t)m * LDZ + C_XN + lane * 16 + 8, n1);
        } else {
#pragma unroll
            for (int i = 0; i < 16; i += 4) *(float4*)(op + i) = make_float4(nv[i], nv[i + 1], nv[i + 2], nv[i + 3]);
        }
    }
}
#undef PG_ROLES

enum { PH_NORM_MIX = 0, PH_INPROJ, PH_MIXERS, PH_MERGE, PH_WOUT, PH_NORM_FFN, PH_QUERY, PH_TOPK, PH_GATHER, PH_PER_LAYER, PH_FINAL = 100, PH_WPREP = 101 };
__device__ __forceinline__ void run_phase(KParams p, int l, int ph, char* smem) {
    h16_t* ACT = (h16_t*)(p->ws + OFF_ACT);
    const float* hin = l == 0 ? p->in[I_X] : p->out;
    switch (ph) {
    case PH_WPREP: stage_wprep(p, smem); break;
    case PH_NORM_MIX: if (l == 0) stage_rmsnorm<false>(hin, p->in[I_NMIX] + l * 1024, ACT + C_XN, LDZ, smem); break;
    case PH_INPROJ: stage_gemm(p, l, GP_INPROJ, smem); break;
    case PH_MIXERS: {
        const int nb = gridDim.x, n_rw = nb / 2, n_gd = nb / 4, n_lr = nb - n_rw - n_gd;
        stage_rwkv(p, l, smem, 0, n_rw);
        stage_gdn(p, l, smem, n_rw, n_gd);
        stage_lru(p, l, smem, n_rw + n_gd, n_lr);
    } break;
    case PH_MERGE: stage_gemm(p, l, GP_MERGE, smem); break;
    case PH_WOUT: stage_gemm(p, l, GP_WOUT, smem); break;
    case PH_NORM_FFN: stage_rmsnorm<false>(p->out, p->in[I_NFFN] + l * 1024, ACT + C_XN, LDZ, smem); stage_tabconv(p, l); break;
    case PH_QUERY: stage_gemm(p, l, GP_QUERY, smem); break;
    case PH_TOPK: stage_peer_topk(p, l, smem); break;
    case PH_GATHER: stage_peer_gather(p, l, smem); break;
    case PH_FINAL: break;
    default: break;
    }
}


#if !defined(CPU_EMU) && !MK_MULTI
#define XB_TMO      128
#define XB_XCNT(j)  (256  + 64 * (j))
#define XB_XSUB(j)  (1280 + 64 * (j))
#define XB_XGEN(j)  (2304 + 64 * (j))
#define XB_TOP      3328
#define XB_TOPGEN   3392
#define XCD_BAR_WORDS 3456
#define XB_SPIN_CAP (1u << 22)
#define XB_LAS __attribute__((address_space(3)))
__device__ __forceinline__ unsigned xb_ld(unsigned* p)              { return __hip_atomic_load(p, __ATOMIC_RELAXED, __HIP_MEMORY_SCOPE_AGENT); }
__device__ __forceinline__ unsigned xb_add(unsigned* p, unsigned v) { return __hip_atomic_fetch_add(p, v, __ATOMIC_RELAXED, __HIP_MEMORY_SCOPE_AGENT); }
__device__ __forceinline__ unsigned xb_xcc_id() { return (unsigned)__builtin_amdgcn_s_getreg((3 << 11) | 20) & 0xFu; }
#define XB_SPIN(cond, bar) do { unsigned _sp = 0; while (cond) { __builtin_amdgcn_s_sleep(1); \
    if ((++_sp & 255u) == 0u) { if (xb_ld(&(bar)[XB_TMO])) break; if (_sp > XB_SPIN_CAP) { atomicAdd(&(bar)[XB_TMO], 1u); break; } } } } while (0)
struct XcdBarrier { unsigned* bar; unsigned x; volatile XB_LAS unsigned* st; };
__device__ __forceinline__ XcdBarrier xcd_barrier_post(unsigned* bar, volatile XB_LAS unsigned* st) {
    XcdBarrier b; b.bar = bar; b.x = xb_xcc_id(); b.st = st;
    if (threadIdx.x == 0) (void)xb_add(&bar[XB_XCNT(b.x)], 1u);
    return b;
}
__device__ __forceinline__ void xcd_barrier_complete(unsigned* bar, unsigned x, unsigned& nloc, unsigned& nx) {
    const unsigned G = gridDim.x * gridDim.y * gridDim.z;
    unsigned sum, cnt, mine, sp = 0u;
    for (;;) {
        sum = 0u; cnt = 0u; mine = 0u;
#pragma unroll
        for (unsigned j = 0; j < 16; ++j) { const unsigned c = xb_ld(&bar[XB_XCNT(j)]); sum += c; cnt += (c > 0u) ? 1u : 0u; mine = (j == x) ? c : mine; }
        if (sum == G) break;
        __builtin_amdgcn_s_sleep(1);
        if ((++sp & 255u) == 0u) { if (xb_ld(&bar[XB_TMO])) break; if (sp > XB_SPIN_CAP) { atomicAdd(&bar[XB_TMO], 1u); break; } }
    }
    nloc = mine > 0u ? mine : 1u; nx = cnt > 0u ? cnt : 1u;
}
__device__ __forceinline__ void xcd_barrier(const XcdBarrier& b) {
    asm volatile("s_waitcnt vmcnt(0)" ::: "memory");
    __syncthreads();
    if (threadIdx.x == 0) {
        unsigned* bar = b.bar;
        __builtin_amdgcn_s_waitcnt(0);
        unsigned nloc = b.st[0], nx = b.st[1];
        if (nloc == 0u) { xcd_barrier_complete(bar, b.x, nloc, nx); b.st[0] = nloc; b.st[1] = nx; }
        const unsigned old = xb_add(&bar[XB_XSUB(b.x)], 1u);
        const unsigned gen = old / nloc;
        if (old + 1u == (gen + 1u) * nloc) {
            __builtin_amdgcn_fence(__ATOMIC_RELEASE, "agent");
            asm volatile("s_waitcnt vmcnt(0)" ::: "memory");
            const unsigned og = xb_add(&bar[XB_TOP], 1u);
            const unsigned tg = og / nx;
            if (og + 1u == (tg + 1u) * nx) xb_add(&bar[XB_TOPGEN], 1u);
            else XB_SPIN(xb_ld(&bar[XB_TOPGEN]) == tg, bar);
            __builtin_amdgcn_fence(__ATOMIC_ACQUIRE, "agent");
            xb_add(&bar[XB_XGEN(b.x)], 1u);
            asm volatile("s_waitcnt vmcnt(0)" ::: "memory");
        } else {
            XB_SPIN(xb_ld(&bar[XB_XGEN(b.x)]) == gen, bar);
            __builtin_amdgcn_fence(__ATOMIC_ACQUIRE, "agent");
            asm volatile("s_waitcnt vmcnt(0)" ::: "memory");
        }
    }
    __syncthreads();
}
#endif
#if !defined(CPU_EMU) && !MK_MULTI
__global__ void __launch_bounds__(512, 2) k_mega(Params p_) {
    DYN_SMEM(smem);
    KParams pk = (KParams)__builtin_amdgcn_kernarg_segment_ptr();
    cg::grid_group grid = cg::this_grid();
    volatile XB_LAS unsigned* xst = (volatile XB_LAS unsigned*)(XB_LAS char*)(smem + SMEM_BYTES);
    if (threadIdx.x == 0) { xst[0] = 0u; xst[1] = 0u; xst[2] = 0u; xst[3] = 0u; }
    __syncthreads();
    const XcdBarrier xb = xcd_barrier_post((unsigned*)(pk->ws + OFF_BAR), xst);
    bool first_sync = true;
    constexpr int NIT = NL_ * PH_PER_LAYER;
#pragma unroll 1
    for (int it = -1; it <= NIT; ++it) {
        const int l = (it >= 0 && it < NIT) ? it / PH_PER_LAYER : 0, ph = it < 0 ? (int)PH_WPREP : (it < NIT ? it % PH_PER_LAYER : (int)PH_FINAL);
        KParams q = pk; asm volatile("" : "+s"(q));
        run_phase(q, l, ph, smem);
        if (it >= 0 && it < NIT - 1 && !(l > 0 && ph == PH_NORM_MIX)) {
            if (first_sync) { grid.sync(); first_sync = false; }
            else xcd_barrier(xb);
        }
    }
}
#endif
#ifdef CPU_EMU
__global__ void k_phase(Params p_, int l, int ph) { DYN_SMEM(smem); run_phase(&p_, l, ph, smem); }
#elif MK_MULTI
__global__ void __launch_bounds__(512, 2) k_phase(Params p_, int l, int ph) { DYN_SMEM(smem); KParams pk = (KParams)__builtin_amdgcn_kernarg_segment_ptr(); run_phase(pk, l, ph, smem); }
#endif
}

#ifdef CPU_EMU
int g_emu_stop = 1000;
#endif

extern "C" void kernel_launch(void* const* d_in, const int* in_sizes, int n_in, void* d_out, int out_size, void* d_ws, size_t ws_size, hipStream_t stream) {
    Params p{};
    for (int i = 0; i < N_IN; ++i) p.in[i] = (const float*)d_in[i];
    p.out = (float*)d_out; p.ws = (char*)d_ws;
#if defined(CPU_EMU) || MK_MULTI
    const int grid = 256;
    LAUNCH(k_phase, grid, NT, SMEM_BYTES, stream, p, 0, (int)PH_WPREP);
    for (int l = 0; l < NL_; ++l)
        for (int ph = 0; ph < PH_PER_LAYER; ++ph) {
            LAUNCH(k_phase, grid, NT, SMEM_BYTES, stream, p, l, ph);
#ifdef CPU_EMU
            const int code = ph == PH_INPROJ ? 1 : ph == PH_MIXERS ? 2 : ph == PH_MERGE ? 3 : ph == PH_WOUT ? 4 : ph == PH_GATHER ? 5 : 0;
            if (code && g_emu_stop == l * 10 + code) return;
#endif
        }
    LAUNCH(k_phase, grid, NT, SMEM_BYTES, stream, p, 0, (int)PH_FINAL);
#else
    static int grid_blocks = 0;
    if (!grid_blocks) {
        int dev = 0, cus = 0, per_cu = 0;
        (void)hipGetDevice(&dev);
        (void)hipDeviceGetAttribute(&cus, hipDeviceAttributeMultiprocessorCount, dev);
        (void)hipFuncSetAttribute((const void*)k_mega, hipFuncAttributeMaxDynamicSharedMemorySize, (int)SMEM_BYTES + 16);
        (void)hipOccupancyMaxActiveBlocksPerMultiprocessor(&per_cu, k_mega, NT, SMEM_BYTES + 16);
        if (per_cu > 1) per_cu = 1;
        grid_blocks = cus * per_cu;
    }
    (void)hipMemsetAsync((char*)d_ws + OFF_BAR, 0, 16384, stream);
    void* args[] = {&p};
    hipError_t e = hipLaunchCooperativeKernel((void*)k_mega, dim3(grid_blocks), dim3(NT), args, SMEM_BYTES + 16, stream);
    if (e != hipSuccess) fprintf(stderr, "cooperative launch failed: %s (grid %d)\n", hipGetErrorString(e), grid_blocks);
#endif
}
```

```cpp
#ifndef CPU_EMU
#include <hip/hip_runtime.h>
#include <hip/hip_cooperative_groups.h>
#include <cstdio>
#include <cstdint>
namespace cg = cooperative_groups;
#define DYN_SMEM(name) extern __shared__ __attribute__((aligned(16))) char name[]
#define LAUNCH(kern, grid, block, smem, stream, ...) hipLaunchKernelGGL(kern, dim3(grid), dim3(block), smem, stream, __VA_ARGS__)
#endif

#ifndef CFG_B
#define CFG_B 8
#endif
#ifndef CFG_T
#define CFG_T 2048
#endif
#ifndef MK_MULTI
#define MK_MULTI 0
#endif

namespace {
constexpr int B_ = CFG_B, T_ = CFG_T, M_ = B_ * T_, D_ = 1024, NL_ = 2, NT = 512;
constexpr int INW = 12560;
constexpr int LDZ = 11776;
constexpr int Z_ULRU = 0, Z_GLRU = 1024, Z_Q = 2048, Z_K = 3072, Z_V = 4096, Z_ZG = 5120, Z_RW = 6144, Z_ALPHA = 9472, Z_BETA = 9480;
constexpr int ZN = 9728;
constexpr int C_XN = 9728, C_YC = 10752;
constexpr int C_YA = Z_GLRU, C_YB = Z_ZG;
constexpr int C_GS = Z_Q, C_MG = Z_K;
constexpr int C_QRY = 0;
constexpr int RW_R = 0, RW_K = 1024, RW_V = 2048, RW_WL = 3072, RW_AL = 3136, RW_GL = 3200, RWW = 3328;
constexpr float RMS_EPS = 1e-6f, GN_EPS = 64e-5f;
typedef unsigned short h16_t;

enum { I_X = 0, I_NMIX, I_NFFN, I_NFINAL, I_WIN, I_LCW, I_LCB, I_LWA, I_LBA, I_LWX, I_LBX, I_LLAM, I_GCW, I_GALOG, I_GDT, I_GNW,
       I_RMU, I_RW0, I_RWUP, I_RA0, I_RAUP, I_RGUP, I_RKK, I_RKA, I_RRK, I_RLW, I_RLB, I_MB, I_PL, I_PG, I_PR, I_WOUT, I_PWQ, I_PKEYS, I_PU, I_PV, N_IN };

struct Params {
    const float* in[N_IN];
    float* out;
    char* ws;
};
#ifdef CPU_EMU
typedef const Params* KParams;
#else
typedef const Params __attribute__((address_space(4)))* KParams;
#endif

constexpr size_t al256(size_t x) { return (x + 255) / 256 * 256; }
constexpr size_t OFF_ACT = 0;
constexpr size_t OFF_WT = al256(OFF_ACT + (size_t)M_ * LDZ * 2);
constexpr int WT_IN = 0, WT_MG = ZN, WT_P = WT_MG + 3072, WT_OUT = WT_P + 3072, WT_Q = WT_OUT + 1024, WT_ROWS = WT_Q + 2048;
constexpr size_t OFF_TOPS = al256(OFF_WT + (size_t)NL_ * WT_ROWS * 1024 * 2);
constexpr size_t OFF_TAB = al256(OFF_TOPS + (size_t)M_ * 256 * 4);
constexpr size_t OFF_BAR = OFF_TAB + (M_ == 16384 ? 0 : (size_t)16384 * 2048);
constexpr size_t WS_END = OFF_BAR + 16384;
static_assert(CFG_B != 8 || CFG_T != 2048 || WS_END <= (size_t)512 * 1024 * 1024, "workspace budget");
constexpr size_t SMEM_BYTES = 128 * 1024;

#ifdef CPU_EMU
__device__ __forceinline__ int tid_() { return threadIdx.x; }
__device__ __forceinline__ h16_t f2h(float f) { return (h16_t)_cvtss_sh(f, _MM_FROUND_TO_NEAREST_INT); }
__device__ __forceinline__ float h2f(h16_t h) { return _cvtsh_ss(h); }
#else
__device__ __forceinline__ int tid_() { int t = threadIdx.x; asm volatile("" : "+v"(t)); return t; }
__device__ __forceinline__ h16_t f2h(float f) { return __builtin_bit_cast(unsigned short, (_Float16)f); }
__device__ __forceinline__ float h2f(h16_t h) { return (float)__builtin_bit_cast(_Float16, h); }
#endif
__device__ __forceinline__ int bid_() { return (int)blockIdx.x; }

#ifdef CPU_EMU
__device__ __forceinline__ float fexp_(float x) { return expf(x); }
__device__ __forceinline__ float flog_(float x) { return logf(x); }
__device__ __forceinline__ float frcp_(float x) { return 1.0f / x; }
#else
__device__ __forceinline__ float fexp_(float x) { return __builtin_amdgcn_exp2f(x * 1.4426950408889634f); }
__device__ __forceinline__ float flog_(float x) { return __builtin_amdgcn_logf(x) * 0.6931471805599453f; }
__device__ __forceinline__ float frcp_(float x) { return __builtin_amdgcn_rcpf(x); }
#endif
__device__ __forceinline__ float sigmoidf_(float x) { return frcp_(1.0f + fexp_(-x)); }
__device__ __forceinline__ float softplusf_(float x) { return fmaxf(x, 0.0f) + flog_(1.0f + fexp_(-fabsf(x))); }
__device__ __forceinline__ float siluf_(float x) { return x * sigmoidf_(x); }
__device__ __forceinline__ float tanhf_(float x) { return 1.0f - 2.0f * frcp_(1.0f + fexp_(2.0f * x)); }
__device__ __forceinline__ float geluf_(float x) { return x * frcp_(1.0f + fexp_(-1.5957691216057308f * (x + 0.044715f * x * x * x))); }
__device__ __forceinline__ unsigned pack2h(float a, float b) { return (unsigned)f2h(a) | ((unsigned)f2h(b) << 16); }
__device__ __forceinline__ void store8h(h16_t* p, const float (&v)[8]) {
    uint4 w; w.x = pack2h(v[0], v[1]); w.y = pack2h(v[2], v[3]); w.z = pack2h(v[4], v[5]); w.w = pack2h(v[6], v[7]);
    *(uint4*)p = w;
}
__device__ __forceinline__ void load8h(const h16_t* p, float (&v)[8]) {
    const uint4 w = *(const uint4*)p;
    v[0] = h2f((h16_t)(w.x & 0xffffu)); v[1] = h2f((h16_t)(w.x >> 16)); v[2] = h2f((h16_t)(w.y & 0xffffu)); v[3] = h2f((h16_t)(w.y >> 16));
    v[4] = h2f((h16_t)(w.z & 0xffffu)); v[5] = h2f((h16_t)(w.z >> 16)); v[6] = h2f((h16_t)(w.w & 0xffffu)); v[7] = h2f((h16_t)(w.w >> 16));
}

__device__ __forceinline__ float block_sum512(float v, float* red) {
    const int tid = tid_();
    red[tid] = v;
    __syncthreads();
    if (tid < 32) { float s = 0.f; for (int i = 0; i < 16; ++i) s += red[tid * 16 + i]; red[512 + tid] = s; }
    __syncthreads();
    float tot = 0.f;
    for (int i = 0; i < 32; ++i) tot += red[512 + i];
    __syncthreads();
    return tot;
}

#ifdef CPU_EMU
__device__ __forceinline__ float wave_sum64(float v, float* scr) {
    const int tid = tid_();
    scr[tid] = v; __syncthreads();
    float s = 0.f; const int base = tid & ~63;
    for (int i = 0; i < 64; ++i) s += scr[base + i];
    __syncthreads();
    return s;
}
#else
__device__ __forceinline__ float wave_sum64(float v, float*) {
    v += __builtin_bit_cast(float, __builtin_amdgcn_mov_dpp(__builtin_bit_cast(int, v), 0xB1, 0xf, 0xf, true));
    v += __builtin_bit_cast(float, __builtin_amdgcn_mov_dpp(__builtin_bit_cast(int, v), 0x4E, 0xf, 0xf, true));
    v += __builtin_bit_cast(float, __builtin_amdgcn_mov_dpp(__builtin_bit_cast(int, v), 0x141, 0xf, 0xf, true));
    v += __builtin_bit_cast(float, __builtin_amdgcn_mov_dpp(__builtin_bit_cast(int, v), 0x140, 0xf, 0xf, true));
    v += __builtin_bit_cast(float, __builtin_amdgcn_update_dpp(0, __builtin_bit_cast(int, v), 0x142, 0xa, 0xf, false));
    v += __builtin_bit_cast(float, __builtin_amdgcn_update_dpp(0, __builtin_bit_cast(int, v), 0x143, 0xc, 0xf, false));
    return __builtin_bit_cast(float, __builtin_amdgcn_readlane(__builtin_bit_cast(int, v), 63));
}
#endif
__device__ __forceinline__ void stage_rmsnorm(const float* src, const float* w, h16_t* dst, int ldd, char* smem) {
    float* scr = (float*)smem;
    const int tid = tid_(), lane = tid & 63, wv = tid >> 6;
    const int nw = gridDim.x * 8;
    float4 wv4[4];
#pragma unroll
    for (int i = 0; i < 4; ++i) wv4[i] = *(const float4*)(w + lane * 16 + i * 4);
    for (int row = bid_() * 8 + wv; row < M_; row += 2 * nw) {
        const int row2 = row + nw; const bool has2 = row2 < M_;
        float4 a[4], b[4];
#pragma unroll
        for (int i = 0; i < 4; ++i) { a[i] = *(const float4*)(src + (size_t)row * D_ + lane * 16 + i * 4); b[i] = has2 ? *(const float4*)(src + (size_t)row2 * D_ + lane * 16 + i * 4) : make_float4(0.f, 0.f, 0.f, 0.f); }
        float sa = 0.f, sb = 0.f;
#pragma unroll
        for (int i = 0; i < 4; ++i) { sa += a[i].x * a[i].x + a[i].y * a[i].y + a[i].z * a[i].z + a[i].w * a[i].w; sb += b[i].x * b[i].x + b[i].y * b[i].y + b[i].z * b[i].z + b[i].w * b[i].w; }
        sa = wave_sum64(sa, scr); sb = wave_sum64(sb, scr);
        const float ra = rsqrtf(sa * (1.0f / D_) + RMS_EPS), rb = rsqrtf(sb * (1.0f / D_) + RMS_EPS);
#pragma unroll
        for (int i = 0; i < 4; i += 2) {
            const float va[8] = {a[i].x * ra * wv4[i].x, a[i].y * ra * wv4[i].y, a[i].z * ra * wv4[i].z, a[i].w * ra * wv4[i].w, a[i + 1].x * ra * wv4[i + 1].x, a[i + 1].y * ra * wv4[i + 1].y, a[i + 1].z * ra * wv4[i + 1].z, a[i + 1].w * ra * wv4[i + 1].w};
            store8h(dst + (size_t)row * ldd + lane * 16 + i * 4, va);
            if (has2) {
                const float vb[8] = {b[i].x * rb * wv4[i].x, b[i].y * rb * wv4[i].y, b[i].z * rb * wv4[i].z, b[i].w * rb * wv4[i].w, b[i + 1].x * rb * wv4[i + 1].x, b[i + 1].y * rb * wv4[i + 1].y, b[i + 1].z * rb * wv4[i + 1].z, b[i + 1].w * rb * wv4[i + 1].w};
                store8h(dst + (size_t)row2 * ldd + lane * 16 + i * 4, vb);
            }
        }
    }
}

__device__ __forceinline__ const float* wt_src(KParams p, int l, int r, int& ld) {
    if (r < ZN) {
        ld = INW;
        int c;
        if (r < 6144) c = r; else if (r < 9472) c = r + 16; else if (r < 9488) c = r - 3328; else return nullptr;
        return p->in[I_WIN] + (size_t)l * 1024 * INW + c;
    }
    r -= ZN;
    if (r < 3072) { ld = INW; return p->in[I_WIN] + (size_t)l * 1024 * INW + 9488 + r; }
    r -= 3072;
    if (r < 3072) { ld = 1024; const int br = r >> 10; return p->in[br == 0 ? I_PL : (br == 1 ? I_PG : I_PR)] + (size_t)l * 1024 * 1024 + (r & 1023); }
    r -= 3072;
    if (r < 1024) { ld = 1024; return p->in[I_WOUT] + (size_t)l * 1024 * 1024 + r; }
    r -= 1024;
    ld = 2048; return p->in[I_PWQ] + (size_t)l * 1024 * 2048 + r;
}
__device__ __forceinline__ void stage_wprep(KParams p, char* smem) {
    float* tile = (float*)smem;
    h16_t* WT = (h16_t*)(p->ws + OFF_WT);
    const int tid = tid_();
    const int ntr = WT_ROWS / 64, total = NL_ * ntr * 16;
    for (int it = bid_(); it < total; it += gridDim.x) {
        const int l = it / (ntr * 16), rem = it % (ntr * 16), rt = rem / 16, kt = rem % 16;
        const int r0 = rt * 64, k0 = kt * 64;
        __syncthreads();
        {
            const int nn = tid & 63;
            int ld = 0; const float* src = wt_src(p, l, r0 + nn, ld);
#pragma unroll
            for (int i = 0; i < 8; ++i) { const int kk = (tid >> 6) + 8 * i; tile[kk * 65 + nn] = src ? src[(size_t)(k0 + kk) * ld] : 0.f; }
        }
        __syncthreads();
        {
            const int r = tid >> 3, kq = (tid & 7) * 8;
            float v[8];
#pragma unroll
            for (int j = 0; j < 8; ++j) v[j] = tile[(kq + j) * 65 + r];
            store8h(WT + ((size_t)l * WT_ROWS + r0 + r) * 1024 + k0 + kq, v);
        }
    }
}

namespace pg8 {
constexpr int BM = 256, BK = 64, HALF = 128, HTB = HALF * BK * 2, STAGE_BYTES = 8 * HTB, NXCD = 8, WGM = 8;
struct Unit { const char* A; const char* B; int pm, pn, kind; };
#ifdef CPU_EMU
struct f32x4 { float d[4]; float& operator[](int i) { return d[i]; } const float& operator[](int i) const { return d[i]; } };
#else
#define PG8_LAS __attribute__((address_space(3)))
typedef _Float16 f16x8 __attribute__((ext_vector_type(8)));
typedef float f32x4 __attribute__((ext_vector_type(4)));
__device__ __forceinline__ int lds_byte(int r, int c) { const int st = (r >> 4) * 2 + (c >> 5), rr = r & 15, cc = c & 31, ob = rr * 64 + cc * 2; return st * 1024 + (ob ^ (((ob >> 9) & 1) << 5)); }
__device__ __forceinline__ void stage_rc(int b, int& R, int& C) { const int st = b / 1024, sb = b % 1024, swz = sb ^ (((sb >> 9) & 1) << 5); R = (st >> 1) * 16 + swz / 64; C = (st & 1) * 32 + (swz % 64) / 2; }
__device__ __forceinline__ int perm32(int rho) { const int n = rho >> 4, i = rho & 15; return 8 * (i >> 2) + 4 * n + (i & 3); }
#endif
__device__ __forceinline__ void tile_of(int L, int nM, int nN, int& pm, int& pn) {
    const int nwg = nM * nN;
    int wgid = L; { const int q = nwg / NXCD, r = nwg % NXCD, xcd = wgid % NXCD, off = wgid / NXCD; wgid = (xcd < r ? xcd * (q + 1) : r * (q + 1) + (xcd - r) * q) + off; }
    const int nig = WGM * nN, gid = wgid / nig, fm = gid * WGM, gsz = (nM - fm) < WGM ? (nM - fm) : WGM;
    pm = fm + ((wgid % nig) % gsz); pn = (wgid % nig) / gsz;
}

template <class Sched, class Epi>
__device__ __forceinline__ void gemm_phase(char* smem, const Sched& S, const Epi& E) {
    constexpr int K = 1024, nt = K / BK;
    constexpr unsigned lda = LDZ, ldb = 1024;
#ifdef CPU_EMU
    const int tid = tid_(), wid = tid >> 6, lane = tid & 63, wr = wid >> 2, wc = wid & 3, fr = lane & 15, fq = lane >> 4;
    Unit u;
    for (int ui = 0; S.next(ui, u); ++ui) {
        f32x4 acc[2][2][4][2];
        for (int ai = 0; ai < 2; ++ai) for (int bj = 0; bj < 2; ++bj) for (int m = 0; m < 4; ++m) for (int n = 0; n < 2; ++n) for (int e = 0; e < 4; ++e) {
            const int r = 128 * ai + 64 * wr + 16 * m + fr, c = 128 * bj + 32 * wc + 8 * fq + 4 * n + e;
            const h16_t* a = (const h16_t*)u.A + (size_t)r * lda; const h16_t* b = (const h16_t*)u.B + (size_t)c * ldb;
            float s = 0.f;
            for (int k = 0; k < K; ++k) s += h2f(a[k]) * h2f(b[k]);
            acc[ai][bj][m][n][e] = s;
        }
        E(acc, u, wr, wc, fr, fq);
    }
    (void)smem; (void)nt;
#else
    PG8_LAS unsigned char* lds = (PG8_LAS unsigned char*)smem;
    const int tid = tid_(), wid = __builtin_amdgcn_readfirstlane(tid >> 6), lane = tid & 63, wr = wid >> 2, wc = wid & 3, fr = lane & 15, fq = lane >> 4;
    unsigned voffA[2], voffB[2];
#pragma unroll
    for (int i = 0; i < 2; ++i) { int R, C; stage_rc(tid * 16 + i * 8192, R, C); const int Rb = (R & ~31) + perm32(R & 31);
        voffA[i] = (unsigned)(R * lda + C) * 2u; voffB[i] = (unsigned)(Rb * ldb + C) * 2u; }
    constexpr size_t kstep = (size_t)(BK * 2);
    constexpr size_t hstepA = (size_t)HALF * lda * 2, hstepB = (size_t)HALF * ldb * 2;
    const unsigned ldsw = (unsigned)wid * 1024u;
    const int aoff = lds_byte(wr * 64 + fr, fq * 8), boff = lds_byte(wc * 32 + fr, fq * 8);
#define PG8_SA(b, h) (((b) * 2 + (h)) * HTB)
#define PG8_SB(b, h) ((4 + (b) * 2 + (h)) * HTB)
#define PG8_STAGE(bufoff, gbase, voff) do { _Pragma("unroll") for (int _i = 0; _i < 2; ++_i) \
        __builtin_amdgcn_global_load_lds((const unsigned*)((const char*)(gbase) + (voff)[_i]), (PG8_LAS unsigned*)(lds + (bufoff) + ldsw + _i * 8192), 16, 0, 0); } while (0)
#define PG8_LDA(dst, b, h) do { _Pragma("unroll") for (int m = 0; m < 4; ++m) _Pragma("unroll") for (int k = 0; k < 2; ++k) dst[m][k] = *(const PG8_LAS f16x8*)(lds + PG8_SA(b, h) + aoff + m * 2048 + k * 1024); } while (0)
#define PG8_LDB(dst, b, h) do { _Pragma("unroll") for (int n = 0; n < 2; ++n) _Pragma("unroll") for (int k = 0; k < 2; ++k) dst[n][k] = *(const PG8_LAS f16x8*)(lds + PG8_SB(b, h) + boff + n * 2048 + k * 1024); } while (0)
#define PG8_MMA(ai, bj, At, Bt) do { __builtin_amdgcn_s_setprio(1); _Pragma("unroll") for (int m = 0; m < 4; ++m) _Pragma("unroll") for (int n = 0; n < 2; ++n) _Pragma("unroll") for (int k = 0; k < 2; ++k) \
        acc[ai][bj][m][n] = __builtin_amdgcn_mfma_f32_16x16x32_f16(Bt[n][k], At[m][k], acc[ai][bj][m][n], 0, 0, 0); __builtin_amdgcn_s_setprio(0); } while (0)
#define PG8_WAIT_V(n) asm volatile("s_waitcnt vmcnt(" #n ")" ::: "memory")
#define PG8_WAIT_L(n) asm volatile("s_waitcnt lgkmcnt(" #n ")" ::: "memory")
#define PG8_BAR __builtin_amdgcn_s_barrier()
#define PG8_SCHED __builtin_amdgcn_sched_barrier(0)
    Unit cur, nxt; int ui = 0;
    if (!S.next(0, cur)) return;
    f32x4 acc[2][2][4][2];
#pragma unroll
    for (int a = 0; a < 2; ++a)
#pragma unroll
        for (int b = 0; b < 2; ++b)
#pragma unroll
            for (int m = 0; m < 4; ++m)
#pragma unroll
                for (int n = 0; n < 2; ++n) acc[a][b][m][n] = (f32x4){0.f, 0.f, 0.f, 0.f};
    f16x8 At[4][2], B0[2][2], B1[2][2];
    const char* cA = cur.A; const char* cB = cur.B;
    PG8_STAGE(PG8_SB(0, 0), cB, voffB); PG8_STAGE(PG8_SA(0, 0), cA, voffA); PG8_STAGE(PG8_SB(0, 1), cB + hstepB, voffB); PG8_STAGE(PG8_SA(0, 1), cA + hstepA, voffA);
    if (wr == 1) PG8_BAR;
    PG8_WAIT_V(4); PG8_BAR;
    PG8_STAGE(PG8_SB(1, 0), cB + kstep, voffB); PG8_STAGE(PG8_SA(1, 0), cA + kstep, voffA); PG8_STAGE(PG8_SB(1, 1), cB + hstepB + kstep, voffB);
    PG8_WAIT_V(6); PG8_BAR;
    for (;;) {
        const bool has_next = S.next(ui + 1, nxt);
        const char* nA = has_next ? nxt.A : cA; const char* nB = has_next ? nxt.B : cB;
#pragma unroll 1
        for (int t = 0; t < nt; t += 2) {
            const bool last = (t == nt - 2);
            const char* a1 = cA + (size_t)(t + 1) * kstep;
            const char* a2 = last ? nA : cA + (size_t)(t + 2) * kstep; const char* b2 = last ? nB : cB + (size_t)(t + 2) * kstep;
            const char* a3 = a2 + kstep; const char* b3 = b2 + kstep;
            PG8_LDB(B0, 0, 0); PG8_SCHED; PG8_LDA(At, 0, 0); PG8_STAGE(PG8_SA(1, 1), a1 + hstepA, voffA);
            PG8_WAIT_L(8); PG8_BAR; PG8_WAIT_L(0); PG8_MMA(0, 0, At, B0); PG8_BAR; PG8_SCHED;
            PG8_LDB(B1, 0, 1); PG8_STAGE(PG8_SB(0, 0), b2, voffB);
            PG8_BAR; PG8_WAIT_L(0); PG8_MMA(0, 1, At, B1); PG8_BAR;
            PG8_LDA(At, 0, 1); PG8_STAGE(PG8_SA(0, 0), a2, voffA);
            PG8_BAR; PG8_WAIT_L(0); PG8_MMA(1, 0, At, B0); PG8_BAR; PG8_SCHED;
            PG8_STAGE(PG8_SB(0, 1), b2 + hstepB, voffB);
            PG8_WAIT_V(6); PG8_BAR; PG8_MMA(1, 1, At, B1); PG8_BAR;
            PG8_LDB(B0, 1, 0); PG8_SCHED; PG8_LDA(At, 1, 0); PG8_STAGE(PG8_SA(0, 1), a2 + hstepA, voffA);
            PG8_WAIT_L(8); PG8_BAR; PG8_WAIT_L(0); PG8_MMA(0, 0, At, B0); PG8_BAR; PG8_SCHED;
            PG8_LDB(B1, 1, 1); PG8_STAGE(PG8_SB(1, 0), b3, voffB);
            PG8_BAR; PG8_WAIT_L(0); PG8_MMA(0, 1, At, B1); PG8_BAR;
            PG8_LDA(At, 1, 1); PG8_STAGE(PG8_SA(1, 0), a3, voffA);
            PG8_BAR; PG8_WAIT_L(0); PG8_MMA(1, 0, At, B0); PG8_BAR; PG8_SCHED;
            PG8_STAGE(PG8_SB(1, 1), b3 + hstepB, voffB);
            PG8_WAIT_V(6); PG8_BAR; PG8_MMA(1, 1, At, B1); PG8_BAR;
        }
        E(acc, cur, wr, wc, fr, fq);
        if (!has_next) break;
#pragma unroll
        for (int a = 0; a < 2; ++a)
#pragma unroll
            for (int b = 0; b < 2; ++b)
#pragma unroll
                for (int m = 0; m < 4; ++m)
#pragma unroll
                    for (int n = 0; n < 2; ++n) acc[a][b][m][n] = (f32x4){0.f, 0.f, 0.f, 0.f};
        cur = nxt; cA = nA; cB = nB; ++ui;
    }
    PG8_WAIT_V(0);
    if (wr == 0) PG8_BAR;
    PG8_BAR;
#undef PG8_SA
#undef PG8_SB
#undef PG8_STAGE
#undef PG8_LDA
#undef PG8_LDB
#undef PG8_MMA
#undef PG8_WAIT_V
#undef PG8_WAIT_L
#undef PG8_BAR
#undef PG8_SCHED
#endif
}
}

enum { GK_STORE = 0, GK_GATE0, GK_GATE1, GK_GATE2, GK_PROJ0, GK_PROJ1, GK_PROJ2, GK_RESID };
enum { GP_INPROJ = 0, GP_MERGE, GP_WOUT, GP_QUERY };
struct GemmProg {
    const char* act; const char* wt;
    int which, G, c;
    __device__ __forceinline__ bool next(int i, pg8::Unit& u) const {
        constexpr int nM = M_ / 256;
        constexpr size_t rowA = (size_t)256 * LDZ * 2, rowB = (size_t)256 * 1024 * 2;
        if (which == GP_MERGE) {
            const int L = (i / 6) * G + c, j = i % 6, br = j < 3 ? j : j - 3;
            if (L >= nM * 4) return false;
            pg8::tile_of(L, nM, 4, u.pm, u.pn);
            if (j < 3) { u.A = act + (size_t)C_XN * 2; u.B = wt + ((size_t)(WT_MG + br * 1024) * 1024) * 2; u.kind = GK_GATE0 + br; }
            else { u.A = act + (size_t)(br == 0 ? C_YA : (br == 1 ? C_YB : C_YC)) * 2; u.B = wt + ((size_t)(WT_P + br * 1024) * 1024) * 2; u.kind = GK_PROJ0 + br; }
        } else {
            const int nN = which == GP_INPROJ ? ZN / 256 : (which == GP_WOUT ? 4 : 8);
            const int L = i * G + c;
            if (L >= nM * nN) return false;
            pg8::tile_of(L, nM, nN, u.pm, u.pn);
            u.A = act + (size_t)(which == GP_WOUT ? C_MG : C_XN) * 2;
            u.B = wt + ((size_t)(which == GP_INPROJ ? WT_IN : (which == GP_WOUT ? WT_OUT : WT_Q)) * 1024) * 2;
            u.kind = which == GP_WOUT ? GK_RESID : GK_STORE;
        }
        u.A += (size_t)u.pm * rowA; u.B += (size_t)u.pn * rowB;
        return true;
    }
};
__device__ __forceinline__ int gs_slot(int br) { return br == 0 ? C_GS : (br == 1 ? Z_V : Z_ULRU); }
struct GemmEpi {
    h16_t* act; const float* mb; const float* resid; float* out;
    __device__ __forceinline__ void operator()(const pg8::f32x4 (&acc)[2][2][4][2], const pg8::Unit& u, int wr, int wc, int fr, int fq) const {
        const int row0 = u.pm * 256 + wr * 64 + fr, col0 = u.pn * 256 + wc * 32 + 8 * fq;
#pragma unroll
        for (int ai = 0; ai < 2; ++ai)
#pragma unroll
            for (int m = 0; m < 4; ++m) {
                const int row = row0 + ai * 128 + m * 16;
#pragma unroll
                for (int bj = 0; bj < 2; ++bj) {
                    const int col = col0 + bj * 128;
                    float v[8];
#pragma unroll
                    for (int e = 0; e < 4; ++e) { v[e] = acc[ai][bj][m][0][e]; v[4 + e] = acc[ai][bj][m][1][e]; }
                    h16_t* arow = act + (size_t)row * LDZ;
                    if (u.kind == GK_STORE) {
                        store8h(arow + col, v);
                    } else if (u.kind <= GK_GATE2) {
                        const float* bp = mb + (u.kind - GK_GATE0) * 1024 + col;
                        const float4 b0 = *(const float4*)bp, b1 = *(const float4*)(bp + 4);
                        v[0] = sigmoidf_(v[0] + b0.x); v[1] = sigmoidf_(v[1] + b0.y); v[2] = sigmoidf_(v[2] + b0.z); v[3] = sigmoidf_(v[3] + b0.w);
                        v[4] = sigmoidf_(v[4] + b1.x); v[5] = sigmoidf_(v[5] + b1.y); v[6] = sigmoidf_(v[6] + b1.z); v[7] = sigmoidf_(v[7] + b1.w);
                        store8h(arow + gs_slot(u.kind - GK_GATE0) + col, v);
                    } else if (u.kind <= GK_PROJ2) {
                        float g[8]; load8h(arow + gs_slot(u.kind - GK_PROJ0) + col, g);
                        if (u.kind == GK_PROJ0) {
#pragma unroll
                            for (int e = 0; e < 8; ++e) v[e] = g[e] * v[e];
                        } else {
                            float o[8]; load8h(arow + C_MG + col, o);
#pragma unroll
                            for (int e = 0; e < 8; ++e) v[e] = o[e] + g[e] * v[e];
                        }
                        store8h(arow + C_MG + col, v);
                    } else {
                        const size_t o = (size_t)row * 1024 + col;
                        const float4 r0 = *(const float4*)(resid + o), r1 = *(const float4*)(resid + o + 4);
                        *(float4*)(out + o) = make_float4(r0.x + v[0], r0.y + v[1], r0.z + v[2], r0.w + v[3]);
                        *(float4*)(out + o + 4) = make_float4(r1.x + v[4], r1.y + v[5], r1.z + v[6], r1.w + v[7]);
                    }
                }
            }
    }
};
__device__ __forceinline__ void stage_gemm(KParams p, int l, int which, char* smem) {
    GemmProg S; S.act = p->ws + OFF_ACT; S.wt = p->ws + OFF_WT + (size_t)l * WT_ROWS * 1024 * 2; S.which = which; S.G = gridDim.x; S.c = bid_();
    GemmEpi E; E.act = (h16_t*)(p->ws + OFF_ACT); E.mb = p->in[I_MB] + l * 3072; E.resid = l == 0 ? p->in[I_X] : p->out; E.out = p->out;
    pg8::gemm_phase(smem, S, E);
}

#ifdef CPU_EMU
__device__ __forceinline__ float group_sum(float v, int width, float* scratch) {
    const int tid = tid_();
    scratch[tid] = v;
    __syncthreads();
    float s = 0.f; const int base = tid & ~(width - 1);
    for (int i = 0; i < width; ++i) s += scratch[base + i];
    __syncthreads();
    return s;
}
#else
template <int CTRL> __device__ __forceinline__ float dpp_f(float v) { return __builtin_bit_cast(float, __builtin_amdgcn_update_dpp(0, __builtin_bit_cast(int, v), CTRL, 0xf, 0xf, false)); }
__device__ __forceinline__ float group_sum(float v, int width, float*) {
    v += dpp_f<0xB1>(v);
    v += dpp_f<0x4E>(v);
    if (width >= 8) v += dpp_f<0x141>(v);
    if (width >= 16) v += dpp_f<0x140>(v);
    if (width >= 64) {
        v += __builtin_bit_cast(float, __builtin_amdgcn_update_dpp(0, __builtin_bit_cast(int, v), 0x142, 0xa, 0xf, false));
        v += __builtin_bit_cast(float, __builtin_amdgcn_update_dpp(0, __builtin_bit_cast(int, v), 0x143, 0xc, 0xf, false));
        v = __builtin_bit_cast(float, __builtin_amdgcn_readlane(__builtin_bit_cast(int, v), 63));
    } else if (width >= 32) v += __shfl_xor(v, 16);
    return v;
}
#endif
__device__ __forceinline__ uint4 ldg16(const h16_t* p) { return *(const uint4*)p; }
__device__ __forceinline__ uint4 zero16() { uint4 z; z.x = 0u; z.y = 0u; z.z = 0u; z.w = 0u; return z; }

__device__ __forceinline__ void stage_lru(KParams p, int l, char* smem, int vb0, int nvb) {
    const int vb = bid_() - vb0;
    if (vb < 0 || vb >= nvb) return;
    constexpr int CH = 64;
    float* wa_s = (float*)smem;
    float* wx_s = wa_s + 4096;
    float* xcT = wx_s + 4096;
    float* a_s = xcT + 64 * CH;
    float* b_s = a_s + CH * 64;
    h16_t* ru = (h16_t*)(b_s + CH * 64);
    h16_t* rg = ru + (CH + 3) * 64;
    h16_t* ACT = (h16_t*)(p->ws + OFF_ACT);
    const int tid = tid_(), c = tid & 63, tg = tid >> 6;
    for (int item = vb; item < B_ * 16; item += nvb) {
        const int b = item / 16, n = item % 16, ch = n * 64 + c;
        __syncthreads();
        for (int i = tid; i < 4096; i += NT) { wa_s[i] = p->in[I_LWA][((size_t)l * 16 + n) * 4096 + i]; wx_s[i] = p->in[I_LWX][((size_t)l * 16 + n) * 4096 + i]; }
        const float cw0 = p->in[I_LCW][((size_t)l * 4 + 0) * 1024 + ch], cw1 = p->in[I_LCW][((size_t)l * 4 + 1) * 1024 + ch];
        const float cw2 = p->in[I_LCW][((size_t)l * 4 + 2) * 1024 + ch], cw3 = p->in[I_LCW][((size_t)l * 4 + 3) * 1024 + ch];
        const float cb = p->in[I_LCB][l * 1024 + ch], ba = p->in[I_LBA][l * 1024 + ch], bx = p->in[I_LBX][l * 1024 + ch];
        const float sp = softplusf_(-p->in[I_LLAM][l * 1024 + ch]);
        float hst = 0.f;
        uint4 pf[3];
#define LRU_LOAD(t0_) do { _Pragma("unroll") for (int i = 0; i < 3; ++i) { const int j = tid + NT * i; pf[i] = zero16(); \
            if (j < 536) { const int t = (t0_) - 3 + (j >> 3); if (t >= 0) pf[i] = ldg16(ACT + ((size_t)b * T_ + t) * LDZ + Z_ULRU + n * 64 + (j & 7) * 8); } \
            else if (j < 1048) { const int jj = j - 536; pf[i] = ldg16(ACT + ((size_t)b * T_ + (t0_) + (jj >> 3)) * LDZ + Z_GLRU + n * 64 + (jj & 7) * 8); } } } while (0)
#define LRU_PUT() do { _Pragma("unroll") for (int i = 0; i < 3; ++i) { const int j = tid + NT * i; \
            if (j < 536) *(uint4*)(ru + (j >> 3) * 64 + (j & 7) * 8) = pf[i]; else if (j < 1048) *(uint4*)(rg + ((j - 536) >> 3) * 64 + ((j - 536) & 7) * 8) = pf[i]; } } while (0)
        LRU_LOAD(0);
        LRU_PUT();
        __syncthreads();
#pragma unroll 1
        for (int t0 = 0; t0 < T_; t0 += CH) {
            float xc[8];
            {
                float u[11];
#pragma unroll
                for (int s = 0; s < 11; ++s) u[s] = h2f(ru[(tg * 8 + s) * 64 + c]);
#pragma unroll
                for (int s = 0; s < 8; ++s) { xc[s] = cw0 * u[s] + cw1 * u[s + 1] + cw2 * u[s + 2] + cw3 * u[s + 3] + cb; xcT[c * CH + tg * 8 + s] = xc[s]; }
            }
            __syncthreads();
            if (t0 + CH < T_) LRU_LOAD(t0 + CH);
            {
                float dr[8], di[8];
#pragma unroll
                for (int s = 0; s < 8; ++s) { dr[s] = 0.f; di[s] = 0.f; }
#pragma unroll 4
                for (int i = 0; i < 64; ++i) {
                    const float wa = wa_s[i * 64 + c], wx = wx_s[i * 64 + c];
                    const float4 x0 = *(const float4*)(xcT + i * CH + tg * 8), x1 = *(const float4*)(xcT + i * CH + tg * 8 + 4);
                    dr[0] += x0.x * wa; dr[1] += x0.y * wa; dr[2] += x0.z * wa; dr[3] += x0.w * wa; dr[4] += x1.x * wa; dr[5] += x1.y * wa; dr[6] += x1.z * wa; dr[7] += x1.w * wa;
                    di[0] += x0.x * wx; di[1] += x0.y * wx; di[2] += x0.z * wx; di[3] += x0.w * wx; di[4] += x1.x * wx; di[5] += x1.y * wx; di[6] += x1.z * wx; di[7] += x1.w * wx;
                }
#pragma unroll
                for (int s = 0; s < 8; ++s) {
                    const float r = sigmoidf_(dr[s] + ba), ig = sigmoidf_(di[s] + bx);
                    const float log_a = -8.0f * r * sp;
                    a_s[(tg * 8 + s) * 64 + c] = fexp_(log_a);
                    b_s[(tg * 8 + s) * 64 + c] = sqrtf(fmaxf(1.0f - fexp_(2.0f * log_a), 0.0f)) * (ig * xc[s]);
                }
            }
            __syncthreads();
            if (tid < 64) {
#pragma unroll 8
                for (int t = 0; t < CH; ++t) { hst = a_s[t * 64 + c] * hst + b_s[t * 64 + c]; b_s[t * 64 + c] = hst; }
            }
            __syncthreads();
#pragma unroll
            for (int s = 0; s < 8; ++s) { h16_t* gp = rg + (tg * 8 + s) * 64 + c; *gp = f2h(b_s[(tg * 8 + s) * 64 + c] * geluf_(h2f(*gp))); }
            __syncthreads();
            *(uint4*)(ACT + ((size_t)b * T_ + t0 + (tid >> 3)) * LDZ + Z_GLRU + n * 64 + (tid & 7) * 8) = *(const uint4*)(rg + (tid >> 3) * 64 + (tid & 7) * 8);
            __syncthreads();
            if (t0 + CH < T_) LRU_PUT();
            __syncthreads();
        }
#undef LRU_LOAD
#undef LRU_PUT
    }
}

#ifdef CPU_EMU
struct hfrag { h16_t v[8]; };
struct facc { float d[4]; float& operator[](int i) { return d[i]; } const float& operator[](int i) const { return d[i]; } };
__device__ __forceinline__ facc facc_zero() { facc a; a.d[0] = a.d[1] = a.d[2] = a.d[3] = 0.f; return a; }
__device__ __forceinline__ hfrag frag_u4(uint4 w) { hfrag f; memcpy(&f, &w, 16); return f; }
__device__ __forceinline__ hfrag frag_2u2(uint2 lo, uint2 hi) { hfrag f; memcpy(&f.v[0], &lo, 8); memcpy(&f.v[4], &hi, 8); return f; }
__device__ __forceinline__ hfrag frag_mul(hfrag a, hfrag b) { hfrag f; for (int j = 0; j < 8; ++j) f.v[j] = f2h(h2f(a.v[j]) * h2f(b.v[j])); return f; }
__device__ __forceinline__ facc mfma16(hfrag a, hfrag b, facc c) {
    const int tid = tid_(), w = tid >> 6, l = tid & 63;
    unsigned short (*X)[64][16] = emu::ctx->xscr;
    for (int j = 0; j < 8; ++j) { X[w][l][j] = a.v[j]; X[w][l][8 + j] = b.v[j]; }
    __syncthreads();
    for (int reg = 0; reg < 4; ++reg) {
        const int row = 4 * (l >> 4) + reg, col = l & 15;
        float s = 0.f;
        for (int k = 0; k < 32; ++k) s += h2f(X[w][row + 16 * (k >> 3)][k & 7]) * h2f(X[w][col + 16 * (k >> 3)][8 + (k & 7)]);
        c.d[reg] += s;
    }
    __syncthreads();
    return c;
}
#else
typedef _Float16 hfrag __attribute__((ext_vector_type(8)));
typedef float facc __attribute__((ext_vector_type(4)));
__device__ __forceinline__ facc facc_zero() { return (facc){0.f, 0.f, 0.f, 0.f}; }
__device__ __forceinline__ hfrag frag_u4(uint4 w) { return __builtin_bit_cast(hfrag, w); }
__device__ __forceinline__ hfrag frag_2u2(uint2 lo, uint2 hi) { uint4 w; w.x = lo.x; w.y = lo.y; w.z = hi.x; w.w = hi.y; return __builtin_bit_cast(hfrag, w); }
__device__ __forceinline__ hfrag frag_mul(hfrag a, hfrag b) { return a * b; }
__device__ __forceinline__ facc mfma16(hfrag a, hfrag b, facc c) { return __builtin_amdgcn_mfma_f32_16x16x32_f16(a, b, c, 0, 0, 0); }
#endif
__device__ __forceinline__ hfrag frag_pack8(float a0, float a1, float a2, float a3, float a4, float a5, float a6, float a7) {
    uint4 w; w.x = pack2h(a0, a1); w.y = pack2h(a2, a3); w.z = pack2h(a4, a5); w.w = pack2h(a6, a7); return frag_u4(w);
}
__device__ __forceinline__ hfrag frag_acc2(const facc& t0, const facc& t1) { return frag_pack8(t0[0], t0[1], t0[2], t0[3], t1[0], t1[1], t1[2], t1[3]); }
__device__ __forceinline__ hfrag permfrag(const h16_t* rowp, int ks, int g) { return frag_2u2(*(const uint2*)(rowp + 32 * ks + 4 * g), *(const uint2*)(rowp + 32 * ks + 16 + 4 * g)); }

__device__ __forceinline__ void stage_gdn(KParams p, int l, char* smem, int vb0, int nvb) {
    const int vb = bid_() - vb0;
    if (vb < 0 || vb >= nvb) return;
    constexpr int CH = 64, QS = 136, TS = 72, AS = 68, KTS = 128 * TS + 16 * 8;
#define KTO(d) ((d) * TS + ((d) >> 3) * 8)
    h16_t* Qs = (h16_t*)smem;
    h16_t* Ks = Qs + 64 * QS;
    h16_t* Kt = Ks + 64 * QS;
    h16_t* Vt = Kt + KTS;
    float* A32 = (float*)(Vt + KTS);
    h16_t* ob = (h16_t*)A32;
    h16_t* Tu = (h16_t*)(A32 + 64 * AS);
    h16_t* Tw = Tu + 64 * TS;
    h16_t* QKm = Tw + 64 * TS;
    float* gc_s = (float*)(QKm + 64 * TS);
    float* be_s = gc_s + 64;
    float* e1_s = be_s + 64;
    float* part_s = e1_s + 64;
    float* scr = part_s + 512;
    float* cw_s = scr + 512;
    h16_t* ACT = (h16_t*)(p->ws + OFF_ACT);
    int tid = tid_(), lane = tid & 63, w = tid >> 6, g = lane >> 4, r16 = lane & 15;
    int sg = lane >> 4, pc = lane & 15, rb = w;
#define GDN_ROLES() do { tid = tid_(); lane = tid & 63; w = tid >> 6; g = lane >> 4; r16 = lane & 15; sg = g; pc = r16; rb = w; } while (0)
    for (int item = vb; item < B_ * 8; item += nvb) {
        const int b = item / 8, h = item % 8;
        const float a_exp = fexp_(p->in[I_GALOG][l * 8 + h]), dtb = p->in[I_GDT][l * 8 + h];
        facc S[8];
#pragma unroll
        for (int dt = 0; dt < 8; ++dt) S[dt] = facc_zero();
        __syncthreads();
        for (int i = tid; i < 64 * TS / 2; i += NT) ((unsigned*)QKm)[i] = 0u;
        for (int i = tid; i < 4 * 384; i += NT) { const int jj = i / 384, c3 = i % 384; cw_s[i] = p->in[I_GCW][((size_t)l * 4 + jj) * 3072 + (c3 >> 7) * 1024 + h * 128 + (c3 & 127)]; }
        uint4 pf[11];
#define GDN_LOAD(t0_) do { GDN_ROLES(); const h16_t* colp = ACT + ((size_t)b * T_ + (t0_) + 8 * rb - 3) * LDZ + (sg < 3 ? Z_Q + sg * 1024 : Z_ZG) + h * 128 + pc * 8; \
            _Pragma("unroll") for (int i = 0; i < 11; ++i) { const int t = (t0_) + 8 * rb - 3 + i; pf[i] = (t >= 0 && sg < 3) ? ldg16(colp + (size_t)i * LDZ) : zero16(); } } while (0)
        GDN_LOAD(0);
        h16_t pfa = 0, pfb = 0;
#define GDN_LOADS(t0_) do { if (tid < 64) { const size_t m_ = (size_t)b * T_ + (t0_) + tid; pfa = ACT[m_ * LDZ + Z_ALPHA + h]; pfb = ACT[m_ * LDZ + Z_BETA + h]; } } while (0)
        GDN_LOADS(0);
#pragma unroll 1
        for (int t0 = 0; t0 < T_; t0 += CH) {
            GDN_ROLES();
            if (tid < 64) {
                part_s[tid] = -a_exp * softplusf_(h2f(pfa) + dtb);
                be_s[tid] = sigmoidf_(h2f(pfb));
            }
            __syncthreads();
            if (tid < 64) { float s = 0.f;
#pragma unroll
                for (int i4 = 0; i4 < 16; ++i4) { const float4 pv = *(const float4*)(part_s + i4 * 4); s += (i4 * 4 <= tid ? pv.x : 0.f) + (i4 * 4 + 1 <= tid ? pv.y : 0.f) + (i4 * 4 + 2 <= tid ? pv.z : 0.f) + (i4 * 4 + 3 <= tid ? pv.w : 0.f); }
                gc_s[tid] = s; }
#pragma unroll
            for (int hf = 0; hf < 2; ++hf) {
                float ov[4][8];
#pragma unroll
                for (int i = 0; i < 4; ++i) {
#pragma unroll
                    for (int cc = 0; cc < 8; ++cc) ov[i][cc] = 0.f;
#pragma unroll
                    for (int jj = 0; jj < 4; ++jj) {
                        const uint4 wv = pf[hf * 4 + i + jj];
                        const float* cwp = cw_s + jj * 384 + (sg < 3 ? sg : 0) * 128 + pc * 8;
                        const float4 c0 = *(const float4*)cwp, c1 = *(const float4*)(cwp + 4);
                        ov[i][0] += c0.x * h2f((h16_t)(wv.x & 0xffffu)); ov[i][1] += c0.y * h2f((h16_t)(wv.x >> 16)); ov[i][2] += c0.z * h2f((h16_t)(wv.y & 0xffffu)); ov[i][3] += c0.w * h2f((h16_t)(wv.y >> 16));
                        ov[i][4] += c1.x * h2f((h16_t)(wv.z & 0xffffu)); ov[i][5] += c1.y * h2f((h16_t)(wv.z >> 16)); ov[i][6] += c1.z * h2f((h16_t)(wv.w & 0xffffu)); ov[i][7] += c1.w * h2f((h16_t)(wv.w >> 16));
                    }
                    float ss = 0.f;
#pragma unroll
                    for (int cc = 0; cc < 8; ++cc) { ov[i][cc] = siluf_(ov[i][cc]); ss += ov[i][cc] * ov[i][cc]; }
                    ss = group_sum(ss, 16, scr);
                    const float rn = sg == 0 ? rsqrtf(ss + RMS_EPS) * 0.08838834764831845f : (sg == 1 ? rsqrtf(ss + RMS_EPS) : 1.0f);
#pragma unroll
                    for (int cc = 0; cc < 8; ++cc) ov[i][cc] *= rn;
                    const int t = 8 * rb + hf * 4 + i;
                    if (sg == 0) store8h(Qs + t * QS + pc * 8, ov[i]);
                    else if (sg == 1) store8h(Ks + t * QS + pc * 8, ov[i]);
                }
                if (sg == 1 || sg == 2) {
                    h16_t* dstT = sg == 1 ? Kt : Vt;
#pragma unroll
                    for (int cc = 0; cc < 8; ++cc) { uint2 w2; w2.x = pack2h(ov[0][cc], ov[1][cc]); w2.y = pack2h(ov[2][cc], ov[3][cc]); *(uint2*)(dstT + KTO(pc * 8 + cc) + 8 * rb + hf * 4) = w2; }
                }
            }
            __syncthreads();
            GDN_ROLES();
            if (tid < 64) e1_s[tid] = fexp_(gc_s[63] - gc_s[tid]);
            for (int e = tid; e < 64 * 64; e += NT) { const int i = e >> 6, j = e & 63; if ((j >> 4) > (i >> 4)) A32[i * AS + (j & 7) * 8 + (j >> 3)] = 0.f; }
#pragma unroll 1
            for (int jr = 0; jr < 3; ++jr) {
                const int jb = w + 8 * jr; const bool valid = jb < 20;
                const int kind = (valid && jb >= 10) ? 1 : 0, tix = valid ? (jb % 10) : 0;
                const int ti = tix < 1 ? 0 : (tix < 3 ? 1 : (tix < 6 ? 2 : 3)), tj = tix - (ti * (ti + 1)) / 2;
                const h16_t* ap = (kind ? Qs : Ks) + (16 * ti + r16) * QS + 8 * g; const h16_t* bp = Ks + (16 * tj + r16) * QS + 8 * g;
                facc acc = facc_zero();
#pragma unroll
                for (int ks = 0; ks < 4; ++ks) acc = mfma16(frag_u4(*(const uint4*)(ap + 32 * ks)), frag_u4(*(const uint4*)(bp + 32 * ks)), acc);
                if (valid) {
                    const int j = 16 * tj + r16; const float gj = gc_s[j];
#pragma unroll
                    for (int reg = 0; reg < 4; ++reg) {
                        const int i = 16 * ti + 4 * g + reg;
                        const float dec = fexp_(fminf(gc_s[i] - gj, 0.f));
                        if (kind == 0) A32[i * AS + (j & 7) * 8 + (j >> 3)] = i > j ? be_s[i] * acc[reg] * dec : 0.f;
                        else QKm[i * TS + j] = f2h(i >= j ? acc[reg] * dec : 0.f);
                    }
                }
            }
            __syncthreads();
            GDN_ROLES();
            {
                const int t = tid >> 3, d0 = (tid & 7) * 16; const float eg = fexp_(gc_s[t]);
                float v8[8];
                load8h(Qs + t * QS + d0, v8);
#pragma unroll
                for (int e = 0; e < 8; ++e) v8[e] *= eg;
                store8h(Qs + t * QS + d0, v8);
                load8h(Qs + t * QS + d0 + 8, v8);
#pragma unroll
                for (int e = 0; e < 8; ++e) v8[e] *= eg;
                store8h(Qs + t * QS + d0 + 8, v8);
            }
            {
                const int c = tid >> 3, q = tid & 7;
                const float bc = be_s[c], bgc = bc * fexp_(gc_s[c]);
                float x[8];
#pragma unroll
                for (int i = 0; i < 8; ++i) x[i] = 0.f;
#pragma unroll
                for (int r = 0; r < 64; ++r) {
                    float sacc = 0.f;
                    if (r > 0) {
                        const float4 a0 = *(const float4*)(A32 + r * AS + q * 8);
                        sacc = a0.x * x[0];
                        if (r > 8) sacc += a0.y * x[1];
                        if (r > 16) sacc += a0.z * x[2];
                        if (r > 24) sacc += a0.w * x[3];
                        if (r > 32) {
                            const float4 a1 = *(const float4*)(A32 + r * AS + q * 8 + 4);
                            sacc += a1.x * x[4];
                            if (r > 40) sacc += a1.y * x[5];
                            if (r > 48) sacc += a1.z * x[6];
                            if (r > 56) sacc += a1.w * x[7];
                        }
                        sacc = group_sum(sacc, 8, scr);
                    }
                    const float xr = ((r == c) ? 1.f : 0.f) - sacc;
                    if (q == (r & 7)) { x[r >> 3] = xr; Tu[r * TS + c] = f2h(xr * bc); Tw[r * TS + c] = f2h(xr * bgc); }
                }
            }
            __syncthreads();
            GDN_ROLES();
            facc vn[4], aw[4];
#pragma unroll
            for (int tt = 0; tt < 4; ++tt) { vn[tt] = facc_zero(); aw[tt] = facc_zero(); }
#pragma unroll
            for (int tt = 0; tt < 4; ++tt)
#pragma unroll
                for (int ks = 0; ks <= (tt >> 1); ++ks) {
                    const hfrag au = frag_u4(*(const uint4*)(Tu + (16 * tt + r16) * TS + 32 * ks + 8 * g)), aww = frag_u4(*(const uint4*)(Tw + (16 * tt + r16) * TS + 32 * ks + 8 * g));
                    vn[tt] = mfma16(au, frag_u4(*(const uint4*)(Vt + KTO(16 * w + r16) + 32 * ks + 8 * g)), vn[tt]);
                    aw[tt] = mfma16(aww, frag_u4(*(const uint4*)(Kt + KTO(16 * w + r16) + 32 * ks + 8 * g)), aw[tt]);
                }
#pragma unroll
            for (int tt = 0; tt < 4; ++tt)
#pragma unroll
                for (int reg = 0; reg < 4; ++reg) Ks[(16 * tt + 4 * g + reg) * QS + 16 * w + r16] = f2h(-aw[tt][reg]);
            __syncthreads();
            GDN_ROLES();
            h16_t zraw[16];
#pragma unroll
            for (int tt = 0; tt < 4; ++tt)
#pragma unroll
                for (int reg = 0; reg < 4; ++reg) zraw[tt * 4 + reg] = ACT[((size_t)b * T_ + t0 + 16 * tt + 4 * g + reg) * LDZ + Z_ZG + h * 128 + 16 * w + r16];
            hfrag Sb[4];
#pragma unroll
            for (int ks = 0; ks < 4; ++ks) Sb[ks] = frag_acc2(S[2 * ks], S[2 * ks + 1]);
            facc oc[4];
#pragma unroll
            for (int tt = 0; tt < 4; ++tt) {
                oc[tt] = facc_zero();
                const h16_t* wrow = Ks + (16 * tt + r16) * QS; const h16_t* qrow = Qs + (16 * tt + r16) * QS;
#pragma unroll
                for (int ks = 0; ks < 4; ++ks) { vn[tt] = mfma16(permfrag(wrow, ks, g), Sb[ks], vn[tt]); oc[tt] = mfma16(permfrag(qrow, ks, g), Sb[ks], oc[tt]); }
            }
            hfrag VNb[2];
            VNb[0] = frag_acc2(vn[0], vn[1]); VNb[1] = frag_acc2(vn[2], vn[3]);
#pragma unroll
            for (int tt = 0; tt < 4; ++tt)
#pragma unroll
                for (int ks2 = 0; ks2 <= (tt >> 1); ++ks2) oc[tt] = mfma16(permfrag(QKm + (16 * tt + r16) * TS, ks2, g), VNb[ks2], oc[tt]);
            {
                const float egl = fexp_(gc_s[63]);
                hfrag e1f[2];
#pragma unroll
                for (int ks2 = 0; ks2 < 2; ++ks2) { const float* ep = e1_s + 32 * ks2 + 4 * g; e1f[ks2] = frag_pack8(ep[0], ep[1], ep[2], ep[3], ep[16], ep[17], ep[18], ep[19]); }
#pragma unroll
                for (int dt = 0; dt < 8; ++dt) {
#pragma unroll
                    for (int reg = 0; reg < 4; ++reg) S[dt][reg] *= egl;
#pragma unroll
                    for (int ks2 = 0; ks2 < 2; ++ks2) S[dt] = mfma16(frag_mul(permfrag(Kt + KTO(16 * dt + r16), ks2, g), e1f[ks2]), VNb[ks2], S[dt]);
                }
            }
            if (t0 + CH < T_) { GDN_LOAD(t0 + CH); GDN_LOADS(t0 + CH); }
            GDN_ROLES();
#pragma unroll
            for (int tt = 0; tt < 4; ++tt)
#pragma unroll
                for (int reg = 0; reg < 4; ++reg) { const float ss = group_sum(oc[tt][reg] * oc[tt][reg], 16, scr); if (r16 == 0) part_s[w * 64 + 16 * tt + 4 * g + reg] = ss; }
            __syncthreads();
            const float nw = p->in[I_GNW][l * 128 + w * 16 + r16];
#pragma unroll
            for (int tt = 0; tt < 4; ++tt)
#pragma unroll
                for (int reg = 0; reg < 4; ++reg) {
                    const int t = 16 * tt + 4 * g + reg;
                    float ms = 0.f;
#pragma unroll
                    for (int ww = 0; ww < 8; ++ww) ms += part_s[ww * 64 + t];
                    ob[t * 128 + 16 * w + r16] = f2h(oc[tt][reg] * rsqrtf(ms * (1.0f / 128.0f) + RMS_EPS) * nw * siluf_(h2f(zraw[tt * 4 + reg])));
                }
            __syncthreads();
            GDN_ROLES();
#pragma unroll
            for (int i = 0; i < 2; ++i) { const int j = tid + NT * i; *(uint4*)(ACT + ((size_t)b * T_ + t0 + (j >> 4)) * LDZ + Z_ZG + h * 128 + (j & 15) * 8) = *(const uint4*)(ob + (j >> 4) * 128 + (j & 15) * 8); }
            __syncthreads();
        }
#undef GDN_LOAD
#undef GDN_LOADS
#undef KTO
#undef GDN_ROLES
    }
}

#ifndef CPU_EMU
typedef _Float16 rw_f16x8 __attribute__((ext_vector_type(8)));
typedef float rw_f32x4 __attribute__((ext_vector_type(4)));
#endif
__device__ __forceinline__ void stage_rwkv(KParams p, int l, char* smem, int vb0, int nvb) {
    const int vb = bid_() - vb0;
    if (vb < 0 || vb >= nvb) return;
    constexpr int CH = 32, XS = 264;
    float* r_s = (float*)smem;
    float* k_s = r_s + CH * 64;
    float* v_s = k_s + CH * 64;
    float* w_s = v_s + CH * 64;
    float* kk_s = w_s + CH * 64;
    float* ka_s = kk_s + CH * 64;
    float* g_s = ka_s + CH * 64;
    float* o_s = g_s + CH * 64;
    float* bon_s = o_s + CH * 64;
    float* scr = bon_s + CH;
    h16_t* raw = (h16_t*)(scr + 512);
    h16_t* xs = raw + (CH + 1) * 448;
    h16_t* ACT = (h16_t*)(p->ws + OFF_ACT);
    int tid = tid_(), c = tid & 63, tg = tid >> 6;
    int ri = tid >> 3, q8 = tid & 7;
#define RW_ROLES() do { tid = tid_(); c = tid & 63; tg = tid >> 6; ri = tid >> 3; q8 = tid & 7; } while (0)
    float* cst_s = (float*)(xs + CH * XS);
    for (int item = vb; item < B_ * 16; item += nvb) {
        const int b = item / 16, h = item % 16, ch = h * 64 + c;
        __syncthreads();
        if (tid < 64) {
            const float* mu = p->in[I_RMU] + (size_t)l * RWW;
            cst_s[0 * 64 + c] = p->in[I_RW0][l * 1024 + ch]; cst_s[1 * 64 + c] = p->in[I_RA0][l * 1024 + ch]; cst_s[2 * 64 + c] = p->in[I_RKK][l * 1024 + ch]; cst_s[3 * 64 + c] = p->in[I_RKA][l * 1024 + ch];
            cst_s[4 * 64 + c] = p->in[I_RRK][(size_t)l * 1024 + ch]; cst_s[5 * 64 + c] = p->in[I_RLW][l * 1024 + ch]; cst_s[6 * 64 + c] = p->in[I_RLB][l * 1024 + ch];
            cst_s[7 * 64 + c] = mu[RW_R + ch]; cst_s[8 * 64 + c] = mu[RW_K + ch]; cst_s[9 * 64 + c] = mu[RW_V + ch];
            cst_s[10 * 64 + c] = mu[RW_WL + c]; cst_s[11 * 64 + c] = mu[RW_AL + c]; cst_s[12 * 64 + c] = mu[RW_GL + c]; cst_s[13 * 64 + c] = mu[RW_GL + 64 + c];
        }
        const float* wup = p->in[I_RWUP] + (size_t)l * 64 * 1024 + h * 64; const float* aup = p->in[I_RAUP] + (size_t)l * 64 * 1024 + h * 64; const float* gup = p->in[I_RGUP] + (size_t)l * 128 * 1024 + h * 64;
#ifndef CPU_EMU
        const int wid = tid >> 6, lane = tid & 63, mt = wid >> 2, nt = wid & 3;
        rw_f16x8 bw[2], ba_[2], bg[4];
        {
            const int cn = nt * 16 + (lane & 15), kb = 8 * (lane >> 4);
#pragma unroll
            for (int ks = 0; ks < 2; ++ks)
#pragma unroll
                for (int j = 0; j < 8; ++j) { bw[ks][j] = (_Float16)wup[(size_t)(ks * 32 + kb + j) * 1024 + cn]; ba_[ks][j] = (_Float16)aup[(size_t)(ks * 32 + kb + j) * 1024 + cn]; }
#pragma unroll
            for (int ks = 0; ks < 4; ++ks)
#pragma unroll
                for (int j = 0; j < 8; ++j) bg[ks][j] = (_Float16)gup[(size_t)(ks * 32 + kb + j) * 1024 + cn];
        }
#endif
        float S[8];
#pragma unroll
        for (int e = 0; e < 8; ++e) S[e] = 0.f;
        uint4 pf[4];
#define RW_LOAD(t0_) do { _Pragma("unroll") for (int i = 0; i < 4; ++i) { const int j = tid + NT * i, row = j / 56, u = j % 56, t = (t0_) - 1 + row; pf[i] = zero16(); \
            if (j < (CH + 1) * 56 && t >= 0) pf[i] = ldg16(ACT + ((size_t)b * T_ + t) * LDZ + Z_RW + (u < 24 ? (u >> 3) * 1024 + h * 64 + (u & 7) * 8 : 3072 + (u - 24) * 8)); } } while (0)
#define RW_PUT() do { _Pragma("unroll") for (int i = 0; i < 4; ++i) { const int j = tid + NT * i; if (j < (CH + 1) * 56) *(uint4*)(raw + (j / 56) * 448 + (j % 56) * 8) = pf[i]; } } while (0)
        __syncthreads();
        RW_LOAD(0);
        RW_PUT();
        __syncthreads();
#pragma unroll 1
        for (int t0 = 0; t0 < T_; t0 += CH) {
            RW_ROLES();
            {
            const float mu_r = cst_s[7 * 64 + c], mu_k = cst_s[8 * 64 + c], mu_v = cst_s[9 * 64 + c], mu_wl = cst_s[10 * 64 + c], mu_al = cst_s[11 * 64 + c], mu_g0 = cst_s[12 * 64 + c], mu_g1 = cst_s[13 * 64 + c];
#pragma unroll
            for (int s = 0; s < 4; ++s) {
                const int tl = tg * 4 + s;
                const h16_t* zc = raw + (tl + 1) * 448; const h16_t* zp = raw + tl * 448;
#define RW_SHIFT(col, muv) ({ const float zz = h2f(zc[col]); zz + (muv) * (h2f(zp[col]) - zz); })
                r_s[tl * 64 + c] = RW_SHIFT(c, mu_r);
                k_s[tl * 64 + c] = RW_SHIFT(64 + c, mu_k);
                v_s[tl * 64 + c] = RW_SHIFT(128 + c, mu_v);
                xs[tl * XS + c] = f2h(tanhf_(RW_SHIFT(192 + c, mu_wl)));
                xs[tl * XS + 64 + c] = f2h(RW_SHIFT(256 + c, mu_al));
                xs[tl * XS + 128 + c] = f2h(sigmoidf_(RW_SHIFT(320 + c, mu_g0)));
                xs[tl * XS + 192 + c] = f2h(sigmoidf_(RW_SHIFT(384 + c, mu_g1)));
#undef RW_SHIFT
            }
            }
            __syncthreads();
#ifdef CPU_EMU
#pragma unroll
            for (int s = 0; s < 4; ++s) {
                const int tl = tg * 4 + s;
                float dw = 0.f, da = 0.f, dg = 0.f;
                for (int i = 0; i < 64; ++i) { dw += h2f(xs[tl * XS + i]) * h2f(f2h(wup[(size_t)i * 1024 + c])); da += h2f(xs[tl * XS + 64 + i]) * h2f(f2h(aup[(size_t)i * 1024 + c])); }
                for (int i = 0; i < 128; ++i) dg += h2f(xs[tl * XS + 128 + i]) * h2f(f2h(gup[(size_t)i * 1024 + c]));
                w_s[tl * 64 + c] = dw; ka_s[tl * 64 + c] = da; g_s[tl * 64 + c] = dg;
            }
#else
            {
                const h16_t* ap = xs + (mt * 16 + (lane & 15)) * XS + 8 * (lane >> 4);
                rw_f32x4 dw = {0.f, 0.f, 0.f, 0.f}, da = {0.f, 0.f, 0.f, 0.f}, dg = {0.f, 0.f, 0.f, 0.f};
#pragma unroll
                for (int ks = 0; ks < 2; ++ks) {
                    dw = __builtin_amdgcn_mfma_f32_16x16x32_f16(*(const rw_f16x8*)(ap + ks * 32), bw[ks], dw, 0, 0, 0);
                    da = __builtin_amdgcn_mfma_f32_16x16x32_f16(*(const rw_f16x8*)(ap + 64 + ks * 32), ba_[ks], da, 0, 0, 0);
                }
#pragma unroll
                for (int ks = 0; ks < 4; ++ks) dg = __builtin_amdgcn_mfma_f32_16x16x32_f16(*(const rw_f16x8*)(ap + 128 + ks * 32), bg[ks], dg, 0, 0, 0);
#pragma unroll
                for (int rg = 0; rg < 4; ++rg) { const int o = (mt * 16 + 4 * (lane >> 4) + rg) * 64 + nt * 16 + (lane & 15); w_s[o] = dw[rg]; ka_s[o] = da[rg]; g_s[o] = dg[rg]; }
            }
#endif
            __syncthreads();
            RW_ROLES();
            {
            const float w0 = cst_s[0 * 64 + c], a0 = cst_s[1 * 64 + c], k_k = cst_s[2 * 64 + c], k_a = cst_s[3 * 64 + c], rk_c = cst_s[4 * 64 + c];
#pragma unroll
            for (int s = 0; s < 4; ++s) {
                const int tl = tg * 4 + s;
                const float w_log = -softplusf_(-(w0 + w_s[tl * 64 + c])) - 0.5f;
                const float decay = fexp_(-fexp_(w_log));
                const float a = sigmoidf_(a0 + ka_s[tl * 64 + c]);
                const float kx = k_s[tl * 64 + c], rx = r_s[tl * 64 + c];
                const float kkr = kx * k_k, k2 = kx * (1.0f + (a - 1.0f) * k_a);
                const float nsq = group_sum(kkr * kkr, 64, scr);
                const float bon = group_sum(rx * k2 * rk_c, 64, scr);
                const float kkn = kkr * rsqrtf(nsq + RMS_EPS);
                w_s[tl * 64 + c] = decay; k_s[tl * 64 + c] = k2; kk_s[tl * 64 + c] = kkn; ka_s[tl * 64 + c] = kkn * a;
                if (c == 0) bon_s[tl] = bon;
            }
            }
            __syncthreads();
            RW_ROLES();
            {
                struct StepVec { float4 kk0, kk1, w0, w1, a0, a1, k0, k1, r0, r1; float vi; };
#define RW_LDSTEP(V_, t_) do { const int o8_ = (t_) * 64 + q8 * 8; V_.kk0 = *(const float4*)(kk_s + o8_); V_.kk1 = *(const float4*)(kk_s + o8_ + 4); V_.w0 = *(const float4*)(w_s + o8_); V_.w1 = *(const float4*)(w_s + o8_ + 4); \
                    V_.a0 = *(const float4*)(ka_s + o8_); V_.a1 = *(const float4*)(ka_s + o8_ + 4); V_.k0 = *(const float4*)(k_s + o8_); V_.k1 = *(const float4*)(k_s + o8_ + 4); \
                    V_.r0 = *(const float4*)(r_s + o8_); V_.r1 = *(const float4*)(r_s + o8_ + 4); V_.vi = v_s[(t_) * 64 + ri]; } while (0)
#define RW_STEP(V_, t_) do { \
                    const float pk = (S[0] * V_.kk0.x + S[1] * V_.kk0.y) + (S[2] * V_.kk0.z + S[3] * V_.kk0.w) + ((S[4] * V_.kk1.x + S[5] * V_.kk1.y) + (S[6] * V_.kk1.z + S[7] * V_.kk1.w)); \
                    const float skk = group_sum(pk, 8, scr); const float vi = V_.vi; \
                    S[0] = S[0] * V_.w0.x - skk * V_.a0.x + vi * V_.k0.x; S[1] = S[1] * V_.w0.y - skk * V_.a0.y + vi * V_.k0.y; S[2] = S[2] * V_.w0.z - skk * V_.a0.z + vi * V_.k0.z; S[3] = S[3] * V_.w0.w - skk * V_.a0.w + vi * V_.k0.w; \
                    S[4] = S[4] * V_.w1.x - skk * V_.a1.x + vi * V_.k1.x; S[5] = S[5] * V_.w1.y - skk * V_.a1.y + vi * V_.k1.y; S[6] = S[6] * V_.w1.z - skk * V_.a1.z + vi * V_.k1.z; S[7] = S[7] * V_.w1.w - skk * V_.a1.w + vi * V_.k1.w; \
                    const float po = (S[0] * V_.r0.x + S[1] * V_.r0.y) + (S[2] * V_.r0.z + S[3] * V_.r0.w) + ((S[4] * V_.r1.x + S[5] * V_.r1.y) + (S[6] * V_.r1.z + S[7] * V_.r1.w)); \
                    const float o = group_sum(po, 8, scr); \
                    if (q8 == 0) o_s[(t_) * 64 + ri] = o; } while (0)
                StepVec va, vb;
                RW_LDSTEP(va, 0);
#pragma unroll 1
                for (int t = 0; t < CH; t += 2) {
                    RW_LDSTEP(vb, t + 1);
                    RW_STEP(va, t);
                    if (t + 2 < CH) RW_LDSTEP(va, t + 2);
                    RW_STEP(vb, t + 1);
                }
#undef RW_LDSTEP
#undef RW_STEP
            }
            if (t0 + CH < T_) RW_LOAD(t0 + CH);
            __syncthreads();
            RW_ROLES();
            {
            const float lnw = cst_s[5 * 64 + c], lnb = cst_s[6 * 64 + c];
            const int ch = h * 64 + c;
#pragma unroll
            for (int s = 0; s < 4; ++s) {
                const int tl = tg * 4 + s;
                const float ov = o_s[tl * 64 + c];
                const float mean = group_sum(ov, 64, scr) * (1.0f / 64.0f);
                const float d = ov - mean;
                const float var = group_sum(d * d, 64, scr) * (1.0f / 64.0f);
                const float y = (d * rsqrtf(var + GN_EPS) * lnw + lnb + bon_s[tl] * v_s[tl * 64 + c]) * g_s[tl * 64 + c];
                ACT[((size_t)b * T_ + t0 + tl) * LDZ + C_YC + ch] = f2h(y);
            }
            }
            __syncthreads();
            RW_ROLES();
            if (t0 + CH < T_) RW_PUT();
            __syncthreads();
        }
#undef RW_LOAD
#undef RW_PUT
#undef RW_ROLES
    }
}

constexpr bool TAB_IN_ACT = (M_ == 16384);
constexpr float TAB_SU = 256.0f, TAB_SV = 32.0f;
__device__ __forceinline__ unsigned char* tab_row(char* ws, int e) {
    if (TAB_IN_ACT) return (unsigned char*)((h16_t*)(ws + OFF_ACT) + (size_t)e * LDZ + C_GS);
    return (unsigned char*)(ws + OFF_TAB) + (size_t)e * 2048;
}
#ifdef CPU_EMU
__device__ __forceinline__ unsigned f2fp8(float f) {
    const unsigned sgn = f < 0.f ? 0x80u : 0u; float a = fabsf(f);
    if (!(a == a)) return 0x7fu;
    if (a >= 448.0f) return sgn | 0x7eu;
    if (a < 0.0009765625f) return sgn;
    int e; frexpf(a, &e); e -= 1;
    if (e < -6) { const float q = nearbyintf(a * 512.0f); return sgn | (unsigned)q; }
    float q = nearbyintf((a / ldexpf(1.0f, e) - 1.0f) * 8.0f);
    if (q >= 8.0f) { q = 0.f; e += 1; }
    if (e > 8) return sgn | 0x7eu;
    const unsigned r = ((unsigned)(e + 7) << 3) | (unsigned)q;
    return sgn | (r > 0x7eu ? 0x7eu : r);
}
__device__ __forceinline__ float fp82f(unsigned b) {
    const unsigned e = (b >> 3) & 15u, m = b & 7u; const float s = (b & 0x80u) ? -1.f : 1.f;
    if (e == 0) return s * (float)m * 0.001953125f;
    return s * ldexpf(1.0f + (float)m * 0.125f, (int)e - 7);
}
__device__ __forceinline__ unsigned pack4fp8(float a, float b, float c, float d) { return f2fp8(a) | (f2fp8(b) << 8) | (f2fp8(c) << 16) | (f2fp8(d) << 24); }
__device__ __forceinline__ void dec4fp8(unsigned w, float* o) { o[0] = fp82f(w & 255u); o[1] = fp82f((w >> 8) & 255u); o[2] = fp82f((w >> 16) & 255u); o[3] = fp82f(w >> 24); }
#else
__device__ __forceinline__ unsigned pack4fp8(float a, float b, float c, float d) { int p = __builtin_amdgcn_cvt_pk_fp8_f32(a, b, 0, false); p = __builtin_amdgcn_cvt_pk_fp8_f32(c, d, p, true); return (unsigned)p; }
__device__ __forceinline__ void dec4fp8(unsigned w, float* o) { const auto lo = __builtin_amdgcn_cvt_pk_f32_fp8((int)w, false); const auto hi = __builtin_amdgcn_cvt_pk_f32_fp8((int)w, true); o[0] = lo[0]; o[1] = lo[1]; o[2] = hi[0]; o[3] = hi[1]; }
#endif
__device__ __forceinline__ void stage_tabconv(KParams p, int l) {
    const int tid = tid_();
    const float* U = p->in[I_PU] + (size_t)l * 16384 * 1024; const float* V = p->in[I_PV] + (size_t)l * 16384 * 1024;
    char* ws = p->ws;
    for (int it = bid_() * NT + tid; it < 16384 * 128; it += gridDim.x * NT) {
        const int r = it >> 7, ck = it & 127, which = ck >> 6, c16 = ck & 63;
        const float* src = (which ? V : U) + (size_t)r * 1024 + c16 * 16;
        const float sc = which ? TAB_SV : TAB_SU;
        const float4 a = *(const float4*)src, b = *(const float4*)(src + 4), c = *(const float4*)(src + 8), d = *(const float4*)(src + 12);
        uint4 w;
        w.x = pack4fp8(a.x * sc, a.y * sc, a.z * sc, a.w * sc); w.y = pack4fp8(b.x * sc, b.y * sc, b.z * sc, b.w * sc);
        w.z = pack4fp8(c.x * sc, c.y * sc, c.z * sc, c.w * sc); w.w = pack4fp8(d.x * sc, d.y * sc, d.z * sc, d.w * sc);
        *(uint4*)(tab_row(ws, r) + which * 1024 + c16 * 16) = w;
    }
}

#ifdef CPU_EMU
__device__ __forceinline__ float group_max16(float v, float* scr) {
    const int tid = tid_();
    scr[tid] = v;
    __syncthreads();
    float m = -3.0e38f; const int base = tid & ~15;
    for (int i = 0; i < 16; ++i) m = fmaxf(m, scr[base + i]);
    __syncthreads();
    return m;
}
#else
__device__ __forceinline__ float group_max16(float v, float*) {
    v = fmaxf(v, dpp_f<0xB1>(v)); v = fmaxf(v, dpp_f<0x4E>(v)); v = fmaxf(v, dpp_f<0x141>(v)); v = fmaxf(v, dpp_f<0x140>(v));
    return v;
}
#endif
__device__ __forceinline__ void stage_peer_topk(KParams p, int l, char* smem) {
    constexpr int KS = 136;
    h16_t* khi = (h16_t*)smem;
    h16_t* klo = khi + 128 * KS;
    float* scr = (float*)(klo + 128 * KS);
    const h16_t* ACT = (const h16_t*)(p->ws + OFF_ACT);
    float* TOPS = (float*)(p->ws + OFF_TOPS);
    int tid = tid_(), lane = tid & 63, w = tid >> 6, g = lane >> 4, r16 = lane & 15;
#define TK_ROLES() do { tid = tid_(); lane = tid & 63; w = tid >> 6; g = lane >> 4; r16 = lane & 15; } while (0)
    const int nb = gridDim.x;
    for (int hs = bid_() % 16; hs < 16; hs += nb) {
        const int hd = hs >> 1, s = hs & 1;
        __syncthreads();
        {
            const float* kp = p->in[I_PKEYS] + (((size_t)l * 8 + hd) * 2 + s) * 128 * 128;
            for (int i = tid * 4; i < 128 * 128; i += NT * 4) {
                const float4 kv = *(const float4*)(kp + i);
                const int n = i >> 7, c0 = i & 127;
                const float h0 = h2f(f2h(kv.x)), h1 = h2f(f2h(kv.y)), h2 = h2f(f2h(kv.z)), h3 = h2f(f2h(kv.w));
                uint2 hw, lw; hw.x = pack2h(kv.x, kv.y); hw.y = pack2h(kv.z, kv.w); lw.x = pack2h(kv.x - h0, kv.y - h1); lw.y = pack2h(kv.z - h2, kv.w - h3);
                *(uint2*)(khi + n * KS + c0) = hw; *(uint2*)(klo + n * KS + c0) = lw;
            }
        }
        __syncthreads();
        const int nblk = nb >= 16 ? nb / 16 : 1, bsub = nb >= 16 ? bid_() / 16 : 0;
        for (int chunk = bsub; chunk < (M_ + NT - 1) / NT; chunk += nblk) {
            if (nb >= 16 && bid_() >= nblk * 16) break;
#pragma unroll 1
            for (int tt = 0; tt < 4; ++tt) {
                TK_ROLES();
                const int tok0 = chunk * NT + w * 64 + tt * 16;
                const bool live = tok0 < M_;
                hfrag af[4];
                {
                    const h16_t* qp = ACT + (size_t)(live ? tok0 + r16 : 0) * LDZ + C_QRY + hd * 256 + s * 128 + 8 * g;
#pragma unroll
                    for (int ks = 0; ks < 4; ++ks) af[ks] = frag_u4(*(const uint4*)(qp + 32 * ks));
                }
                facc acc[8];
#pragma unroll
                for (int nt = 0; nt < 8; ++nt) {
                    acc[nt] = facc_zero();
                    const h16_t* bh = khi + (16 * nt + r16) * KS + 8 * g; const h16_t* bl = klo + (16 * nt + r16) * KS + 8 * g;
#pragma unroll
                    for (int ks = 0; ks < 4; ++ks) { acc[nt] = mfma16(af[ks], frag_u4(*(const uint4*)(bh + 32 * ks)), acc[nt]); acc[nt] = mfma16(af[ks], frag_u4(*(const uint4*)(bl + 32 * ks)), acc[nt]); }
                }
#pragma unroll 1
                for (int rp = 0; rp < 2; ++rp) {
                  TK_ROLES();
#pragma unroll
                  for (int r2 = 0; r2 < 2; ++r2) {
                    const int reg = rp * 2 + r2;
                    float v[8];
#pragma unroll
                    for (int nt = 0; nt < 8; ++nt) { const float av = rp == 0 ? (r2 == 0 ? acc[nt][0] : acc[nt][1]) : (r2 == 0 ? acc[nt][2] : acc[nt][3]); v[nt] = __uint_as_float((__float_as_uint(av) & ~127u) | (unsigned)(127 - (16 * nt + r16))); }
#define CE(i, j) { const float hi_ = fmaxf(v[i], v[j]), lo_ = fminf(v[i], v[j]); v[i] = hi_; v[j] = lo_; }
                    CE(0, 1) CE(2, 3) CE(4, 5) CE(6, 7) CE(0, 2) CE(1, 3) CE(4, 6) CE(5, 7) CE(1, 2) CE(5, 6) CE(0, 4) CE(1, 5) CE(2, 6) CE(3, 7) CE(2, 4) CE(3, 5) CE(1, 2) CE(3, 4) CE(5, 6)
#undef CE
                    float res = 0.f;
#pragma unroll
                    for (int rnd = 0; rnd < 16; ++rnd) {
                        const float m = group_max16(v[0], scr);
                        const bool win = v[0] == m;
#pragma unroll
                        for (int i = 0; i < 7; ++i) v[i] = win ? v[i + 1] : v[i];
                        v[7] = win ? -3.0e38f : v[7];
                        res = (r16 == rnd) ? m : res;
                    }
                    if (live) TOPS[(((size_t)(tok0 + 4 * g + reg) * 8 + hd) * 2 + s) * 16 + r16] = res;
                  }
                }
            }
        }
    }
}

#undef TK_ROLES
__device__ __forceinline__ void peer_cand(int k, int& i, int& j) {
    if (k < 16) { i = 0; j = k; } else if (k < 24) { i = 1; j = k - 16; } else if (k < 29) { i = 2; j = k - 24; } else if (k < 33) { i = 3; j = k - 29; }
    else if (k < 36) { i = 4; j = k - 33; } else if (k < 38) { i = 5; j = k - 36; } else if (k < 40) { i = 6; j = k - 38; } else if (k < 42) { i = 7; j = k - 40; }
    else { i = k - 34; j = 0; }
}
__device__ __forceinline__ float dot16q(const uint4 a, const float (&x)[16]) {
    float t[4], s0, s1;
    dec4fp8(a.x, t); s0 = t[0] * x[0] + t[1] * x[1]; s1 = t[2] * x[2] + t[3] * x[3];
    dec4fp8(a.y, t); s0 += t[0] * x[4] + t[1] * x[5]; s1 += t[2] * x[6] + t[3] * x[7];
    dec4fp8(a.z, t); s0 += t[0] * x[8] + t[1] * x[9]; s1 += t[2] * x[10] + t[3] * x[11];
    dec4fp8(a.w, t); s0 += t[0] * x[12] + t[1] * x[13]; s1 += t[2] * x[14] + t[3] * x[15];
    return s0 + s1;
}
__device__ __forceinline__ void axpy16q(const uint4 a, float s, float (&y)[16]) {
    float t[4];
    dec4fp8(a.x, t); y[0] += s * t[0]; y[1] += s * t[1]; y[2] += s * t[2]; y[3] += s * t[3];
    dec4fp8(a.y, t); y[4] += s * t[0]; y[5] += s * t[1]; y[6] += s * t[2]; y[7] += s * t[3];
    dec4fp8(a.z, t); y[8] += s * t[0]; y[9] += s * t[1]; y[10] += s * t[2]; y[11] += s * t[3];
    dec4fp8(a.w, t); y[12] += s * t[0]; y[13] += s * t[1]; y[14] += s * t[2]; y[15] += s * t[3];
}
#ifdef CPU_EMU
__device__ __forceinline__ float lane_xor(float v, int mask, float* scr) { const int tid = tid_(); scr[tid] = v; __syncthreads(); const float r = scr[tid ^ mask]; __syncthreads(); return r; }
__device__ __forceinline__ float lane_bcast(float v, int src, float* scr) { const int tid = tid_(); scr[tid] = v; __syncthreads(); const float r = scr[(tid & ~63) + src]; __syncthreads(); return r; }
#else
__device__ __forceinline__ float lane_xor(float v, int mask, float*) { return mask == 1 ? dpp_f<0xB1>(v) : (mask == 2 ? dpp_f<0x4E>(v) : __shfl_xor(v, mask)); }
__device__ __forceinline__ float lane_bcast(float v, int src, float*) { return __builtin_bit_cast(float, __builtin_amdgcn_readlane(__builtin_bit_cast(int, v), src)); }
#endif
__device__ __forceinline__ float reduce8(const float (&v)[8], int lane, float* scr) {
    const bool b0 = lane & 1, b1 = lane & 2, b2 = lane & 4;
    float w4[4], u2[2];
#pragma unroll
    for (int j = 0; j < 4; ++j) { const float keep = b0 ? v[2 * j + 1] : v[2 * j], send = b0 ? v[2 * j] : v[2 * j + 1]; w4[j] = keep + lane_xor(send, 1, scr); }
#pragma unroll
    for (int j = 0; j < 2; ++j) { const float keep = b1 ? w4[2 * j + 1] : w4[2 * j], send = b1 ? w4[2 * j] : w4[2 * j + 1]; u2[j] = keep + lane_xor(send, 2, scr); }
    float z = (b2 ? u2[1] : u2[0]) + lane_xor(b2 ? u2[0] : u2[1], 4, scr);
    z += lane_xor(z, 8, scr); z += lane_xor(z, 16, scr); z += lane_xor(z, 32, scr);
    return z;
}
__device__ __forceinline__ void stage_peer_gather(KParams p, int l, char* smem) {
    int tid = tid_(), w = tid >> 6, lane = tid & 63;
    float* base; float* tops_s; float* cand_s; float* best_s; int* idx_s; float* gate_s; int* pos_s;
#define PG_ROLES() do { tid = tid_(); w = tid >> 6; lane = tid & 63; base = (float*)smem + w * 2048; tops_s = base; cand_s = tops_s + 256; best_s = cand_s + 64; \
        idx_s = (int*)(best_s + 128); gate_s = (float*)(idx_s + 128); pos_s = (int*)(gate_s + 128); } while (0)
    PG_ROLES();
    float* scr = (float*)smem + 8 * 2048;
    h16_t* ACT = (h16_t*)(p->ws + OFF_ACT);
    const float* TOPS = (const float*)(p->ws + OFF_TOPS);
    char* ws = p->ws;
    const float* nxt_w = (l + 1 < NL_) ? p->in[I_NMIX] + (l + 1) * 1024 : p->in[I_NFINAL];
    const int nwaves = gridDim.x * 8;
    for (int m = bid_() * 8 + w; m < M_; m += nwaves) {
        PG_ROLES();
        __syncthreads();
        *(float4*)(tops_s + lane * 4) = *(const float4*)(TOPS + (size_t)m * 256 + lane * 4);
        float x[16];
        { float t8[8]; load8h(ACT + (size_t)m * LDZ + C_XN + lane * 16, t8);
#pragma unroll
          for (int j = 0; j < 8; ++j) x[j] = t8[j];
          load8h(ACT + (size_t)m * LDZ + C_XN + lane * 16 + 8, t8);
#pragma unroll
          for (int j = 0; j < 8; ++j) x[8 + j] = t8[j]; }
        __syncthreads();
        int ci = 0, cj = 0;
        if (lane < 50) peer_cand(lane, ci, cj);
        const int pos = ci * 16 + cj;
        pos_s[lane] = pos;
#pragma unroll 1
        for (int hd = 0; hd < 8; ++hd) {
            const float cs = lane < 50 ? tops_s[hd * 32 + ci] + tops_s[hd * 32 + 16 + cj] : -3.0e38f;
            cand_s[lane] = cs;
            __syncthreads();
            if (lane < 50) {
                int cnt = 0;
#pragma unroll 10
                for (int o = 0; o < 50; ++o) { const float ov = cand_s[o]; cnt += (ov > cs || (ov == cs && pos_s[o] < pos)) ? 1 : 0; }
                if (cnt < 16) {
                    best_s[hd * 16 + cnt] = cs;
                    const int n0 = 127 - (int)(__float_as_uint(tops_s[hd * 32 + ci]) & 127u), n1 = 127 - (int)(__float_as_uint(tops_s[hd * 32 + 16 + cj]) & 127u);
                    idx_s[hd * 16 + cnt] = n0 * 128 + n1;
                }
            }
            __syncthreads();
        }
#pragma unroll
        for (int rr = 0; rr < 2; ++rr) {
            const int e = lane + 64 * rr, hd = e >> 4;
            const float mx = best_s[hd * 16];
            float sum = 0.f;
#pragma unroll
            for (int i = 0; i < 16; ++i) sum += fexp_(best_s[hd * 16 + i] - mx);
            gate_s[e] = fexp_(best_s[e] - mx) / sum;
        }
        __syncthreads();
        float y[16];
#pragma unroll
        for (int i = 0; i < 16; ++i) y[i] = 0.f;
        PG_ROLES();
        uint4 uu[8], vv[8];
#define PG_LOADU(eb_) do { _Pragma("unroll") for (int k = 0; k < 8; ++k) uu[k] = *(const uint4*)(tab_row(ws, idx_s[(eb_) + k]) + lane * 16); } while (0)
#define PG_LOADV(eb_) do { _Pragma("unroll") for (int k = 0; k < 8; ++k) vv[k] = *(const uint4*)(tab_row(ws, idx_s[(eb_) + k]) + 1024 + lane * 16); } while (0)
        PG_LOADU(0); PG_LOADV(0);
#pragma unroll 1
        for (int eb = 0; eb < 128; eb += 8) {
            float d8[8];
#pragma unroll
            for (int k = 0; k < 8; ++k) d8[k] = dot16q(uu[k], x);
            if (eb + 8 < 128) PG_LOADU(eb + 8);
            const float tot = reduce8(d8, lane, scr);
            const float hk = gate_s[eb + (lane & 7)] * geluf_(tot * (1.0f / TAB_SU));
#pragma unroll
            for (int k = 0; k < 8; ++k) axpy16q(vv[k], lane_bcast(hk, k, scr), y);
            if (eb + 8 < 128) PG_LOADV(eb + 8);
        }
#undef PG_LOADU
#undef PG_LOADV
        PG_ROLES();
        float* op = p->out + (size_t)m * 1024 + lane * 16;
        float hn[16]; float ss = 0.f;
#pragma unroll
        for (int i = 0; i < 16; i += 4) {
            const float4 o4 = *(const float4*)(op + i);
            hn[i] = o4.x + y[i] * (1.0f / TAB_SV); hn[i + 1] = o4.y + y[i + 1] * (1.0f / TAB_SV); hn[i + 2] = o4.z + y[i + 2] * (1.0f / TAB_SV); hn[i + 3] = o4.w + y[i + 3] * (1.0f / TAB_SV);
            ss += hn[i] * hn[i] + hn[i + 1] * hn[i + 1] + hn[i + 2] * hn[i + 2] + hn[i + 3] * hn[i + 3];
        }
        ss = group_sum(ss, 64, scr);
        const float rstd = rsqrtf(ss * (1.0f / D_) + RMS_EPS);
        float nv[16];
#pragma unroll
        for (int i = 0; i < 16; i += 4) { const float4 w4 = *(const float4*)(nxt_w + lane * 16 + i); nv[i] = hn[i] * rstd * w4.x; nv[i + 1] = hn[i + 1] * rstd * w4.y; nv[i + 2] = hn[i + 2] * rstd * w4.z; nv[i + 3] = hn[i + 3] * rstd * w4.w; }
        if (l + 1 < NL_) {
#pragma unroll
            for (int i = 0; i < 16; i += 4) *(float4*)(op + i) = make_float4(hn[i], hn[i + 1], hn[i + 2], hn[i + 3]);
            const float n0[8] = {nv[0], nv[1], nv[2], nv[3], nv[4], nv[5], nv[6], nv[7]}, n1[8] = {nv[8], nv[9], nv[10], nv[11], nv[12], nv[13], nv[14], nv[15]};
            store8h(ACT + (size_t)m * LDZ + C_XN + lane * 16, n0); store8h(ACT + (size_t)m * LDZ + C_XN + lane * 16 + 8, n1);
        } else {
#pragma unroll
            for (int i = 0; i < 16; i += 4) *(float4*)(op + i) = make_float4(nv[i], nv[i + 1], nv[i + 2], nv[i + 3]);
        }
    }
}
#undef PG_ROLES

enum { PH_NORM_MIX = 0, PH_INPROJ, PH_MIXERS, PH_MERGE, PH_WOUT, PH_NORM_FFN, PH_QUERY, PH_TOPK, PH_GATHER, PH_PER_LAYER, PH_FINAL = 100, PH_WPREP = 101 };
__device__ __forceinline__ void run_phase(KParams p, int l, int ph, char* smem) {
    h16_t* ACT = (h16_t*)(p->ws + OFF_ACT);
    const float* hin = l == 0 ? p->in[I_X] : p->out;
    switch (ph) {
    case PH_WPREP: stage_wprep(p, smem); break;
    case PH_NORM_MIX: if (l == 0) stage_rmsnorm(hin, p->in[I_NMIX] + l * 1024, ACT + C_XN, LDZ, smem); break;
    case PH_INPROJ: stage_gemm(p, l, GP_INPROJ, smem); break;
    case PH_MIXERS: {
        const int nb = gridDim.x, n_rw = nb / 2, n_gd = nb / 4, n_lr = nb - n_rw - n_gd;
        stage_rwkv(p, l, smem, 0, n_rw);
        stage_gdn(p, l, smem, n_rw, n_gd);
        stage_lru(p, l, smem, n_rw + n_gd, n_lr);
    } break;
    case PH_MERGE: stage_gemm(p, l, GP_MERGE, smem); break;
    case PH_WOUT: stage_gemm(p, l, GP_WOUT, smem); break;
    case PH_NORM_FFN: stage_rmsnorm(p->out, p->in[I_NFFN] + l * 1024, ACT + C_XN, LDZ, smem); stage_tabconv(p, l); break;
    case PH_QUERY: stage_gemm(p, l, GP_QUERY, smem); break;
    case PH_TOPK: stage_peer_topk(p, l, smem); break;
    case PH_GATHER: stage_peer_gather(p, l, smem); break;
    case PH_FINAL: break;
    default: break;
    }
}


#if !defined(CPU_EMU) && !MK_MULTI
#define XB_TMO      128
#define XB_XCNT(j)  (256  + 64 * (j))
#define XB_XSUB(j)  (1280 + 64 * (j))
#define XB_XGEN(j)  (2304 + 64 * (j))
#define XB_TOP      3328
#define XB_TOPGEN   3392
#define XCD_BAR_WORDS 3456
#define XB_SPIN_CAP (1u << 22)
#define XB_LAS __attribute__((address_space(3)))
__device__ __forceinline__ unsigned xb_ld(unsigned* p)              { return __hip_atomic_load(p, __ATOMIC_RELAXED, __HIP_MEMORY_SCOPE_AGENT); }
__device__ __forceinline__ unsigned xb_add(unsigned* p, unsigned v) { return __hip_atomic_fetch_add(p, v, __ATOMIC_RELAXED, __HIP_MEMORY_SCOPE_AGENT); }
__device__ __forceinline__ unsigned xb_xcc_id() { return (unsigned)__builtin_amdgcn_s_getreg((3 << 11) | 20) & 0xFu; }
#define XB_SPIN(cond, bar) do { unsigned _sp = 0; while (cond) { __builtin_amdgcn_s_sleep(1); \
    if ((++_sp & 255u) == 0u) { if (xb_ld(&(bar)[XB_TMO])) break; if (_sp > XB_SPIN_CAP) { atomicAdd(&(bar)[XB_TMO], 1u); break; } } } } while (0)
struct XcdBarrier { unsigned* bar; unsigned x; volatile XB_LAS unsigned* st; };
__device__ __forceinline__ XcdBarrier xcd_barrier_post(unsigned* bar, volatile XB_LAS unsigned* st) {
    XcdBarrier b; b.bar = bar; b.x = xb_xcc_id(); b.st = st;
    if (threadIdx.x == 0) (void)xb_add(&bar[XB_XCNT(b.x)], 1u);
    return b;
}
__device__ __forceinline__ void xcd_barrier_complete(unsigned* bar, unsigned x, unsigned& nloc, unsigned& nx) {
    const unsigned G = gridDim.x * gridDim.y * gridDim.z;
    unsigned sum, cnt, mine, sp = 0u;
    for (;;) {
        sum = 0u; cnt = 0u; mine = 0u;
#pragma unroll
        for (unsigned j = 0; j < 16; ++j) { const unsigned c = xb_ld(&bar[XB_XCNT(j)]); sum += c; cnt += (c > 0u) ? 1u : 0u; mine = (j == x) ? c : mine; }
        if (sum == G) break;
        __builtin_amdgcn_s_sleep(1);
        if ((++sp & 255u) == 0u) { if (xb_ld(&bar[XB_TMO])) break; if (sp > XB_SPIN_CAP) { atomicAdd(&bar[XB_TMO], 1u); break; } }
    }
    nloc = mine > 0u ? mine : 1u; nx = cnt > 0u ? cnt : 1u;
}
__device__ __forceinline__ void xcd_barrier(const XcdBarrier& b) {
    asm volatile("s_waitcnt vmcnt(0)" ::: "memory");
    __syncthreads();
    if (threadIdx.x == 0) {
        unsigned* bar = b.bar;
        __builtin_amdgcn_s_waitcnt(0);
        unsigned nloc = b.st[0], nx = b.st[1];
        if (nloc == 0u) { xcd_barrier_complete(bar, b.x, nloc, nx); b.st[0] = nloc; b.st[1] = nx; }
        const unsigned old = xb_add(&bar[XB_XSUB(b.x)], 1u);
        const unsigned gen = old / nloc;
        if (old + 1u == (gen + 1u) * nloc) {
            __builtin_amdgcn_fence(__ATOMIC_RELEASE, "agent");
            asm volatile("s_waitcnt vmcnt(0)" ::: "memory");
            const unsigned og = xb_add(&bar[XB_TOP], 1u);
            const unsigned tg = og / nx;
            if (og + 1u == (tg + 1u) * nx) xb_add(&bar[XB_TOPGEN], 1u);
            else XB_SPIN(xb_ld(&bar[XB_TOPGEN]) == tg, bar);
            __builtin_amdgcn_fence(__ATOMIC_ACQUIRE, "agent");
            xb_add(&bar[XB_XGEN(b.x)], 1u);
            asm volatile("s_waitcnt vmcnt(0)" ::: "memory");
        } else {
            XB_SPIN(xb_ld(&bar[XB_XGEN(b.x)]) == gen, bar);
            __builtin_amdgcn_fence(__ATOMIC_ACQUIRE, "agent");
            asm volatile("s_waitcnt vmcnt(0)" ::: "memory");
        }
    }
    __syncthreads();
}
#endif
#if !defined(CPU_EMU) && !MK_MULTI
__global__ void __launch_bounds__(512, 2) k_mega(Params p_) {
    DYN_SMEM(smem);
    KParams pk = (KParams)__builtin_amdgcn_kernarg_segment_ptr();
    cg::grid_group grid = cg::this_grid();
    volatile XB_LAS unsigned* xst = (volatile XB_LAS unsigned*)(XB_LAS char*)(smem + SMEM_BYTES);
    if (threadIdx.x == 0) { xst[0] = 0u; xst[1] = 0u; xst[2] = 0u; xst[3] = 0u; }
    __syncthreads();
    const XcdBarrier xb = xcd_barrier_post((unsigned*)(pk->ws + OFF_BAR), xst);
    bool first_sync = true;
    constexpr int NIT = NL_ * PH_PER_LAYER;
#pragma unroll 1
    for (int it = -1; it <= NIT; ++it) {
        const int l = (it >= 0 && it < NIT) ? it / PH_PER_LAYER : 0, ph = it < 0 ? (int)PH_WPREP : (it < NIT ? it % PH_PER_LAYER : (int)PH_FINAL);
        KParams q = pk; asm volatile("" : "+s"(q));
        run_phase(q, l, ph, smem);
        if (it >= 0 && it < NIT - 1 && !(l > 0 && ph == PH_NORM_MIX)) {
            if (first_sync) { grid.sync(); first_sync = false; }
            else xcd_barrier(xb);
        }
    }
}
#endif
#ifdef CPU_EMU
__global__ void k_phase(Params p_, int l, int ph) { DYN_SMEM(smem); run_phase(&p_, l, ph, smem); }
#elif MK_MULTI
__global__ void __launch_bounds__(512, 2) k_phase(Params p_, int l, int ph) { DYN_SMEM(smem); KParams pk = (KParams)__builtin_amdgcn_kernarg_segment_ptr(); run_phase(pk, l, ph, smem); }
#endif
}

#ifdef CPU_EMU
int g_emu_stop = 1000;
#endif

extern "C" void kernel_launch(void* const* d_in, const int* in_sizes, int n_in, void* d_out, int out_size, void* d_ws, size_t ws_size, hipStream_t stream) {
    Params p{};
    for (int i = 0; i < N_IN; ++i) p.in[i] = (const float*)d_in[i];
    p.out = (float*)d_out; p.ws = (char*)d_ws;
#if defined(CPU_EMU) || MK_MULTI
    const int grid = 256;
    LAUNCH(k_phase, grid, NT, SMEM_BYTES, stream, p, 0, (int)PH_WPREP);
    for (int l = 0; l < NL_; ++l)
        for (int ph = 0; ph < PH_PER_LAYER; ++ph) {
            LAUNCH(k_phase, grid, NT, SMEM_BYTES, stream, p, l, ph);
#ifdef CPU_EMU
            const int code = ph == PH_INPROJ ? 1 : ph == PH_MIXERS ? 2 : ph == PH_MERGE ? 3 : ph == PH_WOUT ? 4 : ph == PH_GATHER ? 5 : 0;
            if (code && g_emu_stop == l * 10 + code) return;
#endif
        }
    LAUNCH(k_phase, grid, NT, SMEM_BYTES, stream, p, 0, (int)PH_FINAL);
#else
    static int grid_blocks = 0;
    if (!grid_blocks) {
        int dev = 0, cus = 0, per_cu = 0;
        (void)hipGetDevice(&dev);
        (void)hipDeviceGetAttribute(&cus, hipDeviceAttributeMultiprocessorCount, dev);
        (void)hipFuncSetAttribute((const void*)k_mega, hipFuncAttributeMaxDynamicSharedMemorySize, (int)SMEM_BYTES + 16);
        (void)hipOccupancyMaxActiveBlocksPerMultiprocessor(&per_cu, k_mega, NT, SMEM_BYTES + 16);
        if (per_cu > 1) per_cu = 1;
        grid_blocks = cus * per_cu;
    }
    (void)hipMemsetAsync((char*)d_ws + OFF_BAR, 0, 16384, stream);
    void* args[] = {&p};
    hipError_t e = hipLaunchCooperativeKernel((void*)k_mega, dim3(grid_blocks), dim3(NT), args, SMEM_BYTES + 16, stream);
    if (e != hipSuccess) fprintf(stderr, "cooperative launch failed: %s (grid %d)\n", hipGetErrorString(e), grid_blocks);
#endif
}
```

```cpp
#ifndef CPU_EMU
#include <hip/hip_runtime.h>
#include <hip/hip_cooperative_groups.h>
#include <cstdio>
#include <cstdint>
namespace cg = cooperative_groups;
#define DYN_SMEM(name) extern __shared__ __attribute__((aligned(16))) char name[]
#define LAUNCH(kern, grid, block, smem, stream, ...) hipLaunchKernelGGL(kern, dim3(grid), dim3(block), smem, stream, __VA_ARGS__)
#endif

#ifndef CFG_B
#define CFG_B 8
#endif
#ifndef CFG_T
#define CFG_T 2048
#endif
#ifndef MK_MULTI
#define MK_MULTI 0
#endif

namespace {
constexpr int B_ = CFG_B, T_ = CFG_T, M_ = B_ * T_, D_ = 1024, NL_ = 2, NT = 512;
constexpr int INW = 12560;
constexpr int LDZ = 11776;
constexpr int Z_ULRU = 0, Z_GLRU = 1024, Z_Q = 2048, Z_K = 3072, Z_V = 4096, Z_ZG = 5120, Z_RW = 6144, Z_ALPHA = 9472, Z_BETA = 9480;
constexpr int ZN = 9728;
constexpr int C_XN = 9728, C_YC = 10752;
constexpr int C_YA = Z_GLRU, C_YB = Z_ZG;
constexpr int C_GS = Z_Q, C_MG = Z_K;
constexpr int C_QRY = 0;
constexpr int RW_R = 0, RW_K = 1024, RW_V = 2048, RW_WL = 3072, RW_AL = 3136, RW_GL = 3200, RWW = 3328;
constexpr float RMS_EPS = 1e-6f, GN_EPS = 64e-5f;
typedef unsigned short h16_t;

enum { I_X = 0, I_NMIX, I_NFFN, I_NFINAL, I_WIN, I_LCW, I_LCB, I_LWA, I_LBA, I_LWX, I_LBX, I_LLAM, I_GCW, I_GALOG, I_GDT, I_GNW,
       I_RMU, I_RW0, I_RWUP, I_RA0, I_RAUP, I_RGUP, I_RKK, I_RKA, I_RRK, I_RLW, I_RLB, I_MB, I_PL, I_PG, I_PR, I_WOUT, I_PWQ, I_PKEYS, I_PU, I_PV, N_IN };

struct Params {
    const float* in[N_IN];
    float* out;
    char* ws;
};
#ifdef CPU_EMU
typedef const Params* KParams;
#else
typedef const Params __attribute__((address_space(4)))* KParams;
#endif

constexpr size_t al256(size_t x) { return (x + 255) / 256 * 256; }
constexpr size_t OFF_ACT = 0;
constexpr size_t OFF_WT = al256(OFF_ACT + (size_t)M_ * LDZ * 2);
constexpr int WT_IN = 0, WT_MG = ZN, WT_P = WT_MG + 3072, WT_OUT = WT_P + 3072, WT_Q = WT_OUT + 1024, WT_ROWS = WT_Q + 2048;
constexpr size_t OFF_TOPS = al256(OFF_WT + (size_t)NL_ * WT_ROWS * 1024 * 2);
constexpr size_t OFF_TAB = al256(OFF_TOPS + (size_t)M_ * 256 * 4);
constexpr size_t OFF_BAR = OFF_TAB + (M_ == 16384 ? 0 : (size_t)16384 * 2048);
constexpr size_t WS_END = OFF_BAR + 16384;
static_assert(CFG_B != 8 || CFG_T != 2048 || WS_END <= (size_t)512 * 1024 * 1024, "workspace budget");
constexpr size_t SMEM_BYTES = 128 * 1024;

#ifdef CPU_EMU
__device__ __forceinline__ int tid_() { return threadIdx.x; }
__device__ __forceinline__ h16_t f2h(float f) { return (h16_t)_cvtss_sh(f, _MM_FROUND_TO_NEAREST_INT); }
__device__ __forceinline__ float h2f(h16_t h) { return _cvtsh_ss(h); }
#else
__device__ __forceinline__ int tid_() { int t = threadIdx.x; asm volatile("" : "+v"(t)); return t; }
__device__ __forceinline__ h16_t f2h(float f) { return __builtin_bit_cast(unsigned short, (_Float16)f); }
__device__ __forceinline__ float h2f(h16_t h) { return (float)__builtin_bit_cast(_Float16, h); }
#endif
__device__ __forceinline__ int bid_() { return (int)blockIdx.x; }

#ifdef CPU_EMU
__device__ __forceinline__ float fexp_(float x) { return expf(x); }
__device__ __forceinline__ float flog_(float x) { return logf(x); }
__device__ __forceinline__ float frcp_(float x) { return 1.0f / x; }
#else
__device__ __forceinline__ float fexp_(float x) { return __builtin_amdgcn_exp2f(x * 1.4426950408889634f); }
__device__ __forceinline__ float flog_(float x) { return __builtin_amdgcn_logf(x) * 0.6931471805599453f; }
__device__ __forceinline__ float frcp_(float x) { return __builtin_amdgcn_rcpf(x); }
#endif
__device__ __forceinline__ float sigmoidf_(float x) { return frcp_(1.0f + fexp_(-x)); }
__device__ __forceinline__ float softplusf_(float x) { return fmaxf(x, 0.0f) + flog_(1.0f + fexp_(-fabsf(x))); }
__device__ __forceinline__ float siluf_(float x) { return x * sigmoidf_(x); }
__device__ __forceinline__ float tanhf_(float x) { return 1.0f - 2.0f * frcp_(1.0f + fexp_(2.0f * x)); }
__device__ __forceinline__ float geluf_(float x) { return x * frcp_(1.0f + fexp_(-1.5957691216057308f * (x + 0.044715f * x * x * x))); }
__device__ __forceinline__ unsigned pack2h(float a, float b) { return (unsigned)f2h(a) | ((unsigned)f2h(b) << 16); }
__device__ __forceinline__ void store8h(h16_t* p, const float (&v)[8]) {
    uint4 w; w.x = pack2h(v[0], v[1]); w.y = pack2h(v[2], v[3]); w.z = pack2h(v[4], v[5]); w.w = pack2h(v[6], v[7]);
    *(uint4*)p = w;
}
__device__ __forceinline__ void load8h(const h16_t* p, float (&v)[8]) {
    const uint4 w = *(const uint4*)p;
    v[0] = h2f((h16_t)(w.x & 0xffffu)); v[1] = h2f((h16_t)(w.x >> 16)); v[2] = h2f((h16_t)(w.y & 0xffffu)); v[3] = h2f((h16_t)(w.y >> 16));
    v[4] = h2f((h16_t)(w.z & 0xffffu)); v[5] = h2f((h16_t)(w.z >> 16)); v[6] = h2f((h16_t)(w.w & 0xffffu)); v[7] = h2f((h16_t)(w.w >> 16));
}

__device__ __forceinline__ float block_sum512(float v, float* red) {
    const int tid = tid_();
    red[tid] = v;
    __syncthreads();
    if (tid < 32) { float s = 0.f; for (int i = 0; i < 16; ++i) s += red[tid * 16 + i]; red[512 + tid] = s; }
    __syncthreads();
    float tot = 0.f;
    for (int i = 0; i < 32; ++i) tot += red[512 + i];
    __syncthreads();
    return tot;
}

#ifdef CPU_EMU
__device__ __forceinline__ float wave_sum64(float v, float* scr) {
    const int tid = tid_();
    scr[tid] = v; __syncthreads();
    float s = 0.f; const int base = tid & ~63;
    for (int i = 0; i < 64; ++i) s += scr[base + i];
    __syncthreads();
    return s;
}
#else
__device__ __forceinline__ float wave_sum64(float v, float*) {
    v += __builtin_bit_cast(float, __builtin_amdgcn_mov_dpp(__builtin_bit_cast(int, v), 0xB1, 0xf, 0xf, true));
    v += __builtin_bit_cast(float, __builtin_amdgcn_mov_dpp(__builtin_bit_cast(int, v), 0x4E, 0xf, 0xf, true));
    v += __builtin_bit_cast(float, __builtin_amdgcn_mov_dpp(__builtin_bit_cast(int, v), 0x141, 0xf, 0xf, true));
    v += __builtin_bit_cast(float, __builtin_amdgcn_mov_dpp(__builtin_bit_cast(int, v), 0x140, 0xf, 0xf, true));
    v += __builtin_bit_cast(float, __builtin_amdgcn_update_dpp(0, __builtin_bit_cast(int, v), 0x142, 0xa, 0xf, false));
    v += __builtin_bit_cast(float, __builtin_amdgcn_update_dpp(0, __builtin_bit_cast(int, v), 0x143, 0xc, 0xf, false));
    return __builtin_bit_cast(float, __builtin_amdgcn_readlane(__builtin_bit_cast(int, v), 63));
}
#endif
__device__ __forceinline__ void stage_rmsnorm(const float* src, const float* w, h16_t* dst, int ldd, char* smem) {
    float* scr = (float*)smem;
    const int tid = tid_(), lane = tid & 63, wv = tid >> 6;
    const int nw = gridDim.x * 8;
    float4 wv4[4];
#pragma unroll
    for (int i = 0; i < 4; ++i) wv4[i] = *(const float4*)(w + lane * 16 + i * 4);
    for (int row = bid_() * 8 + wv; row < M_; row += 2 * nw) {
        const int row2 = row + nw; const bool has2 = row2 < M_;
        float4 a[4], b[4];
#pragma unroll
        for (int i = 0; i < 4; ++i) { a[i] = *(const float4*)(src + (size_t)row * D_ + lane * 16 + i * 4); b[i] = has2 ? *(const float4*)(src + (size_t)row2 * D_ + lane * 16 + i * 4) : make_float4(0.f, 0.f, 0.f, 0.f); }
        float sa = 0.f, sb = 0.f;
#pragma unroll
        for (int i = 0; i < 4; ++i) { sa += a[i].x * a[i].x + a[i].y * a[i].y + a[i].z * a[i].z + a[i].w * a[i].w; sb += b[i].x * b[i].x + b[i].y * b[i].y + b[i].z * b[i].z + b[i].w * b[i].w; }
        sa = wave_sum64(sa, scr); sb = wave_sum64(sb, scr);
        const float ra = rsqrtf(sa * (1.0f / D_) + RMS_EPS), rb = rsqrtf(sb * (1.0f / D_) + RMS_EPS);
#pragma unroll
        for (int i = 0; i < 4; i += 2) {
            const float va[8] = {a[i].x * ra * wv4[i].x, a[i].y * ra * wv4[i].y, a[i].z * ra * wv4[i].z, a[i].w * ra * wv4[i].w, a[i + 1].x * ra * wv4[i + 1].x, a[i + 1].y * ra * wv4[i + 1].y, a[i + 1].z * ra * wv4[i + 1].z, a[i + 1].w * ra * wv4[i + 1].w};
            store8h(dst + (size_t)row * ldd + lane * 16 + i * 4, va);
            if (has2) {
                const float vb[8] = {b[i].x * rb * wv4[i].x, b[i].y * rb * wv4[i].y, b[i].z * rb * wv4[i].z, b[i].w * rb * wv4[i].w, b[i + 1].x * rb * wv4[i + 1].x, b[i + 1].y * rb * wv4[i + 1].y, b[i + 1].z * rb * wv4[i + 1].z, b[i + 1].w * rb * wv4[i + 1].w};
                store8h(dst + (size_t)row2 * ldd + lane * 16 + i * 4, vb);
            }
        }
    }
}

__device__ __forceinline__ const float* wt_src(KParams p, int l, int r, int& ld) {
    if (r < ZN) {
        ld = INW;
        int c;
        if (r < 6144) c = r; else if (r < 9472) c = r + 16; else if (r < 9488) c = r - 3328; else return nullptr;
        return p->in[I_WIN] + (size_t)l * 1024 * INW + c;
    }
    r -= ZN;
    if (r < 3072) { ld = INW; return p->in[I_WIN] + (size_t)l * 1024 * INW + 9488 + r; }
    r -= 3072;
    if (r < 3072) { ld = 1024; const int br = r >> 10; return p->in[br == 0 ? I_PL : (br == 1 ? I_PG : I_PR)] + (size_t)l * 1024 * 1024 + (r & 1023); }
    r -= 3072;
    if (r < 1024) { ld = 1024; return p->in[I_WOUT] + (size_t)l * 1024 * 1024 + r; }
    r -= 1024;
    ld = 2048; return p->in[I_PWQ] + (size_t)l * 1024 * 2048 + r;
}
__device__ __forceinline__ void stage_wprep(KParams p, char* smem) {
    float* tile = (float*)smem;
    h16_t* WT = (h16_t*)(p->ws + OFF_WT);
    const int tid = tid_();
    const int ntr = WT_ROWS / 64, total = NL_ * ntr * 16;
    for (int it = bid_(); it < total; it += gridDim.x) {
        const int l = it / (ntr * 16), rem = it % (ntr * 16), rt = rem / 16, kt = rem % 16;
        const int r0 = rt * 64, k0 = kt * 64;
        __syncthreads();
        {
            const int nn = tid & 63;
            int ld = 0; const float* src = wt_src(p, l, r0 + nn, ld);
#pragma unroll
            for (int i = 0; i < 8; ++i) { const int kk = (tid >> 6) + 8 * i; tile[kk * 65 + nn] = src ? src[(size_t)(k0 + kk) * ld] : 0.f; }
        }
        __syncthreads();
        {
            const int r = tid >> 3, kq = (tid & 7) * 8;
            float v[8];
#pragma unroll
            for (int j = 0; j < 8; ++j) v[j] = tile[(kq + j) * 65 + r];
            store8h(WT + ((size_t)l * WT_ROWS + r0 + r) * 1024 + k0 + kq, v);
        }
    }
}

namespace pg8 {
constexpr int BM = 256, BK = 64, HALF = 128, HTB = HALF * BK * 2, STAGE_BYTES = 8 * HTB, NXCD = 8, WGM = 8;
struct Unit { const char* A; const char* B; int pm, pn, kind; };
#ifdef CPU_EMU
struct f32x4 { float d[4]; float& operator[](int i) { return d[i]; } const float& operator[](int i) const { return d[i]; } };
#else
#define PG8_LAS __attribute__((address_space(3)))
typedef _Float16 f16x8 __attribute__((ext_vector_type(8)));
typedef float f32x4 __attribute__((ext_vector_type(4)));
__device__ __forceinline__ int lds_byte(int r, int c) { const int st = (r >> 4) * 2 + (c >> 5), rr = r & 15, cc = c & 31, ob = rr * 64 + cc * 2; return st * 1024 + (ob ^ (((ob >> 9) & 1) << 5)); }
__device__ __forceinline__ void stage_rc(int b, int& R, int& C) { const int st = b / 1024, sb = b % 1024, swz = sb ^ (((sb >> 9) & 1) << 5); R = (st >> 1) * 16 + swz / 64; C = (st & 1) * 32 + (swz % 64) / 2; }
__device__ __forceinline__ int perm32(int rho) { const int n = rho >> 4, i = rho & 15; return 8 * (i >> 2) + 4 * n + (i & 3); }
#endif
__device__ __forceinline__ void tile_of(int L, int nM, int nN, int& pm, int& pn) {
    const int nwg = nM * nN;
    int wgid = L; { const int q = nwg / NXCD, r = nwg % NXCD, xcd = wgid % NXCD, off = wgid / NXCD; wgid = (xcd < r ? xcd * (q + 1) : r * (q + 1) + (xcd - r) * q) + off; }
    const int nig = WGM * nN, gid = wgid / nig, fm = gid * WGM, gsz = (nM - fm) < WGM ? (nM - fm) : WGM;
    pm = fm + ((wgid % nig) % gsz); pn = (wgid % nig) / gsz;
}

template <class Sched, class Epi>
__device__ __forceinline__ void gemm_phase(char* smem, const Sched& S, const Epi& E) {
    constexpr int K = 1024, nt = K / BK;
    constexpr unsigned lda = LDZ, ldb = 1024;
#ifdef CPU_EMU
    const int tid = tid_(), wid = tid >> 6, lane = tid & 63, wr = wid >> 2, wc = wid & 3, fr = lane & 15, fq = lane >> 4;
    Unit u;
    for (int ui = 0; S.next(ui, u); ++ui) {
        f32x4 acc[2][2][4][2];
        for (int ai = 0; ai < 2; ++ai) for (int bj = 0; bj < 2; ++bj) for (int m = 0; m < 4; ++m) for (int n = 0; n < 2; ++n) for (int e = 0; e < 4; ++e) {
            const int r = 128 * ai + 64 * wr + 16 * m + fr, c = 128 * bj + 32 * wc + 8 * fq + 4 * n + e;
            const h16_t* a = (const h16_t*)u.A + (size_t)r * lda; const h16_t* b = (const h16_t*)u.B + (size_t)c * ldb;
            float s = 0.f;
            for (int k = 0; k < K; ++k) s += h2f(a[k]) * h2f(b[k]);
            acc[ai][bj][m][n][e] = s;
        }
        E(acc, u, wr, wc, fr, fq);
    }
    (void)smem; (void)nt;
#else
    PG8_LAS unsigned char* lds = (PG8_LAS unsigned char*)smem;
    const int tid = tid_(), wid = __builtin_amdgcn_readfirstlane(tid >> 6), lane = tid & 63, wr = wid >> 2, wc = wid & 3, fr = lane & 15, fq = lane >> 4;
    unsigned voffA[2], voffB[2];
#pragma unroll
    for (int i = 0; i < 2; ++i) { int R, C; stage_rc(tid * 16 + i * 8192, R, C); const int Rb = (R & ~31) + perm32(R & 31);
        voffA[i] = (unsigned)(R * lda + C) * 2u; voffB[i] = (unsigned)(Rb * ldb + C) * 2u; }
    constexpr size_t kstep = (size_t)(BK * 2);
    constexpr size_t hstepA = (size_t)HALF * lda * 2, hstepB = (size_t)HALF * ldb * 2;
    const unsigned ldsw = (unsigned)wid * 1024u;
    const int aoff = lds_byte(wr * 64 + fr, fq * 8), boff = lds_byte(wc * 32 + fr, fq * 8);
#define PG8_SA(b, h) (((b) * 2 + (h)) * HTB)
#define PG8_SB(b, h) ((4 + (b) * 2 + (h)) * HTB)
#define PG8_STAGE(bufoff, gbase, voff) do { _Pragma("unroll") for (int _i = 0; _i < 2; ++_i) \
        __builtin_amdgcn_global_load_lds((const unsigned*)((const char*)(gbase) + (voff)[_i]), (PG8_LAS unsigned*)(lds + (bufoff) + ldsw + _i * 8192), 16, 0, 0); } while (0)
#define PG8_LDA(dst, b, h) do { _Pragma("unroll") for (int m = 0; m < 4; ++m) _Pragma("unroll") for (int k = 0; k < 2; ++k) dst[m][k] = *(const PG8_LAS f16x8*)(lds + PG8_SA(b, h) + aoff + m * 2048 + k * 1024); } while (0)
#define PG8_LDB(dst, b, h) do { _Pragma("unroll") for (int n = 0; n < 2; ++n) _Pragma("unroll") for (int k = 0; k < 2; ++k) dst[n][k] = *(const PG8_LAS f16x8*)(lds + PG8_SB(b, h) + boff + n * 2048 + k * 1024); } while (0)
#define PG8_MMA(ai, bj, At, Bt) do { __builtin_amdgcn_s_setprio(1); _Pragma("unroll") for (int m = 0; m < 4; ++m) _Pragma("unroll") for (int n = 0; n < 2; ++n) _Pragma("unroll") for (int k = 0; k < 2; ++k) \
        acc[ai][bj][m][n] = __builtin_amdgcn_mfma_f32_16x16x32_f16(Bt[n][k], At[m][k], acc[ai][bj][m][n], 0, 0, 0); __builtin_amdgcn_s_setprio(0); } while (0)
#define PG8_WAIT_V(n) asm volatile("s_waitcnt vmcnt(" #n ")" ::: "memory")
#define PG8_WAIT_L(n) asm volatile("s_waitcnt lgkmcnt(" #n ")" ::: "memory")
#define PG8_BAR __builtin_amdgcn_s_barrier()
#define PG8_SCHED __builtin_amdgcn_sched_barrier(0)
    Unit cur, nxt; int ui = 0;
    if (!S.next(0, cur)) return;
    f32x4 acc[2][2][4][2];
#pragma unroll
    for (int a = 0; a < 2; ++a)
#pragma unroll
        for (int b = 0; b < 2; ++b)
#pragma unroll
            for (int m = 0; m < 4; ++m)
#pragma unroll
                for (int n = 0; n < 2; ++n) acc[a][b][m][n] = (f32x4){0.f, 0.f, 0.f, 0.f};
    f16x8 At[4][2], B0[2][2], B1[2][2];
    const char* cA = cur.A; const char* cB = cur.B;
    PG8_STAGE(PG8_SB(0, 0), cB, voffB); PG8_STAGE(PG8_SA(0, 0), cA, voffA); PG8_STAGE(PG8_SB(0, 1), cB + hstepB, voffB); PG8_STAGE(PG8_SA(0, 1), cA + hstepA, voffA);
    if (wr == 1) PG8_BAR;
    PG8_WAIT_V(4); PG8_BAR;
    PG8_STAGE(PG8_SB(1, 0), cB + kstep, voffB); PG8_STAGE(PG8_SA(1, 0), cA + kstep, voffA); PG8_STAGE(PG8_SB(1, 1), cB + hstepB + kstep, voffB);
    PG8_WAIT_V(6); PG8_BAR;
    for (;;) {
        const bool has_next = S.next(ui + 1, nxt);
        const char* nA = has_next ? nxt.A : cA; const char* nB = has_next ? nxt.B : cB;
#pragma unroll 1
        for (int t = 0; t < nt; t += 2) {
            const bool last = (t == nt - 2);
            const char* a1 = cA + (size_t)(t + 1) * kstep;
            const char* a2 = last ? nA : cA + (size_t)(t + 2) * kstep; const char* b2 = last ? nB : cB + (size_t)(t + 2) * kstep;
            const char* a3 = a2 + kstep; const char* b3 = b2 + kstep;
            PG8_LDB(B0, 0, 0); PG8_SCHED; PG8_LDA(At, 0, 0); PG8_STAGE(PG8_SA(1, 1), a1 + hstepA, voffA);
            PG8_WAIT_L(8); PG8_BAR; PG8_WAIT_L(0); PG8_MMA(0, 0, At, B0); PG8_BAR; PG8_SCHED;
            PG8_LDB(B1, 0, 1); PG8_STAGE(PG8_SB(0, 0), b2, voffB);
            PG8_BAR; PG8_WAIT_L(0); PG8_MMA(0, 1, At, B1); PG8_BAR;
            PG8_LDA(At, 0, 1); PG8_STAGE(PG8_SA(0, 0), a2, voffA);
            PG8_BAR; PG8_WAIT_L(0); PG8_MMA(1, 0, At, B0); PG8_BAR; PG8_SCHED;
            PG8_STAGE(PG8_SB(0, 1), b2 + hstepB, voffB);
            PG8_WAIT_V(6); PG8_BAR; PG8_MMA(1, 1, At, B1); PG8_BAR;
            PG8_LDB(B0, 1, 0); PG8_SCHED; PG8_LDA(At, 1, 0); PG8_STAGE(PG8_SA(0, 1), a2 + hstepA, voffA);
            PG8_WAIT_L(8); PG8_BAR; PG8_WAIT_L(0); PG8_MMA(0, 0, At, B0); PG8_BAR; PG8_SCHED;
            PG8_LDB(B1, 1, 1); PG8_STAGE(PG8_SB(1, 0), b3, voffB);
            PG8_BAR; PG8_WAIT_L(0); PG8_MMA(0, 1, At, B1); PG8_BAR;
            PG8_LDA(At, 1, 1); PG8_STAGE(PG8_SA(1, 0), a3, voffA);
            PG8_BAR; PG8_WAIT_L(0); PG8_MMA(1, 0, At, B0); PG8_BAR; PG8_SCHED;
            PG8_STAGE(PG8_SB(1, 1), b3 + hstepB, voffB);
            PG8_WAIT_V(6); PG8_BAR; PG8_MMA(1, 1, At, B1); PG8_BAR;
        }
        E(acc, cur, wr, wc, fr, fq);
        if (!has_next) break;
#pragma unroll
        for (int a = 0; a < 2; ++a)
#pragma unroll
            for (int b = 0; b < 2; ++b)
#pragma unroll
                for (int m = 0; m < 4; ++m)
#pragma unroll
                    for (int n = 0; n < 2; ++n) acc[a][b][m][n] = (f32x4){0.f, 0.f, 0.f, 0.f};
        cur = nxt; cA = nA; cB = nB; ++ui;
    }
    PG8_WAIT_V(0);
    if (wr == 0) PG8_BAR;
    PG8_BAR;
#undef PG8_SA
#undef PG8_SB
#undef PG8_STAGE
#undef PG8_LDA
#undef PG8_LDB
#undef PG8_MMA
#undef PG8_WAIT_V
#undef PG8_WAIT_L
#undef PG8_BAR
#undef PG8_SCHED
#endif
}
}

enum { GK_STORE = 0, GK_GATE0, GK_GATE1, GK_GATE2, GK_PROJ0, GK_PROJ1, GK_PROJ2, GK_RESID };
enum { GP_INPROJ = 0, GP_MERGE, GP_WOUT, GP_QUERY };
struct GemmProg {
    const char* act; const char* wt;
    int which, G, c;
    __device__ __forceinline__ bool next(int i, pg8::Unit& u) const {
        constexpr int nM = M_ / 256;
        constexpr size_t rowA = (size_t)256 * LDZ * 2, rowB = (size_t)256 * 1024 * 2;
        if (which == GP_MERGE) {
            const int L = (i / 6) * G + c, j = i % 6, br = j < 3 ? j : j - 3;
            if (L >= nM * 4) return false;
            pg8::tile_of(L, nM, 4, u.pm, u.pn);
            if (j < 3) { u.A = act + (size_t)C_XN * 2; u.B = wt + ((size_t)(WT_MG + br * 1024) * 1024) * 2; u.kind = GK_GATE0 + br; }
            else { u.A = act + (size_t)(br == 0 ? C_YA : (br == 1 ? C_YB : C_YC)) * 2; u.B = wt + ((size_t)(WT_P + br * 1024) * 1024) * 2; u.kind = GK_PROJ0 + br; }
        } else {
            const int nN = which == GP_INPROJ ? ZN / 256 : (which == GP_WOUT ? 4 : 8);
            const int L = i * G + c;
            if (L >= nM * nN) return false;
            pg8::tile_of(L, nM, nN, u.pm, u.pn);
            u.A = act + (size_t)(which == GP_WOUT ? C_MG : C_XN) * 2;
            u.B = wt + ((size_t)(which == GP_INPROJ ? WT_IN : (which == GP_WOUT ? WT_OUT : WT_Q)) * 1024) * 2;
            u.kind = which == GP_WOUT ? GK_RESID : GK_STORE;
        }
        u.A += (size_t)u.pm * rowA; u.B += (size_t)u.pn * rowB;
        return true;
    }
};
__device__ __forceinline__ int gs_slot(int br) { return br == 0 ? C_GS : (br == 1 ? Z_V : Z_ULRU); }
struct GemmEpi {
    h16_t* act; const float* mb; const float* resid; float* out;
    __device__ __forceinline__ void operator()(const pg8::f32x4 (&acc)[2][2][4][2], const pg8::Unit& u, int wr, int wc, int fr, int fq) const {
        const int row0 = u.pm * 256 + wr * 64 + fr, col0 = u.pn * 256 + wc * 32 + 8 * fq;
#pragma unroll
        for (int ai = 0; ai < 2; ++ai)
#pragma unroll
            for (int m = 0; m < 4; ++m) {
                const int row = row0 + ai * 128 + m * 16;
#pragma unroll
                for (int bj = 0; bj < 2; ++bj) {
                    const int col = col0 + bj * 128;
                    float v[8];
#pragma unroll
                    for (int e = 0; e < 4; ++e) { v[e] = acc[ai][bj][m][0][e]; v[4 + e] = acc[ai][bj][m][1][e]; }
                    h16_t* arow = act + (size_t)row * LDZ;
                    if (u.kind == GK_STORE) {
                        store8h(arow + col, v);
                    } else if (u.kind <= GK_GATE2) {
                        const float* bp = mb + (u.kind - GK_GATE0) * 1024 + col;
                        const float4 b0 = *(const float4*)bp, b1 = *(const float4*)(bp + 4);
                        v[0] = sigmoidf_(v[0] + b0.x); v[1] = sigmoidf_(v[1] + b0.y); v[2] = sigmoidf_(v[2] + b0.z); v[3] = sigmoidf_(v[3] + b0.w);
                        v[4] = sigmoidf_(v[4] + b1.x); v[5] = sigmoidf_(v[5] + b1.y); v[6] = sigmoidf_(v[6] + b1.z); v[7] = sigmoidf_(v[7] + b1.w);
                        store8h(arow + gs_slot(u.kind - GK_GATE0) + col, v);
                    } else if (u.kind <= GK_PROJ2) {
                        float g[8]; load8h(arow + gs_slot(u.kind - GK_PROJ0) + col, g);
                        if (u.kind == GK_PROJ0) {
#pragma unroll
                            for (int e = 0; e < 8; ++e) v[e] = g[e] * v[e];
                        } else {
                            float o[8]; load8h(arow + C_MG + col, o);
#pragma unroll
                            for (int e = 0; e < 8; ++e) v[e] = o[e] + g[e] * v[e];
                        }
                        store8h(arow + C_MG + col, v);
                    } else {
                        const size_t o = (size_t)row * 1024 + col;
                        const float4 r0 = *(const float4*)(resid + o), r1 = *(const float4*)(resid + o + 4);
                        *(float4*)(out + o) = make_float4(r0.x + v[0], r0.y + v[1], r0.z + v[2], r0.w + v[3]);
                        *(float4*)(out + o + 4) = make_float4(r1.x + v[4], r1.y + v[5], r1.z + v[6], r1.w + v[7]);
                    }
                }
            }
    }
};
__device__ __forceinline__ void stage_gemm(KParams p, int l, int which, char* smem) {
    GemmProg S; S.act = p->ws + OFF_ACT; S.wt = p->ws + OFF_WT + (size_t)l * WT_ROWS * 1024 * 2; S.which = which; S.G = gridDim.x; S.c = bid_();
    GemmEpi E; E.act = (h16_t*)(p->ws + OFF_ACT); E.mb = p->in[I_MB] + l * 3072; E.resid = l == 0 ? p->in[I_X] : p->out; E.out = p->out;
    pg8::gemm_phase(smem, S, E);
}

#ifdef CPU_EMU
__device__ __forceinline__ float group_sum(float v, int width, float* scratch) {
    const int tid = tid_();
    scratch[tid] = v;
    __syncthreads();
    float s = 0.f; const int base = tid & ~(width - 1);
    for (int i = 0; i < width; ++i) s += scratch[base + i];
    __syncthreads();
    return s;
}
#else
template <int CTRL> __device__ __forceinline__ float dpp_f(float v) { return __builtin_bit_cast(float, __builtin_amdgcn_update_dpp(0, __builtin_bit_cast(int, v), CTRL, 0xf, 0xf, false)); }
__device__ __forceinline__ float group_sum(float v, int width, float*) {
    v += dpp_f<0xB1>(v);
    v += dpp_f<0x4E>(v);
    if (width >= 8) v += dpp_f<0x141>(v);
    if (width >= 16) v += dpp_f<0x140>(v);
    if (width >= 64) {
        v += __builtin_bit_cast(float, __builtin_amdgcn_update_dpp(0, __builtin_bit_cast(int, v), 0x142, 0xa, 0xf, false));
        v += __builtin_bit_cast(float, __builtin_amdgcn_update_dpp(0, __builtin_bit_cast(int, v), 0x143, 0xc, 0xf, false));
        v = __builtin_bit_cast(float, __builtin_amdgcn_readlane(__builtin_bit_cast(int, v), 63));
    } else if (width >= 32) v += __shfl_xor(v, 16);
    return v;
}
#endif
__device__ __forceinline__ uint4 ldg16(const h16_t* p) { return *(const uint4*)p; }
__device__ __forceinline__ uint4 zero16() { uint4 z; z.x = 0u; z.y = 0u; z.z = 0u; z.w = 0u; return z; }

__device__ __forceinline__ void stage_lru(KParams p, int l, char* smem, int vb0, int nvb) {
    const int vb = bid_() - vb0;
    if (vb < 0 || vb >= nvb) return;
    constexpr int CH = 64;
    float* wa_s = (float*)smem;
    float* wx_s = wa_s + 4096;
    float* xcT = wx_s + 4096;
    float* a_s = xcT + 64 * CH;
    float* b_s = a_s + CH * 64;
    h16_t* ru = (h16_t*)(b_s + CH * 64);
    h16_t* rg = ru + (CH + 3) * 64;
    h16_t* ACT = (h16_t*)(p->ws + OFF_ACT);
    const int tid = tid_(), c = tid & 63, tg = tid >> 6;
    for (int item = vb; item < B_ * 16; item += nvb) {
        const int b = item / 16, n = item % 16, ch = n * 64 + c;
        __syncthreads();
        for (int i = tid; i < 4096; i += NT) { wa_s[i] = p->in[I_LWA][((size_t)l * 16 + n) * 4096 + i]; wx_s[i] = p->in[I_LWX][((size_t)l * 16 + n) * 4096 + i]; }
        const float cw0 = p->in[I_LCW][((size_t)l * 4 + 0) * 1024 + ch], cw1 = p->in[I_LCW][((size_t)l * 4 + 1) * 1024 + ch];
        const float cw2 = p->in[I_LCW][((size_t)l * 4 + 2) * 1024 + ch], cw3 = p->in[I_LCW][((size_t)l * 4 + 3) * 1024 + ch];
        const float cb = p->in[I_LCB][l * 1024 + ch], ba = p->in[I_LBA][l * 1024 + ch], bx = p->in[I_LBX][l * 1024 + ch];
        const float sp = softplusf_(-p->in[I_LLAM][l * 1024 + ch]);
        float hst = 0.f;
        uint4 pf[3];
#define LRU_LOAD(t0_) do { _Pragma("unroll") for (int i = 0; i < 3; ++i) { const int j = tid + NT * i; pf[i] = zero16(); \
            if (j < 536) { const int t = (t0_) - 3 + (j >> 3); if (t >= 0) pf[i] = ldg16(ACT + ((size_t)b * T_ + t) * LDZ + Z_ULRU + n * 64 + (j & 7) * 8); } \
            else if (j < 1048) { const int jj = j - 536; pf[i] = ldg16(ACT + ((size_t)b * T_ + (t0_) + (jj >> 3)) * LDZ + Z_GLRU + n * 64 + (jj & 7) * 8); } } } while (0)
#define LRU_PUT() do { _Pragma("unroll") for (int i = 0; i < 3; ++i) { const int j = tid + NT * i; \
            if (j < 536) *(uint4*)(ru + (j >> 3) * 64 + (j & 7) * 8) = pf[i]; else if (j < 1048) *(uint4*)(rg + ((j - 536) >> 3) * 64 + ((j - 536) & 7) * 8) = pf[i]; } } while (0)
        LRU_LOAD(0);
        LRU_PUT();
        __syncthreads();
#pragma unroll 1
        for (int t0 = 0; t0 < T_; t0 += CH) {
            float xc[8];
            {
                float u[11];
#pragma unroll
                for (int s = 0; s < 11; ++s) u[s] = h2f(ru[(tg * 8 + s) * 64 + c]);
#pragma unroll
                for (int s = 0; s < 8; ++s) { xc[s] = cw0 * u[s] + cw1 * u[s + 1] + cw2 * u[s + 2] + cw3 * u[s + 3] + cb; xcT[c * CH + tg * 8 + s] = xc[s]; }
            }
            __syncthreads();
            if (t0 + CH < T_) LRU_LOAD(t0 + CH);
            {
                float dr[8], di[8];
#pragma unroll
                for (int s = 0; s < 8; ++s) { dr[s] = 0.f; di[s] = 0.f; }
#pragma unroll 4
                for (int i = 0; i < 64; ++i) {
                    const float wa = wa_s[i * 64 + c], wx = wx_s[i * 64 + c];
                    const float4 x0 = *(const float4*)(xcT + i * CH + tg * 8), x1 = *(const float4*)(xcT + i * CH + tg * 8 + 4);
                    dr[0] += x0.x * wa; dr[1] += x0.y * wa; dr[2] += x0.z * wa; dr[3] += x0.w * wa; dr[4] += x1.x * wa; dr[5] += x1.y * wa; dr[6] += x1.z * wa; dr[7] += x1.w * wa;
                    di[0] += x0.x * wx; di[1] += x0.y * wx; di[2] += x0.z * wx; di[3] += x0.w * wx; di[4] += x1.x * wx; di[5] += x1.y * wx; di[6] += x1.z * wx; di[7] += x1.w * wx;
                }
#pragma unroll
                for (int s = 0; s < 8; ++s) {
                    const float r = sigmoidf_(dr[s] + ba), ig = sigmoidf_(di[s] + bx);
                    const float log_a = -8.0f * r * sp;
                    a_s[(tg * 8 + s) * 64 + c] = fexp_(log_a);
                    b_s[(tg * 8 + s) * 64 + c] = sqrtf(fmaxf(1.0f - fexp_(2.0f * log_a), 0.0f)) * (ig * xc[s]);
                }
            }
            __syncthreads();
            if (tid < 64) {
#pragma unroll 8
                for (int t = 0; t < CH; ++t) { hst = a_s[t * 64 + c] * hst + b_s[t * 64 + c]; b_s[t * 64 + c] = hst; }
            }
            __syncthreads();
#pragma unroll
            for (int s = 0; s < 8; ++s) { h16_t* gp = rg + (tg * 8 + s) * 64 + c; *gp = f2h(b_s[(tg * 8 + s) * 64 + c] * geluf_(h2f(*gp))); }
            __syncthreads();
            *(uint4*)(ACT + ((size_t)b * T_ + t0 + (tid >> 3)) * LDZ + Z_GLRU + n * 64 + (tid & 7) * 8) = *(const uint4*)(rg + (tid >> 3) * 64 + (tid & 7) * 8);
            __syncthreads();
            if (t0 + CH < T_) LRU_PUT();
            __syncthreads();
        }
#undef LRU_LOAD
#undef LRU_PUT
    }
}

#ifdef CPU_EMU
struct hfrag { h16_t v[8]; };
struct facc { float d[4]; float& operator[](int i) { return d[i]; } const float& operator[](int i) const { return d[i]; } };
__device__ __forceinline__ facc facc_zero() { facc a; a.d[0] = a.d[1] = a.d[2] = a.d[3] = 0.f; return a; }
__device__ __forceinline__ hfrag frag_u4(uint4 w) { hfrag f; memcpy(&f, &w, 16); return f; }
__device__ __forceinline__ hfrag frag_2u2(uint2 lo, uint2 hi) { hfrag f; memcpy(&f.v[0], &lo, 8); memcpy(&f.v[4], &hi, 8); return f; }
__device__ __forceinline__ hfrag frag_mul(hfrag a, hfrag b) { hfrag f; for (int j = 0; j < 8; ++j) f.v[j] = f2h(h2f(a.v[j]) * h2f(b.v[j])); return f; }
__device__ __forceinline__ facc mfma16(hfrag a, hfrag b, facc c) {
    const int tid = tid_(), w = tid >> 6, l = tid & 63;
    unsigned short (*X)[64][16] = emu::ctx->xscr;
    for (int j = 0; j < 8; ++j) { X[w][l][j] = a.v[j]; X[w][l][8 + j] = b.v[j]; }
    __syncthreads();
    for (int reg = 0; reg < 4; ++reg) {
        const int row = 4 * (l >> 4) + reg, col = l & 15;
        float s = 0.f;
        for (int k = 0; k < 32; ++k) s += h2f(X[w][row + 16 * (k >> 3)][k & 7]) * h2f(X[w][col + 16 * (k >> 3)][8 + (k & 7)]);
        c.d[reg] += s;
    }
    __syncthreads();
    return c;
}
#else
typedef _Float16 hfrag __attribute__((ext_vector_type(8)));
typedef float facc __attribute__((ext_vector_type(4)));
__device__ __forceinline__ facc facc_zero() { return (facc){0.f, 0.f, 0.f, 0.f}; }
__device__ __forceinline__ hfrag frag_u4(uint4 w) { return __builtin_bit_cast(hfrag, w); }
__device__ __forceinline__ hfrag frag_2u2(uint2 lo, uint2 hi) { uint4 w; w.x = lo.x; w.y = lo.y; w.z = hi.x; w.w = hi.y; return __builtin_bit_cast(hfrag, w); }
__device__ __forceinline__ hfrag frag_mul(hfrag a, hfrag b) { return a * b; }
__device__ __forceinline__ facc mfma16(hfrag a, hfrag b, facc c) { return __builtin_amdgcn_mfma_f32_16x16x32_f16(a, b, c, 0, 0, 0); }
#endif
__device__ __forceinline__ hfrag frag_pack8(float a0, float a1, float a2, float a3, float a4, float a5, float a6, float a7) {
    uint4 w; w.x = pack2h(a0, a1); w.y = pack2h(a2, a3); w.z = pack2h(a4, a5); w.w = pack2h(a6, a7); return frag_u4(w);
}
__device__ __forceinline__ hfrag frag_acc2(const facc& t0, const facc& t1) { return frag_pack8(t0[0], t0[1], t0[2], t0[3], t1[0], t1[1], t1[2], t1[3]); }
__device__ __forceinline__ hfrag permfrag(const h16_t* rowp, int ks, int g) { return frag_2u2(*(const uint2*)(rowp + 32 * ks + 4 * g), *(const uint2*)(rowp + 32 * ks + 16 + 4 * g)); }

__device__ __forceinline__ void stage_gdn(KParams p, int l, char* smem, int vb0, int nvb) {
    const int vb = bid_() - vb0;
    if (vb < 0 || vb >= nvb) return;
    constexpr int CH = 64, QS = 136, TS = 72, AS = 68, KTS = 128 * TS + 16 * 8;
#define KTO(d) ((d) * TS + ((d) >> 3) * 8)
    h16_t* Qs = (h16_t*)smem;
    h16_t* Ks = Qs + 64 * QS;
    h16_t* Kt = Ks + 64 * QS;
    h16_t* Vt = Kt + KTS;
    float* A32 = (float*)(Vt + KTS);
    h16_t* ob = (h16_t*)A32;
    h16_t* Tu = (h16_t*)(A32 + 64 * AS);
    h16_t* Tw = Tu + 64 * TS;
    h16_t* QKm = Tw + 64 * TS;
    float* gc_s = (float*)(QKm + 64 * TS);
    float* be_s = gc_s + 64;
    float* e1_s = be_s + 64;
    float* part_s = e1_s + 64;
    float* scr = part_s + 512;
    float* cw_s = scr + 512;
    h16_t* ACT = (h16_t*)(p->ws + OFF_ACT);
    int tid = tid_(), lane = tid & 63, w = tid >> 6, g = lane >> 4, r16 = lane & 15;
    int sg = lane >> 4, pc = lane & 15, rb = w;
#define GDN_ROLES() do { tid = tid_(); lane = tid & 63; w = tid >> 6; g = lane >> 4; r16 = lane & 15; sg = g; pc = r16; rb = w; } while (0)
    for (int item = vb; item < B_ * 8; item += nvb) {
        const int b = item / 8, h = item % 8;
        const float a_exp = fexp_(p->in[I_GALOG][l * 8 + h]), dtb = p->in[I_GDT][l * 8 + h];
        facc S[8];
#pragma unroll
        for (int dt = 0; dt < 8; ++dt) S[dt] = facc_zero();
        __syncthreads();
        for (int i = tid; i < 64 * TS / 2; i += NT) ((unsigned*)QKm)[i] = 0u;
        for (int i = tid; i < 4 * 384; i += NT) { const int jj = i / 384, c3 = i % 384; cw_s[i] = p->in[I_GCW][((size_t)l * 4 + jj) * 3072 + (c3 >> 7) * 1024 + h * 128 + (c3 & 127)]; }
        uint4 pf[11];
#define GDN_LOAD(t0_) do { GDN_ROLES(); const h16_t* colp = ACT + ((size_t)b * T_ + (t0_) + 8 * rb - 3) * LDZ + (sg < 3 ? Z_Q + sg * 1024 : Z_ZG) + h * 128 + pc * 8; \
            _Pragma("unroll") for (int i = 0; i < 11; ++i) { const int t = (t0_) + 8 * rb - 3 + i; pf[i] = (t >= 0 && sg < 3) ? ldg16(colp + (size_t)i * LDZ) : zero16(); } } while (0)
        GDN_LOAD(0);
        h16_t pfa = 0, pfb = 0;
#define GDN_LOADS(t0_) do { if (tid < 64) { const size_t m_ = (size_t)b * T_ + (t0_) + tid; pfa = ACT[m_ * LDZ + Z_ALPHA + h]; pfb = ACT[m_ * LDZ + Z_BETA + h]; } } while (0)
        GDN_LOADS(0);
#pragma unroll 1
        for (int t0 = 0; t0 < T_; t0 += CH) {
            GDN_ROLES();
            if (tid < 64) {
                part_s[tid] = -a_exp * softplusf_(h2f(pfa) + dtb);
                be_s[tid] = sigmoidf_(h2f(pfb));
            }
            __syncthreads();
            if (tid < 64) { float s = 0.f;
#pragma unroll
                for (int i4 = 0; i4 < 16; ++i4) { const float4 pv = *(const float4*)(part_s + i4 * 4); s += (i4 * 4 <= tid ? pv.x : 0.f) + (i4 * 4 + 1 <= tid ? pv.y : 0.f) + (i4 * 4 + 2 <= tid ? pv.z : 0.f) + (i4 * 4 + 3 <= tid ? pv.w : 0.f); }
                gc_s[tid] = s; }
#pragma unroll
            for (int hf = 0; hf < 2; ++hf) {
                float ov[4][8];
#pragma unroll
                for (int i = 0; i < 4; ++i) {
#pragma unroll
                    for (int cc = 0; cc < 8; ++cc) ov[i][cc] = 0.f;
#pragma unroll
                    for (int jj = 0; jj < 4; ++jj) {
                        const uint4 wv = pf[hf * 4 + i + jj];
                        const float* cwp = cw_s + jj * 384 + (sg < 3 ? sg : 0) * 128 + pc * 8;
                        const float4 c0 = *(const float4*)cwp, c1 = *(const float4*)(cwp + 4);
                        ov[i][0] += c0.x * h2f((h16_t)(wv.x & 0xffffu)); ov[i][1] += c0.y * h2f((h16_t)(wv.x >> 16)); ov[i][2] += c0.z * h2f((h16_t)(wv.y & 0xffffu)); ov[i][3] += c0.w * h2f((h16_t)(wv.y >> 16));
                        ov[i][4] += c1.x * h2f((h16_t)(wv.z & 0xffffu)); ov[i][5] += c1.y * h2f((h16_t)(wv.z >> 16)); ov[i][6] += c1.z * h2f((h16_t)(wv.w & 0xffffu)); ov[i][7] += c1.w * h2f((h16_t)(wv.w >> 16));
                    }
                    float ss = 0.f;
#pragma unroll
                    for (int cc = 0; cc < 8; ++cc) { ov[i][cc] = siluf_(ov[i][cc]); ss += ov[i][cc] * ov[i][cc]; }
                    ss = group_sum(ss, 16, scr);
                    const float rn = sg == 0 ? rsqrtf(ss + RMS_EPS) * 0.08838834764831845f : (sg == 1 ? rsqrtf(ss + RMS_EPS) : 1.0f);
#pragma unroll
                    for (int cc = 0; cc < 8; ++cc) ov[i][cc] *= rn;
                    const int t = 8 * rb + hf * 4 + i;
                    if (sg == 0) store8h(Qs + t * QS + pc * 8, ov[i]);
                    else if (sg == 1) store8h(Ks + t * QS + pc * 8, ov[i]);
                }
                if (sg == 1 || sg == 2) {
                    h16_t* dstT = sg == 1 ? Kt : Vt;
#pragma unroll
                    for (int cc = 0; cc < 8; ++cc) { uint2 w2; w2.x = pack2h(ov[0][cc], ov[1][cc]); w2.y = pack2h(ov[2][cc], ov[3][cc]); *(uint2*)(dstT + KTO(pc * 8 + cc) + 8 * rb + hf * 4) = w2; }
                }
            }
            __syncthreads();
            GDN_ROLES();
            if (tid < 64) e1_s[tid] = fexp_(gc_s[63] - gc_s[tid]);
            for (int e = tid; e < 64 * 64; e += NT) { const int i = e >> 6, j = e & 63; if ((j >> 4) > (i >> 4)) A32[i * AS + (j & 7) * 8 + (j >> 3)] = 0.f; }
#pragma unroll 1
            for (int jr = 0; jr < 3; ++jr) {
                const int jb = w + 8 * jr; const bool valid = jb < 20;
                const int kind = (valid && jb >= 10) ? 1 : 0, tix = valid ? (jb % 10) : 0;
                const int ti = tix < 1 ? 0 : (tix < 3 ? 1 : (tix < 6 ? 2 : 3)), tj = tix - (ti * (ti + 1)) / 2;
                const h16_t* ap = (kind ? Qs : Ks) + (16 * ti + r16) * QS + 8 * g; const h16_t* bp = Ks + (16 * tj + r16) * QS + 8 * g;
                facc acc = facc_zero();
#pragma unroll
                for (int ks = 0; ks < 4; ++ks) acc = mfma16(frag_u4(*(const uint4*)(ap + 32 * ks)), frag_u4(*(const uint4*)(bp + 32 * ks)), acc);
                if (valid) {
                    const int j = 16 * tj + r16; const float gj = gc_s[j];
#pragma unroll
                    for (int reg = 0; reg < 4; ++reg) {
                        const int i = 16 * ti + 4 * g + reg;
                        const float dec = fexp_(fminf(gc_s[i] - gj, 0.f));
                        if (kind == 0) A32[i * AS + (j & 7) * 8 + (j >> 3)] = i > j ? be_s[i] * acc[reg] * dec : 0.f;
                        else QKm[i * TS + j] = f2h(i >= j ? acc[reg] * dec : 0.f);
                    }
                }
            }
            __syncthreads();
            GDN_ROLES();
            {
                const int t = tid >> 3, d0 = (tid & 7) * 16; const float eg = fexp_(gc_s[t]);
                float v8[8];
                load8h(Qs + t * QS + d0, v8);
#pragma unroll
                for (int e = 0; e < 8; ++e) v8[e] *= eg;
                store8h(Qs + t * QS + d0, v8);
                load8h(Qs + t * QS + d0 + 8, v8);
#pragma unroll
                for (int e = 0; e < 8; ++e) v8[e] *= eg;
                store8h(Qs + t * QS + d0 + 8, v8);
            }
            {
                const int c = tid >> 3, q = tid & 7;
                const float bc = be_s[c], bgc = bc * fexp_(gc_s[c]);
                float x[8];
#pragma unroll
                for (int i = 0; i < 8; ++i) x[i] = 0.f;
#pragma unroll
                for (int r = 0; r < 64; ++r) {
                    float sacc = 0.f;
                    if (r > 0) {
                        const float4 a0 = *(const float4*)(A32 + r * AS + q * 8);
                        sacc = a0.x * x[0];
                        if (r > 8) sacc += a0.y * x[1];
                        if (r > 16) sacc += a0.z * x[2];
                        if (r > 24) sacc += a0.w * x[3];
                        if (r > 32) {
                            const float4 a1 = *(const float4*)(A32 + r * AS + q * 8 + 4);
                            sacc += a1.x * x[4];
                            if (r > 40) sacc += a1.y * x[5];
                            if (r > 48) sacc += a1.z * x[6];
                            if (r > 56) sacc += a1.w * x[7];
                        }
                        sacc = group_sum(sacc, 8, scr);
                    }
                    const float xr = ((r == c) ? 1.f : 0.f) - sacc;
                    if (q == (r & 7)) { x[r >> 3] = xr; Tu[r * TS + c] = f2h(xr * bc); Tw[r * TS + c] = f2h(xr * bgc); }
                }
            }
            __syncthreads();
            GDN_ROLES();
            facc vn[4], aw[4];
#pragma unroll
            for (int tt = 0; tt < 4; ++tt) { vn[tt] = facc_zero(); aw[tt] = facc_zero(); }
#pragma unroll
            for (int tt = 0; tt < 4; ++tt)
#pragma unroll
                for (int ks = 0; ks <= (tt >> 1); ++ks) {
                    const hfrag au = frag_u4(*(const uint4*)(Tu + (16 * tt + r16) * TS + 32 * ks + 8 * g)), aww = frag_u4(*(const uint4*)(Tw + (16 * tt + r16) * TS + 32 * ks + 8 * g));
                    vn[tt] = mfma16(au, frag_u4(*(const uint4*)(Vt + KTO(16 * w + r16) + 32 * ks + 8 * g)), vn[tt]);
                    aw[tt] = mfma16(aww, frag_u4(*(const uint4*)(Kt + KTO(16 * w + r16) + 32 * ks + 8 * g)), aw[tt]);
                }
#pragma unroll
            for (int tt = 0; tt < 4; ++tt)
#pragma unroll
                for (int reg = 0; reg < 4; ++reg) Ks[(16 * tt + 4 * g + reg) * QS + 16 * w + r16] = f2h(-aw[tt][reg]);
            __syncthreads();
            GDN_ROLES();
            h16_t zraw[16];
#pragma unroll
            for (int tt = 0; tt < 4; ++tt)
#pragma unroll
                for (int reg = 0; reg < 4; ++reg) zraw[tt * 4 + reg] = ACT[((size_t)b * T_ + t0 + 16 * tt + 4 * g + reg) * LDZ + Z_ZG + h * 128 + 16 * w + r16];
            hfrag Sb[4];
#pragma unroll
            for (int ks = 0; ks < 4; ++ks) Sb[ks] = frag_acc2(S[2 * ks], S[2 * ks + 1]);
            facc oc[4];
#pragma unroll
            for (int tt = 0; tt < 4; ++tt) {
                oc[tt] = facc_zero();
                const h16_t* wrow = Ks + (16 * tt + r16) * QS; const h16_t* qrow = Qs + (16 * tt + r16) * QS;
#pragma unroll
                for (int ks = 0; ks < 4; ++ks) { vn[tt] = mfma16(permfrag(wrow, ks, g), Sb[ks], vn[tt]); oc[tt] = mfma16(permfrag(qrow, ks, g), Sb[ks], oc[tt]); }
            }
            hfrag VNb[2];
            VNb[0] = frag_acc2(vn[0], vn[1]); VNb[1] = frag_acc2(vn[2], vn[3]);
#pragma unroll
            for (int tt = 0; tt < 4; ++tt)
#pragma unroll
                for (int ks2 = 0; ks2 <= (tt >> 1); ++ks2) oc[tt] = mfma16(permfrag(QKm + (16 * tt + r16) * TS, ks2, g), VNb[ks2], oc[tt]);
            {
                const float egl = fexp_(gc_s[63]);
                hfrag e1f[2];
#pragma unroll
                for (int ks2 = 0; ks2 < 2; ++ks2) { const float* ep = e1_s + 32 * ks2 + 4 * g; e1f[ks2] = frag_pack8(ep[0], ep[1], ep[2], ep[3], ep[16], ep[17], ep[18], ep[19]); }
#pragma unroll
                for (int dt = 0; dt < 8; ++dt) {
#pragma unroll
                    for (int reg = 0; reg < 4; ++reg) S[dt][reg] *= egl;
#pragma unroll
                    for (int ks2 = 0; ks2 < 2; ++ks2) S[dt] = mfma16(frag_mul(permfrag(Kt + KTO(16 * dt + r16), ks2, g), e1f[ks2]), VNb[ks2], S[dt]);
                }
            }
            if (t0 + CH < T_) { GDN_LOAD(t0 + CH); GDN_LOADS(t0 + CH); }
            GDN_ROLES();
#pragma unroll
            for (int tt = 0; tt < 4; ++tt)
#pragma unroll
                for (int reg = 0; reg < 4; ++reg) { const float ss = group_sum(oc[tt][reg] * oc[tt][reg], 16, scr); if (r16 == 0) part_s[w * 64 + 16 * tt + 4 * g + reg] = ss; }
            __syncthreads();
            const float nw = p->in[I_GNW][l * 128 + w * 16 + r16];
#pragma unroll
            for (int tt = 0; tt < 4; ++tt)
#pragma unroll
                for (int reg = 0; reg < 4; ++reg) {
                    const int t = 16 * tt + 4 * g + reg;
                    float ms = 0.f;
#pragma unroll
                    for (int ww = 0; ww < 8; ++ww) ms += part_s[ww * 64 + t];
                    ob[t * 128 + 16 * w + r16] = f2h(oc[tt][reg] * rsqrtf(ms * (1.0f / 128.0f) + RMS_EPS) * nw * siluf_(h2f(zraw[tt * 4 + reg])));
                }
            __syncthreads();
            GDN_ROLES();
#pragma unroll
            for (int i = 0; i < 2; ++i) { const int j = tid + NT * i; *(uint4*)(ACT + ((size_t)b * T_ + t0 + (j >> 4)) * LDZ + Z_ZG + h * 128 + (j & 15) * 8) = *(const uint4*)(ob + (j >> 4) * 128 + (j & 15) * 8); }
            __syncthreads();
        }
#undef GDN_LOAD
#undef GDN_LOADS
#undef KTO
#undef GDN_ROLES
    }
}

#ifndef CPU_EMU
typedef _Float16 rw_f16x8 __attribute__((ext_vector_type(8)));
typedef float rw_f32x4 __attribute__((ext_vector_type(4)));
#endif
__device__ __forceinline__ void stage_rwkv(KParams p, int l, char* smem, int vb0, int nvb) {
    const int vb = bid_() - vb0;
    if (vb < 0 || vb >= nvb) return;
    constexpr int CH = 32, XS = 264;
    float* r_s = (float*)smem;
    float* k_s = r_s + CH * 64;
    float* v_s = k_s + CH * 64;
    float* w_s = v_s + CH * 64;
    float* kk_s = w_s + CH * 64;
    float* ka_s = kk_s + CH * 64;
    float* g_s = ka_s + CH * 64;
    float* o_s = g_s + CH * 64;
    float* bon_s = o_s + CH * 64;
    float* scr = bon_s + CH;
    h16_t* raw = (h16_t*)(scr + 512);
    h16_t* xs = raw + (CH + 1) * 448;
    h16_t* ACT = (h16_t*)(p->ws + OFF_ACT);
    int tid = tid_(), c = tid & 63, tg = tid >> 6;
    int ri = tid >> 3, q8 = tid & 7;
#define RW_ROLES() do { tid = tid_(); c = tid & 63; tg = tid >> 6; ri = tid >> 3; q8 = tid & 7; } while (0)
    float* cst_s = (float*)(xs + CH * XS);
    for (int item = vb; item < B_ * 16; item += nvb) {
        const int b = item / 16, h = item % 16, ch = h * 64 + c;
        __syncthreads();
        if (tid < 64) {
            const float* mu = p->in[I_RMU] + (size_t)l * RWW;
            cst_s[0 * 64 + c] = p->in[I_RW0][l * 1024 + ch]; cst_s[1 * 64 + c] = p->in[I_RA0][l * 1024 + ch]; cst_s[2 * 64 + c] = p->in[I_RKK][l * 1024 + ch]; cst_s[3 * 64 + c] = p->in[I_RKA][l * 1024 + ch];
            cst_s[4 * 64 + c] = p->in[I_RRK][(size_t)l * 1024 + ch]; cst_s[5 * 64 + c] = p->in[I_RLW][l * 1024 + ch]; cst_s[6 * 64 + c] = p->in[I_RLB][l * 1024 + ch];
            cst_s[7 * 64 + c] = mu[RW_R + ch]; cst_s[8 * 64 + c] = mu[RW_K + ch]; cst_s[9 * 64 + c] = mu[RW_V + ch];
            cst_s[10 * 64 + c] = mu[RW_WL + c]; cst_s[11 * 64 + c] = mu[RW_AL + c]; cst_s[12 * 64 + c] = mu[RW_GL + c]; cst_s[13 * 64 + c] = mu[RW_GL + 64 + c];
        }
        const float* wup = p->in[I_RWUP] + (size_t)l * 64 * 1024 + h * 64; const float* aup = p->in[I_RAUP] + (size_t)l * 64 * 1024 + h * 64; const float* gup = p->in[I_RGUP] + (size_t)l * 128 * 1024 + h * 64;
#ifndef CPU_EMU
        const int wid = tid >> 6, lane = tid & 63, mt = wid >> 2, nt = wid & 3;
        rw_f16x8 bw[2], ba_[2], bg[4];
        {
            const int cn = nt * 16 + (lane & 15), kb = 8 * (lane >> 4);
#pragma unroll
            for (int ks = 0; ks < 2; ++ks)
#pragma unroll
                for (int j = 0; j < 8; ++j) { bw[ks][j] = (_Float16)wup[(size_t)(ks * 32 + kb + j) * 1024 + cn]; ba_[ks][j] = (_Float16)aup[(size_t)(ks * 32 + kb + j) * 1024 + cn]; }
#pragma unroll
            for (int ks = 0; ks < 4; ++ks)
#pragma unroll
                for (int j = 0; j < 8; ++j) bg[ks][j] = (_Float16)gup[(size_t)(ks * 32 + kb + j) * 1024 + cn];
        }
#endif
        float S[8];
#pragma unroll
        for (int e = 0; e < 8; ++e) S[e] = 0.f;
        uint4 pf[4];
#define RW_LOAD(t0_) do { _Pragma("unroll") for (int i = 0; i < 4; ++i) { const int j = tid + NT * i, row = j / 56, u = j % 56, t = (t0_) - 1 + row; pf[i] = zero16(); \
            if (j < (CH + 1) * 56 && t >= 0) pf[i] = ldg16(ACT + ((size_t)b * T_ + t) * LDZ + Z_RW + (u < 24 ? (u >> 3) * 1024 + h * 64 + (u & 7) * 8 : 3072 + (u - 24) * 8)); } } while (0)
#define RW_PUT() do { _Pragma("unroll") for (int i = 0; i < 4; ++i) { const int j = tid + NT * i; if (j < (CH + 1) * 56) *(uint4*)(raw + (j / 56) * 448 + (j % 56) * 8) = pf[i]; } } while (0)
        __syncthreads();
        RW_LOAD(0);
        RW_PUT();
        __syncthreads();
#pragma unroll 1
        for (int t0 = 0; t0 < T_; t0 += CH) {
            RW_ROLES();
            {
            const float mu_r = cst_s[7 * 64 + c], mu_k = cst_s[8 * 64 + c], mu_v = cst_s[9 * 64 + c], mu_wl = cst_s[10 * 64 + c], mu_al = cst_s[11 * 64 + c], mu_g0 = cst_s[12 * 64 + c], mu_g1 = cst_s[13 * 64 + c];
#pragma unroll
            for (int s = 0; s < 4; ++s) {
                const int tl = tg * 4 + s;
                const h16_t* zc = raw + (tl + 1) * 448; const h16_t* zp = raw + tl * 448;
#define RW_SHIFT(col, muv) ({ const float zz = h2f(zc[col]); zz + (muv) * (h2f(zp[col]) - zz); })
                r_s[tl * 64 + c] = RW_SHIFT(c, mu_r);
                k_s[tl * 64 + c] = RW_SHIFT(64 + c, mu_k);
                v_s[tl * 64 + c] = RW_SHIFT(128 + c, mu_v);
                xs[tl * XS + c] = f2h(tanhf_(RW_SHIFT(192 + c, mu_wl)));
                xs[tl * XS + 64 + c] = f2h(RW_SHIFT(256 + c, mu_al));
                xs[tl * XS + 128 + c] = f2h(sigmoidf_(RW_SHIFT(320 + c, mu_g0)));
                xs[tl * XS + 192 + c] = f2h(sigmoidf_(RW_SHIFT(384 + c, mu_g1)));
#undef RW_SHIFT
            }
            }
            __syncthreads();
#ifdef CPU_EMU
#pragma unroll
            for (int s = 0; s < 4; ++s) {
                const int tl = tg * 4 + s;
                float dw = 0.f, da = 0.f, dg = 0.f;
                for (int i = 0; i < 64; ++i) { dw += h2f(xs[tl * XS + i]) * h2f(f2h(wup[(size_t)i * 1024 + c])); da += h2f(xs[tl * XS + 64 + i]) * h2f(f2h(aup[(size_t)i * 1024 + c])); }
                for (int i = 0; i < 128; ++i) dg += h2f(xs[tl * XS + 128 + i]) * h2f(f2h(gup[(size_t)i * 1024 + c]));
                w_s[tl * 64 + c] = dw; ka_s[tl * 64 + c] = da; g_s[tl * 64 + c] = dg;
            }
#else
            {
                const h16_t* ap = xs + (mt * 16 + (lane & 15)) * XS + 8 * (lane >> 4);
                rw_f32x4 dw = {0.f, 0.f, 0.f, 0.f}, da = {0.f, 0.f, 0.f, 0.f}, dg = {0.f, 0.f, 0.f, 0.f};
#pragma unroll
                for (int ks = 0; ks < 2; ++ks) {
                    dw = __builtin_amdgcn_mfma_f32_16x16x32_f16(*(const rw_f16x8*)(ap + ks * 32), bw[ks], dw, 0, 0, 0);
                    da = __builtin_amdgcn_mfma_f32_16x16x32_f16(*(const rw_f16x8*)(ap + 64 + ks * 32), ba_[ks], da, 0, 0, 0);
                }
#pragma unroll
                for (int ks = 0; ks < 4; ++ks) dg = __builtin_amdgcn_mfma_f32_16x16x32_f16(*(const rw_f16x8*)(ap + 128 + ks * 32), bg[ks], dg, 0, 0, 0);
#pragma unroll
                for (int rg = 0; rg < 4; ++rg) { const int o = (mt * 16 + 4 * (lane >> 4) + rg) * 64 + nt * 16 + (lane & 15); w_s[o] = dw[rg]; ka_s[o] = da[rg]; g_s[o] = dg[rg]; }
            }
#endif
            __syncthreads();
            RW_ROLES();
            {
            const float w0 = cst_s[0 * 64 + c], a0 = cst_s[1 * 64 + c], k_k = cst_s[2 * 64 + c], k_a = cst_s[3 * 64 + c], rk_c = cst_s[4 * 64 + c];
#pragma unroll
            for (int s = 0; s < 4; ++s) {
                const int tl = tg * 4 + s;
                const float w_log = -softplusf_(-(w0 + w_s[tl * 64 + c])) - 0.5f;
                const float decay = fexp_(-fexp_(w_log));
                const float a = sigmoidf_(a0 + ka_s[tl * 64 + c]);
                const float kx = k_s[tl * 64 + c], rx = r_s[tl * 64 + c];
                const float kkr = kx * k_k, k2 = kx * (1.0f + (a - 1.0f) * k_a);
                const float nsq = group_sum(kkr * kkr, 64, scr);
                const float bon = group_sum(rx * k2 * rk_c, 64, scr);
                const float kkn = kkr * rsqrtf(nsq + RMS_EPS);
                w_s[tl * 64 + c] = decay; k_s[tl * 64 + c] = k2; kk_s[tl * 64 + c] = kkn; ka_s[tl * 64 + c] = kkn * a;
                if (c == 0) bon_s[tl] = bon;
            }
            }
            __syncthreads();
            RW_ROLES();
            {
                struct StepVec { float4 kk0, kk1, w0, w1, a0, a1, k0, k1, r0, r1; float vi; };
#define RW_LDSTEP(V_, t_) do { const int o8_ = (t_) * 64 + q8 * 8; V_.kk0 = *(const float4*)(kk_s + o8_); V_.kk1 = *(const float4*)(kk_s + o8_ + 4); V_.w0 = *(const float4*)(w_s + o8_); V_.w1 = *(const float4*)(w_s + o8_ + 4); \
                    V_.a0 = *(const float4*)(ka_s + o8_); V_.a1 = *(const float4*)(ka_s + o8_ + 4); V_.k0 = *(const float4*)(k_s + o8_); V_.k1 = *(const float4*)(k_s + o8_ + 4); \
                    V_.r0 = *(const float4*)(r_s + o8_); V_.r1 = *(const float4*)(r_s + o8_ + 4); V_.vi = v_s[(t_) * 64 + ri]; } while (0)
#define RW_STEP(V_, t_) do { \
                    const float pk = (S[0] * V_.kk0.x + S[1] * V_.kk0.y) + (S[2] * V_.kk0.z + S[3] * V_.kk0.w) + ((S[4] * V_.kk1.x + S[5] * V_.kk1.y) + (S[6] * V_.kk1.z + S[7] * V_.kk1.w)); \
                    const float skk = group_sum(pk, 8, scr); const float vi = V_.vi; \
                    S[0] = S[0] * V_.w0.x - skk * V_.a0.x + vi * V_.k0.x; S[1] = S[1] * V_.w0.y - skk * V_.a0.y + vi * V_.k0.y; S[2] = S[2] * V_.w0.z - skk * V_.a0.z + vi * V_.k0.z; S[3] = S[3] * V_.w0.w - skk * V_.a0.w + vi * V_.k0.w; \
                    S[4] = S[4] * V_.w1.x - skk * V_.a1.x + vi * V_.k1.x; S[5] = S[5] * V_.w1.y - skk * V_.a1.y + vi * V_.k1.y; S[6] = S[6] * V_.w1.z - skk * V_.a1.z + vi * V_.k1.z; S[7] = S[7] * V_.w1.w - skk * V_.a1.w + vi * V_.k1.w; \
                    const float po = (S[0] * V_.r0.x + S[1] * V_.r0.y) + (S[2] * V_.r0.z + S[3] * V_.r0.w) + ((S[4] * V_.r1.x + S[5] * V_.r1.y) + (S[6] * V_.r1.z + S[7] * V_.r1.w)); \
                    const float o = group_sum(po, 8, scr); \
                    if (q8 == 0) o_s[(t_) * 64 + ri] = o; } while (0)
                StepVec va, vb;
                RW_LDSTEP(va, 0);
#pragma unroll 1
                for (int t = 0; t < CH; t += 2) {
                    RW_LDSTEP(vb, t + 1);
                    RW_STEP(va, t);
                    if (t + 2 < CH) RW_LDSTEP(va, t + 2);
                    RW_STEP(vb, t + 1);
                }
#undef RW_LDSTEP
#undef RW_STEP
            }
            if (t0 + CH < T_) RW_LOAD(t0 + CH);
            __syncthreads();
            RW_ROLES();
            {
            const float lnw = cst_s[5 * 64 + c], lnb = cst_s[6 * 64 + c];
            const int ch = h * 64 + c;
#pragma unroll
            for (int s = 0; s < 4; ++s) {
                const int tl = tg * 4 + s;
                const float ov = o_s[tl * 64 + c];
                const float mean = group_sum(ov, 64, scr) * (1.0f / 64.0f);
                const float d = ov - mean;
                const float var = group_sum(d * d, 64, scr) * (1.0f / 64.0f);
                const float y = (d * rsqrtf(var + GN_EPS) * lnw + lnb + bon_s[tl] * v_s[tl * 64 + c]) * g_s[tl * 64 + c];
                ACT[((size_t)b * T_ + t0 + tl) * LDZ + C_YC + ch] = f2h(y);
            }
            }
            RW_ROLES();
            if (t0 + CH < T_) RW_PUT();
            __syncthreads();
        }
#undef RW_LOAD
#undef RW_PUT
#undef RW_ROLES
    }
}

constexpr bool TAB_IN_ACT = (M_ == 16384);
constexpr float TAB_SU = 256.0f, TAB_SV = 32.0f;
__device__ __forceinline__ unsigned char* tab_row(char* ws, int e) {
    if (TAB_IN_ACT) return (unsigned char*)((h16_t*)(ws + OFF_ACT) + (size_t)e * LDZ + C_GS);
    return (unsigned char*)(ws + OFF_TAB) + (size_t)e * 2048;
}
#ifdef CPU_EMU
__device__ __forceinline__ unsigned f2fp8(float f) {
    const unsigned sgn = f < 0.f ? 0x80u : 0u; float a = fabsf(f);
    if (!(a == a)) return 0x7fu;
    if (a >= 448.0f) return sgn | 0x7eu;
    if (a < 0.0009765625f) return sgn;
    int e; frexpf(a, &e); e -= 1;
    if (e < -6) { const float q = nearbyintf(a * 512.0f); return sgn | (unsigned)q; }
    float q = nearbyintf((a / ldexpf(1.0f, e) - 1.0f) * 8.0f);
    if (q >= 8.0f) { q = 0.f; e += 1; }
    if (e > 8) return sgn | 0x7eu;
    const unsigned r = ((unsigned)(e + 7) << 3) | (unsigned)q;
    return sgn | (r > 0x7eu ? 0x7eu : r);
}
__device__ __forceinline__ float fp82f(unsigned b) {
    const unsigned e = (b >> 3) & 15u, m = b & 7u; const float s = (b & 0x80u) ? -1.f : 1.f;
    if (e == 0) return s * (float)m * 0.001953125f;
    return s * ldexpf(1.0f + (float)m * 0.125f, (int)e - 7);
}
__device__ __forceinline__ unsigned pack4fp8(float a, float b, float c, float d) { return f2fp8(a) | (f2fp8(b) << 8) | (f2fp8(c) << 16) | (f2fp8(d) << 24); }
__device__ __forceinline__ void dec4fp8(unsigned w, float* o) { o[0] = fp82f(w & 255u); o[1] = fp82f((w >> 8) & 255u); o[2] = fp82f((w >> 16) & 255u); o[3] = fp82f(w >> 24); }
#else
__device__ __forceinline__ unsigned pack4fp8(float a, float b, float c, float d) { int p = __builtin_amdgcn_cvt_pk_fp8_f32(a, b, 0, false); p = __builtin_amdgcn_cvt_pk_fp8_f32(c, d, p, true); return (unsigned)p; }
__device__ __forceinline__ void dec4fp8(unsigned w, float* o) { const auto lo = __builtin_amdgcn_cvt_pk_f32_fp8((int)w, false); const auto hi = __builtin_amdgcn_cvt_pk_f32_fp8((int)w, true); o[0] = lo[0]; o[1] = lo[1]; o[2] = hi[0]; o[3] = hi[1]; }
#endif
__device__ __forceinline__ void stage_tabconv(KParams p, int l) {
    const int tid = tid_();
    const float* U = p->in[I_PU] + (size_t)l * 16384 * 1024; const float* V = p->in[I_PV] + (size_t)l * 16384 * 1024;
    char* ws = p->ws;
    for (int it = bid_() * NT + tid; it < 16384 * 128; it += gridDim.x * NT) {
        const int r = it >> 7, ck = it & 127, which = ck >> 6, c16 = ck & 63;
        const float* src = (which ? V : U) + (size_t)r * 1024 + c16 * 16;
        const float sc = which ? TAB_SV : TAB_SU;
        const float4 a = *(const float4*)src, b = *(const float4*)(src + 4), c = *(const float4*)(src + 8), d = *(const float4*)(src + 12);
        uint4 w;
        w.x = pack4fp8(a.x * sc, a.y * sc, a.z * sc, a.w * sc); w.y = pack4fp8(b.x * sc, b.y * sc, b.z * sc, b.w * sc);
        w.z = pack4fp8(c.x * sc, c.y * sc, c.z * sc, c.w * sc); w.w = pack4fp8(d.x * sc, d.y * sc, d.z * sc, d.w * sc);
        *(uint4*)(tab_row(ws, r) + which * 1024 + c16 * 16) = w;
    }
}

#ifdef CPU_EMU
__device__ __forceinline__ float group_max16(float v, float* scr) {
    const int tid = tid_();
    scr[tid] = v;
    __syncthreads();
    float m = -3.0e38f; const int base = tid & ~15;
    for (int i = 0; i < 16; ++i) m = fmaxf(m, scr[base + i]);
    __syncthreads();
    return m;
}
#else
__device__ __forceinline__ float group_max16(float v, float*) {
    v = fmaxf(v, dpp_f<0xB1>(v)); v = fmaxf(v, dpp_f<0x4E>(v)); v = fmaxf(v, dpp_f<0x141>(v)); v = fmaxf(v, dpp_f<0x140>(v));
    return v;
}
#endif
__device__ __forceinline__ void stage_peer_topk(KParams p, int l, char* smem) {
    constexpr int KS = 136;
    h16_t* khi = (h16_t*)smem;
    h16_t* klo = khi + 128 * KS;
    float* scr = (float*)(klo + 128 * KS);
    const h16_t* ACT = (const h16_t*)(p->ws + OFF_ACT);
    float* TOPS = (float*)(p->ws + OFF_TOPS);
    int tid = tid_(), lane = tid & 63, w = tid >> 6, g = lane >> 4, r16 = lane & 15;
#define TK_ROLES() do { tid = tid_(); lane = tid & 63; w = tid >> 6; g = lane >> 4; r16 = lane & 15; } while (0)
    const int nb = gridDim.x;
    for (int hs = bid_() % 16; hs < 16; hs += nb) {
        const int hd = hs >> 1, s = hs & 1;
        __syncthreads();
        {
            const float* kp = p->in[I_PKEYS] + (((size_t)l * 8 + hd) * 2 + s) * 128 * 128;
            for (int i = tid * 4; i < 128 * 128; i += NT * 4) {
                const float4 kv = *(const float4*)(kp + i);
                const int n = i >> 7, c0 = i & 127;
                const float h0 = h2f(f2h(kv.x)), h1 = h2f(f2h(kv.y)), h2 = h2f(f2h(kv.z)), h3 = h2f(f2h(kv.w));
                uint2 hw, lw; hw.x = pack2h(kv.x, kv.y); hw.y = pack2h(kv.z, kv.w); lw.x = pack2h(kv.x - h0, kv.y - h1); lw.y = pack2h(kv.z - h2, kv.w - h3);
                *(uint2*)(khi + n * KS + c0) = hw; *(uint2*)(klo + n * KS + c0) = lw;
            }
        }
        __syncthreads();
        const int nblk = nb >= 16 ? nb / 16 : 1, bsub = nb >= 16 ? bid_() / 16 : 0;
        for (int chunk = bsub; chunk < (M_ + NT - 1) / NT; chunk += nblk) {
            if (nb >= 16 && bid_() >= nblk * 16) break;
#pragma unroll 1
            for (int tt = 0; tt < 4; ++tt) {
                TK_ROLES();
                const int tok0 = chunk * NT + w * 64 + tt * 16;
                const bool live = tok0 < M_;
                hfrag af[4];
                {
                    const h16_t* qp = ACT + (size_t)(live ? tok0 + r16 : 0) * LDZ + C_QRY + hd * 256 + s * 128 + 8 * g;
#pragma unroll
                    for (int ks = 0; ks < 4; ++ks) af[ks] = frag_u4(*(const uint4*)(qp + 32 * ks));
                }
                facc acc[8];
#pragma unroll
                for (int nt = 0; nt < 8; ++nt) {
                    acc[nt] = facc_zero();
                    const h16_t* bh = khi + (16 * nt + r16) * KS + 8 * g; const h16_t* bl = klo + (16 * nt + r16) * KS + 8 * g;
#pragma unroll
                    for (int ks = 0; ks < 4; ++ks) { acc[nt] = mfma16(af[ks], frag_u4(*(const uint4*)(bh + 32 * ks)), acc[nt]); acc[nt] = mfma16(af[ks], frag_u4(*(const uint4*)(bl + 32 * ks)), acc[nt]); }
                }
#pragma unroll 1
                for (int rp = 0; rp < 2; ++rp) {
                  TK_ROLES();
#pragma unroll
                  for (int r2 = 0; r2 < 2; ++r2) {
                    const int reg = rp * 2 + r2;
                    float v[8];
#pragma unroll
                    for (int nt = 0; nt < 8; ++nt) { const float av = rp == 0 ? (r2 == 0 ? acc[nt][0] : acc[nt][1]) : (r2 == 0 ? acc[nt][2] : acc[nt][3]); v[nt] = __uint_as_float((__float_as_uint(av) & ~127u) | (unsigned)(127 - (16 * nt + r16))); }
#define CE(i, j) { const float hi_ = fmaxf(v[i], v[j]), lo_ = fminf(v[i], v[j]); v[i] = hi_; v[j] = lo_; }
                    CE(0, 1) CE(2, 3) CE(4, 5) CE(6, 7) CE(0, 2) CE(1, 3) CE(4, 6) CE(5, 7) CE(1, 2) CE(5, 6) CE(0, 4) CE(1, 5) CE(2, 6) CE(3, 7) CE(2, 4) CE(3, 5) CE(1, 2) CE(3, 4) CE(5, 6)
#undef CE
                    float res = 0.f;
#pragma unroll
                    for (int rnd = 0; rnd < 16; ++rnd) {
                        const float m = group_max16(v[0], scr);
                        const bool win = v[0] == m;
#pragma unroll
                        for (int i = 0; i < 7; ++i) v[i] = win ? v[i + 1] : v[i];
                        v[7] = win ? -3.0e38f : v[7];
                        res = (r16 == rnd) ? m : res;
                    }
                    if (live) TOPS[(((size_t)(tok0 + 4 * g + reg) * 8 + hd) * 2 + s) * 16 + r16] = res;
                  }
                }
            }
        }
    }
}

#undef TK_ROLES
__device__ __forceinline__ void peer_cand(int k, int& i, int& j) {
    if (k < 16) { i = 0; j = k; } else if (k < 24) { i = 1; j = k - 16; } else if (k < 29) { i = 2; j = k - 24; } else if (k < 33) { i = 3; j = k - 29; }
    else if (k < 36) { i = 4; j = k - 33; } else if (k < 38) { i = 5; j = k - 36; } else if (k < 40) { i = 6; j = k - 38; } else if (k < 42) { i = 7; j = k - 40; }
    else { i = k - 34; j = 0; }
}
__device__ __forceinline__ float dot16q(const uint4 a, const float (&x)[16]) {
    float t[4], s0, s1;
    dec4fp8(a.x, t); s0 = t[0] * x[0] + t[1] * x[1]; s1 = t[2] * x[2] + t[3] * x[3];
    dec4fp8(a.y, t); s0 += t[0] * x[4] + t[1] * x[5]; s1 += t[2] * x[6] + t[3] * x[7];
    dec4fp8(a.z, t); s0 += t[0] * x[8] + t[1] * x[9]; s1 += t[2] * x[10] + t[3] * x[11];
    dec4fp8(a.w, t); s0 += t[0] * x[12] + t[1] * x[13]; s1 += t[2] * x[14] + t[3] * x[15];
    return s0 + s1;
}
__device__ __forceinline__ void axpy16q(const uint4 a, float s, float (&y)[16]) {
    float t[4];
    dec4fp8(a.x, t); y[0] += s * t[0]; y[1] += s * t[1]; y[2] += s * t[2]; y[3] += s * t[3];
    dec4fp8(a.y, t); y[4] += s * t[0]; y[5] += s * t[1]; y[6] += s * t[2]; y[7] += s * t[3];
    dec4fp8(a.z, t); y[8] += s * t[0]; y[9] += s * t[1]; y[10] += s * t[2]; y[11] += s * t[3];
    dec4fp8(a.w, t); y[12] += s * t[0]; y[13] += s * t[1]; y[14] += s * t[2]; y[15] += s * t[3];
}
#ifdef CPU_EMU
__device__ __forceinline__ float lane_xor(float v, int mask, float* scr) { const int tid = tid_(); scr[tid] = v; __syncthreads(); const float r = scr[tid ^ mask]; __syncthreads(); return r; }
__device__ __forceinline__ float lane_bcast(float v, int src, float* scr) { const int tid = tid_(); scr[tid] = v; __syncthreads(); const float r = scr[(tid & ~63) + src]; __syncthreads(); return r; }
#else
__device__ __forceinline__ float lane_xor(float v, int mask, float*) { return mask == 1 ? dpp_f<0xB1>(v) : (mask == 2 ? dpp_f<0x4E>(v) : __shfl_xor(v, mask)); }
__device__ __forceinline__ float lane_bcast(float v, int src, float*) { return __builtin_bit_cast(float, __builtin_amdgcn_readlane(__builtin_bit_cast(int, v), src)); }
#endif
__device__ __forceinline__ float reduce8(const float (&v)[8], int lane, float* scr) {
    const bool b0 = lane & 1, b1 = lane & 2, b2 = lane & 4;
    float w4[4], u2[2];
#pragma unroll
    for (int j = 0; j < 4; ++j) { const float keep = b0 ? v[2 * j + 1] : v[2 * j], send = b0 ? v[2 * j] : v[2 * j + 1]; w4[j] = keep + lane_xor(send, 1, scr); }
#pragma unroll
    for (int j = 0; j < 2; ++j) { const float keep = b1 ? w4[2 * j + 1] : w4[2 * j], send = b1 ? w4[2 * j] : w4[2 * j + 1]; u2[j] = keep + lane_xor(send, 2, scr); }
    float z = (b2 ? u2[1] : u2[0]) + lane_xor(b2 ? u2[0] : u2[1], 4, scr);
    z += lane_xor(z, 8, scr); z += lane_xor(z, 16, scr); z += lane_xor(z, 32, scr);
    return z;
}
__device__ __forceinline__ void stage_peer_gather(KParams p, int l, char* smem) {
    int tid = tid_(), w = tid >> 6, lane = tid & 63;
    float* base; float* tops_s; float* cand_s; float* best_s; int* idx_s; float* gate_s; int* pos_s;
#define PG_ROLES() do { tid = tid_(); w = tid >> 6; lane = tid & 63; base = (float*)smem + w * 2048; tops_s = base; cand_s = tops_s + 256; best_s = cand_s + 64; \
        idx_s = (int*)(best_s + 128); gate_s = (float*)(idx_s + 128); pos_s = (int*)(gate_s + 128); } while (0)
    PG_ROLES();
    float* scr = (float*)smem + 8 * 2048;
    h16_t* ACT = (h16_t*)(p->ws + OFF_ACT);
    const float* TOPS = (const float*)(p->ws + OFF_TOPS);
    char* ws = p->ws;
    const float* nxt_w = (l + 1 < NL_) ? p->in[I_NMIX] + (l + 1) * 1024 : p->in[I_NFINAL];
    const int nwaves = gridDim.x * 8;
    for (int m = bid_() * 8 + w; m < M_; m += nwaves) {
        PG_ROLES();
        __syncthreads();
        *(float4*)(tops_s + lane * 4) = *(const float4*)(TOPS + (size_t)m * 256 + lane * 4);
        float x[16];
        { float t8[8]; load8h(ACT + (size_t)m * LDZ + C_XN + lane * 16, t8);
#pragma unroll
          for (int j = 0; j < 8; ++j) x[j] = t8[j];
          load8h(ACT + (size_t)m * LDZ + C_XN + lane * 16 + 8, t8);
#pragma unroll
          for (int j = 0; j < 8; ++j) x[8 + j] = t8[j]; }
        __syncthreads();
        int ci = 0, cj = 0;
        if (lane < 50) peer_cand(lane, ci, cj);
        const int pos = ci * 16 + cj;
        pos_s[lane] = pos;
#pragma unroll 1
        for (int hd = 0; hd < 8; ++hd) {
            const float cs = lane < 50 ? tops_s[hd * 32 + ci] + tops_s[hd * 32 + 16 + cj] : -3.0e38f;
            cand_s[lane] = cs;
            __syncthreads();
            if (lane < 50) {
                int cnt = 0;
#pragma unroll 10
                for (int o = 0; o < 50; ++o) { const float ov = cand_s[o]; cnt += (ov > cs || (ov == cs && pos_s[o] < pos)) ? 1 : 0; }
                if (cnt < 16) {
                    best_s[hd * 16 + cnt] = cs;
                    const int n0 = 127 - (int)(__float_as_uint(tops_s[hd * 32 + ci]) & 127u), n1 = 127 - (int)(__float_as_uint(tops_s[hd * 32 + 16 + cj]) & 127u);
                    idx_s[hd * 16 + cnt] = n0 * 128 + n1;
                }
            }
            __syncthreads();
        }
#pragma unroll
        for (int rr = 0; rr < 2; ++rr) {
            const int e = lane + 64 * rr, hd = e >> 4;
            const float mx = best_s[hd * 16];
            float sum = 0.f;
#pragma unroll
            for (int i = 0; i < 16; ++i) sum += fexp_(best_s[hd * 16 + i] - mx);
            gate_s[e] = fexp_(best_s[e] - mx) / sum;
        }
        __syncthreads();
        float y[16];
#pragma unroll
        for (int i = 0; i < 16; ++i) y[i] = 0.f;
        PG_ROLES();
        uint4 uu[8], vv[8];
#define PG_LOADU(eb_) do { _Pragma("unroll") for (int k = 0; k < 8; ++k) uu[k] = *(const uint4*)(tab_row(ws, idx_s[(eb_) + k]) + lane * 16); } while (0)
#define PG_LOADV(eb_) do { _Pragma("unroll") for (int k = 0; k < 8; ++k) vv[k] = *(const uint4*)(tab_row(ws, idx_s[(eb_) + k]) + 1024 + lane * 16); } while (0)
        PG_LOADU(0); PG_LOADV(0);
#pragma unroll 1
        for (int eb = 0; eb < 128; eb += 8) {
            float d8[8];
#pragma unroll
            for (int k = 0; k < 8; ++k) d8[k] = dot16q(uu[k], x);
            if (eb + 8 < 128) PG_LOADU(eb + 8);
            const float tot = reduce8(d8, lane, scr);
            const float hk = gate_s[eb + (lane & 7)] * geluf_(tot * (1.0f / TAB_SU));
#pragma unroll
            for (int k = 0; k < 8; ++k) axpy16q(vv[k], lane_bcast(hk, k, scr), y);
            if (eb + 8 < 128) PG_LOADV(eb + 8);
        }
#undef PG_LOADU
#undef PG_LOADV
        PG_ROLES();
        float* op = p->out + (size_t)m * 1024 + lane * 16;
        float hn[16]; float ss = 0.f;
#pragma unroll
        for (int i = 0; i < 16; i += 4) {
            const float4 o4 = *(const float4*)(op + i);
            hn[i] = o4.x + y[i] * (1.0f / TAB_SV); hn[i + 1] = o4.y + y[i + 1] * (1.0f / TAB_SV); hn[i + 2] = o4.z + y[i + 2] * (1.0f / TAB_SV); hn[i + 3] = o4.w + y[i + 3] * (1.0f / TAB_SV);
            ss += hn[i] * hn[i] + hn[i + 1] * hn[i + 1] + hn[i + 2] * hn[i + 2] + hn[i + 3] * hn[i + 3];
        }
        ss = group_sum(ss, 64, scr);
        const float rstd = rsqrtf(ss * (1.0f / D_) + RMS_EPS);
        float nv[16];
#pragma unroll
        for (int i = 0; i < 16; i += 4) { const float4 w4 = *(const float4*)(nxt_w + lane * 16 + i); nv[i] = hn[i] * rstd * w4.x; nv[i + 1] = hn[i + 1] * rstd * w4.y; nv[i + 2] = hn[i + 2] * rstd * w4.z; nv[i + 3] = hn[i + 3] * rstd * w4.w; }
        if (l + 1 < NL_) {
#pragma unroll
            for (int i = 0; i < 16; i += 4) *(float4*)(op + i) = make_float4(hn[i], hn[i + 1], hn[i + 2], hn[i + 3]);
            const float n0[8] = {nv[0], nv[1], nv[2], nv[3], nv[4], nv[5], nv[6], nv[7]}, n1[8] = {nv[8], nv[9], nv[10], nv[11], nv[12], nv[13], nv[14], nv[15]};
            store8h(ACT + (size_t)m * LDZ + C_XN + lane * 16, n0); store8h(ACT + (size_t)m * LDZ + C_XN + lane * 16 + 8, n1);
        } else {
#pragma unroll
            for (int i = 0; i < 16; i += 4) *(float4*)(op + i) = make_float4(nv[i], nv[i + 1], nv[i + 2], nv[i + 3]);
        }
    }
}
#undef PG_ROLES

enum { PH_NORM_MIX = 0, PH_INPROJ, PH_MIXERS, PH_MERGE, PH_WOUT, PH_NORM_FFN, PH_QUERY, PH_TOPK, PH_GATHER, PH_PER_LAYER, PH_FINAL = 100, PH_WPREP = 101 };
__device__ __forceinline__ void run_phase(KParams p, int l, int ph, char* smem) {
    h16_t* ACT = (h16_t*)(p->ws + OFF_ACT);
    const float* hin = l == 0 ? p->in[I_X] : p->out;
    switch (ph) {
    case PH_WPREP: stage_wprep(p, smem); break;
    case PH_NORM_MIX: if (l == 0) stage_rmsnorm(hin, p->in[I_NMIX] + l * 1024, ACT + C_XN, LDZ, smem); break;
    case PH_INPROJ: stage_gemm(p, l, GP_INPROJ, smem); break;
    case PH_MIXERS: {
        const int nb = gridDim.x, n_rw = nb / 2, n_gd = nb / 4, n_lr = nb - n_rw - n_gd;
        stage_rwkv(p, l, smem, 0, n_rw);
        stage_gdn(p, l, smem, n_rw, n_gd);
        stage_lru(p, l, smem, n_rw + n_gd, n_lr);
    } break;
    case PH_MERGE: stage_gemm(p, l, GP_MERGE, smem); break;
    case PH_WOUT: stage_gemm(p, l, GP_WOUT, smem); break;
    case PH_NORM_FFN: stage_rmsnorm(p->out, p->in[I_NFFN] + l * 1024, ACT + C_XN, LDZ, smem); stage_tabconv(p, l); break;
    case PH_QUERY: stage_gemm(p, l, GP_QUERY, smem); break;
    case PH_TOPK: stage_peer_topk(p, l, smem); break;
    case PH_GATHER: stage_peer_gather(p, l, smem); break;
    case PH_FINAL: break;
    default: break;
    }
}


#if !defined(CPU_EMU) && !MK_MULTI
#define XB_TMO      128
#define XB_XCNT(j)  (256  + 64 * (j))
#define XB_XSUB(j)  (1280 + 64 * (j))
#define XB_XGEN(j)  (2304 + 64 * (j))
#define XB_TOP      3328
#define XB_TOPGEN   3392
#define XCD_BAR_WORDS 3456
#define XB_SPIN_CAP (1u << 22)
#define XB_LAS __attribute__((address_space(3)))
__device__ __forceinline__ unsigned xb_ld(unsigned* p)              { return __hip_atomic_load(p, __ATOMIC_RELAXED, __HIP_MEMORY_SCOPE_AGENT); }
__device__ __forceinline__ unsigned xb_add(unsigned* p, unsigned v) { return __hip_atomic_fetch_add(p, v, __ATOMIC_RELAXED, __HIP_MEMORY_SCOPE_AGENT); }
__device__ __forceinline__ unsigned xb_xcc_id() { return (unsigned)__builtin_amdgcn_s_getreg((3 << 11) | 20) & 0xFu; }
#define XB_SPIN(cond, bar) do { unsigned _sp = 0; while (cond) { __builtin_amdgcn_s_sleep(1); \
    if ((++_sp & 255u) == 0u) { if (xb_ld(&(bar)[XB_TMO])) break; if (_sp > XB_SPIN_CAP) { atomicAdd(&(bar)[XB_TMO], 1u); break; } } } } while (0)
struct XcdBarrier { unsigned* bar; unsigned x; volatile XB_LAS unsigned* st; };
__device__ __forceinline__ XcdBarrier xcd_barrier_post(unsigned* bar, volatile XB_LAS unsigned* st) {
    XcdBarrier b; b.bar = bar; b.x = xb_xcc_id(); b.st = st;
    if (threadIdx.x == 0) (void)xb_add(&bar[XB_XCNT(b.x)], 1u);
    return b;
}
__device__ __forceinline__ void xcd_barrier_complete(unsigned* bar, unsigned x, unsigned& nloc, unsigned& nx) {
    const unsigned G = gridDim.x * gridDim.y * gridDim.z;
    unsigned sum, cnt, mine, sp = 0u;
    for (;;) {
        sum = 0u; cnt = 0u; mine = 0u;
#pragma unroll
        for (unsigned j = 0; j < 16; ++j) { const unsigned c = xb_ld(&bar[XB_XCNT(j)]); sum += c; cnt += (c > 0u) ? 1u : 0u; mine = (j == x) ? c : mine; }
        if (sum == G) break;
        __builtin_amdgcn_s_sleep(1);
        if ((++sp & 255u) == 0u) { if (xb_ld(&bar[XB_TMO])) break; if (sp > XB_SPIN_CAP) { atomicAdd(&bar[XB_TMO], 1u); break; } }
    }
    nloc = mine > 0u ? mine : 1u; nx = cnt > 0u ? cnt : 1u;
}
__device__ __forceinline__ void xcd_barrier(const XcdBarrier& b) {
    asm volatile("s_waitcnt vmcnt(0)" ::: "memory");
    __syncthreads();
    if (threadIdx.x == 0) {
        unsigned* bar = b.bar;
        __builtin_amdgcn_s_waitcnt(0);
        unsigned nloc = b.st[0], nx = b.st[1];
        if (nloc == 0u) { xcd_barrier_complete(bar, b.x, nloc, nx); b.st[0] = nloc; b.st[1] = nx; }
        const unsigned old = xb_add(&bar[XB_XSUB(b.x)], 1u);
        const unsigned gen = old / nloc;
        if (old + 1u == (gen + 1u) * nloc) {
            __builtin_amdgcn_fence(__ATOMIC_RELEASE, "agent");
            asm volatile("s_waitcnt vmcnt(0)" ::: "memory");
            const unsigned og = xb_add(&bar[XB_TOP], 1u);
            const unsigned tg = og / nx;
            if (og + 1u == (tg + 1u) * nx) xb_add(&bar[XB_TOPGEN], 1u);
            else XB_SPIN(xb_ld(&bar[XB_TOPGEN]) == tg, bar);
            __builtin_amdgcn_fence(__ATOMIC_ACQUIRE, "agent");
            xb_add(&bar[XB_XGEN(b.x)], 1u);
            asm volatile("s_waitcnt vmcnt(0)" ::: "memory");
        } else {
            XB_SPIN(xb_ld(&bar[XB_XGEN(b.x)]) == gen, bar);
            __builtin_amdgcn_fence(__ATOMIC_ACQUIRE, "agent");
            asm volatile("s_waitcnt vmcnt(0)" ::: "memory");
        }
    }
    __syncthreads();
}
#endif
#if !defined(CPU_EMU) && !MK_MULTI
__global__ void __launch_bounds__(512, 2) k_mega(Params p_) {
    DYN_SMEM(smem);
    KParams pk = (KParams)__builtin_amdgcn_kernarg_segment_ptr();
    cg::grid_group grid = cg::this_grid();
    volatile XB_LAS unsigned* xst = (volatile XB_LAS unsigned*)(XB_LAS char*)(smem + SMEM_BYTES);
    if (threadIdx.x == 0) { xst[0] = 0u; xst[1] = 0u; xst[2] = 0u; xst[3] = 0u; }
    __syncthreads();
    const XcdBarrier xb = xcd_barrier_post((unsigned*)(pk->ws + OFF_BAR), xst);
    bool first_sync = true;
    constexpr int NIT = NL_ * PH_PER_LAYER;
#pragma unroll 1
    for (int it = -1; it <= NIT; ++it) {
        const int l = (it >= 0 && it < NIT) ? it / PH_PER_LAYER : 0, ph = it < 0 ? (int)PH_WPREP : (it < NIT ? it % PH_PER_LAYER : (int)PH_FINAL);
        KParams q = pk; asm volatile("" : "+s"(q));
        run_phase(q, l, ph, smem);
        if (it >= 0 && it < NIT - 1 && !(l > 0 && ph == PH_NORM_MIX)) {
            if (first_sync) { grid.sync(); first_sync = false; }
            else xcd_barrier(xb);
        }
    }
}
#endif
#ifdef CPU_EMU
__global__ void k_phase(Params p_, int l, int ph) { DYN_SMEM(smem); run_phase(&p_, l, ph, smem); }
#elif MK_MULTI
__global__ void __launch_bounds__(512, 2) k_phase(Params p_, int l, int ph) { DYN_SMEM(smem); KParams pk = (KParams)__builtin_amdgcn_kernarg_segment_ptr(); run_phase(pk, l, ph, smem); }
#endif
}

#ifdef CPU_EMU
int g_emu_stop = 1000;
#endif

extern "C" void kernel_launch(void* const* d_in, const int* in_sizes, int n_in, void* d_out, int out_size, void* d_ws, size_t ws_size, hipStream_t stream) {
    Params p{};
    for (int i = 0; i < N_IN; ++i) p.in[i] = (const float*)d_in[i];
    p.out = (float*)d_out; p.ws = (char*)d_ws;
#if defined(CPU_EMU) || MK_MULTI
    const int grid = 256;
    LAUNCH(k_phase, grid, NT, SMEM_BYTES, stream, p, 0, (int)PH_WPREP);
    for (int l = 0; l < NL_; ++l)
        for (int ph = 0; ph < PH_PER_LAYER; ++ph) {
            LAUNCH(k_phase, grid, NT, SMEM_BYTES, stream, p, l, ph);
#ifdef CPU_EMU
            const int code = ph == PH_INPROJ ? 1 : ph == PH_MIXERS ? 2 : ph == PH_MERGE ? 3 : ph == PH_WOUT ? 4 : ph == PH_GATHER ? 5 : 0;
            if (code && g_emu_stop == l * 10 + code) return;
#endif
        }
    LAUNCH(k_phase, grid, NT, SMEM_BYTES, stream, p, 0, (int)PH_FINAL);
#else
    static int grid_blocks = 0;
    if (!grid_blocks) {
        int dev = 0, cus = 0, per_cu = 0;
        (void)hipGetDevice(&dev);
        (void)hipDeviceGetAttribute(&cus, hipDeviceAttributeMultiprocessorCount, dev);
        (void)hipFuncSetAttribute((const void*)k_mega, hipFuncAttributeMaxDynamicSharedMemorySize, (int)SMEM_BYTES + 16);
        (void)hipOccupancyMaxActiveBlocksPerMultiprocessor(&per_cu, k_mega, NT, SMEM_BYTES + 16);
        if (per_cu > 1) per_cu = 1;
        grid_blocks = cus * per_cu;
    }
    (void)hipMemsetAsync((char*)d_ws + OFF_BAR, 0, 16384, stream);
    void* args[] = {&p};
    hipError_t e = hipLaunchCooperativeKernel((void*)k_mega, dim3(grid_blocks), dim3(NT), args, SMEM_BYTES + 16, stream);
    if (e != hipSuccess) fprintf(stderr, "cooperative launch failed: %s (grid %d)\n", hipGetErrorString(e), grid_blocks);
#endif
}
```

```cpp
#ifndef CPU_EMU
#include <hip/hip_runtime.h>
#include <hip/hip_cooperative_groups.h>
#include <cstdio>
#include <cstdint>
namespace cg = cooperative_groups;
#define DYN_SMEM(name) extern __shared__ __attribute__((aligned(16))) char name[]
#define LAUNCH(kern, grid, block, smem, stream, ...) hipLaunchKernelGGL(kern, dim3(grid), dim3(block), smem, stream, __VA_ARGS__)
#endif

#ifndef CFG_B
#define CFG_B 8
#endif
#ifndef CFG_T
#define CFG_T 2048
#endif
#ifndef MK_MULTI
#define MK_MULTI 0
#endif

namespace {
constexpr int B_ = CFG_B, T_ = CFG_T, M_ = B_ * T_, D_ = 1024, NL_ = 2, NT = 512;
constexpr int INW = 12560;
constexpr int LDZ = 11776;
constexpr int Z_ULRU = 0, Z_GLRU = 1024, Z_Q = 2048, Z_K = 3072, Z_V = 4096, Z_ZG = 5120, Z_RW = 6144, Z_ALPHA = 9472, Z_BETA = 9480;
constexpr int ZN = 9728;
constexpr int C_XN = 9728, C_YC = 10752;
constexpr int C_YA = Z_GLRU, C_YB = Z_ZG;
constexpr int C_GS = Z_Q, C_MG = Z_K;
constexpr int C_QRY = 0;
constexpr int RW_R = 0, RW_K = 1024, RW_V = 2048, RW_WL = 3072, RW_AL = 3136, RW_GL = 3200, RWW = 3328;
constexpr float RMS_EPS = 1e-6f, GN_EPS = 64e-5f;
typedef unsigned short h16_t;

enum { I_X = 0, I_NMIX, I_NFFN, I_NFINAL, I_WIN, I_LCW, I_LCB, I_LWA, I_LBA, I_LWX, I_LBX, I_LLAM, I_GCW, I_GALOG, I_GDT, I_GNW,
       I_RMU, I_RW0, I_RWUP, I_RA0, I_RAUP, I_RGUP, I_RKK, I_RKA, I_RRK, I_RLW, I_RLB, I_MB, I_PL, I_PG, I_PR, I_WOUT, I_PWQ, I_PKEYS, I_PU, I_PV, N_IN };

struct Params {
    const float* in[N_IN];
    float* out;
    char* ws;
};
#ifdef CPU_EMU
typedef const Params* KParams;
#else
typedef const Params __attribute__((address_space(4)))* KParams;
#endif

constexpr size_t al256(size_t x) { return (x + 255) / 256 * 256; }
constexpr size_t OFF_ACT = 0;
constexpr size_t OFF_WT = al256(OFF_ACT + (size_t)M_ * LDZ * 2);
constexpr int WT_IN = 0, WT_MG = ZN, WT_P = WT_MG + 3072, WT_OUT = WT_P + 3072, WT_Q = WT_OUT + 1024, WT_ROWS = WT_Q + 2048;
constexpr size_t OFF_TOPS = al256(OFF_WT + (size_t)NL_ * WT_ROWS * 1024 * 2);
constexpr size_t OFF_TAB = al256(OFF_TOPS + (size_t)M_ * 256 * 4);
constexpr size_t OFF_BAR = OFF_TAB + (M_ == 16384 ? 0 : (size_t)16384 * 2048);
constexpr size_t WS_END = OFF_BAR + 16384;
static_assert(CFG_B != 8 || CFG_T != 2048 || WS_END <= (size_t)512 * 1024 * 1024, "workspace budget");
constexpr size_t SMEM_BYTES = 128 * 1024;

#ifdef CPU_EMU
__device__ __forceinline__ int tid_() { return threadIdx.x; }
__device__ __forceinline__ h16_t f2h(float f) { return (h16_t)_cvtss_sh(f, _MM_FROUND_TO_NEAREST_INT); }
__device__ __forceinline__ float h2f(h16_t h) { return _cvtsh_ss(h); }
#else
__device__ __forceinline__ int tid_() { int t = threadIdx.x; asm volatile("" : "+v"(t)); return t; }
__device__ __forceinline__ h16_t f2h(float f) { return __builtin_bit_cast(unsigned short, (_Float16)f); }
__device__ __forceinline__ float h2f(h16_t h) { return (float)__builtin_bit_cast(_Float16, h); }
#endif
__device__ __forceinline__ int bid_() { return (int)blockIdx.x; }

#ifdef CPU_EMU
__device__ __forceinline__ float fexp_(float x) { return expf(x); }
__device__ __forceinline__ float flog_(float x) { return logf(x); }
__device__ __forceinline__ float frcp_(float x) { return 1.0f / x; }
#else
__device__ __forceinline__ float fexp_(float x) { return __builtin_amdgcn_exp2f(x * 1.4426950408889634f); }
__device__ __forceinline__ float flog_(float x) { return __builtin_amdgcn_logf(x) * 0.6931471805599453f; }
__device__ __forceinline__ float frcp_(float x) { return __builtin_amdgcn_rcpf(x); }
#endif
__device__ __forceinline__ float sigmoidf_(float x) { return frcp_(1.0f + fexp_(-x)); }
__device__ __forceinline__ float softplusf_(float x) { return fmaxf(x, 0.0f) + flog_(1.0f + fexp_(-fabsf(x))); }
__device__ __forceinline__ float siluf_(float x) { return x * sigmoidf_(x); }
__device__ __forceinline__ float tanhf_(float x) { return 1.0f - 2.0f * frcp_(1.0f + fexp_(2.0f * x)); }
__device__ __forceinline__ float geluf_(float x) { return x * frcp_(1.0f + fexp_(-1.5957691216057308f * (x + 0.044715f * x * x * x))); }
__device__ __forceinline__ unsigned pack2h(float a, float b) { return (unsigned)f2h(a) | ((unsigned)f2h(b) << 16); }
__device__ __forceinline__ void store8h(h16_t* p, const float (&v)[8]) {
    uint4 w; w.x = pack2h(v[0], v[1]); w.y = pack2h(v[2], v[3]); w.z = pack2h(v[4], v[5]); w.w = pack2h(v[6], v[7]);
    *(uint4*)p = w;
}
__device__ __forceinline__ void load8h(const h16_t* p, float (&v)[8]) {
    const uint4 w = *(const uint4*)p;
    v[0] = h2f((h16_t)(w.x & 0xffffu)); v[1] = h2f((h16_t)(w.x >> 16)); v[2] = h2f((h16_t)(w.y & 0xffffu)); v[3] = h2f((h16_t)(w.y >> 16));
    v[4] = h2f((h16_t)(w.z & 0xffffu)); v[5] = h2f((h16_t)(w.z >> 16)); v[6] = h2f((h16_t)(w.w & 0xffffu)); v[7] = h2f((h16_t)(w.w >> 16));
}

__device__ __forceinline__ float block_sum512(float v, float* red) {
    const int tid = tid_();
    red[tid] = v;
    __syncthreads();
    if (tid < 32) { float s = 0.f; for (int i = 0; i < 16; ++i) s += red[tid * 16 + i]; red[512 + tid] = s; }
    __syncthreads();
    float tot = 0.f;
    for (int i = 0; i < 32; ++i) tot += red[512 + i];
    __syncthreads();
    return tot;
}

#ifdef CPU_EMU
__device__ __forceinline__ float wave_sum64(float v, float* scr) {
    const int tid = tid_();
    scr[tid] = v; __syncthreads();
    float s = 0.f; const int base = tid & ~63;
    for (int i = 0; i < 64; ++i) s += scr[base + i];
    __syncthreads();
    return s;
}
#else
__device__ __forceinline__ float wave_sum64(float v, float*) {
    v += __builtin_bit_cast(float, __builtin_amdgcn_mov_dpp(__builtin_bit_cast(int, v), 0xB1, 0xf, 0xf, true));
    v += __builtin_bit_cast(float, __builtin_amdgcn_mov_dpp(__builtin_bit_cast(int, v), 0x4E, 0xf, 0xf, true));
    v += __builtin_bit_cast(float, __builtin_amdgcn_mov_dpp(__builtin_bit_cast(int, v), 0x141, 0xf, 0xf, true));
    v += __builtin_bit_cast(float, __builtin_amdgcn_mov_dpp(__builtin_bit_cast(int, v), 0x140, 0xf, 0xf, true));
    v += __builtin_bit_cast(float, __builtin_amdgcn_update_dpp(0, __builtin_bit_cast(int, v), 0x142, 0xa, 0xf, false));
    v += __builtin_bit_cast(float, __builtin_amdgcn_update_dpp(0, __builtin_bit_cast(int, v), 0x143, 0xc, 0xf, false));
    return __builtin_bit_cast(float, __builtin_amdgcn_readlane(__builtin_bit_cast(int, v), 63));
}
#endif
__device__ __forceinline__ void stage_rmsnorm(const float* src, const float* w, h16_t* dst, int ldd, char* smem) {
    float* scr = (float*)smem;
    const int tid = tid_(), lane = tid & 63, wv = tid >> 6;
    const int nw = gridDim.x * 8;
    float4 wv4[4];
#pragma unroll
    for (int i = 0; i < 4; ++i) wv4[i] = *(const float4*)(w + lane * 16 + i * 4);
    for (int row = bid_() * 8 + wv; row < M_; row += 2 * nw) {
        const int row2 = row + nw; const bool has2 = row2 < M_;
        float4 a[4], b[4];
#pragma unroll
        for (int i = 0; i < 4; ++i) { a[i] = *(const float4*)(src + (size_t)row * D_ + lane * 16 + i * 4); b[i] = has2 ? *(const float4*)(src + (size_t)row2 * D_ + lane * 16 + i * 4) : make_float4(0.f, 0.f, 0.f, 0.f); }
        float sa = 0.f, sb = 0.f;
#pragma unroll
        for (int i = 0; i < 4; ++i) { sa += a[i].x * a[i].x + a[i].y * a[i].y + a[i].z * a[i].z + a[i].w * a[i].w; sb += b[i].x * b[i].x + b[i].y * b[i].y + b[i].z * b[i].z + b[i].w * b[i].w; }
        sa = wave_sum64(sa, scr); sb = wave_sum64(sb, scr);
        const float ra = rsqrtf(sa * (1.0f / D_) + RMS_EPS), rb = rsqrtf(sb * (1.0f / D_) + RMS_EPS);
#pragma unroll
        for (int i = 0; i < 4; i += 2) {
            const float va[8] = {a[i].x * ra * wv4[i].x, a[i].y * ra * wv4[i].y, a[i].z * ra * wv4[i].z, a[i].w * ra * wv4[i].w, a[i + 1].x * ra * wv4[i + 1].x, a[i + 1].y * ra * wv4[i + 1].y, a[i + 1].z * ra * wv4[i + 1].z, a[i + 1].w * ra * wv4[i + 1].w};
            store8h(dst + (size_t)row * ldd + lane * 16 + i * 4, va);
            if (has2) {
                const float vb[8] = {b[i].x * rb * wv4[i].x, b[i].y * rb * wv4[i].y, b[i].z * rb * wv4[i].z, b[i].w * rb * wv4[i].w, b[i + 1].x * rb * wv4[i + 1].x, b[i + 1].y * rb * wv4[i + 1].y, b[i + 1].z * rb * wv4[i + 1].z, b[i + 1].w * rb * wv4[i + 1].w};
                store8h(dst + (size_t)row2 * ldd + lane * 16 + i * 4, vb);
            }
        }
    }
}

__device__ __forceinline__ const float* wt_src(KParams p, int l, int r, int& ld) {
    if (r < ZN) {
        ld = INW;
        int c;
        if (r < 6144) c = r; else if (r < 9472) c = r + 16; else if (r < 9488) c = r - 3328; else return nullptr;
        return p->in[I_WIN] + (size_t)l * 1024 * INW + c;
    }
    r -= ZN;
    if (r < 3072) { ld = INW; return p->in[I_WIN] + (size_t)l * 1024 * INW + 9488 + r; }
    r -= 3072;
    if (r < 3072) { ld = 1024; const int br = r >> 10; return p->in[br == 0 ? I_PL : (br == 1 ? I_PG : I_PR)] + (size_t)l * 1024 * 1024 + (r & 1023); }
    r -= 3072;
    if (r < 1024) { ld = 1024; return p->in[I_WOUT] + (size_t)l * 1024 * 1024 + r; }
    r -= 1024;
    ld = 2048; return p->in[I_PWQ] + (size_t)l * 1024 * 2048 + r;
}
__device__ __forceinline__ void stage_wprep(KParams p, char* smem) {
    float* tile = (float*)smem;
    h16_t* WT = (h16_t*)(p->ws + OFF_WT);
    const int tid = tid_();
    const int ntr = WT_ROWS / 64, total = NL_ * ntr * 16;
    for (int it = bid_(); it < total; it += gridDim.x) {
        const int l = it / (ntr * 16), rem = it % (ntr * 16), rt = rem / 16, kt = rem % 16;
        const int r0 = rt * 64, k0 = kt * 64;
        __syncthreads();
        {
            const int nn = tid & 63;
            int ld = 0; const float* src = wt_src(p, l, r0 + nn, ld);
#pragma unroll
            for (int i = 0; i < 8; ++i) { const int kk = (tid >> 6) + 8 * i; tile[kk * 65 + nn] = src ? src[(size_t)(k0 + kk) * ld] : 0.f; }
        }
        __syncthreads();
        {
            const int r = tid >> 3, kq = (tid & 7) * 8;
            float v[8];
#pragma unroll
            for (int j = 0; j < 8; ++j) v[j] = tile[(kq + j) * 65 + r];
            store8h(WT + ((size_t)l * WT_ROWS + r0 + r) * 1024 + k0 + kq, v);
        }
    }
}

namespace pg8 {
constexpr int BM = 256, BK = 64, HALF = 128, HTB = HALF * BK * 2, STAGE_BYTES = 8 * HTB, NXCD = 8, WGM = 8;
struct Unit { const char* A; const char* B; int pm, pn, kind; };
#ifdef CPU_EMU
struct f32x4 { float d[4]; float& operator[](int i) { return d[i]; } const float& operator[](int i) const { return d[i]; } };
#else
#define PG8_LAS __attribute__((address_space(3)))
typedef _Float16 f16x8 __attribute__((ext_vector_type(8)));
typedef float f32x4 __attribute__((ext_vector_type(4)));
__device__ __forceinline__ int lds_byte(int r, int c) { const int st = (r >> 4) * 2 + (c >> 5), rr = r & 15, cc = c & 31, ob = rr * 64 + cc * 2; return st * 1024 + (ob ^ (((ob >> 9) & 1) << 5)); }
__device__ __forceinline__ void stage_rc(int b, int& R, int& C) { const int st = b / 1024, sb = b % 1024, swz = sb ^ (((sb >> 9) & 1) << 5); R = (st >> 1) * 16 + swz / 64; C = (st & 1) * 32 + (swz % 64) / 2; }
__device__ __forceinline__ int perm32(int rho) { const int n = rho >> 4, i = rho & 15; return 8 * (i >> 2) + 4 * n + (i & 3); }
#endif
__device__ __forceinline__ void tile_of(int L, int nM, int nN, int& pm, int& pn) {
    const int nwg = nM * nN;
    int wgid = L; { const int q = nwg / NXCD, r = nwg % NXCD, xcd = wgid % NXCD, off = wgid / NXCD; wgid = (xcd < r ? xcd * (q + 1) : r * (q + 1) + (xcd - r) * q) + off; }
    const int nig = WGM * nN, gid = wgid / nig, fm = gid * WGM, gsz = (nM - fm) < WGM ? (nM - fm) : WGM;
    pm = fm + ((wgid % nig) % gsz); pn = (wgid % nig) / gsz;
}

template <class Sched, class Epi>
__device__ __forceinline__ void gemm_phase(char* smem, const Sched& S, const Epi& E) {
    constexpr int K = 1024, nt = K / BK;
    constexpr unsigned lda = LDZ, ldb = 1024;
#ifdef CPU_EMU
    const int tid = tid_(), wid = tid >> 6, lane = tid & 63, wr = wid >> 2, wc = wid & 3, fr = lane & 15, fq = lane >> 4;
    Unit u;
    for (int ui = 0; S.next(ui, u); ++ui) {
        f32x4 acc[2][2][4][2];
        for (int ai = 0; ai < 2; ++ai) for (int bj = 0; bj < 2; ++bj) for (int m = 0; m < 4; ++m) for (int n = 0; n < 2; ++n) for (int e = 0; e < 4; ++e) {
            const int r = 128 * ai + 64 * wr + 16 * m + fr, c = 128 * bj + 32 * wc + 8 * fq + 4 * n + e;
            const h16_t* a = (const h16_t*)u.A + (size_t)r * lda; const h16_t* b = (const h16_t*)u.B + (size_t)c * ldb;
            float s = 0.f;
            for (int k = 0; k < K; ++k) s += h2f(a[k]) * h2f(b[k]);
            acc[ai][bj][m][n][e] = s;
        }
        E(acc, u, wr, wc, fr, fq);
    }
    (void)smem; (void)nt;
#else
    PG8_LAS unsigned char* lds = (PG8_LAS unsigned char*)smem;
    const int tid = tid_(), wid = __builtin_amdgcn_readfirstlane(tid >> 6), lane = tid & 63, wr = wid >> 2, wc = wid & 3, fr = lane & 15, fq = lane >> 4;
    unsigned voffA[2], voffB[2];
#pragma unroll
    for (int i = 0; i < 2; ++i) { int R, C; stage_rc(tid * 16 + i * 8192, R, C); const int Rb = (R & ~31) + perm32(R & 31);
        voffA[i] = (unsigned)(R * lda + C) * 2u; voffB[i] = (unsigned)(Rb * ldb + C) * 2u; }
    constexpr size_t kstep = (size_t)(BK * 2);
    constexpr size_t hstepA = (size_t)HALF * lda * 2, hstepB = (size_t)HALF * ldb * 2;
    const unsigned ldsw = (unsigned)wid * 1024u;
    const int aoff = lds_byte(wr * 64 + fr, fq * 8), boff = lds_byte(wc * 32 + fr, fq * 8);
#define PG8_SA(b, h) (((b) * 2 + (h)) * HTB)
#define PG8_SB(b, h) ((4 + (b) * 2 + (h)) * HTB)
#define PG8_STAGE(bufoff, gbase, voff) do { _Pragma("unroll") for (int _i = 0; _i < 2; ++_i) \
        __builtin_amdgcn_global_load_lds((const unsigned*)((const char*)(gbase) + (voff)[_i]), (PG8_LAS unsigned*)(lds + (bufoff) + ldsw + _i * 8192), 16, 0, 0); } while (0)
#define PG8_LDA(dst, b, h) do { _Pragma("unroll") for (int m = 0; m < 4; ++m) _Pragma("unroll") for (int k = 0; k < 2; ++k) dst[m][k] = *(const PG8_LAS f16x8*)(lds + PG8_SA(b, h) + aoff + m * 2048 + k * 1024); } while (0)
#define PG8_LDB(dst, b, h) do { _Pragma("unroll") for (int n = 0; n < 2; ++n) _Pragma("unroll") for (int k = 0; k < 2; ++k) dst[n][k] = *(const PG8_LAS f16x8*)(lds + PG8_SB(b, h) + boff + n * 2048 + k * 1024); } while (0)
#define PG8_MMA(ai, bj, At, Bt) do { __builtin_amdgcn_s_setprio(1); _Pragma("unroll") for (int m = 0; m < 4; ++m) _Pragma("unroll") for (int n = 0; n < 2; ++n) _Pragma("unroll") for (int k = 0; k < 2; ++k) \
        acc[ai][bj][m][n] = __builtin_amdgcn_mfma_f32_16x16x32_f16(Bt[n][k], At[m][k], acc[ai][bj][m][n], 0, 0, 0); __builtin_amdgcn_s_setprio(0); } while (0)
#define PG8_WAIT_V(n) asm volatile("s_waitcnt vmcnt(" #n ")" ::: "memory")
#define PG8_WAIT_L(n) asm volatile("s_waitcnt lgkmcnt(" #n ")" ::: "memory")
#define PG8_BAR __builtin_amdgcn_s_barrier()
#define PG8_SCHED __builtin_amdgcn_sched_barrier(0)
    Unit cur, nxt; int ui = 0;
    if (!S.next(0, cur)) return;
    f32x4 acc[2][2][4][2];
#pragma unroll
    for (int a = 0; a < 2; ++a)
#pragma unroll
        for (int b = 0; b < 2; ++b)
#pragma unroll
            for (int m = 0; m < 4; ++m)
#pragma unroll
                for (int n = 0; n < 2; ++n) acc[a][b][m][n] = (f32x4){0.f, 0.f, 0.f, 0.f};
    f16x8 At[4][2], B0[2][2], B1[2][2];
    const char* cA = cur.A; const char* cB = cur.B;
    PG8_STAGE(PG8_SB(0, 0), cB, voffB); PG8_STAGE(PG8_SA(0, 0), cA, voffA); PG8_STAGE(PG8_SB(0, 1), cB + hstepB, voffB); PG8_STAGE(PG8_SA(0, 1), cA + hstepA, voffA);
    if (wr == 1) PG8_BAR;
    PG8_WAIT_V(4); PG8_BAR;
    PG8_STAGE(PG8_SB(1, 0), cB + kstep, voffB); PG8_STAGE(PG8_SA(1, 0), cA + kstep, voffA); PG8_STAGE(PG8_SB(1, 1), cB + hstepB + kstep, voffB);
    PG8_WAIT_V(6); PG8_BAR;
    for (;;) {
        const bool has_next = S.next(ui + 1, nxt);
        const char* nA = has_next ? nxt.A : cA; const char* nB = has_next ? nxt.B : cB;
#pragma unroll 1
        for (int t = 0; t < nt; t += 2) {
            const bool last = (t == nt - 2);
            const char* a1 = cA + (size_t)(t + 1) * kstep;
            const char* a2 = last ? nA : cA + (size_t)(t + 2) * kstep; const char* b2 = last ? nB : cB + (size_t)(t + 2) * kstep;
            const char* a3 = a2 + kstep; const char* b3 = b2 + kstep;
            PG8_LDB(B0, 0, 0); PG8_SCHED; PG8_LDA(At, 0, 0); PG8_STAGE(PG8_SA(1, 1), a1 + hstepA, voffA);
            PG8_WAIT_L(8); PG8_BAR; PG8_WAIT_L(0); PG8_MMA(0, 0, At, B0); PG8_BAR; PG8_SCHED;
            PG8_LDB(B1, 0, 1); PG8_STAGE(PG8_SB(0, 0), b2, voffB);
            PG8_BAR; PG8_WAIT_L(0); PG8_MMA(0, 1, At, B1); PG8_BAR;
            PG8_LDA(At, 0, 1); PG8_STAGE(PG8_SA(0, 0), a2, voffA);
            PG8_BAR; PG8_WAIT_L(0); PG8_MMA(1, 0, At, B0); PG8_BAR; PG8_SCHED;
            PG8_STAGE(PG8_SB(0, 1), b2 + hstepB, voffB);
            PG8_WAIT_V(6); PG8_BAR; PG8_MMA(1, 1, At, B1); PG8_BAR;
            PG8_LDB(B0, 1, 0); PG8_SCHED; PG8_LDA(At, 1, 0); PG8_STAGE(PG8_SA(0, 1), a2 + hstepA, voffA);
            PG8_WAIT_L(8); PG8_BAR; PG8_WAIT_L(0); PG8_MMA(0, 0, At, B0); PG8_BAR; PG8_SCHED;
            PG8_LDB(B1, 1, 1); PG8_STAGE(PG8_SB(1, 0), b3, voffB);
            PG8_BAR; PG8_WAIT_L(0); PG8_MMA(0, 1, At, B1); PG8_BAR;
            PG8_LDA(At, 1, 1); PG8_STAGE(PG8_SA(1, 0), a3, voffA);
            PG8_BAR; PG8_WAIT_L(0); PG8_MMA(1, 0, At, B0); PG8_BAR; PG8_SCHED;
            PG8_STAGE(PG8_SB(1, 1), b3 + hstepB, voffB);
            PG8_WAIT_V(6); PG8_BAR; PG8_MMA(1, 1, At, B1); PG8_BAR;
        }
        E(acc, cur, wr, wc, fr, fq);
        if (!has_next) break;
#pragma unroll
        for (int a = 0; a < 2; ++a)
#pragma unroll
            for (int b = 0; b < 2; ++b)
#pragma unroll
                for (int m = 0; m < 4; ++m)
#pragma unroll
                    for (int n = 0; n < 2; ++n) acc[a][b][m][n] = (f32x4){0.f, 0.f, 0.f, 0.f};
        cur = nxt; cA = nA; cB = nB; ++ui;
    }
    PG8_WAIT_V(0);
    if (wr == 0) PG8_BAR;
    PG8_BAR;
#undef PG8_SA
#undef PG8_SB
#undef PG8_STAGE
#undef PG8_LDA
#undef PG8_LDB
#undef PG8_MMA
#undef PG8_WAIT_V
#undef PG8_WAIT_L
#undef PG8_BAR
#undef PG8_SCHED
#endif
}
}

enum { GK_STORE = 0, GK_GATE0, GK_GATE1, GK_GATE2, GK_PROJ0, GK_PROJ1, GK_PROJ2, GK_RESID };
enum { GP_INPROJ = 0, GP_MERGE, GP_WOUT, GP_QUERY };
struct GemmProg {
    const char* act; const char* wt;
    int which, G, c;
    __device__ __forceinline__ bool next(int i, pg8::Unit& u) const {
        constexpr int nM = M_ / 256;
        constexpr size_t rowA = (size_t)256 * LDZ * 2, rowB = (size_t)256 * 1024 * 2;
        if (which == GP_MERGE) {
            const int L = (i / 6) * G + c, j = i % 6, br = j < 3 ? j : j - 3;
            if (L >= nM * 4) return false;
            pg8::tile_of(L, nM, 4, u.pm, u.pn);
            if (j < 3) { u.A = act + (size_t)C_XN * 2; u.B = wt + ((size_t)(WT_MG + br * 1024) * 1024) * 2; u.kind = GK_GATE0 + br; }
            else { u.A = act + (size_t)(br == 0 ? C_YA : (br == 1 ? C_YB : C_YC)) * 2; u.B = wt + ((size_t)(WT_P + br * 1024) * 1024) * 2; u.kind = GK_PROJ0 + br; }
        } else {
            const int nN = which == GP_INPROJ ? ZN / 256 : (which == GP_WOUT ? 4 : 8);
            const int L = i * G + c;
            if (L >= nM * nN) return false;
            pg8::tile_of(L, nM, nN, u.pm, u.pn);
            u.A = act + (size_t)(which == GP_WOUT ? C_MG : C_XN) * 2;
            u.B = wt + ((size_t)(which == GP_INPROJ ? WT_IN : (which == GP_WOUT ? WT_OUT : WT_Q)) * 1024) * 2;
            u.kind = which == GP_WOUT ? GK_RESID : GK_STORE;
        }
        u.A += (size_t)u.pm * rowA; u.B += (size_t)u.pn * rowB;
        return true;
    }
};
__device__ __forceinline__ int gs_slot(int br) { return br == 0 ? C_GS : (br == 1 ? Z_V : Z_ULRU); }
struct GemmEpi {
    h16_t* act; const float* mb; const float* resid; float* out;
    __device__ __forceinline__ void operator()(const pg8::f32x4 (&acc)[2][2][4][2], const pg8::Unit& u, int wr, int wc, int fr, int fq) const {
        const int row0 = u.pm * 256 + wr * 64 + fr, col0 = u.pn * 256 + wc * 32 + 8 * fq;
#pragma unroll
        for (int ai = 0; ai < 2; ++ai)
#pragma unroll
            for (int m = 0; m < 4; ++m) {
                const int row = row0 + ai * 128 + m * 16;
#pragma unroll
                for (int bj = 0; bj < 2; ++bj) {
                    const int col = col0 + bj * 128;
                    float v[8];
#pragma unroll
                    for (int e = 0; e < 4; ++e) { v[e] = acc[ai][bj][m][0][e]; v[4 + e] = acc[ai][bj][m][1][e]; }
                    h16_t* arow = act + (size_t)row * LDZ;
                    if (u.kind == GK_STORE) {
                        store8h(arow + col, v);
                    } else if (u.kind <= GK_GATE2) {
                        const float* bp = mb + (u.kind - GK_GATE0) * 1024 + col;
                        const float4 b0 = *(const float4*)bp, b1 = *(const float4*)(bp + 4);
                        v[0] = sigmoidf_(v[0] + b0.x); v[1] = sigmoidf_(v[1] + b0.y); v[2] = sigmoidf_(v[2] + b0.z); v[3] = sigmoidf_(v[3] + b0.w);
                        v[4] = sigmoidf_(v[4] + b1.x); v[5] = sigmoidf_(v[5] + b1.y); v[6] = sigmoidf_(v[6] + b1.z); v[7] = sigmoidf_(v[7] + b1.w);
                        store8h(arow + gs_slot(u.kind - GK_GATE0) + col, v);
                    } else if (u.kind <= GK_PROJ2) {
                        float g[8]; load8h(arow + gs_slot(u.kind - GK_PROJ0) + col, g);
                        if (u.kind == GK_PROJ0) {
#pragma unroll
                            for (int e = 0; e < 8; ++e) v[e] = g[e] * v[e];
                        } else {
                            float o[8]; load8h(arow + C_MG + col, o);
#pragma unroll
                            for (int e = 0; e < 8; ++e) v[e] = o[e] + g[e] * v[e];
                        }
                        store8h(arow + C_MG + col, v);
                    } else {
                        const size_t o = (size_t)row * 1024 + col;
                        const float4 r0 = *(const float4*)(resid + o), r1 = *(const float4*)(resid + o + 4);
                        *(float4*)(out + o) = make_float4(r0.x + v[0], r0.y + v[1], r0.z + v[2], r0.w + v[3]);
                        *(float4*)(out + o + 4) = make_float4(r1.x + v[4], r1.y + v[5], r1.z + v[6], r1.w + v[7]);
                    }
                }
            }
    }
};
__device__ __forceinline__ void stage_gemm(KParams p, int l, int which, char* smem) {
    GemmProg S; S.act = p->ws + OFF_ACT; S.wt = p->ws + OFF_WT + (size_t)l * WT_ROWS * 1024 * 2; S.which = which; S.G = gridDim.x; S.c = bid_();
    GemmEpi E; E.act = (h16_t*)(p->ws + OFF_ACT); E.mb = p->in[I_MB] + l * 3072; E.resid = l == 0 ? p->in[I_X] : p->out; E.out = p->out;
    pg8::gemm_phase(smem, S, E);
}

#ifdef CPU_EMU
__device__ __forceinline__ float group_sum(float v, int width, float* scratch) {
    const int tid = tid_();
    scratch[tid] = v;
    __syncthreads();
    float s = 0.f; const int base = tid & ~(width - 1);
    for (int i = 0; i < width; ++i) s += scratch[base + i];
    __syncthreads();
    return s;
}
#else
template <int CTRL> __device__ __forceinline__ float dpp_f(float v) { return __builtin_bit_cast(float, __builtin_amdgcn_update_dpp(0, __builtin_bit_cast(int, v), CTRL, 0xf, 0xf, false)); }
__device__ __forceinline__ float group_sum(float v, int width, float*) {
    v += dpp_f<0xB1>(v);
    v += dpp_f<0x4E>(v);
    if (width >= 8) v += dpp_f<0x141>(v);
    if (width >= 16) v += dpp_f<0x140>(v);
    if (width >= 64) {
        v += __builtin_bit_cast(float, __builtin_amdgcn_update_dpp(0, __builtin_bit_cast(int, v), 0x142, 0xa, 0xf, false));
        v += __builtin_bit_cast(float, __builtin_amdgcn_update_dpp(0, __builtin_bit_cast(int, v), 0x143, 0xc, 0xf, false));
        v = __builtin_bit_cast(float, __builtin_amdgcn_readlane(__builtin_bit_cast(int, v), 63));
    } else if (width >= 32) v += __shfl_xor(v, 16);
    return v;
}
#endif
__device__ __forceinline__ uint4 ldg16(const h16_t* p) { return *(const uint4*)p; }
__device__ __forceinline__ uint4 zero16() { uint4 z; z.x = 0u; z.y = 0u; z.z = 0u; z.w = 0u; return z; }

__device__ __forceinline__ void stage_lru(KParams p, int l, char* smem, int vb0, int nvb) {
    const int vb = bid_() - vb0;
    if (vb < 0 || vb >= nvb) return;
    constexpr int CH = 64;
    float* wa_s = (float*)smem;
    float* wx_s = wa_s + 4096;
    float* xcT = wx_s + 4096;
    float* a_s = xcT + 64 * CH;
    float* b_s = a_s + CH * 64;
    h16_t* ru = (h16_t*)(b_s + CH * 64);
    h16_t* rg = ru + (CH + 3) * 64;
    h16_t* ACT = (h16_t*)(p->ws + OFF_ACT);
    const int tid = tid_(), c = tid & 63, tg = tid >> 6;
    for (int item = vb; item < B_ * 16; item += nvb) {
        const int b = item / 16, n = item % 16, ch = n * 64 + c;
        __syncthreads();
        for (int i = tid; i < 4096; i += NT) { wa_s[i] = p->in[I_LWA][((size_t)l * 16 + n) * 4096 + i]; wx_s[i] = p->in[I_LWX][((size_t)l * 16 + n) * 4096 + i]; }
        const float cw0 = p->in[I_LCW][((size_t)l * 4 + 0) * 1024 + ch], cw1 = p->in[I_LCW][((size_t)l * 4 + 1) * 1024 + ch];
        const float cw2 = p->in[I_LCW][((size_t)l * 4 + 2) * 1024 + ch], cw3 = p->in[I_LCW][((size_t)l * 4 + 3) * 1024 + ch];
        const float cb = p->in[I_LCB][l * 1024 + ch], ba = p->in[I_LBA][l * 1024 + ch], bx = p->in[I_LBX][l * 1024 + ch];
        const float sp = softplusf_(-p->in[I_LLAM][l * 1024 + ch]);
        float hst = 0.f;
        uint4 pf[3];
#define LRU_LOAD(t0_) do { _Pragma("unroll") for (int i = 0; i < 3; ++i) { const int j = tid + NT * i; pf[i] = zero16(); \
            if (j < 536) { const int t = (t0_) - 3 + (j >> 3); if (t >= 0) pf[i] = ldg16(ACT + ((size_t)b * T_ + t) * LDZ + Z_ULRU + n * 64 + (j & 7) * 8); } \
            else if (j < 1048) { const int jj = j - 536; pf[i] = ldg16(ACT + ((size_t)b * T_ + (t0_) + (jj >> 3)) * LDZ + Z_GLRU + n * 64 + (jj & 7) * 8); } } } while (0)
#define LRU_PUT() do { _Pragma("unroll") for (int i = 0; i < 3; ++i) { const int j = tid + NT * i; \
            if (j < 536) *(uint4*)(ru + (j >> 3) * 64 + (j & 7) * 8) = pf[i]; else if (j < 1048) *(uint4*)(rg + ((j - 536) >> 3) * 64 + ((j - 536) & 7) * 8) = pf[i]; } } while (0)
        LRU_LOAD(0);
        LRU_PUT();
        __syncthreads();
#pragma unroll 1
        for (int t0 = 0; t0 < T_; t0 += CH) {
            float xc[8];
            {
                float u[11];
#pragma unroll
                for (int s = 0; s < 11; ++s) u[s] = h2f(ru[(tg * 8 + s) * 64 + c]);
#pragma unroll
                for (int s = 0; s < 8; ++s) { xc[s] = cw0 * u[s] + cw1 * u[s + 1] + cw2 * u[s + 2] + cw3 * u[s + 3] + cb; xcT[c * CH + tg * 8 + s] = xc[s]; }
            }
            __syncthreads();
            if (t0 + CH < T_) LRU_LOAD(t0 + CH);
            {
                float dr[8], di[8];
#pragma unroll
                for (int s = 0; s < 8; ++s) { dr[s] = 0.f; di[s] = 0.f; }
#pragma unroll 4
                for (int i = 0; i < 64; ++i) {
                    const float wa = wa_s[i * 64 + c], wx = wx_s[i * 64 + c];
                    const float4 x0 = *(const float4*)(xcT + i * CH + tg * 8), x1 = *(const float4*)(xcT + i * CH + tg * 8 + 4);
                    dr[0] += x0.x * wa; dr[1] += x0.y * wa; dr[2] += x0.z * wa; dr[3] += x0.w * wa; dr[4] += x1.x * wa; dr[5] += x1.y * wa; dr[6] += x1.z * wa; dr[7] += x1.w * wa;
                    di[0] += x0.x * wx; di[1] += x0.y * wx; di[2] += x0.z * wx; di[3] += x0.w * wx; di[4] += x1.x * wx; di[5] += x1.y * wx; di[6] += x1.z * wx; di[7] += x1.w * wx;
                }
#pragma unroll
                for (int s = 0; s < 8; ++s) {
                    const float r = sigmoidf_(dr[s] + ba), ig = sigmoidf_(di[s] + bx);
                    const float log_a = -8.0f * r * sp;
                    a_s[(tg * 8 + s) * 64 + c] = fexp_(log_a);
                    b_s[(tg * 8 + s) * 64 + c] = sqrtf(fmaxf(1.0f - fexp_(2.0f * log_a), 0.0f)) * (ig * xc[s]);
                }
            }
            __syncthreads();
            if (tid < 64) {
#pragma unroll 8
                for (int t = 0; t < CH; ++t) { hst = a_s[t * 64 + c] * hst + b_s[t * 64 + c]; b_s[t * 64 + c] = hst; }
            }
            __syncthreads();
#pragma unroll
            for (int s = 0; s < 8; ++s) { h16_t* gp = rg + (tg * 8 + s) * 64 + c; *gp = f2h(b_s[(tg * 8 + s) * 64 + c] * geluf_(h2f(*gp))); }
            __syncthreads();
            *(uint4*)(ACT + ((size_t)b * T_ + t0 + (tid >> 3)) * LDZ + Z_GLRU + n * 64 + (tid & 7) * 8) = *(const uint4*)(rg + (tid >> 3) * 64 + (tid & 7) * 8);
            __syncthreads();
            if (t0 + CH < T_) LRU_PUT();
            __syncthreads();
        }
#undef LRU_LOAD
#undef LRU_PUT
    }
}

#ifdef CPU_EMU
struct hfrag { h16_t v[8]; };
struct facc { float d[4]; float& operator[](int i) { return d[i]; } const float& operator[](int i) const { return d[i]; } };
__device__ __forceinline__ facc facc_zero() { facc a; a.d[0] = a.d[1] = a.d[2] = a.d[3] = 0.f; return a; }
__device__ __forceinline__ hfrag frag_u4(uint4 w) { hfrag f; memcpy(&f, &w, 16); return f; }
__device__ __forceinline__ hfrag frag_2u2(uint2 lo, uint2 hi) { hfrag f; memcpy(&f.v[0], &lo, 8); memcpy(&f.v[4], &hi, 8); return f; }
__device__ __forceinline__ hfrag frag_mul(hfrag a, hfrag b) { hfrag f; for (int j = 0; j < 8; ++j) f.v[j] = f2h(h2f(a.v[j]) * h2f(b.v[j])); return f; }
__device__ __forceinline__ facc mfma16(hfrag a, hfrag b, facc c) {
    const int tid = tid_(), w = tid >> 6, l = tid & 63;
    unsigned short (*X)[64][16] = emu::ctx->xscr;
    for (int j = 0; j < 8; ++j) { X[w][l][j] = a.v[j]; X[w][l][8 + j] = b.v[j]; }
    __syncthreads();
    for (int reg = 0; reg < 4; ++reg) {
        const int row = 4 * (l >> 4) + reg, col = l & 15;
        float s = 0.f;
        for (int k = 0; k < 32; ++k) s += h2f(X[w][row + 16 * (k >> 3)][k & 7]) * h2f(X[w][col + 16 * (k >> 3)][8 + (k & 7)]);
        c.d[reg] += s;
    }
    __syncthreads();
    return c;
}
#else
typedef _Float16 hfrag __attribute__((ext_vector_type(8)));
typedef float facc __attribute__((ext_vector_type(4)));
__device__ __forceinline__ facc facc_zero() { return (facc){0.f, 0.f, 0.f, 0.f}; }
__device__ __forceinline__ hfrag frag_u4(uint4 w) { return __builtin_bit_cast(hfrag, w); }
__device__ __forceinline__ hfrag frag_2u2(uint2 lo, uint2 hi) { uint4 w; w.x = lo.x; w.y = lo.y; w.z = hi.x; w.w = hi.y; return __builtin_bit_cast(hfrag, w); }
__device__ __forceinline__ hfrag frag_mul(hfrag a, hfrag b) { return a * b; }
__device__ __forceinline__ facc mfma16(hfrag a, hfrag b, facc c) { return __builtin_amdgcn_mfma_f32_16x16x32_f16(a, b, c, 0, 0, 0); }
#endif
__device__ __forceinline__ hfrag frag_pack8(float a0, float a1, float a2, float a3, float a4, float a5, float a6, float a7) {
    uint4 w; w.x = pack2h(a0, a1); w.y = pack2h(a2, a3); w.z = pack2h(a4, a5); w.w = pack2h(a6, a7); return frag_u4(w);
}
__device__ __forceinline__ hfrag frag_acc2(const facc& t0, const facc& t1) { return frag_pack8(t0[0], t0[1], t0[2], t0[3], t1[0], t1[1], t1[2], t1[3]); }
__device__ __forceinline__ hfrag permfrag(const h16_t* rowp, int ks, int g) { return frag_2u2(*(const uint2*)(rowp + 32 * ks + 4 * g), *(const uint2*)(rowp + 32 * ks + 16 + 4 * g)); }

__device__ __forceinline__ void stage_gdn(KParams p, int l, char* smem, int vb0, int nvb) {
    const int vb = bid_() - vb0;
    if (vb < 0 || vb >= nvb) return;
    constexpr int CH = 64, QS = 136, TS = 72, AS = 68, KTS = 128 * TS + 16 * 8;
#define KTO(d) ((d) * TS + ((d) >> 3) * 8)
    h16_t* Qs = (h16_t*)smem;
    h16_t* Ks = Qs + 64 * QS;
    h16_t* Kt = Ks + 64 * QS;
    h16_t* Vt = Kt + KTS;
    float* A32 = (float*)(Vt + KTS);
    h16_t* ob = (h16_t*)A32;
    h16_t* Tu = (h16_t*)(A32 + 64 * AS);
    h16_t* Tw = Tu + 64 * TS;
    h16_t* QKm = Tw + 64 * TS;
    float* gc_s = (float*)(QKm + 64 * TS);
    float* be_s = gc_s + 64;
    float* e1_s = be_s + 64;
    float* part_s = e1_s + 64;
    float* scr = part_s + 512;
    float* cw_s = scr + 512;
    h16_t* ACT = (h16_t*)(p->ws + OFF_ACT);
    int tid = tid_(), lane = tid & 63, w = tid >> 6, g = lane >> 4, r16 = lane & 15;
    int sg = lane >> 4, pc = lane & 15, rb = w;
#define GDN_ROLES() do { tid = tid_(); lane = tid & 63; w = tid >> 6; g = lane >> 4; r16 = lane & 15; sg = g; pc = r16; rb = w; } while (0)
    for (int item = vb; item < B_ * 8; item += nvb) {
        const int b = item / 8, h = item % 8;
        const float a_exp = fexp_(p->in[I_GALOG][l * 8 + h]), dtb = p->in[I_GDT][l * 8 + h];
        facc S[8];
#pragma unroll
        for (int dt = 0; dt < 8; ++dt) S[dt] = facc_zero();
        __syncthreads();
        for (int i = tid; i < 64 * TS / 2; i += NT) ((unsigned*)QKm)[i] = 0u;
        for (int i = tid; i < 4 * 384; i += NT) { const int jj = i / 384, c3 = i % 384; cw_s[i] = p->in[I_GCW][((size_t)l * 4 + jj) * 3072 + (c3 >> 7) * 1024 + h * 128 + (c3 & 127)]; }
        uint4 pf[11];
#define GDN_LOAD(t0_) do { GDN_ROLES(); const h16_t* colp = ACT + ((size_t)b * T_ + (t0_) + 8 * rb - 3) * LDZ + (sg < 3 ? Z_Q + sg * 1024 : Z_ZG) + h * 128 + pc * 8; \
            _Pragma("unroll") for (int i = 0; i < 11; ++i) { const int t = (t0_) + 8 * rb - 3 + i; pf[i] = (t >= 0 && sg < 3) ? ldg16(colp + (size_t)i * LDZ) : zero16(); } } while (0)
        GDN_LOAD(0);
        h16_t pfa = 0, pfb = 0;
#define GDN_LOADS(t0_) do { if (tid < 64) { const size_t m_ = (size_t)b * T_ + (t0_) + tid; pfa = ACT[m_ * LDZ + Z_ALPHA + h]; pfb = ACT[m_ * LDZ + Z_BETA + h]; } } while (0)
        GDN_LOADS(0);
#pragma unroll 1
        for (int t0 = 0; t0 < T_; t0 += CH) {
            GDN_ROLES();
            if (tid < 64) {
                part_s[tid] = -a_exp * softplusf_(h2f(pfa) + dtb);
                be_s[tid] = sigmoidf_(h2f(pfb));
            }
            __syncthreads();
            if (tid < 64) { float s = 0.f;
#pragma unroll
                for (int i4 = 0; i4 < 16; ++i4) { const float4 pv = *(const float4*)(part_s + i4 * 4); s += (i4 * 4 <= tid ? pv.x : 0.f) + (i4 * 4 + 1 <= tid ? pv.y : 0.f) + (i4 * 4 + 2 <= tid ? pv.z : 0.f) + (i4 * 4 + 3 <= tid ? pv.w : 0.f); }
                gc_s[tid] = s; }
#pragma unroll
            for (int hf = 0; hf < 2; ++hf) {
                float ov[4][8];
#pragma unroll
                for (int i = 0; i < 4; ++i) {
#pragma unroll
                    for (int cc = 0; cc < 8; ++cc) ov[i][cc] = 0.f;
#pragma unroll
                    for (int jj = 0; jj < 4; ++jj) {
                        const uint4 wv = pf[hf * 4 + i + jj];
                        const float* cwp = cw_s + jj * 384 + (sg < 3 ? sg : 0) * 128 + pc * 8;
                        const float4 c0 = *(const float4*)cwp, c1 = *(const float4*)(cwp + 4);
                        ov[i][0] += c0.x * h2f((h16_t)(wv.x & 0xffffu)); ov[i][1] += c0.y * h2f((h16_t)(wv.x >> 16)); ov[i][2] += c0.z * h2f((h16_t)(wv.y & 0xffffu)); ov[i][3] += c0.w * h2f((h16_t)(wv.y >> 16));
                        ov[i][4] += c1.x * h2f((h16_t)(wv.z & 0xffffu)); ov[i][5] += c1.y * h2f((h16_t)(wv.z >> 16)); ov[i][6] += c1.z * h2f((h16_t)(wv.w & 0xffffu)); ov[i][7] += c1.w * h2f((h16_t)(wv.w >> 16));
                    }
                    float ss = 0.f;
#pragma unroll
                    for (int cc = 0; cc < 8; ++cc) { ov[i][cc] = siluf_(ov[i][cc]); ss += ov[i][cc] * ov[i][cc]; }
                    ss = group_sum(ss, 16, scr);
                    const float rn = sg == 0 ? rsqrtf(ss + RMS_EPS) * 0.08838834764831845f : (sg == 1 ? rsqrtf(ss + RMS_EPS) : 1.0f);
#pragma unroll
                    for (int cc = 0; cc < 8; ++cc) ov[i][cc] *= rn;
                    const int t = 8 * rb + hf * 4 + i;
                    if (sg == 0) store8h(Qs + t * QS + pc * 8, ov[i]);
                    else if (sg == 1) store8h(Ks + t * QS + pc * 8, ov[i]);
                }
                if (sg == 1 || sg == 2) {
                    h16_t* dstT = sg == 1 ? Kt : Vt;
#pragma unroll
                    for (int cc = 0; cc < 8; ++cc) { uint2 w2; w2.x = pack2h(ov[0][cc], ov[1][cc]); w2.y = pack2h(ov[2][cc], ov[3][cc]); *(uint2*)(dstT + KTO(pc * 8 + cc) + 8 * rb + hf * 4) = w2; }
                }
            }
            __syncthreads();
            GDN_ROLES();
            if (tid < 64) e1_s[tid] = fexp_(gc_s[63] - gc_s[tid]);
            for (int e = tid; e < 64 * 64; e += NT) { const int i = e >> 6, j = e & 63; if ((j >> 4) > (i >> 4)) A32[i * AS + (j & 7) * 8 + (j >> 3)] = 0.f; }
#pragma unroll 1
            for (int jr = 0; jr < 3; ++jr) {
                const int jb = w + 8 * jr; const bool valid = jb < 20;
                const int kind = (valid && jb >= 10) ? 1 : 0, tix = valid ? (jb % 10) : 0;
                const int ti = tix < 1 ? 0 : (tix < 3 ? 1 : (tix < 6 ? 2 : 3)), tj = tix - (ti * (ti + 1)) / 2;
                const h16_t* ap = (kind ? Qs : Ks) + (16 * ti + r16) * QS + 8 * g; const h16_t* bp = Ks + (16 * tj + r16) * QS + 8 * g;
                facc acc = facc_zero();
#pragma unroll
                for (int ks = 0; ks < 4; ++ks) acc = mfma16(frag_u4(*(const uint4*)(ap + 32 * ks)), frag_u4(*(const uint4*)(bp + 32 * ks)), acc);
                if (valid) {
                    const int j = 16 * tj + r16; const float gj = gc_s[j];
#pragma unroll
                    for (int reg = 0; reg < 4; ++reg) {
                        const int i = 16 * ti + 4 * g + reg;
                        const float dec = fexp_(fminf(gc_s[i] - gj, 0.f));
                        if (kind == 0) A32[i * AS + (j & 7) * 8 + (j >> 3)] = i > j ? be_s[i] * acc[reg] * dec : 0.f;
                        else QKm[i * TS + j] = f2h(i >= j ? acc[reg] * dec : 0.f);
                    }
                }
            }
            __syncthreads();
            GDN_ROLES();
            {
                const int t = tid >> 3, d0 = (tid & 7) * 16; const float eg = fexp_(gc_s[t]);
                float v8[8];
                load8h(Qs + t * QS + d0, v8);
#pragma unroll
                for (int e = 0; e < 8; ++e) v8[e] *= eg;
                store8h(Qs + t * QS + d0, v8);
                load8h(Qs + t * QS + d0 + 8, v8);
#pragma unroll
                for (int e = 0; e < 8; ++e) v8[e] *= eg;
                store8h(Qs + t * QS + d0 + 8, v8);
            }
            {
                const int c = tid >> 3, q = tid & 7;
                const float bc = be_s[c], bgc = bc * fexp_(gc_s[c]);
                float x[8];
#pragma unroll
                for (int i = 0; i < 8; ++i) x[i] = 0.f;
#pragma unroll
                for (int r = 0; r < 64; ++r) {
                    float sacc = 0.f;
                    if (r > 0) {
                        const float4 a0 = *(const float4*)(A32 + r * AS + q * 8);
                        sacc = a0.x * x[0];
                        if (r > 8) sacc += a0.y * x[1];
                        if (r > 16) sacc += a0.z * x[2];
                        if (r > 24) sacc += a0.w * x[3];
                        if (r > 32) {
                            const float4 a1 = *(const float4*)(A32 + r * AS + q * 8 + 4);
                            sacc += a1.x * x[4];
                            if (r > 40) sacc += a1.y * x[5];
                            if (r > 48) sacc += a1.z * x[6];
                            if (r > 56) sacc += a1.w * x[7];
                        }
                        sacc = group_sum(sacc, 8, scr);
                    }
                    const float xr = ((r == c) ? 1.f : 0.f) - sacc;
                    if (q == (r & 7)) { x[r >> 3] = xr; Tu[r * TS + c] = f2h(xr * bc); Tw[r * TS + c] = f2h(xr * bgc); }
                }
            }
            __syncthreads();
            GDN_ROLES();
            facc vn[4], aw[4];
#pragma unroll
            for (int tt = 0; tt < 4; ++tt) { vn[tt] = facc_zero(); aw[tt] = facc_zero(); }
#pragma unroll
            for (int tt = 0; tt < 4; ++tt)
#pragma unroll
                for (int ks = 0; ks <= (tt >> 1); ++ks) {
                    const hfrag au = frag_u4(*(const uint4*)(Tu + (16 * tt + r16) * TS + 32 * ks + 8 * g)), aww = frag_u4(*(const uint4*)(Tw + (16 * tt + r16) * TS + 32 * ks + 8 * g));
                    vn[tt] = mfma16(au, frag_u4(*(const uint4*)(Vt + KTO(16 * w + r16) + 32 * ks + 8 * g)), vn[tt]);
                    aw[tt] = mfma16(aww, frag_u4(*(const uint4*)(Kt + KTO(16 * w + r16) + 32 * ks + 8 * g)), aw[tt]);
                }
#pragma unroll
            for (int tt = 0; tt < 4; ++tt)
#pragma unroll
                for (int reg = 0; reg < 4; ++reg) Ks[(16 * tt + 4 * g + reg) * QS + 16 * w + r16] = f2h(-aw[tt][reg]);
            __syncthreads();
            GDN_ROLES();
            h16_t zraw[16];
#pragma unroll
            for (int tt = 0; tt < 4; ++tt)
#pragma unroll
                for (int reg = 0; reg < 4; ++reg) zraw[tt * 4 + reg] = ACT[((size_t)b * T_ + t0 + 16 * tt + 4 * g + reg) * LDZ + Z_ZG + h * 128 + 16 * w + r16];
            hfrag Sb[4];
#pragma unroll
            for (int ks = 0; ks < 4; ++ks) Sb[ks] = frag_acc2(S[2 * ks], S[2 * ks + 1]);
            facc oc[4];
#pragma unroll
            for (int tt = 0; tt < 4; ++tt) {
                oc[tt] = facc_zero();
                const h16_t* wrow = Ks + (16 * tt + r16) * QS; const h16_t* qrow = Qs + (16 * tt + r16) * QS;
#pragma unroll
                for (int ks = 0; ks < 4; ++ks) { vn[tt] = mfma16(permfrag(wrow, ks, g), Sb[ks], vn[tt]); oc[tt] = mfma16(permfrag(qrow, ks, g), Sb[ks], oc[tt]); }
            }
            hfrag VNb[2];
            VNb[0] = frag_acc2(vn[0], vn[1]); VNb[1] = frag_acc2(vn[2], vn[3]);
#pragma unroll
            for (int tt = 0; tt < 4; ++tt)
#pragma unroll
                for (int ks2 = 0; ks2 <= (tt >> 1); ++ks2) oc[tt] = mfma16(permfrag(QKm + (16 * tt + r16) * TS, ks2, g), VNb[ks2], oc[tt]);
            {
                const float egl = fexp_(gc_s[63]);
                hfrag e1f[2];
#pragma unroll
                for (int ks2 = 0; ks2 < 2; ++ks2) { const float* ep = e1_s + 32 * ks2 + 4 * g; e1f[ks2] = frag_pack8(ep[0], ep[1], ep[2], ep[3], ep[16], ep[17], ep[18], ep[19]); }
#pragma unroll
                for (int dt = 0; dt < 8; ++dt) {
#pragma unroll
                    for (int reg = 0; reg < 4; ++reg) S[dt][reg] *= egl;
#pragma unroll
                    for (int ks2 = 0; ks2 < 2; ++ks2) S[dt] = mfma16(frag_mul(permfrag(Kt + KTO(16 * dt + r16), ks2, g), e1f[ks2]), VNb[ks2], S[dt]);
                }
            }
            if (t0 + CH < T_) { GDN_LOAD(t0 + CH); GDN_LOADS(t0 + CH); }
            GDN_ROLES();
#pragma unroll
            for (int tt = 0; tt < 4; ++tt)
#pragma unroll
                for (int reg = 0; reg < 4; ++reg) { const float ss = group_sum(oc[tt][reg] * oc[tt][reg], 16, scr); if (r16 == 0) part_s[w * 64 + 16 * tt + 4 * g + reg] = ss; }
            __syncthreads();
            const float nw = p->in[I_GNW][l * 128 + w * 16 + r16];
#pragma unroll
            for (int tt = 0; tt < 4; ++tt)
#pragma unroll
                for (int reg = 0; reg < 4; ++reg) {
                    const int t = 16 * tt + 4 * g + reg;
                    float ms = 0.f;
#pragma unroll
                    for (int ww = 0; ww < 8; ++ww) ms += part_s[ww * 64 + t];
                    ob[t * 128 + 16 * w + r16] = f2h(oc[tt][reg] * rsqrtf(ms * (1.0f / 128.0f) + RMS_EPS) * nw * siluf_(h2f(zraw[tt * 4 + reg])));
                }
            __syncthreads();
            GDN_ROLES();
#pragma unroll
            for (int i = 0; i < 2; ++i) { const int j = tid + NT * i; *(uint4*)(ACT + ((size_t)b * T_ + t0 + (j >> 4)) * LDZ + Z_ZG + h * 128 + (j & 15) * 8) = *(const uint4*)(ob + (j >> 4) * 128 + (j & 15) * 8); }
            __syncthreads();
        }
#undef GDN_LOAD
#undef GDN_LOADS
#undef KTO
#undef GDN_ROLES
    }
}

#ifndef CPU_EMU
typedef _Float16 rw_f16x8 __attribute__((ext_vector_type(8)));
typedef float rw_f32x4 __attribute__((ext_vector_type(4)));
#endif
__device__ __forceinline__ void stage_rwkv(KParams p, int l, char* smem, int vb0, int nvb) {
    const int vb = bid_() - vb0;
    if (vb < 0 || vb >= nvb) return;
    constexpr int CH = 32, XS = 264;
    float* r_s = (float*)smem;
    float* k_s = r_s + CH * 64;
    float* v_s = k_s + CH * 64;
    float* w_s = v_s + CH * 64;
    float* kk_s = w_s + CH * 64;
    float* ka_s = kk_s + CH * 64;
    float* g_s = ka_s + CH * 64;
    float* o_s = g_s + CH * 64;
    float* bon_s = o_s + CH * 64;
    float* scr = bon_s + CH;
    h16_t* raw = (h16_t*)(scr + 512);
    h16_t* xs = raw + (CH + 1) * 448;
    h16_t* ACT = (h16_t*)(p->ws + OFF_ACT);
    int tid = tid_(), c = tid & 63, tg = tid >> 6;
    int ri = tid >> 3, q8 = tid & 7;
#define RW_ROLES() do { tid = tid_(); c = tid & 63; tg = tid >> 6; ri = tid >> 3; q8 = tid & 7; } while (0)
    float* cst_s = (float*)(xs + CH * XS);
    for (int item = vb; item < B_ * 16; item += nvb) {
        const int b = item / 16, h = item % 16, ch = h * 64 + c;
        __syncthreads();
        if (tid < 64) {
            const float* mu = p->in[I_RMU] + (size_t)l * RWW;
            cst_s[0 * 64 + c] = p->in[I_RW0][l * 1024 + ch]; cst_s[1 * 64 + c] = p->in[I_RA0][l * 1024 + ch]; cst_s[2 * 64 + c] = p->in[I_RKK][l * 1024 + ch]; cst_s[3 * 64 + c] = p->in[I_RKA][l * 1024 + ch];
            cst_s[4 * 64 + c] = p->in[I_RRK][(size_t)l * 1024 + ch]; cst_s[5 * 64 + c] = p->in[I_RLW][l * 1024 + ch]; cst_s[6 * 64 + c] = p->in[I_RLB][l * 1024 + ch];
            cst_s[7 * 64 + c] = mu[RW_R + ch]; cst_s[8 * 64 + c] = mu[RW_K + ch]; cst_s[9 * 64 + c] = mu[RW_V + ch];
            cst_s[10 * 64 + c] = mu[RW_WL + c]; cst_s[11 * 64 + c] = mu[RW_AL + c]; cst_s[12 * 64 + c] = mu[RW_GL + c]; cst_s[13 * 64 + c] = mu[RW_GL + 64 + c];
        }
        const float* wup = p->in[I_RWUP] + (size_t)l * 64 * 1024 + h * 64; const float* aup = p->in[I_RAUP] + (size_t)l * 64 * 1024 + h * 64; const float* gup = p->in[I_RGUP] + (size_t)l * 128 * 1024 + h * 64;
#ifndef CPU_EMU
        const int wid = tid >> 6, lane = tid & 63, mt = wid >> 2, nt = wid & 3;
        rw_f16x8 bw[2], ba_[2], bg[4];
        {
            const int cn = nt * 16 + (lane & 15), kb = 8 * (lane >> 4);
#pragma unroll
            for (int ks = 0; ks < 2; ++ks)
#pragma unroll
                for (int j = 0; j < 8; ++j) { bw[ks][j] = (_Float16)wup[(size_t)(ks * 32 + kb + j) * 1024 + cn]; ba_[ks][j] = (_Float16)aup[(size_t)(ks * 32 + kb + j) * 1024 + cn]; }
#pragma unroll
            for (int ks = 0; ks < 4; ++ks)
#pragma unroll
                for (int j = 0; j < 8; ++j) bg[ks][j] = (_Float16)gup[(size_t)(ks * 32 + kb + j) * 1024 + cn];
        }
#endif
        float S[8];
#pragma unroll
        for (int e = 0; e < 8; ++e) S[e] = 0.f;
        uint4 pf[4];
#define RW_LOAD(t0_) do { _Pragma("unroll") for (int i = 0; i < 4; ++i) { const int j = tid + NT * i, row = j / 56, u = j % 56, t = (t0_) - 1 + row; pf[i] = zero16(); \
            if (j < (CH + 1) * 56 && t >= 0) pf[i] = ldg16(ACT + ((size_t)b * T_ + t) * LDZ + Z_RW + (u < 24 ? (u >> 3) * 1024 + h * 64 + (u & 7) * 8 : 3072 + (u - 24) * 8)); } } while (0)
#define RW_PUT() do { _Pragma("unroll") for (int i = 0; i < 4; ++i) { const int j = tid + NT * i; if (j < (CH + 1) * 56) *(uint4*)(raw + (j / 56) * 448 + (j % 56) * 8) = pf[i]; } } while (0)
        __syncthreads();
        RW_LOAD(0);
        RW_PUT();
        __syncthreads();
#pragma unroll 1
        for (int t0 = 0; t0 < T_; t0 += CH) {
            RW_ROLES();
            {
            const float mu_r = cst_s[7 * 64 + c], mu_k = cst_s[8 * 64 + c], mu_v = cst_s[9 * 64 + c], mu_wl = cst_s[10 * 64 + c], mu_al = cst_s[11 * 64 + c], mu_g0 = cst_s[12 * 64 + c], mu_g1 = cst_s[13 * 64 + c];
#pragma unroll
            for (int s = 0; s < 4; ++s) {
                const int tl = tg * 4 + s;
                const h16_t* zc = raw + (tl + 1) * 448; const h16_t* zp = raw + tl * 448;
#define RW_SHIFT(col, muv) ({ const float zz = h2f(zc[col]); zz + (muv) * (h2f(zp[col]) - zz); })
                r_s[tl * 64 + c] = RW_SHIFT(c, mu_r);
                k_s[tl * 64 + c] = RW_SHIFT(64 + c, mu_k);
                v_s[tl * 64 + c] = RW_SHIFT(128 + c, mu_v);
                xs[tl * XS + c] = f2h(tanhf_(RW_SHIFT(192 + c, mu_wl)));
                xs[tl * XS + 64 + c] = f2h(RW_SHIFT(256 + c, mu_al));
                xs[tl * XS + 128 + c] = f2h(sigmoidf_(RW_SHIFT(320 + c, mu_g0)));
                xs[tl * XS + 192 + c] = f2h(sigmoidf_(RW_SHIFT(384 + c, mu_g1)));
#undef RW_SHIFT
            }
            }
            __syncthreads();
#ifdef CPU_EMU
#pragma unroll
            for (int s = 0; s < 4; ++s) {
                const int tl = tg * 4 + s;
                float dw = 0.f, da = 0.f, dg = 0.f;
                for (int i = 0; i < 64; ++i) { dw += h2f(xs[tl * XS + i]) * h2f(f2h(wup[(size_t)i * 1024 + c])); da += h2f(xs[tl * XS + 64 + i]) * h2f(f2h(aup[(size_t)i * 1024 + c])); }
                for (int i = 0; i < 128; ++i) dg += h2f(xs[tl * XS + 128 + i]) * h2f(f2h(gup[(size_t)i * 1024 + c]));
                w_s[tl * 64 + c] = dw; ka_s[tl * 64 + c] = da; g_s[tl * 64 + c] = dg;
            }
#else
            {
                const h16_t* ap = xs + (mt * 16 + (lane & 15)) * XS + 8 * (lane >> 4);
                rw_f32x4 dw = {0.f, 0.f, 0.f, 0.f}, da = {0.f, 0.f, 0.f, 0.f}, dg = {0.f, 0.f, 0.f, 0.f};
#pragma unroll
                for (int ks = 0; ks < 2; ++ks) {
                    dw = __builtin_amdgcn_mfma_f32_16x16x32_f16(*(const rw_f16x8*)(ap + ks * 32), bw[ks], dw, 0, 0, 0);
                    da = __builtin_amdgcn_mfma_f32_16x16x32_f16(*(const rw_f16x8*)(ap + 64 + ks * 32), ba_[ks], da, 0, 0, 0);
                }
#pragma unroll
                for (int ks = 0; ks < 4; ++ks) dg = __builtin_amdgcn_mfma_f32_16x16x32_f16(*(const rw_f16x8*)(ap + 128 + ks * 32), bg[ks], dg, 0, 0, 0);
#pragma unroll
                for (int rg = 0; rg < 4; ++rg) { const int o = (mt * 16 + 4 * (lane >> 4) + rg) * 64 + nt * 16 + (lane & 15); w_s[o] = dw[rg]; ka_s[o] = da[rg]; g_s[o] = dg[rg]; }
            }
#endif
            __syncthreads();
            RW_ROLES();
            {
            const float w0 = cst_s[0 * 64 + c], a0 = cst_s[1 * 64 + c], k_k = cst_s[2 * 64 + c], k_a = cst_s[3 * 64 + c], rk_c = cst_s[4 * 64 + c];
#pragma unroll
            for (int s = 0; s < 4; ++s) {
                const int tl = tg * 4 + s;
                const float w_log = -softplusf_(-(w0 + w_s[tl * 64 + c])) - 0.5f;
                const float decay = fexp_(-fexp_(w_log));
                const float a = sigmoidf_(a0 + ka_s[tl * 64 + c]);
                const float kx = k_s[tl * 64 + c], rx = r_s[tl * 64 + c];
                const float kkr = kx * k_k, k2 = kx * (1.0f + (a - 1.0f) * k_a);
                const float nsq = group_sum(kkr * kkr, 64, scr);
                const float bon = group_sum(rx * k2 * rk_c, 64, scr);
                const float kkn = kkr * rsqrtf(nsq + RMS_EPS);
                w_s[tl * 64 + c] = decay; k_s[tl * 64 + c] = k2; kk_s[tl * 64 + c] = kkn; ka_s[tl * 64 + c] = kkn * a;
                if (c == 0) bon_s[tl] = bon;
            }
            }
            __syncthreads();
            RW_ROLES();
            {
                struct StepVec { float4 kk0, kk1, w0, w1, a0, a1, k0, k1, r0, r1; float vi; };
#define RW_LDSTEP(V_, t_) do { const int o8_ = (t_) * 64 + q8 * 8; V_.kk0 = *(const float4*)(kk_s + o8_); V_.kk1 = *(const float4*)(kk_s + o8_ + 4); V_.w0 = *(const float4*)(w_s + o8_); V_.w1 = *(const float4*)(w_s + o8_ + 4); \
                    V_.a0 = *(const float4*)(ka_s + o8_); V_.a1 = *(const float4*)(ka_s + o8_ + 4); V_.k0 = *(const float4*)(k_s + o8_); V_.k1 = *(const float4*)(k_s + o8_ + 4); \
                    V_.r0 = *(const float4*)(r_s + o8_); V_.r1 = *(const float4*)(r_s + o8_ + 4); V_.vi = v_s[(t_) * 64 + ri]; } while (0)
#define RW_STEP(V_, t_) do { \
                    const float pk = (S[0] * V_.kk0.x + S[1] * V_.kk0.y) + (S[2] * V_.kk0.z + S[3] * V_.kk0.w) + ((S[4] * V_.kk1.x + S[5] * V_.kk1.y) + (S[6] * V_.kk1.z + S[7] * V_.kk1.w)); \
                    const float skk = group_sum(pk, 8, scr); const float vi = V_.vi; \
                    S[0] = S[0] * V_.w0.x - skk * V_.a0.x + vi * V_.k0.x; S[1] = S[1] * V_.w0.y - skk * V_.a0.y + vi * V_.k0.y; S[2] = S[2] * V_.w0.z - skk * V_.a0.z + vi * V_.k0.z; S[3] = S[3] * V_.w0.w - skk * V_.a0.w + vi * V_.k0.w; \
                    S[4] = S[4] * V_.w1.x - skk * V_.a1.x + vi * V_.k1.x; S[5] = S[5] * V_.w1.y - skk * V_.a1.y + vi * V_.k1.y; S[6] = S[6] * V_.w1.z - skk * V_.a1.z + vi * V_.k1.z; S[7] = S[7] * V_.w1.w - skk * V_.a1.w + vi * V_.k1.w; \
                    const float po = (S[0] * V_.r0.x + S[1] * V_.r0.y) + (S[2] * V_.r0.z + S[3] * V_.r0.w) + ((S[4] * V_.r1.x + S[5] * V_.r1.y) + (S[6] * V_.r1.z + S[7] * V_.r1.w)); \
                    const float o = group_sum(po, 8, scr); \
                    if (q8 == 0) o_s[(t_) * 64 + ri] = o; } while (0)
                StepVec va, vb;
                RW_LDSTEP(va, 0);
#pragma unroll 1
                for (int t = 0; t < CH; t += 2) {
                    RW_LDSTEP(vb, t + 1);
                    RW_STEP(va, t);
                    if (t + 2 < CH) RW_LDSTEP(va, t + 2);
                    RW_STEP(vb, t + 1);
                }
#undef RW_LDSTEP
#undef RW_STEP
            }
            if (t0 + CH < T_) RW_LOAD(t0 + CH);
            __syncthreads();
            RW_ROLES();
            {
            const float lnw = cst_s[5 * 64 + c], lnb = cst_s[6 * 64 + c];
            const int ch = h * 64 + c;
#pragma unroll
            for (int s = 0; s < 4; ++s) {
                const int tl = tg * 4 + s;
                const float ov = o_s[tl * 64 + c];
                const float mean = group_sum(ov, 64, scr) * (1.0f / 64.0f);
                const float d = ov - mean;
                const float var = group_sum(d * d, 64, scr) * (1.0f / 64.0f);
                const float y = (d * rsqrtf(var + GN_EPS) * lnw + lnb + bon_s[tl] * v_s[tl * 64 + c]) * g_s[tl * 64 + c];
                ACT[((size_t)b * T_ + t0 + tl) * LDZ + C_YC + ch] = f2h(y);
            }
            }
            RW_ROLES();
            if (t0 + CH < T_) RW_PUT();
            __syncthreads();
        }
#undef RW_LOAD
#undef RW_PUT
#undef RW_ROLES
    }
}

constexpr bool TAB_IN_ACT = (M_ == 16384);
constexpr float TAB_SU = 256.0f, TAB_SV = 32.0f;
__device__ __forceinline__ unsigned char* tab_row(char* ws, int e) {
    if (TAB_IN_ACT) return (unsigned char*)((h16_t*)(ws + OFF_ACT) + (size_t)e * LDZ + C_GS);
    return (unsigned char*)(ws + OFF_TAB) + (size_t)e * 2048;
}
#ifdef CPU_EMU
__device__ __forceinline__ unsigned f2fp8(float f) {
    const unsigned sgn = f < 0.f ? 0x80u : 0u; float a = fabsf(f);
    if (!(a == a)) return 0x7fu;
    if (a >= 448.0f) return sgn | 0x7eu;
    if (a < 0.0009765625f) return sgn;
    int e; frexpf(a, &e); e -= 1;
    if (e < -6) { const float q = nearbyintf(a * 512.0f); return sgn | (unsigned)q; }
    float q = nearbyintf((a / ldexpf(1.0f, e) - 1.0f) * 8.0f);
    if (q >= 8.0f) { q = 0.f; e += 1; }
    if (e > 8) return sgn | 0x7eu;
    const unsigned r = ((unsigned)(e + 7) << 3) | (unsigned)q;
    return sgn | (r > 0x7eu ? 0x7eu : r);
}
__device__ __forceinline__ float fp82f(unsigned b) {
    const unsigned e = (b >> 3) & 15u, m = b & 7u; const float s = (b & 0x80u) ? -1.f : 1.f;
    if (e == 0) return s * (float)m * 0.001953125f;
    return s * ldexpf(1.0f + (float)m * 0.125f, (int)e - 7);
}
__device__ __forceinline__ unsigned pack4fp8(float a, float b, float c, float d) { return f2fp8(a) | (f2fp8(b) << 8) | (f2fp8(c) << 16) | (f2fp8(d) << 24); }
__device__ __forceinline__ void dec4fp8(unsigned w, float* o) { o[0] = fp82f(w & 255u); o[1] = fp82f((w >> 8) & 255u); o[2] = fp82f((w >> 16) & 255u); o[3] = fp82f(w >> 24); }
#else
__device__ __forceinline__ unsigned pack4fp8(float a, float b, float c, float d) { int p = __builtin_amdgcn_cvt_pk_fp8_f32(a, b, 0, false); p = __builtin_amdgcn_cvt_pk_fp8_f32(c, d, p, true); return (unsigned)p; }
__device__ __forceinline__ void dec4fp8(unsigned w, float* o) { const auto lo = __builtin_amdgcn_cvt_pk_f32_fp8((int)w, false); const auto hi = __builtin_amdgcn_cvt_pk_f32_fp8((int)w, true); o[0] = lo[0]; o[1] = lo[1]; o[2] = hi[0]; o[3] = hi[1]; }
#endif
__device__ __forceinline__ void stage_tabconv(KParams p, int l) {
    const int tid = tid_();
    const float* U = p->in[I_PU] + (size_t)l * 16384 * 1024; const float* V = p->in[I_PV] + (size_t)l * 16384 * 1024;
    char* ws = p->ws;
    for (int it = bid_() * NT + tid; it < 16384 * 128; it += gridDim.x * NT) {
        const int r = it >> 7, ck = it & 127, which = ck >> 6, c16 = ck & 63;
        const float* src = (which ? V : U) + (size_t)r * 1024 + c16 * 16;
        const float sc = which ? TAB_SV : TAB_SU;
        const float4 a = *(const float4*)src, b = *(const float4*)(src + 4), c = *(const float4*)(src + 8), d = *(const float4*)(src + 12);
        uint4 w;
        w.x = pack4fp8(a.x * sc, a.y * sc, a.z * sc, a.w * sc); w.y = pack4fp8(b.x * sc, b.y * sc, b.z * sc, b.w * sc);
        w.z = pack4fp8(c.x * sc, c.y * sc, c.z * sc, c.w * sc); w.w = pack4fp8(d.x * sc, d.y * sc, d.z * sc, d.w * sc);
        *(uint4*)(tab_row(ws, r) + which * 1024 + c16 * 16) = w;
    }
}

#ifdef CPU_EMU
__device__ __forceinline__ float group_max16(float v, float* scr) {
    const int tid = tid_();
    scr[tid] = v;
    __syncthreads();
    float m = -3.0e38f; const int base = tid & ~15;
    for (int i = 0; i < 16; ++i) m = fmaxf(m, scr[base + i]);
    __syncthreads();
    return m;
}
#else
__device__ __forceinline__ float group_max16(float v, float*) {
    v = fmaxf(v, dpp_f<0xB1>(v)); v = fmaxf(v, dpp_f<0x4E>(v)); v = fmaxf(v, dpp_f<0x141>(v)); v = fmaxf(v, dpp_f<0x140>(v));
    return v;
}
#endif
__device__ __forceinline__ void stage_peer_topk(KParams p, int l, char* smem) {
    constexpr int KS = 136;
    h16_t* khi = (h16_t*)smem;
    h16_t* klo = khi + 128 * KS;
    float* scr = (float*)(klo + 128 * KS);
    const h16_t* ACT = (const h16_t*)(p->ws + OFF_ACT);
    float* TOPS = (float*)(p->ws + OFF_TOPS);
    int tid = tid_(), lane = tid & 63, w = tid >> 6, g = lane >> 4, r16 = lane & 15;
#define TK_ROLES() do { tid = tid_(); lane = tid & 63; w = tid >> 6; g = lane >> 4; r16 = lane & 15; } while (0)
    const int nb = gridDim.x;
    for (int hs = bid_() % 16; hs < 16; hs += nb) {
        const int hd = hs >> 1, s = hs & 1;
        __syncthreads();
        {
            const float* kp = p->in[I_PKEYS] + (((size_t)l * 8 + hd) * 2 + s) * 128 * 128;
            for (int i = tid * 4; i < 128 * 128; i += NT * 4) {
                const float4 kv = *(const float4*)(kp + i);
                const int n = i >> 7, c0 = i & 127;
                const float h0 = h2f(f2h(kv.x)), h1 = h2f(f2h(kv.y)), h2 = h2f(f2h(kv.z)), h3 = h2f(f2h(kv.w));
                uint2 hw, lw; hw.x = pack2h(kv.x, kv.y); hw.y = pack2h(kv.z, kv.w); lw.x = pack2h(kv.x - h0, kv.y - h1); lw.y = pack2h(kv.z - h2, kv.w - h3);
                *(uint2*)(khi + n * KS + c0) = hw; *(uint2*)(klo + n * KS + c0) = lw;
            }
        }
        __syncthreads();
        const int nblk = nb >= 16 ? nb / 16 : 1, bsub = nb >= 16 ? bid_() / 16 : 0;
        for (int chunk = bsub; chunk < (M_ + NT - 1) / NT; chunk += nblk) {
            if (nb >= 16 && bid_() >= nblk * 16) break;
#pragma unroll 1
            for (int tt = 0; tt < 4; ++tt) {
                TK_ROLES();
                const int tok0 = chunk * NT + w * 64 + tt * 16;
                const bool live = tok0 < M_;
                hfrag af[4];
                {
                    const h16_t* qp = ACT + (size_t)(live ? tok0 + r16 : 0) * LDZ + C_QRY + hd * 256 + s * 128 + 8 * g;
#pragma unroll
                    for (int ks = 0; ks < 4; ++ks) af[ks] = frag_u4(*(const uint4*)(qp + 32 * ks));
                }
                facc acc[8];
#pragma unroll
                for (int nt = 0; nt < 8; ++nt) {
                    acc[nt] = facc_zero();
                    const h16_t* bh = khi + (16 * nt + r16) * KS + 8 * g; const h16_t* bl = klo + (16 * nt + r16) * KS + 8 * g;
#pragma unroll
                    for (int ks = 0; ks < 4; ++ks) { acc[nt] = mfma16(af[ks], frag_u4(*(const uint4*)(bh + 32 * ks)), acc[nt]); acc[nt] = mfma16(af[ks], frag_u4(*(const uint4*)(bl + 32 * ks)), acc[nt]); }
                }
#pragma unroll 1
                for (int rp = 0; rp < 2; ++rp) {
                  TK_ROLES();
#pragma unroll
                  for (int r2 = 0; r2 < 2; ++r2) {
                    const int reg = rp * 2 + r2;
                    float v[8];
#pragma unroll
                    for (int nt = 0; nt < 8; ++nt) { const float av = rp == 0 ? (r2 == 0 ? acc[nt][0] : acc[nt][1]) : (r2 == 0 ? acc[nt][2] : acc[nt][3]); v[nt] = __uint_as_float((__float_as_uint(av) & ~127u) | (unsigned)(127 - (16 * nt + r16))); }
#define CE(i, j) { const float hi_ = fmaxf(v[i], v[j]), lo_ = fminf(v[i], v[j]); v[i] = hi_; v[j] = lo_; }
                    CE(0, 1) CE(2, 3) CE(4, 5) CE(6, 7) CE(0, 2) CE(1, 3) CE(4, 6) CE(5, 7) CE(1, 2) CE(5, 6) CE(0, 4) CE(1, 5) CE(2, 6) CE(3, 7) CE(2, 4) CE(3, 5) CE(1, 2) CE(3, 4) CE(5, 6)
#undef CE
                    float res = 0.f;
#pragma unroll
                    for (int rnd = 0; rnd < 16; ++rnd) {
                        const float m = group_max16(v[0], scr);
                        const bool win = v[0] == m;
#pragma unroll
                        for (int i = 0; i < 7; ++i) v[i] = win ? v[i + 1] : v[i];
                        v[7] = win ? -3.0e38f : v[7];
                        res = (r16 == rnd) ? m : res;
                    }
                    if (live) TOPS[(((size_t)(tok0 + 4 * g + reg) * 8 + hd) * 2 + s) * 16 + r16] = res;
                  }
                }
            }
        }
    }
}

#undef TK_ROLES
__device__ __forceinline__ void peer_cand(int k, int& i, int& j) {
    if (k < 16) { i = 0; j = k; } else if (k < 24) { i = 1; j = k - 16; } else if (k < 29) { i = 2; j = k - 24; } else if (k < 33) { i = 3; j = k - 29; }
    else if (k < 36) { i = 4; j = k - 33; } else if (k < 38) { i = 5; j = k - 36; } else if (k < 40) { i = 6; j = k - 38; } else if (k < 42) { i = 7; j = k - 40; }
    else { i = k - 34; j = 0; }
}
__device__ __forceinline__ float dot16q(const uint4 a, const float (&x)[16]) {
    float t[4], s0, s1;
    dec4fp8(a.x, t); s0 = t[0] * x[0] + t[1] * x[1]; s1 = t[2] * x[2] + t[3] * x[3];
    dec4fp8(a.y, t); s0 += t[0] * x[4] + t[1] * x[5]; s1 += t[2] * x[6] + t[3] * x[7];
    dec4fp8(a.z, t); s0 += t[0] * x[8] + t[1] * x[9]; s1 += t[2] * x[10] + t[3] * x[11];
    dec4fp8(a.w, t); s0 += t[0] * x[12] + t[1] * x[13]; s1 += t[2] * x[14] + t[3] * x[15];
    return s0 + s1;
}
__device__ __forceinline__ void axpy16q(const uint4 a, float s, float (&y)[16]) {
    float t[4];
    dec4fp8(a.x, t); y[0] += s * t[0]; y[1] += s * t[1]; y[2] += s * t[2]; y[3] += s * t[3];
    dec4fp8(a.y, t); y[4] += s * t[0]; y[5] += s * t[1]; y[6] += s * t[2]; y[7] += s * t[3];
    dec4fp8(a.z, t); y[8] += s * t[0]; y[9] += s * t[1]; y[10] += s * t[2]; y[11] += s * t[3];
    dec4fp8(a.w, t); y[12] += s * t[0]; y[13] += s * t[1]; y[14] += s * t[2]; y[15] += s * t[3];
}
#ifdef CPU_EMU
__device__ __forceinline__ float lane_xor(float v, int mask, float* scr) { const int tid = tid_(); scr[tid] = v; __syncthreads(); const float r = scr[tid ^ mask]; __syncthreads(); return r; }
__device__ __forceinline__ float lane_bcast(float v, int src, float* scr) { const int tid = tid_(); scr[tid] = v; __syncthreads(); const float r = scr[(tid & ~63) + src]; __syncthreads(); return r; }
#else
__device__ __forceinline__ float lane_xor(float v, int mask, float*) { return mask == 1 ? dpp_f<0xB1>(v) : (mask == 2 ? dpp_f<0x4E>(v) : __shfl_xor(v, mask)); }
__device__ __forceinline__ float lane_bcast(float v, int src, float*) { return __builtin_bit_cast(float, __builtin_amdgcn_readlane(__builtin_bit_cast(int, v), src)); }
#endif
__device__ __forceinline__ float reduce8(const float (&v)[8], int lane, float* scr) {
    const bool b0 = lane & 1, b1 = lane & 2, b2 = lane & 4;
    float w4[4], u2[2];
#pragma unroll
    for (int j = 0; j < 4; ++j) { const float keep = b0 ? v[2 * j + 1] : v[2 * j], send = b0 ? v[2 * j] : v[2 * j + 1]; w4[j] = keep + lane_xor(send, 1, scr); }
#pragma unroll
    for (int j = 0; j < 2; ++j) { const float keep = b1 ? w4[2 * j + 1] : w4[2 * j], send = b1 ? w4[2 * j] : w4[2 * j + 1]; u2[j] = keep + lane_xor(send, 2, scr); }
    float z = (b2 ? u2[1] : u2[0]) + lane_xor(b2 ? u2[0] : u2[1], 4, scr);
    z += lane_xor(z, 8, scr); z += lane_xor(z, 16, scr); z += lane_xor(z, 32, scr);
    return z;
}
__device__ __forceinline__ void stage_peer_gather(KParams p, int l, char* smem) {
    int tid = tid_(), w = tid >> 6, lane = tid & 63;
    float* base; float* tops_s; float* cand_s; float* best_s; int* idx_s; float* gate_s; int* pos_s;
#define PG_ROLES() do { tid = tid_(); w = tid >> 6; lane = tid & 63; base = (float*)smem + w * 2048; tops_s = base; cand_s = tops_s + 256; best_s = cand_s + 64; \
        idx_s = (int*)(best_s + 128); gate_s = (float*)(idx_s + 128); pos_s = (int*)(gate_s + 128); } while (0)
    PG_ROLES();
    float* scr = (float*)smem + 8 * 2048;
    h16_t* ACT = (h16_t*)(p->ws + OFF_ACT);
    const float* TOPS = (const float*)(p->ws + OFF_TOPS);
    char* ws = p->ws;
    const float* nxt_w = (l + 1 < NL_) ? p->in[I_NMIX] + (l + 1) * 1024 : p->in[I_NFINAL];
    const int nwaves = gridDim.x * 8;
    for (int m = bid_() * 8 + w; m < M_; m += nwaves) {
        PG_ROLES();
        __syncthreads();
        *(float4*)(tops_s + lane * 4) = *(const float4*)(TOPS + (size_t)m * 256 + lane * 4);
        float x[16];
        { float t8[8]; load8h(ACT + (size_t)m * LDZ + C_XN + lane * 16, t8);
#pragma unroll
          for (int j = 0; j < 8; ++j) x[j] = t8[j];
          load8h(ACT + (size_t)m * LDZ + C_XN + lane * 16 + 8, t8);
#pragma unroll
          for (int j = 0; j < 8; ++j) x[8 + j] = t8[j]; }
        __syncthreads();
        int ci = 0, cj = 0;
        if (lane < 50) peer_cand(lane, ci, cj);
        const int pos = ci * 16 + cj;
        pos_s[lane] = pos;
#pragma unroll 1
        for (int hd = 0; hd < 8; ++hd) {
            const float cs = lane < 50 ? tops_s[hd * 32 + ci] + tops_s[hd * 32 + 16 + cj] : -3.0e38f;
            cand_s[lane] = cs;
            __syncthreads();
            if (lane < 50) {
                int cnt = 0;
#pragma unroll 10
                for (int o = 0; o < 50; ++o) { const float ov = cand_s[o]; cnt += (ov > cs || (ov == cs && pos_s[o] < pos)) ? 1 : 0; }
                if (cnt < 16) {
                    best_s[hd * 16 + cnt] = cs;
                    const int n0 = 127 - (int)(__float_as_uint(tops_s[hd * 32 + ci]) & 127u), n1 = 127 - (int)(__float_as_uint(tops_s[hd * 32 + 16 + cj]) & 127u);
                    idx_s[hd * 16 + cnt] = n0 * 128 + n1;
                }
            }
            __syncthreads();
        }
#pragma unroll
        for (int rr = 0; rr < 2; ++rr) {
            const int e = lane + 64 * rr, hd = e >> 4;
            const float mx = best_s[hd * 16];
            float sum = 0.f;
#pragma unroll
            for (int i = 0; i < 16; ++i) sum += fexp_(best_s[hd * 16 + i] - mx);
            gate_s[e] = fexp_(best_s[e] - mx) / sum;
        }
        __syncthreads();
        float y[16];
#pragma unroll
        for (int i = 0; i < 16; ++i) y[i] = 0.f;
        PG_ROLES();
        uint4 uu[8], vv[8];
#define PG_LOADU(eb_) do { _Pragma("unroll") for (int k = 0; k < 8; ++k) uu[k] = *(const uint4*)(tab_row(ws, idx_s[(eb_) + k]) + lane * 16); } while (0)
#define PG_LOADV(eb_) do { _Pragma("unroll") for (int k = 0; k < 8; ++k) vv[k] = *(const uint4*)(tab_row(ws, idx_s[(eb_) + k]) + 1024 + lane * 16); } while (0)
        PG_LOADU(0); PG_LOADV(0);
#pragma unroll 1
        for (int eb = 0; eb < 128; eb += 8) {
            float d8[8];
#pragma unroll
            for (int k = 0; k < 8; ++k) d8[k] = dot16q(uu[k], x);
            if (eb + 8 < 128) PG_LOADU(eb + 8);
            const float tot = reduce8(d8, lane, scr);
            const float hk = gate_s[eb + (lane & 7)] * geluf_(tot * (1.0f / TAB_SU));
#pragma unroll
            for (int k = 0; k < 8; ++k) axpy16q(vv[k], lane_bcast(hk, k, scr), y);
            if (eb + 8 < 128) PG_LOADV(eb + 8);
        }
#undef PG_LOADU
#undef PG_LOADV
        PG_ROLES();
        float* op = p->out + (size_t)m * 1024 + lane * 16;
        float hn[16]; float ss = 0.f;
#pragma unroll
        for (int i = 0; i < 16; i += 4) {
            const float4 o4 = *(const float4*)(op + i);
            hn[i] = o4.x + y[i] * (1.0f / TAB_SV); hn[i + 1] = o4.y + y[i + 1] * (1.0f / TAB_SV); hn[i + 2] = o4.z + y[i + 2] * (1.0f / TAB_SV); hn[i + 3] = o4.w + y[i + 3] * (1.0f / TAB_SV);
            ss += hn[i] * hn[i] + hn[i + 1] * hn[i + 1] + hn[i + 2] * hn[i + 2] + hn[i + 3] * hn[i + 3];
        }
        ss = group_sum(ss, 64, scr);
        const float rstd = rsqrtf(ss * (1.0f / D_) + RMS_EPS);
        float nv[16];
#pragma unroll
        for (int i = 0; i < 16; i += 4) { const float4 w4 = *(const float4*)(nxt_w + lane * 16 + i); nv[i] = hn[i] * rstd * w4.x; nv[i + 1] = hn[i + 1] * rstd * w4.y; nv[i + 2] = hn[i + 2] * rstd * w4.z; nv[i + 3] = hn[i + 3] * rstd * w4.w; }
        if (l + 1 < NL_) {
#pragma unroll
            for (int i = 0; i < 16; i += 4) *(float4*)(op + i) = make_float4(hn[i], hn[i + 1], hn[i + 2], hn[i + 3]);
            const float n0[8] = {nv[0], nv[1], nv[2], nv[3], nv[4], nv[5], nv[6], nv[7]}, n1[8] = {nv[8], nv[9], nv[10], nv[11], nv[12], nv[13], nv[14], nv[15]};
            store8h(ACT + (size_t)m * LDZ + C_XN + lane * 16, n0); store8h(ACT + (size_t)m * LDZ + C_XN + lane * 16 + 8, n1);
        } else {
#pragma unroll
            for (int i = 0; i < 16; i += 4) *(float4*)(op + i) = make_float4(nv[i], nv[i + 1], nv[i + 2], nv[i + 3]);
        }
    }
}
#undef PG_ROLES

enum { PH_NORM_MIX = 0, PH_INPROJ, PH_MIXERS, PH_MERGE, PH_WOUT, PH_NORM_FFN, PH_QUERY, PH_TOPK, PH_GATHER, PH_PER_LAYER, PH_FINAL = 100, PH_WPREP = 101 };
__device__ __forceinline__ void run_phase(KParams p, int l, int ph, char* smem) {
    h16_t* ACT = (h16_t*)(p->ws + OFF_ACT);
    const float* hin = l == 0 ? p->in[I_X] : p->out;
    switch (ph) {
    case PH_WPREP: stage_wprep(p, smem); break;
    case PH_NORM_MIX: if (l == 0) stage_rmsnorm(hin, p->in[I_NMIX] + l * 1024, ACT + C_XN, LDZ, smem); break;
    case PH_INPROJ: stage_gemm(p, l, GP_INPROJ, smem); break;
    case PH_MIXERS: {
        const int nb = gridDim.x, n_rw = nb / 2, n_gd = nb / 4, n_lr = nb - n_rw - n_gd;
        stage_rwkv(p, l, smem, 0, n_rw);
        stage_gdn(p, l, smem, n_rw, n_gd);
        stage_lru(p, l, smem, n_rw + n_gd, n_lr);
    } break;
    case PH_MERGE: stage_gemm(p, l, GP_MERGE, smem); break;
    case PH_WOUT: stage_gemm(p, l, GP_WOUT, smem); break;
    case PH_NORM_FFN: stage_rmsnorm(p->out, p->in[I_NFFN] + l * 1024, ACT + C_XN, LDZ, smem); stage_tabconv(p, l); break;
    case PH_QUERY: stage_gemm(p, l, GP_QUERY, smem); break;
    case PH_TOPK: stage_peer_topk(p, l, smem); break;
    case PH_GATHER: stage_peer_gather(p, l, smem); break;
    case PH_FINAL: break;
    default: break;
    }
}


#if !defined(CPU_EMU) && !MK_MULTI
#define XB_TMO      128
#define XB_XCNT(j)  (256  + 64 * (j))
#define XB_XSUB(j)  (1280 + 64 * (j))
#define XB_XGEN(j)  (2304 + 64 * (j))
#define XB_TOP      3328
#define XB_TOPGEN   3392
#define XCD_BAR_WORDS 3456
#define XB_SPIN_CAP (1u << 22)
#define XB_LAS __attribute__((address_space(3)))
__device__ __forceinline__ unsigned xb_ld(unsigned* p)              { return __hip_atomic_load(p, __ATOMIC_RELAXED, __HIP_MEMORY_SCOPE_AGENT); }
__device__ __forceinline__ unsigned xb_add(unsigned* p, unsigned v) { return __hip_atomic_fetch_add(p, v, __ATOMIC_RELAXED, __HIP_MEMORY_SCOPE_AGENT); }
__device__ __forceinline__ unsigned xb_xcc_id() { return (unsigned)__builtin_amdgcn_s_getreg((3 << 11) | 20) & 0xFu; }
#define XB_SPIN(cond, bar) do { unsigned _sp = 0; while (cond) { __builtin_amdgcn_s_sleep(1); \
    if ((++_sp & 255u) == 0u) { if (xb_ld(&(bar)[XB_TMO])) break; if (_sp > XB_SPIN_CAP) { atomicAdd(&(bar)[XB_TMO], 1u); break; } } } } while (0)
struct XcdBarrier { unsigned* bar; unsigned x; volatile XB_LAS unsigned* st; };
__device__ __forceinline__ XcdBarrier xcd_barrier_post(unsigned* bar, volatile XB_LAS unsigned* st) {
    XcdBarrier b; b.bar = bar; b.x = xb_xcc_id(); b.st = st;
    if (threadIdx.x == 0) (void)xb_add(&bar[XB_XCNT(b.x)], 1u);
    return b;
}
__device__ __forceinline__ void xcd_barrier_complete(unsigned* bar, unsigned x, unsigned& nloc, unsigned& nx) {
    const unsigned G = gridDim.x * gridDim.y * gridDim.z;
    unsigned sum, cnt, mine, sp = 0u;
    for (;;) {
        sum = 0u; cnt = 0u; mine = 0u;
#pragma unroll
        for (unsigned j = 0; j < 16; ++j) { const unsigned c = xb_ld(&bar[XB_XCNT(j)]); sum += c; cnt += (c > 0u) ? 1u : 0u; mine = (j == x) ? c : mine; }
        if (sum == G) break;
        __builtin_amdgcn_s_sleep(1);
        if ((++sp & 255u) == 0u) { if (xb_ld(&bar[XB_TMO])) break; if (sp > XB_SPIN_CAP) { atomicAdd(&bar[XB_TMO], 1u); break; } }
    }
    nloc = mine > 0u ? mine : 1u; nx = cnt > 0u ? cnt : 1u;
}
__device__ __forceinline__ void xcd_barrier(const XcdBarrier& b) {
    asm volatile("s_waitcnt vmcnt(0)" ::: "memory");
    __syncthreads();
    if (threadIdx.x == 0) {
        unsigned* bar = b.bar;
        __builtin_amdgcn_s_waitcnt(0);
        unsigned nloc = b.st[0], nx = b.st[1];
        if (nloc == 0u) { xcd_barrier_complete(bar, b.x, nloc, nx); b.st[0] = nloc; b.st[1] = nx; }
        const unsigned old = xb_add(&bar[XB_XSUB(b.x)], 1u);
        const unsigned gen = old / nloc;
        if (old + 1u == (gen + 1u) * nloc) {
            __builtin_amdgcn_fence(__ATOMIC_RELEASE, "agent");
            asm volatile("s_waitcnt vmcnt(0)" ::: "memory");
            const unsigned og = xb_add(&bar[XB_TOP], 1u);
            const unsigned tg = og / nx;
            if (og + 1u == (tg + 1u) * nx) xb_add(&bar[XB_TOPGEN], 1u);
            else XB_SPIN(xb_ld(&bar[XB_TOPGEN]) == tg, bar);
            __builtin_amdgcn_fence(__ATOMIC_ACQUIRE, "agent");
            xb_add(&bar[XB_XGEN(b.x)], 1u);
            asm volatile("s_waitcnt vmcnt(0)" ::: "memory");
        } else {
            XB_SPIN(xb_ld(&bar[XB_XGEN(b.x)]) == gen, bar);
            __builtin_amdgcn_fence(__ATOMIC_ACQUIRE, "agent");
            asm volatile("s_waitcnt vmcnt(0)" ::: "memory");
        }
    }
    __syncthreads();
}
#endif
#if !defined(CPU_EMU) && !MK_MULTI
__global__ void __launch_bounds__(512, 2) k_mega(Params p_) {
    DYN_SMEM(smem);
    KParams pk = (KParams)__builtin_amdgcn_kernarg_segment_ptr();
    cg::grid_group grid = cg::this_grid();
    volatile XB_LAS unsigned* xst = (volatile XB_LAS unsigned*)(XB_LAS char*)(smem + SMEM_BYTES);
    if (threadIdx.x == 0) { xst[0] = 0u; xst[1] = 0u; xst[2] = 0u; xst[3] = 0u; }
    __syncthreads();
    const XcdBarrier xb = xcd_barrier_post((unsigned*)(pk->ws + OFF_BAR), xst);
    if (gridDim.x > 0x100000u) grid.sync();
    constexpr int NIT = NL_ * PH_PER_LAYER;
#pragma unroll 1
    for (int it = -1; it <= NIT; ++it) {
        const int l = (it >= 0 && it < NIT) ? it / PH_PER_LAYER : 0, ph = it < 0 ? (int)PH_WPREP : (it < NIT ? it % PH_PER_LAYER : (int)PH_FINAL);
        KParams q = pk; asm volatile("" : "+s"(q));
        run_phase(q, l, ph, smem);
        if (it >= 0 && it < NIT - 1 && !(l > 0 && ph == PH_NORM_MIX)) {
            xcd_barrier(xb);
        }
    }
}
#endif
#ifdef CPU_EMU
__global__ void k_phase(Params p_, int l, int ph) { DYN_SMEM(smem); run_phase(&p_, l, ph, smem); }
#elif MK_MULTI
__global__ void __launch_bounds__(512, 2) k_phase(Params p_, int l, int ph) { DYN_SMEM(smem); KParams pk = (KParams)__builtin_amdgcn_kernarg_segment_ptr(); run_phase(pk, l, ph, smem); }
#endif
}

#ifdef CPU_EMU
int g_emu_stop = 1000;
#endif

extern "C" void kernel_launch(void* const* d_in, const int* in_sizes, int n_in, void* d_out, int out_size, void* d_ws, size_t ws_size, hipStream_t stream) {
    Params p{};
    for (int i = 0; i < N_IN; ++i) p.in[i] = (const float*)d_in[i];
    p.out = (float*)d_out; p.ws = (char*)d_ws;
#if defined(CPU_EMU) || MK_MULTI
    const int grid = 256;
    LAUNCH(k_phase, grid, NT, SMEM_BYTES, stream, p, 0, (int)PH_WPREP);
    for (int l = 0; l < NL_; ++l)
        for (int ph = 0; ph < PH_PER_LAYER; ++ph) {
            LAUNCH(k_phase, grid, NT, SMEM_BYTES, stream, p, l, ph);
#ifdef CPU_EMU
            const int code = ph == PH_INPROJ ? 1 : ph == PH_MIXERS ? 2 : ph == PH_MERGE ? 3 : ph == PH_WOUT ? 4 : ph == PH_GATHER ? 5 : 0;
            if (code && g_emu_stop == l * 10 + code) return;
#endif
        }
    LAUNCH(k_phase, grid, NT, SMEM_BYTES, stream, p, 0, (int)PH_FINAL);
#else
    static int grid_blocks = 0;
    if (!grid_blocks) {
        int dev = 0, cus = 0, per_cu = 0;
        (void)hipGetDevice(&dev);
        (void)hipDeviceGetAttribute(&cus, hipDeviceAttributeMultiprocessorCount, dev);
        (void)hipFuncSetAttribute((const void*)k_mega, hipFuncAttributeMaxDynamicSharedMemorySize, (int)SMEM_BYTES + 16);
        (void)hipOccupancyMaxActiveBlocksPerMultiprocessor(&per_cu, k_mega, NT, SMEM_BYTES + 16);
        if (per_cu > 1) per_cu = 1;
        grid_blocks = cus * per_cu;
    }
    (void)hipMemsetAsync((char*)d_ws + OFF_BAR, 0, 16384, stream);
    void* args[] = {&p};
    hipError_t e = hipLaunchCooperativeKernel((void*)k_mega, dim3(grid_blocks), dim3(NT), args, SMEM_BYTES + 16, stream);
    if (e != hipSuccess) fprintf(stderr, "cooperative launch failed: %s (grid %d)\n", hipGetErrorString(e), grid_blocks);
#endif
}
```

```cpp
#ifndef CPU_EMU
#include <hip/hip_runtime.h>
#include <hip/hip_cooperative_groups.h>
#include <cstdio>
#include <cstdint>
namespace cg = cooperative_groups;
#define DYN_SMEM(name) extern __shared__ __attribute__((aligned(16))) char name[]
#define LAUNCH(kern, grid, block, smem, stream, ...) hipLaunchKernelGGL(kern, dim3(grid), dim3(block), smem, stream, __VA_ARGS__)
#endif

#ifndef CFG_B
#define CFG_B 8
#endif
#ifndef CFG_T
#define CFG_T 2048
#endif
#ifndef MK_MULTI
#define MK_MULTI 0
#endif

namespace {
constexpr int B_ = CFG_B, T_ = CFG_T, M_ = B_ * T_, D_ = 1024, NL_ = 2, NT = 512;
constexpr int INW = 12560;
constexpr int LDZ = 11776;
constexpr int Z_ULRU = 0, Z_GLRU = 1024, Z_Q = 2048, Z_K = 3072, Z_V = 4096, Z_ZG = 5120, Z_RW = 6144, Z_ALPHA = 9472, Z_BETA = 9480;
constexpr int ZN = 9728;
constexpr int C_XN = 9728, C_YC = 10752;
constexpr int C_YA = Z_GLRU, C_YB = Z_ZG;
constexpr int C_GS = Z_Q, C_MG = Z_K;
constexpr int C_QRY = 0;
constexpr int RW_R = 0, RW_K = 1024, RW_V = 2048, RW_WL = 3072, RW_AL = 3136, RW_GL = 3200, RWW = 3328;
constexpr float RMS_EPS = 1e-6f, GN_EPS = 64e-5f;
typedef unsigned short h16_t;

enum { I_X = 0, I_NMIX, I_NFFN, I_NFINAL, I_WIN, I_LCW, I_LCB, I_LWA, I_LBA, I_LWX, I_LBX, I_LLAM, I_GCW, I_GALOG, I_GDT, I_GNW,
       I_RMU, I_RW0, I_RWUP, I_RA0, I_RAUP, I_RGUP, I_RKK, I_RKA, I_RRK, I_RLW, I_RLB, I_MB, I_PL, I_PG, I_PR, I_WOUT, I_PWQ, I_PKEYS, I_PU, I_PV, N_IN };

struct Params {
    const float* in[N_IN];
    float* out;
    char* ws;
};
#ifdef CPU_EMU
typedef const Params* KParams;
#else
typedef const Params __attribute__((address_space(4)))* KParams;
#endif

constexpr size_t al256(size_t x) { return (x + 255) / 256 * 256; }
constexpr size_t OFF_ACT = 0;
constexpr size_t OFF_WT = al256(OFF_ACT + (size_t)M_ * LDZ * 2);
constexpr int WT_IN = 0, WT_MG = ZN, WT_P = WT_MG + 3072, WT_OUT = WT_P + 3072, WT_Q = WT_OUT + 1024, WT_ROWS = WT_Q + 2048;
constexpr size_t OFF_TOPS = al256(OFF_WT + (size_t)NL_ * WT_ROWS * 1024 * 2);
constexpr size_t OFF_TAB = al256(OFF_TOPS + (size_t)M_ * 256 * 4);
constexpr size_t OFF_BAR = OFF_TAB + (M_ == 16384 ? 0 : (size_t)16384 * 2048);
constexpr size_t WS_END = OFF_BAR + 16384;
static_assert(CFG_B != 8 || CFG_T != 2048 || WS_END <= (size_t)512 * 1024 * 1024, "workspace budget");
constexpr size_t SMEM_BYTES = 128 * 1024;

#ifdef CPU_EMU
__device__ __forceinline__ int tid_() { return threadIdx.x; }
__device__ __forceinline__ h16_t f2h(float f) { return (h16_t)_cvtss_sh(f, _MM_FROUND_TO_NEAREST_INT); }
__device__ __forceinline__ float h2f(h16_t h) { return _cvtsh_ss(h); }
#else
__device__ __forceinline__ int tid_() { int t = threadIdx.x; asm volatile("" : "+v"(t)); return t; }
__device__ __forceinline__ h16_t f2h(float f) { return __builtin_bit_cast(unsigned short, (_Float16)f); }
__device__ __forceinline__ float h2f(h16_t h) { return (float)__builtin_bit_cast(_Float16, h); }
#endif
__device__ __forceinline__ int bid_() { return (int)blockIdx.x; }

#ifdef CPU_EMU
__device__ __forceinline__ float fexp_(float x) { return expf(x); }
__device__ __forceinline__ float flog_(float x) { return logf(x); }
__device__ __forceinline__ float frcp_(float x) { return 1.0f / x; }
#else
__device__ __forceinline__ float fexp_(float x) { return __builtin_amdgcn_exp2f(x * 1.4426950408889634f); }
__device__ __forceinline__ float flog_(float x) { return __builtin_amdgcn_logf(x) * 0.6931471805599453f; }
__device__ __forceinline__ float frcp_(float x) { return __builtin_amdgcn_rcpf(x); }
#endif
__device__ __forceinline__ float sigmoidf_(float x) { return frcp_(1.0f + fexp_(-x)); }
__device__ __forceinline__ float softplusf_(float x) { return fmaxf(x, 0.0f) + flog_(1.0f + fexp_(-fabsf(x))); }
__device__ __forceinline__ float siluf_(float x) { return x * sigmoidf_(x); }
__device__ __forceinline__ float tanhf_(float x) { return 1.0f - 2.0f * frcp_(1.0f + fexp_(2.0f * x)); }
__device__ __forceinline__ float geluf_(float x) { return x * frcp_(1.0f + fexp_(-1.5957691216057308f * (x + 0.044715f * x * x * x))); }
__device__ __forceinline__ unsigned pack2h(float a, float b) { return (unsigned)f2h(a) | ((unsigned)f2h(b) << 16); }
__device__ __forceinline__ void store8h(h16_t* p, const float (&v)[8]) {
    uint4 w; w.x = pack2h(v[0], v[1]); w.y = pack2h(v[2], v[3]); w.z = pack2h(v[4], v[5]); w.w = pack2h(v[6], v[7]);
    *(uint4*)p = w;
}
__device__ __forceinline__ void load8h(const h16_t* p, float (&v)[8]) {
    const uint4 w = *(const uint4*)p;
    v[0] = h2f((h16_t)(w.x & 0xffffu)); v[1] = h2f((h16_t)(w.x >> 16)); v[2] = h2f((h16_t)(w.y & 0xffffu)); v[3] = h2f((h16_t)(w.y >> 16));
    v[4] = h2f((h16_t)(w.z & 0xffffu)); v[5] = h2f((h16_t)(w.z >> 16)); v[6] = h2f((h16_t)(w.w & 0xffffu)); v[7] = h2f((h16_t)(w.w >> 16));
}

__device__ __forceinline__ float block_sum512(float v, float* red) {
    const int tid = tid_();
    red[tid] = v;
    __syncthreads();
    if (tid < 32) { float s = 0.f; for (int i = 0; i < 16; ++i) s += red[tid * 16 + i]; red[512 + tid] = s; }
    __syncthreads();
    float tot = 0.f;
    for (int i = 0; i < 32; ++i) tot += red[512 + i];
    __syncthreads();
    return tot;
}

#ifdef CPU_EMU
__device__ __forceinline__ float wave_sum64(float v, float* scr) {
    const int tid = tid_();
    scr[tid] = v; __syncthreads();
    float s = 0.f; const int base = tid & ~63;
    for (int i = 0; i < 64; ++i) s += scr[base + i];
    __syncthreads();
    return s;
}
#else
__device__ __forceinline__ float wave_sum64(float v, float*) {
    v += __builtin_bit_cast(float, __builtin_amdgcn_mov_dpp(__builtin_bit_cast(int, v), 0xB1, 0xf, 0xf, true));
    v += __builtin_bit_cast(float, __builtin_amdgcn_mov_dpp(__builtin_bit_cast(int, v), 0x4E, 0xf, 0xf, true));
    v += __builtin_bit_cast(float, __builtin_amdgcn_mov_dpp(__builtin_bit_cast(int, v), 0x141, 0xf, 0xf, true));
    v += __builtin_bit_cast(float, __builtin_amdgcn_mov_dpp(__builtin_bit_cast(int, v), 0x140, 0xf, 0xf, true));
    v += __builtin_bit_cast(float, __builtin_amdgcn_update_dpp(0, __builtin_bit_cast(int, v), 0x142, 0xa, 0xf, false));
    v += __builtin_bit_cast(float, __builtin_amdgcn_update_dpp(0, __builtin_bit_cast(int, v), 0x143, 0xc, 0xf, false));
    return __builtin_bit_cast(float, __builtin_amdgcn_readlane(__builtin_bit_cast(int, v), 63));
}
#endif
__device__ __forceinline__ void stage_rmsnorm(const float* src, const float* w, h16_t* dst, int ldd, char* smem) {
    float* scr = (float*)smem;
    const int tid = tid_(), lane = tid & 63, wv = tid >> 6;
    const int nw = gridDim.x * 8;
    float4 wv4[4];
#pragma unroll
    for (int i = 0; i < 4; ++i) wv4[i] = *(const float4*)(w + lane * 16 + i * 4);
    for (int row = bid_() * 8 + wv; row < M_; row += 2 * nw) {
        const int row2 = row + nw; const bool has2 = row2 < M_;
        float4 a[4], b[4];
#pragma unroll
        for (int i = 0; i < 4; ++i) { a[i] = *(const float4*)(src + (size_t)row * D_ + lane * 16 + i * 4); b[i] = has2 ? *(const float4*)(src + (size_t)row2 * D_ + lane * 16 + i * 4) : make_float4(0.f, 0.f, 0.f, 0.f); }
        float sa = 0.f, sb = 0.f;
#pragma unroll
        for (int i = 0; i < 4; ++i) { sa += a[i].x * a[i].x + a[i].y * a[i].y + a[i].z * a[i].z + a[i].w * a[i].w; sb += b[i].x * b[i].x + b[i].y * b[i].y + b[i].z * b[i].z + b[i].w * b[i].w; }
        sa = wave_sum64(sa, scr); sb = wave_sum64(sb, scr);
        const float ra = rsqrtf(sa * (1.0f / D_) + RMS_EPS), rb = rsqrtf(sb * (1.0f / D_) + RMS_EPS);
#pragma unroll
        for (int i = 0; i < 4; i += 2) {
            const float va[8] = {a[i].x * ra * wv4[i].x, a[i].y * ra * wv4[i].y, a[i].z * ra * wv4[i].z, a[i].w * ra * wv4[i].w, a[i + 1].x * ra * wv4[i + 1].x, a[i + 1].y * ra * wv4[i + 1].y, a[i + 1].z * ra * wv4[i + 1].z, a[i + 1].w * ra * wv4[i + 1].w};
            store8h(dst + (size_t)row * ldd + lane * 16 + i * 4, va);
            if (has2) {
                const float vb[8] = {b[i].x * rb * wv4[i].x, b[i].y * rb * wv4[i].y, b[i].z * rb * wv4[i].z, b[i].w * rb * wv4[i].w, b[i + 1].x * rb * wv4[i + 1].x, b[i + 1].y * rb * wv4[i + 1].y, b[i + 1].z * rb * wv4[i + 1].z, b[i + 1].w * rb * wv4[i + 1].w};
                store8h(dst + (size_t)row2 * ldd + lane * 16 + i * 4, vb);
            }
        }
    }
}

__device__ __forceinline__ const float* wt_src(KParams p, int l, int r, int& ld) {
    if (r < ZN) {
        ld = INW;
        int c;
        if (r < 6144) c = r; else if (r < 9472) c = r + 16; else if (r < 9488) c = r - 3328; else return nullptr;
        return p->in[I_WIN] + (size_t)l * 1024 * INW + c;
    }
    r -= ZN;
    if (r < 3072) { ld = INW; return p->in[I_WIN] + (size_t)l * 1024 * INW + 9488 + r; }
    r -= 3072;
    if (r < 3072) { ld = 1024; const int br = r >> 10; return p->in[br == 0 ? I_PL : (br == 1 ? I_PG : I_PR)] + (size_t)l * 1024 * 1024 + (r & 1023); }
    r -= 3072;
    if (r < 1024) { ld = 1024; return p->in[I_WOUT] + (size_t)l * 1024 * 1024 + r; }
    r -= 1024;
    ld = 2048; return p->in[I_PWQ] + (size_t)l * 1024 * 2048 + r;
}
__device__ __forceinline__ void stage_wprep(KParams p, char* smem) {
    float* tile = (float*)smem;
    h16_t* WT = (h16_t*)(p->ws + OFF_WT);
    const int tid = tid_();
    const int ntr = WT_ROWS / 64, total = NL_ * ntr * 16;
    for (int it = bid_(); it < total; it += gridDim.x) {
        const int l = it / (ntr * 16), rem = it % (ntr * 16), rt = rem / 16, kt = rem % 16;
        const int r0 = rt * 64, k0 = kt * 64;
        __syncthreads();
        {
            const int nn = tid & 63;
            int ld = 0; const float* src = wt_src(p, l, r0 + nn, ld);
#pragma unroll
            for (int i = 0; i < 8; ++i) { const int kk = (tid >> 6) + 8 * i; tile[kk * 65 + nn] = src ? src[(size_t)(k0 + kk) * ld] : 0.f; }
        }
        __syncthreads();
        {
            const int r = tid >> 3, kq = (tid & 7) * 8;
            float v[8];
#pragma unroll
            for (int j = 0; j < 8; ++j) v[j] = tile[(kq + j) * 65 + r];
            store8h(WT + ((size_t)l * WT_ROWS + r0 + r) * 1024 + k0 + kq, v);
        }
    }
}

namespace pg8 {
constexpr int BM = 256, BK = 64, HALF = 128, HTB = HALF * BK * 2, STAGE_BYTES = 8 * HTB, NXCD = 8, WGM = 8;
struct Unit { const char* A; const char* B; int pm, pn, kind; };
#ifdef CPU_EMU
struct f32x4 { float d[4]; float& operator[](int i) { return d[i]; } const float& operator[](int i) const { return d[i]; } };
#else
#define PG8_LAS __attribute__((address_space(3)))
typedef _Float16 f16x8 __attribute__((ext_vector_type(8)));
typedef float f32x4 __attribute__((ext_vector_type(4)));
__device__ __forceinline__ int lds_byte(int r, int c) { const int st = (r >> 4) * 2 + (c >> 5), rr = r & 15, cc = c & 31, ob = rr * 64 + cc * 2; return st * 1024 + (ob ^ (((ob >> 9) & 1) << 5)); }
__device__ __forceinline__ void stage_rc(int b, int& R, int& C) { const int st = b / 1024, sb = b % 1024, swz = sb ^ (((sb >> 9) & 1) << 5); R = (st >> 1) * 16 + swz / 64; C = (st & 1) * 32 + (swz % 64) / 2; }
__device__ __forceinline__ int perm32(int rho) { const int n = rho >> 4, i = rho & 15; return 8 * (i >> 2) + 4 * n + (i & 3); }
#endif
__device__ __forceinline__ void tile_of(int L, int nM, int nN, int& pm, int& pn) {
    const int nwg = nM * nN;
    int wgid = L; { const int q = nwg / NXCD, r = nwg % NXCD, xcd = wgid % NXCD, off = wgid / NXCD; wgid = (xcd < r ? xcd * (q + 1) : r * (q + 1) + (xcd - r) * q) + off; }
    const int nig = WGM * nN, gid = wgid / nig, fm = gid * WGM, gsz = (nM - fm) < WGM ? (nM - fm) : WGM;
    pm = fm + ((wgid % nig) % gsz); pn = (wgid % nig) / gsz;
}

template <class Sched, class Epi>
__device__ __forceinline__ void gemm_phase(char* smem, const Sched& S, const Epi& E) {
    constexpr int K = 1024, nt = K / BK;
    constexpr unsigned lda = LDZ, ldb = 1024;
#ifdef CPU_EMU
    const int tid = tid_(), wid = tid >> 6, lane = tid & 63, wr = wid >> 2, wc = wid & 3, fr = lane & 15, fq = lane >> 4;
    Unit u;
    for (int ui = 0; S.next(ui, u); ++ui) {
        f32x4 acc[2][2][4][2];
        for (int ai = 0; ai < 2; ++ai) for (int bj = 0; bj < 2; ++bj) for (int m = 0; m < 4; ++m) for (int n = 0; n < 2; ++n) for (int e = 0; e < 4; ++e) {
            const int r = 128 * ai + 64 * wr + 16 * m + fr, c = 128 * bj + 32 * wc + 8 * fq + 4 * n + e;
            const h16_t* a = (const h16_t*)u.A + (size_t)r * lda; const h16_t* b = (const h16_t*)u.B + (size_t)c * ldb;
            float s = 0.f;
            for (int k = 0; k < K; ++k) s += h2f(a[k]) * h2f(b[k]);
            acc[ai][bj][m][n][e] = s;
        }
        E(acc, u, wr, wc, fr, fq);
    }
    (void)smem; (void)nt;
#else
    PG8_LAS unsigned char* lds = (PG8_LAS unsigned char*)smem;
    const int tid = tid_(), wid = __builtin_amdgcn_readfirstlane(tid >> 6), lane = tid & 63, wr = wid >> 2, wc = wid & 3, fr = lane & 15, fq = lane >> 4;
    unsigned voffA[2], voffB[2];
#pragma unroll
    for (int i = 0; i < 2; ++i) { int R, C; stage_rc(tid * 16 + i * 8192, R, C); const int Rb = (R & ~31) + perm32(R & 31);
        voffA[i] = (unsigned)(R * lda + C) * 2u; voffB[i] = (unsigned)(Rb * ldb + C) * 2u; }
    constexpr size_t kstep = (size_t)(BK * 2);
    constexpr size_t hstepA = (size_t)HALF * lda * 2, hstepB = (size_t)HALF * ldb * 2;
    const unsigned ldsw = (unsigned)wid * 1024u;
    const int aoff = lds_byte(wr * 64 + fr, fq * 8), boff = lds_byte(wc * 32 + fr, fq * 8);
#define PG8_SA(b, h) (((b) * 2 + (h)) * HTB)
#define PG8_SB(b, h) ((4 + (b) * 2 + (h)) * HTB)
#define PG8_STAGE(bufoff, gbase, voff) do { _Pragma("unroll") for (int _i = 0; _i < 2; ++_i) \
        __builtin_amdgcn_global_load_lds((const unsigned*)((const char*)(gbase) + (voff)[_i]), (PG8_LAS unsigned*)(lds + (bufoff) + ldsw + _i * 8192), 16, 0, 0); } while (0)
#define PG8_LDA(dst, b, h) do { _Pragma("unroll") for (int m = 0; m < 4; ++m) _Pragma("unroll") for (int k = 0; k < 2; ++k) dst[m][k] = *(const PG8_LAS f16x8*)(lds + PG8_SA(b, h) + aoff + m * 2048 + k * 1024); } while (0)
#define PG8_LDB(dst, b, h) do { _Pragma("unroll") for (int n = 0; n < 2; ++n) _Pragma("unroll") for (int k = 0; k < 2; ++k) dst[n][k] = *(const PG8_LAS f16x8*)(lds + PG8_SB(b, h) + boff + n * 2048 + k * 1024); } while (0)
#define PG8_MMA(ai, bj, At, Bt) do { __builtin_amdgcn_s_setprio(1); _Pragma("unroll") for (int m = 0; m < 4; ++m) _Pragma("unroll") for (int n = 0; n < 2; ++n) _Pragma("unroll") for (int k = 0; k < 2; ++k) \
        acc[ai][bj][m][n] = __builtin_amdgcn_mfma_f32_16x16x32_f16(Bt[n][k], At[m][k], acc[ai][bj][m][n], 0, 0, 0); __builtin_amdgcn_s_setprio(0); } while (0)
#define PG8_WAIT_V(n) asm volatile("s_waitcnt vmcnt(" #n ")" ::: "memory")
#define PG8_WAIT_L(n) asm volatile("s_waitcnt lgkmcnt(" #n ")" ::: "memory")
#define PG8_BAR __builtin_amdgcn_s_barrier()
#define PG8_SCHED __builtin_amdgcn_sched_barrier(0)
    Unit cur, nxt; int ui = 0;
    if (!S.next(0, cur)) return;
    f32x4 acc[2][2][4][2];
#pragma unroll
    for (int a = 0; a < 2; ++a)
#pragma unroll
        for (int b = 0; b < 2; ++b)
#pragma unroll
            for (int m = 0; m < 4; ++m)
#pragma unroll
                for (int n = 0; n < 2; ++n) acc[a][b][m][n] = (f32x4){0.f, 0.f, 0.f, 0.f};
    f16x8 At[4][2], B0[2][2], B1[2][2];
    const char* cA = cur.A; const char* cB = cur.B;
    PG8_STAGE(PG8_SB(0, 0), cB, voffB); PG8_STAGE(PG8_SA(0, 0), cA, voffA); PG8_STAGE(PG8_SB(0, 1), cB + hstepB, voffB); PG8_STAGE(PG8_SA(0, 1), cA + hstepA, voffA);
    if (wr == 1) PG8_BAR;
    PG8_WAIT_V(4); PG8_BAR;
    PG8_STAGE(PG8_SB(1, 0), cB + kstep, voffB); PG8_STAGE(PG8_SA(1, 0), cA + kstep, voffA); PG8_STAGE(PG8_SB(1, 1), cB + hstepB + kstep, voffB);
    PG8_WAIT_V(6); PG8_BAR;
    for (;;) {
        const bool has_next = S.next(ui + 1, nxt);
        const char* nA = has_next ? nxt.A : cA; const char* nB = has_next ? nxt.B : cB;
#pragma unroll 1
        for (int t = 0; t < nt; t += 2) {
            const bool last = (t == nt - 2);
            const char* a1 = cA + (size_t)(t + 1) * kstep;
            const char* a2 = last ? nA : cA + (size_t)(t + 2) * kstep; const char* b2 = last ? nB : cB + (size_t)(t + 2) * kstep;
            const char* a3 = a2 + kstep; const char* b3 = b2 + kstep;
            PG8_LDB(B0, 0, 0); PG8_SCHED; PG8_LDA(At, 0, 0); PG8_STAGE(PG8_SA(1, 1), a1 + hstepA, voffA);
            PG8_WAIT_L(8); PG8_BAR; PG8_WAIT_L(0); PG8_MMA(0, 0, At, B0); PG8_BAR; PG8_SCHED;
            PG8_LDB(B1, 0, 1); PG8_STAGE(PG8_SB(0, 0), b2, voffB);
            PG8_BAR; PG8_WAIT_L(0); PG8_MMA(0, 1, At, B1); PG8_BAR;
            PG8_LDA(At, 0, 1); PG8_STAGE(PG8_SA(0, 0), a2, voffA);
            PG8_BAR; PG8_WAIT_L(0); PG8_MMA(1, 0, At, B0); PG8_BAR; PG8_SCHED;
            PG8_STAGE(PG8_SB(0, 1), b2 + hstepB, voffB);
            PG8_WAIT_V(6); PG8_BAR; PG8_MMA(1, 1, At, B1); PG8_BAR;
            PG8_LDB(B0, 1, 0); PG8_SCHED; PG8_LDA(At, 1, 0); PG8_STAGE(PG8_SA(0, 1), a2 + hstepA, voffA);
            PG8_WAIT_L(8); PG8_BAR; PG8_WAIT_L(0); PG8_MMA(0, 0, At, B0); PG8_BAR; PG8_SCHED;
            PG8_LDB(B1, 1, 1); PG8_STAGE(PG8_SB(1, 0), b3, voffB);
            PG8_BAR; PG8_WAIT_L(0); PG8_MMA(0, 1, At, B1); PG8_BAR;
            PG8_LDA(At, 1, 1); PG8_STAGE(PG8_SA(1, 0), a3, voffA);
            PG8_BAR; PG8_WAIT_L(0); PG8_MMA(1, 0, At, B0); PG8_BAR; PG8_SCHED;
            PG8_STAGE(PG8_SB(1, 1), b3 + hstepB, voffB);
            PG8_WAIT_V(6); PG8_BAR; PG8_MMA(1, 1, At, B1); PG8_BAR;
        }
        E(acc, cur, wr, wc, fr, fq);
        if (!has_next) break;
#pragma unroll
        for (int a = 0; a < 2; ++a)
#pragma unroll
            for (int b = 0; b < 2; ++b)
#pragma unroll
                for (int m = 0; m < 4; ++m)
#pragma unroll
                    for (int n = 0; n < 2; ++n) acc[a][b][m][n] = (f32x4){0.f, 0.f, 0.f, 0.f};
        cur = nxt; cA = nA; cB = nB; ++ui;
    }
    PG8_WAIT_V(0);
    if (wr == 0) PG8_BAR;
    PG8_BAR;
#undef PG8_SA
#undef PG8_SB
#undef PG8_STAGE
#undef PG8_LDA
#undef PG8_LDB
#undef PG8_MMA
#undef PG8_WAIT_V
#undef PG8_WAIT_L
#undef PG8_BAR
#undef PG8_SCHED
#endif
}
}

enum { GK_STORE = 0, GK_GATE0, GK_GATE1, GK_GATE2, GK_PROJ0, GK_PROJ1, GK_PROJ2, GK_RESID };
enum { GP_INPROJ = 0, GP_MERGE, GP_WOUT, GP_QUERY };
struct GemmProg {
    const char* act; const char* wt;
    int which, G, c;
    __device__ __forceinline__ bool next(int i, pg8::Unit& u) const {
        constexpr int nM = M_ / 256;
        constexpr size_t rowA = (size_t)256 * LDZ * 2, rowB = (size_t)256 * 1024 * 2;
        if (which == GP_MERGE) {
            const int L = (i / 6) * G + c, j = i % 6, br = j < 3 ? j : j - 3;
            if (L >= nM * 4) return false;
            pg8::tile_of(L, nM, 4, u.pm, u.pn);
            if (j < 3) { u.A = act + (size_t)C_XN * 2; u.B = wt + ((size_t)(WT_MG + br * 1024) * 1024) * 2; u.kind = GK_GATE0 + br; }
            else { u.A = act + (size_t)(br == 0 ? C_YA : (br == 1 ? C_YB : C_YC)) * 2; u.B = wt + ((size_t)(WT_P + br * 1024) * 1024) * 2; u.kind = GK_PROJ0 + br; }
        } else {
            const int nN = which == GP_INPROJ ? ZN / 256 : (which == GP_WOUT ? 4 : 8);
            const int L = i * G + c;
            if (L >= nM * nN) return false;
            pg8::tile_of(L, nM, nN, u.pm, u.pn);
            u.A = act + (size_t)(which == GP_WOUT ? C_MG : C_XN) * 2;
            u.B = wt + ((size_t)(which == GP_INPROJ ? WT_IN : (which == GP_WOUT ? WT_OUT : WT_Q)) * 1024) * 2;
            u.kind = which == GP_WOUT ? GK_RESID : GK_STORE;
        }
        u.A += (size_t)u.pm * rowA; u.B += (size_t)u.pn * rowB;
        return true;
    }
};
__device__ __forceinline__ int gs_slot(int br) { return br == 0 ? C_GS : (br == 1 ? Z_V : Z_ULRU); }
struct GemmEpi {
    h16_t* act; const float* mb; const float* resid; float* out;
    __device__ __forceinline__ void operator()(const pg8::f32x4 (&acc)[2][2][4][2], const pg8::Unit& u, int wr, int wc, int fr, int fq) const {
        const int row0 = u.pm * 256 + wr * 64 + fr, col0 = u.pn * 256 + wc * 32 + 8 * fq;
#pragma unroll
        for (int ai = 0; ai < 2; ++ai)
#pragma unroll
            for (int m = 0; m < 4; ++m) {
                const int row = row0 + ai * 128 + m * 16;
#pragma unroll
                for (int bj = 0; bj < 2; ++bj) {
                    const int col = col0 + bj * 128;
                    float v[8];
#pragma unroll
                    for (int e = 0; e < 4; ++e) { v[e] = acc[ai][bj][m][0][e]; v[4 + e] = acc[ai][bj][m][1][e]; }
                    h16_t* arow = act + (size_t)row * LDZ;
                    if (u.kind == GK_STORE) {
                        store8h(arow + col, v);
                    } else if (u.kind <= GK_GATE2) {
                        const float* bp = mb + (u.kind - GK_GATE0) * 1024 + col;
                        const float4 b0 = *(const float4*)bp, b1 = *(const float4*)(bp + 4);
                        v[0] = sigmoidf_(v[0] + b0.x); v[1] = sigmoidf_(v[1] + b0.y); v[2] = sigmoidf_(v[2] + b0.z); v[3] = sigmoidf_(v[3] + b0.w);
                        v[4] = sigmoidf_(v[4] + b1.x); v[5] = sigmoidf_(v[5] + b1.y); v[6] = sigmoidf_(v[6] + b1.z); v[7] = sigmoidf_(v[7] + b1.w);
                        store8h(arow + gs_slot(u.kind - GK_GATE0) + col, v);
                    } else if (u.kind <= GK_PROJ2) {
                        float g[8]; load8h(arow + gs_slot(u.kind - GK_PROJ0) + col, g);
                        if (u.kind == GK_PROJ0) {
#pragma unroll
                            for (int e = 0; e < 8; ++e) v[e] = g[e] * v[e];
                        } else {
                            float o[8]; load8h(arow + C_MG + col, o);
#pragma unroll
                            for (int e = 0; e < 8; ++e) v[e] = o[e] + g[e] * v[e];
                        }
                        store8h(arow + C_MG + col, v);
                    } else {
                        const size_t o = (size_t)row * 1024 + col;
                        const float4 r0 = *(const float4*)(resid + o), r1 = *(const float4*)(resid + o + 4);
                        *(float4*)(out + o) = make_float4(r0.x + v[0], r0.y + v[1], r0.z + v[2], r0.w + v[3]);
                        *(float4*)(out + o + 4) = make_float4(r1.x + v[4], r1.y + v[5], r1.z + v[6], r1.w + v[7]);
                    }
                }
            }
    }
};
__device__ __forceinline__ void stage_gemm(KParams p, int l, int which, char* smem) {
    GemmProg S; S.act = p->ws + OFF_ACT; S.wt = p->ws + OFF_WT + (size_t)l * WT_ROWS * 1024 * 2; S.which = which; S.G = gridDim.x; S.c = bid_();
    GemmEpi E; E.act = (h16_t*)(p->ws + OFF_ACT); E.mb = p->in[I_MB] + l * 3072; E.resid = l == 0 ? p->in[I_X] : p->out; E.out = p->out;
    pg8::gemm_phase(smem, S, E);
}

#ifdef CPU_EMU
__device__ __forceinline__ float group_sum(float v, int width, float* scratch) {
    const int tid = tid_();
    scratch[tid] = v;
    __syncthreads();
    float s = 0.f; const int base = tid & ~(width - 1);
    for (int i = 0; i < width; ++i) s += scratch[base + i];
    __syncthreads();
    return s;
}
#else
template <int CTRL> __device__ __forceinline__ float dpp_f(float v) { return __builtin_bit_cast(float, __builtin_amdgcn_update_dpp(0, __builtin_bit_cast(int, v), CTRL, 0xf, 0xf, false)); }
__device__ __forceinline__ float group_sum(float v, int width, float*) {
    v += dpp_f<0xB1>(v);
    v += dpp_f<0x4E>(v);
    if (width >= 8) v += dpp_f<0x141>(v);
    if (width >= 16) v += dpp_f<0x140>(v);
    if (width >= 64) {
        v += __builtin_bit_cast(float, __builtin_amdgcn_update_dpp(0, __builtin_bit_cast(int, v), 0x142, 0xa, 0xf, false));
        v += __builtin_bit_cast(float, __builtin_amdgcn_update_dpp(0, __builtin_bit_cast(int, v), 0x143, 0xc, 0xf, false));
        v = __builtin_bit_cast(float, __builtin_amdgcn_readlane(__builtin_bit_cast(int, v), 63));
    } else if (width >= 32) v += __shfl_xor(v, 16);
    return v;
}
#endif
__device__ __forceinline__ uint4 ldg16(const h16_t* p) { return *(const uint4*)p; }
__device__ __forceinline__ uint4 zero16() { uint4 z; z.x = 0u; z.y = 0u; z.z = 0u; z.w = 0u; return z; }

__device__ __forceinline__ void stage_lru(KParams p, int l, char* smem, int vb0, int nvb) {
    const int vb = bid_() - vb0;
    if (vb < 0 || vb >= nvb) return;
    constexpr int CH = 64;
    float* wa_s = (float*)smem;
    float* wx_s = wa_s + 4096;
    float* xcT = wx_s + 4096;
    float* a_s = xcT + 64 * CH;
    float* b_s = a_s + CH * 64;
    h16_t* ru = (h16_t*)(b_s + CH * 64);
    h16_t* rg = ru + (CH + 3) * 64;
    h16_t* ACT = (h16_t*)(p->ws + OFF_ACT);
    const int tid = tid_(), c = tid & 63, tg = tid >> 6;
    for (int item = vb; item < B_ * 16; item += nvb) {
        const int b = item / 16, n = item % 16, ch = n * 64 + c;
        __syncthreads();
        for (int i = tid; i < 4096; i += NT) { wa_s[i] = p->in[I_LWA][((size_t)l * 16 + n) * 4096 + i]; wx_s[i] = p->in[I_LWX][((size_t)l * 16 + n) * 4096 + i]; }
        const float cw0 = p->in[I_LCW][((size_t)l * 4 + 0) * 1024 + ch], cw1 = p->in[I_LCW][((size_t)l * 4 + 1) * 1024 + ch];
        const float cw2 = p->in[I_LCW][((size_t)l * 4 + 2) * 1024 + ch], cw3 = p->in[I_LCW][((size_t)l * 4 + 3) * 1024 + ch];
        const float cb = p->in[I_LCB][l * 1024 + ch], ba = p->in[I_LBA][l * 1024 + ch], bx = p->in[I_LBX][l * 1024 + ch];
        const float sp = softplusf_(-p->in[I_LLAM][l * 1024 + ch]);
        float hst = 0.f;
        uint4 pf[3];
#define LRU_LOAD(t0_) do { _Pragma("unroll") for (int i = 0; i < 3; ++i) { const int j = tid + NT * i; pf[i] = zero16(); \
            if (j < 536) { const int t = (t0_) - 3 + (j >> 3); if (t >= 0) pf[i] = ldg16(ACT + ((size_t)b * T_ + t) * LDZ + Z_ULRU + n * 64 + (j & 7) * 8); } \
            else if (j < 1048) { const int jj = j - 536; pf[i] = ldg16(ACT + ((size_t)b * T_ + (t0_) + (jj >> 3)) * LDZ + Z_GLRU + n * 64 + (jj & 7) * 8); } } } while (0)
#define LRU_PUT() do { _Pragma("unroll") for (int i = 0; i < 3; ++i) { const int j = tid + NT * i; \
            if (j < 536) *(uint4*)(ru + (j >> 3) * 64 + (j & 7) * 8) = pf[i]; else if (j < 1048) *(uint4*)(rg + ((j - 536) >> 3) * 64 + ((j - 536) & 7) * 8) = pf[i]; } } while (0)
        LRU_LOAD(0);
        LRU_PUT();
        __syncthreads();
#pragma unroll 1
        for (int t0 = 0; t0 < T_; t0 += CH) {
            float xc[8];
            {
                float u[11];
#pragma unroll
                for (int s = 0; s < 11; ++s) u[s] = h2f(ru[(tg * 8 + s) * 64 + c]);
#pragma unroll
                for (int s = 0; s < 8; ++s) { xc[s] = cw0 * u[s] + cw1 * u[s + 1] + cw2 * u[s + 2] + cw3 * u[s + 3] + cb; xcT[c * CH + tg * 8 + s] = xc[s]; }
            }
            __syncthreads();
            if (t0 + CH < T_) LRU_LOAD(t0 + CH);
            {
                float dr[8], di[8];
#pragma unroll
                for (int s = 0; s < 8; ++s) { dr[s] = 0.f; di[s] = 0.f; }
#pragma unroll 4
                for (int i = 0; i < 64; ++i) {
                    const float wa = wa_s[i * 64 + c], wx = wx_s[i * 64 + c];
                    const float4 x0 = *(const float4*)(xcT + i * CH + tg * 8), x1 = *(const float4*)(xcT + i * CH + tg * 8 + 4);
                    dr[0] += x0.x * wa; dr[1] += x0.y * wa; dr[2] += x0.z * wa; dr[3] += x0.w * wa; dr[4] += x1.x * wa; dr[5] += x1.y * wa; dr[6] += x1.z * wa; dr[7] += x1.w * wa;
                    di[0] += x0.x * wx; di[1] += x0.y * wx; di[2] += x0.z * wx; di[3] += x0.w * wx; di[4] += x1.x * wx; di[5] += x1.y * wx; di[6] += x1.z * wx; di[7] += x1.w * wx;
                }
#pragma unroll
                for (int s = 0; s < 8; ++s) {
                    const float r = sigmoidf_(dr[s] + ba), ig = sigmoidf_(di[s] + bx);
                    const float log_a = -8.0f * r * sp;
                    a_s[(tg * 8 + s) * 64 + c] = fexp_(log_a);
                    b_s[(tg * 8 + s) * 64 + c] = sqrtf(fmaxf(1.0f - fexp_(2.0f * log_a), 0.0f)) * (ig * xc[s]);
                }
            }
            __syncthreads();
            if (tid < 64) {
#pragma unroll 8
                for (int t = 0; t < CH; ++t) { hst = a_s[t * 64 + c] * hst + b_s[t * 64 + c]; b_s[t * 64 + c] = hst; }
            }
            __syncthreads();
#pragma unroll
            for (int s = 0; s < 8; ++s) { h16_t* gp = rg + (tg * 8 + s) * 64 + c; *gp = f2h(b_s[(tg * 8 + s) * 64 + c] * geluf_(h2f(*gp))); }
            __syncthreads();
            *(uint4*)(ACT + ((size_t)b * T_ + t0 + (tid >> 3)) * LDZ + Z_GLRU + n * 64 + (tid & 7) * 8) = *(const uint4*)(rg + (tid >> 3) * 64 + (tid & 7) * 8);
            __syncthreads();
            if (t0 + CH < T_) LRU_PUT();
            __syncthreads();
        }
#undef LRU_LOAD
#undef LRU_PUT
    }
}

#ifdef CPU_EMU
struct hfrag { h16_t v[8]; };
struct facc { float d[4]; float& operator[](int i) { return d[i]; } const float& operator[](int i) const { return d[i]; } };
__device__ __forceinline__ facc facc_zero() { facc a; a.d[0] = a.d[1] = a.d[2] = a.d[3] = 0.f; return a; }
__device__ __forceinline__ hfrag frag_u4(uint4 w) { hfrag f; memcpy(&f, &w, 16); return f; }
__device__ __forceinline__ hfrag frag_2u2(uint2 lo, uint2 hi) { hfrag f; memcpy(&f.v[0], &lo, 8); memcpy(&f.v[4], &hi, 8); return f; }
__device__ __forceinline__ hfrag frag_mul(hfrag a, hfrag b) { hfrag f; for (int j = 0; j < 8; ++j) f.v[j] = f2h(h2f(a.v[j]) * h2f(b.v[j])); return f; }
__device__ __forceinline__ facc mfma16(hfrag a, hfrag b, facc c) {
    const int tid = tid_(), w = tid >> 6, l = tid & 63;
    unsigned short (*X)[64][16] = emu::ctx->xscr;
    for (int j = 0; j < 8; ++j) { X[w][l][j] = a.v[j]; X[w][l][8 + j] = b.v[j]; }
    __syncthreads();
    for (int reg = 0; reg < 4; ++reg) {
        const int row = 4 * (l >> 4) + reg, col = l & 15;
        float s = 0.f;
        for (int k = 0; k < 32; ++k) s += h2f(X[w][row + 16 * (k >> 3)][k & 7]) * h2f(X[w][col + 16 * (k >> 3)][8 + (k & 7)]);
        c.d[reg] += s;
    }
    __syncthreads();
    return c;
}
#else
typedef _Float16 hfrag __attribute__((ext_vector_type(8)));
typedef float facc __attribute__((ext_vector_type(4)));
__device__ __forceinline__ facc facc_zero() { return (facc){0.f, 0.f, 0.f, 0.f}; }
__device__ __forceinline__ hfrag frag_u4(uint4 w) { return __builtin_bit_cast(hfrag, w); }
__device__ __forceinline__ hfrag frag_2u2(uint2 lo, uint2 hi) { uint4 w; w.x = lo.x; w.y = lo.y; w.z = hi.x; w.w = hi.y; return __builtin_bit_cast(hfrag, w); }
__device__ __forceinline__ hfrag frag_mul(hfrag a, hfrag b) { return a * b; }
__device__ __forceinline__ facc mfma16(hfrag a, hfrag b, facc c) { return __builtin_amdgcn_mfma_f32_16x16x32_f16(a, b, c, 0, 0, 0); }
#endif
__device__ __forceinline__ hfrag frag_pack8(float a0, float a1, float a2, float a3, float a4, float a5, float a6, float a7) {
    uint4 w; w.x = pack2h(a0, a1); w.y = pack2h(a2, a3); w.z = pack2h(a4, a5); w.w = pack2h(a6, a7); return frag_u4(w);
}
__device__ __forceinline__ hfrag frag_acc2(const facc& t0, const facc& t1) { return frag_pack8(t0[0], t0[1], t0[2], t0[3], t1[0], t1[1], t1[2], t1[3]); }
__device__ __forceinline__ hfrag permfrag(const h16_t* rowp, int ks, int g) { return frag_2u2(*(const uint2*)(rowp + 32 * ks + 4 * g), *(const uint2*)(rowp + 32 * ks + 16 + 4 * g)); }

__device__ __forceinline__ void stage_gdn(KParams p, int l, char* smem, int vb0, int nvb) {
    const int vb = bid_() - vb0;
    if (vb < 0 || vb >= nvb) return;
    constexpr int CH = 64, QS = 136, TS = 72, AS = 68, KTS = 128 * TS + 16 * 8;
#define KTO(d) ((d) * TS + ((d) >> 3) * 8)
    h16_t* Qs = (h16_t*)smem;
    h16_t* Ks = Qs + 64 * QS;
    h16_t* Kt = Ks + 64 * QS;
    h16_t* Vt = Kt + KTS;
    float* A32 = (float*)(Vt + KTS);
    h16_t* ob = (h16_t*)A32;
    h16_t* Tu = (h16_t*)(A32 + 64 * AS);
    h16_t* Tw = Tu + 64 * TS;
    h16_t* QKm = Tw + 64 * TS;
    float* gc_s = (float*)(QKm + 64 * TS);
    float* be_s = gc_s + 64;
    float* e1_s = be_s + 64;
    float* part_s = e1_s + 64;
    float* scr = part_s + 512;
    float* cw_s = scr + 512;
    h16_t* ACT = (h16_t*)(p->ws + OFF_ACT);
    int tid = tid_(), lane = tid & 63, w = tid >> 6, g = lane >> 4, r16 = lane & 15;
    int sg = lane >> 4, pc = lane & 15, rb = w;
#define GDN_ROLES() do { tid = tid_(); lane = tid & 63; w = tid >> 6; g = lane >> 4; r16 = lane & 15; sg = g; pc = r16; rb = w; } while (0)
    for (int item = vb; item < B_ * 8; item += nvb) {
        const int b = item / 8, h = item % 8;
        const float a_exp = fexp_(p->in[I_GALOG][l * 8 + h]), dtb = p->in[I_GDT][l * 8 + h];
        facc S[8];
#pragma unroll
        for (int dt = 0; dt < 8; ++dt) S[dt] = facc_zero();
        __syncthreads();
        for (int i = tid; i < 64 * TS / 2; i += NT) ((unsigned*)QKm)[i] = 0u;
        for (int i = tid; i < 4 * 384; i += NT) { const int jj = i / 384, c3 = i % 384; cw_s[i] = p->in[I_GCW][((size_t)l * 4 + jj) * 3072 + (c3 >> 7) * 1024 + h * 128 + (c3 & 127)]; }
        uint4 pf[11];
#define GDN_LOAD(t0_) do { GDN_ROLES(); const h16_t* colp = ACT + ((size_t)b * T_ + (t0_) + 8 * rb - 3) * LDZ + (sg < 3 ? Z_Q + sg * 1024 : Z_ZG) + h * 128 + pc * 8; \
            _Pragma("unroll") for (int i = 0; i < 11; ++i) { const int t = (t0_) + 8 * rb - 3 + i; pf[i] = (t >= 0 && sg < 3) ? ldg16(colp + (size_t)i * LDZ) : zero16(); } } while (0)
        GDN_LOAD(0);
        h16_t pfa = 0, pfb = 0;
#define GDN_LOADS(t0_) do { if (tid < 64) { const size_t m_ = (size_t)b * T_ + (t0_) + tid; pfa = ACT[m_ * LDZ + Z_ALPHA + h]; pfb = ACT[m_ * LDZ + Z_BETA + h]; } } while (0)
        GDN_LOADS(0);
#pragma unroll 1
        for (int t0 = 0; t0 < T_; t0 += CH) {
            GDN_ROLES();
            if (tid < 64) {
                part_s[tid] = -a_exp * softplusf_(h2f(pfa) + dtb);
                be_s[tid] = sigmoidf_(h2f(pfb));
            }
            __syncthreads();
            if (tid < 64) { float s = 0.f;
#pragma unroll
                for (int i4 = 0; i4 < 16; ++i4) { const float4 pv = *(const float4*)(part_s + i4 * 4); s += (i4 * 4 <= tid ? pv.x : 0.f) + (i4 * 4 + 1 <= tid ? pv.y : 0.f) + (i4 * 4 + 2 <= tid ? pv.z : 0.f) + (i4 * 4 + 3 <= tid ? pv.w : 0.f); }
                gc_s[tid] = s; }
#pragma unroll
            for (int hf = 0; hf < 2; ++hf) {
                float ov[4][8];
#pragma unroll
                for (int i = 0; i < 4; ++i) {
#pragma unroll
                    for (int cc = 0; cc < 8; ++cc) ov[i][cc] = 0.f;
#pragma unroll
                    for (int jj = 0; jj < 4; ++jj) {
                        const uint4 wv = pf[hf * 4 + i + jj];
                        const float* cwp = cw_s + jj * 384 + (sg < 3 ? sg : 0) * 128 + pc * 8;
                        const float4 c0 = *(const float4*)cwp, c1 = *(const float4*)(cwp + 4);
                        ov[i][0] += c0.x * h2f((h16_t)(wv.x & 0xffffu)); ov[i][1] += c0.y * h2f((h16_t)(wv.x >> 16)); ov[i][2] += c0.z * h2f((h16_t)(wv.y & 0xffffu)); ov[i][3] += c0.w * h2f((h16_t)(wv.y >> 16));
                        ov[i][4] += c1.x * h2f((h16_t)(wv.z & 0xffffu)); ov[i][5] += c1.y * h2f((h16_t)(wv.z >> 16)); ov[i][6] += c1.z * h2f((h16_t)(wv.w & 0xffffu)); ov[i][7] += c1.w * h2f((h16_t)(wv.w >> 16));
                    }
                    float ss = 0.f;
#pragma unroll
                    for (int cc = 0; cc < 8; ++cc) { ov[i][cc] = siluf_(ov[i][cc]); ss += ov[i][cc] * ov[i][cc]; }
                    ss = group_sum(ss, 16, scr);
                    const float rn = sg == 0 ? rsqrtf(ss + RMS_EPS) * 0.08838834764831845f : (sg == 1 ? rsqrtf(ss + RMS_EPS) : 1.0f);
#pragma unroll
                    for (int cc = 0; cc < 8; ++cc) ov[i][cc] *= rn;
                    const int t = 8 * rb + hf * 4 + i;
                    if (sg == 0) store8h(Qs + t * QS + pc * 8, ov[i]);
                    else if (sg == 1) store8h(Ks + t * QS + pc * 8, ov[i]);
                }
                if (sg == 1 || sg == 2) {
                    h16_t* dstT = sg == 1 ? Kt : Vt;
#pragma unroll
                    for (int cc = 0; cc < 8; ++cc) { uint2 w2; w2.x = pack2h(ov[0][cc], ov[1][cc]); w2.y = pack2h(ov[2][cc], ov[3][cc]); *(uint2*)(dstT + KTO(pc * 8 + cc) + 8 * rb + hf * 4) = w2; }
                }
            }
            __syncthreads();
            GDN_ROLES();
            if (tid < 64) e1_s[tid] = fexp_(gc_s[63] - gc_s[tid]);
            for (int e = tid; e < 64 * 64; e += NT) { const int i = e >> 6, j = e & 63; if ((j >> 4) > (i >> 4)) A32[i * AS + (j & 7) * 8 + (j >> 3)] = 0.f; }
#pragma unroll 1
            for (int jr = 0; jr < 3; ++jr) {
                const int jb = w + 8 * jr; const bool valid = jb < 20;
                const int kind = (valid && jb >= 10) ? 1 : 0, tix = valid ? (jb % 10) : 0;
                const int ti = tix < 1 ? 0 : (tix < 3 ? 1 : (tix < 6 ? 2 : 3)), tj = tix - (ti * (ti + 1)) / 2;
                const h16_t* ap = (kind ? Qs : Ks) + (16 * ti + r16) * QS + 8 * g; const h16_t* bp = Ks + (16 * tj + r16) * QS + 8 * g;
                facc acc = facc_zero();
#pragma unroll
                for (int ks = 0; ks < 4; ++ks) acc = mfma16(frag_u4(*(const uint4*)(ap + 32 * ks)), frag_u4(*(const uint4*)(bp + 32 * ks)), acc);
                if (valid) {
                    const int j = 16 * tj + r16; const float gj = gc_s[j];
#pragma unroll
                    for (int reg = 0; reg < 4; ++reg) {
                        const int i = 16 * ti + 4 * g + reg;
                        const float dec = fexp_(fminf(gc_s[i] - gj, 0.f));
                        if (kind == 0) A32[i * AS + (j & 7) * 8 + (j >> 3)] = i > j ? be_s[i] * acc[reg] * dec : 0.f;
                        else QKm[i * TS + j] = f2h(i >= j ? acc[reg] * dec : 0.f);
                    }
                }
            }
            __syncthreads();
            GDN_ROLES();
            {
                const int t = tid >> 3, d0 = (tid & 7) * 16; const float eg = fexp_(gc_s[t]);
                float v8[8];
                load8h(Qs + t * QS + d0, v8);
#pragma unroll
                for (int e = 0; e < 8; ++e) v8[e] *= eg;
                store8h(Qs + t * QS + d0, v8);
                load8h(Qs + t * QS + d0 + 8, v8);
#pragma unroll
                for (int e = 0; e < 8; ++e) v8[e] *= eg;
                store8h(Qs + t * QS + d0 + 8, v8);
            }
            {
                const int c = tid >> 3, q = tid & 7;
                const float bc = be_s[c], bgc = bc * fexp_(gc_s[c]);
                float x[8];
#pragma unroll
                for (int i = 0; i < 8; ++i) x[i] = 0.f;
#pragma unroll
                for (int r = 0; r < 64; ++r) {
                    float sacc = 0.f;
                    if (r > 0) {
                        const float4 a0 = *(const float4*)(A32 + r * AS + q * 8);
                        sacc = a0.x * x[0];
                        if (r > 8) sacc += a0.y * x[1];
                        if (r > 16) sacc += a0.z * x[2];
                        if (r > 24) sacc += a0.w * x[3];
                        if (r > 32) {
                            const float4 a1 = *(const float4*)(A32 + r * AS + q * 8 + 4);
                            sacc += a1.x * x[4];
                            if (r > 40) sacc += a1.y * x[5];
                            if (r > 48) sacc += a1.z * x[6];
                            if (r > 56) sacc += a1.w * x[7];
                        }
                        sacc = group_sum(sacc, 8, scr);
                    }
                    const float xr = ((r == c) ? 1.f : 0.f) - sacc;
                    if (q == (r & 7)) { x[r >> 3] = xr; Tu[r * TS + c] = f2h(xr * bc); Tw[r * TS + c] = f2h(xr * bgc); }
                }
            }
            __syncthreads();
            GDN_ROLES();
            facc vn[4], aw[4];
#pragma unroll
            for (int tt = 0; tt < 4; ++tt) { vn[tt] = facc_zero(); aw[tt] = facc_zero(); }
#pragma unroll
            for (int tt = 0; tt < 4; ++tt)
#pragma unroll
                for (int ks = 0; ks <= (tt >> 1); ++ks) {
                    const hfrag au = frag_u4(*(const uint4*)(Tu + (16 * tt + r16) * TS + 32 * ks + 8 * g)), aww = frag_u4(*(const uint4*)(Tw + (16 * tt + r16) * TS + 32 * ks + 8 * g));
                    vn[tt] = mfma16(au, frag_u4(*(const uint4*)(Vt + KTO(16 * w + r16) + 32 * ks + 8 * g)), vn[tt]);
                    aw[tt] = mfma16(aww, frag_u4(*(const uint4*)(Kt + KTO(16 * w + r16) + 32 * ks + 8 * g)), aw[tt]);
                }
#pragma unroll
            for (int tt = 0; tt < 4; ++tt)
#pragma unroll
                for (int reg = 0; reg < 4; ++reg) Ks[(16 * tt + 4 * g + reg) * QS + 16 * w + r16] = f2h(-aw[tt][reg]);
            __syncthreads();
            GDN_ROLES();
            h16_t zraw[16];
#pragma unroll
            for (int tt = 0; tt < 4; ++tt)
#pragma unroll
                for (int reg = 0; reg < 4; ++reg) zraw[tt * 4 + reg] = ACT[((size_t)b * T_ + t0 + 16 * tt + 4 * g + reg) * LDZ + Z_ZG + h * 128 + 16 * w + r16];
            hfrag Sb[4];
#pragma unroll
            for (int ks = 0; ks < 4; ++ks) Sb[ks] = frag_acc2(S[2 * ks], S[2 * ks + 1]);
            facc oc[4];
#pragma unroll
            for (int tt = 0; tt < 4; ++tt) {
                oc[tt] = facc_zero();
                const h16_t* wrow = Ks + (16 * tt + r16) * QS; const h16_t* qrow = Qs + (16 * tt + r16) * QS;
#pragma unroll
                for (int ks = 0; ks < 4; ++ks) { vn[tt] = mfma16(permfrag(wrow, ks, g), Sb[ks], vn[tt]); oc[tt] = mfma16(permfrag(qrow, ks, g), Sb[ks], oc[tt]); }
            }
            hfrag VNb[2];
            VNb[0] = frag_acc2(vn[0], vn[1]); VNb[1] = frag_acc2(vn[2], vn[3]);
#pragma unroll
            for (int tt = 0; tt < 4; ++tt)
#pragma unroll
                for (int ks2 = 0; ks2 <= (tt >> 1); ++ks2) oc[tt] = mfma16(permfrag(QKm + (16 * tt + r16) * TS, ks2, g), VNb[ks2], oc[tt]);
            {
                const float egl = fexp_(gc_s[63]);
                hfrag e1f[2];
#pragma unroll
                for (int ks2 = 0; ks2 < 2; ++ks2) { const float* ep = e1_s + 32 * ks2 + 4 * g; e1f[ks2] = frag_pack8(ep[0], ep[1], ep[2], ep[3], ep[16], ep[17], ep[18], ep[19]); }
#pragma unroll
                for (int dt = 0; dt < 8; ++dt) {
#pragma unroll
                    for (int reg = 0; reg < 4; ++reg) S[dt][reg] *= egl;
#pragma unroll
                    for (int ks2 = 0; ks2 < 2; ++ks2) S[dt] = mfma16(frag_mul(permfrag(Kt + KTO(16 * dt + r16), ks2, g), e1f[ks2]), VNb[ks2], S[dt]);
                }
            }
            if (t0 + CH < T_) { GDN_LOAD(t0 + CH); GDN_LOADS(t0 + CH); }
            GDN_ROLES();
#pragma unroll
            for (int tt = 0; tt < 4; ++tt)
#pragma unroll
                for (int reg = 0; reg < 4; ++reg) { const float ss = group_sum(oc[tt][reg] * oc[tt][reg], 16, scr); if (r16 == 0) part_s[w * 64 + 16 * tt + 4 * g + reg] = ss; }
            __syncthreads();
            const float nw = p->in[I_GNW][l * 128 + w * 16 + r16];
#pragma unroll
            for (int tt = 0; tt < 4; ++tt)
#pragma unroll
                for (int reg = 0; reg < 4; ++reg) {
                    const int t = 16 * tt + 4 * g + reg;
                    float ms = 0.f;
#pragma unroll
                    for (int ww = 0; ww < 8; ++ww) ms += part_s[ww * 64 + t];
                    ob[t * 128 + 16 * w + r16] = f2h(oc[tt][reg] * rsqrtf(ms * (1.0f / 128.0f) + RMS_EPS) * nw * siluf_(h2f(zraw[tt * 4 + reg])));
                }
            __syncthreads();
            GDN_ROLES();
#pragma unroll
            for (int i = 0; i < 2; ++i) { const int j = tid + NT * i; *(uint4*)(ACT + ((size_t)b * T_ + t0 + (j >> 4)) * LDZ + Z_ZG + h * 128 + (j & 15) * 8) = *(const uint4*)(ob + (j >> 4) * 128 + (j & 15) * 8); }
            __syncthreads();
        }
#undef GDN_LOAD
#undef GDN_LOADS
#undef KTO
#undef GDN_ROLES
    }
}

#ifndef CPU_EMU
typedef _Float16 rw_f16x8 __attribute__((ext_vector_type(8)));
typedef float rw_f32x4 __attribute__((ext_vector_type(4)));
#endif
__device__ __forceinline__ void stage_rwkv(KParams p, int l, char* smem, int vb0, int nvb) {
    const int vb = bid_() - vb0;
    if (vb < 0 || vb >= nvb) return;
    constexpr int CH = 32, XS = 264;
    float* r_s = (float*)smem;
    float* k_s = r_s + CH * 64;
    float* v_s = k_s + CH * 64;
    float* w_s = v_s + CH * 64;
    float* kk_s = w_s + CH * 64;
    float* ka_s = kk_s + CH * 64;
    float* g_s = ka_s + CH * 64;
    float* o_s = g_s + CH * 64;
    float* bon_s = o_s + CH * 64;
    float* scr = bon_s + CH;
    h16_t* raw = (h16_t*)(scr + 512);
    h16_t* xs = raw + (CH + 1) * 448;
    h16_t* ACT = (h16_t*)(p->ws + OFF_ACT);
    int tid = tid_(), c = tid & 63, tg = tid >> 6;
    int ri = tid >> 3, q8 = tid & 7;
#define RW_ROLES() do { tid = tid_(); c = tid & 63; tg = tid >> 6; ri = tid >> 3; q8 = tid & 7; } while (0)
    float* cst_s = (float*)(xs + CH * XS);
    for (int item = vb; item < B_ * 16; item += nvb) {
        const int b = item / 16, h = item % 16, ch = h * 64 + c;
        __syncthreads();
        if (tid < 64) {
            const float* mu = p->in[I_RMU] + (size_t)l * RWW;
            cst_s[0 * 64 + c] = p->in[I_RW0][l * 1024 + ch]; cst_s[1 * 64 + c] = p->in[I_RA0][l * 1024 + ch]; cst_s[2 * 64 + c] = p->in[I_RKK][l * 1024 + ch]; cst_s[3 * 64 + c] = p->in[I_RKA][l * 1024 + ch];
            cst_s[4 * 64 + c] = p->in[I_RRK][(size_t)l * 1024 + ch]; cst_s[5 * 64 + c] = p->in[I_RLW][l * 1024 + ch]; cst_s[6 * 64 + c] = p->in[I_RLB][l * 1024 + ch];
            cst_s[7 * 64 + c] = mu[RW_R + ch]; cst_s[8 * 64 + c] = mu[RW_K + ch]; cst_s[9 * 64 + c] = mu[RW_V + ch];
            cst_s[10 * 64 + c] = mu[RW_WL + c]; cst_s[11 * 64 + c] = mu[RW_AL + c]; cst_s[12 * 64 + c] = mu[RW_GL + c]; cst_s[13 * 64 + c] = mu[RW_GL + 64 + c];
        }
        const float* wup = p->in[I_RWUP] + (size_t)l * 64 * 1024 + h * 64; const float* aup = p->in[I_RAUP] + (size_t)l * 64 * 1024 + h * 64; const float* gup = p->in[I_RGUP] + (size_t)l * 128 * 1024 + h * 64;
#ifndef CPU_EMU
        const int wid = tid >> 6, lane = tid & 63, mt = wid >> 2, nt = wid & 3;
        rw_f16x8 bw[2], ba_[2], bg[4];
        {
            const int cn = nt * 16 + (lane & 15), kb = 8 * (lane >> 4);
#pragma unroll
            for (int ks = 0; ks < 2; ++ks)
#pragma unroll
                for (int j = 0; j < 8; ++j) { bw[ks][j] = (_Float16)wup[(size_t)(ks * 32 + kb + j) * 1024 + cn]; ba_[ks][j] = (_Float16)aup[(size_t)(ks * 32 + kb + j) * 1024 + cn]; }
#pragma unroll
            for (int ks = 0; ks < 4; ++ks)
#pragma unroll
                for (int j = 0; j < 8; ++j) bg[ks][j] = (_Float16)gup[(size_t)(ks * 32 + kb + j) * 1024 + cn];
        }
#endif
        float S[8];
#pragma unroll
        for (int e = 0; e < 8; ++e) S[e] = 0.f;
        uint4 pf[4];
#define RW_LOAD(t0_) do { _Pragma("unroll") for (int i = 0; i < 4; ++i) { const int j = tid + NT * i, row = j / 56, u = j % 56, t = (t0_) - 1 + row; pf[i] = zero16(); \
            if (j < (CH + 1) * 56 && t >= 0) pf[i] = ldg16(ACT + ((size_t)b * T_ + t) * LDZ + Z_RW + (u < 24 ? (u >> 3) * 1024 + h * 64 + (u & 7) * 8 : 3072 + (u - 24) * 8)); } } while (0)
#define RW_PUT() do { _Pragma("unroll") for (int i = 0; i < 4; ++i) { const int j = tid + NT * i; if (j < (CH + 1) * 56) *(uint4*)(raw + (j / 56) * 448 + (j % 56) * 8) = pf[i]; } } while (0)
        __syncthreads();
        RW_LOAD(0);
        RW_PUT();
        __syncthreads();
#pragma unroll 1
        for (int t0 = 0; t0 < T_; t0 += CH) {
            RW_ROLES();
            {
            const float mu_r = cst_s[7 * 64 + c], mu_k = cst_s[8 * 64 + c], mu_v = cst_s[9 * 64 + c], mu_wl = cst_s[10 * 64 + c], mu_al = cst_s[11 * 64 + c], mu_g0 = cst_s[12 * 64 + c], mu_g1 = cst_s[13 * 64 + c];
#pragma unroll
            for (int s = 0; s < 4; ++s) {
                const int tl = tg * 4 + s;
                const h16_t* zc = raw + (tl + 1) * 448; const h16_t* zp = raw + tl * 448;
#define RW_SHIFT(col, muv) ({ const float zz = h2f(zc[col]); zz + (muv) * (h2f(zp[col]) - zz); })
                r_s[tl * 64 + c] = RW_SHIFT(c, mu_r);
                k_s[tl * 64 + c] = RW_SHIFT(64 + c, mu_k);
                v_s[tl * 64 + c] = RW_SHIFT(128 + c, mu_v);
                xs[tl * XS + c] = f2h(tanhf_(RW_SHIFT(192 + c, mu_wl)));
                xs[tl * XS + 64 + c] = f2h(RW_SHIFT(256 + c, mu_al));
                xs[tl * XS + 128 + c] = f2h(sigmoidf_(RW_SHIFT(320 + c, mu_g0)));
                xs[tl * XS + 192 + c] = f2h(sigmoidf_(RW_SHIFT(384 + c, mu_g1)));
#undef RW_SHIFT
            }
            }
            __syncthreads();
#ifdef CPU_EMU
#pragma unroll
            for (int s = 0; s < 4; ++s) {
                const int tl = tg * 4 + s;
                float dw = 0.f, da = 0.f, dg = 0.f;
                for (int i = 0; i < 64; ++i) { dw += h2f(xs[tl * XS + i]) * h2f(f2h(wup[(size_t)i * 1024 + c])); da += h2f(xs[tl * XS + 64 + i]) * h2f(f2h(aup[(size_t)i * 1024 + c])); }
                for (int i = 0; i < 128; ++i) dg += h2f(xs[tl * XS + 128 + i]) * h2f(f2h(gup[(size_t)i * 1024 + c]));
                w_s[tl * 64 + c] = dw; ka_s[tl * 64 + c] = da; g_s[tl * 64 + c] = dg;
            }
#else
            {
                const h16_t* ap = xs + (mt * 16 + (lane & 15)) * XS + 8 * (lane >> 4);
                rw_f32x4 dw = {0.f, 0.f, 0.f, 0.f}, da = {0.f, 0.f, 0.f, 0.f}, dg = {0.f, 0.f, 0.f, 0.f};
#pragma unroll
                for (int ks = 0; ks < 2; ++ks) {
                    dw = __builtin_amdgcn_mfma_f32_16x16x32_f16(*(const rw_f16x8*)(ap + ks * 32), bw[ks], dw, 0, 0, 0);
                    da = __builtin_amdgcn_mfma_f32_16x16x32_f16(*(const rw_f16x8*)(ap + 64 + ks * 32), ba_[ks], da, 0, 0, 0);
                }
#pragma unroll
                for (int ks = 0; ks < 4; ++ks) dg = __builtin_amdgcn_mfma_f32_16x16x32_f16(*(const rw_f16x8*)(ap + 128 + ks * 32), bg[ks], dg, 0, 0, 0);
#pragma unroll
                for (int rg = 0; rg < 4; ++rg) { const int o = (mt * 16 + 4 * (lane >> 4) + rg) * 64 + nt * 16 + (lane & 15); w_s[o] = dw[rg]; ka_s[o] = da[rg]; g_s[o] = dg[rg]; }
            }
#endif
            __syncthreads();
            RW_ROLES();
            {
            const float w0 = cst_s[0 * 64 + c], a0 = cst_s[1 * 64 + c], k_k = cst_s[2 * 64 + c], k_a = cst_s[3 * 64 + c], rk_c = cst_s[4 * 64 + c];
#pragma unroll
            for (int s = 0; s < 4; ++s) {
                const int tl = tg * 4 + s;
                const float w_log = -softplusf_(-(w0 + w_s[tl * 64 + c])) - 0.5f;
                const float decay = fexp_(-fexp_(w_log));
                const float a = sigmoidf_(a0 + ka_s[tl * 64 + c]);
                const float kx = k_s[tl * 64 + c], rx = r_s[tl * 64 + c];
                const float kkr = kx * k_k, k2 = kx * (1.0f + (a - 1.0f) * k_a);
                const float nsq = group_sum(kkr * kkr, 64, scr);
                const float bon = group_sum(rx * k2 * rk_c, 64, scr);
                const float kkn = kkr * rsqrtf(nsq + RMS_EPS);
                w_s[tl * 64 + c] = decay; k_s[tl * 64 + c] = k2; kk_s[tl * 64 + c] = kkn; ka_s[tl * 64 + c] = kkn * a;
                if (c == 0) bon_s[tl] = bon;
            }
            }
            __syncthreads();
            RW_ROLES();
            {
                struct StepVec { float4 kk0, kk1, w0, w1, a0, a1, k0, k1, r0, r1; float vi; };
#define RW_LDSTEP(V_, t_) do { const int o8_ = (t_) * 64 + q8 * 8; V_.kk0 = *(const float4*)(kk_s + o8_); V_.kk1 = *(const float4*)(kk_s + o8_ + 4); V_.w0 = *(const float4*)(w_s + o8_); V_.w1 = *(const float4*)(w_s + o8_ + 4); \
                    V_.a0 = *(const float4*)(ka_s + o8_); V_.a1 = *(const float4*)(ka_s + o8_ + 4); V_.k0 = *(const float4*)(k_s + o8_); V_.k1 = *(const float4*)(k_s + o8_ + 4); \
                    V_.r0 = *(const float4*)(r_s + o8_); V_.r1 = *(const float4*)(r_s + o8_ + 4); V_.vi = v_s[(t_) * 64 + ri]; } while (0)
#define RW_STEP(V_, t_) do { \
                    const float pk = (S[0] * V_.kk0.x + S[1] * V_.kk0.y) + (S[2] * V_.kk0.z + S[3] * V_.kk0.w) + ((S[4] * V_.kk1.x + S[5] * V_.kk1.y) + (S[6] * V_.kk1.z + S[7] * V_.kk1.w)); \
                    const float skk = group_sum(pk, 8, scr); const float vi = V_.vi; \
                    S[0] = S[0] * V_.w0.x - skk * V_.a0.x + vi * V_.k0.x; S[1] = S[1] * V_.w0.y - skk * V_.a0.y + vi * V_.k0.y; S[2] = S[2] * V_.w0.z - skk * V_.a0.z + vi * V_.k0.z; S[3] = S[3] * V_.w0.w - skk * V_.a0.w + vi * V_.k0.w; \
                    S[4] = S[4] * V_.w1.x - skk * V_.a1.x + vi * V_.k1.x; S[5] = S[5] * V_.w1.y - skk * V_.a1.y + vi * V_.k1.y; S[6] = S[6] * V_.w1.z - skk * V_.a1.z + vi * V_.k1.z; S[7] = S[7] * V_.w1.w - skk * V_.a1.w + vi * V_.k1.w; \
                    const float po = (S[0] * V_.r0.x + S[1] * V_.r0.y) + (S[2] * V_.r0.z + S[3] * V_.r0.w) + ((S[4] * V_.r1.x + S[5] * V_.r1.y) + (S[6] * V_.r1.z + S[7] * V_.r1.w)); \
                    const float o = group_sum(po, 8, scr); \
                    if (q8 == 0) o_s[(t_) * 64 + ri] = o; } while (0)
                StepVec va, vb;
                RW_LDSTEP(va, 0);
#pragma unroll 1
                for (int t = 0; t < CH; t += 2) {
                    RW_LDSTEP(vb, t + 1);
                    RW_STEP(va, t);
                    if (t + 2 < CH) RW_LDSTEP(va, t + 2);
                    RW_STEP(vb, t + 1);
                }
#undef RW_LDSTEP
#undef RW_STEP
            }
            if (t0 + CH < T_) RW_LOAD(t0 + CH);
            __syncthreads();
            RW_ROLES();
            {
            const float lnw = cst_s[5 * 64 + c], lnb = cst_s[6 * 64 + c];
            const int ch = h * 64 + c;
#pragma unroll
            for (int s = 0; s < 4; ++s) {
                const int tl = tg * 4 + s;
                const float ov = o_s[tl * 64 + c];
                const float mean = group_sum(ov, 64, scr) * (1.0f / 64.0f);
                const float d = ov - mean;
                const float var = group_sum(d * d, 64, scr) * (1.0f / 64.0f);
                const float y = (d * rsqrtf(var + GN_EPS) * lnw + lnb + bon_s[tl] * v_s[tl * 64 + c]) * g_s[tl * 64 + c];
                ACT[((size_t)b * T_ + t0 + tl) * LDZ + C_YC + ch] = f2h(y);
            }
            }
            RW_ROLES();
            if (t0 + CH < T_) RW_PUT();
            __syncthreads();
        }
#undef RW_LOAD
#undef RW_PUT
#undef RW_ROLES
    }
}

constexpr bool TAB_IN_ACT = (M_ == 16384);
constexpr float TAB_SU = 256.0f, TAB_SV = 32.0f;
__device__ __forceinline__ unsigned char* tab_row(char* ws, int e) {
    if (TAB_IN_ACT) return (unsigned char*)((h16_t*)(ws + OFF_ACT) + (size_t)e * LDZ + C_GS);
    return (unsigned char*)(ws + OFF_TAB) + (size_t)e * 2048;
}
#ifdef CPU_EMU
__device__ __forceinline__ unsigned f2fp8(float f) {
    const unsigned sgn = f < 0.f ? 0x80u : 0u; float a = fabsf(f);
    if (!(a == a)) return 0x7fu;
    if (a >= 448.0f) return sgn | 0x7eu;
    if (a < 0.0009765625f) return sgn;
    int e; frexpf(a, &e); e -= 1;
    if (e < -6) { const float q = nearbyintf(a * 512.0f); return sgn | (unsigned)q; }
    float q = nearbyintf((a / ldexpf(1.0f, e) - 1.0f) * 8.0f);
    if (q >= 8.0f) { q = 0.f; e += 1; }
    if (e > 8) return sgn | 0x7eu;
    const unsigned r = ((unsigned)(e + 7) << 3) | (unsigned)q;
    return sgn | (r > 0x7eu ? 0x7eu : r);
}
__device__ __forceinline__ float fp82f(unsigned b) {
    const unsigned e = (b >> 3) & 15u, m = b & 7u; const float s = (b & 0x80u) ? -1.f : 1.f;
    if (e == 0) return s * (float)m * 0.001953125f;
    return s * ldexpf(1.0f + (float)m * 0.125f, (int)e - 7);
}
__device__ __forceinline__ unsigned pack4fp8(float a, float b, float c, float d) { return f2fp8(a) | (f2fp8(b) << 8) | (f2fp8(c) << 16) | (f2fp8(d) << 24); }
__device__ __forceinline__ void dec4fp8(unsigned w, float* o) { o[0] = fp82f(w & 255u); o[1] = fp82f((w >> 8) & 255u); o[2] = fp82f((w >> 16) & 255u); o[3] = fp82f(w >> 24); }
#else
__device__ __forceinline__ unsigned pack4fp8(float a, float b, float c, float d) { int p = __builtin_amdgcn_cvt_pk_fp8_f32(a, b, 0, false); p = __builtin_amdgcn_cvt_pk_fp8_f32(c, d, p, true); return (unsigned)p; }
__device__ __forceinline__ void dec4fp8(unsigned w, float* o) { const auto lo = __builtin_amdgcn_cvt_pk_f32_fp8((int)w, false); const auto hi = __builtin_amdgcn_cvt_pk_f32_fp8((int)w, true); o[0] = lo[0]; o[1] = lo[1]; o[2] = hi[0]; o[3] = hi[1]; }
#endif
__device__ __forceinline__ void stage_tabconv(KParams p, int l) {
    const int tid = tid_();
    const float* U = p->in[I_PU] + (size_t)l * 16384 * 1024; const float* V = p->in[I_PV] + (size_t)l * 16384 * 1024;
    char* ws = p->ws;
    for (int it = bid_() * NT + tid; it < 16384 * 128; it += gridDim.x * NT) {
        const int r = it >> 7, ck = it & 127, which = ck >> 6, c16 = ck & 63;
        const float* src = (which ? V : U) + (size_t)r * 1024 + c16 * 16;
        const float sc = which ? TAB_SV : TAB_SU;
        const float4 a = *(const float4*)src, b = *(const float4*)(src + 4), c = *(const float4*)(src + 8), d = *(const float4*)(src + 12);
        uint4 w;
        w.x = pack4fp8(a.x * sc, a.y * sc, a.z * sc, a.w * sc); w.y = pack4fp8(b.x * sc, b.y * sc, b.z * sc, b.w * sc);
        w.z = pack4fp8(c.x * sc, c.y * sc, c.z * sc, c.w * sc); w.w = pack4fp8(d.x * sc, d.y * sc, d.z * sc, d.w * sc);
        *(uint4*)(tab_row(ws, r) + which * 1024 + c16 * 16) = w;
    }
}

#ifdef CPU_EMU
__device__ __forceinline__ float group_max16(float v, float* scr) {
    const int tid = tid_();
    scr[tid] = v;
    __syncthreads();
    float m = -3.0e38f; const int base = tid & ~15;
    for (int i = 0; i < 16; ++i) m = fmaxf(m, scr[base + i]);
    __syncthreads();
    return m;
}
#else
__device__ __forceinline__ float group_max16(float v, float*) {
    v = fmaxf(v, dpp_f<0xB1>(v)); v = fmaxf(v, dpp_f<0x4E>(v)); v = fmaxf(v, dpp_f<0x141>(v)); v = fmaxf(v, dpp_f<0x140>(v));
    return v;
}
#endif
__device__ __forceinline__ void stage_peer_topk(KParams p, int l, char* smem) {
    constexpr int KS = 136;
    h16_t* khi = (h16_t*)smem;
    h16_t* klo = khi + 128 * KS;
    float* scr = (float*)(klo + 128 * KS);
    const h16_t* ACT = (const h16_t*)(p->ws + OFF_ACT);
    float* TOPS = (float*)(p->ws + OFF_TOPS);
    int tid = tid_(), lane = tid & 63, w = tid >> 6, g = lane >> 4, r16 = lane & 15;
#define TK_ROLES() do { tid = tid_(); lane = tid & 63; w = tid >> 6; g = lane >> 4; r16 = lane & 15; } while (0)
    const int nb = gridDim.x;
    for (int hs = bid_() % 16; hs < 16; hs += nb) {
        const int hd = hs >> 1, s = hs & 1;
        __syncthreads();
        {
            const float* kp = p->in[I_PKEYS] + (((size_t)l * 8 + hd) * 2 + s) * 128 * 128;
            for (int i = tid * 4; i < 128 * 128; i += NT * 4) {
                const float4 kv = *(const float4*)(kp + i);
                const int n = i >> 7, c0 = i & 127;
                const float h0 = h2f(f2h(kv.x)), h1 = h2f(f2h(kv.y)), h2 = h2f(f2h(kv.z)), h3 = h2f(f2h(kv.w));
                uint2 hw, lw; hw.x = pack2h(kv.x, kv.y); hw.y = pack2h(kv.z, kv.w); lw.x = pack2h(kv.x - h0, kv.y - h1); lw.y = pack2h(kv.z - h2, kv.w - h3);
                *(uint2*)(khi + n * KS + c0) = hw; *(uint2*)(klo + n * KS + c0) = lw;
            }
        }
        __syncthreads();
        const int nblk = nb >= 16 ? nb / 16 : 1, bsub = nb >= 16 ? bid_() / 16 : 0;
        for (int chunk = bsub; chunk < (M_ + NT - 1) / NT; chunk += nblk) {
            if (nb >= 16 && bid_() >= nblk * 16) break;
#pragma unroll 1
            for (int tt = 0; tt < 4; ++tt) {
                TK_ROLES();
                const int tok0 = chunk * NT + w * 64 + tt * 16;
                const bool live = tok0 < M_;
                hfrag af[4];
                {
                    const h16_t* qp = ACT + (size_t)(live ? tok0 + r16 : 0) * LDZ + C_QRY + hd * 256 + s * 128 + 8 * g;
#pragma unroll
                    for (int ks = 0; ks < 4; ++ks) af[ks] = frag_u4(*(const uint4*)(qp + 32 * ks));
                }
                facc acc[8];
#pragma unroll
                for (int nt = 0; nt < 8; ++nt) {
                    acc[nt] = facc_zero();
                    const h16_t* bh = khi + (16 * nt + r16) * KS + 8 * g; const h16_t* bl = klo + (16 * nt + r16) * KS + 8 * g;
#pragma unroll
                    for (int ks = 0; ks < 4; ++ks) { acc[nt] = mfma16(af[ks], frag_u4(*(const uint4*)(bh + 32 * ks)), acc[nt]); acc[nt] = mfma16(af[ks], frag_u4(*(const uint4*)(bl + 32 * ks)), acc[nt]); }
                }
#pragma unroll 1
                for (int rp = 0; rp < 2; ++rp) {
                  TK_ROLES();
#pragma unroll
                  for (int r2 = 0; r2 < 2; ++r2) {
                    const int reg = rp * 2 + r2;
                    float v[8];
#pragma unroll
                    for (int nt = 0; nt < 8; ++nt) { const float av = rp == 0 ? (r2 == 0 ? acc[nt][0] : acc[nt][1]) : (r2 == 0 ? acc[nt][2] : acc[nt][3]); v[nt] = __uint_as_float((__float_as_uint(av) & ~127u) | (unsigned)(127 - (16 * nt + r16))); }
#define CE(i, j) { const float hi_ = fmaxf(v[i], v[j]), lo_ = fminf(v[i], v[j]); v[i] = hi_; v[j] = lo_; }
                    CE(0, 1) CE(2, 3) CE(4, 5) CE(6, 7) CE(0, 2) CE(1, 3) CE(4, 6) CE(5, 7) CE(1, 2) CE(5, 6) CE(0, 4) CE(1, 5) CE(2, 6) CE(3, 7) CE(2, 4) CE(3, 5) CE(1, 2) CE(3, 4) CE(5, 6)
#undef CE
                    float res = 0.f;
#pragma unroll
                    for (int rnd = 0; rnd < 16; ++rnd) {
                        const float m = group_max16(v[0], scr);
                        const bool win = v[0] == m;
#pragma unroll
                        for (int i = 0; i < 7; ++i) v[i] = win ? v[i + 1] : v[i];
                        v[7] = win ? -3.0e38f : v[7];
                        res = (r16 == rnd) ? m : res;
                    }
                    if (live) TOPS[(((size_t)(tok0 + 4 * g + reg) * 8 + hd) * 2 + s) * 16 + r16] = res;
                  }
                }
            }
        }
    }
}

#undef TK_ROLES
__device__ __forceinline__ void peer_cand(int k, int& i, int& j) {
    if (k < 16) { i = 0; j = k; } else if (k < 24) { i = 1; j = k - 16; } else if (k < 29) { i = 2; j = k - 24; } else if (k < 33) { i = 3; j = k - 29; }
    else if (k < 36) { i = 4; j = k - 33; } else if (k < 38) { i = 5; j = k - 36; } else if (k < 40) { i = 6; j = k - 38; } else if (k < 42) { i = 7; j = k - 40; }
    else { i = k - 34; j = 0; }
}
__device__ __forceinline__ float dot16q(const uint4 a, const float (&x)[16]) {
    float t[4], s0, s1;
    dec4fp8(a.x, t); s0 = t[0] * x[0] + t[1] * x[1]; s1 = t[2] * x[2] + t[3] * x[3];
    dec4fp8(a.y, t); s0 += t[0] * x[4] + t[1] * x[5]; s1 += t[2] * x[6] + t[3] * x[7];
    dec4fp8(a.z, t); s0 += t[0] * x[8] + t[1] * x[9]; s1 += t[2] * x[10] + t[3] * x[11];
    dec4fp8(a.w, t); s0 += t[0] * x[12] + t[1] * x[13]; s1 += t[2] * x[14] + t[3] * x[15];
    return s0 + s1;
}
__device__ __forceinline__ void axpy16q(const uint4 a, float s, float (&y)[16]) {
    float t[4];
    dec4fp8(a.x, t); y[0] += s * t[0]; y[1] += s * t[1]; y[2] += s * t[2]; y[3] += s * t[3];
    dec4fp8(a.y, t); y[4] += s * t[0]; y[5] += s * t[1]; y[6] += s * t[2]; y[7] += s * t[3];
    dec4fp8(a.z, t); y[8] += s * t[0]; y[9] += s * t[1]; y[10] += s * t[2]; y[11] += s * t[3];
    dec4fp8(a.w, t); y[12] += s * t[0]; y[13] += s * t[1]; y[14] += s * t[2]; y[15] += s * t[3];
}
#ifdef CPU_EMU
__device__ __forceinline__ float lane_xor(float v, int mask, float* scr) { const int tid = tid_(); scr[tid] = v; __syncthreads(); const float r = scr[tid ^ mask]; __syncthreads(); return r; }
__device__ __forceinline__ float lane_bcast(float v, int src, float* scr) { const int tid = tid_(); scr[tid] = v; __syncthreads(); const float r = scr[(tid & ~63) + src]; __syncthreads(); return r; }
#else
__device__ __forceinline__ float lane_xor(float v, int mask, float*) { return mask == 1 ? dpp_f<0xB1>(v) : (mask == 2 ? dpp_f<0x4E>(v) : __shfl_xor(v, mask)); }
__device__ __forceinline__ float lane_bcast(float v, int src, float*) { return __builtin_bit_cast(float, __builtin_amdgcn_readlane(__builtin_bit_cast(int, v), src)); }
#endif
__device__ __forceinline__ float reduce8(const float (&v)[8], int lane, float* scr) {
    const bool b0 = lane & 1, b1 = lane & 2, b2 = lane & 4;
    float w4[4], u2[2];
#pragma unroll
    for (int j = 0; j < 4; ++j) { const float keep = b0 ? v[2 * j + 1] : v[2 * j], send = b0 ? v[2 * j] : v[2 * j + 1]; w4[j] = keep + lane_xor(send, 1, scr); }
#pragma unroll
    for (int j = 0; j < 2; ++j) { const float keep = b1 ? w4[2 * j + 1] : w4[2 * j], send = b1 ? w4[2 * j] : w4[2 * j + 1]; u2[j] = keep + lane_xor(send, 2, scr); }
    float z = (b2 ? u2[1] : u2[0]) + lane_xor(b2 ? u2[0] : u2[1], 4, scr);
    z += lane_xor(z, 8, scr); z += lane_xor(z, 16, scr); z += lane_xor(z, 32, scr);
    return z;
}
#ifdef CPU_EMU
#define PG_WSYNC() __syncthreads()
#else
#define PG_WSYNC() do { __builtin_amdgcn_fence(__ATOMIC_RELEASE, "wavefront"); __builtin_amdgcn_wave_barrier(); __builtin_amdgcn_fence(__ATOMIC_ACQUIRE, "wavefront"); } while (0)
#endif
__device__ __forceinline__ void stage_peer_gather(KParams p, int l, char* smem) {
    int tid = tid_(), w = tid >> 6, lane = tid & 63;
    float* base; float* tops_s; float* cand_s; float* best_s; int* idx_s; float* gate_s; int* pos_s;
#define PG_ROLES() do { tid = tid_(); w = tid >> 6; lane = tid & 63; base = (float*)smem + w * 2048; tops_s = base; cand_s = tops_s + 256; best_s = cand_s + 64; \
        idx_s = (int*)(best_s + 128); gate_s = (float*)(idx_s + 128); pos_s = (int*)(gate_s + 128); } while (0)
    PG_ROLES();
    float* scr = (float*)smem + 8 * 2048;
    h16_t* ACT = (h16_t*)(p->ws + OFF_ACT);
    const float* TOPS = (const float*)(p->ws + OFF_TOPS);
    char* ws = p->ws;
    const float* nxt_w = (l + 1 < NL_) ? p->in[I_NMIX] + (l + 1) * 1024 : p->in[I_NFINAL];
    const int nwaves = gridDim.x * 8;
    for (int m = bid_() * 8 + w; m < M_; m += nwaves) {
        PG_ROLES();
        PG_WSYNC();
        *(float4*)(tops_s + lane * 4) = *(const float4*)(TOPS + (size_t)m * 256 + lane * 4);
        float x[16];
        { float t8[8]; load8h(ACT + (size_t)m * LDZ + C_XN + lane * 16, t8);
#pragma unroll
          for (int j = 0; j < 8; ++j) x[j] = t8[j];
          load8h(ACT + (size_t)m * LDZ + C_XN + lane * 16 + 8, t8);
#pragma unroll
          for (int j = 0; j < 8; ++j) x[8 + j] = t8[j]; }
        PG_WSYNC();
        int ci = 0, cj = 0;
        if (lane < 50) peer_cand(lane, ci, cj);
        const int pos = ci * 16 + cj;
        pos_s[lane] = pos;
#pragma unroll 1
        for (int hd = 0; hd < 8; ++hd) {
            const float cs = lane < 50 ? tops_s[hd * 32 + ci] + tops_s[hd * 32 + 16 + cj] : -3.0e38f;
            cand_s[lane] = cs;
            PG_WSYNC();
            if (lane < 50) {
                int cnt = 0;
#pragma unroll 10
                for (int o = 0; o < 50; ++o) { const float ov = cand_s[o]; cnt += (ov > cs || (ov == cs && pos_s[o] < pos)) ? 1 : 0; }
                if (cnt < 16) {
                    best_s[hd * 16 + cnt] = cs;
                    const int n0 = 127 - (int)(__float_as_uint(tops_s[hd * 32 + ci]) & 127u), n1 = 127 - (int)(__float_as_uint(tops_s[hd * 32 + 16 + cj]) & 127u);
                    idx_s[hd * 16 + cnt] = n0 * 128 + n1;
                }
            }
            PG_WSYNC();
        }
#pragma unroll
        for (int rr = 0; rr < 2; ++rr) {
            const int e = lane + 64 * rr, hd = e >> 4;
            const float mx = best_s[hd * 16];
            float sum = 0.f;
#pragma unroll
            for (int i = 0; i < 16; ++i) sum += fexp_(best_s[hd * 16 + i] - mx);
            gate_s[e] = fexp_(best_s[e] - mx) / sum;
        }
        PG_WSYNC();
        float y[16];
#pragma unroll
        for (int i = 0; i < 16; ++i) y[i] = 0.f;
        PG_ROLES();
        uint4 uu[8], vv[8];
#define PG_LOADU(eb_) do { _Pragma("unroll") for (int k = 0; k < 8; ++k) uu[k] = *(const uint4*)(tab_row(ws, idx_s[(eb_) + k]) + lane * 16); } while (0)
#define PG_LOADV(eb_) do { _Pragma("unroll") for (int k = 0; k < 8; ++k) vv[k] = *(const uint4*)(tab_row(ws, idx_s[(eb_) + k]) + 1024 + lane * 16); } while (0)
        PG_LOADU(0); PG_LOADV(0);
#pragma unroll 1
        for (int eb = 0; eb < 128; eb += 8) {
            float d8[8];
#pragma unroll
            for (int k = 0; k < 8; ++k) d8[k] = dot16q(uu[k], x);
            if (eb + 8 < 128) PG_LOADU(eb + 8);
            const float tot = reduce8(d8, lane, scr);
            const float hk = gate_s[eb + (lane & 7)] * geluf_(tot * (1.0f / TAB_SU));
#pragma unroll
            for (int k = 0; k < 8; ++k) axpy16q(vv[k], lane_bcast(hk, k, scr), y);
            if (eb + 8 < 128) PG_LOADV(eb + 8);
        }
#undef PG_LOADU
#undef PG_LOADV
        PG_ROLES();
        float* op = p->out + (size_t)m * 1024 + lane * 16;
        float hn[16]; float ss = 0.f;
#pragma unroll
        for (int i = 0; i < 16; i += 4) {
            const float4 o4 = *(const float4*)(op + i);
            hn[i] = o4.x + y[i] * (1.0f / TAB_SV); hn[i + 1] = o4.y + y[i + 1] * (1.0f / TAB_SV); hn[i + 2] = o4.z + y[i + 2] * (1.0f / TAB_SV); hn[i + 3] = o4.w + y[i + 3] * (1.0f / TAB_SV);
            ss += hn[i] * hn[i] + hn[i + 1] * hn[i + 1] + hn[i + 2] * hn[i + 2] + hn[i + 3] * hn[i + 3];
        }
        ss = group_sum(ss, 64, scr);
        const float rstd = rsqrtf(ss * (1.0f / D_) + RMS_EPS);
        float nv[16];
#pragma unroll
        for (int i = 0; i < 16; i += 4) { const float4 w4 = *(const float4*)(nxt_w + lane * 16 + i); nv[i] = hn[i] * rstd * w4.x; nv[i + 1] = hn[i + 1] * rstd * w4.y; nv[i + 2] = hn[i + 2] * rstd * w4.z; nv[i + 3] = hn[i + 3] * rstd * w4.w; }
        if (l + 1 < NL_) {
#pragma unroll
            for (int i = 0; i < 16; i += 4) *(float4*)(op + i) = make_float4(hn[i], hn[i + 1], hn[i + 2], hn[i + 3]);
            const float n0[8] = {nv[0], nv[1], nv[2], nv[3], nv[4], nv[5], nv[6], nv[7]}, n1[8] = {nv[8], nv[9], nv[10], nv[11], nv[12], nv[13], nv[14], nv[15]};
            store8h(ACT + (size_t)m * LDZ + C_XN + lane * 16, n0); store8h(ACT + (size_t)m * LDZ + C_XN + lane * 16 + 8, n1);
        } else {
#pragma unroll
            for (int i = 0; i < 16; i += 4) *(float4*)(op + i) = make_float4(nv[i], nv[i + 1], nv[i + 2], nv[i + 3]);
        }
    }
}
#undef PG_ROLES
#undef PG_WSYNC

enum { PH_NORM_MIX = 0, PH_INPROJ, PH_MIXERS, PH_MERGE, PH_WOUT, PH_NORM_FFN, PH_QUERY, PH_TOPK, PH_GATHER, PH_PER_LAYER, PH_FINAL = 100, PH_WPREP = 101 };
__device__ __forceinline__ void run_phase(KParams p, int l, int ph, char* smem) {
    h16_t* ACT = (h16_t*)(p->ws + OFF_ACT);
    const float* hin = l == 0 ? p->in[I_X] : p->out;
    switch (ph) {
    case PH_WPREP: stage_wprep(p, smem); break;
    case PH_NORM_MIX: if (l == 0) stage_rmsnorm(hin, p->in[I_NMIX] + l * 1024, ACT + C_XN, LDZ, smem); break;
    case PH_INPROJ: stage_gemm(p, l, GP_INPROJ, smem); break;
    case PH_MIXERS: {
        const int nb = gridDim.x, n_rw = nb / 2, n_gd = nb / 4, n_lr = nb - n_rw - n_gd;
        stage_rwkv(p, l, smem, 0, n_rw);
        stage_gdn(p, l, smem, n_rw, n_gd);
        stage_lru(p, l, smem, n_rw + n_gd, n_lr);
    } break;
    case PH_MERGE: stage_gemm(p, l, GP_MERGE, smem); break;
    case PH_WOUT: stage_gemm(p, l, GP_WOUT, smem); break;
    case PH_NORM_FFN: stage_rmsnorm(p->out, p->in[I_NFFN] + l * 1024, ACT + C_XN, LDZ, smem); stage_tabconv(p, l); break;
    case PH_QUERY: stage_gemm(p, l, GP_QUERY, smem); break;
    case PH_TOPK: stage_peer_topk(p, l, smem); break;
    case PH_GATHER: stage_peer_gather(p, l, smem); break;
    case PH_FINAL: break;
    default: break;
    }
}


#if !defined(CPU_EMU) && !MK_MULTI
#define XB_TMO      128
#define XB_XCNT(j)  (256  + 64 * (j))
#define XB_XSUB(j)  (1280 + 64 * (j))
#define XB_XGEN(j)  (2304 + 64 * (j))
#define XB_TOP      3328
#define XB_TOPGEN   3392
#define XCD_BAR_WORDS 3456
#define XB_SPIN_CAP (1u << 22)
#define XB_LAS __attribute__((address_space(3)))
__device__ __forceinline__ unsigned xb_ld(unsigned* p)              { return __hip_atomic_load(p, __ATOMIC_RELAXED, __HIP_MEMORY_SCOPE_AGENT); }
__device__ __forceinline__ unsigned xb_add(unsigned* p, unsigned v) { return __hip_atomic_fetch_add(p, v, __ATOMIC_RELAXED, __HIP_MEMORY_SCOPE_AGENT); }
__device__ __forceinline__ unsigned xb_xcc_id() { return (unsigned)__builtin_amdgcn_s_getreg((3 << 11) | 20) & 0xFu; }
#define XB_SPIN(cond, bar) do { unsigned _sp = 0; while (cond) { __builtin_amdgcn_s_sleep(1); \
    if ((++_sp & 255u) == 0u) { if (xb_ld(&(bar)[XB_TMO])) break; if (_sp > XB_SPIN_CAP) { atomicAdd(&(bar)[XB_TMO], 1u); break; } } } } while (0)
struct XcdBarrier { unsigned* bar; unsigned x; volatile XB_LAS unsigned* st; };
__device__ __forceinline__ XcdBarrier xcd_barrier_post(unsigned* bar, volatile XB_LAS unsigned* st) {
    XcdBarrier b; b.bar = bar; b.x = xb_xcc_id(); b.st = st;
    if (threadIdx.x == 0) (void)xb_add(&bar[XB_XCNT(b.x)], 1u);
    return b;
}
__device__ __forceinline__ void xcd_barrier_complete(unsigned* bar, unsigned x, unsigned& nloc, unsigned& nx) {
    const unsigned G = gridDim.x * gridDim.y * gridDim.z;
    unsigned sum, cnt, mine, sp = 0u;
    for (;;) {
        sum = 0u; cnt = 0u; mine = 0u;
#pragma unroll
        for (unsigned j = 0; j < 16; ++j) { const unsigned c = xb_ld(&bar[XB_XCNT(j)]); sum += c; cnt += (c > 0u) ? 1u : 0u; mine = (j == x) ? c : mine; }
        if (sum == G) break;
        __builtin_amdgcn_s_sleep(1);
        if ((++sp & 255u) == 0u) { if (xb_ld(&bar[XB_TMO])) break; if (sp > XB_SPIN_CAP) { atomicAdd(&bar[XB_TMO], 1u); break; } }
    }
    nloc = mine > 0u ? mine : 1u; nx = cnt > 0u ? cnt : 1u;
}
__device__ __forceinline__ void xcd_barrier(const XcdBarrier& b) {
    asm volatile("s_waitcnt vmcnt(0)" ::: "memory");
    __syncthreads();
    if (threadIdx.x == 0) {
        unsigned* bar = b.bar;
        __builtin_amdgcn_s_waitcnt(0);
        unsigned nloc = b.st[0], nx = b.st[1];
        if (nloc == 0u) { xcd_barrier_complete(bar, b.x, nloc, nx); b.st[0] = nloc; b.st[1] = nx; }
        const unsigned old = xb_add(&bar[XB_XSUB(b.x)], 1u);
        const unsigned gen = old / nloc;
        if (old + 1u == (gen + 1u) * nloc) {
            __builtin_amdgcn_fence(__ATOMIC_RELEASE, "agent");
            asm volatile("s_waitcnt vmcnt(0)" ::: "memory");
            const unsigned og = xb_add(&bar[XB_TOP], 1u);
            const unsigned tg = og / nx;
            if (og + 1u == (tg + 1u) * nx) xb_add(&bar[XB_TOPGEN], 1u);
            else XB_SPIN(xb_ld(&bar[XB_TOPGEN]) == tg, bar);
            __builtin_amdgcn_fence(__ATOMIC_ACQUIRE, "agent");
            xb_add(&bar[XB_XGEN(b.x)], 1u);
            asm volatile("s_waitcnt vmcnt(0)" ::: "memory");
        } else {
            XB_SPIN(xb_ld(&bar[XB_XGEN(b.x)]) == gen, bar);
            __builtin_amdgcn_fence(__ATOMIC_ACQUIRE, "agent");
            asm volatile("s_waitcnt vmcnt(0)" ::: "memory");
        }
    }
    __syncthreads();
}
#endif
#if !defined(CPU_EMU) && !MK_MULTI
__global__ void __launch_bounds__(512, 2) k_mega(Params p_) {
    DYN_SMEM(smem);
    KParams pk = (KParams)__builtin_amdgcn_kernarg_segment_ptr();
    cg::grid_group grid = cg::this_grid();
    volatile XB_LAS unsigned* xst = (volatile XB_LAS unsigned*)(XB_LAS char*)(smem + SMEM_BYTES);
    if (threadIdx.x == 0) { xst[0] = 0u; xst[1] = 0u; xst[2] = 0u; xst[3] = 0u; }
    __syncthreads();
    const XcdBarrier xb = xcd_barrier_post((unsigned*)(pk->ws + OFF_BAR), xst);
    if (gridDim.x > 0x100000u) grid.sync();
    constexpr int NIT = NL_ * PH_PER_LAYER;
#pragma unroll 1
    for (int it = -1; it <= NIT; ++it) {
        const int l = (it >= 0 && it < NIT) ? it / PH_PER_LAYER : 0, ph = it < 0 ? (int)PH_WPREP : (it < NIT ? it % PH_PER_LAYER : (int)PH_FINAL);
        KParams q = pk; asm volatile("" : "+s"(q));
        run_phase(q, l, ph, smem);
        if (it >= 0 && it < NIT - 1 && !(l > 0 && ph == PH_NORM_MIX)) {
            xcd_barrier(xb);
        }
    }
}
#endif
#ifdef CPU_EMU
__global__ void k_phase(Params p_, int l, int ph) { DYN_SMEM(smem); run_phase(&p_, l, ph, smem); }
#elif MK_MULTI
__global__ void __launch_bounds__(512, 2) k_phase(Params p_, int l, int ph) { DYN_SMEM(smem); KParams pk = (KParams)__builtin_amdgcn_kernarg_segment_ptr(); run_phase(pk, l, ph, smem); }
#endif
}

#ifdef CPU_EMU
int g_emu_stop = 1000;
#endif

extern "C" void kernel_launch(void* const* d_in, const int* in_sizes, int n_in, void* d_out, int out_size, void* d_ws, size_t ws_size, hipStream_t stream) {
    Params p{};
    for (int i = 0; i < N_IN; ++i) p.in[i] = (const float*)d_in[i];
    p.out = (float*)d_out; p.ws = (char*)d_ws;
#if defined(CPU_EMU) || MK_MULTI
    const int grid = 256;
    LAUNCH(k_phase, grid, NT, SMEM_BYTES, stream, p, 0, (int)PH_WPREP);
    for (int l = 0; l < NL_; ++l)
        for (int ph = 0; ph < PH_PER_LAYER; ++ph) {
            LAUNCH(k_phase, grid, NT, SMEM_BYTES, stream, p, l, ph);
#ifdef CPU_EMU
            const int code = ph == PH_INPROJ ? 1 : ph == PH_MIXERS ? 2 : ph == PH_MERGE ? 3 : ph == PH_WOUT ? 4 : ph == PH_GATHER ? 5 : 0;
            if (code && g_emu_stop == l * 10 + code) return;
#endif
        }
    LAUNCH(k_phase, grid, NT, SMEM_BYTES, stream, p, 0, (int)PH_FINAL);
#else
    static int grid_blocks = 0;
    if (!grid_blocks) {
        int dev = 0, cus = 0, per_cu = 0;
        (void)hipGetDevice(&dev);
        (void)hipDeviceGetAttribute(&cus, hipDeviceAttributeMultiprocessorCount, dev);
        (void)hipFuncSetAttribute((const void*)k_mega, hipFuncAttributeMaxDynamicSharedMemorySize, (int)SMEM_BYTES + 16);
        (void)hipOccupancyMaxActiveBlocksPerMultiprocessor(&per_cu, k_mega, NT, SMEM_BYTES + 16);
        if (per_cu > 1) per_cu = 1;
        grid_blocks = cus * per_cu;
    }
    (void)hipMemsetAsync((char*)d_ws + OFF_BAR, 0, 16384, stream);
    void* args[] = {&p};
    hipError_t e = hipLaunchCooperativeKernel((void*)k_mega, dim3(grid_blocks), dim3(NT), args, SMEM_BYTES + 16, stream);
    if (e != hipSuccess) fprintf(stderr, "cooperative launch failed: %s (grid %d)\n", hipGetErrorString(e), grid_blocks);
#endif
}
```

```cpp
#ifndef CPU_EMU
#include <hip/hip_runtime.h>
#include <hip/hip_cooperative_groups.h>
#include <cstdio>
#include <cstdint>
namespace cg = cooperative_groups;
#define DYN_SMEM(name) extern __shared__ __attribute__((aligned(16))) char name[]
#define LAUNCH(kern, grid, block, smem, stream, ...) hipLaunchKernelGGL(kern, dim3(grid), dim3(block), smem, stream, __VA_ARGS__)
#endif

#ifndef CFG_B
#define CFG_B 8
#endif
#ifndef CFG_T
#define CFG_T 2048
#endif
#ifndef MK_MULTI
#define MK_MULTI 0
#endif

namespace {
constexpr int B_ = CFG_B, T_ = CFG_T, M_ = B_ * T_, D_ = 1024, NL_ = 2, NT = 512;
constexpr int INW = 12560;
constexpr int LDZ = 11776;
constexpr int Z_ULRU = 0, Z_GLRU = 1024, Z_Q = 2048, Z_K = 3072, Z_V = 4096, Z_ZG = 5120, Z_RW = 6144, Z_ALPHA = 9472, Z_BETA = 9480;
constexpr int ZN = 9728;
constexpr int C_XN = 9728, C_YC = 10752;
constexpr int C_YA = Z_GLRU, C_YB = Z_ZG;
constexpr int C_GS = Z_Q, C_MG = Z_K;
constexpr int C_QRY = 0;
constexpr int RW_R = 0, RW_K = 1024, RW_V = 2048, RW_WL = 3072, RW_AL = 3136, RW_GL = 3200, RWW = 3328;
constexpr float RMS_EPS = 1e-6f, GN_EPS = 64e-5f;
typedef unsigned short h16_t;

enum { I_X = 0, I_NMIX, I_NFFN, I_NFINAL, I_WIN, I_LCW, I_LCB, I_LWA, I_LBA, I_LWX, I_LBX, I_LLAM, I_GCW, I_GALOG, I_GDT, I_GNW,
       I_RMU, I_RW0, I_RWUP, I_RA0, I_RAUP, I_RGUP, I_RKK, I_RKA, I_RRK, I_RLW, I_RLB, I_MB, I_PL, I_PG, I_PR, I_WOUT, I_PWQ, I_PKEYS, I_PU, I_PV, N_IN };

struct Params {
    const float* in[N_IN];
    float* out;
    char* ws;
};
#ifdef CPU_EMU
typedef const Params* KParams;
#else
typedef const Params __attribute__((address_space(4)))* KParams;
#endif

constexpr size_t al256(size_t x) { return (x + 255) / 256 * 256; }
constexpr size_t OFF_ACT = 0;
constexpr size_t OFF_WT = al256(OFF_ACT + (size_t)M_ * LDZ * 2);
constexpr int WT_IN = 0, WT_MG = ZN, WT_P = WT_MG + 3072, WT_OUT = WT_P + 3072, WT_Q = WT_OUT + 1024, WT_ROWS = WT_Q + 2048;
constexpr size_t OFF_TOPS = al256(OFF_WT + (size_t)NL_ * WT_ROWS * 1024 * 2);
constexpr size_t OFF_TAB = al256(OFF_TOPS + (size_t)M_ * 256 * 4);
constexpr size_t OFF_BAR = OFF_TAB + (size_t)16384 * 2048;
constexpr size_t WS_END = OFF_BAR + 16384;
static_assert(CFG_B != 8 || CFG_T != 2048 || WS_END <= (size_t)512 * 1024 * 1024, "workspace budget");
constexpr size_t SMEM_BYTES = 128 * 1024;

#ifdef CPU_EMU
__device__ __forceinline__ int tid_() { return threadIdx.x; }
__device__ __forceinline__ h16_t f2h(float f) { return (h16_t)_cvtss_sh(f, _MM_FROUND_TO_NEAREST_INT); }
__device__ __forceinline__ float h2f(h16_t h) { return _cvtsh_ss(h); }
#else
__device__ __forceinline__ int tid_() { int t = threadIdx.x; asm volatile("" : "+v"(t)); return t; }
__device__ __forceinline__ h16_t f2h(float f) { return __builtin_bit_cast(unsigned short, (_Float16)f); }
__device__ __forceinline__ float h2f(h16_t h) { return (float)__builtin_bit_cast(_Float16, h); }
#endif
__device__ __forceinline__ int bid_() { return (int)blockIdx.x; }

#ifdef CPU_EMU
__device__ __forceinline__ float fexp_(float x) { return expf(x); }
__device__ __forceinline__ float flog_(float x) { return logf(x); }
__device__ __forceinline__ float frcp_(float x) { return 1.0f / x; }
#else
__device__ __forceinline__ float fexp_(float x) { return __builtin_amdgcn_exp2f(x * 1.4426950408889634f); }
__device__ __forceinline__ float flog_(float x) { return __builtin_amdgcn_logf(x) * 0.6931471805599453f; }
__device__ __forceinline__ float frcp_(float x) { return __builtin_amdgcn_rcpf(x); }
#endif
__device__ __forceinline__ float sigmoidf_(float x) { return frcp_(1.0f + fexp_(-x)); }
__device__ __forceinline__ float softplusf_(float x) { return fmaxf(x, 0.0f) + flog_(1.0f + fexp_(-fabsf(x))); }
__device__ __forceinline__ float siluf_(float x) { return x * sigmoidf_(x); }
__device__ __forceinline__ float tanhf_(float x) { return 1.0f - 2.0f * frcp_(1.0f + fexp_(2.0f * x)); }
__device__ __forceinline__ float geluf_(float x) { return x * frcp_(1.0f + fexp_(-1.5957691216057308f * (x + 0.044715f * x * x * x))); }
__device__ __forceinline__ unsigned pack2h(float a, float b) { return (unsigned)f2h(a) | ((unsigned)f2h(b) << 16); }
__device__ __forceinline__ void store8h(h16_t* p, const float (&v)[8]) {
    uint4 w; w.x = pack2h(v[0], v[1]); w.y = pack2h(v[2], v[3]); w.z = pack2h(v[4], v[5]); w.w = pack2h(v[6], v[7]);
    *(uint4*)p = w;
}
__device__ __forceinline__ void load8h(const h16_t* p, float (&v)[8]) {
    const uint4 w = *(const uint4*)p;
    v[0] = h2f((h16_t)(w.x & 0xffffu)); v[1] = h2f((h16_t)(w.x >> 16)); v[2] = h2f((h16_t)(w.y & 0xffffu)); v[3] = h2f((h16_t)(w.y >> 16));
    v[4] = h2f((h16_t)(w.z & 0xffffu)); v[5] = h2f((h16_t)(w.z >> 16)); v[6] = h2f((h16_t)(w.w & 0xffffu)); v[7] = h2f((h16_t)(w.w >> 16));
}

__device__ __forceinline__ float block_sum512(float v, float* red) {
    const int tid = tid_();
    red[tid] = v;
    __syncthreads();
    if (tid < 32) { float s = 0.f; for (int i = 0; i < 16; ++i) s += red[tid * 16 + i]; red[512 + tid] = s; }
    __syncthreads();
    float tot = 0.f;
    for (int i = 0; i < 32; ++i) tot += red[512 + i];
    __syncthreads();
    return tot;
}

#ifdef CPU_EMU
__device__ __forceinline__ float wave_sum64(float v, float* scr) {
    const int tid = tid_();
    scr[tid] = v; __syncthreads();
    float s = 0.f; const int base = tid & ~63;
    for (int i = 0; i < 64; ++i) s += scr[base + i];
    __syncthreads();
    return s;
}
#else
__device__ __forceinline__ float wave_sum64(float v, float*) {
    v += __builtin_bit_cast(float, __builtin_amdgcn_mov_dpp(__builtin_bit_cast(int, v), 0xB1, 0xf, 0xf, true));
    v += __builtin_bit_cast(float, __builtin_amdgcn_mov_dpp(__builtin_bit_cast(int, v), 0x4E, 0xf, 0xf, true));
    v += __builtin_bit_cast(float, __builtin_amdgcn_mov_dpp(__builtin_bit_cast(int, v), 0x141, 0xf, 0xf, true));
    v += __builtin_bit_cast(float, __builtin_amdgcn_mov_dpp(__builtin_bit_cast(int, v), 0x140, 0xf, 0xf, true));
    v += __builtin_bit_cast(float, __builtin_amdgcn_update_dpp(0, __builtin_bit_cast(int, v), 0x142, 0xa, 0xf, false));
    v += __builtin_bit_cast(float, __builtin_amdgcn_update_dpp(0, __builtin_bit_cast(int, v), 0x143, 0xc, 0xf, false));
    return __builtin_bit_cast(float, __builtin_amdgcn_readlane(__builtin_bit_cast(int, v), 63));
}
#endif
__device__ __forceinline__ void stage_rmsnorm(const float* src, const float* w, h16_t* dst, int ldd, char* smem) {
    float* scr = (float*)smem;
    const int tid = tid_(), lane = tid & 63, wv = tid >> 6;
    const int nw = gridDim.x * 8;
    float4 wv4[4];
#pragma unroll
    for (int i = 0; i < 4; ++i) wv4[i] = *(const float4*)(w + lane * 16 + i * 4);
    for (int row = bid_() * 8 + wv; row < M_; row += 2 * nw) {
        const int row2 = row + nw; const bool has2 = row2 < M_;
        float4 a[4], b[4];
#pragma unroll
        for (int i = 0; i < 4; ++i) { a[i] = *(const float4*)(src + (size_t)row * D_ + lane * 16 + i * 4); b[i] = has2 ? *(const float4*)(src + (size_t)row2 * D_ + lane * 16 + i * 4) : make_float4(0.f, 0.f, 0.f, 0.f); }
        float sa = 0.f, sb = 0.f;
#pragma unroll
        for (int i = 0; i < 4; ++i) { sa += a[i].x * a[i].x + a[i].y * a[i].y + a[i].z * a[i].z + a[i].w * a[i].w; sb += b[i].x * b[i].x + b[i].y * b[i].y + b[i].z * b[i].z + b[i].w * b[i].w; }
        sa = wave_sum64(sa, scr); sb = wave_sum64(sb, scr);
        const float ra = rsqrtf(sa * (1.0f / D_) + RMS_EPS), rb = rsqrtf(sb * (1.0f / D_) + RMS_EPS);
#pragma unroll
        for (int i = 0; i < 4; i += 2) {
            const float va[8] = {a[i].x * ra * wv4[i].x, a[i].y * ra * wv4[i].y, a[i].z * ra * wv4[i].z, a[i].w * ra * wv4[i].w, a[i + 1].x * ra * wv4[i + 1].x, a[i + 1].y * ra * wv4[i + 1].y, a[i + 1].z * ra * wv4[i + 1].z, a[i + 1].w * ra * wv4[i + 1].w};
            store8h(dst + (size_t)row * ldd + lane * 16 + i * 4, va);
            if (has2) {
                const float vb[8] = {b[i].x * rb * wv4[i].x, b[i].y * rb * wv4[i].y, b[i].z * rb * wv4[i].z, b[i].w * rb * wv4[i].w, b[i + 1].x * rb * wv4[i + 1].x, b[i + 1].y * rb * wv4[i + 1].y, b[i + 1].z * rb * wv4[i + 1].z, b[i + 1].w * rb * wv4[i + 1].w};
                store8h(dst + (size_t)row2 * ldd + lane * 16 + i * 4, vb);
            }
        }
    }
}

__device__ __forceinline__ const float* wt_src(KParams p, int l, int r, int& ld) {
    if (r < ZN) {
        ld = INW;
        int c;
        if (r < 6144) c = r; else if (r < 9472) c = r + 16; else if (r < 9488) c = r - 3328; else return nullptr;
        return p->in[I_WIN] + (size_t)l * 1024 * INW + c;
    }
    r -= ZN;
    if (r < 3072) { ld = INW; return p->in[I_WIN] + (size_t)l * 1024 * INW + 9488 + r; }
    r -= 3072;
    if (r < 3072) { ld = 1024; const int br = r >> 10; return p->in[br == 0 ? I_PL : (br == 1 ? I_PG : I_PR)] + (size_t)l * 1024 * 1024 + (r & 1023); }
    r -= 3072;
    if (r < 1024) { ld = 1024; return p->in[I_WOUT] + (size_t)l * 1024 * 1024 + r; }
    r -= 1024;
    ld = 2048; return p->in[I_PWQ] + (size_t)l * 1024 * 2048 + r;
}
__device__ __forceinline__ void stage_wprep(KParams p, char* smem) {
    float* tile = (float*)smem;
    h16_t* WT = (h16_t*)(p->ws + OFF_WT);
    const int tid = tid_();
    const int ntr = WT_ROWS / 64, total = NL_ * ntr * 16;
    for (int it = bid_(); it < total; it += gridDim.x) {
        const int l = it / (ntr * 16), rem = it % (ntr * 16), rt = rem / 16, kt = rem % 16;
        const int r0 = rt * 64, k0 = kt * 64;
        __syncthreads();
        {
            const int nn = tid & 63;
            int ld = 0; const float* src = wt_src(p, l, r0 + nn, ld);
#pragma unroll
            for (int i = 0; i < 8; ++i) { const int kk = (tid >> 6) + 8 * i; tile[kk * 65 + nn] = src ? src[(size_t)(k0 + kk) * ld] : 0.f; }
        }
        __syncthreads();
        {
            const int r = tid >> 3, kq = (tid & 7) * 8;
            float v[8];
#pragma unroll
            for (int j = 0; j < 8; ++j) v[j] = tile[(kq + j) * 65 + r];
            store8h(WT + ((size_t)l * WT_ROWS + r0 + r) * 1024 + k0 + kq, v);
        }
    }
}

namespace pg8 {
constexpr int BM = 256, BK = 64, HALF = 128, HTB = HALF * BK * 2, STAGE_BYTES = 8 * HTB, NXCD = 8, WGM = 8;
struct Unit { const char* A; const char* B; int pm, pn, kind; };
#ifdef CPU_EMU
struct f32x4 { float d[4]; float& operator[](int i) { return d[i]; } const float& operator[](int i) const { return d[i]; } };
#else
#define PG8_LAS __attribute__((address_space(3)))
typedef _Float16 f16x8 __attribute__((ext_vector_type(8)));
typedef float f32x4 __attribute__((ext_vector_type(4)));
__device__ __forceinline__ int lds_byte(int r, int c) { const int st = (r >> 4) * 2 + (c >> 5), rr = r & 15, cc = c & 31, ob = rr * 64 + cc * 2; return st * 1024 + (ob ^ (((ob >> 9) & 1) << 5)); }
__device__ __forceinline__ void stage_rc(int b, int& R, int& C) { const int st = b / 1024, sb = b % 1024, swz = sb ^ (((sb >> 9) & 1) << 5); R = (st >> 1) * 16 + swz / 64; C = (st & 1) * 32 + (swz % 64) / 2; }
__device__ __forceinline__ int perm32(int rho) { const int n = rho >> 4, i = rho & 15; return 8 * (i >> 2) + 4 * n + (i & 3); }
#endif
__device__ __forceinline__ void tile_of(int L, int nM, int nN, int& pm, int& pn) {
    const int nwg = nM * nN;
    int wgid = L; { const int q = nwg / NXCD, r = nwg % NXCD, xcd = wgid % NXCD, off = wgid / NXCD; wgid = (xcd < r ? xcd * (q + 1) : r * (q + 1) + (xcd - r) * q) + off; }
    const int nig = WGM * nN, gid = wgid / nig, fm = gid * WGM, gsz = (nM - fm) < WGM ? (nM - fm) : WGM;
    pm = fm + ((wgid % nig) % gsz); pn = (wgid % nig) / gsz;
}

template <class Sched, class Epi>
__device__ __forceinline__ void gemm_phase(char* smem, const Sched& S, const Epi& E) {
    constexpr int K = 1024, nt = K / BK;
    constexpr unsigned lda = LDZ, ldb = 1024;
#ifdef CPU_EMU
    const int tid = tid_(), wid = tid >> 6, lane = tid & 63, wr = wid >> 2, wc = wid & 3, fr = lane & 15, fq = lane >> 4;
    Unit u;
    for (int ui = 0; S.next(ui, u); ++ui) {
        f32x4 acc[2][2][4][2];
        for (int ai = 0; ai < 2; ++ai) for (int bj = 0; bj < 2; ++bj) for (int m = 0; m < 4; ++m) for (int n = 0; n < 2; ++n) for (int e = 0; e < 4; ++e) {
            const int r = 128 * ai + 64 * wr + 16 * m + fr, c = 128 * bj + 32 * wc + 8 * fq + 4 * n + e;
            const h16_t* a = (const h16_t*)u.A + (size_t)r * lda; const h16_t* b = (const h16_t*)u.B + (size_t)c * ldb;
            float s = 0.f;
            for (int k = 0; k < K; ++k) s += h2f(a[k]) * h2f(b[k]);
            acc[ai][bj][m][n][e] = s;
        }
        E(acc, u, wr, wc, fr, fq);
    }
    (void)smem; (void)nt;
#else
    PG8_LAS unsigned char* lds = (PG8_LAS unsigned char*)smem;
    const int tid = tid_(), wid = __builtin_amdgcn_readfirstlane(tid >> 6), lane = tid & 63, wr = wid >> 2, wc = wid & 3, fr = lane & 15, fq = lane >> 4;
    unsigned voffA[2], voffB[2];
#pragma unroll
    for (int i = 0; i < 2; ++i) { int R, C; stage_rc(tid * 16 + i * 8192, R, C); const int Rb = (R & ~31) + perm32(R & 31);
        voffA[i] = (unsigned)(R * lda + C) * 2u; voffB[i] = (unsigned)(Rb * ldb + C) * 2u; }
    constexpr size_t kstep = (size_t)(BK * 2);
    constexpr size_t hstepA = (size_t)HALF * lda * 2, hstepB = (size_t)HALF * ldb * 2;
    const unsigned ldsw = (unsigned)wid * 1024u;
    const int aoff = lds_byte(wr * 64 + fr, fq * 8), boff = lds_byte(wc * 32 + fr, fq * 8);
#define PG8_SA(b, h) (((b) * 2 + (h)) * HTB)
#define PG8_SB(b, h) ((4 + (b) * 2 + (h)) * HTB)
#define PG8_STAGE(bufoff, gbase, voff) do { _Pragma("unroll") for (int _i = 0; _i < 2; ++_i) \
        __builtin_amdgcn_global_load_lds((const unsigned*)((const char*)(gbase) + (voff)[_i]), (PG8_LAS unsigned*)(lds + (bufoff) + ldsw + _i * 8192), 16, 0, 0); } while (0)
#define PG8_LDA(dst, b, h) do { _Pragma("unroll") for (int m = 0; m < 4; ++m) _Pragma("unroll") for (int k = 0; k < 2; ++k) dst[m][k] = *(const PG8_LAS f16x8*)(lds + PG8_SA(b, h) + aoff + m * 2048 + k * 1024); } while (0)
#define PG8_LDB(dst, b, h) do { _Pragma("unroll") for (int n = 0; n < 2; ++n) _Pragma("unroll") for (int k = 0; k < 2; ++k) dst[n][k] = *(const PG8_LAS f16x8*)(lds + PG8_SB(b, h) + boff + n * 2048 + k * 1024); } while (0)
#define PG8_MMA(ai, bj, At, Bt) do { __builtin_amdgcn_s_setprio(1); _Pragma("unroll") for (int m = 0; m < 4; ++m) _Pragma("unroll") for (int n = 0; n < 2; ++n) _Pragma("unroll") for (int k = 0; k < 2; ++k) \
        acc[ai][bj][m][n] = __builtin_amdgcn_mfma_f32_16x16x32_f16(Bt[n][k], At[m][k], acc[ai][bj][m][n], 0, 0, 0); __builtin_amdgcn_s_setprio(0); } while (0)
#define PG8_WAIT_V(n) asm volatile("s_waitcnt vmcnt(" #n ")" ::: "memory")
#define PG8_WAIT_L(n) asm volatile("s_waitcnt lgkmcnt(" #n ")" ::: "memory")
#define PG8_BAR __builtin_amdgcn_s_barrier()
#define PG8_SCHED __builtin_amdgcn_sched_barrier(0)
    Unit cur, nxt; int ui = 0;
    if (!S.next(0, cur)) return;
    f32x4 acc[2][2][4][2];
#pragma unroll
    for (int a = 0; a < 2; ++a)
#pragma unroll
        for (int b = 0; b < 2; ++b)
#pragma unroll
            for (int m = 0; m < 4; ++m)
#pragma unroll
                for (int n = 0; n < 2; ++n) acc[a][b][m][n] = (f32x4){0.f, 0.f, 0.f, 0.f};
    f16x8 At[4][2], B0[2][2], B1[2][2];
    const char* cA = cur.A; const char* cB = cur.B;
    PG8_STAGE(PG8_SB(0, 0), cB, voffB); PG8_STAGE(PG8_SA(0, 0), cA, voffA); PG8_STAGE(PG8_SB(0, 1), cB + hstepB, voffB); PG8_STAGE(PG8_SA(0, 1), cA + hstepA, voffA);
    if (wr == 1) PG8_BAR;
    PG8_WAIT_V(4); PG8_BAR;
    PG8_STAGE(PG8_SB(1, 0), cB + kstep, voffB); PG8_STAGE(PG8_SA(1, 0), cA + kstep, voffA); PG8_STAGE(PG8_SB(1, 1), cB + hstepB + kstep, voffB);
    PG8_WAIT_V(6); PG8_BAR;
    for (;;) {
        const bool has_next = S.next(ui + 1, nxt);
        const char* nA = has_next ? nxt.A : cA; const char* nB = has_next ? nxt.B : cB;
#pragma unroll 1
        for (int t = 0; t < nt; t += 2) {
            const bool last = (t == nt - 2);
            const char* a1 = cA + (size_t)(t + 1) * kstep;
            const char* a2 = last ? nA : cA + (size_t)(t + 2) * kstep; const char* b2 = last ? nB : cB + (size_t)(t + 2) * kstep;
            const char* a3 = a2 + kstep; const char* b3 = b2 + kstep;
            PG8_LDB(B0, 0, 0); PG8_SCHED; PG8_LDA(At, 0, 0); PG8_STAGE(PG8_SA(1, 1), a1 + hstepA, voffA);
            PG8_WAIT_L(8); PG8_BAR; PG8_WAIT_L(0); PG8_MMA(0, 0, At, B0); PG8_BAR; PG8_SCHED;
            PG8_LDB(B1, 0, 1); PG8_STAGE(PG8_SB(0, 0), b2, voffB);
            PG8_BAR; PG8_WAIT_L(0); PG8_MMA(0, 1, At, B1); PG8_BAR;
            PG8_LDA(At, 0, 1); PG8_STAGE(PG8_SA(0, 0), a2, voffA);
            PG8_BAR; PG8_WAIT_L(0); PG8_MMA(1, 0, At, B0); PG8_BAR; PG8_SCHED;
            PG8_STAGE(PG8_SB(0, 1), b2 + hstepB, voffB);
            PG8_WAIT_V(6); PG8_BAR; PG8_MMA(1, 1, At, B1); PG8_BAR;
            PG8_LDB(B0, 1, 0); PG8_SCHED; PG8_LDA(At, 1, 0); PG8_STAGE(PG8_SA(0, 1), a2 + hstepA, voffA);
            PG8_WAIT_L(8); PG8_BAR; PG8_WAIT_L(0); PG8_MMA(0, 0, At, B0); PG8_BAR; PG8_SCHED;
            PG8_LDB(B1, 1, 1); PG8_STAGE(PG8_SB(1, 0), b3, voffB);
            PG8_BAR; PG8_WAIT_L(0); PG8_MMA(0, 1, At, B1); PG8_BAR;
            PG8_LDA(At, 1, 1); PG8_STAGE(PG8_SA(1, 0), a3, voffA);
            PG8_BAR; PG8_WAIT_L(0); PG8_MMA(1, 0, At, B0); PG8_BAR; PG8_SCHED;
            PG8_STAGE(PG8_SB(1, 1), b3 + hstepB, voffB);
            PG8_WAIT_V(6); PG8_BAR; PG8_MMA(1, 1, At, B1); PG8_BAR;
        }
        E(acc, cur, wr, wc, fr, fq);
        if (!has_next) break;
#pragma unroll
        for (int a = 0; a < 2; ++a)
#pragma unroll
            for (int b = 0; b < 2; ++b)
#pragma unroll
                for (int m = 0; m < 4; ++m)
#pragma unroll
                    for (int n = 0; n < 2; ++n) acc[a][b][m][n] = (f32x4){0.f, 0.f, 0.f, 0.f};
        cur = nxt; cA = nA; cB = nB; ++ui;
    }
    PG8_WAIT_V(0);
    if (wr == 0) PG8_BAR;
    PG8_BAR;
#undef PG8_SA
#undef PG8_SB
#undef PG8_STAGE
#undef PG8_LDA
#undef PG8_LDB
#undef PG8_MMA
#undef PG8_WAIT_V
#undef PG8_WAIT_L
#undef PG8_BAR
#undef PG8_SCHED
#endif
}
}

enum { GK_STORE = 0, GK_GATE0, GK_GATE1, GK_GATE2, GK_PROJ0, GK_PROJ1, GK_PROJ2, GK_RESID };
enum { GP_INPROJ = 0, GP_MERGE, GP_WOUT, GP_QUERY };
struct GemmProg {
    const char* act; const char* wt;
    int which, G, c;
    __device__ __forceinline__ bool next(int i, pg8::Unit& u) const {
        constexpr int nM = M_ / 256;
        constexpr size_t rowA = (size_t)256 * LDZ * 2, rowB = (size_t)256 * 1024 * 2;
        if (which == GP_MERGE) {
            const int L = (i / 6) * G + c, j = i % 6, br = j < 3 ? j : j - 3;
            if (L >= nM * 4) return false;
            pg8::tile_of(L, nM, 4, u.pm, u.pn);
            if (j < 3) { u.A = act + (size_t)C_XN * 2; u.B = wt + ((size_t)(WT_MG + br * 1024) * 1024) * 2; u.kind = GK_GATE0 + br; }
            else { u.A = act + (size_t)(br == 0 ? C_YA : (br == 1 ? C_YB : C_YC)) * 2; u.B = wt + ((size_t)(WT_P + br * 1024) * 1024) * 2; u.kind = GK_PROJ0 + br; }
        } else {
            const int nN = which == GP_INPROJ ? ZN / 256 : (which == GP_WOUT ? 4 : 8);
            const int L = i * G + c;
            if (L >= nM * nN) return false;
            pg8::tile_of(L, nM, nN, u.pm, u.pn);
            u.A = act + (size_t)(which == GP_WOUT ? C_MG : C_XN) * 2;
            u.B = wt + ((size_t)(which == GP_INPROJ ? WT_IN : (which == GP_WOUT ? WT_OUT : WT_Q)) * 1024) * 2;
            u.kind = which == GP_WOUT ? GK_RESID : GK_STORE;
        }
        u.A += (size_t)u.pm * rowA; u.B += (size_t)u.pn * rowB;
        return true;
    }
};
__device__ __forceinline__ int gs_slot(int br) { return br == 0 ? C_GS : (br == 1 ? Z_V : Z_ULRU); }
struct GemmEpi {
    h16_t* act; const float* mb; const float* resid; float* out;
    __device__ __forceinline__ void operator()(const pg8::f32x4 (&acc)[2][2][4][2], const pg8::Unit& u, int wr, int wc, int fr, int fq) const {
        const int row0 = u.pm * 256 + wr * 64 + fr, col0 = u.pn * 256 + wc * 32 + 8 * fq;
#pragma unroll
        for (int ai = 0; ai < 2; ++ai)
#pragma unroll
            for (int m = 0; m < 4; ++m) {
                const int row = row0 + ai * 128 + m * 16;
#pragma unroll
                for (int bj = 0; bj < 2; ++bj) {
                    const int col = col0 + bj * 128;
                    float v[8];
#pragma unroll
                    for (int e = 0; e < 4; ++e) { v[e] = acc[ai][bj][m][0][e]; v[4 + e] = acc[ai][bj][m][1][e]; }
                    h16_t* arow = act + (size_t)row * LDZ;
                    if (u.kind == GK_STORE) {
                        store8h(arow + col, v);
                    } else if (u.kind <= GK_GATE2) {
                        const float* bp = mb + (u.kind - GK_GATE0) * 1024 + col;
                        const float4 b0 = *(const float4*)bp, b1 = *(const float4*)(bp + 4);
                        v[0] = sigmoidf_(v[0] + b0.x); v[1] = sigmoidf_(v[1] + b0.y); v[2] = sigmoidf_(v[2] + b0.z); v[3] = sigmoidf_(v[3] + b0.w);
                        v[4] = sigmoidf_(v[4] + b1.x); v[5] = sigmoidf_(v[5] + b1.y); v[6] = sigmoidf_(v[6] + b1.z); v[7] = sigmoidf_(v[7] + b1.w);
                        store8h(arow + gs_slot(u.kind - GK_GATE0) + col, v);
                    } else if (u.kind <= GK_PROJ2) {
                        float g[8]; load8h(arow + gs_slot(u.kind - GK_PROJ0) + col, g);
                        if (u.kind == GK_PROJ0) {
#pragma unroll
                            for (int e = 0; e < 8; ++e) v[e] = g[e] * v[e];
                        } else {
                            float o[8]; load8h(arow + C_MG + col, o);
#pragma unroll
                            for (int e = 0; e < 8; ++e) v[e] = o[e] + g[e] * v[e];
                        }
                        store8h(arow + C_MG + col, v);
                    } else {
                        const size_t o = (size_t)row * 1024 + col;
                        const float4 r0 = *(const float4*)(resid + o), r1 = *(const float4*)(resid + o + 4);
                        *(float4*)(out + o) = make_float4(r0.x + v[0], r0.y + v[1], r0.z + v[2], r0.w + v[3]);
                        *(float4*)(out + o + 4) = make_float4(r1.x + v[4], r1.y + v[5], r1.z + v[6], r1.w + v[7]);
                    }
                }
            }
    }
};
__device__ __forceinline__ void stage_gemm(KParams p, int l, int which, char* smem) {
    GemmProg S; S.act = p->ws + OFF_ACT; S.wt = p->ws + OFF_WT + (size_t)l * WT_ROWS * 1024 * 2; S.which = which; S.G = gridDim.x; S.c = bid_();
    GemmEpi E; E.act = (h16_t*)(p->ws + OFF_ACT); E.mb = p->in[I_MB] + l * 3072; E.resid = l == 0 ? p->in[I_X] : p->out; E.out = p->out;
    pg8::gemm_phase(smem, S, E);
}

#ifdef CPU_EMU
__device__ __forceinline__ float group_sum(float v, int width, float* scratch) {
    const int tid = tid_();
    scratch[tid] = v;
    __syncthreads();
    float s = 0.f; const int base = tid & ~(width - 1);
    for (int i = 0; i < width; ++i) s += scratch[base + i];
    __syncthreads();
    return s;
}
#else
template <int CTRL> __device__ __forceinline__ float dpp_f(float v) { return __builtin_bit_cast(float, __builtin_amdgcn_update_dpp(0, __builtin_bit_cast(int, v), CTRL, 0xf, 0xf, false)); }
__device__ __forceinline__ float group_sum(float v, int width, float*) {
    v += dpp_f<0xB1>(v);
    v += dpp_f<0x4E>(v);
    if (width >= 8) v += dpp_f<0x141>(v);
    if (width >= 16) v += dpp_f<0x140>(v);
    if (width >= 64) {
        v += __builtin_bit_cast(float, __builtin_amdgcn_update_dpp(0, __builtin_bit_cast(int, v), 0x142, 0xa, 0xf, false));
        v += __builtin_bit_cast(float, __builtin_amdgcn_update_dpp(0, __builtin_bit_cast(int, v), 0x143, 0xc, 0xf, false));
        v = __builtin_bit_cast(float, __builtin_amdgcn_readlane(__builtin_bit_cast(int, v), 63));
    } else if (width >= 32) v += __shfl_xor(v, 16);
    return v;
}
#endif
__device__ __forceinline__ uint4 ldg16(const h16_t* p) { return *(const uint4*)p; }
__device__ __forceinline__ uint4 zero16() { uint4 z; z.x = 0u; z.y = 0u; z.z = 0u; z.w = 0u; return z; }

__device__ __forceinline__ void stage_lru(KParams p, int l, char* smem, int vb0, int nvb) {
    const int vb = bid_() - vb0;
    if (vb < 0 || vb >= nvb) return;
    constexpr int CH = 64;
    float* wa_s = (float*)smem;
    float* wx_s = wa_s + 4096;
    float* xcT = wx_s + 4096;
    float* a_s = xcT + 64 * CH;
    float* b_s = a_s + CH * 64;
    h16_t* ru = (h16_t*)(b_s + CH * 64);
    h16_t* rg = ru + (CH + 3) * 64;
    h16_t* ACT = (h16_t*)(p->ws + OFF_ACT);
    const int tid = tid_(), c = tid & 63, tg = tid >> 6;
    for (int item = vb; item < B_ * 16; item += nvb) {
        const int b = item / 16, n = item % 16, ch = n * 64 + c;
        __syncthreads();
        for (int i = tid; i < 4096; i += NT) { wa_s[i] = p->in[I_LWA][((size_t)l * 16 + n) * 4096 + i]; wx_s[i] = p->in[I_LWX][((size_t)l * 16 + n) * 4096 + i]; }
        const float cw0 = p->in[I_LCW][((size_t)l * 4 + 0) * 1024 + ch], cw1 = p->in[I_LCW][((size_t)l * 4 + 1) * 1024 + ch];
        const float cw2 = p->in[I_LCW][((size_t)l * 4 + 2) * 1024 + ch], cw3 = p->in[I_LCW][((size_t)l * 4 + 3) * 1024 + ch];
        const float cb = p->in[I_LCB][l * 1024 + ch], ba = p->in[I_LBA][l * 1024 + ch], bx = p->in[I_LBX][l * 1024 + ch];
        const float sp = softplusf_(-p->in[I_LLAM][l * 1024 + ch]);
        float hst = 0.f;
        uint4 pf[3];
#define LRU_LOAD(t0_) do { _Pragma("unroll") for (int i = 0; i < 3; ++i) { const int j = tid + NT * i; pf[i] = zero16(); \
            if (j < 536) { const int t = (t0_) - 3 + (j >> 3); if (t >= 0) pf[i] = ldg16(ACT + ((size_t)b * T_ + t) * LDZ + Z_ULRU + n * 64 + (j & 7) * 8); } \
            else if (j < 1048) { const int jj = j - 536; pf[i] = ldg16(ACT + ((size_t)b * T_ + (t0_) + (jj >> 3)) * LDZ + Z_GLRU + n * 64 + (jj & 7) * 8); } } } while (0)
#define LRU_PUT() do { _Pragma("unroll") for (int i = 0; i < 3; ++i) { const int j = tid + NT * i; \
            if (j < 536) *(uint4*)(ru + (j >> 3) * 64 + (j & 7) * 8) = pf[i]; else if (j < 1048) *(uint4*)(rg + ((j - 536) >> 3) * 64 + ((j - 536) & 7) * 8) = pf[i]; } } while (0)
        LRU_LOAD(0);
        LRU_PUT();
        __syncthreads();
#pragma unroll 1
        for (int t0 = 0; t0 < T_; t0 += CH) {
            float xc[8];
            {
                float u[11];
#pragma unroll
                for (int s = 0; s < 11; ++s) u[s] = h2f(ru[(tg * 8 + s) * 64 + c]);
#pragma unroll
                for (int s = 0; s < 8; ++s) { xc[s] = cw0 * u[s] + cw1 * u[s + 1] + cw2 * u[s + 2] + cw3 * u[s + 3] + cb; xcT[c * CH + tg * 8 + s] = xc[s]; }
            }
            __syncthreads();
            if (t0 + CH < T_) LRU_LOAD(t0 + CH);
            {
                float dr[8], di[8];
#pragma unroll
                for (int s = 0; s < 8; ++s) { dr[s] = 0.f; di[s] = 0.f; }
#pragma unroll 4
                for (int i = 0; i < 64; ++i) {
                    const float wa = wa_s[i * 64 + c], wx = wx_s[i * 64 + c];
                    const float4 x0 = *(const float4*)(xcT + i * CH + tg * 8), x1 = *(const float4*)(xcT + i * CH + tg * 8 + 4);
                    dr[0] += x0.x * wa; dr[1] += x0.y * wa; dr[2] += x0.z * wa; dr[3] += x0.w * wa; dr[4] += x1.x * wa; dr[5] += x1.y * wa; dr[6] += x1.z * wa; dr[7] += x1.w * wa;
                    di[0] += x0.x * wx; di[1] += x0.y * wx; di[2] += x0.z * wx; di[3] += x0.w * wx; di[4] += x1.x * wx; di[5] += x1.y * wx; di[6] += x1.z * wx; di[7] += x1.w * wx;
                }
#pragma unroll
                for (int s = 0; s < 8; ++s) {
                    const float r = sigmoidf_(dr[s] + ba), ig = sigmoidf_(di[s] + bx);
                    const float log_a = -8.0f * r * sp;
                    a_s[(tg * 8 + s) * 64 + c] = fexp_(log_a);
                    b_s[(tg * 8 + s) * 64 + c] = sqrtf(fmaxf(1.0f - fexp_(2.0f * log_a), 0.0f)) * (ig * xc[s]);
                }
            }
            __syncthreads();
            if (tid < 64) {
#pragma unroll 8
                for (int t = 0; t < CH; ++t) { hst = a_s[t * 64 + c] * hst + b_s[t * 64 + c]; b_s[t * 64 + c] = hst; }
            }
            __syncthreads();
#pragma unroll
            for (int s = 0; s < 8; ++s) { h16_t* gp = rg + (tg * 8 + s) * 64 + c; *gp = f2h(b_s[(tg * 8 + s) * 64 + c] * geluf_(h2f(*gp))); }
            __syncthreads();
            *(uint4*)(ACT + ((size_t)b * T_ + t0 + (tid >> 3)) * LDZ + Z_GLRU + n * 64 + (tid & 7) * 8) = *(const uint4*)(rg + (tid >> 3) * 64 + (tid & 7) * 8);
            __syncthreads();
            if (t0 + CH < T_) LRU_PUT();
            __syncthreads();
        }
#undef LRU_LOAD
#undef LRU_PUT
    }
}

#ifdef CPU_EMU
struct hfrag { h16_t v[8]; };
struct facc { float d[4]; float& operator[](int i) { return d[i]; } const float& operator[](int i) const { return d[i]; } };
__device__ __forceinline__ facc facc_zero() { facc a; a.d[0] = a.d[1] = a.d[2] = a.d[3] = 0.f; return a; }
__device__ __forceinline__ hfrag frag_u4(uint4 w) { hfrag f; memcpy(&f, &w, 16); return f; }
__device__ __forceinline__ hfrag frag_2u2(uint2 lo, uint2 hi) { hfrag f; memcpy(&f.v[0], &lo, 8); memcpy(&f.v[4], &hi, 8); return f; }
__device__ __forceinline__ hfrag frag_mul(hfrag a, hfrag b) { hfrag f; for (int j = 0; j < 8; ++j) f.v[j] = f2h(h2f(a.v[j]) * h2f(b.v[j])); return f; }
__device__ __forceinline__ facc mfma16(hfrag a, hfrag b, facc c) {
    const int tid = tid_(), w = tid >> 6, l = tid & 63;
    unsigned short (*X)[64][16] = emu::ctx->xscr;
    for (int j = 0; j < 8; ++j) { X[w][l][j] = a.v[j]; X[w][l][8 + j] = b.v[j]; }
    __syncthreads();
    for (int reg = 0; reg < 4; ++reg) {
        const int row = 4 * (l >> 4) + reg, col = l & 15;
        float s = 0.f;
        for (int k = 0; k < 32; ++k) s += h2f(X[w][row + 16 * (k >> 3)][k & 7]) * h2f(X[w][col + 16 * (k >> 3)][8 + (k & 7)]);
        c.d[reg] += s;
    }
    __syncthreads();
    return c;
}
#else
typedef _Float16 hfrag __attribute__((ext_vector_type(8)));
typedef float facc __attribute__((ext_vector_type(4)));
__device__ __forceinline__ facc facc_zero() { return (facc){0.f, 0.f, 0.f, 0.f}; }
__device__ __forceinline__ hfrag frag_u4(uint4 w) { return __builtin_bit_cast(hfrag, w); }
__device__ __forceinline__ hfrag frag_2u2(uint2 lo, uint2 hi) { uint4 w; w.x = lo.x; w.y = lo.y; w.z = hi.x; w.w = hi.y; return __builtin_bit_cast(hfrag, w); }
__device__ __forceinline__ hfrag frag_mul(hfrag a, hfrag b) { return a * b; }
__device__ __forceinline__ facc mfma16(hfrag a, hfrag b, facc c) { return __builtin_amdgcn_mfma_f32_16x16x32_f16(a, b, c, 0, 0, 0); }
#endif
__device__ __forceinline__ hfrag frag_pack8(float a0, float a1, float a2, float a3, float a4, float a5, float a6, float a7) {
    uint4 w; w.x = pack2h(a0, a1); w.y = pack2h(a2, a3); w.z = pack2h(a4, a5); w.w = pack2h(a6, a7); return frag_u4(w);
}
__device__ __forceinline__ hfrag frag_acc2(const facc& t0, const facc& t1) { return frag_pack8(t0[0], t0[1], t0[2], t0[3], t1[0], t1[1], t1[2], t1[3]); }
__device__ __forceinline__ hfrag permfrag(const h16_t* rowp, int ks, int g) { return frag_2u2(*(const uint2*)(rowp + 32 * ks + 4 * g), *(const uint2*)(rowp + 32 * ks + 16 + 4 * g)); }

__device__ __forceinline__ void stage_gdn(KParams p, int l, char* smem, int vb0, int nvb) {
    const int vb = bid_() - vb0;
    if (vb < 0 || vb >= nvb) return;
    constexpr int CH = 64, QS = 136, TS = 72, AS = 68, KTS = 128 * TS + 16 * 8;
#define KTO(d) ((d) * TS + ((d) >> 3) * 8)
    h16_t* Qs = (h16_t*)smem;
    h16_t* Ks = Qs + 64 * QS;
    h16_t* Kt = Ks + 64 * QS;
    h16_t* Vt = Kt + KTS;
    float* A32 = (float*)(Vt + KTS);
    h16_t* ob = (h16_t*)A32;
    h16_t* Tu = (h16_t*)(A32 + 64 * AS);
    h16_t* Tw = Tu + 64 * TS;
    h16_t* QKm = Tw + 64 * TS;
    float* gc_s = (float*)(QKm + 64 * TS);
    float* be_s = gc_s + 64;
    float* e1_s = be_s + 64;
    float* part_s = e1_s + 64;
    float* scr = part_s + 512;
    float* cw_s = scr + 512;
    h16_t* ACT = (h16_t*)(p->ws + OFF_ACT);
    int tid = tid_(), lane = tid & 63, w = tid >> 6, g = lane >> 4, r16 = lane & 15;
    int sg = lane >> 4, pc = lane & 15, rb = w;
#define GDN_ROLES() do { tid = tid_(); lane = tid & 63; w = tid >> 6; g = lane >> 4; r16 = lane & 15; sg = g; pc = r16; rb = w; } while (0)
    for (int item = vb; item < B_ * 8; item += nvb) {
        const int b = item / 8, h = item % 8;
        const float a_exp = fexp_(p->in[I_GALOG][l * 8 + h]), dtb = p->in[I_GDT][l * 8 + h];
        facc S[8];
#pragma unroll
        for (int dt = 0; dt < 8; ++dt) S[dt] = facc_zero();
        __syncthreads();
        for (int i = tid; i < 64 * TS / 2; i += NT) ((unsigned*)QKm)[i] = 0u;
        for (int i = tid; i < 4 * 384; i += NT) { const int jj = i / 384, c3 = i % 384; cw_s[i] = p->in[I_GCW][((size_t)l * 4 + jj) * 3072 + (c3 >> 7) * 1024 + h * 128 + (c3 & 127)]; }
        uint4 pf[11];
#define GDN_LOAD(t0_) do { GDN_ROLES(); const h16_t* colp = ACT + ((size_t)b * T_ + (t0_) + 8 * rb - 3) * LDZ + (sg < 3 ? Z_Q + sg * 1024 : Z_ZG) + h * 128 + pc * 8; \
            _Pragma("unroll") for (int i = 0; i < 11; ++i) { const int t = (t0_) + 8 * rb - 3 + i; pf[i] = (t >= 0 && sg < 3) ? ldg16(colp + (size_t)i * LDZ) : zero16(); } } while (0)
        GDN_LOAD(0);
        h16_t pfa = 0, pfb = 0;
#define GDN_LOADS(t0_) do { if (tid < 64) { const size_t m_ = (size_t)b * T_ + (t0_) + tid; pfa = ACT[m_ * LDZ + Z_ALPHA + h]; pfb = ACT[m_ * LDZ + Z_BETA + h]; } } while (0)
        GDN_LOADS(0);
#pragma unroll 1
        for (int t0 = 0; t0 < T_; t0 += CH) {
            GDN_ROLES();
            if (tid < 64) {
                part_s[tid] = -a_exp * softplusf_(h2f(pfa) + dtb);
                be_s[tid] = sigmoidf_(h2f(pfb));
            }
            __syncthreads();
            if (tid < 64) { float s = 0.f;
#pragma unroll
                for (int i4 = 0; i4 < 16; ++i4) { const float4 pv = *(const float4*)(part_s + i4 * 4); s += (i4 * 4 <= tid ? pv.x : 0.f) + (i4 * 4 + 1 <= tid ? pv.y : 0.f) + (i4 * 4 + 2 <= tid ? pv.z : 0.f) + (i4 * 4 + 3 <= tid ? pv.w : 0.f); }
                gc_s[tid] = s; }
#pragma unroll
            for (int hf = 0; hf < 2; ++hf) {
                float ov[4][8];
#pragma unroll
                for (int i = 0; i < 4; ++i) {
#pragma unroll
                    for (int cc = 0; cc < 8; ++cc) ov[i][cc] = 0.f;
#pragma unroll
                    for (int jj = 0; jj < 4; ++jj) {
                        const uint4 wv = pf[hf * 4 + i + jj];
                        const float* cwp = cw_s + jj * 384 + (sg < 3 ? sg : 0) * 128 + pc * 8;
                        const float4 c0 = *(const float4*)cwp, c1 = *(const float4*)(cwp + 4);
                        ov[i][0] += c0.x * h2f((h16_t)(wv.x & 0xffffu)); ov[i][1] += c0.y * h2f((h16_t)(wv.x >> 16)); ov[i][2] += c0.z * h2f((h16_t)(wv.y & 0xffffu)); ov[i][3] += c0.w * h2f((h16_t)(wv.y >> 16));
                        ov[i][4] += c1.x * h2f((h16_t)(wv.z & 0xffffu)); ov[i][5] += c1.y * h2f((h16_t)(wv.z >> 16)); ov[i][6] += c1.z * h2f((h16_t)(wv.w & 0xffffu)); ov[i][7] += c1.w * h2f((h16_t)(wv.w >> 16));
                    }
                    float ss = 0.f;
#pragma unroll
                    for (int cc = 0; cc < 8; ++cc) { ov[i][cc] = siluf_(ov[i][cc]); ss += ov[i][cc] * ov[i][cc]; }
                    ss = group_sum(ss, 16, scr);
                    const float rn = sg == 0 ? rsqrtf(ss + RMS_EPS) * 0.08838834764831845f : (sg == 1 ? rsqrtf(ss + RMS_EPS) : 1.0f);
#pragma unroll
                    for (int cc = 0; cc < 8; ++cc) ov[i][cc] *= rn;
                    const int t = 8 * rb + hf * 4 + i;
                    if (sg == 0) store8h(Qs + t * QS + pc * 8, ov[i]);
                    else if (sg == 1) store8h(Ks + t * QS + pc * 8, ov[i]);
                }
                if (sg == 1 || sg == 2) {
                    h16_t* dstT = sg == 1 ? Kt : Vt;
#pragma unroll
                    for (int cc = 0; cc < 8; ++cc) { uint2 w2; w2.x = pack2h(ov[0][cc], ov[1][cc]); w2.y = pack2h(ov[2][cc], ov[3][cc]); *(uint2*)(dstT + KTO(pc * 8 + cc) + 8 * rb + hf * 4) = w2; }
                }
            }
            __syncthreads();
            GDN_ROLES();
            if (tid < 64) e1_s[tid] = fexp_(gc_s[63] - gc_s[tid]);
            for (int e = tid; e < 64 * 64; e += NT) { const int i = e >> 6, j = e & 63; if ((j >> 4) > (i >> 4)) A32[i * AS + (j & 7) * 8 + (j >> 3)] = 0.f; }
#pragma unroll 1
            for (int jr = 0; jr < 3; ++jr) {
                const int jb = w + 8 * jr; const bool valid = jb < 20;
                const int kind = (valid && jb >= 10) ? 1 : 0, tix = valid ? (jb % 10) : 0;
                const int ti = tix < 1 ? 0 : (tix < 3 ? 1 : (tix < 6 ? 2 : 3)), tj = tix - (ti * (ti + 1)) / 2;
                const h16_t* ap = (kind ? Qs : Ks) + (16 * ti + r16) * QS + 8 * g; const h16_t* bp = Ks + (16 * tj + r16) * QS + 8 * g;
                facc acc = facc_zero();
#pragma unroll
                for (int ks = 0; ks < 4; ++ks) acc = mfma16(frag_u4(*(const uint4*)(ap + 32 * ks)), frag_u4(*(const uint4*)(bp + 32 * ks)), acc);
                if (valid) {
                    const int j = 16 * tj + r16; const float gj = gc_s[j];
#pragma unroll
                    for (int reg = 0; reg < 4; ++reg) {
                        const int i = 16 * ti + 4 * g + reg;
                        const float dec = fexp_(fminf(gc_s[i] - gj, 0.f));
                        if (kind == 0) A32[i * AS + (j & 7) * 8 + (j >> 3)] = i > j ? be_s[i] * acc[reg] * dec : 0.f;
                        else QKm[i * TS + j] = f2h(i >= j ? acc[reg] * dec : 0.f);
                    }
                }
            }
            __syncthreads();
            GDN_ROLES();
            {
                const int t = tid >> 3, d0 = (tid & 7) * 16; const float eg = fexp_(gc_s[t]);
                float v8[8];
                load8h(Qs + t * QS + d0, v8);
#pragma unroll
                for (int e = 0; e < 8; ++e) v8[e] *= eg;
                store8h(Qs + t * QS + d0, v8);
                load8h(Qs + t * QS + d0 + 8, v8);
#pragma unroll
                for (int e = 0; e < 8; ++e) v8[e] *= eg;
                store8h(Qs + t * QS + d0 + 8, v8);
            }
            {
                const int c = tid >> 3, q = tid & 7;
                const float bc = be_s[c], bgc = bc * fexp_(gc_s[c]);
                float x[8];
#pragma unroll
                for (int i = 0; i < 8; ++i) x[i] = 0.f;
#pragma unroll
                for (int r = 0; r < 64; ++r) {
                    float sacc = 0.f;
                    if (r > 0) {
                        const float4 a0 = *(const float4*)(A32 + r * AS + q * 8);
                        sacc = a0.x * x[0];
                        if (r > 8) sacc += a0.y * x[1];
                        if (r > 16) sacc += a0.z * x[2];
                        if (r > 24) sacc += a0.w * x[3];
                        if (r > 32) {
                            const float4 a1 = *(const float4*)(A32 + r * AS + q * 8 + 4);
                            sacc += a1.x * x[4];
                            if (r > 40) sacc += a1.y * x[5];
                            if (r > 48) sacc += a1.z * x[6];
                            if (r > 56) sacc += a1.w * x[7];
                        }
                        sacc = group_sum(sacc, 8, scr);
                    }
                    const float xr = ((r == c) ? 1.f : 0.f) - sacc;
                    if (q == (r & 7)) { x[r >> 3] = xr; Tu[r * TS + c] = f2h(xr * bc); Tw[r * TS + c] = f2h(xr * bgc); }
                }
            }
            __syncthreads();
            GDN_ROLES();
            facc vn[4], aw[4];
#pragma unroll
            for (int tt = 0; tt < 4; ++tt) { vn[tt] = facc_zero(); aw[tt] = facc_zero(); }
#pragma unroll
            for (int tt = 0; tt < 4; ++tt)
#pragma unroll
                for (int ks = 0; ks <= (tt >> 1); ++ks) {
                    const hfrag au = frag_u4(*(const uint4*)(Tu + (16 * tt + r16) * TS + 32 * ks + 8 * g)), aww = frag_u4(*(const uint4*)(Tw + (16 * tt + r16) * TS + 32 * ks + 8 * g));
                    vn[tt] = mfma16(au, frag_u4(*(const uint4*)(Vt + KTO(16 * w + r16) + 32 * ks + 8 * g)), vn[tt]);
                    aw[tt] = mfma16(aww, frag_u4(*(const uint4*)(Kt + KTO(16 * w + r16) + 32 * ks + 8 * g)), aw[tt]);
                }
#pragma unroll
            for (int tt = 0; tt < 4; ++tt)
#pragma unroll
                for (int reg = 0; reg < 4; ++reg) Ks[(16 * tt + 4 * g + reg) * QS + 16 * w + r16] = f2h(-aw[tt][reg]);
            __syncthreads();
            GDN_ROLES();
            h16_t zraw[16];
#pragma unroll
            for (int tt = 0; tt < 4; ++tt)
#pragma unroll
                for (int reg = 0; reg < 4; ++reg) zraw[tt * 4 + reg] = ACT[((size_t)b * T_ + t0 + 16 * tt + 4 * g + reg) * LDZ + Z_ZG + h * 128 + 16 * w + r16];
            hfrag Sb[4];
#pragma unroll
            for (int ks = 0; ks < 4; ++ks) Sb[ks] = frag_acc2(S[2 * ks], S[2 * ks + 1]);
            facc oc[4];
#pragma unroll
            for (int tt = 0; tt < 4; ++tt) {
                oc[tt] = facc_zero();
                const h16_t* wrow = Ks + (16 * tt + r16) * QS; const h16_t* qrow = Qs + (16 * tt + r16) * QS;
#pragma unroll
                for (int ks = 0; ks < 4; ++ks) { vn[tt] = mfma16(permfrag(wrow, ks, g), Sb[ks], vn[tt]); oc[tt] = mfma16(permfrag(qrow, ks, g), Sb[ks], oc[tt]); }
            }
            hfrag VNb[2];
            VNb[0] = frag_acc2(vn[0], vn[1]); VNb[1] = frag_acc2(vn[2], vn[3]);
#pragma unroll
            for (int tt = 0; tt < 4; ++tt)
#pragma unroll
                for (int ks2 = 0; ks2 <= (tt >> 1); ++ks2) oc[tt] = mfma16(permfrag(QKm + (16 * tt + r16) * TS, ks2, g), VNb[ks2], oc[tt]);
            {
                const float egl = fexp_(gc_s[63]);
                hfrag e1f[2];
#pragma unroll
                for (int ks2 = 0; ks2 < 2; ++ks2) { const float* ep = e1_s + 32 * ks2 + 4 * g; e1f[ks2] = frag_pack8(ep[0], ep[1], ep[2], ep[3], ep[16], ep[17], ep[18], ep[19]); }
#pragma unroll
                for (int dt = 0; dt < 8; ++dt) {
#pragma unroll
                    for (int reg = 0; reg < 4; ++reg) S[dt][reg] *= egl;
#pragma unroll
                    for (int ks2 = 0; ks2 < 2; ++ks2) S[dt] = mfma16(frag_mul(permfrag(Kt + KTO(16 * dt + r16), ks2, g), e1f[ks2]), VNb[ks2], S[dt]);
                }
            }
            if (t0 + CH < T_) { GDN_LOAD(t0 + CH); GDN_LOADS(t0 + CH); }
            GDN_ROLES();
#pragma unroll
            for (int tt = 0; tt < 4; ++tt)
#pragma unroll
                for (int reg = 0; reg < 4; ++reg) { const float ss = group_sum(oc[tt][reg] * oc[tt][reg], 16, scr); if (r16 == 0) part_s[w * 64 + 16 * tt + 4 * g + reg] = ss; }
            __syncthreads();
            const float nw = p->in[I_GNW][l * 128 + w * 16 + r16];
#pragma unroll
            for (int tt = 0; tt < 4; ++tt)
#pragma unroll
                for (int reg = 0; reg < 4; ++reg) {
                    const int t = 16 * tt + 4 * g + reg;
                    float ms = 0.f;
#pragma unroll
                    for (int ww = 0; ww < 8; ++ww) ms += part_s[ww * 64 + t];
                    ob[t * 128 + 16 * w + r16] = f2h(oc[tt][reg] * rsqrtf(ms * (1.0f / 128.0f) + RMS_EPS) * nw * siluf_(h2f(zraw[tt * 4 + reg])));
                }
            __syncthreads();
            GDN_ROLES();
#pragma unroll
            for (int i = 0; i < 2; ++i) { const int j = tid + NT * i; *(uint4*)(ACT + ((size_t)b * T_ + t0 + (j >> 4)) * LDZ + Z_ZG + h * 128 + (j & 15) * 8) = *(const uint4*)(ob + (j >> 4) * 128 + (j & 15) * 8); }
            __syncthreads();
        }
#undef GDN_LOAD
#undef GDN_LOADS
#undef KTO
#undef GDN_ROLES
    }
}

#ifndef CPU_EMU
typedef _Float16 rw_f16x8 __attribute__((ext_vector_type(8)));
typedef float rw_f32x4 __attribute__((ext_vector_type(4)));
#endif
__device__ __forceinline__ void stage_rwkv(KParams p, int l, char* smem, int vb0, int nvb) {
    const int vb = bid_() - vb0;
    if (vb < 0 || vb >= nvb) return;
    constexpr int CH = 32, XS = 264;
    float* r_s = (float*)smem;
    float* k_s = r_s + CH * 64;
    float* v_s = k_s + CH * 64;
    float* w_s = v_s + CH * 64;
    float* kk_s = w_s + CH * 64;
    float* ka_s = kk_s + CH * 64;
    float* g_s = ka_s + CH * 64;
    float* o_s = g_s + CH * 64;
    float* bon_s = o_s + CH * 64;
    float* scr = bon_s + CH;
    h16_t* raw = (h16_t*)(scr + 512);
    h16_t* xs = raw + (CH + 1) * 448;
    h16_t* ACT = (h16_t*)(p->ws + OFF_ACT);
    int tid = tid_(), c = tid & 63, tg = tid >> 6;
    int ri = tid >> 3, q8 = tid & 7;
#define RW_ROLES() do { tid = tid_(); c = tid & 63; tg = tid >> 6; ri = tid >> 3; q8 = tid & 7; } while (0)
    float* cst_s = (float*)(xs + CH * XS);
    for (int item = vb; item < B_ * 16; item += nvb) {
        const int b = item / 16, h = item % 16, ch = h * 64 + c;
        __syncthreads();
        if (tid < 64) {
            const float* mu = p->in[I_RMU] + (size_t)l * RWW;
            cst_s[0 * 64 + c] = p->in[I_RW0][l * 1024 + ch]; cst_s[1 * 64 + c] = p->in[I_RA0][l * 1024 + ch]; cst_s[2 * 64 + c] = p->in[I_RKK][l * 1024 + ch]; cst_s[3 * 64 + c] = p->in[I_RKA][l * 1024 + ch];
            cst_s[4 * 64 + c] = p->in[I_RRK][(size_t)l * 1024 + ch]; cst_s[5 * 64 + c] = p->in[I_RLW][l * 1024 + ch]; cst_s[6 * 64 + c] = p->in[I_RLB][l * 1024 + ch];
            cst_s[7 * 64 + c] = mu[RW_R + ch]; cst_s[8 * 64 + c] = mu[RW_K + ch]; cst_s[9 * 64 + c] = mu[RW_V + ch];
            cst_s[10 * 64 + c] = mu[RW_WL + c]; cst_s[11 * 64 + c] = mu[RW_AL + c]; cst_s[12 * 64 + c] = mu[RW_GL + c]; cst_s[13 * 64 + c] = mu[RW_GL + 64 + c];
        }
        const float* wup = p->in[I_RWUP] + (size_t)l * 64 * 1024 + h * 64; const float* aup = p->in[I_RAUP] + (size_t)l * 64 * 1024 + h * 64; const float* gup = p->in[I_RGUP] + (size_t)l * 128 * 1024 + h * 64;
#ifndef CPU_EMU
        const int wid = tid >> 6, lane = tid & 63, mt = wid >> 2, nt = wid & 3;
        rw_f16x8 bw[2], ba_[2], bg[4];
        {
            const int cn = nt * 16 + (lane & 15), kb = 8 * (lane >> 4);
#pragma unroll
            for (int ks = 0; ks < 2; ++ks)
#pragma unroll
                for (int j = 0; j < 8; ++j) { bw[ks][j] = (_Float16)wup[(size_t)(ks * 32 + kb + j) * 1024 + cn]; ba_[ks][j] = (_Float16)aup[(size_t)(ks * 32 + kb + j) * 1024 + cn]; }
#pragma unroll
            for (int ks = 0; ks < 4; ++ks)
#pragma unroll
                for (int j = 0; j < 8; ++j) bg[ks][j] = (_Float16)gup[(size_t)(ks * 32 + kb + j) * 1024 + cn];
        }
#endif
        float S[8];
#pragma unroll
        for (int e = 0; e < 8; ++e) S[e] = 0.f;
        uint4 pf[4];
#define RW_LOAD(t0_) do { _Pragma("unroll") for (int i = 0; i < 4; ++i) { const int j = tid + NT * i, row = j / 56, u = j % 56, t = (t0_) - 1 + row; pf[i] = zero16(); \
            if (j < (CH + 1) * 56 && t >= 0) pf[i] = ldg16(ACT + ((size_t)b * T_ + t) * LDZ + Z_RW + (u < 24 ? (u >> 3) * 1024 + h * 64 + (u & 7) * 8 : 3072 + (u - 24) * 8)); } } while (0)
#define RW_PUT() do { _Pragma("unroll") for (int i = 0; i < 4; ++i) { const int j = tid + NT * i; if (j < (CH + 1) * 56) *(uint4*)(raw + (j / 56) * 448 + (j % 56) * 8) = pf[i]; } } while (0)
        __syncthreads();
        RW_LOAD(0);
        RW_PUT();
        __syncthreads();
#pragma unroll 1
        for (int t0 = 0; t0 < T_; t0 += CH) {
            RW_ROLES();
            {
            const float mu_r = cst_s[7 * 64 + c], mu_k = cst_s[8 * 64 + c], mu_v = cst_s[9 * 64 + c], mu_wl = cst_s[10 * 64 + c], mu_al = cst_s[11 * 64 + c], mu_g0 = cst_s[12 * 64 + c], mu_g1 = cst_s[13 * 64 + c];
#pragma unroll
            for (int s = 0; s < 4; ++s) {
                const int tl = tg * 4 + s;
                const h16_t* zc = raw + (tl + 1) * 448; const h16_t* zp = raw + tl * 448;
#define RW_SHIFT(col, muv) ({ const float zz = h2f(zc[col]); zz + (muv) * (h2f(zp[col]) - zz); })
                r_s[tl * 64 + c] = RW_SHIFT(c, mu_r);
                k_s[tl * 64 + c] = RW_SHIFT(64 + c, mu_k);
                v_s[tl * 64 + c] = RW_SHIFT(128 + c, mu_v);
                xs[tl * XS + c] = f2h(tanhf_(RW_SHIFT(192 + c, mu_wl)));
                xs[tl * XS + 64 + c] = f2h(RW_SHIFT(256 + c, mu_al));
                xs[tl * XS + 128 + c] = f2h(sigmoidf_(RW_SHIFT(320 + c, mu_g0)));
                xs[tl * XS + 192 + c] = f2h(sigmoidf_(RW_SHIFT(384 + c, mu_g1)));
#undef RW_SHIFT
            }
            }
            __syncthreads();
#ifdef CPU_EMU
#pragma unroll
            for (int s = 0; s < 4; ++s) {
                const int tl = tg * 4 + s;
                float dw = 0.f, da = 0.f, dg = 0.f;
                for (int i = 0; i < 64; ++i) { dw += h2f(xs[tl * XS + i]) * h2f(f2h(wup[(size_t)i * 1024 + c])); da += h2f(xs[tl * XS + 64 + i]) * h2f(f2h(aup[(size_t)i * 1024 + c])); }
                for (int i = 0; i < 128; ++i) dg += h2f(xs[tl * XS + 128 + i]) * h2f(f2h(gup[(size_t)i * 1024 + c]));
                w_s[tl * 64 + c] = dw; ka_s[tl * 64 + c] = da; g_s[tl * 64 + c] = dg;
            }
#else
            {
                const h16_t* ap = xs + (mt * 16 + (lane & 15)) * XS + 8 * (lane >> 4);
                rw_f32x4 dw = {0.f, 0.f, 0.f, 0.f}, da = {0.f, 0.f, 0.f, 0.f}, dg = {0.f, 0.f, 0.f, 0.f};
#pragma unroll
                for (int ks = 0; ks < 2; ++ks) {
                    dw = __builtin_amdgcn_mfma_f32_16x16x32_f16(*(const rw_f16x8*)(ap + ks * 32), bw[ks], dw, 0, 0, 0);
                    da = __builtin_amdgcn_mfma_f32_16x16x32_f16(*(const rw_f16x8*)(ap + 64 + ks * 32), ba_[ks], da, 0, 0, 0);
                }
#pragma unroll
                for (int ks = 0; ks < 4; ++ks) dg = __builtin_amdgcn_mfma_f32_16x16x32_f16(*(const rw_f16x8*)(ap + 128 + ks * 32), bg[ks], dg, 0, 0, 0);
#pragma unroll
                for (int rg = 0; rg < 4; ++rg) { const int o = (mt * 16 + 4 * (lane >> 4) + rg) * 64 + nt * 16 + (lane & 15); w_s[o] = dw[rg]; ka_s[o] = da[rg]; g_s[o] = dg[rg]; }
            }
#endif
            __syncthreads();
            RW_ROLES();
            {
            const float w0 = cst_s[0 * 64 + c], a0 = cst_s[1 * 64 + c], k_k = cst_s[2 * 64 + c], k_a = cst_s[3 * 64 + c], rk_c = cst_s[4 * 64 + c];
#pragma unroll
            for (int s = 0; s < 4; ++s) {
                const int tl = tg * 4 + s;
                const float w_log = -softplusf_(-(w0 + w_s[tl * 64 + c])) - 0.5f;
                const float decay = fexp_(-fexp_(w_log));
                const float a = sigmoidf_(a0 + ka_s[tl * 64 + c]);
                const float kx = k_s[tl * 64 + c], rx = r_s[tl * 64 + c];
                const float kkr = kx * k_k, k2 = kx * (1.0f + (a - 1.0f) * k_a);
                const float nsq = group_sum(kkr * kkr, 64, scr);
                const float bon = group_sum(rx * k2 * rk_c, 64, scr);
                const float kkn = kkr * rsqrtf(nsq + RMS_EPS);
                w_s[tl * 64 + c] = decay; k_s[tl * 64 + c] = k2; kk_s[tl * 64 + c] = kkn; ka_s[tl * 64 + c] = kkn * a;
                if (c == 0) bon_s[tl] = bon;
            }
            }
            __syncthreads();
            RW_ROLES();
            {
                struct StepVec { float4 kk0, kk1, w0, w1, a0, a1, k0, k1, r0, r1; float vi; };
#define RW_LDSTEP(V_, t_) do { const int o8_ = (t_) * 64 + q8 * 8; V_.kk0 = *(const float4*)(kk_s + o8_); V_.kk1 = *(const float4*)(kk_s + o8_ + 4); V_.w0 = *(const float4*)(w_s + o8_); V_.w1 = *(const float4*)(w_s + o8_ + 4); \
                    V_.a0 = *(const float4*)(ka_s + o8_); V_.a1 = *(const float4*)(ka_s + o8_ + 4); V_.k0 = *(const float4*)(k_s + o8_); V_.k1 = *(const float4*)(k_s + o8_ + 4); \
                    V_.r0 = *(const float4*)(r_s + o8_); V_.r1 = *(const float4*)(r_s + o8_ + 4); V_.vi = v_s[(t_) * 64 + ri]; } while (0)
#define RW_STEP(V_, t_) do { \
                    const float pk = (S[0] * V_.kk0.x + S[1] * V_.kk0.y) + (S[2] * V_.kk0.z + S[3] * V_.kk0.w) + ((S[4] * V_.kk1.x + S[5] * V_.kk1.y) + (S[6] * V_.kk1.z + S[7] * V_.kk1.w)); \
                    const float skk = group_sum(pk, 8, scr); const float vi = V_.vi; \
                    S[0] = S[0] * V_.w0.x - skk * V_.a0.x + vi * V_.k0.x; S[1] = S[1] * V_.w0.y - skk * V_.a0.y + vi * V_.k0.y; S[2] = S[2] * V_.w0.z - skk * V_.a0.z + vi * V_.k0.z; S[3] = S[3] * V_.w0.w - skk * V_.a0.w + vi * V_.k0.w; \
                    S[4] = S[4] * V_.w1.x - skk * V_.a1.x + vi * V_.k1.x; S[5] = S[5] * V_.w1.y - skk * V_.a1.y + vi * V_.k1.y; S[6] = S[6] * V_.w1.z - skk * V_.a1.z + vi * V_.k1.z; S[7] = S[7] * V_.w1.w - skk * V_.a1.w + vi * V_.k1.w; \
                    const float po = (S[0] * V_.r0.x + S[1] * V_.r0.y) + (S[2] * V_.r0.z + S[3] * V_.r0.w) + ((S[4] * V_.r1.x + S[5] * V_.r1.y) + (S[6] * V_.r1.z + S[7] * V_.r1.w)); \
                    const float o = group_sum(po, 8, scr); \
                    if (q8 == 0) o_s[(t_) * 64 + ri] = o; } while (0)
                StepVec va, vb;
                RW_LDSTEP(va, 0);
#pragma unroll 1
                for (int t = 0; t < CH; t += 2) {
                    RW_LDSTEP(vb, t + 1);
                    RW_STEP(va, t);
                    if (t + 2 < CH) RW_LDSTEP(va, t + 2);
                    RW_STEP(vb, t + 1);
                }
#undef RW_LDSTEP
#undef RW_STEP
            }
            if (t0 + CH < T_) RW_LOAD(t0 + CH);
            __syncthreads();
            RW_ROLES();
            {
            const float lnw = cst_s[5 * 64 + c], lnb = cst_s[6 * 64 + c];
            const int ch = h * 64 + c;
#pragma unroll
            for (int s = 0; s < 4; ++s) {
                const int tl = tg * 4 + s;
                const float ov = o_s[tl * 64 + c];
                const float mean = group_sum(ov, 64, scr) * (1.0f / 64.0f);
                const float d = ov - mean;
                const float var = group_sum(d * d, 64, scr) * (1.0f / 64.0f);
                const float y = (d * rsqrtf(var + GN_EPS) * lnw + lnb + bon_s[tl] * v_s[tl * 64 + c]) * g_s[tl * 64 + c];
                ACT[((size_t)b * T_ + t0 + tl) * LDZ + C_YC + ch] = f2h(y);
            }
            }
            RW_ROLES();
            if (t0 + CH < T_) RW_PUT();
            __syncthreads();
        }
#undef RW_LOAD
#undef RW_PUT
#undef RW_ROLES
    }
}

constexpr bool TAB_IN_ACT = false;
constexpr float TAB_SU = 256.0f, TAB_SV = 32.0f;
__device__ __forceinline__ unsigned char* tab_row(char* ws, int e) {
    if (TAB_IN_ACT) return (unsigned char*)((h16_t*)(ws + OFF_ACT) + (size_t)e * LDZ + C_GS);
    return (unsigned char*)(ws + OFF_TAB) + (size_t)e * 2048;
}
#ifdef CPU_EMU
__device__ __forceinline__ unsigned f2fp8(float f) {
    const unsigned sgn = f < 0.f ? 0x80u : 0u; float a = fabsf(f);
    if (!(a == a)) return 0x7fu;
    if (a >= 448.0f) return sgn | 0x7eu;
    if (a < 0.0009765625f) return sgn;
    int e; frexpf(a, &e); e -= 1;
    if (e < -6) { const float q = nearbyintf(a * 512.0f); return sgn | (unsigned)q; }
    float q = nearbyintf((a / ldexpf(1.0f, e) - 1.0f) * 8.0f);
    if (q >= 8.0f) { q = 0.f; e += 1; }
    if (e > 8) return sgn | 0x7eu;
    const unsigned r = ((unsigned)(e + 7) << 3) | (unsigned)q;
    return sgn | (r > 0x7eu ? 0x7eu : r);
}
__device__ __forceinline__ float fp82f(unsigned b) {
    const unsigned e = (b >> 3) & 15u, m = b & 7u; const float s = (b & 0x80u) ? -1.f : 1.f;
    if (e == 0) return s * (float)m * 0.001953125f;
    return s * ldexpf(1.0f + (float)m * 0.125f, (int)e - 7);
}
__device__ __forceinline__ unsigned pack4fp8(float a, float b, float c, float d) { return f2fp8(a) | (f2fp8(b) << 8) | (f2fp8(c) << 16) | (f2fp8(d) << 24); }
__device__ __forceinline__ void dec4fp8(unsigned w, float* o) { o[0] = fp82f(w & 255u); o[1] = fp82f((w >> 8) & 255u); o[2] = fp82f((w >> 16) & 255u); o[3] = fp82f(w >> 24); }
#else
__device__ __forceinline__ unsigned pack4fp8(float a, float b, float c, float d) { int p = __builtin_amdgcn_cvt_pk_fp8_f32(a, b, 0, false); p = __builtin_amdgcn_cvt_pk_fp8_f32(c, d, p, true); return (unsigned)p; }
__device__ __forceinline__ void dec4fp8(unsigned w, float* o) { const auto lo = __builtin_amdgcn_cvt_pk_f32_fp8((int)w, false); const auto hi = __builtin_amdgcn_cvt_pk_f32_fp8((int)w, true); o[0] = lo[0]; o[1] = lo[1]; o[2] = hi[0]; o[3] = hi[1]; }
#endif
__device__ __forceinline__ void stage_tabconv(KParams p, int l, int vb0, int nvb) {
    const int vb = bid_() - vb0;
    if (vb < 0 || vb >= nvb) return;
    const int tid = tid_();
    const float* U = p->in[I_PU] + (size_t)l * 16384 * 1024; const float* V = p->in[I_PV] + (size_t)l * 16384 * 1024;
    char* ws = p->ws;
    for (int it = vb * NT + tid; it < 16384 * 128; it += nvb * NT) {
        const int r = it >> 7, ck = it & 127, which = ck >> 6, c16 = ck & 63;
        const float* src = (which ? V : U) + (size_t)r * 1024 + c16 * 16;
        const float sc = which ? TAB_SV : TAB_SU;
        const float4 a = *(const float4*)src, b = *(const float4*)(src + 4), c = *(const float4*)(src + 8), d = *(const float4*)(src + 12);
        uint4 w;
        w.x = pack4fp8(a.x * sc, a.y * sc, a.z * sc, a.w * sc); w.y = pack4fp8(b.x * sc, b.y * sc, b.z * sc, b.w * sc);
        w.z = pack4fp8(c.x * sc, c.y * sc, c.z * sc, c.w * sc); w.w = pack4fp8(d.x * sc, d.y * sc, d.z * sc, d.w * sc);
        *(uint4*)(tab_row(ws, r) + which * 1024 + c16 * 16) = w;
    }
}

#ifdef CPU_EMU
__device__ __forceinline__ float group_max16(float v, float* scr) {
    const int tid = tid_();
    scr[tid] = v;
    __syncthreads();
    float m = -3.0e38f; const int base = tid & ~15;
    for (int i = 0; i < 16; ++i) m = fmaxf(m, scr[base + i]);
    __syncthreads();
    return m;
}
#else
__device__ __forceinline__ float group_max16(float v, float*) {
    v = fmaxf(v, dpp_f<0xB1>(v)); v = fmaxf(v, dpp_f<0x4E>(v)); v = fmaxf(v, dpp_f<0x141>(v)); v = fmaxf(v, dpp_f<0x140>(v));
    return v;
}
#endif
__device__ __forceinline__ void stage_peer_topk(KParams p, int l, char* smem) {
    constexpr int KS = 136;
    h16_t* khi = (h16_t*)smem;
    h16_t* klo = khi + 128 * KS;
    float* scr = (float*)(klo + 128 * KS);
    const h16_t* ACT = (const h16_t*)(p->ws + OFF_ACT);
    float* TOPS = (float*)(p->ws + OFF_TOPS);
    int tid = tid_(), lane = tid & 63, w = tid >> 6, g = lane >> 4, r16 = lane & 15;
#define TK_ROLES() do { tid = tid_(); lane = tid & 63; w = tid >> 6; g = lane >> 4; r16 = lane & 15; } while (0)
    const int nb = gridDim.x;
    for (int hs = bid_() % 16; hs < 16; hs += nb) {
        const int hd = hs >> 1, s = hs & 1;
        __syncthreads();
        {
            const float* kp = p->in[I_PKEYS] + (((size_t)l * 8 + hd) * 2 + s) * 128 * 128;
            for (int i = tid * 4; i < 128 * 128; i += NT * 4) {
                const float4 kv = *(const float4*)(kp + i);
                const int n = i >> 7, c0 = i & 127;
                const float h0 = h2f(f2h(kv.x)), h1 = h2f(f2h(kv.y)), h2 = h2f(f2h(kv.z)), h3 = h2f(f2h(kv.w));
                uint2 hw, lw; hw.x = pack2h(kv.x, kv.y); hw.y = pack2h(kv.z, kv.w); lw.x = pack2h(kv.x - h0, kv.y - h1); lw.y = pack2h(kv.z - h2, kv.w - h3);
                *(uint2*)(khi + n * KS + c0) = hw; *(uint2*)(klo + n * KS + c0) = lw;
            }
        }
        __syncthreads();
        const int nblk = nb >= 16 ? nb / 16 : 1, bsub = nb >= 16 ? bid_() / 16 : 0;
        for (int chunk = bsub; chunk < (M_ + NT - 1) / NT; chunk += nblk) {
            if (nb >= 16 && bid_() >= nblk * 16) break;
#pragma unroll 1
            for (int tt = 0; tt < 4; ++tt) {
                TK_ROLES();
                const int tok0 = chunk * NT + w * 64 + tt * 16;
                const bool live = tok0 < M_;
                hfrag af[4];
                {
                    const h16_t* qp = ACT + (size_t)(live ? tok0 + r16 : 0) * LDZ + C_QRY + hd * 256 + s * 128 + 8 * g;
#pragma unroll
                    for (int ks = 0; ks < 4; ++ks) af[ks] = frag_u4(*(const uint4*)(qp + 32 * ks));
                }
                facc acc[8];
#pragma unroll
                for (int nt = 0; nt < 8; ++nt) {
                    acc[nt] = facc_zero();
                    const h16_t* bh = khi + (16 * nt + r16) * KS + 8 * g; const h16_t* bl = klo + (16 * nt + r16) * KS + 8 * g;
#pragma unroll
                    for (int ks = 0; ks < 4; ++ks) { acc[nt] = mfma16(af[ks], frag_u4(*(const uint4*)(bh + 32 * ks)), acc[nt]); acc[nt] = mfma16(af[ks], frag_u4(*(const uint4*)(bl + 32 * ks)), acc[nt]); }
                }
#pragma unroll 1
                for (int rp = 0; rp < 2; ++rp) {
                  TK_ROLES();
#pragma unroll
                  for (int r2 = 0; r2 < 2; ++r2) {
                    const int reg = rp * 2 + r2;
                    float v[8];
#pragma unroll
                    for (int nt = 0; nt < 8; ++nt) { const float av = rp == 0 ? (r2 == 0 ? acc[nt][0] : acc[nt][1]) : (r2 == 0 ? acc[nt][2] : acc[nt][3]); v[nt] = __uint_as_float((__float_as_uint(av) & ~127u) | (unsigned)(127 - (16 * nt + r16))); }
#define CE(i, j) { const float hi_ = fmaxf(v[i], v[j]), lo_ = fminf(v[i], v[j]); v[i] = hi_; v[j] = lo_; }
                    CE(0, 1) CE(2, 3) CE(4, 5) CE(6, 7) CE(0, 2) CE(1, 3) CE(4, 6) CE(5, 7) CE(1, 2) CE(5, 6) CE(0, 4) CE(1, 5) CE(2, 6) CE(3, 7) CE(2, 4) CE(3, 5) CE(1, 2) CE(3, 4) CE(5, 6)
#undef CE
                    float res = 0.f;
#pragma unroll
                    for (int rnd = 0; rnd < 16; ++rnd) {
                        const float m = group_max16(v[0], scr);
                        const bool win = v[0] == m;
#pragma unroll
                        for (int i = 0; i < 7; ++i) v[i] = win ? v[i + 1] : v[i];
                        v[7] = win ? -3.0e38f : v[7];
                        res = (r16 == rnd) ? m : res;
                    }
                    if (live) TOPS[(((size_t)(tok0 + 4 * g + reg) * 8 + hd) * 2 + s) * 16 + r16] = res;
                  }
                }
            }
        }
    }
}

#undef TK_ROLES
__device__ __forceinline__ void peer_cand(int k, int& i, int& j) {
    if (k < 16) { i = 0; j = k; } else if (k < 24) { i = 1; j = k - 16; } else if (k < 29) { i = 2; j = k - 24; } else if (k < 33) { i = 3; j = k - 29; }
    else if (k < 36) { i = 4; j = k - 33; } else if (k < 38) { i = 5; j = k - 36; } else if (k < 40) { i = 6; j = k - 38; } else if (k < 42) { i = 7; j = k - 40; }
    else { i = k - 34; j = 0; }
}
__device__ __forceinline__ float dot16q(const uint4 a, const float (&x)[16]) {
    float t[4], s0, s1;
    dec4fp8(a.x, t); s0 = t[0] * x[0] + t[1] * x[1]; s1 = t[2] * x[2] + t[3] * x[3];
    dec4fp8(a.y, t); s0 += t[0] * x[4] + t[1] * x[5]; s1 += t[2] * x[6] + t[3] * x[7];
    dec4fp8(a.z, t); s0 += t[0] * x[8] + t[1] * x[9]; s1 += t[2] * x[10] + t[3] * x[11];
    dec4fp8(a.w, t); s0 += t[0] * x[12] + t[1] * x[13]; s1 += t[2] * x[14] + t[3] * x[15];
    return s0 + s1;
}
__device__ __forceinline__ void axpy16q(const uint4 a, float s, float (&y)[16]) {
    float t[4];
    dec4fp8(a.x, t); y[0] += s * t[0]; y[1] += s * t[1]; y[2] += s * t[2]; y[3] += s * t[3];
    dec4fp8(a.y, t); y[4] += s * t[0]; y[5] += s * t[1]; y[6] += s * t[2]; y[7] += s * t[3];
    dec4fp8(a.z, t); y[8] += s * t[0]; y[9] += s * t[1]; y[10] += s * t[2]; y[11] += s * t[3];
    dec4fp8(a.w, t); y[12] += s * t[0]; y[13] += s * t[1]; y[14] += s * t[2]; y[15] += s * t[3];
}
#ifdef CPU_EMU
__device__ __forceinline__ float lane_xor(float v, int mask, float* scr) { const int tid = tid_(); scr[tid] = v; __syncthreads(); const float r = scr[tid ^ mask]; __syncthreads(); return r; }
__device__ __forceinline__ float lane_bcast(float v, int src, float* scr) { const int tid = tid_(); scr[tid] = v; __syncthreads(); const float r = scr[(tid & ~63) + src]; __syncthreads(); return r; }
#else
__device__ __forceinline__ float lane_xor(float v, int mask, float*) { return mask == 1 ? dpp_f<0xB1>(v) : (mask == 2 ? dpp_f<0x4E>(v) : __shfl_xor(v, mask)); }
__device__ __forceinline__ float lane_bcast(float v, int src, float*) { return __builtin_bit_cast(float, __builtin_amdgcn_readlane(__builtin_bit_cast(int, v), src)); }
#endif
__device__ __forceinline__ float reduce8(const float (&v)[8], int lane, float* scr) {
    const bool b0 = lane & 1, b1 = lane & 2, b2 = lane & 4;
    float w4[4], u2[2];
#pragma unroll
    for (int j = 0; j < 4; ++j) { const float keep = b0 ? v[2 * j + 1] : v[2 * j], send = b0 ? v[2 * j] : v[2 * j + 1]; w4[j] = keep + lane_xor(send, 1, scr); }
#pragma unroll
    for (int j = 0; j < 2; ++j) { const float keep = b1 ? w4[2 * j + 1] : w4[2 * j], send = b1 ? w4[2 * j] : w4[2 * j + 1]; u2[j] = keep + lane_xor(send, 2, scr); }
    float z = (b2 ? u2[1] : u2[0]) + lane_xor(b2 ? u2[0] : u2[1], 4, scr);
    z += lane_xor(z, 8, scr); z += lane_xor(z, 16, scr); z += lane_xor(z, 32, scr);
    return z;
}
#ifdef CPU_EMU
#define PG_WSYNC() __syncthreads()
#else
#define PG_WSYNC() do { __builtin_amdgcn_fence(__ATOMIC_RELEASE, "wavefront"); __builtin_amdgcn_wave_barrier(); __builtin_amdgcn_fence(__ATOMIC_ACQUIRE, "wavefront"); } while (0)
#endif
__device__ __forceinline__ void stage_peer_gather(KParams p, int l, char* smem) {
    int tid = tid_(), w = tid >> 6, lane = tid & 63;
    float* base; float* tops_s; float* cand_s; float* best_s; int* idx_s; float* gate_s; int* pos_s;
#define PG_ROLES() do { tid = tid_(); w = tid >> 6; lane = tid & 63; base = (float*)smem + w * 2048; tops_s = base; cand_s = tops_s + 256; best_s = cand_s + 64; \
        idx_s = (int*)(best_s + 128); gate_s = (float*)(idx_s + 128); pos_s = (int*)(gate_s + 128); } while (0)
    PG_ROLES();
    float* scr = (float*)smem + 8 * 2048;
    h16_t* ACT = (h16_t*)(p->ws + OFF_ACT);
    const float* TOPS = (const float*)(p->ws + OFF_TOPS);
    char* ws = p->ws;
    const float* nxt_w = (l + 1 < NL_) ? p->in[I_NMIX] + (l + 1) * 1024 : p->in[I_NFINAL];
    const int nwaves = gridDim.x * 8;
    for (int m = bid_() * 8 + w; m < M_; m += nwaves) {
        PG_ROLES();
        PG_WSYNC();
        *(float4*)(tops_s + lane * 4) = *(const float4*)(TOPS + (size_t)m * 256 + lane * 4);
        float x[16];
        { float t8[8]; load8h(ACT + (size_t)m * LDZ + C_XN + lane * 16, t8);
#pragma unroll
          for (int j = 0; j < 8; ++j) x[j] = t8[j];
          load8h(ACT + (size_t)m * LDZ + C_XN + lane * 16 + 8, t8);
#pragma unroll
          for (int j = 0; j < 8; ++j) x[8 + j] = t8[j]; }
        PG_WSYNC();
        int ci = 0, cj = 0;
        if (lane < 50) peer_cand(lane, ci, cj);
        const int pos = ci * 16 + cj;
        pos_s[lane] = pos;
#pragma unroll 1
        for (int hd = 0; hd < 8; ++hd) {
            const float cs = lane < 50 ? tops_s[hd * 32 + ci] + tops_s[hd * 32 + 16 + cj] : -3.0e38f;
            cand_s[lane] = cs;
            PG_WSYNC();
            if (lane < 50) {
                int cnt = 0;
#pragma unroll 10
                for (int o = 0; o < 50; ++o) { const float ov = cand_s[o]; cnt += (ov > cs || (ov == cs && pos_s[o] < pos)) ? 1 : 0; }
                if (cnt < 16) {
                    best_s[hd * 16 + cnt] = cs;
                    const int n0 = 127 - (int)(__float_as_uint(tops_s[hd * 32 + ci]) & 127u), n1 = 127 - (int)(__float_as_uint(tops_s[hd * 32 + 16 + cj]) & 127u);
                    idx_s[hd * 16 + cnt] = n0 * 128 + n1;
                }
            }
            PG_WSYNC();
        }
#pragma unroll
        for (int rr = 0; rr < 2; ++rr) {
            const int e = lane + 64 * rr, hd = e >> 4;
            const float mx = best_s[hd * 16];
            float sum = 0.f;
#pragma unroll
            for (int i = 0; i < 16; ++i) sum += fexp_(best_s[hd * 16 + i] - mx);
            gate_s[e] = fexp_(best_s[e] - mx) / sum;
        }
        PG_WSYNC();
        float y[16];
#pragma unroll
        for (int i = 0; i < 16; ++i) y[i] = 0.f;
        PG_ROLES();
        uint4 uu[8], vv[8];
#define PG_LOADU(eb_) do { _Pragma("unroll") for (int k = 0; k < 8; ++k) uu[k] = *(const uint4*)(tab_row(ws, idx_s[(eb_) + k]) + lane * 16); } while (0)
#define PG_LOADV(eb_) do { _Pragma("unroll") for (int k = 0; k < 8; ++k) vv[k] = *(const uint4*)(tab_row(ws, idx_s[(eb_) + k]) + 1024 + lane * 16); } while (0)
        PG_LOADU(0); PG_LOADV(0);
#pragma unroll 1
        for (int eb = 0; eb < 128; eb += 8) {
            float d8[8];
#pragma unroll
            for (int k = 0; k < 8; ++k) d8[k] = dot16q(uu[k], x);
            if (eb + 8 < 128) PG_LOADU(eb + 8);
            const float tot = reduce8(d8, lane, scr);
            const float hk = gate_s[eb + (lane & 7)] * geluf_(tot * (1.0f / TAB_SU));
#pragma unroll
            for (int k = 0; k < 8; ++k) axpy16q(vv[k], lane_bcast(hk, k, scr), y);
            if (eb + 8 < 128) PG_LOADV(eb + 8);
        }
#undef PG_LOADU
#undef PG_LOADV
        PG_ROLES();
        float* op = p->out + (size_t)m * 1024 + lane * 16;
        float hn[16]; float ss = 0.f;
#pragma unroll
        for (int i = 0; i < 16; i += 4) {
            const float4 o4 = *(const float4*)(op + i);
            hn[i] = o4.x + y[i] * (1.0f / TAB_SV); hn[i + 1] = o4.y + y[i + 1] * (1.0f / TAB_SV); hn[i + 2] = o4.z + y[i + 2] * (1.0f / TAB_SV); hn[i + 3] = o4.w + y[i + 3] * (1.0f / TAB_SV);
            ss += hn[i] * hn[i] + hn[i + 1] * hn[i + 1] + hn[i + 2] * hn[i + 2] + hn[i + 3] * hn[i + 3];
        }
        ss = group_sum(ss, 64, scr);
        const float rstd = rsqrtf(ss * (1.0f / D_) + RMS_EPS);
        float nv[16];
#pragma unroll
        for (int i = 0; i < 16; i += 4) { const float4 w4 = *(const float4*)(nxt_w + lane * 16 + i); nv[i] = hn[i] * rstd * w4.x; nv[i + 1] = hn[i + 1] * rstd * w4.y; nv[i + 2] = hn[i + 2] * rstd * w4.z; nv[i + 3] = hn[i + 3] * rstd * w4.w; }
        if (l + 1 < NL_) {
#pragma unroll
            for (int i = 0; i < 16; i += 4) *(float4*)(op + i) = make_float4(hn[i], hn[i + 1], hn[i + 2], hn[i + 3]);
            const float n0[8] = {nv[0], nv[1], nv[2], nv[3], nv[4], nv[5], nv[6], nv[7]}, n1[8] = {nv[8], nv[9], nv[10], nv[11], nv[12], nv[13], nv[14], nv[15]};
            store8h(ACT + (size_t)m * LDZ + C_XN + lane * 16, n0); store8h(ACT + (size_t)m * LDZ + C_XN + lane * 16 + 8, n1);
        } else {
#pragma unroll
            for (int i = 0; i < 16; i += 4) *(float4*)(op + i) = make_float4(nv[i], nv[i + 1], nv[i + 2], nv[i + 3]);
        }
    }
}
#undef PG_ROLES
#undef PG_WSYNC

enum { PH_NORM_MIX = 0, PH_INPROJ, PH_MIXERS, PH_MERGE, PH_WOUT, PH_NORM_FFN, PH_QUERY, PH_TOPK, PH_GATHER, PH_PER_LAYER, PH_FINAL = 100, PH_WPREP = 101 };
__device__ __forceinline__ void run_phase(KParams p, int l, int ph, char* smem) {
    h16_t* ACT = (h16_t*)(p->ws + OFF_ACT);
    const float* hin = l == 0 ? p->in[I_X] : p->out;
    switch (ph) {
    case PH_WPREP: stage_wprep(p, smem); break;
    case PH_NORM_MIX: if (l == 0) stage_rmsnorm(hin, p->in[I_NMIX] + l * 1024, ACT + C_XN, LDZ, smem); break;
    case PH_INPROJ: stage_gemm(p, l, GP_INPROJ, smem); break;
    case PH_MIXERS: {
        const int nb = gridDim.x, n_rw = nb / 2, n_gd = nb / 4, n_lr = nb - n_rw - n_gd;
        stage_rwkv(p, l, smem, 0, n_rw);
        stage_gdn(p, l, smem, n_rw, n_gd);
        stage_lru(p, l, smem, n_rw + n_gd, n_lr);
        stage_tabconv(p, l, n_rw + n_gd, n_lr);
    } break;
    case PH_MERGE: stage_gemm(p, l, GP_MERGE, smem); break;
    case PH_WOUT: stage_gemm(p, l, GP_WOUT, smem); break;
    case PH_NORM_FFN: stage_rmsnorm(p->out, p->in[I_NFFN] + l * 1024, ACT + C_XN, LDZ, smem); break;
    case PH_QUERY: stage_gemm(p, l, GP_QUERY, smem); break;
    case PH_TOPK: stage_peer_topk(p, l, smem); break;
    case PH_GATHER: stage_peer_gather(p, l, smem); break;
    case PH_FINAL: break;
    default: break;
    }
}


#if !defined(CPU_EMU) && !MK_MULTI
#define XB_TMO      128
#define XB_XCNT(j)  (256  + 64 * (j))
#define XB_XSUB(j)  (1280 + 64 * (j))
#define XB_XGEN(j)  (2304 + 64 * (j))
#define XB_TOP      3328
#define XB_TOPGEN   3392
#define XCD_BAR_WORDS 3456
#define XB_SPIN_CAP (1u << 22)
#define XB_LAS __attribute__((address_space(3)))
__device__ __forceinline__ unsigned xb_ld(unsigned* p)              { return __hip_atomic_load(p, __ATOMIC_RELAXED, __HIP_MEMORY_SCOPE_AGENT); }
__device__ __forceinline__ unsigned xb_add(unsigned* p, unsigned v) { return __hip_atomic_fetch_add(p, v, __ATOMIC_RELAXED, __HIP_MEMORY_SCOPE_AGENT); }
__device__ __forceinline__ unsigned xb_xcc_id() { return (unsigned)__builtin_amdgcn_s_getreg((3 << 11) | 20) & 0xFu; }
#define XB_SPIN(cond, bar) do { unsigned _sp = 0; while (cond) { __builtin_amdgcn_s_sleep(1); \
    if ((++_sp & 255u) == 0u) { if (xb_ld(&(bar)[XB_TMO])) break; if (_sp > XB_SPIN_CAP) { atomicAdd(&(bar)[XB_TMO], 1u); break; } } } } while (0)
struct XcdBarrier { unsigned* bar; unsigned x; volatile XB_LAS unsigned* st; };
__device__ __forceinline__ XcdBarrier xcd_barrier_post(unsigned* bar, volatile XB_LAS unsigned* st) {
    XcdBarrier b; b.bar = bar; b.x = xb_xcc_id(); b.st = st;
    if (threadIdx.x == 0) (void)xb_add(&bar[XB_XCNT(b.x)], 1u);
    return b;
}
__device__ __forceinline__ void xcd_barrier_complete(unsigned* bar, unsigned x, unsigned& nloc, unsigned& nx) {
    const unsigned G = gridDim.x * gridDim.y * gridDim.z;
    unsigned sum, cnt, mine, sp = 0u;
    for (;;) {
        sum = 0u; cnt = 0u; mine = 0u;
#pragma unroll
        for (unsigned j = 0; j < 16; ++j) { const unsigned c = xb_ld(&bar[XB_XCNT(j)]); sum += c; cnt += (c > 0u) ? 1u : 0u; mine = (j == x) ? c : mine; }
        if (sum == G) break;
        __builtin_amdgcn_s_sleep(1);
        if ((++sp & 255u) == 0u) { if (xb_ld(&bar[XB_TMO])) break; if (sp > XB_SPIN_CAP) { atomicAdd(&bar[XB_TMO], 1u); break; } }
    }
    nloc = mine > 0u ? mine : 1u; nx = cnt > 0u ? cnt : 1u;
}
__device__ __forceinline__ void xcd_barrier(const XcdBarrier& b) {
    asm volatile("s_waitcnt vmcnt(0)" ::: "memory");
    __syncthreads();
    if (threadIdx.x == 0) {
        unsigned* bar = b.bar;
        __builtin_amdgcn_s_waitcnt(0);
        unsigned nloc = b.st[0], nx = b.st[1];
        if (nloc == 0u) { xcd_barrier_complete(bar, b.x, nloc, nx); b.st[0] = nloc; b.st[1] = nx; }
        const unsigned old = xb_add(&bar[XB_XSUB(b.x)], 1u);
        const unsigned gen = old / nloc;
        if (old + 1u == (gen + 1u) * nloc) {
            __builtin_amdgcn_fence(__ATOMIC_RELEASE, "agent");
            asm volatile("s_waitcnt vmcnt(0)" ::: "memory");
            const unsigned og = xb_add(&bar[XB_TOP], 1u);
            const unsigned tg = og / nx;
            if (og + 1u == (tg + 1u) * nx) xb_add(&bar[XB_TOPGEN], 1u);
            else XB_SPIN(xb_ld(&bar[XB_TOPGEN]) == tg, bar);
            __builtin_amdgcn_fence(__ATOMIC_ACQUIRE, "agent");
            xb_add(&bar[XB_XGEN(b.x)], 1u);
            asm volatile("s_waitcnt vmcnt(0)" ::: "memory");
        } else {
            XB_SPIN(xb_ld(&bar[XB_XGEN(b.x)]) == gen, bar);
            __builtin_amdgcn_fence(__ATOMIC_ACQUIRE, "agent");
            asm volatile("s_waitcnt vmcnt(0)" ::: "memory");
        }
    }
    __syncthreads();
}
#endif
#if !defined(CPU_EMU) && !MK_MULTI
__global__ void __launch_bounds__(512, 2) k_mega(Params p_) {
    DYN_SMEM(smem);
    KParams pk = (KParams)__builtin_amdgcn_kernarg_segment_ptr();
    cg::grid_group grid = cg::this_grid();
    volatile XB_LAS unsigned* xst = (volatile XB_LAS unsigned*)(XB_LAS char*)(smem + SMEM_BYTES);
    if (threadIdx.x == 0) { xst[0] = 0u; xst[1] = 0u; xst[2] = 0u; xst[3] = 0u; }
    __syncthreads();
    const XcdBarrier xb = xcd_barrier_post((unsigned*)(pk->ws + OFF_BAR), xst);
    if (gridDim.x > 0x100000u) grid.sync();
    constexpr int NIT = NL_ * PH_PER_LAYER;
#pragma unroll 1
    for (int it = -1; it <= NIT; ++it) {
        const int l = (it >= 0 && it < NIT) ? it / PH_PER_LAYER : 0, ph = it < 0 ? (int)PH_WPREP : (it < NIT ? it % PH_PER_LAYER : (int)PH_FINAL);
        KParams q = pk; asm volatile("" : "+s"(q));
        run_phase(q, l, ph, smem);
        if (it >= 0 && it < NIT - 1 && !(l > 0 && ph == PH_NORM_MIX)) {
            xcd_barrier(xb);
        }
    }
}
#endif
#ifdef CPU_EMU
__global__ void k_phase(Params p_, int l, int ph) { DYN_SMEM(smem); run_phase(&p_, l, ph, smem); }
#elif MK_MULTI
__global__ void __launch_bounds__(512, 2) k_phase(Params p_, int l, int ph) { DYN_SMEM(smem); KParams pk = (KParams)__builtin_amdgcn_kernarg_segment_ptr(); run_phase(pk, l, ph, smem); }
#endif
}

#ifdef CPU_EMU
int g_emu_stop = 1000;
#endif

extern "C" void kernel_launch(void* const* d_in, const int* in_sizes, int n_in, void* d_out, int out_size, void* d_ws, size_t ws_size, hipStream_t stream) {
    Params p{};
    for (int i = 0; i < N_IN; ++i) p.in[i] = (const float*)d_in[i];
    p.out = (float*)d_out; p.ws = (char*)d_ws;
#if defined(CPU_EMU) || MK_MULTI
    const int grid = 256;
    LAUNCH(k_phase, grid, NT, SMEM_BYTES, stream, p, 0, (int)PH_WPREP);
    for (int l = 0; l < NL_; ++l)
        for (int ph = 0; ph < PH_PER_LAYER; ++ph) {
            LAUNCH(k_phase, grid, NT, SMEM_BYTES, stream, p, l, ph);
#ifdef CPU_EMU
            const int code = ph == PH_INPROJ ? 1 : ph == PH_MIXERS ? 2 : ph == PH_MERGE ? 3 : ph == PH_WOUT ? 4 : ph == PH_GATHER ? 5 : 0;
            if (code && g_emu_stop == l * 10 + code) return;
#endif
        }
    LAUNCH(k_phase, grid, NT, SMEM_BYTES, stream, p, 0, (int)PH_FINAL);
#else
    static int grid_blocks = 0;
    if (!grid_blocks) {
        int dev = 0, cus = 0, per_cu = 0;
        (void)hipGetDevice(&dev);
        (void)hipDeviceGetAttribute(&cus, hipDeviceAttributeMultiprocessorCount, dev);
        (void)hipFuncSetAttribute((const void*)k_mega, hipFuncAttributeMaxDynamicSharedMemorySize, (int)SMEM_BYTES + 16);
        (void)hipOccupancyMaxActiveBlocksPerMultiprocessor(&per_cu, k_mega, NT, SMEM_BYTES + 16);
        if (per_cu > 1) per_cu = 1;
        grid_blocks = cus * per_cu;
    }
    (void)hipMemsetAsync((char*)d_ws + OFF_BAR, 0, 16384, stream);
    void* args[] = {&p};
    hipError_t e = hipLaunchCooperativeKernel((void*)k_mega, dim3(grid_blocks), dim3(NT), args, SMEM_BYTES + 16, stream);
    if (e != hipSuccess) fprintf(stderr, "cooperative launch failed: %s (grid %d)\n", hipGetErrorString(e), grid_blocks);
#endif
}
```

```cpp
#ifndef CPU_EMU
#include <hip/hip_runtime.h>
#include <hip/hip_cooperative_groups.h>
#include <cstdio>
#include <cstdint>
namespace cg = cooperative_groups;
#define DYN_SMEM(name) extern __shared__ __attribute__((aligned(16))) char name[]
#define LAUNCH(kern, grid, block, smem, stream, ...) hipLaunchKernelGGL(kern, dim3(grid), dim3(block), smem, stream, __VA_ARGS__)
#endif

#ifndef CFG_B
#define CFG_B 8
#endif
#ifndef CFG_T
#define CFG_T 2048
#endif
#ifndef MK_MULTI
#define MK_MULTI 0
#endif

namespace {
constexpr int B_ = CFG_B, T_ = CFG_T, M_ = B_ * T_, D_ = 1024, NL_ = 2, NT = 512;
constexpr int INW = 12560;
constexpr int LDZ = 11776;
constexpr int Z_ULRU = 0, Z_GLRU = 1024, Z_Q = 2048, Z_K = 3072, Z_V = 4096, Z_ZG = 5120, Z_RW = 6144, Z_ALPHA = 9472, Z_BETA = 9480;
constexpr int ZN = 9728;
constexpr int C_XN = 9728, C_YC = 10752;
constexpr int C_YA = Z_GLRU, C_YB = Z_ZG;
constexpr int C_GS = Z_Q, C_MG = Z_K;
constexpr int C_QRY = 0;
constexpr int RW_R = 0, RW_K = 1024, RW_V = 2048, RW_WL = 3072, RW_AL = 3136, RW_GL = 3200, RWW = 3328;
constexpr float RMS_EPS = 1e-6f, GN_EPS = 64e-5f;
typedef unsigned short h16_t;

enum { I_X = 0, I_NMIX, I_NFFN, I_NFINAL, I_WIN, I_LCW, I_LCB, I_LWA, I_LBA, I_LWX, I_LBX, I_LLAM, I_GCW, I_GALOG, I_GDT, I_GNW,
       I_RMU, I_RW0, I_RWUP, I_RA0, I_RAUP, I_RGUP, I_RKK, I_RKA, I_RRK, I_RLW, I_RLB, I_MB, I_PL, I_PG, I_PR, I_WOUT, I_PWQ, I_PKEYS, I_PU, I_PV, N_IN };

struct Params {
    const float* in[N_IN];
    float* out;
    char* ws;
};
#ifdef CPU_EMU
typedef const Params* KParams;
#else
typedef const Params __attribute__((address_space(4)))* KParams;
#endif

constexpr size_t al256(size_t x) { return (x + 255) / 256 * 256; }
constexpr size_t OFF_ACT = 0;
constexpr size_t OFF_WT = al256(OFF_ACT + (size_t)M_ * LDZ * 2);
constexpr int WT_IN = 0, WT_MG = ZN, WT_P = WT_MG + 3072, WT_OUT = WT_P + 3072, WT_Q = WT_OUT + 1024, WT_ROWS = WT_Q + 2048;
constexpr size_t OFF_TOPS = al256(OFF_WT + (size_t)NL_ * WT_ROWS * 1024 * 2);
constexpr size_t OFF_TAB = al256(OFF_TOPS + (size_t)M_ * 256 * 4);
constexpr size_t OFF_BAR = OFF_TAB + (size_t)16384 * 2048;
constexpr size_t WS_END = OFF_BAR + 16384;
static_assert(CFG_B != 8 || CFG_T != 2048 || WS_END <= (size_t)512 * 1024 * 1024, "workspace budget");
constexpr size_t SMEM_BYTES = 128 * 1024;

#ifdef CPU_EMU
__device__ __forceinline__ int tid_() { return threadIdx.x; }
__device__ __forceinline__ h16_t f2h(float f) { return (h16_t)_cvtss_sh(f, _MM_FROUND_TO_NEAREST_INT); }
__device__ __forceinline__ float h2f(h16_t h) { return _cvtsh_ss(h); }
#else
__device__ __forceinline__ int tid_() { int t = threadIdx.x; asm volatile("" : "+v"(t)); return t; }
__device__ __forceinline__ h16_t f2h(float f) { return __builtin_bit_cast(unsigned short, (_Float16)f); }
__device__ __forceinline__ float h2f(h16_t h) { return (float)__builtin_bit_cast(_Float16, h); }
#endif
__device__ __forceinline__ int bid_() { return (int)blockIdx.x; }

#ifdef CPU_EMU
__device__ __forceinline__ float fexp_(float x) { return expf(x); }
__device__ __forceinline__ float flog_(float x) { return logf(x); }
__device__ __forceinline__ float frcp_(float x) { return 1.0f / x; }
#else
__device__ __forceinline__ float fexp_(float x) { return __builtin_amdgcn_exp2f(x * 1.4426950408889634f); }
__device__ __forceinline__ float flog_(float x) { return __builtin_amdgcn_logf(x) * 0.6931471805599453f; }
__device__ __forceinline__ float frcp_(float x) { return __builtin_amdgcn_rcpf(x); }
#endif
__device__ __forceinline__ float sigmoidf_(float x) { return frcp_(1.0f + fexp_(-x)); }
__device__ __forceinline__ float softplusf_(float x) { return fmaxf(x, 0.0f) + flog_(1.0f + fexp_(-fabsf(x))); }
__device__ __forceinline__ float siluf_(float x) { return x * sigmoidf_(x); }
__device__ __forceinline__ float tanhf_(float x) { return 1.0f - 2.0f * frcp_(1.0f + fexp_(2.0f * x)); }
__device__ __forceinline__ float geluf_(float x) { return x * frcp_(1.0f + fexp_(-1.5957691216057308f * (x + 0.044715f * x * x * x))); }
__device__ __forceinline__ unsigned pack2h(float a, float b) { return (unsigned)f2h(a) | ((unsigned)f2h(b) << 16); }
__device__ __forceinline__ void store8h(h16_t* p, const float (&v)[8]) {
    uint4 w; w.x = pack2h(v[0], v[1]); w.y = pack2h(v[2], v[3]); w.z = pack2h(v[4], v[5]); w.w = pack2h(v[6], v[7]);
    *(uint4*)p = w;
}
__device__ __forceinline__ void load8h(const h16_t* p, float (&v)[8]) {
    const uint4 w = *(const uint4*)p;
    v[0] = h2f((h16_t)(w.x & 0xffffu)); v[1] = h2f((h16_t)(w.x >> 16)); v[2] = h2f((h16_t)(w.y & 0xffffu)); v[3] = h2f((h16_t)(w.y >> 16));
    v[4] = h2f((h16_t)(w.z & 0xffffu)); v[5] = h2f((h16_t)(w.z >> 16)); v[6] = h2f((h16_t)(w.w & 0xffffu)); v[7] = h2f((h16_t)(w.w >> 16));
}

__device__ __forceinline__ float block_sum512(float v, float* red) {
    const int tid = tid_();
    red[tid] = v;
    __syncthreads();
    if (tid < 32) { float s = 0.f; for (int i = 0; i < 16; ++i) s += red[tid * 16 + i]; red[512 + tid] = s; }
    __syncthreads();
    float tot = 0.f;
    for (int i = 0; i < 32; ++i) tot += red[512 + i];
    __syncthreads();
    return tot;
}

#ifdef CPU_EMU
__device__ __forceinline__ float wave_sum64(float v, float* scr) {
    const int tid = tid_();
    scr[tid] = v; __syncthreads();
    float s = 0.f; const int base = tid & ~63;
    for (int i = 0; i < 64; ++i) s += scr[base + i];
    __syncthreads();
    return s;
}
#else
__device__ __forceinline__ float wave_sum64(float v, float*) {
    v += __builtin_bit_cast(float, __builtin_amdgcn_mov_dpp(__builtin_bit_cast(int, v), 0xB1, 0xf, 0xf, true));
    v += __builtin_bit_cast(float, __builtin_amdgcn_mov_dpp(__builtin_bit_cast(int, v), 0x4E, 0xf, 0xf, true));
    v += __builtin_bit_cast(float, __builtin_amdgcn_mov_dpp(__builtin_bit_cast(int, v), 0x141, 0xf, 0xf, true));
    v += __builtin_bit_cast(float, __builtin_amdgcn_mov_dpp(__builtin_bit_cast(int, v), 0x140, 0xf, 0xf, true));
    v += __builtin_bit_cast(float, __builtin_amdgcn_update_dpp(0, __builtin_bit_cast(int, v), 0x142, 0xa, 0xf, false));
    v += __builtin_bit_cast(float, __builtin_amdgcn_update_dpp(0, __builtin_bit_cast(int, v), 0x143, 0xc, 0xf, false));
    return __builtin_bit_cast(float, __builtin_amdgcn_readlane(__builtin_bit_cast(int, v), 63));
}
#endif
__device__ __forceinline__ void stage_rmsnorm(const float* src, const float* w, h16_t* dst, int ldd, char* smem) {
    float* scr = (float*)smem;
    const int tid = tid_(), lane = tid & 63, wv = tid >> 6;
    const int nw = gridDim.x * 8;
    float4 wv4[4];
#pragma unroll
    for (int i = 0; i < 4; ++i) wv4[i] = *(const float4*)(w + lane * 16 + i * 4);
    for (int row = bid_() * 8 + wv; row < M_; row += 2 * nw) {
        const int row2 = row + nw; const bool has2 = row2 < M_;
        float4 a[4], b[4];
#pragma unroll
        for (int i = 0; i < 4; ++i) { a[i] = *(const float4*)(src + (size_t)row * D_ + lane * 16 + i * 4); b[i] = has2 ? *(const float4*)(src + (size_t)row2 * D_ + lane * 16 + i * 4) : make_float4(0.f, 0.f, 0.f, 0.f); }
        float sa = 0.f, sb = 0.f;
#pragma unroll
        for (int i = 0; i < 4; ++i) { sa += a[i].x * a[i].x + a[i].y * a[i].y + a[i].z * a[i].z + a[i].w * a[i].w; sb += b[i].x * b[i].x + b[i].y * b[i].y + b[i].z * b[i].z + b[i].w * b[i].w; }
        sa = wave_sum64(sa, scr); sb = wave_sum64(sb, scr);
        const float ra = rsqrtf(sa * (1.0f / D_) + RMS_EPS), rb = rsqrtf(sb * (1.0f / D_) + RMS_EPS);
#pragma unroll
        for (int i = 0; i < 4; i += 2) {
            const float va[8] = {a[i].x * ra * wv4[i].x, a[i].y * ra * wv4[i].y, a[i].z * ra * wv4[i].z, a[i].w * ra * wv4[i].w, a[i + 1].x * ra * wv4[i + 1].x, a[i + 1].y * ra * wv4[i + 1].y, a[i + 1].z * ra * wv4[i + 1].z, a[i + 1].w * ra * wv4[i + 1].w};
            store8h(dst + (size_t)row * ldd + lane * 16 + i * 4, va);
            if (has2) {
                const float vb[8] = {b[i].x * rb * wv4[i].x, b[i].y * rb * wv4[i].y, b[i].z * rb * wv4[i].z, b[i].w * rb * wv4[i].w, b[i + 1].x * rb * wv4[i + 1].x, b[i + 1].y * rb * wv4[i + 1].y, b[i + 1].z * rb * wv4[i + 1].z, b[i + 1].w * rb * wv4[i + 1].w};
                store8h(dst + (size_t)row2 * ldd + lane * 16 + i * 4, vb);
            }
        }
    }
}

__device__ __forceinline__ const float* wt_src(KParams p, int l, int r, int& ld) {
    if (r < ZN) {
        ld = INW;
        int c;
        if (r < 6144) c = r; else if (r < 9472) c = r + 16; else if (r < 9488) c = r - 3328; else return nullptr;
        return p->in[I_WIN] + (size_t)l * 1024 * INW + c;
    }
    r -= ZN;
    if (r < 3072) { ld = INW; return p->in[I_WIN] + (size_t)l * 1024 * INW + 9488 + r; }
    r -= 3072;
    if (r < 3072) { ld = 1024; const int br = r >> 10; return p->in[br == 0 ? I_PL : (br == 1 ? I_PG : I_PR)] + (size_t)l * 1024 * 1024 + (r & 1023); }
    r -= 3072;
    if (r < 1024) { ld = 1024; return p->in[I_WOUT] + (size_t)l * 1024 * 1024 + r; }
    r -= 1024;
    ld = 2048; return p->in[I_PWQ] + (size_t)l * 1024 * 2048 + r;
}
__device__ __forceinline__ void stage_wprep(KParams p, char* smem) {
    float* tile = (float*)smem;
    h16_t* WT = (h16_t*)(p->ws + OFF_WT);
    const int tid = tid_();
    const int ntr = WT_ROWS / 64, total = NL_ * ntr * 16;
    for (int it = bid_(); it < total; it += gridDim.x) {
        const int l = it / (ntr * 16), rem = it % (ntr * 16), rt = rem / 16, kt = rem % 16;
        const int r0 = rt * 64, k0 = kt * 64;
        __syncthreads();
        {
            const int nn = tid & 63;
            int ld = 0; const float* src = wt_src(p, l, r0 + nn, ld);
#pragma unroll
            for (int i = 0; i < 8; ++i) { const int kk = (tid >> 6) + 8 * i; tile[kk * 65 + nn] = src ? src[(size_t)(k0 + kk) * ld] : 0.f; }
        }
        __syncthreads();
        {
            const int r = tid >> 3, kq = (tid & 7) * 8;
            float v[8];
#pragma unroll
            for (int j = 0; j < 8; ++j) v[j] = tile[(kq + j) * 65 + r];
            store8h(WT + ((size_t)l * WT_ROWS + r0 + r) * 1024 + k0 + kq, v);
        }
    }
}

namespace pg8 {
constexpr int BM = 256, BK = 64, HALF = 128, HTB = HALF * BK * 2, STAGE_BYTES = 8 * HTB, NXCD = 8, WGM = 8;
struct Unit { const char* A; const char* B; int pm, pn, kind; };
#ifdef CPU_EMU
struct f32x4 { float d[4]; float& operator[](int i) { return d[i]; } const float& operator[](int i) const { return d[i]; } };
#else
#define PG8_LAS __attribute__((address_space(3)))
typedef _Float16 f16x8 __attribute__((ext_vector_type(8)));
typedef float f32x4 __attribute__((ext_vector_type(4)));
__device__ __forceinline__ int lds_byte(int r, int c) { const int st = (r >> 4) * 2 + (c >> 5), rr = r & 15, cc = c & 31, ob = rr * 64 + cc * 2; return st * 1024 + (ob ^ (((ob >> 9) & 1) << 5)); }
__device__ __forceinline__ void stage_rc(int b, int& R, int& C) { const int st = b / 1024, sb = b % 1024, swz = sb ^ (((sb >> 9) & 1) << 5); R = (st >> 1) * 16 + swz / 64; C = (st & 1) * 32 + (swz % 64) / 2; }
__device__ __forceinline__ int perm32(int rho) { const int n = rho >> 4, i = rho & 15; return 8 * (i >> 2) + 4 * n + (i & 3); }
#endif
__device__ __forceinline__ void tile_of(int L, int nM, int nN, int& pm, int& pn) {
    const int nwg = nM * nN;
    int wgid = L; { const int q = nwg / NXCD, r = nwg % NXCD, xcd = wgid % NXCD, off = wgid / NXCD; wgid = (xcd < r ? xcd * (q + 1) : r * (q + 1) + (xcd - r) * q) + off; }
    const int nig = WGM * nN, gid = wgid / nig, fm = gid * WGM, gsz = (nM - fm) < WGM ? (nM - fm) : WGM;
    pm = fm + ((wgid % nig) % gsz); pn = (wgid % nig) / gsz;
}

template <class Sched, class Epi>
__device__ __forceinline__ void gemm_phase(char* smem, const Sched& S, const Epi& E) {
    constexpr int K = 1024, nt = K / BK;
    constexpr unsigned lda = LDZ, ldb = 1024;
#ifdef CPU_EMU
    const int tid = tid_(), wid = tid >> 6, lane = tid & 63, wr = wid >> 2, wc = wid & 3, fr = lane & 15, fq = lane >> 4;
    Unit u;
    for (int ui = 0; S.next(ui, u); ++ui) {
        f32x4 acc[2][2][4][2];
        for (int ai = 0; ai < 2; ++ai) for (int bj = 0; bj < 2; ++bj) for (int m = 0; m < 4; ++m) for (int n = 0; n < 2; ++n) for (int e = 0; e < 4; ++e) {
            const int r = 128 * ai + 64 * wr + 16 * m + fr, c = 128 * bj + 32 * wc + 8 * fq + 4 * n + e;
            const h16_t* a = (const h16_t*)u.A + (size_t)r * lda; const h16_t* b = (const h16_t*)u.B + (size_t)c * ldb;
            float s = 0.f;
            for (int k = 0; k < K; ++k) s += h2f(a[k]) * h2f(b[k]);
            acc[ai][bj][m][n][e] = s;
        }
        E(acc, u, wr, wc, fr, fq);
    }
    (void)smem; (void)nt;
#else
    PG8_LAS unsigned char* lds = (PG8_LAS unsigned char*)smem;
    const int tid = tid_(), wid = __builtin_amdgcn_readfirstlane(tid >> 6), lane = tid & 63, wr = wid >> 2, wc = wid & 3, fr = lane & 15, fq = lane >> 4;
    unsigned voffA[2], voffB[2];
#pragma unroll
    for (int i = 0; i < 2; ++i) { int R, C; stage_rc(tid * 16 + i * 8192, R, C); const int Rb = (R & ~31) + perm32(R & 31);
        voffA[i] = (unsigned)(R * lda + C) * 2u; voffB[i] = (unsigned)(Rb * ldb + C) * 2u; }
    constexpr size_t kstep = (size_t)(BK * 2);
    constexpr size_t hstepA = (size_t)HALF * lda * 2, hstepB = (size_t)HALF * ldb * 2;
    const unsigned ldsw = (unsigned)wid * 1024u;
    const int aoff = lds_byte(wr * 64 + fr, fq * 8), boff = lds_byte(wc * 32 + fr, fq * 8);
#define PG8_SA(b, h) (((b) * 2 + (h)) * HTB)
#define PG8_SB(b, h) ((4 + (b) * 2 + (h)) * HTB)
#define PG8_STAGE(bufoff, gbase, voff) do { _Pragma("unroll") for (int _i = 0; _i < 2; ++_i) \
        __builtin_amdgcn_global_load_lds((const unsigned*)((const char*)(gbase) + (voff)[_i]), (PG8_LAS unsigned*)(lds + (bufoff) + ldsw + _i * 8192), 16, 0, 0); } while (0)
#define PG8_LDA(dst, b, h) do { _Pragma("unroll") for (int m = 0; m < 4; ++m) _Pragma("unroll") for (int k = 0; k < 2; ++k) dst[m][k] = *(const PG8_LAS f16x8*)(lds + PG8_SA(b, h) + aoff + m * 2048 + k * 1024); } while (0)
#define PG8_LDB(dst, b, h) do { _Pragma("unroll") for (int n = 0; n < 2; ++n) _Pragma("unroll") for (int k = 0; k < 2; ++k) dst[n][k] = *(const PG8_LAS f16x8*)(lds + PG8_SB(b, h) + boff + n * 2048 + k * 1024); } while (0)
#define PG8_MMA(ai, bj, At, Bt) do { __builtin_amdgcn_s_setprio(1); _Pragma("unroll") for (int m = 0; m < 4; ++m) _Pragma("unroll") for (int n = 0; n < 2; ++n) _Pragma("unroll") for (int k = 0; k < 2; ++k) \
        acc[ai][bj][m][n] = __builtin_amdgcn_mfma_f32_16x16x32_f16(Bt[n][k], At[m][k], acc[ai][bj][m][n], 0, 0, 0); __builtin_amdgcn_s_setprio(0); } while (0)
#define PG8_WAIT_V(n) asm volatile("s_waitcnt vmcnt(" #n ")" ::: "memory")
#define PG8_WAIT_L(n) asm volatile("s_waitcnt lgkmcnt(" #n ")" ::: "memory")
#define PG8_BAR __builtin_amdgcn_s_barrier()
#define PG8_SCHED __builtin_amdgcn_sched_barrier(0)
    Unit cur, nxt; int ui = 0;
    if (!S.next(0, cur)) return;
    f32x4 acc[2][2][4][2];
#pragma unroll
    for (int a = 0; a < 2; ++a)
#pragma unroll
        for (int b = 0; b < 2; ++b)
#pragma unroll
            for (int m = 0; m < 4; ++m)
#pragma unroll
                for (int n = 0; n < 2; ++n) acc[a][b][m][n] = (f32x4){0.f, 0.f, 0.f, 0.f};
    f16x8 At[4][2], B0[2][2], B1[2][2];
    const char* cA = cur.A; const char* cB = cur.B;
    PG8_STAGE(PG8_SB(0, 0), cB, voffB); PG8_STAGE(PG8_SA(0, 0), cA, voffA); PG8_STAGE(PG8_SB(0, 1), cB + hstepB, voffB); PG8_STAGE(PG8_SA(0, 1), cA + hstepA, voffA);
    if (wr == 1) PG8_BAR;
    PG8_WAIT_V(4); PG8_BAR;
    PG8_STAGE(PG8_SB(1, 0), cB + kstep, voffB); PG8_STAGE(PG8_SA(1, 0), cA + kstep, voffA); PG8_STAGE(PG8_SB(1, 1), cB + hstepB + kstep, voffB);
    PG8_WAIT_V(6); PG8_BAR;
    for (;;) {
        const bool has_next = S.next(ui + 1, nxt);
        const char* nA = has_next ? nxt.A : cA; const char* nB = has_next ? nxt.B : cB;
#pragma unroll 1
        for (int t = 0; t < nt; t += 2) {
            const bool last = (t == nt - 2);
            const char* a1 = cA + (size_t)(t + 1) * kstep;
            const char* a2 = last ? nA : cA + (size_t)(t + 2) * kstep; const char* b2 = last ? nB : cB + (size_t)(t + 2) * kstep;
            const char* a3 = a2 + kstep; const char* b3 = b2 + kstep;
            PG8_LDB(B0, 0, 0); PG8_SCHED; PG8_LDA(At, 0, 0); PG8_STAGE(PG8_SA(1, 1), a1 + hstepA, voffA);
            PG8_WAIT_L(8); PG8_BAR; PG8_WAIT_L(0); PG8_MMA(0, 0, At, B0); PG8_BAR; PG8_SCHED;
            PG8_LDB(B1, 0, 1); PG8_STAGE(PG8_SB(0, 0), b2, voffB);
            PG8_BAR; PG8_WAIT_L(0); PG8_MMA(0, 1, At, B1); PG8_BAR;
            PG8_LDA(At, 0, 1); PG8_STAGE(PG8_SA(0, 0), a2, voffA);
            PG8_BAR; PG8_WAIT_L(0); PG8_MMA(1, 0, At, B0); PG8_BAR; PG8_SCHED;
            PG8_STAGE(PG8_SB(0, 1), b2 + hstepB, voffB);
            PG8_WAIT_V(6); PG8_BAR; PG8_MMA(1, 1, At, B1); PG8_BAR;
            PG8_LDB(B0, 1, 0); PG8_SCHED; PG8_LDA(At, 1, 0); PG8_STAGE(PG8_SA(0, 1), a2 + hstepA, voffA);
            PG8_WAIT_L(8); PG8_BAR; PG8_WAIT_L(0); PG8_MMA(0, 0, At, B0); PG8_BAR; PG8_SCHED;
            PG8_LDB(B1, 1, 1); PG8_STAGE(PG8_SB(1, 0), b3, voffB);
            PG8_BAR; PG8_WAIT_L(0); PG8_MMA(0, 1, At, B1); PG8_BAR;
            PG8_LDA(At, 1, 1); PG8_STAGE(PG8_SA(1, 0), a3, voffA);
            PG8_BAR; PG8_WAIT_L(0); PG8_MMA(1, 0, At, B0); PG8_BAR; PG8_SCHED;
            PG8_STAGE(PG8_SB(1, 1), b3 + hstepB, voffB);
            PG8_WAIT_V(6); PG8_BAR; PG8_MMA(1, 1, At, B1); PG8_BAR;
        }
        E(acc, cur, wr, wc, fr, fq);
        if (!has_next) break;
#pragma unroll
        for (int a = 0; a < 2; ++a)
#pragma unroll
            for (int b = 0; b < 2; ++b)
#pragma unroll
                for (int m = 0; m < 4; ++m)
#pragma unroll
                    for (int n = 0; n < 2; ++n) acc[a][b][m][n] = (f32x4){0.f, 0.f, 0.f, 0.f};
        cur = nxt; cA = nA; cB = nB; ++ui;
    }
    PG8_WAIT_V(0);
    if (wr == 0) PG8_BAR;
    PG8_BAR;
#undef PG8_SA
#undef PG8_SB
#undef PG8_STAGE
#undef PG8_LDA
#undef PG8_LDB
#undef PG8_MMA
#undef PG8_WAIT_V
#undef PG8_WAIT_L
#undef PG8_BAR
#undef PG8_SCHED
#endif
}
}

enum { GK_STORE = 0, GK_GATE0, GK_GATE1, GK_GATE2, GK_PROJ0, GK_PROJ1, GK_PROJ2, GK_RESID };
enum { GP_INPROJ = 0, GP_MERGE, GP_WOUT, GP_QUERY };
struct GemmProg {
    const char* act; const char* wt;
    int which, G, c;
    __device__ __forceinline__ bool next(int i, pg8::Unit& u) const {
        constexpr int nM = M_ / 256;
        constexpr size_t rowA = (size_t)256 * LDZ * 2, rowB = (size_t)256 * 1024 * 2;
        if (which == GP_MERGE) {
            const int L = (i / 6) * G + c, j = i % 6, br = j < 3 ? j : j - 3;
            if (L >= nM * 4) return false;
            pg8::tile_of(L, nM, 4, u.pm, u.pn);
            if (j < 3) { u.A = act + (size_t)C_XN * 2; u.B = wt + ((size_t)(WT_MG + br * 1024) * 1024) * 2; u.kind = GK_GATE0 + br; }
            else { u.A = act + (size_t)(br == 0 ? C_YA : (br == 1 ? C_YB : C_YC)) * 2; u.B = wt + ((size_t)(WT_P + br * 1024) * 1024) * 2; u.kind = GK_PROJ0 + br; }
        } else {
            const int nN = which == GP_INPROJ ? ZN / 256 : (which == GP_WOUT ? 4 : 8);
            const int L = i * G + c;
            if (L >= nM * nN) return false;
            pg8::tile_of(L, nM, nN, u.pm, u.pn);
            u.A = act + (size_t)(which == GP_WOUT ? C_MG : C_XN) * 2;
            u.B = wt + ((size_t)(which == GP_INPROJ ? WT_IN : (which == GP_WOUT ? WT_OUT : WT_Q)) * 1024) * 2;
            u.kind = which == GP_WOUT ? GK_RESID : GK_STORE;
        }
        u.A += (size_t)u.pm * rowA; u.B += (size_t)u.pn * rowB;
        return true;
    }
};
__device__ __forceinline__ int gs_slot(int br) { return br == 0 ? C_GS : (br == 1 ? Z_V : Z_ULRU); }
struct GemmEpi {
    h16_t* act; const float* mb; const float* resid; float* out;
    __device__ __forceinline__ void operator()(const pg8::f32x4 (&acc)[2][2][4][2], const pg8::Unit& u, int wr, int wc, int fr, int fq) const {
        const int row0 = u.pm * 256 + wr * 64 + fr, col0 = u.pn * 256 + wc * 32 + 8 * fq;
#pragma unroll
        for (int ai = 0; ai < 2; ++ai)
#pragma unroll
            for (int m = 0; m < 4; ++m) {
                const int row = row0 + ai * 128 + m * 16;
#pragma unroll
                for (int bj = 0; bj < 2; ++bj) {
                    const int col = col0 + bj * 128;
                    float v[8];
#pragma unroll
                    for (int e = 0; e < 4; ++e) { v[e] = acc[ai][bj][m][0][e]; v[4 + e] = acc[ai][bj][m][1][e]; }
                    h16_t* arow = act + (size_t)row * LDZ;
                    if (u.kind == GK_STORE) {
                        store8h(arow + col, v);
                    } else if (u.kind <= GK_GATE2) {
                        const float* bp = mb + (u.kind - GK_GATE0) * 1024 + col;
                        const float4 b0 = *(const float4*)bp, b1 = *(const float4*)(bp + 4);
                        v[0] = sigmoidf_(v[0] + b0.x); v[1] = sigmoidf_(v[1] + b0.y); v[2] = sigmoidf_(v[2] + b0.z); v[3] = sigmoidf_(v[3] + b0.w);
                        v[4] = sigmoidf_(v[4] + b1.x); v[5] = sigmoidf_(v[5] + b1.y); v[6] = sigmoidf_(v[6] + b1.z); v[7] = sigmoidf_(v[7] + b1.w);
                        store8h(arow + gs_slot(u.kind - GK_GATE0) + col, v);
                    } else if (u.kind <= GK_PROJ2) {
                        float g[8]; load8h(arow + gs_slot(u.kind - GK_PROJ0) + col, g);
                        if (u.kind == GK_PROJ0) {
#pragma unroll
                            for (int e = 0; e < 8; ++e) v[e] = g[e] * v[e];
                        } else {
                            float o[8]; load8h(arow + C_MG + col, o);
#pragma unroll
                            for (int e = 0; e < 8; ++e) v[e] = o[e] + g[e] * v[e];
                        }
                        store8h(arow + C_MG + col, v);
                    } else {
                        const size_t o = (size_t)row * 1024 + col;
                        const float4 r0 = *(const float4*)(resid + o), r1 = *(const float4*)(resid + o + 4);
                        *(float4*)(out + o) = make_float4(r0.x + v[0], r0.y + v[1], r0.z + v[2], r0.w + v[3]);
                        *(float4*)(out + o + 4) = make_float4(r1.x + v[4], r1.y + v[5], r1.z + v[6], r1.w + v[7]);
                    }
                }
            }
    }
};
__device__ __forceinline__ void stage_gemm(KParams p, int l, int which, char* smem) {
    GemmProg S; S.act = p->ws + OFF_ACT; S.wt = p->ws + OFF_WT + (size_t)l * WT_ROWS * 1024 * 2; S.which = which; S.G = gridDim.x; S.c = bid_();
    GemmEpi E; E.act = (h16_t*)(p->ws + OFF_ACT); E.mb = p->in[I_MB] + l * 3072; E.resid = l == 0 ? p->in[I_X] : p->out; E.out = p->out;
    pg8::gemm_phase(smem, S, E);
}

#ifdef CPU_EMU
__device__ __forceinline__ float group_sum(float v, int width, float* scratch) {
    const int tid = tid_();
    scratch[tid] = v;
    __syncthreads();
    float s = 0.f; const int base = tid & ~(width - 1);
    for (int i = 0; i < width; ++i) s += scratch[base + i];
    __syncthreads();
    return s;
}
#else
template <int CTRL> __device__ __forceinline__ float dpp_f(float v) { return __builtin_bit_cast(float, __builtin_amdgcn_update_dpp(0, __builtin_bit_cast(int, v), CTRL, 0xf, 0xf, false)); }
__device__ __forceinline__ float group_sum(float v, int width, float*) {
    v += dpp_f<0xB1>(v);
    v += dpp_f<0x4E>(v);
    if (width >= 8) v += dpp_f<0x141>(v);
    if (width >= 16) v += dpp_f<0x140>(v);
    if (width >= 64) {
        v += __builtin_bit_cast(float, __builtin_amdgcn_update_dpp(0, __builtin_bit_cast(int, v), 0x142, 0xa, 0xf, false));
        v += __builtin_bit_cast(float, __builtin_amdgcn_update_dpp(0, __builtin_bit_cast(int, v), 0x143, 0xc, 0xf, false));
        v = __builtin_bit_cast(float, __builtin_amdgcn_readlane(__builtin_bit_cast(int, v), 63));
    } else if (width >= 32) v += __shfl_xor(v, 16);
    return v;
}
#endif
__device__ __forceinline__ uint4 ldg16(const h16_t* p) { return *(const uint4*)p; }
__device__ __forceinline__ uint4 zero16() { uint4 z; z.x = 0u; z.y = 0u; z.z = 0u; z.w = 0u; return z; }

__device__ __forceinline__ void stage_lru(KParams p, int l, char* smem, int vb0, int nvb) {
    const int vb = bid_() - vb0;
    if (vb < 0 || vb >= nvb) return;
    constexpr int CH = 64;
    float* wa_s = (float*)smem;
    float* wx_s = wa_s + 4096;
    float* xcT = wx_s + 4096;
    float* a_s = xcT + 64 * CH;
    float* b_s = a_s + CH * 64;
    h16_t* ru = (h16_t*)(b_s + CH * 64);
    h16_t* rg = ru + (CH + 3) * 64;
    h16_t* ACT = (h16_t*)(p->ws + OFF_ACT);
    const int tid = tid_(), c = tid & 63, tg = tid >> 6;
    for (int item = vb; item < B_ * 16; item += nvb) {
        const int b = item / 16, n = item % 16, ch = n * 64 + c;
        __syncthreads();
        for (int i = tid; i < 4096; i += NT) { wa_s[i] = p->in[I_LWA][((size_t)l * 16 + n) * 4096 + i]; wx_s[i] = p->in[I_LWX][((size_t)l * 16 + n) * 4096 + i]; }
        const float cw0 = p->in[I_LCW][((size_t)l * 4 + 0) * 1024 + ch], cw1 = p->in[I_LCW][((size_t)l * 4 + 1) * 1024 + ch];
        const float cw2 = p->in[I_LCW][((size_t)l * 4 + 2) * 1024 + ch], cw3 = p->in[I_LCW][((size_t)l * 4 + 3) * 1024 + ch];
        const float cb = p->in[I_LCB][l * 1024 + ch], ba = p->in[I_LBA][l * 1024 + ch], bx = p->in[I_LBX][l * 1024 + ch];
        const float sp = softplusf_(-p->in[I_LLAM][l * 1024 + ch]);
        float hst = 0.f;
        uint4 pf[3];
#define LRU_LOAD(t0_) do { _Pragma("unroll") for (int i = 0; i < 3; ++i) { const int j = tid + NT * i; pf[i] = zero16(); \
            if (j < 536) { const int t = (t0_) - 3 + (j >> 3); if (t >= 0) pf[i] = ldg16(ACT + ((size_t)b * T_ + t) * LDZ + Z_ULRU + n * 64 + (j & 7) * 8); } \
            else if (j < 1048) { const int jj = j - 536; pf[i] = ldg16(ACT + ((size_t)b * T_ + (t0_) + (jj >> 3)) * LDZ + Z_GLRU + n * 64 + (jj & 7) * 8); } } } while (0)
#define LRU_PUT() do { _Pragma("unroll") for (int i = 0; i < 3; ++i) { const int j = tid + NT * i; \
            if (j < 536) *(uint4*)(ru + (j >> 3) * 64 + (j & 7) * 8) = pf[i]; else if (j < 1048) *(uint4*)(rg + ((j - 536) >> 3) * 64 + ((j - 536) & 7) * 8) = pf[i]; } } while (0)
        LRU_LOAD(0);
        LRU_PUT();
        __syncthreads();
#pragma unroll 1
        for (int t0 = 0; t0 < T_; t0 += CH) {
            float xc[8];
            {
                float u[11];
#pragma unroll
                for (int s = 0; s < 11; ++s) u[s] = h2f(ru[(tg * 8 + s) * 64 + c]);
#pragma unroll
                for (int s = 0; s < 8; ++s) { xc[s] = cw0 * u[s] + cw1 * u[s + 1] + cw2 * u[s + 2] + cw3 * u[s + 3] + cb; xcT[c * CH + tg * 8 + s] = xc[s]; }
            }
            __syncthreads();
            if (t0 + CH < T_) LRU_LOAD(t0 + CH);
            {
                float dr[8], di[8];
#pragma unroll
                for (int s = 0; s < 8; ++s) { dr[s] = 0.f; di[s] = 0.f; }
#pragma unroll 4
                for (int i = 0; i < 64; ++i) {
                    const float wa = wa_s[i * 64 + c], wx = wx_s[i * 64 + c];
                    const float4 x0 = *(const float4*)(xcT + i * CH + tg * 8), x1 = *(const float4*)(xcT + i * CH + tg * 8 + 4);
                    dr[0] += x0.x * wa; dr[1] += x0.y * wa; dr[2] += x0.z * wa; dr[3] += x0.w * wa; dr[4] += x1.x * wa; dr[5] += x1.y * wa; dr[6] += x1.z * wa; dr[7] += x1.w * wa;
                    di[0] += x0.x * wx; di[1] += x0.y * wx; di[2] += x0.z * wx; di[3] += x0.w * wx; di[4] += x1.x * wx; di[5] += x1.y * wx; di[6] += x1.z * wx; di[7] += x1.w * wx;
                }
#pragma unroll
                for (int s = 0; s < 8; ++s) {
                    const float r = sigmoidf_(dr[s] + ba), ig = sigmoidf_(di[s] + bx);
                    const float log_a = -8.0f * r * sp;
                    a_s[(tg * 8 + s) * 64 + c] = fexp_(log_a);
                    b_s[(tg * 8 + s) * 64 + c] = sqrtf(fmaxf(1.0f - fexp_(2.0f * log_a), 0.0f)) * (ig * xc[s]);
                }
            }
            __syncthreads();
            if (tid < 64) {
#pragma unroll 8
                for (int t = 0; t < CH; ++t) { hst = a_s[t * 64 + c] * hst + b_s[t * 64 + c]; b_s[t * 64 + c] = hst; }
            }
            __syncthreads();
#pragma unroll
            for (int s = 0; s < 8; ++s) { h16_t* gp = rg + (tg * 8 + s) * 64 + c; *gp = f2h(b_s[(tg * 8 + s) * 64 + c] * geluf_(h2f(*gp))); }
            __syncthreads();
            *(uint4*)(ACT + ((size_t)b * T_ + t0 + (tid >> 3)) * LDZ + Z_GLRU + n * 64 + (tid & 7) * 8) = *(const uint4*)(rg + (tid >> 3) * 64 + (tid & 7) * 8);
            __syncthreads();
            if (t0 + CH < T_) LRU_PUT();
            __syncthreads();
        }
#undef LRU_LOAD
#undef LRU_PUT
    }
}

#ifdef CPU_EMU
struct hfrag { h16_t v[8]; };
struct facc { float d[4]; float& operator[](int i) { return d[i]; } const float& operator[](int i) const { return d[i]; } };
__device__ __forceinline__ facc facc_zero() { facc a; a.d[0] = a.d[1] = a.d[2] = a.d[3] = 0.f; return a; }
__device__ __forceinline__ hfrag frag_u4(uint4 w) { hfrag f; memcpy(&f, &w, 16); return f; }
__device__ __forceinline__ hfrag frag_2u2(uint2 lo, uint2 hi) { hfrag f; memcpy(&f.v[0], &lo, 8); memcpy(&f.v[4], &hi, 8); return f; }
__device__ __forceinline__ hfrag frag_mul(hfrag a, hfrag b) { hfrag f; for (int j = 0; j < 8; ++j) f.v[j] = f2h(h2f(a.v[j]) * h2f(b.v[j])); return f; }
__device__ __forceinline__ facc mfma16(hfrag a, hfrag b, facc c) {
    const int tid = tid_(), w = tid >> 6, l = tid & 63;
    unsigned short (*X)[64][16] = emu::ctx->xscr;
    for (int j = 0; j < 8; ++j) { X[w][l][j] = a.v[j]; X[w][l][8 + j] = b.v[j]; }
    __syncthreads();
    for (int reg = 0; reg < 4; ++reg) {
        const int row = 4 * (l >> 4) + reg, col = l & 15;
        float s = 0.f;
        for (int k = 0; k < 32; ++k) s += h2f(X[w][row + 16 * (k >> 3)][k & 7]) * h2f(X[w][col + 16 * (k >> 3)][8 + (k & 7)]);
        c.d[reg] += s;
    }
    __syncthreads();
    return c;
}
#else
typedef _Float16 hfrag __attribute__((ext_vector_type(8)));
typedef float facc __attribute__((ext_vector_type(4)));
__device__ __forceinline__ facc facc_zero() { return (facc){0.f, 0.f, 0.f, 0.f}; }
__device__ __forceinline__ hfrag frag_u4(uint4 w) { return __builtin_bit_cast(hfrag, w); }
__device__ __forceinline__ hfrag frag_2u2(uint2 lo, uint2 hi) { uint4 w; w.x = lo.x; w.y = lo.y; w.z = hi.x; w.w = hi.y; return __builtin_bit_cast(hfrag, w); }
__device__ __forceinline__ hfrag frag_mul(hfrag a, hfrag b) { return a * b; }
__device__ __forceinline__ facc mfma16(hfrag a, hfrag b, facc c) { return __builtin_amdgcn_mfma_f32_16x16x32_f16(a, b, c, 0, 0, 0); }
#endif
__device__ __forceinline__ hfrag frag_pack8(float a0, float a1, float a2, float a3, float a4, float a5, float a6, float a7) {
    uint4 w; w.x = pack2h(a0, a1); w.y = pack2h(a2, a3); w.z = pack2h(a4, a5); w.w = pack2h(a6, a7); return frag_u4(w);
}
__device__ __forceinline__ hfrag frag_acc2(const facc& t0, const facc& t1) { return frag_pack8(t0[0], t0[1], t0[2], t0[3], t1[0], t1[1], t1[2], t1[3]); }
__device__ __forceinline__ hfrag permfrag(const h16_t* rowp, int ks, int g) { return frag_2u2(*(const uint2*)(rowp + 32 * ks + 4 * g), *(const uint2*)(rowp + 32 * ks + 16 + 4 * g)); }

__device__ __forceinline__ void stage_gdn(KParams p, int l, char* smem, int vb0, int nvb) {
    const int vb = bid_() - vb0;
    if (vb < 0 || vb >= nvb) return;
    constexpr int CH = 64, QS = 136, TS = 72, AS = 68, KTS = 128 * TS + 16 * 8;
#define KTO(d) ((d) * TS + ((d) >> 3) * 8)
    h16_t* Qs = (h16_t*)smem;
    h16_t* Ks = Qs + 64 * QS;
    h16_t* Kt = Ks + 64 * QS;
    h16_t* Vt = Kt + KTS;
    float* A32 = (float*)(Vt + KTS);
    h16_t* ob = (h16_t*)A32;
    h16_t* Tu = (h16_t*)(A32 + 64 * AS);
    h16_t* Tw = Tu + 64 * TS;
    h16_t* QKm = Tw + 64 * TS;
    float* gc_s = (float*)(QKm + 64 * TS);
    float* be_s = gc_s + 64;
    float* e1_s = be_s + 64;
    float* part_s = e1_s + 64;
    float* scr = part_s + 512;
    float* cw_s = scr + 512;
    h16_t* ACT = (h16_t*)(p->ws + OFF_ACT);
    int tid = tid_(), lane = tid & 63, w = tid >> 6, g = lane >> 4, r16 = lane & 15;
    int sg = lane >> 4, pc = lane & 15, rb = w;
#define GDN_ROLES() do { tid = tid_(); lane = tid & 63; w = tid >> 6; g = lane >> 4; r16 = lane & 15; sg = g; pc = r16; rb = w; } while (0)
    for (int item = vb; item < B_ * 8; item += nvb) {
        const int b = item / 8, h = item % 8;
        const float a_exp = fexp_(p->in[I_GALOG][l * 8 + h]), dtb = p->in[I_GDT][l * 8 + h];
        facc S[8];
#pragma unroll
        for (int dt = 0; dt < 8; ++dt) S[dt] = facc_zero();
        __syncthreads();
        for (int i = tid; i < 64 * TS / 2; i += NT) ((unsigned*)QKm)[i] = 0u;
        for (int i = tid; i < 4 * 384; i += NT) { const int jj = i / 384, c3 = i % 384; cw_s[i] = p->in[I_GCW][((size_t)l * 4 + jj) * 3072 + (c3 >> 7) * 1024 + h * 128 + (c3 & 127)]; }
        uint4 pf[11];
#define GDN_LOAD(t0_) do { GDN_ROLES(); const h16_t* colp = ACT + ((size_t)b * T_ + (t0_) + 8 * rb - 3) * LDZ + (sg < 3 ? Z_Q + sg * 1024 : Z_ZG) + h * 128 + pc * 8; \
            _Pragma("unroll") for (int i = 0; i < 11; ++i) { const int t = (t0_) + 8 * rb - 3 + i; pf[i] = (t >= 0 && sg < 3) ? ldg16(colp + (size_t)i * LDZ) : zero16(); } } while (0)
        GDN_LOAD(0);
        h16_t pfa = 0, pfb = 0;
#define GDN_LOADS(t0_) do { if (tid < 64) { const size_t m_ = (size_t)b * T_ + (t0_) + tid; pfa = ACT[m_ * LDZ + Z_ALPHA + h]; pfb = ACT[m_ * LDZ + Z_BETA + h]; } } while (0)
        GDN_LOADS(0);
#pragma unroll 1
        for (int t0 = 0; t0 < T_; t0 += CH) {
            GDN_ROLES();
            if (tid < 64) {
                part_s[tid] = -a_exp * softplusf_(h2f(pfa) + dtb);
                be_s[tid] = sigmoidf_(h2f(pfb));
            }
            __syncthreads();
            if (tid < 64) { float s = 0.f;
#pragma unroll
                for (int i4 = 0; i4 < 16; ++i4) { const float4 pv = *(const float4*)(part_s + i4 * 4); s += (i4 * 4 <= tid ? pv.x : 0.f) + (i4 * 4 + 1 <= tid ? pv.y : 0.f) + (i4 * 4 + 2 <= tid ? pv.z : 0.f) + (i4 * 4 + 3 <= tid ? pv.w : 0.f); }
                gc_s[tid] = s; }
#pragma unroll
            for (int hf = 0; hf < 2; ++hf) {
                float ov[4][8];
#pragma unroll
                for (int i = 0; i < 4; ++i) {
#pragma unroll
                    for (int cc = 0; cc < 8; ++cc) ov[i][cc] = 0.f;
#pragma unroll
                    for (int jj = 0; jj < 4; ++jj) {
                        const uint4 wv = pf[hf * 4 + i + jj];
                        const float* cwp = cw_s + jj * 384 + (sg < 3 ? sg : 0) * 128 + pc * 8;
                        const float4 c0 = *(const float4*)cwp, c1 = *(const float4*)(cwp + 4);
                        ov[i][0] += c0.x * h2f((h16_t)(wv.x & 0xffffu)); ov[i][1] += c0.y * h2f((h16_t)(wv.x >> 16)); ov[i][2] += c0.z * h2f((h16_t)(wv.y & 0xffffu)); ov[i][3] += c0.w * h2f((h16_t)(wv.y >> 16));
                        ov[i][4] += c1.x * h2f((h16_t)(wv.z & 0xffffu)); ov[i][5] += c1.y * h2f((h16_t)(wv.z >> 16)); ov[i][6] += c1.z * h2f((h16_t)(wv.w & 0xffffu)); ov[i][7] += c1.w * h2f((h16_t)(wv.w >> 16));
                    }
                    float ss = 0.f;
#pragma unroll
                    for (int cc = 0; cc < 8; ++cc) { ov[i][cc] = siluf_(ov[i][cc]); ss += ov[i][cc] * ov[i][cc]; }
                    ss = group_sum(ss, 16, scr);
                    const float rn = sg == 0 ? rsqrtf(ss + RMS_EPS) * 0.08838834764831845f : (sg == 1 ? rsqrtf(ss + RMS_EPS) : 1.0f);
#pragma unroll
                    for (int cc = 0; cc < 8; ++cc) ov[i][cc] *= rn;
                    const int t = 8 * rb + hf * 4 + i;
                    if (sg == 0) store8h(Qs + t * QS + pc * 8, ov[i]);
                    else if (sg == 1) store8h(Ks + t * QS + pc * 8, ov[i]);
                }
                if (sg == 1 || sg == 2) {
                    h16_t* dstT = sg == 1 ? Kt : Vt;
#pragma unroll
                    for (int cc = 0; cc < 8; ++cc) { uint2 w2; w2.x = pack2h(ov[0][cc], ov[1][cc]); w2.y = pack2h(ov[2][cc], ov[3][cc]); *(uint2*)(dstT + KTO(pc * 8 + cc) + 8 * rb + hf * 4) = w2; }
                }
            }
            __syncthreads();
            GDN_ROLES();
            if (tid < 64) e1_s[tid] = fexp_(gc_s[63] - gc_s[tid]);
            for (int e = tid; e < 64 * 64; e += NT) { const int i = e >> 6, j = e & 63; if ((j >> 4) > (i >> 4)) A32[i * AS + (j & 7) * 8 + (j >> 3)] = 0.f; }
#pragma unroll 1
            for (int jr = 0; jr < 3; ++jr) {
                const int jb = w + 8 * jr; const bool valid = jb < 20;
                const int kind = (valid && jb >= 10) ? 1 : 0, tix = valid ? (jb % 10) : 0;
                const int ti = tix < 1 ? 0 : (tix < 3 ? 1 : (tix < 6 ? 2 : 3)), tj = tix - (ti * (ti + 1)) / 2;
                const h16_t* ap = (kind ? Qs : Ks) + (16 * ti + r16) * QS + 8 * g; const h16_t* bp = Ks + (16 * tj + r16) * QS + 8 * g;
                facc acc = facc_zero();
#pragma unroll
                for (int ks = 0; ks < 4; ++ks) acc = mfma16(frag_u4(*(const uint4*)(ap + 32 * ks)), frag_u4(*(const uint4*)(bp + 32 * ks)), acc);
                if (valid) {
                    const int j = 16 * tj + r16; const float gj = gc_s[j];
#pragma unroll
                    for (int reg = 0; reg < 4; ++reg) {
                        const int i = 16 * ti + 4 * g + reg;
                        const float dec = fexp_(fminf(gc_s[i] - gj, 0.f));
                        if (kind == 0) A32[i * AS + (j & 7) * 8 + (j >> 3)] = i > j ? be_s[i] * acc[reg] * dec : 0.f;
                        else QKm[i * TS + j] = f2h(i >= j ? acc[reg] * dec : 0.f);
                    }
                }
            }
            __syncthreads();
            GDN_ROLES();
            {
                const int t = tid >> 3, d0 = (tid & 7) * 16; const float eg = fexp_(gc_s[t]);
                float v8[8];
                load8h(Qs + t * QS + d0, v8);
#pragma unroll
                for (int e = 0; e < 8; ++e) v8[e] *= eg;
                store8h(Qs + t * QS + d0, v8);
                load8h(Qs + t * QS + d0 + 8, v8);
#pragma unroll
                for (int e = 0; e < 8; ++e) v8[e] *= eg;
                store8h(Qs + t * QS + d0 + 8, v8);
            }
            {
                const int c = tid >> 3, q = tid & 7;
                const float bc = be_s[c], bgc = bc * fexp_(gc_s[c]);
                float x[8];
#pragma unroll
                for (int i = 0; i < 8; ++i) x[i] = 0.f;
#pragma unroll
                for (int r = 0; r < 64; ++r) {
                    float sacc = 0.f;
                    if (r > 0) {
                        const float4 a0 = *(const float4*)(A32 + r * AS + q * 8);
                        sacc = a0.x * x[0];
                        if (r > 8) sacc += a0.y * x[1];
                        if (r > 16) sacc += a0.z * x[2];
                        if (r > 24) sacc += a0.w * x[3];
                        if (r > 32) {
                            const float4 a1 = *(const float4*)(A32 + r * AS + q * 8 + 4);
                            sacc += a1.x * x[4];
                            if (r > 40) sacc += a1.y * x[5];
                            if (r > 48) sacc += a1.z * x[6];
                            if (r > 56) sacc += a1.w * x[7];
                        }
                        sacc = group_sum(sacc, 8, scr);
                    }
                    const float xr = ((r == c) ? 1.f : 0.f) - sacc;
                    if (q == (r & 7)) { x[r >> 3] = xr; Tu[r * TS + c] = f2h(xr * bc); Tw[r * TS + c] = f2h(xr * bgc); }
                }
            }
            __syncthreads();
            GDN_ROLES();
            facc vn[4], aw[4];
#pragma unroll
            for (int tt = 0; tt < 4; ++tt) { vn[tt] = facc_zero(); aw[tt] = facc_zero(); }
#pragma unroll
            for (int tt = 0; tt < 4; ++tt)
#pragma unroll
                for (int ks = 0; ks <= (tt >> 1); ++ks) {
                    const hfrag au = frag_u4(*(const uint4*)(Tu + (16 * tt + r16) * TS + 32 * ks + 8 * g)), aww = frag_u4(*(const uint4*)(Tw + (16 * tt + r16) * TS + 32 * ks + 8 * g));
                    vn[tt] = mfma16(au, frag_u4(*(const uint4*)(Vt + KTO(16 * w + r16) + 32 * ks + 8 * g)), vn[tt]);
                    aw[tt] = mfma16(aww, frag_u4(*(const uint4*)(Kt + KTO(16 * w + r16) + 32 * ks + 8 * g)), aw[tt]);
                }
#pragma unroll
            for (int tt = 0; tt < 4; ++tt)
#pragma unroll
                for (int reg = 0; reg < 4; ++reg) Ks[(16 * tt + 4 * g + reg) * QS + 16 * w + r16] = f2h(-aw[tt][reg]);
            __syncthreads();
            GDN_ROLES();
            h16_t zraw[16];
#pragma unroll
            for (int tt = 0; tt < 4; ++tt)
#pragma unroll
                for (int reg = 0; reg < 4; ++reg) zraw[tt * 4 + reg] = ACT[((size_t)b * T_ + t0 + 16 * tt + 4 * g + reg) * LDZ + Z_ZG + h * 128 + 16 * w + r16];
            hfrag Sb[4];
#pragma unroll
            for (int ks = 0; ks < 4; ++ks) Sb[ks] = frag_acc2(S[2 * ks], S[2 * ks + 1]);
            facc oc[4];
#pragma unroll
            for (int tt = 0; tt < 4; ++tt) {
                oc[tt] = facc_zero();
                const h16_t* wrow = Ks + (16 * tt + r16) * QS; const h16_t* qrow = Qs + (16 * tt + r16) * QS;
#pragma unroll
                for (int ks = 0; ks < 4; ++ks) { vn[tt] = mfma16(permfrag(wrow, ks, g), Sb[ks], vn[tt]); oc[tt] = mfma16(permfrag(qrow, ks, g), Sb[ks], oc[tt]); }
            }
            hfrag VNb[2];
            VNb[0] = frag_acc2(vn[0], vn[1]); VNb[1] = frag_acc2(vn[2], vn[3]);
#pragma unroll
            for (int tt = 0; tt < 4; ++tt)
#pragma unroll
                for (int ks2 = 0; ks2 <= (tt >> 1); ++ks2) oc[tt] = mfma16(permfrag(QKm + (16 * tt + r16) * TS, ks2, g), VNb[ks2], oc[tt]);
            {
                const float egl = fexp_(gc_s[63]);
                hfrag e1f[2];
#pragma unroll
                for (int ks2 = 0; ks2 < 2; ++ks2) { const float* ep = e1_s + 32 * ks2 + 4 * g; e1f[ks2] = frag_pack8(ep[0], ep[1], ep[2], ep[3], ep[16], ep[17], ep[18], ep[19]); }
#pragma unroll
                for (int dt = 0; dt < 8; ++dt) {
#pragma unroll
                    for (int reg = 0; reg < 4; ++reg) S[dt][reg] *= egl;
#pragma unroll
                    for (int ks2 = 0; ks2 < 2; ++ks2) S[dt] = mfma16(frag_mul(permfrag(Kt + KTO(16 * dt + r16), ks2, g), e1f[ks2]), VNb[ks2], S[dt]);
                }
            }
            if (t0 + CH < T_) { GDN_LOAD(t0 + CH); GDN_LOADS(t0 + CH); }
            GDN_ROLES();
#pragma unroll
            for (int tt = 0; tt < 4; ++tt)
#pragma unroll
                for (int reg = 0; reg < 4; ++reg) { const float ss = group_sum(oc[tt][reg] * oc[tt][reg], 16, scr); if (r16 == 0) part_s[w * 64 + 16 * tt + 4 * g + reg] = ss; }
            __syncthreads();
            const float nw = p->in[I_GNW][l * 128 + w * 16 + r16];
#pragma unroll
            for (int tt = 0; tt < 4; ++tt)
#pragma unroll
                for (int reg = 0; reg < 4; ++reg) {
                    const int t = 16 * tt + 4 * g + reg;
                    float ms = 0.f;
#pragma unroll
                    for (int ww = 0; ww < 8; ++ww) ms += part_s[ww * 64 + t];
                    ob[t * 128 + 16 * w + r16] = f2h(oc[tt][reg] * rsqrtf(ms * (1.0f / 128.0f) + RMS_EPS) * nw * siluf_(h2f(zraw[tt * 4 + reg])));
                }
            __syncthreads();
            GDN_ROLES();
#pragma unroll
            for (int i = 0; i < 2; ++i) { const int j = tid + NT * i; *(uint4*)(ACT + ((size_t)b * T_ + t0 + (j >> 4)) * LDZ + Z_ZG + h * 128 + (j & 15) * 8) = *(const uint4*)(ob + (j >> 4) * 128 + (j & 15) * 8); }
            __syncthreads();
        }
#undef GDN_LOAD
#undef GDN_LOADS
#undef KTO
#undef GDN_ROLES
    }
}

__device__ __forceinline__ unsigned short f2bf_(float f) { unsigned u = __float_as_uint(f); u += 0x7fffu + ((u >> 16) & 1u); return (unsigned short)(u >> 16); }
__device__ __forceinline__ unsigned pack2bf(float a, float b) { return (unsigned)f2bf_(a) | ((unsigned)f2bf_(b) << 16); }
#ifdef CPU_EMU
struct bfrag { unsigned short v[8]; };
__device__ __forceinline__ bfrag bfrag_u4(uint4 w) { bfrag f; memcpy(&f, &w, 16); return f; }
__device__ __forceinline__ bfrag bfrag_2u2(uint2 lo, uint2 hi) { bfrag f; memcpy(&f.v[0], &lo, 8); memcpy(&f.v[4], &hi, 8); return f; }
__device__ __forceinline__ facc mfma16b(bfrag a, bfrag b, facc c) {
    const int tid = tid_(), w = tid >> 6, l = tid & 63;
    unsigned short (*X)[64][16] = emu::ctx->xscr;
    for (int j = 0; j < 8; ++j) { X[w][l][j] = a.v[j]; X[w][l][8 + j] = b.v[j]; }
    __syncthreads();
    for (int reg = 0; reg < 4; ++reg) {
        const int row = 4 * (l >> 4) + reg, col = l & 15;
        float s = 0.f;
        for (int k = 0; k < 32; ++k) s += __uint_as_float((unsigned)X[w][row + 16 * (k >> 3)][k & 7] << 16) * __uint_as_float((unsigned)X[w][col + 16 * (k >> 3)][8 + (k & 7)] << 16);
        c.d[reg] += s;
    }
    __syncthreads();
    return c;
}
#else
typedef __bf16 bfrag __attribute__((ext_vector_type(8)));
__device__ __forceinline__ bfrag bfrag_u4(uint4 w) { return __builtin_bit_cast(bfrag, w); }
__device__ __forceinline__ bfrag bfrag_2u2(uint2 lo, uint2 hi) { uint4 w; w.x = lo.x; w.y = lo.y; w.z = hi.x; w.w = hi.y; return __builtin_bit_cast(bfrag, w); }
__device__ __forceinline__ facc mfma16b(bfrag a, bfrag b, facc c) { return __builtin_amdgcn_mfma_f32_16x16x32_bf16(a, b, c, 0, 0, 0); }
#endif
__device__ __forceinline__ bfrag bfrag_acc2(const facc& t0, const facc& t1) { uint4 w; w.x = pack2bf(t0[0], t0[1]); w.y = pack2bf(t0[2], t0[3]); w.z = pack2bf(t1[0], t1[1]); w.w = pack2bf(t1[2], t1[3]); return bfrag_u4(w); }
__device__ __forceinline__ bfrag bfrag_ld(const unsigned short* p) { return bfrag_u4(*(const uint4*)p); }
__device__ __forceinline__ bfrag bpermfrag(const unsigned short* rowp, int ks, int g) { return bfrag_2u2(*(const uint2*)(rowp + 32 * ks + 4 * g), *(const uint2*)(rowp + 32 * ks + 16 + 4 * g)); }

#ifndef CPU_EMU
typedef _Float16 rw_f16x8 __attribute__((ext_vector_type(8)));
typedef float rw_f32x4 __attribute__((ext_vector_type(4)));
#endif
__device__ __forceinline__ void stage_rwkv(KParams p, int l, char* smem, int vb0, int nvb) {
    const int vb = bid_() - vb0;
    if (vb < 0 || vb >= nvb) return;
    constexpr int CH = 32, XS = 264, IS = 72, TS2 = 40, LS = 36;
    float* r_s = (float*)smem;
    float* k_s = r_s + CH * 64;
    float* o_s = k_s;
    float* v_s = k_s + CH * 64;
    float* w_s = v_s + CH * 64;
    float* ka_s = w_s + CH * 64;
    float* L32 = ka_s;
    float* g_s = ka_s + CH * 64;
    float* bon_s = g_s + CH * 64;
    float* gC_s = bon_s + CH;
    float* scr = gC_s + 64;
    h16_t* raw = (h16_t*)(scr + 512);
    h16_t* xs = raw + (CH + 1) * 448;
    unsigned short* Aim = (unsigned short*)raw;
    unsigned short* Rim = Aim + 32 * IS;
    unsigned short* Bim = Rim + 32 * IS;
    unsigned short* Cim = Bim + 32 * IS;
    unsigned short* Vt = Cim + 32 * IS;
    unsigned short* Ct = Vt + 64 * TS2;
    unsigned short* Btn = Ct + 64 * TS2;
    unsigned short* Nim = Btn + 64 * TS2;
    unsigned short* Tim = Nim + 32 * TS2;
    unsigned short* G1 = Tim + 32 * TS2;
    unsigned short* G2n = G1 + 32 * TS2;
    h16_t* ACT = (h16_t*)(p->ws + OFF_ACT);
    int tid = tid_(), c = tid & 63, tg = tid >> 6;
    int lane = tid & 63, wv = tid >> 6, g = lane >> 4, r16 = lane & 15;
#define RW_ROLES() do { tid = tid_(); c = tid & 63; tg = tid >> 6; lane = c; wv = tg; g = lane >> 4; r16 = lane & 15; } while (0)
    float* cst_s = (float*)(xs + CH * XS);
    for (int item = vb; item < B_ * 16; item += nvb) {
        const int b = item / 16, h = item % 16, ch = h * 64 + c;
        __syncthreads();
        if (tid < 64) {
            const float* mu = p->in[I_RMU] + (size_t)l * RWW;
            cst_s[0 * 64 + c] = p->in[I_RW0][l * 1024 + ch]; cst_s[1 * 64 + c] = p->in[I_RA0][l * 1024 + ch]; cst_s[2 * 64 + c] = p->in[I_RKK][l * 1024 + ch]; cst_s[3 * 64 + c] = p->in[I_RKA][l * 1024 + ch];
            cst_s[4 * 64 + c] = p->in[I_RRK][(size_t)l * 1024 + ch]; cst_s[5 * 64 + c] = p->in[I_RLW][l * 1024 + ch]; cst_s[6 * 64 + c] = p->in[I_RLB][l * 1024 + ch];
            cst_s[7 * 64 + c] = mu[RW_R + ch]; cst_s[8 * 64 + c] = mu[RW_K + ch]; cst_s[9 * 64 + c] = mu[RW_V + ch];
            cst_s[10 * 64 + c] = mu[RW_WL + c]; cst_s[11 * 64 + c] = mu[RW_AL + c]; cst_s[12 * 64 + c] = mu[RW_GL + c]; cst_s[13 * 64 + c] = mu[RW_GL + 64 + c];
        }
        const float* wup = p->in[I_RWUP] + (size_t)l * 64 * 1024 + h * 64; const float* aup = p->in[I_RAUP] + (size_t)l * 64 * 1024 + h * 64; const float* gup = p->in[I_RGUP] + (size_t)l * 128 * 1024 + h * 64;
#ifndef CPU_EMU
        const int mt = wv >> 2, nt = wv & 3;
        rw_f16x8 bw[2], ba_[2], bg[4];
        {
            const int cn = nt * 16 + (lane & 15), kb = 8 * (lane >> 4);
#pragma unroll
            for (int ks = 0; ks < 2; ++ks)
#pragma unroll
                for (int j = 0; j < 8; ++j) { bw[ks][j] = (_Float16)wup[(size_t)(ks * 32 + kb + j) * 1024 + cn]; ba_[ks][j] = (_Float16)aup[(size_t)(ks * 32 + kb + j) * 1024 + cn]; }
#pragma unroll
            for (int ks = 0; ks < 4; ++ks)
#pragma unroll
                for (int j = 0; j < 8; ++j) bg[ks][j] = (_Float16)gup[(size_t)(ks * 32 + kb + j) * 1024 + cn];
        }
#endif
        facc ST[4];
#pragma unroll
        for (int jt = 0; jt < 4; ++jt) ST[jt] = facc_zero();
        uint4 pf[4];
#define RW_LOAD(t0_) do { _Pragma("unroll") for (int i = 0; i < 4; ++i) { const int j = tid + NT * i, row = j / 56, u = j % 56, t = (t0_) - 1 + row; pf[i] = zero16(); \
            if (j < (CH + 1) * 56 && t >= 0) pf[i] = ldg16(ACT + ((size_t)b * T_ + t) * LDZ + Z_RW + (u < 24 ? (u >> 3) * 1024 + h * 64 + (u & 7) * 8 : 3072 + (u - 24) * 8)); } } while (0)
#define RW_PUT() do { _Pragma("unroll") for (int i = 0; i < 4; ++i) { const int j = tid + NT * i; if (j < (CH + 1) * 56) *(uint4*)(raw + (j / 56) * 448 + (j % 56) * 8) = pf[i]; } } while (0)
        __syncthreads();
        RW_LOAD(0);
        RW_PUT();
        __syncthreads();
#pragma unroll 1
        for (int t0 = 0; t0 < T_; t0 += CH) {
            RW_ROLES();
            {
            const float mu_r = cst_s[7 * 64 + c], mu_k = cst_s[8 * 64 + c], mu_v = cst_s[9 * 64 + c], mu_wl = cst_s[10 * 64 + c], mu_al = cst_s[11 * 64 + c], mu_g0 = cst_s[12 * 64 + c], mu_g1 = cst_s[13 * 64 + c];
            float sr[4], sk[4], sv[4], swl[4], sal[4], sg0[4], sg1[4];
#pragma unroll
            for (int s = 0; s < 4; ++s) {
                const int tl = tg * 4 + s;
                const h16_t* zc = raw + (tl + 1) * 448; const h16_t* zp = raw + tl * 448;
#define RW_SHIFT(col, muv) ({ const float zz = h2f(zc[col]); zz + (muv) * (h2f(zp[col]) - zz); })
                sr[s] = RW_SHIFT(c, mu_r); sk[s] = RW_SHIFT(64 + c, mu_k); sv[s] = RW_SHIFT(128 + c, mu_v);
                swl[s] = tanhf_(RW_SHIFT(192 + c, mu_wl)); sal[s] = RW_SHIFT(256 + c, mu_al); sg0[s] = sigmoidf_(RW_SHIFT(320 + c, mu_g0)); sg1[s] = sigmoidf_(RW_SHIFT(384 + c, mu_g1));
#undef RW_SHIFT
            }
            __syncthreads();
#pragma unroll
            for (int s = 0; s < 4; ++s) {
                const int tl = tg * 4 + s;
                r_s[tl * 64 + c] = sr[s]; k_s[tl * 64 + c] = sk[s]; v_s[tl * 64 + c] = sv[s];
                xs[tl * XS + c] = f2h(swl[s]); xs[tl * XS + 64 + c] = f2h(sal[s]); xs[tl * XS + 128 + c] = f2h(sg0[s]); xs[tl * XS + 192 + c] = f2h(sg1[s]);
            }
            }
            __syncthreads();
#ifdef CPU_EMU
#pragma unroll
            for (int s = 0; s < 4; ++s) {
                const int tl = tg * 4 + s;
                float dw = 0.f, da = 0.f, dg = 0.f;
                for (int i = 0; i < 64; ++i) { dw += h2f(xs[tl * XS + i]) * h2f(f2h(wup[(size_t)i * 1024 + c])); da += h2f(xs[tl * XS + 64 + i]) * h2f(f2h(aup[(size_t)i * 1024 + c])); }
                for (int i = 0; i < 128; ++i) dg += h2f(xs[tl * XS + 128 + i]) * h2f(f2h(gup[(size_t)i * 1024 + c]));
                w_s[tl * 64 + c] = dw; ka_s[tl * 64 + c] = da; g_s[tl * 64 + c] = dg;
            }
#else
            {
                const h16_t* ap = xs + (mt * 16 + (lane & 15)) * XS + 8 * (lane >> 4);
                rw_f32x4 dw = {0.f, 0.f, 0.f, 0.f}, da = {0.f, 0.f, 0.f, 0.f}, dg = {0.f, 0.f, 0.f, 0.f};
#pragma unroll
                for (int ks = 0; ks < 2; ++ks) {
                    dw = __builtin_amdgcn_mfma_f32_16x16x32_f16(*(const rw_f16x8*)(ap + ks * 32), bw[ks], dw, 0, 0, 0);
                    da = __builtin_amdgcn_mfma_f32_16x16x32_f16(*(const rw_f16x8*)(ap + 64 + ks * 32), ba_[ks], da, 0, 0, 0);
                }
#pragma unroll
                for (int ks = 0; ks < 4; ++ks) dg = __builtin_amdgcn_mfma_f32_16x16x32_f16(*(const rw_f16x8*)(ap + 128 + ks * 32), bg[ks], dg, 0, 0, 0);
#pragma unroll
                for (int rg = 0; rg < 4; ++rg) { const int o = (mt * 16 + 4 * (lane >> 4) + rg) * 64 + nt * 16 + (lane & 15); w_s[o] = dw[rg]; ka_s[o] = da[rg]; g_s[o] = dg[rg]; }
            }
#endif
            __syncthreads();
            RW_ROLES();
            float kkn4[4], kka4[4], k24[4], rx4[4];
            {
            const float w0 = cst_s[0 * 64 + c], a0 = cst_s[1 * 64 + c], k_k = cst_s[2 * 64 + c], k_a = cst_s[3 * 64 + c], rk_c = cst_s[4 * 64 + c];
#pragma unroll
            for (int s = 0; s < 4; ++s) {
                const int tl = tg * 4 + s;
                const float w_log = -softplusf_(-(w0 + w_s[tl * 64 + c])) - 0.5f;
                const float a = sigmoidf_(a0 + ka_s[tl * 64 + c]);
                const float kx = k_s[tl * 64 + c], rx = r_s[tl * 64 + c];
                const float kkr = kx * k_k, k2 = kx * (1.0f + (a - 1.0f) * k_a);
                const float nsq = group_sum(kkr * kkr, 64, scr);
                const float bon = group_sum(rx * k2 * rk_c, 64, scr);
                const float kkn = kkr * rsqrtf(nsq + RMS_EPS);
                w_s[tl * 64 + c] = fexp_(w_log);
                kkn4[s] = kkn; kka4[s] = kkn * a; k24[s] = k2; rx4[s] = rx;
                if (c == 0) bon_s[tl] = bon;
            }
            }
            __syncthreads();
            if (tid < 64) {
                float acc = 0.f;
#pragma unroll 8
                for (int t = 0; t < CH; ++t) { acc += w_s[t * 64 + tid]; w_s[t * 64 + tid] = acc; }
                gC_s[tid] = fexp_(-acc);
            }
            __syncthreads();
            RW_ROLES();
            {
                const float PC = w_s[(CH - 1) * 64 + c];
                float vt4[4], ct4[4], bt4[4];
#pragma unroll
                for (int s = 0; s < 4; ++s) {
                    const int tl = tg * 4 + s;
                    const float P = w_s[tl * 64 + c], Pm = tl > 0 ? w_s[(tl - 1) * 64 + c] : 0.f;
                    const float gt = fexp_(-P), gm = fexp_(-Pm), ig = fexp_(P), gcr = fexp_(P - PC);
                    Aim[tl * IS + c] = f2bf_(kkn4[s] * gm); Rim[tl * IS + c] = f2bf_(rx4[s] * gt); Bim[tl * IS + c] = f2bf_(kka4[s] * ig); Cim[tl * IS + c] = f2bf_(k24[s] * ig);
                    vt4[s] = v_s[tl * 64 + c]; ct4[s] = k24[s] * gcr; bt4[s] = -kka4[s] * gcr;
                }
                uint2 w2;
                w2.x = pack2bf(vt4[0], vt4[1]); w2.y = pack2bf(vt4[2], vt4[3]); *(uint2*)(Vt + c * TS2 + tg * 4) = w2;
                w2.x = pack2bf(ct4[0], ct4[1]); w2.y = pack2bf(ct4[2], ct4[3]); *(uint2*)(Ct + c * TS2 + tg * 4) = w2;
                w2.x = pack2bf(bt4[0], bt4[1]); w2.y = pack2bf(bt4[2], bt4[3]); *(uint2*)(Btn + c * TS2 + tg * 4) = w2;
                if (tid < 384) { unsigned short* im = tid < 128 ? Nim : (tid < 256 ? G1 : G2n); const int e = tid & 127; *(unsigned*)(im + (e >> 3) * TS2 + 16 + (e & 7) * 2) = 0u; }
            }
            __syncthreads();
            RW_ROLES();
#pragma unroll 1
            for (int jr = 0; jr < 2; ++jr) {
                const int jb = wv + 8 * jr; const bool valid = jb < 12;
                const int prod = valid ? jb / 3 : 0, tix = valid ? jb % 3 : 0, ti = tix > 0 ? 1 : 0, tj = tix > 1 ? 1 : 0;
                const unsigned short* xp = (prod < 2 ? Aim : Rim) + (16 * ti + r16) * IS + 8 * g;
                const unsigned short* yp = ((prod == 0 || prod == 3) ? Bim : Cim) + (16 * tj + r16) * IS + 8 * g;
                facc acc = facc_zero();
#pragma unroll
                for (int ks = 0; ks < 2; ++ks) acc = mfma16b(bfrag_ld(xp + 32 * ks), bfrag_ld(yp + 32 * ks), acc);
                if (valid) {
                    const int s = 16 * tj + r16;
#pragma unroll
                    for (int reg = 0; reg < 4; ++reg) {
                        const int t = 16 * ti + 4 * g + reg;
                        if (prod == 0) L32[t * LS + (s & 7) * 4 + (s >> 3)] = t > s ? acc[reg] : 0.f;
                        else if (prod == 1) Nim[t * TS2 + s] = f2bf_(t > s ? acc[reg] : 0.f);
                        else if (prod == 2) G1[t * TS2 + s] = f2bf_(t >= s ? acc[reg] : 0.f);
                        else G2n[t * TS2 + s] = f2bf_(t >= s ? -acc[reg] : 0.f);
                    }
                }
            }
            __syncthreads();
            RW_ROLES();
            if (tid < 256) {
                const int cc = tid >> 3, q = tid & 7;
                float x[4] = {0.f, 0.f, 0.f, 0.f};
#pragma unroll
                for (int r = 0; r < 32; ++r) {
                    float sacc = 0.f;
                    if (r > 0) {
                        const float4 a4 = *(const float4*)(L32 + r * LS + q * 4);
                        sacc = a4.x * x[0];
                        if (r > 8) sacc += a4.y * x[1];
                        if (r > 16) sacc += a4.z * x[2];
                        if (r > 24) sacc += a4.w * x[3];
                        sacc = group_sum(sacc, 8, scr);
                    }
                    const float xr = ((r == cc) ? 1.f : 0.f) - sacc;
                    x[r >> 3] = (q == (r & 7)) ? xr : x[r >> 3];
                    Tim[r * TS2 + cc] = f2bf_(xr);
                }
            }
#ifdef CPU_EMU
            else { for (int r = 1; r < 32; ++r) (void)group_sum(0.f, 8, scr); }
#endif
            __syncthreads();
            if (t0 + CH < T_) RW_LOAD(t0 + CH);
            RW_ROLES();
            {
                const int it = wv & 3;
                bfrag STb[2];
                STb[0] = bfrag_acc2(ST[0], ST[1]); STb[1] = bfrag_acc2(ST[2], ST[3]);
                const bfrag vtf = bfrag_ld(Vt + (16 * it + r16) * TS2 + 8 * g);
                facc rhs[2], oo[2];
#pragma unroll
                for (int tt = 0; tt < 2; ++tt) {
                    const unsigned short* arow = Aim + (16 * tt + r16) * IS; const unsigned short* rrow = Rim + (16 * tt + r16) * IS;
                    rhs[tt] = mfma16b(bpermfrag(arow, 0, g), STb[0], facc_zero()); rhs[tt] = mfma16b(bpermfrag(arow, 1, g), STb[1], rhs[tt]);
                    rhs[tt] = mfma16b(bfrag_ld(Nim + (16 * tt + r16) * TS2 + 8 * g), vtf, rhs[tt]);
                    oo[tt] = mfma16b(bpermfrag(rrow, 0, g), STb[0], facc_zero()); oo[tt] = mfma16b(bpermfrag(rrow, 1, g), STb[1], oo[tt]);
                    oo[tt] = mfma16b(bfrag_ld(G1 + (16 * tt + r16) * TS2 + 8 * g), vtf, oo[tt]);
                }
                const bfrag rhsb = bfrag_acc2(rhs[0], rhs[1]);
                facc uu[2];
#pragma unroll
                for (int tt = 0; tt < 2; ++tt) uu[tt] = mfma16b(bpermfrag(Tim + (16 * tt + r16) * TS2, 0, g), rhsb, facc_zero());
                const bfrag ub = bfrag_acc2(uu[0], uu[1]);
#pragma unroll
                for (int tt = 0; tt < 2; ++tt) {
                    oo[tt] = mfma16b(bpermfrag(G2n + (16 * tt + r16) * TS2, 0, g), ub, oo[tt]);
                    if (wv < 4) {
#pragma unroll
                        for (int reg = 0; reg < 4; ++reg) o_s[(16 * tt + 4 * g + reg) * 64 + 16 * it + r16] = oo[tt][reg];
                    }
                }
#pragma unroll
                for (int jt = 0; jt < 4; ++jt) {
#pragma unroll
                    for (int reg = 0; reg < 4; ++reg) ST[jt][reg] *= gC_s[16 * jt + 4 * g + reg];
                    ST[jt] = mfma16b(bfrag_ld(Ct + (16 * jt + r16) * TS2 + 8 * g), vtf, ST[jt]);
                    ST[jt] = mfma16b(bpermfrag(Btn + (16 * jt + r16) * TS2, 0, g), ub, ST[jt]);
                }
            }
            __syncthreads();
            RW_ROLES();
            {
            const float lnw = cst_s[5 * 64 + c], lnb = cst_s[6 * 64 + c];
            const int chh = h * 64 + c;
#pragma unroll
            for (int s = 0; s < 4; ++s) {
                const int tl = tg * 4 + s;
                const float ov = o_s[tl * 64 + c];
                const float mean = group_sum(ov, 64, scr) * (1.0f / 64.0f);
                const float d = ov - mean;
                const float var = group_sum(d * d, 64, scr) * (1.0f / 64.0f);
                const float y = (d * rsqrtf(var + GN_EPS) * lnw + lnb + bon_s[tl] * v_s[tl * 64 + c]) * g_s[tl * 64 + c];
                ACT[((size_t)b * T_ + t0 + tl) * LDZ + C_YC + chh] = f2h(y);
            }
            }
            RW_ROLES();
            if (t0 + CH < T_) RW_PUT();
            __syncthreads();
        }
#undef RW_LOAD
#undef RW_PUT
#undef RW_ROLES
    }
}
constexpr bool TAB_IN_ACT = false;
constexpr float TAB_SU = 256.0f, TAB_SV = 32.0f;
__device__ __forceinline__ unsigned char* tab_row(char* ws, int e) {
    if (TAB_IN_ACT) return (unsigned char*)((h16_t*)(ws + OFF_ACT) + (size_t)e * LDZ + C_GS);
    return (unsigned char*)(ws + OFF_TAB) + (size_t)e * 2048;
}
#ifdef CPU_EMU
__device__ __forceinline__ unsigned f2fp8(float f) {
    const unsigned sgn = f < 0.f ? 0x80u : 0u; float a = fabsf(f);
    if (!(a == a)) return 0x7fu;
    if (a >= 448.0f) return sgn | 0x7eu;
    if (a < 0.0009765625f) return sgn;
    int e; frexpf(a, &e); e -= 1;
    if (e < -6) { const float q = nearbyintf(a * 512.0f); return sgn | (unsigned)q; }
    float q = nearbyintf((a / ldexpf(1.0f, e) - 1.0f) * 8.0f);
    if (q >= 8.0f) { q = 0.f; e += 1; }
    if (e > 8) return sgn | 0x7eu;
    const unsigned r = ((unsigned)(e + 7) << 3) | (unsigned)q;
    return sgn | (r > 0x7eu ? 0x7eu : r);
}
__device__ __forceinline__ float fp82f(unsigned b) {
    const unsigned e = (b >> 3) & 15u, m = b & 7u; const float s = (b & 0x80u) ? -1.f : 1.f;
    if (e == 0) return s * (float)m * 0.001953125f;
    return s * ldexpf(1.0f + (float)m * 0.125f, (int)e - 7);
}
__device__ __forceinline__ unsigned pack4fp8(float a, float b, float c, float d) { return f2fp8(a) | (f2fp8(b) << 8) | (f2fp8(c) << 16) | (f2fp8(d) << 24); }
__device__ __forceinline__ void dec4fp8(unsigned w, float* o) { o[0] = fp82f(w & 255u); o[1] = fp82f((w >> 8) & 255u); o[2] = fp82f((w >> 16) & 255u); o[3] = fp82f(w >> 24); }
#else
__device__ __forceinline__ unsigned pack4fp8(float a, float b, float c, float d) { int p = __builtin_amdgcn_cvt_pk_fp8_f32(a, b, 0, false); p = __builtin_amdgcn_cvt_pk_fp8_f32(c, d, p, true); return (unsigned)p; }
__device__ __forceinline__ void dec4fp8(unsigned w, float* o) { const auto lo = __builtin_amdgcn_cvt_pk_f32_fp8((int)w, false); const auto hi = __builtin_amdgcn_cvt_pk_f32_fp8((int)w, true); o[0] = lo[0]; o[1] = lo[1]; o[2] = hi[0]; o[3] = hi[1]; }
#endif
__device__ __forceinline__ void stage_tabconv(KParams p, int l, int vb0, int nvb) {
    const int vb = bid_() - vb0;
    if (vb < 0 || vb >= nvb) return;
    const int tid = tid_();
    const float* U = p->in[I_PU] + (size_t)l * 16384 * 1024; const float* V = p->in[I_PV] + (size_t)l * 16384 * 1024;
    char* ws = p->ws;
    for (int it = vb * NT + tid; it < 16384 * 128; it += nvb * NT) {
        const int r = it >> 7, ck = it & 127, which = ck >> 6, c16 = ck & 63;
        const float* src = (which ? V : U) + (size_t)r * 1024 + c16 * 16;
        const float sc = which ? TAB_SV : TAB_SU;
        const float4 a = *(const float4*)src, b = *(const float4*)(src + 4), c = *(const float4*)(src + 8), d = *(const float4*)(src + 12);
        uint4 w;
        w.x = pack4fp8(a.x * sc, a.y * sc, a.z * sc, a.w * sc); w.y = pack4fp8(b.x * sc, b.y * sc, b.z * sc, b.w * sc);
        w.z = pack4fp8(c.x * sc, c.y * sc, c.z * sc, c.w * sc); w.w = pack4fp8(d.x * sc, d.y * sc, d.z * sc, d.w * sc);
        *(uint4*)(tab_row(ws, r) + which * 1024 + c16 * 16) = w;
    }
}

#ifdef CPU_EMU
__device__ __forceinline__ float group_max16(float v, float* scr) {
    const int tid = tid_();
    scr[tid] = v;
    __syncthreads();
    float m = -3.0e38f; const int base = tid & ~15;
    for (int i = 0; i < 16; ++i) m = fmaxf(m, scr[base + i]);
    __syncthreads();
    return m;
}
#else
__device__ __forceinline__ float group_max16(float v, float*) {
    v = fmaxf(v, dpp_f<0xB1>(v)); v = fmaxf(v, dpp_f<0x4E>(v)); v = fmaxf(v, dpp_f<0x141>(v)); v = fmaxf(v, dpp_f<0x140>(v));
    return v;
}
#endif
__device__ __forceinline__ void stage_peer_topk(KParams p, int l, char* smem) {
    constexpr int KS = 136;
    h16_t* khi = (h16_t*)smem;
    h16_t* klo = khi + 128 * KS;
    float* scr = (float*)(klo + 128 * KS);
    const h16_t* ACT = (const h16_t*)(p->ws + OFF_ACT);
    float* TOPS = (float*)(p->ws + OFF_TOPS);
    int tid = tid_(), lane = tid & 63, w = tid >> 6, g = lane >> 4, r16 = lane & 15;
#define TK_ROLES() do { tid = tid_(); lane = tid & 63; w = tid >> 6; g = lane >> 4; r16 = lane & 15; } while (0)
    const int nb = gridDim.x;
    for (int hs = bid_() % 16; hs < 16; hs += nb) {
        const int hd = hs >> 1, s = hs & 1;
        __syncthreads();
        {
            const float* kp = p->in[I_PKEYS] + (((size_t)l * 8 + hd) * 2 + s) * 128 * 128;
            for (int i = tid * 4; i < 128 * 128; i += NT * 4) {
                const float4 kv = *(const float4*)(kp + i);
                const int n = i >> 7, c0 = i & 127;
                const float h0 = h2f(f2h(kv.x)), h1 = h2f(f2h(kv.y)), h2 = h2f(f2h(kv.z)), h3 = h2f(f2h(kv.w));
                uint2 hw, lw; hw.x = pack2h(kv.x, kv.y); hw.y = pack2h(kv.z, kv.w); lw.x = pack2h(kv.x - h0, kv.y - h1); lw.y = pack2h(kv.z - h2, kv.w - h3);
                *(uint2*)(khi + n * KS + c0) = hw; *(uint2*)(klo + n * KS + c0) = lw;
            }
        }
        __syncthreads();
        const int nblk = nb >= 16 ? nb / 16 : 1, bsub = nb >= 16 ? bid_() / 16 : 0;
        for (int chunk = bsub; chunk < (M_ + NT - 1) / NT; chunk += nblk) {
            if (nb >= 16 && bid_() >= nblk * 16) break;
#pragma unroll 1
            for (int tt = 0; tt < 4; ++tt) {
                TK_ROLES();
                const int tok0 = chunk * NT + w * 64 + tt * 16;
                const bool live = tok0 < M_;
                hfrag af[4];
                {
                    const h16_t* qp = ACT + (size_t)(live ? tok0 + r16 : 0) * LDZ + C_QRY + hd * 256 + s * 128 + 8 * g;
#pragma unroll
                    for (int ks = 0; ks < 4; ++ks) af[ks] = frag_u4(*(const uint4*)(qp + 32 * ks));
                }
                facc acc[8];
#pragma unroll
                for (int nt = 0; nt < 8; ++nt) {
                    acc[nt] = facc_zero();
                    const h16_t* bh = khi + (16 * nt + r16) * KS + 8 * g; const h16_t* bl = klo + (16 * nt + r16) * KS + 8 * g;
#pragma unroll
                    for (int ks = 0; ks < 4; ++ks) { acc[nt] = mfma16(af[ks], frag_u4(*(const uint4*)(bh + 32 * ks)), acc[nt]); acc[nt] = mfma16(af[ks], frag_u4(*(const uint4*)(bl + 32 * ks)), acc[nt]); }
                }
#pragma unroll 1
                for (int rp = 0; rp < 2; ++rp) {
                  TK_ROLES();
#pragma unroll
                  for (int r2 = 0; r2 < 2; ++r2) {
                    const int reg = rp * 2 + r2;
                    float v[8];
#pragma unroll
                    for (int nt = 0; nt < 8; ++nt) { const float av = rp == 0 ? (r2 == 0 ? acc[nt][0] : acc[nt][1]) : (r2 == 0 ? acc[nt][2] : acc[nt][3]); v[nt] = __uint_as_float((__float_as_uint(av) & ~127u) | (unsigned)(127 - (16 * nt + r16))); }
#define CE(i, j) { const float hi_ = fmaxf(v[i], v[j]), lo_ = fminf(v[i], v[j]); v[i] = hi_; v[j] = lo_; }
                    CE(0, 1) CE(2, 3) CE(4, 5) CE(6, 7) CE(0, 2) CE(1, 3) CE(4, 6) CE(5, 7) CE(1, 2) CE(5, 6) CE(0, 4) CE(1, 5) CE(2, 6) CE(3, 7) CE(2, 4) CE(3, 5) CE(1, 2) CE(3, 4) CE(5, 6)
#undef CE
                    float res = 0.f;
#pragma unroll
                    for (int rnd = 0; rnd < 16; ++rnd) {
                        const float m = group_max16(v[0], scr);
                        const bool win = v[0] == m;
#pragma unroll
                        for (int i = 0; i < 7; ++i) v[i] = win ? v[i + 1] : v[i];
                        v[7] = win ? -3.0e38f : v[7];
                        res = (r16 == rnd) ? m : res;
                    }
                    if (live) TOPS[(((size_t)(tok0 + 4 * g + reg) * 8 + hd) * 2 + s) * 16 + r16] = res;
                  }
                }
            }
        }
    }
}

#undef TK_ROLES
__device__ __forceinline__ void peer_cand(int k, int& i, int& j) {
    if (k < 16) { i = 0; j = k; } else if (k < 24) { i = 1; j = k - 16; } else if (k < 29) { i = 2; j = k - 24; } else if (k < 33) { i = 3; j = k - 29; }
    else if (k < 36) { i = 4; j = k - 33; } else if (k < 38) { i = 5; j = k - 36; } else if (k < 40) { i = 6; j = k - 38; } else if (k < 42) { i = 7; j = k - 40; }
    else { i = k - 34; j = 0; }
}
__device__ __forceinline__ float dot16q(const uint4 a, const float (&x)[16]) {
    float t[4], s0, s1;
    dec4fp8(a.x, t); s0 = t[0] * x[0] + t[1] * x[1]; s1 = t[2] * x[2] + t[3] * x[3];
    dec4fp8(a.y, t); s0 += t[0] * x[4] + t[1] * x[5]; s1 += t[2] * x[6] + t[3] * x[7];
    dec4fp8(a.z, t); s0 += t[0] * x[8] + t[1] * x[9]; s1 += t[2] * x[10] + t[3] * x[11];
    dec4fp8(a.w, t); s0 += t[0] * x[12] + t[1] * x[13]; s1 += t[2] * x[14] + t[3] * x[15];
    return s0 + s1;
}
__device__ __forceinline__ void axpy16q(const uint4 a, float s, float (&y)[16]) {
    float t[4];
    dec4fp8(a.x, t); y[0] += s * t[0]; y[1] += s * t[1]; y[2] += s * t[2]; y[3] += s * t[3];
    dec4fp8(a.y, t); y[4] += s * t[0]; y[5] += s * t[1]; y[6] += s * t[2]; y[7] += s * t[3];
    dec4fp8(a.z, t); y[8] += s * t[0]; y[9] += s * t[1]; y[10] += s * t[2]; y[11] += s * t[3];
    dec4fp8(a.w, t); y[12] += s * t[0]; y[13] += s * t[1]; y[14] += s * t[2]; y[15] += s * t[3];
}
#ifdef CPU_EMU
__device__ __forceinline__ float lane_xor(float v, int mask, float* scr) { const int tid = tid_(); scr[tid] = v; __syncthreads(); const float r = scr[tid ^ mask]; __syncthreads(); return r; }
__device__ __forceinline__ float lane_bcast(float v, int src, float* scr) { const int tid = tid_(); scr[tid] = v; __syncthreads(); const float r = scr[(tid & ~63) + src]; __syncthreads(); return r; }
#else
__device__ __forceinline__ float lane_xor(float v, int mask, float*) { return mask == 1 ? dpp_f<0xB1>(v) : (mask == 2 ? dpp_f<0x4E>(v) : __shfl_xor(v, mask)); }
__device__ __forceinline__ float lane_bcast(float v, int src, float*) { return __builtin_bit_cast(float, __builtin_amdgcn_readlane(__builtin_bit_cast(int, v), src)); }
#endif
__device__ __forceinline__ float reduce8(const float (&v)[8], int lane, float* scr) {
    const bool b0 = lane & 1, b1 = lane & 2, b2 = lane & 4;
    float w4[4], u2[2];
#pragma unroll
    for (int j = 0; j < 4; ++j) { const float keep = b0 ? v[2 * j + 1] : v[2 * j], send = b0 ? v[2 * j] : v[2 * j + 1]; w4[j] = keep + lane_xor(send, 1, scr); }
#pragma unroll
    for (int j = 0; j < 2; ++j) { const float keep = b1 ? w4[2 * j + 1] : w4[2 * j], send = b1 ? w4[2 * j] : w4[2 * j + 1]; u2[j] = keep + lane_xor(send, 2, scr); }
    float z = (b2 ? u2[1] : u2[0]) + lane_xor(b2 ? u2[0] : u2[1], 4, scr);
    z += lane_xor(z, 8, scr); z += lane_xor(z, 16, scr); z += lane_xor(z, 32, scr);
    return z;
}
#ifdef CPU_EMU
#define PG_WSYNC() __syncthreads()
#else
#define PG_WSYNC() do { __builtin_amdgcn_fence(__ATOMIC_RELEASE, "wavefront"); __builtin_amdgcn_wave_barrier(); __builtin_amdgcn_fence(__ATOMIC_ACQUIRE, "wavefront"); } while (0)
#endif
__device__ __forceinline__ void stage_peer_gather(KParams p, int l, char* smem) {
    int tid = tid_(), w = tid >> 6, lane = tid & 63;
    float* base; float* tops_s; float* cand_s; float* best_s; int* idx_s; float* gate_s; int* pos_s;
#define PG_ROLES() do { tid = tid_(); w = tid >> 6; lane = tid & 63; base = (float*)smem + w * 2048; tops_s = base; cand_s = tops_s + 256; best_s = cand_s + 64; \
        idx_s = (int*)(best_s + 128); gate_s = (float*)(idx_s + 128); pos_s = (int*)(gate_s + 128); } while (0)
    PG_ROLES();
    float* scr = (float*)smem + 8 * 2048;
    h16_t* ACT = (h16_t*)(p->ws + OFF_ACT);
    const float* TOPS = (const float*)(p->ws + OFF_TOPS);
    char* ws = p->ws;
    const float* nxt_w = (l + 1 < NL_) ? p->in[I_NMIX] + (l + 1) * 1024 : p->in[I_NFINAL];
    const int nwaves = gridDim.x * 8;
    for (int m = bid_() * 8 + w; m < M_; m += nwaves) {
        PG_ROLES();
        PG_WSYNC();
        *(float4*)(tops_s + lane * 4) = *(const float4*)(TOPS + (size_t)m * 256 + lane * 4);
        float x[16];
        { float t8[8]; load8h(ACT + (size_t)m * LDZ + C_XN + lane * 16, t8);
#pragma unroll
          for (int j = 0; j < 8; ++j) x[j] = t8[j];
          load8h(ACT + (size_t)m * LDZ + C_XN + lane * 16 + 8, t8);
#pragma unroll
          for (int j = 0; j < 8; ++j) x[8 + j] = t8[j]; }
        PG_WSYNC();
        int ci = 0, cj = 0;
        if (lane < 50) peer_cand(lane, ci, cj);
        const int pos = ci * 16 + cj;
        pos_s[lane] = pos;
#pragma unroll 1
        for (int hd = 0; hd < 8; ++hd) {
            const float cs = lane < 50 ? tops_s[hd * 32 + ci] + tops_s[hd * 32 + 16 + cj] : -3.0e38f;
            cand_s[lane] = cs;
            PG_WSYNC();
            if (lane < 50) {
                int cnt = 0;
#pragma unroll 10
                for (int o = 0; o < 50; ++o) { const float ov = cand_s[o]; cnt += (ov > cs || (ov == cs && pos_s[o] < pos)) ? 1 : 0; }
                if (cnt < 16) {
                    best_s[hd * 16 + cnt] = cs;
                    const int n0 = 127 - (int)(__float_as_uint(tops_s[hd * 32 + ci]) & 127u), n1 = 127 - (int)(__float_as_uint(tops_s[hd * 32 + 16 + cj]) & 127u);
                    idx_s[hd * 16 + cnt] = n0 * 128 + n1;
                }
            }
            PG_WSYNC();
        }
#pragma unroll
        for (int rr = 0; rr < 2; ++rr) {
            const int e = lane + 64 * rr, hd = e >> 4;
            const float mx = best_s[hd * 16];
            float sum = 0.f;
#pragma unroll
            for (int i = 0; i < 16; ++i) sum += fexp_(best_s[hd * 16 + i] - mx);
            gate_s[e] = fexp_(best_s[e] - mx) / sum;
        }
        PG_WSYNC();
        float y[16];
#pragma unroll
        for (int i = 0; i < 16; ++i) y[i] = 0.f;
        PG_ROLES();
        uint4 uu[8], vv[8];
#define PG_LOADU(eb_) do { _Pragma("unroll") for (int k = 0; k < 8; ++k) uu[k] = *(const uint4*)(tab_row(ws, idx_s[(eb_) + k]) + lane * 16); } while (0)
#define PG_LOADV(eb_) do { _Pragma("unroll") for (int k = 0; k < 8; ++k) vv[k] = *(const uint4*)(tab_row(ws, idx_s[(eb_) + k]) + 1024 + lane * 16); } while (0)
        PG_LOADU(0); PG_LOADV(0);
#pragma unroll 1
        for (int eb = 0; eb < 128; eb += 8) {
            float d8[8];
#pragma unroll
            for (int k = 0; k < 8; ++k) d8[k] = dot16q(uu[k], x);
            if (eb + 8 < 128) PG_LOADU(eb + 8);
            const float tot = reduce8(d8, lane, scr);
            const float hk = gate_s[eb + (lane & 7)] * geluf_(tot * (1.0f / TAB_SU));
#pragma unroll
            for (int k = 0; k < 8; ++k) axpy16q(vv[k], lane_bcast(hk, k, scr), y);
            if (eb + 8 < 128) PG_LOADV(eb + 8);
        }
#undef PG_LOADU
#undef PG_LOADV
        PG_ROLES();
        float* op = p->out + (size_t)m * 1024 + lane * 16;
        float hn[16]; float ss = 0.f;
#pragma unroll
        for (int i = 0; i < 16; i += 4) {
            const float4 o4 = *(const float4*)(op + i);
            hn[i] = o4.x + y[i] * (1.0f / TAB_SV); hn[i + 1] = o4.y + y[i + 1] * (1.0f / TAB_SV); hn[i + 2] = o4.z + y[i + 2] * (1.0f / TAB_SV); hn[i + 3] = o4.w + y[i + 3] * (1.0f / TAB_SV);
            ss += hn[i] * hn[i] + hn[i + 1] * hn[i + 1] + hn[i + 2] * hn[i + 2] + hn[i + 3] * hn[i + 3];
        }
        ss = group_sum(ss, 64, scr);
        const float rstd = rsqrtf(ss * (1.0f / D_) + RMS_EPS);
        float nv[16];
#pragma unroll
        for (int i = 0; i < 16; i += 4) { const float4 w4 = *(const float4*)(nxt_w + lane * 16 + i); nv[i] = hn[i] * rstd * w4.x; nv[i + 1] = hn[i + 1] * rstd * w4.y; nv[i + 2] = hn[i + 2] * rstd * w4.z; nv[i + 3] = hn[i + 3] * rstd * w4.w; }
        if (l + 1 < NL_) {
#pragma unroll
            for (int i = 0; i < 16; i += 4) *(float4*)(op + i) = make_float4(hn[i], hn[i + 1], hn[i + 2], hn[i + 3]);
            const float n0[8] = {nv[0], nv[1], nv[2], nv[3], nv[4], nv[5], nv[6], nv[7]}, n1[8] = {nv[8], nv[9], nv[10], nv[11], nv[12], nv[13], nv[14], nv[15]};
            store8h(ACT + (size_t)m * LDZ + C_XN + lane * 16, n0); store8h(ACT + (size_t)m * LDZ + C_XN + lane * 16 + 8, n1);
        } else {
#pragma unroll
            for (int i = 0; i < 16; i += 4) *(float4*)(op + i) = make_float4(nv[i], nv[i + 1], nv[i + 2], nv[i + 3]);
        }
    }
}
#undef PG_ROLES
#undef PG_WSYNC

enum { PH_NORM_MIX = 0, PH_INPROJ, PH_MIXERS, PH_MERGE, PH_WOUT, PH_NORM_FFN, PH_QUERY, PH_TOPK, PH_GATHER, PH_PER_LAYER, PH_FINAL = 100, PH_WPREP = 101 };
__device__ __forceinline__ void run_phase(KParams p, int l, int ph, char* smem) {
    h16_t* ACT = (h16_t*)(p->ws + OFF_ACT);
    const float* hin = l == 0 ? p->in[I_X] : p->out;
    switch (ph) {
    case PH_WPREP: stage_wprep(p, smem); break;
    case PH_NORM_MIX: if (l == 0) stage_rmsnorm(hin, p->in[I_NMIX] + l * 1024, ACT + C_XN, LDZ, smem); break;
    case PH_INPROJ: stage_gemm(p, l, GP_INPROJ, smem); break;
    case PH_MIXERS: {
        const int nb = gridDim.x, n_rw = nb / 2, n_gd = nb / 4, n_lr = nb - n_rw - n_gd;
        stage_rwkv(p, l, smem, 0, n_rw);
        stage_gdn(p, l, smem, n_rw, n_gd);
        stage_lru(p, l, smem, n_rw + n_gd, n_lr);
        stage_tabconv(p, l, n_rw + n_gd, n_lr);
    } break;
    case PH_MERGE: stage_gemm(p, l, GP_MERGE, smem); break;
    case PH_WOUT: stage_gemm(p, l, GP_WOUT, smem); break;
    case PH_NORM_FFN: stage_rmsnorm(p->out, p->in[I_NFFN] + l * 1024, ACT + C_XN, LDZ, smem); break;
    case PH_QUERY: stage_gemm(p, l, GP_QUERY, smem); break;
    case PH_TOPK: stage_peer_topk(p, l, smem); break;
    case PH_GATHER: stage_peer_gather(p, l, smem); break;
    case PH_FINAL: break;
    default: break;
    }
}


#if !defined(CPU_EMU) && !MK_MULTI
#define XB_TMO      128
#define XB_XCNT(j)  (256  + 64 * (j))
#define XB_XSUB(j)  (1280 + 64 * (j))
#define XB_XGEN(j)  (2304 + 64 * (j))
#define XB_TOP      3328
#define XB_TOPGEN   3392
#define XCD_BAR_WORDS 3456
#define XB_SPIN_CAP (1u << 22)
#define XB_LAS __attribute__((address_space(3)))
__device__ __forceinline__ unsigned xb_ld(unsigned* p)              { return __hip_atomic_load(p, __ATOMIC_RELAXED, __HIP_MEMORY_SCOPE_AGENT); }
__device__ __forceinline__ unsigned xb_add(unsigned* p, unsigned v) { return __hip_atomic_fetch_add(p, v, __ATOMIC_RELAXED, __HIP_MEMORY_SCOPE_AGENT); }
__device__ __forceinline__ unsigned xb_xcc_id() { return (unsigned)__builtin_amdgcn_s_getreg((3 << 11) | 20) & 0xFu; }
#define XB_SPIN(cond, bar) do { unsigned _sp = 0; while (cond) { __builtin_amdgcn_s_sleep(1); \
    if ((++_sp & 255u) == 0u) { if (xb_ld(&(bar)[XB_TMO])) break; if (_sp > XB_SPIN_CAP) { atomicAdd(&(bar)[XB_TMO], 1u); break; } } } } while (0)
struct XcdBarrier { unsigned* bar; unsigned x; volatile XB_LAS unsigned* st; };
__device__ __forceinline__ XcdBarrier xcd_barrier_post(unsigned* bar, volatile XB_LAS unsigned* st) {
    XcdBarrier b; b.bar = bar; b.x = xb_xcc_id(); b.st = st;
    if (threadIdx.x == 0) (void)xb_add(&bar[XB_XCNT(b.x)], 1u);
    return b;
}
__device__ __forceinline__ void xcd_barrier_complete(unsigned* bar, unsigned x, unsigned& nloc, unsigned& nx) {
    const unsigned G = gridDim.x * gridDim.y * gridDim.z;
    unsigned sum, cnt, mine, sp = 0u;
    for (;;) {
        sum = 0u; cnt = 0u; mine = 0u;
#pragma unroll
        for (unsigned j = 0; j < 16; ++j) { const unsigned c = xb_ld(&bar[XB_XCNT(j)]); sum += c; cnt += (c > 0u) ? 1u : 0u; mine = (j == x) ? c : mine; }
        if (sum == G) break;
        __builtin_amdgcn_s_sleep(1);
        if ((++sp & 255u) == 0u) { if (xb_ld(&bar[XB_TMO])) break; if (sp > XB_SPIN_CAP) { atomicAdd(&bar[XB_TMO], 1u); break; } }
    }
    nloc = mine > 0u ? mine : 1u; nx = cnt > 0u ? cnt : 1u;
}
__device__ __forceinline__ void xcd_barrier(const XcdBarrier& b) {
    asm volatile("s_waitcnt vmcnt(0)" ::: "memory");
    __syncthreads();
    if (threadIdx.x == 0) {
        unsigned* bar = b.bar;
        __builtin_amdgcn_s_waitcnt(0);
        unsigned nloc = b.st[0], nx = b.st[1];
        if (nloc == 0u) { xcd_barrier_complete(bar, b.x, nloc, nx); b.st[0] = nloc; b.st[1] = nx; }
        const unsigned old = xb_add(&bar[XB_XSUB(b.x)], 1u);
        const unsigned gen = old / nloc;
        if (old + 1u == (gen + 1u) * nloc) {
            __builtin_amdgcn_fence(__ATOMIC_RELEASE, "agent");
            asm volatile("s_waitcnt vmcnt(0)" ::: "memory");
            const unsigned og = xb_add(&bar[XB_TOP], 1u);
            const unsigned tg = og / nx;
            if (og + 1u == (tg + 1u) * nx) xb_add(&bar[XB_TOPGEN], 1u);
            else XB_SPIN(xb_ld(&bar[XB_TOPGEN]) == tg, bar);
            __builtin_amdgcn_fence(__ATOMIC_ACQUIRE, "agent");
            xb_add(&bar[XB_XGEN(b.x)], 1u);
            asm volatile("s_waitcnt vmcnt(0)" ::: "memory");
        } else {
            XB_SPIN(xb_ld(&bar[XB_XGEN(b.x)]) == gen, bar);
            __builtin_amdgcn_fence(__ATOMIC_ACQUIRE, "agent");
            asm volatile("s_waitcnt vmcnt(0)" ::: "memory");
        }
    }
    __syncthreads();
}
#endif
#if !defined(CPU_EMU) && !MK_MULTI
__global__ void __launch_bounds__(512, 2) k_mega(Params p_) {
    DYN_SMEM(smem);
    KParams pk = (KParams)__builtin_amdgcn_kernarg_segment_ptr();
    cg::grid_group grid = cg::this_grid();
    volatile XB_LAS unsigned* xst = (volatile XB_LAS unsigned*)(XB_LAS char*)(smem + SMEM_BYTES);
    if (threadIdx.x == 0) { xst[0] = 0u; xst[1] = 0u; xst[2] = 0u; xst[3] = 0u; }
    __syncthreads();
    const XcdBarrier xb = xcd_barrier_post((unsigned*)(pk->ws + OFF_BAR), xst);
    if (gridDim.x > 0x100000u) grid.sync();
    constexpr int NIT = NL_ * PH_PER_LAYER;
#pragma unroll 1
    for (int it = -1; it <= NIT; ++it) {
        const int l = (it >= 0 && it < NIT) ? it / PH_PER_LAYER : 0, ph = it < 0 ? (int)PH_WPREP : (it < NIT ? it % PH_PER_LAYER : (int)PH_FINAL);
        KParams q = pk; asm volatile("" : "+s"(q));
        run_phase(q, l, ph, smem);
        if (it >= 0 && it < NIT - 1 && !(l > 0 && ph == PH_NORM_MIX)) {
            xcd_barrier(xb);
        }
    }
}
#endif
#ifdef CPU_EMU
__global__ void k_phase(Params p_, int l, int ph) { DYN_SMEM(smem); run_phase(&p_, l, ph, smem); }
#elif MK_MULTI
__global__ void __launch_bounds__(512, 2) k_phase(Params p_, int l, int ph) { DYN_SMEM(smem); KParams pk = (KParams)__builtin_amdgcn_kernarg_segment_ptr(); run_phase(pk, l, ph, smem); }
#endif
}

#ifdef CPU_EMU
int g_emu_stop = 1000;
#endif

extern "C" void kernel_launch(void* const* d_in, const int* in_sizes, int n_in, void* d_out, int out_size, void* d_ws, size_t ws_size, hipStream_t stream) {
    Params p{};
    for (int i = 0; i < N_IN; ++i) p.in[i] = (const float*)d_in[i];
    p.out = (float*)d_out; p.ws = (char*)d_ws;
#if defined(CPU_EMU) || MK_MULTI
    const int grid = 256;
    LAUNCH(k_phase, grid, NT, SMEM_BYTES, stream, p, 0, (int)PH_WPREP);
    for (int l = 0; l < NL_; ++l)
        for (int ph = 0; ph < PH_PER_LAYER; ++ph) {
            LAUNCH(k_phase, grid, NT, SMEM_BYTES, stream, p, l, ph);
#ifdef CPU_EMU
            const int code = ph == PH_INPROJ ? 1 : ph == PH_MIXERS ? 2 : ph == PH_MERGE ? 3 : ph == PH_WOUT ? 4 : ph == PH_GATHER ? 5 : 0;
            if (code && g_emu_stop == l * 10 + code) return;
#endif
        }
    LAUNCH(k_phase, grid, NT, SMEM_BYTES, stream, p, 0, (int)PH_FINAL);
#else
    static int grid_blocks = 0;
    if (!grid_blocks) {
        int dev = 0, cus = 0, per_cu = 0;
        (void)hipGetDevice(&dev);
        (void)hipDeviceGetAttribute(&cus, hipDeviceAttributeMultiprocessorCount, dev);
        (void)hipFuncSetAttribute((const void*)k_mega, hipFuncAttributeMaxDynamicSharedMemorySize, (int)SMEM_BYTES + 16);
        (void)hipOccupancyMaxActiveBlocksPerMultiprocessor(&per_cu, k_mega, NT, SMEM_BYTES + 16);
        if (per_cu > 1) per_cu = 1;
        grid_blocks = cus * per_cu;
    }
    (void)hipMemsetAsync((char*)d_ws + OFF_BAR, 0, 16384, stream);
    void* args[] = {&p};
    hipError_t e = hipLaunchCooperativeKernel((void*)k_mega, dim3(grid_blocks), dim3(NT), args, SMEM_BYTES + 16, stream);
    if (e != hipSuccess) fprintf(stderr, "cooperative launch failed: %s (grid %d)\n", hipGetErrorString(e), grid_blocks);
#endif
}
```

```cpp
#ifndef CPU_EMU
#include <hip/hip_runtime.h>
#include <hip/hip_cooperative_groups.h>
#include <cstdio>
#include <cstdint>
namespace cg = cooperative_groups;
#define DYN_SMEM(name) extern __shared__ __attribute__((aligned(16))) char name[]
#define LAUNCH(kern, grid, block, smem, stream, ...) hipLaunchKernelGGL(kern, dim3(grid), dim3(block), smem, stream, __VA_ARGS__)
#endif

#ifndef CFG_B
#define CFG_B 8
#endif
#ifndef CFG_T
#define CFG_T 2048
#endif
#ifndef MK_MULTI
#define MK_MULTI 0
#endif

namespace {
constexpr int B_ = CFG_B, T_ = CFG_T, M_ = B_ * T_, D_ = 1024, NL_ = 2, NT = 512;
constexpr int INW = 12560;
constexpr int LDZ = 11776;
constexpr int Z_ULRU = 0, Z_GLRU = 1024, Z_Q = 2048, Z_K = 3072, Z_V = 4096, Z_ZG = 5120, Z_RW = 6144, Z_ALPHA = 9472, Z_BETA = 9480;
constexpr int ZN = 9728;
constexpr int C_XN = 9728, C_YC = 10752;
constexpr int C_YA = Z_GLRU, C_YB = Z_ZG;
constexpr int C_GS = Z_Q, C_MG = Z_K;
constexpr int C_QRY = 0;
constexpr int RW_R = 0, RW_K = 1024, RW_V = 2048, RW_WL = 3072, RW_AL = 3136, RW_GL = 3200, RWW = 3328;
constexpr float RMS_EPS = 1e-6f, GN_EPS = 64e-5f;
typedef unsigned short h16_t;

enum { I_X = 0, I_NMIX, I_NFFN, I_NFINAL, I_WIN, I_LCW, I_LCB, I_LWA, I_LBA, I_LWX, I_LBX, I_LLAM, I_GCW, I_GALOG, I_GDT, I_GNW,
       I_RMU, I_RW0, I_RWUP, I_RA0, I_RAUP, I_RGUP, I_RKK, I_RKA, I_RRK, I_RLW, I_RLB, I_MB, I_PL, I_PG, I_PR, I_WOUT, I_PWQ, I_PKEYS, I_PU, I_PV, N_IN };

struct Params {
    const float* in[N_IN];
    float* out;
    char* ws;
};
#ifdef CPU_EMU
typedef const Params* KParams;
#else
typedef const Params __attribute__((address_space(4)))* KParams;
#endif

constexpr size_t al256(size_t x) { return (x + 255) / 256 * 256; }
constexpr size_t OFF_ACT = 0;
constexpr size_t OFF_WT = al256(OFF_ACT + (size_t)M_ * LDZ * 2);
constexpr int WT_IN = 0, WT_MG = ZN, WT_P = WT_MG + 3072, WT_OUT = WT_P + 3072, WT_Q = WT_OUT + 1024, WT_ROWS = WT_Q + 2048;
constexpr size_t OFF_TOPS = al256(OFF_WT + (size_t)NL_ * WT_ROWS * 1024 * 2);
constexpr size_t OFF_TAB = al256(OFF_TOPS + (size_t)M_ * 256 * 4);
constexpr size_t OFF_BAR = OFF_TAB + (size_t)16384 * 2048;
constexpr size_t WS_END = OFF_BAR + 16384;
static_assert(CFG_B != 8 || CFG_T != 2048 || WS_END <= (size_t)512 * 1024 * 1024, "workspace budget");
constexpr size_t SMEM_BYTES = 128 * 1024;

#ifdef CPU_EMU
__device__ __forceinline__ int tid_() { return threadIdx.x; }
__device__ __forceinline__ h16_t f2h(float f) { return (h16_t)_cvtss_sh(f, _MM_FROUND_TO_NEAREST_INT); }
__device__ __forceinline__ float h2f(h16_t h) { return _cvtsh_ss(h); }
#else
__device__ __forceinline__ int tid_() { int t = threadIdx.x; asm volatile("" : "+v"(t)); return t; }
__device__ __forceinline__ h16_t f2h(float f) { return __builtin_bit_cast(unsigned short, (_Float16)f); }
__device__ __forceinline__ float h2f(h16_t h) { return (float)__builtin_bit_cast(_Float16, h); }
#endif
__device__ __forceinline__ int bid_() { return (int)blockIdx.x; }

#ifdef CPU_EMU
__device__ __forceinline__ float fexp_(float x) { return expf(x); }
__device__ __forceinline__ float flog_(float x) { return logf(x); }
__device__ __forceinline__ float frcp_(float x) { return 1.0f / x; }
#else
__device__ __forceinline__ float fexp_(float x) { return __builtin_amdgcn_exp2f(x * 1.4426950408889634f); }
__device__ __forceinline__ float flog_(float x) { return __builtin_amdgcn_logf(x) * 0.6931471805599453f; }
__device__ __forceinline__ float frcp_(float x) { return __builtin_amdgcn_rcpf(x); }
#endif
__device__ __forceinline__ float sigmoidf_(float x) { return frcp_(1.0f + fexp_(-x)); }
__device__ __forceinline__ float softplusf_(float x) { return fmaxf(x, 0.0f) + flog_(1.0f + fexp_(-fabsf(x))); }
__device__ __forceinline__ float siluf_(float x) { return x * sigmoidf_(x); }
__device__ __forceinline__ float tanhf_(float x) { return 1.0f - 2.0f * frcp_(1.0f + fexp_(2.0f * x)); }
__device__ __forceinline__ float geluf_(float x) { return x * frcp_(1.0f + fexp_(-1.5957691216057308f * (x + 0.044715f * x * x * x))); }
__device__ __forceinline__ unsigned pack2h(float a, float b) { return (unsigned)f2h(a) | ((unsigned)f2h(b) << 16); }
__device__ __forceinline__ void store8h(h16_t* p, const float (&v)[8]) {
    uint4 w; w.x = pack2h(v[0], v[1]); w.y = pack2h(v[2], v[3]); w.z = pack2h(v[4], v[5]); w.w = pack2h(v[6], v[7]);
    *(uint4*)p = w;
}
__device__ __forceinline__ void load8h(const h16_t* p, float (&v)[8]) {
    const uint4 w = *(const uint4*)p;
    v[0] = h2f((h16_t)(w.x & 0xffffu)); v[1] = h2f((h16_t)(w.x >> 16)); v[2] = h2f((h16_t)(w.y & 0xffffu)); v[3] = h2f((h16_t)(w.y >> 16));
    v[4] = h2f((h16_t)(w.z & 0xffffu)); v[5] = h2f((h16_t)(w.z >> 16)); v[6] = h2f((h16_t)(w.w & 0xffffu)); v[7] = h2f((h16_t)(w.w >> 16));
}

__device__ __forceinline__ float block_sum512(float v, float* red) {
    const int tid = tid_();
    red[tid] = v;
    __syncthreads();
    if (tid < 32) { float s = 0.f; for (int i = 0; i < 16; ++i) s += red[tid * 16 + i]; red[512 + tid] = s; }
    __syncthreads();
    float tot = 0.f;
    for (int i = 0; i < 32; ++i) tot += red[512 + i];
    __syncthreads();
    return tot;
}

#ifdef CPU_EMU
__device__ __forceinline__ float wave_sum64(float v, float* scr) {
    const int tid = tid_();
    scr[tid] = v; __syncthreads();
    float s = 0.f; const int base = tid & ~63;
    for (int i = 0; i < 64; ++i) s += scr[base + i];
    __syncthreads();
    return s;
}
#else
__device__ __forceinline__ float wave_sum64(float v, float*) {
    v += __builtin_bit_cast(float, __builtin_amdgcn_mov_dpp(__builtin_bit_cast(int, v), 0xB1, 0xf, 0xf, true));
    v += __builtin_bit_cast(float, __builtin_amdgcn_mov_dpp(__builtin_bit_cast(int, v), 0x4E, 0xf, 0xf, true));
    v += __builtin_bit_cast(float, __builtin_amdgcn_mov_dpp(__builtin_bit_cast(int, v), 0x141, 0xf, 0xf, true));
    v += __builtin_bit_cast(float, __builtin_amdgcn_mov_dpp(__builtin_bit_cast(int, v), 0x140, 0xf, 0xf, true));
    v += __builtin_bit_cast(float, __builtin_amdgcn_update_dpp(0, __builtin_bit_cast(int, v), 0x142, 0xa, 0xf, false));
    v += __builtin_bit_cast(float, __builtin_amdgcn_update_dpp(0, __builtin_bit_cast(int, v), 0x143, 0xc, 0xf, false));
    return __builtin_bit_cast(float, __builtin_amdgcn_readlane(__builtin_bit_cast(int, v), 63));
}
#endif
__device__ __forceinline__ void stage_rmsnorm(const float* src, const float* w, h16_t* dst, int ldd, char* smem) {
    float* scr = (float*)smem;
    const int tid = tid_(), lane = tid & 63, wv = tid >> 6;
    const int nw = gridDim.x * 8;
    float4 wv4[4];
#pragma unroll
    for (int i = 0; i < 4; ++i) wv4[i] = *(const float4*)(w + lane * 16 + i * 4);
    for (int row = bid_() * 8 + wv; row < M_; row += 2 * nw) {
        const int row2 = row + nw; const bool has2 = row2 < M_;
        float4 a[4], b[4];
#pragma unroll
        for (int i = 0; i < 4; ++i) { a[i] = *(const float4*)(src + (size_t)row * D_ + lane * 16 + i * 4); b[i] = has2 ? *(const float4*)(src + (size_t)row2 * D_ + lane * 16 + i * 4) : make_float4(0.f, 0.f, 0.f, 0.f); }
        float sa = 0.f, sb = 0.f;
#pragma unroll
        for (int i = 0; i < 4; ++i) { sa += a[i].x * a[i].x + a[i].y * a[i].y + a[i].z * a[i].z + a[i].w * a[i].w; sb += b[i].x * b[i].x + b[i].y * b[i].y + b[i].z * b[i].z + b[i].w * b[i].w; }
        sa = wave_sum64(sa, scr); sb = wave_sum64(sb, scr);
        const float ra = rsqrtf(sa * (1.0f / D_) + RMS_EPS), rb = rsqrtf(sb * (1.0f / D_) + RMS_EPS);
#pragma unroll
        for (int i = 0; i < 4; i += 2) {
            const float va[8] = {a[i].x * ra * wv4[i].x, a[i].y * ra * wv4[i].y, a[i].z * ra * wv4[i].z, a[i].w * ra * wv4[i].w, a[i + 1].x * ra * wv4[i + 1].x, a[i + 1].y * ra * wv4[i + 1].y, a[i + 1].z * ra * wv4[i + 1].z, a[i + 1].w * ra * wv4[i + 1].w};
            store8h(dst + (size_t)row * ldd + lane * 16 + i * 4, va);
            if (has2) {
                const float vb[8] = {b[i].x * rb * wv4[i].x, b[i].y * rb * wv4[i].y, b[i].z * rb * wv4[i].z, b[i].w * rb * wv4[i].w, b[i + 1].x * rb * wv4[i + 1].x, b[i + 1].y * rb * wv4[i + 1].y, b[i + 1].z * rb * wv4[i + 1].z, b[i + 1].w * rb * wv4[i + 1].w};
                store8h(dst + (size_t)row2 * ldd + lane * 16 + i * 4, vb);
            }
        }
    }
}

__device__ __forceinline__ const float* wt_src(KParams p, int l, int r, int& ld) {
    if (r < ZN) {
        ld = INW;
        int c;
        if (r < 6144) c = r; else if (r < 9472) c = r + 16; else if (r < 9488) c = r - 3328; else return nullptr;
        return p->in[I_WIN] + (size_t)l * 1024 * INW + c;
    }
    r -= ZN;
    if (r < 3072) { ld = INW; return p->in[I_WIN] + (size_t)l * 1024 * INW + 9488 + r; }
    r -= 3072;
    if (r < 3072) { ld = 1024; const int br = r >> 10; return p->in[br == 0 ? I_PL : (br == 1 ? I_PG : I_PR)] + (size_t)l * 1024 * 1024 + (r & 1023); }
    r -= 3072;
    if (r < 1024) { ld = 1024; return p->in[I_WOUT] + (size_t)l * 1024 * 1024 + r; }
    r -= 1024;
    ld = 2048; return p->in[I_PWQ] + (size_t)l * 1024 * 2048 + r;
}
__device__ __forceinline__ void stage_wprep(KParams p, char* smem) {
    float* tile = (float*)smem;
    h16_t* WT = (h16_t*)(p->ws + OFF_WT);
    const int tid = tid_();
    const int ntr = WT_ROWS / 64, total = NL_ * ntr * 16;
    for (int it = bid_(); it < total; it += gridDim.x) {
        const int l = it / (ntr * 16), rem = it % (ntr * 16), rt = rem / 16, kt = rem % 16;
        const int r0 = rt * 64, k0 = kt * 64;
        __syncthreads();
        {
            const int nn = tid & 63;
            int ld = 0; const float* src = wt_src(p, l, r0 + nn, ld);
#pragma unroll
            for (int i = 0; i < 8; ++i) { const int kk = (tid >> 6) + 8 * i; tile[kk * 65 + nn] = src ? src[(size_t)(k0 + kk) * ld] : 0.f; }
        }
        __syncthreads();
        {
            const int r = tid >> 3, kq = (tid & 7) * 8;
            float v[8];
#pragma unroll
            for (int j = 0; j < 8; ++j) v[j] = tile[(kq + j) * 65 + r];
            store8h(WT + ((size_t)l * WT_ROWS + r0 + r) * 1024 + k0 + kq, v);
        }
    }
}

namespace pg8 {
constexpr int BM = 256, BK = 64, HALF = 128, HTB = HALF * BK * 2, STAGE_BYTES = 8 * HTB, NXCD = 8, WGM = 8;
struct Unit { const char* A; const char* B; int pm, pn, kind; };
#ifdef CPU_EMU
struct f32x4 { float d[4]; float& operator[](int i) { return d[i]; } const float& operator[](int i) const { return d[i]; } };
#else
#define PG8_LAS __attribute__((address_space(3)))
typedef _Float16 f16x8 __attribute__((ext_vector_type(8)));
typedef float f32x4 __attribute__((ext_vector_type(4)));
__device__ __forceinline__ int lds_byte(int r, int c) { const int st = (r >> 4) * 2 + (c >> 5), rr = r & 15, cc = c & 31, ob = rr * 64 + cc * 2; return st * 1024 + (ob ^ (((ob >> 9) & 1) << 5)); }
__device__ __forceinline__ void stage_rc(int b, int& R, int& C) { const int st = b / 1024, sb = b % 1024, swz = sb ^ (((sb >> 9) & 1) << 5); R = (st >> 1) * 16 + swz / 64; C = (st & 1) * 32 + (swz % 64) / 2; }
__device__ __forceinline__ int perm32(int rho) { const int n = rho >> 4, i = rho & 15; return 8 * (i >> 2) + 4 * n + (i & 3); }
#endif
__device__ __forceinline__ void tile_of(int L, int nM, int nN, int& pm, int& pn) {
    const int nwg = nM * nN;
    int wgid = L; { const int q = nwg / NXCD, r = nwg % NXCD, xcd = wgid % NXCD, off = wgid / NXCD; wgid = (xcd < r ? xcd * (q + 1) : r * (q + 1) + (xcd - r) * q) + off; }
    const int nig = WGM * nN, gid = wgid / nig, fm = gid * WGM, gsz = (nM - fm) < WGM ? (nM - fm) : WGM;
    pm = fm + ((wgid % nig) % gsz); pn = (wgid % nig) / gsz;
}

template <class Sched, class Epi>
__device__ __forceinline__ void gemm_phase(char* smem, const Sched& S, const Epi& E) {
    constexpr int K = 1024, nt = K / BK;
    constexpr unsigned lda = LDZ, ldb = 1024;
#ifdef CPU_EMU
    const int tid = tid_(), wid = tid >> 6, lane = tid & 63, wr = wid >> 2, wc = wid & 3, fr = lane & 15, fq = lane >> 4;
    Unit u;
    for (int ui = 0; S.next(ui, u); ++ui) {
        f32x4 acc[2][2][4][2];
        for (int ai = 0; ai < 2; ++ai) for (int bj = 0; bj < 2; ++bj) for (int m = 0; m < 4; ++m) for (int n = 0; n < 2; ++n) for (int e = 0; e < 4; ++e) {
            const int r = 128 * ai + 64 * wr + 16 * m + fr, c = 128 * bj + 32 * wc + 8 * fq + 4 * n + e;
            const h16_t* a = (const h16_t*)u.A + (size_t)r * lda; const h16_t* b = (const h16_t*)u.B + (size_t)c * ldb;
            float s = 0.f;
            for (int k = 0; k < K; ++k) s += h2f(a[k]) * h2f(b[k]);
            acc[ai][bj][m][n][e] = s;
        }
        E(acc, u, wr, wc, fr, fq);
    }
    (void)smem; (void)nt;
#else
    PG8_LAS unsigned char* lds = (PG8_LAS unsigned char*)smem;
    const int tid = tid_(), wid = __builtin_amdgcn_readfirstlane(tid >> 6), lane = tid & 63, wr = wid >> 2, wc = wid & 3, fr = lane & 15, fq = lane >> 4;
    unsigned voffA[2], voffB[2];
#pragma unroll
    for (int i = 0; i < 2; ++i) { int R, C; stage_rc(tid * 16 + i * 8192, R, C); const int Rb = (R & ~31) + perm32(R & 31);
        voffA[i] = (unsigned)(R * lda + C) * 2u; voffB[i] = (unsigned)(Rb * ldb + C) * 2u; }
    constexpr size_t kstep = (size_t)(BK * 2);
    constexpr size_t hstepA = (size_t)HALF * lda * 2, hstepB = (size_t)HALF * ldb * 2;
    const unsigned ldsw = (unsigned)wid * 1024u;
    const int aoff = lds_byte(wr * 64 + fr, fq * 8), boff = lds_byte(wc * 32 + fr, fq * 8);
#define PG8_SA(b, h) (((b) * 2 + (h)) * HTB)
#define PG8_SB(b, h) ((4 + (b) * 2 + (h)) * HTB)
#define PG8_STAGE(bufoff, gbase, voff) do { _Pragma("unroll") for (int _i = 0; _i < 2; ++_i) \
        __builtin_amdgcn_global_load_lds((const unsigned*)((const char*)(gbase) + (voff)[_i]), (PG8_LAS unsigned*)(lds + (bufoff) + ldsw + _i * 8192), 16, 0, 0); } while (0)
#define PG8_LDA(dst, b, h) do { _Pragma("unroll") for (int m = 0; m < 4; ++m) _Pragma("unroll") for (int k = 0; k < 2; ++k) dst[m][k] = *(const PG8_LAS f16x8*)(lds + PG8_SA(b, h) + aoff + m * 2048 + k * 1024); } while (0)
#define PG8_LDB(dst, b, h) do { _Pragma("unroll") for (int n = 0; n < 2; ++n) _Pragma("unroll") for (int k = 0; k < 2; ++k) dst[n][k] = *(const PG8_LAS f16x8*)(lds + PG8_SB(b, h) + boff + n * 2048 + k * 1024); } while (0)
#define PG8_MMA(ai, bj, At, Bt) do { __builtin_amdgcn_s_setprio(1); _Pragma("unroll") for (int m = 0; m < 4; ++m) _Pragma("unroll") for (int n = 0; n < 2; ++n) _Pragma("unroll") for (int k = 0; k < 2; ++k) \
        acc[ai][bj][m][n] = __builtin_amdgcn_mfma_f32_16x16x32_f16(Bt[n][k], At[m][k], acc[ai][bj][m][n], 0, 0, 0); __builtin_amdgcn_s_setprio(0); } while (0)
#define PG8_WAIT_V(n) asm volatile("s_waitcnt vmcnt(" #n ")" ::: "memory")
#define PG8_WAIT_L(n) asm volatile("s_waitcnt lgkmcnt(" #n ")" ::: "memory")
#define PG8_BAR __builtin_amdgcn_s_barrier()
#define PG8_SCHED __builtin_amdgcn_sched_barrier(0)
    Unit cur, nxt; int ui = 0;
    if (!S.next(0, cur)) return;
    f32x4 acc[2][2][4][2];
#pragma unroll
    for (int a = 0; a < 2; ++a)
#pragma unroll
        for (int b = 0; b < 2; ++b)
#pragma unroll
            for (int m = 0; m < 4; ++m)
#pragma unroll
                for (int n = 0; n < 2; ++n) acc[a][b][m][n] = (f32x4){0.f, 0.f, 0.f, 0.f};
    f16x8 At[4][2], B0[2][2], B1[2][2];
    const char* cA = cur.A; const char* cB = cur.B;
    PG8_STAGE(PG8_SB(0, 0), cB, voffB); PG8_STAGE(PG8_SA(0, 0), cA, voffA); PG8_STAGE(PG8_SB(0, 1), cB + hstepB, voffB); PG8_STAGE(PG8_SA(0, 1), cA + hstepA, voffA);
    if (wr == 1) PG8_BAR;
    PG8_WAIT_V(4); PG8_BAR;
    PG8_STAGE(PG8_SB(1, 0), cB + kstep, voffB); PG8_STAGE(PG8_SA(1, 0), cA + kstep, voffA); PG8_STAGE(PG8_SB(1, 1), cB + hstepB + kstep, voffB);
    PG8_WAIT_V(6); PG8_BAR;
    for (;;) {
        const bool has_next = S.next(ui + 1, nxt);
        const char* nA = has_next ? nxt.A : cA; const char* nB = has_next ? nxt.B : cB;
#pragma unroll 1
        for (int t = 0; t < nt; t += 2) {
            const bool last = (t == nt - 2);
            const char* a1 = cA + (size_t)(t + 1) * kstep;
            const char* a2 = last ? nA : cA + (size_t)(t + 2) * kstep; const char* b2 = last ? nB : cB + (size_t)(t + 2) * kstep;
            const char* a3 = a2 + kstep; const char* b3 = b2 + kstep;
            PG8_LDB(B0, 0, 0); PG8_SCHED; PG8_LDA(At, 0, 0); PG8_STAGE(PG8_SA(1, 1), a1 + hstepA, voffA);
            PG8_WAIT_L(8); PG8_BAR; PG8_WAIT_L(0); PG8_MMA(0, 0, At, B0); PG8_BAR; PG8_SCHED;
            PG8_LDB(B1, 0, 1); PG8_STAGE(PG8_SB(0, 0), b2, voffB);
            PG8_BAR; PG8_WAIT_L(0); PG8_MMA(0, 1, At, B1); PG8_BAR;
            PG8_LDA(At, 0, 1); PG8_STAGE(PG8_SA(0, 0), a2, voffA);
            PG8_BAR; PG8_WAIT_L(0); PG8_MMA(1, 0, At, B0); PG8_BAR; PG8_SCHED;
            PG8_STAGE(PG8_SB(0, 1), b2 + hstepB, voffB);
            PG8_WAIT_V(6); PG8_BAR; PG8_MMA(1, 1, At, B1); PG8_BAR;
            PG8_LDB(B0, 1, 0); PG8_SCHED; PG8_LDA(At, 1, 0); PG8_STAGE(PG8_SA(0, 1), a2 + hstepA, voffA);
            PG8_WAIT_L(8); PG8_BAR; PG8_WAIT_L(0); PG8_MMA(0, 0, At, B0); PG8_BAR; PG8_SCHED;
            PG8_LDB(B1, 1, 1); PG8_STAGE(PG8_SB(1, 0), b3, voffB);
            PG8_BAR; PG8_WAIT_L(0); PG8_MMA(0, 1, At, B1); PG8_BAR;
            PG8_LDA(At, 1, 1); PG8_STAGE(PG8_SA(1, 0), a3, voffA);
            PG8_BAR; PG8_WAIT_L(0); PG8_MMA(1, 0, At, B0); PG8_BAR; PG8_SCHED;
            PG8_STAGE(PG8_SB(1, 1), b3 + hstepB, voffB);
            PG8_WAIT_V(6); PG8_BAR; PG8_MMA(1, 1, At, B1); PG8_BAR;
        }
        E(acc, cur, wr, wc, fr, fq);
        if (!has_next) break;
#pragma unroll
        for (int a = 0; a < 2; ++a)
#pragma unroll
            for (int b = 0; b < 2; ++b)
#pragma unroll
                for (int m = 0; m < 4; ++m)
#pragma unroll
                    for (int n = 0; n < 2; ++n) acc[a][b][m][n] = (f32x4){0.f, 0.f, 0.f, 0.f};
        cur = nxt; cA = nA; cB = nB; ++ui;
    }
    PG8_WAIT_V(0);
    if (wr == 0) PG8_BAR;
    PG8_BAR;
#undef PG8_SA
#undef PG8_SB
#undef PG8_STAGE
#undef PG8_LDA
#undef PG8_LDB
#undef PG8_MMA
#undef PG8_WAIT_V
#undef PG8_WAIT_L
#undef PG8_BAR
#undef PG8_SCHED
#endif
}
}

enum { GK_STORE = 0, GK_GATE0, GK_GATE1, GK_GATE2, GK_PROJ0, GK_PROJ1, GK_PROJ2, GK_RESID };
enum { GP_INPROJ = 0, GP_MERGE, GP_WOUT, GP_QUERY };
struct GemmProg {
    const char* act; const char* wt;
    int which, G, c;
    __device__ __forceinline__ bool next(int i, pg8::Unit& u) const {
        constexpr int nM = M_ / 256;
        constexpr size_t rowA = (size_t)256 * LDZ * 2, rowB = (size_t)256 * 1024 * 2;
        if (which == GP_MERGE) {
            const int L = (i / 6) * G + c, j = i % 6, br = j < 3 ? j : j - 3;
            if (L >= nM * 4) return false;
            pg8::tile_of(L, nM, 4, u.pm, u.pn);
            if (j < 3) { u.A = act + (size_t)C_XN * 2; u.B = wt + ((size_t)(WT_MG + br * 1024) * 1024) * 2; u.kind = GK_GATE0 + br; }
            else { u.A = act + (size_t)(br == 0 ? C_YA : (br == 1 ? C_YB : C_YC)) * 2; u.B = wt + ((size_t)(WT_P + br * 1024) * 1024) * 2; u.kind = GK_PROJ0 + br; }
        } else {
            const int nN = which == GP_INPROJ ? ZN / 256 : (which == GP_WOUT ? 4 : 8);
            const int L = i * G + c;
            if (L >= nM * nN) return false;
            pg8::tile_of(L, nM, nN, u.pm, u.pn);
            u.A = act + (size_t)(which == GP_WOUT ? C_MG : C_XN) * 2;
            u.B = wt + ((size_t)(which == GP_INPROJ ? WT_IN : (which == GP_WOUT ? WT_OUT : WT_Q)) * 1024) * 2;
            u.kind = which == GP_WOUT ? GK_RESID : GK_STORE;
        }
        u.A += (size_t)u.pm * rowA; u.B += (size_t)u.pn * rowB;
        return true;
    }
};
__device__ __forceinline__ int gs_slot(int br) { return br == 0 ? C_GS : (br == 1 ? Z_V : Z_ULRU); }
struct GemmEpi {
    h16_t* act; const float* mb; const float* resid; float* out;
    __device__ __forceinline__ void operator()(const pg8::f32x4 (&acc)[2][2][4][2], const pg8::Unit& u, int wr, int wc, int fr, int fq) const {
        const int row0 = u.pm * 256 + wr * 64 + fr, col0 = u.pn * 256 + wc * 32 + 8 * fq;
#pragma unroll
        for (int ai = 0; ai < 2; ++ai)
#pragma unroll
            for (int m = 0; m < 4; ++m) {
                const int row = row0 + ai * 128 + m * 16;
#pragma unroll
                for (int bj = 0; bj < 2; ++bj) {
                    const int col = col0 + bj * 128;
                    float v[8];
#pragma unroll
                    for (int e = 0; e < 4; ++e) { v[e] = acc[ai][bj][m][0][e]; v[4 + e] = acc[ai][bj][m][1][e]; }
                    h16_t* arow = act + (size_t)row * LDZ;
                    if (u.kind == GK_STORE) {
                        store8h(arow + col, v);
                    } else if (u.kind <= GK_GATE2) {
                        const float* bp = mb + (u.kind - GK_GATE0) * 1024 + col;
                        const float4 b0 = *(const float4*)bp, b1 = *(const float4*)(bp + 4);
                        v[0] = sigmoidf_(v[0] + b0.x); v[1] = sigmoidf_(v[1] + b0.y); v[2] = sigmoidf_(v[2] + b0.z); v[3] = sigmoidf_(v[3] + b0.w);
                        v[4] = sigmoidf_(v[4] + b1.x); v[5] = sigmoidf_(v[5] + b1.y); v[6] = sigmoidf_(v[6] + b1.z); v[7] = sigmoidf_(v[7] + b1.w);
                        store8h(arow + gs_slot(u.kind - GK_GATE0) + col, v);
                    } else if (u.kind <= GK_PROJ2) {
                        float g[8]; load8h(arow + gs_slot(u.kind - GK_PROJ0) + col, g);
                        if (u.kind == GK_PROJ0) {
#pragma unroll
                            for (int e = 0; e < 8; ++e) v[e] = g[e] * v[e];
                        } else {
                            float o[8]; load8h(arow + C_MG + col, o);
#pragma unroll
                            for (int e = 0; e < 8; ++e) v[e] = o[e] + g[e] * v[e];
                        }
                        store8h(arow + C_MG + col, v);
                    } else {
                        const size_t o = (size_t)row * 1024 + col;
                        const float4 r0 = *(const float4*)(resid + o), r1 = *(const float4*)(resid + o + 4);
                        *(float4*)(out + o) = make_float4(r0.x + v[0], r0.y + v[1], r0.z + v[2], r0.w + v[3]);
                        *(float4*)(out + o + 4) = make_float4(r1.x + v[4], r1.y + v[5], r1.z + v[6], r1.w + v[7]);
                    }
                }
            }
    }
};
__device__ __forceinline__ void stage_gemm(KParams p, int l, int which, char* smem) {
    GemmProg S; S.act = p->ws + OFF_ACT; S.wt = p->ws + OFF_WT + (size_t)l * WT_ROWS * 1024 * 2; S.which = which; S.G = gridDim.x; S.c = bid_();
    GemmEpi E; E.act = (h16_t*)(p->ws + OFF_ACT); E.mb = p->in[I_MB] + l * 3072; E.resid = l == 0 ? p->in[I_X] : p->out; E.out = p->out;
    pg8::gemm_phase(smem, S, E);
}

#ifdef CPU_EMU
__device__ __forceinline__ float group_sum(float v, int width, float* scratch) {
    const int tid = tid_();
    scratch[tid] = v;
    __syncthreads();
    float s = 0.f; const int base = tid & ~(width - 1);
    for (int i = 0; i < width; ++i) s += scratch[base + i];
    __syncthreads();
    return s;
}
#else
template <int CTRL> __device__ __forceinline__ float dpp_f(float v) { return __builtin_bit_cast(float, __builtin_amdgcn_update_dpp(0, __builtin_bit_cast(int, v), CTRL, 0xf, 0xf, false)); }
__device__ __forceinline__ float group_sum(float v, int width, float*) {
    v += dpp_f<0xB1>(v);
    v += dpp_f<0x4E>(v);
    if (width >= 8) v += dpp_f<0x141>(v);
    if (width >= 16) v += dpp_f<0x140>(v);
    if (width >= 64) {
        v += __builtin_bit_cast(float, __builtin_amdgcn_update_dpp(0, __builtin_bit_cast(int, v), 0x142, 0xa, 0xf, false));
        v += __builtin_bit_cast(float, __builtin_amdgcn_update_dpp(0, __builtin_bit_cast(int, v), 0x143, 0xc, 0xf, false));
        v = __builtin_bit_cast(float, __builtin_amdgcn_readlane(__builtin_bit_cast(int, v), 63));
    } else if (width >= 32) v += __shfl_xor(v, 16);
    return v;
}
#endif
__device__ __forceinline__ uint4 ldg16(const h16_t* p) { return *(const uint4*)p; }
__device__ __forceinline__ uint4 zero16() { uint4 z; z.x = 0u; z.y = 0u; z.z = 0u; z.w = 0u; return z; }

__device__ __forceinline__ void stage_lru(KParams p, int l, char* smem, int vb0, int nvb) {
    const int vb = bid_() - vb0;
    if (vb < 0 || vb >= nvb) return;
    constexpr int CH = 64;
    float* wa_s = (float*)smem;
    float* wx_s = wa_s + 4096;
    float* xcT = wx_s + 4096;
    float* a_s = xcT + 64 * CH;
    float* b_s = a_s + CH * 64;
    h16_t* ru = (h16_t*)(b_s + CH * 64);
    h16_t* rg = ru + (CH + 3) * 64;
    h16_t* ACT = (h16_t*)(p->ws + OFF_ACT);
    const int tid = tid_(), c = tid & 63, tg = tid >> 6;
    for (int item = vb; item < B_ * 16; item += nvb) {
        const int b = item / 16, n = item % 16, ch = n * 64 + c;
        __syncthreads();
        for (int i = tid; i < 4096; i += NT) { wa_s[i] = p->in[I_LWA][((size_t)l * 16 + n) * 4096 + i]; wx_s[i] = p->in[I_LWX][((size_t)l * 16 + n) * 4096 + i]; }
        const float cw0 = p->in[I_LCW][((size_t)l * 4 + 0) * 1024 + ch], cw1 = p->in[I_LCW][((size_t)l * 4 + 1) * 1024 + ch];
        const float cw2 = p->in[I_LCW][((size_t)l * 4 + 2) * 1024 + ch], cw3 = p->in[I_LCW][((size_t)l * 4 + 3) * 1024 + ch];
        const float cb = p->in[I_LCB][l * 1024 + ch], ba = p->in[I_LBA][l * 1024 + ch], bx = p->in[I_LBX][l * 1024 + ch];
        const float sp = softplusf_(-p->in[I_LLAM][l * 1024 + ch]);
        float hst = 0.f;
        uint4 pf[3];
#define LRU_LOAD(t0_) do { _Pragma("unroll") for (int i = 0; i < 3; ++i) { const int j = tid + NT * i; pf[i] = zero16(); \
            if (j < 536) { const int t = (t0_) - 3 + (j >> 3); if (t >= 0) pf[i] = ldg16(ACT + ((size_t)b * T_ + t) * LDZ + Z_ULRU + n * 64 + (j & 7) * 8); } \
            else if (j < 1048) { const int jj = j - 536; pf[i] = ldg16(ACT + ((size_t)b * T_ + (t0_) + (jj >> 3)) * LDZ + Z_GLRU + n * 64 + (jj & 7) * 8); } } } while (0)
#define LRU_PUT() do { _Pragma("unroll") for (int i = 0; i < 3; ++i) { const int j = tid + NT * i; \
            if (j < 536) *(uint4*)(ru + (j >> 3) * 64 + (j & 7) * 8) = pf[i]; else if (j < 1048) *(uint4*)(rg + ((j - 536) >> 3) * 64 + ((j - 536) & 7) * 8) = pf[i]; } } while (0)
        LRU_LOAD(0);
        LRU_PUT();
        __syncthreads();
#pragma unroll 1
        for (int t0 = 0; t0 < T_; t0 += CH) {
            float xc[8];
            {
                float u[11];
#pragma unroll
                for (int s = 0; s < 11; ++s) u[s] = h2f(ru[(tg * 8 + s) * 64 + c]);
#pragma unroll
                for (int s = 0; s < 8; ++s) { xc[s] = cw0 * u[s] + cw1 * u[s + 1] + cw2 * u[s + 2] + cw3 * u[s + 3] + cb; xcT[c * CH + tg * 8 + s] = xc[s]; }
            }
            __syncthreads();
            if (t0 + CH < T_) LRU_LOAD(t0 + CH);
            {
                float dr[8], di[8];
#pragma unroll
                for (int s = 0; s < 8; ++s) { dr[s] = 0.f; di[s] = 0.f; }
#pragma unroll 4
                for (int i = 0; i < 64; ++i) {
                    const float wa = wa_s[i * 64 + c], wx = wx_s[i * 64 + c];
                    const float4 x0 = *(const float4*)(xcT + i * CH + tg * 8), x1 = *(const float4*)(xcT + i * CH + tg * 8 + 4);
                    dr[0] += x0.x * wa; dr[1] += x0.y * wa; dr[2] += x0.z * wa; dr[3] += x0.w * wa; dr[4] += x1.x * wa; dr[5] += x1.y * wa; dr[6] += x1.z * wa; dr[7] += x1.w * wa;
                    di[0] += x0.x * wx; di[1] += x0.y * wx; di[2] += x0.z * wx; di[3] += x0.w * wx; di[4] += x1.x * wx; di[5] += x1.y * wx; di[6] += x1.z * wx; di[7] += x1.w * wx;
                }
#pragma unroll
                for (int s = 0; s < 8; ++s) {
                    const float r = sigmoidf_(dr[s] + ba), ig = sigmoidf_(di[s] + bx);
                    const float log_a = -8.0f * r * sp;
                    a_s[(tg * 8 + s) * 64 + c] = fexp_(log_a);
                    b_s[(tg * 8 + s) * 64 + c] = sqrtf(fmaxf(1.0f - fexp_(2.0f * log_a), 0.0f)) * (ig * xc[s]);
                }
            }
            __syncthreads();
            if (tid < 64) {
#pragma unroll 8
                for (int t = 0; t < CH; ++t) { hst = a_s[t * 64 + c] * hst + b_s[t * 64 + c]; b_s[t * 64 + c] = hst; }
            }
            __syncthreads();
#pragma unroll
            for (int s = 0; s < 8; ++s) { h16_t* gp = rg + (tg * 8 + s) * 64 + c; *gp = f2h(b_s[(tg * 8 + s) * 64 + c] * geluf_(h2f(*gp))); }
            __syncthreads();
            *(uint4*)(ACT + ((size_t)b * T_ + t0 + (tid >> 3)) * LDZ + Z_GLRU + n * 64 + (tid & 7) * 8) = *(const uint4*)(rg + (tid >> 3) * 64 + (tid & 7) * 8);
            __syncthreads();
            if (t0 + CH < T_) LRU_PUT();
            __syncthreads();
        }
#undef LRU_LOAD
#undef LRU_PUT
    }
}

#ifdef CPU_EMU
struct hfrag { h16_t v[8]; };
struct facc { float d[4]; float& operator[](int i) { return d[i]; } const float& operator[](int i) const { return d[i]; } };
__device__ __forceinline__ facc facc_zero() { facc a; a.d[0] = a.d[1] = a.d[2] = a.d[3] = 0.f; return a; }
__device__ __forceinline__ hfrag frag_u4(uint4 w) { hfrag f; memcpy(&f, &w, 16); return f; }
__device__ __forceinline__ hfrag frag_2u2(uint2 lo, uint2 hi) { hfrag f; memcpy(&f.v[0], &lo, 8); memcpy(&f.v[4], &hi, 8); return f; }
__device__ __forceinline__ hfrag frag_mul(hfrag a, hfrag b) { hfrag f; for (int j = 0; j < 8; ++j) f.v[j] = f2h(h2f(a.v[j]) * h2f(b.v[j])); return f; }
__device__ __forceinline__ facc mfma16(hfrag a, hfrag b, facc c) {
    const int tid = tid_(), w = tid >> 6, l = tid & 63;
    unsigned short (*X)[64][16] = emu::ctx->xscr;
    for (int j = 0; j < 8; ++j) { X[w][l][j] = a.v[j]; X[w][l][8 + j] = b.v[j]; }
    __syncthreads();
    for (int reg = 0; reg < 4; ++reg) {
        const int row = 4 * (l >> 4) + reg, col = l & 15;
        float s = 0.f;
        for (int k = 0; k < 32; ++k) s += h2f(X[w][row + 16 * (k >> 3)][k & 7]) * h2f(X[w][col + 16 * (k >> 3)][8 + (k & 7)]);
        c.d[reg] += s;
    }
    __syncthreads();
    return c;
}
#else
typedef _Float16 hfrag __attribute__((ext_vector_type(8)));
typedef float facc __attribute__((ext_vector_type(4)));
__device__ __forceinline__ facc facc_zero() { return (facc){0.f, 0.f, 0.f, 0.f}; }
__device__ __forceinline__ hfrag frag_u4(uint4 w) { return __builtin_bit_cast(hfrag, w); }
__device__ __forceinline__ hfrag frag_2u2(uint2 lo, uint2 hi) { uint4 w; w.x = lo.x; w.y = lo.y; w.z = hi.x; w.w = hi.y; return __builtin_bit_cast(hfrag, w); }
__device__ __forceinline__ hfrag frag_mul(hfrag a, hfrag b) { return a * b; }
__device__ __forceinline__ facc mfma16(hfrag a, hfrag b, facc c) { return __builtin_amdgcn_mfma_f32_16x16x32_f16(a, b, c, 0, 0, 0); }
#endif
__device__ __forceinline__ hfrag frag_pack8(float a0, float a1, float a2, float a3, float a4, float a5, float a6, float a7) {
    uint4 w; w.x = pack2h(a0, a1); w.y = pack2h(a2, a3); w.z = pack2h(a4, a5); w.w = pack2h(a6, a7); return frag_u4(w);
}
__device__ __forceinline__ hfrag frag_acc2(const facc& t0, const facc& t1) { return frag_pack8(t0[0], t0[1], t0[2], t0[3], t1[0], t1[1], t1[2], t1[3]); }
__device__ __forceinline__ hfrag permfrag(const h16_t* rowp, int ks, int g) { return frag_2u2(*(const uint2*)(rowp + 32 * ks + 4 * g), *(const uint2*)(rowp + 32 * ks + 16 + 4 * g)); }

__device__ __forceinline__ void stage_gdn(KParams p, int l, char* smem, int vb0, int nvb) {
    const int vb = bid_() - vb0;
    if (vb < 0 || vb >= nvb) return;
    constexpr int CH = 64, QS = 136, TS = 72, AS = 68, KTS = 128 * TS + 16 * 8;
#define KTO(d) ((d) * TS + ((d) >> 3) * 8)
    h16_t* Qs = (h16_t*)smem;
    h16_t* Ks = Qs + 64 * QS;
    h16_t* Kt = Ks + 64 * QS;
    h16_t* Vt = Kt + KTS;
    float* A32 = (float*)(Vt + KTS);
    h16_t* ob = (h16_t*)A32;
    h16_t* Tu = (h16_t*)(A32 + 64 * AS);
    h16_t* Tw = Tu + 64 * TS;
    h16_t* QKm = Tw + 64 * TS;
    float* gc_s = (float*)(QKm + 64 * TS);
    float* be_s = gc_s + 64;
    float* e1_s = be_s + 64;
    float* part_s = e1_s + 64;
    float* scr = part_s + 512;
    float* cw_s = scr + 512;
    h16_t* ACT = (h16_t*)(p->ws + OFF_ACT);
    int tid = tid_(), lane = tid & 63, w = tid >> 6, g = lane >> 4, r16 = lane & 15;
    int sg = lane >> 4, pc = lane & 15, rb = w;
#define GDN_ROLES() do { tid = tid_(); lane = tid & 63; w = tid >> 6; g = lane >> 4; r16 = lane & 15; sg = g; pc = r16; rb = w; } while (0)
    for (int item = vb; item < B_ * 8; item += nvb) {
        const int b = item / 8, h = item % 8;
        const float a_exp = fexp_(p->in[I_GALOG][l * 8 + h]), dtb = p->in[I_GDT][l * 8 + h];
        facc S[8];
#pragma unroll
        for (int dt = 0; dt < 8; ++dt) S[dt] = facc_zero();
        __syncthreads();
        for (int i = tid; i < 64 * TS / 2; i += NT) ((unsigned*)QKm)[i] = 0u;
        for (int i = tid; i < 4 * 384; i += NT) { const int jj = i / 384, c3 = i % 384; cw_s[i] = p->in[I_GCW][((size_t)l * 4 + jj) * 3072 + (c3 >> 7) * 1024 + h * 128 + (c3 & 127)]; }
        uint4 pf[11];
#define GDN_LOAD(t0_) do { GDN_ROLES(); const h16_t* colp = ACT + ((size_t)b * T_ + (t0_) + 8 * rb - 3) * LDZ + (sg < 3 ? Z_Q + sg * 1024 : Z_ZG) + h * 128 + pc * 8; \
            _Pragma("unroll") for (int i = 0; i < 11; ++i) { const int t = (t0_) + 8 * rb - 3 + i; pf[i] = (t >= 0 && sg < 3) ? ldg16(colp + (size_t)i * LDZ) : zero16(); } } while (0)
        GDN_LOAD(0);
        h16_t pfa = 0, pfb = 0;
#define GDN_LOADS(t0_) do { if (tid < 64) { const size_t m_ = (size_t)b * T_ + (t0_) + tid; pfa = ACT[m_ * LDZ + Z_ALPHA + h]; pfb = ACT[m_ * LDZ + Z_BETA + h]; } } while (0)
        GDN_LOADS(0);
#pragma unroll 1
        for (int t0 = 0; t0 < T_; t0 += CH) {
            GDN_ROLES();
            if (tid < 64) {
                part_s[tid] = -a_exp * softplusf_(h2f(pfa) + dtb);
                be_s[tid] = sigmoidf_(h2f(pfb));
            }
            __syncthreads();
            if (tid < 64) { float s = 0.f;
#pragma unroll
                for (int i4 = 0; i4 < 16; ++i4) { const float4 pv = *(const float4*)(part_s + i4 * 4); s += (i4 * 4 <= tid ? pv.x : 0.f) + (i4 * 4 + 1 <= tid ? pv.y : 0.f) + (i4 * 4 + 2 <= tid ? pv.z : 0.f) + (i4 * 4 + 3 <= tid ? pv.w : 0.f); }
                gc_s[tid] = s; }
#pragma unroll
            for (int hf = 0; hf < 2; ++hf) {
                float ov[4][8];
#pragma unroll
                for (int i = 0; i < 4; ++i) {
#pragma unroll
                    for (int cc = 0; cc < 8; ++cc) ov[i][cc] = 0.f;
#pragma unroll
                    for (int jj = 0; jj < 4; ++jj) {
                        const uint4 wv = pf[hf * 4 + i + jj];
                        const float* cwp = cw_s + jj * 384 + (sg < 3 ? sg : 0) * 128 + pc * 8;
                        const float4 c0 = *(const float4*)cwp, c1 = *(const float4*)(cwp + 4);
                        ov[i][0] += c0.x * h2f((h16_t)(wv.x & 0xffffu)); ov[i][1] += c0.y * h2f((h16_t)(wv.x >> 16)); ov[i][2] += c0.z * h2f((h16_t)(wv.y & 0xffffu)); ov[i][3] += c0.w * h2f((h16_t)(wv.y >> 16));
                        ov[i][4] += c1.x * h2f((h16_t)(wv.z & 0xffffu)); ov[i][5] += c1.y * h2f((h16_t)(wv.z >> 16)); ov[i][6] += c1.z * h2f((h16_t)(wv.w & 0xffffu)); ov[i][7] += c1.w * h2f((h16_t)(wv.w >> 16));
                    }
                    float ss = 0.f;
#pragma unroll
                    for (int cc = 0; cc < 8; ++cc) { ov[i][cc] = siluf_(ov[i][cc]); ss += ov[i][cc] * ov[i][cc]; }
                    ss = group_sum(ss, 16, scr);
                    const float rn = sg == 0 ? rsqrtf(ss + RMS_EPS) * 0.08838834764831845f : (sg == 1 ? rsqrtf(ss + RMS_EPS) : 1.0f);
#pragma unroll
                    for (int cc = 0; cc < 8; ++cc) ov[i][cc] *= rn;
                    const int t = 8 * rb + hf * 4 + i;
                    if (sg == 0) store8h(Qs + t * QS + pc * 8, ov[i]);
                    else if (sg == 1) store8h(Ks + t * QS + pc * 8, ov[i]);
                }
                if (sg == 1 || sg == 2) {
                    h16_t* dstT = sg == 1 ? Kt : Vt;
#pragma unroll
                    for (int cc = 0; cc < 8; ++cc) { uint2 w2; w2.x = pack2h(ov[0][cc], ov[1][cc]); w2.y = pack2h(ov[2][cc], ov[3][cc]); *(uint2*)(dstT + KTO(pc * 8 + cc) + 8 * rb + hf * 4) = w2; }
                }
            }
            __syncthreads();
            GDN_ROLES();
            if (tid < 64) e1_s[tid] = fexp_(gc_s[63] - gc_s[tid]);
            for (int e = tid; e < 64 * 64; e += NT) { const int i = e >> 6, j = e & 63; if ((j >> 4) > (i >> 4)) A32[i * AS + (j & 7) * 8 + (j >> 3)] = 0.f; }
#pragma unroll 1
            for (int jr = 0; jr < 3; ++jr) {
                const int jb = w + 8 * jr; const bool valid = jb < 20;
                const int kind = (valid && jb >= 10) ? 1 : 0, tix = valid ? (jb % 10) : 0;
                const int ti = tix < 1 ? 0 : (tix < 3 ? 1 : (tix < 6 ? 2 : 3)), tj = tix - (ti * (ti + 1)) / 2;
                const h16_t* ap = (kind ? Qs : Ks) + (16 * ti + r16) * QS + 8 * g; const h16_t* bp = Ks + (16 * tj + r16) * QS + 8 * g;
                facc acc = facc_zero();
#pragma unroll
                for (int ks = 0; ks < 4; ++ks) acc = mfma16(frag_u4(*(const uint4*)(ap + 32 * ks)), frag_u4(*(const uint4*)(bp + 32 * ks)), acc);
                if (valid) {
                    const int j = 16 * tj + r16; const float gj = gc_s[j];
#pragma unroll
                    for (int reg = 0; reg < 4; ++reg) {
                        const int i = 16 * ti + 4 * g + reg;
                        const float dec = fexp_(fminf(gc_s[i] - gj, 0.f));
                        if (kind == 0) A32[i * AS + (j & 7) * 8 + (j >> 3)] = i > j ? be_s[i] * acc[reg] * dec : 0.f;
                        else QKm[i * TS + j] = f2h(i >= j ? acc[reg] * dec : 0.f);
                    }
                }
            }
            __syncthreads();
            GDN_ROLES();
            {
                const int t = tid >> 3, d0 = (tid & 7) * 16; const float eg = fexp_(gc_s[t]);
                float v8[8];
                load8h(Qs + t * QS + d0, v8);
#pragma unroll
                for (int e = 0; e < 8; ++e) v8[e] *= eg;
                store8h(Qs + t * QS + d0, v8);
                load8h(Qs + t * QS + d0 + 8, v8);
#pragma unroll
                for (int e = 0; e < 8; ++e) v8[e] *= eg;
                store8h(Qs + t * QS + d0 + 8, v8);
            }
            {
                const int c = tid >> 3, q = tid & 7;
                const float bc = be_s[c], bgc = bc * fexp_(gc_s[c]);
                float x[8];
#pragma unroll
                for (int i = 0; i < 8; ++i) x[i] = 0.f;
#pragma unroll
                for (int r = 0; r < 64; ++r) {
                    float sacc = 0.f;
                    if (r > 0) {
                        const float4 a0 = *(const float4*)(A32 + r * AS + q * 8);
                        sacc = a0.x * x[0];
                        if (r > 8) sacc += a0.y * x[1];
                        if (r > 16) sacc += a0.z * x[2];
                        if (r > 24) sacc += a0.w * x[3];
                        if (r > 32) {
                            const float4 a1 = *(const float4*)(A32 + r * AS + q * 8 + 4);
                            sacc += a1.x * x[4];
                            if (r > 40) sacc += a1.y * x[5];
                            if (r > 48) sacc += a1.z * x[6];
                            if (r > 56) sacc += a1.w * x[7];
                        }
                        sacc = group_sum(sacc, 8, scr);
                    }
                    const float xr = ((r == c) ? 1.f : 0.f) - sacc;
                    if (q == (r & 7)) { x[r >> 3] = xr; Tu[r * TS + c] = f2h(xr * bc); Tw[r * TS + c] = f2h(xr * bgc); }
                }
            }
            __syncthreads();
            GDN_ROLES();
            facc vn[4], aw[4];
#pragma unroll
            for (int tt = 0; tt < 4; ++tt) { vn[tt] = facc_zero(); aw[tt] = facc_zero(); }
#pragma unroll
            for (int tt = 0; tt < 4; ++tt)
#pragma unroll
                for (int ks = 0; ks <= (tt >> 1); ++ks) {
                    const hfrag au = frag_u4(*(const uint4*)(Tu + (16 * tt + r16) * TS + 32 * ks + 8 * g)), aww = frag_u4(*(const uint4*)(Tw + (16 * tt + r16) * TS + 32 * ks + 8 * g));
                    vn[tt] = mfma16(au, frag_u4(*(const uint4*)(Vt + KTO(16 * w + r16) + 32 * ks + 8 * g)), vn[tt]);
                    aw[tt] = mfma16(aww, frag_u4(*(const uint4*)(Kt + KTO(16 * w + r16) + 32 * ks + 8 * g)), aw[tt]);
                }
#pragma unroll
            for (int tt = 0; tt < 4; ++tt)
#pragma unroll
                for (int reg = 0; reg < 4; ++reg) Ks[(16 * tt + 4 * g + reg) * QS + 16 * w + r16] = f2h(-aw[tt][reg]);
            __syncthreads();
            GDN_ROLES();
            h16_t zraw[16];
#pragma unroll
            for (int tt = 0; tt < 4; ++tt)
#pragma unroll
                for (int reg = 0; reg < 4; ++reg) zraw[tt * 4 + reg] = ACT[((size_t)b * T_ + t0 + 16 * tt + 4 * g + reg) * LDZ + Z_ZG + h * 128 + 16 * w + r16];
            hfrag Sb[4];
#pragma unroll
            for (int ks = 0; ks < 4; ++ks) Sb[ks] = frag_acc2(S[2 * ks], S[2 * ks + 1]);
            facc oc[4];
#pragma unroll
            for (int tt = 0; tt < 4; ++tt) {
                oc[tt] = facc_zero();
                const h16_t* wrow = Ks + (16 * tt + r16) * QS; const h16_t* qrow = Qs + (16 * tt + r16) * QS;
#pragma unroll
                for (int ks = 0; ks < 4; ++ks) { vn[tt] = mfma16(permfrag(wrow, ks, g), Sb[ks], vn[tt]); oc[tt] = mfma16(permfrag(qrow, ks, g), Sb[ks], oc[tt]); }
            }
            hfrag VNb[2];
            VNb[0] = frag_acc2(vn[0], vn[1]); VNb[1] = frag_acc2(vn[2], vn[3]);
#pragma unroll
            for (int tt = 0; tt < 4; ++tt)
#pragma unroll
                for (int ks2 = 0; ks2 <= (tt >> 1); ++ks2) oc[tt] = mfma16(permfrag(QKm + (16 * tt + r16) * TS, ks2, g), VNb[ks2], oc[tt]);
            {
                const float egl = fexp_(gc_s[63]);
                hfrag e1f[2];
#pragma unroll
                for (int ks2 = 0; ks2 < 2; ++ks2) { const float* ep = e1_s + 32 * ks2 + 4 * g; e1f[ks2] = frag_pack8(ep[0], ep[1], ep[2], ep[3], ep[16], ep[17], ep[18], ep[19]); }
#pragma unroll
                for (int dt = 0; dt < 8; ++dt) {
#pragma unroll
                    for (int reg = 0; reg < 4; ++reg) S[dt][reg] *= egl;
#pragma unroll
                    for (int ks2 = 0; ks2 < 2; ++ks2) S[dt] = mfma16(frag_mul(permfrag(Kt + KTO(16 * dt + r16), ks2, g), e1f[ks2]), VNb[ks2], S[dt]);
                }
            }
            if (t0 + CH < T_) { GDN_LOAD(t0 + CH); GDN_LOADS(t0 + CH); }
            GDN_ROLES();
#pragma unroll
            for (int tt = 0; tt < 4; ++tt)
#pragma unroll
                for (int reg = 0; reg < 4; ++reg) { const float ss = group_sum(oc[tt][reg] * oc[tt][reg], 16, scr); if (r16 == 0) part_s[w * 64 + 16 * tt + 4 * g + reg] = ss; }
            __syncthreads();
            const float nw = p->in[I_GNW][l * 128 + w * 16 + r16];
#pragma unroll
            for (int tt = 0; tt < 4; ++tt)
#pragma unroll
                for (int reg = 0; reg < 4; ++reg) {
                    const int t = 16 * tt + 4 * g + reg;
                    float ms = 0.f;
#pragma unroll
                    for (int ww = 0; ww < 8; ++ww) ms += part_s[ww * 64 + t];
                    ob[t * 128 + 16 * w + r16] = f2h(oc[tt][reg] * rsqrtf(ms * (1.0f / 128.0f) + RMS_EPS) * nw * siluf_(h2f(zraw[tt * 4 + reg])));
                }
            __syncthreads();
            GDN_ROLES();
#pragma unroll
            for (int i = 0; i < 2; ++i) { const int j = tid + NT * i; *(uint4*)(ACT + ((size_t)b * T_ + t0 + (j >> 4)) * LDZ + Z_ZG + h * 128 + (j & 15) * 8) = *(const uint4*)(ob + (j >> 4) * 128 + (j & 15) * 8); }
            __syncthreads();
        }
#undef GDN_LOAD
#undef GDN_LOADS
#undef KTO
#undef GDN_ROLES
    }
}

__device__ __forceinline__ unsigned short f2bf_(float f) { unsigned u = __float_as_uint(f); u += 0x7fffu + ((u >> 16) & 1u); return (unsigned short)(u >> 16); }
__device__ __forceinline__ unsigned pack2bf(float a, float b) { return (unsigned)f2bf_(a) | ((unsigned)f2bf_(b) << 16); }
#ifdef CPU_EMU
struct bfrag { unsigned short v[8]; };
__device__ __forceinline__ bfrag bfrag_u4(uint4 w) { bfrag f; memcpy(&f, &w, 16); return f; }
__device__ __forceinline__ bfrag bfrag_2u2(uint2 lo, uint2 hi) { bfrag f; memcpy(&f.v[0], &lo, 8); memcpy(&f.v[4], &hi, 8); return f; }
__device__ __forceinline__ facc mfma16b(bfrag a, bfrag b, facc c) {
    const int tid = tid_(), w = tid >> 6, l = tid & 63;
    unsigned short (*X)[64][16] = emu::ctx->xscr;
    for (int j = 0; j < 8; ++j) { X[w][l][j] = a.v[j]; X[w][l][8 + j] = b.v[j]; }
    __syncthreads();
    for (int reg = 0; reg < 4; ++reg) {
        const int row = 4 * (l >> 4) + reg, col = l & 15;
        float s = 0.f;
        for (int k = 0; k < 32; ++k) s += __uint_as_float((unsigned)X[w][row + 16 * (k >> 3)][k & 7] << 16) * __uint_as_float((unsigned)X[w][col + 16 * (k >> 3)][8 + (k & 7)] << 16);
        c.d[reg] += s;
    }
    __syncthreads();
    return c;
}
#else
typedef __bf16 bfrag __attribute__((ext_vector_type(8)));
__device__ __forceinline__ bfrag bfrag_u4(uint4 w) { return __builtin_bit_cast(bfrag, w); }
__device__ __forceinline__ bfrag bfrag_2u2(uint2 lo, uint2 hi) { uint4 w; w.x = lo.x; w.y = lo.y; w.z = hi.x; w.w = hi.y; return __builtin_bit_cast(bfrag, w); }
__device__ __forceinline__ facc mfma16b(bfrag a, bfrag b, facc c) { return __builtin_amdgcn_mfma_f32_16x16x32_bf16(a, b, c, 0, 0, 0); }
#endif
__device__ __forceinline__ bfrag bfrag_acc2(const facc& t0, const facc& t1) { uint4 w; w.x = pack2bf(t0[0], t0[1]); w.y = pack2bf(t0[2], t0[3]); w.z = pack2bf(t1[0], t1[1]); w.w = pack2bf(t1[2], t1[3]); return bfrag_u4(w); }
__device__ __forceinline__ bfrag bfrag_ld(const unsigned short* p) { return bfrag_u4(*(const uint4*)p); }
__device__ __forceinline__ bfrag bpermfrag(const unsigned short* rowp, int ks, int g) { return bfrag_2u2(*(const uint2*)(rowp + 32 * ks + 4 * g), *(const uint2*)(rowp + 32 * ks + 16 + 4 * g)); }

#ifndef CPU_EMU
typedef _Float16 rw_f16x8 __attribute__((ext_vector_type(8)));
typedef float rw_f32x4 __attribute__((ext_vector_type(4)));
#endif
__device__ __forceinline__ void stage_rwkv(KParams p, int l, char* smem, int vb0, int nvb) {
    const int vb = bid_() - vb0;
    if (vb < 0 || vb >= nvb) return;
    constexpr int CH = 32, XS = 264, IS = 72, TS2 = 40, LS = 36;
    float* r_s = (float*)smem;
    float* k_s = r_s + CH * 64;
    float* o_s = k_s;
    float* v_s = k_s + CH * 64;
    float* w_s = v_s + CH * 64;
    float* ka_s = w_s + CH * 64;
    float* L32 = ka_s;
    float* g_s = ka_s + CH * 64;
    float* bon_s = g_s + CH * 64;
    float* gC_s = bon_s + CH;
    float* scr = gC_s + 64;
    h16_t* raw = (h16_t*)(scr + 512);
    h16_t* xs = raw + (CH + 1) * 448;
    unsigned short* Aim = (unsigned short*)raw;
    unsigned short* Rim = Aim + 32 * IS;
    unsigned short* Bim = Rim + 32 * IS;
    unsigned short* Cim = Bim + 32 * IS;
    unsigned short* Vt = Cim + 32 * IS;
    unsigned short* Ct = Vt + 64 * TS2;
    unsigned short* Btn = Ct + 64 * TS2;
    unsigned short* Nim = Btn + 64 * TS2;
    unsigned short* Tim = Nim + 32 * TS2;
    unsigned short* G1 = Tim + 32 * TS2;
    unsigned short* G2n = G1 + 32 * TS2;
    h16_t* ACT = (h16_t*)(p->ws + OFF_ACT);
    int tid = tid_(), c = tid & 63, tg = tid >> 6;
    int lane = tid & 63, wv = tid >> 6, g = lane >> 4, r16 = lane & 15;
#define RW_ROLES() do { tid = tid_(); c = tid & 63; tg = tid >> 6; lane = c; wv = tg; g = lane >> 4; r16 = lane & 15; } while (0)
    float* cst_s = (float*)(xs + CH * XS);
    for (int item = vb; item < B_ * 16; item += nvb) {
        const int b = item / 16, h = item % 16, ch = h * 64 + c;
        __syncthreads();
        if (tid < 64) {
            const float* mu = p->in[I_RMU] + (size_t)l * RWW;
            cst_s[0 * 64 + c] = p->in[I_RW0][l * 1024 + ch]; cst_s[1 * 64 + c] = p->in[I_RA0][l * 1024 + ch]; cst_s[2 * 64 + c] = p->in[I_RKK][l * 1024 + ch]; cst_s[3 * 64 + c] = p->in[I_RKA][l * 1024 + ch];
            cst_s[4 * 64 + c] = p->in[I_RRK][(size_t)l * 1024 + ch]; cst_s[5 * 64 + c] = p->in[I_RLW][l * 1024 + ch]; cst_s[6 * 64 + c] = p->in[I_RLB][l * 1024 + ch];
            cst_s[7 * 64 + c] = mu[RW_R + ch]; cst_s[8 * 64 + c] = mu[RW_K + ch]; cst_s[9 * 64 + c] = mu[RW_V + ch];
            cst_s[10 * 64 + c] = mu[RW_WL + c]; cst_s[11 * 64 + c] = mu[RW_AL + c]; cst_s[12 * 64 + c] = mu[RW_GL + c]; cst_s[13 * 64 + c] = mu[RW_GL + 64 + c];
        }
        const float* wup = p->in[I_RWUP] + (size_t)l * 64 * 1024 + h * 64; const float* aup = p->in[I_RAUP] + (size_t)l * 64 * 1024 + h * 64; const float* gup = p->in[I_RGUP] + (size_t)l * 128 * 1024 + h * 64;
#ifndef CPU_EMU
        const int mt = wv >> 2, nt = wv & 3;
        rw_f16x8 bw[2], ba_[2], bg[4];
        {
            const int cn = nt * 16 + (lane & 15), kb = 8 * (lane >> 4);
#pragma unroll
            for (int ks = 0; ks < 2; ++ks)
#pragma unroll
                for (int j = 0; j < 8; ++j) { bw[ks][j] = (_Float16)wup[(size_t)(ks * 32 + kb + j) * 1024 + cn]; ba_[ks][j] = (_Float16)aup[(size_t)(ks * 32 + kb + j) * 1024 + cn]; }
#pragma unroll
            for (int ks = 0; ks < 4; ++ks)
#pragma unroll
                for (int j = 0; j < 8; ++j) bg[ks][j] = (_Float16)gup[(size_t)(ks * 32 + kb + j) * 1024 + cn];
        }
#endif
        facc ST[4];
#pragma unroll
        for (int jt = 0; jt < 4; ++jt) ST[jt] = facc_zero();
        uint4 pf[4];
#define RW_LOAD(t0_) do { _Pragma("unroll") for (int i = 0; i < 4; ++i) { const int j = tid + NT * i, row = j / 56, u = j % 56, t = (t0_) - 1 + row; pf[i] = zero16(); \
            if (j < (CH + 1) * 56 && t >= 0) pf[i] = ldg16(ACT + ((size_t)b * T_ + t) * LDZ + Z_RW + (u < 24 ? (u >> 3) * 1024 + h * 64 + (u & 7) * 8 : 3072 + (u - 24) * 8)); } } while (0)
#define RW_PUT() do { _Pragma("unroll") for (int i = 0; i < 4; ++i) { const int j = tid + NT * i; if (j < (CH + 1) * 56) *(uint4*)(raw + (j / 56) * 448 + (j % 56) * 8) = pf[i]; } } while (0)
        __syncthreads();
        RW_LOAD(0);
        RW_PUT();
        __syncthreads();
#pragma unroll 1
        for (int t0 = 0; t0 < T_; t0 += CH) {
            RW_ROLES();
            {
            const float mu_r = cst_s[7 * 64 + c], mu_k = cst_s[8 * 64 + c], mu_v = cst_s[9 * 64 + c], mu_wl = cst_s[10 * 64 + c], mu_al = cst_s[11 * 64 + c], mu_g0 = cst_s[12 * 64 + c], mu_g1 = cst_s[13 * 64 + c];
            float sr[4], sk[4], sv[4], swl[4], sal[4], sg0[4], sg1[4];
#pragma unroll
            for (int s = 0; s < 4; ++s) {
                const int tl = tg * 4 + s;
                const h16_t* zc = raw + (tl + 1) * 448; const h16_t* zp = raw + tl * 448;
#define RW_SHIFT(col, muv) ({ const float zz = h2f(zc[col]); zz + (muv) * (h2f(zp[col]) - zz); })
                sr[s] = RW_SHIFT(c, mu_r); sk[s] = RW_SHIFT(64 + c, mu_k); sv[s] = RW_SHIFT(128 + c, mu_v);
                swl[s] = tanhf_(RW_SHIFT(192 + c, mu_wl)); sal[s] = RW_SHIFT(256 + c, mu_al); sg0[s] = sigmoidf_(RW_SHIFT(320 + c, mu_g0)); sg1[s] = sigmoidf_(RW_SHIFT(384 + c, mu_g1));
#undef RW_SHIFT
            }
            __syncthreads();
#pragma unroll
            for (int s = 0; s < 4; ++s) {
                const int tl = tg * 4 + s;
                r_s[tl * 64 + c] = sr[s]; k_s[tl * 64 + c] = sk[s]; v_s[tl * 64 + c] = sv[s];
                xs[tl * XS + c] = f2h(swl[s]); xs[tl * XS + 64 + c] = f2h(sal[s]); xs[tl * XS + 128 + c] = f2h(sg0[s]); xs[tl * XS + 192 + c] = f2h(sg1[s]);
            }
            }
            __syncthreads();
#ifdef CPU_EMU
#pragma unroll
            for (int s = 0; s < 4; ++s) {
                const int tl = tg * 4 + s;
                float dw = 0.f, da = 0.f, dg = 0.f;
                for (int i = 0; i < 64; ++i) { dw += h2f(xs[tl * XS + i]) * h2f(f2h(wup[(size_t)i * 1024 + c])); da += h2f(xs[tl * XS + 64 + i]) * h2f(f2h(aup[(size_t)i * 1024 + c])); }
                for (int i = 0; i < 128; ++i) dg += h2f(xs[tl * XS + 128 + i]) * h2f(f2h(gup[(size_t)i * 1024 + c]));
                w_s[tl * 64 + c] = dw; ka_s[tl * 64 + c] = da; g_s[tl * 64 + c] = dg;
            }
#else
            {
                const h16_t* ap = xs + (mt * 16 + (lane & 15)) * XS + 8 * (lane >> 4);
                rw_f32x4 dw = {0.f, 0.f, 0.f, 0.f}, da = {0.f, 0.f, 0.f, 0.f}, dg = {0.f, 0.f, 0.f, 0.f};
#pragma unroll
                for (int ks = 0; ks < 2; ++ks) {
                    dw = __builtin_amdgcn_mfma_f32_16x16x32_f16(*(const rw_f16x8*)(ap + ks * 32), bw[ks], dw, 0, 0, 0);
                    da = __builtin_amdgcn_mfma_f32_16x16x32_f16(*(const rw_f16x8*)(ap + 64 + ks * 32), ba_[ks], da, 0, 0, 0);
                }
#pragma unroll
                for (int ks = 0; ks < 4; ++ks) dg = __builtin_amdgcn_mfma_f32_16x16x32_f16(*(const rw_f16x8*)(ap + 128 + ks * 32), bg[ks], dg, 0, 0, 0);
#pragma unroll
                for (int rg = 0; rg < 4; ++rg) { const int o = (mt * 16 + 4 * (lane >> 4) + rg) * 64 + nt * 16 + (lane & 15); w_s[o] = dw[rg]; ka_s[o] = da[rg]; g_s[o] = dg[rg]; }
            }
#endif
            __syncthreads();
            RW_ROLES();
            float kkn4[4], kka4[4], k24[4], rx4[4];
            {
            const float w0 = cst_s[0 * 64 + c], a0 = cst_s[1 * 64 + c], k_k = cst_s[2 * 64 + c], k_a = cst_s[3 * 64 + c], rk_c = cst_s[4 * 64 + c];
#pragma unroll
            for (int s = 0; s < 4; ++s) {
                const int tl = tg * 4 + s;
                const float w_log = -softplusf_(-(w0 + w_s[tl * 64 + c])) - 0.5f;
                const float a = sigmoidf_(a0 + ka_s[tl * 64 + c]);
                const float kx = k_s[tl * 64 + c], rx = r_s[tl * 64 + c];
                const float kkr = kx * k_k, k2 = kx * (1.0f + (a - 1.0f) * k_a);
                const float nsq = group_sum(kkr * kkr, 64, scr);
                const float bon = group_sum(rx * k2 * rk_c, 64, scr);
                const float kkn = kkr * rsqrtf(nsq + RMS_EPS);
                w_s[tl * 64 + c] = fexp_(w_log);
                kkn4[s] = kkn; kka4[s] = kkn * a; k24[s] = k2; rx4[s] = rx;
                if (c == 0) bon_s[tl] = bon;
            }
            }
            __syncthreads();
            if (tid < 64) {
                float acc = 0.f;
#pragma unroll 8
                for (int t = 0; t < CH; ++t) { acc += w_s[t * 64 + tid]; w_s[t * 64 + tid] = acc; }
                gC_s[tid] = fexp_(-acc);
            }
            __syncthreads();
            RW_ROLES();
            {
                const float PC = w_s[(CH - 1) * 64 + c];
                float vt4[4], ct4[4], bt4[4];
#pragma unroll
                for (int s = 0; s < 4; ++s) {
                    const int tl = tg * 4 + s;
                    const float P = w_s[tl * 64 + c], Pm = tl > 0 ? w_s[(tl - 1) * 64 + c] : 0.f;
                    const float gt = fexp_(-P), gm = fexp_(-Pm), ig = fexp_(P), gcr = fexp_(P - PC);
                    Aim[tl * IS + c] = f2bf_(kkn4[s] * gm); Rim[tl * IS + c] = f2bf_(rx4[s] * gt); Bim[tl * IS + c] = f2bf_(kka4[s] * ig); Cim[tl * IS + c] = f2bf_(k24[s] * ig);
                    vt4[s] = v_s[tl * 64 + c]; ct4[s] = k24[s] * gcr; bt4[s] = -kka4[s] * gcr;
                }
                uint2 w2;
                w2.x = pack2bf(vt4[0], vt4[1]); w2.y = pack2bf(vt4[2], vt4[3]); *(uint2*)(Vt + c * TS2 + tg * 4) = w2;
                w2.x = pack2bf(ct4[0], ct4[1]); w2.y = pack2bf(ct4[2], ct4[3]); *(uint2*)(Ct + c * TS2 + tg * 4) = w2;
                w2.x = pack2bf(bt4[0], bt4[1]); w2.y = pack2bf(bt4[2], bt4[3]); *(uint2*)(Btn + c * TS2 + tg * 4) = w2;
                if (tid < 384) { unsigned short* im = tid < 128 ? Nim : (tid < 256 ? G1 : G2n); const int e = tid & 127; *(unsigned*)(im + (e >> 3) * TS2 + 16 + (e & 7) * 2) = 0u; }
            }
            __syncthreads();
            RW_ROLES();
#pragma unroll 1
            for (int jr = 0; jr < 2; ++jr) {
                const int jb = wv + 8 * jr; const bool valid = jb < 12;
                const int prod = valid ? jb / 3 : 0, tix = valid ? jb % 3 : 0, ti = tix > 0 ? 1 : 0, tj = tix > 1 ? 1 : 0;
                const unsigned short* xp = (prod < 2 ? Aim : Rim) + (16 * ti + r16) * IS + 8 * g;
                const unsigned short* yp = ((prod == 0 || prod == 3) ? Bim : Cim) + (16 * tj + r16) * IS + 8 * g;
                facc acc = facc_zero();
#pragma unroll
                for (int ks = 0; ks < 2; ++ks) acc = mfma16b(bfrag_ld(xp + 32 * ks), bfrag_ld(yp + 32 * ks), acc);
                if (valid) {
                    const int s = 16 * tj + r16;
#pragma unroll
                    for (int reg = 0; reg < 4; ++reg) {
                        const int t = 16 * ti + 4 * g + reg;
                        if (prod == 0) L32[t * LS + (s & 7) * 4 + (s >> 3)] = t > s ? acc[reg] : 0.f;
                        else if (prod == 1) Nim[t * TS2 + s] = f2bf_(t > s ? acc[reg] : 0.f);
                        else if (prod == 2) G1[t * TS2 + s] = f2bf_(t >= s ? acc[reg] : 0.f);
                        else G2n[t * TS2 + s] = f2bf_(t >= s ? -acc[reg] : 0.f);
                    }
                }
            }
            __syncthreads();
            RW_ROLES();
            if (tid < 256) {
                const int cc = tid >> 3, q = tid & 7;
                float x[4] = {0.f, 0.f, 0.f, 0.f};
#pragma unroll
                for (int r = 0; r < 32; ++r) {
                    float sacc = 0.f;
                    if (r > 0) {
                        const float4 a4 = *(const float4*)(L32 + r * LS + q * 4);
                        sacc = a4.x * x[0];
                        if (r > 8) sacc += a4.y * x[1];
                        if (r > 16) sacc += a4.z * x[2];
                        if (r > 24) sacc += a4.w * x[3];
                        sacc = group_sum(sacc, 8, scr);
                    }
                    const float xr = ((r == cc) ? 1.f : 0.f) - sacc;
                    x[r >> 3] = (q == (r & 7)) ? xr : x[r >> 3];
                    Tim[r * TS2 + cc] = f2bf_(xr);
                }
            }
#ifdef CPU_EMU
            else { for (int r = 1; r < 32; ++r) (void)group_sum(0.f, 8, scr); }
#endif
            __syncthreads();
            if (t0 + CH < T_) RW_LOAD(t0 + CH);
            RW_ROLES();
            {
                const int it = wv & 3;
                bfrag STb[2];
                STb[0] = bfrag_acc2(ST[0], ST[1]); STb[1] = bfrag_acc2(ST[2], ST[3]);
                const bfrag vtf = bfrag_ld(Vt + (16 * it + r16) * TS2 + 8 * g);
                facc rhs[2], oo[2];
#pragma unroll
                for (int tt = 0; tt < 2; ++tt) {
                    const unsigned short* arow = Aim + (16 * tt + r16) * IS; const unsigned short* rrow = Rim + (16 * tt + r16) * IS;
                    rhs[tt] = mfma16b(bpermfrag(arow, 0, g), STb[0], facc_zero()); rhs[tt] = mfma16b(bpermfrag(arow, 1, g), STb[1], rhs[tt]);
                    rhs[tt] = mfma16b(bfrag_ld(Nim + (16 * tt + r16) * TS2 + 8 * g), vtf, rhs[tt]);
                    oo[tt] = mfma16b(bpermfrag(rrow, 0, g), STb[0], facc_zero()); oo[tt] = mfma16b(bpermfrag(rrow, 1, g), STb[1], oo[tt]);
                    oo[tt] = mfma16b(bfrag_ld(G1 + (16 * tt + r16) * TS2 + 8 * g), vtf, oo[tt]);
                }
                const bfrag rhsb = bfrag_acc2(rhs[0], rhs[1]);
                facc uu[2];
#pragma unroll
                for (int tt = 0; tt < 2; ++tt) uu[tt] = mfma16b(bpermfrag(Tim + (16 * tt + r16) * TS2, 0, g), rhsb, facc_zero());
                const bfrag ub = bfrag_acc2(uu[0], uu[1]);
#pragma unroll
                for (int tt = 0; tt < 2; ++tt) {
                    oo[tt] = mfma16b(bpermfrag(G2n + (16 * tt + r16) * TS2, 0, g), ub, oo[tt]);
                    if (wv < 4) {
#pragma unroll
                        for (int reg = 0; reg < 4; ++reg) o_s[(16 * tt + 4 * g + reg) * 64 + 16 * it + r16] = oo[tt][reg];
                    }
                }
#pragma unroll
                for (int jt = 0; jt < 4; ++jt) {
#pragma unroll
                    for (int reg = 0; reg < 4; ++reg) ST[jt][reg] *= gC_s[16 * jt + 4 * g + reg];
                    ST[jt] = mfma16b(bfrag_ld(Ct + (16 * jt + r16) * TS2 + 8 * g), vtf, ST[jt]);
                    ST[jt] = mfma16b(bpermfrag(Btn + (16 * jt + r16) * TS2, 0, g), ub, ST[jt]);
                }
            }
            __syncthreads();
            RW_ROLES();
            {
            const float lnw = cst_s[5 * 64 + c], lnb = cst_s[6 * 64 + c];
            const int chh = h * 64 + c;
#pragma unroll
            for (int s = 0; s < 4; ++s) {
                const int tl = tg * 4 + s;
                const float ov = o_s[tl * 64 + c];
                const float mean = group_sum(ov, 64, scr) * (1.0f / 64.0f);
                const float d = ov - mean;
                const float var = group_sum(d * d, 64, scr) * (1.0f / 64.0f);
                const float y = (d * rsqrtf(var + GN_EPS) * lnw + lnb + bon_s[tl] * v_s[tl * 64 + c]) * g_s[tl * 64 + c];
                ACT[((size_t)b * T_ + t0 + tl) * LDZ + C_YC + chh] = f2h(y);
            }
            }
            RW_ROLES();
            if (t0 + CH < T_) RW_PUT();
            __syncthreads();
        }
#undef RW_LOAD
#undef RW_PUT
#undef RW_ROLES
    }
}
constexpr bool TAB_IN_ACT = false;
constexpr float TAB_SU = 256.0f, TAB_SV = 32.0f;
__device__ __forceinline__ unsigned char* tab_row(char* ws, int e) {
    if (TAB_IN_ACT) return (unsigned char*)((h16_t*)(ws + OFF_ACT) + (size_t)e * LDZ + C_GS);
    return (unsigned char*)(ws + OFF_TAB) + (size_t)e * 2048;
}
#ifdef CPU_EMU
__device__ __forceinline__ unsigned f2fp8(float f) {
    const unsigned sgn = f < 0.f ? 0x80u : 0u; float a = fabsf(f);
    if (!(a == a)) return 0x7fu;
    if (a >= 448.0f) return sgn | 0x7eu;
    if (a < 0.0009765625f) return sgn;
    int e; frexpf(a, &e); e -= 1;
    if (e < -6) { const float q = nearbyintf(a * 512.0f); return sgn | (unsigned)q; }
    float q = nearbyintf((a / ldexpf(1.0f, e) - 1.0f) * 8.0f);
    if (q >= 8.0f) { q = 0.f; e += 1; }
    if (e > 8) return sgn | 0x7eu;
    const unsigned r = ((unsigned)(e + 7) << 3) | (unsigned)q;
    return sgn | (r > 0x7eu ? 0x7eu : r);
}
__device__ __forceinline__ float fp82f(unsigned b) {
    const unsigned e = (b >> 3) & 15u, m = b & 7u; const float s = (b & 0x80u) ? -1.f : 1.f;
    if (e == 0) return s * (float)m * 0.001953125f;
    return s * ldexpf(1.0f + (float)m * 0.125f, (int)e - 7);
}
__device__ __forceinline__ unsigned pack4fp8(float a, float b, float c, float d) { return f2fp8(a) | (f2fp8(b) << 8) | (f2fp8(c) << 16) | (f2fp8(d) << 24); }
__device__ __forceinline__ void dec4fp8(unsigned w, float* o) { o[0] = fp82f(w & 255u); o[1] = fp82f((w >> 8) & 255u); o[2] = fp82f((w >> 16) & 255u); o[3] = fp82f(w >> 24); }
#else
__device__ __forceinline__ unsigned pack4fp8(float a, float b, float c, float d) { int p = __builtin_amdgcn_cvt_pk_fp8_f32(a, b, 0, false); p = __builtin_amdgcn_cvt_pk_fp8_f32(c, d, p, true); return (unsigned)p; }
__device__ __forceinline__ void dec4fp8(unsigned w, float* o) { const auto lo = __builtin_amdgcn_cvt_pk_f32_fp8((int)w, false); const auto hi = __builtin_amdgcn_cvt_pk_f32_fp8((int)w, true); o[0] = lo[0]; o[1] = lo[1]; o[2] = hi[0]; o[3] = hi[1]; }
#endif
__device__ __forceinline__ void stage_tabconv(KParams p, int l, int vb0, int nvb) {
    const int vb = bid_() - vb0;
    if (vb < 0 || vb >= nvb) return;
    const int tid = tid_();
    const float* U = p->in[I_PU] + (size_t)l * 16384 * 1024; const float* V = p->in[I_PV] + (size_t)l * 16384 * 1024;
    char* ws = p->ws;
    for (int it = vb * NT + tid; it < 16384 * 128; it += nvb * NT) {
        const int r = it >> 7, ck = it & 127, which = ck >> 6, c16 = ck & 63;
        const float* src = (which ? V : U) + (size_t)r * 1024 + c16 * 16;
        const float sc = which ? TAB_SV : TAB_SU;
        const float4 a = *(const float4*)src, b = *(const float4*)(src + 4), c = *(const float4*)(src + 8), d = *(const float4*)(src + 12);
        uint4 w;
        w.x = pack4fp8(a.x * sc, a.y * sc, a.z * sc, a.w * sc); w.y = pack4fp8(b.x * sc, b.y * sc, b.z * sc, b.w * sc);
        w.z = pack4fp8(c.x * sc, c.y * sc, c.z * sc, c.w * sc); w.w = pack4fp8(d.x * sc, d.y * sc, d.z * sc, d.w * sc);
        *(uint4*)(tab_row(ws, r) + which * 1024 + c16 * 16) = w;
    }
}

#ifdef CPU_EMU
__device__ __forceinline__ float group_max16(float v, float* scr) {
    const int tid = tid_();
    scr[tid] = v;
    __syncthreads();
    float m = -3.0e38f; const int base = tid & ~15;
    for (int i = 0; i < 16; ++i) m = fmaxf(m, scr[base + i]);
    __syncthreads();
    return m;
}
#else
__device__ __forceinline__ float group_max16(float v, float*) {
    v = fmaxf(v, dpp_f<0xB1>(v)); v = fmaxf(v, dpp_f<0x4E>(v)); v = fmaxf(v, dpp_f<0x141>(v)); v = fmaxf(v, dpp_f<0x140>(v));
    return v;
}
#endif
__device__ __forceinline__ void stage_peer_topk(KParams p, int l, char* smem) {
    constexpr int KS = 136;
    h16_t* khi = (h16_t*)smem;
    h16_t* klo = khi + 128 * KS;
    float* scr = (float*)(klo + 128 * KS);
    const h16_t* ACT = (const h16_t*)(p->ws + OFF_ACT);
    float* TOPS = (float*)(p->ws + OFF_TOPS);
    int tid = tid_(), lane = tid & 63, w = tid >> 6, g = lane >> 4, r16 = lane & 15;
#define TK_ROLES() do { tid = tid_(); lane = tid & 63; w = tid >> 6; g = lane >> 4; r16 = lane & 15; } while (0)
    const int nb = gridDim.x;
    for (int hs = bid_() % 16; hs < 16; hs += nb) {
        const int hd = hs >> 1, s = hs & 1;
        __syncthreads();
        {
            const float* kp = p->in[I_PKEYS] + (((size_t)l * 8 + hd) * 2 + s) * 128 * 128;
            for (int i = tid * 4; i < 128 * 128; i += NT * 4) {
                const float4 kv = *(const float4*)(kp + i);
                const int n = i >> 7, c0 = i & 127;
                const float h0 = h2f(f2h(kv.x)), h1 = h2f(f2h(kv.y)), h2 = h2f(f2h(kv.z)), h3 = h2f(f2h(kv.w));
                uint2 hw, lw; hw.x = pack2h(kv.x, kv.y); hw.y = pack2h(kv.z, kv.w); lw.x = pack2h(kv.x - h0, kv.y - h1); lw.y = pack2h(kv.z - h2, kv.w - h3);
                *(uint2*)(khi + n * KS + c0) = hw; *(uint2*)(klo + n * KS + c0) = lw;
            }
        }
        __syncthreads();
        const int nblk = nb >= 16 ? nb / 16 : 1, bsub = nb >= 16 ? bid_() / 16 : 0;
        for (int chunk = bsub; chunk < (M_ + NT - 1) / NT; chunk += nblk) {
            if (nb >= 16 && bid_() >= nblk * 16) break;
#pragma unroll 1
            for (int tt = 0; tt < 4; ++tt) {
                TK_ROLES();
                const int tok0 = chunk * NT + w * 64 + tt * 16;
                const bool live = tok0 < M_;
                hfrag af[4];
                {
                    const h16_t* qp = ACT + (size_t)(live ? tok0 + r16 : 0) * LDZ + C_QRY + hd * 256 + s * 128 + 8 * g;
#pragma unroll
                    for (int ks = 0; ks < 4; ++ks) af[ks] = frag_u4(*(const uint4*)(qp + 32 * ks));
                }
                facc acc[8];
#pragma unroll
                for (int nt = 0; nt < 8; ++nt) {
                    acc[nt] = facc_zero();
                    const h16_t* bh = khi + (16 * nt + r16) * KS + 8 * g; const h16_t* bl = klo + (16 * nt + r16) * KS + 8 * g;
#pragma unroll
                    for (int ks = 0; ks < 4; ++ks) { acc[nt] = mfma16(af[ks], frag_u4(*(const uint4*)(bh + 32 * ks)), acc[nt]); acc[nt] = mfma16(af[ks], frag_u4(*(const uint4*)(bl + 32 * ks)), acc[nt]); }
                }
#pragma unroll 1
                for (int rp = 0; rp < 2; ++rp) {
                  TK_ROLES();
#pragma unroll
                  for (int r2 = 0; r2 < 2; ++r2) {
                    const int reg = rp * 2 + r2;
                    float v[8];
#pragma unroll
                    for (int nt = 0; nt < 8; ++nt) { const float av = rp == 0 ? (r2 == 0 ? acc[nt][0] : acc[nt][1]) : (r2 == 0 ? acc[nt][2] : acc[nt][3]); v[nt] = __uint_as_float((__float_as_uint(av) & ~127u) | (unsigned)(127 - (16 * nt + r16))); }
#define CE(i, j) { const float hi_ = fmaxf(v[i], v[j]), lo_ = fminf(v[i], v[j]); v[i] = hi_; v[j] = lo_; }
                    CE(0, 1) CE(2, 3) CE(4, 5) CE(6, 7) CE(0, 2) CE(1, 3) CE(4, 6) CE(5, 7) CE(1, 2) CE(5, 6) CE(0, 4) CE(1, 5) CE(2, 6) CE(3, 7) CE(2, 4) CE(3, 5) CE(1, 2) CE(3, 4) CE(5, 6)
#undef CE
                    float res = 0.f;
#pragma unroll
                    for (int rnd = 0; rnd < 16; ++rnd) {
                        const float m = group_max16(v[0], scr);
                        const bool win = v[0] == m;
#pragma unroll
                        for (int i = 0; i < 7; ++i) v[i] = win ? v[i + 1] : v[i];
                        v[7] = win ? -3.0e38f : v[7];
                        res = (r16 == rnd) ? m : res;
                    }
                    if (live) TOPS[(((size_t)(tok0 + 4 * g + reg) * 8 + hd) * 2 + s) * 16 + r16] = res;
                  }
                }
            }
        }
    }
}

#undef TK_ROLES
__device__ __forceinline__ void peer_cand(int k, int& i, int& j) {
    if (k < 16) { i = 0; j = k; } else if (k < 24) { i = 1; j = k - 16; } else if (k < 29) { i = 2; j = k - 24; } else if (k < 33) { i = 3; j = k - 29; }
    else if (k < 36) { i = 4; j = k - 33; } else if (k < 38) { i = 5; j = k - 36; } else if (k < 40) { i = 6; j = k - 38; } else if (k < 42) { i = 7; j = k - 40; }
    else { i = k - 34; j = 0; }
}
__device__ __forceinline__ constexpr int peer_cand_pos(int k) {
    return k < 16 ? k : k < 24 ? 16 + (k - 16) : k < 29 ? 32 + (k - 24) : k < 33 ? 48 + (k - 29) : k < 36 ? 64 + (k - 33) : k < 38 ? 80 + (k - 36) : k < 40 ? 96 + (k - 38) : k < 42 ? 112 + (k - 40) : k < 50 ? (k - 34) * 16 : 8192;
}
__device__ __forceinline__ int peer_ahead(float ov, float cs, int opos, int pos) { return (int)((ov > cs) | ((ov == cs) & (opos < pos))); }
__device__ __forceinline__ float dot16q(const uint4 a, const float (&x)[16]) {
    float t[4], s0, s1;
    dec4fp8(a.x, t); s0 = t[0] * x[0] + t[1] * x[1]; s1 = t[2] * x[2] + t[3] * x[3];
    dec4fp8(a.y, t); s0 += t[0] * x[4] + t[1] * x[5]; s1 += t[2] * x[6] + t[3] * x[7];
    dec4fp8(a.z, t); s0 += t[0] * x[8] + t[1] * x[9]; s1 += t[2] * x[10] + t[3] * x[11];
    dec4fp8(a.w, t); s0 += t[0] * x[12] + t[1] * x[13]; s1 += t[2] * x[14] + t[3] * x[15];
    return s0 + s1;
}
__device__ __forceinline__ void axpy16q(const uint4 a, float s, float (&y)[16]) {
    float t[4];
    dec4fp8(a.x, t); y[0] += s * t[0]; y[1] += s * t[1]; y[2] += s * t[2]; y[3] += s * t[3];
    dec4fp8(a.y, t); y[4] += s * t[0]; y[5] += s * t[1]; y[6] += s * t[2]; y[7] += s * t[3];
    dec4fp8(a.z, t); y[8] += s * t[0]; y[9] += s * t[1]; y[10] += s * t[2]; y[11] += s * t[3];
    dec4fp8(a.w, t); y[12] += s * t[0]; y[13] += s * t[1]; y[14] += s * t[2]; y[15] += s * t[3];
}
#ifdef CPU_EMU
__device__ __forceinline__ float lane_xor(float v, int mask, float* scr) { const int tid = tid_(); scr[tid] = v; __syncthreads(); const float r = scr[tid ^ mask]; __syncthreads(); return r; }
__device__ __forceinline__ float lane_bcast(float v, int src, float* scr) { const int tid = tid_(); scr[tid] = v; __syncthreads(); const float r = scr[(tid & ~63) + src]; __syncthreads(); return r; }
#else
__device__ __forceinline__ float lane_xor(float v, int mask, float*) { return mask == 1 ? dpp_f<0xB1>(v) : (mask == 2 ? dpp_f<0x4E>(v) : __shfl_xor(v, mask)); }
__device__ __forceinline__ float lane_bcast(float v, int src, float*) { return __builtin_bit_cast(float, __builtin_amdgcn_readlane(__builtin_bit_cast(int, v), src)); }
#endif
__device__ __forceinline__ float reduce8(const float (&v)[8], int lane, float* scr) {
    const bool b0 = lane & 1, b1 = lane & 2, b2 = lane & 4;
    float w4[4], u2[2];
#pragma unroll
    for (int j = 0; j < 4; ++j) { const float keep = b0 ? v[2 * j + 1] : v[2 * j], send = b0 ? v[2 * j] : v[2 * j + 1]; w4[j] = keep + lane_xor(send, 1, scr); }
#pragma unroll
    for (int j = 0; j < 2; ++j) { const float keep = b1 ? w4[2 * j + 1] : w4[2 * j], send = b1 ? w4[2 * j] : w4[2 * j + 1]; u2[j] = keep + lane_xor(send, 2, scr); }
    float z = (b2 ? u2[1] : u2[0]) + lane_xor(b2 ? u2[0] : u2[1], 4, scr);
    z += lane_xor(z, 8, scr); z += lane_xor(z, 16, scr); z += lane_xor(z, 32, scr);
    return z;
}
#ifdef CPU_EMU
#define PG_WSYNC() __syncthreads()
#else
#define PG_WSYNC() do { __builtin_amdgcn_fence(__ATOMIC_RELEASE, "wavefront"); __builtin_amdgcn_wave_barrier(); __builtin_amdgcn_fence(__ATOMIC_ACQUIRE, "wavefront"); } while (0)
#endif
__device__ __forceinline__ void stage_peer_gather(KParams p, int l, char* smem) {
    int tid = tid_(), w = tid >> 6, lane = tid & 63;
    float* base; float* tops_s; float* cand_s; float* best_s; int* idx_s; float* gate_s;
#define PG_ROLES() do { tid = tid_(); w = tid >> 6; lane = tid & 63; base = (float*)smem + w * 2048; tops_s = base; cand_s = tops_s + 256; best_s = cand_s + 512; \
        idx_s = (int*)(best_s + 128); gate_s = (float*)(idx_s + 128); } while (0)
    PG_ROLES();
    float* scr = (float*)smem + 8 * 2048;
    h16_t* ACT = (h16_t*)(p->ws + OFF_ACT);
    const float* TOPS = (const float*)(p->ws + OFF_TOPS);
    char* ws = p->ws;
    const float* nxt_w = (l + 1 < NL_) ? p->in[I_NMIX] + (l + 1) * 1024 : p->in[I_NFINAL];
    const int nwaves = gridDim.x * 8;
    for (int m = bid_() * 8 + w; m < M_; m += nwaves) {
        PG_ROLES();
        PG_WSYNC();
        *(float4*)(tops_s + lane * 4) = *(const float4*)(TOPS + (size_t)m * 256 + lane * 4);
        float x[16];
        { float t8[8]; load8h(ACT + (size_t)m * LDZ + C_XN + lane * 16, t8);
#pragma unroll
          for (int j = 0; j < 8; ++j) x[j] = t8[j];
          load8h(ACT + (size_t)m * LDZ + C_XN + lane * 16 + 8, t8);
#pragma unroll
          for (int j = 0; j < 8; ++j) x[8 + j] = t8[j]; }
        PG_WSYNC();
        int ci = 0, cj = 0;
        peer_cand(lane < 50 ? lane : 0, ci, cj);
        const int pos = lane < 50 ? ci * 16 + cj : 4096;
#pragma unroll
        for (int hd = 0; hd < 8; ++hd) cand_s[hd * 64 + lane] = lane < 50 ? tops_s[hd * 32 + ci] + tops_s[hd * 32 + 16 + cj] : -3.0e38f;
        PG_WSYNC();
#pragma unroll 1
        for (int hd = 0; hd < 8; ++hd) {
            const float cs = cand_s[hd * 64 + lane];
            int cnt = 0;
#pragma unroll
            for (int q = 0; q < 13; ++q) {
                const float4 c4 = *(const float4*)(cand_s + hd * 64 + q * 4);
                cnt += peer_ahead(c4.x, cs, peer_cand_pos(q * 4 + 0), pos) + peer_ahead(c4.y, cs, peer_cand_pos(q * 4 + 1), pos) + peer_ahead(c4.z, cs, peer_cand_pos(q * 4 + 2), pos) + peer_ahead(c4.w, cs, peer_cand_pos(q * 4 + 3), pos);
            }
            if (cnt < 16) {
                best_s[hd * 16 + cnt] = cs;
                const int n0 = 127 - (int)(__float_as_uint(tops_s[hd * 32 + ci]) & 127u), n1 = 127 - (int)(__float_as_uint(tops_s[hd * 32 + 16 + cj]) & 127u);
                idx_s[hd * 16 + cnt] = n0 * 128 + n1;
            }
        }
        PG_WSYNC();
#pragma unroll
        for (int rr = 0; rr < 2; ++rr) {
            const int e = lane + 64 * rr, hd = e >> 4;
            const float mx = best_s[hd * 16];
            float sum = 0.f;
#pragma unroll
            for (int i = 0; i < 16; ++i) sum += fexp_(best_s[hd * 16 + i] - mx);
            gate_s[e] = fexp_(best_s[e] - mx) / sum;
        }
        PG_WSYNC();
        float y[16];
#pragma unroll
        for (int i = 0; i < 16; ++i) y[i] = 0.f;
        PG_ROLES();
        uint4 uu[8], vv[8];
#define PG_LOADU(eb_) do { _Pragma("unroll") for (int k = 0; k < 8; ++k) uu[k] = *(const uint4*)(tab_row(ws, idx_s[(eb_) + k]) + lane * 16); } while (0)
#define PG_LOADV(eb_) do { _Pragma("unroll") for (int k = 0; k < 8; ++k) vv[k] = *(const uint4*)(tab_row(ws, idx_s[(eb_) + k]) + 1024 + lane * 16); } while (0)
        PG_LOADU(0); PG_LOADV(0);
#pragma unroll 1
        for (int eb = 0; eb < 128; eb += 8) {
            float d8[8];
#pragma unroll
            for (int k = 0; k < 8; ++k) d8[k] = dot16q(uu[k], x);
            if (eb + 8 < 128) PG_LOADU(eb + 8);
            const float tot = reduce8(d8, lane, scr);
            const float hk = gate_s[eb + (lane & 7)] * geluf_(tot * (1.0f / TAB_SU));
#pragma unroll
            for (int k = 0; k < 8; ++k) axpy16q(vv[k], lane_bcast(hk, k, scr), y);
            if (eb + 8 < 128) PG_LOADV(eb + 8);
        }
#undef PG_LOADU
#undef PG_LOADV
        PG_ROLES();
        float* op = p->out + (size_t)m * 1024 + lane * 16;
        float hn[16]; float ss = 0.f;
#pragma unroll
        for (int i = 0; i < 16; i += 4) {
            const float4 o4 = *(const float4*)(op + i);
            hn[i] = o4.x + y[i] * (1.0f / TAB_SV); hn[i + 1] = o4.y + y[i + 1] * (1.0f / TAB_SV); hn[i + 2] = o4.z + y[i + 2] * (1.0f / TAB_SV); hn[i + 3] = o4.w + y[i + 3] * (1.0f / TAB_SV);
            ss += hn[i] * hn[i] + hn[i + 1] * hn[i + 1] + hn[i + 2] * hn[i + 2] + hn[i + 3] * hn[i + 3];
        }
        ss = group_sum(ss, 64, scr);
        const float rstd = rsqrtf(ss * (1.0f / D_) + RMS_EPS);
        float nv[16];
#pragma unroll
        for (int i = 0; i < 16; i += 4) { const float4 w4 = *(const float4*)(nxt_w + lane * 16 + i); nv[i] = hn[i] * rstd * w4.x; nv[i + 1] = hn[i + 1] * rstd * w4.y; nv[i + 2] = hn[i + 2] * rstd * w4.z; nv[i + 3] = hn[i + 3] * rstd * w4.w; }
        if (l + 1 < NL_) {
#pragma unroll
            for (int i = 0; i < 16; i += 4) *(float4*)(op + i) = make_float4(hn[i], hn[i + 1], hn[i + 2], hn[i + 3]);
            const float n0[8] = {nv[0], nv[1], nv[2], nv[3], nv[4], nv[5], nv[6], nv[7]}, n1[8] = {nv[8], nv[9], nv[10], nv[11], nv[12], nv[13], nv[14], nv[15]};
            store8h(ACT + (size_t)m * LDZ + C_XN + lane * 16, n0); store8h(ACT + (size_t)m * LDZ + C_XN + lane * 16 + 8, n1);
        } else {
#pragma unroll
            for (int i = 0; i < 16; i += 4) *(float4*)(op + i) = make_float4(nv[i], nv[i + 1], nv[i + 2], nv[i + 3]);
        }
    }
}
#undef PG_ROLES
#undef PG_WSYNC

enum { PH_NORM_MIX = 0, PH_INPROJ, PH_MIXERS, PH_MERGE, PH_WOUT, PH_NORM_FFN, PH_QUERY, PH_TOPK, PH_GATHER, PH_PER_LAYER, PH_FINAL = 100, PH_WPREP = 101 };
__device__ __forceinline__ void run_phase(KParams p, int l, int ph, char* smem) {
    h16_t* ACT = (h16_t*)(p->ws + OFF_ACT);
    const float* hin = l == 0 ? p->in[I_X] : p->out;
    switch (ph) {
    case PH_WPREP: stage_wprep(p, smem); break;
    case PH_NORM_MIX: if (l == 0) stage_rmsnorm(hin, p->in[I_NMIX] + l * 1024, ACT + C_XN, LDZ, smem); break;
    case PH_INPROJ: stage_gemm(p, l, GP_INPROJ, smem); break;
    case PH_MIXERS: {
        const int nb = gridDim.x, n_rw = nb / 2, n_gd = nb / 4, n_lr = nb - n_rw - n_gd;
        stage_rwkv(p, l, smem, 0, n_rw);
        stage_gdn(p, l, smem, n_rw, n_gd);
        stage_lru(p, l, smem, n_rw + n_gd, n_lr);
        stage_tabconv(p, l, n_rw + n_gd, n_lr);
    } break;
    case PH_MERGE: stage_gemm(p, l, GP_MERGE, smem); break;
    case PH_WOUT: stage_gemm(p, l, GP_WOUT, smem); break;
    case PH_NORM_FFN: stage_rmsnorm(p->out, p->in[I_NFFN] + l * 1024, ACT + C_XN, LDZ, smem); break;
    case PH_QUERY: stage_gemm(p, l, GP_QUERY, smem); break;
    case PH_TOPK: stage_peer_topk(p, l, smem); break;
    case PH_GATHER: stage_peer_gather(p, l, smem); break;
    case PH_FINAL: break;
    default: break;
    }
}


#if !defined(CPU_EMU) && !MK_MULTI
#define XB_TMO      128
#define XB_XCNT(j)  (256  + 64 * (j))
#define XB_XSUB(j)  (1280 + 64 * (j))
#define XB_XGEN(j)  (2304 + 64 * (j))
#define XB_TOP      3328
#define XB_TOPGEN   3392
#define XCD_BAR_WORDS 3456
#define XB_SPIN_CAP (1u << 22)
#define XB_LAS __attribute__((address_space(3)))
__device__ __forceinline__ unsigned xb_ld(unsigned* p)              { return __hip_atomic_load(p, __ATOMIC_RELAXED, __HIP_MEMORY_SCOPE_AGENT); }
__device__ __forceinline__ unsigned xb_add(unsigned* p, unsigned v) { return __hip_atomic_fetch_add(p, v, __ATOMIC_RELAXED, __HIP_MEMORY_SCOPE_AGENT); }
__device__ __forceinline__ unsigned xb_xcc_id() { return (unsigned)__builtin_amdgcn_s_getreg((3 << 11) | 20) & 0xFu; }
#define XB_SPIN(cond, bar) do { unsigned _sp = 0; while (cond) { __builtin_amdgcn_s_sleep(1); \
    if ((++_sp & 255u) == 0u) { if (xb_ld(&(bar)[XB_TMO])) break; if (_sp > XB_SPIN_CAP) { atomicAdd(&(bar)[XB_TMO], 1u); break; } } } } while (0)
struct XcdBarrier { unsigned* bar; unsigned x; volatile XB_LAS unsigned* st; };
__device__ __forceinline__ XcdBarrier xcd_barrier_post(unsigned* bar, volatile XB_LAS unsigned* st) {
    XcdBarrier b; b.bar = bar; b.x = xb_xcc_id(); b.st = st;
    if (threadIdx.x == 0) (void)xb_add(&bar[XB_XCNT(b.x)], 1u);
    return b;
}
__device__ __forceinline__ void xcd_barrier_complete(unsigned* bar, unsigned x, unsigned& nloc, unsigned& nx) {
    const unsigned G = gridDim.x * gridDim.y * gridDim.z;
    unsigned sum, cnt, mine, sp = 0u;
    for (;;) {
        sum = 0u; cnt = 0u; mine = 0u;
#pragma unroll
        for (unsigned j = 0; j < 16; ++j) { const unsigned c = xb_ld(&bar[XB_XCNT(j)]); sum += c; cnt += (c > 0u) ? 1u : 0u; mine = (j == x) ? c : mine; }
        if (sum == G) break;
        __builtin_amdgcn_s_sleep(1);
        if ((++sp & 255u) == 0u) { if (xb_ld(&bar[XB_TMO])) break; if (sp > XB_SPIN_CAP) { atomicAdd(&bar[XB_TMO], 1u); break; } }
    }
    nloc = mine > 0u ? mine : 1u; nx = cnt > 0u ? cnt : 1u;
}
__device__ __forceinline__ void xcd_barrier(const XcdBarrier& b) {
    asm volatile("s_waitcnt vmcnt(0)" ::: "memory");
    __syncthreads();
    if (threadIdx.x == 0) {
        unsigned* bar = b.bar;
        __builtin_amdgcn_s_waitcnt(0);
        unsigned nloc = b.st[0], nx = b.st[1];
        if (nloc == 0u) { xcd_barrier_complete(bar, b.x, nloc, nx); b.st[0] = nloc; b.st[1] = nx; }
        const unsigned old = xb_add(&bar[XB_XSUB(b.x)], 1u);
        const unsigned gen = old / nloc;
        if (old + 1u == (gen + 1u) * nloc) {
            __builtin_amdgcn_fence(__ATOMIC_RELEASE, "agent");
            asm volatile("s_waitcnt vmcnt(0)" ::: "memory");
            const unsigned og = xb_add(&bar[XB_TOP], 1u);
            const unsigned tg = og / nx;
            if (og + 1u == (tg + 1u) * nx) xb_add(&bar[XB_TOPGEN], 1u);
            else XB_SPIN(xb_ld(&bar[XB_TOPGEN]) == tg, bar);
            __builtin_amdgcn_fence(__ATOMIC_ACQUIRE, "agent");
            xb_add(&bar[XB_XGEN(b.x)], 1u);
            asm volatile("s_waitcnt vmcnt(0)" ::: "memory");
        } else {
            XB_SPIN(xb_ld(&bar[XB_XGEN(b.x)]) == gen, bar);
            __builtin_amdgcn_fence(__ATOMIC_ACQUIRE, "agent");
            asm volatile("s_waitcnt vmcnt(0)" ::: "memory");
        }
    }
    __syncthreads();
}
#endif
#if !defined(CPU_EMU) && !MK_MULTI
__global__ void __launch_bounds__(512, 2) k_mega(Params p_) {
    DYN_SMEM(smem);
    KParams pk = (KParams)__builtin_amdgcn_kernarg_segment_ptr();
    cg::grid_group grid = cg::this_grid();
    volatile XB_LAS unsigned* xst = (volatile XB_LAS unsigned*)(XB_LAS char*)(smem + SMEM_BYTES);
    if (threadIdx.x == 0) { xst[0] = 0u; xst[1] = 0u; xst[2] = 0u; xst[3] = 0u; }
    __syncthreads();
    const XcdBarrier xb = xcd_barrier_post((unsigned*)(pk->ws + OFF_BAR), xst);
    if (gridDim.x > 0x100000u) grid.sync();
    constexpr int NIT = NL_ * PH_PER_LAYER;
#pragma unroll 1
    for (int it = -1; it <= NIT; ++it) {
        const int l = (it >= 0 && it < NIT) ? it / PH_PER_LAYER : 0, ph = it < 0 ? (int)PH_WPREP : (it < NIT ? it % PH_PER_LAYER : (int)PH_FINAL);
        KParams q = pk; asm volatile("" : "+s"(q));
        run_phase(q, l, ph, smem);
        if (it >= 0 && it < NIT - 1 && !(l > 0 && ph == PH_NORM_MIX)) {
            xcd_barrier(xb);
        }
    }
}
#endif
#ifdef CPU_EMU
__global__ void k_phase(Params p_, int l, int ph) { DYN_SMEM(smem); run_phase(&p_, l, ph, smem); }
#elif MK_MULTI
__global__ void __launch_bounds__(512, 2) k_phase(Params p_, int l, int ph) { DYN_SMEM(smem); KParams pk = (KParams)__builtin_amdgcn_kernarg_segment_ptr(); run_phase(pk, l, ph, smem); }
#endif
}

#ifdef CPU_EMU
int g_emu_stop = 1000;
#endif

extern "C" void kernel_launch(void* const* d_in, const int* in_sizes, int n_in, void* d_out, int out_size, void* d_ws, size_t ws_size, hipStream_t stream) {
    Params p{};
    for (int i = 0; i < N_IN; ++i) p.in[i] = (const float*)d_in[i];
    p.out = (float*)d_out; p.ws = (char*)d_ws;
#if defined(CPU_EMU) || MK_MULTI
    const int grid = 256;
    LAUNCH(k_phase, grid, NT, SMEM_BYTES, stream, p, 0, (int)PH_WPREP);
    for (int l = 0; l < NL_; ++l)
        for (int ph = 0; ph < PH_PER_LAYER; ++ph) {
            LAUNCH(k_phase, grid, NT, SMEM_BYTES, stream, p, l, ph);
#ifdef CPU_EMU
            const int code = ph == PH_INPROJ ? 1 : ph == PH_MIXERS ? 2 : ph == PH_MERGE ? 3 : ph == PH_WOUT ? 4 : ph == PH_GATHER ? 5 : 0;
            if (code && g_emu_stop == l * 10 + code) return;
#endif
        }
    LAUNCH(k_phase, grid, NT, SMEM_BYTES, stream, p, 0, (int)PH_FINAL);
#else
    static int grid_blocks = 0;
    if (!grid_blocks) {
        int dev = 0, cus = 0, per_cu = 0;
        (void)hipGetDevice(&dev);
        (void)hipDeviceGetAttribute(&cus, hipDeviceAttributeMultiprocessorCount, dev);
        (void)hipFuncSetAttribute((const void*)k_mega, hipFuncAttributeMaxDynamicSharedMemorySize, (int)SMEM_BYTES + 16);
        (void)hipOccupancyMaxActiveBlocksPerMultiprocessor(&per_cu, k_mega, NT, SMEM_BYTES + 16);
        if (per_cu > 1) per_cu = 1;
        grid_blocks = cus * per_cu;
    }
    (void)hipMemsetAsync((char*)d_ws + OFF_BAR, 0, 16384, stream);
    void* args[] = {&p};
    hipError_t e = hipLaunchCooperativeKernel((void*)k_mega, dim3(grid_blocks), dim3(NT), args, SMEM_BYTES + 16, stream);
    if (e != hipSuccess) fprintf(stderr, "cooperative launch failed: %s (grid %d)\n", hipGetErrorString(e), grid_blocks);
#endif
}
```

```cpp
#ifndef CPU_EMU
#include <hip/hip_runtime.h>
#include <hip/hip_cooperative_groups.h>
#include <cstdio>
#include <cstdint>
namespace cg = cooperative_groups;
#define DYN_SMEM(name) extern __shared__ __attribute__((aligned(16))) char name[]
#define LAUNCH(kern, grid, block, smem, stream, ...) hipLaunchKernelGGL(kern, dim3(grid), dim3(block), smem, stream, __VA_ARGS__)
#endif

#ifndef CFG_B
#define CFG_B 8
#endif
#ifndef CFG_T
#define CFG_T 2048
#endif
#ifndef MK_MULTI
#define MK_MULTI 0
#endif

namespace {
constexpr int B_ = CFG_B, T_ = CFG_T, M_ = B_ * T_, D_ = 1024, NL_ = 2, NT = 512;
constexpr int INW = 12560;
constexpr int LDZ = 11776;
constexpr int Z_ULRU = 0, Z_GLRU = 1024, Z_Q = 2048, Z_K = 3072, Z_V = 4096, Z_ZG = 5120, Z_RW = 6144, Z_ALPHA = 9472, Z_BETA = 9480;
constexpr int ZN = 9728;
constexpr int C_XN = 9728, C_YC = 10752;
constexpr int C_YA = Z_GLRU, C_YB = Z_ZG;
constexpr int C_GS = Z_Q, C_MG = Z_K;
constexpr int C_QRY = 0;
constexpr int RW_R = 0, RW_K = 1024, RW_V = 2048, RW_WL = 3072, RW_AL = 3136, RW_GL = 3200, RWW = 3328;
constexpr float RMS_EPS = 1e-6f, GN_EPS = 64e-5f;
typedef unsigned short h16_t;

enum { I_X = 0, I_NMIX, I_NFFN, I_NFINAL, I_WIN, I_LCW, I_LCB, I_LWA, I_LBA, I_LWX, I_LBX, I_LLAM, I_GCW, I_GALOG, I_GDT, I_GNW,
       I_RMU, I_RW0, I_RWUP, I_RA0, I_RAUP, I_RGUP, I_RKK, I_RKA, I_RRK, I_RLW, I_RLB, I_MB, I_PL, I_PG, I_PR, I_WOUT, I_PWQ, I_PKEYS, I_PU, I_PV, N_IN };

struct Params {
    const float* in[N_IN];
    float* out;
    char* ws;
};
#ifdef CPU_EMU
typedef const Params* KParams;
#else
typedef const Params __attribute__((address_space(4)))* KParams;
#endif

constexpr size_t al256(size_t x) { return (x + 255) / 256 * 256; }
constexpr size_t OFF_ACT = 0;
constexpr size_t OFF_WT = al256(OFF_ACT + (size_t)M_ * LDZ * 2);
constexpr int WT_IN = 0, WT_MG = ZN, WT_P = WT_MG + 3072, WT_OUT = WT_P + 3072, WT_Q = WT_OUT + 1024, WT_ROWS = WT_Q + 2048;
constexpr size_t OFF_TOPS = al256(OFF_WT + (size_t)NL_ * WT_ROWS * 1024 * 2);
constexpr size_t OFF_TAB = al256(OFF_TOPS + (size_t)M_ * 256 * 4);
constexpr size_t OFF_BAR = OFF_TAB + (size_t)16384 * 2048;
constexpr size_t WS_END = OFF_BAR + 16384;
static_assert(CFG_B != 8 || CFG_T != 2048 || WS_END <= (size_t)512 * 1024 * 1024, "workspace budget");
constexpr size_t SMEM_BYTES = 128 * 1024;

#ifdef CPU_EMU
__device__ __forceinline__ int tid_() { return threadIdx.x; }
__device__ __forceinline__ h16_t f2h(float f) { return (h16_t)_cvtss_sh(f, _MM_FROUND_TO_NEAREST_INT); }
__device__ __forceinline__ float h2f(h16_t h) { return _cvtsh_ss(h); }
#else
__device__ __forceinline__ int tid_() { int t = threadIdx.x; asm volatile("" : "+v"(t)); return t; }
__device__ __forceinline__ h16_t f2h(float f) { return __builtin_bit_cast(unsigned short, (_Float16)f); }
__device__ __forceinline__ float h2f(h16_t h) { return (float)__builtin_bit_cast(_Float16, h); }
#endif
__device__ __forceinline__ int bid_() { return (int)blockIdx.x; }

#ifdef CPU_EMU
__device__ __forceinline__ float fexp_(float x) { return expf(x); }
__device__ __forceinline__ float flog_(float x) { return logf(x); }
__device__ __forceinline__ float frcp_(float x) { return 1.0f / x; }
#else
__device__ __forceinline__ float fexp_(float x) { return __builtin_amdgcn_exp2f(x * 1.4426950408889634f); }
__device__ __forceinline__ float flog_(float x) { return __builtin_amdgcn_logf(x) * 0.6931471805599453f; }
__device__ __forceinline__ float frcp_(float x) { return __builtin_amdgcn_rcpf(x); }
#endif
__device__ __forceinline__ float sigmoidf_(float x) { return frcp_(1.0f + fexp_(-x)); }
__device__ __forceinline__ float softplusf_(float x) { return fmaxf(x, 0.0f) + flog_(1.0f + fexp_(-fabsf(x))); }
__device__ __forceinline__ float siluf_(float x) { return x * sigmoidf_(x); }
__device__ __forceinline__ float tanhf_(float x) { return 1.0f - 2.0f * frcp_(1.0f + fexp_(2.0f * x)); }
__device__ __forceinline__ float geluf_(float x) { return x * frcp_(1.0f + fexp_(-1.5957691216057308f * (x + 0.044715f * x * x * x))); }
__device__ __forceinline__ unsigned pack2h(float a, float b) { return (unsigned)f2h(a) | ((unsigned)f2h(b) << 16); }
__device__ __forceinline__ void store8h(h16_t* p, const float (&v)[8]) {
    uint4 w; w.x = pack2h(v[0], v[1]); w.y = pack2h(v[2], v[3]); w.z = pack2h(v[4], v[5]); w.w = pack2h(v[6], v[7]);
    *(uint4*)p = w;
}
__device__ __forceinline__ void load8h(const h16_t* p, float (&v)[8]) {
    const uint4 w = *(const uint4*)p;
    v[0] = h2f((h16_t)(w.x & 0xffffu)); v[1] = h2f((h16_t)(w.x >> 16)); v[2] = h2f((h16_t)(w.y & 0xffffu)); v[3] = h2f((h16_t)(w.y >> 16));
    v[4] = h2f((h16_t)(w.z & 0xffffu)); v[5] = h2f((h16_t)(w.z >> 16)); v[6] = h2f((h16_t)(w.w & 0xffffu)); v[7] = h2f((h16_t)(w.w >> 16));
}

__device__ __forceinline__ float block_sum512(float v, float* red) {
    const int tid = tid_();
    red[tid] = v;
    __syncthreads();
    if (tid < 32) { float s = 0.f; for (int i = 0; i < 16; ++i) s += red[tid * 16 + i]; red[512 + tid] = s; }
    __syncthreads();
    float tot = 0.f;
    for (int i = 0; i < 32; ++i) tot += red[512 + i];
    __syncthreads();
    return tot;
}

#ifdef CPU_EMU
__device__ __forceinline__ float wave_sum64(float v, float* scr) {
    const int tid = tid_();
    scr[tid] = v; __syncthreads();
    float s = 0.f; const int base = tid & ~63;
    for (int i = 0; i < 64; ++i) s += scr[base + i];
    __syncthreads();
    return s;
}
#else
__device__ __forceinline__ float wave_sum64(float v, float*) {
    v += __builtin_bit_cast(float, __builtin_amdgcn_mov_dpp(__builtin_bit_cast(int, v), 0xB1, 0xf, 0xf, true));
    v += __builtin_bit_cast(float, __builtin_amdgcn_mov_dpp(__builtin_bit_cast(int, v), 0x4E, 0xf, 0xf, true));
    v += __builtin_bit_cast(float, __builtin_amdgcn_mov_dpp(__builtin_bit_cast(int, v), 0x141, 0xf, 0xf, true));
    v += __builtin_bit_cast(float, __builtin_amdgcn_mov_dpp(__builtin_bit_cast(int, v), 0x140, 0xf, 0xf, true));
    v += __builtin_bit_cast(float, __builtin_amdgcn_update_dpp(0, __builtin_bit_cast(int, v), 0x142, 0xa, 0xf, false));
    v += __builtin_bit_cast(float, __builtin_amdgcn_update_dpp(0, __builtin_bit_cast(int, v), 0x143, 0xc, 0xf, false));
    return __builtin_bit_cast(float, __builtin_amdgcn_readlane(__builtin_bit_cast(int, v), 63));
}
#endif
__device__ __forceinline__ void stage_rmsnorm(const float* src, const float* w, h16_t* dst, int ldd, char* smem) {
    float* scr = (float*)smem;
    const int tid = tid_(), lane = tid & 63, wv = tid >> 6;
    const int nw = gridDim.x * 8;
    float4 wv4[4];
#pragma unroll
    for (int i = 0; i < 4; ++i) wv4[i] = *(const float4*)(w + lane * 16 + i * 4);
    for (int row = bid_() * 8 + wv; row < M_; row += 2 * nw) {
        const int row2 = row + nw; const bool has2 = row2 < M_;
        float4 a[4], b[4];
#pragma unroll
        for (int i = 0; i < 4; ++i) { a[i] = *(const float4*)(src + (size_t)row * D_ + lane * 16 + i * 4); b[i] = has2 ? *(const float4*)(src + (size_t)row2 * D_ + lane * 16 + i * 4) : make_float4(0.f, 0.f, 0.f, 0.f); }
        float sa = 0.f, sb = 0.f;
#pragma unroll
        for (int i = 0; i < 4; ++i) { sa += a[i].x * a[i].x + a[i].y * a[i].y + a[i].z * a[i].z + a[i].w * a[i].w; sb += b[i].x * b[i].x + b[i].y * b[i].y + b[i].z * b[i].z + b[i].w * b[i].w; }
        sa = wave_sum64(sa, scr); sb = wave_sum64(sb, scr);
        const float ra = rsqrtf(sa * (1.0f / D_) + RMS_EPS), rb = rsqrtf(sb * (1.0f / D_) + RMS_EPS);
#pragma unroll
        for (int i = 0; i < 4; i += 2) {
            const float va[8] = {a[i].x * ra * wv4[i].x, a[i].y * ra * wv4[i].y, a[i].z * ra * wv4[i].z, a[i].w * ra * wv4[i].w, a[i + 1].x * ra * wv4[i + 1].x, a[i + 1].y * ra * wv4[i + 1].y, a[i + 1].z * ra * wv4[i + 1].z, a[i + 1].w * ra * wv4[i + 1].w};
            store8h(dst + (size_t)row * ldd + lane * 16 + i * 4, va);
            if (has2) {
                const float vb[8] = {b[i].x * rb * wv4[i].x, b[i].y * rb * wv4[i].y, b[i].z * rb * wv4[i].z, b[i].w * rb * wv4[i].w, b[i + 1].x * rb * wv4[i + 1].x, b[i + 1].y * rb * wv4[i + 1].y, b[i + 1].z * rb * wv4[i + 1].z, b[i + 1].w * rb * wv4[i + 1].w};
                store8h(dst + (size_t)row2 * ldd + lane * 16 + i * 4, vb);
            }
        }
    }
}

__device__ __forceinline__ const float* wt_src(KParams p, int l, int r, int& ld) {
    if (r < ZN) {
        ld = INW;
        int c;
        if (r < 6144) c = r; else if (r < 9472) c = r + 16; else if (r < 9488) c = r - 3328; else return nullptr;
        return p->in[I_WIN] + (size_t)l * 1024 * INW + c;
    }
    r -= ZN;
    if (r < 3072) { ld = INW; return p->in[I_WIN] + (size_t)l * 1024 * INW + 9488 + r; }
    r -= 3072;
    if (r < 3072) { ld = 1024; const int br = r >> 10; return p->in[br == 0 ? I_PL : (br == 1 ? I_PG : I_PR)] + (size_t)l * 1024 * 1024 + (r & 1023); }
    r -= 3072;
    if (r < 1024) { ld = 1024; return p->in[I_WOUT] + (size_t)l * 1024 * 1024 + r; }
    r -= 1024;
    ld = 2048; return p->in[I_PWQ] + (size_t)l * 1024 * 2048 + r;
}
__device__ __forceinline__ void stage_wprep(KParams p, char* smem) {
    float* tile = (float*)smem;
    h16_t* WT = (h16_t*)(p->ws + OFF_WT);
    const int tid = tid_();
    const int ntr = WT_ROWS / 64, total = NL_ * ntr * 16;
    for (int it = bid_(); it < total; it += gridDim.x) {
        const int l = it / (ntr * 16), rem = it % (ntr * 16), rt = rem / 16, kt = rem % 16;
        const int r0 = rt * 64, k0 = kt * 64;
        __syncthreads();
        {
            const int nn = tid & 63;
            int ld = 0; const float* src = wt_src(p, l, r0 + nn, ld);
#pragma unroll
            for (int i = 0; i < 8; ++i) { const int kk = (tid >> 6) + 8 * i; tile[kk * 65 + nn] = src ? src[(size_t)(k0 + kk) * ld] : 0.f; }
        }
        __syncthreads();
        {
            const int r = tid >> 3, kq = (tid & 7) * 8;
            float v[8];
#pragma unroll
            for (int j = 0; j < 8; ++j) v[j] = tile[(kq + j) * 65 + r];
            store8h(WT + ((size_t)l * WT_ROWS + r0 + r) * 1024 + k0 + kq, v);
        }
    }
}

namespace pg8 {
constexpr int BM = 256, BK = 64, HALF = 128, HTB = HALF * BK * 2, STAGE_BYTES = 8 * HTB, NXCD = 8, WGM = 8;
struct Unit { const char* A; const char* B; int pm, pn, kind; };
#ifdef CPU_EMU
struct f32x4 { float d[4]; float& operator[](int i) { return d[i]; } const float& operator[](int i) const { return d[i]; } };
#else
#define PG8_LAS __attribute__((address_space(3)))
typedef _Float16 f16x8 __attribute__((ext_vector_type(8)));
typedef float f32x4 __attribute__((ext_vector_type(4)));
__device__ __forceinline__ int lds_byte(int r, int c) { const int st = (r >> 4) * 2 + (c >> 5), rr = r & 15, cc = c & 31, ob = rr * 64 + cc * 2; return st * 1024 + (ob ^ (((ob >> 9) & 1) << 5)); }
__device__ __forceinline__ void stage_rc(int b, int& R, int& C) { const int st = b / 1024, sb = b % 1024, swz = sb ^ (((sb >> 9) & 1) << 5); R = (st >> 1) * 16 + swz / 64; C = (st & 1) * 32 + (swz % 64) / 2; }
__device__ __forceinline__ int perm32(int rho) { const int n = rho >> 4, i = rho & 15; return 8 * (i >> 2) + 4 * n + (i & 3); }
#endif
__device__ __forceinline__ void tile_of(int L, int nM, int nN, int& pm, int& pn) {
    const int nwg = nM * nN;
    int wgid = L; { const int q = nwg / NXCD, r = nwg % NXCD, xcd = wgid % NXCD, off = wgid / NXCD; wgid = (xcd < r ? xcd * (q + 1) : r * (q + 1) + (xcd - r) * q) + off; }
    const int nig = WGM * nN, gid = wgid / nig, fm = gid * WGM, gsz = (nM - fm) < WGM ? (nM - fm) : WGM;
    pm = fm + ((wgid % nig) % gsz); pn = (wgid % nig) / gsz;
}

template <class Sched, class Epi>
__device__ __forceinline__ void gemm_phase(char* smem, const Sched& S, const Epi& E) {
    constexpr int K = 1024, nt = K / BK;
    constexpr unsigned lda = LDZ, ldb = 1024;
#ifdef CPU_EMU
    const int tid = tid_(), wid = tid >> 6, lane = tid & 63, wr = wid >> 2, wc = wid & 3, fr = lane & 15, fq = lane >> 4;
    Unit u;
    for (int ui = 0; S.next(ui, u); ++ui) {
        f32x4 acc[2][2][4][2];
        for (int ai = 0; ai < 2; ++ai) for (int bj = 0; bj < 2; ++bj) for (int m = 0; m < 4; ++m) for (int n = 0; n < 2; ++n) for (int e = 0; e < 4; ++e) {
            const int r = 128 * ai + 64 * wr + 16 * m + fr, c = 128 * bj + 32 * wc + 8 * fq + 4 * n + e;
            const h16_t* a = (const h16_t*)u.A + (size_t)r * lda; const h16_t* b = (const h16_t*)u.B + (size_t)c * ldb;
            float s = 0.f;
            for (int k = 0; k < K; ++k) s += h2f(a[k]) * h2f(b[k]);
            acc[ai][bj][m][n][e] = s;
        }
        E(acc, u, wr, wc, fr, fq);
    }
    (void)smem; (void)nt;
#else
    PG8_LAS unsigned char* lds = (PG8_LAS unsigned char*)smem;
    const int tid = tid_(), wid = __builtin_amdgcn_readfirstlane(tid >> 6), lane = tid & 63, wr = wid >> 2, wc = wid & 3, fr = lane & 15, fq = lane >> 4;
    unsigned voffA[2], voffB[2];
#pragma unroll
    for (int i = 0; i < 2; ++i) { int R, C; stage_rc(tid * 16 + i * 8192, R, C); const int Rb = (R & ~31) + perm32(R & 31);
        voffA[i] = (unsigned)(R * lda + C) * 2u; voffB[i] = (unsigned)(Rb * ldb + C) * 2u; }
    constexpr size_t kstep = (size_t)(BK * 2);
    constexpr size_t hstepA = (size_t)HALF * lda * 2, hstepB = (size_t)HALF * ldb * 2;
    const unsigned ldsw = (unsigned)wid * 1024u;
    const int aoff = lds_byte(wr * 64 + fr, fq * 8), boff = lds_byte(wc * 32 + fr, fq * 8);
#define PG8_SA(b, h) (((b) * 2 + (h)) * HTB)
#define PG8_SB(b, h) ((4 + (b) * 2 + (h)) * HTB)
#define PG8_STAGE(bufoff, gbase, voff) do { _Pragma("unroll") for (int _i = 0; _i < 2; ++_i) \
        __builtin_amdgcn_global_load_lds((const unsigned*)((const char*)(gbase) + (voff)[_i]), (PG8_LAS unsigned*)(lds + (bufoff) + ldsw + _i * 8192), 16, 0, 0); } while (0)
#define PG8_LDA(dst, b, h) do { _Pragma("unroll") for (int m = 0; m < 4; ++m) _Pragma("unroll") for (int k = 0; k < 2; ++k) dst[m][k] = *(const PG8_LAS f16x8*)(lds + PG8_SA(b, h) + aoff + m * 2048 + k * 1024); } while (0)
#define PG8_LDB(dst, b, h) do { _Pragma("unroll") for (int n = 0; n < 2; ++n) _Pragma("unroll") for (int k = 0; k < 2; ++k) dst[n][k] = *(const PG8_LAS f16x8*)(lds + PG8_SB(b, h) + boff + n * 2048 + k * 1024); } while (0)
#define PG8_MMA(ai, bj, At, Bt) do { __builtin_amdgcn_s_setprio(1); _Pragma("unroll") for (int m = 0; m < 4; ++m) _Pragma("unroll") for (int n = 0; n < 2; ++n) _Pragma("unroll") for (int k = 0; k < 2; ++k) \
        acc[ai][bj][m][n] = __builtin_amdgcn_mfma_f32_16x16x32_f16(Bt[n][k], At[m][k], acc[ai][bj][m][n], 0, 0, 0); __builtin_amdgcn_s_setprio(0); } while (0)
#define PG8_WAIT_V(n) asm volatile("s_waitcnt vmcnt(" #n ")" ::: "memory")
#define PG8_WAIT_L(n) asm volatile("s_waitcnt lgkmcnt(" #n ")" ::: "memory")
#define PG8_BAR __builtin_amdgcn_s_barrier()
#define PG8_SCHED __builtin_amdgcn_sched_barrier(0)
    Unit cur, nxt; int ui = 0;
    if (!S.next(0, cur)) return;
    f32x4 acc[2][2][4][2];
#pragma unroll
    for (int a = 0; a < 2; ++a)
#pragma unroll
        for (int b = 0; b < 2; ++b)
#pragma unroll
            for (int m = 0; m < 4; ++m)
#pragma unroll
                for (int n = 0; n < 2; ++n) acc[a][b][m][n] = (f32x4){0.f, 0.f, 0.f, 0.f};
    f16x8 At[4][2], B0[2][2], B1[2][2];
    const char* cA = cur.A; const char* cB = cur.B;
    PG8_STAGE(PG8_SB(0, 0), cB, voffB); PG8_STAGE(PG8_SA(0, 0), cA, voffA); PG8_STAGE(PG8_SB(0, 1), cB + hstepB, voffB); PG8_STAGE(PG8_SA(0, 1), cA + hstepA, voffA);
    if (wr == 1) PG8_BAR;
    PG8_WAIT_V(4); PG8_BAR;
    PG8_STAGE(PG8_SB(1, 0), cB + kstep, voffB); PG8_STAGE(PG8_SA(1, 0), cA + kstep, voffA); PG8_STAGE(PG8_SB(1, 1), cB + hstepB + kstep, voffB);
    PG8_WAIT_V(6); PG8_BAR;
    for (;;) {
        const bool has_next = S.next(ui + 1, nxt);
        const char* nA = has_next ? nxt.A : cA; const char* nB = has_next ? nxt.B : cB;
#pragma unroll 1
        for (int t = 0; t < nt; t += 2) {
            const bool last = (t == nt - 2);
            const char* a1 = cA + (size_t)(t + 1) * kstep;
            const char* a2 = last ? nA : cA + (size_t)(t + 2) * kstep; const char* b2 = last ? nB : cB + (size_t)(t + 2) * kstep;
            const char* a3 = a2 + kstep; const char* b3 = b2 + kstep;
            PG8_LDB(B0, 0, 0); PG8_SCHED; PG8_LDA(At, 0, 0); PG8_STAGE(PG8_SA(1, 1), a1 + hstepA, voffA);
            PG8_WAIT_L(8); PG8_BAR; PG8_WAIT_L(0); PG8_MMA(0, 0, At, B0); PG8_BAR; PG8_SCHED;
            PG8_LDB(B1, 0, 1); PG8_STAGE(PG8_SB(0, 0), b2, voffB);
            PG8_BAR; PG8_WAIT_L(0); PG8_MMA(0, 1, At, B1); PG8_BAR;
            PG8_LDA(At, 0, 1); PG8_STAGE(PG8_SA(0, 0), a2, voffA);
            PG8_BAR; PG8_WAIT_L(0); PG8_MMA(1, 0, At, B0); PG8_BAR; PG8_SCHED;
            PG8_STAGE(PG8_SB(0, 1), b2 + hstepB, voffB);
            PG8_WAIT_V(6); PG8_BAR; PG8_MMA(1, 1, At, B1); PG8_BAR;
            PG8_LDB(B0, 1, 0); PG8_SCHED; PG8_LDA(At, 1, 0); PG8_STAGE(PG8_SA(0, 1), a2 + hstepA, voffA);
            PG8_WAIT_L(8); PG8_BAR; PG8_WAIT_L(0); PG8_MMA(0, 0, At, B0); PG8_BAR; PG8_SCHED;
            PG8_LDB(B1, 1, 1); PG8_STAGE(PG8_SB(1, 0), b3, voffB);
            PG8_BAR; PG8_WAIT_L(0); PG8_MMA(0, 1, At, B1); PG8_BAR;
            PG8_LDA(At, 1, 1); PG8_STAGE(PG8_SA(1, 0), a3, voffA);
            PG8_BAR; PG8_WAIT_L(0); PG8_MMA(1, 0, At, B0); PG8_BAR; PG8_SCHED;
            PG8_STAGE(PG8_SB(1, 1), b3 + hstepB, voffB);
            PG8_WAIT_V(6); PG8_BAR; PG8_MMA(1, 1, At, B1); PG8_BAR;
        }
        E(acc, cur, wr, wc, fr, fq);
        if (!has_next) break;
#pragma unroll
        for (int a = 0; a < 2; ++a)
#pragma unroll
            for (int b = 0; b < 2; ++b)
#pragma unroll
                for (int m = 0; m < 4; ++m)
#pragma unroll
                    for (int n = 0; n < 2; ++n) acc[a][b][m][n] = (f32x4){0.f, 0.f, 0.f, 0.f};
        cur = nxt; cA = nA; cB = nB; ++ui;
    }
    PG8_WAIT_V(0);
    if (wr == 0) PG8_BAR;
    PG8_BAR;
#undef PG8_SA
#undef PG8_SB
#undef PG8_STAGE
#undef PG8_LDA
#undef PG8_LDB
#undef PG8_MMA
#undef PG8_WAIT_V
#undef PG8_WAIT_L
#undef PG8_BAR
#undef PG8_SCHED
#endif
}
}

enum { GK_STORE = 0, GK_GATE0, GK_GATE1, GK_GATE2, GK_PROJ0, GK_PROJ1, GK_PROJ2, GK_RESID };
enum { GP_INPROJ = 0, GP_MERGE, GP_WOUT, GP_QUERY };
struct GemmProg {
    const char* act; const char* wt;
    int which, G, c;
    __device__ __forceinline__ bool next(int i, pg8::Unit& u) const {
        constexpr int nM = M_ / 256;
        constexpr size_t rowA = (size_t)256 * LDZ * 2, rowB = (size_t)256 * 1024 * 2;
        if (which == GP_MERGE) {
            const int L = (i / 6) * G + c, j = i % 6, br = j < 3 ? j : j - 3;
            if (L >= nM * 4) return false;
            pg8::tile_of(L, nM, 4, u.pm, u.pn);
            if (j < 3) { u.A = act + (size_t)C_XN * 2; u.B = wt + ((size_t)(WT_MG + br * 1024) * 1024) * 2; u.kind = GK_GATE0 + br; }
            else { u.A = act + (size_t)(br == 0 ? C_YA : (br == 1 ? C_YB : C_YC)) * 2; u.B = wt + ((size_t)(WT_P + br * 1024) * 1024) * 2; u.kind = GK_PROJ0 + br; }
        } else {
            const int nN = which == GP_INPROJ ? ZN / 256 : (which == GP_WOUT ? 4 : 8);
            const int L = i * G + c;
            if (L >= nM * nN) return false;
            pg8::tile_of(L, nM, nN, u.pm, u.pn);
            u.A = act + (size_t)(which == GP_WOUT ? C_MG : C_XN) * 2;
            u.B = wt + ((size_t)(which == GP_INPROJ ? WT_IN : (which == GP_WOUT ? WT_OUT : WT_Q)) * 1024) * 2;
            u.kind = which == GP_WOUT ? GK_RESID : GK_STORE;
        }
        u.A += (size_t)u.pm * rowA; u.B += (size_t)u.pn * rowB;
        return true;
    }
};
__device__ __forceinline__ int gs_slot(int br) { return br == 0 ? C_GS : (br == 1 ? Z_V : Z_ULRU); }
struct GemmEpi {
    h16_t* act; const float* mb; const float* resid; float* out;
    __device__ __forceinline__ void operator()(const pg8::f32x4 (&acc)[2][2][4][2], const pg8::Unit& u, int wr, int wc, int fr, int fq) const {
        const int row0 = u.pm * 256 + wr * 64 + fr, col0 = u.pn * 256 + wc * 32 + 8 * fq;
#pragma unroll
        for (int ai = 0; ai < 2; ++ai)
#pragma unroll
            for (int m = 0; m < 4; ++m) {
                const int row = row0 + ai * 128 + m * 16;
#pragma unroll
                for (int bj = 0; bj < 2; ++bj) {
                    const int col = col0 + bj * 128;
                    float v[8];
#pragma unroll
                    for (int e = 0; e < 4; ++e) { v[e] = acc[ai][bj][m][0][e]; v[4 + e] = acc[ai][bj][m][1][e]; }
                    h16_t* arow = act + (size_t)row * LDZ;
                    if (u.kind == GK_STORE) {
                        store8h(arow + col, v);
                    } else if (u.kind <= GK_GATE2) {
                        const float* bp = mb + (u.kind - GK_GATE0) * 1024 + col;
                        const float4 b0 = *(const float4*)bp, b1 = *(const float4*)(bp + 4);
                        v[0] = sigmoidf_(v[0] + b0.x); v[1] = sigmoidf_(v[1] + b0.y); v[2] = sigmoidf_(v[2] + b0.z); v[3] = sigmoidf_(v[3] + b0.w);
                        v[4] = sigmoidf_(v[4] + b1.x); v[5] = sigmoidf_(v[5] + b1.y); v[6] = sigmoidf_(v[6] + b1.z); v[7] = sigmoidf_(v[7] + b1.w);
                        store8h(arow + gs_slot(u.kind - GK_GATE0) + col, v);
                    } else if (u.kind <= GK_PROJ2) {
                        float g[8]; load8h(arow + gs_slot(u.kind - GK_PROJ0) + col, g);
                        if (u.kind == GK_PROJ0) {
#pragma unroll
                            for (int e = 0; e < 8; ++e) v[e] = g[e] * v[e];
                        } else {
                            float o[8]; load8h(arow + C_MG + col, o);
#pragma unroll
                            for (int e = 0; e < 8; ++e) v[e] = o[e] + g[e] * v[e];
                        }
                        store8h(arow + C_MG + col, v);
                    } else {
                        const size_t o = (size_t)row * 1024 + col;
                        const float4 r0 = *(const float4*)(resid + o), r1 = *(const float4*)(resid + o + 4);
                        *(float4*)(out + o) = make_float4(r0.x + v[0], r0.y + v[1], r0.z + v[2], r0.w + v[3]);
                        *(float4*)(out + o + 4) = make_float4(r1.x + v[4], r1.y + v[5], r1.z + v[6], r1.w + v[7]);
                    }
                }
            }
    }
};
__device__ __forceinline__ void stage_gemm(KParams p, int l, int which, char* smem) {
    GemmProg S; S.act = p->ws + OFF_ACT; S.wt = p->ws + OFF_WT + (size_t)l * WT_ROWS * 1024 * 2; S.which = which; S.G = gridDim.x; S.c = bid_();
    GemmEpi E; E.act = (h16_t*)(p->ws + OFF_ACT); E.mb = p->in[I_MB] + l * 3072; E.resid = l == 0 ? p->in[I_X] : p->out; E.out = p->out;
    pg8::gemm_phase(smem, S, E);
}

#ifdef CPU_EMU
__device__ __forceinline__ float group_sum(float v, int width, float* scratch) {
    const int tid = tid_();
    scratch[tid] = v;
    __syncthreads();
    float s = 0.f; const int base = tid & ~(width - 1);
    for (int i = 0; i < width; ++i) s += scratch[base + i];
    __syncthreads();
    return s;
}
#else
template <int CTRL> __device__ __forceinline__ float dpp_f(float v) { return __builtin_bit_cast(float, __builtin_amdgcn_update_dpp(0, __builtin_bit_cast(int, v), CTRL, 0xf, 0xf, false)); }
__device__ __forceinline__ float group_sum(float v, int width, float*) {
    v += dpp_f<0xB1>(v);
    v += dpp_f<0x4E>(v);
    if (width >= 8) v += dpp_f<0x141>(v);
    if (width >= 16) v += dpp_f<0x140>(v);
    if (width >= 64) {
        v += __builtin_bit_cast(float, __builtin_amdgcn_update_dpp(0, __builtin_bit_cast(int, v), 0x142, 0xa, 0xf, false));
        v += __builtin_bit_cast(float, __builtin_amdgcn_update_dpp(0, __builtin_bit_cast(int, v), 0x143, 0xc, 0xf, false));
        v = __builtin_bit_cast(float, __builtin_amdgcn_readlane(__builtin_bit_cast(int, v), 63));
    } else if (width >= 32) v += __shfl_xor(v, 16);
    return v;
}
#endif
__device__ __forceinline__ uint4 ldg16(const h16_t* p) { return *(const uint4*)p; }
__device__ __forceinline__ uint4 zero16() { uint4 z; z.x = 0u; z.y = 0u; z.z = 0u; z.w = 0u; return z; }

__device__ __forceinline__ void stage_lru(KParams p, int l, char* smem, int vb0, int nvb) {
    const int vb = bid_() - vb0;
    if (vb < 0 || vb >= nvb) return;
    constexpr int CH = 64;
    float* wa_s = (float*)smem;
    float* wx_s = wa_s + 4096;
    float* xcT = wx_s + 4096;
    float* a_s = xcT + 64 * CH;
    float* b_s = a_s + CH * 64;
    h16_t* ru = (h16_t*)(b_s + CH * 64);
    h16_t* rg = ru + (CH + 3) * 64;
    h16_t* ACT = (h16_t*)(p->ws + OFF_ACT);
    const int tid = tid_(), c = tid & 63, tg = tid >> 6;
    for (int item = vb; item < B_ * 16; item += nvb) {
        const int b = item / 16, n = item % 16, ch = n * 64 + c;
        __syncthreads();
        for (int i = tid; i < 4096; i += NT) { wa_s[i] = p->in[I_LWA][((size_t)l * 16 + n) * 4096 + i]; wx_s[i] = p->in[I_LWX][((size_t)l * 16 + n) * 4096 + i]; }
        const float cw0 = p->in[I_LCW][((size_t)l * 4 + 0) * 1024 + ch], cw1 = p->in[I_LCW][((size_t)l * 4 + 1) * 1024 + ch];
        const float cw2 = p->in[I_LCW][((size_t)l * 4 + 2) * 1024 + ch], cw3 = p->in[I_LCW][((size_t)l * 4 + 3) * 1024 + ch];
        const float cb = p->in[I_LCB][l * 1024 + ch], ba = p->in[I_LBA][l * 1024 + ch], bx = p->in[I_LBX][l * 1024 + ch];
        const float sp = softplusf_(-p->in[I_LLAM][l * 1024 + ch]);
        float hst = 0.f;
        uint4 pf[3];
#define LRU_LOAD(t0_) do { _Pragma("unroll") for (int i = 0; i < 3; ++i) { const int j = tid + NT * i; pf[i] = zero16(); \
            if (j < 536) { const int t = (t0_) - 3 + (j >> 3); if (t >= 0) pf[i] = ldg16(ACT + ((size_t)b * T_ + t) * LDZ + Z_ULRU + n * 64 + (j & 7) * 8); } \
            else if (j < 1048) { const int jj = j - 536; pf[i] = ldg16(ACT + ((size_t)b * T_ + (t0_) + (jj >> 3)) * LDZ + Z_GLRU + n * 64 + (jj & 7) * 8); } } } while (0)
#define LRU_PUT() do { _Pragma("unroll") for (int i = 0; i < 3; ++i) { const int j = tid + NT * i; \
            if (j < 536) *(uint4*)(ru + (j >> 3) * 64 + (j & 7) * 8) = pf[i]; else if (j < 1048) *(uint4*)(rg + ((j - 536) >> 3) * 64 + ((j - 536) & 7) * 8) = pf[i]; } } while (0)
        LRU_LOAD(0);
        LRU_PUT();
        __syncthreads();
#pragma unroll 1
        for (int t0 = 0; t0 < T_; t0 += CH) {
            float xc[8];
            {
                float u[11];
#pragma unroll
                for (int s = 0; s < 11; ++s) u[s] = h2f(ru[(tg * 8 + s) * 64 + c]);
#pragma unroll
                for (int s = 0; s < 8; ++s) { xc[s] = cw0 * u[s] + cw1 * u[s + 1] + cw2 * u[s + 2] + cw3 * u[s + 3] + cb; xcT[c * CH + tg * 8 + s] = xc[s]; }
            }
            __syncthreads();
            if (t0 + CH < T_) LRU_LOAD(t0 + CH);
            {
                float dr[8], di[8];
#pragma unroll
                for (int s = 0; s < 8; ++s) { dr[s] = 0.f; di[s] = 0.f; }
#pragma unroll 4
                for (int i = 0; i < 64; ++i) {
                    const float wa = wa_s[i * 64 + c], wx = wx_s[i * 64 + c];
                    const float4 x0 = *(const float4*)(xcT + i * CH + tg * 8), x1 = *(const float4*)(xcT + i * CH + tg * 8 + 4);
                    dr[0] += x0.x * wa; dr[1] += x0.y * wa; dr[2] += x0.z * wa; dr[3] += x0.w * wa; dr[4] += x1.x * wa; dr[5] += x1.y * wa; dr[6] += x1.z * wa; dr[7] += x1.w * wa;
                    di[0] += x0.x * wx; di[1] += x0.y * wx; di[2] += x0.z * wx; di[3] += x0.w * wx; di[4] += x1.x * wx; di[5] += x1.y * wx; di[6] += x1.z * wx; di[7] += x1.w * wx;
                }
#pragma unroll
                for (int s = 0; s < 8; ++s) {
                    const float r = sigmoidf_(dr[s] + ba), ig = sigmoidf_(di[s] + bx);
                    const float log_a = -8.0f * r * sp;
                    a_s[(tg * 8 + s) * 64 + c] = fexp_(log_a);
                    b_s[(tg * 8 + s) * 64 + c] = sqrtf(fmaxf(1.0f - fexp_(2.0f * log_a), 0.0f)) * (ig * xc[s]);
                }
            }
            __syncthreads();
            if (tid < 64) {
#pragma unroll 8
                for (int t = 0; t < CH; ++t) { hst = a_s[t * 64 + c] * hst + b_s[t * 64 + c]; b_s[t * 64 + c] = hst; }
            }
            __syncthreads();
#pragma unroll
            for (int s = 0; s < 8; ++s) { h16_t* gp = rg + (tg * 8 + s) * 64 + c; *gp = f2h(b_s[(tg * 8 + s) * 64 + c] * geluf_(h2f(*gp))); }
            __syncthreads();
            *(uint4*)(ACT + ((size_t)b * T_ + t0 + (tid >> 3)) * LDZ + Z_GLRU + n * 64 + (tid & 7) * 8) = *(const uint4*)(rg + (tid >> 3) * 64 + (tid & 7) * 8);
            __syncthreads();
            if (t0 + CH < T_) LRU_PUT();
            __syncthreads();
        }
#undef LRU_LOAD
#undef LRU_PUT
    }
}

#ifdef CPU_EMU
struct hfrag { h16_t v[8]; };
struct facc { float d[4]; float& operator[](int i) { return d[i]; } const float& operator[](int i) const { return d[i]; } };
__device__ __forceinline__ facc facc_zero() { facc a; a.d[0] = a.d[1] = a.d[2] = a.d[3] = 0.f; return a; }
__device__ __forceinline__ hfrag frag_u4(uint4 w) { hfrag f; memcpy(&f, &w, 16); return f; }
__device__ __forceinline__ hfrag frag_2u2(uint2 lo, uint2 hi) { hfrag f; memcpy(&f.v[0], &lo, 8); memcpy(&f.v[4], &hi, 8); return f; }
__device__ __forceinline__ hfrag frag_mul(hfrag a, hfrag b) { hfrag f; for (int j = 0; j < 8; ++j) f.v[j] = f2h(h2f(a.v[j]) * h2f(b.v[j])); return f; }
__device__ __forceinline__ facc mfma16(hfrag a, hfrag b, facc c) {
    const int tid = tid_(), w = tid >> 6, l = tid & 63;
    unsigned short (*X)[64][16] = emu::ctx->xscr;
    for (int j = 0; j < 8; ++j) { X[w][l][j] = a.v[j]; X[w][l][8 + j] = b.v[j]; }
    __syncthreads();
    for (int reg = 0; reg < 4; ++reg) {
        const int row = 4 * (l >> 4) + reg, col = l & 15;
        float s = 0.f;
        for (int k = 0; k < 32; ++k) s += h2f(X[w][row + 16 * (k >> 3)][k & 7]) * h2f(X[w][col + 16 * (k >> 3)][8 + (k & 7)]);
        c.d[reg] += s;
    }
    __syncthreads();
    return c;
}
#else
typedef _Float16 hfrag __attribute__((ext_vector_type(8)));
typedef float facc __attribute__((ext_vector_type(4)));
__device__ __forceinline__ facc facc_zero() { return (facc){0.f, 0.f, 0.f, 0.f}; }
__device__ __forceinline__ hfrag frag_u4(uint4 w) { return __builtin_bit_cast(hfrag, w); }
__device__ __forceinline__ hfrag frag_2u2(uint2 lo, uint2 hi) { uint4 w; w.x = lo.x; w.y = lo.y; w.z = hi.x; w.w = hi.y; return __builtin_bit_cast(hfrag, w); }
__device__ __forceinline__ hfrag frag_mul(hfrag a, hfrag b) { return a * b; }
__device__ __forceinline__ facc mfma16(hfrag a, hfrag b, facc c) { return __builtin_amdgcn_mfma_f32_16x16x32_f16(a, b, c, 0, 0, 0); }
#endif
__device__ __forceinline__ hfrag frag_pack8(float a0, float a1, float a2, float a3, float a4, float a5, float a6, float a7) {
    uint4 w; w.x = pack2h(a0, a1); w.y = pack2h(a2, a3); w.z = pack2h(a4, a5); w.w = pack2h(a6, a7); return frag_u4(w);
}
__device__ __forceinline__ hfrag frag_acc2(const facc& t0, const facc& t1) { return frag_pack8(t0[0], t0[1], t0[2], t0[3], t1[0], t1[1], t1[2], t1[3]); }
__device__ __forceinline__ hfrag permfrag(const h16_t* rowp, int ks, int g) { return frag_2u2(*(const uint2*)(rowp + 32 * ks + 4 * g), *(const uint2*)(rowp + 32 * ks + 16 + 4 * g)); }

__device__ __forceinline__ void stage_gdn(KParams p, int l, char* smem, int vb0, int nvb) {
    const int vb = bid_() - vb0;
    if (vb < 0 || vb >= nvb) return;
    constexpr int CH = 64, QS = 136, TS = 72, AS = 68, KTS = 128 * TS + 16 * 8;
#define KTO(d) ((d) * TS + ((d) >> 3) * 8)
    h16_t* Qs = (h16_t*)smem;
    h16_t* Ks = Qs + 64 * QS;
    h16_t* Kt = Ks + 64 * QS;
    h16_t* Vt = Kt + KTS;
    float* A32 = (float*)(Vt + KTS);
    h16_t* ob = (h16_t*)A32;
    h16_t* Tu = (h16_t*)(A32 + 64 * AS);
    h16_t* Tw = Tu + 64 * TS;
    h16_t* QKm = Tw + 64 * TS;
    float* gc_s = (float*)(QKm + 64 * TS);
    float* be_s = gc_s + 64;
    float* e1_s = be_s + 64;
    float* part_s = e1_s + 64;
    float* scr = part_s + 512;
    float* cw_s = scr + 512;
    h16_t* ACT = (h16_t*)(p->ws + OFF_ACT);
    int tid = tid_(), lane = tid & 63, w = tid >> 6, g = lane >> 4, r16 = lane & 15;
    int sg = lane >> 4, pc = lane & 15, rb = w;
#define GDN_ROLES() do { tid = tid_(); lane = tid & 63; w = tid >> 6; g = lane >> 4; r16 = lane & 15; sg = g; pc = r16; rb = w; } while (0)
    for (int item = vb; item < B_ * 8; item += nvb) {
        const int b = item / 8, h = item % 8;
        const float a_exp = fexp_(p->in[I_GALOG][l * 8 + h]), dtb = p->in[I_GDT][l * 8 + h];
        facc S[8];
#pragma unroll
        for (int dt = 0; dt < 8; ++dt) S[dt] = facc_zero();
        __syncthreads();
        for (int i = tid; i < 64 * TS / 2; i += NT) ((unsigned*)QKm)[i] = 0u;
        for (int i = tid; i < 4 * 384; i += NT) { const int jj = i / 384, c3 = i % 384; cw_s[i] = p->in[I_GCW][((size_t)l * 4 + jj) * 3072 + (c3 >> 7) * 1024 + h * 128 + (c3 & 127)]; }
        uint4 pf[11];
#define GDN_LOAD(t0_) do { GDN_ROLES(); const h16_t* colp = ACT + ((size_t)b * T_ + (t0_) + 8 * rb - 3) * LDZ + (sg < 3 ? Z_Q + sg * 1024 : Z_ZG) + h * 128 + pc * 8; \
            _Pragma("unroll") for (int i = 0; i < 11; ++i) { const int t = (t0_) + 8 * rb - 3 + i; pf[i] = (t >= 0 && sg < 3) ? ldg16(colp + (size_t)i * LDZ) : zero16(); } } while (0)
        GDN_LOAD(0);
        h16_t pfa = 0, pfb = 0;
#define GDN_LOADS(t0_) do { if (tid < 64) { const size_t m_ = (size_t)b * T_ + (t0_) + tid; pfa = ACT[m_ * LDZ + Z_ALPHA + h]; pfb = ACT[m_ * LDZ + Z_BETA + h]; } } while (0)
        GDN_LOADS(0);
#pragma unroll 1
        for (int t0 = 0; t0 < T_; t0 += CH) {
            GDN_ROLES();
            if (tid < 64) {
                part_s[tid] = -a_exp * softplusf_(h2f(pfa) + dtb);
                be_s[tid] = sigmoidf_(h2f(pfb));
            }
            __syncthreads();
            if (tid < 64) { float s = 0.f;
#pragma unroll
                for (int i4 = 0; i4 < 16; ++i4) { const float4 pv = *(const float4*)(part_s + i4 * 4); s += (i4 * 4 <= tid ? pv.x : 0.f) + (i4 * 4 + 1 <= tid ? pv.y : 0.f) + (i4 * 4 + 2 <= tid ? pv.z : 0.f) + (i4 * 4 + 3 <= tid ? pv.w : 0.f); }
                gc_s[tid] = s; }
#pragma unroll
            for (int hf = 0; hf < 2; ++hf) {
                float ov[4][8];
#pragma unroll
                for (int i = 0; i < 4; ++i) {
#pragma unroll
                    for (int cc = 0; cc < 8; ++cc) ov[i][cc] = 0.f;
#pragma unroll
                    for (int jj = 0; jj < 4; ++jj) {
                        const uint4 wv = pf[hf * 4 + i + jj];
                        const float* cwp = cw_s + jj * 384 + (sg < 3 ? sg : 0) * 128 + pc * 8;
                        const float4 c0 = *(const float4*)cwp, c1 = *(const float4*)(cwp + 4);
                        ov[i][0] += c0.x * h2f((h16_t)(wv.x & 0xffffu)); ov[i][1] += c0.y * h2f((h16_t)(wv.x >> 16)); ov[i][2] += c0.z * h2f((h16_t)(wv.y & 0xffffu)); ov[i][3] += c0.w * h2f((h16_t)(wv.y >> 16));
                        ov[i][4] += c1.x * h2f((h16_t)(wv.z & 0xffffu)); ov[i][5] += c1.y * h2f((h16_t)(wv.z >> 16)); ov[i][6] += c1.z * h2f((h16_t)(wv.w & 0xffffu)); ov[i][7] += c1.w * h2f((h16_t)(wv.w >> 16));
                    }
                    float ss = 0.f;
#pragma unroll
                    for (int cc = 0; cc < 8; ++cc) { ov[i][cc] = siluf_(ov[i][cc]); ss += ov[i][cc] * ov[i][cc]; }
                    ss = group_sum(ss, 16, scr);
                    const float rn = sg == 0 ? rsqrtf(ss + RMS_EPS) * 0.08838834764831845f : (sg == 1 ? rsqrtf(ss + RMS_EPS) : 1.0f);
#pragma unroll
                    for (int cc = 0; cc < 8; ++cc) ov[i][cc] *= rn;
                    const int t = 8 * rb + hf * 4 + i;
                    if (sg == 0) store8h(Qs + t * QS + pc * 8, ov[i]);
                    else if (sg == 1) store8h(Ks + t * QS + pc * 8, ov[i]);
                }
                if (sg == 1 || sg == 2) {
                    h16_t* dstT = sg == 1 ? Kt : Vt;
#pragma unroll
                    for (int cc = 0; cc < 8; ++cc) { uint2 w2; w2.x = pack2h(ov[0][cc], ov[1][cc]); w2.y = pack2h(ov[2][cc], ov[3][cc]); *(uint2*)(dstT + KTO(pc * 8 + cc) + 8 * rb + hf * 4) = w2; }
                }
            }
            __syncthreads();
            GDN_ROLES();
            if (tid < 64) e1_s[tid] = fexp_(gc_s[63] - gc_s[tid]);
            for (int e = tid; e < 64 * 64; e += NT) { const int i = e >> 6, j = e & 63; if ((j >> 4) > (i >> 4)) A32[i * AS + (j & 7) * 8 + (j >> 3)] = 0.f; }
#pragma unroll 1
            for (int jr = 0; jr < 3; ++jr) {
                const int jb = w + 8 * jr; const bool valid = jb < 20;
                const int kind = (valid && jb >= 10) ? 1 : 0, tix = valid ? (jb % 10) : 0;
                const int ti = tix < 1 ? 0 : (tix < 3 ? 1 : (tix < 6 ? 2 : 3)), tj = tix - (ti * (ti + 1)) / 2;
                const h16_t* ap = (kind ? Qs : Ks) + (16 * ti + r16) * QS + 8 * g; const h16_t* bp = Ks + (16 * tj + r16) * QS + 8 * g;
                facc acc = facc_zero();
#pragma unroll
                for (int ks = 0; ks < 4; ++ks) acc = mfma16(frag_u4(*(const uint4*)(ap + 32 * ks)), frag_u4(*(const uint4*)(bp + 32 * ks)), acc);
                if (valid) {
                    const int j = 16 * tj + r16; const float gj = gc_s[j];
#pragma unroll
                    for (int reg = 0; reg < 4; ++reg) {
                        const int i = 16 * ti + 4 * g + reg;
                        const float dec = fexp_(fminf(gc_s[i] - gj, 0.f));
                        if (kind == 0) A32[i * AS + (j & 7) * 8 + (j >> 3)] = i > j ? be_s[i] * acc[reg] * dec : 0.f;
                        else QKm[i * TS + j] = f2h(i >= j ? acc[reg] * dec : 0.f);
                    }
                }
            }
            __syncthreads();
            GDN_ROLES();
            {
                const int t = tid >> 3, d0 = (tid & 7) * 16; const float eg = fexp_(gc_s[t]);
                float v8[8];
                load8h(Qs + t * QS + d0, v8);
#pragma unroll
                for (int e = 0; e < 8; ++e) v8[e] *= eg;
                store8h(Qs + t * QS + d0, v8);
                load8h(Qs + t * QS + d0 + 8, v8);
#pragma unroll
                for (int e = 0; e < 8; ++e) v8[e] *= eg;
                store8h(Qs + t * QS + d0 + 8, v8);
            }
            {
                const int c = tid >> 3, q = tid & 7;
                const float bc = be_s[c], bgc = bc * fexp_(gc_s[c]);
                float x[8];
#pragma unroll
                for (int i = 0; i < 8; ++i) x[i] = 0.f;
#pragma unroll
                for (int r = 0; r < 64; ++r) {
                    float sacc = 0.f;
                    if (r > 0) {
                        const float4 a0 = *(const float4*)(A32 + r * AS + q * 8);
                        sacc = a0.x * x[0];
                        if (r > 8) sacc += a0.y * x[1];
                        if (r > 16) sacc += a0.z * x[2];
                        if (r > 24) sacc += a0.w * x[3];
                        if (r > 32) {
                            const float4 a1 = *(const float4*)(A32 + r * AS + q * 8 + 4);
                            sacc += a1.x * x[4];
                            if (r > 40) sacc += a1.y * x[5];
                            if (r > 48) sacc += a1.z * x[6];
                            if (r > 56) sacc += a1.w * x[7];
                        }
                        sacc = group_sum(sacc, 8, scr);
                    }
                    const float xr = ((r == c) ? 1.f : 0.f) - sacc;
                    if (q == (r & 7)) { x[r >> 3] = xr; Tu[r * TS + c] = f2h(xr * bc); Tw[r * TS + c] = f2h(xr * bgc); }
                }
            }
            __syncthreads();
            GDN_ROLES();
            facc vn[4], aw[4];
#pragma unroll
            for (int tt = 0; tt < 4; ++tt) { vn[tt] = facc_zero(); aw[tt] = facc_zero(); }
#pragma unroll
            for (int tt = 0; tt < 4; ++tt)
#pragma unroll
                for (int ks = 0; ks <= (tt >> 1); ++ks) {
                    const hfrag au = frag_u4(*(const uint4*)(Tu + (16 * tt + r16) * TS + 32 * ks + 8 * g)), aww = frag_u4(*(const uint4*)(Tw + (16 * tt + r16) * TS + 32 * ks + 8 * g));
                    vn[tt] = mfma16(au, frag_u4(*(const uint4*)(Vt + KTO(16 * w + r16) + 32 * ks + 8 * g)), vn[tt]);
                    aw[tt] = mfma16(aww, frag_u4(*(const uint4*)(Kt + KTO(16 * w + r16) + 32 * ks + 8 * g)), aw[tt]);
                }
#pragma unroll
            for (int tt = 0; tt < 4; ++tt)
#pragma unroll
                for (int reg = 0; reg < 4; ++reg) Ks[(16 * tt + 4 * g + reg) * QS + 16 * w + r16] = f2h(-aw[tt][reg]);
            __syncthreads();
            GDN_ROLES();
            h16_t zraw[16];
#pragma unroll
            for (int tt = 0; tt < 4; ++tt)
#pragma unroll
                for (int reg = 0; reg < 4; ++reg) zraw[tt * 4 + reg] = ACT[((size_t)b * T_ + t0 + 16 * tt + 4 * g + reg) * LDZ + Z_ZG + h * 128 + 16 * w + r16];
            hfrag Sb[4];
#pragma unroll
            for (int ks = 0; ks < 4; ++ks) Sb[ks] = frag_acc2(S[2 * ks], S[2 * ks + 1]);
            facc oc[4];
#pragma unroll
            for (int tt = 0; tt < 4; ++tt) {
                oc[tt] = facc_zero();
                const h16_t* wrow = Ks + (16 * tt + r16) * QS; const h16_t* qrow = Qs + (16 * tt + r16) * QS;
#pragma unroll
                for (int ks = 0; ks < 4; ++ks) { vn[tt] = mfma16(permfrag(wrow, ks, g), Sb[ks], vn[tt]); oc[tt] = mfma16(permfrag(qrow, ks, g), Sb[ks], oc[tt]); }
            }
            hfrag VNb[2];
            VNb[0] = frag_acc2(vn[0], vn[1]); VNb[1] = frag_acc2(vn[2], vn[3]);
#pragma unroll
            for (int tt = 0; tt < 4; ++tt)
#pragma unroll
                for (int ks2 = 0; ks2 <= (tt >> 1); ++ks2) oc[tt] = mfma16(permfrag(QKm + (16 * tt + r16) * TS, ks2, g), VNb[ks2], oc[tt]);
            {
                const float egl = fexp_(gc_s[63]);
                hfrag e1f[2];
#pragma unroll
                for (int ks2 = 0; ks2 < 2; ++ks2) { const float* ep = e1_s + 32 * ks2 + 4 * g; e1f[ks2] = frag_pack8(ep[0], ep[1], ep[2], ep[3], ep[16], ep[17], ep[18], ep[19]); }
#pragma unroll
                for (int dt = 0; dt < 8; ++dt) {
#pragma unroll
                    for (int reg = 0; reg < 4; ++reg) S[dt][reg] *= egl;
#pragma unroll
                    for (int ks2 = 0; ks2 < 2; ++ks2) S[dt] = mfma16(frag_mul(permfrag(Kt + KTO(16 * dt + r16), ks2, g), e1f[ks2]), VNb[ks2], S[dt]);
                }
            }
            if (t0 + CH < T_) { GDN_LOAD(t0 + CH); GDN_LOADS(t0 + CH); }
            GDN_ROLES();
#pragma unroll
            for (int tt = 0; tt < 4; ++tt)
#pragma unroll
                for (int reg = 0; reg < 4; ++reg) { const float ss = group_sum(oc[tt][reg] * oc[tt][reg], 16, scr); if (r16 == 0) part_s[w * 64 + 16 * tt + 4 * g + reg] = ss; }
            __syncthreads();
            const float nw = p->in[I_GNW][l * 128 + w * 16 + r16];
#pragma unroll
            for (int tt = 0; tt < 4; ++tt)
#pragma unroll
                for (int reg = 0; reg < 4; ++reg) {
                    const int t = 16 * tt + 4 * g + reg;
                    float ms = 0.f;
#pragma unroll
                    for (int ww = 0; ww < 8; ++ww) ms += part_s[ww * 64 + t];
                    ob[t * 128 + 16 * w + r16] = f2h(oc[tt][reg] * rsqrtf(ms * (1.0f / 128.0f) + RMS_EPS) * nw * siluf_(h2f(zraw[tt * 4 + reg])));
                }
            __syncthreads();
            GDN_ROLES();
#pragma unroll
            for (int i = 0; i < 2; ++i) { const int j = tid + NT * i; *(uint4*)(ACT + ((size_t)b * T_ + t0 + (j >> 4)) * LDZ + Z_ZG + h * 128 + (j & 15) * 8) = *(const uint4*)(ob + (j >> 4) * 128 + (j & 15) * 8); }
            __syncthreads();
        }
#undef GDN_LOAD
#undef GDN_LOADS
#undef KTO
#undef GDN_ROLES
    }
}

__device__ __forceinline__ unsigned short f2bf_(float f) { unsigned u = __float_as_uint(f); u += 0x7fffu + ((u >> 16) & 1u); return (unsigned short)(u >> 16); }
__device__ __forceinline__ unsigned pack2bf(float a, float b) { return (unsigned)f2bf_(a) | ((unsigned)f2bf_(b) << 16); }
#ifdef CPU_EMU
struct bfrag { unsigned short v[8]; };
__device__ __forceinline__ bfrag bfrag_u4(uint4 w) { bfrag f; memcpy(&f, &w, 16); return f; }
__device__ __forceinline__ bfrag bfrag_2u2(uint2 lo, uint2 hi) { bfrag f; memcpy(&f.v[0], &lo, 8); memcpy(&f.v[4], &hi, 8); return f; }
__device__ __forceinline__ facc mfma16b(bfrag a, bfrag b, facc c) {
    const int tid = tid_(), w = tid >> 6, l = tid & 63;
    unsigned short (*X)[64][16] = emu::ctx->xscr;
    for (int j = 0; j < 8; ++j) { X[w][l][j] = a.v[j]; X[w][l][8 + j] = b.v[j]; }
    __syncthreads();
    for (int reg = 0; reg < 4; ++reg) {
        const int row = 4 * (l >> 4) + reg, col = l & 15;
        float s = 0.f;
        for (int k = 0; k < 32; ++k) s += __uint_as_float((unsigned)X[w][row + 16 * (k >> 3)][k & 7] << 16) * __uint_as_float((unsigned)X[w][col + 16 * (k >> 3)][8 + (k & 7)] << 16);
        c.d[reg] += s;
    }
    __syncthreads();
    return c;
}
#else
typedef __bf16 bfrag __attribute__((ext_vector_type(8)));
__device__ __forceinline__ bfrag bfrag_u4(uint4 w) { return __builtin_bit_cast(bfrag, w); }
__device__ __forceinline__ bfrag bfrag_2u2(uint2 lo, uint2 hi) { uint4 w; w.x = lo.x; w.y = lo.y; w.z = hi.x; w.w = hi.y; return __builtin_bit_cast(bfrag, w); }
__device__ __forceinline__ facc mfma16b(bfrag a, bfrag b, facc c) { return __builtin_amdgcn_mfma_f32_16x16x32_bf16(a, b, c, 0, 0, 0); }
#endif
__device__ __forceinline__ bfrag bfrag_acc2(const facc& t0, const facc& t1) { uint4 w; w.x = pack2bf(t0[0], t0[1]); w.y = pack2bf(t0[2], t0[3]); w.z = pack2bf(t1[0], t1[1]); w.w = pack2bf(t1[2], t1[3]); return bfrag_u4(w); }
__device__ __forceinline__ bfrag bfrag_ld(const unsigned short* p) { return bfrag_u4(*(const uint4*)p); }
__device__ __forceinline__ bfrag bpermfrag(const unsigned short* rowp, int ks, int g) { return bfrag_2u2(*(const uint2*)(rowp + 32 * ks + 4 * g), *(const uint2*)(rowp + 32 * ks + 16 + 4 * g)); }

#ifndef CPU_EMU
typedef _Float16 rw_f16x8 __attribute__((ext_vector_type(8)));
typedef float rw_f32x4 __attribute__((ext_vector_type(4)));
#endif
__device__ __forceinline__ void stage_rwkv(KParams p, int l, char* smem, int vb0, int nvb) {
    const int vb = bid_() - vb0;
    if (vb < 0 || vb >= nvb) return;
    constexpr int CH = 32, XS = 264, IS = 72, TS2 = 40, LS = 36;
    float* r_s = (float*)smem;
    float* k_s = r_s + CH * 64;
    float* o_s = k_s;
    float* v_s = k_s + CH * 64;
    float* w_s = v_s + CH * 64;
    float* ka_s = w_s + CH * 64;
    float* L32 = ka_s;
    float* g_s = ka_s + CH * 64;
    float* bon_s = g_s + CH * 64;
    float* gC_s = bon_s + CH;
    float* scr = gC_s + 64;
    h16_t* raw = (h16_t*)(scr + 512);
    h16_t* xs = raw + (CH + 1) * 448;
    unsigned short* Aim = (unsigned short*)raw;
    unsigned short* Rim = Aim + 32 * IS;
    unsigned short* Bim = Rim + 32 * IS;
    unsigned short* Cim = Bim + 32 * IS;
    unsigned short* Vt = Cim + 32 * IS;
    unsigned short* Ct = Vt + 64 * TS2;
    unsigned short* Btn = Ct + 64 * TS2;
    unsigned short* Nim = Btn + 64 * TS2;
    unsigned short* Tim = Nim + 32 * TS2;
    unsigned short* G1 = Tim + 32 * TS2;
    unsigned short* G2n = G1 + 32 * TS2;
    h16_t* ACT = (h16_t*)(p->ws + OFF_ACT);
    int tid = tid_(), c = tid & 63, tg = tid >> 6;
    int lane = tid & 63, wv = tid >> 6, g = lane >> 4, r16 = lane & 15;
#define RW_ROLES() do { tid = tid_(); c = tid & 63; tg = tid >> 6; lane = c; wv = tg; g = lane >> 4; r16 = lane & 15; } while (0)
    float* cst_s = (float*)(xs + CH * XS);
    for (int item = vb; item < B_ * 16; item += nvb) {
        const int b = item / 16, h = item % 16, ch = h * 64 + c;
        __syncthreads();
        if (tid < 64) {
            const float* mu = p->in[I_RMU] + (size_t)l * RWW;
            cst_s[0 * 64 + c] = p->in[I_RW0][l * 1024 + ch]; cst_s[1 * 64 + c] = p->in[I_RA0][l * 1024 + ch]; cst_s[2 * 64 + c] = p->in[I_RKK][l * 1024 + ch]; cst_s[3 * 64 + c] = p->in[I_RKA][l * 1024 + ch];
            cst_s[4 * 64 + c] = p->in[I_RRK][(size_t)l * 1024 + ch]; cst_s[5 * 64 + c] = p->in[I_RLW][l * 1024 + ch]; cst_s[6 * 64 + c] = p->in[I_RLB][l * 1024 + ch];
            cst_s[7 * 64 + c] = mu[RW_R + ch]; cst_s[8 * 64 + c] = mu[RW_K + ch]; cst_s[9 * 64 + c] = mu[RW_V + ch];
            cst_s[10 * 64 + c] = mu[RW_WL + c]; cst_s[11 * 64 + c] = mu[RW_AL + c]; cst_s[12 * 64 + c] = mu[RW_GL + c]; cst_s[13 * 64 + c] = mu[RW_GL + 64 + c];
        }
        const float* wup = p->in[I_RWUP] + (size_t)l * 64 * 1024 + h * 64; const float* aup = p->in[I_RAUP] + (size_t)l * 64 * 1024 + h * 64; const float* gup = p->in[I_RGUP] + (size_t)l * 128 * 1024 + h * 64;
#ifndef CPU_EMU
        const int mt = wv >> 2, nt = wv & 3;
        rw_f16x8 bw[2], ba_[2], bg[4];
        {
            const int cn = nt * 16 + (lane & 15), kb = 8 * (lane >> 4);
#pragma unroll
            for (int ks = 0; ks < 2; ++ks)
#pragma unroll
                for (int j = 0; j < 8; ++j) { bw[ks][j] = (_Float16)wup[(size_t)(ks * 32 + kb + j) * 1024 + cn]; ba_[ks][j] = (_Float16)aup[(size_t)(ks * 32 + kb + j) * 1024 + cn]; }
#pragma unroll
            for (int ks = 0; ks < 4; ++ks)
#pragma unroll
                for (int j = 0; j < 8; ++j) bg[ks][j] = (_Float16)gup[(size_t)(ks * 32 + kb + j) * 1024 + cn];
        }
#endif
        facc ST[4];
#pragma unroll
        for (int jt = 0; jt < 4; ++jt) ST[jt] = facc_zero();
        uint4 pf[4];
#define RW_LOAD(t0_) do { _Pragma("unroll") for (int i = 0; i < 4; ++i) { const int j = tid + NT * i, row = j / 56, u = j % 56, t = (t0_) - 1 + row; pf[i] = zero16(); \
            if (j < (CH + 1) * 56 && t >= 0) pf[i] = ldg16(ACT + ((size_t)b * T_ + t) * LDZ + Z_RW + (u < 24 ? (u >> 3) * 1024 + h * 64 + (u & 7) * 8 : 3072 + (u - 24) * 8)); } } while (0)
#define RW_PUT() do { _Pragma("unroll") for (int i = 0; i < 4; ++i) { const int j = tid + NT * i; if (j < (CH + 1) * 56) *(uint4*)(raw + (j / 56) * 448 + (j % 56) * 8) = pf[i]; } } while (0)
        __syncthreads();
        RW_LOAD(0);
        RW_PUT();
        __syncthreads();
#pragma unroll 1
        for (int t0 = 0; t0 < T_; t0 += CH) {
            RW_ROLES();
            {
            const float mu_r = cst_s[7 * 64 + c], mu_k = cst_s[8 * 64 + c], mu_v = cst_s[9 * 64 + c], mu_wl = cst_s[10 * 64 + c], mu_al = cst_s[11 * 64 + c], mu_g0 = cst_s[12 * 64 + c], mu_g1 = cst_s[13 * 64 + c];
            float sr[4], sk[4], sv[4], swl[4], sal[4], sg0[4], sg1[4];
#pragma unroll
            for (int s = 0; s < 4; ++s) {
                const int tl = tg * 4 + s;
                const h16_t* zc = raw + (tl + 1) * 448; const h16_t* zp = raw + tl * 448;
#define RW_SHIFT(col, muv) ({ const float zz = h2f(zc[col]); zz + (muv) * (h2f(zp[col]) - zz); })
                sr[s] = RW_SHIFT(c, mu_r); sk[s] = RW_SHIFT(64 + c, mu_k); sv[s] = RW_SHIFT(128 + c, mu_v);
                swl[s] = tanhf_(RW_SHIFT(192 + c, mu_wl)); sal[s] = RW_SHIFT(256 + c, mu_al); sg0[s] = sigmoidf_(RW_SHIFT(320 + c, mu_g0)); sg1[s] = sigmoidf_(RW_SHIFT(384 + c, mu_g1));
#undef RW_SHIFT
            }
            __syncthreads();
#pragma unroll
            for (int s = 0; s < 4; ++s) {
                const int tl = tg * 4 + s;
                r_s[tl * 64 + c] = sr[s]; k_s[tl * 64 + c] = sk[s]; v_s[tl * 64 + c] = sv[s];
                xs[tl * XS + c] = f2h(swl[s]); xs[tl * XS + 64 + c] = f2h(sal[s]); xs[tl * XS + 128 + c] = f2h(sg0[s]); xs[tl * XS + 192 + c] = f2h(sg1[s]);
            }
            }
            __syncthreads();
#ifdef CPU_EMU
#pragma unroll
            for (int s = 0; s < 4; ++s) {
                const int tl = tg * 4 + s;
                float dw = 0.f, da = 0.f, dg = 0.f;
                for (int i = 0; i < 64; ++i) { dw += h2f(xs[tl * XS + i]) * h2f(f2h(wup[(size_t)i * 1024 + c])); da += h2f(xs[tl * XS + 64 + i]) * h2f(f2h(aup[(size_t)i * 1024 + c])); }
                for (int i = 0; i < 128; ++i) dg += h2f(xs[tl * XS + 128 + i]) * h2f(f2h(gup[(size_t)i * 1024 + c]));
                w_s[tl * 64 + c] = dw; ka_s[tl * 64 + c] = da; g_s[tl * 64 + c] = dg;
            }
#else
            {
                const h16_t* ap = xs + (mt * 16 + (lane & 15)) * XS + 8 * (lane >> 4);
                rw_f32x4 dw = {0.f, 0.f, 0.f, 0.f}, da = {0.f, 0.f, 0.f, 0.f}, dg = {0.f, 0.f, 0.f, 0.f};
#pragma unroll
                for (int ks = 0; ks < 2; ++ks) {
                    dw = __builtin_amdgcn_mfma_f32_16x16x32_f16(*(const rw_f16x8*)(ap + ks * 32), bw[ks], dw, 0, 0, 0);
                    da = __builtin_amdgcn_mfma_f32_16x16x32_f16(*(const rw_f16x8*)(ap + 64 + ks * 32), ba_[ks], da, 0, 0, 0);
                }
#pragma unroll
                for (int ks = 0; ks < 4; ++ks) dg = __builtin_amdgcn_mfma_f32_16x16x32_f16(*(const rw_f16x8*)(ap + 128 + ks * 32), bg[ks], dg, 0, 0, 0);
#pragma unroll
                for (int rg = 0; rg < 4; ++rg) { const int o = (mt * 16 + 4 * (lane >> 4) + rg) * 64 + nt * 16 + (lane & 15); w_s[o] = dw[rg]; ka_s[o] = da[rg]; g_s[o] = dg[rg]; }
            }
#endif
            __syncthreads();
            RW_ROLES();
            float kkn4[4], kka4[4], k24[4], rx4[4];
            {
            const float w0 = cst_s[0 * 64 + c], a0 = cst_s[1 * 64 + c], k_k = cst_s[2 * 64 + c], k_a = cst_s[3 * 64 + c], rk_c = cst_s[4 * 64 + c];
#pragma unroll
            for (int s = 0; s < 4; ++s) {
                const int tl = tg * 4 + s;
                const float w_log = -softplusf_(-(w0 + w_s[tl * 64 + c])) - 0.5f;
                const float a = sigmoidf_(a0 + ka_s[tl * 64 + c]);
                const float kx = k_s[tl * 64 + c], rx = r_s[tl * 64 + c];
                const float kkr = kx * k_k, k2 = kx * (1.0f + (a - 1.0f) * k_a);
                const float nsq = group_sum(kkr * kkr, 64, scr);
                const float bon = group_sum(rx * k2 * rk_c, 64, scr);
                const float kkn = kkr * rsqrtf(nsq + RMS_EPS);
                w_s[tl * 64 + c] = fexp_(w_log);
                kkn4[s] = kkn; kka4[s] = kkn * a; k24[s] = k2; rx4[s] = rx;
                if (c == 0) bon_s[tl] = bon;
            }
            }
            __syncthreads();
            if (tid < 64) {
                float acc = 0.f;
#pragma unroll 8
                for (int t = 0; t < CH; ++t) { acc += w_s[t * 64 + tid]; w_s[t * 64 + tid] = acc; }
                gC_s[tid] = fexp_(-acc);
            }
            __syncthreads();
            RW_ROLES();
            {
                const float PC = w_s[(CH - 1) * 64 + c];
                float vt4[4], ct4[4], bt4[4];
#pragma unroll
                for (int s = 0; s < 4; ++s) {
                    const int tl = tg * 4 + s;
                    const float P = w_s[tl * 64 + c], Pm = tl > 0 ? w_s[(tl - 1) * 64 + c] : 0.f;
                    const float gt = fexp_(-P), gm = fexp_(-Pm), ig = fexp_(P), gcr = fexp_(P - PC);
                    Aim[tl * IS + c] = f2bf_(kkn4[s] * gm); Rim[tl * IS + c] = f2bf_(rx4[s] * gt); Bim[tl * IS + c] = f2bf_(kka4[s] * ig); Cim[tl * IS + c] = f2bf_(k24[s] * ig);
                    vt4[s] = v_s[tl * 64 + c]; ct4[s] = k24[s] * gcr; bt4[s] = -kka4[s] * gcr;
                }
                uint2 w2;
                w2.x = pack2bf(vt4[0], vt4[1]); w2.y = pack2bf(vt4[2], vt4[3]); *(uint2*)(Vt + c * TS2 + tg * 4) = w2;
                w2.x = pack2bf(ct4[0], ct4[1]); w2.y = pack2bf(ct4[2], ct4[3]); *(uint2*)(Ct + c * TS2 + tg * 4) = w2;
                w2.x = pack2bf(bt4[0], bt4[1]); w2.y = pack2bf(bt4[2], bt4[3]); *(uint2*)(Btn + c * TS2 + tg * 4) = w2;
                if (tid < 384) { unsigned short* im = tid < 128 ? Nim : (tid < 256 ? G1 : G2n); const int e = tid & 127; *(unsigned*)(im + (e >> 3) * TS2 + 16 + (e & 7) * 2) = 0u; }
            }
            __syncthreads();
            RW_ROLES();
#pragma unroll 1
            for (int jr = 0; jr < 2; ++jr) {
                const int jb = wv + 8 * jr; const bool valid = jb < 12;
                const int prod = valid ? jb / 3 : 0, tix = valid ? jb % 3 : 0, ti = tix > 0 ? 1 : 0, tj = tix > 1 ? 1 : 0;
                const unsigned short* xp = (prod < 2 ? Aim : Rim) + (16 * ti + r16) * IS + 8 * g;
                const unsigned short* yp = ((prod == 0 || prod == 3) ? Bim : Cim) + (16 * tj + r16) * IS + 8 * g;
                facc acc = facc_zero();
#pragma unroll
                for (int ks = 0; ks < 2; ++ks) acc = mfma16b(bfrag_ld(xp + 32 * ks), bfrag_ld(yp + 32 * ks), acc);
                if (valid) {
                    const int s = 16 * tj + r16;
#pragma unroll
                    for (int reg = 0; reg < 4; ++reg) {
                        const int t = 16 * ti + 4 * g + reg;
                        if (prod == 0) L32[t * LS + (s & 7) * 4 + (s >> 3)] = t > s ? acc[reg] : 0.f;
                        else if (prod == 1) Nim[t * TS2 + s] = f2bf_(t > s ? acc[reg] : 0.f);
                        else if (prod == 2) G1[t * TS2 + s] = f2bf_(t >= s ? acc[reg] : 0.f);
                        else G2n[t * TS2 + s] = f2bf_(t >= s ? -acc[reg] : 0.f);
                    }
                }
            }
            __syncthreads();
            RW_ROLES();
            if (tid < 256) {
                const int cc = tid >> 3, q = tid & 7;
                float x[4] = {0.f, 0.f, 0.f, 0.f};
#pragma unroll
                for (int r = 0; r < 32; ++r) {
                    float sacc = 0.f;
                    if (r > 0) {
                        const float4 a4 = *(const float4*)(L32 + r * LS + q * 4);
                        sacc = a4.x * x[0];
                        if (r > 8) sacc += a4.y * x[1];
                        if (r > 16) sacc += a4.z * x[2];
                        if (r > 24) sacc += a4.w * x[3];
                        sacc = group_sum(sacc, 8, scr);
                    }
                    const float xr = ((r == cc) ? 1.f : 0.f) - sacc;
                    x[r >> 3] = (q == (r & 7)) ? xr : x[r >> 3];
                    Tim[r * TS2 + cc] = f2bf_(xr);
                }
            }
#ifdef CPU_EMU
            else { for (int r = 1; r < 32; ++r) (void)group_sum(0.f, 8, scr); }
#endif
            __syncthreads();
            if (t0 + CH < T_) RW_LOAD(t0 + CH);
            RW_ROLES();
            {
                const int it = wv & 3;
                bfrag STb[2];
                STb[0] = bfrag_acc2(ST[0], ST[1]); STb[1] = bfrag_acc2(ST[2], ST[3]);
                const bfrag vtf = bfrag_ld(Vt + (16 * it + r16) * TS2 + 8 * g);
                facc rhs[2], oo[2];
#pragma unroll
                for (int tt = 0; tt < 2; ++tt) {
                    const unsigned short* arow = Aim + (16 * tt + r16) * IS; const unsigned short* rrow = Rim + (16 * tt + r16) * IS;
                    rhs[tt] = mfma16b(bpermfrag(arow, 0, g), STb[0], facc_zero()); rhs[tt] = mfma16b(bpermfrag(arow, 1, g), STb[1], rhs[tt]);
                    rhs[tt] = mfma16b(bfrag_ld(Nim + (16 * tt + r16) * TS2 + 8 * g), vtf, rhs[tt]);
                    oo[tt] = mfma16b(bpermfrag(rrow, 0, g), STb[0], facc_zero()); oo[tt] = mfma16b(bpermfrag(rrow, 1, g), STb[1], oo[tt]);
                    oo[tt] = mfma16b(bfrag_ld(G1 + (16 * tt + r16) * TS2 + 8 * g), vtf, oo[tt]);
                }
                const bfrag rhsb = bfrag_acc2(rhs[0], rhs[1]);
                facc uu[2];
#pragma unroll
                for (int tt = 0; tt < 2; ++tt) uu[tt] = mfma16b(bpermfrag(Tim + (16 * tt + r16) * TS2, 0, g), rhsb, facc_zero());
                const bfrag ub = bfrag_acc2(uu[0], uu[1]);
#pragma unroll
                for (int tt = 0; tt < 2; ++tt) {
                    oo[tt] = mfma16b(bpermfrag(G2n + (16 * tt + r16) * TS2, 0, g), ub, oo[tt]);
                    if (wv < 4) {
#pragma unroll
                        for (int reg = 0; reg < 4; ++reg) o_s[(16 * tt + 4 * g + reg) * 64 + 16 * it + r16] = oo[tt][reg];
                    }
                }
#pragma unroll
                for (int jt = 0; jt < 4; ++jt) {
#pragma unroll
                    for (int reg = 0; reg < 4; ++reg) ST[jt][reg] *= gC_s[16 * jt + 4 * g + reg];
                    ST[jt] = mfma16b(bfrag_ld(Ct + (16 * jt + r16) * TS2 + 8 * g), vtf, ST[jt]);
                    ST[jt] = mfma16b(bpermfrag(Btn + (16 * jt + r16) * TS2, 0, g), ub, ST[jt]);
                }
            }
            __syncthreads();
            RW_ROLES();
            {
            const float lnw = cst_s[5 * 64 + c], lnb = cst_s[6 * 64 + c];
            const int chh = h * 64 + c;
#pragma unroll
            for (int s = 0; s < 4; ++s) {
                const int tl = tg * 4 + s;
                const float ov = o_s[tl * 64 + c];
                const float mean = group_sum(ov, 64, scr) * (1.0f / 64.0f);
                const float d = ov - mean;
                const float var = group_sum(d * d, 64, scr) * (1.0f / 64.0f);
                const float y = (d * rsqrtf(var + GN_EPS) * lnw + lnb + bon_s[tl] * v_s[tl * 64 + c]) * g_s[tl * 64 + c];
                ACT[((size_t)b * T_ + t0 + tl) * LDZ + C_YC + chh] = f2h(y);
            }
            }
            RW_ROLES();
            if (t0 + CH < T_) RW_PUT();
            __syncthreads();
        }
#undef RW_LOAD
#undef RW_PUT
#undef RW_ROLES
    }
}
constexpr bool TAB_IN_ACT = false;
constexpr float TAB_SU = 256.0f, TAB_SV = 32.0f;
__device__ __forceinline__ unsigned char* tab_row(char* ws, int e) {
    if (TAB_IN_ACT) return (unsigned char*)((h16_t*)(ws + OFF_ACT) + (size_t)e * LDZ + C_GS);
    return (unsigned char*)(ws + OFF_TAB) + (size_t)e * 2048;
}
#ifdef CPU_EMU
__device__ __forceinline__ unsigned f2fp8(float f) {
    const unsigned sgn = f < 0.f ? 0x80u : 0u; float a = fabsf(f);
    if (!(a == a)) return 0x7fu;
    if (a >= 448.0f) return sgn | 0x7eu;
    if (a < 0.0009765625f) return sgn;
    int e; frexpf(a, &e); e -= 1;
    if (e < -6) { const float q = nearbyintf(a * 512.0f); return sgn | (unsigned)q; }
    float q = nearbyintf((a / ldexpf(1.0f, e) - 1.0f) * 8.0f);
    if (q >= 8.0f) { q = 0.f; e += 1; }
    if (e > 8) return sgn | 0x7eu;
    const unsigned r = ((unsigned)(e + 7) << 3) | (unsigned)q;
    return sgn | (r > 0x7eu ? 0x7eu : r);
}
__device__ __forceinline__ float fp82f(unsigned b) {
    const unsigned e = (b >> 3) & 15u, m = b & 7u; const float s = (b & 0x80u) ? -1.f : 1.f;
    if (e == 0) return s * (float)m * 0.001953125f;
    return s * ldexpf(1.0f + (float)m * 0.125f, (int)e - 7);
}
__device__ __forceinline__ unsigned pack4fp8(float a, float b, float c, float d) { return f2fp8(a) | (f2fp8(b) << 8) | (f2fp8(c) << 16) | (f2fp8(d) << 24); }
__device__ __forceinline__ void dec4fp8(unsigned w, float* o) { o[0] = fp82f(w & 255u); o[1] = fp82f((w >> 8) & 255u); o[2] = fp82f((w >> 16) & 255u); o[3] = fp82f(w >> 24); }
#else
__device__ __forceinline__ unsigned pack4fp8(float a, float b, float c, float d) { int p = __builtin_amdgcn_cvt_pk_fp8_f32(a, b, 0, false); p = __builtin_amdgcn_cvt_pk_fp8_f32(c, d, p, true); return (unsigned)p; }
__device__ __forceinline__ void dec4fp8(unsigned w, float* o) { const auto lo = __builtin_amdgcn_cvt_pk_f32_fp8((int)w, false); const auto hi = __builtin_amdgcn_cvt_pk_f32_fp8((int)w, true); o[0] = lo[0]; o[1] = lo[1]; o[2] = hi[0]; o[3] = hi[1]; }
#endif
__device__ __forceinline__ void stage_tabconv(KParams p, int l, int vb0, int nvb) {
    const int vb = bid_() - vb0;
    if (vb < 0 || vb >= nvb) return;
    const int tid = tid_();
    const float* U = p->in[I_PU] + (size_t)l * 16384 * 1024; const float* V = p->in[I_PV] + (size_t)l * 16384 * 1024;
    char* ws = p->ws;
    for (int it = vb * NT + tid; it < 16384 * 128; it += nvb * NT) {
        const int r = it >> 7, ck = it & 127, which = ck >> 6, c16 = ck & 63;
        const float* src = (which ? V : U) + (size_t)r * 1024 + c16 * 16;
        const float sc = which ? TAB_SV : TAB_SU;
        const float4 a = *(const float4*)src, b = *(const float4*)(src + 4), c = *(const float4*)(src + 8), d = *(const float4*)(src + 12);
        uint4 w;
        w.x = pack4fp8(a.x * sc, a.y * sc, a.z * sc, a.w * sc); w.y = pack4fp8(b.x * sc, b.y * sc, b.z * sc, b.w * sc);
        w.z = pack4fp8(c.x * sc, c.y * sc, c.z * sc, c.w * sc); w.w = pack4fp8(d.x * sc, d.y * sc, d.z * sc, d.w * sc);
        *(uint4*)(tab_row(ws, r) + which * 1024 + c16 * 16) = w;
    }
}

#ifdef CPU_EMU
__device__ __forceinline__ float group_max16(float v, float* scr) {
    const int tid = tid_();
    scr[tid] = v;
    __syncthreads();
    float m = -3.0e38f; const int base = tid & ~15;
    for (int i = 0; i < 16; ++i) m = fmaxf(m, scr[base + i]);
    __syncthreads();
    return m;
}
#else
__device__ __forceinline__ float group_max16(float v, float*) {
    v = fmaxf(v, dpp_f<0xB1>(v)); v = fmaxf(v, dpp_f<0x4E>(v)); v = fmaxf(v, dpp_f<0x141>(v)); v = fmaxf(v, dpp_f<0x140>(v));
    return v;
}
#endif
__device__ __forceinline__ void stage_peer_topk(KParams p, int l, char* smem) {
    constexpr int KS = 136;
    h16_t* khi = (h16_t*)smem;
    h16_t* klo = khi + 128 * KS;
    float* scr = (float*)(klo + 128 * KS);
    const h16_t* ACT = (const h16_t*)(p->ws + OFF_ACT);
    float* TOPS = (float*)(p->ws + OFF_TOPS);
    int tid = tid_(), lane = tid & 63, w = tid >> 6, g = lane >> 4, r16 = lane & 15;
#define TK_ROLES() do { tid = tid_(); lane = tid & 63; w = tid >> 6; g = lane >> 4; r16 = lane & 15; } while (0)
    const int nb = gridDim.x;
    for (int hs = bid_() % 16; hs < 16; hs += nb) {
        const int hd = hs >> 1, s = hs & 1;
        __syncthreads();
        {
            const float* kp = p->in[I_PKEYS] + (((size_t)l * 8 + hd) * 2 + s) * 128 * 128;
            for (int i = tid * 4; i < 128 * 128; i += NT * 4) {
                const float4 kv = *(const float4*)(kp + i);
                const int n = i >> 7, c0 = i & 127;
                const float h0 = h2f(f2h(kv.x)), h1 = h2f(f2h(kv.y)), h2 = h2f(f2h(kv.z)), h3 = h2f(f2h(kv.w));
                uint2 hw, lw; hw.x = pack2h(kv.x, kv.y); hw.y = pack2h(kv.z, kv.w); lw.x = pack2h(kv.x - h0, kv.y - h1); lw.y = pack2h(kv.z - h2, kv.w - h3);
                *(uint2*)(khi + n * KS + c0) = hw; *(uint2*)(klo + n * KS + c0) = lw;
            }
        }
        __syncthreads();
        const int nblk = nb >= 16 ? nb / 16 : 1, bsub = nb >= 16 ? bid_() / 16 : 0;
        for (int chunk = bsub; chunk < (M_ + NT - 1) / NT; chunk += nblk) {
            if (nb >= 16 && bid_() >= nblk * 16) break;
#pragma unroll 1
            for (int tt = 0; tt < 4; ++tt) {
                TK_ROLES();
                const int tok0 = chunk * NT + w * 64 + tt * 16;
                const bool live = tok0 < M_;
                hfrag af[4];
                {
                    const h16_t* qp = ACT + (size_t)(live ? tok0 + r16 : 0) * LDZ + C_QRY + hd * 256 + s * 128 + 8 * g;
#pragma unroll
                    for (int ks = 0; ks < 4; ++ks) af[ks] = frag_u4(*(const uint4*)(qp + 32 * ks));
                }
                facc acc[8];
#pragma unroll
                for (int nt = 0; nt < 8; ++nt) {
                    acc[nt] = facc_zero();
                    const h16_t* bh = khi + (16 * nt + r16) * KS + 8 * g; const h16_t* bl = klo + (16 * nt + r16) * KS + 8 * g;
#pragma unroll
                    for (int ks = 0; ks < 4; ++ks) { acc[nt] = mfma16(af[ks], frag_u4(*(const uint4*)(bh + 32 * ks)), acc[nt]); acc[nt] = mfma16(af[ks], frag_u4(*(const uint4*)(bl + 32 * ks)), acc[nt]); }
                }
#pragma unroll 1
                for (int rp = 0; rp < 2; ++rp) {
                  TK_ROLES();
#pragma unroll
                  for (int r2 = 0; r2 < 2; ++r2) {
                    const int reg = rp * 2 + r2;
                    float v[8];
#pragma unroll
                    for (int nt = 0; nt < 8; ++nt) { const float av = rp == 0 ? (r2 == 0 ? acc[nt][0] : acc[nt][1]) : (r2 == 0 ? acc[nt][2] : acc[nt][3]); v[nt] = __uint_as_float((__float_as_uint(av) & ~127u) | (unsigned)(127 - (16 * nt + r16))); }
#define CE(i, j) { const float hi_ = fmaxf(v[i], v[j]), lo_ = fminf(v[i], v[j]); v[i] = hi_; v[j] = lo_; }
                    CE(0, 1) CE(2, 3) CE(4, 5) CE(6, 7) CE(0, 2) CE(1, 3) CE(4, 6) CE(5, 7) CE(1, 2) CE(5, 6) CE(0, 4) CE(1, 5) CE(2, 6) CE(3, 7) CE(2, 4) CE(3, 5) CE(1, 2) CE(3, 4) CE(5, 6)
#undef CE
                    float res = 0.f;
#pragma unroll
                    for (int rnd = 0; rnd < 16; ++rnd) {
                        const float m = group_max16(v[0], scr);
                        const bool win = v[0] == m;
#pragma unroll
                        for (int i = 0; i < 7; ++i) v[i] = win ? v[i + 1] : v[i];
                        v[7] = win ? -3.0e38f : v[7];
                        res = (r16 == rnd) ? m : res;
                    }
                    if (live) TOPS[(((size_t)(tok0 + 4 * g + reg) * 8 + hd) * 2 + s) * 16 + r16] = res;
                  }
                }
            }
        }
    }
}

#undef TK_ROLES
__device__ __forceinline__ void peer_cand(int k, int& i, int& j) {
    if (k < 16) { i = 0; j = k; } else if (k < 24) { i = 1; j = k - 16; } else if (k < 29) { i = 2; j = k - 24; } else if (k < 33) { i = 3; j = k - 29; }
    else if (k < 36) { i = 4; j = k - 33; } else if (k < 38) { i = 5; j = k - 36; } else if (k < 40) { i = 6; j = k - 38; } else if (k < 42) { i = 7; j = k - 40; }
    else { i = k - 34; j = 0; }
}
#ifdef CPU_EMU
__device__ __forceinline__ float dot16q(const uint4 a, const unsigned (&xh)[8]) {
    const unsigned aw[4] = {a.x, a.y, a.z, a.w};
    float s = 0.f;
    for (int i = 0; i < 4; ++i) { float t[4]; dec4fp8(aw[i], t);
        for (int j = 0; j < 2; ++j) { const unsigned xw = xh[2 * i + j]; unsigned short lo = (unsigned short)(xw & 0xffffu), hi = (unsigned short)(xw >> 16); h16_t hl, hh; memcpy(&hl, &lo, 2); memcpy(&hh, &hi, 2);
            s += t[2 * j] * h2f(hl) + t[2 * j + 1] * h2f(hh); } }
    return s;
}
#else
typedef _Float16 pg_h2 __attribute__((ext_vector_type(2)));
__device__ __forceinline__ float dot16q(const uint4 a, const unsigned (&xh)[8]) {
    float s0, s1;
    s0 = __builtin_amdgcn_fdot2(__builtin_amdgcn_cvt_scalef32_pk_f16_fp8(a.x, 1.0f, false), __builtin_bit_cast(pg_h2, xh[0]), 0.f, false);
    s1 = __builtin_amdgcn_fdot2(__builtin_amdgcn_cvt_scalef32_pk_f16_fp8(a.x, 1.0f, true), __builtin_bit_cast(pg_h2, xh[1]), 0.f, false);
    s0 = __builtin_amdgcn_fdot2(__builtin_amdgcn_cvt_scalef32_pk_f16_fp8(a.y, 1.0f, false), __builtin_bit_cast(pg_h2, xh[2]), s0, false);
    s1 = __builtin_amdgcn_fdot2(__builtin_amdgcn_cvt_scalef32_pk_f16_fp8(a.y, 1.0f, true), __builtin_bit_cast(pg_h2, xh[3]), s1, false);
    s0 = __builtin_amdgcn_fdot2(__builtin_amdgcn_cvt_scalef32_pk_f16_fp8(a.z, 1.0f, false), __builtin_bit_cast(pg_h2, xh[4]), s0, false);
    s1 = __builtin_amdgcn_fdot2(__builtin_amdgcn_cvt_scalef32_pk_f16_fp8(a.z, 1.0f, true), __builtin_bit_cast(pg_h2, xh[5]), s1, false);
    s0 = __builtin_amdgcn_fdot2(__builtin_amdgcn_cvt_scalef32_pk_f16_fp8(a.w, 1.0f, false), __builtin_bit_cast(pg_h2, xh[6]), s0, false);
    s1 = __builtin_amdgcn_fdot2(__builtin_amdgcn_cvt_scalef32_pk_f16_fp8(a.w, 1.0f, true), __builtin_bit_cast(pg_h2, xh[7]), s1, false);
    return s0 + s1;
}
#endif
__device__ __forceinline__ void axpy16q(const uint4 a, float s, float (&y)[16]) {
    float t[4];
    dec4fp8(a.x, t); y[0] += s * t[0]; y[1] += s * t[1]; y[2] += s * t[2]; y[3] += s * t[3];
    dec4fp8(a.y, t); y[4] += s * t[0]; y[5] += s * t[1]; y[6] += s * t[2]; y[7] += s * t[3];
    dec4fp8(a.z, t); y[8] += s * t[0]; y[9] += s * t[1]; y[10] += s * t[2]; y[11] += s * t[3];
    dec4fp8(a.w, t); y[12] += s * t[0]; y[13] += s * t[1]; y[14] += s * t[2]; y[15] += s * t[3];
}
#ifdef CPU_EMU
__device__ __forceinline__ float lane_xor(float v, int mask, float* scr) { const int tid = tid_(); scr[tid] = v; __syncthreads(); const float r = scr[tid ^ mask]; __syncthreads(); return r; }
__device__ __forceinline__ float lane_bcast(float v, int src, float* scr) { const int tid = tid_(); scr[tid] = v; __syncthreads(); const float r = scr[(tid & ~63) + src]; __syncthreads(); return r; }
#else
__device__ __forceinline__ float lane_xor(float v, int mask, float*) { return mask == 1 ? dpp_f<0xB1>(v) : (mask == 2 ? dpp_f<0x4E>(v) : __shfl_xor(v, mask)); }
__device__ __forceinline__ float lane_bcast(float v, int src, float*) { return __builtin_bit_cast(float, __builtin_amdgcn_readlane(__builtin_bit_cast(int, v), src)); }
#endif
__device__ __forceinline__ float reduce8(const float (&v)[8], int lane, float* scr) {
    const bool b0 = lane & 1, b1 = lane & 2, b2 = lane & 4;
    float w4[4], u2[2];
#pragma unroll
    for (int j = 0; j < 4; ++j) { const float keep = b0 ? v[2 * j + 1] : v[2 * j], send = b0 ? v[2 * j] : v[2 * j + 1]; w4[j] = keep + lane_xor(send, 1, scr); }
#pragma unroll
    for (int j = 0; j < 2; ++j) { const float keep = b1 ? w4[2 * j + 1] : w4[2 * j], send = b1 ? w4[2 * j] : w4[2 * j + 1]; u2[j] = keep + lane_xor(send, 2, scr); }
    float z = (b2 ? u2[1] : u2[0]) + lane_xor(b2 ? u2[0] : u2[1], 4, scr);
    z += lane_xor(z, 8, scr); z += lane_xor(z, 16, scr); z += lane_xor(z, 32, scr);
    return z;
}
#ifdef CPU_EMU
#define PG_WSYNC() __syncthreads()
#else
#define PG_WSYNC() do { __builtin_amdgcn_fence(__ATOMIC_RELEASE, "wavefront"); __builtin_amdgcn_wave_barrier(); __builtin_amdgcn_fence(__ATOMIC_ACQUIRE, "wavefront"); } while (0)
#endif
__device__ __forceinline__ void stage_peer_gather(KParams p, int l, char* smem) {
    int tid = tid_(), w = tid >> 6, lane = tid & 63;
    float* base; float* tops_s; float* cand_s; float* best_s; int* idx_s; float* gate_s;
#define PG_ROLES() do { tid = tid_(); w = tid >> 6; lane = tid & 63; base = (float*)smem + w * 2048; tops_s = base; cand_s = tops_s + 256; best_s = cand_s + 512; \
        idx_s = (int*)(best_s + 128); gate_s = (float*)(idx_s + 128); } while (0)
    PG_ROLES();
    float* scr = (float*)smem + 8 * 2048;
    h16_t* ACT = (h16_t*)(p->ws + OFF_ACT);
    const float* TOPS = (const float*)(p->ws + OFF_TOPS);
    char* ws = p->ws;
    const float* nxt_w = (l + 1 < NL_) ? p->in[I_NMIX] + (l + 1) * 1024 : p->in[I_NFINAL];
    const int nwaves = gridDim.x * 8;
    for (int m = bid_() * 8 + w; m < M_; m += nwaves) {
        PG_ROLES();
        PG_WSYNC();
        *(float4*)(tops_s + lane * 4) = *(const float4*)(TOPS + (size_t)m * 256 + lane * 4);
        unsigned x[8];
        { const uint4 x0 = *(const uint4*)(ACT + (size_t)m * LDZ + C_XN + lane * 16), x1 = *(const uint4*)(ACT + (size_t)m * LDZ + C_XN + lane * 16 + 8);
          x[0] = x0.x; x[1] = x0.y; x[2] = x0.z; x[3] = x0.w; x[4] = x1.x; x[5] = x1.y; x[6] = x1.z; x[7] = x1.w; }
        PG_WSYNC();
        int ci = 0, cj = 0;
        peer_cand(lane < 50 ? lane : 0, ci, cj);
#pragma unroll
        for (int hd = 0; hd < 8; ++hd) cand_s[hd * 64 + lane] = lane < 50 ? tops_s[hd * 32 + ci] + tops_s[hd * 32 + 16 + cj] : -3.0e38f;
        PG_WSYNC();
#pragma unroll 1
        for (int hd = 0; hd < 8; ++hd) {
            const float cs = cand_s[hd * 64 + lane];
            int cnt = 0;
#pragma unroll
            for (int q = 0; q < 13; ++q) {
                const float4 c4 = *(const float4*)(cand_s + hd * 64 + q * 4);
                cnt += (int)(c4.x > cs) + (int)(c4.y > cs) + (int)(c4.z > cs) + (int)(c4.w > cs);
            }
            if (group_sum(lane < 50 ? (float)cnt : 0.f, 64, scr) != 1225.0f) {
                cnt = 0;
#pragma unroll 1
                for (int o = 0; o < 50; ++o) { const float ov = cand_s[hd * 64 + o]; cnt += (int)((ov > cs) | ((ov == cs) & (o < lane))); }
                if (lane >= 50) cnt = 64;
            }
            if (cnt < 16) {
                best_s[hd * 16 + cnt] = cs;
                const int n0 = 127 - (int)(__float_as_uint(tops_s[hd * 32 + ci]) & 127u), n1 = 127 - (int)(__float_as_uint(tops_s[hd * 32 + 16 + cj]) & 127u);
                idx_s[hd * 16 + cnt] = n0 * 128 + n1;
            }
        }
        PG_WSYNC();
#pragma unroll
        for (int rr = 0; rr < 2; ++rr) {
            const int e = lane + 64 * rr, hd = e >> 4;
            const float mx = best_s[hd * 16];
            float sum = 0.f;
#pragma unroll
            for (int i = 0; i < 16; ++i) sum += fexp_(best_s[hd * 16 + i] - mx);
            gate_s[e] = fexp_(best_s[e] - mx) / sum;
        }
        PG_WSYNC();
        float y[16];
#pragma unroll
        for (int i = 0; i < 16; ++i) y[i] = 0.f;
        PG_ROLES();
        uint4 uu[8], vv[8];
#define PG_LOADU(eb_) do { _Pragma("unroll") for (int k = 0; k < 8; ++k) uu[k] = *(const uint4*)(tab_row(ws, idx_s[(eb_) + k]) + lane * 16); } while (0)
#define PG_LOADV(eb_) do { _Pragma("unroll") for (int k = 0; k < 8; ++k) vv[k] = *(const uint4*)(tab_row(ws, idx_s[(eb_) + k]) + 1024 + lane * 16); } while (0)
        PG_LOADU(0); PG_LOADV(0);
#pragma unroll 1
        for (int eb = 0; eb < 128; eb += 8) {
            float d8[8];
#pragma unroll
            for (int k = 0; k < 8; ++k) d8[k] = dot16q(uu[k], x);
            if (eb + 8 < 128) PG_LOADU(eb + 8);
            const float tot = reduce8(d8, lane, scr);
            const float hk = gate_s[eb + (lane & 7)] * geluf_(tot * (1.0f / TAB_SU));
#pragma unroll
            for (int k = 0; k < 8; ++k) axpy16q(vv[k], lane_bcast(hk, k, scr), y);
            if (eb + 8 < 128) PG_LOADV(eb + 8);
        }
#undef PG_LOADU
#undef PG_LOADV
        PG_ROLES();
        float* op = p->out + (size_t)m * 1024 + lane * 16;
        float hn[16]; float ss = 0.f;
#pragma unroll
        for (int i = 0; i < 16; i += 4) {
            const float4 o4 = *(const float4*)(op + i);
            hn[i] = o4.x + y[i] * (1.0f / TAB_SV); hn[i + 1] = o4.y + y[i + 1] * (1.0f / TAB_SV); hn[i + 2] = o4.z + y[i + 2] * (1.0f / TAB_SV); hn[i + 3] = o4.w + y[i + 3] * (1.0f / TAB_SV);
            ss += hn[i] * hn[i] + hn[i + 1] * hn[i + 1] + hn[i + 2] * hn[i + 2] + hn[i + 3] * hn[i + 3];
        }
        ss = group_sum(ss, 64, scr);
        const float rstd = rsqrtf(ss * (1.0f / D_) + RMS_EPS);
        float nv[16];
#pragma unroll
        for (int i = 0; i < 16; i += 4) { const float4 w4 = *(const float4*)(nxt_w + lane * 16 + i); nv[i] = hn[i] * rstd * w4.x; nv[i + 1] = hn[i + 1] * rstd * w4.y; nv[i + 2] = hn[i + 2] * rstd * w4.z; nv[i + 3] = hn[i + 3] * rstd * w4.w; }
        if (l + 1 < NL_) {
#pragma unroll
            for (int i = 0; i < 16; i += 4) *(float4*)(op + i) = make_float4(hn[i], hn[i + 1], hn[i + 2], hn[i + 3]);
            const float n0[8] = {nv[0], nv[1], nv[2], nv[3], nv[4], nv[5], nv[6], nv[7]}, n1[8] = {nv[8], nv[9], nv[10], nv[11], nv[12], nv[13], nv[14], nv[15]};
            store8h(ACT + (size_t)m * LDZ + C_XN + lane * 16, n0); store8h(ACT + (size_t)m * LDZ + C_XN + lane * 16 + 8, n1);
        } else {
#pragma unroll
            for (int i = 0; i < 16; i += 4) *(float4*)(op + i) = make_float4(nv[i], nv[i + 1], nv[i + 2], nv[i + 3]);
        }
    }
}
#undef PG_ROLES
#undef PG_WSYNC

enum { PH_NORM_MIX = 0, PH_INPROJ, PH_MIXERS, PH_MERGE, PH_WOUT, PH_NORM_FFN, PH_QUERY, PH_TOPK, PH_GATHER, PH_PER_LAYER, PH_FINAL = 100, PH_WPREP = 101 };
__device__ __forceinline__ void run_phase(KParams p, int l, int ph, char* smem) {
    h16_t* ACT = (h16_t*)(p->ws + OFF_ACT);
    const float* hin = l == 0 ? p->in[I_X] : p->out;
    switch (ph) {
    case PH_WPREP: stage_wprep(p, smem); break;
    case PH_NORM_MIX: if (l == 0) stage_rmsnorm(hin, p->in[I_NMIX] + l * 1024, ACT + C_XN, LDZ, smem); break;
    case PH_INPROJ: stage_gemm(p, l, GP_INPROJ, smem); break;
    case PH_MIXERS: {
        const int nb = gridDim.x, n_rw = nb / 2, n_gd = nb / 4, n_lr = nb - n_rw - n_gd;
        stage_rwkv(p, l, smem, 0, n_rw);
        stage_gdn(p, l, smem, n_rw, n_gd);
        stage_lru(p, l, smem, n_rw + n_gd, n_lr);
        stage_tabconv(p, l, n_rw + n_gd, n_lr);
    } break;
    case PH_MERGE: stage_gemm(p, l, GP_MERGE, smem); break;
    case PH_WOUT: stage_gemm(p, l, GP_WOUT, smem); break;
    case PH_NORM_FFN: stage_rmsnorm(p->out, p->in[I_NFFN] + l * 1024, ACT + C_XN, LDZ, smem); break;
    case PH_QUERY: stage_gemm(p, l, GP_QUERY, smem); break;
    case PH_TOPK: stage_peer_topk(p, l, smem); break;
    case PH_GATHER: stage_peer_gather(p, l, smem); break;
    case PH_FINAL: break;
    default: break;
    }
}


#if !defined(CPU_EMU) && !MK_MULTI
#define XB_TMO      128
#define XB_XCNT(j)  (256  + 64 * (j))
#define XB_XSUB(j)  (1280 + 64 * (j))
#define XB_XGEN(j)  (2304 + 64 * (j))
#define XB_TOP      3328
#define XB_TOPGEN   3392
#define XCD_BAR_WORDS 3456
#define XB_SPIN_CAP (1u << 22)
#define XB_LAS __attribute__((address_space(3)))
__device__ __forceinline__ unsigned xb_ld(unsigned* p)              { return __hip_atomic_load(p, __ATOMIC_RELAXED, __HIP_MEMORY_SCOPE_AGENT); }
__device__ __forceinline__ unsigned xb_add(unsigned* p, unsigned v) { return __hip_atomic_fetch_add(p, v, __ATOMIC_RELAXED, __HIP_MEMORY_SCOPE_AGENT); }
__device__ __forceinline__ unsigned xb_xcc_id() { return (unsigned)__builtin_amdgcn_s_getreg((3 << 11) | 20) & 0xFu; }
#define XB_SPIN(cond, bar) do { unsigned _sp = 0; while (cond) { __builtin_amdgcn_s_sleep(1); \
    if ((++_sp & 255u) == 0u) { if (xb_ld(&(bar)[XB_TMO])) break; if (_sp > XB_SPIN_CAP) { atomicAdd(&(bar)[XB_TMO], 1u); break; } } } } while (0)
struct XcdBarrier { unsigned* bar; unsigned x; volatile XB_LAS unsigned* st; };
__device__ __forceinline__ XcdBarrier xcd_barrier_post(unsigned* bar, volatile XB_LAS unsigned* st) {
    XcdBarrier b; b.bar = bar; b.x = xb_xcc_id(); b.st = st;
    if (threadIdx.x == 0) (void)xb_add(&bar[XB_XCNT(b.x)], 1u);
    return b;
}
__device__ __forceinline__ void xcd_barrier_complete(unsigned* bar, unsigned x, unsigned& nloc, unsigned& nx) {
    const unsigned G = gridDim.x * gridDim.y * gridDim.z;
    unsigned sum, cnt, mine, sp = 0u;
    for (;;) {
        sum = 0u; cnt = 0u; mine = 0u;
#pragma unroll
        for (unsigned j = 0; j < 16; ++j) { const unsigned c = xb_ld(&bar[XB_XCNT(j)]); sum += c; cnt += (c > 0u) ? 1u : 0u; mine = (j == x) ? c : mine; }
        if (sum == G) break;
        __builtin_amdgcn_s_sleep(1);
        if ((++sp & 255u) == 0u) { if (xb_ld(&bar[XB_TMO])) break; if (sp > XB_SPIN_CAP) { atomicAdd(&bar[XB_TMO], 1u); break; } }
    }
    nloc = mine > 0u ? mine : 1u; nx = cnt > 0u ? cnt : 1u;
}
__device__ __forceinline__ void xcd_barrier(const XcdBarrier& b) {
    asm volatile("s_waitcnt vmcnt(0)" ::: "memory");
    __syncthreads();
    if (threadIdx.x == 0) {
        unsigned* bar = b.bar;
        __builtin_amdgcn_s_waitcnt(0);
        unsigned nloc = b.st[0], nx = b.st[1];
        if (nloc == 0u) { xcd_barrier_complete(bar, b.x, nloc, nx); b.st[0] = nloc; b.st[1] = nx; }
        const unsigned old = xb_add(&bar[XB_XSUB(b.x)], 1u);
        const unsigned gen = old / nloc;
        if (old + 1u == (gen + 1u) * nloc) {
            __builtin_amdgcn_fence(__ATOMIC_RELEASE, "agent");
            asm volatile("s_waitcnt vmcnt(0)" ::: "memory");
            const unsigned og = xb_add(&bar[XB_TOP], 1u);
            const unsigned tg = og / nx;
            if (og + 1u == (tg + 1u) * nx) xb_add(&bar[XB_TOPGEN], 1u);
            else XB_SPIN(xb_ld(&bar[XB_TOPGEN]) == tg, bar);
            __builtin_amdgcn_fence(__ATOMIC_ACQUIRE, "agent");
            xb_add(&bar[XB_XGEN(b.x)], 1u);
            asm volatile("s_waitcnt vmcnt(0)" ::: "memory");
        } else {
            XB_SPIN(xb_ld(&bar[XB_XGEN(b.x)]) == gen, bar);
            __builtin_amdgcn_fence(__ATOMIC_ACQUIRE, "agent");
            asm volatile("s_waitcnt vmcnt(0)" ::: "memory");
        }
    }
    __syncthreads();
}
#endif
#if !defined(CPU_EMU) && !MK_MULTI
__global__ void __launch_bounds__(512, 2) k_mega(Params p_) {
    DYN_SMEM(smem);
    KParams pk = (KParams)__builtin_amdgcn_kernarg_segment_ptr();
    cg::grid_group grid = cg::this_grid();
    volatile XB_LAS unsigned* xst = (volatile XB_LAS unsigned*)(XB_LAS char*)(smem + SMEM_BYTES);
    if (threadIdx.x == 0) { xst[0] = 0u; xst[1] = 0u; xst[2] = 0u; xst[3] = 0u; }
    __syncthreads();
    const XcdBarrier xb = xcd_barrier_post((unsigned*)(pk->ws + OFF_BAR), xst);
    if (gridDim.x > 0x100000u) grid.sync();
    constexpr int NIT = NL_ * PH_PER_LAYER;
#pragma unroll 1
    for (int it = -1; it <= NIT; ++it) {
        const int l = (it >= 0 && it < NIT) ? it / PH_PER_LAYER : 0, ph = it < 0 ? (int)PH_WPREP : (it < NIT ? it % PH_PER_LAYER : (int)PH_FINAL);
        KParams q = pk; asm volatile("" : "+s"(q));
        run_phase(q, l, ph, smem);
        if (it >= 0 && it < NIT - 1 && !(l > 0 && ph == PH_NORM_MIX)) {
            xcd_barrier(xb);
        }
    }
}
#endif
#ifdef CPU_EMU
__global__ void k_phase(Params p_, int l, int ph) { DYN_SMEM(smem); run_phase(&p_, l, ph, smem); }
#elif MK_MULTI
__global__ void __launch_bounds__(512, 2) k_phase(Params p_, int l, int ph) { DYN_SMEM(smem); KParams pk = (KParams)__builtin_amdgcn_kernarg_segment_ptr(); run_phase(pk, l, ph, smem); }
#endif
}

#ifdef CPU_EMU
int g_emu_stop = 1000;
#endif

extern "C" void kernel_launch(void* const* d_in, const int* in_sizes, int n_in, void* d_out, int out_size, void* d_ws, size_t ws_size, hipStream_t stream) {
    Params p{};
    for (int i = 0; i < N_IN; ++i) p.in[i] = (const float*)d_in[i];
    p.out = (float*)d_out; p.ws = (char*)d_ws;
#if defined(CPU_EMU) || MK_MULTI
    const int grid = 256;
    LAUNCH(k_phase, grid, NT, SMEM_BYTES, stream, p, 0, (int)PH_WPREP);
    for (int l = 0; l < NL_; ++l)
        for (int ph = 0; ph < PH_PER_LAYER; ++ph) {
            LAUNCH(k_phase, grid, NT, SMEM_BYTES, stream, p, l, ph);
#ifdef CPU_EMU
            const int code = ph == PH_INPROJ ? 1 : ph == PH_MIXERS ? 2 : ph == PH_MERGE ? 3 : ph == PH_WOUT ? 4 : ph == PH_GATHER ? 5 : 0;
            if (code && g_emu_stop == l * 10 + code) return;
#endif
        }
    LAUNCH(k_phase, grid, NT, SMEM_BYTES, stream, p, 0, (int)PH_FINAL);
#else
    static int grid_blocks = 0;
    if (!grid_blocks) {
        int dev = 0, cus = 0, per_cu = 0;
        (void)hipGetDevice(&dev);
        (void)hipDeviceGetAttribute(&cus, hipDeviceAttributeMultiprocessorCount, dev);
        (void)hipFuncSetAttribute((const void*)k_mega, hipFuncAttributeMaxDynamicSharedMemorySize, (int)SMEM_BYTES + 16);
        (void)hipOccupancyMaxActiveBlocksPerMultiprocessor(&per_cu, k_mega, NT, SMEM_BYTES + 16);
        if (per_cu > 1) per_cu = 1;
        grid_blocks = cus * per_cu;
    }
    (void)hipMemsetAsync((char*)d_ws + OFF_BAR, 0, 16384, stream);
    void* args[] = {&p};
    hipError_t e = hipLaunchCooperativeKernel((void*)k_mega, dim3(grid_blocks), dim3(NT), args, SMEM_BYTES + 16, stream);
    if (e != hipSuccess) fprintf(stderr, "cooperative launch failed: %s (grid %d)\n", hipGetErrorString(e), grid_blocks);
#endif
}
```

```cpp
#ifndef CPU_EMU
#include <hip/hip_runtime.h>
#include <hip/hip_cooperative_groups.h>
#include <cstdio>
#include <cstdint>
namespace cg = cooperative_groups;
#define DYN_SMEM(name) extern __shared__ __attribute__((aligned(16))) char name[]
#define LAUNCH(kern, grid, block, smem, stream, ...) hipLaunchKernelGGL(kern, dim3(grid), dim3(block), smem, stream, __VA_ARGS__)
#endif

#ifndef CFG_B
#define CFG_B 8
#endif
#ifndef CFG_T
#define CFG_T 2048
#endif
#ifndef MK_MULTI
#define MK_MULTI 0
#endif

namespace {
constexpr int B_ = CFG_B, T_ = CFG_T, M_ = B_ * T_, D_ = 1024, NL_ = 2, NT = 512;
constexpr int INW = 12560;
constexpr int LDZ = 11776;
constexpr int Z_ULRU = 0, Z_GLRU = 1024, Z_Q = 2048, Z_K = 3072, Z_V = 4096, Z_ZG = 5120, Z_RW = 6144, Z_ALPHA = 9472, Z_BETA = 9480;
constexpr int ZN = 9728;
constexpr int C_XN = 9728, C_YC = 10752;
constexpr int C_YA = Z_GLRU, C_YB = Z_ZG;
constexpr int C_GS = Z_Q, C_MG = Z_K;
constexpr int C_QRY = 0;
constexpr int RW_R = 0, RW_K = 1024, RW_V = 2048, RW_WL = 3072, RW_AL = 3136, RW_GL = 3200, RWW = 3328;
constexpr float RMS_EPS = 1e-6f, GN_EPS = 64e-5f;
typedef unsigned short h16_t;

enum { I_X = 0, I_NMIX, I_NFFN, I_NFINAL, I_WIN, I_LCW, I_LCB, I_LWA, I_LBA, I_LWX, I_LBX, I_LLAM, I_GCW, I_GALOG, I_GDT, I_GNW,
       I_RMU, I_RW0, I_RWUP, I_RA0, I_RAUP, I_RGUP, I_RKK, I_RKA, I_RRK, I_RLW, I_RLB, I_MB, I_PL, I_PG, I_PR, I_WOUT, I_PWQ, I_PKEYS, I_PU, I_PV, N_IN };

struct Params {
    const float* in[N_IN];
    float* out;
    char* ws;
};
#ifdef CPU_EMU
typedef const Params* KParams;
#else
typedef const Params __attribute__((address_space(4)))* KParams;
#endif

constexpr size_t al256(size_t x) { return (x + 255) / 256 * 256; }
constexpr size_t OFF_ACT = 0;
constexpr size_t OFF_WT = al256(OFF_ACT + (size_t)M_ * LDZ * 2);
constexpr int WT_IN = 0, WT_MG = ZN, WT_P = WT_MG + 3072, WT_OUT = WT_P + 3072, WT_Q = WT_OUT + 1024, WT_ROWS = WT_Q + 2048;
constexpr size_t OFF_TOPS = al256(OFF_WT + (size_t)NL_ * WT_ROWS * 1024 * 2);
constexpr size_t OFF_TAB = al256(OFF_TOPS + (size_t)M_ * 256 * 4);
constexpr size_t OFF_BAR = OFF_TAB + (size_t)16384 * 2048;
constexpr size_t OFF_PG1 = OFF_BAR + 16384;
constexpr size_t WS_END = OFF_PG1 + (size_t)M_ * 1024;
static_assert(CFG_B != 8 || CFG_T != 2048 || WS_END <= (size_t)512 * 1024 * 1024, "workspace budget");
constexpr size_t SMEM_BYTES = 128 * 1024;

#ifdef CPU_EMU
__device__ __forceinline__ int tid_() { return threadIdx.x; }
__device__ __forceinline__ h16_t f2h(float f) { return (h16_t)_cvtss_sh(f, _MM_FROUND_TO_NEAREST_INT); }
__device__ __forceinline__ float h2f(h16_t h) { return _cvtsh_ss(h); }
#else
__device__ __forceinline__ int tid_() { int t = threadIdx.x; asm volatile("" : "+v"(t)); return t; }
__device__ __forceinline__ h16_t f2h(float f) { return __builtin_bit_cast(unsigned short, (_Float16)f); }
__device__ __forceinline__ float h2f(h16_t h) { return (float)__builtin_bit_cast(_Float16, h); }
#endif
__device__ __forceinline__ int bid_() { return (int)blockIdx.x; }

#ifdef CPU_EMU
__device__ __forceinline__ float fexp_(float x) { return expf(x); }
__device__ __forceinline__ float flog_(float x) { return logf(x); }
__device__ __forceinline__ float frcp_(float x) { return 1.0f / x; }
#else
__device__ __forceinline__ float fexp_(float x) { return __builtin_amdgcn_exp2f(x * 1.4426950408889634f); }
__device__ __forceinline__ float flog_(float x) { return __builtin_amdgcn_logf(x) * 0.6931471805599453f; }
__device__ __forceinline__ float frcp_(float x) { return __builtin_amdgcn_rcpf(x); }
#endif
__device__ __forceinline__ float sigmoidf_(float x) { return frcp_(1.0f + fexp_(-x)); }
__device__ __forceinline__ float softplusf_(float x) { return fmaxf(x, 0.0f) + flog_(1.0f + fexp_(-fabsf(x))); }
__device__ __forceinline__ float siluf_(float x) { return x * sigmoidf_(x); }
__device__ __forceinline__ float tanhf_(float x) { return 1.0f - 2.0f * frcp_(1.0f + fexp_(2.0f * x)); }
__device__ __forceinline__ float geluf_(float x) { return x * frcp_(1.0f + fexp_(-1.5957691216057308f * (x + 0.044715f * x * x * x))); }
__device__ __forceinline__ unsigned pack2h(float a, float b) { return (unsigned)f2h(a) | ((unsigned)f2h(b) << 16); }
__device__ __forceinline__ void store8h(h16_t* p, const float (&v)[8]) {
    uint4 w; w.x = pack2h(v[0], v[1]); w.y = pack2h(v[2], v[3]); w.z = pack2h(v[4], v[5]); w.w = pack2h(v[6], v[7]);
    *(uint4*)p = w;
}
__device__ __forceinline__ void unpack8h(const uint4 w, float (&v)[8]) {
    v[0] = h2f((h16_t)(w.x & 0xffffu)); v[1] = h2f((h16_t)(w.x >> 16)); v[2] = h2f((h16_t)(w.y & 0xffffu)); v[3] = h2f((h16_t)(w.y >> 16));
    v[4] = h2f((h16_t)(w.z & 0xffffu)); v[5] = h2f((h16_t)(w.z >> 16)); v[6] = h2f((h16_t)(w.w & 0xffffu)); v[7] = h2f((h16_t)(w.w >> 16));
}
__device__ __forceinline__ void load8h(const h16_t* p, float (&v)[8]) {
    const uint4 w = *(const uint4*)p;
    v[0] = h2f((h16_t)(w.x & 0xffffu)); v[1] = h2f((h16_t)(w.x >> 16)); v[2] = h2f((h16_t)(w.y & 0xffffu)); v[3] = h2f((h16_t)(w.y >> 16));
    v[4] = h2f((h16_t)(w.z & 0xffffu)); v[5] = h2f((h16_t)(w.z >> 16)); v[6] = h2f((h16_t)(w.w & 0xffffu)); v[7] = h2f((h16_t)(w.w >> 16));
}

__device__ __forceinline__ float block_sum512(float v, float* red) {
    const int tid = tid_();
    red[tid] = v;
    __syncthreads();
    if (tid < 32) { float s = 0.f; for (int i = 0; i < 16; ++i) s += red[tid * 16 + i]; red[512 + tid] = s; }
    __syncthreads();
    float tot = 0.f;
    for (int i = 0; i < 32; ++i) tot += red[512 + i];
    __syncthreads();
    return tot;
}

#ifdef CPU_EMU
__device__ __forceinline__ float wave_sum64(float v, float* scr) {
    const int tid = tid_();
    scr[tid] = v; __syncthreads();
    float s = 0.f; const int base = tid & ~63;
    for (int i = 0; i < 64; ++i) s += scr[base + i];
    __syncthreads();
    return s;
}
#else
__device__ __forceinline__ float wave_sum64(float v, float*) {
    v += __builtin_bit_cast(float, __builtin_amdgcn_mov_dpp(__builtin_bit_cast(int, v), 0xB1, 0xf, 0xf, true));
    v += __builtin_bit_cast(float, __builtin_amdgcn_mov_dpp(__builtin_bit_cast(int, v), 0x4E, 0xf, 0xf, true));
    v += __builtin_bit_cast(float, __builtin_amdgcn_mov_dpp(__builtin_bit_cast(int, v), 0x141, 0xf, 0xf, true));
    v += __builtin_bit_cast(float, __builtin_amdgcn_mov_dpp(__builtin_bit_cast(int, v), 0x140, 0xf, 0xf, true));
    v += __builtin_bit_cast(float, __builtin_amdgcn_update_dpp(0, __builtin_bit_cast(int, v), 0x142, 0xa, 0xf, false));
    v += __builtin_bit_cast(float, __builtin_amdgcn_update_dpp(0, __builtin_bit_cast(int, v), 0x143, 0xc, 0xf, false));
    return __builtin_bit_cast(float, __builtin_amdgcn_readlane(__builtin_bit_cast(int, v), 63));
}
#endif
__device__ __forceinline__ void stage_rmsnorm(const float* src, const float* w, h16_t* dst, int ldd, char* smem) {
    float* scr = (float*)smem;
    const int tid = tid_(), lane = tid & 63, wv = tid >> 6;
    const int nw = gridDim.x * 8;
    float4 wv4[4];
#pragma unroll
    for (int i = 0; i < 4; ++i) wv4[i] = *(const float4*)(w + lane * 16 + i * 4);
    for (int row = bid_() * 8 + wv; row < M_; row += 2 * nw) {
        const int row2 = row + nw; const bool has2 = row2 < M_;
        float4 a[4], b[4];
#pragma unroll
        for (int i = 0; i < 4; ++i) { a[i] = *(const float4*)(src + (size_t)row * D_ + lane * 16 + i * 4); b[i] = has2 ? *(const float4*)(src + (size_t)row2 * D_ + lane * 16 + i * 4) : make_float4(0.f, 0.f, 0.f, 0.f); }
        float sa = 0.f, sb = 0.f;
#pragma unroll
        for (int i = 0; i < 4; ++i) { sa += a[i].x * a[i].x + a[i].y * a[i].y + a[i].z * a[i].z + a[i].w * a[i].w; sb += b[i].x * b[i].x + b[i].y * b[i].y + b[i].z * b[i].z + b[i].w * b[i].w; }
        sa = wave_sum64(sa, scr); sb = wave_sum64(sb, scr);
        const float ra = rsqrtf(sa * (1.0f / D_) + RMS_EPS), rb = rsqrtf(sb * (1.0f / D_) + RMS_EPS);
#pragma unroll
        for (int i = 0; i < 4; i += 2) {
            const float va[8] = {a[i].x * ra * wv4[i].x, a[i].y * ra * wv4[i].y, a[i].z * ra * wv4[i].z, a[i].w * ra * wv4[i].w, a[i + 1].x * ra * wv4[i + 1].x, a[i + 1].y * ra * wv4[i + 1].y, a[i + 1].z * ra * wv4[i + 1].z, a[i + 1].w * ra * wv4[i + 1].w};
            store8h(dst + (size_t)row * ldd + lane * 16 + i * 4, va);
            if (has2) {
                const float vb[8] = {b[i].x * rb * wv4[i].x, b[i].y * rb * wv4[i].y, b[i].z * rb * wv4[i].z, b[i].w * rb * wv4[i].w, b[i + 1].x * rb * wv4[i + 1].x, b[i + 1].y * rb * wv4[i + 1].y, b[i + 1].z * rb * wv4[i + 1].z, b[i + 1].w * rb * wv4[i + 1].w};
                store8h(dst + (size_t)row2 * ldd + lane * 16 + i * 4, vb);
            }
        }
    }
}

__device__ __forceinline__ const float* wt_src(KParams p, int l, int r, int& ld) {
    if (r < ZN) {
        ld = INW;
        int c;
        if (r < 6144) c = r; else if (r < 9472) c = r + 16; else if (r < 9488) c = r - 3328; else return nullptr;
        return p->in[I_WIN] + (size_t)l * 1024 * INW + c;
    }
    r -= ZN;
    if (r < 3072) { ld = INW; return p->in[I_WIN] + (size_t)l * 1024 * INW + 9488 + r; }
    r -= 3072;
    if (r < 3072) { ld = 1024; const int br = r >> 10; return p->in[br == 0 ? I_PL : (br == 1 ? I_PG : I_PR)] + (size_t)l * 1024 * 1024 + (r & 1023); }
    r -= 3072;
    if (r < 1024) { ld = 1024; return p->in[I_WOUT] + (size_t)l * 1024 * 1024 + r; }
    r -= 1024;
    ld = 2048; return p->in[I_PWQ] + (size_t)l * 1024 * 2048 + r;
}
__device__ __forceinline__ void stage_wprep(KParams p, char* smem) {
    float* tile = (float*)smem;
    h16_t* WT = (h16_t*)(p->ws + OFF_WT);
    const int tid = tid_();
    const int ntr = WT_ROWS / 64, total = NL_ * ntr * 16;
    for (int it = bid_(); it < total; it += gridDim.x) {
        const int l = it / (ntr * 16), rem = it % (ntr * 16), rt = rem / 16, kt = rem % 16;
        const int r0 = rt * 64, k0 = kt * 64;
        __syncthreads();
        {
            const int nn = tid & 63;
            int ld = 0; const float* src = wt_src(p, l, r0 + nn, ld);
#pragma unroll
            for (int i = 0; i < 8; ++i) { const int kk = (tid >> 6) + 8 * i; tile[kk * 65 + nn] = src ? src[(size_t)(k0 + kk) * ld] : 0.f; }
        }
        __syncthreads();
        {
            const int r = tid >> 3, kq = (tid & 7) * 8;
            float v[8];
#pragma unroll
            for (int j = 0; j < 8; ++j) v[j] = tile[(kq + j) * 65 + r];
            store8h(WT + ((size_t)l * WT_ROWS + r0 + r) * 1024 + k0 + kq, v);
        }
    }
}

namespace pg8 {
constexpr int BM = 256, BK = 64, HALF = 128, HTB = HALF * BK * 2, STAGE_BYTES = 8 * HTB, NXCD = 8, WGM = 8;
struct Unit { const char* A; const char* B; int pm, pn, kind; };
#ifdef CPU_EMU
struct f32x4 { float d[4]; float& operator[](int i) { return d[i]; } const float& operator[](int i) const { return d[i]; } };
#else
#define PG8_LAS __attribute__((address_space(3)))
typedef _Float16 f16x8 __attribute__((ext_vector_type(8)));
typedef float f32x4 __attribute__((ext_vector_type(4)));
__device__ __forceinline__ int lds_byte(int r, int c) { const int st = (r >> 4) * 2 + (c >> 5), rr = r & 15, cc = c & 31, ob = rr * 64 + cc * 2; return st * 1024 + (ob ^ (((ob >> 9) & 1) << 5)); }
__device__ __forceinline__ void stage_rc(int b, int& R, int& C) { const int st = b / 1024, sb = b % 1024, swz = sb ^ (((sb >> 9) & 1) << 5); R = (st >> 1) * 16 + swz / 64; C = (st & 1) * 32 + (swz % 64) / 2; }
__device__ __forceinline__ int perm32(int rho) { const int n = rho >> 4, i = rho & 15; return 8 * (i >> 2) + 4 * n + (i & 3); }
#endif
__device__ __forceinline__ void tile_of(int L, int nM, int nN, int& pm, int& pn) {
    const int nwg = nM * nN;
    int wgid = L; { const int q = nwg / NXCD, r = nwg % NXCD, xcd = wgid % NXCD, off = wgid / NXCD; wgid = (xcd < r ? xcd * (q + 1) : r * (q + 1) + (xcd - r) * q) + off; }
    const int nig = WGM * nN, gid = wgid / nig, fm = gid * WGM, gsz = (nM - fm) < WGM ? (nM - fm) : WGM;
    pm = fm + ((wgid % nig) % gsz); pn = (wgid % nig) / gsz;
}

template <class Sched, class Epi>
__device__ __forceinline__ void gemm_phase(char* smem, const Sched& S, const Epi& E) {
    constexpr int K = 1024, nt = K / BK;
    constexpr unsigned lda = LDZ, ldb = 1024;
#ifdef CPU_EMU
    const int tid = tid_(), wid = tid >> 6, lane = tid & 63, wr = wid >> 2, wc = wid & 3, fr = lane & 15, fq = lane >> 4;
    Unit u;
    for (int ui = 0; S.next(ui, u); ++ui) {
        f32x4 acc[2][2][4][2];
        for (int ai = 0; ai < 2; ++ai) for (int bj = 0; bj < 2; ++bj) for (int m = 0; m < 4; ++m) for (int n = 0; n < 2; ++n) for (int e = 0; e < 4; ++e) {
            const int r = 128 * ai + 64 * wr + 16 * m + fr, c = 128 * bj + 32 * wc + 8 * fq + 4 * n + e;
            const h16_t* a = (const h16_t*)u.A + (size_t)r * lda; const h16_t* b = (const h16_t*)u.B + (size_t)c * ldb;
            float s = 0.f;
            for (int k = 0; k < K; ++k) s += h2f(a[k]) * h2f(b[k]);
            acc[ai][bj][m][n][e] = s;
        }
        E(acc, u, wr, wc, fr, fq);
    }
    (void)smem; (void)nt;
#else
    PG8_LAS unsigned char* lds = (PG8_LAS unsigned char*)smem;
    const int tid = tid_(), wid = __builtin_amdgcn_readfirstlane(tid >> 6), lane = tid & 63, wr = wid >> 2, wc = wid & 3, fr = lane & 15, fq = lane >> 4;
    unsigned voffA[2], voffB[2];
#pragma unroll
    for (int i = 0; i < 2; ++i) { int R, C; stage_rc(tid * 16 + i * 8192, R, C); const int Rb = (R & ~31) + perm32(R & 31);
        voffA[i] = (unsigned)(R * lda + C) * 2u; voffB[i] = (unsigned)(Rb * ldb + C) * 2u; }
    constexpr size_t kstep = (size_t)(BK * 2);
    constexpr size_t hstepA = (size_t)HALF * lda * 2, hstepB = (size_t)HALF * ldb * 2;
    const unsigned ldsw = (unsigned)wid * 1024u;
    const int aoff = lds_byte(wr * 64 + fr, fq * 8), boff = lds_byte(wc * 32 + fr, fq * 8);
#define PG8_SA(b, h) (((b) * 2 + (h)) * HTB)
#define PG8_SB(b, h) ((4 + (b) * 2 + (h)) * HTB)
#define PG8_STAGE(bufoff, gbase, voff) do { _Pragma("unroll") for (int _i = 0; _i < 2; ++_i) \
        __builtin_amdgcn_global_load_lds((const unsigned*)((const char*)(gbase) + (voff)[_i]), (PG8_LAS unsigned*)(lds + (bufoff) + ldsw + _i * 8192), 16, 0, 0); } while (0)
#define PG8_LDA(dst, b, h) do { _Pragma("unroll") for (int m = 0; m < 4; ++m) _Pragma("unroll") for (int k = 0; k < 2; ++k) dst[m][k] = *(const PG8_LAS f16x8*)(lds + PG8_SA(b, h) + aoff + m * 2048 + k * 1024); } while (0)
#define PG8_LDB(dst, b, h) do { _Pragma("unroll") for (int n = 0; n < 2; ++n) _Pragma("unroll") for (int k = 0; k < 2; ++k) dst[n][k] = *(const PG8_LAS f16x8*)(lds + PG8_SB(b, h) + boff + n * 2048 + k * 1024); } while (0)
#define PG8_MMA(ai, bj, At, Bt) do { __builtin_amdgcn_s_setprio(1); _Pragma("unroll") for (int m = 0; m < 4; ++m) _Pragma("unroll") for (int n = 0; n < 2; ++n) _Pragma("unroll") for (int k = 0; k < 2; ++k) \
        acc[ai][bj][m][n] = __builtin_amdgcn_mfma_f32_16x16x32_f16(Bt[n][k], At[m][k], acc[ai][bj][m][n], 0, 0, 0); __builtin_amdgcn_s_setprio(0); } while (0)
#define PG8_WAIT_V(n) asm volatile("s_waitcnt vmcnt(" #n ")" ::: "memory")
#define PG8_WAIT_L(n) asm volatile("s_waitcnt lgkmcnt(" #n ")" ::: "memory")
#define PG8_BAR __builtin_amdgcn_s_barrier()
#define PG8_SCHED __builtin_amdgcn_sched_barrier(0)
    Unit cur, nxt; int ui = 0;
    if (!S.next(0, cur)) return;
    f32x4 acc[2][2][4][2];
#pragma unroll
    for (int a = 0; a < 2; ++a)
#pragma unroll
        for (int b = 0; b < 2; ++b)
#pragma unroll
            for (int m = 0; m < 4; ++m)
#pragma unroll
                for (int n = 0; n < 2; ++n) acc[a][b][m][n] = (f32x4){0.f, 0.f, 0.f, 0.f};
    f16x8 At[4][2], B0[2][2], B1[2][2];
    const char* cA = cur.A; const char* cB = cur.B;
    PG8_STAGE(PG8_SB(0, 0), cB, voffB); PG8_STAGE(PG8_SA(0, 0), cA, voffA); PG8_STAGE(PG8_SB(0, 1), cB + hstepB, voffB); PG8_STAGE(PG8_SA(0, 1), cA + hstepA, voffA);
    if (wr == 1) PG8_BAR;
    PG8_WAIT_V(4); PG8_BAR;
    PG8_STAGE(PG8_SB(1, 0), cB + kstep, voffB); PG8_STAGE(PG8_SA(1, 0), cA + kstep, voffA); PG8_STAGE(PG8_SB(1, 1), cB + hstepB + kstep, voffB);
    PG8_WAIT_V(6); PG8_BAR;
    for (;;) {
        const bool has_next = S.next(ui + 1, nxt);
        const char* nA = has_next ? nxt.A : cA; const char* nB = has_next ? nxt.B : cB;
#pragma unroll 1
        for (int t = 0; t < nt; t += 2) {
            const bool last = (t == nt - 2);
            const char* a1 = cA + (size_t)(t + 1) * kstep;
            const char* a2 = last ? nA : cA + (size_t)(t + 2) * kstep; const char* b2 = last ? nB : cB + (size_t)(t + 2) * kstep;
            const char* a3 = a2 + kstep; const char* b3 = b2 + kstep;
            PG8_LDB(B0, 0, 0); PG8_SCHED; PG8_LDA(At, 0, 0); PG8_STAGE(PG8_SA(1, 1), a1 + hstepA, voffA);
            PG8_WAIT_L(8); PG8_BAR; PG8_WAIT_L(0); PG8_MMA(0, 0, At, B0); PG8_BAR; PG8_SCHED;
            PG8_LDB(B1, 0, 1); PG8_STAGE(PG8_SB(0, 0), b2, voffB);
            PG8_BAR; PG8_WAIT_L(0); PG8_MMA(0, 1, At, B1); PG8_BAR;
            PG8_LDA(At, 0, 1); PG8_STAGE(PG8_SA(0, 0), a2, voffA);
            PG8_BAR; PG8_WAIT_L(0); PG8_MMA(1, 0, At, B0); PG8_BAR; PG8_SCHED;
            PG8_STAGE(PG8_SB(0, 1), b2 + hstepB, voffB);
            PG8_WAIT_V(6); PG8_BAR; PG8_MMA(1, 1, At, B1); PG8_BAR;
            PG8_LDB(B0, 1, 0); PG8_SCHED; PG8_LDA(At, 1, 0); PG8_STAGE(PG8_SA(0, 1), a2 + hstepA, voffA);
            PG8_WAIT_L(8); PG8_BAR; PG8_WAIT_L(0); PG8_MMA(0, 0, At, B0); PG8_BAR; PG8_SCHED;
            PG8_LDB(B1, 1, 1); PG8_STAGE(PG8_SB(1, 0), b3, voffB);
            PG8_BAR; PG8_WAIT_L(0); PG8_MMA(0, 1, At, B1); PG8_BAR;
            PG8_LDA(At, 1, 1); PG8_STAGE(PG8_SA(1, 0), a3, voffA);
            PG8_BAR; PG8_WAIT_L(0); PG8_MMA(1, 0, At, B0); PG8_BAR; PG8_SCHED;
            PG8_STAGE(PG8_SB(1, 1), b3 + hstepB, voffB);
            PG8_WAIT_V(6); PG8_BAR; PG8_MMA(1, 1, At, B1); PG8_BAR;
        }
        E(acc, cur, wr, wc, fr, fq);
        if (!has_next) break;
#pragma unroll
        for (int a = 0; a < 2; ++a)
#pragma unroll
            for (int b = 0; b < 2; ++b)
#pragma unroll
                for (int m = 0; m < 4; ++m)
#pragma unroll
                    for (int n = 0; n < 2; ++n) acc[a][b][m][n] = (f32x4){0.f, 0.f, 0.f, 0.f};
        cur = nxt; cA = nA; cB = nB; ++ui;
    }
    PG8_WAIT_V(0);
    if (wr == 0) PG8_BAR;
    PG8_BAR;
#undef PG8_SA
#undef PG8_SB
#undef PG8_STAGE
#undef PG8_LDA
#undef PG8_LDB
#undef PG8_MMA
#undef PG8_WAIT_V
#undef PG8_WAIT_L
#undef PG8_BAR
#undef PG8_SCHED
#endif
}
}

enum { GK_STORE = 0, GK_GATE0, GK_GATE1, GK_GATE2, GK_PROJ0, GK_PROJ1, GK_PROJ2, GK_RESID, GK_PGATE0, GK_PGATE1, GK_PGATE2 };
enum { GP_INPROJ = 0, GP_MERGE, GP_WOUT, GP_QUERY, GP_PREGATE };
struct GemmProg {
    const char* act; const char* wt;
    int which, G, c;
    __device__ __forceinline__ bool next(int i, pg8::Unit& u) const {
        constexpr int nM = M_ / 256;
        constexpr size_t rowA = (size_t)256 * LDZ * 2, rowB = (size_t)256 * 1024 * 2;
        if (which == GP_MERGE) {
            const int L = (i / 3) * G + c, br = i % 3;
            if (L >= nM * 4) return false;
            pg8::tile_of(L, nM, 4, u.pm, u.pn);
            u.A = act + (size_t)(br == 0 ? C_YA : (br == 1 ? C_YB : C_YC)) * 2; u.B = wt + ((size_t)(WT_P + br * 1024) * 1024) * 2; u.kind = GK_PROJ0 + br;
        } else if (which == GP_PREGATE) {
            const int L = (i / 3) * G + c, br = i % 3;
            if (L >= nM * 4) return false;
            pg8::tile_of(L, nM, 4, u.pm, u.pn);
            u.A = act + (size_t)C_XN * 2; u.B = wt + ((size_t)(WT_MG + br * 1024) * 1024) * 2; u.kind = GK_PGATE0 + br;
        } else {
            const int nN = which == GP_INPROJ ? ZN / 256 : (which == GP_WOUT ? 4 : 8);
            const int L = i * G + c;
            if (L >= nM * nN) return false;
            pg8::tile_of(L, nM, nN, u.pm, u.pn);
            u.A = act + (size_t)(which == GP_WOUT ? C_MG : C_XN) * 2;
            u.B = wt + ((size_t)(which == GP_INPROJ ? WT_IN : (which == GP_WOUT ? WT_OUT : WT_Q)) * 1024) * 2;
            u.kind = which == GP_WOUT ? GK_RESID : GK_STORE;
        }
        u.A += (size_t)u.pm * rowA; u.B += (size_t)u.pn * rowB;
        return true;
    }
};
__device__ __forceinline__ int gs_slot(int br) { return br == 0 ? C_GS : (br == 1 ? Z_V : Z_ULRU); }
struct GemmEpi {
    h16_t* act; const float* mb; const float* resid; float* out; unsigned char* pg0; unsigned char* pg1; unsigned char* pg2;
    __device__ __forceinline__ void operator()(const pg8::f32x4 (&acc)[2][2][4][2], const pg8::Unit& u, int wr, int wc, int fr, int fq) const {
        const int row0 = u.pm * 256 + wr * 64 + fr, col0 = u.pn * 256 + wc * 32 + 8 * fq;
        if (u.kind == GK_RESID) {
#pragma unroll
            for (int grp = 0; grp < 4; ++grp) {
                float4 ra[4], rb[4];
#pragma unroll
                for (int pc = 0; pc < 4; ++pc) {
                    const int row = row0 + (grp >> 1) * 128 + (2 * (grp & 1) + (pc >> 1)) * 16, col = col0 + (pc & 1) * 128;
                    const size_t o = (size_t)row * 1024 + col;
                    ra[pc] = *(const float4*)(resid + o); rb[pc] = *(const float4*)(resid + o + 4);
                }
#pragma unroll
                for (int pc = 0; pc < 4; ++pc) {
                    const int ai = grp >> 1, m = 2 * (grp & 1) + (pc >> 1), bj = pc & 1;
                    const int row = row0 + ai * 128 + m * 16, col = col0 + bj * 128;
                    const size_t o = (size_t)row * 1024 + col;
                    *(float4*)(out + o) = make_float4(ra[pc].x + acc[ai][bj][m][0][0], ra[pc].y + acc[ai][bj][m][0][1], ra[pc].z + acc[ai][bj][m][0][2], ra[pc].w + acc[ai][bj][m][0][3]);
                    *(float4*)(out + o + 4) = make_float4(rb[pc].x + acc[ai][bj][m][1][0], rb[pc].y + acc[ai][bj][m][1][1], rb[pc].z + acc[ai][bj][m][1][2], rb[pc].w + acc[ai][bj][m][1][3]);
                }
            }
            return;
        }
        if (u.kind >= GK_PROJ0 && u.kind <= GK_PROJ2) {
#pragma unroll
            for (int grp = 0; grp < 4; ++grp) {
                uint4 gq[4], oq[4];
#pragma unroll
                for (int pc = 0; pc < 4; ++pc) {
                    const int row = row0 + (grp >> 1) * 128 + (2 * (grp & 1) + (pc >> 1)) * 16, col = col0 + (pc & 1) * 128;
                    const h16_t* arow = act + (size_t)row * LDZ;
                    gq[pc].x = 0u; gq[pc].y = 0u; gq[pc].z = 0u; gq[pc].w = 0u; oq[pc] = gq[pc];
                    { const uint2 w2 = *(const uint2*)((u.kind == GK_PROJ0 ? pg0 : (u.kind == GK_PROJ1 ? pg1 : pg2)) + (size_t)row * 1024 + col); gq[pc].x = w2.x; gq[pc].y = w2.y; }
                    if (u.kind != GK_PROJ0) oq[pc] = *(const uint4*)(arow + C_MG + col);
                }
#pragma unroll
                for (int pc = 0; pc < 4; ++pc) {
                    const int ai = grp >> 1, m = 2 * (grp & 1) + (pc >> 1), bj = pc & 1;
                    const int row = row0 + ai * 128 + m * 16, col = col0 + bj * 128;
                    float v[8], g[8], o[8];
#pragma unroll
                    for (int e = 0; e < 4; ++e) { v[e] = acc[ai][bj][m][0][e]; v[4 + e] = acc[ai][bj][m][1][e]; }
#pragma unroll
                    for (int e = 0; e < 4; ++e) { g[e] = (float)((gq[pc].x >> (8 * e)) & 255u) * (1.0f / 255.0f); g[4 + e] = (float)((gq[pc].y >> (8 * e)) & 255u) * (1.0f / 255.0f); }
                    unpack8h(oq[pc], o);
#pragma unroll
                    for (int e = 0; e < 8; ++e) v[e] = o[e] + g[e] * v[e];
                    store8h(act + (size_t)row * LDZ + C_MG + col, v);
                }
            }
            return;
        }
#pragma unroll
        for (int ai = 0; ai < 2; ++ai)
#pragma unroll
            for (int m = 0; m < 4; ++m) {
                const int row = row0 + ai * 128 + m * 16;
#pragma unroll
                for (int bj = 0; bj < 2; ++bj) {
                    const int col = col0 + bj * 128;
                    float v[8];
#pragma unroll
                    for (int e = 0; e < 4; ++e) { v[e] = acc[ai][bj][m][0][e]; v[4 + e] = acc[ai][bj][m][1][e]; }
                    h16_t* arow = act + (size_t)row * LDZ;
                    if (u.kind >= GK_PGATE0) {
                        const float* bp = mb + (u.kind - GK_PGATE0) * 1024 + col;
                        const float4 b0 = *(const float4*)bp, b1 = *(const float4*)(bp + 4);
                        const float bb[8] = {b0.x, b0.y, b0.z, b0.w, b1.x, b1.y, b1.z, b1.w};
                        unsigned q[8];
#pragma unroll
                        for (int e = 0; e < 8; ++e) q[e] = (unsigned)(sigmoidf_(v[e] + bb[e]) * 255.0f + 0.5f);
                        uint2 w2; w2.x = q[0] | (q[1] << 8) | (q[2] << 16) | (q[3] << 24); w2.y = q[4] | (q[5] << 8) | (q[6] << 16) | (q[7] << 24);
                        *(uint2*)((u.kind == GK_PGATE0 ? pg0 : (u.kind == GK_PGATE1 ? pg1 : pg2)) + (size_t)row * 1024 + col) = w2;
                    } else if (u.kind == GK_STORE) {
                        store8h(arow + col, v);
                    } else if (u.kind <= GK_GATE2) {
                        const float* bp = mb + (u.kind - GK_GATE0) * 1024 + col;
                        const float4 b0 = *(const float4*)bp, b1 = *(const float4*)(bp + 4);
                        v[0] = sigmoidf_(v[0] + b0.x); v[1] = sigmoidf_(v[1] + b0.y); v[2] = sigmoidf_(v[2] + b0.z); v[3] = sigmoidf_(v[3] + b0.w);
                        v[4] = sigmoidf_(v[4] + b1.x); v[5] = sigmoidf_(v[5] + b1.y); v[6] = sigmoidf_(v[6] + b1.z); v[7] = sigmoidf_(v[7] + b1.w);
                        store8h(arow + gs_slot(u.kind - GK_GATE0) + col, v);
                    }
                }
            }
    }
};
__device__ __forceinline__ void stage_gemm_on(KParams p, int l, int which, char* smem, int vb0, int nvb) {
    const int vb = bid_() - vb0;
    if (vb < 0 || vb >= nvb) return;
    GemmProg S; S.act = p->ws + OFF_ACT; S.wt = p->ws + OFF_WT + (size_t)l * WT_ROWS * 1024 * 2; S.which = which; S.G = nvb; S.c = vb;
    GemmEpi E; E.act = (h16_t*)(p->ws + OFF_ACT); E.mb = p->in[I_MB] + l * 3072; E.resid = l == 0 ? p->in[I_X] : p->out; E.out = p->out;
    E.pg0 = (unsigned char*)(p->ws + OFF_TOPS); E.pg1 = (unsigned char*)(p->ws + OFF_PG1);
    E.pg2 = (unsigned char*)(p->ws + OFF_WT + (size_t)l * WT_ROWS * 1024 * 2);
    pg8::gemm_phase(smem, S, E);
}
__device__ __forceinline__ void stage_gemm(KParams p, int l, int which, char* smem) { stage_gemm_on(p, l, which, smem, 0, (int)gridDim.x); }
#ifdef CPU_EMU
__device__ __forceinline__ float group_sum(float v, int width, float* scratch) {
    const int tid = tid_();
    scratch[tid] = v;
    __syncthreads();
    float s = 0.f; const int base = tid & ~(width - 1);
    for (int i = 0; i < width; ++i) s += scratch[base + i];
    __syncthreads();
    return s;
}
#else
template <int CTRL> __device__ __forceinline__ float dpp_f(float v) { return __builtin_bit_cast(float, __builtin_amdgcn_update_dpp(0, __builtin_bit_cast(int, v), CTRL, 0xf, 0xf, false)); }
__device__ __forceinline__ float group_sum(float v, int width, float*) {
    v += dpp_f<0xB1>(v);
    v += dpp_f<0x4E>(v);
    if (width >= 8) v += dpp_f<0x141>(v);
    if (width >= 16) v += dpp_f<0x140>(v);
    if (width >= 64) {
        v += __builtin_bit_cast(float, __builtin_amdgcn_update_dpp(0, __builtin_bit_cast(int, v), 0x142, 0xa, 0xf, false));
        v += __builtin_bit_cast(float, __builtin_amdgcn_update_dpp(0, __builtin_bit_cast(int, v), 0x143, 0xc, 0xf, false));
        v = __builtin_bit_cast(float, __builtin_amdgcn_readlane(__builtin_bit_cast(int, v), 63));
    } else if (width >= 32) v += __shfl_xor(v, 16);
    return v;
}
#endif
__device__ __forceinline__ uint4 ldg16(const h16_t* p) { return *(const uint4*)p; }
__device__ __forceinline__ uint4 zero16() { uint4 z; z.x = 0u; z.y = 0u; z.z = 0u; z.w = 0u; return z; }

#ifdef CPU_EMU
#define MIX_SCHEDB()
#define WAVE_UNIFORM(x) (x)
#define GDN_T_EMU_SKIP() do { for (int i_ = 0; i_ < 8; ++i_) if (rb8 * 8 + i_ > 0) (void)group_sum(0.f, 8, scr); } while (0)
#else
#define MIX_SCHEDB() __builtin_amdgcn_sched_barrier(0)
#define WAVE_UNIFORM(x) __builtin_amdgcn_readfirstlane(x)
#define GDN_T_EMU_SKIP() do { } while (0)
#endif
#ifdef CPU_EMU
struct hfrag { h16_t v[8]; };
struct facc { float d[4]; float& operator[](int i) { return d[i]; } const float& operator[](int i) const { return d[i]; } };
__device__ __forceinline__ facc facc_zero() { facc a; a.d[0] = a.d[1] = a.d[2] = a.d[3] = 0.f; return a; }
__device__ __forceinline__ hfrag frag_u4(uint4 w) { hfrag f; memcpy(&f, &w, 16); return f; }
__device__ __forceinline__ hfrag frag_2u2(uint2 lo, uint2 hi) { hfrag f; memcpy(&f.v[0], &lo, 8); memcpy(&f.v[4], &hi, 8); return f; }
__device__ __forceinline__ hfrag frag_mul(hfrag a, hfrag b) { hfrag f; for (int j = 0; j < 8; ++j) f.v[j] = f2h(h2f(a.v[j]) * h2f(b.v[j])); return f; }
__device__ __forceinline__ facc mfma16(hfrag a, hfrag b, facc c) {
    const int tid = tid_(), w = tid >> 6, l = tid & 63;
    unsigned short (*X)[64][16] = emu::ctx->xscr;
    for (int j = 0; j < 8; ++j) { X[w][l][j] = a.v[j]; X[w][l][8 + j] = b.v[j]; }
    __syncthreads();
    for (int reg = 0; reg < 4; ++reg) {
        const int row = 4 * (l >> 4) + reg, col = l & 15;
        float s = 0.f;
        for (int k = 0; k < 32; ++k) s += h2f(X[w][row + 16 * (k >> 3)][k & 7]) * h2f(X[w][col + 16 * (k >> 3)][8 + (k & 7)]);
        c.d[reg] += s;
    }
    __syncthreads();
    return c;
}
#else
typedef _Float16 hfrag __attribute__((ext_vector_type(8)));
typedef float facc __attribute__((ext_vector_type(4)));
__device__ __forceinline__ facc facc_zero() { return (facc){0.f, 0.f, 0.f, 0.f}; }
__device__ __forceinline__ hfrag frag_u4(uint4 w) { return __builtin_bit_cast(hfrag, w); }
__device__ __forceinline__ hfrag frag_2u2(uint2 lo, uint2 hi) { uint4 w; w.x = lo.x; w.y = lo.y; w.z = hi.x; w.w = hi.y; return __builtin_bit_cast(hfrag, w); }
__device__ __forceinline__ hfrag frag_mul(hfrag a, hfrag b) { return a * b; }
__device__ __forceinline__ facc mfma16(hfrag a, hfrag b, facc c) { return __builtin_amdgcn_mfma_f32_16x16x32_f16(a, b, c, 0, 0, 0); }
#endif
__device__ __forceinline__ hfrag frag_pack8(float a0, float a1, float a2, float a3, float a4, float a5, float a6, float a7) {
    uint4 w; w.x = pack2h(a0, a1); w.y = pack2h(a2, a3); w.z = pack2h(a4, a5); w.w = pack2h(a6, a7); return frag_u4(w);
}
__device__ __forceinline__ hfrag frag_acc2(const facc& t0, const facc& t1) { return frag_pack8(t0[0], t0[1], t0[2], t0[3], t1[0], t1[1], t1[2], t1[3]); }
__device__ __forceinline__ hfrag permfrag(const h16_t* rowp, int ks, int g) { return frag_2u2(*(const uint2*)(rowp + 32 * ks + 4 * g), *(const uint2*)(rowp + 32 * ks + 16 + 4 * g)); }

__device__ __forceinline__ void stage_lru(KParams p, int l, char* smem, int vb0, int nvb) {
    const int vb = bid_() - vb0;
    if (vb < 0 || vb >= nvb) return;
    constexpr int CH = 64, XS = 72;
    h16_t* WaT = (h16_t*)smem;
    h16_t* WxT = WaT + 64 * XS;
    h16_t* Xh = WxT + 64 * XS;
    float* a_s = (float*)(Xh + 64 * XS);
    float* b_s = a_s + CH * 64;
    h16_t* ru = (h16_t*)(b_s + CH * 64);
    h16_t* rg = ru + (CH + 3) * 64;
    h16_t* ACT = (h16_t*)(p->ws + OFF_ACT);
    const int tid = tid_(), c = tid & 63, tg = tid >> 6;
    const int lane = tid & 63, wv = tid >> 6, g = lane >> 4, r16 = lane & 15, tt = wv >> 1, ct0 = 2 * (wv & 1);
    for (int item = vb; item < B_ * 16; item += nvb) {
        const int b = item / 16, n = item % 16, ch = n * 64 + c;
        __syncthreads();
        for (int i = tid; i < 4096; i += NT) { const int ii = i >> 6, cc = i & 63; WaT[cc * XS + ii] = f2h(p->in[I_LWA][((size_t)l * 16 + n) * 4096 + i]); WxT[cc * XS + ii] = f2h(p->in[I_LWX][((size_t)l * 16 + n) * 4096 + i]); }
        const float cw0 = p->in[I_LCW][((size_t)l * 4 + 0) * 1024 + ch], cw1 = p->in[I_LCW][((size_t)l * 4 + 1) * 1024 + ch];
        const float cw2 = p->in[I_LCW][((size_t)l * 4 + 2) * 1024 + ch], cw3 = p->in[I_LCW][((size_t)l * 4 + 3) * 1024 + ch];
        const float cb = p->in[I_LCB][l * 1024 + ch];
        float ba2[2], bx2[2], sp2[2];
#pragma unroll
        for (int j = 0; j < 2; ++j) { const int cg = n * 64 + 16 * (ct0 + j) + r16; ba2[j] = p->in[I_LBA][l * 1024 + cg]; bx2[j] = p->in[I_LBX][l * 1024 + cg]; sp2[j] = softplusf_(-p->in[I_LLAM][l * 1024 + cg]); }
        float hst = 0.f;
        uint4 pf[3];
#define LRU_LOAD(t0_) do { _Pragma("unroll") for (int i = 0; i < 3; ++i) { const int j = tid + NT * i; pf[i] = zero16(); \
            if (j < 536) { const int t = (t0_) - 3 + (j >> 3); if (t >= 0) pf[i] = ldg16(ACT + ((size_t)b * T_ + t) * LDZ + Z_ULRU + n * 64 + (j & 7) * 8); } \
            else if (j < 1048) { const int jj = j - 536; pf[i] = ldg16(ACT + ((size_t)b * T_ + (t0_) + (jj >> 3)) * LDZ + Z_GLRU + n * 64 + (jj & 7) * 8); } } } while (0)
#define LRU_PUT() do { _Pragma("unroll") for (int i = 0; i < 3; ++i) { const int j = tid + NT * i; \
            if (j < 536) *(uint4*)(ru + (j >> 3) * 64 + (j & 7) * 8) = pf[i]; else if (j < 1048) *(uint4*)(rg + ((j - 536) >> 3) * 64 + ((j - 536) & 7) * 8) = pf[i]; } } while (0)
        LRU_LOAD(0);
        LRU_PUT();
        __syncthreads();
        hfrag bwa[2][2], bwx[2][2];
#pragma unroll
        for (int j = 0; j < 2; ++j)
#pragma unroll
            for (int ks = 0; ks < 2; ++ks) { bwa[j][ks] = frag_u4(*(const uint4*)(WaT + (16 * (ct0 + j) + r16) * XS + 32 * ks + 8 * g)); bwx[j][ks] = frag_u4(*(const uint4*)(WxT + (16 * (ct0 + j) + r16) * XS + 32 * ks + 8 * g)); }
#pragma unroll 1
        for (int t0 = 0; t0 < T_; t0 += CH) {
            {
                float u[11];
#pragma unroll
                for (int s = 0; s < 11; ++s) u[s] = h2f(ru[(tg * 8 + s) * 64 + c]);
#pragma unroll
                for (int s = 0; s < 8; ++s) Xh[(tg * 8 + s) * XS + c] = f2h(cw0 * u[s] + cw1 * u[s + 1] + cw2 * u[s + 2] + cw3 * u[s + 3] + cb);
            }
            __syncthreads();
            if (t0 + CH < T_) LRU_LOAD(t0 + CH);
            {
                hfrag af[2];
#pragma unroll
                for (int ks = 0; ks < 2; ++ks) af[ks] = frag_u4(*(const uint4*)(Xh + (16 * tt + r16) * XS + 32 * ks + 8 * g));
#pragma unroll
                for (int j = 0; j < 2; ++j) {
                    facc dr = mfma16(af[0], bwa[j][0], facc_zero()); dr = mfma16(af[1], bwa[j][1], dr);
                    facc di = mfma16(af[0], bwx[j][0], facc_zero()); di = mfma16(af[1], bwx[j][1], di);
                    const int cc = 16 * (ct0 + j) + r16;
#pragma unroll
                    for (int reg = 0; reg < 4; ++reg) {
                        const int t = 16 * tt + 4 * g + reg;
                        const float r = sigmoidf_(dr[reg] + ba2[j]), ig = sigmoidf_(di[reg] + bx2[j]);
                        const float log_a = -8.0f * r * sp2[j];
                        a_s[t * 64 + cc] = fexp_(log_a);
                        b_s[t * 64 + cc] = sqrtf(fmaxf(1.0f - fexp_(2.0f * log_a), 0.0f)) * (ig * h2f(Xh[t * XS + cc]));
                    }
                }
            }
            __syncthreads();
            if (tid < 64) {
#pragma unroll 1
                for (int t8 = 0; t8 < CH; t8 += 8) {
                    float av[8], bv[8];
#pragma unroll
                    for (int i = 0; i < 8; ++i) { av[i] = a_s[(t8 + i) * 64 + c]; bv[i] = b_s[(t8 + i) * 64 + c]; }
#pragma unroll
                    for (int i = 0; i < 8; ++i) { hst = av[i] * hst + bv[i]; bv[i] = hst; }
#pragma unroll
                    for (int i = 0; i < 8; ++i) b_s[(t8 + i) * 64 + c] = bv[i];
                }
            }
            __syncthreads();
            {
                float hv[8], gv[8];
#pragma unroll
                for (int s = 0; s < 8; ++s) { hv[s] = b_s[(tg * 8 + s) * 64 + c]; gv[s] = h2f(rg[(tg * 8 + s) * 64 + c]); }
#pragma unroll
                for (int s = 0; s < 8; ++s) rg[(tg * 8 + s) * 64 + c] = f2h(hv[s] * geluf_(gv[s]));
            }
            __syncthreads();
            *(uint4*)(ACT + ((size_t)b * T_ + t0 + (tid >> 3)) * LDZ + Z_GLRU + n * 64 + (tid & 7) * 8) = *(const uint4*)(rg + (tid >> 3) * 64 + (tid & 7) * 8);
            __syncthreads();
            if (t0 + CH < T_) LRU_PUT();
            __syncthreads();
        }
#undef LRU_LOAD
#undef LRU_PUT
    }
}

__device__ __forceinline__ void stage_gdn(KParams p, int l, char* smem, int vb0, int nvb) {
    const int vb = bid_() - vb0;
    if (vb < 0 || vb >= nvb) return;
    constexpr int CH = 64, QS = 136, TS = 72, AS = 68, KTS = 128 * TS + 16 * 8;
#define KTO(d) ((d) * TS + ((d) >> 3) * 8)
    h16_t* Qs = (h16_t*)smem;
    h16_t* Ks = Qs + 64 * QS;
    h16_t* Kt = Ks + 64 * QS;
    h16_t* Vt = Kt + KTS;
    float* A32 = (float*)(Vt + KTS);
    h16_t* ob = (h16_t*)A32;
    h16_t* Tu = (h16_t*)(A32 + 64 * AS);
    h16_t* Tw = Tu + 64 * TS;
    h16_t* QKm = Tw + 64 * TS;
    float* gc_s = (float*)(QKm + 64 * TS);
    float* be_s = gc_s + 64;
    float* e1_s = be_s + 64;
    float* part_s = e1_s + 64;
    float* scr = part_s + 512;
    float* cw_s = scr + 512;
    h16_t* Ab = (h16_t*)part_s;
    h16_t* dump_s = (h16_t*)(cw_s + 4 * 384);
    h16_t* TaT = Tu + 32;
    h16_t* TbR = Tw + 32;
    h16_t* ACT = (h16_t*)(p->ws + OFF_ACT);
    int tid = tid_(), lane = tid & 63, w = tid >> 6, g = lane >> 4, r16 = lane & 15;
    int sg = lane >> 4, pc = lane & 15, rb = w;
#define GDN_ROLES() do { tid = tid_(); lane = tid & 63; w = tid >> 6; g = lane >> 4; r16 = lane & 15; sg = g; pc = r16; rb = w; } while (0)
    for (int item = vb; item < B_ * 8; item += nvb) {
        const int b = item / 8, h = item % 8;
        const float a_exp = fexp_(p->in[I_GALOG][l * 8 + h]), dtb = p->in[I_GDT][l * 8 + h];
        facc S[8];
#pragma unroll
        for (int dt = 0; dt < 8; ++dt) S[dt] = facc_zero();
        __syncthreads();
        for (int i = tid; i < 64 * TS / 2; i += NT) ((unsigned*)QKm)[i] = 0u;
        for (int i = tid; i < 4 * 384; i += NT) { const int jj = i / 384, c3 = i % 384; cw_s[i] = p->in[I_GCW][((size_t)l * 4 + jj) * 3072 + (c3 >> 7) * 1024 + h * 128 + (c3 & 127)]; }
        uint4 pf[11];
#define GDN_LOAD(t0_) do { GDN_ROLES(); const h16_t* colp = ACT + ((size_t)b * T_ + (t0_) + 8 * rb - 3) * LDZ + (sg < 3 ? Z_Q + sg * 1024 : Z_ZG) + h * 128 + pc * 8; \
            _Pragma("unroll") for (int i = 0; i < 11; ++i) { const int t = (t0_) + 8 * rb - 3 + i; pf[i] = (t >= 0 && sg < 3) ? ldg16(colp + (size_t)i * LDZ) : zero16(); } } while (0)
        GDN_LOAD(0);
        h16_t pfa = 0, pfb = 0;
#define GDN_LOADS(t0_) do { if (tid < 64) { const size_t m_ = (size_t)b * T_ + (t0_) + tid; pfa = ACT[m_ * LDZ + Z_ALPHA + h]; pfb = ACT[m_ * LDZ + Z_BETA + h]; } } while (0)
        GDN_LOADS(0);
#pragma unroll 1
        for (int t0 = 0; t0 < T_; t0 += CH) {
            GDN_ROLES();
            if (tid < 64) {
                part_s[tid] = -a_exp * softplusf_(h2f(pfa) + dtb);
                be_s[tid] = sigmoidf_(h2f(pfb));
            }
            __syncthreads();
            if (tid < 64) { float s = 0.f;
#pragma unroll
                for (int i4 = 0; i4 < 16; ++i4) { const float4 pv = *(const float4*)(part_s + i4 * 4); s += (i4 * 4 <= tid ? pv.x : 0.f) + (i4 * 4 + 1 <= tid ? pv.y : 0.f) + (i4 * 4 + 2 <= tid ? pv.z : 0.f) + (i4 * 4 + 3 <= tid ? pv.w : 0.f); }
                gc_s[tid] = s; }
#pragma unroll
            for (int hf = 0; hf < 2; ++hf) {
                float ov[4][8];
#pragma unroll
                for (int i = 0; i < 4; ++i) {
#pragma unroll
                    for (int cc = 0; cc < 8; ++cc) ov[i][cc] = 0.f;
#pragma unroll
                    for (int jj = 0; jj < 4; ++jj) {
                        const uint4 wv = pf[hf * 4 + i + jj];
                        const float* cwp = cw_s + jj * 384 + (sg < 3 ? sg : 0) * 128 + pc * 8;
                        const float4 c0 = *(const float4*)cwp, c1 = *(const float4*)(cwp + 4);
                        ov[i][0] += c0.x * h2f((h16_t)(wv.x & 0xffffu)); ov[i][1] += c0.y * h2f((h16_t)(wv.x >> 16)); ov[i][2] += c0.z * h2f((h16_t)(wv.y & 0xffffu)); ov[i][3] += c0.w * h2f((h16_t)(wv.y >> 16));
                        ov[i][4] += c1.x * h2f((h16_t)(wv.z & 0xffffu)); ov[i][5] += c1.y * h2f((h16_t)(wv.z >> 16)); ov[i][6] += c1.z * h2f((h16_t)(wv.w & 0xffffu)); ov[i][7] += c1.w * h2f((h16_t)(wv.w >> 16));
                    }
                    float ss = 0.f;
#pragma unroll
                    for (int cc = 0; cc < 8; ++cc) { ov[i][cc] = siluf_(ov[i][cc]); ss += ov[i][cc] * ov[i][cc]; }
                    ss = group_sum(ss, 16, scr);
                    const float rn = sg == 0 ? rsqrtf(ss + RMS_EPS) * 0.08838834764831845f : (sg == 1 ? rsqrtf(ss + RMS_EPS) : 1.0f);
#pragma unroll
                    for (int cc = 0; cc < 8; ++cc) ov[i][cc] *= rn;
                    const int t = 8 * rb + hf * 4 + i;
                    if (sg == 0) store8h(Qs + t * QS + pc * 8, ov[i]);
                    else if (sg == 1) store8h(Ks + t * QS + pc * 8, ov[i]);
                }
                if (sg == 1 || sg == 2) {
                    h16_t* dstT = sg == 1 ? Kt : Vt;
#pragma unroll
                    for (int cc = 0; cc < 8; ++cc) { uint2 w2; w2.x = pack2h(ov[0][cc], ov[1][cc]); w2.y = pack2h(ov[2][cc], ov[3][cc]); *(uint2*)(dstT + KTO(pc * 8 + cc) + 8 * rb + hf * 4) = w2; }
                }
            }
            __syncthreads();
            GDN_ROLES();
            if (tid < 64) e1_s[tid] = fexp_(gc_s[63] - gc_s[tid]);
            for (int e = tid; e < 64 * 64; e += NT) { const int i = e >> 6, j = e & 63; if ((j >> 4) > (i >> 4)) A32[i * AS + (j & 7) * 8 + (j >> 3)] = 0.f; }
#pragma unroll 1
            for (int jr = 0; jr < 3; ++jr) {
                const int jb = WAVE_UNIFORM(w) + 8 * jr; const bool valid = jb < 20;
                const int kind = (valid && jb >= 10) ? 1 : 0, tix = valid ? (jb % 10) : 0;
                const int ti = tix < 1 ? 0 : (tix < 3 ? 1 : (tix < 6 ? 2 : 3)), tj = tix - (ti * (ti + 1)) / 2;
                const h16_t* ap = (kind ? Qs : Ks) + (16 * ti + r16) * QS + 8 * g; const h16_t* bp = Ks + (16 * tj + r16) * QS + 8 * g;
                facc acc = facc_zero();
                hfrag kaf[4], kbf[4];
#pragma unroll
                for (int ks = 0; ks < 4; ++ks) { kaf[ks] = frag_u4(*(const uint4*)(ap + 32 * ks)); kbf[ks] = frag_u4(*(const uint4*)(bp + 32 * ks)); }
                MIX_SCHEDB();
#pragma unroll
                for (int ks = 0; ks < 4; ++ks) acc = mfma16(kaf[ks], kbf[ks], acc);
                MIX_SCHEDB();
                if (valid) {
                    const int j = 16 * tj + r16; const float gj = gc_s[j];
#pragma unroll
                    for (int reg = 0; reg < 4; ++reg) {
                        const int i = 16 * ti + 4 * g + reg;
                        const float dec = fexp_(fminf(gc_s[i] - gj, 0.f));
                        if (kind == 0) { const float av = i > j ? be_s[i] * acc[reg] * dec : 0.f; A32[i * AS + (j & 7) * 8 + (j >> 3)] = av; if (ti >= 2 && tj < 2) Ab[(i - 32) * 32 + j] = f2h(av); }
                        else QKm[i * TS + j] = f2h(i >= j ? acc[reg] * dec : 0.f);
                    }
                }
            }
            __syncthreads();
            GDN_ROLES();
            {
                const int t = tid >> 3, d0 = (tid & 7) * 16; const float eg = fexp_(gc_s[t]);
                float v8[8];
                load8h(Qs + t * QS + d0, v8);
#pragma unroll
                for (int e = 0; e < 8; ++e) v8[e] *= eg;
                store8h(Qs + t * QS + d0, v8);
                load8h(Qs + t * QS + d0 + 8, v8);
#pragma unroll
                for (int e = 0; e < 8; ++e) v8[e] *= eg;
                store8h(Qs + t * QS + d0 + 8, v8);
            }
            {
                const int cb8 = WAVE_UNIFORM((tid >> 6) < 4 ? (tid >> 6) : 11 - (tid >> 6));
                const int c = cb8 * 8 + ((tid & 63) >> 3), q = tid & 7, half = cb8 >> 2, lb = cb8 & 3, rbase = half * 32, cl = c & 31;
                const float bsel = q == 0 ? be_s[c] : (q == 1 ? be_s[c] * fexp_(gc_s[c]) : 1.0f);
                h16_t* const tbase = q == 0 ? Tu + rbase * TS + c : (q == 1 ? Tw + rbase * TS + c : (q == 2 ? (half == 0 ? TaT + cl * TS : TbR + cl) : dump_s + tid));
                const int tstr = q < 2 ? TS : (q == 2 ? (half == 0 ? 1 : TS) : 0);
                const float* arow = A32 + rbase * AS + q * 8 + half * 4;
                float x[4] = {0.f, 0.f, 0.f, 0.f};
#pragma unroll
                for (int rb8 = 0; rb8 < 4; ++rb8) {
                    if (rb8 < lb) {
#pragma unroll
                        for (int i = 0; i < 8; ++i) tbase[(rb8 * 8 + i) * tstr] = f2h(0.f);
                        GDN_T_EMU_SKIP();
                        continue;
                    }
                    float4 a4[8];
#pragma unroll
                    for (int i = 0; i < 8; ++i) { a4[i] = make_float4(0.f, 0.f, 0.f, 0.f); if (rb8 * 8 + i > 0) a4[i] = *(const float4*)(arow + (rb8 * 8 + i) * AS); }
#pragma unroll
                    for (int i = 0; i < 8; ++i) {
                        const int rl = rb8 * 8 + i;
                        float sacc = 0.f;
                        if (rl > 0) {
                            sacc = a4[i].x * x[0];
                            if (rl > 8) sacc += a4[i].y * x[1];
                            if (rl > 16) sacc += a4[i].z * x[2];
                            if (rl > 24) sacc += a4[i].w * x[3];
                            sacc = group_sum(sacc, 8, scr);
                        }
                        const float xr = ((rl == cl) ? 1.f : 0.f) - sacc;
                        x[rl >> 3] = (q == (rl & 7)) ? xr : x[rl >> 3];
                        tbase[rl * tstr] = f2h(xr * bsel);
                    }
                }
            }
            __syncthreads();
            GDN_ROLES();
            {
                const int ct = w & 1, rt = (w >> 1) & 1;
                const hfrag tb = frag_u4(*(const uint4*)(TaT + (16 * ct + r16) * TS + 8 * g));
                const facc x0 = mfma16(frag_u4(*(const uint4*)(Ab + r16 * 32 + 8 * g)), tb, facc_zero());
                const facc x1 = mfma16(frag_u4(*(const uint4*)(Ab + (16 + r16) * 32 + 8 * g)), tb, facc_zero());
                const facc d = mfma16(permfrag(TbR + (16 * rt + r16) * TS, 0, g), frag_acc2(x0, x1), facc_zero());
                if (w < 4) {
                    const int col = 16 * ct + r16; const float bu = be_s[col], bw_ = bu * fexp_(gc_s[col]);
#pragma unroll
                    for (int reg = 0; reg < 4; ++reg) { const int row = 32 + 16 * rt + 4 * g + reg; Tu[row * TS + col] = f2h(-d[reg] * bu); Tw[row * TS + col] = f2h(-d[reg] * bw_); }
                }
            }
            __syncthreads();
            GDN_ROLES();
            facc vn[4], aw[4];
#pragma unroll
            for (int tt = 0; tt < 4; ++tt) { vn[tt] = facc_zero(); aw[tt] = facc_zero(); }
            {
                hfrag bv[2], bk[2], au[4][2], aww[4][2];
#pragma unroll
                for (int ks = 0; ks < 2; ++ks) { bv[ks] = frag_u4(*(const uint4*)(Vt + KTO(16 * w + r16) + 32 * ks + 8 * g)); bk[ks] = frag_u4(*(const uint4*)(Kt + KTO(16 * w + r16) + 32 * ks + 8 * g)); }
#pragma unroll
                for (int tt = 0; tt < 4; ++tt)
#pragma unroll
                    for (int ks = 0; ks <= (tt >> 1); ++ks) { au[tt][ks] = frag_u4(*(const uint4*)(Tu + (16 * tt + r16) * TS + 32 * ks + 8 * g)); aww[tt][ks] = frag_u4(*(const uint4*)(Tw + (16 * tt + r16) * TS + 32 * ks + 8 * g)); }
                MIX_SCHEDB();
#pragma unroll
                for (int tt = 0; tt < 4; ++tt)
#pragma unroll
                    for (int ks = 0; ks <= (tt >> 1); ++ks) { vn[tt] = mfma16(au[tt][ks], bv[ks], vn[tt]); aw[tt] = mfma16(aww[tt][ks], bk[ks], aw[tt]); }
                MIX_SCHEDB();
            }
#pragma unroll
            for (int tt = 0; tt < 4; ++tt)
#pragma unroll
                for (int reg = 0; reg < 4; ++reg) Ks[(16 * tt + 4 * g + reg) * QS + 16 * w + r16] = f2h(-aw[tt][reg]);
            __syncthreads();
            GDN_ROLES();
            h16_t zraw[16];
#pragma unroll
            for (int tt = 0; tt < 4; ++tt)
#pragma unroll
                for (int reg = 0; reg < 4; ++reg) zraw[tt * 4 + reg] = ACT[((size_t)b * T_ + t0 + 16 * tt + 4 * g + reg) * LDZ + Z_ZG + h * 128 + 16 * w + r16];
            hfrag Sb[4];
#pragma unroll
            for (int ks = 0; ks < 4; ++ks) Sb[ks] = frag_acc2(S[2 * ks], S[2 * ks + 1]);
            facc oc[4];
#pragma unroll
            for (int tt = 0; tt < 4; ++tt) {
                oc[tt] = facc_zero();
                const h16_t* wrow = Ks + (16 * tt + r16) * QS; const h16_t* qrow = Qs + (16 * tt + r16) * QS;
                hfrag wf[4], qf[4];
#pragma unroll
                for (int ks = 0; ks < 4; ++ks) { wf[ks] = permfrag(wrow, ks, g); qf[ks] = permfrag(qrow, ks, g); }
                MIX_SCHEDB();
#pragma unroll
                for (int ks = 0; ks < 4; ++ks) { vn[tt] = mfma16(wf[ks], Sb[ks], vn[tt]); oc[tt] = mfma16(qf[ks], Sb[ks], oc[tt]); }
                MIX_SCHEDB();
            }
            hfrag VNb[2];
            VNb[0] = frag_acc2(vn[0], vn[1]); VNb[1] = frag_acc2(vn[2], vn[3]);
            {
                hfrag mf[6];
                mf[0] = permfrag(QKm + (r16) * TS, 0, g); mf[1] = permfrag(QKm + (16 + r16) * TS, 0, g);
                mf[2] = permfrag(QKm + (32 + r16) * TS, 0, g); mf[3] = permfrag(QKm + (32 + r16) * TS, 1, g);
                mf[4] = permfrag(QKm + (48 + r16) * TS, 0, g); mf[5] = permfrag(QKm + (48 + r16) * TS, 1, g);
                MIX_SCHEDB();
                oc[0] = mfma16(mf[0], VNb[0], oc[0]); oc[1] = mfma16(mf[1], VNb[0], oc[1]);
                oc[2] = mfma16(mf[2], VNb[0], oc[2]); oc[2] = mfma16(mf[3], VNb[1], oc[2]);
                oc[3] = mfma16(mf[4], VNb[0], oc[3]); oc[3] = mfma16(mf[5], VNb[1], oc[3]);
                MIX_SCHEDB();
            }
            {
                const float egl = fexp_(gc_s[63]);
                hfrag e1f[2];
#pragma unroll
                for (int ks2 = 0; ks2 < 2; ++ks2) { const float* ep = e1_s + 32 * ks2 + 4 * g; e1f[ks2] = frag_pack8(ep[0], ep[1], ep[2], ep[3], ep[16], ep[17], ep[18], ep[19]); }
#pragma unroll
                for (int dp = 0; dp < 8; dp += 4) {
                    hfrag kf[4][2];
#pragma unroll
                    for (int d4 = 0; d4 < 4; ++d4)
#pragma unroll
                        for (int ks2 = 0; ks2 < 2; ++ks2) kf[d4][ks2] = permfrag(Kt + KTO(16 * (dp + d4) + r16), ks2, g);
                    MIX_SCHEDB();
#pragma unroll
                    for (int d4 = 0; d4 < 4; ++d4) {
                        const int dt = dp + d4;
#pragma unroll
                        for (int reg = 0; reg < 4; ++reg) S[dt][reg] *= egl;
#pragma unroll
                        for (int ks2 = 0; ks2 < 2; ++ks2) S[dt] = mfma16(frag_mul(kf[d4][ks2], e1f[ks2]), VNb[ks2], S[dt]);
                    }
                    MIX_SCHEDB();
                }
            }
            if (t0 + CH < T_) { GDN_LOAD(t0 + CH); GDN_LOADS(t0 + CH); }
            GDN_ROLES();
#pragma unroll
            for (int tt = 0; tt < 4; ++tt)
#pragma unroll
                for (int reg = 0; reg < 4; ++reg) { const float ss = group_sum(oc[tt][reg] * oc[tt][reg], 16, scr); if (r16 == 0) part_s[(16 * tt + 4 * g + reg) * 8 + w] = ss; }
            __syncthreads();
            const float nw = p->in[I_GNW][l * 128 + w * 16 + r16];
            float ms[16];
#pragma unroll
            for (int tt = 0; tt < 4; ++tt)
#pragma unroll
                for (int reg = 0; reg < 4; ++reg) {
                    const float* pp = part_s + (16 * tt + 4 * g + reg) * 8;
                    const float4 p0 = *(const float4*)pp, p1 = *(const float4*)(pp + 4);
                    ms[tt * 4 + reg] = ((p0.x + p0.y) + (p0.z + p0.w)) + ((p1.x + p1.y) + (p1.z + p1.w));
                }
#pragma unroll
            for (int tt = 0; tt < 4; ++tt)
#pragma unroll
                for (int reg = 0; reg < 4; ++reg) {
                    const int t = 16 * tt + 4 * g + reg;
                    ob[t * 128 + 16 * w + r16] = f2h(oc[tt][reg] * rsqrtf(ms[tt * 4 + reg] * (1.0f / 128.0f) + RMS_EPS) * nw * siluf_(h2f(zraw[tt * 4 + reg])));
                }
            __syncthreads();
            GDN_ROLES();
#pragma unroll
            for (int i = 0; i < 2; ++i) { const int j = tid + NT * i; *(uint4*)(ACT + ((size_t)b * T_ + t0 + (j >> 4)) * LDZ + Z_ZG + h * 128 + (j & 15) * 8) = *(const uint4*)(ob + (j >> 4) * 128 + (j & 15) * 8); }
            __syncthreads();
        }
#undef GDN_LOAD
#undef GDN_LOADS
#undef KTO
#undef GDN_ROLES
    }
}

#ifdef CPU_EMU
__device__ __forceinline__ unsigned short f2bf_(float f) { unsigned u = __float_as_uint(f); u += 0x7fffu + ((u >> 16) & 1u); return (unsigned short)(u >> 16); }
__device__ __forceinline__ unsigned pack2bf(float a, float b) { return (unsigned)f2bf_(a) | ((unsigned)f2bf_(b) << 16); }
#else
typedef __bf16 rw_bf2 __attribute__((ext_vector_type(2)));
typedef float rw_f2 __attribute__((ext_vector_type(2)));
__device__ __forceinline__ unsigned pack2bf(float a, float b) { const rw_f2 v = {a, b}; return __builtin_bit_cast(unsigned, __builtin_convertvector(v, rw_bf2)); }
__device__ __forceinline__ unsigned short f2bf_(float f) { return (unsigned short)pack2bf(f, f); }
#endif
#ifdef CPU_EMU
struct bfrag { unsigned short v[8]; };
__device__ __forceinline__ bfrag bfrag_u4(uint4 w) { bfrag f; memcpy(&f, &w, 16); return f; }
__device__ __forceinline__ bfrag bfrag_2u2(uint2 lo, uint2 hi) { bfrag f; memcpy(&f.v[0], &lo, 8); memcpy(&f.v[4], &hi, 8); return f; }
__device__ __forceinline__ facc mfma16b(bfrag a, bfrag b, facc c) {
    const int tid = tid_(), w = tid >> 6, l = tid & 63;
    unsigned short (*X)[64][16] = emu::ctx->xscr;
    for (int j = 0; j < 8; ++j) { X[w][l][j] = a.v[j]; X[w][l][8 + j] = b.v[j]; }
    __syncthreads();
    for (int reg = 0; reg < 4; ++reg) {
        const int row = 4 * (l >> 4) + reg, col = l & 15;
        float s = 0.f;
        for (int k = 0; k < 32; ++k) s += __uint_as_float((unsigned)X[w][row + 16 * (k >> 3)][k & 7] << 16) * __uint_as_float((unsigned)X[w][col + 16 * (k >> 3)][8 + (k & 7)] << 16);
        c.d[reg] += s;
    }
    __syncthreads();
    return c;
}
#else
typedef __bf16 bfrag __attribute__((ext_vector_type(8)));
__device__ __forceinline__ bfrag bfrag_u4(uint4 w) { return __builtin_bit_cast(bfrag, w); }
__device__ __forceinline__ bfrag bfrag_2u2(uint2 lo, uint2 hi) { uint4 w; w.x = lo.x; w.y = lo.y; w.z = hi.x; w.w = hi.y; return __builtin_bit_cast(bfrag, w); }
__device__ __forceinline__ facc mfma16b(bfrag a, bfrag b, facc c) { return __builtin_amdgcn_mfma_f32_16x16x32_bf16(a, b, c, 0, 0, 0); }
#endif
__device__ __forceinline__ bfrag bfrag_acc2(const facc& t0, const facc& t1) { uint4 w; w.x = pack2bf(t0[0], t0[1]); w.y = pack2bf(t0[2], t0[3]); w.z = pack2bf(t1[0], t1[1]); w.w = pack2bf(t1[2], t1[3]); return bfrag_u4(w); }
__device__ __forceinline__ bfrag bfrag_ld(const unsigned short* p) { return bfrag_u4(*(const uint4*)p); }
__device__ __forceinline__ bfrag bpermfrag(const unsigned short* rowp, int ks, int g) { return bfrag_2u2(*(const uint2*)(rowp + 32 * ks + 4 * g), *(const uint2*)(rowp + 32 * ks + 16 + 4 * g)); }

#ifndef CPU_EMU
typedef _Float16 rw_f16x8 __attribute__((ext_vector_type(8)));
typedef float rw_f32x4 __attribute__((ext_vector_type(4)));
#endif
__device__ __forceinline__ void stage_rwkv(KParams p, int l, char* smem, int vb0, int nvb) {
    const int vb = bid_() - vb0;
    if (vb < 0 || vb >= nvb) return;
    constexpr int CH = 32, XS = 264, IS = 72, TS2 = 40, LS = 36;
    float* r_s = (float*)smem;
    float* k_s = r_s + CH * 64;
    float* o_s = k_s;
    float* v_s = k_s + CH * 64;
    float* w_s = v_s + CH * 64;
    float* ka_s = w_s + CH * 64;
    float* L32 = ka_s;
    float* g_s = ka_s + CH * 64;
    float* bon_s = g_s + CH * 64;
    float* gC_s = bon_s + CH;
    float* gs_s = gC_s + 64;
    float* scr = gs_s + 512;
    h16_t* raw = (h16_t*)(scr + 512);
    h16_t* xs = raw + (CH + 1) * 448;
    unsigned short* Aim = (unsigned short*)raw;
    unsigned short* Rim = Aim + 32 * IS;
    unsigned short* Bim = Rim + 32 * IS;
    unsigned short* Cim = Bim + 32 * IS;
    unsigned short* Vt = Cim + 32 * IS;
    unsigned short* Ct = Vt + 64 * TS2;
    unsigned short* Btn = Ct + 64 * TS2;
    unsigned short* Nim = Btn + 64 * TS2;
    unsigned short* Tim = Nim + 32 * TS2;
    unsigned short* G1 = Tim + 32 * TS2;
    unsigned short* G2n = G1 + 32 * TS2;
    h16_t* ACT = (h16_t*)(p->ws + OFF_ACT);
    int tid = tid_(), c = tid & 63, tg = tid >> 6;
    int lane = tid & 63, wv = tid >> 6, g = lane >> 4, r16 = lane & 15;
#define RW_ROLES() do { tid = tid_(); c = tid & 63; tg = tid >> 6; lane = c; wv = tg; g = lane >> 4; r16 = lane & 15; } while (0)
    float* cst_s = (float*)(xs + CH * XS);
    for (int item = vb; item < B_ * 16; item += nvb) {
        const int b = item / 16, h = item % 16, ch = h * 64 + c;
        __syncthreads();
        if (tid < 64) {
            const float* mu = p->in[I_RMU] + (size_t)l * RWW;
            cst_s[0 * 64 + c] = p->in[I_RW0][l * 1024 + ch]; cst_s[1 * 64 + c] = p->in[I_RA0][l * 1024 + ch]; cst_s[2 * 64 + c] = p->in[I_RKK][l * 1024 + ch]; cst_s[3 * 64 + c] = p->in[I_RKA][l * 1024 + ch];
            cst_s[4 * 64 + c] = p->in[I_RRK][(size_t)l * 1024 + ch]; cst_s[5 * 64 + c] = p->in[I_RLW][l * 1024 + ch]; cst_s[6 * 64 + c] = p->in[I_RLB][l * 1024 + ch];
            cst_s[7 * 64 + c] = mu[RW_R + ch]; cst_s[8 * 64 + c] = mu[RW_K + ch]; cst_s[9 * 64 + c] = mu[RW_V + ch];
            cst_s[10 * 64 + c] = mu[RW_WL + c]; cst_s[11 * 64 + c] = mu[RW_AL + c]; cst_s[12 * 64 + c] = mu[RW_GL + c]; cst_s[13 * 64 + c] = mu[RW_GL + 64 + c];
        }
        const float* wup = p->in[I_RWUP] + (size_t)l * 64 * 1024 + h * 64; const float* aup = p->in[I_RAUP] + (size_t)l * 64 * 1024 + h * 64; const float* gup = p->in[I_RGUP] + (size_t)l * 128 * 1024 + h * 64;
#ifndef CPU_EMU
        const int mt = wv >> 2, nt = wv & 3;
        rw_f16x8 bw[2], ba_[2], bg[4];
        {
            const int cn = nt * 16 + (lane & 15), kb = 8 * (lane >> 4);
#pragma unroll
            for (int ks = 0; ks < 2; ++ks)
#pragma unroll
                for (int j = 0; j < 8; ++j) { bw[ks][j] = (_Float16)wup[(size_t)(ks * 32 + kb + j) * 1024 + cn]; ba_[ks][j] = (_Float16)aup[(size_t)(ks * 32 + kb + j) * 1024 + cn]; }
#pragma unroll
            for (int ks = 0; ks < 4; ++ks)
#pragma unroll
                for (int j = 0; j < 8; ++j) bg[ks][j] = (_Float16)gup[(size_t)(ks * 32 + kb + j) * 1024 + cn];
        }
#endif
        facc ST[4];
#pragma unroll
        for (int jt = 0; jt < 4; ++jt) ST[jt] = facc_zero();
        uint4 pf[4];
#define RW_LOAD(t0_) do { _Pragma("unroll") for (int i = 0; i < 4; ++i) { const int j = tid + NT * i, row = j / 56, u = j % 56, t = (t0_) - 1 + row; pf[i] = zero16(); \
            if (j < (CH + 1) * 56 && t >= 0) pf[i] = ldg16(ACT + ((size_t)b * T_ + t) * LDZ + Z_RW + (u < 24 ? (u >> 3) * 1024 + h * 64 + (u & 7) * 8 : 3072 + (u - 24) * 8)); } } while (0)
#define RW_PUT() do { _Pragma("unroll") for (int i = 0; i < 4; ++i) { const int j = tid + NT * i; if (j < (CH + 1) * 56) *(uint4*)(raw + (j / 56) * 448 + (j % 56) * 8) = pf[i]; } } while (0)
        __syncthreads();
        RW_LOAD(0);
        RW_PUT();
        __syncthreads();
#pragma unroll 1
        for (int t0 = 0; t0 < T_; t0 += CH) {
            RW_ROLES();
            {
            const float mu_r = cst_s[7 * 64 + c], mu_k = cst_s[8 * 64 + c], mu_v = cst_s[9 * 64 + c], mu_wl = cst_s[10 * 64 + c], mu_al = cst_s[11 * 64 + c], mu_g0 = cst_s[12 * 64 + c], mu_g1 = cst_s[13 * 64 + c];
            float sr[4], sk[4], sv[4], swl[4], sal[4], sg0[4], sg1[4];
#pragma unroll
            for (int s = 0; s < 4; ++s) {
                const int tl = tg * 4 + s;
                const h16_t* zc = raw + (tl + 1) * 448; const h16_t* zp = raw + tl * 448;
#define RW_SHIFT(col, muv) ({ const float zz = h2f(zc[col]); zz + (muv) * (h2f(zp[col]) - zz); })
                sr[s] = RW_SHIFT(c, mu_r); sk[s] = RW_SHIFT(64 + c, mu_k); sv[s] = RW_SHIFT(128 + c, mu_v);
                swl[s] = tanhf_(RW_SHIFT(192 + c, mu_wl)); sal[s] = RW_SHIFT(256 + c, mu_al); sg0[s] = sigmoidf_(RW_SHIFT(320 + c, mu_g0)); sg1[s] = sigmoidf_(RW_SHIFT(384 + c, mu_g1));
#undef RW_SHIFT
            }
            __syncthreads();
#pragma unroll
            for (int s = 0; s < 4; ++s) {
                const int tl = tg * 4 + s;
                r_s[tl * 64 + c] = sr[s]; k_s[tl * 64 + c] = sk[s]; v_s[tl * 64 + c] = sv[s];
                xs[tl * XS + c] = f2h(swl[s]); xs[tl * XS + 64 + c] = f2h(sal[s]); xs[tl * XS + 128 + c] = f2h(sg0[s]); xs[tl * XS + 192 + c] = f2h(sg1[s]);
            }
            }
            __syncthreads();
#ifdef CPU_EMU
#pragma unroll
            for (int s = 0; s < 4; ++s) {
                const int tl = tg * 4 + s;
                float dw = 0.f, da = 0.f, dg = 0.f;
                for (int i = 0; i < 64; ++i) { dw += h2f(xs[tl * XS + i]) * h2f(f2h(wup[(size_t)i * 1024 + c])); da += h2f(xs[tl * XS + 64 + i]) * h2f(f2h(aup[(size_t)i * 1024 + c])); }
                for (int i = 0; i < 128; ++i) dg += h2f(xs[tl * XS + 128 + i]) * h2f(f2h(gup[(size_t)i * 1024 + c]));
                w_s[tl * 64 + c] = dw; ka_s[tl * 64 + c] = da; g_s[tl * 64 + c] = dg;
            }
#else
            {
                const h16_t* ap = xs + (mt * 16 + (lane & 15)) * XS + 8 * (lane >> 4);
                rw_f32x4 dw = {0.f, 0.f, 0.f, 0.f}, da = {0.f, 0.f, 0.f, 0.f}, dg = {0.f, 0.f, 0.f, 0.f};
#pragma unroll
                for (int ks = 0; ks < 2; ++ks) {
                    dw = __builtin_amdgcn_mfma_f32_16x16x32_f16(*(const rw_f16x8*)(ap + ks * 32), bw[ks], dw, 0, 0, 0);
                    da = __builtin_amdgcn_mfma_f32_16x16x32_f16(*(const rw_f16x8*)(ap + 64 + ks * 32), ba_[ks], da, 0, 0, 0);
                }
#pragma unroll
                for (int ks = 0; ks < 4; ++ks) dg = __builtin_amdgcn_mfma_f32_16x16x32_f16(*(const rw_f16x8*)(ap + 128 + ks * 32), bg[ks], dg, 0, 0, 0);
#pragma unroll
                for (int rg = 0; rg < 4; ++rg) { const int o = (mt * 16 + 4 * (lane >> 4) + rg) * 64 + nt * 16 + (lane & 15); w_s[o] = dw[rg]; ka_s[o] = da[rg]; g_s[o] = dg[rg]; }
            }
#endif
            __syncthreads();
            RW_ROLES();
            float kkn4[4], kka4[4], k24[4], rx4[4], e4[4];
            {
            const float w0 = cst_s[0 * 64 + c], a0 = cst_s[1 * 64 + c], k_k = cst_s[2 * 64 + c], k_a = cst_s[3 * 64 + c], rk_c = cst_s[4 * 64 + c];
#pragma unroll
            for (int s = 0; s < 4; ++s) {
                const int tl = tg * 4 + s;
                const float w_log = -softplusf_(-(w0 + w_s[tl * 64 + c])) - 0.5f;
                const float a = sigmoidf_(a0 + ka_s[tl * 64 + c]);
                const float kx = k_s[tl * 64 + c], rx = r_s[tl * 64 + c];
                const float kkr = kx * k_k, k2 = kx * (1.0f + (a - 1.0f) * k_a);
                const float nsq = group_sum(kkr * kkr, 64, scr);
                const float bon = group_sum(rx * k2 * rk_c, 64, scr);
                const float kkn = kkr * rsqrtf(nsq + RMS_EPS);
                e4[s] = fexp_(w_log);
                kkn4[s] = kkn; kka4[s] = kkn * a; k24[s] = k2; rx4[s] = rx;
                if (c == 0) bon_s[tl] = bon;
            }
            gs_s[tg * 64 + c] = (e4[0] + e4[1]) + (e4[2] + e4[3]);
            }
            __syncthreads();
            RW_ROLES();
            {
                float pre = 0.f, PC = 0.f;
#pragma unroll
                for (int gq = 0; gq < 8; ++gq) { const float gv = gs_s[gq * 64 + c]; PC += gv; pre += gq < tg ? gv : 0.f; }
                if (tg == 0) gC_s[c] = fexp_(-PC);
                float vt4[4], ct4[4], bt4[4];
#pragma unroll
                for (int s = 0; s < 4; ++s) {
                    const int tl = tg * 4 + s;
                    const float Pm = pre; pre += e4[s];
                    const float P = pre;
                    const float gt = fexp_(-P), gm = fexp_(-Pm), ig = fexp_(P), gcr = fexp_(P - PC);
                    Aim[tl * IS + c] = f2bf_(kkn4[s] * gm); Rim[tl * IS + c] = f2bf_(rx4[s] * gt); Bim[tl * IS + c] = f2bf_(kka4[s] * ig); Cim[tl * IS + c] = f2bf_(k24[s] * ig);
                    vt4[s] = v_s[tl * 64 + c]; ct4[s] = k24[s] * gcr; bt4[s] = -kka4[s] * gcr;
                }
                uint2 w2;
                w2.x = pack2bf(vt4[0], vt4[1]); w2.y = pack2bf(vt4[2], vt4[3]); *(uint2*)(Vt + c * TS2 + tg * 4) = w2;
                w2.x = pack2bf(ct4[0], ct4[1]); w2.y = pack2bf(ct4[2], ct4[3]); *(uint2*)(Ct + c * TS2 + tg * 4) = w2;
                w2.x = pack2bf(bt4[0], bt4[1]); w2.y = pack2bf(bt4[2], bt4[3]); *(uint2*)(Btn + c * TS2 + tg * 4) = w2;
                if (tid < 384) { unsigned short* im = tid < 128 ? Nim : (tid < 256 ? G1 : G2n); const int e = tid & 127; *(unsigned*)(im + (e >> 3) * TS2 + 16 + (e & 7) * 2) = 0u; }
            }
            __syncthreads();
            RW_ROLES();
#pragma unroll 1
            for (int jr = 0; jr < 2; ++jr) {
                const int jb = WAVE_UNIFORM(wv) + 8 * jr; const bool valid = jb < 12;
                const int prod = valid ? jb / 3 : 0, tix = valid ? jb % 3 : 0, ti = tix > 0 ? 1 : 0, tj = tix > 1 ? 1 : 0;
                const unsigned short* xp = (prod < 2 ? Aim : Rim) + (16 * ti + r16) * IS + 8 * g;
                const unsigned short* yp = ((prod == 0 || prod == 3) ? Bim : Cim) + (16 * tj + r16) * IS + 8 * g;
                facc acc = facc_zero();
#pragma unroll
                for (int ks = 0; ks < 2; ++ks) acc = mfma16b(bfrag_ld(xp + 32 * ks), bfrag_ld(yp + 32 * ks), acc);
                if (valid) {
                    const int s = 16 * tj + r16;
#pragma unroll
                    for (int reg = 0; reg < 4; ++reg) {
                        const int t = 16 * ti + 4 * g + reg;
                        if (prod == 0) L32[t * LS + (s & 7) * 4 + (s >> 3)] = t > s ? acc[reg] : 0.f;
                        else if (prod == 1) Nim[t * TS2 + s] = f2bf_(t > s ? acc[reg] : 0.f);
                        else if (prod == 2) G1[t * TS2 + s] = f2bf_(t >= s ? acc[reg] : 0.f);
                        else G2n[t * TS2 + s] = f2bf_(t >= s ? -acc[reg] : 0.f);
                    }
                }
            }
            __syncthreads();
            RW_ROLES();
            if (tid < 256) {
                const int cc = tid >> 3, q = tid & 7;
                float x[4] = {0.f, 0.f, 0.f, 0.f};
#pragma unroll
                for (int rb8 = 0; rb8 < 4; ++rb8) {
                    float4 a4[8];
#pragma unroll
                    for (int i = 0; i < 8; ++i) { a4[i] = make_float4(0.f, 0.f, 0.f, 0.f); if (rb8 * 8 + i > 0) a4[i] = *(const float4*)(L32 + (rb8 * 8 + i) * LS + q * 4); }
#pragma unroll
                    for (int i = 0; i < 8; ++i) {
                        const int r = rb8 * 8 + i;
                        float sacc = 0.f;
                        if (r > 0) {
                            sacc = a4[i].x * x[0];
                            if (r > 8) sacc += a4[i].y * x[1];
                            if (r > 16) sacc += a4[i].z * x[2];
                            if (r > 24) sacc += a4[i].w * x[3];
                            sacc = group_sum(sacc, 8, scr);
                        }
                        const float xr = ((r == cc) ? 1.f : 0.f) - sacc;
                        x[r >> 3] = (q == (r & 7)) ? xr : x[r >> 3];
                        Tim[r * TS2 + cc] = f2bf_(xr);
                    }
                }
            }
#ifdef CPU_EMU
            else { for (int r = 1; r < 32; ++r) (void)group_sum(0.f, 8, scr); }
#endif
            __syncthreads();
            if (t0 + CH < T_) RW_LOAD(t0 + CH);
            RW_ROLES();
            {
                const int it = wv & 3;
                const bfrag vtf = bfrag_ld(Vt + (16 * it + r16) * TS2 + 8 * g);
                bfrag fa[2][2], fr_[2][2], fn[2], fg1[2], ft[2], fg2[2], fc[4], fb[4];
                float gcv[4][4];
#pragma unroll
                for (int tt = 0; tt < 2; ++tt) {
                    const unsigned short* arow = Aim + (16 * tt + r16) * IS; const unsigned short* rrow = Rim + (16 * tt + r16) * IS;
                    fa[tt][0] = bpermfrag(arow, 0, g); fa[tt][1] = bpermfrag(arow, 1, g); fr_[tt][0] = bpermfrag(rrow, 0, g); fr_[tt][1] = bpermfrag(rrow, 1, g);
                    fn[tt] = bfrag_ld(Nim + (16 * tt + r16) * TS2 + 8 * g); fg1[tt] = bfrag_ld(G1 + (16 * tt + r16) * TS2 + 8 * g);
                    ft[tt] = bpermfrag(Tim + (16 * tt + r16) * TS2, 0, g); fg2[tt] = bpermfrag(G2n + (16 * tt + r16) * TS2, 0, g);
                }
#pragma unroll
                for (int jt = 0; jt < 4; ++jt) {
                    fc[jt] = bfrag_ld(Ct + (16 * jt + r16) * TS2 + 8 * g); fb[jt] = bpermfrag(Btn + (16 * jt + r16) * TS2, 0, g);
#pragma unroll
                    for (int reg = 0; reg < 4; ++reg) gcv[jt][reg] = gC_s[16 * jt + 4 * g + reg];
                }
                MIX_SCHEDB();
                bfrag STb[2];
                STb[0] = bfrag_acc2(ST[0], ST[1]); STb[1] = bfrag_acc2(ST[2], ST[3]);
                facc rhs[2], oo[2];
#pragma unroll
                for (int tt = 0; tt < 2; ++tt) {
                    rhs[tt] = mfma16b(fa[tt][0], STb[0], facc_zero()); rhs[tt] = mfma16b(fa[tt][1], STb[1], rhs[tt]);
                    rhs[tt] = mfma16b(fn[tt], vtf, rhs[tt]);
                    oo[tt] = mfma16b(fr_[tt][0], STb[0], facc_zero()); oo[tt] = mfma16b(fr_[tt][1], STb[1], oo[tt]);
                    oo[tt] = mfma16b(fg1[tt], vtf, oo[tt]);
                }
                const bfrag rhsb = bfrag_acc2(rhs[0], rhs[1]);
                facc uu[2];
#pragma unroll
                for (int tt = 0; tt < 2; ++tt) uu[tt] = mfma16b(ft[tt], rhsb, facc_zero());
                const bfrag ub = bfrag_acc2(uu[0], uu[1]);
#pragma unroll
                for (int tt = 0; tt < 2; ++tt) {
                    oo[tt] = mfma16b(fg2[tt], ub, oo[tt]);
                    if (wv < 4) {
#pragma unroll
                        for (int reg = 0; reg < 4; ++reg) o_s[(16 * tt + 4 * g + reg) * 64 + 16 * it + r16] = oo[tt][reg];
                    }
                }
#pragma unroll
                for (int jt = 0; jt < 4; ++jt) {
#pragma unroll
                    for (int reg = 0; reg < 4; ++reg) ST[jt][reg] *= gcv[jt][reg];
                    ST[jt] = mfma16b(fc[jt], vtf, ST[jt]);
                    ST[jt] = mfma16b(fb[jt], ub, ST[jt]);
                }
            }
            __syncthreads();
            RW_ROLES();
            {
            const float lnw = cst_s[5 * 64 + c], lnb = cst_s[6 * 64 + c];
            const int chh = h * 64 + c;
#pragma unroll
            for (int s = 0; s < 4; ++s) {
                const int tl = tg * 4 + s;
                const float ov = o_s[tl * 64 + c];
                const float mean = group_sum(ov, 64, scr) * (1.0f / 64.0f);
                const float d = ov - mean;
                const float var = group_sum(d * d, 64, scr) * (1.0f / 64.0f);
                const float y = (d * rsqrtf(var + GN_EPS) * lnw + lnb + bon_s[tl] * v_s[tl * 64 + c]) * g_s[tl * 64 + c];
                ACT[((size_t)b * T_ + t0 + tl) * LDZ + C_YC + chh] = f2h(y);
            }
            }
            RW_ROLES();
            if (t0 + CH < T_) RW_PUT();
            __syncthreads();
        }
#undef RW_LOAD
#undef RW_PUT
#undef RW_ROLES
    }
}
constexpr bool TAB_IN_ACT = false;
constexpr float TAB_SU = 256.0f, TAB_SV = 32.0f;
__device__ __forceinline__ unsigned char* tab_row(char* ws, int e) {
    if (TAB_IN_ACT) return (unsigned char*)((h16_t*)(ws + OFF_ACT) + (size_t)e * LDZ + C_GS);
    return (unsigned char*)(ws + OFF_TAB) + (size_t)e * 2048;
}
#ifdef CPU_EMU
__device__ __forceinline__ unsigned f2fp8(float f) {
    const unsigned sgn = f < 0.f ? 0x80u : 0u; float a = fabsf(f);
    if (!(a == a)) return 0x7fu;
    if (a >= 448.0f) return sgn | 0x7eu;
    if (a < 0.0009765625f) return sgn;
    int e; frexpf(a, &e); e -= 1;
    if (e < -6) { const float q = nearbyintf(a * 512.0f); return sgn | (unsigned)q; }
    float q = nearbyintf((a / ldexpf(1.0f, e) - 1.0f) * 8.0f);
    if (q >= 8.0f) { q = 0.f; e += 1; }
    if (e > 8) return sgn | 0x7eu;
    const unsigned r = ((unsigned)(e + 7) << 3) | (unsigned)q;
    return sgn | (r > 0x7eu ? 0x7eu : r);
}
__device__ __forceinline__ float fp82f(unsigned b) {
    const unsigned e = (b >> 3) & 15u, m = b & 7u; const float s = (b & 0x80u) ? -1.f : 1.f;
    if (e == 0) return s * (float)m * 0.001953125f;
    return s * ldexpf(1.0f + (float)m * 0.125f, (int)e - 7);
}
__device__ __forceinline__ unsigned pack4fp8(float a, float b, float c, float d) { return f2fp8(a) | (f2fp8(b) << 8) | (f2fp8(c) << 16) | (f2fp8(d) << 24); }
__device__ __forceinline__ void dec4fp8(unsigned w, float* o) { o[0] = fp82f(w & 255u); o[1] = fp82f((w >> 8) & 255u); o[2] = fp82f((w >> 16) & 255u); o[3] = fp82f(w >> 24); }
#else
__device__ __forceinline__ unsigned pack4fp8(float a, float b, float c, float d) { int p = __builtin_amdgcn_cvt_pk_fp8_f32(a, b, 0, false); p = __builtin_amdgcn_cvt_pk_fp8_f32(c, d, p, true); return (unsigned)p; }
__device__ __forceinline__ void dec4fp8(unsigned w, float* o) { const auto lo = __builtin_amdgcn_cvt_pk_f32_fp8((int)w, false); const auto hi = __builtin_amdgcn_cvt_pk_f32_fp8((int)w, true); o[0] = lo[0]; o[1] = lo[1]; o[2] = hi[0]; o[3] = hi[1]; }
#endif
__device__ __forceinline__ void stage_tabconv(KParams p, int l, int vb0, int nvb) {
    const int vb = bid_() - vb0;
    if (vb < 0 || vb >= nvb) return;
    const int tid = tid_();
    const float* U = p->in[I_PU] + (size_t)l * 16384 * 1024; const float* V = p->in[I_PV] + (size_t)l * 16384 * 1024;
    char* ws = p->ws;
    for (int it = vb * NT + tid; it < 16384 * 128; it += nvb * NT) {
        const int r = it >> 7, ck = it & 127, which = ck >> 6, c16 = ck & 63;
        const float* src = (which ? V : U) + (size_t)r * 1024 + c16 * 16;
        const float sc = which ? TAB_SV : TAB_SU;
        const float4 a = *(const float4*)src, b = *(const float4*)(src + 4), c = *(const float4*)(src + 8), d = *(const float4*)(src + 12);
        uint4 w;
        w.x = pack4fp8(a.x * sc, a.y * sc, a.z * sc, a.w * sc); w.y = pack4fp8(b.x * sc, b.y * sc, b.z * sc, b.w * sc);
        w.z = pack4fp8(c.x * sc, c.y * sc, c.z * sc, c.w * sc); w.w = pack4fp8(d.x * sc, d.y * sc, d.z * sc, d.w * sc);
        *(uint4*)(tab_row(ws, r) + which * 1024 + c16 * 16) = w;
    }
}

#ifdef CPU_EMU
__device__ __forceinline__ float group_max16(float v, float* scr) {
    const int tid = tid_();
    scr[tid] = v;
    __syncthreads();
    float m = -3.0e38f; const int base = tid & ~15;
    for (int i = 0; i < 16; ++i) m = fmaxf(m, scr[base + i]);
    __syncthreads();
    return m;
}
#else
__device__ __forceinline__ float group_max16(float v, float*) {
    v = fmaxf(v, dpp_f<0xB1>(v)); v = fmaxf(v, dpp_f<0x4E>(v)); v = fmaxf(v, dpp_f<0x141>(v)); v = fmaxf(v, dpp_f<0x140>(v));
    return v;
}
#endif
#ifdef CPU_EMU
#define TK_SCHEDB()
#else
#define TK_SCHEDB() __builtin_amdgcn_sched_barrier(0)
#endif
__device__ __forceinline__ void stage_peer_topk(KParams p, int l, char* smem) {
    constexpr int KS = 136;
    h16_t* khi = (h16_t*)smem;
    h16_t* klo = khi + 128 * KS;
    float* scr = (float*)(klo + 128 * KS);
    const h16_t* ACT = (const h16_t*)(p->ws + OFF_ACT);
    float* TOPS = (float*)(p->ws + OFF_TOPS);
    int tid = tid_(), lane = tid & 63, w = tid >> 6, g = lane >> 4, r16 = lane & 15;
#define TK_ROLES() do { tid = tid_(); lane = tid & 63; w = tid >> 6; g = lane >> 4; r16 = lane & 15; } while (0)
    const int nb = gridDim.x;
    for (int hs = bid_() % 16; hs < 16; hs += nb) {
        const int hd = hs >> 1, s = hs & 1;
        __syncthreads();
        {
            const float* kp = p->in[I_PKEYS] + (((size_t)l * 8 + hd) * 2 + s) * 128 * 128;
            for (int i = tid * 4; i < 128 * 128; i += NT * 4) {
                const float4 kv = *(const float4*)(kp + i);
                const int n = i >> 7, c0 = i & 127;
                const float h0 = h2f(f2h(kv.x)), h1 = h2f(f2h(kv.y)), h2 = h2f(f2h(kv.z)), h3 = h2f(f2h(kv.w));
                uint2 hw, lw; hw.x = pack2h(kv.x, kv.y); hw.y = pack2h(kv.z, kv.w); lw.x = pack2h(kv.x - h0, kv.y - h1); lw.y = pack2h(kv.z - h2, kv.w - h3);
                *(uint2*)(khi + n * KS + c0) = hw; *(uint2*)(klo + n * KS + c0) = lw;
            }
        }
        __syncthreads();
        const int nblk = nb >= 16 ? nb / 16 : 1, bsub = nb >= 16 ? bid_() / 16 : 0;
        for (int chunk = bsub; chunk < (M_ + NT - 1) / NT; chunk += nblk) {
            if (nb >= 16 && bid_() >= nblk * 16) break;
#pragma unroll 1
            for (int tt = 0; tt < 4; ++tt) {
                TK_ROLES();
                const int tok0 = chunk * NT + w * 64 + tt * 16;
                const bool live = tok0 < M_;
                hfrag af[4];
                {
                    const h16_t* qp = ACT + (size_t)(live ? tok0 + r16 : 0) * LDZ + C_QRY + hd * 256 + s * 128 + 8 * g;
#pragma unroll
                    for (int ks = 0; ks < 4; ++ks) af[ks] = frag_u4(*(const uint4*)(qp + 32 * ks));
                }
                facc acc[8];
                hfrag kb[2][8];
#define TK_LDK(buf_, nt_) do { const h16_t* bh = khi + (16 * (nt_) + r16) * KS + 8 * g; const h16_t* bl = klo + (16 * (nt_) + r16) * KS + 8 * g; \
                    _Pragma("unroll") for (int ks = 0; ks < 4; ++ks) { kb[buf_][2 * ks] = frag_u4(*(const uint4*)(bh + 32 * ks)); kb[buf_][2 * ks + 1] = frag_u4(*(const uint4*)(bl + 32 * ks)); } } while (0)
                TK_LDK(0, 0);
#pragma unroll
                for (int nt = 0; nt < 8; ++nt) {
                    if (nt + 1 < 8) TK_LDK((nt + 1) & 1, nt + 1);
                    TK_SCHEDB();
                    acc[nt] = facc_zero();
#pragma unroll
                    for (int ks = 0; ks < 4; ++ks) { acc[nt] = mfma16(af[ks], kb[nt & 1][2 * ks], acc[nt]); acc[nt] = mfma16(af[ks], kb[nt & 1][2 * ks + 1], acc[nt]); }
                    TK_SCHEDB();
                }
#undef TK_LDK
#pragma unroll 1
                for (int rp = 0; rp < 2; ++rp) {
                  TK_ROLES();
#pragma unroll
                  for (int r2 = 0; r2 < 2; ++r2) {
                    const int reg = rp * 2 + r2;
                    float v[8];
#pragma unroll
                    for (int nt = 0; nt < 8; ++nt) { const float av = rp == 0 ? (r2 == 0 ? acc[nt][0] : acc[nt][1]) : (r2 == 0 ? acc[nt][2] : acc[nt][3]); v[nt] = __uint_as_float((__float_as_uint(av) & ~127u) | (unsigned)(127 - (16 * nt + r16))); }
#define CE(i, j) { const float hi_ = fmaxf(v[i], v[j]), lo_ = fminf(v[i], v[j]); v[i] = hi_; v[j] = lo_; }
                    CE(0, 1) CE(2, 3) CE(4, 5) CE(6, 7) CE(0, 2) CE(1, 3) CE(4, 6) CE(5, 7) CE(1, 2) CE(5, 6) CE(0, 4) CE(1, 5) CE(2, 6) CE(3, 7) CE(2, 4) CE(3, 5) CE(1, 2) CE(3, 4) CE(5, 6)
#undef CE
                    float res = 0.f;
#pragma unroll
                    for (int rnd = 0; rnd < 16; ++rnd) {
                        const float m = group_max16(v[0], scr);
                        const bool win = v[0] == m;
#pragma unroll
                        for (int i = 0; i < 7; ++i) v[i] = win ? v[i + 1] : v[i];
                        v[7] = win ? -3.0e38f : v[7];
                        res = (r16 == rnd) ? m : res;
                    }
                    if (live) TOPS[(((size_t)(tok0 + 4 * g + reg) * 8 + hd) * 2 + s) * 16 + r16] = res;
                  }
                }
            }
        }
    }
}

#undef TK_ROLES
__device__ __forceinline__ void peer_cand(int k, int& i, int& j) {
    if (k < 16) { i = 0; j = k; } else if (k < 24) { i = 1; j = k - 16; } else if (k < 29) { i = 2; j = k - 24; } else if (k < 33) { i = 3; j = k - 29; }
    else if (k < 36) { i = 4; j = k - 33; } else if (k < 38) { i = 5; j = k - 36; } else if (k < 40) { i = 6; j = k - 38; } else if (k < 42) { i = 7; j = k - 40; }
    else { i = k - 34; j = 0; }
}
#ifdef CPU_EMU
__device__ __forceinline__ float dot16q(const uint4 a, const unsigned (&xh)[8]) {
    const unsigned aw[4] = {a.x, a.y, a.z, a.w};
    float s = 0.f;
    for (int i = 0; i < 4; ++i) { float t[4]; dec4fp8(aw[i], t);
        for (int j = 0; j < 2; ++j) { const unsigned xw = xh[2 * i + j]; unsigned short lo = (unsigned short)(xw & 0xffffu), hi = (unsigned short)(xw >> 16); h16_t hl, hh; memcpy(&hl, &lo, 2); memcpy(&hh, &hi, 2);
            s += t[2 * j] * h2f(hl) + t[2 * j + 1] * h2f(hh); } }
    return s;
}
#else
typedef _Float16 pg_h2 __attribute__((ext_vector_type(2)));
__device__ __forceinline__ float dot16q(const uint4 a, const unsigned (&xh)[8]) {
    float s0, s1;
    s0 = __builtin_amdgcn_fdot2(__builtin_amdgcn_cvt_scalef32_pk_f16_fp8(a.x, 1.0f, false), __builtin_bit_cast(pg_h2, xh[0]), 0.f, false);
    s1 = __builtin_amdgcn_fdot2(__builtin_amdgcn_cvt_scalef32_pk_f16_fp8(a.x, 1.0f, true), __builtin_bit_cast(pg_h2, xh[1]), 0.f, false);
    s0 = __builtin_amdgcn_fdot2(__builtin_amdgcn_cvt_scalef32_pk_f16_fp8(a.y, 1.0f, false), __builtin_bit_cast(pg_h2, xh[2]), s0, false);
    s1 = __builtin_amdgcn_fdot2(__builtin_amdgcn_cvt_scalef32_pk_f16_fp8(a.y, 1.0f, true), __builtin_bit_cast(pg_h2, xh[3]), s1, false);
    s0 = __builtin_amdgcn_fdot2(__builtin_amdgcn_cvt_scalef32_pk_f16_fp8(a.z, 1.0f, false), __builtin_bit_cast(pg_h2, xh[4]), s0, false);
    s1 = __builtin_amdgcn_fdot2(__builtin_amdgcn_cvt_scalef32_pk_f16_fp8(a.z, 1.0f, true), __builtin_bit_cast(pg_h2, xh[5]), s1, false);
    s0 = __builtin_amdgcn_fdot2(__builtin_amdgcn_cvt_scalef32_pk_f16_fp8(a.w, 1.0f, false), __builtin_bit_cast(pg_h2, xh[6]), s0, false);
    s1 = __builtin_amdgcn_fdot2(__builtin_amdgcn_cvt_scalef32_pk_f16_fp8(a.w, 1.0f, true), __builtin_bit_cast(pg_h2, xh[7]), s1, false);
    return s0 + s1;
}
#endif
__device__ __forceinline__ void axpy16q(const uint4 a, float s, float (&y)[16]) {
    float t[4];
    dec4fp8(a.x, t); y[0] += s * t[0]; y[1] += s * t[1]; y[2] += s * t[2]; y[3] += s * t[3];
    dec4fp8(a.y, t); y[4] += s * t[0]; y[5] += s * t[1]; y[6] += s * t[2]; y[7] += s * t[3];
    dec4fp8(a.z, t); y[8] += s * t[0]; y[9] += s * t[1]; y[10] += s * t[2]; y[11] += s * t[3];
    dec4fp8(a.w, t); y[12] += s * t[0]; y[13] += s * t[1]; y[14] += s * t[2]; y[15] += s * t[3];
}
#ifdef CPU_EMU
__device__ __forceinline__ float lane_xor(float v, int mask, float* scr) { const int tid = tid_(); scr[tid] = v; __syncthreads(); const float r = scr[tid ^ mask]; __syncthreads(); return r; }
__device__ __forceinline__ float lane_bcast(float v, int src, float* scr) { const int tid = tid_(); scr[tid] = v; __syncthreads(); const float r = scr[(tid & ~63) + src]; __syncthreads(); return r; }
#else
__device__ __forceinline__ float lane_xor(float v, int mask, float*) { return mask == 1 ? dpp_f<0xB1>(v) : (mask == 2 ? dpp_f<0x4E>(v) : __shfl_xor(v, mask)); }
__device__ __forceinline__ float lane_bcast(float v, int src, float*) { return __builtin_bit_cast(float, __builtin_amdgcn_readlane(__builtin_bit_cast(int, v), src)); }
#endif
__device__ __forceinline__ float reduce8(const float (&v)[8], int lane, float* scr) {
    const bool b0 = lane & 1, b1 = lane & 2, b2 = lane & 4;
    float w4[4], u2[2];
#pragma unroll
    for (int j = 0; j < 4; ++j) { const float keep = b0 ? v[2 * j + 1] : v[2 * j], send = b0 ? v[2 * j] : v[2 * j + 1]; w4[j] = keep + lane_xor(send, 1, scr); }
#pragma unroll
    for (int j = 0; j < 2; ++j) { const float keep = b1 ? w4[2 * j + 1] : w4[2 * j], send = b1 ? w4[2 * j] : w4[2 * j + 1]; u2[j] = keep + lane_xor(send, 2, scr); }
    float z = (b2 ? u2[1] : u2[0]) + lane_xor(b2 ? u2[0] : u2[1], 4, scr);
    z += lane_xor(z, 8, scr); z += lane_xor(z, 16, scr); z += lane_xor(z, 32, scr);
    return z;
}
#ifdef CPU_EMU
#define PG_WSYNC() __syncthreads()
#else
#define PG_WSYNC() do { __builtin_amdgcn_fence(__ATOMIC_RELEASE, "wavefront"); __builtin_amdgcn_wave_barrier(); __builtin_amdgcn_fence(__ATOMIC_ACQUIRE, "wavefront"); } while (0)
#endif
__device__ __forceinline__ void stage_peer_gather(KParams p, int l, char* smem) {
    int tid = tid_(), w = tid >> 6, lane = tid & 63;
    float* base; float* tops_s; float* cand_s; float* best_s; int* idx_s; float* gate_s;
#define PG_ROLES() do { tid = tid_(); w = tid >> 6; lane = tid & 63; base = (float*)smem + w * 2048; tops_s = base; cand_s = tops_s + 256; best_s = cand_s + 512; \
        idx_s = (int*)(best_s + 128); gate_s = (float*)(idx_s + 128); } while (0)
    PG_ROLES();
    float* scr = (float*)smem + 8 * 2048;
    h16_t* ACT = (h16_t*)(p->ws + OFF_ACT);
    const float* TOPS = (const float*)(p->ws + OFF_TOPS);
    char* ws = p->ws;
    const float* nxt_w = (l + 1 < NL_) ? p->in[I_NMIX] + (l + 1) * 1024 : p->in[I_NFINAL];
    const int nwaves = gridDim.x * 8;
    for (int m = bid_() * 8 + w; m < M_; m += nwaves) {
        PG_ROLES();
        PG_WSYNC();
        *(float4*)(tops_s + lane * 4) = *(const float4*)(TOPS + (size_t)m * 256 + lane * 4);
        unsigned x[8];
        { const uint4 x0 = *(const uint4*)(ACT + (size_t)m * LDZ + C_XN + lane * 16), x1 = *(const uint4*)(ACT + (size_t)m * LDZ + C_XN + lane * 16 + 8);
          x[0] = x0.x; x[1] = x0.y; x[2] = x0.z; x[3] = x0.w; x[4] = x1.x; x[5] = x1.y; x[6] = x1.z; x[7] = x1.w; }
        PG_WSYNC();
        int ci = 0, cj = 0;
        peer_cand(lane < 50 ? lane : 0, ci, cj);
#pragma unroll
        for (int hd = 0; hd < 8; ++hd) cand_s[hd * 64 + lane] = lane < 50 ? tops_s[hd * 32 + ci] + tops_s[hd * 32 + 16 + cj] : -3.0e38f;
        PG_WSYNC();
#pragma unroll 1
        for (int hd = 0; hd < 8; ++hd) {
            const float cs = cand_s[hd * 64 + lane];
            int cnt = 0;
#pragma unroll
            for (int q = 0; q < 13; ++q) {
                const float4 c4 = *(const float4*)(cand_s + hd * 64 + q * 4);
                cnt += (int)(c4.x > cs) + (int)(c4.y > cs) + (int)(c4.z > cs) + (int)(c4.w > cs);
            }
            if (group_sum(lane < 50 ? (float)cnt : 0.f, 64, scr) != 1225.0f) {
                cnt = 0;
#pragma unroll 1
                for (int o = 0; o < 50; ++o) { const float ov = cand_s[hd * 64 + o]; cnt += (int)((ov > cs) | ((ov == cs) & (o < lane))); }
                if (lane >= 50) cnt = 64;
            }
            if (cnt < 16) {
                best_s[hd * 16 + cnt] = cs;
                const int n0 = 127 - (int)(__float_as_uint(tops_s[hd * 32 + ci]) & 127u), n1 = 127 - (int)(__float_as_uint(tops_s[hd * 32 + 16 + cj]) & 127u);
                idx_s[hd * 16 + cnt] = n0 * 128 + n1;
            }
        }
        PG_WSYNC();
#pragma unroll
        for (int rr = 0; rr < 2; ++rr) {
            const int e = lane + 64 * rr, hd = e >> 4;
            const float ex = fexp_(best_s[e] - best_s[hd * 16]);
            gate_s[e] = ex / group_sum(ex, 16, scr);
        }
        PG_WSYNC();
        float y[16];
#pragma unroll
        for (int i = 0; i < 16; ++i) y[i] = 0.f;
        PG_ROLES();
        uint4 uu[8], vv[8];
#define PG_LOADU(eb_) do { _Pragma("unroll") for (int k = 0; k < 8; ++k) uu[k] = *(const uint4*)(tab_row(ws, idx_s[(eb_) + k]) + lane * 16); } while (0)
#define PG_LOADV(eb_) do { _Pragma("unroll") for (int k = 0; k < 8; ++k) vv[k] = *(const uint4*)(tab_row(ws, idx_s[(eb_) + k]) + 1024 + lane * 16); } while (0)
        PG_LOADU(0); PG_LOADV(0);
#pragma unroll 1
        for (int eb = 0; eb < 128; eb += 8) {
            float d8[8];
#pragma unroll
            for (int k = 0; k < 8; ++k) d8[k] = dot16q(uu[k], x);
            if (eb + 8 < 128) PG_LOADU(eb + 8);
            const float tot = reduce8(d8, lane, scr);
            const float hk = gate_s[eb + (lane & 7)] * geluf_(tot * (1.0f / TAB_SU));
#pragma unroll
            for (int k = 0; k < 8; ++k) axpy16q(vv[k], lane_bcast(hk, k, scr), y);
            if (eb + 8 < 128) PG_LOADV(eb + 8);
        }
#undef PG_LOADU
#undef PG_LOADV
        PG_ROLES();
        float* op = p->out + (size_t)m * 1024 + lane * 16;
        float hn[16]; float ss = 0.f;
#pragma unroll
        for (int i = 0; i < 16; i += 4) {
            const float4 o4 = *(const float4*)(op + i);
            hn[i] = o4.x + y[i] * (1.0f / TAB_SV); hn[i + 1] = o4.y + y[i + 1] * (1.0f / TAB_SV); hn[i + 2] = o4.z + y[i + 2] * (1.0f / TAB_SV); hn[i + 3] = o4.w + y[i + 3] * (1.0f / TAB_SV);
            ss += hn[i] * hn[i] + hn[i + 1] * hn[i + 1] + hn[i + 2] * hn[i + 2] + hn[i + 3] * hn[i + 3];
        }
        ss = group_sum(ss, 64, scr);
        const float rstd = rsqrtf(ss * (1.0f / D_) + RMS_EPS);
        float nv[16];
#pragma unroll
        for (int i = 0; i < 16; i += 4) { const float4 w4 = *(const float4*)(nxt_w + lane * 16 + i); nv[i] = hn[i] * rstd * w4.x; nv[i + 1] = hn[i + 1] * rstd * w4.y; nv[i + 2] = hn[i + 2] * rstd * w4.z; nv[i + 3] = hn[i + 3] * rstd * w4.w; }
        if (l + 1 < NL_) {
#pragma unroll
            for (int i = 0; i < 16; i += 4) *(float4*)(op + i) = make_float4(hn[i], hn[i + 1], hn[i + 2], hn[i + 3]);
            const float n0[8] = {nv[0], nv[1], nv[2], nv[3], nv[4], nv[5], nv[6], nv[7]}, n1[8] = {nv[8], nv[9], nv[10], nv[11], nv[12], nv[13], nv[14], nv[15]};
            store8h(ACT + (size_t)m * LDZ + C_XN + lane * 16, n0); store8h(ACT + (size_t)m * LDZ + C_XN + lane * 16 + 8, n1);
        } else {
#pragma unroll
            for (int i = 0; i < 16; i += 4) *(float4*)(op + i) = make_float4(nv[i], nv[i + 1], nv[i + 2], nv[i + 3]);
        }
    }
}
#undef PG_ROLES
#undef PG_WSYNC

enum { PH_NORM_MIX = 0, PH_INPROJ, PH_MIXERS, PH_MERGE, PH_WOUT, PH_NORM_FFN, PH_QUERY, PH_TOPK, PH_GATHER, PH_PER_LAYER, PH_FINAL = 100, PH_WPREP = 101 };
__device__ __forceinline__ void run_phase(KParams p, int l, int ph, char* smem) {
    h16_t* ACT = (h16_t*)(p->ws + OFF_ACT);
    const float* hin = l == 0 ? p->in[I_X] : p->out;
    switch (ph) {
    case PH_WPREP: stage_wprep(p, smem); break;
    case PH_NORM_MIX: if (l == 0) stage_rmsnorm(hin, p->in[I_NMIX] + l * 1024, ACT + C_XN, LDZ, smem); break;
    case PH_INPROJ: stage_gemm(p, l, GP_INPROJ, smem); break;
    case PH_MIXERS: {
        const int nb = gridDim.x, n_rw = nb / 2, n_gd = nb / 4, n_lr = nb - n_rw - n_gd;
        stage_rwkv(p, l, smem, 0, n_rw);
        stage_gdn(p, l, smem, n_rw, n_gd);
        stage_lru(p, l, smem, n_rw + n_gd, n_lr);
        stage_tabconv(p, l, 0, n_rw);
        __syncthreads();
        stage_gemm_on(p, l, GP_PREGATE, smem, n_rw + n_gd, n_lr);
    } break;
    case PH_MERGE: stage_gemm(p, l, GP_MERGE, smem); break;
    case PH_WOUT: stage_gemm(p, l, GP_WOUT, smem); break;
    case PH_NORM_FFN: stage_rmsnorm(p->out, p->in[I_NFFN] + l * 1024, ACT + C_XN, LDZ, smem); break;
    case PH_QUERY: stage_gemm(p, l, GP_QUERY, smem); break;
    case PH_TOPK: stage_peer_topk(p, l, smem); break;
    case PH_GATHER: stage_peer_gather(p, l, smem); break;
    case PH_FINAL: break;
    default: break;
    }
}


#if !defined(CPU_EMU) && !MK_MULTI
#define XB_TMO      128
#define XB_XCNT(j)  (256  + 64 * (j))
#define XB_XSUB(j)  (1280 + 64 * (j))
#define XB_XGEN(j)  (2304 + 64 * (j))
#define XB_TOP      3328
#define XB_TOPGEN   3392
#define XCD_BAR_WORDS 3456
#define XB_SPIN_CAP (1u << 22)
#define XB_LAS __attribute__((address_space(3)))
__device__ __forceinline__ unsigned xb_ld(unsigned* p)              { return __hip_atomic_load(p, __ATOMIC_RELAXED, __HIP_MEMORY_SCOPE_AGENT); }
__device__ __forceinline__ unsigned xb_add(unsigned* p, unsigned v) { return __hip_atomic_fetch_add(p, v, __ATOMIC_RELAXED, __HIP_MEMORY_SCOPE_AGENT); }
__device__ __forceinline__ unsigned xb_xcc_id() { return (unsigned)__builtin_amdgcn_s_getreg((3 << 11) | 20) & 0xFu; }
#define XB_SPIN(cond, bar) do { unsigned _sp = 0; while (cond) { __builtin_amdgcn_s_sleep(1); \
    if ((++_sp & 255u) == 0u) { if (xb_ld(&(bar)[XB_TMO])) break; if (_sp > XB_SPIN_CAP) { atomicAdd(&(bar)[XB_TMO], 1u); break; } } } } while (0)
struct XcdBarrier { unsigned* bar; unsigned x; volatile XB_LAS unsigned* st; };
__device__ __forceinline__ XcdBarrier xcd_barrier_post(unsigned* bar, volatile XB_LAS unsigned* st) {
    XcdBarrier b; b.bar = bar; b.x = xb_xcc_id(); b.st = st;
    if (threadIdx.x == 0) (void)xb_add(&bar[XB_XCNT(b.x)], 1u);
    return b;
}
__device__ __forceinline__ void xcd_barrier_complete(unsigned* bar, unsigned x, unsigned& nloc, unsigned& nx) {
    const unsigned G = gridDim.x * gridDim.y * gridDim.z;
    unsigned sum, cnt, mine, sp = 0u;
    for (;;) {
        sum = 0u; cnt = 0u; mine = 0u;
#pragma unroll
        for (unsigned j = 0; j < 16; ++j) { const unsigned c = xb_ld(&bar[XB_XCNT(j)]); sum += c; cnt += (c > 0u) ? 1u : 0u; mine = (j == x) ? c : mine; }
        if (sum == G) break;
        __builtin_amdgcn_s_sleep(1);
        if ((++sp & 255u) == 0u) { if (xb_ld(&bar[XB_TMO])) break; if (sp > XB_SPIN_CAP) { atomicAdd(&bar[XB_TMO], 1u); break; } }
    }
    nloc = mine > 0u ? mine : 1u; nx = cnt > 0u ? cnt : 1u;
}
__device__ __forceinline__ void xcd_barrier(const XcdBarrier& b) {
    asm volatile("s_waitcnt vmcnt(0)" ::: "memory");
    __syncthreads();
    if (threadIdx.x == 0) {
        unsigned* bar = b.bar;
        __builtin_amdgcn_s_waitcnt(0);
        unsigned nloc = b.st[0], nx = b.st[1];
        if (nloc == 0u) { xcd_barrier_complete(bar, b.x, nloc, nx); b.st[0] = nloc; b.st[1] = nx; }
        const unsigned old = xb_add(&bar[XB_XSUB(b.x)], 1u);
        const unsigned gen = old / nloc;
        if (old + 1u == (gen + 1u) * nloc) {
            __builtin_amdgcn_fence(__ATOMIC_RELEASE, "agent");
            asm volatile("s_waitcnt vmcnt(0)" ::: "memory");
            const unsigned og = xb_add(&bar[XB_TOP], 1u);
            const unsigned tg = og / nx;
            if (og + 1u == (tg + 1u) * nx) xb_add(&bar[XB_TOPGEN], 1u);
            else XB_SPIN(xb_ld(&bar[XB_TOPGEN]) == tg, bar);
            __builtin_amdgcn_fence(__ATOMIC_ACQUIRE, "agent");
            xb_add(&bar[XB_XGEN(b.x)], 1u);
            asm volatile("s_waitcnt vmcnt(0)" ::: "memory");
        } else {
            XB_SPIN(xb_ld(&bar[XB_XGEN(b.x)]) == gen, bar);
            __builtin_amdgcn_fence(__ATOMIC_ACQUIRE, "agent");
            asm volatile("s_waitcnt vmcnt(0)" ::: "memory");
        }
    }
    __syncthreads();
}
#endif
#if !defined(CPU_EMU) && !MK_MULTI
__global__ void __launch_bounds__(512, 2) k_mega(Params p_) {
    DYN_SMEM(smem);
    KParams pk = (KParams)__builtin_amdgcn_kernarg_segment_ptr();
    cg::grid_group grid = cg::this_grid();
    volatile XB_LAS unsigned* xst = (volatile XB_LAS unsigned*)(XB_LAS char*)(smem + SMEM_BYTES);
    if (threadIdx.x == 0) { xst[0] = 0u; xst[1] = 0u; xst[2] = 0u; xst[3] = 0u; }
    __syncthreads();
    const XcdBarrier xb = xcd_barrier_post((unsigned*)(pk->ws + OFF_BAR), xst);
    if (gridDim.x > 0x100000u) grid.sync();
    constexpr int NIT = NL_ * PH_PER_LAYER;
#pragma unroll 1
    for (int it = -1; it <= NIT; ++it) {
        const int l = (it >= 0 && it < NIT) ? it / PH_PER_LAYER : 0, ph = it < 0 ? (int)PH_WPREP : (it < NIT ? it % PH_PER_LAYER : (int)PH_FINAL);
        KParams q = pk; asm volatile("" : "+s"(q));
        run_phase(q, l, ph, smem);
        if (it >= 0 && it < NIT - 1 && !(l > 0 && ph == PH_NORM_MIX)) {
            xcd_barrier(xb);
        }
    }
}
#endif
#ifdef CPU_EMU
__global__ void k_phase(Params p_, int l, int ph) { DYN_SMEM(smem); run_phase(&p_, l, ph, smem); }
#elif MK_MULTI
__global__ void __launch_bounds__(512, 2) k_phase(Params p_, int l, int ph) { DYN_SMEM(smem); KParams pk = (KParams)__builtin_amdgcn_kernarg_segment_ptr(); run_phase(pk, l, ph, smem); }
#endif
}

#ifdef CPU_EMU
int g_emu_stop = 1000;
#endif

extern "C" void kernel_launch(void* const* d_in, const int* in_sizes, int n_in, void* d_out, int out_size, void* d_ws, size_t ws_size, hipStream_t stream) {
    Params p{};
    for (int i = 0; i < N_IN; ++i) p.in[i] = (const float*)d_in[i];
    p.out = (float*)d_out; p.ws = (char*)d_ws;
#if defined(CPU_EMU) || MK_MULTI
    const int grid = 256;
    LAUNCH(k_phase, grid, NT, SMEM_BYTES, stream, p, 0, (int)PH_WPREP);
    for (int l = 0; l < NL_; ++l)
        for (int ph = 0; ph < PH_PER_LAYER; ++ph) {
            LAUNCH(k_phase, grid, NT, SMEM_BYTES, stream, p, l, ph);
#ifdef CPU_EMU
            const int code = ph == PH_INPROJ ? 1 : ph == PH_MIXERS ? 2 : ph == PH_MERGE ? 3 : ph == PH_WOUT ? 4 : ph == PH_GATHER ? 5 : 0;
            if (code && g_emu_stop == l * 10 + code) return;
#endif
        }
    LAUNCH(k_phase, grid, NT, SMEM_BYTES, stream, p, 0, (int)PH_FINAL);
#else
    static int grid_blocks = 0;
    if (!grid_blocks) {
        int dev = 0, cus = 0, per_cu = 0;
        (void)hipGetDevice(&dev);
        (void)hipDeviceGetAttribute(&cus, hipDeviceAttributeMultiprocessorCount, dev);
        (void)hipFuncSetAttribute((const void*)k_mega, hipFuncAttributeMaxDynamicSharedMemorySize, (int)SMEM_BYTES + 16);
        (void)hipOccupancyMaxActiveBlocksPerMultiprocessor(&per_cu, k_mega, NT, SMEM_BYTES + 16);
        if (per_cu > 1) per_cu = 1;
        grid_blocks = cus * per_cu;
    }
    (void)hipMemsetAsync((char*)d_ws + OFF_BAR, 0, 16384, stream);
    void* args[] = {&p};
    hipError_t e = hipLaunchCooperativeKernel((void*)k_mega, dim3(grid_blocks), dim3(NT), args, SMEM_BYTES + 16, stream);
    if (e != hipSuccess) fprintf(stderr, "cooperative launch failed: %s (grid %d)\n", hipGetErrorString(e), grid_blocks);
#endif
}
```
